# Optimizing an MI355X kernel written in HIP

```python
import math
import jax, jax.numpy as jnp
from jax import lax
import numpy as np

D_MODEL = 1024
BATCH = 2
SEQ = 16384
DEPTH = 4

MEM_LEN = 256
N_MIXERS = 2
MIX_WIDTH = 768
MEM_HEADS = 4
MEM_HEAD_DIM = 64
MEM_WIDTH = MEM_HEADS * MEM_HEAD_DIM
MIX_TOTAL = MIX_WIDTH + MEM_WIDTH
HGRN_EXPAND = 128
HGRN_HEADS = MIX_WIDTH // HGRN_EXPAND
HGRN_VDIM = MIX_WIDTH // HGRN_HEADS
HGRN_CHUNK = 64
MOBA_HEADS = 12
MOBA_HEAD_DIM = MIX_WIDTH // MOBA_HEADS
MOBA_BLOCK = 256
MOBA_TOPK = 3
MOBA_QBLOCK = 32
N_EXPERTS = 32
TOP_K = 4
D_FF = 1024
SWIGLU_ALPHA = 1.702
SWIGLU_LIMIT = 7.0
MOE_ROW_BLOCK = 512
DEEPNORM_ALPHA = (2 * DEPTH) ** 0.25
DEEPNORM_BETA = (8 * DEPTH) ** -0.25
LN_EPS = 1e-5
RMS_EPS = 1e-6
N_HGRN_LAYERS = (DEPTH + 1) // 2
N_MOBA_LAYERS = DEPTH // 2
HGRN_COLS = 4 * MIX_WIDTH + MEM_WIDTH
MOBA_COLS = 3 * MIX_WIDTH + MEM_WIDTH

kernel_name = 'hybrid_hgrn2_moba_memxattn_moe_deepnorm'


def _alibi_slope_list(n):
    def pow2(m):
        start = 2.0 ** (-(2.0 ** -(math.log2(m) - 3)))
        return [start ** (i + 1) for i in range(m)]
    if math.log2(n).is_integer():
        return pow2(n)
    c = 2 ** math.floor(math.log2(n))
    return pow2(c) + _alibi_slope_list(2 * c)[0::2][:n - c]


def alibi_slopes(n):
    return jnp.asarray(_alibi_slope_list(n), dtype=jnp.float32)


def layer_norm(x, g, b):
    xf = x.astype(jnp.float32)
    mu = jnp.mean(xf, axis=-1, keepdims=True)
    var = jnp.mean(jnp.square(xf - mu), axis=-1, keepdims=True)
    return ((xf - mu) * lax.rsqrt(var + LN_EPS) * g.astype(jnp.float32) + b.astype(jnp.float32)).astype(x.dtype)


def hgrn2_mixer(h, lb, norm_g):
    B, S, _ = h.shape
    dt = h.dtype
    q, f, i, g = jnp.split(h, 4, axis=-1)
    q = jax.nn.silu(q.astype(jnp.float32))
    forget = lb + (1.0 - lb) * jax.nn.sigmoid(f.astype(jnp.float32))
    k = 1.0 - forget
    logf = jnp.log(forget)
    nc = S // HGRN_CHUNK

    def to_chunks(t, d):
        return t.reshape(B, nc, HGRN_CHUNK, HGRN_HEADS, d).transpose(1, 0, 3, 2, 4)

    qs = to_chunks(q, HGRN_EXPAND)
    ks = to_chunks(k, HGRN_EXPAND)
    gs = to_chunks(logf, HGRN_EXPAND)
    vs = to_chunks(i.astype(jnp.float32), HGRN_VDIM)
    causal = jnp.tril(jnp.ones((HGRN_CHUNK, HGRN_CHUNK), dtype=bool))

    def step(state, inp):
        qc, kc, vc, gc = inp
        G = jnp.cumsum(gc, axis=2)
        diff = jnp.where(causal[:, :, None], G[:, :, :, None, :] - G[:, :, None, :, :], -jnp.inf)
        A = jnp.einsum('bhtd,bhsd,bhtsd->bhts', qc, kc, jnp.exp(diff))
        o = (jnp.einsum('bhts,bhsv->bhtv', A, vc)
             + jnp.einsum('bhtd,bhdv->bhtv', qc * jnp.exp(G), state))
        G_end = G[:, :, -1:, :]
        state = (jnp.exp(G_end[:, :, 0, :, None]) * state
                 + jnp.einsum('bhsd,bhsv->bhdv', kc * jnp.exp(G_end - G), vc))
        return state, o

    state0 = jnp.zeros((B, HGRN_HEADS, HGRN_EXPAND, HGRN_VDIM), jnp.float32)
    _, o = lax.scan(step, state0, (qs, ks, vs, gs))
    o = o.transpose(1, 0, 3, 2, 4).reshape(B, S, HGRN_HEADS, HGRN_VDIM)
    o = o * lax.rsqrt(jnp.mean(jnp.square(o), axis=-1, keepdims=True) + RMS_EPS) * norm_g.astype(jnp.float32)
    o = o.reshape(B, S, MIX_WIDTH) * jax.nn.sigmoid(g.astype(jnp.float32))
    return o.astype(dt)


def moba_attention(h):
    B, S, _ = h.shape
    H, dh, BLK = MOBA_HEADS, MOBA_HEAD_DIM, MOBA_BLOCK
    q, k, v = jnp.split(h, 3, axis=-1)
    q, k, v = (t.reshape(B, S, H, dh).transpose(0, 2, 1, 3) for t in (q, k, v))
    nb = -(-S // BLK)
    pad = nb * BLK - S
    k = jnp.pad(k, ((0, 0), (0, 0), (0, pad), (0, 0)))
    v = jnp.pad(v, ((0, 0), (0, 0), (0, pad), (0, 0)))
    k_blocks = k.reshape(B, H, nb, BLK, dh)
    v_blocks = v.reshape(B, H, nb, BLK, dh)
    k_mean = jnp.mean(k_blocks.astype(jnp.float32), axis=3)
    n_sel = min(MOBA_TOPK, nb)
    slopes = alibi_slopes(H)
    scale = dh ** -0.5
    b_idx = jnp.arange(B)[:, None, None, None]
    h_idx = jnp.arange(H)[None, :, None, None]
    blk_pos = jnp.arange(BLK)
    blk_ids = jnp.arange(nb)

    def one_query_block(c):
        t0 = c * MOBA_QBLOCK
        qc = lax.dynamic_slice_in_dim(q, t0, MOBA_QBLOCK, axis=2)
        t = t0 + jnp.arange(MOBA_QBLOCK)
        cur = t0 // BLK
        gate = jnp.einsum('bhqd,bhnd->bhqn', qc.astype(jnp.float32), k_mean)
        gate = jnp.where(blk_ids < cur, gate, -jnp.inf)
        _, sel = lax.top_k(gate, n_sel)
        valid = sel < cur
        k_sel = k_blocks[b_idx, h_idx, sel]
        v_sel = v_blocks[b_idx, h_idx, sel]
        s_sel = sel[..., None] * BLK + blk_pos
        lg_sel = (jnp.einsum('bhqd,bhqnkd->bhqnk', qc, k_sel).astype(jnp.float32) * scale
                  - slopes[:, None, None, None] * (t[:, None, None] - s_sel).astype(jnp.float32))
        lg_sel = jnp.where(valid[..., None], lg_sel, -jnp.inf)
        k_own = lax.dynamic_slice_in_dim(k, cur * BLK, BLK, axis=2)
        v_own = lax.dynamic_slice_in_dim(v, cur * BLK, BLK, axis=2)
        s_own = cur * BLK + blk_pos
        lg_own = (jnp.einsum('bhqd,bhkd->bhqk', qc, k_own).astype(jnp.float32) * scale
                  - slopes[:, None, None] * (t[:, None] - s_own[None, :]).astype(jnp.float32))
        lg_own = jnp.where(s_own[None, :] <= t[:, None], lg_own, -jnp.inf)
        logits = jnp.concatenate([lg_sel.reshape(B, H, MOBA_QBLOCK, n_sel * BLK), lg_own], axis=-1)
        p = jax.nn.softmax(logits, axis=-1).astype(v.dtype)
        p_sel = p[..., :n_sel * BLK].reshape(B, H, MOBA_QBLOCK, n_sel, BLK)
        p_own = p[..., n_sel * BLK:]
        return (jnp.einsum('bhqnk,bhqnkd->bhqd', p_sel, v_sel)
                + jnp.einsum('bhqk,bhkd->bhqd', p_own, v_own))

    out = lax.map(one_query_block, jnp.arange(S // MOBA_QBLOCK))
    return out.transpose(1, 0, 3, 2, 4).reshape(B, S, MIX_WIDTH)


def memory_attention(q_mem, mem, w_kv):
    B, S, _ = q_mem.shape
    q = q_mem.reshape(B, S, MEM_HEADS, MEM_HEAD_DIM)
    kv = mem @ w_kv
    km, vm = jnp.split(kv, 2, axis=-1)
    km = km.reshape(B, -1, MEM_HEADS, MEM_HEAD_DIM)
    vm = vm.reshape(B, -1, MEM_HEADS, MEM_HEAD_DIM)
    s = jnp.einsum('bshd,bmhd->bhsm', q, km).astype(jnp.float32) * (MEM_HEAD_DIM ** -0.5)
    p = jax.nn.softmax(s, axis=-1).astype(vm.dtype)
    return jnp.einsum('bhsm,bmhd->bshd', p, vm).reshape(B, S, MEM_WIDTH)


def moe_ffn(x, w_router, b_router, w_gate, b_gate, w_up, b_up, w_down, b_down):
    B, S, D = x.shape
    T = B * S
    TK = T * TOP_K
    xt = x.reshape(T, D)
    logits = (xt @ w_router + b_router).astype(jnp.float32)
    top_val, top_idx = lax.top_k(logits, TOP_K)
    gates = jax.nn.softmax(top_val, axis=-1)
    flat_e = top_idx.reshape(-1)
    order = jnp.argsort(flat_e)
    sorted_e = flat_e[order]
    sorted_tok = (order // TOP_K).astype(jnp.int32)
    sorted_w = gates.reshape(-1)[order]
    counts = jnp.bincount(flat_e, length=N_EXPERTS)
    starts = jnp.cumsum(counts) - counts
    padded = (counts + MOE_ROW_BLOCK - 1) // MOE_ROW_BLOCK * MOE_ROW_BLOCK
    padded_ends = jnp.cumsum(padded)
    padded_starts = padded_ends - padded
    dest = padded_starts[sorted_e] + jnp.arange(TK) - starts[sorted_e]
    n_blocks = -(-TK // MOE_ROW_BLOCK) + N_EXPERTS
    n_rows = n_blocks * MOE_ROW_BLOCK
    row_tok = jnp.zeros((n_rows,), jnp.int32).at[dest].set(sorted_tok)
    row_w = jnp.zeros((n_rows,), x.dtype).at[dest].set(sorted_w.astype(x.dtype))
    block_e = jnp.minimum(
        jnp.searchsorted(padded_ends, jnp.arange(n_blocks) * MOE_ROW_BLOCK, side='right'),
        N_EXPERTS - 1)

    def expert_block(args):
        tok, w, e = args
        xb = xt[tok]
        gate = jnp.minimum(xb @ w_gate[e] + b_gate[e], SWIGLU_LIMIT)
        up = jnp.clip(xb @ w_up[e] + b_up[e], -SWIGLU_LIMIT, SWIGLU_LIMIT)
        hid = gate * jax.nn.sigmoid(SWIGLU_ALPHA * gate) * (up + 1.0)
        return (hid @ w_down[e] + b_down[e]) * w[:, None]

    y_rows = lax.map(expert_block, (row_tok.reshape(n_blocks, MOE_ROW_BLOCK),
                                    row_w.reshape(n_blocks, MOE_ROW_BLOCK), block_e))
    y = jax.ops.segment_sum(y_rows.reshape(n_rows, D), row_tok, num_segments=T)
    return y.reshape(B, S, D).astype(x.dtype)


def setup_inputs(seed: int = 0) -> dict:
    key = jax.random.key(seed)
    ks = jax.random.split(key, 22)
    nrm = jax.random.normal
    f32 = jnp.float32
    d = D_MODEL
    return {
        'x': nrm(ks[0], (BATCH, SEQ, d), f32),
        'mem': nrm(ks[1], (BATCH, MEM_LEN, d), f32),
        'w_in_hgrn': nrm(ks[2], (N_HGRN_LAYERS, d, HGRN_COLS), f32) * d ** -0.5,
        'hgrn_lb_logits': nrm(ks[3], (N_HGRN_LAYERS, MIX_WIDTH), f32) * 0.5,
        'hgrn_norm_g': 1.0 + 0.02 * nrm(ks[4], (N_HGRN_LAYERS, HGRN_VDIM), f32),
        'w_in_moba': nrm(ks[5], (N_MOBA_LAYERS, d, MOBA_COLS), f32) * d ** -0.5,
        'w_mem_kv': nrm(ks[6], (DEPTH, d, 2 * MEM_WIDTH), f32) * d ** -0.5,
        'w_o': nrm(ks[7], (DEPTH, MIX_TOTAL, d), f32) * (MIX_TOTAL ** -0.5 * DEEPNORM_BETA),
        'ln_mix_g': 1.0 + 0.02 * nrm(ks[8], (DEPTH, d), f32),
        'ln_mix_b': 0.02 * nrm(ks[9], (DEPTH, d), f32),
        'w_router': nrm(ks[10], (DEPTH, d, N_EXPERTS), f32) * d ** -0.5,
        'b_router': 0.01 * nrm(ks[11], (DEPTH, N_EXPERTS), f32),
        'w_gate': nrm(ks[12], (DEPTH, N_EXPERTS, d, D_FF), f32) * d ** -0.5,
        'b_gate': 0.01 * nrm(ks[13], (DEPTH, N_EXPERTS, D_FF), f32),
        'w_up': nrm(ks[14], (DEPTH, N_EXPERTS, d, D_FF), f32) * d ** -0.5,
        'b_up': 0.01 * nrm(ks[15], (DEPTH, N_EXPERTS, D_FF), f32),
        'w_down': nrm(ks[16], (DEPTH, N_EXPERTS, D_FF, d), f32) * (D_FF ** -0.5 * DEEPNORM_BETA),
        'b_down': 0.01 * nrm(ks[17], (DEPTH, N_EXPERTS, d), f32),
        'ln_ffn_g': 1.0 + 0.02 * nrm(ks[18], (DEPTH, d), f32),
        'ln_ffn_b': 0.02 * nrm(ks[19], (DEPTH, d), f32),
    }


def reference(x, mem, w_in_hgrn, hgrn_lb_logits, hgrn_norm_g, w_in_moba, w_mem_kv, w_o,
              ln_mix_g, ln_mix_b, w_router, b_router, w_gate, b_gate, w_up, b_up,
              w_down, b_down, ln_ffn_g, ln_ffn_b):
    p_lb = jax.nn.softmax(hgrn_lb_logits.astype(jnp.float32), axis=0)
    lower_bounds = jnp.cumsum(p_lb, axis=0) - p_lb[0]
    for layer in range(DEPTH):
        j = layer // N_MIXERS
        if layer % N_MIXERS == 0:
            h = x @ w_in_hgrn[j]
            mix = hgrn2_mixer(h[..., :4 * MIX_WIDTH], lower_bounds[j], hgrn_norm_g[j])
        else:
            h = x @ w_in_moba[j]
            mix = moba_attention(h[..., :3 * MIX_WIDTH])
        mem_out = memory_attention(h[..., -MEM_WIDTH:], mem, w_mem_kv[layer])
        y = jnp.concatenate([mix, mem_out.astype(mix.dtype)], axis=-1) @ w_o[layer]
        x = layer_norm(DEEPNORM_ALPHA * x + y, ln_mix_g[layer], ln_mix_b[layer])
        f = moe_ffn(x, w_router[layer], b_router[layer], w_gate[layer], b_gate[layer],
                    w_up[layer], b_up[layer], w_down[layer], b_down[layer])
        x = layer_norm(DEEPNORM_ALPHA * x + f, ln_ffn_g[layer], ln_ffn_b[layer])
    return x
```

```cpp
#include <hip/hip_runtime.h>
#include <cstdio>
#include <cstdint>
#include <cmath>
namespace pg8 {
#define PG8_LAS __attribute__((address_space(3)))
typedef unsigned short bf16_t;
typedef short bf16x8 __attribute__((ext_vector_type(8)));
typedef float f32x4 __attribute__((ext_vector_type(4)));
typedef unsigned u32x4 __attribute__((ext_vector_type(4)));
constexpr int BM = 256, BK = 64, HALF = 128, HTB = HALF * BK * 2  , STAGE_BYTES = 8 * HTB, NXCD = 8, WGM = 8;

__host__ __device__ __forceinline__ int lds_byte(int r, int c) { const int st = (r >> 4) * 2 + (c >> 5), rr = r & 15, cc = c & 31, ob = rr * 64 + cc * 2; return st * 1024 + (ob ^ (((ob >> 9) & 1) << 5)); }
__host__ __device__ __forceinline__ void stage_rc(int b, int& R, int& C) { const int st = b / 1024, sb = b % 1024, swz = sb ^ (((sb >> 9) & 1) << 5); R = (st >> 1) * 16 + swz / 64; C = (st & 1) * 32 + (swz % 64) / 2; }
__host__ __device__ __forceinline__ int perm32(int rho) { const int n = rho >> 4, i = rho & 15; return 8 * (i >> 2) + 4 * n + (i & 3); }

struct Unit { int pm, pn; };
struct Gemm { const bf16_t* A; const bf16_t* Bt; int M, N, K; };

struct StaticOrder {
    int nM, nN, nwg, G, c;
    __host__ __device__ void init(int M, int N, int G_, int c_) { nM = M / BM; nN = N / BM; nwg = nM * nN; G = G_; c = c_; }
    __host__ __device__ bool next(int i, Unit& u) const {
        const long L = (long)i * G + c; if (L >= nwg) return false;
        int wgid = (int)L; { const int q = nwg / NXCD, r = nwg % NXCD, xcd = wgid % NXCD, off = wgid / NXCD; wgid = (xcd < r ? xcd * (q + 1) : r * (q + 1) + (xcd - r) * q) + off; }
        const int nig = WGM * nN, gid = wgid / nig, fm = gid * WGM, gsz = (nM - fm) < WGM ? (nM - fm) : WGM;
        u.pm = fm + ((wgid % nig) % gsz); u.pn = (wgid % nig) / gsz; return true;
    }
    __device__ __forceinline__ void a_ready(const Unit&) const {}
    __device__ __forceinline__ void done(const Unit&) const {}
};

__device__ __forceinline__ unsigned cvt_pk_bf16(float lo, float hi) { unsigned r; asm volatile("v_cvt_pk_bf16_f32 %0, %1, %2" : "=v"(r) : "v"(lo), "v"(hi)); return r; }
typedef float f32x2 __attribute__((ext_vector_type(2)));
struct EpiPlain {
    static constexpr bool PERM = true, AFTER_DRAIN = false;
    bf16_t* O; int ldc;
    __device__ __forceinline__ void operator()(const f32x4 (&acc)[2][2][4][2], const Unit& u, int wr, int wc, int fr, int fq) const {
        const int row0 = u.pm * BM + wr * 64 + fr; const int col0 = u.pn * BM + wc * 32 + 8 * fq;
#pragma unroll
        for (int ai = 0; ai < 2; ++ai)
#pragma unroll
            for (int m = 0; m < 4; ++m) { bf16_t* rowp = O + (size_t)(row0 + ai * HALF + m * 16) * ldc + col0;
#pragma unroll
                for (int bj = 0; bj < 2; ++bj) { const f32x4 v0 = acc[ai][bj][m][0], v1 = acc[ai][bj][m][1];
                    u32x4 w; w.x = cvt_pk_bf16(v0[0], v0[1]); w.y = cvt_pk_bf16(v0[2], v0[3]); w.z = cvt_pk_bf16(v1[0], v1[1]); w.w = cvt_pk_bf16(v1[2], v1[3]);
                    *(u32x4*)(rowp + bj * HALF) = w; } }
    }
};
__device__ __forceinline__ float swiglu1(float g, float u) {
    g = fminf(g, 7.0f); u = fminf(fmaxf(u, -7.0f), 7.0f);
    const float s = __builtin_amdgcn_rcpf(1.0f + __builtin_amdgcn_exp2f(g * (-1.702f * 1.4426950408889634f)));
    return g * s * (u + 1.0f);
}
struct EpiSwiglu {
    static constexpr bool PERM = true, AFTER_DRAIN = false;
    bf16_t* hid; const float* bg; const float* bu;
    __device__ __forceinline__ void operator()(const f32x4 (&acc)[2][2][4][2], const Unit& u, int wr, int wc, int fr, int fq) const {
        const int e = u.pn >> 3, pn = u.pn & 7;
        const int row0 = u.pm * BM + wr * 64 + fr; const int col0 = pn * 128 + wc * 32 + 8 * fq;
        const f32x4 g0 = *(const f32x4*)(bg + e * 1024 + col0), g1 = *(const f32x4*)(bg + e * 1024 + col0 + 4);
        const f32x4 u0 = *(const f32x4*)(bu + e * 1024 + col0), u1 = *(const f32x4*)(bu + e * 1024 + col0 + 4);
#pragma unroll
        for (int ai = 0; ai < 2; ++ai)
#pragma unroll
            for (int m = 0; m < 4; ++m) { bf16_t* rowp = hid + (size_t)(row0 + ai * HALF + m * 16) * 1024 + col0;
                const f32x4 ga = acc[ai][0][m][0] + g0, gb = acc[ai][0][m][1] + g1, ua = acc[ai][1][m][0] + u0, ub = acc[ai][1][m][1] + u1;
                u32x4 w;
                w.x = cvt_pk_bf16(swiglu1(ga[0], ua[0]), swiglu1(ga[1], ua[1])); w.y = cvt_pk_bf16(swiglu1(ga[2], ua[2]), swiglu1(ga[3], ua[3]));
                w.z = cvt_pk_bf16(swiglu1(gb[0], ub[0]), swiglu1(gb[1], ub[1])); w.w = cvt_pk_bf16(swiglu1(gb[2], ub[2]), swiglu1(gb[3], ub[3]));
                *(u32x4*)rowp = w; }
    }
};
struct EpiDown {
    static constexpr bool PERM = true, AFTER_DRAIN = false;
    bf16_t* y; const float* bd;
    __device__ __forceinline__ void operator()(const f32x4 (&acc)[2][2][4][2], const Unit& u, int wr, int wc, int fr, int fq) const {
        const int e = u.pn >> 2, pn = u.pn & 3;
        const int row0 = u.pm * BM + wr * 64 + fr; const int col0 = pn * BM + wc * 32 + 8 * fq;
        f32x4 bv[2][2];
#pragma unroll
        for (int bj = 0; bj < 2; ++bj)
#pragma unroll
            for (int n = 0; n < 2; ++n) bv[bj][n] = *(const f32x4*)(bd + e * 1024 + col0 + bj * HALF + 4 * n);
#pragma unroll
        for (int ai = 0; ai < 2; ++ai)
#pragma unroll
            for (int m = 0; m < 4; ++m) { bf16_t* rowp = y + (size_t)(row0 + ai * HALF + m * 16) * 1024 + col0;
#pragma unroll
                for (int bj = 0; bj < 2; ++bj) { const f32x4 v0 = acc[ai][bj][m][0] + bv[bj][0], v1 = acc[ai][bj][m][1] + bv[bj][1];
                    u32x4 w; w.x = cvt_pk_bf16(v0[0], v0[1]); w.y = cvt_pk_bf16(v0[2], v0[3]); w.z = cvt_pk_bf16(v1[0], v1[1]); w.w = cvt_pk_bf16(v1[2], v1[3]);
                    *(u32x4*)(rowp + bj * HALF) = w; } }
    }
};
struct MoeOrder {
    const PG8_LAS int* tab; int npn, G, c, nunits;
    __device__ __forceinline__ bool next(int i, Unit& u) const {
        const int L = i * G + c; if (L >= nunits) return false;
        const int tile = L / npn, pn = L - tile * npn; int e = 0;
#pragma unroll
        for (int k = 1; k < 32; ++k) e += (tab[k] <= tile) ? 1 : 0;
        u.pm = tile; u.pn = e * npn + pn; return true;
    }
    __device__ __forceinline__ void a_ready(const Unit&) const {}
    __device__ __forceinline__ void done(const Unit&) const {}
};
template <class Epi, class Sched, bool ALIGN_EPI = false, bool SP2 = false>
__device__ __forceinline__ void gemm_phase(PG8_LAS unsigned char* lds, const Gemm g, const Sched& S, const Epi& E) {
    const int tid = threadIdx.x, wid = __builtin_amdgcn_readfirstlane(tid >> 6), lane = tid & 63, wr = wid >> 2, wc = wid & 3, fr = lane & 15, fq = lane >> 4;
    const int K = g.K, nt = K / BK;
    unsigned voffA[2], voffB[2];
#pragma unroll
    for (int i = 0; i < 2; ++i) { int R, C; stage_rc(tid * 16 + i * 8192, R, C); const int Rb = Epi::PERM ? ((R & ~31) + perm32(R & 31)) : R;
        voffA[i] = (unsigned)(R * K + C) * 2u; voffB[i] = (unsigned)(Rb * K + C) * 2u; }
    const size_t kstep = (size_t)(BK * 2);
    const size_t hstep = (size_t)HALF * K * 2;
    const size_t tstep = 2 * hstep;
    const unsigned ldsw = (unsigned)wid * 1024u;
    const int aoff = lds_byte(wr * 64 + fr, fq * 8), boff = lds_byte(wc * 32 + fr, fq * 8);
#define PG8_SA(b, h) (((b) * 2 + (h)) * HTB)
#define PG8_SB(b, h) ((4 + (b) * 2 + (h)) * HTB)
#define PG8_STAGE(bufoff, gbase, voff) do { _Pragma("unroll") for (int _i = 0; _i < 2; ++_i) \
        __builtin_amdgcn_global_load_lds((const unsigned*)((const char*)(gbase) + (voff)[_i]), (PG8_LAS unsigned*)(lds + (bufoff) + ldsw + _i * 8192), 16, 0, 0); } while (0)
#define PG8_LDA(dst, b, h) do { _Pragma("unroll") for (int m = 0; m < 4; ++m) _Pragma("unroll") for (int k = 0; k < 2; ++k) dst[m][k] = *(const PG8_LAS bf16x8*)(lds + PG8_SA(b, h) + aoff + m * 2048 + k * 1024); } while (0)
#define PG8_LDB(dst, b, h) do { _Pragma("unroll") for (int n = 0; n < 2; ++n) _Pragma("unroll") for (int k = 0; k < 2; ++k) dst[n][k] = *(const PG8_LAS bf16x8*)(lds + PG8_SB(b, h) + boff + n * 2048 + k * 1024); } while (0)
#define PG8_MMA(ai, bj, At, Bt) do { __builtin_amdgcn_s_setprio(1); _Pragma("unroll") for (int m = 0; m < 4; ++m) _Pragma("unroll") for (int n = 0; n < 2; ++n) _Pragma("unroll") for (int k = 0; k < 2; ++k) \
        acc[ai][bj][m][n] = __builtin_amdgcn_mfma_f32_16x16x32_bf16(Bt[n][k], At[m][k], acc[ai][bj][m][n], 0, 0, 0); __builtin_amdgcn_s_setprio(0); } while (0)
#define PG8_WAIT_V(n) asm volatile("s_waitcnt vmcnt(" #n ")" ::: "memory")
#define PG8_WAIT_L(n) asm volatile("s_waitcnt lgkmcnt(" #n ")" ::: "memory")
#define PG8_BAR __builtin_amdgcn_s_barrier()
#define PG8_SCHED __builtin_amdgcn_sched_barrier(0)
    Unit cur, nxt; int ui = 0;
    if (!S.next(0, cur)) return;
    f32x4 acc[2][2][4][2];
#pragma unroll
    for (int a = 0; a < 2; ++a)
#pragma unroll
        for (int b = 0; b < 2; ++b)
#pragma unroll
            for (int m = 0; m < 4; ++m)
#pragma unroll
                for (int n = 0; n < 2; ++n) acc[a][b][m][n] = (f32x4){0.f, 0.f, 0.f, 0.f};
    bf16x8 At[4][2], B0[2][2], B1[2][2];
    const char* cA = (const char*)g.A + (size_t)cur.pm * tstep; const char* cB = (const char*)g.Bt + (size_t)cur.pn * tstep;
    S.a_ready(cur);
    if constexpr (SP2) {
        PG8_STAGE(PG8_SB(0, 0), cB, voffB); PG8_STAGE(PG8_SB(0, 1), cB + hstep, voffB); PG8_STAGE(PG8_SA(0, 0), cA, voffA); PG8_STAGE(PG8_SA(0, 1), cA + hstep, voffA);
        if (wr == 1) PG8_BAR;
        PG8_WAIT_V(2); PG8_BAR;
        PG8_STAGE(PG8_SB(1, 0), cB + kstep, voffB); PG8_STAGE(PG8_SA(1, 0), cA + kstep, voffA); PG8_STAGE(PG8_SB(1, 1), cB + hstep + kstep, voffB);
        PG8_WAIT_V(6); PG8_BAR;
    } else {
        PG8_STAGE(PG8_SB(0, 0), cB, voffB); PG8_STAGE(PG8_SA(0, 0), cA, voffA); PG8_STAGE(PG8_SB(0, 1), cB + hstep, voffB); PG8_STAGE(PG8_SA(0, 1), cA + hstep, voffA);
        if (wr == 1) PG8_BAR;
        PG8_WAIT_V(4); PG8_BAR;
        PG8_STAGE(PG8_SB(1, 0), cB + kstep, voffB); PG8_STAGE(PG8_SA(1, 0), cA + kstep, voffA); PG8_STAGE(PG8_SB(1, 1), cB + hstep + kstep, voffB);
        PG8_WAIT_V(6); PG8_BAR;
    }
    for (;;) {
        const bool has_next = S.next(ui + 1, nxt);
        const char* nA = has_next ? (const char*)g.A + (size_t)nxt.pm * tstep : cA; const char* nB = has_next ? (const char*)g.Bt + (size_t)nxt.pn * tstep : cB;
        for (int t = 0; t < nt; t += 2) {
            const bool last = (t == nt - 2);
            const char* a1 = cA + (size_t)(t + 1) * kstep;
            const char* a2 = last ? nA : cA + (size_t)(t + 2) * kstep; const char* b2 = last ? nB : cB + (size_t)(t + 2) * kstep;
            const char* a3 = a2 + kstep; const char* b3 = b2 + kstep;
            if (last && has_next) S.a_ready(nxt);
            if constexpr (SP2) {
            PG8_LDB(B0, 0, 0); PG8_LDB(B1, 0, 1); PG8_SCHED; PG8_LDA(At, 0, 0); PG8_STAGE(PG8_SA(1, 1), a1 + hstep, voffA);
            PG8_WAIT_V(8); PG8_WAIT_L(0); PG8_BAR; PG8_MMA(0, 0, At, B0); PG8_MMA(0, 1, At, B1); PG8_BAR; PG8_SCHED;
            PG8_LDA(At, 0, 1); PG8_STAGE(PG8_SB(0, 0), b2, voffB); PG8_STAGE(PG8_SB(0, 1), b2 + hstep, voffB); PG8_STAGE(PG8_SA(0, 0), a2, voffA);
            PG8_WAIT_V(8); PG8_WAIT_L(0); PG8_BAR; PG8_MMA(1, 0, At, B0); PG8_MMA(1, 1, At, B1); PG8_BAR; PG8_SCHED;
            PG8_LDB(B0, 1, 0); PG8_LDB(B1, 1, 1); PG8_SCHED; PG8_LDA(At, 1, 0); PG8_STAGE(PG8_SA(0, 1), a2 + hstep, voffA);
            PG8_WAIT_V(8); PG8_WAIT_L(0); PG8_BAR; PG8_MMA(0, 0, At, B0); PG8_MMA(0, 1, At, B1); PG8_BAR; PG8_SCHED;
            PG8_LDA(At, 1, 1); PG8_STAGE(PG8_SB(1, 0), b3, voffB); PG8_STAGE(PG8_SB(1, 1), b3 + hstep, voffB); PG8_STAGE(PG8_SA(1, 0), a3, voffA);
            PG8_WAIT_V(8); PG8_WAIT_L(0); PG8_BAR; PG8_MMA(1, 0, At, B0); PG8_MMA(1, 1, At, B1); PG8_BAR; PG8_SCHED;
            } else {
            PG8_LDB(B0, 0, 0); PG8_SCHED; PG8_LDA(At, 0, 0); PG8_STAGE(PG8_SA(1, 1), a1 + hstep, voffA);
            PG8_WAIT_L(8); PG8_BAR; PG8_WAIT_L(0); PG8_MMA(0, 0, At, B0); PG8_BAR; PG8_SCHED;
            PG8_LDB(B1, 0, 1); PG8_STAGE(PG8_SB(0, 0), b2, voffB);
            PG8_BAR; PG8_WAIT_L(0); PG8_MMA(0, 1, At, B1); PG8_BAR;
            PG8_LDA(At, 0, 1); PG8_STAGE(PG8_SA(0, 0), a2, voffA);
            PG8_BAR; PG8_WAIT_L(0); PG8_MMA(1, 0, At, B0); PG8_BAR; PG8_SCHED;
            PG8_STAGE(PG8_SB(0, 1), b2 + hstep, voffB);
            PG8_WAIT_V(6); PG8_BAR; PG8_MMA(1, 1, At, B1); PG8_BAR;
            PG8_LDB(B0, 1, 0); PG8_SCHED; PG8_LDA(At, 1, 0); PG8_STAGE(PG8_SA(0, 1), a2 + hstep, voffA);
            PG8_WAIT_L(8); PG8_BAR; PG8_WAIT_L(0); PG8_MMA(0, 0, At, B0); PG8_BAR; PG8_SCHED;
            PG8_LDB(B1, 1, 1); PG8_STAGE(PG8_SB(1, 0), b3, voffB);
            PG8_BAR; PG8_WAIT_L(0); PG8_MMA(0, 1, At, B1); PG8_BAR;
            PG8_LDA(At, 1, 1); PG8_STAGE(PG8_SA(1, 0), a3, voffA);
            PG8_BAR; PG8_WAIT_L(0); PG8_MMA(1, 0, At, B0); PG8_BAR; PG8_SCHED;
            PG8_STAGE(PG8_SB(1, 1), b3 + hstep, voffB);
            PG8_WAIT_V(6); PG8_BAR; PG8_MMA(1, 1, At, B1); PG8_BAR;
            }
        }
        if constexpr (ALIGN_EPI) { if (wr == 0) PG8_BAR; }
        if constexpr (!Epi::AFTER_DRAIN) { E(acc, cur, wr, wc, fr, fq); S.done(cur); }
        if (!has_next) break;
#pragma unroll
        for (int a = 0; a < 2; ++a)
#pragma unroll
            for (int b = 0; b < 2; ++b)
#pragma unroll
                for (int m = 0; m < 4; ++m)
#pragma unroll
                    for (int n = 0; n < 2; ++n) acc[a][b][m][n] = (f32x4){0.f, 0.f, 0.f, 0.f};
        cur = nxt; cA = nA; cB = nB; ++ui;
        if constexpr (ALIGN_EPI) { if (wr == 1) PG8_BAR; }
    }
    PG8_WAIT_V(0);
    if constexpr (!ALIGN_EPI) { if (wr == 0) PG8_BAR; }
    PG8_BAR;
    if constexpr (Epi::AFTER_DRAIN) { E.fused(acc, cur, wr, wc, fr, fq, lds, wid, lane); S.done(cur); }
#undef PG8_SA
#undef PG8_SB
#undef PG8_STAGE
#undef PG8_LDA
#undef PG8_LDB
#undef PG8_MMA
#undef PG8_WAIT_V
#undef PG8_WAIT_L
#undef PG8_BAR
#undef PG8_SCHED
}
}

constexpr int NWAVES = 8, NTHR = 512, GRID = 256;
constexpr int NBATCH = 2, SEQ = 16384, T = NBATCH * SEQ, D = 1024, DEPTH = 4;
constexpr int MIXW = 768, NC_H = 3328, NC_M = 2560;
constexpr int HG_H = 6;
constexpr int HSEG = 256, HNSEG = SEQ / HSEG;
constexpr int MB_H = 12, MB_NB = 64;
constexpr int NE = 32;
constexpr float DN_ALPHA = 1.6817928305074290f;
constexpr int MOE_MAXROWS = T * 4 + NE * 256;
#ifndef ONE_LAUNCH
#define ONE_LAUNCH 1
#endif
constexpr int NPHASE = 13;

constexpr size_t MiB = 1u << 20;
constexpr size_t WS_CTL = 0, CTL_ZERO_BYTES = 1 * MiB;
constexpr size_t WS_WIN = 1 * MiB, WS_WKV = 9 * MiB, WS_WO = 10 * MiB, WS_WGU = 12 * MiB, WS_WD = 140 * MiB;
constexpr size_t WS_XBF = 204 * MiB, WS_XA = 268 * MiB, WS_XB = 396 * MiB, WS_MEMBF = 524 * MiB, WS_KV = 525 * MiB;
constexpr size_t WS_H = 526 * MiB, WS_MIX = 734 * MiB, WS_Y = 798 * MiB, WS_SLOC = 862 * MiB, WS_DSEG = 910 * MiB, WS_KMEAN = 911 * MiB;
constexpr size_t WS_SELINFO = 912 * MiB, WS_TOK = 914 * MiB, WS_R1 = 918 * MiB;
constexpr size_t WS_LIST = WS_R1, WS_PML = WS_R1 + 96 * MiB, WS_PO = WS_R1 + 108 * MiB;
constexpr size_t WS_XS = WS_R1, WS_HID = WS_R1 + 272 * MiB;
constexpr size_t WS_END = WS_R1 + 544 * MiB;
static_assert((size_t)MOE_MAXROWS * 1024 * 2 <= 272 * MiB, "moe rows");
static_assert((size_t)T * MB_H * 4 * 64 * 4 <= 384 * MiB && (size_t)24 * 64 * 16384 * 4 <= 96 * MiB, "moba bufs");
constexpr size_t TOK_E = 0, TOK_LR = 512 * 1024, TOK_W = 1024 * 1024, TOK_ROW = 1536 * 1024, TOK_BLKCNT = 2048 * 1024, TOK_TAB = 2048 * 1024 + 65536;
constexpr int CW_BAR = 4096, CW_GCOUNT = 8192;

constexpr int RING_BYTES = 131072, MISC_OFF = RING_BYTES, LDS_BYTES = 147456;

#define GAS __attribute__((address_space(1)))
#define LAS __attribute__((address_space(3)))
typedef unsigned short bf16;
typedef unsigned v4u __attribute__((ext_vector_type(4)));
typedef unsigned v2u __attribute__((ext_vector_type(2)));
typedef float f32x4 __attribute__((ext_vector_type(4)));
typedef float f32x2 __attribute__((ext_vector_type(2)));
#define LDS_WAIT() asm volatile("s_waitcnt lgkmcnt(0)" ::: "memory")
__device__ __forceinline__ unsigned f2bf(float f) { unsigned u = __builtin_bit_cast(unsigned, f); return (u + 0x7fffu + ((u >> 16) & 1u)) >> 16; }
__device__ __forceinline__ unsigned pk2(float lo, float hi) { return f2bf(lo) | (f2bf(hi) << 16); }
__device__ __forceinline__ float bflo(unsigned w) { return __builtin_bit_cast(float, w << 16); }
__device__ __forceinline__ float bfhi(unsigned w) { return __builtin_bit_cast(float, w & 0xffff0000u); }
__device__ __forceinline__ float bf2f(bf16 h) { return __builtin_bit_cast(float, (unsigned)h << 16); }
__device__ __forceinline__ float sigmoidf_(float z) { return __builtin_amdgcn_rcpf(1.0f + __builtin_amdgcn_exp2f(-1.4426950408889634f * z)); }
__device__ __forceinline__ float wave_sum(float v) {
#pragma unroll
    for (int o = 1; o < 64; o <<= 1) v += __shfl_xor(v, o);
    return v;
}
__device__ __forceinline__ float wave_max(float v) {
#pragma unroll
    for (int o = 1; o < 64; o <<= 1) v = fmaxf(v, __shfl_xor(v, o));
    return v;
}
#define XB_TMO      128
#define XB_XCNT(j)  (256  + 64 * (j))
#define XB_XSUB(j)  (1280 + 64 * (j))
#define XB_XGEN(j)  (2304 + 64 * (j))
#define XB_TOP      3328
#define XB_TOPGEN   3392
#define XCD_BAR_WORDS 3456
#define XB_SPIN_CAP (1u << 18)

__device__ __forceinline__ unsigned xb_ld(unsigned* p)              { return __hip_atomic_load(p, __ATOMIC_RELAXED, __HIP_MEMORY_SCOPE_AGENT); }
__device__ __forceinline__ unsigned xb_add(unsigned* p, unsigned v) { return __hip_atomic_fetch_add(p, v, __ATOMIC_RELAXED, __HIP_MEMORY_SCOPE_AGENT); }
__device__ __forceinline__ unsigned xb_xcc_id() { return (unsigned)__builtin_amdgcn_s_getreg((3 << 11) | 20) & 0xFu; }
#define XB_SPIN(cond, bar) do { unsigned _sp = 0; while (cond) { __builtin_amdgcn_s_sleep(1); \
    if ((++_sp & 255u) == 0u) { if (xb_ld(&(bar)[XB_TMO])) break; if (_sp > XB_SPIN_CAP) { atomicAdd(&(bar)[XB_TMO], 1u); break; } } } } while (0)

struct XcdBarrier {
    unsigned* bar; unsigned x;
    volatile LAS unsigned* st;
};

__device__ __forceinline__ XcdBarrier xcd_barrier_post(unsigned* bar, volatile LAS unsigned* st) {
    XcdBarrier b; b.bar = bar; b.x = xb_xcc_id(); b.st = st;
    if (threadIdx.x == 0) (void)xb_add(&bar[XB_XCNT(b.x)], 1u);
    return b;
}
__device__ __forceinline__ void xcd_barrier_complete(unsigned* bar, unsigned x, unsigned& nloc, unsigned& nx) {
    const unsigned G = gridDim.x * gridDim.y * gridDim.z;
    unsigned sum, cnt, mine, sp = 0u;
    for (;;) {
        sum = 0u; cnt = 0u; mine = 0u;
#pragma unroll
        for (unsigned j = 0; j < 16; ++j) { const unsigned c = xb_ld(&bar[XB_XCNT(j)]); sum += c; cnt += (c > 0u) ? 1u : 0u; mine = (j == x) ? c : mine; }
        if (sum == G) break;
        __builtin_amdgcn_s_sleep(1);
        if ((++sp & 255u) == 0u) { if (xb_ld(&bar[XB_TMO])) break; if (sp > XB_SPIN_CAP) { atomicAdd(&bar[XB_TMO], 1u); break; } }
    }
    nloc = mine > 0u ? mine : 1u; nx = cnt > 0u ? cnt : 1u;
}

__device__ __forceinline__ void xcd_barrier(const XcdBarrier& b) {
    asm volatile("s_waitcnt vmcnt(0)" ::: "memory");
    __syncthreads();
    if (threadIdx.x == 0) {
        unsigned* bar = b.bar;
        __builtin_amdgcn_s_waitcnt(0);
        unsigned nloc = b.st[0], nx = b.st[1];
        if (nloc == 0u) { xcd_barrier_complete(bar, b.x, nloc, nx); b.st[0] = nloc; b.st[1] = nx; }
        const unsigned old = xb_add(&bar[XB_XSUB(b.x)], 1u);
        const unsigned gen = old / nloc;
        if (old + 1u == (gen + 1u) * nloc) {
            __builtin_amdgcn_fence(__ATOMIC_RELEASE, "agent");
            asm volatile("s_waitcnt vmcnt(0)" ::: "memory");
            const unsigned og = xb_add(&bar[XB_TOP], 1u);
            const unsigned tg = og / nx;
            if (og + 1u == (tg + 1u) * nx) xb_add(&bar[XB_TOPGEN], 1u);
            else XB_SPIN(xb_ld(&bar[XB_TOPGEN]) == tg, bar);
            __builtin_amdgcn_fence(__ATOMIC_ACQUIRE, "agent");
            xb_add(&bar[XB_XGEN(b.x)], 1u);
            asm volatile("s_waitcnt vmcnt(0)" ::: "memory");
        } else {
            XB_SPIN(xb_ld(&bar[XB_XGEN(b.x)]) == gen, bar);
            __builtin_amdgcn_fence(__ATOMIC_ACQUIRE, "agent");
            asm volatile("s_waitcnt vmcnt(0)" ::: "memory");
        }
    }
    __syncthreads();
}

__device__ __forceinline__ void cvt_rows_bf16(const float* src, bf16* dst, size_t n8, size_t gtid, size_t gthreads) {
    for (size_t i = gtid; i < n8; i += gthreads) { const f32x4 a = ((const f32x4*)src)[2 * i], b = ((const f32x4*)src)[2 * i + 1];
        v4u o; o.x = pk2(a.x, a.y); o.y = pk2(a.z, a.w); o.z = pk2(b.x, b.y); o.w = pk2(b.z, b.w); ((v4u*)dst)[i] = o; }
}
__device__ __forceinline__ void transpose_item(const float* W, int N, bf16* WT, int dst_row0, LAS float* scr, int k0, int n0, int lane) {
#pragma unroll 8
    for (int i = 0; i < 32; ++i) { const int kk = 2 * i + (lane >> 5); scr[kk * 33 + (lane & 31)] = W[(size_t)(k0 + kk) * N + n0 + (lane & 31)]; }
    LDS_WAIT(); asm volatile("" ::: "memory");
    const int c = lane & 7;
#pragma unroll
    for (int j = 0; j < 4; ++j) { const int n = (lane >> 3) + 8 * j; const LAS float* s = scr + (8 * c) * 33 + n;
        v4u o; o.x = pk2(s[0 * 33], s[1 * 33]); o.y = pk2(s[2 * 33], s[3 * 33]); o.z = pk2(s[4 * 33], s[5 * 33]); o.w = pk2(s[6 * 33], s[7 * 33]);
        *(v4u*)(WT + (size_t)(dst_row0 + n) * 1024 + k0 + 8 * c) = o; }
    LDS_WAIT(); asm volatile("" ::: "memory");
}
__device__ __forceinline__ void phase_weights(LAS float* scr, int gw, int ngw, int lane, const float* win_src, int NC, const float* wkv_src, const float* wo_src,
                                              const float* wg_src, const float* wu_src, const float* wd_src, bf16* win_t, bf16* wkv_t, bf16* wo_t, bf16* wgu_t, bf16* wd_t) {
    const int nbw = NC / 32, nWin = nbw * 16, NIT = nWin + 256 + 512 + NE * 1536;
    for (int it = gw; it < NIT; it += ngw) {
        int r = it;
        if (r < nWin) { const int kb = r / nbw, nb = r - kb * nbw; transpose_item(win_src, NC, win_t, 32 * nb, scr, 64 * kb, 32 * nb, lane); continue; } r -= nWin;
        if (r < 256) { const int kb = r >> 4, nb = r & 15; transpose_item(wkv_src, 512, wkv_t, 32 * nb, scr, 64 * kb, 32 * nb, lane); continue; } r -= 256;
        if (r < 512) { const int kb = r >> 5, nb = r & 31; transpose_item(wo_src, 1024, wo_t, 32 * nb, scr, 64 * kb, 32 * nb, lane); continue; } r -= 512;
        const int e = r / 1536, q = r - e * 1536, which = q >> 9, rr = q & 511, kb = rr >> 5, nb = rr & 31, n0 = 32 * nb;
        const size_t eoff = (size_t)e * 1024 * 1024;
        if (which == 0) transpose_item(wg_src + eoff, 1024, wgu_t + 2 * eoff, (n0 >> 7) * 256 + (n0 & 127), scr, 64 * kb, n0, lane);
        else if (which == 1) transpose_item(wu_src + eoff, 1024, wgu_t + 2 * eoff, (n0 >> 7) * 256 + 128 + (n0 & 127), scr, 64 * kb, n0, lane);
        else transpose_item(wd_src + eoff, 1024, wd_t + eoff, n0, scr, 64 * kb, n0, lane);
    }
}

template <bool OUT>
__device__ __forceinline__ void hgrn_seg(LAS unsigned char* lds, const bf16* h, const float* lbl, int j, const float* normg, float* Sloc, float* Dseg, bf16* mix, int unit, int tid, int wave, int lane) {
    const int seg = unit & (HNSEG - 1), bh = unit >> 6, hh = bh % HG_H, b = bh / HG_H;
    const int v = tid & 127, dg = tid >> 7;
    LAS float* fgs = (LAS float*)lds; LAS float* vs = fgs + 4096; LAS float* qs = vs + 4096; LAS float* op = qs + 4096;
    float st[32];
    float* Sp = Sloc + (size_t)unit * 16384 + (size_t)(dg * 32) * 128 + v;
#pragma unroll
    for (int dd = 0; dd < 32; ++dd) st[dd] = OUT ? Sp[dd * 128] : 0.f;
    float dprod = 1.f;
    const int stok = tid >> 4, c8 = (tid & 15) * 8;
    float lb[8];
#pragma unroll
    for (int i = 0; i < 8; ++i) { lb[i] = 0.f; if (j > 0) { const float a0 = lbl[hh * 128 + c8 + i], a1 = lbl[MIXW + hh * 128 + c8 + i]; lb[i] = 1.f / (1.f + __expf(a0 - a1)); } }
    for (int ch = 0; ch < HSEG / 32; ++ch) {
        const size_t t0 = (size_t)b * SEQ + seg * HSEG + ch * 32;
        { const bf16* row = h + (t0 + stok) * NC_H + hh * 128 + c8;
          const v4u f8 = *(const v4u*)(row + 768), i8 = *(const v4u*)(row + 1536); v4u q8 = {0u, 0u, 0u, 0u}; if (OUT) q8 = *(const v4u*)row;
#pragma unroll
          for (int w = 0; w < 4; ++w) { const float f0 = bflo(f8[w]), f1 = bfhi(f8[w]); const int o = stok * 128 + c8 + 2 * w;
              fgs[o] = lb[2 * w] + (1.f - lb[2 * w]) * sigmoidf_(f0); fgs[o + 1] = lb[2 * w + 1] + (1.f - lb[2 * w + 1]) * sigmoidf_(f1);
              vs[o] = bflo(i8[w]); vs[o + 1] = bfhi(i8[w]);
              if (OUT) { const float q0 = bflo(q8[w]), q1 = bfhi(q8[w]); qs[o] = q0 * sigmoidf_(q0); qs[o + 1] = q1 * sigmoidf_(q1); } } }
        __syncthreads();
        if (!OUT) { if (tid < 128) { for (int tt = 0; tt < 32; ++tt) dprod *= fgs[tt * 128 + tid]; } }
#pragma unroll 2
        for (int tt = 0; tt < 32; ++tt) {
            const float vv = vs[tt * 128 + v]; float acc = 0.f;
#pragma unroll
            for (int d4 = 0; d4 < 8; ++d4) { const f32x4 f4 = *(const LAS f32x4*)(fgs + tt * 128 + dg * 32 + d4 * 4);
                f32x4 q4 = {0.f, 0.f, 0.f, 0.f}; if (OUT) q4 = *(const LAS f32x4*)(qs + tt * 128 + dg * 32 + d4 * 4);
#pragma unroll
                for (int i = 0; i < 4; ++i) { st[d4 * 4 + i] = f4[i] * (st[d4 * 4 + i] - vv) + vv; if (OUT) acc += q4[i] * st[d4 * 4 + i]; } }
            if (OUT) op[(dg * 32 + tt) * 128 + v] = acc;
        }
        if (OUT) {
            __syncthreads();
#pragma unroll
            for (int k = 0; k < 4; ++k) { const int tt = wave + 8 * k; float o0 = 0.f, o1 = 0.f;
#pragma unroll
                for (int g = 0; g < 4; ++g) { o0 += op[(g * 32 + tt) * 128 + lane]; o1 += op[(g * 32 + tt) * 128 + lane + 64]; }
                const float ms = wave_sum(o0 * o0 + o1 * o1) * (1.f / 128.f), r = 1.f / sqrtf(ms + 1e-6f);
                const bf16* grow = h + (t0 + tt) * NC_H + 2304 + hh * 128; const float g0 = bf2f(grow[lane]), g1 = bf2f(grow[lane + 64]);
                bf16* mrow = mix + (t0 + tt) * 1024 + hh * 128;
                mrow[lane] = (bf16)f2bf(o0 * r * normg[lane] * sigmoidf_(g0)); mrow[lane + 64] = (bf16)f2bf(o1 * r * normg[lane + 64] * sigmoidf_(g1)); }
        }
        __syncthreads();
    }
    if (!OUT) {
#pragma unroll
        for (int dd = 0; dd < 32; ++dd) Sp[dd * 128] = st[dd];
        if (tid < 128) Dseg[(size_t)unit * 128 + tid] = dprod;
    }
}
__device__ __forceinline__ void hgrn_scan(float* Sloc, const float* Dseg, size_t gtid, size_t gthreads) {
    for (size_t idx = gtid; idx < (size_t)NBATCH * HG_H * 16384; idx += gthreads) { const int bh = (int)(idx >> 14), e = (int)(idx & 16383), d = e >> 7; float cur = 0.f;
        for (int seg = 0; seg < HNSEG; ++seg) { const size_t u = (size_t)bh * HNSEG + seg; float* p = Sloc + u * 16384 + e; const float tmp = *p; *p = cur; cur = Dseg[u * 128 + d] * cur + tmp; } }
}

template <bool MASK>
__device__ __forceinline__ void attn4(const LAS unsigned* Ks, const LAS bf16* Vs, const LAS float* qst, LAS float* pb, int lane, const int (&tq)[4], int kbase, float slope,
                                      float (&mo)[4], float (&lo)[4], float (&oo)[4]) {
    float sc[4][4];
#pragma unroll
    for (int a = 0; a < 4; ++a)
#pragma unroll
        for (int c = 0; c < 4; ++c) sc[a][c] = 0.f;
#pragma unroll 4
    for (int dd = 0; dd < 32; ++dd) {
        f32x2 qv[4];
#pragma unroll
        for (int qi = 0; qi < 4; ++qi) qv[qi] = *(const LAS f32x2*)(qst + qi * 64 + 2 * dd);
#pragma unroll
        for (int kk = 0; kk < 4; ++kk) { const unsigned kw = Ks[(lane + 64 * kk) * 33 + dd]; const float k0 = bflo(kw), k1 = bfhi(kw);
#pragma unroll
            for (int qi = 0; qi < 4; ++qi) sc[qi][kk] += qv[qi].x * k0 + qv[qi].y * k1; }
    }
#pragma unroll
    for (int qi = 0; qi < 4; ++qi) { float mx = -INFINITY;
#pragma unroll
        for (int kk = 0; kk < 4; ++kk) { const int pos = kbase + lane + 64 * kk; float lg = sc[qi][kk] * 0.125f - slope * (float)(tq[qi] - pos); if (MASK && pos > tq[qi]) lg = -INFINITY; sc[qi][kk] = lg; mx = fmaxf(mx, lg); }
        mx = wave_max(mx); float s = 0.f;
#pragma unroll
        for (int kk = 0; kk < 4; ++kk) { const float p = __builtin_amdgcn_exp2f((sc[qi][kk] - mx) * 1.4426950408889634f); pb[qi * 256 + lane + 64 * kk] = p; s += p; }
        lo[qi] = wave_sum(s); mo[qi] = mx; }
    float o[4] = {0.f, 0.f, 0.f, 0.f};
#pragma unroll 4
    for (int k4 = 0; k4 < 64; ++k4) { f32x4 p4[4];
#pragma unroll
        for (int qi = 0; qi < 4; ++qi) p4[qi] = *(const LAS f32x4*)(pb + qi * 256 + 4 * k4);
#pragma unroll
        for (int jj = 0; jj < 4; ++jj) { const float vv = bf2f(Vs[(4 * k4 + jj) * 64 + lane]);
#pragma unroll
            for (int qi = 0; qi < 4; ++qi) o[qi] += p4[qi][jj] * vv; } }
#pragma unroll
    for (int qi = 0; qi < 4; ++qi) oo[qi] = o[qi];
}
constexpr int AT_KS = 0, AT_VS = 33792, AT_WV = 66560, AT_WVB = 5120;

__device__ __forceinline__ void memattn_unit(LAS unsigned char* lds, const bf16* h, int NC, int qoff, const bf16* kv, bf16* mix, int unit, int tid, int wave, int lane) {
    const int chunk = unit & 31, bm = unit >> 5, mh = bm & 3, b = bm >> 2;
    LAS unsigned* Ks = (LAS unsigned*)(lds + AT_KS); LAS unsigned* Vs32 = (LAS unsigned*)(lds + AT_VS);
    LAS float* qst = (LAS float*)(lds + AT_WV + wave * AT_WVB); LAS float* pb = qst + 256;
    for (int i = 0; i < 16; ++i) { const int idx = tid + 512 * i, r = idx >> 5, dd = idx & 31; const unsigned* src = (const unsigned*)(kv + (size_t)(b * 256 + r) * 512 + mh * 64);
        Ks[r * 33 + dd] = src[dd]; Vs32[r * 32 + dd] = src[128 + dd]; }
    __syncthreads();
    for (int qd = 0; qd < 16; ++qd) { const size_t tg = (size_t)b * SEQ + chunk * 512 + wave * 64 + qd * 4;
#pragma unroll
        for (int qi = 0; qi < 4; ++qi) qst[qi * 64 + lane] = bf2f(h[(tg + qi) * NC + qoff + mh * 64 + lane]);
        const int tq[4] = {0, 0, 0, 0}; float m[4], l[4], o[4];
        attn4<false>(Ks, (const LAS bf16*)Vs32, qst, pb, lane, tq, 0, 0.f, m, l, o);
#pragma unroll
        for (int qi = 0; qi < 4; ++qi) mix[(tg + qi) * 1024 + MIXW + mh * 64 + lane] = (bf16)f2bf(o[qi] / l[qi]); }
    __syncthreads();
}
__device__ __forceinline__ void kmean_unit(LAS unsigned char* lds, const bf16* h, float* kmean, int unit, int tid) {
    const int n = unit & 63, bh = unit >> 6, hh = bh % MB_H, b = bh / MB_H, d = tid & 63, part = tid >> 6;
    LAS float* red = (LAS float*)lds;
    float s = 0.f; const bf16* p = h + ((size_t)b * SEQ + n * 256 + part * 32) * NC_M + 768 + hh * 64 + d;
    for (int i = 0; i < 32; ++i) s += bf2f(p[(size_t)i * NC_M]);
    red[part * 64 + d] = s; __syncthreads();
    if (tid < 64) { float a = 0.f; for (int pp = 0; pp < 8; ++pp) a += red[pp * 64 + tid]; kmean[((size_t)bh * 64 + n) * 64 + tid] = a * (1.f / 256.f); }
    __syncthreads();
}
__device__ __forceinline__ void moba_gate_unit(LAS unsigned char* lds, const bf16* h, const float* kmean, unsigned* gcount, int* selinfo, unsigned* list, int unit, int tid) {
    const int c = unit & 63, bh = unit >> 6, hh = bh % MB_H, b = bh / MB_H;
    LAS float* km = (LAS float*)lds; LAS int* hist = (LAS int*)(lds + 16384); LAS int* base = hist + 64;
    for (int i = tid; i < 4096; i += NTHR) km[i] = kmean[(size_t)bh * 4096 + i];
    if (tid < 64) hist[tid] = 0;
    __syncthreads();
    int s0 = 0, s1 = 0, s2 = 0, r0 = 0, r1 = 0, r2 = 0, ns = 0; const int t = c * 256 + tid;
    if (tid < 256) {
        float q[64]; const v4u* qp = (const v4u*)(h + ((size_t)b * SEQ + t) * NC_M + hh * 64);
#pragma unroll
        for (int w = 0; w < 8; ++w) { const v4u x = qp[w]; q[8 * w] = bflo(x.x); q[8 * w + 1] = bfhi(x.x); q[8 * w + 2] = bflo(x.y); q[8 * w + 3] = bfhi(x.y); q[8 * w + 4] = bflo(x.z); q[8 * w + 5] = bfhi(x.z); q[8 * w + 6] = bflo(x.w); q[8 * w + 7] = bfhi(x.w); }
        float v0 = -INFINITY, v1 = -INFINITY, v2 = -INFINITY;
        for (int n = 0; n < c; ++n) { float g = 0.f;
#pragma unroll
            for (int d4 = 0; d4 < 16; ++d4) { const f32x4 k4 = *(const LAS f32x4*)(km + n * 64 + 4 * d4); g += q[4 * d4] * k4.x + q[4 * d4 + 1] * k4.y + q[4 * d4 + 2] * k4.z + q[4 * d4 + 3] * k4.w; }
            if (g > v0) { v2 = v1; s2 = s1; v1 = v0; s1 = s0; v0 = g; s0 = n; } else if (g > v1) { v2 = v1; s2 = s1; v1 = g; s1 = n; } else if (g > v2) { v2 = g; s2 = n; } }
        ns = c < 3 ? c : 3;
        if (ns > 0) r0 = __hip_atomic_fetch_add(hist + s0, 1, __ATOMIC_RELAXED, __HIP_MEMORY_SCOPE_WORKGROUP);
        if (ns > 1) r1 = __hip_atomic_fetch_add(hist + s1, 1, __ATOMIC_RELAXED, __HIP_MEMORY_SCOPE_WORKGROUP);
        if (ns > 2) r2 = __hip_atomic_fetch_add(hist + s2, 1, __ATOMIC_RELAXED, __HIP_MEMORY_SCOPE_WORKGROUP);
        selinfo[((size_t)b * SEQ + t) * MB_H + hh] = ns;
    }
    __syncthreads();
    if (tid < 64) { const int hc = hist[tid]; if (hc > 0) base[tid] = (int)__hip_atomic_fetch_add(gcount + bh * 64 + tid, (unsigned)hc, __ATOMIC_RELAXED, __HIP_MEMORY_SCOPE_AGENT); }
    __syncthreads();
    if (tid < 256) { unsigned* lp = list + ((size_t)bh * 64 << 14);
        if (ns > 0) lp[((size_t)s0 << 14) + base[s0] + r0] = (unsigned)t;
        if (ns > 1) lp[((size_t)s1 << 14) + base[s1] + r1] = (unsigned)t | (1u << 14);
        if (ns > 2) lp[((size_t)s2 << 14) + base[s2] + r2] = (unsigned)t | (2u << 14); }
    __syncthreads();
}
__device__ __forceinline__ void moba_attn_item(LAS unsigned char* lds, const bf16* h, const unsigned* gcount, const unsigned* list, float* po, float* pml, int item, int tid, int wave, int lane) {
    const int n = item / 24, bh = item - n * 24, hh = bh % MB_H, b = bh / MB_H;
    LAS unsigned* Ks = (LAS unsigned*)(lds + AT_KS); LAS unsigned* Vs32 = (LAS unsigned*)(lds + AT_VS);
    LAS float* qst = (LAS float*)(lds + AT_WV + wave * AT_WVB); LAS float* pb = qst + 256;
    for (int i = 0; i < 16; ++i) { const int idx = tid + 512 * i, r = idx >> 5, dd = idx & 31; const unsigned* src = (const unsigned*)(h + ((size_t)b * SEQ + n * 256 + r) * NC_M + hh * 64);
        Ks[r * 33 + dd] = src[384 + dd]; Vs32[r * 32 + dd] = src[768 + dd]; }
    __syncthreads();
    const int cnt = (int)gcount[bh * 64 + n], total = 256 + cnt, nquads = (total + 3) >> 2;
    const float slope = hh < 8 ? ldexpf(1.0f, -(hh + 1)) : ldexpf(0.70710678118654752f, -(hh - 8));
    const unsigned* lp = list + (((size_t)bh * 64 + n) << 14);
    for (int quad = wave; quad < nquads; quad += 8) {
        int tq[4], slot[4];
#pragma unroll
        for (int qi = 0; qi < 4; ++qi) { int idx = quad * 4 + qi; idx = idx < total ? idx : total - 1;
            if (idx < 256) { tq[qi] = n * 256 + idx; slot[qi] = 3; } else { const unsigned e = lp[idx - 256]; tq[qi] = (int)(e & 16383u); slot[qi] = (int)(e >> 14); } }
#pragma unroll
        for (int qi = 0; qi < 4; ++qi) qst[qi * 64 + lane] = bf2f(h[((size_t)b * SEQ + tq[qi]) * NC_M + hh * 64 + lane]);
        float m[4], l[4], o[4];
        attn4<true>(Ks, (const LAS bf16*)Vs32, qst, pb, lane, tq, n * 256, slope, m, l, o);
#pragma unroll
        for (int qi = 0; qi < 4; ++qi) if (quad * 4 + qi < total) { const size_t pi = (((size_t)b * SEQ + tq[qi]) * MB_H + hh) * 4 + slot[qi];
            po[pi * 64 + lane] = o[qi]; if (lane == 0) { pml[pi * 2] = m[qi]; pml[pi * 2 + 1] = l[qi]; } }
    }
    __syncthreads();
}
__device__ __forceinline__ void moba_combine(const float* po, const float* pml, const int* selinfo, bf16* mix, int gw, int ngw, int lane) {
    for (int idx = gw; idx < T * MB_H; idx += ngw) { const int tg = idx / MB_H, hh = idx - tg * MB_H, ns = selinfo[idx]; const size_t p4 = (size_t)idx * 4;
        const float m3 = pml[(p4 + 3) * 2]; float M = m3, m0 = -INFINITY, m1 = -INFINITY, m2 = -INFINITY;
        if (ns > 0) { m0 = pml[(p4 + 0) * 2]; M = fmaxf(M, m0); } if (ns > 1) { m1 = pml[(p4 + 1) * 2]; M = fmaxf(M, m1); } if (ns > 2) { m2 = pml[(p4 + 2) * 2]; M = fmaxf(M, m2); }
        float w = __builtin_amdgcn_exp2f((m3 - M) * 1.4426950408889634f), den = w * pml[(p4 + 3) * 2 + 1], num = w * po[(p4 + 3) * 64 + lane];
        if (ns > 0) { w = __builtin_amdgcn_exp2f((m0 - M) * 1.4426950408889634f); den += w * pml[(p4 + 0) * 2 + 1]; num += w * po[(p4 + 0) * 64 + lane]; }
        if (ns > 1) { w = __builtin_amdgcn_exp2f((m1 - M) * 1.4426950408889634f); den += w * pml[(p4 + 1) * 2 + 1]; num += w * po[(p4 + 1) * 64 + lane]; }
        if (ns > 2) { w = __builtin_amdgcn_exp2f((m2 - M) * 1.4426950408889634f); den += w * pml[(p4 + 2) * 2 + 1]; num += w * po[(p4 + 2) * 64 + lane]; }
        mix[(size_t)tg * 1024 + hh * 64 + lane] = (bf16)f2bf(num / den); }
}

__device__ __forceinline__ void ln_row(f32x4 (&v)[4], const f32x4 (&gv)[4], const f32x4 (&bv)[4]) {
    float s = 0.f;
#pragma unroll
    for (int j = 0; j < 4; ++j) s += (v[j].x + v[j].y) + (v[j].z + v[j].w);
    const float mean = wave_sum(s) * (1.f / D); float s2 = 0.f;
#pragma unroll
    for (int j = 0; j < 4; ++j) { v[j] = v[j] - mean; s2 += (v[j].x * v[j].x + v[j].y * v[j].y) + (v[j].z * v[j].z + v[j].w * v[j].w); }
    const float rstd = 1.f / sqrtf(wave_sum(s2) * (1.f / D) + 1e-5f);
#pragma unroll
    for (int j = 0; j < 4; ++j) v[j] = v[j] * rstd * gv[j] + bv[j];
}
__device__ __forceinline__ void phase_ln1(LAS unsigned char* lds, const float* xin, const bf16* y, const float* g, const float* bb, const float* wr, const float* br,
                                          float* xout, bf16* xbf, int* tok_e, int* tok_lr, float* tok_w, int* blk_cnt, int blk, int tid, int wave, int lane) {
    LAS float* xst = (LAS float*)(lds + wave * 4096); LAS int* hist = (LAS int*)(lds + 32768);
    if (tid < 32) hist[tid] = 0;
    __syncthreads();
    constexpr int TPB = T / GRID;
    f32x4 gv[4], bv[4];
#pragma unroll
    for (int j = 0; j < 4; ++j) { gv[j] = ((const f32x4*)g)[lane + 64 * j]; bv[j] = ((const f32x4*)bb)[lane + 64 * j]; }
    for (int i = wave; i < TPB; i += NWAVES) { const size_t t = (size_t)blk * TPB + i;
        const f32x4* xr = (const f32x4*)(xin + t * D) + lane; const v2u* yr = (const v2u*)(y + t * D) + lane; f32x4 v[4];
#pragma unroll
        for (int j = 0; j < 4; ++j) { const f32x4 xv = xr[64 * j]; const v2u yw = yr[64 * j];
            v[j].x = DN_ALPHA * xv.x + bflo(yw.x); v[j].y = DN_ALPHA * xv.y + bfhi(yw.x); v[j].z = DN_ALPHA * xv.z + bflo(yw.y); v[j].w = DN_ALPHA * xv.w + bfhi(yw.y); }
        ln_row(v, gv, bv);
        f32x4* xo = (f32x4*)(xout + t * D) + lane; v2u* xb = (v2u*)(xbf + t * D) + lane;
#pragma unroll
        for (int j = 0; j < 4; ++j) { xo[64 * j] = v[j]; v2u w; w.x = pk2(v[j].x, v[j].y); w.y = pk2(v[j].z, v[j].w); xb[64 * j] = w; ((LAS f32x4*)xst)[lane + 64 * j] = v[j]; }
        const int e = lane & 31, half = lane >> 5; float acc = 0.f; const float* wp = wr + (size_t)(half * 512) * NE + e;
#pragma unroll 4
        for (int d4 = 0; d4 < 128; ++d4) { const f32x4 xv = *(const LAS f32x4*)(xst + half * 512 + 4 * d4);
            acc += xv.x * wp[(4 * d4) * NE]; acc += xv.y * wp[(4 * d4 + 1) * NE]; acc += xv.z * wp[(4 * d4 + 2) * NE]; acc += xv.w * wp[(4 * d4 + 3) * NE]; }
        acc += __shfl_xor(acc, 32);
        float logit = acc + br[e];
        int se[4]; float sv[4];
#pragma unroll
        for (int k = 0; k < 4; ++k) { float bvv = logit; int bi = e;
#pragma unroll
            for (int o = 1; o < 32; o <<= 1) { const float ov = __shfl_xor(bvv, o); const int oi = __shfl_xor(bi, o); if (ov > bvv || (ov == bvv && oi < bi)) { bvv = ov; bi = oi; } }
            se[k] = bi; sv[k] = bvv; if (e == bi) logit = -INFINITY; }
        const float e1 = __expf(sv[1] - sv[0]), e2 = __expf(sv[2] - sv[0]), e3 = __expf(sv[3] - sv[0]), inv = 1.f / (1.f + e1 + e2 + e3);
        const float wk[4] = {inv, e1 * inv, e2 * inv, e3 * inv};
        if (lane == 0) {
#pragma unroll
            for (int k = 0; k < 4; ++k) { const int lr = __hip_atomic_fetch_add(hist + se[k], 1, __ATOMIC_RELAXED, __HIP_MEMORY_SCOPE_WORKGROUP);
                tok_e[t * 4 + k] = se[k]; tok_lr[t * 4 + k] = lr; tok_w[t * 4 + k] = wk[k]; } }
    }
    __syncthreads();
    if (tid < 32) blk_cnt[blk * 32 + tid] = hist[tid];
    __syncthreads();
}
__device__ __forceinline__ void phase_dispatch(LAS unsigned char* lds, const int* blk_cnt, const int* tok_e, const int* tok_lr, int* tok_row, int* tab, const bf16* xbf, bf16* xs, int blk, int tid, int wave, int lane) {
    LAS int* tot = (LAS int*)lds; LAS int* pre = tot + 32; LAS int* pst = pre + 32;
    if (tid < 32) { int s = 0, p = 0; for (int bb = 0; bb < GRID; ++bb) { const int c = blk_cnt[bb * 32 + tid]; p += (bb < blk) ? c : 0; s += c; } tot[tid] = s; pre[tid] = p; }
    __syncthreads();
    if (tid == 0) { int acc = 0; for (int e = 0; e < 32; ++e) { pst[e] = acc; acc += ((tot[e] + 255) >> 8) << 8; } pst[32] = acc; }
    __syncthreads();
    if (blk == 0 && tid < 33) tab[tid] = pst[tid] >> 8;
    constexpr int TPB = T / GRID;
    for (int i = wave; i < TPB * 4; i += NWAVES) { const size_t ti = ((size_t)blk * TPB + (i >> 2)) * 4 + (i & 3); const int e = tok_e[ti]; const int r = pst[e] + pre[e] + tok_lr[ti];
        if (lane == 0) tok_row[ti] = r;
        const v4u* src = (const v4u*)(xbf + (ti >> 2) * D); v4u* dst = (v4u*)(xs + (size_t)r * D); dst[lane] = src[lane]; dst[lane + 64] = src[lane + 64]; }
    __syncthreads();
}
__device__ __forceinline__ void phase_ln2(const float* x1, const bf16* yrows, const int* tok_row, const float* tok_w, const float* g, const float* bb, float* xout, bf16* xbf, int gw, int ngw, int lane) {
    f32x4 gv[4], bv[4];
#pragma unroll
    for (int j = 0; j < 4; ++j) { gv[j] = ((const f32x4*)g)[lane + 64 * j]; bv[j] = ((const f32x4*)bb)[lane + 64 * j]; }
    for (int t = gw; t < T; t += ngw) { int r[4]; float w[4];
#pragma unroll
        for (int k = 0; k < 4; ++k) { r[k] = tok_row[(size_t)t * 4 + k]; w[k] = tok_w[(size_t)t * 4 + k]; }
        const f32x4* xr = (const f32x4*)(x1 + (size_t)t * D) + lane; f32x4 v[4];
#pragma unroll
        for (int j = 0; j < 4; ++j) { f32x4 f = {0.f, 0.f, 0.f, 0.f};
#pragma unroll
            for (int k = 0; k < 4; ++k) { const v2u yw = ((const v2u*)(yrows + (size_t)r[k] * D))[lane + 64 * j]; f.x += w[k] * bflo(yw.x); f.y += w[k] * bfhi(yw.x); f.z += w[k] * bflo(yw.y); f.w += w[k] * bfhi(yw.y); }
            v[j] = xr[64 * j] * DN_ALPHA + f; }
        ln_row(v, gv, bv);
        f32x4* xo = (f32x4*)(xout + (size_t)t * D) + lane; v2u* xb = (v2u*)(xbf + (size_t)t * D) + lane;
#pragma unroll
        for (int j = 0; j < 4; ++j) { xo[64 * j] = v[j]; v2u ww; ww.x = pk2(v[j].x, v[j].y); ww.y = pk2(v[j].z, v[j].w); xb[64 * j] = ww; } }
}

struct Args { const float* in[20]; float* out; unsigned char* ws; int l_lo, l_hi, ph_lo, ph_hi; };
typedef const __attribute__((address_space(4))) Args* KArgsP;
#define KA_LOAD() ({ KArgsP p_ = (KArgsP)__builtin_amdgcn_kernarg_segment_ptr(); asm volatile("" : "+s"(p_)); p_; })
#ifndef PHMASK
#define PHMASK 0xFFFF
#endif
#define PH_BEGIN(k) { KArgsP ka = KA_LOAD(); if (((PHMASK >> (k)) & 1) && ka->ph_lo <= (k) && (k) < ka->ph_hi) { unsigned char* ws = ka->ws; int tid = threadIdx.x; asm volatile("" : "+v"(tid)); \
    const int lane = tid & 63, wave = __builtin_amdgcn_readfirstlane(tid >> 6); int blk = blockIdx.x; asm volatile("" : "+s"(blk)); \
    const int gw = blk * NWAVES + wave; const size_t gtid = (size_t)blk * NTHR + tid; (void)lane; (void)gw; (void)gtid; (void)ws;
#if ONE_LAUNCH
#define PH_SEAM() do { XcdBarrier b_; b_.bar = (unsigned*)(KA_LOAD()->ws + WS_CTL) + CW_BAR; b_.x = xb_xcc_id(); b_.st = (volatile LAS unsigned*)(lds + MISC_OFF); xcd_barrier(b_); } while (0)
#else
#define PH_SEAM() do {} while (0)
#endif
#define PH_END() PH_SEAM(); } }
#define PH_END_NOSEAM() } }
#define WSP(type, off) ((type*)(ws + (off)))
constexpr int G = GRID, NGW = GRID * NWAVES; constexpr size_t GTHREADS = (size_t)GRID * NTHR;
__global__ void __launch_bounds__(NTHR, 2) fwd_kernel(Args args) {
    extern __shared__ __attribute__((aligned(16))) unsigned char lds_raw[];
    LAS unsigned char* lds = (LAS unsigned char*)lds_raw;
    LAS int* tabL = (LAS int*)(lds + MISC_OFF + 256);
    if (threadIdx.x < 4) ((LAS unsigned*)(lds + MISC_OFF))[threadIdx.x] = 0u;
    __syncthreads();
#if ONE_LAUNCH
    (void)xcd_barrier_post((unsigned*)(args.ws + WS_CTL) + CW_BAR, (volatile LAS unsigned*)(lds + MISC_OFF));
#endif
    PH_BEGIN(0)
        if (ka->l_lo == 0) {
            cvt_rows_bf16(ka->in[0], WSP(bf16, WS_XBF), (size_t)T * D / 8, gtid, GTHREADS);
            cvt_rows_bf16(ka->in[1], WSP(bf16, WS_MEMBF), (size_t)512 * D / 8, gtid, GTHREADS);
        }
    PH_END_NOSEAM()
    for (int l = args.l_lo; l < KA_LOAD()->l_hi; ++l) {
        const int j = l >> 1; const bool moba = (l & 1) != 0;
        const int NC = moba ? NC_M : NC_H, qoff = moba ? 2304 : 3072;

        PH_BEGIN(1)
            const float* win_src = moba ? ka->in[5] + (size_t)j * D * NC_M : ka->in[2] + (size_t)j * D * NC_H;
            const size_t moff = (size_t)l * NE * 1024 * 1024;
            phase_weights((LAS float*)(lds + wave * 16384), gw, NGW, lane, win_src, NC, ka->in[6] + (size_t)l * D * 512, ka->in[7] + (size_t)l * D * D,
                          ka->in[12] + moff, ka->in[14] + moff, ka->in[16] + moff, WSP(bf16, WS_WIN), WSP(bf16, WS_WKV), WSP(bf16, WS_WO), WSP(bf16, WS_WGU), WSP(bf16, WS_WD));
        PH_END()
        PH_BEGIN(2)
            { pg8::Gemm g{WSP(bf16, WS_XBF), WSP(bf16, WS_WIN), T, NC, D}; pg8::StaticOrder S; S.init(T, NC, G, blk); pg8::EpiPlain E{WSP(bf16, WS_H), NC};
              pg8::gemm_phase<pg8::EpiPlain, pg8::StaticOrder, true, true>(lds, g, S, E); }
            { pg8::Gemm g{WSP(bf16, WS_MEMBF), WSP(bf16, WS_WKV), 512, 512, D}; pg8::StaticOrder S; S.init(512, 512, G, blk); pg8::EpiPlain E{WSP(bf16, WS_KV), 512};
              pg8::gemm_phase<pg8::EpiPlain, pg8::StaticOrder, true, true>(lds, g, S, E); }
        PH_END()
        if (!moba) {
            PH_BEGIN(3)
                for (int u = blk; u < NBATCH * HG_H * HNSEG; u += G) hgrn_seg<false>(lds, WSP(bf16, WS_H), ka->in[3], j, ka->in[4] + j * 128, WSP(float, WS_SLOC), WSP(float, WS_DSEG), WSP(bf16, WS_MIX), u, tid, wave, lane);
                for (int u = blk; u < 256; u += G) memattn_unit(lds, WSP(bf16, WS_H), NC, qoff, WSP(bf16, WS_KV), WSP(bf16, WS_MIX), u, tid, wave, lane);
            PH_END()
            PH_BEGIN(4)
                hgrn_scan(WSP(float, WS_SLOC), WSP(float, WS_DSEG), gtid, GTHREADS);
            PH_END()
            PH_BEGIN(5)
                for (int u = blk; u < NBATCH * HG_H * HNSEG; u += G) hgrn_seg<true>(lds, WSP(bf16, WS_H), ka->in[3], j, ka->in[4] + j * 128, WSP(float, WS_SLOC), WSP(float, WS_DSEG), WSP(bf16, WS_MIX), u, tid, wave, lane);
            PH_END()
        } else {
            PH_BEGIN(3)
                for (int u = blk; u < 24 * MB_NB; u += G) kmean_unit(lds, WSP(bf16, WS_H), WSP(float, WS_KMEAN), u, tid);
                for (int u = blk; u < 256; u += G) memattn_unit(lds, WSP(bf16, WS_H), NC, qoff, WSP(bf16, WS_KV), WSP(bf16, WS_MIX), u, tid, wave, lane);
            PH_END()
            PH_BEGIN(4)
                for (int u = blk; u < 24 * MB_NB; u += G) moba_gate_unit(lds, WSP(bf16, WS_H), WSP(float, WS_KMEAN), WSP(unsigned, WS_CTL) + CW_GCOUNT + j * 1536, WSP(int, WS_SELINFO), WSP(unsigned, WS_LIST), u, tid);
            PH_END()
            PH_BEGIN(5)
                for (int r = 0; r * G < 24 * MB_NB; ++r) { const int it = r * G + ((r & 1) ? (G - 1 - blk) : blk);
                    if (it < 24 * MB_NB) moba_attn_item(lds, WSP(bf16, WS_H), WSP(unsigned, WS_CTL) + CW_GCOUNT + j * 1536, WSP(unsigned, WS_LIST), WSP(float, WS_PO), WSP(float, WS_PML), it, tid, wave, lane); }
            PH_END()
            PH_BEGIN(6)
                moba_combine(WSP(float, WS_PO), WSP(float, WS_PML), WSP(int, WS_SELINFO), WSP(bf16, WS_MIX), gw, NGW, lane);
            PH_END()
        }
        PH_BEGIN(7)
            pg8::Gemm g{WSP(bf16, WS_MIX), WSP(bf16, WS_WO), T, D, D}; pg8::StaticOrder S; S.init(T, D, G, blk); pg8::EpiPlain E{WSP(bf16, WS_Y), D};
            pg8::gemm_phase<pg8::EpiPlain, pg8::StaticOrder, true, true>(lds, g, S, E);
        PH_END()
        PH_BEGIN(8)
            const float* xin = (l == 0) ? ka->in[0] : WSP(float, WS_XA);
            phase_ln1(lds, xin, WSP(bf16, WS_Y), ka->in[8] + l * D, ka->in[9] + l * D, ka->in[10] + (size_t)l * D * NE, ka->in[11] + l * NE, WSP(float, WS_XB), WSP(bf16, WS_XBF),
                      WSP(int, WS_TOK + TOK_E), WSP(int, WS_TOK + TOK_LR), WSP(float, WS_TOK + TOK_W), WSP(int, WS_TOK + TOK_BLKCNT), blk, tid, wave, lane);
        PH_END()
        PH_BEGIN(9)
            phase_dispatch(lds, WSP(int, WS_TOK + TOK_BLKCNT), WSP(int, WS_TOK + TOK_E), WSP(int, WS_TOK + TOK_LR), WSP(int, WS_TOK + TOK_ROW), WSP(int, WS_TOK + TOK_TAB), WSP(bf16, WS_XBF), WSP(bf16, WS_XS), blk, tid, wave, lane);
        PH_END()
        PH_BEGIN(10)
            if (tid < 33) tabL[tid] = WSP(int, WS_TOK + TOK_TAB)[tid];
            __syncthreads();
            pg8::Gemm g{WSP(bf16, WS_XS), WSP(bf16, WS_WGU), MOE_MAXROWS, NE * 2048, D}; pg8::MoeOrder S{tabL, 8, G, blk, tabL[32] * 8};
            pg8::EpiSwiglu E{WSP(bf16, WS_HID), ka->in[13] + (size_t)l * NE * 1024, ka->in[15] + (size_t)l * NE * 1024};
            pg8::gemm_phase<pg8::EpiSwiglu, pg8::MoeOrder, true, true>(lds, g, S, E);
        PH_END()
        PH_BEGIN(11)
            if (tid < 33) tabL[tid] = WSP(int, WS_TOK + TOK_TAB)[tid];
            __syncthreads();
            pg8::Gemm g{WSP(bf16, WS_HID), WSP(bf16, WS_WD), MOE_MAXROWS, NE * 1024, D}; pg8::MoeOrder S{tabL, 4, G, blk, tabL[32] * 4};
            pg8::EpiDown E{WSP(bf16, WS_XS), ka->in[17] + (size_t)l * NE * 1024};
            pg8::gemm_phase<pg8::EpiDown, pg8::MoeOrder, true, true>(lds, g, S, E);
        PH_END()
        PH_BEGIN(12)
            float* x2out = (l == DEPTH - 1) ? ka->out : WSP(float, WS_XA);
            phase_ln2(WSP(float, WS_XB), WSP(bf16, WS_XS), WSP(int, WS_TOK + TOK_ROW), WSP(float, WS_TOK + TOK_W), ka->in[18] + l * D, ka->in[19] + l * D, x2out, WSP(bf16, WS_XBF), gw, NGW, lane);
            if (l + 1 < ka->l_hi) PH_SEAM();
        PH_END_NOSEAM()
    }
}

extern "C" void kernel_launch(void* const* d_in, const int* in_sizes, int n_in, void* d_out, int out_size, void* d_ws, size_t ws_size, hipStream_t stream) {
    static int ready = 0;
    if (ready == 0) {
        if (n_in != 20 || in_sizes[0] != T * D || out_size != T * D || ws_size < WS_END) { fprintf(stderr, "kernel_launch: unexpected shapes (n_in %d, in0 %d, out %d, ws %zu < %zu)\n", n_in, n_in > 0 ? in_sizes[0] : -1, out_size, ws_size, (size_t)WS_END); ready = -1; return; }
        if (hipFuncSetAttribute((const void*)fwd_kernel, hipFuncAttributeMaxDynamicSharedMemorySize, LDS_BYTES) != hipSuccess) { fprintf(stderr, "kernel_launch: hipFuncSetAttribute failed\n"); ready = -1; return; }
        int per_cu = 0;
        if (hipOccupancyMaxActiveBlocksPerMultiprocessor(&per_cu, (const void*)fwd_kernel, NTHR, LDS_BYTES) != hipSuccess || per_cu < 1) fprintf(stderr, "kernel_launch: occupancy query says %d\n", per_cu);
        (void)hipGetLastError();
        ready = 1;
    }
    if (ready < 0) return;
    if (hipMemsetAsync((char*)d_ws + WS_CTL, 0, CTL_ZERO_BYTES, stream) != hipSuccess) return;
    Args a{};
    for (int i = 0; i < 20; ++i) a.in[i] = (const float*)d_in[i];
    a.out = (float*)d_out; a.ws = (unsigned char*)d_ws;
#if ONE_LAUNCH
    a.l_lo = 0; a.l_hi = DEPTH; a.ph_lo = 0; a.ph_hi = NPHASE;
    hipLaunchKernelGGL(fwd_kernel, dim3(GRID), dim3(NTHR), LDS_BYTES, stream, a);
#else
    a.l_lo = 0; a.l_hi = 1; a.ph_lo = 0; a.ph_hi = 1;
    hipLaunchKernelGGL(fwd_kernel, dim3(GRID), dim3(NTHR), LDS_BYTES, stream, a);
    for (int l = 0; l < DEPTH; ++l)
        for (int ph = 1; ph < NPHASE; ++ph) {
            if (ph == 6 && (l & 1) == 0) continue;
            a.l_lo = l; a.l_hi = l + 1; a.ph_lo = ph; a.ph_hi = ph + 1;
            hipLaunchKernelGGL(fwd_kernel, dim3(GRID), dim3(NTHR), LDS_BYTES, stream, a);
        }
#endif
}
```

```cpp
#include <hip/hip_runtime.h>
#include <cstdio>
#include <cstdint>
#include <cmath>
namespace pg8 {
#define PG8_LAS __attribute__((address_space(3)))
typedef unsigned short bf16_t;
typedef short bf16x8 __attribute__((ext_vector_type(8)));
typedef float f32x4 __attribute__((ext_vector_type(4)));
typedef unsigned u32x4 __attribute__((ext_vector_type(4)));
constexpr int BM = 256, BK = 64, HALF = 128, HTB = HALF * BK * 2  , STAGE_BYTES = 8 * HTB, NXCD = 8, WGM = 8;

__host__ __device__ __forceinline__ int lds_byte(int r, int c) { const int st = (r >> 4) * 2 + (c >> 5), rr = r & 15, cc = c & 31, ob = rr * 64 + cc * 2; return st * 1024 + (ob ^ (((ob >> 9) & 1) << 5)); }
__host__ __device__ __forceinline__ void stage_rc(int b, int& R, int& C) { const int st = b / 1024, sb = b % 1024, swz = sb ^ (((sb >> 9) & 1) << 5); R = (st >> 1) * 16 + swz / 64; C = (st & 1) * 32 + (swz % 64) / 2; }
__host__ __device__ __forceinline__ int perm32(int rho) { const int n = rho >> 4, i = rho & 15; return 8 * (i >> 2) + 4 * n + (i & 3); }

struct Unit { int pm, pn; };
struct Gemm { const bf16_t* A; const bf16_t* Bt; int M, N, K; };

struct StaticOrder {
    int nM, nN, nwg, G, c;
    __host__ __device__ void init(int M, int N, int G_, int c_) { nM = M / BM; nN = N / BM; nwg = nM * nN; G = G_; c = c_; }
    __host__ __device__ bool next(int i, Unit& u) const {
        const long L = (long)i * G + c; if (L >= nwg) return false;
        int wgid = (int)L; { const int q = nwg / NXCD, r = nwg % NXCD, xcd = wgid % NXCD, off = wgid / NXCD; wgid = (xcd < r ? xcd * (q + 1) : r * (q + 1) + (xcd - r) * q) + off; }
        const int nig = WGM * nN, gid = wgid / nig, fm = gid * WGM, gsz = (nM - fm) < WGM ? (nM - fm) : WGM;
        u.pm = fm + ((wgid % nig) % gsz); u.pn = (wgid % nig) / gsz; return true;
    }
    __device__ __forceinline__ void a_ready(const Unit&) const {}
    __device__ __forceinline__ void done(const Unit&) const {}
};

__device__ __forceinline__ unsigned cvt_pk_bf16(float lo, float hi) { unsigned r; asm volatile("v_cvt_pk_bf16_f32 %0, %1, %2" : "=v"(r) : "v"(lo), "v"(hi)); return r; }
typedef float f32x2 __attribute__((ext_vector_type(2)));
struct EpiPlain {
    static constexpr bool PERM = true, AFTER_DRAIN = false;
    bf16_t* O; int ldc;
    __device__ __forceinline__ void operator()(const f32x4 (&acc)[2][2][4][2], const Unit& u, int wr, int wc, int fr, int fq) const {
        const int row0 = u.pm * BM + wr * 64 + fr; const int col0 = u.pn * BM + wc * 32 + 8 * fq;
#pragma unroll
        for (int ai = 0; ai < 2; ++ai)
#pragma unroll
            for (int m = 0; m < 4; ++m) { bf16_t* rowp = O + (size_t)(row0 + ai * HALF + m * 16) * ldc + col0;
#pragma unroll
                for (int bj = 0; bj < 2; ++bj) { const f32x4 v0 = acc[ai][bj][m][0], v1 = acc[ai][bj][m][1];
                    u32x4 w; w.x = cvt_pk_bf16(v0[0], v0[1]); w.y = cvt_pk_bf16(v0[2], v0[3]); w.z = cvt_pk_bf16(v1[0], v1[1]); w.w = cvt_pk_bf16(v1[2], v1[3]);
                    *(u32x4*)(rowp + bj * HALF) = w; } }
    }
};
__device__ __forceinline__ float swiglu1(float g, float u) {
    g = fminf(g, 7.0f); u = fminf(fmaxf(u, -7.0f), 7.0f);
    const float s = __builtin_amdgcn_rcpf(1.0f + __builtin_amdgcn_exp2f(g * (-1.702f * 1.4426950408889634f)));
    return g * s * (u + 1.0f);
}
struct EpiSwiglu {
    static constexpr bool PERM = true, AFTER_DRAIN = false;
    bf16_t* hid; const float* bg; const float* bu;
    __device__ __forceinline__ void operator()(const f32x4 (&acc)[2][2][4][2], const Unit& u, int wr, int wc, int fr, int fq) const {
        const int e = u.pn >> 3, pn = u.pn & 7;
        const int row0 = u.pm * BM + wr * 64 + fr; const int col0 = pn * 128 + wc * 32 + 8 * fq;
        const f32x4 g0 = *(const f32x4*)(bg + e * 1024 + col0), g1 = *(const f32x4*)(bg + e * 1024 + col0 + 4);
        const f32x4 u0 = *(const f32x4*)(bu + e * 1024 + col0), u1 = *(const f32x4*)(bu + e * 1024 + col0 + 4);
#pragma unroll
        for (int ai = 0; ai < 2; ++ai)
#pragma unroll
            for (int m = 0; m < 4; ++m) { bf16_t* rowp = hid + (size_t)(row0 + ai * HALF + m * 16) * 1024 + col0;
                const f32x4 ga = acc[ai][0][m][0] + g0, gb = acc[ai][0][m][1] + g1, ua = acc[ai][1][m][0] + u0, ub = acc[ai][1][m][1] + u1;
                u32x4 w;
                w.x = cvt_pk_bf16(swiglu1(ga[0], ua[0]), swiglu1(ga[1], ua[1])); w.y = cvt_pk_bf16(swiglu1(ga[2], ua[2]), swiglu1(ga[3], ua[3]));
                w.z = cvt_pk_bf16(swiglu1(gb[0], ub[0]), swiglu1(gb[1], ub[1])); w.w = cvt_pk_bf16(swiglu1(gb[2], ub[2]), swiglu1(gb[3], ub[3]));
                *(u32x4*)rowp = w; }
    }
};
struct EpiDown {
    static constexpr bool PERM = true, AFTER_DRAIN = false;
    bf16_t* y; const float* bd;
    __device__ __forceinline__ void operator()(const f32x4 (&acc)[2][2][4][2], const Unit& u, int wr, int wc, int fr, int fq) const {
        const int e = u.pn >> 2, pn = u.pn & 3;
        const int row0 = u.pm * BM + wr * 64 + fr; const int col0 = pn * BM + wc * 32 + 8 * fq;
        f32x4 bv[2][2];
#pragma unroll
        for (int bj = 0; bj < 2; ++bj)
#pragma unroll
            for (int n = 0; n < 2; ++n) bv[bj][n] = *(const f32x4*)(bd + e * 1024 + col0 + bj * HALF + 4 * n);
#pragma unroll
        for (int ai = 0; ai < 2; ++ai)
#pragma unroll
            for (int m = 0; m < 4; ++m) { bf16_t* rowp = y + (size_t)(row0 + ai * HALF + m * 16) * 1024 + col0;
#pragma unroll
                for (int bj = 0; bj < 2; ++bj) { const f32x4 v0 = acc[ai][bj][m][0] + bv[bj][0], v1 = acc[ai][bj][m][1] + bv[bj][1];
                    u32x4 w; w.x = cvt_pk_bf16(v0[0], v0[1]); w.y = cvt_pk_bf16(v0[2], v0[3]); w.z = cvt_pk_bf16(v1[0], v1[1]); w.w = cvt_pk_bf16(v1[2], v1[3]);
                    *(u32x4*)(rowp + bj * HALF) = w; } }
    }
};
struct MoeOrder {
    const PG8_LAS int* tab; int npn, G, c, nunits;
    __device__ __forceinline__ bool next(int i, Unit& u) const {
        const int L = i * G + c; if (L >= nunits) return false;
        const int tile = L / npn, pn = L - tile * npn; int e = 0;
#pragma unroll
        for (int k = 1; k < 32; ++k) e += (tab[k] <= tile) ? 1 : 0;
        u.pm = tile; u.pn = e * npn + pn; return true;
    }
    __device__ __forceinline__ void a_ready(const Unit&) const {}
    __device__ __forceinline__ void done(const Unit&) const {}
};
template <class Epi, class Sched, bool ALIGN_EPI = false, bool SP2 = false>
__device__ __forceinline__ void gemm_phase(PG8_LAS unsigned char* lds, const Gemm g, const Sched& S, const Epi& E) {
    int tid_ = threadIdx.x; asm volatile("" : "+v"(tid_));
    const int tid = tid_, wid = __builtin_amdgcn_readfirstlane(tid >> 6), lane = tid & 63, wr = wid >> 2, wc = wid & 3, fr = lane & 15, fq = lane >> 4;
    const int K = g.K, nt = K / BK;
    unsigned voffA[2], voffB[2];
#pragma unroll
    for (int i = 0; i < 2; ++i) { int R, C; stage_rc(tid * 16 + i * 8192, R, C); const int Rb = Epi::PERM ? ((R & ~31) + perm32(R & 31)) : R;
        voffA[i] = (unsigned)(R * K + C) * 2u; voffB[i] = (unsigned)(Rb * K + C) * 2u; }
    const size_t kstep = (size_t)(BK * 2);
    const size_t hstep = (size_t)HALF * K * 2;
    const size_t tstep = 2 * hstep;
    const unsigned ldsw = (unsigned)wid * 1024u;
    const int aoff = lds_byte(wr * 64 + fr, fq * 8), boff = lds_byte(wc * 32 + fr, fq * 8);
#define PG8_SA(b, h) (((b) * 2 + (h)) * HTB)
#define PG8_SB(b, h) ((4 + (b) * 2 + (h)) * HTB)
#define PG8_STAGE(bufoff, gbase, voff) do { _Pragma("unroll") for (int _i = 0; _i < 2; ++_i) \
        __builtin_amdgcn_global_load_lds((const unsigned*)((const char*)(gbase) + (voff)[_i]), (PG8_LAS unsigned*)(lds + (bufoff) + ldsw + _i * 8192), 16, 0, 0); } while (0)
#define PG8_LDA(dst, b, h) do { _Pragma("unroll") for (int m = 0; m < 4; ++m) _Pragma("unroll") for (int k = 0; k < 2; ++k) dst[m][k] = *(const PG8_LAS bf16x8*)(lds + PG8_SA(b, h) + aoff + m * 2048 + k * 1024); } while (0)
#define PG8_LDB(dst, b, h) do { _Pragma("unroll") for (int n = 0; n < 2; ++n) _Pragma("unroll") for (int k = 0; k < 2; ++k) dst[n][k] = *(const PG8_LAS bf16x8*)(lds + PG8_SB(b, h) + boff + n * 2048 + k * 1024); } while (0)
#define PG8_MMA(ai, bj, At, Bt) do { __builtin_amdgcn_s_setprio(1); _Pragma("unroll") for (int m = 0; m < 4; ++m) _Pragma("unroll") for (int n = 0; n < 2; ++n) _Pragma("unroll") for (int k = 0; k < 2; ++k) \
        acc[ai][bj][m][n] = __builtin_amdgcn_mfma_f32_16x16x32_bf16(Bt[n][k], At[m][k], acc[ai][bj][m][n], 0, 0, 0); __builtin_amdgcn_s_setprio(0); } while (0)
#define PG8_WAIT_V(n) asm volatile("s_waitcnt vmcnt(" #n ")" ::: "memory")
#define PG8_WAIT_L(n) asm volatile("s_waitcnt lgkmcnt(" #n ")" ::: "memory")
#define PG8_BAR __builtin_amdgcn_s_barrier()
#define PG8_SCHED __builtin_amdgcn_sched_barrier(0)
    Unit cur, nxt; int ui = 0;
    if (!S.next(0, cur)) return;
    f32x4 acc[2][2][4][2];
#pragma unroll
    for (int a = 0; a < 2; ++a)
#pragma unroll
        for (int b = 0; b < 2; ++b)
#pragma unroll
            for (int m = 0; m < 4; ++m)
#pragma unroll
                for (int n = 0; n < 2; ++n) acc[a][b][m][n] = (f32x4){0.f, 0.f, 0.f, 0.f};
    bf16x8 At[4][2], B0[2][2], B1[2][2];
    const char* cA = (const char*)g.A + (size_t)cur.pm * tstep; const char* cB = (const char*)g.Bt + (size_t)cur.pn * tstep;
    S.a_ready(cur);
    if constexpr (SP2) {
        PG8_STAGE(PG8_SB(0, 0), cB, voffB); PG8_STAGE(PG8_SB(0, 1), cB + hstep, voffB); PG8_STAGE(PG8_SA(0, 0), cA, voffA); PG8_STAGE(PG8_SA(0, 1), cA + hstep, voffA);
        if (wr == 1) PG8_BAR;
        PG8_WAIT_V(2); PG8_BAR;
        PG8_STAGE(PG8_SB(1, 0), cB + kstep, voffB); PG8_STAGE(PG8_SA(1, 0), cA + kstep, voffA); PG8_STAGE(PG8_SB(1, 1), cB + hstep + kstep, voffB);
        PG8_WAIT_V(6); PG8_BAR;
    } else {
        PG8_STAGE(PG8_SB(0, 0), cB, voffB); PG8_STAGE(PG8_SA(0, 0), cA, voffA); PG8_STAGE(PG8_SB(0, 1), cB + hstep, voffB); PG8_STAGE(PG8_SA(0, 1), cA + hstep, voffA);
        if (wr == 1) PG8_BAR;
        PG8_WAIT_V(4); PG8_BAR;
        PG8_STAGE(PG8_SB(1, 0), cB + kstep, voffB); PG8_STAGE(PG8_SA(1, 0), cA + kstep, voffA); PG8_STAGE(PG8_SB(1, 1), cB + hstep + kstep, voffB);
        PG8_WAIT_V(6); PG8_BAR;
    }
    for (;;) {
        const bool has_next = S.next(ui + 1, nxt);
        const char* nA = has_next ? (const char*)g.A + (size_t)nxt.pm * tstep : cA; const char* nB = has_next ? (const char*)g.Bt + (size_t)nxt.pn * tstep : cB;
        for (int t = 0; t < nt; t += 2) {
            const bool last = (t == nt - 2);
            const char* a1 = cA + (size_t)(t + 1) * kstep;
            const char* a2 = last ? nA : cA + (size_t)(t + 2) * kstep; const char* b2 = last ? nB : cB + (size_t)(t + 2) * kstep;
            const char* a3 = a2 + kstep; const char* b3 = b2 + kstep;
            if (last && has_next) S.a_ready(nxt);
            if constexpr (SP2) {
            PG8_LDB(B0, 0, 0); PG8_LDB(B1, 0, 1); PG8_SCHED; PG8_LDA(At, 0, 0); PG8_STAGE(PG8_SA(1, 1), a1 + hstep, voffA);
            PG8_WAIT_V(8); PG8_WAIT_L(0); PG8_BAR; PG8_MMA(0, 0, At, B0); PG8_MMA(0, 1, At, B1); PG8_BAR; PG8_SCHED;
            PG8_LDA(At, 0, 1); PG8_STAGE(PG8_SB(0, 0), b2, voffB); PG8_STAGE(PG8_SB(0, 1), b2 + hstep, voffB); PG8_STAGE(PG8_SA(0, 0), a2, voffA);
            PG8_WAIT_V(8); PG8_WAIT_L(0); PG8_BAR; PG8_MMA(1, 0, At, B0); PG8_MMA(1, 1, At, B1); PG8_BAR; PG8_SCHED;
            PG8_LDB(B0, 1, 0); PG8_LDB(B1, 1, 1); PG8_SCHED; PG8_LDA(At, 1, 0); PG8_STAGE(PG8_SA(0, 1), a2 + hstep, voffA);
            PG8_WAIT_V(8); PG8_WAIT_L(0); PG8_BAR; PG8_MMA(0, 0, At, B0); PG8_MMA(0, 1, At, B1); PG8_BAR; PG8_SCHED;
            PG8_LDA(At, 1, 1); PG8_STAGE(PG8_SB(1, 0), b3, voffB); PG8_STAGE(PG8_SB(1, 1), b3 + hstep, voffB); PG8_STAGE(PG8_SA(1, 0), a3, voffA);
            PG8_WAIT_V(8); PG8_WAIT_L(0); PG8_BAR; PG8_MMA(1, 0, At, B0); PG8_MMA(1, 1, At, B1); PG8_BAR; PG8_SCHED;
            } else {
            PG8_LDB(B0, 0, 0); PG8_SCHED; PG8_LDA(At, 0, 0); PG8_STAGE(PG8_SA(1, 1), a1 + hstep, voffA);
            PG8_WAIT_L(8); PG8_BAR; PG8_WAIT_L(0); PG8_MMA(0, 0, At, B0); PG8_BAR; PG8_SCHED;
            PG8_LDB(B1, 0, 1); PG8_STAGE(PG8_SB(0, 0), b2, voffB);
            PG8_BAR; PG8_WAIT_L(0); PG8_MMA(0, 1, At, B1); PG8_BAR;
            PG8_LDA(At, 0, 1); PG8_STAGE(PG8_SA(0, 0), a2, voffA);
            PG8_BAR; PG8_WAIT_L(0); PG8_MMA(1, 0, At, B0); PG8_BAR; PG8_SCHED;
            PG8_STAGE(PG8_SB(0, 1), b2 + hstep, voffB);
            PG8_WAIT_V(6); PG8_BAR; PG8_MMA(1, 1, At, B1); PG8_BAR;
            PG8_LDB(B0, 1, 0); PG8_SCHED; PG8_LDA(At, 1, 0); PG8_STAGE(PG8_SA(0, 1), a2 + hstep, voffA);
            PG8_WAIT_L(8); PG8_BAR; PG8_WAIT_L(0); PG8_MMA(0, 0, At, B0); PG8_BAR; PG8_SCHED;
            PG8_LDB(B1, 1, 1); PG8_STAGE(PG8_SB(1, 0), b3, voffB);
            PG8_BAR; PG8_WAIT_L(0); PG8_MMA(0, 1, At, B1); PG8_BAR;
            PG8_LDA(At, 1, 1); PG8_STAGE(PG8_SA(1, 0), a3, voffA);
            PG8_BAR; PG8_WAIT_L(0); PG8_MMA(1, 0, At, B0); PG8_BAR; PG8_SCHED;
            PG8_STAGE(PG8_SB(1, 1), b3 + hstep, voffB);
            PG8_WAIT_V(6); PG8_BAR; PG8_MMA(1, 1, At, B1); PG8_BAR;
            }
        }
        if constexpr (ALIGN_EPI) { if (wr == 0) PG8_BAR; }
        if constexpr (!Epi::AFTER_DRAIN) { E(acc, cur, wr, wc, fr, fq); S.done(cur); }
        if (!has_next) break;
#pragma unroll
        for (int a = 0; a < 2; ++a)
#pragma unroll
            for (int b = 0; b < 2; ++b)
#pragma unroll
                for (int m = 0; m < 4; ++m)
#pragma unroll
                    for (int n = 0; n < 2; ++n) acc[a][b][m][n] = (f32x4){0.f, 0.f, 0.f, 0.f};
        cur = nxt; cA = nA; cB = nB; ++ui;
        if constexpr (ALIGN_EPI) { if (wr == 1) PG8_BAR; }
    }
    PG8_WAIT_V(0);
    if constexpr (!ALIGN_EPI) { if (wr == 0) PG8_BAR; }
    PG8_BAR;
    if constexpr (Epi::AFTER_DRAIN) { E.fused(acc, cur, wr, wc, fr, fq, lds, wid, lane); S.done(cur); }
#undef PG8_SA
#undef PG8_SB
#undef PG8_STAGE
#undef PG8_LDA
#undef PG8_LDB
#undef PG8_MMA
#undef PG8_WAIT_V
#undef PG8_WAIT_L
#undef PG8_BAR
#undef PG8_SCHED
}
}

constexpr int NWAVES = 8, NTHR = 512, GRID = 256;
constexpr int NBATCH = 2, SEQ = 16384, T = NBATCH * SEQ, D = 1024, DEPTH = 4;
constexpr int MIXW = 768, NC_H = 3328, NC_M = 2560;
constexpr int HG_H = 6;
constexpr int HSEG = 256, HNSEG = SEQ / HSEG;
constexpr int MB_H = 12, MB_NB = 64;
constexpr int NE = 32;
constexpr float DN_ALPHA = 1.6817928305074290f;
constexpr int MOE_MAXROWS = T * 4 + NE * 256;
#ifndef ONE_LAUNCH
#define ONE_LAUNCH 1
#endif
constexpr int NPHASE = 13;

constexpr size_t MiB = 1u << 20;
constexpr size_t WS_CTL = 0, CTL_ZERO_BYTES = 1 * MiB;
constexpr size_t WS_WIN = 1 * MiB, WS_WKV = 9 * MiB, WS_WO = 10 * MiB, WS_WGU = 12 * MiB, WS_WD = 140 * MiB;
constexpr size_t WS_XBF = 204 * MiB, WS_XA = 268 * MiB, WS_XB = 396 * MiB, WS_MEMBF = 524 * MiB, WS_KV = 525 * MiB;
constexpr size_t WS_H = 526 * MiB, WS_MIX = 734 * MiB, WS_Y = 798 * MiB, WS_SLOC = 862 * MiB, WS_DSEG = 910 * MiB, WS_KMEAN = 911 * MiB;
constexpr size_t WS_SELINFO = 912 * MiB, WS_TOK = 914 * MiB, WS_R1 = 918 * MiB;
constexpr size_t WS_LIST = WS_R1, WS_PML = WS_R1 + 96 * MiB, WS_PO = WS_R1 + 108 * MiB;
constexpr size_t WS_XS = WS_R1, WS_HID = WS_R1 + 272 * MiB;
constexpr size_t WS_END = WS_R1 + 544 * MiB;
static_assert((size_t)MOE_MAXROWS * 1024 * 2 <= 272 * MiB, "moe rows");
static_assert((size_t)T * MB_H * 4 * 64 * 4 <= 384 * MiB && (size_t)24 * 64 * 16384 * 4 <= 96 * MiB, "moba bufs");
constexpr size_t TOK_E = 0, TOK_LR = 512 * 1024, TOK_W = 1024 * 1024, TOK_ROW = 1536 * 1024, TOK_BLKCNT = 2048 * 1024, TOK_TAB = 2048 * 1024 + 65536;
constexpr int CW_BAR = 4096, CW_GCOUNT = 8192;

constexpr int RING_BYTES = 131072, MISC_OFF = RING_BYTES, LDS_BYTES = 147456;

#define GAS __attribute__((address_space(1)))
#define LAS __attribute__((address_space(3)))
typedef unsigned short bf16;
typedef unsigned v4u __attribute__((ext_vector_type(4)));
typedef unsigned v2u __attribute__((ext_vector_type(2)));
typedef float f32x4 __attribute__((ext_vector_type(4)));
typedef float f32x2 __attribute__((ext_vector_type(2)));
#define LDS_WAIT() asm volatile("s_waitcnt lgkmcnt(0)" ::: "memory")
__device__ __forceinline__ unsigned f2bf(float f) { unsigned u = __builtin_bit_cast(unsigned, f); return (u + 0x7fffu + ((u >> 16) & 1u)) >> 16; }
__device__ __forceinline__ unsigned pk2(float lo, float hi) { return f2bf(lo) | (f2bf(hi) << 16); }
__device__ __forceinline__ float bflo(unsigned w) { return __builtin_bit_cast(float, w << 16); }
__device__ __forceinline__ float bfhi(unsigned w) { return __builtin_bit_cast(float, w & 0xffff0000u); }
__device__ __forceinline__ float bf2f(bf16 h) { return __builtin_bit_cast(float, (unsigned)h << 16); }
__device__ __forceinline__ float sigmoidf_(float z) { return __builtin_amdgcn_rcpf(1.0f + __builtin_amdgcn_exp2f(-1.4426950408889634f * z)); }
__device__ __forceinline__ float wave_sum(float v) {
#pragma unroll
    for (int o = 1; o < 64; o <<= 1) v += __shfl_xor(v, o);
    return v;
}
__device__ __forceinline__ float wave_max(float v) {
#pragma unroll
    for (int o = 1; o < 64; o <<= 1) v = fmaxf(v, __shfl_xor(v, o));
    return v;
}
#define XB_TMO      128
#define XB_XCNT(j)  (256  + 64 * (j))
#define XB_XSUB(j)  (1280 + 64 * (j))
#define XB_XGEN(j)  (2304 + 64 * (j))
#define XB_TOP      3328
#define XB_TOPGEN   3392
#define XCD_BAR_WORDS 3456
#define XB_SPIN_CAP (1u << 18)

__device__ __forceinline__ unsigned xb_ld(unsigned* p)              { return __hip_atomic_load(p, __ATOMIC_RELAXED, __HIP_MEMORY_SCOPE_AGENT); }
__device__ __forceinline__ unsigned xb_add(unsigned* p, unsigned v) { return __hip_atomic_fetch_add(p, v, __ATOMIC_RELAXED, __HIP_MEMORY_SCOPE_AGENT); }
__device__ __forceinline__ unsigned xb_xcc_id() { return (unsigned)__builtin_amdgcn_s_getreg((3 << 11) | 20) & 0xFu; }
#define XB_SPIN(cond, bar) do { unsigned _sp = 0; while (cond) { __builtin_amdgcn_s_sleep(1); \
    if ((++_sp & 255u) == 0u) { if (xb_ld(&(bar)[XB_TMO])) break; if (_sp > XB_SPIN_CAP) { atomicAdd(&(bar)[XB_TMO], 1u); break; } } } } while (0)

struct XcdBarrier {
    unsigned* bar; unsigned x;
    volatile LAS unsigned* st;
};

__device__ __forceinline__ XcdBarrier xcd_barrier_post(unsigned* bar, volatile LAS unsigned* st) {
    XcdBarrier b; b.bar = bar; b.x = xb_xcc_id(); b.st = st;
    if (threadIdx.x == 0) (void)xb_add(&bar[XB_XCNT(b.x)], 1u);
    return b;
}
__device__ __forceinline__ void xcd_barrier_complete(unsigned* bar, unsigned x, unsigned& nloc, unsigned& nx) {
    const unsigned G = gridDim.x * gridDim.y * gridDim.z;
    unsigned sum, cnt, mine, sp = 0u;
    for (;;) {
        sum = 0u; cnt = 0u; mine = 0u;
#pragma unroll
        for (unsigned j = 0; j < 16; ++j) { const unsigned c = xb_ld(&bar[XB_XCNT(j)]); sum += c; cnt += (c > 0u) ? 1u : 0u; mine = (j == x) ? c : mine; }
        if (sum == G) break;
        __builtin_amdgcn_s_sleep(1);
        if ((++sp & 255u) == 0u) { if (xb_ld(&bar[XB_TMO])) break; if (sp > XB_SPIN_CAP) { atomicAdd(&bar[XB_TMO], 1u); break; } }
    }
    nloc = mine > 0u ? mine : 1u; nx = cnt > 0u ? cnt : 1u;
}

__device__ __forceinline__ void xcd_barrier(const XcdBarrier& b) {
    asm volatile("s_waitcnt vmcnt(0)" ::: "memory");
    __syncthreads();
    if (threadIdx.x == 0) {
        unsigned* bar = b.bar;
        __builtin_amdgcn_s_waitcnt(0);
        unsigned nloc = b.st[0], nx = b.st[1];
        if (nloc == 0u) { xcd_barrier_complete(bar, b.x, nloc, nx); b.st[0] = nloc; b.st[1] = nx; }
        const unsigned old = xb_add(&bar[XB_XSUB(b.x)], 1u);
        const unsigned gen = old / nloc;
        if (old + 1u == (gen + 1u) * nloc) {
            __builtin_amdgcn_fence(__ATOMIC_RELEASE, "agent");
            asm volatile("s_waitcnt vmcnt(0)" ::: "memory");
            const unsigned og = xb_add(&bar[XB_TOP], 1u);
            const unsigned tg = og / nx;
            if (og + 1u == (tg + 1u) * nx) xb_add(&bar[XB_TOPGEN], 1u);
            else XB_SPIN(xb_ld(&bar[XB_TOPGEN]) == tg, bar);
            __builtin_amdgcn_fence(__ATOMIC_ACQUIRE, "agent");
            xb_add(&bar[XB_XGEN(b.x)], 1u);
            asm volatile("s_waitcnt vmcnt(0)" ::: "memory");
        } else {
            XB_SPIN(xb_ld(&bar[XB_XGEN(b.x)]) == gen, bar);
            __builtin_amdgcn_fence(__ATOMIC_ACQUIRE, "agent");
            asm volatile("s_waitcnt vmcnt(0)" ::: "memory");
        }
    }
    __syncthreads();
}

__device__ __forceinline__ void cvt_rows_bf16(const float* src, bf16* dst, size_t n8, size_t gtid, size_t gthreads) {
    for (size_t i = gtid; i < n8; i += gthreads) { const f32x4 a = ((const f32x4*)src)[2 * i], b = ((const f32x4*)src)[2 * i + 1];
        v4u o; o.x = pk2(a.x, a.y); o.y = pk2(a.z, a.w); o.z = pk2(b.x, b.y); o.w = pk2(b.z, b.w); ((v4u*)dst)[i] = o; }
}
__device__ __forceinline__ void transpose_item(const float* W, int N, bf16* WT, int dst_row0, LAS float* scr, int k0, int n0, int lane) {
#pragma unroll 8
    for (int i = 0; i < 32; ++i) { const int kk = 2 * i + (lane >> 5); scr[kk * 33 + (lane & 31)] = W[(size_t)(k0 + kk) * N + n0 + (lane & 31)]; }
    LDS_WAIT(); asm volatile("" ::: "memory");
    const int c = lane & 7;
#pragma unroll
    for (int j = 0; j < 4; ++j) { const int n = (lane >> 3) + 8 * j; const LAS float* s = scr + (8 * c) * 33 + n;
        v4u o; o.x = pk2(s[0 * 33], s[1 * 33]); o.y = pk2(s[2 * 33], s[3 * 33]); o.z = pk2(s[4 * 33], s[5 * 33]); o.w = pk2(s[6 * 33], s[7 * 33]);
        *(v4u*)(WT + (size_t)(dst_row0 + n) * 1024 + k0 + 8 * c) = o; }
    LDS_WAIT(); asm volatile("" ::: "memory");
}
__device__ __forceinline__ void phase_weights(LAS float* scr, int gw, int ngw, int lane, const float* win_src, int NC, const float* wkv_src, const float* wo_src,
                                              const float* wg_src, const float* wu_src, const float* wd_src, bf16* win_t, bf16* wkv_t, bf16* wo_t, bf16* wgu_t, bf16* wd_t) {
    const int nbw = NC / 32, nWin = nbw * 16, NIT = nWin + 256 + 512 + NE * 1536;
    for (int it = gw; it < NIT; it += ngw) {
        int r = it;
        if (r < nWin) { const int kb = r / nbw, nb = r - kb * nbw; transpose_item(win_src, NC, win_t, 32 * nb, scr, 64 * kb, 32 * nb, lane); continue; } r -= nWin;
        if (r < 256) { const int kb = r >> 4, nb = r & 15; transpose_item(wkv_src, 512, wkv_t, 32 * nb, scr, 64 * kb, 32 * nb, lane); continue; } r -= 256;
        if (r < 512) { const int kb = r >> 5, nb = r & 31; transpose_item(wo_src, 1024, wo_t, 32 * nb, scr, 64 * kb, 32 * nb, lane); continue; } r -= 512;
        const int e = r / 1536, q = r - e * 1536, which = q >> 9, rr = q & 511, kb = rr >> 5, nb = rr & 31, n0 = 32 * nb;
        const size_t eoff = (size_t)e * 1024 * 1024;
        if (which == 0) transpose_item(wg_src + eoff, 1024, wgu_t + 2 * eoff, (n0 >> 7) * 256 + (n0 & 127), scr, 64 * kb, n0, lane);
        else if (which == 1) transpose_item(wu_src + eoff, 1024, wgu_t + 2 * eoff, (n0 >> 7) * 256 + 128 + (n0 & 127), scr, 64 * kb, n0, lane);
        else transpose_item(wd_src + eoff, 1024, wd_t + eoff, n0, scr, 64 * kb, n0, lane);
    }
}

template <bool OUT>
__device__ __forceinline__ void hgrn_seg(LAS unsigned char* lds, const bf16* h, const float* lbl, int j, const float* normg, float* Sloc, float* Dseg, bf16* mix, int unit, int tid, int wave, int lane) {
    const int seg = unit & (HNSEG - 1), bh = unit >> 6, hh = bh % HG_H, b = bh / HG_H;
    const int v = tid & 127, dg = tid >> 7;
    LAS float* fgs = (LAS float*)lds; LAS float* vs = fgs + 4096; LAS float* qs = vs + 4096; LAS float* op = qs + 4096;
    float st[32];
    float* Sp = Sloc + (size_t)unit * 16384 + (size_t)(dg * 32) * 128 + v;
#pragma unroll
    for (int dd = 0; dd < 32; ++dd) st[dd] = OUT ? Sp[dd * 128] : 0.f;
    float dprod = 1.f;
    const int stok = tid >> 4, c8 = (tid & 15) * 8;
    float lb[8];
#pragma unroll
    for (int i = 0; i < 8; ++i) { lb[i] = 0.f; if (j > 0) { const float a0 = lbl[hh * 128 + c8 + i], a1 = lbl[MIXW + hh * 128 + c8 + i]; lb[i] = 1.f / (1.f + __expf(a0 - a1)); } }
    for (int ch = 0; ch < HSEG / 32; ++ch) {
        const size_t t0 = (size_t)b * SEQ + seg * HSEG + ch * 32;
        { const bf16* row = h + (t0 + stok) * NC_H + hh * 128 + c8;
          const v4u f8 = *(const v4u*)(row + 768), i8 = *(const v4u*)(row + 1536); v4u q8 = {0u, 0u, 0u, 0u}; if (OUT) q8 = *(const v4u*)row;
#pragma unroll
          for (int w = 0; w < 4; ++w) { const float f0 = bflo(f8[w]), f1 = bfhi(f8[w]); const int o = stok * 128 + c8 + 2 * w;
              fgs[o] = lb[2 * w] + (1.f - lb[2 * w]) * sigmoidf_(f0); fgs[o + 1] = lb[2 * w + 1] + (1.f - lb[2 * w + 1]) * sigmoidf_(f1);
              vs[o] = bflo(i8[w]); vs[o + 1] = bfhi(i8[w]);
              if (OUT) { const float q0 = bflo(q8[w]), q1 = bfhi(q8[w]); qs[o] = q0 * sigmoidf_(q0); qs[o + 1] = q1 * sigmoidf_(q1); } } }
        __syncthreads();
        if (!OUT) { if (tid < 128) { for (int tt = 0; tt < 32; ++tt) dprod *= fgs[tt * 128 + tid]; } }
#pragma unroll 2
        for (int tt = 0; tt < 32; ++tt) {
            const float vv = vs[tt * 128 + v]; float acc = 0.f;
#pragma unroll
            for (int d4 = 0; d4 < 8; ++d4) { const f32x4 f4 = *(const LAS f32x4*)(fgs + tt * 128 + dg * 32 + d4 * 4);
                f32x4 q4 = {0.f, 0.f, 0.f, 0.f}; if (OUT) q4 = *(const LAS f32x4*)(qs + tt * 128 + dg * 32 + d4 * 4);
#pragma unroll
                for (int i = 0; i < 4; ++i) { st[d4 * 4 + i] = f4[i] * (st[d4 * 4 + i] - vv) + vv; if (OUT) acc += q4[i] * st[d4 * 4 + i]; } }
            if (OUT) op[(dg * 32 + tt) * 128 + v] = acc;
        }
        if (OUT) {
            __syncthreads();
#pragma unroll
            for (int k = 0; k < 4; ++k) { const int tt = wave + 8 * k; float o0 = 0.f, o1 = 0.f;
#pragma unroll
                for (int g = 0; g < 4; ++g) { o0 += op[(g * 32 + tt) * 128 + lane]; o1 += op[(g * 32 + tt) * 128 + lane + 64]; }
                const float ms = wave_sum(o0 * o0 + o1 * o1) * (1.f / 128.f), r = 1.f / sqrtf(ms + 1e-6f);
                const bf16* grow = h + (t0 + tt) * NC_H + 2304 + hh * 128; const float g0 = bf2f(grow[lane]), g1 = bf2f(grow[lane + 64]);
                bf16* mrow = mix + (t0 + tt) * 1024 + hh * 128;
                mrow[lane] = (bf16)f2bf(o0 * r * normg[lane] * sigmoidf_(g0)); mrow[lane + 64] = (bf16)f2bf(o1 * r * normg[lane + 64] * sigmoidf_(g1)); }
        }
        __syncthreads();
    }
    if (!OUT) {
#pragma unroll
        for (int dd = 0; dd < 32; ++dd) Sp[dd * 128] = st[dd];
        if (tid < 128) Dseg[(size_t)unit * 128 + tid] = dprod;
    }
}
__device__ __forceinline__ void hgrn_scan(float* Sloc, const float* Dseg, size_t gtid, size_t gthreads) {
    for (size_t idx = gtid; idx < (size_t)NBATCH * HG_H * 16384; idx += gthreads) { const int bh = (int)(idx >> 14), e = (int)(idx & 16383), d = e >> 7; float cur = 0.f;
        for (int seg = 0; seg < HNSEG; ++seg) { const size_t u = (size_t)bh * HNSEG + seg; float* p = Sloc + u * 16384 + e; const float tmp = *p; *p = cur; cur = Dseg[u * 128 + d] * cur + tmp; } }
}

template <bool MASK>
__device__ __forceinline__ void attn4(const LAS unsigned* Ks, const LAS bf16* Vs, const LAS float* qst, LAS float* pb, int lane, const int (&tq)[4], int kbase, float slope,
                                      float (&mo)[4], float (&lo)[4], float (&oo)[4]) {
    float sc[4][4];
#pragma unroll
    for (int a = 0; a < 4; ++a)
#pragma unroll
        for (int c = 0; c < 4; ++c) sc[a][c] = 0.f;
#pragma unroll 4
    for (int dd = 0; dd < 32; ++dd) {
        f32x2 qv[4];
#pragma unroll
        for (int qi = 0; qi < 4; ++qi) qv[qi] = *(const LAS f32x2*)(qst + qi * 64 + 2 * dd);
#pragma unroll
        for (int kk = 0; kk < 4; ++kk) { const unsigned kw = Ks[(lane + 64 * kk) * 33 + dd]; const float k0 = bflo(kw), k1 = bfhi(kw);
#pragma unroll
            for (int qi = 0; qi < 4; ++qi) sc[qi][kk] += qv[qi].x * k0 + qv[qi].y * k1; }
    }
#pragma unroll
    for (int qi = 0; qi < 4; ++qi) { float mx = -INFINITY;
#pragma unroll
        for (int kk = 0; kk < 4; ++kk) { const int pos = kbase + lane + 64 * kk; float lg = sc[qi][kk] * 0.125f - slope * (float)(tq[qi] - pos); if (MASK && pos > tq[qi]) lg = -INFINITY; sc[qi][kk] = lg; mx = fmaxf(mx, lg); }
        mx = wave_max(mx); float s = 0.f;
#pragma unroll
        for (int kk = 0; kk < 4; ++kk) { const float p = __builtin_amdgcn_exp2f((sc[qi][kk] - mx) * 1.4426950408889634f); pb[qi * 256 + lane + 64 * kk] = p; s += p; }
        lo[qi] = wave_sum(s); mo[qi] = mx; }
    float o[4] = {0.f, 0.f, 0.f, 0.f};
#pragma unroll 4
    for (int k4 = 0; k4 < 64; ++k4) { f32x4 p4[4];
#pragma unroll
        for (int qi = 0; qi < 4; ++qi) p4[qi] = *(const LAS f32x4*)(pb + qi * 256 + 4 * k4);
#pragma unroll
        for (int jj = 0; jj < 4; ++jj) { const float vv = bf2f(Vs[(4 * k4 + jj) * 64 + lane]);
#pragma unroll
            for (int qi = 0; qi < 4; ++qi) o[qi] += p4[qi][jj] * vv; } }
#pragma unroll
    for (int qi = 0; qi < 4; ++qi) oo[qi] = o[qi];
}
constexpr int AT_KS = 0, AT_VS = 33792, AT_WV = 66560, AT_WVB = 5120;

__device__ __forceinline__ void memattn_unit(LAS unsigned char* lds, const bf16* h, int NC, int qoff, const bf16* kv, bf16* mix, int unit, int tid, int wave, int lane) {
    const int chunk = unit & 31, bm = unit >> 5, mh = bm & 3, b = bm >> 2;
    LAS unsigned* Ks = (LAS unsigned*)(lds + AT_KS); LAS unsigned* Vs32 = (LAS unsigned*)(lds + AT_VS);
    LAS float* qst = (LAS float*)(lds + AT_WV + wave * AT_WVB); LAS float* pb = qst + 256;
    for (int i = 0; i < 16; ++i) { const int idx = tid + 512 * i, r = idx >> 5, dd = idx & 31; const unsigned* src = (const unsigned*)(kv + (size_t)(b * 256 + r) * 512 + mh * 64);
        Ks[r * 33 + dd] = src[dd]; Vs32[r * 32 + dd] = src[128 + dd]; }
    __syncthreads();
    for (int qd = 0; qd < 16; ++qd) { const size_t tg = (size_t)b * SEQ + chunk * 512 + wave * 64 + qd * 4;
#pragma unroll
        for (int qi = 0; qi < 4; ++qi) qst[qi * 64 + lane] = bf2f(h[(tg + qi) * NC + qoff + mh * 64 + lane]);
        const int tq[4] = {0, 0, 0, 0}; float m[4], l[4], o[4];
        attn4<false>(Ks, (const LAS bf16*)Vs32, qst, pb, lane, tq, 0, 0.f, m, l, o);
#pragma unroll
        for (int qi = 0; qi < 4; ++qi) mix[(tg + qi) * 1024 + MIXW + mh * 64 + lane] = (bf16)f2bf(o[qi] / l[qi]); }
    __syncthreads();
}

typedef short s16x8 __attribute__((ext_vector_type(8)));
typedef float f32x16 __attribute__((ext_vector_type(16)));
typedef float f32x2_t __attribute__((ext_vector_type(2))); typedef __bf16 bf16x2_t __attribute__((ext_vector_type(2)));
__device__ __forceinline__ unsigned cvtpk(float lo, float hi) { f32x2_t v = {lo, hi}; bf16x2_t b = __builtin_convertvector(v, bf16x2_t); return __builtin_bit_cast(unsigned, b); }
constexpr int AT2_K = 0, AT2_V = 36864, AT2_KROW = 144, AT2_VROW = 528;
__device__ __forceinline__ void stage_kv_images(LAS unsigned char* lds, const bf16* kp, const bf16* vp, size_t row_stride, int tid) {
#pragma unroll
    for (int i = 0; i < 4; ++i) { const int idx = tid + 512 * i, key = idx >> 3, c = idx & 7;
        const v4u kx = *(const v4u*)(kp + (size_t)key * row_stride + 8 * c);
        *(LAS v4u*)(lds + AT2_K + key * AT2_KROW + c * 16) = kx;
        const v4u vx = *(const v4u*)(vp + (size_t)key * row_stride + 8 * c);
        const int pos = (key & ~15) | (key & 3) | ((key & 4) << 1) | ((key & 8) >> 1);
        LAS bf16* vt = (LAS bf16*)(lds + AT2_V) + pos;
#pragma unroll
        for (int w = 0; w < 4; ++w) { vt[(8 * c + 2 * w) * (AT2_VROW / 2)] = (bf16)(vx[w] & 0xffffu); vt[(8 * c + 2 * w + 1) * (AT2_VROW / 2)] = (bf16)(vx[w] >> 16); } }
}
template <bool MASK>
__device__ __forceinline__ void attn_tile32(const LAS unsigned char* lds, const bf16* qrow, int lane, float dist0, float slope2, f32x16 (&o)[2], float& mrow, float& lrow) {
    const int r = lane & 31, hf = lane >> 5;
    s16x8 qf[4];
#pragma unroll
    for (int s = 0; s < 4; ++s) qf[s] = *(const s16x8*)(qrow + 16 * s + 8 * hf);
    f32x16 acc[8];
    const LAS unsigned char* kb = lds + AT2_K + r * AT2_KROW + hf * 16;
#pragma unroll
    for (int kt = 0; kt < 8; ++kt) {
#pragma unroll
        for (int i = 0; i < 16; ++i) acc[kt][i] = 0.f;
#pragma unroll
        for (int s = 0; s < 4; ++s) { const s16x8 kf = *(const LAS s16x8*)(kb + kt * 32 * AT2_KROW + s * 32); acc[kt] = __builtin_amdgcn_mfma_f32_32x32x16_bf16(kf, qf[s], acc[kt], 0, 0, 0); }
        __builtin_amdgcn_sched_barrier(0); }
    const float base2 = dist0 - 4.f * (float)hf; float mx = -INFINITY;
#pragma unroll
    for (int kt = 0; kt < 8; ++kt)
#pragma unroll
        for (int i = 0; i < 16; ++i) { const float dist = base2 - (float)(32 * kt + (i & 3) + 8 * (i >> 2)); float lg = acc[kt][i] * (0.125f * 1.4426950408889634f);
            if (MASK) { lg -= slope2 * dist; if (dist < 0.f) lg = -INFINITY; } acc[kt][i] = lg; mx = fmaxf(mx, lg); }
    mx = fmaxf(mx, __shfl_xor(mx, 32));
    float sum = 0.f;
#pragma unroll
    for (int i = 0; i < 16; ++i) { o[0][i] = 0.f; o[1][i] = 0.f; }
    const LAS unsigned char* vb = lds + AT2_V + r * AT2_VROW + hf * 16;
#pragma unroll
    for (int kt = 0; kt < 8; ++kt) {
#pragma unroll
        for (int i = 0; i < 16; ++i) { const float p = __builtin_amdgcn_exp2f(acc[kt][i] - mx); sum += p; acc[kt][i] = p; }
#pragma unroll
        for (int s2 = 0; s2 < 2; ++s2) { v4u pw; pw.x = cvtpk(acc[kt][8 * s2], acc[kt][8 * s2 + 1]); pw.y = cvtpk(acc[kt][8 * s2 + 2], acc[kt][8 * s2 + 3]);
            pw.z = cvtpk(acc[kt][8 * s2 + 4], acc[kt][8 * s2 + 5]); pw.w = cvtpk(acc[kt][8 * s2 + 6], acc[kt][8 * s2 + 7]); const s16x8 pf = __builtin_bit_cast(s16x8, pw);
#pragma unroll
            for (int dt = 0; dt < 2; ++dt) { const s16x8 vf = *(const LAS s16x8*)(vb + dt * 32 * AT2_VROW + (32 * kt + 16 * s2) * 2); o[dt] = __builtin_amdgcn_mfma_f32_32x32x16_bf16(vf, pf, o[dt], 0, 0, 0); } }
        __builtin_amdgcn_sched_barrier(0); }
    sum += __shfl_xor(sum, 32);
    mrow = mx; lrow = sum;
}
__device__ __forceinline__ void memattn_unit2(LAS unsigned char* lds, const bf16* h, int NC, int qoff, const bf16* kv, bf16* mix, int unit, int tid, int wave, int lane) {
    const int chunk = unit & 63, bm = unit >> 6, mh = bm & 3, b = bm >> 2, r = lane & 31, hf = lane >> 5;
    const bf16* kvrow0 = kv + (size_t)(b * 256) * 512 + mh * 64;
    stage_kv_images(lds, kvrow0, kvrow0 + 256, 512, tid);
    __syncthreads();
    { const size_t tg = (size_t)b * SEQ + chunk * 256 + wave * 32 + r;
        f32x16 o[2]; float m2, l;
        attn_tile32<false>(lds, h + tg * NC + qoff + mh * 64, lane, 0.f, 0.f, o, m2, l);
        const float inv = 1.f / l; bf16* mp = mix + tg * 1024 + MIXW + mh * 64 + 4 * hf;
#pragma unroll
        for (int dt = 0; dt < 2; ++dt)
#pragma unroll
            for (int g = 0; g < 4; ++g) { v2u w; w.x = cvtpk(o[dt][4 * g] * inv, o[dt][4 * g + 1] * inv); w.y = cvtpk(o[dt][4 * g + 2] * inv, o[dt][4 * g + 3] * inv); *(v2u*)(mp + 32 * dt + 8 * g) = w; } }
    __syncthreads();
}
__device__ __forceinline__ void kmean_unit(LAS unsigned char* lds, const bf16* h, float* kmean, int unit, int tid) {
    const int n = unit & 63, bh = unit >> 6, hh = bh % MB_H, b = bh / MB_H, d = tid & 63, part = tid >> 6;
    LAS float* red = (LAS float*)lds;
    float s = 0.f; const bf16* p = h + ((size_t)b * SEQ + n * 256 + part * 32) * NC_M + 768 + hh * 64 + d;
    for (int i = 0; i < 32; ++i) s += bf2f(p[(size_t)i * NC_M]);
    red[part * 64 + d] = s; __syncthreads();
    if (tid < 64) { float a = 0.f; for (int pp = 0; pp < 8; ++pp) a += red[pp * 64 + tid]; kmean[((size_t)bh * 64 + n) * 64 + tid] = a * (1.f / 256.f); }
    __syncthreads();
}
__device__ __forceinline__ void moba_gate_unit(LAS unsigned char* lds, const bf16* h, const float* kmean, unsigned* gcount, int* selinfo, unsigned* list, int unit, int tid) {
    const int c = unit & 63, bh = unit >> 6, hh = bh % MB_H, b = bh / MB_H;
    LAS float* km = (LAS float*)lds; LAS int* hist = (LAS int*)(lds + 16384); LAS int* base = hist + 64;
    for (int i = tid; i < 4096; i += NTHR) km[i] = kmean[(size_t)bh * 4096 + i];
    if (tid < 64) hist[tid] = 0;
    __syncthreads();
    int s0 = 0, s1 = 0, s2 = 0, r0 = 0, r1 = 0, r2 = 0, ns = 0; const int t = c * 256 + tid;
    if (tid < 256) {
        float q[64]; const v4u* qp = (const v4u*)(h + ((size_t)b * SEQ + t) * NC_M + hh * 64);
#pragma unroll
        for (int w = 0; w < 8; ++w) { const v4u x = qp[w]; q[8 * w] = bflo(x.x); q[8 * w + 1] = bfhi(x.x); q[8 * w + 2] = bflo(x.y); q[8 * w + 3] = bfhi(x.y); q[8 * w + 4] = bflo(x.z); q[8 * w + 5] = bfhi(x.z); q[8 * w + 6] = bflo(x.w); q[8 * w + 7] = bfhi(x.w); }
        float v0 = -INFINITY, v1 = -INFINITY, v2 = -INFINITY;
        for (int n = 0; n < c; ++n) { float g = 0.f;
#pragma unroll
            for (int d4 = 0; d4 < 16; ++d4) { const f32x4 k4 = *(const LAS f32x4*)(km + n * 64 + 4 * d4); g += q[4 * d4] * k4.x + q[4 * d4 + 1] * k4.y + q[4 * d4 + 2] * k4.z + q[4 * d4 + 3] * k4.w; }
            if (g > v0) { v2 = v1; s2 = s1; v1 = v0; s1 = s0; v0 = g; s0 = n; } else if (g > v1) { v2 = v1; s2 = s1; v1 = g; s1 = n; } else if (g > v2) { v2 = g; s2 = n; } }
        ns = c < 3 ? c : 3;
        if (ns > 0) r0 = __hip_atomic_fetch_add(hist + s0, 1, __ATOMIC_RELAXED, __HIP_MEMORY_SCOPE_WORKGROUP);
        if (ns > 1) r1 = __hip_atomic_fetch_add(hist + s1, 1, __ATOMIC_RELAXED, __HIP_MEMORY_SCOPE_WORKGROUP);
        if (ns > 2) r2 = __hip_atomic_fetch_add(hist + s2, 1, __ATOMIC_RELAXED, __HIP_MEMORY_SCOPE_WORKGROUP);
        selinfo[((size_t)b * SEQ + t) * MB_H + hh] = ns;
    }
    __syncthreads();
    if (tid < 64) { const int hc = hist[tid]; if (hc > 0) base[tid] = (int)__hip_atomic_fetch_add(gcount + bh * 64 + tid, (unsigned)hc, __ATOMIC_RELAXED, __HIP_MEMORY_SCOPE_AGENT); }
    __syncthreads();
    if (tid < 256) { unsigned* lp = list + ((size_t)bh * 64 << 14);
        if (ns > 0) lp[((size_t)s0 << 14) + base[s0] + r0] = (unsigned)t;
        if (ns > 1) lp[((size_t)s1 << 14) + base[s1] + r1] = (unsigned)t | (1u << 14);
        if (ns > 2) lp[((size_t)s2 << 14) + base[s2] + r2] = (unsigned)t | (2u << 14); }
    __syncthreads();
}
__device__ __forceinline__ void moba_attn_item(LAS unsigned char* lds, const bf16* h, const unsigned* gcount, const unsigned* list, float* po, float* pml, int item, int tid, int wave, int lane) {
    const int n = item / 24, bh = item - n * 24, hh = bh % MB_H, b = bh / MB_H;
    LAS unsigned* Ks = (LAS unsigned*)(lds + AT_KS); LAS unsigned* Vs32 = (LAS unsigned*)(lds + AT_VS);
    LAS float* qst = (LAS float*)(lds + AT_WV + wave * AT_WVB); LAS float* pb = qst + 256;
    for (int i = 0; i < 16; ++i) { const int idx = tid + 512 * i, r = idx >> 5, dd = idx & 31; const unsigned* src = (const unsigned*)(h + ((size_t)b * SEQ + n * 256 + r) * NC_M + hh * 64);
        Ks[r * 33 + dd] = src[384 + dd]; Vs32[r * 32 + dd] = src[768 + dd]; }
    __syncthreads();
    const int cnt = (int)gcount[bh * 64 + n], total = 256 + cnt, nquads = (total + 3) >> 2;
    const float slope = hh < 8 ? ldexpf(1.0f, -(hh + 1)) : ldexpf(0.70710678118654752f, -(hh - 8));
    const unsigned* lp = list + (((size_t)bh * 64 + n) << 14);
    for (int quad = wave; quad < nquads; quad += 8) {
        int tq[4], slot[4];
#pragma unroll
        for (int qi = 0; qi < 4; ++qi) { int idx = quad * 4 + qi; idx = idx < total ? idx : total - 1;
            if (idx < 256) { tq[qi] = n * 256 + idx; slot[qi] = 3; } else { const unsigned e = lp[idx - 256]; tq[qi] = (int)(e & 16383u); slot[qi] = (int)(e >> 14); } }
#pragma unroll
        for (int qi = 0; qi < 4; ++qi) qst[qi * 64 + lane] = bf2f(h[((size_t)b * SEQ + tq[qi]) * NC_M + hh * 64 + lane]);
        float m[4], l[4], o[4];
        attn4<true>(Ks, (const LAS bf16*)Vs32, qst, pb, lane, tq, n * 256, slope, m, l, o);
#pragma unroll
        for (int qi = 0; qi < 4; ++qi) if (quad * 4 + qi < total) { const size_t pi = (((size_t)b * SEQ + tq[qi]) * MB_H + hh) * 4 + slot[qi];
            po[pi * 64 + lane] = o[qi]; if (lane == 0) { pml[pi * 2] = m[qi]; pml[pi * 2 + 1] = l[qi]; } }
    }
    __syncthreads();
}

__device__ __forceinline__ void moba_attn_item2(LAS unsigned char* lds, const bf16* h, const unsigned* gcount, const unsigned* list, float* po, float* pml, int item, int tid, int wave, int lane) {
    const int n = item / 24, bh = item - n * 24, hh = bh % MB_H, b = bh / MB_H, r = lane & 31, hf = lane >> 5;
    const bf16* hrow0 = h + ((size_t)b * SEQ + n * 256) * NC_M + hh * 64;
    stage_kv_images(lds, hrow0 + 768, hrow0 + 1536, NC_M, tid);
    __syncthreads();
    const int cnt = (int)gcount[bh * 64 + n], total = 256 + cnt, ntiles = (total + 31) >> 5;
    const float slope2 = (hh < 8 ? ldexpf(1.0f, -(hh + 1)) : ldexpf(0.70710678118654752f, -(hh - 8))) * 1.4426950408889634f;
    const unsigned* lp = list + (((size_t)bh * 64 + n) << 14);
#pragma unroll 1
    for (int tile = wave; tile < ntiles; tile += NWAVES) {
        int idx = tile * 32 + r; const bool valid = idx < total; idx = valid ? idx : total - 1;
        int tq, slot; if (idx < 256) { tq = n * 256 + idx; slot = 3; } else { const unsigned e = lp[idx - 256]; tq = (int)(e & 16383u); slot = (int)(e >> 14); }
        f32x16 o[2]; float m2, l;
        attn_tile32<true>(lds, h + ((size_t)b * SEQ + tq) * NC_M + hh * 64, lane, (float)(tq - n * 256), slope2, o, m2, l);
        if (valid) { const size_t pi = (((size_t)b * SEQ + tq) * MB_H + hh) * 4 + slot; float* op = po + pi * 64 + 4 * hf;
#pragma unroll
            for (int dt = 0; dt < 2; ++dt)
#pragma unroll
                for (int g = 0; g < 4; ++g) { const f32x4 v = {o[dt][4 * g], o[dt][4 * g + 1], o[dt][4 * g + 2], o[dt][4 * g + 3]}; *(f32x4*)(op + 32 * dt + 8 * g) = v; }
            if (hf == 0) { pml[pi * 2] = m2; pml[pi * 2 + 1] = l; } }
    }
    __syncthreads();
}
__device__ __forceinline__ void moba_combine(const float* po, const float* pml, const int* selinfo, bf16* mix, int gw, int ngw, int lane) {
    for (int idx = gw; idx < T * MB_H; idx += ngw) { const int tg = idx / MB_H, hh = idx - tg * MB_H, ns = selinfo[idx]; const size_t p4 = (size_t)idx * 4;
        const float m3 = pml[(p4 + 3) * 2]; float M = m3, m0 = -INFINITY, m1 = -INFINITY, m2 = -INFINITY;
        if (ns > 0) { m0 = pml[(p4 + 0) * 2]; M = fmaxf(M, m0); } if (ns > 1) { m1 = pml[(p4 + 1) * 2]; M = fmaxf(M, m1); } if (ns > 2) { m2 = pml[(p4 + 2) * 2]; M = fmaxf(M, m2); }
        float w = __builtin_amdgcn_exp2f(m3 - M), den = w * pml[(p4 + 3) * 2 + 1], num = w * po[(p4 + 3) * 64 + lane];
        if (ns > 0) { w = __builtin_amdgcn_exp2f(m0 - M); den += w * pml[(p4 + 0) * 2 + 1]; num += w * po[(p4 + 0) * 64 + lane]; }
        if (ns > 1) { w = __builtin_amdgcn_exp2f(m1 - M); den += w * pml[(p4 + 1) * 2 + 1]; num += w * po[(p4 + 1) * 64 + lane]; }
        if (ns > 2) { w = __builtin_amdgcn_exp2f(m2 - M); den += w * pml[(p4 + 2) * 2 + 1]; num += w * po[(p4 + 2) * 64 + lane]; }
        mix[(size_t)tg * 1024 + hh * 64 + lane] = (bf16)f2bf(num / den); }
}

__device__ __forceinline__ void ln_row(f32x4 (&v)[4], const f32x4 (&gv)[4], const f32x4 (&bv)[4]) {
    float s = 0.f;
#pragma unroll
    for (int j = 0; j < 4; ++j) s += (v[j].x + v[j].y) + (v[j].z + v[j].w);
    const float mean = wave_sum(s) * (1.f / D); float s2 = 0.f;
#pragma unroll
    for (int j = 0; j < 4; ++j) { v[j] = v[j] - mean; s2 += (v[j].x * v[j].x + v[j].y * v[j].y) + (v[j].z * v[j].z + v[j].w * v[j].w); }
    const float rstd = 1.f / sqrtf(wave_sum(s2) * (1.f / D) + 1e-5f);
#pragma unroll
    for (int j = 0; j < 4; ++j) v[j] = v[j] * rstd * gv[j] + bv[j];
}
__device__ __forceinline__ void phase_ln1(LAS unsigned char* lds, const float* xin, const bf16* y, const float* g, const float* bb, const float* wr, const float* br,
                                          float* xout, bf16* xbf, int* tok_e, int* tok_lr, float* tok_w, int* blk_cnt, int blk, int tid, int wave, int lane) {
    LAS float* xst = (LAS float*)lds;
    LAS float* part = (LAS float*)(lds + 32768);
    LAS int* hist = (LAS int*)(lds + 40960);
    if (tid < 32) hist[tid] = 0;
    constexpr int TPB = T / GRID;
    const int e = lane & 31, half = lane >> 5;
    float wreg[64];
    { const float* wp = wr + (size_t)(wave * 128 + half * 64) * NE + e;
#pragma unroll
      for (int k = 0; k < 64; ++k) wreg[k] = wp[k * NE]; }
    const float bre = br[e];
    __syncthreads();
    for (int grp = 0; grp < TPB / NWAVES; ++grp) { const size_t t = (size_t)blk * TPB + grp * NWAVES + wave;
        { f32x4 gv[4], bv[4];
#pragma unroll
          for (int j = 0; j < 4; ++j) { gv[j] = ((const f32x4*)g)[lane + 64 * j]; bv[j] = ((const f32x4*)bb)[lane + 64 * j]; }
          const f32x4* xr = (const f32x4*)(xin + t * D) + lane; const v2u* yr = (const v2u*)(y + t * D) + lane; f32x4 v[4];
#pragma unroll
          for (int j = 0; j < 4; ++j) { const f32x4 xv = xr[64 * j]; const v2u yw = yr[64 * j];
              v[j].x = DN_ALPHA * xv.x + bflo(yw.x); v[j].y = DN_ALPHA * xv.y + bfhi(yw.x); v[j].z = DN_ALPHA * xv.z + bflo(yw.y); v[j].w = DN_ALPHA * xv.w + bfhi(yw.y); }
          ln_row(v, gv, bv);
          f32x4* xo = (f32x4*)(xout + t * D) + lane; v2u* xb = (v2u*)(xbf + t * D) + lane;
#pragma unroll
          for (int j = 0; j < 4; ++j) { xo[64 * j] = v[j]; v2u w; w.x = pk2(v[j].x, v[j].y); w.y = pk2(v[j].z, v[j].w); xb[64 * j] = w; ((LAS f32x4*)(xst + wave * 1024))[lane + 64 * j] = v[j]; } }
        __syncthreads();
#pragma unroll 2
        for (int tk = 0; tk < 8; ++tk) { float acc = 0.f; const LAS float* xs_ = xst + tk * 1024 + wave * 128 + half * 64;
#pragma unroll
            for (int k4 = 0; k4 < 16; ++k4) { const f32x4 xv = *(const LAS f32x4*)(xs_ + 4 * k4); acc += xv.x * wreg[4 * k4]; acc += xv.y * wreg[4 * k4 + 1]; acc += xv.z * wreg[4 * k4 + 2]; acc += xv.w * wreg[4 * k4 + 3]; }
            acc += __shfl_xor(acc, 32);
            if (half == 0) part[(wave * 8 + tk) * 32 + e] = acc; }
        __syncthreads();
        float logit = bre;
#pragma unroll
        for (int w = 0; w < 8; ++w) logit += part[(w * 8 + wave) * 32 + e];
        int se[4]; float sv[4];
#pragma unroll
        for (int k = 0; k < 4; ++k) { float bvv = logit; int bi = e;
#pragma unroll
            for (int o = 1; o < 32; o <<= 1) { const float ov = __shfl_xor(bvv, o); const int oi = __shfl_xor(bi, o); if (ov > bvv || (ov == bvv && oi < bi)) { bvv = ov; bi = oi; } }
            se[k] = bi; sv[k] = bvv; if (e == bi) logit = -INFINITY; }
        const float e1 = __expf(sv[1] - sv[0]), e2 = __expf(sv[2] - sv[0]), e3 = __expf(sv[3] - sv[0]), inv = 1.f / (1.f + e1 + e2 + e3);
        const float wk[4] = {inv, e1 * inv, e2 * inv, e3 * inv};
        if (lane == 0) {
#pragma unroll
            for (int k = 0; k < 4; ++k) { const int lr = __hip_atomic_fetch_add(hist + se[k], 1, __ATOMIC_RELAXED, __HIP_MEMORY_SCOPE_WORKGROUP);
                tok_e[t * 4 + k] = se[k]; tok_lr[t * 4 + k] = lr; tok_w[t * 4 + k] = wk[k]; } }
    }
    __syncthreads();
    if (tid < 32) blk_cnt[blk * 32 + tid] = hist[tid];
    __syncthreads();
}
__device__ __forceinline__ void phase_dispatch(LAS unsigned char* lds, const int* blk_cnt, const int* tok_e, const int* tok_lr, int* tok_row, int* tab, const bf16* xbf, bf16* xs, int blk, int tid, int wave, int lane) {
    LAS int* tot = (LAS int*)lds; LAS int* pre = tot + 32; LAS int* pst = pre + 32;
    if (tid < 32) { int s = 0, p = 0; for (int bb = 0; bb < GRID; ++bb) { const int c = blk_cnt[bb * 32 + tid]; p += (bb < blk) ? c : 0; s += c; } tot[tid] = s; pre[tid] = p; }
    __syncthreads();
    if (tid == 0) { int acc = 0; for (int e = 0; e < 32; ++e) { pst[e] = acc; acc += ((tot[e] + 255) >> 8) << 8; } pst[32] = acc; }
    __syncthreads();
    if (blk == 0 && tid < 33) tab[tid] = pst[tid] >> 8;
    constexpr int TPB = T / GRID;
    for (int i = wave; i < TPB * 4; i += NWAVES) { const size_t ti = ((size_t)blk * TPB + (i >> 2)) * 4 + (i & 3); const int e = tok_e[ti]; const int r = pst[e] + pre[e] + tok_lr[ti];
        if (lane == 0) tok_row[ti] = r;
        const v4u* src = (const v4u*)(xbf + (ti >> 2) * D); v4u* dst = (v4u*)(xs + (size_t)r * D); dst[lane] = src[lane]; dst[lane + 64] = src[lane + 64]; }
    __syncthreads();
}
__device__ __forceinline__ void phase_ln2(const float* x1, const bf16* yrows, const int* tok_row, const float* tok_w, const float* g, const float* bb, float* xout, bf16* xbf, int gw, int ngw, int lane) {
    f32x4 gv[4], bv[4];
#pragma unroll
    for (int j = 0; j < 4; ++j) { gv[j] = ((const f32x4*)g)[lane + 64 * j]; bv[j] = ((const f32x4*)bb)[lane + 64 * j]; }
    for (int t = gw; t < T; t += ngw) { int r[4]; float w[4];
#pragma unroll
        for (int k = 0; k < 4; ++k) { r[k] = tok_row[(size_t)t * 4 + k]; w[k] = tok_w[(size_t)t * 4 + k]; }
        const f32x4* xr = (const f32x4*)(x1 + (size_t)t * D) + lane; f32x4 v[4];
#pragma unroll
        for (int j = 0; j < 4; ++j) { f32x4 f = {0.f, 0.f, 0.f, 0.f};
#pragma unroll
            for (int k = 0; k < 4; ++k) { const v2u yw = ((const v2u*)(yrows + (size_t)r[k] * D))[lane + 64 * j]; f.x += w[k] * bflo(yw.x); f.y += w[k] * bfhi(yw.x); f.z += w[k] * bflo(yw.y); f.w += w[k] * bfhi(yw.y); }
            v[j] = xr[64 * j] * DN_ALPHA + f; }
        ln_row(v, gv, bv);
        f32x4* xo = (f32x4*)(xout + (size_t)t * D) + lane; v2u* xb = (v2u*)(xbf + (size_t)t * D) + lane;
#pragma unroll
        for (int j = 0; j < 4; ++j) { xo[64 * j] = v[j]; v2u ww; ww.x = pk2(v[j].x, v[j].y); ww.y = pk2(v[j].z, v[j].w); xb[64 * j] = ww; } }
}

struct Args { const float* in[20]; float* out; unsigned char* ws; int l_lo, l_hi, ph_lo, ph_hi; };
typedef const __attribute__((address_space(4))) Args* KArgsP;
#define KA_LOAD() ({ KArgsP p_ = (KArgsP)__builtin_amdgcn_kernarg_segment_ptr(); asm volatile("" : "+s"(p_)); p_; })
#ifndef PHMASK
#define PHMASK 0xFFFF
#endif
#ifndef REPEAT_MASK
#define REPEAT_MASK 0
#endif
#define PH_BEGIN(k) _Pragma("unroll") for (int rep_ = 0; rep_ < (((REPEAT_MASK >> (k)) & 1) ? 2 : 1); ++rep_) { KArgsP ka = KA_LOAD(); if (((PHMASK >> (k)) & 1) && ka->ph_lo <= (k) && (k) < ka->ph_hi) { unsigned char* ws = ka->ws; int tid = threadIdx.x; asm volatile("" : "+v"(tid)); \
    const int lane = tid & 63, wave = __builtin_amdgcn_readfirstlane(tid >> 6); int blk = blockIdx.x; asm volatile("" : "+s"(blk)); \
    const int gw = blk * NWAVES + wave; const size_t gtid = (size_t)blk * NTHR + tid; (void)lane; (void)gw; (void)gtid; (void)ws;
#if ONE_LAUNCH
#define PH_SEAM() do { XcdBarrier b_; b_.bar = (unsigned*)(KA_LOAD()->ws + WS_CTL) + CW_BAR; b_.x = xb_xcc_id(); b_.st = (volatile LAS unsigned*)(lds + MISC_OFF); xcd_barrier(b_); } while (0)
#else
#define PH_SEAM() do {} while (0)
#endif
#define PH_END() PH_SEAM(); } }
#define PH_END_NOSEAM() } }
#define WSP(type, off) ((type*)(ws + (off)))
constexpr int G = GRID, NGW = GRID * NWAVES; constexpr size_t GTHREADS = (size_t)GRID * NTHR;
__global__ void __launch_bounds__(NTHR, 2) fwd_kernel(Args args) {
    extern __shared__ __attribute__((aligned(16))) unsigned char lds_raw[];
    LAS unsigned char* lds = (LAS unsigned char*)lds_raw;
    LAS int* tabL = (LAS int*)(lds + MISC_OFF + 256);
    if (threadIdx.x < 4) ((LAS unsigned*)(lds + MISC_OFF))[threadIdx.x] = 0u;
    __syncthreads();
#if ONE_LAUNCH
    (void)xcd_barrier_post((unsigned*)(args.ws + WS_CTL) + CW_BAR, (volatile LAS unsigned*)(lds + MISC_OFF));
#endif
    PH_BEGIN(0)
        if (ka->l_lo == 0) {
            cvt_rows_bf16(ka->in[0], WSP(bf16, WS_XBF), (size_t)T * D / 8, gtid, GTHREADS);
            cvt_rows_bf16(ka->in[1], WSP(bf16, WS_MEMBF), (size_t)512 * D / 8, gtid, GTHREADS);
        }
    PH_END_NOSEAM()
    for (int l = args.l_lo; l < KA_LOAD()->l_hi; ++l) {
        const int j = l >> 1; const bool moba = (l & 1) != 0;
        const int NC = moba ? NC_M : NC_H, qoff = moba ? 2304 : 3072;

        PH_BEGIN(1)
            const float* win_src = moba ? ka->in[5] + (size_t)j * D * NC_M : ka->in[2] + (size_t)j * D * NC_H;
            const size_t moff = (size_t)l * NE * 1024 * 1024;
            phase_weights((LAS float*)(lds + wave * 16384), gw, NGW, lane, win_src, NC, ka->in[6] + (size_t)l * D * 512, ka->in[7] + (size_t)l * D * D,
                          ka->in[12] + moff, ka->in[14] + moff, ka->in[16] + moff, WSP(bf16, WS_WIN), WSP(bf16, WS_WKV), WSP(bf16, WS_WO), WSP(bf16, WS_WGU), WSP(bf16, WS_WD));
        PH_END()
        PH_BEGIN(2)
            { pg8::Gemm g{WSP(bf16, WS_XBF), WSP(bf16, WS_WIN), T, NC, D}; pg8::StaticOrder S; S.init(T, NC, G, blk); pg8::EpiPlain E{WSP(bf16, WS_H), NC};
              pg8::gemm_phase<pg8::EpiPlain, pg8::StaticOrder, true, true>(lds, g, S, E); }
            { pg8::Gemm g{WSP(bf16, WS_MEMBF), WSP(bf16, WS_WKV), 512, 512, D}; pg8::StaticOrder S; S.init(512, 512, G, blk); pg8::EpiPlain E{WSP(bf16, WS_KV), 512};
              pg8::gemm_phase<pg8::EpiPlain, pg8::StaticOrder, true, true>(lds, g, S, E); }
        PH_END()
        if (!moba) {
            PH_BEGIN(3)
                for (int u = blk; u < NBATCH * HG_H * HNSEG; u += G) hgrn_seg<false>(lds, WSP(bf16, WS_H), ka->in[3], j, ka->in[4] + j * 128, WSP(float, WS_SLOC), WSP(float, WS_DSEG), WSP(bf16, WS_MIX), u, tid, wave, lane);
                for (int u = blk; u < 512; u += G) memattn_unit2(lds, WSP(bf16, WS_H), NC, qoff, WSP(bf16, WS_KV), WSP(bf16, WS_MIX), u, tid, wave, lane);
            PH_END()
            PH_BEGIN(4)
                hgrn_scan(WSP(float, WS_SLOC), WSP(float, WS_DSEG), gtid, GTHREADS);
            PH_END()
            PH_BEGIN(5)
                for (int u = blk; u < NBATCH * HG_H * HNSEG; u += G) hgrn_seg<true>(lds, WSP(bf16, WS_H), ka->in[3], j, ka->in[4] + j * 128, WSP(float, WS_SLOC), WSP(float, WS_DSEG), WSP(bf16, WS_MIX), u, tid, wave, lane);
            PH_END()
        } else {
            PH_BEGIN(3)
                for (int u = blk; u < 24 * MB_NB; u += G) kmean_unit(lds, WSP(bf16, WS_H), WSP(float, WS_KMEAN), u, tid);
                for (int u = blk; u < 512; u += G) memattn_unit2(lds, WSP(bf16, WS_H), NC, qoff, WSP(bf16, WS_KV), WSP(bf16, WS_MIX), u, tid, wave, lane);
            PH_END()
            PH_BEGIN(4)
                for (int u = blk; u < 24 * MB_NB; u += G) moba_gate_unit(lds, WSP(bf16, WS_H), WSP(float, WS_KMEAN), WSP(unsigned, WS_CTL) + CW_GCOUNT + j * 1536, WSP(int, WS_SELINFO), WSP(unsigned, WS_LIST), u, tid);
            PH_END()
            PH_BEGIN(5)
                for (int r = 0; r * G < 24 * MB_NB; ++r) { const int it = r * G + ((r & 1) ? (G - 1 - blk) : blk);
                    if (it < 24 * MB_NB) moba_attn_item2(lds, WSP(bf16, WS_H), WSP(unsigned, WS_CTL) + CW_GCOUNT + j * 1536, WSP(unsigned, WS_LIST), WSP(float, WS_PO), WSP(float, WS_PML), it, tid, wave, lane); }
            PH_END()
            PH_BEGIN(6)
                moba_combine(WSP(float, WS_PO), WSP(float, WS_PML), WSP(int, WS_SELINFO), WSP(bf16, WS_MIX), gw, NGW, lane);
            PH_END()
        }
        PH_BEGIN(7)
            pg8::Gemm g{WSP(bf16, WS_MIX), WSP(bf16, WS_WO), T, D, D}; pg8::StaticOrder S; S.init(T, D, G, blk); pg8::EpiPlain E{WSP(bf16, WS_Y), D};
            pg8::gemm_phase<pg8::EpiPlain, pg8::StaticOrder, true, true>(lds, g, S, E);
        PH_END()
        PH_BEGIN(8)
            const float* xin = (l == 0) ? ka->in[0] : WSP(float, WS_XA);
            phase_ln1(lds, xin, WSP(bf16, WS_Y), ka->in[8] + l * D, ka->in[9] + l * D, ka->in[10] + (size_t)l * D * NE, ka->in[11] + l * NE, WSP(float, WS_XB), WSP(bf16, WS_XBF),
                      WSP(int, WS_TOK + TOK_E), WSP(int, WS_TOK + TOK_LR), WSP(float, WS_TOK + TOK_W), WSP(int, WS_TOK + TOK_BLKCNT), blk, tid, wave, lane);
        PH_END()
        PH_BEGIN(9)
            phase_dispatch(lds, WSP(int, WS_TOK + TOK_BLKCNT), WSP(int, WS_TOK + TOK_E), WSP(int, WS_TOK + TOK_LR), WSP(int, WS_TOK + TOK_ROW), WSP(int, WS_TOK + TOK_TAB), WSP(bf16, WS_XBF), WSP(bf16, WS_XS), blk, tid, wave, lane);
        PH_END()
        PH_BEGIN(10)
            if (tid < 33) tabL[tid] = WSP(int, WS_TOK + TOK_TAB)[tid];
            __syncthreads();
            pg8::Gemm g{WSP(bf16, WS_XS), WSP(bf16, WS_WGU), MOE_MAXROWS, NE * 2048, D}; pg8::MoeOrder S{tabL, 8, G, blk, tabL[32] * 8};
            pg8::EpiSwiglu E{WSP(bf16, WS_HID), ka->in[13] + (size_t)l * NE * 1024, ka->in[15] + (size_t)l * NE * 1024};
            pg8::gemm_phase<pg8::EpiSwiglu, pg8::MoeOrder, true, true>(lds, g, S, E);
        PH_END()
        PH_BEGIN(11)
            if (tid < 33) tabL[tid] = WSP(int, WS_TOK + TOK_TAB)[tid];
            __syncthreads();
            pg8::Gemm g{WSP(bf16, WS_HID), WSP(bf16, WS_WD), MOE_MAXROWS, NE * 1024, D}; pg8::MoeOrder S{tabL, 4, G, blk, tabL[32] * 4};
            pg8::EpiDown E{WSP(bf16, WS_XS), ka->in[17] + (size_t)l * NE * 1024};
            pg8::gemm_phase<pg8::EpiDown, pg8::MoeOrder, true, true>(lds, g, S, E);
        PH_END()
        PH_BEGIN(12)
            float* x2out = (l == DEPTH - 1) ? ka->out : WSP(float, WS_XA);
            phase_ln2(WSP(float, WS_XB), WSP(bf16, WS_XS), WSP(int, WS_TOK + TOK_ROW), WSP(float, WS_TOK + TOK_W), ka->in[18] + l * D, ka->in[19] + l * D, x2out, WSP(bf16, WS_XBF), gw, NGW, lane);
            if (l + 1 < ka->l_hi) PH_SEAM();
        PH_END_NOSEAM()
    }
}

extern "C" void kernel_launch(void* const* d_in, const int* in_sizes, int n_in, void* d_out, int out_size, void* d_ws, size_t ws_size, hipStream_t stream) {
    static int ready = 0;
    if (ready == 0) {
        if (n_in != 20 || in_sizes[0] != T * D || out_size != T * D || ws_size < WS_END) { fprintf(stderr, "kernel_launch: unexpected shapes (n_in %d, in0 %d, out %d, ws %zu < %zu)\n", n_in, n_in > 0 ? in_sizes[0] : -1, out_size, ws_size, (size_t)WS_END); ready = -1; return; }
        if (hipFuncSetAttribute((const void*)fwd_kernel, hipFuncAttributeMaxDynamicSharedMemorySize, LDS_BYTES) != hipSuccess) { fprintf(stderr, "kernel_launch: hipFuncSetAttribute failed\n"); ready = -1; return; }
        int per_cu = 0;
        if (hipOccupancyMaxActiveBlocksPerMultiprocessor(&per_cu, (const void*)fwd_kernel, NTHR, LDS_BYTES) != hipSuccess || per_cu < 1) fprintf(stderr, "kernel_launch: occupancy query says %d\n", per_cu);
        (void)hipGetLastError();
        ready = 1;
    }
    if (ready < 0) return;
    if (hipMemsetAsync((char*)d_ws + WS_CTL, 0, CTL_ZERO_BYTES, stream) != hipSuccess) return;
    Args a{};
    for (int i = 0; i < 20; ++i) a.in[i] = (const float*)d_in[i];
    a.out = (float*)d_out; a.ws = (unsigned char*)d_ws;
#if ONE_LAUNCH
    a.l_lo = 0; a.l_hi = DEPTH; a.ph_lo = 0; a.ph_hi = NPHASE;
    hipLaunchKernelGGL(fwd_kernel, dim3(GRID), dim3(NTHR), LDS_BYTES, stream, a);
#else
    a.l_lo = 0; a.l_hi = 1; a.ph_lo = 0; a.ph_hi = 1;
    hipLaunchKernelGGL(fwd_kernel, dim3(GRID), dim3(NTHR), LDS_BYTES, stream, a);
    for (int l = 0; l < DEPTH; ++l)
        for (int ph = 1; ph < NPHASE; ++ph) {
            if (ph == 6 && (l & 1) == 0) continue;
            a.l_lo = l; a.l_hi = l + 1; a.ph_lo = ph; a.ph_hi = ph + 1;
            hipLaunchKernelGGL(fwd_kernel, dim3(GRID), dim3(NTHR), LDS_BYTES, stream, a);
        }
#endif
}
```

```cpp
#include <hip/hip_runtime.h>
#include <cstdio>
#include <cstdint>
#include <cmath>
namespace pg8 {
#define PG8_LAS __attribute__((address_space(3)))
typedef unsigned short bf16_t;
typedef short bf16x8 __attribute__((ext_vector_type(8)));
typedef float f32x4 __attribute__((ext_vector_type(4)));
typedef unsigned u32x4 __attribute__((ext_vector_type(4)));
constexpr int BM = 256, BK = 64, HALF = 128, HTB = HALF * BK * 2  , STAGE_BYTES = 8 * HTB, NXCD = 8, WGM = 8;

__host__ __device__ __forceinline__ int lds_byte(int r, int c) { const int st = (r >> 4) * 2 + (c >> 5), rr = r & 15, cc = c & 31, ob = rr * 64 + cc * 2; return st * 1024 + (ob ^ (((ob >> 9) & 1) << 5)); }
__host__ __device__ __forceinline__ void stage_rc(int b, int& R, int& C) { const int st = b / 1024, sb = b % 1024, swz = sb ^ (((sb >> 9) & 1) << 5); R = (st >> 1) * 16 + swz / 64; C = (st & 1) * 32 + (swz % 64) / 2; }
__host__ __device__ __forceinline__ int perm32(int rho) { const int n = rho >> 4, i = rho & 15; return 8 * (i >> 2) + 4 * n + (i & 3); }

struct Unit { int pm, pn; };
struct Gemm { const bf16_t* A; const bf16_t* Bt; int M, N, K; int sw, sx; };
typedef int i32x8 __attribute__((ext_vector_type(8))); typedef int i32x4 __attribute__((ext_vector_type(4)));

struct StaticOrder {
    int nM, nN, nwg, G, c;
    __host__ __device__ void init(int M, int N, int G_, int c_) { nM = M / BM; nN = N / BM; nwg = nM * nN; G = G_; c = c_; }
    __host__ __device__ bool next(int i, Unit& u) const {
        const long L = (long)i * G + c; if (L >= nwg) return false;
        int wgid = (int)L; { const int q = nwg / NXCD, r = nwg % NXCD, xcd = wgid % NXCD, off = wgid / NXCD; wgid = (xcd < r ? xcd * (q + 1) : r * (q + 1) + (xcd - r) * q) + off; }
        const int nig = WGM * nN, gid = wgid / nig, fm = gid * WGM, gsz = (nM - fm) < WGM ? (nM - fm) : WGM;
        u.pm = fm + ((wgid % nig) % gsz); u.pn = (wgid % nig) / gsz; return true;
    }
    __device__ __forceinline__ void a_ready(const Unit&) const {}
    __device__ __forceinline__ void done(const Unit&) const {}
};

__device__ __forceinline__ unsigned cvt_pk_bf16(float lo, float hi) { unsigned r; asm volatile("v_cvt_pk_bf16_f32 %0, %1, %2" : "=v"(r) : "v"(lo), "v"(hi)); return r; }
typedef float f32x2 __attribute__((ext_vector_type(2)));
struct EpiPlain {
    static constexpr bool PERM = true, AFTER_DRAIN = false;
    bf16_t* O; int ldc;
    __device__ __forceinline__ void operator()(const f32x4 (&acc)[2][2][4][2], const Unit& u, int wr, int wc, int fr, int fq) const {
        const int row0 = u.pm * BM + wr * 64 + fr; const int col0 = u.pn * BM + wc * 32 + 8 * fq;
#pragma unroll
        for (int ai = 0; ai < 2; ++ai)
#pragma unroll
            for (int m = 0; m < 4; ++m) { bf16_t* rowp = O + (size_t)(row0 + ai * HALF + m * 16) * ldc + col0;
#pragma unroll
                for (int bj = 0; bj < 2; ++bj) { const f32x4 v0 = acc[ai][bj][m][0], v1 = acc[ai][bj][m][1];
                    u32x4 w; w.x = cvt_pk_bf16(v0[0], v0[1]); w.y = cvt_pk_bf16(v0[2], v0[3]); w.z = cvt_pk_bf16(v1[0], v1[1]); w.w = cvt_pk_bf16(v1[2], v1[3]);
                    *(u32x4*)(rowp + bj * HALF) = w; } }
    }
};
__device__ __forceinline__ float swiglu1(float g, float u) {
    g = fminf(g, 7.0f); u = fminf(fmaxf(u, -7.0f), 7.0f);
    const float s = __builtin_amdgcn_rcpf(1.0f + __builtin_amdgcn_exp2f(g * (-1.702f * 1.4426950408889634f)));
    return g * s * (u + 1.0f);
}
struct EpiSwiglu {
    static constexpr bool PERM = true, AFTER_DRAIN = false;
    bf16_t* hid; const float* bg; const float* bu;
    __device__ __forceinline__ void operator()(const f32x4 (&acc)[2][2][4][2], const Unit& u, int wr, int wc, int fr, int fq) const {
        const int e = u.pn >> 3, pn = u.pn & 7;
        const int row0 = u.pm * BM + wr * 64 + fr; const int col0 = pn * 128 + wc * 32 + 8 * fq;
        const f32x4 g0 = *(const f32x4*)(bg + e * 1024 + col0), g1 = *(const f32x4*)(bg + e * 1024 + col0 + 4);
        const f32x4 u0 = *(const f32x4*)(bu + e * 1024 + col0), u1 = *(const f32x4*)(bu + e * 1024 + col0 + 4);
#pragma unroll
        for (int ai = 0; ai < 2; ++ai)
#pragma unroll
            for (int m = 0; m < 4; ++m) { bf16_t* rowp = hid + (size_t)(row0 + ai * HALF + m * 16) * 1024 + col0;
                const f32x4 ga = acc[ai][0][m][0] + g0, gb = acc[ai][0][m][1] + g1, ua = acc[ai][1][m][0] + u0, ub = acc[ai][1][m][1] + u1;
                u32x4 w;
                w.x = cvt_pk_bf16(swiglu1(ga[0], ua[0]), swiglu1(ga[1], ua[1])); w.y = cvt_pk_bf16(swiglu1(ga[2], ua[2]), swiglu1(ga[3], ua[3]));
                w.z = cvt_pk_bf16(swiglu1(gb[0], ub[0]), swiglu1(gb[1], ub[1])); w.w = cvt_pk_bf16(swiglu1(gb[2], ub[2]), swiglu1(gb[3], ub[3]));
                *(u32x4*)rowp = w; }
    }
};
struct EpiDown {
    static constexpr bool PERM = true, AFTER_DRAIN = false;
    bf16_t* y; const float* bd;
    __device__ __forceinline__ void operator()(const f32x4 (&acc)[2][2][4][2], const Unit& u, int wr, int wc, int fr, int fq) const {
        const int e = u.pn >> 2, pn = u.pn & 3;
        const int row0 = u.pm * BM + wr * 64 + fr; const int col0 = pn * BM + wc * 32 + 8 * fq;
        f32x4 bv[2][2];
#pragma unroll
        for (int bj = 0; bj < 2; ++bj)
#pragma unroll
            for (int n = 0; n < 2; ++n) bv[bj][n] = *(const f32x4*)(bd + e * 1024 + col0 + bj * HALF + 4 * n);
#pragma unroll
        for (int ai = 0; ai < 2; ++ai)
#pragma unroll
            for (int m = 0; m < 4; ++m) { bf16_t* rowp = y + (size_t)(row0 + ai * HALF + m * 16) * 1024 + col0;
#pragma unroll
                for (int bj = 0; bj < 2; ++bj) { const f32x4 v0 = acc[ai][bj][m][0] + bv[bj][0], v1 = acc[ai][bj][m][1] + bv[bj][1];
                    u32x4 w; w.x = cvt_pk_bf16(v0[0], v0[1]); w.y = cvt_pk_bf16(v0[2], v0[3]); w.z = cvt_pk_bf16(v1[0], v1[1]); w.w = cvt_pk_bf16(v1[2], v1[3]);
                    *(u32x4*)(rowp + bj * HALF) = w; } }
    }
};
struct MoeOrder {
    const PG8_LAS int* tab; int npn, G, c, nunits;
    __device__ __forceinline__ bool next(int i, Unit& u) const {
        const int tpx = 32 / npn, s = c >> 3, tile = (i * 8 + (c & 7)) * tpx + s / npn, pn = s % npn;
        if ((i * 8) * tpx >= nunits / npn) return false;
        if (tile >= nunits / npn) { u.pm = 0; u.pn = 0; return false; }
        int e = 0;
#pragma unroll
        for (int k = 1; k < 32; ++k) e += (tab[k] <= tile) ? 1 : 0;
        u.pm = tile; u.pn = __builtin_amdgcn_readfirstlane(e) * npn + pn; return true;
    }
    __device__ __forceinline__ void a_ready(const Unit&) const {}
    __device__ __forceinline__ void done(const Unit&) const {}
};
template <class Epi, class Sched, bool ALIGN_EPI = false, bool SP2 = false, bool F8 = false>
__device__ __forceinline__ void gemm_phase(PG8_LAS unsigned char* lds, const Gemm g, const Sched& S, const Epi& E) {
    int tid_ = threadIdx.x; asm volatile("" : "+v"(tid_));
    const int tid = tid_, wid = __builtin_amdgcn_readfirstlane(tid >> 6), lane = tid & 63, wr = wid >> 2, wc = wid & 3, fr = lane & 15, fq = lane >> 4;
    const int K = g.K, nt = K / BK;
    unsigned voffA, voffB;
    { int R, C; stage_rc(tid * 16, R, C); const int Rb = Epi::PERM ? ((R & ~31) + perm32(R & 31)) : R; voffA = (unsigned)(R * K + C) * 2u; voffB = (unsigned)(Rb * K + C) * 2u; }
    const unsigned qstep = 64u * (unsigned)K * 2u;
    const unsigned kstep = (unsigned)(BK * 2);
    const unsigned hstep = (unsigned)HALF * (unsigned)K * 2u;
    const unsigned tstep = 2u * hstep;
    const __amdgpu_buffer_rsrc_t rA = __builtin_amdgcn_make_buffer_rsrc((void*)g.A, 0, 0x7FFFFFFF, 0x00020000), rB = __builtin_amdgcn_make_buffer_rsrc((void*)g.Bt, 0, 0x7FFFFFFF, 0x00020000);
    const unsigned ldsw = (unsigned)wid * 1024u;
    const int aoff = lds_byte(wr * 64 + fr, fq * 8), boff = lds_byte(wc * 32 + fr, fq * 8);
#define PG8_SA(b, h) (((b) * 2 + (h)) * HTB)
#define PG8_SB(b, h) ((4 + (b) * 2 + (h)) * HTB)
#define PG8_STG(bufoff, rsrc, soff, voff) do { _Pragma("unroll") for (int _i = 0; _i < 2; ++_i) \
        __builtin_amdgcn_raw_ptr_buffer_load_lds((rsrc), (PG8_LAS void*)(lds + (bufoff) + ldsw + _i * 8192), 16, (int)(voff), (int)((soff) + (unsigned)_i * qstep), 0, 0); } while (0)
#define PG8_STGA(bufoff, soff) PG8_STG(bufoff, rA, soff, voffA)
#define PG8_STGB(bufoff, soff) PG8_STG(bufoff, rB, soff, voffB)
#define PG8_LDA(dst, b, h) do { _Pragma("unroll") for (int m = 0; m < 4; ++m) { if constexpr (F8) { const i32x4 lo_ = *(const PG8_LAS i32x4*)(lds + PG8_SA(b, h) + aoff + m * 2048), hi_ = *(const PG8_LAS i32x4*)(lds + PG8_SA(b, h) + aoff + m * 2048 + 1024); \
            dst##_8[m] = __builtin_shufflevector(lo_, hi_, 0, 1, 2, 3, 4, 5, 6, 7); } else { _Pragma("unroll") for (int k = 0; k < 2; ++k) dst[m][k] = *(const PG8_LAS bf16x8*)(lds + PG8_SA(b, h) + aoff + m * 2048 + k * 1024); } } } while (0)
#define PG8_LDB(dst, b, h) do { _Pragma("unroll") for (int n = 0; n < 2; ++n) { if constexpr (F8) { const i32x4 lo_ = *(const PG8_LAS i32x4*)(lds + PG8_SB(b, h) + boff + n * 2048), hi_ = *(const PG8_LAS i32x4*)(lds + PG8_SB(b, h) + boff + n * 2048 + 1024); \
            dst##_8[n] = __builtin_shufflevector(lo_, hi_, 0, 1, 2, 3, 4, 5, 6, 7); } else { _Pragma("unroll") for (int k = 0; k < 2; ++k) dst[n][k] = *(const PG8_LAS bf16x8*)(lds + PG8_SB(b, h) + boff + n * 2048 + k * 1024); } } } while (0)
#define PG8_MMA(ai, bj, At, Bt) do { __builtin_amdgcn_s_setprio(1); _Pragma("unroll") for (int m = 0; m < 4; ++m) _Pragma("unroll") for (int n = 0; n < 2; ++n) { \
        if constexpr (F8) acc[ai][bj][m][n] = __builtin_amdgcn_mfma_scale_f32_16x16x128_f8f6f4(Bt##_8[n], At##_8[m], acc[ai][bj][m][n], 0, 0, 0, g.sw, 0, g.sx); \
        else { _Pragma("unroll") for (int k = 0; k < 2; ++k) acc[ai][bj][m][n] = __builtin_amdgcn_mfma_f32_16x16x32_bf16(Bt[n][k], At[m][k], acc[ai][bj][m][n], 0, 0, 0); } } \
        __builtin_amdgcn_s_setprio(0); } while (0)
#define PG8_WAIT_V(n) asm volatile("s_waitcnt vmcnt(" #n ")" ::: "memory")
#define PG8_WAIT_L(n) asm volatile("s_waitcnt lgkmcnt(" #n ")" ::: "memory")
#define PG8_BAR __builtin_amdgcn_s_barrier()
#define PG8_SCHED __builtin_amdgcn_sched_barrier(0)
    Unit cur, nxt; int ui = 0;
    if (!S.next(0, cur)) return;
    f32x4 acc[2][2][4][2];
#pragma unroll
    for (int a = 0; a < 2; ++a)
#pragma unroll
        for (int b = 0; b < 2; ++b)
#pragma unroll
            for (int m = 0; m < 4; ++m)
#pragma unroll
                for (int n = 0; n < 2; ++n) acc[a][b][m][n] = (f32x4){0.f, 0.f, 0.f, 0.f};
    bf16x8 At[4][2], B0[2][2], B1[2][2]; i32x8 At_8[4], B0_8[2], B1_8[2];
    unsigned cA = (unsigned)cur.pm * tstep, cB = (unsigned)cur.pn * tstep;
    S.a_ready(cur);
    if constexpr (SP2) {
        PG8_STGB(PG8_SB(0, 0), cB); PG8_STGB(PG8_SB(0, 1), cB + hstep); PG8_STGA(PG8_SA(0, 0), cA); PG8_STGA(PG8_SA(0, 1), cA + hstep);
        if (wr == 1) PG8_BAR;
        PG8_WAIT_V(2); PG8_BAR;
        PG8_STGB(PG8_SB(1, 0), cB + kstep); PG8_STGA(PG8_SA(1, 0), cA + kstep); PG8_STGB(PG8_SB(1, 1), cB + hstep + kstep);
        PG8_WAIT_V(6); PG8_BAR;
    } else {
        PG8_STGB(PG8_SB(0, 0), cB); PG8_STGA(PG8_SA(0, 0), cA); PG8_STGB(PG8_SB(0, 1), cB + hstep); PG8_STGA(PG8_SA(0, 1), cA + hstep);
        if (wr == 1) PG8_BAR;
        PG8_WAIT_V(4); PG8_BAR;
        PG8_STGB(PG8_SB(1, 0), cB + kstep); PG8_STGA(PG8_SA(1, 0), cA + kstep); PG8_STGB(PG8_SB(1, 1), cB + hstep + kstep);
        PG8_WAIT_V(6); PG8_BAR;
    }
    for (;;) {
        const bool has_next = S.next(ui + 1, nxt);
        const unsigned nA = has_next ? (unsigned)nxt.pm * tstep : cA, nB = has_next ? (unsigned)nxt.pn * tstep : cB;
#pragma unroll 1
        for (int t = 0; t < nt; t += 2) {
            const bool last = (t == nt - 2);
            const unsigned a1 = cA + (unsigned)(t + 1) * kstep;
            const unsigned a2 = last ? nA : cA + (unsigned)(t + 2) * kstep, b2 = last ? nB : cB + (unsigned)(t + 2) * kstep;
            const unsigned a3 = a2 + kstep, b3 = b2 + kstep;
            if (last && has_next) S.a_ready(nxt);
            if constexpr (SP2) {
            PG8_LDB(B0, 0, 0); PG8_LDB(B1, 0, 1); PG8_SCHED; PG8_LDA(At, 0, 0); PG8_STGA(PG8_SA(1, 1), a1 + hstep);
            PG8_WAIT_V(8); PG8_WAIT_L(0); PG8_BAR; PG8_MMA(0, 0, At, B0); PG8_MMA(0, 1, At, B1); PG8_BAR; PG8_SCHED;
            PG8_LDA(At, 0, 1); PG8_STGB(PG8_SB(0, 0), b2); PG8_STGB(PG8_SB(0, 1), b2 + hstep); PG8_STGA(PG8_SA(0, 0), a2);
            PG8_WAIT_V(8); PG8_WAIT_L(0); PG8_BAR; PG8_MMA(1, 0, At, B0); PG8_MMA(1, 1, At, B1); PG8_BAR; PG8_SCHED;
            PG8_LDB(B0, 1, 0); PG8_LDB(B1, 1, 1); PG8_SCHED; PG8_LDA(At, 1, 0); PG8_STGA(PG8_SA(0, 1), a2 + hstep);
            PG8_WAIT_V(8); PG8_WAIT_L(0); PG8_BAR; PG8_MMA(0, 0, At, B0); PG8_MMA(0, 1, At, B1); PG8_BAR; PG8_SCHED;
            PG8_LDA(At, 1, 1); PG8_STGB(PG8_SB(1, 0), b3); PG8_STGB(PG8_SB(1, 1), b3 + hstep); PG8_STGA(PG8_SA(1, 0), a3);
            PG8_WAIT_V(8); PG8_WAIT_L(0); PG8_BAR; PG8_MMA(1, 0, At, B0); PG8_MMA(1, 1, At, B1); PG8_BAR; PG8_SCHED;
            } else {
            PG8_LDB(B0, 0, 0); PG8_SCHED; PG8_LDA(At, 0, 0); PG8_STGA(PG8_SA(1, 1), a1 + hstep);
            PG8_WAIT_L(8); PG8_BAR; PG8_WAIT_L(0); PG8_MMA(0, 0, At, B0); PG8_BAR; PG8_SCHED;
            PG8_LDB(B1, 0, 1); PG8_STGB(PG8_SB(0, 0), b2);
            PG8_BAR; PG8_WAIT_L(0); PG8_MMA(0, 1, At, B1); PG8_BAR;
            PG8_LDA(At, 0, 1); PG8_STGA(PG8_SA(0, 0), a2);
            PG8_BAR; PG8_WAIT_L(0); PG8_MMA(1, 0, At, B0); PG8_BAR; PG8_SCHED;
            PG8_STGB(PG8_SB(0, 1), b2 + hstep);
            PG8_WAIT_V(6); PG8_BAR; PG8_MMA(1, 1, At, B1); PG8_BAR;
            PG8_LDB(B0, 1, 0); PG8_SCHED; PG8_LDA(At, 1, 0); PG8_STGA(PG8_SA(0, 1), a2 + hstep);
            PG8_WAIT_L(8); PG8_BAR; PG8_WAIT_L(0); PG8_MMA(0, 0, At, B0); PG8_BAR; PG8_SCHED;
            PG8_LDB(B1, 1, 1); PG8_STGB(PG8_SB(1, 0), b3);
            PG8_BAR; PG8_WAIT_L(0); PG8_MMA(0, 1, At, B1); PG8_BAR;
            PG8_LDA(At, 1, 1); PG8_STGA(PG8_SA(1, 0), a3);
            PG8_BAR; PG8_WAIT_L(0); PG8_MMA(1, 0, At, B0); PG8_BAR; PG8_SCHED;
            PG8_STGB(PG8_SB(1, 1), b3 + hstep);
            PG8_WAIT_V(6); PG8_BAR; PG8_MMA(1, 1, At, B1); PG8_BAR;
            }
        }
        if constexpr (ALIGN_EPI) { if (wr == 0) PG8_BAR; }
        if constexpr (!Epi::AFTER_DRAIN) { int t2_ = threadIdx.x; asm volatile("" : "+v"(t2_)); E(acc, cur, wr, wc, t2_ & 15, (t2_ & 63) >> 4); S.done(cur); }
        if (!has_next) break;
#pragma unroll
        for (int a = 0; a < 2; ++a)
#pragma unroll
            for (int b = 0; b < 2; ++b)
#pragma unroll
                for (int m = 0; m < 4; ++m)
#pragma unroll
                    for (int n = 0; n < 2; ++n) acc[a][b][m][n] = (f32x4){0.f, 0.f, 0.f, 0.f};
        cur = nxt; cA = nA; cB = nB; ++ui;
        if constexpr (ALIGN_EPI) { if (wr == 1) PG8_BAR; }
    }
    PG8_WAIT_V(0);
    if constexpr (!ALIGN_EPI) { if (wr == 0) PG8_BAR; }
    PG8_BAR;
    if constexpr (Epi::AFTER_DRAIN) { E.fused(acc, cur, wr, wc, fr, fq, lds, wid, lane); S.done(cur); }
#undef PG8_SA
#undef PG8_SB
#undef PG8_STG
#undef PG8_STGA
#undef PG8_STGB
#undef PG8_LDA
#undef PG8_LDB
#undef PG8_MMA
#undef PG8_WAIT_V
#undef PG8_WAIT_L
#undef PG8_BAR
#undef PG8_SCHED
}
}

constexpr int NWAVES = 8, NTHR = 512, GRID = 256;
constexpr int NBATCH = 2, SEQ = 16384, T = NBATCH * SEQ, D = 1024, DEPTH = 4;
constexpr int MIXW = 768, NC_H = 3328, NC_M = 2560;
constexpr int HG_H = 6;
constexpr int HSEG = 256, HNSEG = SEQ / HSEG;
constexpr int MB_H = 12, MB_NB = 64;
constexpr int NE = 32;
constexpr float DN_ALPHA = 1.6817928305074290f;
constexpr int MOE_MAXROWS = T * 4 + NE * 256;
#ifndef ONE_LAUNCH
#define ONE_LAUNCH 1
#endif
constexpr int NPHASE = 13;

constexpr size_t MiB = 1u << 20;
constexpr size_t WS_CTL = 0, CTL_ZERO_BYTES = 1 * MiB;
constexpr size_t WS_WIN = 1 * MiB, WS_WKV = 9 * MiB, WS_WO = 10 * MiB, WS_WGU = 12 * MiB, WS_WD = 140 * MiB;
constexpr size_t WS_XBF = 204 * MiB, WS_XA = 268 * MiB, WS_XB = 396 * MiB, WS_MEMBF = 524 * MiB, WS_KV = 525 * MiB;
constexpr size_t WS_H = 526 * MiB, WS_MIX = 734 * MiB, WS_Y = 798 * MiB, WS_SLOC = 862 * MiB, WS_DSEG = 910 * MiB, WS_KMEAN = 911 * MiB;
constexpr size_t WS_SELINFO = 912 * MiB, WS_TOK = 914 * MiB, WS_R1 = 918 * MiB;
constexpr size_t WS_LIST = WS_R1, WS_PML = WS_R1 + 96 * MiB, WS_PO = WS_R1 + 108 * MiB;
constexpr size_t WS_XS = WS_R1, WS_HID = WS_R1 + 272 * MiB;
constexpr size_t WS_END = WS_R1 + 544 * MiB;
static_assert((size_t)MOE_MAXROWS * 1024 * 2 <= 272 * MiB, "moe rows");
static_assert((size_t)T * MB_H * 4 * 64 * 4 <= 384 * MiB && (size_t)24 * 64 * 16384 * 4 <= 96 * MiB, "moba bufs");
constexpr size_t TOK_E = 0, TOK_LR = 512 * 1024, TOK_W = 1024 * 1024, TOK_ROW = 1536 * 1024, TOK_BLKCNT = 2048 * 1024, TOK_TAB = 2048 * 1024 + 65536;
constexpr int CW_BAR = 4096, CW_GCOUNT = 8192;

constexpr int RING_BYTES = 131072, MISC_OFF = RING_BYTES, LDS_BYTES = 147456;

#define GAS __attribute__((address_space(1)))
#define LAS __attribute__((address_space(3)))
typedef unsigned short bf16;
typedef unsigned v4u __attribute__((ext_vector_type(4)));
typedef unsigned v2u __attribute__((ext_vector_type(2)));
typedef float f32x4 __attribute__((ext_vector_type(4)));
typedef float f32x2 __attribute__((ext_vector_type(2)));
#define LDS_WAIT() asm volatile("s_waitcnt lgkmcnt(0)" ::: "memory")
__device__ __forceinline__ unsigned f2bf(float f) { unsigned u = __builtin_bit_cast(unsigned, f); return (u + 0x7fffu + ((u >> 16) & 1u)) >> 16; }
__device__ __forceinline__ unsigned pk2(float lo, float hi) { return f2bf(lo) | (f2bf(hi) << 16); }
__device__ __forceinline__ float bflo(unsigned w) { return __builtin_bit_cast(float, w << 16); }
__device__ __forceinline__ float bfhi(unsigned w) { return __builtin_bit_cast(float, w & 0xffff0000u); }
__device__ __forceinline__ float bf2f(bf16 h) { return __builtin_bit_cast(float, (unsigned)h << 16); }
__device__ __forceinline__ float sigmoidf_(float z) { return __builtin_amdgcn_rcpf(1.0f + __builtin_amdgcn_exp2f(-1.4426950408889634f * z)); }
template <int X> __device__ __forceinline__ float xorf(float v) { return __builtin_bit_cast(float, __builtin_amdgcn_ds_swizzle(__builtin_bit_cast(int, v), (X << 10) | 0x1F)); }
template <int X> __device__ __forceinline__ int xori(int v) { return __builtin_amdgcn_ds_swizzle(v, (X << 10) | 0x1F); }
__device__ __forceinline__ float wave_sum(float v) {
    v += xorf<1>(v); v += xorf<2>(v); v += xorf<4>(v); v += xorf<8>(v); v += xorf<16>(v);
    return __builtin_bit_cast(float, __builtin_amdgcn_readlane(__builtin_bit_cast(int, v), 0)) + __builtin_bit_cast(float, __builtin_amdgcn_readlane(__builtin_bit_cast(int, v), 32));
}
__device__ __forceinline__ float wave_max(float v) {
    v = fmaxf(v, xorf<1>(v)); v = fmaxf(v, xorf<2>(v)); v = fmaxf(v, xorf<4>(v)); v = fmaxf(v, xorf<8>(v)); v = fmaxf(v, xorf<16>(v));
    return fmaxf(__builtin_bit_cast(float, __builtin_amdgcn_readlane(__builtin_bit_cast(int, v), 0)), __builtin_bit_cast(float, __builtin_amdgcn_readlane(__builtin_bit_cast(int, v), 32)));
}
__device__ __forceinline__ float xor32f(float v, int lane) { return __builtin_bit_cast(float, __builtin_amdgcn_ds_bpermute((lane ^ 32) << 2, __builtin_bit_cast(int, v))); }
#define XB_TMO      128
#define XB_XCNT(j)  (256  + 64 * (j))
#define XB_XSUB(j)  (1280 + 64 * (j))
#define XB_XGEN(j)  (2304 + 64 * (j))
#define XB_TOP      3328
#define XB_TOPGEN   3392
#define XCD_BAR_WORDS 3456
#define XB_SPIN_CAP (1u << 18)

__device__ __forceinline__ unsigned xb_ld(unsigned* p)              { return __hip_atomic_load(p, __ATOMIC_RELAXED, __HIP_MEMORY_SCOPE_AGENT); }
__device__ __forceinline__ unsigned xb_add(unsigned* p, unsigned v) { return __hip_atomic_fetch_add(p, v, __ATOMIC_RELAXED, __HIP_MEMORY_SCOPE_AGENT); }
__device__ __forceinline__ unsigned xb_xcc_id() { return (unsigned)__builtin_amdgcn_s_getreg((3 << 11) | 20) & 0xFu; }
#define XB_SPIN(cond, bar) do { unsigned _sp = 0; while (cond) { __builtin_amdgcn_s_sleep(1); \
    if ((++_sp & 255u) == 0u) { if (xb_ld(&(bar)[XB_TMO])) break; if (_sp > XB_SPIN_CAP) { atomicAdd(&(bar)[XB_TMO], 1u); break; } } } } while (0)

struct XcdBarrier {
    unsigned* bar; unsigned x;
    volatile LAS unsigned* st;
};

__device__ __forceinline__ XcdBarrier xcd_barrier_post(unsigned* bar, volatile LAS unsigned* st) {
    XcdBarrier b; b.bar = bar; b.x = xb_xcc_id(); b.st = st;
    if (threadIdx.x == 0) (void)xb_add(&bar[XB_XCNT(b.x)], 1u);
    return b;
}
__device__ __forceinline__ void xcd_barrier_complete(unsigned* bar, unsigned x, unsigned& nloc, unsigned& nx) {
    const unsigned G = gridDim.x * gridDim.y * gridDim.z;
    unsigned sum, cnt, mine, sp = 0u;
    for (;;) {
        sum = 0u; cnt = 0u; mine = 0u;
#pragma unroll
        for (unsigned j = 0; j < 16; ++j) { const unsigned c = xb_ld(&bar[XB_XCNT(j)]); sum += c; cnt += (c > 0u) ? 1u : 0u; mine = (j == x) ? c : mine; }
        if (sum == G) break;
        __builtin_amdgcn_s_sleep(1);
        if ((++sp & 255u) == 0u) { if (xb_ld(&bar[XB_TMO])) break; if (sp > XB_SPIN_CAP) { atomicAdd(&bar[XB_TMO], 1u); break; } }
    }
    nloc = mine > 0u ? mine : 1u; nx = cnt > 0u ? cnt : 1u;
}

__device__ __forceinline__ void xcd_barrier(const XcdBarrier& b) {
    asm volatile("s_waitcnt vmcnt(0)" ::: "memory");
    __syncthreads();
    if (threadIdx.x == 0) {
        unsigned* bar = b.bar;
        __builtin_amdgcn_s_waitcnt(0);
        unsigned nloc = b.st[0], nx = b.st[1];
        if (nloc == 0u) { xcd_barrier_complete(bar, b.x, nloc, nx); b.st[0] = nloc; b.st[1] = nx; }
        const unsigned old = xb_add(&bar[XB_XSUB(b.x)], 1u);
        const unsigned gen = old / nloc;
        if (old + 1u == (gen + 1u) * nloc) {
            __builtin_amdgcn_fence(__ATOMIC_RELEASE, "agent");
            asm volatile("s_waitcnt vmcnt(0)" ::: "memory");
            const unsigned og = xb_add(&bar[XB_TOP], 1u);
            const unsigned tg = og / nx;
            if (og + 1u == (tg + 1u) * nx) xb_add(&bar[XB_TOPGEN], 1u);
            else XB_SPIN(xb_ld(&bar[XB_TOPGEN]) == tg, bar);
            __builtin_amdgcn_fence(__ATOMIC_ACQUIRE, "agent");
            xb_add(&bar[XB_XGEN(b.x)], 1u);
            asm volatile("s_waitcnt vmcnt(0)" ::: "memory");
        } else {
            XB_SPIN(xb_ld(&bar[XB_XGEN(b.x)]) == gen, bar);
            __builtin_amdgcn_fence(__ATOMIC_ACQUIRE, "agent");
            asm volatile("s_waitcnt vmcnt(0)" ::: "memory");
        }
    }
    __syncthreads();
}

__device__ __forceinline__ void cvt_rows_bf16(const float* src, bf16* dst, size_t n8, size_t gtid, size_t gthreads) {
    for (size_t i = gtid; i < n8; i += gthreads) { const f32x4 a = ((const f32x4*)src)[2 * i], b = ((const f32x4*)src)[2 * i + 1];
        v4u o; o.x = pk2(a.x, a.y); o.y = pk2(a.z, a.w); o.z = pk2(b.x, b.y); o.w = pk2(b.z, b.w); ((v4u*)dst)[i] = o; }
}
__device__ __forceinline__ void transpose_item(const float* W, int N, bf16* WT, int dst_row0, LAS float* scr, int k0, int n0, int lane) {
#pragma unroll 8
    for (int i = 0; i < 32; ++i) { const int kk = 2 * i + (lane >> 5); scr[kk * 33 + (lane & 31)] = W[(size_t)(k0 + kk) * N + n0 + (lane & 31)]; }
    LDS_WAIT(); asm volatile("" ::: "memory");
    const int c = lane & 7;
#pragma unroll
    for (int j = 0; j < 4; ++j) { const int n = (lane >> 3) + 8 * j; const LAS float* s = scr + (8 * c) * 33 + n;
        v4u o; o.x = pk2(s[0 * 33], s[1 * 33]); o.y = pk2(s[2 * 33], s[3 * 33]); o.z = pk2(s[4 * 33], s[5 * 33]); o.w = pk2(s[6 * 33], s[7 * 33]);
        *(v4u*)(WT + (size_t)(dst_row0 + n) * 1024 + k0 + 8 * c) = o; }
    LDS_WAIT(); asm volatile("" ::: "memory");
}
__device__ __forceinline__ unsigned pk4_fp8(float a, float b, float c, float d) { int w = 0; w = __builtin_amdgcn_cvt_pk_fp8_f32(a, b, w, false); w = __builtin_amdgcn_cvt_pk_fp8_f32(c, d, w, true); return (unsigned)w; }
__device__ __forceinline__ void transpose_item_f8(const float* W, int N, unsigned char* WT8, int dst_row0, LAS float* scr, int k0, int n0, int lane, float wscale) {
#pragma unroll 8
    for (int i = 0; i < 32; ++i) { const int kk = 2 * i + (lane >> 5); scr[kk * 33 + (lane & 31)] = W[(size_t)(k0 + kk) * N + n0 + (lane & 31)]; }
    LDS_WAIT(); asm volatile("" ::: "memory");
    const int c = lane & 7;
#pragma unroll
    for (int j = 0; j < 4; ++j) { const int n = (lane >> 3) + 8 * j; const LAS float* s = scr + (8 * c) * 33 + n;
        v2u o; o.x = pk4_fp8(s[0 * 33] * wscale, s[1 * 33] * wscale, s[2 * 33] * wscale, s[3 * 33] * wscale); o.y = pk4_fp8(s[4 * 33] * wscale, s[5 * 33] * wscale, s[6 * 33] * wscale, s[7 * 33] * wscale);
        *(v2u*)(WT8 + (size_t)(dst_row0 + n) * 1024 + k0 + 8 * c) = o; }
    LDS_WAIT(); asm volatile("" ::: "memory");
}
__device__ __forceinline__ void phase_weights(LAS float* scr, int gw, int ngw, int lane, const float* win_src, int NC, const float* wkv_src, const float* wo_src,
                                              const float* wg_src, const float* wu_src, const float* wd_src, bf16* win_t, bf16* wkv_t, bf16* wo_t, bf16* wgu_t, bf16* wd_t) {
    const int nbw = NC / 32, nWin = nbw * 16, NIT = nWin + 256 + 512 + NE * 1536;
    for (int it = gw; it < NIT; it += ngw) {
        int r = it;
        if (r < nWin) { const int kb = r / nbw, nb = r - kb * nbw; transpose_item(win_src, NC, win_t, 32 * nb, scr, 64 * kb, 32 * nb, lane); continue; } r -= nWin;
        if (r < 256) { const int kb = r >> 4, nb = r & 15; transpose_item(wkv_src, 512, wkv_t, 32 * nb, scr, 64 * kb, 32 * nb, lane); continue; } r -= 256;
        if (r < 512) { const int kb = r >> 5, nb = r & 31; transpose_item(wo_src, 1024, wo_t, 32 * nb, scr, 64 * kb, 32 * nb, lane); continue; } r -= 512;
        const int e = r / 1536, q = r - e * 1536, which = q >> 9, rr = q & 511, kb = rr >> 5, nb = rr & 31, n0 = 32 * nb;
        const size_t eoff = (size_t)e * 1024 * 1024;
        if (which == 0) transpose_item_f8(wg_src + eoff, 1024, (unsigned char*)wgu_t + 2 * eoff, (n0 >> 7) * 256 + (n0 & 127), scr, 64 * kb, n0, lane, 32.f);
        else if (which == 1) transpose_item_f8(wu_src + eoff, 1024, (unsigned char*)wgu_t + 2 * eoff, (n0 >> 7) * 256 + 128 + (n0 & 127), scr, 64 * kb, n0, lane, 32.f);
        else transpose_item(wd_src + eoff, 1024, wd_t + eoff, n0, scr, 64 * kb, n0, lane);
    }
}

template <bool OUT>
__device__ __forceinline__ void hgrn_seg(LAS unsigned char* lds, const bf16* h, const float* lbl, int j, const float* normg, float* Sloc, float* Dseg, bf16* mix, int unit, int tid, int wave, int lane) {
    const int seg = unit & (HNSEG - 1), bh = unit >> 6, hh = bh % HG_H, b = bh / HG_H;
    const int v = tid & 127, dg = tid >> 7;
    LAS float* fgs = (LAS float*)lds; LAS float* vs = fgs + 4096; LAS float* qs = vs + 4096; LAS float* op = qs + 4096;
    f32x2 st[16];
    float* Sp = Sloc + (size_t)unit * 16384 + (size_t)(dg * 32) * 128 + v;
#pragma unroll
    for (int dd = 0; dd < 16; ++dd) { st[dd].x = OUT ? Sp[(2 * dd) * 128] : 0.f; st[dd].y = OUT ? Sp[(2 * dd + 1) * 128] : 0.f; }
    float dprod = 1.f;
    const int stok = tid >> 4, c8 = (tid & 15) * 8;
    float lb[8];
#pragma unroll
    for (int i = 0; i < 8; ++i) { lb[i] = 0.f; if (j > 0) { const float a0 = lbl[hh * 128 + c8 + i], a1 = lbl[MIXW + hh * 128 + c8 + i]; lb[i] = 1.f / (1.f + __expf(a0 - a1)); } }
    for (int ch = 0; ch < HSEG / 32; ++ch) {
        const size_t t0 = (size_t)b * SEQ + seg * HSEG + ch * 32;
        { const bf16* row = h + (t0 + stok) * NC_H + hh * 128 + c8;
          const v4u f8 = *(const v4u*)(row + 768), i8 = *(const v4u*)(row + 1536); v4u q8 = {0u, 0u, 0u, 0u}; if (OUT) q8 = *(const v4u*)row;
#pragma unroll
          for (int w = 0; w < 4; ++w) { const float f0 = bflo(f8[w]), f1 = bfhi(f8[w]); const int o = stok * 128 + c8 + 2 * w;
              fgs[o] = lb[2 * w] + (1.f - lb[2 * w]) * sigmoidf_(f0); fgs[o + 1] = lb[2 * w + 1] + (1.f - lb[2 * w + 1]) * sigmoidf_(f1);
              vs[o] = bflo(i8[w]); vs[o + 1] = bfhi(i8[w]);
              if (OUT) { const float q0 = bflo(q8[w]), q1 = bfhi(q8[w]); qs[o] = q0 * sigmoidf_(q0); qs[o + 1] = q1 * sigmoidf_(q1); } } }
        __syncthreads();
        if (!OUT) { if (tid < 128) { for (int tt = 0; tt < 32; ++tt) dprod *= fgs[tt * 128 + tid]; } }
        f32x4 fA[8], qA[8], fB[8], qB[8]; float vA, vB;
#define HG_LOAD(F, Q, V, tt_) do { V = vs[(tt_) * 128 + v]; _Pragma("unroll") for (int d4 = 0; d4 < 8; ++d4) { F[d4] = *(const LAS f32x4*)(fgs + (tt_) * 128 + dg * 32 + d4 * 4); \
            if (OUT) Q[d4] = *(const LAS f32x4*)(qs + (tt_) * 128 + dg * 32 + d4 * 4); } } while (0)
#define HG_STEP(F, Q, V, tt_) do { const f32x2 vv2 = {V, V}; f32x2 acc2 = {0.f, 0.f}; _Pragma("unroll") for (int d4 = 0; d4 < 8; ++d4) { \
            const f32x2 fa = {F[d4].x, F[d4].y}, fb = {F[d4].z, F[d4].w}; \
            st[2 * d4] = fa * (st[2 * d4] - vv2) + vv2; st[2 * d4 + 1] = fb * (st[2 * d4 + 1] - vv2) + vv2; \
            if (OUT) { const f32x2 qa = {Q[d4].x, Q[d4].y}, qb = {Q[d4].z, Q[d4].w}; acc2 = qa * st[2 * d4] + acc2; acc2 = qb * st[2 * d4 + 1] + acc2; } } \
            if (OUT) op[(dg * 32 + (tt_)) * 128 + v] = acc2.x + acc2.y; } while (0)
        HG_LOAD(fA, qA, vA, 0);
#pragma unroll 1
        for (int tt = 0; tt < 32; tt += 2) {
            HG_LOAD(fB, qB, vB, tt + 1);
            __builtin_amdgcn_sched_barrier(0);
            HG_STEP(fA, qA, vA, tt);
            __builtin_amdgcn_sched_barrier(0);
            if (tt + 2 < 32) HG_LOAD(fA, qA, vA, tt + 2);
            __builtin_amdgcn_sched_barrier(0);
            HG_STEP(fB, qB, vB, tt + 1);
            __builtin_amdgcn_sched_barrier(0);
        }
#undef HG_LOAD
#undef HG_STEP
        if (OUT) {
            __syncthreads();
#pragma unroll
            for (int k = 0; k < 4; ++k) { const int tt = wave + 8 * k; float o0 = 0.f, o1 = 0.f;
#pragma unroll
                for (int g = 0; g < 4; ++g) { o0 += op[(g * 32 + tt) * 128 + lane]; o1 += op[(g * 32 + tt) * 128 + lane + 64]; }
                const float ms = wave_sum(o0 * o0 + o1 * o1) * (1.f / 128.f), r = 1.f / sqrtf(ms + 1e-6f);
                const bf16* grow = h + (t0 + tt) * NC_H + 2304 + hh * 128; const float g0 = bf2f(grow[lane]), g1 = bf2f(grow[lane + 64]);
                bf16* mrow = mix + (t0 + tt) * 1024 + hh * 128;
                mrow[lane] = (bf16)f2bf(o0 * r * normg[lane] * sigmoidf_(g0)); mrow[lane + 64] = (bf16)f2bf(o1 * r * normg[lane + 64] * sigmoidf_(g1)); }
        }
        __syncthreads();
    }
    if (!OUT) {
#pragma unroll
        for (int dd = 0; dd < 16; ++dd) { Sp[(2 * dd) * 128] = st[dd].x; Sp[(2 * dd + 1) * 128] = st[dd].y; }
        if (tid < 128) Dseg[(size_t)unit * 128 + tid] = dprod;
    }
}
__device__ __forceinline__ void hgrn_scan(float* Sloc, const float* Dseg, size_t gtid, size_t gthreads) {
    for (size_t idx = gtid; idx < (size_t)NBATCH * HG_H * 16384; idx += gthreads) { const int bh = (int)(idx >> 14), e = (int)(idx & 16383), d = e >> 7; float cur = 0.f;
        for (int seg = 0; seg < HNSEG; ++seg) { const size_t u = (size_t)bh * HNSEG + seg; float* p = Sloc + u * 16384 + e; const float tmp = *p; *p = cur; cur = Dseg[u * 128 + d] * cur + tmp; } }
}

template <bool MASK>
__device__ __forceinline__ void attn4(const LAS unsigned* Ks, const LAS bf16* Vs, const LAS float* qst, LAS float* pb, int lane, const int (&tq)[4], int kbase, float slope,
                                      float (&mo)[4], float (&lo)[4], float (&oo)[4]) {
    float sc[4][4];
#pragma unroll
    for (int a = 0; a < 4; ++a)
#pragma unroll
        for (int c = 0; c < 4; ++c) sc[a][c] = 0.f;
#pragma unroll 4
    for (int dd = 0; dd < 32; ++dd) {
        f32x2 qv[4];
#pragma unroll
        for (int qi = 0; qi < 4; ++qi) qv[qi] = *(const LAS f32x2*)(qst + qi * 64 + 2 * dd);
#pragma unroll
        for (int kk = 0; kk < 4; ++kk) { const unsigned kw = Ks[(lane + 64 * kk) * 33 + dd]; const float k0 = bflo(kw), k1 = bfhi(kw);
#pragma unroll
            for (int qi = 0; qi < 4; ++qi) sc[qi][kk] += qv[qi].x * k0 + qv[qi].y * k1; }
    }
#pragma unroll
    for (int qi = 0; qi < 4; ++qi) { float mx = -INFINITY;
#pragma unroll
        for (int kk = 0; kk < 4; ++kk) { const int pos = kbase + lane + 64 * kk; float lg = sc[qi][kk] * 0.125f - slope * (float)(tq[qi] - pos); if (MASK && pos > tq[qi]) lg = -INFINITY; sc[qi][kk] = lg; mx = fmaxf(mx, lg); }
        mx = wave_max(mx); float s = 0.f;
#pragma unroll
        for (int kk = 0; kk < 4; ++kk) { const float p = __builtin_amdgcn_exp2f((sc[qi][kk] - mx) * 1.4426950408889634f); pb[qi * 256 + lane + 64 * kk] = p; s += p; }
        lo[qi] = wave_sum(s); mo[qi] = mx; }
    float o[4] = {0.f, 0.f, 0.f, 0.f};
#pragma unroll 4
    for (int k4 = 0; k4 < 64; ++k4) { f32x4 p4[4];
#pragma unroll
        for (int qi = 0; qi < 4; ++qi) p4[qi] = *(const LAS f32x4*)(pb + qi * 256 + 4 * k4);
#pragma unroll
        for (int jj = 0; jj < 4; ++jj) { const float vv = bf2f(Vs[(4 * k4 + jj) * 64 + lane]);
#pragma unroll
            for (int qi = 0; qi < 4; ++qi) o[qi] += p4[qi][jj] * vv; } }
#pragma unroll
    for (int qi = 0; qi < 4; ++qi) oo[qi] = o[qi];
}
constexpr int AT_KS = 0, AT_VS = 33792, AT_WV = 66560, AT_WVB = 5120;

__device__ __forceinline__ void memattn_unit(LAS unsigned char* lds, const bf16* h, int NC, int qoff, const bf16* kv, bf16* mix, int unit, int tid, int wave, int lane) {
    const int chunk = unit & 31, bm = unit >> 5, mh = bm & 3, b = bm >> 2;
    LAS unsigned* Ks = (LAS unsigned*)(lds + AT_KS); LAS unsigned* Vs32 = (LAS unsigned*)(lds + AT_VS);
    LAS float* qst = (LAS float*)(lds + AT_WV + wave * AT_WVB); LAS float* pb = qst + 256;
    for (int i = 0; i < 16; ++i) { const int idx = tid + 512 * i, r = idx >> 5, dd = idx & 31; const unsigned* src = (const unsigned*)(kv + (size_t)(b * 256 + r) * 512 + mh * 64);
        Ks[r * 33 + dd] = src[dd]; Vs32[r * 32 + dd] = src[128 + dd]; }
    __syncthreads();
    for (int qd = 0; qd < 16; ++qd) { const size_t tg = (size_t)b * SEQ + chunk * 512 + wave * 64 + qd * 4;
#pragma unroll
        for (int qi = 0; qi < 4; ++qi) qst[qi * 64 + lane] = bf2f(h[(tg + qi) * NC + qoff + mh * 64 + lane]);
        const int tq[4] = {0, 0, 0, 0}; float m[4], l[4], o[4];
        attn4<false>(Ks, (const LAS bf16*)Vs32, qst, pb, lane, tq, 0, 0.f, m, l, o);
#pragma unroll
        for (int qi = 0; qi < 4; ++qi) mix[(tg + qi) * 1024 + MIXW + mh * 64 + lane] = (bf16)f2bf(o[qi] / l[qi]); }
    __syncthreads();
}

typedef short s16x8 __attribute__((ext_vector_type(8)));
typedef float f32x16 __attribute__((ext_vector_type(16)));
typedef float f32x2_t __attribute__((ext_vector_type(2))); typedef __bf16 bf16x2_t __attribute__((ext_vector_type(2)));
__device__ __forceinline__ unsigned cvtpk(float lo, float hi) { f32x2_t v = {lo, hi}; bf16x2_t b = __builtin_convertvector(v, bf16x2_t); return __builtin_bit_cast(unsigned, b); }
constexpr int AT2_K = 0, AT2_V = 36864, AT2_KROW = 144, AT2_VROW = 528;
__device__ __forceinline__ void stage_kv_images(LAS unsigned char* lds, const bf16* kp, const bf16* vp, size_t row_stride, int tid) {
#pragma unroll
    for (int i = 0; i < 4; ++i) { const int idx = tid + 512 * i, key = idx >> 3, c = idx & 7;
        const v4u kx = *(const v4u*)(kp + (size_t)key * row_stride + 8 * c);
        *(LAS v4u*)(lds + AT2_K + key * AT2_KROW + c * 16) = kx;
        const v4u vx = *(const v4u*)(vp + (size_t)key * row_stride + 8 * c);
        const int pos = (key & ~15) | (key & 3) | ((key & 4) << 1) | ((key & 8) >> 1);
        LAS bf16* vt = (LAS bf16*)(lds + AT2_V) + pos;
#pragma unroll
        for (int w = 0; w < 4; ++w) { vt[(8 * c + 2 * w) * (AT2_VROW / 2)] = (bf16)(vx[w] & 0xffffu); vt[(8 * c + 2 * w + 1) * (AT2_VROW / 2)] = (bf16)(vx[w] >> 16); } }
}
template <bool MASK>
__device__ __forceinline__ void attn_tile32(const LAS unsigned char* lds, const bf16* qrow, int lane, float dist0, float slope2, f32x16 (&o)[2], float& mrow, float& lrow) {
    const int r = lane & 31, hf = lane >> 5;
    s16x8 qf[4];
#pragma unroll
    for (int s = 0; s < 4; ++s) qf[s] = *(const s16x8*)(qrow + 16 * s + 8 * hf);
    f32x16 acc[8];
    const LAS unsigned char* kb = lds + AT2_K + r * AT2_KROW + hf * 16;
#pragma unroll
    for (int kt = 0; kt < 8; ++kt) {
#pragma unroll
        for (int i = 0; i < 16; ++i) acc[kt][i] = 0.f;
#pragma unroll
        for (int s = 0; s < 4; ++s) { const s16x8 kf = *(const LAS s16x8*)(kb + kt * 32 * AT2_KROW + s * 32); acc[kt] = __builtin_amdgcn_mfma_f32_32x32x16_bf16(kf, qf[s], acc[kt], 0, 0, 0); }
        __builtin_amdgcn_sched_barrier(0); }
    const float base2 = dist0 - 4.f * (float)hf; float mx = -INFINITY;
#pragma unroll
    for (int kt = 0; kt < 8; ++kt)
#pragma unroll
        for (int i = 0; i < 16; ++i) { const float dist = base2 - (float)(32 * kt + (i & 3) + 8 * (i >> 2)); float lg = acc[kt][i] * (0.125f * 1.4426950408889634f);
            if (MASK) { lg -= slope2 * dist; if (dist < 0.f) lg = -INFINITY; } acc[kt][i] = lg; mx = fmaxf(mx, lg); }
    mx = fmaxf(mx, xor32f(mx, lane));
    float sum = 0.f;
#pragma unroll
    for (int i = 0; i < 16; ++i) { o[0][i] = 0.f; o[1][i] = 0.f; }
    const LAS unsigned char* vb = lds + AT2_V + r * AT2_VROW + hf * 16;
#pragma unroll
    for (int kt = 0; kt < 8; ++kt) {
#pragma unroll
        for (int i = 0; i < 16; ++i) { const float p = __builtin_amdgcn_exp2f(acc[kt][i] - mx); sum += p; acc[kt][i] = p; }
#pragma unroll
        for (int s2 = 0; s2 < 2; ++s2) { v4u pw; pw.x = cvtpk(acc[kt][8 * s2], acc[kt][8 * s2 + 1]); pw.y = cvtpk(acc[kt][8 * s2 + 2], acc[kt][8 * s2 + 3]);
            pw.z = cvtpk(acc[kt][8 * s2 + 4], acc[kt][8 * s2 + 5]); pw.w = cvtpk(acc[kt][8 * s2 + 6], acc[kt][8 * s2 + 7]); const s16x8 pf = __builtin_bit_cast(s16x8, pw);
#pragma unroll
            for (int dt = 0; dt < 2; ++dt) { const s16x8 vf = *(const LAS s16x8*)(vb + dt * 32 * AT2_VROW + (32 * kt + 16 * s2) * 2); o[dt] = __builtin_amdgcn_mfma_f32_32x32x16_bf16(vf, pf, o[dt], 0, 0, 0); } }
        __builtin_amdgcn_sched_barrier(0); }
    sum += xor32f(sum, lane);
    mrow = mx; lrow = sum;
}
__device__ __forceinline__ void memattn_unit2(LAS unsigned char* lds, const bf16* h, int NC, int qoff, const bf16* kv, bf16* mix, int unit, int tid, int wave, int lane) {
    const int chunk = unit & 63, bm = unit >> 6, mh = bm & 3, b = bm >> 2, r = lane & 31, hf = lane >> 5;
    const bf16* kvrow0 = kv + (size_t)(b * 256) * 512 + mh * 64;
    stage_kv_images(lds, kvrow0, kvrow0 + 256, 512, tid);
    __syncthreads();
    { const size_t tg = (size_t)b * SEQ + chunk * 256 + wave * 32 + r;
        f32x16 o[2]; float m2, l;
        attn_tile32<false>(lds, h + tg * NC + qoff + mh * 64, lane, 0.f, 0.f, o, m2, l);
        const float inv = 1.f / l; bf16* mp = mix + tg * 1024 + MIXW + mh * 64 + 4 * hf;
#pragma unroll
        for (int dt = 0; dt < 2; ++dt)
#pragma unroll
            for (int g = 0; g < 4; ++g) { v2u w; w.x = cvtpk(o[dt][4 * g] * inv, o[dt][4 * g + 1] * inv); w.y = cvtpk(o[dt][4 * g + 2] * inv, o[dt][4 * g + 3] * inv); *(v2u*)(mp + 32 * dt + 8 * g) = w; } }
    __syncthreads();
}
__device__ __forceinline__ void kmean_unit(LAS unsigned char* lds, const bf16* h, float* kmean, int unit, int tid) {
    const int n = unit & 63, bh = unit >> 6, hh = bh % MB_H, b = bh / MB_H, d = tid & 63, part = tid >> 6;
    LAS float* red = (LAS float*)lds;
    float s = 0.f; const bf16* p = h + ((size_t)b * SEQ + n * 256 + part * 32) * NC_M + 768 + hh * 64 + d;
    for (int i = 0; i < 32; ++i) s += bf2f(p[(size_t)i * NC_M]);
    red[part * 64 + d] = s; __syncthreads();
    if (tid < 64) { float a = 0.f; for (int pp = 0; pp < 8; ++pp) a += red[pp * 64 + tid]; kmean[((size_t)bh * 64 + n) * 64 + tid] = a * (1.f / 256.f); }
    __syncthreads();
}
__device__ __forceinline__ void moba_gate_unit(LAS unsigned char* lds, const bf16* h, const float* kmean, unsigned* gcount, int* selinfo, unsigned* list, int unit, int tid) {
    const int c = unit & 63, bh = unit >> 6, hh = bh % MB_H, b = bh / MB_H;
    LAS float* km = (LAS float*)lds; LAS int* hist = (LAS int*)(lds + 16384); LAS int* base = hist + 64;
    for (int i = tid; i < 4096; i += NTHR) km[i] = kmean[(size_t)bh * 4096 + i];
    if (tid < 64) hist[tid] = 0;
    __syncthreads();
    int s0 = 0, s1 = 0, s2 = 0, r0 = 0, r1 = 0, r2 = 0, ns = 0; const int t = c * 256 + tid;
    if (tid < 256) {
        float q[64]; const v4u* qp = (const v4u*)(h + ((size_t)b * SEQ + t) * NC_M + hh * 64);
#pragma unroll
        for (int w = 0; w < 8; ++w) { const v4u x = qp[w]; q[8 * w] = bflo(x.x); q[8 * w + 1] = bfhi(x.x); q[8 * w + 2] = bflo(x.y); q[8 * w + 3] = bfhi(x.y); q[8 * w + 4] = bflo(x.z); q[8 * w + 5] = bfhi(x.z); q[8 * w + 6] = bflo(x.w); q[8 * w + 7] = bfhi(x.w); }
        float v0 = -INFINITY, v1 = -INFINITY, v2 = -INFINITY;
        for (int n = 0; n < c; ++n) { float g = 0.f;
#pragma unroll
            for (int d4 = 0; d4 < 16; ++d4) { const f32x4 k4 = *(const LAS f32x4*)(km + n * 64 + 4 * d4); g += q[4 * d4] * k4.x + q[4 * d4 + 1] * k4.y + q[4 * d4 + 2] * k4.z + q[4 * d4 + 3] * k4.w; }
            if (g > v0) { v2 = v1; s2 = s1; v1 = v0; s1 = s0; v0 = g; s0 = n; } else if (g > v1) { v2 = v1; s2 = s1; v1 = g; s1 = n; } else if (g > v2) { v2 = g; s2 = n; } }
        ns = c < 3 ? c : 3;
        if (ns > 0) r0 = __hip_atomic_fetch_add(hist + s0, 1, __ATOMIC_RELAXED, __HIP_MEMORY_SCOPE_WORKGROUP);
        if (ns > 1) r1 = __hip_atomic_fetch_add(hist + s1, 1, __ATOMIC_RELAXED, __HIP_MEMORY_SCOPE_WORKGROUP);
        if (ns > 2) r2 = __hip_atomic_fetch_add(hist + s2, 1, __ATOMIC_RELAXED, __HIP_MEMORY_SCOPE_WORKGROUP);
        selinfo[((size_t)b * SEQ + t) * MB_H + hh] = ns;
    }
    __syncthreads();
    if (tid < 64) { const int hc = hist[tid]; if (hc > 0) base[tid] = (int)__hip_atomic_fetch_add(gcount + bh * 64 + tid, (unsigned)hc, __ATOMIC_RELAXED, __HIP_MEMORY_SCOPE_AGENT); }
    __syncthreads();
    if (tid < 256) { unsigned* lp = list + ((size_t)bh * 64 << 14);
        if (ns > 0) lp[((size_t)s0 << 14) + base[s0] + r0] = (unsigned)t;
        if (ns > 1) lp[((size_t)s1 << 14) + base[s1] + r1] = (unsigned)t | (1u << 14);
        if (ns > 2) lp[((size_t)s2 << 14) + base[s2] + r2] = (unsigned)t | (2u << 14); }
    __syncthreads();
}
__device__ __forceinline__ void moba_attn_item(LAS unsigned char* lds, const bf16* h, const unsigned* gcount, const unsigned* list, float* po, float* pml, int item, int tid, int wave, int lane) {
    const int n = item / 24, bh = item - n * 24, hh = bh % MB_H, b = bh / MB_H;
    LAS unsigned* Ks = (LAS unsigned*)(lds + AT_KS); LAS unsigned* Vs32 = (LAS unsigned*)(lds + AT_VS);
    LAS float* qst = (LAS float*)(lds + AT_WV + wave * AT_WVB); LAS float* pb = qst + 256;
    for (int i = 0; i < 16; ++i) { const int idx = tid + 512 * i, r = idx >> 5, dd = idx & 31; const unsigned* src = (const unsigned*)(h + ((size_t)b * SEQ + n * 256 + r) * NC_M + hh * 64);
        Ks[r * 33 + dd] = src[384 + dd]; Vs32[r * 32 + dd] = src[768 + dd]; }
    __syncthreads();
    const int cnt = (int)gcount[bh * 64 + n], total = 256 + cnt, nquads = (total + 3) >> 2;
    const float slope = hh < 8 ? ldexpf(1.0f, -(hh + 1)) : ldexpf(0.70710678118654752f, -(hh - 8));
    const unsigned* lp = list + (((size_t)bh * 64 + n) << 14);
    for (int quad = wave; quad < nquads; quad += 8) {
        int tq[4], slot[4];
#pragma unroll
        for (int qi = 0; qi < 4; ++qi) { int idx = quad * 4 + qi; idx = idx < total ? idx : total - 1;
            if (idx < 256) { tq[qi] = n * 256 + idx; slot[qi] = 3; } else { const unsigned e = lp[idx - 256]; tq[qi] = (int)(e & 16383u); slot[qi] = (int)(e >> 14); } }
#pragma unroll
        for (int qi = 0; qi < 4; ++qi) qst[qi * 64 + lane] = bf2f(h[((size_t)b * SEQ + tq[qi]) * NC_M + hh * 64 + lane]);
        float m[4], l[4], o[4];
        attn4<true>(Ks, (const LAS bf16*)Vs32, qst, pb, lane, tq, n * 256, slope, m, l, o);
#pragma unroll
        for (int qi = 0; qi < 4; ++qi) if (quad * 4 + qi < total) { const size_t pi = (((size_t)b * SEQ + tq[qi]) * MB_H + hh) * 4 + slot[qi];
            po[pi * 64 + lane] = o[qi]; if (lane == 0) { pml[pi * 2] = m[qi]; pml[pi * 2 + 1] = l[qi]; } }
    }
    __syncthreads();
}

__device__ __forceinline__ void moba_attn_item2(LAS unsigned char* lds, const bf16* h, const unsigned* gcount, const unsigned* list, float* po, float* pml, int item, int tid, int wave, int lane) {
    const int n = item / 24, bh = item - n * 24, hh = bh % MB_H, b = bh / MB_H, r = lane & 31, hf = lane >> 5;
    const bf16* hrow0 = h + ((size_t)b * SEQ + n * 256) * NC_M + hh * 64;
    stage_kv_images(lds, hrow0 + 768, hrow0 + 1536, NC_M, tid);
    __syncthreads();
    const int cnt = (int)gcount[bh * 64 + n], total = 256 + cnt, ntiles = (total + 31) >> 5;
    const float slope2 = (hh < 8 ? ldexpf(1.0f, -(hh + 1)) : ldexpf(0.70710678118654752f, -(hh - 8))) * 1.4426950408889634f;
    const unsigned* lp = list + (((size_t)bh * 64 + n) << 14);
#pragma unroll 1
    for (int tile = wave; tile < ntiles; tile += NWAVES) {
        int idx = tile * 32 + r; const bool valid = idx < total; idx = valid ? idx : total - 1;
        int tq, slot; if (idx < 256) { tq = n * 256 + idx; slot = 3; } else { const unsigned e = lp[idx - 256]; tq = (int)(e & 16383u); slot = (int)(e >> 14); }
        f32x16 o[2]; float m2, l;
        attn_tile32<true>(lds, h + ((size_t)b * SEQ + tq) * NC_M + hh * 64, lane, (float)(tq - n * 256), slope2, o, m2, l);
        if (valid) { const size_t pi = (((size_t)b * SEQ + tq) * MB_H + hh) * 4 + slot; float* op = po + pi * 64 + 4 * hf;
#pragma unroll
            for (int dt = 0; dt < 2; ++dt)
#pragma unroll
                for (int g = 0; g < 4; ++g) { const f32x4 v = {o[dt][4 * g], o[dt][4 * g + 1], o[dt][4 * g + 2], o[dt][4 * g + 3]}; *(f32x4*)(op + 32 * dt + 8 * g) = v; }
            if (hf == 0) { pml[pi * 2] = m2; pml[pi * 2 + 1] = l; } }
    }
    __syncthreads();
}
__device__ __forceinline__ void moba_combine(const float* __restrict__ po, const float* __restrict__ pml, const int* __restrict__ selinfo, bf16* __restrict__ mix, int gw, int ngw, int lane) {
    const int sub = lane >> 4, d4 = (lane & 15) * 4;
#pragma unroll 2
    for (int idx = gw * 4 + sub; idx < T * MB_H; idx += ngw * 4) { const int tg = idx / MB_H, hh = idx - tg * MB_H, ns = selinfo[idx]; const size_t p4 = (size_t)idx * 4;
        f32x2 ml[4]; f32x4 ov[4];
#pragma unroll
        for (int j = 0; j < 4; ++j) { ml[j] = ((const f32x2*)pml)[p4 + j]; ov[j] = *(const f32x4*)(po + (p4 + j) * 64 + d4); }
        float M = ml[3].x;
#pragma unroll
        for (int j = 0; j < 3; ++j) { const bool ok = j < ns; ml[j].x = ok ? ml[j].x : -INFINITY; ml[j].y = ok ? ml[j].y : 0.f; M = fmaxf(M, ml[j].x);
            ov[j].x = ok ? ov[j].x : 0.f; ov[j].y = ok ? ov[j].y : 0.f; ov[j].z = ok ? ov[j].z : 0.f; ov[j].w = ok ? ov[j].w : 0.f; }
        float den = 0.f; f32x4 num = {0.f, 0.f, 0.f, 0.f};
#pragma unroll
        for (int j = 0; j < 4; ++j) { const float w = __builtin_amdgcn_exp2f(ml[j].x - M); den += w * ml[j].y; num += ov[j] * w; }
        const float inv = 1.f / den; v2u o; o.x = pk2(num.x * inv, num.y * inv); o.y = pk2(num.z * inv, num.w * inv);
        *(v2u*)(mix + (size_t)tg * 1024 + hh * 64 + d4) = o; }
}

__device__ __forceinline__ void ln_row(f32x4 (&v)[4], const f32x4 (&gv)[4], const f32x4 (&bv)[4]) {
    float s = 0.f;
#pragma unroll
    for (int j = 0; j < 4; ++j) s += (v[j].x + v[j].y) + (v[j].z + v[j].w);
    const float mean = wave_sum(s) * (1.f / D); float s2 = 0.f;
#pragma unroll
    for (int j = 0; j < 4; ++j) { v[j] = v[j] - mean; s2 += (v[j].x * v[j].x + v[j].y * v[j].y) + (v[j].z * v[j].z + v[j].w * v[j].w); }
    const float rstd = 1.f / sqrtf(wave_sum(s2) * (1.f / D) + 1e-5f);
#pragma unroll
    for (int j = 0; j < 4; ++j) v[j] = v[j] * rstd * gv[j] + bv[j];
}
__device__ __forceinline__ void phase_ln1(LAS unsigned char* lds, const float* xin, const bf16* y, const float* g, const float* bb, const float* wr, const float* br,
                                          float* xout, bf16* xbf, int* tok_e, int* tok_lr, float* tok_w, int* blk_cnt, int blk, int tid, int wave, int lane) {
    LAS float* xst = (LAS float*)lds;
    LAS float* part = (LAS float*)(lds + 32768);
    LAS int* hist = (LAS int*)(lds + 40960);
    if (tid < 32) hist[tid] = 0;
    constexpr int TPB = T / GRID;
    const int e = lane & 31, half = lane >> 5;
    float wreg[64];
    { const float* wp = wr + (size_t)(wave * 128 + half * 64) * NE + e;
#pragma unroll
      for (int k = 0; k < 64; ++k) wreg[k] = wp[k * NE]; }
    const float bre = br[e];
    __syncthreads();
    for (int grp = 0; grp < TPB / NWAVES; ++grp) { const size_t t = (size_t)blk * TPB + grp * NWAVES + wave;
        { f32x4 gv[4], bv[4];
#pragma unroll
          for (int j = 0; j < 4; ++j) { gv[j] = ((const f32x4*)g)[lane + 64 * j]; bv[j] = ((const f32x4*)bb)[lane + 64 * j]; }
          const f32x4* xr = (const f32x4*)(xin + t * D) + lane; const v2u* yr = (const v2u*)(y + t * D) + lane; f32x4 v[4];
#pragma unroll
          for (int j = 0; j < 4; ++j) { const f32x4 xv = xr[64 * j]; const v2u yw = yr[64 * j];
              v[j].x = DN_ALPHA * xv.x + bflo(yw.x); v[j].y = DN_ALPHA * xv.y + bfhi(yw.x); v[j].z = DN_ALPHA * xv.z + bflo(yw.y); v[j].w = DN_ALPHA * xv.w + bfhi(yw.y); }
          ln_row(v, gv, bv);
          f32x4* xo = (f32x4*)(xout + t * D) + lane; v2u* xb = (v2u*)(xbf + t * D) + lane;
#pragma unroll
          for (int j = 0; j < 4; ++j) { xo[64 * j] = v[j]; v2u w; w.x = pk2(v[j].x, v[j].y); w.y = pk2(v[j].z, v[j].w); xb[64 * j] = w; ((LAS f32x4*)(xst + wave * 1024))[lane + 64 * j] = v[j]; } }
        __syncthreads();
#pragma unroll 2
        for (int tk = 0; tk < 8; ++tk) { float acc = 0.f; const LAS float* xs_ = xst + tk * 1024 + wave * 128 + half * 64;
#pragma unroll
            for (int k4 = 0; k4 < 16; ++k4) { const f32x4 xv = *(const LAS f32x4*)(xs_ + 4 * k4); acc += xv.x * wreg[4 * k4]; acc += xv.y * wreg[4 * k4 + 1]; acc += xv.z * wreg[4 * k4 + 2]; acc += xv.w * wreg[4 * k4 + 3]; }
            acc += xor32f(acc, lane);
            if (half == 0) part[(wave * 8 + tk) * 32 + e] = acc; }
        __syncthreads();
        float logit = bre;
#pragma unroll
        for (int w = 0; w < 8; ++w) logit += part[(w * 8 + wave) * 32 + e];
        int se[4]; float sv[4];
#pragma unroll
        for (int k = 0; k < 4; ++k) { float bvv = logit; int bi = e;
#define ARGMAX_STEP(X) { const float ov = xorf<X>(bvv); const int oi = xori<X>(bi); if (ov > bvv || (ov == bvv && oi < bi)) { bvv = ov; bi = oi; } }
            ARGMAX_STEP(1) ARGMAX_STEP(2) ARGMAX_STEP(4) ARGMAX_STEP(8) ARGMAX_STEP(16)
#undef ARGMAX_STEP
            se[k] = bi; sv[k] = bvv; if (e == bi) logit = -INFINITY; }
        const float e1 = __expf(sv[1] - sv[0]), e2 = __expf(sv[2] - sv[0]), e3 = __expf(sv[3] - sv[0]), inv = 1.f / (1.f + e1 + e2 + e3);
        const float wk[4] = {inv, e1 * inv, e2 * inv, e3 * inv};
        if (lane == 0) {
#pragma unroll
            for (int k = 0; k < 4; ++k) { const int lr = __hip_atomic_fetch_add(hist + se[k], 1, __ATOMIC_RELAXED, __HIP_MEMORY_SCOPE_WORKGROUP);
                tok_e[t * 4 + k] = se[k]; tok_lr[t * 4 + k] = lr; tok_w[t * 4 + k] = wk[k]; } }
    }
    __syncthreads();
    if (tid < 32) blk_cnt[blk * 32 + tid] = hist[tid];
    __syncthreads();
}
__device__ __forceinline__ void phase_dispatch(LAS unsigned char* lds, const int* __restrict__ blk_cnt, const int* __restrict__ tok_e, const int* __restrict__ tok_lr, int* __restrict__ tok_row, int* __restrict__ tab,
                                               const bf16* __restrict__ xbf, bf16* __restrict__ xs, int blk, int tid, int wave, int lane) {
    LAS int* tot = (LAS int*)lds; LAS int* pre = tot + 32; LAS int* pst = pre + 32; LAS int* rows = pst + 64;
    if (tid < 32) { int s = 0, p = 0;
#pragma unroll 8
        for (int bb = 0; bb < GRID; ++bb) { const int c = blk_cnt[bb * 32 + tid]; p += (bb < blk) ? c : 0; s += c; } tot[tid] = s; pre[tid] = p; }
    __syncthreads();
    if (tid == 0) { int acc = 0; for (int e = 0; e < 32; ++e) { pst[e] = acc; acc += ((tot[e] + 255) >> 8) << 8; } pst[32] = acc; }
    __syncthreads();
    if (blk == 0 && tid < 33) tab[tid] = pst[tid] >> 8;
    constexpr int TPB = T / GRID;
    static_assert(TPB * 4 == NTHR, "one (token, k) pair per thread");
    { const size_t ti = (size_t)blk * TPB * 4 + tid; const int e = tok_e[ti]; const int r = pst[e] + pre[e] + tok_lr[ti]; tok_row[ti] = r; rows[tid] = r; }
    __syncthreads();
#pragma unroll 4
    for (int i = wave; i < TPB * 4; i += NWAVES) { const int r = rows[i];
        const v4u* src = (const v4u*)(xbf + ((size_t)blk * TPB + (i >> 2)) * D) + 2 * lane; const v4u a = src[0], b = src[1];
        v4u o; o.x = pk4_fp8(bflo(a.x), bfhi(a.x), bflo(a.y), bfhi(a.y)); o.y = pk4_fp8(bflo(a.z), bfhi(a.z), bflo(a.w), bfhi(a.w)); o.z = pk4_fp8(bflo(b.x), bfhi(b.x), bflo(b.y), bfhi(b.y)); o.w = pk4_fp8(bflo(b.z), bfhi(b.z), bflo(b.w), bfhi(b.w));
        ((v4u*)((unsigned char*)xs + (size_t)r * D))[lane] = o; }
    __syncthreads();
}
__device__ __forceinline__ void phase_ln2(const float* __restrict__ x1, const bf16* __restrict__ yrows, const int* __restrict__ tok_row, const float* __restrict__ tok_w, const float* __restrict__ g, const float* __restrict__ bb,
                                          float* __restrict__ xout, bf16* __restrict__ xbf, int gw, int ngw, int lane) {
    f32x4 gv[4], bv[4];
#pragma unroll
    for (int j = 0; j < 4; ++j) { gv[j] = ((const f32x4*)g)[lane + 64 * j]; bv[j] = ((const f32x4*)bb)[lane + 64 * j]; }
    static_assert(T % (2 * GRID * NWAVES) == 0, "two tokens per wave per step");
    for (int t0 = gw; t0 < T; t0 += 2 * ngw) {
        f32x4 v[2][4];
#pragma unroll
        for (int u = 0; u < 2; ++u) { const int t = t0 + u * ngw; int r[4]; float w[4];
#pragma unroll
            for (int k = 0; k < 4; ++k) { r[k] = tok_row[(size_t)t * 4 + k]; w[k] = tok_w[(size_t)t * 4 + k]; }
            const f32x4* xr = (const f32x4*)(x1 + (size_t)t * D) + lane;
#pragma unroll
            for (int j = 0; j < 4; ++j) { f32x4 f = {0.f, 0.f, 0.f, 0.f};
#pragma unroll
                for (int k = 0; k < 4; ++k) { const v2u yw = ((const v2u*)(yrows + (size_t)r[k] * D))[lane + 64 * j]; f.x += w[k] * bflo(yw.x); f.y += w[k] * bfhi(yw.x); f.z += w[k] * bflo(yw.y); f.w += w[k] * bfhi(yw.y); }
                v[u][j] = xr[64 * j] * DN_ALPHA + f; } }
#pragma unroll
        for (int u = 0; u < 2; ++u) { const int t = t0 + u * ngw;
            ln_row(v[u], gv, bv);
            f32x4* xo = (f32x4*)(xout + (size_t)t * D) + lane; v2u* xb = (v2u*)(xbf + (size_t)t * D) + lane;
#pragma unroll
            for (int j = 0; j < 4; ++j) { xo[64 * j] = v[u][j]; v2u ww; ww.x = pk2(v[u][j].x, v[u][j].y); ww.y = pk2(v[u][j].z, v[u][j].w); xb[64 * j] = ww; } } }
}

struct Args { const float* in[20]; float* out; unsigned char* ws; int l_lo, l_hi, ph_lo, ph_hi; };
typedef const __attribute__((address_space(4))) Args* KArgsP;
#define KA_LOAD() ({ KArgsP p_ = (KArgsP)__builtin_amdgcn_kernarg_segment_ptr(); asm volatile("" : "+s"(p_)); p_; })
#ifndef PHMASK
#define PHMASK 0xFFFF
#endif
#ifndef REPEAT_MASK
#define REPEAT_MASK 0
#endif
#ifndef REPEAT_LMASK
#define REPEAT_LMASK 0xF
#endif
#define PH_BEGIN(k) _Pragma("unroll") for (int rep_ = 0; rep_ < ((((REPEAT_MASK >> (k)) & 1) && ((REPEAT_LMASK >> l) & 1)) ? 2 : 1); ++rep_) { if ((PHMASK >> (k)) & 1) { KArgsP ka = KA_LOAD(); unsigned char* ws = ka->ws; int tid = threadIdx.x; asm volatile("" : "+v"(tid)); \
    const int lane = tid & 63, wave = __builtin_amdgcn_readfirstlane(tid >> 6); int blk = blockIdx.x; asm volatile("" : "+s"(blk)); \
    const int gw = blk * NWAVES + wave; const size_t gtid = (size_t)blk * NTHR + tid; (void)lane; (void)gw; (void)gtid; (void)ws;
#if ONE_LAUNCH
#define PH_SEAM() do { XcdBarrier b_; b_.bar = (unsigned*)(KA_LOAD()->ws + WS_CTL) + CW_BAR; b_.x = xb_xcc_id(); b_.st = (volatile LAS unsigned*)(lds + MISC_OFF); xcd_barrier(b_); } while (0)
#else
#define PH_SEAM() do {} while (0)
#endif
#define PH_END() PH_SEAM(); } }
#define PH_END_NOSEAM() } }
#define WSP(type, off) ((type*)(ws + (off)))
constexpr int G = GRID, NGW = GRID * NWAVES; constexpr size_t GTHREADS = (size_t)GRID * NTHR;
template <int L> __device__ __forceinline__ void layer_phases(LAS unsigned char* lds) {
    constexpr int l = L; LAS int* tabL = (LAS int*)(lds + MISC_OFF + 256);

        const int j = l >> 1; const bool moba = (l & 1) != 0;
        const int NC = moba ? NC_M : NC_H, qoff = moba ? 2304 : 3072;

        PH_BEGIN(1)
            const float* win_src = moba ? ka->in[5] + (size_t)j * D * NC_M : ka->in[2] + (size_t)j * D * NC_H;
            const size_t moff = (size_t)l * NE * 1024 * 1024;
            phase_weights((LAS float*)(lds + wave * 16384), gw, NGW, lane, win_src, NC, ka->in[6] + (size_t)l * D * 512, ka->in[7] + (size_t)l * D * D,
                          ka->in[12] + moff, ka->in[14] + moff, ka->in[16] + moff, WSP(bf16, WS_WIN), WSP(bf16, WS_WKV), WSP(bf16, WS_WO), WSP(bf16, WS_WGU), WSP(bf16, WS_WD));
        PH_END()
        PH_BEGIN(2)
            { pg8::Gemm g{WSP(bf16, WS_XBF), WSP(bf16, WS_WIN), T, NC, D, 0, 0}; pg8::StaticOrder S; S.init(T, NC, G, blk); pg8::EpiPlain E{WSP(bf16, WS_H), NC};
              pg8::gemm_phase<pg8::EpiPlain, pg8::StaticOrder, true, true>(lds, g, S, E); }
            { pg8::Gemm g{WSP(bf16, WS_MEMBF), WSP(bf16, WS_WKV), 512, 512, D, 0, 0}; pg8::StaticOrder S; S.init(512, 512, G, blk); pg8::EpiPlain E{WSP(bf16, WS_KV), 512};
              pg8::gemm_phase<pg8::EpiPlain, pg8::StaticOrder, true, true>(lds, g, S, E); }
        PH_END()
        if (!moba) {
            PH_BEGIN(3)
                for (int u = blk; u < NBATCH * HG_H * HNSEG; u += G) hgrn_seg<false>(lds, WSP(bf16, WS_H), ka->in[3], j, ka->in[4] + j * 128, WSP(float, WS_SLOC), WSP(float, WS_DSEG), WSP(bf16, WS_MIX), u, tid, wave, lane);
                for (int u = blk; u < 512; u += G) memattn_unit2(lds, WSP(bf16, WS_H), NC, qoff, WSP(bf16, WS_KV), WSP(bf16, WS_MIX), u, tid, wave, lane);
            PH_END()
            PH_BEGIN(4)
                hgrn_scan(WSP(float, WS_SLOC), WSP(float, WS_DSEG), gtid, GTHREADS);
            PH_END()
            PH_BEGIN(5)
                for (int u = blk; u < NBATCH * HG_H * HNSEG; u += G) hgrn_seg<true>(lds, WSP(bf16, WS_H), ka->in[3], j, ka->in[4] + j * 128, WSP(float, WS_SLOC), WSP(float, WS_DSEG), WSP(bf16, WS_MIX), u, tid, wave, lane);
            PH_END()
        } else {
            PH_BEGIN(3)
                for (int u = blk; u < 24 * MB_NB; u += G) kmean_unit(lds, WSP(bf16, WS_H), WSP(float, WS_KMEAN), u, tid);
                for (int u = blk; u < 512; u += G) memattn_unit2(lds, WSP(bf16, WS_H), NC, qoff, WSP(bf16, WS_KV), WSP(bf16, WS_MIX), u, tid, wave, lane);
            PH_END()
            PH_BEGIN(4)
                for (int u = blk; u < 24 * MB_NB; u += G) moba_gate_unit(lds, WSP(bf16, WS_H), WSP(float, WS_KMEAN), WSP(unsigned, WS_CTL) + CW_GCOUNT + j * 1536, WSP(int, WS_SELINFO), WSP(unsigned, WS_LIST), u, tid);
            PH_END()
            PH_BEGIN(5)
                for (int r = 0; r * G < 24 * MB_NB; ++r) { const int it = r * G + ((r & 1) ? (G - 1 - blk) : blk);
                    if (it < 24 * MB_NB) moba_attn_item2(lds, WSP(bf16, WS_H), WSP(unsigned, WS_CTL) + CW_GCOUNT + j * 1536, WSP(unsigned, WS_LIST), WSP(float, WS_PO), WSP(float, WS_PML), it, tid, wave, lane); }
            PH_END()
            PH_BEGIN(6)
                moba_combine(WSP(float, WS_PO), WSP(float, WS_PML), WSP(int, WS_SELINFO), WSP(bf16, WS_MIX), gw, NGW, lane);
            PH_END()
        }
        PH_BEGIN(7)
            pg8::Gemm g{WSP(bf16, WS_MIX), WSP(bf16, WS_WO), T, D, D, 0, 0}; pg8::StaticOrder S; S.init(T, D, G, blk); pg8::EpiPlain E{WSP(bf16, WS_Y), D};
            pg8::gemm_phase<pg8::EpiPlain, pg8::StaticOrder, true, true>(lds, g, S, E);
        PH_END()
        PH_BEGIN(8)
            const float* xin = (l == 0) ? ka->in[0] : WSP(float, WS_XA);
            phase_ln1(lds, xin, WSP(bf16, WS_Y), ka->in[8] + l * D, ka->in[9] + l * D, ka->in[10] + (size_t)l * D * NE, ka->in[11] + l * NE, WSP(float, WS_XB), WSP(bf16, WS_XBF),
                      WSP(int, WS_TOK + TOK_E), WSP(int, WS_TOK + TOK_LR), WSP(float, WS_TOK + TOK_W), WSP(int, WS_TOK + TOK_BLKCNT), blk, tid, wave, lane);
        PH_END()
        PH_BEGIN(9)
            phase_dispatch(lds, WSP(int, WS_TOK + TOK_BLKCNT), WSP(int, WS_TOK + TOK_E), WSP(int, WS_TOK + TOK_LR), WSP(int, WS_TOK + TOK_ROW), WSP(int, WS_TOK + TOK_TAB), WSP(bf16, WS_XBF), WSP(bf16, WS_XS), blk, tid, wave, lane);
        PH_END()
        PH_BEGIN(10)
            if (tid < 33) tabL[tid] = WSP(int, WS_TOK + TOK_TAB)[tid];
            __syncthreads();
            int sw_ = 0x7A7A7A7A, sx_ = 0x7F7F7F7F; asm volatile("" : "+s"(sw_), "+s"(sx_));
            pg8::Gemm g{WSP(bf16, WS_XS), WSP(bf16, WS_WGU), MOE_MAXROWS, NE * 2048, D / 2, sw_, sx_}; pg8::MoeOrder S{tabL, 8, G, blk, tabL[32] * 8};
            pg8::EpiSwiglu E{WSP(bf16, WS_HID), ka->in[13] + (size_t)l * NE * 1024, ka->in[15] + (size_t)l * NE * 1024};
            pg8::gemm_phase<pg8::EpiSwiglu, pg8::MoeOrder, false, true, true>(lds, g, S, E);
        PH_END()
        PH_BEGIN(11)
            if (tid < 33) tabL[tid] = WSP(int, WS_TOK + TOK_TAB)[tid];
            __syncthreads();
            pg8::Gemm g{WSP(bf16, WS_HID), WSP(bf16, WS_WD), MOE_MAXROWS, NE * 1024, D, 0, 0}; pg8::MoeOrder S{tabL, 4, G, blk, tabL[32] * 4};
            pg8::EpiDown E{WSP(bf16, WS_XS), ka->in[17] + (size_t)l * NE * 1024};
            pg8::gemm_phase<pg8::EpiDown, pg8::MoeOrder, true, true>(lds, g, S, E);
        PH_END()
        PH_BEGIN(12)
            float* x2out = (l == DEPTH - 1) ? ka->out : WSP(float, WS_XA);
            phase_ln2(WSP(float, WS_XB), WSP(bf16, WS_XS), WSP(int, WS_TOK + TOK_ROW), WSP(float, WS_TOK + TOK_W), ka->in[18] + l * D, ka->in[19] + l * D, x2out, WSP(bf16, WS_XBF), gw, NGW, lane);
            if (l + 1 < DEPTH) PH_SEAM();
        PH_END_NOSEAM()
}
__global__ void __launch_bounds__(NTHR, 2) fwd_kernel(Args args) {
    extern __shared__ __attribute__((aligned(16))) unsigned char lds_raw[];
    LAS unsigned char* lds = (LAS unsigned char*)lds_raw;
    if (threadIdx.x < 4) ((LAS unsigned*)(lds + MISC_OFF))[threadIdx.x] = 0u;
    __syncthreads();
#if ONE_LAUNCH
    (void)xcd_barrier_post((unsigned*)(args.ws + WS_CTL) + CW_BAR, (volatile LAS unsigned*)(lds + MISC_OFF));
#endif
    { const int l = 0; (void)l;
    PH_BEGIN(0)
        cvt_rows_bf16(ka->in[0], WSP(bf16, WS_XBF), (size_t)T * D / 8, gtid, GTHREADS);
        cvt_rows_bf16(ka->in[1], WSP(bf16, WS_MEMBF), (size_t)512 * D / 8, gtid, GTHREADS);
    PH_END_NOSEAM() }
    layer_phases<0>(lds); layer_phases<1>(lds); layer_phases<2>(lds); layer_phases<3>(lds);
}

extern "C" void kernel_launch(void* const* d_in, const int* in_sizes, int n_in, void* d_out, int out_size, void* d_ws, size_t ws_size, hipStream_t stream) {
    static int ready = 0;
    if (ready == 0) {
        if (n_in != 20 || in_sizes[0] != T * D || out_size != T * D || ws_size < WS_END) { fprintf(stderr, "kernel_launch: unexpected shapes (n_in %d, in0 %d, out %d, ws %zu < %zu)\n", n_in, n_in > 0 ? in_sizes[0] : -1, out_size, ws_size, (size_t)WS_END); ready = -1; return; }
        if (hipFuncSetAttribute((const void*)fwd_kernel, hipFuncAttributeMaxDynamicSharedMemorySize, LDS_BYTES) != hipSuccess) { fprintf(stderr, "kernel_launch: hipFuncSetAttribute failed\n"); ready = -1; return; }
        int per_cu = 0;
        if (hipOccupancyMaxActiveBlocksPerMultiprocessor(&per_cu, (const void*)fwd_kernel, NTHR, LDS_BYTES) != hipSuccess || per_cu < 1) fprintf(stderr, "kernel_launch: occupancy query says %d\n", per_cu);
        (void)hipGetLastError();
        ready = 1;
    }
    if (ready < 0) return;
    if (hipMemsetAsync((char*)d_ws + WS_CTL, 0, CTL_ZERO_BYTES, stream) != hipSuccess) return;
    Args a{};
    for (int i = 0; i < 20; ++i) a.in[i] = (const float*)d_in[i];
    a.out = (float*)d_out; a.ws = (unsigned char*)d_ws;
    a.l_lo = 0; a.l_hi = DEPTH; a.ph_lo = 0; a.ph_hi = NPHASE;
    hipLaunchKernelGGL(fwd_kernel, dim3(GRID), dim3(NTHR), LDS_BYTES, stream, a);
}
```

```cpp
#include <hip/hip_runtime.h>
#include <cstdio>
#include <cstdint>
#include <cmath>
namespace pg8 {
#define PG8_LAS __attribute__((address_space(3)))
typedef unsigned short bf16_t;
typedef short bf16x8 __attribute__((ext_vector_type(8)));
typedef float f32x4 __attribute__((ext_vector_type(4)));
typedef unsigned u32x4 __attribute__((ext_vector_type(4)));
constexpr int BM = 256, BK = 64, HALF = 128, HTB = HALF * BK * 2  , STAGE_BYTES = 8 * HTB, NXCD = 8, WGM = 8;

__host__ __device__ __forceinline__ int lds_byte(int r, int c) { const int st = (r >> 4) * 2 + (c >> 5), rr = r & 15, cc = c & 31, ob = rr * 64 + cc * 2; return st * 1024 + (ob ^ (((ob >> 9) & 1) << 5)); }
__host__ __device__ __forceinline__ void stage_rc(int b, int& R, int& C) { const int st = b / 1024, sb = b % 1024, swz = sb ^ (((sb >> 9) & 1) << 5); R = (st >> 1) * 16 + swz / 64; C = (st & 1) * 32 + (swz % 64) / 2; }
__host__ __device__ __forceinline__ int perm32(int rho) { const int n = rho >> 4, i = rho & 15; return 8 * (i >> 2) + 4 * n + (i & 3); }

struct Unit { int pm, pn; };
struct Gemm { const bf16_t* A; const bf16_t* Bt; int M, N, K; int sw, sx; };
typedef int i32x8 __attribute__((ext_vector_type(8))); typedef int i32x4 __attribute__((ext_vector_type(4)));

struct StaticOrder {
    int nM, nN, nwg, G, c;
    __host__ __device__ void init(int M, int N, int G_, int c_) { nM = M / BM; nN = N / BM; nwg = nM * nN; G = G_; c = c_; }
    __host__ __device__ bool next(int i, Unit& u) const {
        const long L = (long)i * G + c; if (L >= nwg) return false;
        int wgid = (int)L; { const int q = nwg / NXCD, r = nwg % NXCD, xcd = wgid % NXCD, off = wgid / NXCD; wgid = (xcd < r ? xcd * (q + 1) : r * (q + 1) + (xcd - r) * q) + off; }
        const int nig = WGM * nN, gid = wgid / nig, fm = gid * WGM, gsz = (nM - fm) < WGM ? (nM - fm) : WGM;
        u.pm = fm + ((wgid % nig) % gsz); u.pn = (wgid % nig) / gsz; return true;
    }
    __device__ __forceinline__ void a_ready(const Unit&) const {}
    __device__ __forceinline__ void done(const Unit&) const {}
};

__device__ __forceinline__ unsigned cvt_pk_bf16(float lo, float hi) { unsigned r; asm volatile("v_cvt_pk_bf16_f32 %0, %1, %2" : "=v"(r) : "v"(lo), "v"(hi)); return r; }
typedef float f32x2 __attribute__((ext_vector_type(2)));
struct EpiPlain {
    static constexpr bool PERM = true, AFTER_DRAIN = false;
    bf16_t* O; int ldc;
    __device__ __forceinline__ void operator()(const f32x4 (&acc)[2][2][4][2], const Unit& u, int wr, int wc, int fr, int fq) const {
        const int row0 = u.pm * BM + wr * 64 + fr; const int col0 = u.pn * BM + wc * 32 + 8 * fq;
#pragma unroll
        for (int ai = 0; ai < 2; ++ai)
#pragma unroll
            for (int m = 0; m < 4; ++m) { bf16_t* rowp = O + (size_t)(row0 + ai * HALF + m * 16) * ldc + col0;
#pragma unroll
                for (int bj = 0; bj < 2; ++bj) { const f32x4 v0 = acc[ai][bj][m][0], v1 = acc[ai][bj][m][1];
                    u32x4 w; w.x = cvt_pk_bf16(v0[0], v0[1]); w.y = cvt_pk_bf16(v0[2], v0[3]); w.z = cvt_pk_bf16(v1[0], v1[1]); w.w = cvt_pk_bf16(v1[2], v1[3]);
                    *(u32x4*)(rowp + bj * HALF) = w; } }
    }
};
__device__ __forceinline__ float swiglu1(float g, float u) {
    g = fminf(g, 7.0f); u = fminf(fmaxf(u, -7.0f), 7.0f);
    const float s = __builtin_amdgcn_rcpf(1.0f + __builtin_amdgcn_exp2f(g * (-1.702f * 1.4426950408889634f)));
    return g * s * (u + 1.0f);
}
__device__ __forceinline__ unsigned pk4_fp8e(float a, float b, float c, float d) { int w = 0; w = __builtin_amdgcn_cvt_pk_fp8_f32(a, b, w, false); w = __builtin_amdgcn_cvt_pk_fp8_f32(c, d, w, true); return (unsigned)w; }
struct EpiSwiglu {
    static constexpr bool PERM = true, AFTER_DRAIN = false;
    unsigned char* hid; const float* bg; const float* bu;
    __device__ __forceinline__ void operator()(const f32x4 (&acc)[2][2][4][2], const Unit& u, int wr, int wc, int fr, int fq) const {
        const int e = u.pn >> 3, pn = u.pn & 7;
        const int row0 = u.pm * BM + wr * 64 + fr; const int col0 = pn * 128 + wc * 32 + 8 * fq;
        const f32x4 g0 = *(const f32x4*)(bg + e * 1024 + col0), g1 = *(const f32x4*)(bg + e * 1024 + col0 + 4);
        const f32x4 u0 = *(const f32x4*)(bu + e * 1024 + col0), u1 = *(const f32x4*)(bu + e * 1024 + col0 + 4);
#pragma unroll
        for (int ai = 0; ai < 2; ++ai)
#pragma unroll
            for (int m = 0; m < 4; ++m) { unsigned char* rowp = hid + (size_t)(row0 + ai * HALF + m * 16) * 1024 + col0;
                const f32x4 ga = acc[ai][0][m][0] + g0, gb = acc[ai][0][m][1] + g1, ua = acc[ai][1][m][0] + u0, ub = acc[ai][1][m][1] + u1;
                typedef unsigned u32x2 __attribute__((ext_vector_type(2))); u32x2 w;
                w.x = pk4_fp8e(swiglu1(ga[0], ua[0]), swiglu1(ga[1], ua[1]), swiglu1(ga[2], ua[2]), swiglu1(ga[3], ua[3]));
                w.y = pk4_fp8e(swiglu1(gb[0], ub[0]), swiglu1(gb[1], ub[1]), swiglu1(gb[2], ub[2]), swiglu1(gb[3], ub[3]));
                *(u32x2*)rowp = w; }
    }
};
struct EpiDown {
    static constexpr bool PERM = true, AFTER_DRAIN = false;
    bf16_t* y; const float* bd;
    __device__ __forceinline__ void operator()(const f32x4 (&acc)[2][2][4][2], const Unit& u, int wr, int wc, int fr, int fq) const {
        const int e = u.pn >> 2, pn = u.pn & 3;
        const int row0 = u.pm * BM + wr * 64 + fr; const int col0 = pn * BM + wc * 32 + 8 * fq;
        f32x4 bv[2][2];
#pragma unroll
        for (int bj = 0; bj < 2; ++bj)
#pragma unroll
            for (int n = 0; n < 2; ++n) bv[bj][n] = *(const f32x4*)(bd + e * 1024 + col0 + bj * HALF + 4 * n);
#pragma unroll
        for (int ai = 0; ai < 2; ++ai)
#pragma unroll
            for (int m = 0; m < 4; ++m) { bf16_t* rowp = y + (size_t)(row0 + ai * HALF + m * 16) * 1024 + col0;
#pragma unroll
                for (int bj = 0; bj < 2; ++bj) { const f32x4 v0 = acc[ai][bj][m][0] + bv[bj][0], v1 = acc[ai][bj][m][1] + bv[bj][1];
                    u32x4 w; w.x = cvt_pk_bf16(v0[0], v0[1]); w.y = cvt_pk_bf16(v0[2], v0[3]); w.z = cvt_pk_bf16(v1[0], v1[1]); w.w = cvt_pk_bf16(v1[2], v1[3]);
                    *(u32x4*)(rowp + bj * HALF) = w; } }
    }
};
struct MoeOrder {
    const PG8_LAS int* tab; int npn, G, c, nunits;
    __device__ __forceinline__ bool next(int i, Unit& u) const {
        const int tpx = 32 / npn, s = c >> 3, tile = (i * 8 + (c & 7)) * tpx + s / npn, pn = s % npn;
        if ((i * 8) * tpx >= nunits / npn) return false;
        if (tile >= nunits / npn) { u.pm = 0; u.pn = 0; return false; }
        int e = 0;
#pragma unroll
        for (int k = 1; k < 32; ++k) e += (tab[k] <= tile) ? 1 : 0;
        u.pm = tile; u.pn = __builtin_amdgcn_readfirstlane(e) * npn + pn; return true;
    }
    __device__ __forceinline__ void a_ready(const Unit&) const {}
    __device__ __forceinline__ void done(const Unit&) const {}
};
template <class Epi, class Sched, bool ALIGN_EPI = false, bool SP2 = false, bool F8 = false>
__device__ __forceinline__ void gemm_phase(PG8_LAS unsigned char* lds, const Gemm g, const Sched& S, const Epi& E) {
    int tid_ = threadIdx.x; asm volatile("" : "+v"(tid_));
    const int tid = tid_, wid = __builtin_amdgcn_readfirstlane(tid >> 6), lane = tid & 63, wr = wid >> 2, wc = wid & 3, fr = lane & 15, fq = lane >> 4;
    const int K = g.K, nt = K / BK;
    unsigned voffA, voffB;
    { int R, C; stage_rc(tid * 16, R, C); const int Rb = Epi::PERM ? ((R & ~31) + perm32(R & 31)) : R; voffA = (unsigned)(R * K + C) * 2u; voffB = (unsigned)(Rb * K + C) * 2u; }
    const unsigned qstep = 64u * (unsigned)K * 2u;
    const unsigned kstep = (unsigned)(BK * 2);
    const unsigned hstep = (unsigned)HALF * (unsigned)K * 2u;
    const unsigned tstep = 2u * hstep;
    const __amdgpu_buffer_rsrc_t rA = __builtin_amdgcn_make_buffer_rsrc((void*)g.A, 0, 0x7FFFFFFF, 0x00020000), rB = __builtin_amdgcn_make_buffer_rsrc((void*)g.Bt, 0, 0x7FFFFFFF, 0x00020000);
    const unsigned ldsw = (unsigned)wid * 1024u;
    const int aoff = lds_byte(wr * 64 + fr, fq * 8), boff = lds_byte(wc * 32 + fr, fq * 8);
#define PG8_SA(b, h) (((b) * 2 + (h)) * HTB)
#define PG8_SB(b, h) ((4 + (b) * 2 + (h)) * HTB)
#define PG8_STG(bufoff, rsrc, soff, voff) do { _Pragma("unroll") for (int _i = 0; _i < 2; ++_i) \
        __builtin_amdgcn_raw_ptr_buffer_load_lds((rsrc), (PG8_LAS void*)(lds + (bufoff) + ldsw + _i * 8192), 16, (int)(voff), (int)((soff) + (unsigned)_i * qstep), 0, 0); } while (0)
#define PG8_STGA(bufoff, soff) PG8_STG(bufoff, rA, soff, voffA)
#define PG8_STGB(bufoff, soff) PG8_STG(bufoff, rB, soff, voffB)
#define PG8_LDA(dst, b, h) do { _Pragma("unroll") for (int m = 0; m < 4; ++m) { if constexpr (F8) { const i32x4 lo_ = *(const PG8_LAS i32x4*)(lds + PG8_SA(b, h) + aoff + m * 2048), hi_ = *(const PG8_LAS i32x4*)(lds + PG8_SA(b, h) + aoff + m * 2048 + 1024); \
            dst##_8[m] = __builtin_shufflevector(lo_, hi_, 0, 1, 2, 3, 4, 5, 6, 7); } else { _Pragma("unroll") for (int k = 0; k < 2; ++k) dst[m][k] = *(const PG8_LAS bf16x8*)(lds + PG8_SA(b, h) + aoff + m * 2048 + k * 1024); } } } while (0)
#define PG8_LDB(dst, b, h) do { _Pragma("unroll") for (int n = 0; n < 2; ++n) { if constexpr (F8) { const i32x4 lo_ = *(const PG8_LAS i32x4*)(lds + PG8_SB(b, h) + boff + n * 2048), hi_ = *(const PG8_LAS i32x4*)(lds + PG8_SB(b, h) + boff + n * 2048 + 1024); \
            dst##_8[n] = __builtin_shufflevector(lo_, hi_, 0, 1, 2, 3, 4, 5, 6, 7); } else { _Pragma("unroll") for (int k = 0; k < 2; ++k) dst[n][k] = *(const PG8_LAS bf16x8*)(lds + PG8_SB(b, h) + boff + n * 2048 + k * 1024); } } } while (0)
#define PG8_MMA(ai, bj, At, Bt) do { __builtin_amdgcn_s_setprio(1); _Pragma("unroll") for (int m = 0; m < 4; ++m) _Pragma("unroll") for (int n = 0; n < 2; ++n) { \
        if constexpr (F8) acc[ai][bj][m][n] = __builtin_amdgcn_mfma_scale_f32_16x16x128_f8f6f4(Bt##_8[n], At##_8[m], acc[ai][bj][m][n], 0, 0, 0, g.sw, 0, g.sx); \
        else { _Pragma("unroll") for (int k = 0; k < 2; ++k) acc[ai][bj][m][n] = __builtin_amdgcn_mfma_f32_16x16x32_bf16(Bt[n][k], At[m][k], acc[ai][bj][m][n], 0, 0, 0); } } \
        __builtin_amdgcn_s_setprio(0); } while (0)
#define PG8_WAIT_V(n) asm volatile("s_waitcnt vmcnt(" #n ")" ::: "memory")
#define PG8_WAIT_L(n) asm volatile("s_waitcnt lgkmcnt(" #n ")" ::: "memory")
#define PG8_BAR __builtin_amdgcn_s_barrier()
#define PG8_SCHED __builtin_amdgcn_sched_barrier(0)
    Unit cur, nxt; int ui = 0;
    if (!S.next(0, cur)) return;
    f32x4 acc[2][2][4][2];
#pragma unroll
    for (int a = 0; a < 2; ++a)
#pragma unroll
        for (int b = 0; b < 2; ++b)
#pragma unroll
            for (int m = 0; m < 4; ++m)
#pragma unroll
                for (int n = 0; n < 2; ++n) acc[a][b][m][n] = (f32x4){0.f, 0.f, 0.f, 0.f};
    bf16x8 At[4][2], B0[2][2], B1[2][2]; i32x8 At_8[4], B0_8[2], B1_8[2];
    unsigned cA = (unsigned)cur.pm * tstep, cB = (unsigned)cur.pn * tstep;
    S.a_ready(cur);
    if constexpr (SP2) {
        PG8_STGB(PG8_SB(0, 0), cB); PG8_STGB(PG8_SB(0, 1), cB + hstep); PG8_STGA(PG8_SA(0, 0), cA); PG8_STGA(PG8_SA(0, 1), cA + hstep);
        if (wr == 1) PG8_BAR;
        PG8_WAIT_V(2); PG8_BAR;
        PG8_STGB(PG8_SB(1, 0), cB + kstep); PG8_STGA(PG8_SA(1, 0), cA + kstep); PG8_STGB(PG8_SB(1, 1), cB + hstep + kstep);
        PG8_WAIT_V(6); PG8_BAR;
    } else {
        PG8_STGB(PG8_SB(0, 0), cB); PG8_STGA(PG8_SA(0, 0), cA); PG8_STGB(PG8_SB(0, 1), cB + hstep); PG8_STGA(PG8_SA(0, 1), cA + hstep);
        if (wr == 1) PG8_BAR;
        PG8_WAIT_V(4); PG8_BAR;
        PG8_STGB(PG8_SB(1, 0), cB + kstep); PG8_STGA(PG8_SA(1, 0), cA + kstep); PG8_STGB(PG8_SB(1, 1), cB + hstep + kstep);
        PG8_WAIT_V(6); PG8_BAR;
    }
    for (;;) {
        const bool has_next = S.next(ui + 1, nxt);
        const unsigned nA = has_next ? (unsigned)nxt.pm * tstep : cA, nB = has_next ? (unsigned)nxt.pn * tstep : cB;
#pragma unroll 1
        for (int t = 0; t < nt; t += 2) {
            const bool last = (t == nt - 2);
            const unsigned a1 = cA + (unsigned)(t + 1) * kstep;
            const unsigned a2 = last ? nA : cA + (unsigned)(t + 2) * kstep, b2 = last ? nB : cB + (unsigned)(t + 2) * kstep;
            const unsigned a3 = a2 + kstep, b3 = b2 + kstep;
            if (last && has_next) S.a_ready(nxt);
            if constexpr (SP2) {
            PG8_LDB(B0, 0, 0); PG8_LDB(B1, 0, 1); PG8_SCHED; PG8_LDA(At, 0, 0); PG8_STGA(PG8_SA(1, 1), a1 + hstep);
            PG8_WAIT_V(8); PG8_WAIT_L(0); PG8_BAR; PG8_MMA(0, 0, At, B0); PG8_MMA(0, 1, At, B1); PG8_BAR; PG8_SCHED;
            PG8_LDA(At, 0, 1); PG8_STGB(PG8_SB(0, 0), b2); PG8_STGB(PG8_SB(0, 1), b2 + hstep); PG8_STGA(PG8_SA(0, 0), a2);
            PG8_WAIT_V(8); PG8_WAIT_L(0); PG8_BAR; PG8_MMA(1, 0, At, B0); PG8_MMA(1, 1, At, B1); PG8_BAR; PG8_SCHED;
            PG8_LDB(B0, 1, 0); PG8_LDB(B1, 1, 1); PG8_SCHED; PG8_LDA(At, 1, 0); PG8_STGA(PG8_SA(0, 1), a2 + hstep);
            PG8_WAIT_V(8); PG8_WAIT_L(0); PG8_BAR; PG8_MMA(0, 0, At, B0); PG8_MMA(0, 1, At, B1); PG8_BAR; PG8_SCHED;
            PG8_LDA(At, 1, 1); PG8_STGB(PG8_SB(1, 0), b3); PG8_STGB(PG8_SB(1, 1), b3 + hstep); PG8_STGA(PG8_SA(1, 0), a3);
            PG8_WAIT_V(8); PG8_WAIT_L(0); PG8_BAR; PG8_MMA(1, 0, At, B0); PG8_MMA(1, 1, At, B1); PG8_BAR; PG8_SCHED;
            } else {
            PG8_LDB(B0, 0, 0); PG8_SCHED; PG8_LDA(At, 0, 0); PG8_STGA(PG8_SA(1, 1), a1 + hstep);
            PG8_WAIT_L(8); PG8_BAR; PG8_WAIT_L(0); PG8_MMA(0, 0, At, B0); PG8_BAR; PG8_SCHED;
            PG8_LDB(B1, 0, 1); PG8_STGB(PG8_SB(0, 0), b2);
            PG8_BAR; PG8_WAIT_L(0); PG8_MMA(0, 1, At, B1); PG8_BAR;
            PG8_LDA(At, 0, 1); PG8_STGA(PG8_SA(0, 0), a2);
            PG8_BAR; PG8_WAIT_L(0); PG8_MMA(1, 0, At, B0); PG8_BAR; PG8_SCHED;
            PG8_STGB(PG8_SB(0, 1), b2 + hstep);
            PG8_WAIT_V(6); PG8_BAR; PG8_MMA(1, 1, At, B1); PG8_BAR;
            PG8_LDB(B0, 1, 0); PG8_SCHED; PG8_LDA(At, 1, 0); PG8_STGA(PG8_SA(0, 1), a2 + hstep);
            PG8_WAIT_L(8); PG8_BAR; PG8_WAIT_L(0); PG8_MMA(0, 0, At, B0); PG8_BAR; PG8_SCHED;
            PG8_LDB(B1, 1, 1); PG8_STGB(PG8_SB(1, 0), b3);
            PG8_BAR; PG8_WAIT_L(0); PG8_MMA(0, 1, At, B1); PG8_BAR;
            PG8_LDA(At, 1, 1); PG8_STGA(PG8_SA(1, 0), a3);
            PG8_BAR; PG8_WAIT_L(0); PG8_MMA(1, 0, At, B0); PG8_BAR; PG8_SCHED;
            PG8_STGB(PG8_SB(1, 1), b3 + hstep);
            PG8_WAIT_V(6); PG8_BAR; PG8_MMA(1, 1, At, B1); PG8_BAR;
            }
        }
        if constexpr (ALIGN_EPI) { if (wr == 0) PG8_BAR; }
        if constexpr (!Epi::AFTER_DRAIN) { int t2_ = threadIdx.x; asm volatile("" : "+v"(t2_)); E(acc, cur, wr, wc, t2_ & 15, (t2_ & 63) >> 4); S.done(cur); }
        if (!has_next) break;
#pragma unroll
        for (int a = 0; a < 2; ++a)
#pragma unroll
            for (int b = 0; b < 2; ++b)
#pragma unroll
                for (int m = 0; m < 4; ++m)
#pragma unroll
                    for (int n = 0; n < 2; ++n) acc[a][b][m][n] = (f32x4){0.f, 0.f, 0.f, 0.f};
        cur = nxt; cA = nA; cB = nB; ++ui;
        if constexpr (ALIGN_EPI) { if (wr == 1) PG8_BAR; }
    }
    PG8_WAIT_V(0);
    if constexpr (!ALIGN_EPI) { if (wr == 0) PG8_BAR; }
    PG8_BAR;
    if constexpr (Epi::AFTER_DRAIN) { E.fused(acc, cur, wr, wc, fr, fq, lds, wid, lane); S.done(cur); }
#undef PG8_SA
#undef PG8_SB
#undef PG8_STG
#undef PG8_STGA
#undef PG8_STGB
#undef PG8_LDA
#undef PG8_LDB
#undef PG8_MMA
#undef PG8_WAIT_V
#undef PG8_WAIT_L
#undef PG8_BAR
#undef PG8_SCHED
}
}

constexpr int NWAVES = 8, NTHR = 512, GRID = 256;
constexpr int NBATCH = 2, SEQ = 16384, T = NBATCH * SEQ, D = 1024, DEPTH = 4;
constexpr int MIXW = 768, NC_H = 3328, NC_M = 2560;
constexpr int HG_H = 6;
constexpr int HSEG = 256, HNSEG = SEQ / HSEG;
constexpr int MB_H = 12, MB_NB = 64;
constexpr int NE = 32;
constexpr float DN_ALPHA = 1.6817928305074290f;
constexpr int MOE_MAXROWS = T * 4 + NE * 256;
#ifndef ONE_LAUNCH
#define ONE_LAUNCH 1
#endif
constexpr int NPHASE = 13;

constexpr size_t MiB = 1u << 20;
constexpr size_t WS_CTL = 0, CTL_ZERO_BYTES = 1 * MiB;
constexpr size_t WS_WIN = 1 * MiB, WS_WKV = 9 * MiB, WS_WO = 10 * MiB, WS_WGU = 12 * MiB, WS_WD = 140 * MiB;
constexpr size_t WS_XBF = 204 * MiB, WS_XA = 268 * MiB, WS_XB = 396 * MiB, WS_MEMBF = 524 * MiB, WS_KV = 525 * MiB;
constexpr size_t WS_H = 526 * MiB, WS_MIX = 734 * MiB, WS_Y = 798 * MiB, WS_SLOC = 862 * MiB, WS_DSEG = 910 * MiB, WS_KMEAN = 911 * MiB;
constexpr size_t WS_SELINFO = 912 * MiB, WS_TOK = 914 * MiB, WS_R1 = 918 * MiB;
constexpr size_t WS_LIST = WS_R1, WS_PML = WS_R1 + 96 * MiB, WS_PO = WS_R1 + 108 * MiB;
constexpr size_t WS_XS = WS_R1, WS_HID = WS_R1 + 272 * MiB;
constexpr size_t WS_END = WS_R1 + 544 * MiB;
static_assert((size_t)MOE_MAXROWS * 1024 * 2 <= 272 * MiB, "moe rows");
static_assert((size_t)T * MB_H * 4 * 64 * 4 <= 384 * MiB && (size_t)24 * 64 * 16384 * 4 <= 96 * MiB, "moba bufs");
constexpr size_t TOK_E = 0, TOK_LR = 512 * 1024, TOK_W = 1024 * 1024, TOK_ROW = 1536 * 1024, TOK_BLKCNT = 2048 * 1024, TOK_TAB = 2048 * 1024 + 65536;
constexpr int CW_BAR = 4096, CW_GCOUNT = 8192;

constexpr int RING_BYTES = 131072, MISC_OFF = RING_BYTES, LDS_BYTES = 147456;

#define GAS __attribute__((address_space(1)))
#define LAS __attribute__((address_space(3)))
typedef unsigned short bf16;
typedef unsigned v4u __attribute__((ext_vector_type(4)));
typedef unsigned v2u __attribute__((ext_vector_type(2)));
typedef float f32x4 __attribute__((ext_vector_type(4)));
typedef float f32x2 __attribute__((ext_vector_type(2)));
#define LDS_WAIT() asm volatile("s_waitcnt lgkmcnt(0)" ::: "memory")
__device__ __forceinline__ unsigned f2bf(float f) { unsigned u = __builtin_bit_cast(unsigned, f); return (u + 0x7fffu + ((u >> 16) & 1u)) >> 16; }
__device__ __forceinline__ unsigned pk2(float lo, float hi) { return f2bf(lo) | (f2bf(hi) << 16); }
__device__ __forceinline__ float bflo(unsigned w) { return __builtin_bit_cast(float, w << 16); }
__device__ __forceinline__ float bfhi(unsigned w) { return __builtin_bit_cast(float, w & 0xffff0000u); }
__device__ __forceinline__ float bf2f(bf16 h) { return __builtin_bit_cast(float, (unsigned)h << 16); }
__device__ __forceinline__ float sigmoidf_(float z) { return __builtin_amdgcn_rcpf(1.0f + __builtin_amdgcn_exp2f(-1.4426950408889634f * z)); }
template <int X> __device__ __forceinline__ float xorf(float v) { return __builtin_bit_cast(float, __builtin_amdgcn_ds_swizzle(__builtin_bit_cast(int, v), (X << 10) | 0x1F)); }
template <int X> __device__ __forceinline__ int xori(int v) { return __builtin_amdgcn_ds_swizzle(v, (X << 10) | 0x1F); }
__device__ __forceinline__ float wave_sum(float v) {
    v += xorf<1>(v); v += xorf<2>(v); v += xorf<4>(v); v += xorf<8>(v); v += xorf<16>(v);
    return __builtin_bit_cast(float, __builtin_amdgcn_readlane(__builtin_bit_cast(int, v), 0)) + __builtin_bit_cast(float, __builtin_amdgcn_readlane(__builtin_bit_cast(int, v), 32));
}
__device__ __forceinline__ float wave_max(float v) {
    v = fmaxf(v, xorf<1>(v)); v = fmaxf(v, xorf<2>(v)); v = fmaxf(v, xorf<4>(v)); v = fmaxf(v, xorf<8>(v)); v = fmaxf(v, xorf<16>(v));
    return fmaxf(__builtin_bit_cast(float, __builtin_amdgcn_readlane(__builtin_bit_cast(int, v), 0)), __builtin_bit_cast(float, __builtin_amdgcn_readlane(__builtin_bit_cast(int, v), 32)));
}
__device__ __forceinline__ float xor32f(float v, int lane) { return __builtin_bit_cast(float, __builtin_amdgcn_ds_bpermute((lane ^ 32) << 2, __builtin_bit_cast(int, v))); }
#define XB_TMO      128
#define XB_XCNT(j)  (256  + 64 * (j))
#define XB_XSUB(j)  (1280 + 64 * (j))
#define XB_XGEN(j)  (2304 + 64 * (j))
#define XB_TOP      3328
#define XB_TOPGEN   3392
#define XCD_BAR_WORDS 3456
#define XB_SPIN_CAP (1u << 18)

__device__ __forceinline__ unsigned xb_ld(unsigned* p)              { return __hip_atomic_load(p, __ATOMIC_RELAXED, __HIP_MEMORY_SCOPE_AGENT); }
__device__ __forceinline__ unsigned xb_add(unsigned* p, unsigned v) { return __hip_atomic_fetch_add(p, v, __ATOMIC_RELAXED, __HIP_MEMORY_SCOPE_AGENT); }
__device__ __forceinline__ unsigned xb_xcc_id() { return (unsigned)__builtin_amdgcn_s_getreg((3 << 11) | 20) & 0xFu; }
#define XB_SPIN(cond, bar) do { unsigned _sp = 0; while (cond) { __builtin_amdgcn_s_sleep(1); \
    if ((++_sp & 255u) == 0u) { if (xb_ld(&(bar)[XB_TMO])) break; if (_sp > XB_SPIN_CAP) { atomicAdd(&(bar)[XB_TMO], 1u); break; } } } } while (0)

struct XcdBarrier {
    unsigned* bar; unsigned x;
    volatile LAS unsigned* st;
};

__device__ __forceinline__ XcdBarrier xcd_barrier_post(unsigned* bar, volatile LAS unsigned* st) {
    XcdBarrier b; b.bar = bar; b.x = xb_xcc_id(); b.st = st;
    if (threadIdx.x == 0) (void)xb_add(&bar[XB_XCNT(b.x)], 1u);
    return b;
}
__device__ __forceinline__ void xcd_barrier_complete(unsigned* bar, unsigned x, unsigned& nloc, unsigned& nx) {
    const unsigned G = gridDim.x * gridDim.y * gridDim.z;
    unsigned sum, cnt, mine, sp = 0u;
    for (;;) {
        sum = 0u; cnt = 0u; mine = 0u;
#pragma unroll
        for (unsigned j = 0; j < 16; ++j) { const unsigned c = xb_ld(&bar[XB_XCNT(j)]); sum += c; cnt += (c > 0u) ? 1u : 0u; mine = (j == x) ? c : mine; }
        if (sum == G) break;
        __builtin_amdgcn_s_sleep(1);
        if ((++sp & 255u) == 0u) { if (xb_ld(&bar[XB_TMO])) break; if (sp > XB_SPIN_CAP) { atomicAdd(&bar[XB_TMO], 1u); break; } }
    }
    nloc = mine > 0u ? mine : 1u; nx = cnt > 0u ? cnt : 1u;
}

__device__ __forceinline__ void xcd_barrier(const XcdBarrier& b) {
    asm volatile("s_waitcnt vmcnt(0)" ::: "memory");
    __syncthreads();
    if (threadIdx.x == 0) {
        unsigned* bar = b.bar;
        __builtin_amdgcn_s_waitcnt(0);
        unsigned nloc = b.st[0], nx = b.st[1];
        if (nloc == 0u) { xcd_barrier_complete(bar, b.x, nloc, nx); b.st[0] = nloc; b.st[1] = nx; }
        const unsigned old = xb_add(&bar[XB_XSUB(b.x)], 1u);
        const unsigned gen = old / nloc;
        if (old + 1u == (gen + 1u) * nloc) {
            __builtin_amdgcn_fence(__ATOMIC_RELEASE, "agent");
            asm volatile("s_waitcnt vmcnt(0)" ::: "memory");
            const unsigned og = xb_add(&bar[XB_TOP], 1u);
            const unsigned tg = og / nx;
            if (og + 1u == (tg + 1u) * nx) xb_add(&bar[XB_TOPGEN], 1u);
            else XB_SPIN(xb_ld(&bar[XB_TOPGEN]) == tg, bar);
            __builtin_amdgcn_fence(__ATOMIC_ACQUIRE, "agent");
            xb_add(&bar[XB_XGEN(b.x)], 1u);
            asm volatile("s_waitcnt vmcnt(0)" ::: "memory");
        } else {
            XB_SPIN(xb_ld(&bar[XB_XGEN(b.x)]) == gen, bar);
            __builtin_amdgcn_fence(__ATOMIC_ACQUIRE, "agent");
            asm volatile("s_waitcnt vmcnt(0)" ::: "memory");
        }
    }
    __syncthreads();
}

__device__ __forceinline__ void cvt_rows_bf16(const float* src, bf16* dst, size_t n8, size_t gtid, size_t gthreads) {
    for (size_t i = gtid; i < n8; i += gthreads) { const f32x4 a = ((const f32x4*)src)[2 * i], b = ((const f32x4*)src)[2 * i + 1];
        v4u o; o.x = pk2(a.x, a.y); o.y = pk2(a.z, a.w); o.z = pk2(b.x, b.y); o.w = pk2(b.z, b.w); ((v4u*)dst)[i] = o; }
}
__device__ __forceinline__ void transpose_item(const float* W, int N, bf16* WT, int dst_row0, LAS float* scr, int k0, int n0, int lane) {
#pragma unroll 8
    for (int i = 0; i < 32; ++i) { const int kk = 2 * i + (lane >> 5); scr[kk * 33 + (lane & 31)] = W[(size_t)(k0 + kk) * N + n0 + (lane & 31)]; }
    LDS_WAIT(); asm volatile("" ::: "memory");
    const int c = lane & 7;
#pragma unroll
    for (int j = 0; j < 4; ++j) { const int n = (lane >> 3) + 8 * j; const LAS float* s = scr + (8 * c) * 33 + n;
        v4u o; o.x = pk2(s[0 * 33], s[1 * 33]); o.y = pk2(s[2 * 33], s[3 * 33]); o.z = pk2(s[4 * 33], s[5 * 33]); o.w = pk2(s[6 * 33], s[7 * 33]);
        *(v4u*)(WT + (size_t)(dst_row0 + n) * 1024 + k0 + 8 * c) = o; }
    LDS_WAIT(); asm volatile("" ::: "memory");
}
__device__ __forceinline__ unsigned pk4_fp8(float a, float b, float c, float d) { int w = 0; w = __builtin_amdgcn_cvt_pk_fp8_f32(a, b, w, false); w = __builtin_amdgcn_cvt_pk_fp8_f32(c, d, w, true); return (unsigned)w; }
__device__ __forceinline__ void transpose_item_f8(const float* W, int N, unsigned char* WT8, int dst_row0, LAS float* scr, int k0, int n0, int lane, float wscale) {
#pragma unroll 8
    for (int i = 0; i < 32; ++i) { const int kk = 2 * i + (lane >> 5); scr[kk * 33 + (lane & 31)] = W[(size_t)(k0 + kk) * N + n0 + (lane & 31)]; }
    LDS_WAIT(); asm volatile("" ::: "memory");
    const int c = lane & 7;
#pragma unroll
    for (int j = 0; j < 4; ++j) { const int n = (lane >> 3) + 8 * j; const LAS float* s = scr + (8 * c) * 33 + n;
        v2u o; o.x = pk4_fp8(s[0 * 33] * wscale, s[1 * 33] * wscale, s[2 * 33] * wscale, s[3 * 33] * wscale); o.y = pk4_fp8(s[4 * 33] * wscale, s[5 * 33] * wscale, s[6 * 33] * wscale, s[7 * 33] * wscale);
        *(v2u*)(WT8 + (size_t)(dst_row0 + n) * 1024 + k0 + 8 * c) = o; }
    LDS_WAIT(); asm volatile("" ::: "memory");
}
__device__ __forceinline__ void phase_weights(LAS float* scr, int gw, int ngw, int lane, const float* win_src, int NC, const float* wkv_src, const float* wo_src,
                                              const float* wg_src, const float* wu_src, const float* wd_src, bf16* win_t, bf16* wkv_t, bf16* wo_t, bf16* wgu_t, bf16* wd_t) {
    const int nbw = NC / 32, nWin = nbw * 16, NIT = nWin + 256 + 512 + NE * 1536;
    for (int it = gw; it < NIT; it += ngw) {
        int r = it;
        if (r < nWin) { const int kb = r / nbw, nb = r - kb * nbw; transpose_item(win_src, NC, win_t, 32 * nb, scr, 64 * kb, 32 * nb, lane); continue; } r -= nWin;
        if (r < 256) { const int kb = r >> 4, nb = r & 15; transpose_item(wkv_src, 512, wkv_t, 32 * nb, scr, 64 * kb, 32 * nb, lane); continue; } r -= 256;
        if (r < 512) { const int kb = r >> 5, nb = r & 31; transpose_item(wo_src, 1024, wo_t, 32 * nb, scr, 64 * kb, 32 * nb, lane); continue; } r -= 512;
        const int e = r / 1536, q = r - e * 1536, which = q >> 9, rr = q & 511, kb = rr >> 5, nb = rr & 31, n0 = 32 * nb;
        const size_t eoff = (size_t)e * 1024 * 1024;
        if (which == 0) transpose_item_f8(wg_src + eoff, 1024, (unsigned char*)wgu_t + 2 * eoff, (n0 >> 7) * 256 + (n0 & 127), scr, 64 * kb, n0, lane, 32.f);
        else if (which == 1) transpose_item_f8(wu_src + eoff, 1024, (unsigned char*)wgu_t + 2 * eoff, (n0 >> 7) * 256 + 128 + (n0 & 127), scr, 64 * kb, n0, lane, 32.f);
        else transpose_item_f8(wd_src + eoff, 1024, (unsigned char*)wd_t + eoff, n0, scr, 64 * kb, n0, lane, 64.f);
    }
}

template <bool OUT>
__device__ __forceinline__ void hgrn_seg(LAS unsigned char* lds, const bf16* h, const float* lbl, int j, const float* normg, float* Sloc, float* Dseg, bf16* mix, int unit, int tid, int wave, int lane) {
    const int seg = unit & (HNSEG - 1), bh = unit >> 6, hh = bh % HG_H, b = bh / HG_H;
    const int v = tid & 127, dg = tid >> 7;
    LAS float* fgs = (LAS float*)lds; LAS float* vs = fgs + 4096; LAS float* qs = vs + 4096; LAS float* op = qs + 4096;
    f32x2 st[16];
    float* Sp = Sloc + (size_t)unit * 16384 + (size_t)(dg * 32) * 128 + v;
#pragma unroll
    for (int dd = 0; dd < 16; ++dd) { st[dd].x = OUT ? Sp[(2 * dd) * 128] : 0.f; st[dd].y = OUT ? Sp[(2 * dd + 1) * 128] : 0.f; }
    float dprod = 1.f;
    const int stok = tid >> 4, c8 = (tid & 15) * 8;
    float lb[8];
#pragma unroll
    for (int i = 0; i < 8; ++i) { lb[i] = 0.f; if (j > 0) { const float a0 = lbl[hh * 128 + c8 + i], a1 = lbl[MIXW + hh * 128 + c8 + i]; lb[i] = 1.f / (1.f + __expf(a0 - a1)); } }
    for (int ch = 0; ch < HSEG / 32; ++ch) {
        const size_t t0 = (size_t)b * SEQ + seg * HSEG + ch * 32;
        { const bf16* row = h + (t0 + stok) * NC_H + hh * 128 + c8;
          const v4u f8 = *(const v4u*)(row + 768), i8 = *(const v4u*)(row + 1536); v4u q8 = {0u, 0u, 0u, 0u}; if (OUT) q8 = *(const v4u*)row;
#pragma unroll
          for (int w = 0; w < 4; ++w) { const float f0 = bflo(f8[w]), f1 = bfhi(f8[w]); const int o = stok * 128 + c8 + 2 * w;
              fgs[o] = lb[2 * w] + (1.f - lb[2 * w]) * sigmoidf_(f0); fgs[o + 1] = lb[2 * w + 1] + (1.f - lb[2 * w + 1]) * sigmoidf_(f1);
              vs[o] = bflo(i8[w]); vs[o + 1] = bfhi(i8[w]);
              if (OUT) { const float q0 = bflo(q8[w]), q1 = bfhi(q8[w]); qs[o] = q0 * sigmoidf_(q0); qs[o + 1] = q1 * sigmoidf_(q1); } } }
        __syncthreads();
        if (!OUT) { if (tid < 128) { for (int tt = 0; tt < 32; ++tt) dprod *= fgs[tt * 128 + tid]; } }
        f32x4 fA[8], qA[8], fB[8], qB[8]; float vA, vB;
#define HG_LOAD(F, Q, V, tt_) do { V = vs[(tt_) * 128 + v]; _Pragma("unroll") for (int d4 = 0; d4 < 8; ++d4) { F[d4] = *(const LAS f32x4*)(fgs + (tt_) * 128 + dg * 32 + d4 * 4); \
            if (OUT) Q[d4] = *(const LAS f32x4*)(qs + (tt_) * 128 + dg * 32 + d4 * 4); } } while (0)
#define HG_STEP(F, Q, V, tt_) do { const f32x2 vv2 = {V, V}; f32x2 acc2 = {0.f, 0.f}; _Pragma("unroll") for (int d4 = 0; d4 < 8; ++d4) { \
            const f32x2 fa = {F[d4].x, F[d4].y}, fb = {F[d4].z, F[d4].w}; \
            st[2 * d4] = fa * (st[2 * d4] - vv2) + vv2; st[2 * d4 + 1] = fb * (st[2 * d4 + 1] - vv2) + vv2; \
            if (OUT) { const f32x2 qa = {Q[d4].x, Q[d4].y}, qb = {Q[d4].z, Q[d4].w}; acc2 = qa * st[2 * d4] + acc2; acc2 = qb * st[2 * d4 + 1] + acc2; } } \
            if (OUT) op[(dg * 32 + (tt_)) * 128 + v] = acc2.x + acc2.y; } while (0)
        HG_LOAD(fA, qA, vA, 0);
#pragma unroll 1
        for (int tt = 0; tt < 32; tt += 2) {
            HG_LOAD(fB, qB, vB, tt + 1);
            __builtin_amdgcn_sched_barrier(0);
            HG_STEP(fA, qA, vA, tt);
            __builtin_amdgcn_sched_barrier(0);
            if (tt + 2 < 32) HG_LOAD(fA, qA, vA, tt + 2);
            __builtin_amdgcn_sched_barrier(0);
            HG_STEP(fB, qB, vB, tt + 1);
            __builtin_amdgcn_sched_barrier(0);
        }
#undef HG_LOAD
#undef HG_STEP
        if (OUT) {
            __syncthreads();
#pragma unroll
            for (int k = 0; k < 4; ++k) { const int tt = wave + 8 * k; float o0 = 0.f, o1 = 0.f;
#pragma unroll
                for (int g = 0; g < 4; ++g) { o0 += op[(g * 32 + tt) * 128 + lane]; o1 += op[(g * 32 + tt) * 128 + lane + 64]; }
                const float ms = wave_sum(o0 * o0 + o1 * o1) * (1.f / 128.f), r = 1.f / sqrtf(ms + 1e-6f);
                const bf16* grow = h + (t0 + tt) * NC_H + 2304 + hh * 128; const float g0 = bf2f(grow[lane]), g1 = bf2f(grow[lane + 64]);
                bf16* mrow = mix + (t0 + tt) * 1024 + hh * 128;
                mrow[lane] = (bf16)f2bf(o0 * r * normg[lane] * sigmoidf_(g0)); mrow[lane + 64] = (bf16)f2bf(o1 * r * normg[lane + 64] * sigmoidf_(g1)); }
        }
        __syncthreads();
    }
    if (!OUT) {
#pragma unroll
        for (int dd = 0; dd < 16; ++dd) { Sp[(2 * dd) * 128] = st[dd].x; Sp[(2 * dd + 1) * 128] = st[dd].y; }
        if (tid < 128) Dseg[(size_t)unit * 128 + tid] = dprod;
    }
}
__device__ __forceinline__ void hgrn_scan(float* Sloc, const float* Dseg, size_t gtid, size_t gthreads) {
    for (size_t idx = gtid; idx < (size_t)NBATCH * HG_H * 16384; idx += gthreads) { const int bh = (int)(idx >> 14), e = (int)(idx & 16383), d = e >> 7; float cur = 0.f;
        for (int seg = 0; seg < HNSEG; ++seg) { const size_t u = (size_t)bh * HNSEG + seg; float* p = Sloc + u * 16384 + e; const float tmp = *p; *p = cur; cur = Dseg[u * 128 + d] * cur + tmp; } }
}

template <bool MASK>
__device__ __forceinline__ void attn4(const LAS unsigned* Ks, const LAS bf16* Vs, const LAS float* qst, LAS float* pb, int lane, const int (&tq)[4], int kbase, float slope,
                                      float (&mo)[4], float (&lo)[4], float (&oo)[4]) {
    float sc[4][4];
#pragma unroll
    for (int a = 0; a < 4; ++a)
#pragma unroll
        for (int c = 0; c < 4; ++c) sc[a][c] = 0.f;
#pragma unroll 4
    for (int dd = 0; dd < 32; ++dd) {
        f32x2 qv[4];
#pragma unroll
        for (int qi = 0; qi < 4; ++qi) qv[qi] = *(const LAS f32x2*)(qst + qi * 64 + 2 * dd);
#pragma unroll
        for (int kk = 0; kk < 4; ++kk) { const unsigned kw = Ks[(lane + 64 * kk) * 33 + dd]; const float k0 = bflo(kw), k1 = bfhi(kw);
#pragma unroll
            for (int qi = 0; qi < 4; ++qi) sc[qi][kk] += qv[qi].x * k0 + qv[qi].y * k1; }
    }
#pragma unroll
    for (int qi = 0; qi < 4; ++qi) { float mx = -INFINITY;
#pragma unroll
        for (int kk = 0; kk < 4; ++kk) { const int pos = kbase + lane + 64 * kk; float lg = sc[qi][kk] * 0.125f - slope * (float)(tq[qi] - pos); if (MASK && pos > tq[qi]) lg = -INFINITY; sc[qi][kk] = lg; mx = fmaxf(mx, lg); }
        mx = wave_max(mx); float s = 0.f;
#pragma unroll
        for (int kk = 0; kk < 4; ++kk) { const float p = __builtin_amdgcn_exp2f((sc[qi][kk] - mx) * 1.4426950408889634f); pb[qi * 256 + lane + 64 * kk] = p; s += p; }
        lo[qi] = wave_sum(s); mo[qi] = mx; }
    float o[4] = {0.f, 0.f, 0.f, 0.f};
#pragma unroll 4
    for (int k4 = 0; k4 < 64; ++k4) { f32x4 p4[4];
#pragma unroll
        for (int qi = 0; qi < 4; ++qi) p4[qi] = *(const LAS f32x4*)(pb + qi * 256 + 4 * k4);
#pragma unroll
        for (int jj = 0; jj < 4; ++jj) { const float vv = bf2f(Vs[(4 * k4 + jj) * 64 + lane]);
#pragma unroll
            for (int qi = 0; qi < 4; ++qi) o[qi] += p4[qi][jj] * vv; } }
#pragma unroll
    for (int qi = 0; qi < 4; ++qi) oo[qi] = o[qi];
}
constexpr int AT_KS = 0, AT_VS = 33792, AT_WV = 66560, AT_WVB = 5120;

__device__ __forceinline__ void memattn_unit(LAS unsigned char* lds, const bf16* h, int NC, int qoff, const bf16* kv, bf16* mix, int unit, int tid, int wave, int lane) {
    const int chunk = unit & 31, bm = unit >> 5, mh = bm & 3, b = bm >> 2;
    LAS unsigned* Ks = (LAS unsigned*)(lds + AT_KS); LAS unsigned* Vs32 = (LAS unsigned*)(lds + AT_VS);
    LAS float* qst = (LAS float*)(lds + AT_WV + wave * AT_WVB); LAS float* pb = qst + 256;
    for (int i = 0; i < 16; ++i) { const int idx = tid + 512 * i, r = idx >> 5, dd = idx & 31; const unsigned* src = (const unsigned*)(kv + (size_t)(b * 256 + r) * 512 + mh * 64);
        Ks[r * 33 + dd] = src[dd]; Vs32[r * 32 + dd] = src[128 + dd]; }
    __syncthreads();
    for (int qd = 0; qd < 16; ++qd) { const size_t tg = (size_t)b * SEQ + chunk * 512 + wave * 64 + qd * 4;
#pragma unroll
        for (int qi = 0; qi < 4; ++qi) qst[qi * 64 + lane] = bf2f(h[(tg + qi) * NC + qoff + mh * 64 + lane]);
        const int tq[4] = {0, 0, 0, 0}; float m[4], l[4], o[4];
        attn4<false>(Ks, (const LAS bf16*)Vs32, qst, pb, lane, tq, 0, 0.f, m, l, o);
#pragma unroll
        for (int qi = 0; qi < 4; ++qi) mix[(tg + qi) * 1024 + MIXW + mh * 64 + lane] = (bf16)f2bf(o[qi] / l[qi]); }
    __syncthreads();
}

typedef short s16x8 __attribute__((ext_vector_type(8)));
typedef float f32x16 __attribute__((ext_vector_type(16)));
typedef float f32x2_t __attribute__((ext_vector_type(2))); typedef __bf16 bf16x2_t __attribute__((ext_vector_type(2)));
__device__ __forceinline__ unsigned cvtpk(float lo, float hi) { f32x2_t v = {lo, hi}; bf16x2_t b = __builtin_convertvector(v, bf16x2_t); return __builtin_bit_cast(unsigned, b); }
constexpr int AT2_K = 0, AT2_V = 36864, AT2_KROW = 144, AT2_VROW = 528;
__device__ __forceinline__ void stage_kv_images(LAS unsigned char* lds, const bf16* kp, const bf16* vp, size_t row_stride, int tid) {
#pragma unroll
    for (int i = 0; i < 4; ++i) { const int idx = tid + 512 * i, key = idx >> 3, c = idx & 7;
        const v4u kx = *(const v4u*)(kp + (size_t)key * row_stride + 8 * c);
        *(LAS v4u*)(lds + AT2_K + key * AT2_KROW + c * 16) = kx;
        const v4u vx = *(const v4u*)(vp + (size_t)key * row_stride + 8 * c);
        const int pos = (key & ~15) | (key & 3) | ((key & 4) << 1) | ((key & 8) >> 1);
        LAS bf16* vt = (LAS bf16*)(lds + AT2_V) + pos;
#pragma unroll
        for (int w = 0; w < 4; ++w) { vt[(8 * c + 2 * w) * (AT2_VROW / 2)] = (bf16)(vx[w] & 0xffffu); vt[(8 * c + 2 * w + 1) * (AT2_VROW / 2)] = (bf16)(vx[w] >> 16); } }
}
template <bool MASK>
__device__ __forceinline__ void attn_tile32(const LAS unsigned char* lds, const bf16* qrow, int lane, float dist0, float slope2, f32x16 (&o)[2], float& mrow, float& lrow) {
    const int r = lane & 31, hf = lane >> 5;
    s16x8 qf[4];
#pragma unroll
    for (int s = 0; s < 4; ++s) qf[s] = *(const s16x8*)(qrow + 16 * s + 8 * hf);
    f32x16 acc[8];
    const LAS unsigned char* kb = lds + AT2_K + r * AT2_KROW + hf * 16;
#pragma unroll
    for (int kt = 0; kt < 8; ++kt) {
#pragma unroll
        for (int i = 0; i < 16; ++i) acc[kt][i] = 0.f;
#pragma unroll
        for (int s = 0; s < 4; ++s) { const s16x8 kf = *(const LAS s16x8*)(kb + kt * 32 * AT2_KROW + s * 32); acc[kt] = __builtin_amdgcn_mfma_f32_32x32x16_bf16(kf, qf[s], acc[kt], 0, 0, 0); }
        __builtin_amdgcn_sched_barrier(0); }
    const float base2 = dist0 - 4.f * (float)hf; float mx = -INFINITY;
#pragma unroll
    for (int kt = 0; kt < 8; ++kt)
#pragma unroll
        for (int i = 0; i < 16; ++i) { const float dist = base2 - (float)(32 * kt + (i & 3) + 8 * (i >> 2)); float lg = acc[kt][i] * (0.125f * 1.4426950408889634f);
            if (MASK) { lg -= slope2 * dist; if (dist < 0.f) lg = -INFINITY; } acc[kt][i] = lg; mx = fmaxf(mx, lg); }
    mx = fmaxf(mx, xor32f(mx, lane));
    float sum = 0.f;
#pragma unroll
    for (int i = 0; i < 16; ++i) { o[0][i] = 0.f; o[1][i] = 0.f; }
    const LAS unsigned char* vb = lds + AT2_V + r * AT2_VROW + hf * 16;
#pragma unroll
    for (int kt = 0; kt < 8; ++kt) {
#pragma unroll
        for (int i = 0; i < 16; ++i) { const float p = __builtin_amdgcn_exp2f(acc[kt][i] - mx); sum += p; acc[kt][i] = p; }
#pragma unroll
        for (int s2 = 0; s2 < 2; ++s2) { v4u pw; pw.x = cvtpk(acc[kt][8 * s2], acc[kt][8 * s2 + 1]); pw.y = cvtpk(acc[kt][8 * s2 + 2], acc[kt][8 * s2 + 3]);
            pw.z = cvtpk(acc[kt][8 * s2 + 4], acc[kt][8 * s2 + 5]); pw.w = cvtpk(acc[kt][8 * s2 + 6], acc[kt][8 * s2 + 7]); const s16x8 pf = __builtin_bit_cast(s16x8, pw);
#pragma unroll
            for (int dt = 0; dt < 2; ++dt) { const s16x8 vf = *(const LAS s16x8*)(vb + dt * 32 * AT2_VROW + (32 * kt + 16 * s2) * 2); o[dt] = __builtin_amdgcn_mfma_f32_32x32x16_bf16(vf, pf, o[dt], 0, 0, 0); } }
        __builtin_amdgcn_sched_barrier(0); }
    sum += xor32f(sum, lane);
    mrow = mx; lrow = sum;
}
__device__ __forceinline__ void memattn_unit2(LAS unsigned char* lds, const bf16* h, int NC, int qoff, const bf16* kv, bf16* mix, int unit, int tid, int wave, int lane) {
    const int chunk = unit & 63, bm = unit >> 6, mh = bm & 3, b = bm >> 2, r = lane & 31, hf = lane >> 5;
    const bf16* kvrow0 = kv + (size_t)(b * 256) * 512 + mh * 64;
    stage_kv_images(lds, kvrow0, kvrow0 + 256, 512, tid);
    __syncthreads();
    { const size_t tg = (size_t)b * SEQ + chunk * 256 + wave * 32 + r;
        f32x16 o[2]; float m2, l;
        attn_tile32<false>(lds, h + tg * NC + qoff + mh * 64, lane, 0.f, 0.f, o, m2, l);
        const float inv = 1.f / l; bf16* mp = mix + tg * 1024 + MIXW + mh * 64 + 4 * hf;
#pragma unroll
        for (int dt = 0; dt < 2; ++dt)
#pragma unroll
            for (int g = 0; g < 4; ++g) { v2u w; w.x = cvtpk(o[dt][4 * g] * inv, o[dt][4 * g + 1] * inv); w.y = cvtpk(o[dt][4 * g + 2] * inv, o[dt][4 * g + 3] * inv); *(v2u*)(mp + 32 * dt + 8 * g) = w; } }
    __syncthreads();
}
__device__ __forceinline__ void kmean_unit(LAS unsigned char* lds, const bf16* h, float* kmean, int unit, int tid) {
    const int n = unit & 63, bh = unit >> 6, hh = bh % MB_H, b = bh / MB_H, d = tid & 63, part = tid >> 6;
    LAS float* red = (LAS float*)lds;
    float s = 0.f; const bf16* p = h + ((size_t)b * SEQ + n * 256 + part * 32) * NC_M + 768 + hh * 64 + d;
    for (int i = 0; i < 32; ++i) s += bf2f(p[(size_t)i * NC_M]);
    red[part * 64 + d] = s; __syncthreads();
    if (tid < 64) { float a = 0.f; for (int pp = 0; pp < 8; ++pp) a += red[pp * 64 + tid]; kmean[((size_t)bh * 64 + n) * 64 + tid] = a * (1.f / 256.f); }
    __syncthreads();
}
__device__ __forceinline__ void moba_gate_unit(LAS unsigned char* lds, const bf16* h, const float* kmean, unsigned* gcount, int* selinfo, unsigned* list, int unit, int tid) {
    const int c = unit & 63, bh = unit >> 6, hh = bh % MB_H, b = bh / MB_H;
    LAS float* km = (LAS float*)lds; LAS int* hist = (LAS int*)(lds + 16384); LAS int* base = hist + 64;
    for (int i = tid; i < 4096; i += NTHR) km[i] = kmean[(size_t)bh * 4096 + i];
    if (tid < 64) hist[tid] = 0;
    __syncthreads();
    int s0 = 0, s1 = 0, s2 = 0, r0 = 0, r1 = 0, r2 = 0, ns = 0; const int t = c * 256 + tid;
    if (tid < 256) {
        float q[64]; const v4u* qp = (const v4u*)(h + ((size_t)b * SEQ + t) * NC_M + hh * 64);
#pragma unroll
        for (int w = 0; w < 8; ++w) { const v4u x = qp[w]; q[8 * w] = bflo(x.x); q[8 * w + 1] = bfhi(x.x); q[8 * w + 2] = bflo(x.y); q[8 * w + 3] = bfhi(x.y); q[8 * w + 4] = bflo(x.z); q[8 * w + 5] = bfhi(x.z); q[8 * w + 6] = bflo(x.w); q[8 * w + 7] = bfhi(x.w); }
        float v0 = -INFINITY, v1 = -INFINITY, v2 = -INFINITY;
        for (int n = 0; n < c; ++n) { float g = 0.f;
#pragma unroll
            for (int d4 = 0; d4 < 16; ++d4) { const f32x4 k4 = *(const LAS f32x4*)(km + n * 64 + 4 * d4); g += q[4 * d4] * k4.x + q[4 * d4 + 1] * k4.y + q[4 * d4 + 2] * k4.z + q[4 * d4 + 3] * k4.w; }
            if (g > v0) { v2 = v1; s2 = s1; v1 = v0; s1 = s0; v0 = g; s0 = n; } else if (g > v1) { v2 = v1; s2 = s1; v1 = g; s1 = n; } else if (g > v2) { v2 = g; s2 = n; } }
        ns = c < 3 ? c : 3;
        if (ns > 0) r0 = __hip_atomic_fetch_add(hist + s0, 1, __ATOMIC_RELAXED, __HIP_MEMORY_SCOPE_WORKGROUP);
        if (ns > 1) r1 = __hip_atomic_fetch_add(hist + s1, 1, __ATOMIC_RELAXED, __HIP_MEMORY_SCOPE_WORKGROUP);
        if (ns > 2) r2 = __hip_atomic_fetch_add(hist + s2, 1, __ATOMIC_RELAXED, __HIP_MEMORY_SCOPE_WORKGROUP);
        selinfo[((size_t)b * SEQ + t) * MB_H + hh] = ns;
    }
    __syncthreads();
    if (tid < 64) { const int hc = hist[tid]; if (hc > 0) base[tid] = (int)__hip_atomic_fetch_add(gcount + bh * 64 + tid, (unsigned)hc, __ATOMIC_RELAXED, __HIP_MEMORY_SCOPE_AGENT); }
    __syncthreads();
    if (tid < 256) { unsigned* lp = list + ((size_t)bh * 64 << 14);
        if (ns > 0) lp[((size_t)s0 << 14) + base[s0] + r0] = (unsigned)t;
        if (ns > 1) lp[((size_t)s1 << 14) + base[s1] + r1] = (unsigned)t | (1u << 14);
        if (ns > 2) lp[((size_t)s2 << 14) + base[s2] + r2] = (unsigned)t | (2u << 14); }
    __syncthreads();
}
__device__ __forceinline__ void moba_attn_item(LAS unsigned char* lds, const bf16* h, const unsigned* gcount, const unsigned* list, float* po, float* pml, int item, int tid, int wave, int lane) {
    const int n = item / 24, bh = item - n * 24, hh = bh % MB_H, b = bh / MB_H;
    LAS unsigned* Ks = (LAS unsigned*)(lds + AT_KS); LAS unsigned* Vs32 = (LAS unsigned*)(lds + AT_VS);
    LAS float* qst = (LAS float*)(lds + AT_WV + wave * AT_WVB); LAS float* pb = qst + 256;
    for (int i = 0; i < 16; ++i) { const int idx = tid + 512 * i, r = idx >> 5, dd = idx & 31; const unsigned* src = (const unsigned*)(h + ((size_t)b * SEQ + n * 256 + r) * NC_M + hh * 64);
        Ks[r * 33 + dd] = src[384 + dd]; Vs32[r * 32 + dd] = src[768 + dd]; }
    __syncthreads();
    const int cnt = (int)gcount[bh * 64 + n], total = 256 + cnt, nquads = (total + 3) >> 2;
    const float slope = hh < 8 ? ldexpf(1.0f, -(hh + 1)) : ldexpf(0.70710678118654752f, -(hh - 8));
    const unsigned* lp = list + (((size_t)bh * 64 + n) << 14);
    for (int quad = wave; quad < nquads; quad += 8) {
        int tq[4], slot[4];
#pragma unroll
        for (int qi = 0; qi < 4; ++qi) { int idx = quad * 4 + qi; idx = idx < total ? idx : total - 1;
            if (idx < 256) { tq[qi] = n * 256 + idx; slot[qi] = 3; } else { const unsigned e = lp[idx - 256]; tq[qi] = (int)(e & 16383u); slot[qi] = (int)(e >> 14); } }
#pragma unroll
        for (int qi = 0; qi < 4; ++qi) qst[qi * 64 + lane] = bf2f(h[((size_t)b * SEQ + tq[qi]) * NC_M + hh * 64 + lane]);
        float m[4], l[4], o[4];
        attn4<true>(Ks, (const LAS bf16*)Vs32, qst, pb, lane, tq, n * 256, slope, m, l, o);
#pragma unroll
        for (int qi = 0; qi < 4; ++qi) if (quad * 4 + qi < total) { const size_t pi = (((size_t)b * SEQ + tq[qi]) * MB_H + hh) * 4 + slot[qi];
            po[pi * 64 + lane] = o[qi]; if (lane == 0) { pml[pi * 2] = m[qi]; pml[pi * 2 + 1] = l[qi]; } }
    }
    __syncthreads();
}

__device__ __forceinline__ void moba_attn_item2(LAS unsigned char* lds, const bf16* h, const unsigned* gcount, const unsigned* list, float* po, float* pml, int item, int tid, int wave, int lane) {
    const int n = item / 24, bh = item - n * 24, hh = bh % MB_H, b = bh / MB_H, r = lane & 31, hf = lane >> 5;
    const bf16* hrow0 = h + ((size_t)b * SEQ + n * 256) * NC_M + hh * 64;
    stage_kv_images(lds, hrow0 + 768, hrow0 + 1536, NC_M, tid);
    __syncthreads();
    const int cnt = (int)gcount[bh * 64 + n], total = 256 + cnt, ntiles = (total + 31) >> 5;
    const float slope2 = (hh < 8 ? ldexpf(1.0f, -(hh + 1)) : ldexpf(0.70710678118654752f, -(hh - 8))) * 1.4426950408889634f;
    const unsigned* lp = list + (((size_t)bh * 64 + n) << 14);
#pragma unroll 1
    for (int tile = wave; tile < ntiles; tile += NWAVES) {
        int idx = tile * 32 + r; const bool valid = idx < total; idx = valid ? idx : total - 1;
        int tq, slot; if (idx < 256) { tq = n * 256 + idx; slot = 3; } else { const unsigned e = lp[idx - 256]; tq = (int)(e & 16383u); slot = (int)(e >> 14); }
        f32x16 o[2]; float m2, l;
        attn_tile32<true>(lds, h + ((size_t)b * SEQ + tq) * NC_M + hh * 64, lane, (float)(tq - n * 256), slope2, o, m2, l);
        if (valid) { const size_t pi = (((size_t)b * SEQ + tq) * MB_H + hh) * 4 + slot; float* op = po + pi * 64 + 4 * hf;
#pragma unroll
            for (int dt = 0; dt < 2; ++dt)
#pragma unroll
                for (int g = 0; g < 4; ++g) { const f32x4 v = {o[dt][4 * g], o[dt][4 * g + 1], o[dt][4 * g + 2], o[dt][4 * g + 3]}; *(f32x4*)(op + 32 * dt + 8 * g) = v; }
            if (hf == 0) { pml[pi * 2] = m2; pml[pi * 2 + 1] = l; } }
    }
    __syncthreads();
}
__device__ __forceinline__ void moba_combine(const float* __restrict__ po, const float* __restrict__ pml, const int* __restrict__ selinfo, bf16* __restrict__ mix, int gw, int ngw, int lane) {
    const int sub = lane >> 4, d4 = (lane & 15) * 4;
#pragma unroll 2
    for (int idx = gw * 4 + sub; idx < T * MB_H; idx += ngw * 4) { const int tg = idx / MB_H, hh = idx - tg * MB_H, ns = selinfo[idx]; const size_t p4 = (size_t)idx * 4;
        f32x2 ml[4]; f32x4 ov[4];
#pragma unroll
        for (int j = 0; j < 4; ++j) { ml[j] = ((const f32x2*)pml)[p4 + j]; ov[j] = *(const f32x4*)(po + (p4 + j) * 64 + d4); }
        float M = ml[3].x;
#pragma unroll
        for (int j = 0; j < 3; ++j) { const bool ok = j < ns; ml[j].x = ok ? ml[j].x : -INFINITY; ml[j].y = ok ? ml[j].y : 0.f; M = fmaxf(M, ml[j].x);
            ov[j].x = ok ? ov[j].x : 0.f; ov[j].y = ok ? ov[j].y : 0.f; ov[j].z = ok ? ov[j].z : 0.f; ov[j].w = ok ? ov[j].w : 0.f; }
        float den = 0.f; f32x4 num = {0.f, 0.f, 0.f, 0.f};
#pragma unroll
        for (int j = 0; j < 4; ++j) { const float w = __builtin_amdgcn_exp2f(ml[j].x - M); den += w * ml[j].y; num += ov[j] * w; }
        const float inv = 1.f / den; v2u o; o.x = pk2(num.x * inv, num.y * inv); o.y = pk2(num.z * inv, num.w * inv);
        *(v2u*)(mix + (size_t)tg * 1024 + hh * 64 + d4) = o; }
}

__device__ __forceinline__ void ln_row(f32x4 (&v)[4], const f32x4 (&gv)[4], const f32x4 (&bv)[4]) {
    float s = 0.f;
#pragma unroll
    for (int j = 0; j < 4; ++j) s += (v[j].x + v[j].y) + (v[j].z + v[j].w);
    const float mean = wave_sum(s) * (1.f / D); float s2 = 0.f;
#pragma unroll
    for (int j = 0; j < 4; ++j) { v[j] = v[j] - mean; s2 += (v[j].x * v[j].x + v[j].y * v[j].y) + (v[j].z * v[j].z + v[j].w * v[j].w); }
    const float rstd = 1.f / sqrtf(wave_sum(s2) * (1.f / D) + 1e-5f);
#pragma unroll
    for (int j = 0; j < 4; ++j) v[j] = v[j] * rstd * gv[j] + bv[j];
}
__device__ __forceinline__ void phase_ln1(LAS unsigned char* lds, const float* xin, const bf16* y, const float* g, const float* bb, const float* wr, const float* br,
                                          float* xout, bf16* xbf, int* tok_e, int* tok_lr, float* tok_w, int* blk_cnt, int blk, int tid, int wave, int lane) {
    LAS float* xst = (LAS float*)lds;
    LAS float* part = (LAS float*)(lds + 32768);
    LAS int* hist = (LAS int*)(lds + 40960);
    if (tid < 32) hist[tid] = 0;
    constexpr int TPB = T / GRID;
    const int e = lane & 31, half = lane >> 5;
    float wreg[64];
    { const float* wp = wr + (size_t)(wave * 128 + half * 64) * NE + e;
#pragma unroll
      for (int k = 0; k < 64; ++k) wreg[k] = wp[k * NE]; }
    const float bre = br[e];
    __syncthreads();
    for (int grp = 0; grp < TPB / NWAVES; ++grp) { const size_t t = (size_t)blk * TPB + grp * NWAVES + wave;
        { f32x4 gv[4], bv[4];
#pragma unroll
          for (int j = 0; j < 4; ++j) { gv[j] = ((const f32x4*)g)[lane + 64 * j]; bv[j] = ((const f32x4*)bb)[lane + 64 * j]; }
          const f32x4* xr = (const f32x4*)(xin + t * D) + lane; const v2u* yr = (const v2u*)(y + t * D) + lane; f32x4 v[4];
#pragma unroll
          for (int j = 0; j < 4; ++j) { const f32x4 xv = xr[64 * j]; const v2u yw = yr[64 * j];
              v[j].x = DN_ALPHA * xv.x + bflo(yw.x); v[j].y = DN_ALPHA * xv.y + bfhi(yw.x); v[j].z = DN_ALPHA * xv.z + bflo(yw.y); v[j].w = DN_ALPHA * xv.w + bfhi(yw.y); }
          ln_row(v, gv, bv);
          f32x4* xo = (f32x4*)(xout + t * D) + lane; v2u* xb = (v2u*)(xbf + t * D) + lane;
#pragma unroll
          for (int j = 0; j < 4; ++j) { xo[64 * j] = v[j]; v2u w; w.x = pk2(v[j].x, v[j].y); w.y = pk2(v[j].z, v[j].w); xb[64 * j] = w; ((LAS f32x4*)(xst + wave * 1024))[lane + 64 * j] = v[j]; } }
        __syncthreads();
#pragma unroll 2
        for (int tk = 0; tk < 8; ++tk) { float acc = 0.f; const LAS float* xs_ = xst + tk * 1024 + wave * 128 + half * 64;
#pragma unroll
            for (int k4 = 0; k4 < 16; ++k4) { const f32x4 xv = *(const LAS f32x4*)(xs_ + 4 * k4); acc += xv.x * wreg[4 * k4]; acc += xv.y * wreg[4 * k4 + 1]; acc += xv.z * wreg[4 * k4 + 2]; acc += xv.w * wreg[4 * k4 + 3]; }
            acc += xor32f(acc, lane);
            if (half == 0) part[(wave * 8 + tk) * 32 + e] = acc; }
        __syncthreads();
        float logit = bre;
#pragma unroll
        for (int w = 0; w < 8; ++w) logit += part[(w * 8 + wave) * 32 + e];
        int se[4]; float sv[4];
#pragma unroll
        for (int k = 0; k < 4; ++k) { float bvv = logit; int bi = e;
#define ARGMAX_STEP(X) { const float ov = xorf<X>(bvv); const int oi = xori<X>(bi); if (ov > bvv || (ov == bvv && oi < bi)) { bvv = ov; bi = oi; } }
            ARGMAX_STEP(1) ARGMAX_STEP(2) ARGMAX_STEP(4) ARGMAX_STEP(8) ARGMAX_STEP(16)
#undef ARGMAX_STEP
            se[k] = bi; sv[k] = bvv; if (e == bi) logit = -INFINITY; }
        const float e1 = __expf(sv[1] - sv[0]), e2 = __expf(sv[2] - sv[0]), e3 = __expf(sv[3] - sv[0]), inv = 1.f / (1.f + e1 + e2 + e3);
        const float wk[4] = {inv, e1 * inv, e2 * inv, e3 * inv};
        if (lane == 0) {
#pragma unroll
            for (int k = 0; k < 4; ++k) { const int lr = __hip_atomic_fetch_add(hist + se[k], 1, __ATOMIC_RELAXED, __HIP_MEMORY_SCOPE_WORKGROUP);
                tok_e[t * 4 + k] = se[k]; tok_lr[t * 4 + k] = lr; tok_w[t * 4 + k] = wk[k]; } }
    }
    __syncthreads();
    if (tid < 32) blk_cnt[blk * 32 + tid] = hist[tid];
    __syncthreads();
}
__device__ __forceinline__ void phase_dispatch(LAS unsigned char* lds, const int* __restrict__ blk_cnt, const int* __restrict__ tok_e, const int* __restrict__ tok_lr, int* __restrict__ tok_row, int* __restrict__ tab,
                                               const bf16* __restrict__ xbf, bf16* __restrict__ xs, int blk, int tid, int wave, int lane) {
    LAS int* tot = (LAS int*)lds; LAS int* pre = tot + 32; LAS int* pst = pre + 32; LAS int* rows = pst + 64;
    if (tid < 32) { int s = 0, p = 0;
#pragma unroll 8
        for (int bb = 0; bb < GRID; ++bb) { const int c = blk_cnt[bb * 32 + tid]; p += (bb < blk) ? c : 0; s += c; } tot[tid] = s; pre[tid] = p; }
    __syncthreads();
    if (tid == 0) { int acc = 0; for (int e = 0; e < 32; ++e) { pst[e] = acc; acc += ((tot[e] + 255) >> 8) << 8; } pst[32] = acc; }
    __syncthreads();
    if (blk == 0 && tid < 33) tab[tid] = pst[tid] >> 8;
    constexpr int TPB = T / GRID;
    static_assert(TPB * 4 == NTHR, "one (token, k) pair per thread");
    { const size_t ti = (size_t)blk * TPB * 4 + tid; const int e = tok_e[ti]; const int r = pst[e] + pre[e] + tok_lr[ti]; tok_row[ti] = r; rows[tid] = r; }
    __syncthreads();
#pragma unroll 4
    for (int i = wave; i < TPB * 4; i += NWAVES) { const int r = rows[i];
        const v4u* src = (const v4u*)(xbf + ((size_t)blk * TPB + (i >> 2)) * D) + 2 * lane; const v4u a = src[0], b = src[1];
        v4u o; o.x = pk4_fp8(bflo(a.x), bfhi(a.x), bflo(a.y), bfhi(a.y)); o.y = pk4_fp8(bflo(a.z), bfhi(a.z), bflo(a.w), bfhi(a.w)); o.z = pk4_fp8(bflo(b.x), bfhi(b.x), bflo(b.y), bfhi(b.y)); o.w = pk4_fp8(bflo(b.z), bfhi(b.z), bflo(b.w), bfhi(b.w));
        ((v4u*)((unsigned char*)xs + (size_t)r * D))[lane] = o; }
    __syncthreads();
}
__device__ __forceinline__ void phase_ln2(const float* __restrict__ x1, const bf16* __restrict__ yrows, const int* __restrict__ tok_row, const float* __restrict__ tok_w, const float* __restrict__ g, const float* __restrict__ bb,
                                          float* __restrict__ xout, bf16* __restrict__ xbf, int gw, int ngw, int lane) {
    f32x4 gv[4], bv[4];
#pragma unroll
    for (int j = 0; j < 4; ++j) { gv[j] = ((const f32x4*)g)[lane + 64 * j]; bv[j] = ((const f32x4*)bb)[lane + 64 * j]; }
    static_assert(T % (2 * GRID * NWAVES) == 0, "two tokens per wave per step");
    for (int t0 = gw; t0 < T; t0 += 2 * ngw) {
        f32x4 v[2][4];
#pragma unroll
        for (int u = 0; u < 2; ++u) { const int t = t0 + u * ngw; int r[4]; float w[4];
#pragma unroll
            for (int k = 0; k < 4; ++k) { r[k] = tok_row[(size_t)t * 4 + k]; w[k] = tok_w[(size_t)t * 4 + k]; }
            const f32x4* xr = (const f32x4*)(x1 + (size_t)t * D) + lane;
#pragma unroll
            for (int j = 0; j < 4; ++j) { f32x4 f = {0.f, 0.f, 0.f, 0.f};
#pragma unroll
                for (int k = 0; k < 4; ++k) { const v2u yw = ((const v2u*)(yrows + (size_t)r[k] * D))[lane + 64 * j]; f.x += w[k] * bflo(yw.x); f.y += w[k] * bfhi(yw.x); f.z += w[k] * bflo(yw.y); f.w += w[k] * bfhi(yw.y); }
                v[u][j] = xr[64 * j] * DN_ALPHA + f; } }
#pragma unroll
        for (int u = 0; u < 2; ++u) { const int t = t0 + u * ngw;
            ln_row(v[u], gv, bv);
            f32x4* xo = (f32x4*)(xout + (size_t)t * D) + lane; v2u* xb = (v2u*)(xbf + (size_t)t * D) + lane;
#pragma unroll
            for (int j = 0; j < 4; ++j) { xo[64 * j] = v[u][j]; v2u ww; ww.x = pk2(v[u][j].x, v[u][j].y); ww.y = pk2(v[u][j].z, v[u][j].w); xb[64 * j] = ww; } } }
}

struct Args { const float* in[20]; float* out; unsigned char* ws; int l_lo, l_hi, ph_lo, ph_hi; };
typedef const __attribute__((address_space(4))) Args* KArgsP;
#define KA_LOAD() ({ KArgsP p_ = (KArgsP)__builtin_amdgcn_kernarg_segment_ptr(); asm volatile("" : "+s"(p_)); p_; })
#ifndef PHMASK
#define PHMASK 0xFFFF
#endif
#ifndef REPEAT_MASK
#define REPEAT_MASK 0
#endif
#ifndef REPEAT_LMASK
#define REPEAT_LMASK 0xF
#endif
#define PH_BEGIN(k) _Pragma("unroll") for (int rep_ = 0; rep_ < ((((REPEAT_MASK >> (k)) & 1) && ((REPEAT_LMASK >> l) & 1)) ? 2 : 1); ++rep_) { if ((PHMASK >> (k)) & 1) { KArgsP ka = KA_LOAD(); unsigned char* ws = ka->ws; int tid = threadIdx.x; asm volatile("" : "+v"(tid)); \
    const int lane = tid & 63, wave = __builtin_amdgcn_readfirstlane(tid >> 6); int blk = blockIdx.x; asm volatile("" : "+s"(blk)); \
    const int gw = blk * NWAVES + wave; const size_t gtid = (size_t)blk * NTHR + tid; (void)lane; (void)gw; (void)gtid; (void)ws;
#if ONE_LAUNCH
#define PH_SEAM() do { XcdBarrier b_; b_.bar = (unsigned*)(KA_LOAD()->ws + WS_CTL) + CW_BAR; b_.x = xb_xcc_id(); b_.st = (volatile LAS unsigned*)(lds + MISC_OFF); xcd_barrier(b_); } while (0)
#else
#define PH_SEAM() do {} while (0)
#endif
#define PH_END() PH_SEAM(); } }
#define PH_END_NOSEAM() } }
#define WSP(type, off) ((type*)(ws + (off)))
constexpr int G = GRID, NGW = GRID * NWAVES; constexpr size_t GTHREADS = (size_t)GRID * NTHR;
template <int L> __device__ __forceinline__ void layer_phases(LAS unsigned char* lds) {
    constexpr int l = L; LAS int* tabL = (LAS int*)(lds + MISC_OFF + 256);

        const int j = l >> 1; const bool moba = (l & 1) != 0;
        const int NC = moba ? NC_M : NC_H, qoff = moba ? 2304 : 3072;

        PH_BEGIN(1)
            const float* win_src = moba ? ka->in[5] + (size_t)j * D * NC_M : ka->in[2] + (size_t)j * D * NC_H;
            const size_t moff = (size_t)l * NE * 1024 * 1024;
            phase_weights((LAS float*)(lds + wave * 16384), gw, NGW, lane, win_src, NC, ka->in[6] + (size_t)l * D * 512, ka->in[7] + (size_t)l * D * D,
                          ka->in[12] + moff, ka->in[14] + moff, ka->in[16] + moff, WSP(bf16, WS_WIN), WSP(bf16, WS_WKV), WSP(bf16, WS_WO), WSP(bf16, WS_WGU), WSP(bf16, WS_WD));
        PH_END()
        PH_BEGIN(2)
            { pg8::Gemm g{WSP(bf16, WS_XBF), WSP(bf16, WS_WIN), T, NC, D, 0, 0}; pg8::StaticOrder S; S.init(T, NC, G, blk); pg8::EpiPlain E{WSP(bf16, WS_H), NC};
              pg8::gemm_phase<pg8::EpiPlain, pg8::StaticOrder, true, true>(lds, g, S, E); }
            { pg8::Gemm g{WSP(bf16, WS_MEMBF), WSP(bf16, WS_WKV), 512, 512, D, 0, 0}; pg8::StaticOrder S; S.init(512, 512, G, blk); pg8::EpiPlain E{WSP(bf16, WS_KV), 512};
              pg8::gemm_phase<pg8::EpiPlain, pg8::StaticOrder, true, true>(lds, g, S, E); }
        PH_END()
        if (!moba) {
            PH_BEGIN(3)
                for (int u = blk; u < NBATCH * HG_H * HNSEG; u += G) hgrn_seg<false>(lds, WSP(bf16, WS_H), ka->in[3], j, ka->in[4] + j * 128, WSP(float, WS_SLOC), WSP(float, WS_DSEG), WSP(bf16, WS_MIX), u, tid, wave, lane);
                for (int u = blk; u < 512; u += G) memattn_unit2(lds, WSP(bf16, WS_H), NC, qoff, WSP(bf16, WS_KV), WSP(bf16, WS_MIX), u, tid, wave, lane);
            PH_END()
            PH_BEGIN(4)
                hgrn_scan(WSP(float, WS_SLOC), WSP(float, WS_DSEG), gtid, GTHREADS);
            PH_END()
            PH_BEGIN(5)
                for (int u = blk; u < NBATCH * HG_H * HNSEG; u += G) hgrn_seg<true>(lds, WSP(bf16, WS_H), ka->in[3], j, ka->in[4] + j * 128, WSP(float, WS_SLOC), WSP(float, WS_DSEG), WSP(bf16, WS_MIX), u, tid, wave, lane);
            PH_END()
        } else {
            PH_BEGIN(3)
                for (int u = blk; u < 24 * MB_NB; u += G) kmean_unit(lds, WSP(bf16, WS_H), WSP(float, WS_KMEAN), u, tid);
                for (int u = blk; u < 512; u += G) memattn_unit2(lds, WSP(bf16, WS_H), NC, qoff, WSP(bf16, WS_KV), WSP(bf16, WS_MIX), u, tid, wave, lane);
            PH_END()
            PH_BEGIN(4)
                for (int u = blk; u < 24 * MB_NB; u += G) moba_gate_unit(lds, WSP(bf16, WS_H), WSP(float, WS_KMEAN), WSP(unsigned, WS_CTL) + CW_GCOUNT + j * 1536, WSP(int, WS_SELINFO), WSP(unsigned, WS_LIST), u, tid);
            PH_END()
            PH_BEGIN(5)
                for (int r = 0; r * G < 24 * MB_NB; ++r) { const int it = r * G + ((r & 1) ? (G - 1 - blk) : blk);
                    if (it < 24 * MB_NB) moba_attn_item2(lds, WSP(bf16, WS_H), WSP(unsigned, WS_CTL) + CW_GCOUNT + j * 1536, WSP(unsigned, WS_LIST), WSP(float, WS_PO), WSP(float, WS_PML), it, tid, wave, lane); }
            PH_END()
            PH_BEGIN(6)
                moba_combine(WSP(float, WS_PO), WSP(float, WS_PML), WSP(int, WS_SELINFO), WSP(bf16, WS_MIX), gw, NGW, lane);
            PH_END()
        }
        PH_BEGIN(7)
            pg8::Gemm g{WSP(bf16, WS_MIX), WSP(bf16, WS_WO), T, D, D, 0, 0}; pg8::StaticOrder S; S.init(T, D, G, blk); pg8::EpiPlain E{WSP(bf16, WS_Y), D};
            pg8::gemm_phase<pg8::EpiPlain, pg8::StaticOrder, true, true>(lds, g, S, E);
        PH_END()
        PH_BEGIN(8)
            const float* xin = (l == 0) ? ka->in[0] : WSP(float, WS_XA);
            phase_ln1(lds, xin, WSP(bf16, WS_Y), ka->in[8] + l * D, ka->in[9] + l * D, ka->in[10] + (size_t)l * D * NE, ka->in[11] + l * NE, WSP(float, WS_XB), WSP(bf16, WS_XBF),
                      WSP(int, WS_TOK + TOK_E), WSP(int, WS_TOK + TOK_LR), WSP(float, WS_TOK + TOK_W), WSP(int, WS_TOK + TOK_BLKCNT), blk, tid, wave, lane);
        PH_END()
        PH_BEGIN(9)
            phase_dispatch(lds, WSP(int, WS_TOK + TOK_BLKCNT), WSP(int, WS_TOK + TOK_E), WSP(int, WS_TOK + TOK_LR), WSP(int, WS_TOK + TOK_ROW), WSP(int, WS_TOK + TOK_TAB), WSP(bf16, WS_XBF), WSP(bf16, WS_XS), blk, tid, wave, lane);
        PH_END()
        PH_BEGIN(10)
            if (tid < 33) tabL[tid] = WSP(int, WS_TOK + TOK_TAB)[tid];
            __syncthreads();
            int sw_ = 0x7A7A7A7A, sx_ = 0x7F7F7F7F; asm volatile("" : "+s"(sw_), "+s"(sx_));
            pg8::Gemm g{WSP(bf16, WS_XS), WSP(bf16, WS_WGU), MOE_MAXROWS, NE * 2048, D / 2, sw_, sx_}; pg8::MoeOrder S{tabL, 8, G, blk, tabL[32] * 8};
            pg8::EpiSwiglu E{WSP(unsigned char, WS_HID), ka->in[13] + (size_t)l * NE * 1024, ka->in[15] + (size_t)l * NE * 1024};
            pg8::gemm_phase<pg8::EpiSwiglu, pg8::MoeOrder, false, true, true>(lds, g, S, E);
        PH_END()
        PH_BEGIN(11)
            if (tid < 33) tabL[tid] = WSP(int, WS_TOK + TOK_TAB)[tid];
            __syncthreads();
            int sw_ = 0x79797979, sx_ = 0x7F7F7F7F; asm volatile("" : "+s"(sw_), "+s"(sx_));
            pg8::Gemm g{WSP(bf16, WS_HID), WSP(bf16, WS_WD), MOE_MAXROWS, NE * 1024, D / 2, sw_, sx_}; pg8::MoeOrder S{tabL, 4, G, blk, tabL[32] * 4};
            pg8::EpiDown E{WSP(bf16, WS_XS), ka->in[17] + (size_t)l * NE * 1024};
            pg8::gemm_phase<pg8::EpiDown, pg8::MoeOrder, false, true, true>(lds, g, S, E);
        PH_END()
        PH_BEGIN(12)
            float* x2out = (l == DEPTH - 1) ? ka->out : WSP(float, WS_XA);
            phase_ln2(WSP(float, WS_XB), WSP(bf16, WS_XS), WSP(int, WS_TOK + TOK_ROW), WSP(float, WS_TOK + TOK_W), ka->in[18] + l * D, ka->in[19] + l * D, x2out, WSP(bf16, WS_XBF), gw, NGW, lane);
            if (l + 1 < DEPTH) PH_SEAM();
        PH_END_NOSEAM()
}
__global__ void __launch_bounds__(NTHR, 2) fwd_kernel(Args args) {
    extern __shared__ __attribute__((aligned(16))) unsigned char lds_raw[];
    LAS unsigned char* lds = (LAS unsigned char*)lds_raw;
    if (threadIdx.x < 4) ((LAS unsigned*)(lds + MISC_OFF))[threadIdx.x] = 0u;
    __syncthreads();
#if ONE_LAUNCH
    (void)xcd_barrier_post((unsigned*)(args.ws + WS_CTL) + CW_BAR, (volatile LAS unsigned*)(lds + MISC_OFF));
#endif
    { const int l = 0; (void)l;
    PH_BEGIN(0)
        cvt_rows_bf16(ka->in[0], WSP(bf16, WS_XBF), (size_t)T * D / 8, gtid, GTHREADS);
        cvt_rows_bf16(ka->in[1], WSP(bf16, WS_MEMBF), (size_t)512 * D / 8, gtid, GTHREADS);
    PH_END_NOSEAM() }
    layer_phases<0>(lds); layer_phases<1>(lds); layer_phases<2>(lds); layer_phases<3>(lds);
}

extern "C" void kernel_launch(void* const* d_in, const int* in_sizes, int n_in, void* d_out, int out_size, void* d_ws, size_t ws_size, hipStream_t stream) {
    static int ready = 0;
    if (ready == 0) {
        if (n_in != 20 || in_sizes[0] != T * D || out_size != T * D || ws_size < WS_END) { fprintf(stderr, "kernel_launch: unexpected shapes (n_in %d, in0 %d, out %d, ws %zu < %zu)\n", n_in, n_in > 0 ? in_sizes[0] : -1, out_size, ws_size, (size_t)WS_END); ready = -1; return; }
        if (hipFuncSetAttribute((const void*)fwd_kernel, hipFuncAttributeMaxDynamicSharedMemorySize, LDS_BYTES) != hipSuccess) { fprintf(stderr, "kernel_launch: hipFuncSetAttribute failed\n"); ready = -1; return; }
        int per_cu = 0;
        if (hipOccupancyMaxActiveBlocksPerMultiprocessor(&per_cu, (const void*)fwd_kernel, NTHR, LDS_BYTES) != hipSuccess || per_cu < 1) fprintf(stderr, "kernel_launch: occupancy query says %d\n", per_cu);
        (void)hipGetLastError();
        ready = 1;
    }
    if (ready < 0) return;
    if (hipMemsetAsync((char*)d_ws + WS_CTL, 0, CTL_ZERO_BYTES, stream) != hipSuccess) return;
    Args a{};
    for (int i = 0; i < 20; ++i) a.in[i] = (const float*)d_in[i];
    a.out = (float*)d_out; a.ws = (unsigned char*)d_ws;
    a.l_lo = 0; a.l_hi = DEPTH; a.ph_lo = 0; a.ph_hi = NPHASE;
    hipLaunchKernelGGL(fwd_kernel, dim3(GRID), dim3(NTHR), LDS_BYTES, stream, a);
}
```

```cpp
#include <hip/hip_runtime.h>
#include <cstdio>
#include <cstdint>
#include <cmath>
namespace pg8 {
#define PG8_LAS __attribute__((address_space(3)))
typedef unsigned short bf16_t;
typedef short bf16x8 __attribute__((ext_vector_type(8)));
typedef float f32x4 __attribute__((ext_vector_type(4)));
typedef unsigned u32x4 __attribute__((ext_vector_type(4)));
constexpr int BM = 256, BK = 64, HALF = 128, HTB = HALF * BK * 2  , STAGE_BYTES = 8 * HTB, NXCD = 8, WGM = 8;

__host__ __device__ __forceinline__ int lds_byte(int r, int c) { const int st = (r >> 4) * 2 + (c >> 5), rr = r & 15, cc = c & 31, ob = rr * 64 + cc * 2; return st * 1024 + (ob ^ (((ob >> 9) & 1) << 5)); }
__host__ __device__ __forceinline__ void stage_rc(int b, int& R, int& C) { const int st = b / 1024, sb = b % 1024, swz = sb ^ (((sb >> 9) & 1) << 5); R = (st >> 1) * 16 + swz / 64; C = (st & 1) * 32 + (swz % 64) / 2; }
__host__ __device__ __forceinline__ int perm32(int rho) { const int n = rho >> 4, i = rho & 15; return 8 * (i >> 2) + 4 * n + (i & 3); }

struct Unit { int pm, pn; };
struct Gemm { const bf16_t* A; const bf16_t* Bt; int M, N, K; int sw, sx; };
typedef int i32x8 __attribute__((ext_vector_type(8))); typedef int i32x4 __attribute__((ext_vector_type(4)));

struct StaticOrder {
    int nM, nN, nwg, G, c;
    __host__ __device__ void init(int M, int N, int G_, int c_) { nM = M / BM; nN = N / BM; nwg = nM * nN; G = G_; c = c_; }
    __host__ __device__ bool next(int i, Unit& u) const {
        const long L = (long)i * G + c; if (L >= nwg) return false;
        int wgid = (int)L; { const int q = nwg / NXCD, r = nwg % NXCD, xcd = wgid % NXCD, off = wgid / NXCD; wgid = (xcd < r ? xcd * (q + 1) : r * (q + 1) + (xcd - r) * q) + off; }
        const int nig = WGM * nN, gid = wgid / nig, fm = gid * WGM, gsz = (nM - fm) < WGM ? (nM - fm) : WGM;
        u.pm = fm + ((wgid % nig) % gsz); u.pn = (wgid % nig) / gsz; return true;
    }
    __device__ __forceinline__ void a_ready(const Unit&) const {}
    __device__ __forceinline__ void done(const Unit&) const {}
};

__device__ __forceinline__ unsigned cvt_pk_bf16(float lo, float hi) { unsigned r; asm volatile("v_cvt_pk_bf16_f32 %0, %1, %2" : "=v"(r) : "v"(lo), "v"(hi)); return r; }
typedef float f32x2 __attribute__((ext_vector_type(2)));
struct EpiPlain {
    static constexpr bool PERM = true, AFTER_DRAIN = false;
    bf16_t* O; int ldc;
    __device__ __forceinline__ void operator()(const f32x4 (&acc)[2][2][4][2], const Unit& u, int wr, int wc, int fr, int fq) const {
        const int row0 = u.pm * BM + wr * 64 + fr; const int col0 = u.pn * BM + wc * 32 + 8 * fq;
#pragma unroll
        for (int ai = 0; ai < 2; ++ai)
#pragma unroll
            for (int m = 0; m < 4; ++m) { bf16_t* rowp = O + (size_t)(row0 + ai * HALF + m * 16) * ldc + col0;
#pragma unroll
                for (int bj = 0; bj < 2; ++bj) { const f32x4 v0 = acc[ai][bj][m][0], v1 = acc[ai][bj][m][1];
                    u32x4 w; w.x = cvt_pk_bf16(v0[0], v0[1]); w.y = cvt_pk_bf16(v0[2], v0[3]); w.z = cvt_pk_bf16(v1[0], v1[1]); w.w = cvt_pk_bf16(v1[2], v1[3]);
                    *(u32x4*)(rowp + bj * HALF) = w; } }
    }
};
__device__ __forceinline__ float swiglu1(float g, float u) {
    g = fminf(g, 7.0f); u = fminf(fmaxf(u, -7.0f), 7.0f);
    const float s = __builtin_amdgcn_rcpf(1.0f + __builtin_amdgcn_exp2f(g * (-1.702f * 1.4426950408889634f)));
    return g * s * (u + 1.0f);
}
__device__ __forceinline__ unsigned pk4_fp8e(float a, float b, float c, float d) { int w = 0; w = __builtin_amdgcn_cvt_pk_fp8_f32(a, b, w, false); w = __builtin_amdgcn_cvt_pk_fp8_f32(c, d, w, true); return (unsigned)w; }
struct EpiSwiglu {
    static constexpr bool PERM = true, AFTER_DRAIN = false;
    unsigned char* hid; const float* bg; const float* bu;
    __device__ __forceinline__ void operator()(const f32x4 (&acc)[2][2][4][2], const Unit& u, int wr, int wc, int fr, int fq) const {
        const int e = u.pn >> 3, pn = u.pn & 7;
        const int row0 = u.pm * BM + wr * 64 + fr; const int col0 = pn * 128 + wc * 32 + 8 * fq;
        const f32x4 g0 = *(const f32x4*)(bg + e * 1024 + col0), g1 = *(const f32x4*)(bg + e * 1024 + col0 + 4);
        const f32x4 u0 = *(const f32x4*)(bu + e * 1024 + col0), u1 = *(const f32x4*)(bu + e * 1024 + col0 + 4);
#pragma unroll
        for (int ai = 0; ai < 2; ++ai)
#pragma unroll
            for (int m = 0; m < 4; ++m) { unsigned char* rowp = hid + (size_t)(row0 + ai * HALF + m * 16) * 1024 + col0;
                const f32x4 ga = acc[ai][0][m][0] + g0, gb = acc[ai][0][m][1] + g1, ua = acc[ai][1][m][0] + u0, ub = acc[ai][1][m][1] + u1;
                typedef unsigned u32x2 __attribute__((ext_vector_type(2))); u32x2 w;
                w.x = pk4_fp8e(swiglu1(ga[0], ua[0]), swiglu1(ga[1], ua[1]), swiglu1(ga[2], ua[2]), swiglu1(ga[3], ua[3]));
                w.y = pk4_fp8e(swiglu1(gb[0], ub[0]), swiglu1(gb[1], ub[1]), swiglu1(gb[2], ub[2]), swiglu1(gb[3], ub[3]));
                *(u32x2*)rowp = w; }
    }
};
struct EpiDown {
    static constexpr bool PERM = true, AFTER_DRAIN = false;
    unsigned char* y; const float* bd;
    __device__ __forceinline__ void operator()(const f32x4 (&acc)[2][2][4][2], const Unit& u, int wr, int wc, int fr, int fq) const {
        const int e = u.pn >> 2, pn = u.pn & 3;
        const int row0 = u.pm * BM + wr * 64 + fr; const int col0 = pn * BM + wc * 32 + 8 * fq;
        f32x4 bv[2][2];
#pragma unroll
        for (int bj = 0; bj < 2; ++bj)
#pragma unroll
            for (int n = 0; n < 2; ++n) bv[bj][n] = *(const f32x4*)(bd + e * 1024 + col0 + bj * HALF + 4 * n);
#pragma unroll
        for (int ai = 0; ai < 2; ++ai)
#pragma unroll
            for (int m = 0; m < 4; ++m) { unsigned char* rowp = y + (size_t)(row0 + ai * HALF + m * 16) * 1024 + col0;
#pragma unroll
                for (int bj = 0; bj < 2; ++bj) { const f32x4 v0 = (acc[ai][bj][m][0] + bv[bj][0]) * 16.f, v1 = (acc[ai][bj][m][1] + bv[bj][1]) * 16.f;
                    typedef unsigned u32x2 __attribute__((ext_vector_type(2))); u32x2 w; w.x = pk4_fp8e(v0[0], v0[1], v0[2], v0[3]); w.y = pk4_fp8e(v1[0], v1[1], v1[2], v1[3]);
                    *(u32x2*)(rowp + bj * HALF) = w; } }
    }
};
struct MoeOrder {
    const PG8_LAS int* tab; int npn, G, c, nunits;
    __device__ __forceinline__ bool next(int i, Unit& u) const {
        const int tpx = 32 / npn, s = c >> 3, tile = (i * 8 + (c & 7)) * tpx + s / npn, pn = s % npn;
        if ((i * 8) * tpx >= nunits / npn) return false;
        if (tile >= nunits / npn) { u.pm = 0; u.pn = 0; return false; }
        int e = 0;
#pragma unroll
        for (int k = 1; k < 32; ++k) e += (tab[k] <= tile) ? 1 : 0;
        u.pm = tile; u.pn = __builtin_amdgcn_readfirstlane(e) * npn + pn; return true;
    }
    __device__ __forceinline__ void a_ready(const Unit&) const {}
    __device__ __forceinline__ void done(const Unit&) const {}
};
template <class Epi, class Sched, bool ALIGN_EPI = false, bool SP2 = false, bool F8 = false>
__device__ __forceinline__ void gemm_phase(PG8_LAS unsigned char* lds, const Gemm g, const Sched& S, const Epi& E) {
    int tid_ = threadIdx.x; asm volatile("" : "+v"(tid_));
    const int tid = tid_, wid = __builtin_amdgcn_readfirstlane(tid >> 6), lane = tid & 63, wr = wid >> 2, wc = wid & 3, fr = lane & 15, fq = lane >> 4;
    const int K = g.K, nt = K / BK;
    unsigned voffA, voffB;
    { int R, C; stage_rc(tid * 16, R, C); const int Rb = Epi::PERM ? ((R & ~31) + perm32(R & 31)) : R; voffA = (unsigned)(R * K + C) * 2u; voffB = (unsigned)(Rb * K + C) * 2u; }
    const unsigned qstep = 64u * (unsigned)K * 2u;
    const unsigned kstep = (unsigned)(BK * 2);
    const unsigned hstep = (unsigned)HALF * (unsigned)K * 2u;
    const unsigned tstep = 2u * hstep;
    const __amdgpu_buffer_rsrc_t rA = __builtin_amdgcn_make_buffer_rsrc((void*)g.A, 0, 0x7FFFFFFF, 0x00020000), rB = __builtin_amdgcn_make_buffer_rsrc((void*)g.Bt, 0, 0x7FFFFFFF, 0x00020000);
    const unsigned ldsw = (unsigned)wid * 1024u;
    const int aoff = lds_byte(wr * 64 + fr, fq * 8), boff = lds_byte(wc * 32 + fr, fq * 8);
#define PG8_SA(b, h) (((b) * 2 + (h)) * HTB)
#define PG8_SB(b, h) ((4 + (b) * 2 + (h)) * HTB)
#define PG8_STG(bufoff, rsrc, soff, voff) do { _Pragma("unroll") for (int _i = 0; _i < 2; ++_i) \
        __builtin_amdgcn_raw_ptr_buffer_load_lds((rsrc), (PG8_LAS void*)(lds + (bufoff) + ldsw + _i * 8192), 16, (int)(voff), (int)((soff) + (unsigned)_i * qstep), 0, 0); } while (0)
#define PG8_STGA(bufoff, soff) PG8_STG(bufoff, rA, soff, voffA)
#define PG8_STGB(bufoff, soff) PG8_STG(bufoff, rB, soff, voffB)
#define PG8_LDA(dst, b, h) do { _Pragma("unroll") for (int m = 0; m < 4; ++m) { if constexpr (F8) { const i32x4 lo_ = *(const PG8_LAS i32x4*)(lds + PG8_SA(b, h) + aoff + m * 2048), hi_ = *(const PG8_LAS i32x4*)(lds + PG8_SA(b, h) + aoff + m * 2048 + 1024); \
            dst##_8[m] = __builtin_shufflevector(lo_, hi_, 0, 1, 2, 3, 4, 5, 6, 7); } else { _Pragma("unroll") for (int k = 0; k < 2; ++k) dst[m][k] = *(const PG8_LAS bf16x8*)(lds + PG8_SA(b, h) + aoff + m * 2048 + k * 1024); } } } while (0)
#define PG8_LDB(dst, b, h) do { _Pragma("unroll") for (int n = 0; n < 2; ++n) { if constexpr (F8) { const i32x4 lo_ = *(const PG8_LAS i32x4*)(lds + PG8_SB(b, h) + boff + n * 2048), hi_ = *(const PG8_LAS i32x4*)(lds + PG8_SB(b, h) + boff + n * 2048 + 1024); \
            dst##_8[n] = __builtin_shufflevector(lo_, hi_, 0, 1, 2, 3, 4, 5, 6, 7); } else { _Pragma("unroll") for (int k = 0; k < 2; ++k) dst[n][k] = *(const PG8_LAS bf16x8*)(lds + PG8_SB(b, h) + boff + n * 2048 + k * 1024); } } } while (0)
#define PG8_MMA(ai, bj, At, Bt) do { __builtin_amdgcn_s_setprio(1); _Pragma("unroll") for (int m = 0; m < 4; ++m) _Pragma("unroll") for (int n = 0; n < 2; ++n) { \
        if constexpr (F8) acc[ai][bj][m][n] = __builtin_amdgcn_mfma_scale_f32_16x16x128_f8f6f4(Bt##_8[n], At##_8[m], acc[ai][bj][m][n], 0, 0, 0, g.sw, 0, g.sx); \
        else { _Pragma("unroll") for (int k = 0; k < 2; ++k) acc[ai][bj][m][n] = __builtin_amdgcn_mfma_f32_16x16x32_bf16(Bt[n][k], At[m][k], acc[ai][bj][m][n], 0, 0, 0); } } \
        __builtin_amdgcn_s_setprio(0); } while (0)
#define PG8_WAIT_V(n) asm volatile("s_waitcnt vmcnt(" #n ")" ::: "memory")
#define PG8_WAIT_L(n) asm volatile("s_waitcnt lgkmcnt(" #n ")" ::: "memory")
#define PG8_BAR __builtin_amdgcn_s_barrier()
#define PG8_SCHED __builtin_amdgcn_sched_barrier(0)
    Unit cur, nxt; int ui = 0;
    if (!S.next(0, cur)) return;
    f32x4 acc[2][2][4][2];
#pragma unroll
    for (int a = 0; a < 2; ++a)
#pragma unroll
        for (int b = 0; b < 2; ++b)
#pragma unroll
            for (int m = 0; m < 4; ++m)
#pragma unroll
                for (int n = 0; n < 2; ++n) acc[a][b][m][n] = (f32x4){0.f, 0.f, 0.f, 0.f};
    bf16x8 At[4][2], B0[2][2], B1[2][2]; i32x8 At_8[4], B0_8[2], B1_8[2];
    unsigned cA = (unsigned)cur.pm * tstep, cB = (unsigned)cur.pn * tstep;
    S.a_ready(cur);
    if constexpr (SP2) {
        PG8_STGB(PG8_SB(0, 0), cB); PG8_STGB(PG8_SB(0, 1), cB + hstep); PG8_STGA(PG8_SA(0, 0), cA); PG8_STGA(PG8_SA(0, 1), cA + hstep);
        if (wr == 1) PG8_BAR;
        PG8_WAIT_V(2); PG8_BAR;
        PG8_STGB(PG8_SB(1, 0), cB + kstep); PG8_STGA(PG8_SA(1, 0), cA + kstep); PG8_STGB(PG8_SB(1, 1), cB + hstep + kstep);
        PG8_WAIT_V(6); PG8_BAR;
    } else {
        PG8_STGB(PG8_SB(0, 0), cB); PG8_STGA(PG8_SA(0, 0), cA); PG8_STGB(PG8_SB(0, 1), cB + hstep); PG8_STGA(PG8_SA(0, 1), cA + hstep);
        if (wr == 1) PG8_BAR;
        PG8_WAIT_V(4); PG8_BAR;
        PG8_STGB(PG8_SB(1, 0), cB + kstep); PG8_STGA(PG8_SA(1, 0), cA + kstep); PG8_STGB(PG8_SB(1, 1), cB + hstep + kstep);
        PG8_WAIT_V(6); PG8_BAR;
    }
    for (;;) {
        const bool has_next = S.next(ui + 1, nxt);
        const unsigned nA = has_next ? (unsigned)nxt.pm * tstep : cA, nB = has_next ? (unsigned)nxt.pn * tstep : cB;
#pragma unroll 1
        for (int t = 0; t < nt; t += 2) {
            const bool last = (t == nt - 2);
            const unsigned a1 = cA + (unsigned)(t + 1) * kstep;
            const unsigned a2 = last ? nA : cA + (unsigned)(t + 2) * kstep, b2 = last ? nB : cB + (unsigned)(t + 2) * kstep;
            const unsigned a3 = a2 + kstep, b3 = b2 + kstep;
            if (last && has_next) S.a_ready(nxt);
            if constexpr (SP2) {
            PG8_LDB(B0, 0, 0); PG8_LDB(B1, 0, 1); PG8_SCHED; PG8_LDA(At, 0, 0); PG8_STGA(PG8_SA(1, 1), a1 + hstep);
            PG8_WAIT_V(8); PG8_WAIT_L(0); PG8_BAR; PG8_MMA(0, 0, At, B0); PG8_MMA(0, 1, At, B1); PG8_BAR; PG8_SCHED;
            PG8_LDA(At, 0, 1); PG8_STGB(PG8_SB(0, 0), b2); PG8_STGB(PG8_SB(0, 1), b2 + hstep); PG8_STGA(PG8_SA(0, 0), a2);
            PG8_WAIT_V(8); PG8_WAIT_L(0); PG8_BAR; PG8_MMA(1, 0, At, B0); PG8_MMA(1, 1, At, B1); PG8_BAR; PG8_SCHED;
            PG8_LDB(B0, 1, 0); PG8_LDB(B1, 1, 1); PG8_SCHED; PG8_LDA(At, 1, 0); PG8_STGA(PG8_SA(0, 1), a2 + hstep);
            PG8_WAIT_V(8); PG8_WAIT_L(0); PG8_BAR; PG8_MMA(0, 0, At, B0); PG8_MMA(0, 1, At, B1); PG8_BAR; PG8_SCHED;
            PG8_LDA(At, 1, 1); PG8_STGB(PG8_SB(1, 0), b3); PG8_STGB(PG8_SB(1, 1), b3 + hstep); PG8_STGA(PG8_SA(1, 0), a3);
            PG8_WAIT_V(8); PG8_WAIT_L(0); PG8_BAR; PG8_MMA(1, 0, At, B0); PG8_MMA(1, 1, At, B1); PG8_BAR; PG8_SCHED;
            } else {
            PG8_LDB(B0, 0, 0); PG8_SCHED; PG8_LDA(At, 0, 0); PG8_STGA(PG8_SA(1, 1), a1 + hstep);
            PG8_WAIT_L(8); PG8_BAR; PG8_WAIT_L(0); PG8_MMA(0, 0, At, B0); PG8_BAR; PG8_SCHED;
            PG8_LDB(B1, 0, 1); PG8_STGB(PG8_SB(0, 0), b2);
            PG8_BAR; PG8_WAIT_L(0); PG8_MMA(0, 1, At, B1); PG8_BAR;
            PG8_LDA(At, 0, 1); PG8_STGA(PG8_SA(0, 0), a2);
            PG8_BAR; PG8_WAIT_L(0); PG8_MMA(1, 0, At, B0); PG8_BAR; PG8_SCHED;
            PG8_STGB(PG8_SB(0, 1), b2 + hstep);
            PG8_WAIT_V(6); PG8_BAR; PG8_MMA(1, 1, At, B1); PG8_BAR;
            PG8_LDB(B0, 1, 0); PG8_SCHED; PG8_LDA(At, 1, 0); PG8_STGA(PG8_SA(0, 1), a2 + hstep);
            PG8_WAIT_L(8); PG8_BAR; PG8_WAIT_L(0); PG8_MMA(0, 0, At, B0); PG8_BAR; PG8_SCHED;
            PG8_LDB(B1, 1, 1); PG8_STGB(PG8_SB(1, 0), b3);
            PG8_BAR; PG8_WAIT_L(0); PG8_MMA(0, 1, At, B1); PG8_BAR;
            PG8_LDA(At, 1, 1); PG8_STGA(PG8_SA(1, 0), a3);
            PG8_BAR; PG8_WAIT_L(0); PG8_MMA(1, 0, At, B0); PG8_BAR; PG8_SCHED;
            PG8_STGB(PG8_SB(1, 1), b3 + hstep);
            PG8_WAIT_V(6); PG8_BAR; PG8_MMA(1, 1, At, B1); PG8_BAR;
            }
        }
        if constexpr (ALIGN_EPI) { if (wr == 0) PG8_BAR; }
        if constexpr (!Epi::AFTER_DRAIN) { int t2_ = threadIdx.x; asm volatile("" : "+v"(t2_)); E(acc, cur, wr, wc, t2_ & 15, (t2_ & 63) >> 4); S.done(cur); }
        if (!has_next) break;
#pragma unroll
        for (int a = 0; a < 2; ++a)
#pragma unroll
            for (int b = 0; b < 2; ++b)
#pragma unroll
                for (int m = 0; m < 4; ++m)
#pragma unroll
                    for (int n = 0; n < 2; ++n) acc[a][b][m][n] = (f32x4){0.f, 0.f, 0.f, 0.f};
        cur = nxt; cA = nA; cB = nB; ++ui;
        if constexpr (ALIGN_EPI) { if (wr == 1) PG8_BAR; }
    }
    PG8_WAIT_V(0);
    if constexpr (!ALIGN_EPI) { if (wr == 0) PG8_BAR; }
    PG8_BAR;
    if constexpr (Epi::AFTER_DRAIN) { E.fused(acc, cur, wr, wc, fr, fq, lds, wid, lane); S.done(cur); }
#undef PG8_SA
#undef PG8_SB
#undef PG8_STG
#undef PG8_STGA
#undef PG8_STGB
#undef PG8_LDA
#undef PG8_LDB
#undef PG8_MMA
#undef PG8_WAIT_V
#undef PG8_WAIT_L
#undef PG8_BAR
#undef PG8_SCHED
}
}

constexpr int NWAVES = 8, NTHR = 512, GRID = 256;
constexpr int NBATCH = 2, SEQ = 16384, T = NBATCH * SEQ, D = 1024, DEPTH = 4;
constexpr int MIXW = 768, NC_H = 3328, NC_M = 2560;
constexpr int HG_H = 6;
constexpr int HSEG = 256, HNSEG = SEQ / HSEG;
constexpr int MB_H = 12, MB_NB = 64;
constexpr int NE = 32;
constexpr float DN_ALPHA = 1.6817928305074290f;
constexpr int MOE_MAXROWS = T * 4 + NE * 256;
#ifndef ONE_LAUNCH
#define ONE_LAUNCH 1
#endif
constexpr int NPHASE = 13;

constexpr size_t MiB = 1u << 20;
constexpr size_t WS_CTL = 0, CTL_ZERO_BYTES = 1 * MiB;
constexpr size_t WS_WIN = 1 * MiB, WS_WKV = 9 * MiB, WS_WO = 10 * MiB, WS_WGU = 12 * MiB, WS_WD = 140 * MiB;
constexpr size_t WS_XBF = 204 * MiB, WS_XA = 268 * MiB, WS_XB = 396 * MiB, WS_MEMBF = 524 * MiB, WS_KV = 525 * MiB;
constexpr size_t WS_H = 526 * MiB, WS_MIX = 734 * MiB, WS_Y = 798 * MiB, WS_SLOC = 862 * MiB, WS_DSEG = 910 * MiB, WS_KMEAN = 911 * MiB;
constexpr size_t WS_SELINFO = 912 * MiB, WS_TOK = 914 * MiB, WS_R1 = 918 * MiB;
constexpr size_t WS_LIST = WS_R1, WS_PML = WS_R1 + 96 * MiB, WS_PO = WS_R1 + 108 * MiB;
constexpr size_t WS_XS = WS_R1, WS_HID = WS_R1 + 272 * MiB;
constexpr size_t WS_END = WS_R1 + 544 * MiB;
static_assert((size_t)MOE_MAXROWS * 1024 * 2 <= 272 * MiB, "moe rows");
static_assert((size_t)T * MB_H * 4 * 64 * 4 <= 384 * MiB && (size_t)24 * 64 * 16384 * 4 <= 96 * MiB, "moba bufs");
constexpr size_t TOK_E = 0, TOK_LR = 512 * 1024, TOK_W = 1024 * 1024, TOK_ROW = 1536 * 1024, TOK_BLKCNT = 2048 * 1024, TOK_TAB = 2048 * 1024 + 65536;
constexpr int CW_BAR = 4096, CW_GCOUNT = 8192;

constexpr int RING_BYTES = 131072, MISC_OFF = RING_BYTES, LDS_BYTES = 147456;

#define GAS __attribute__((address_space(1)))
#define LAS __attribute__((address_space(3)))
typedef unsigned short bf16;
typedef unsigned v4u __attribute__((ext_vector_type(4)));
typedef unsigned v2u __attribute__((ext_vector_type(2)));
typedef float f32x4 __attribute__((ext_vector_type(4)));
typedef float f32x2 __attribute__((ext_vector_type(2)));
#define LDS_WAIT() asm volatile("s_waitcnt lgkmcnt(0)" ::: "memory")
__device__ __forceinline__ unsigned f2bf(float f) { unsigned u = __builtin_bit_cast(unsigned, f); return (u + 0x7fffu + ((u >> 16) & 1u)) >> 16; }
__device__ __forceinline__ unsigned pk2(float lo, float hi) { return f2bf(lo) | (f2bf(hi) << 16); }
__device__ __forceinline__ float bflo(unsigned w) { return __builtin_bit_cast(float, w << 16); }
__device__ __forceinline__ float bfhi(unsigned w) { return __builtin_bit_cast(float, w & 0xffff0000u); }
__device__ __forceinline__ float bf2f(bf16 h) { return __builtin_bit_cast(float, (unsigned)h << 16); }
__device__ __forceinline__ float sigmoidf_(float z) { return __builtin_amdgcn_rcpf(1.0f + __builtin_amdgcn_exp2f(-1.4426950408889634f * z)); }
template <int X> __device__ __forceinline__ float xorf(float v) { return __builtin_bit_cast(float, __builtin_amdgcn_ds_swizzle(__builtin_bit_cast(int, v), (X << 10) | 0x1F)); }
template <int X> __device__ __forceinline__ int xori(int v) { return __builtin_amdgcn_ds_swizzle(v, (X << 10) | 0x1F); }
__device__ __forceinline__ float wave_sum(float v) {
    v += xorf<1>(v); v += xorf<2>(v); v += xorf<4>(v); v += xorf<8>(v); v += xorf<16>(v);
    return __builtin_bit_cast(float, __builtin_amdgcn_readlane(__builtin_bit_cast(int, v), 0)) + __builtin_bit_cast(float, __builtin_amdgcn_readlane(__builtin_bit_cast(int, v), 32));
}
__device__ __forceinline__ float wave_max(float v) {
    v = fmaxf(v, xorf<1>(v)); v = fmaxf(v, xorf<2>(v)); v = fmaxf(v, xorf<4>(v)); v = fmaxf(v, xorf<8>(v)); v = fmaxf(v, xorf<16>(v));
    return fmaxf(__builtin_bit_cast(float, __builtin_amdgcn_readlane(__builtin_bit_cast(int, v), 0)), __builtin_bit_cast(float, __builtin_amdgcn_readlane(__builtin_bit_cast(int, v), 32)));
}
__device__ __forceinline__ float xor32f(float v, int lane) { return __builtin_bit_cast(float, __builtin_amdgcn_ds_bpermute((lane ^ 32) << 2, __builtin_bit_cast(int, v))); }
#define XB_TMO      128
#define XB_XCNT(j)  (256  + 64 * (j))
#define XB_XSUB(j)  (1280 + 64 * (j))
#define XB_XGEN(j)  (2304 + 64 * (j))
#define XB_TOP      3328
#define XB_TOPGEN   3392
#define XCD_BAR_WORDS 3456
#define XB_SPIN_CAP (1u << 18)

__device__ __forceinline__ unsigned xb_ld(unsigned* p)              { return __hip_atomic_load(p, __ATOMIC_RELAXED, __HIP_MEMORY_SCOPE_AGENT); }
__device__ __forceinline__ unsigned xb_add(unsigned* p, unsigned v) { return __hip_atomic_fetch_add(p, v, __ATOMIC_RELAXED, __HIP_MEMORY_SCOPE_AGENT); }
__device__ __forceinline__ unsigned xb_xcc_id() { return (unsigned)__builtin_amdgcn_s_getreg((3 << 11) | 20) & 0xFu; }
#define XB_SPIN(cond, bar) do { unsigned _sp = 0; while (cond) { __builtin_amdgcn_s_sleep(1); \
    if ((++_sp & 255u) == 0u) { if (xb_ld(&(bar)[XB_TMO])) break; if (_sp > XB_SPIN_CAP) { atomicAdd(&(bar)[XB_TMO], 1u); break; } } } } while (0)

struct XcdBarrier {
    unsigned* bar; unsigned x;
    volatile LAS unsigned* st;
};

__device__ __forceinline__ XcdBarrier xcd_barrier_post(unsigned* bar, volatile LAS unsigned* st) {
    XcdBarrier b; b.bar = bar; b.x = xb_xcc_id(); b.st = st;
    if (threadIdx.x == 0) (void)xb_add(&bar[XB_XCNT(b.x)], 1u);
    return b;
}
__device__ __forceinline__ void xcd_barrier_complete(unsigned* bar, unsigned x, unsigned& nloc, unsigned& nx) {
    const unsigned G = gridDim.x * gridDim.y * gridDim.z;
    unsigned sum, cnt, mine, sp = 0u;
    for (;;) {
        sum = 0u; cnt = 0u; mine = 0u;
#pragma unroll
        for (unsigned j = 0; j < 16; ++j) { const unsigned c = xb_ld(&bar[XB_XCNT(j)]); sum += c; cnt += (c > 0u) ? 1u : 0u; mine = (j == x) ? c : mine; }
        if (sum == G) break;
        __builtin_amdgcn_s_sleep(1);
        if ((++sp & 255u) == 0u) { if (xb_ld(&bar[XB_TMO])) break; if (sp > XB_SPIN_CAP) { atomicAdd(&bar[XB_TMO], 1u); break; } }
    }
    nloc = mine > 0u ? mine : 1u; nx = cnt > 0u ? cnt : 1u;
}

__device__ __forceinline__ void xcd_barrier(const XcdBarrier& b) {
    asm volatile("s_waitcnt vmcnt(0)" ::: "memory");
    __syncthreads();
    if (threadIdx.x == 0) {
        unsigned* bar = b.bar;
        __builtin_amdgcn_s_waitcnt(0);
        unsigned nloc = b.st[0], nx = b.st[1];
        if (nloc == 0u) { xcd_barrier_complete(bar, b.x, nloc, nx); b.st[0] = nloc; b.st[1] = nx; }
        const unsigned old = xb_add(&bar[XB_XSUB(b.x)], 1u);
        const unsigned gen = old / nloc;
        if (old + 1u == (gen + 1u) * nloc) {
            __builtin_amdgcn_fence(__ATOMIC_RELEASE, "agent");
            asm volatile("s_waitcnt vmcnt(0)" ::: "memory");
            const unsigned og = xb_add(&bar[XB_TOP], 1u);
            const unsigned tg = og / nx;
            if (og + 1u == (tg + 1u) * nx) xb_add(&bar[XB_TOPGEN], 1u);
            else XB_SPIN(xb_ld(&bar[XB_TOPGEN]) == tg, bar);
            __builtin_amdgcn_fence(__ATOMIC_ACQUIRE, "agent");
            xb_add(&bar[XB_XGEN(b.x)], 1u);
            asm volatile("s_waitcnt vmcnt(0)" ::: "memory");
        } else {
            XB_SPIN(xb_ld(&bar[XB_XGEN(b.x)]) == gen, bar);
            __builtin_amdgcn_fence(__ATOMIC_ACQUIRE, "agent");
            asm volatile("s_waitcnt vmcnt(0)" ::: "memory");
        }
    }
    __syncthreads();
}

__device__ __forceinline__ void cvt_rows_bf16(const float* src, bf16* dst, size_t n8, size_t gtid, size_t gthreads) {
    for (size_t i = gtid; i < n8; i += gthreads) { const f32x4 a = ((const f32x4*)src)[2 * i], b = ((const f32x4*)src)[2 * i + 1];
        v4u o; o.x = pk2(a.x, a.y); o.y = pk2(a.z, a.w); o.z = pk2(b.x, b.y); o.w = pk2(b.z, b.w); ((v4u*)dst)[i] = o; }
}
__device__ __forceinline__ void transpose_item(const float* W, int N, bf16* WT, int dst_row0, LAS float* scr, int k0, int n0, int lane) {
#pragma unroll 8
    for (int i = 0; i < 32; ++i) { const int kk = 2 * i + (lane >> 5); scr[kk * 33 + (lane & 31)] = W[(size_t)(k0 + kk) * N + n0 + (lane & 31)]; }
    LDS_WAIT(); asm volatile("" ::: "memory");
    const int c = lane & 7;
#pragma unroll
    for (int j = 0; j < 4; ++j) { const int n = (lane >> 3) + 8 * j; const LAS float* s = scr + (8 * c) * 33 + n;
        v4u o; o.x = pk2(s[0 * 33], s[1 * 33]); o.y = pk2(s[2 * 33], s[3 * 33]); o.z = pk2(s[4 * 33], s[5 * 33]); o.w = pk2(s[6 * 33], s[7 * 33]);
        *(v4u*)(WT + (size_t)(dst_row0 + n) * 1024 + k0 + 8 * c) = o; }
    LDS_WAIT(); asm volatile("" ::: "memory");
}
__device__ __forceinline__ unsigned pk4_fp8(float a, float b, float c, float d) { int w = 0; w = __builtin_amdgcn_cvt_pk_fp8_f32(a, b, w, false); w = __builtin_amdgcn_cvt_pk_fp8_f32(c, d, w, true); return (unsigned)w; }
__device__ __forceinline__ void transpose_item_f8(const float* W, int N, unsigned char* WT8, int dst_row0, LAS float* scr, int k0, int n0, int lane, float wscale) {
#pragma unroll 8
    for (int i = 0; i < 32; ++i) { const int kk = 2 * i + (lane >> 5); scr[kk * 33 + (lane & 31)] = W[(size_t)(k0 + kk) * N + n0 + (lane & 31)]; }
    LDS_WAIT(); asm volatile("" ::: "memory");
    const int c = lane & 7;
#pragma unroll
    for (int j = 0; j < 4; ++j) { const int n = (lane >> 3) + 8 * j; const LAS float* s = scr + (8 * c) * 33 + n;
        v2u o; o.x = pk4_fp8(s[0 * 33] * wscale, s[1 * 33] * wscale, s[2 * 33] * wscale, s[3 * 33] * wscale); o.y = pk4_fp8(s[4 * 33] * wscale, s[5 * 33] * wscale, s[6 * 33] * wscale, s[7 * 33] * wscale);
        *(v2u*)(WT8 + (size_t)(dst_row0 + n) * 1024 + k0 + 8 * c) = o; }
    LDS_WAIT(); asm volatile("" ::: "memory");
}
__device__ __forceinline__ void phase_weights(LAS float* scr, int gw, int ngw, int lane, const float* win_src, int NC, const float* wkv_src, const float* wo_src,
                                              const float* wg_src, const float* wu_src, const float* wd_src, bf16* win_t, bf16* wkv_t, bf16* wo_t, bf16* wgu_t, bf16* wd_t) {
    const int nbw = NC / 32, nWin = nbw * 16, NIT = nWin + 256 + 512 + NE * 1536;
    for (int it = gw; it < NIT; it += ngw) {
        int r = it;
        if (r < nWin) { const int kb = r / nbw, nb = r - kb * nbw; transpose_item(win_src, NC, win_t, 32 * nb, scr, 64 * kb, 32 * nb, lane); continue; } r -= nWin;
        if (r < 256) { const int kb = r >> 4, nb = r & 15; transpose_item(wkv_src, 512, wkv_t, 32 * nb, scr, 64 * kb, 32 * nb, lane); continue; } r -= 256;
        if (r < 512) { const int kb = r >> 5, nb = r & 31; transpose_item(wo_src, 1024, wo_t, 32 * nb, scr, 64 * kb, 32 * nb, lane); continue; } r -= 512;
        const int e = r / 1536, q = r - e * 1536, which = q >> 9, rr = q & 511, kb = rr >> 5, nb = rr & 31, n0 = 32 * nb;
        const size_t eoff = (size_t)e * 1024 * 1024;
        if (which == 0) transpose_item_f8(wg_src + eoff, 1024, (unsigned char*)wgu_t + 2 * eoff, (n0 >> 7) * 256 + (n0 & 127), scr, 64 * kb, n0, lane, 32.f);
        else if (which == 1) transpose_item_f8(wu_src + eoff, 1024, (unsigned char*)wgu_t + 2 * eoff, (n0 >> 7) * 256 + 128 + (n0 & 127), scr, 64 * kb, n0, lane, 32.f);
        else transpose_item_f8(wd_src + eoff, 1024, (unsigned char*)wd_t + eoff, n0, scr, 64 * kb, n0, lane, 64.f);
    }
}

template <bool OUT>
__device__ __forceinline__ void hgrn_seg(LAS unsigned char* lds, const bf16* h, const float* lbl, int j, const float* normg, float* Sloc, float* Dseg, bf16* mix, int unit, int tid, int wave, int lane) {
    const int seg = unit & (HNSEG - 1), bh = unit >> 6, hh = bh % HG_H, b = bh / HG_H;
    const int v = tid & 127, dg = tid >> 7;
    LAS float* fgs = (LAS float*)lds; LAS float* vs = fgs + 4096; LAS float* qs = vs + 4096; LAS float* op = qs + 4096;
    f32x2 st[16];
    float* Sp = Sloc + (size_t)unit * 16384 + (size_t)(dg * 32) * 128 + v;
#pragma unroll
    for (int dd = 0; dd < 16; ++dd) { st[dd].x = OUT ? Sp[(2 * dd) * 128] : 0.f; st[dd].y = OUT ? Sp[(2 * dd + 1) * 128] : 0.f; }
    float dprod = 1.f;
    const int stok = tid >> 4, c8 = (tid & 15) * 8;
    float lb[8];
#pragma unroll
    for (int i = 0; i < 8; ++i) { lb[i] = 0.f; if (j > 0) { const float a0 = lbl[hh * 128 + c8 + i], a1 = lbl[MIXW + hh * 128 + c8 + i]; lb[i] = 1.f / (1.f + __expf(a0 - a1)); } }
    for (int ch = 0; ch < HSEG / 32; ++ch) {
        const size_t t0 = (size_t)b * SEQ + seg * HSEG + ch * 32;
        { const bf16* row = h + (t0 + stok) * NC_H + hh * 128 + c8;
          const v4u f8 = *(const v4u*)(row + 768), i8 = *(const v4u*)(row + 1536); v4u q8 = {0u, 0u, 0u, 0u}; if (OUT) q8 = *(const v4u*)row;
#pragma unroll
          for (int w = 0; w < 4; ++w) { const float f0 = bflo(f8[w]), f1 = bfhi(f8[w]); const int o = stok * 128 + c8 + 2 * w;
              fgs[o] = lb[2 * w] + (1.f - lb[2 * w]) * sigmoidf_(f0); fgs[o + 1] = lb[2 * w + 1] + (1.f - lb[2 * w + 1]) * sigmoidf_(f1);
              vs[o] = bflo(i8[w]); vs[o + 1] = bfhi(i8[w]);
              if (OUT) { const float q0 = bflo(q8[w]), q1 = bfhi(q8[w]); qs[o] = q0 * sigmoidf_(q0); qs[o + 1] = q1 * sigmoidf_(q1); } } }
        __syncthreads();
        if (!OUT) { if (tid < 128) { for (int tt = 0; tt < 32; ++tt) dprod *= fgs[tt * 128 + tid]; } }
        f32x4 fA[8], qA[8], fB[8], qB[8]; float vA, vB;
#define HG_LOAD(F, Q, V, tt_) do { V = vs[(tt_) * 128 + v]; _Pragma("unroll") for (int d4 = 0; d4 < 8; ++d4) { F[d4] = *(const LAS f32x4*)(fgs + (tt_) * 128 + dg * 32 + d4 * 4); \
            if (OUT) Q[d4] = *(const LAS f32x4*)(qs + (tt_) * 128 + dg * 32 + d4 * 4); } } while (0)
#define HG_STEP(F, Q, V, tt_) do { const f32x2 vv2 = {V, V}; f32x2 acc2 = {0.f, 0.f}; _Pragma("unroll") for (int d4 = 0; d4 < 8; ++d4) { \
            const f32x2 fa = {F[d4].x, F[d4].y}, fb = {F[d4].z, F[d4].w}; \
            st[2 * d4] = fa * (st[2 * d4] - vv2) + vv2; st[2 * d4 + 1] = fb * (st[2 * d4 + 1] - vv2) + vv2; \
            if (OUT) { const f32x2 qa = {Q[d4].x, Q[d4].y}, qb = {Q[d4].z, Q[d4].w}; acc2 = qa * st[2 * d4] + acc2; acc2 = qb * st[2 * d4 + 1] + acc2; } } \
            if (OUT) op[(dg * 32 + (tt_)) * 128 + v] = acc2.x + acc2.y; } while (0)
        HG_LOAD(fA, qA, vA, 0);
#pragma unroll 1
        for (int tt = 0; tt < 32; tt += 2) {
            HG_LOAD(fB, qB, vB, tt + 1);
            __builtin_amdgcn_sched_barrier(0);
            HG_STEP(fA, qA, vA, tt);
            __builtin_amdgcn_sched_barrier(0);
            if (tt + 2 < 32) HG_LOAD(fA, qA, vA, tt + 2);
            __builtin_amdgcn_sched_barrier(0);
            HG_STEP(fB, qB, vB, tt + 1);
            __builtin_amdgcn_sched_barrier(0);
        }
#undef HG_LOAD
#undef HG_STEP
        if (OUT) {
            __syncthreads();
#pragma unroll
            for (int k = 0; k < 4; ++k) { const int tt = wave + 8 * k; float o0 = 0.f, o1 = 0.f;
#pragma unroll
                for (int g = 0; g < 4; ++g) { o0 += op[(g * 32 + tt) * 128 + lane]; o1 += op[(g * 32 + tt) * 128 + lane + 64]; }
                const float ms = wave_sum(o0 * o0 + o1 * o1) * (1.f / 128.f), r = 1.f / sqrtf(ms + 1e-6f);
                const bf16* grow = h + (t0 + tt) * NC_H + 2304 + hh * 128; const float g0 = bf2f(grow[lane]), g1 = bf2f(grow[lane + 64]);
                bf16* mrow = mix + (t0 + tt) * 1024 + hh * 128;
                mrow[lane] = (bf16)f2bf(o0 * r * normg[lane] * sigmoidf_(g0)); mrow[lane + 64] = (bf16)f2bf(o1 * r * normg[lane + 64] * sigmoidf_(g1)); }
        }
        __syncthreads();
    }
    if (!OUT) {
#pragma unroll
        for (int dd = 0; dd < 16; ++dd) { Sp[(2 * dd) * 128] = st[dd].x; Sp[(2 * dd + 1) * 128] = st[dd].y; }
        if (tid < 128) Dseg[(size_t)unit * 128 + tid] = dprod;
    }
}
__device__ __forceinline__ void hgrn_scan(float* Sloc, const float* Dseg, size_t gtid, size_t gthreads) {
    for (size_t idx = gtid; idx < (size_t)NBATCH * HG_H * 16384; idx += gthreads) { const int bh = (int)(idx >> 14), e = (int)(idx & 16383), d = e >> 7; float cur = 0.f;
        for (int seg = 0; seg < HNSEG; ++seg) { const size_t u = (size_t)bh * HNSEG + seg; float* p = Sloc + u * 16384 + e; const float tmp = *p; *p = cur; cur = Dseg[u * 128 + d] * cur + tmp; } }
}

template <bool MASK>
__device__ __forceinline__ void attn4(const LAS unsigned* Ks, const LAS bf16* Vs, const LAS float* qst, LAS float* pb, int lane, const int (&tq)[4], int kbase, float slope,
                                      float (&mo)[4], float (&lo)[4], float (&oo)[4]) {
    float sc[4][4];
#pragma unroll
    for (int a = 0; a < 4; ++a)
#pragma unroll
        for (int c = 0; c < 4; ++c) sc[a][c] = 0.f;
#pragma unroll 4
    for (int dd = 0; dd < 32; ++dd) {
        f32x2 qv[4];
#pragma unroll
        for (int qi = 0; qi < 4; ++qi) qv[qi] = *(const LAS f32x2*)(qst + qi * 64 + 2 * dd);
#pragma unroll
        for (int kk = 0; kk < 4; ++kk) { const unsigned kw = Ks[(lane + 64 * kk) * 33 + dd]; const float k0 = bflo(kw), k1 = bfhi(kw);
#pragma unroll
            for (int qi = 0; qi < 4; ++qi) sc[qi][kk] += qv[qi].x * k0 + qv[qi].y * k1; }
    }
#pragma unroll
    for (int qi = 0; qi < 4; ++qi) { float mx = -INFINITY;
#pragma unroll
        for (int kk = 0; kk < 4; ++kk) { const int pos = kbase + lane + 64 * kk; float lg = sc[qi][kk] * 0.125f - slope * (float)(tq[qi] - pos); if (MASK && pos > tq[qi]) lg = -INFINITY; sc[qi][kk] = lg; mx = fmaxf(mx, lg); }
        mx = wave_max(mx); float s = 0.f;
#pragma unroll
        for (int kk = 0; kk < 4; ++kk) { const float p = __builtin_amdgcn_exp2f((sc[qi][kk] - mx) * 1.4426950408889634f); pb[qi * 256 + lane + 64 * kk] = p; s += p; }
        lo[qi] = wave_sum(s); mo[qi] = mx; }
    float o[4] = {0.f, 0.f, 0.f, 0.f};
#pragma unroll 4
    for (int k4 = 0; k4 < 64; ++k4) { f32x4 p4[4];
#pragma unroll
        for (int qi = 0; qi < 4; ++qi) p4[qi] = *(const LAS f32x4*)(pb + qi * 256 + 4 * k4);
#pragma unroll
        for (int jj = 0; jj < 4; ++jj) { const float vv = bf2f(Vs[(4 * k4 + jj) * 64 + lane]);
#pragma unroll
            for (int qi = 0; qi < 4; ++qi) o[qi] += p4[qi][jj] * vv; } }
#pragma unroll
    for (int qi = 0; qi < 4; ++qi) oo[qi] = o[qi];
}
constexpr int AT_KS = 0, AT_VS = 33792, AT_WV = 66560, AT_WVB = 5120;

__device__ __forceinline__ void memattn_unit(LAS unsigned char* lds, const bf16* h, int NC, int qoff, const bf16* kv, bf16* mix, int unit, int tid, int wave, int lane) {
    const int chunk = unit & 31, bm = unit >> 5, mh = bm & 3, b = bm >> 2;
    LAS unsigned* Ks = (LAS unsigned*)(lds + AT_KS); LAS unsigned* Vs32 = (LAS unsigned*)(lds + AT_VS);
    LAS float* qst = (LAS float*)(lds + AT_WV + wave * AT_WVB); LAS float* pb = qst + 256;
    for (int i = 0; i < 16; ++i) { const int idx = tid + 512 * i, r = idx >> 5, dd = idx & 31; const unsigned* src = (const unsigned*)(kv + (size_t)(b * 256 + r) * 512 + mh * 64);
        Ks[r * 33 + dd] = src[dd]; Vs32[r * 32 + dd] = src[128 + dd]; }
    __syncthreads();
    for (int qd = 0; qd < 16; ++qd) { const size_t tg = (size_t)b * SEQ + chunk * 512 + wave * 64 + qd * 4;
#pragma unroll
        for (int qi = 0; qi < 4; ++qi) qst[qi * 64 + lane] = bf2f(h[(tg + qi) * NC + qoff + mh * 64 + lane]);
        const int tq[4] = {0, 0, 0, 0}; float m[4], l[4], o[4];
        attn4<false>(Ks, (const LAS bf16*)Vs32, qst, pb, lane, tq, 0, 0.f, m, l, o);
#pragma unroll
        for (int qi = 0; qi < 4; ++qi) mix[(tg + qi) * 1024 + MIXW + mh * 64 + lane] = (bf16)f2bf(o[qi] / l[qi]); }
    __syncthreads();
}

typedef short s16x8 __attribute__((ext_vector_type(8)));
typedef float f32x16 __attribute__((ext_vector_type(16)));
typedef float f32x2_t __attribute__((ext_vector_type(2))); typedef __bf16 bf16x2_t __attribute__((ext_vector_type(2)));
__device__ __forceinline__ unsigned cvtpk(float lo, float hi) { f32x2_t v = {lo, hi}; bf16x2_t b = __builtin_convertvector(v, bf16x2_t); return __builtin_bit_cast(unsigned, b); }
constexpr int AT2_K = 0, AT2_V = 36864, AT2_KROW = 144, AT2_VROW = 528;
__device__ __forceinline__ void stage_kv_images(LAS unsigned char* lds, const bf16* kp, const bf16* vp, size_t row_stride, int tid) {
#pragma unroll
    for (int i = 0; i < 4; ++i) { const int idx = tid + 512 * i, key = idx >> 3, c = idx & 7;
        const v4u kx = *(const v4u*)(kp + (size_t)key * row_stride + 8 * c);
        *(LAS v4u*)(lds + AT2_K + key * AT2_KROW + c * 16) = kx;
        const v4u vx = *(const v4u*)(vp + (size_t)key * row_stride + 8 * c);
        const int pos = (key & ~15) | (key & 3) | ((key & 4) << 1) | ((key & 8) >> 1);
        LAS bf16* vt = (LAS bf16*)(lds + AT2_V) + pos;
#pragma unroll
        for (int w = 0; w < 4; ++w) { vt[(8 * c + 2 * w) * (AT2_VROW / 2)] = (bf16)(vx[w] & 0xffffu); vt[(8 * c + 2 * w + 1) * (AT2_VROW / 2)] = (bf16)(vx[w] >> 16); } }
}
template <bool MASK>
__device__ __forceinline__ void attn_tile32(const LAS unsigned char* lds, const bf16* qrow, int lane, float dist0, float slope2, f32x16 (&o)[2], float& mrow, float& lrow) {
    const int r = lane & 31, hf = lane >> 5;
    s16x8 qf[4];
#pragma unroll
    for (int s = 0; s < 4; ++s) qf[s] = *(const s16x8*)(qrow + 16 * s + 8 * hf);
    f32x16 acc[8];
    const LAS unsigned char* kb = lds + AT2_K + r * AT2_KROW + hf * 16;
#pragma unroll
    for (int kt = 0; kt < 8; ++kt) {
#pragma unroll
        for (int i = 0; i < 16; ++i) acc[kt][i] = 0.f;
#pragma unroll
        for (int s = 0; s < 4; ++s) { const s16x8 kf = *(const LAS s16x8*)(kb + kt * 32 * AT2_KROW + s * 32); acc[kt] = __builtin_amdgcn_mfma_f32_32x32x16_bf16(kf, qf[s], acc[kt], 0, 0, 0); }
        __builtin_amdgcn_sched_barrier(0); }
    const float base2 = dist0 - 4.f * (float)hf; float mx = -INFINITY;
#pragma unroll
    for (int kt = 0; kt < 8; ++kt)
#pragma unroll
        for (int i = 0; i < 16; ++i) { const float dist = base2 - (float)(32 * kt + (i & 3) + 8 * (i >> 2)); float lg = acc[kt][i] * (0.125f * 1.4426950408889634f);
            if (MASK) { lg -= slope2 * dist; if (dist < 0.f) lg = -INFINITY; } acc[kt][i] = lg; mx = fmaxf(mx, lg); }
    mx = fmaxf(mx, xor32f(mx, lane));
    float sum = 0.f;
#pragma unroll
    for (int i = 0; i < 16; ++i) { o[0][i] = 0.f; o[1][i] = 0.f; }
    const LAS unsigned char* vb = lds + AT2_V + r * AT2_VROW + hf * 16;
#pragma unroll
    for (int kt = 0; kt < 8; ++kt) {
#pragma unroll
        for (int i = 0; i < 16; ++i) { const float p = __builtin_amdgcn_exp2f(acc[kt][i] - mx); sum += p; acc[kt][i] = p; }
#pragma unroll
        for (int s2 = 0; s2 < 2; ++s2) { v4u pw; pw.x = cvtpk(acc[kt][8 * s2], acc[kt][8 * s2 + 1]); pw.y = cvtpk(acc[kt][8 * s2 + 2], acc[kt][8 * s2 + 3]);
            pw.z = cvtpk(acc[kt][8 * s2 + 4], acc[kt][8 * s2 + 5]); pw.w = cvtpk(acc[kt][8 * s2 + 6], acc[kt][8 * s2 + 7]); const s16x8 pf = __builtin_bit_cast(s16x8, pw);
#pragma unroll
            for (int dt = 0; dt < 2; ++dt) { const s16x8 vf = *(const LAS s16x8*)(vb + dt * 32 * AT2_VROW + (32 * kt + 16 * s2) * 2); o[dt] = __builtin_amdgcn_mfma_f32_32x32x16_bf16(vf, pf, o[dt], 0, 0, 0); } }
        __builtin_amdgcn_sched_barrier(0); }
    sum += xor32f(sum, lane);
    mrow = mx; lrow = sum;
}
__device__ __forceinline__ void memattn_unit2(LAS unsigned char* lds, const bf16* h, int NC, int qoff, const bf16* kv, bf16* mix, int unit, int tid, int wave, int lane) {
    const int chunk = unit & 63, bm = unit >> 6, mh = bm & 3, b = bm >> 2, r = lane & 31, hf = lane >> 5;
    const bf16* kvrow0 = kv + (size_t)(b * 256) * 512 + mh * 64;
    stage_kv_images(lds, kvrow0, kvrow0 + 256, 512, tid);
    __syncthreads();
    { const size_t tg = (size_t)b * SEQ + chunk * 256 + wave * 32 + r;
        f32x16 o[2]; float m2, l;
        attn_tile32<false>(lds, h + tg * NC + qoff + mh * 64, lane, 0.f, 0.f, o, m2, l);
        const float inv = 1.f / l; bf16* mp = mix + tg * 1024 + MIXW + mh * 64 + 4 * hf;
#pragma unroll
        for (int dt = 0; dt < 2; ++dt)
#pragma unroll
            for (int g = 0; g < 4; ++g) { v2u w; w.x = cvtpk(o[dt][4 * g] * inv, o[dt][4 * g + 1] * inv); w.y = cvtpk(o[dt][4 * g + 2] * inv, o[dt][4 * g + 3] * inv); *(v2u*)(mp + 32 * dt + 8 * g) = w; } }
    __syncthreads();
}
__device__ __forceinline__ void kmean_unit(LAS unsigned char* lds, const bf16* h, float* kmean, int unit, int tid) {
    const int n = unit & 63, bh = unit >> 6, hh = bh % MB_H, b = bh / MB_H, d = tid & 63, part = tid >> 6;
    LAS float* red = (LAS float*)lds;
    float s = 0.f; const bf16* p = h + ((size_t)b * SEQ + n * 256 + part * 32) * NC_M + 768 + hh * 64 + d;
    for (int i = 0; i < 32; ++i) s += bf2f(p[(size_t)i * NC_M]);
    red[part * 64 + d] = s; __syncthreads();
    if (tid < 64) { float a = 0.f; for (int pp = 0; pp < 8; ++pp) a += red[pp * 64 + tid]; kmean[((size_t)bh * 64 + n) * 64 + tid] = a * (1.f / 256.f); }
    __syncthreads();
}
__device__ __forceinline__ void moba_gate_unit(LAS unsigned char* lds, const bf16* h, const float* kmean, unsigned* gcount, int* selinfo, unsigned* list, int unit, int tid) {
    const int c = unit & 63, bh = unit >> 6, hh = bh % MB_H, b = bh / MB_H;
    LAS float* km = (LAS float*)lds; LAS int* hist = (LAS int*)(lds + 16384); LAS int* base = hist + 64;
    for (int i = tid; i < 4096; i += NTHR) km[i] = kmean[(size_t)bh * 4096 + i];
    if (tid < 64) hist[tid] = 0;
    __syncthreads();
    int s0 = 0, s1 = 0, s2 = 0, r0 = 0, r1 = 0, r2 = 0, ns = 0; const int t = c * 256 + tid;
    if (tid < 256) {
        float q[64]; const v4u* qp = (const v4u*)(h + ((size_t)b * SEQ + t) * NC_M + hh * 64);
#pragma unroll
        for (int w = 0; w < 8; ++w) { const v4u x = qp[w]; q[8 * w] = bflo(x.x); q[8 * w + 1] = bfhi(x.x); q[8 * w + 2] = bflo(x.y); q[8 * w + 3] = bfhi(x.y); q[8 * w + 4] = bflo(x.z); q[8 * w + 5] = bfhi(x.z); q[8 * w + 6] = bflo(x.w); q[8 * w + 7] = bfhi(x.w); }
        float v0 = -INFINITY, v1 = -INFINITY, v2 = -INFINITY;
        for (int n = 0; n < c; ++n) { float g = 0.f;
#pragma unroll
            for (int d4 = 0; d4 < 16; ++d4) { const f32x4 k4 = *(const LAS f32x4*)(km + n * 64 + 4 * d4); g += q[4 * d4] * k4.x + q[4 * d4 + 1] * k4.y + q[4 * d4 + 2] * k4.z + q[4 * d4 + 3] * k4.w; }
            if (g > v0) { v2 = v1; s2 = s1; v1 = v0; s1 = s0; v0 = g; s0 = n; } else if (g > v1) { v2 = v1; s2 = s1; v1 = g; s1 = n; } else if (g > v2) { v2 = g; s2 = n; } }
        ns = c < 3 ? c : 3;
        if (ns > 0) r0 = __hip_atomic_fetch_add(hist + s0, 1, __ATOMIC_RELAXED, __HIP_MEMORY_SCOPE_WORKGROUP);
        if (ns > 1) r1 = __hip_atomic_fetch_add(hist + s1, 1, __ATOMIC_RELAXED, __HIP_MEMORY_SCOPE_WORKGROUP);
        if (ns > 2) r2 = __hip_atomic_fetch_add(hist + s2, 1, __ATOMIC_RELAXED, __HIP_MEMORY_SCOPE_WORKGROUP);
        selinfo[((size_t)b * SEQ + t) * MB_H + hh] = ns;
    }
    __syncthreads();
    if (tid < 64) { const int hc = hist[tid]; if (hc > 0) base[tid] = (int)__hip_atomic_fetch_add(gcount + bh * 64 + tid, (unsigned)hc, __ATOMIC_RELAXED, __HIP_MEMORY_SCOPE_AGENT); }
    __syncthreads();
    if (tid < 256) { unsigned* lp = list + ((size_t)bh * 64 << 14);
        if (ns > 0) lp[((size_t)s0 << 14) + base[s0] + r0] = (unsigned)t;
        if (ns > 1) lp[((size_t)s1 << 14) + base[s1] + r1] = (unsigned)t | (1u << 14);
        if (ns > 2) lp[((size_t)s2 << 14) + base[s2] + r2] = (unsigned)t | (2u << 14); }
    __syncthreads();
}
__device__ __forceinline__ void moba_attn_item(LAS unsigned char* lds, const bf16* h, const unsigned* gcount, const unsigned* list, float* po, float* pml, int item, int tid, int wave, int lane) {
    const int n = item / 24, bh = item - n * 24, hh = bh % MB_H, b = bh / MB_H;
    LAS unsigned* Ks = (LAS unsigned*)(lds + AT_KS); LAS unsigned* Vs32 = (LAS unsigned*)(lds + AT_VS);
    LAS float* qst = (LAS float*)(lds + AT_WV + wave * AT_WVB); LAS float* pb = qst + 256;
    for (int i = 0; i < 16; ++i) { const int idx = tid + 512 * i, r = idx >> 5, dd = idx & 31; const unsigned* src = (const unsigned*)(h + ((size_t)b * SEQ + n * 256 + r) * NC_M + hh * 64);
        Ks[r * 33 + dd] = src[384 + dd]; Vs32[r * 32 + dd] = src[768 + dd]; }
    __syncthreads();
    const int cnt = (int)gcount[bh * 64 + n], total = 256 + cnt, nquads = (total + 3) >> 2;
    const float slope = hh < 8 ? ldexpf(1.0f, -(hh + 1)) : ldexpf(0.70710678118654752f, -(hh - 8));
    const unsigned* lp = list + (((size_t)bh * 64 + n) << 14);
    for (int quad = wave; quad < nquads; quad += 8) {
        int tq[4], slot[4];
#pragma unroll
        for (int qi = 0; qi < 4; ++qi) { int idx = quad * 4 + qi; idx = idx < total ? idx : total - 1;
            if (idx < 256) { tq[qi] = n * 256 + idx; slot[qi] = 3; } else { const unsigned e = lp[idx - 256]; tq[qi] = (int)(e & 16383u); slot[qi] = (int)(e >> 14); } }
#pragma unroll
        for (int qi = 0; qi < 4; ++qi) qst[qi * 64 + lane] = bf2f(h[((size_t)b * SEQ + tq[qi]) * NC_M + hh * 64 + lane]);
        float m[4], l[4], o[4];
        attn4<true>(Ks, (const LAS bf16*)Vs32, qst, pb, lane, tq, n * 256, slope, m, l, o);
#pragma unroll
        for (int qi = 0; qi < 4; ++qi) if (quad * 4 + qi < total) { const size_t pi = (((size_t)b * SEQ + tq[qi]) * MB_H + hh) * 4 + slot[qi];
            po[pi * 64 + lane] = o[qi]; if (lane == 0) { pml[pi * 2] = m[qi]; pml[pi * 2 + 1] = l[qi]; } }
    }
    __syncthreads();
}

__device__ __forceinline__ void moba_attn_item2(LAS unsigned char* lds, const bf16* h, const unsigned* gcount, const unsigned* list, float* po, float* pml, int item, int tid, int wave, int lane) {
    const int n = item / 24, bh = item - n * 24, hh = bh % MB_H, b = bh / MB_H, r = lane & 31, hf = lane >> 5;
    const bf16* hrow0 = h + ((size_t)b * SEQ + n * 256) * NC_M + hh * 64;
    stage_kv_images(lds, hrow0 + 768, hrow0 + 1536, NC_M, tid);
    __syncthreads();
    const int cnt = (int)gcount[bh * 64 + n], total = 256 + cnt, ntiles = (total + 31) >> 5;
    const float slope2 = (hh < 8 ? ldexpf(1.0f, -(hh + 1)) : ldexpf(0.70710678118654752f, -(hh - 8))) * 1.4426950408889634f;
    const unsigned* lp = list + (((size_t)bh * 64 + n) << 14);
#pragma unroll 1
    for (int tile = wave; tile < ntiles; tile += NWAVES) {
        int idx = tile * 32 + r; const bool valid = idx < total; idx = valid ? idx : total - 1;
        int tq, slot; if (idx < 256) { tq = n * 256 + idx; slot = 3; } else { const unsigned e = lp[idx - 256]; tq = (int)(e & 16383u); slot = (int)(e >> 14); }
        f32x16 o[2]; float m2, l;
        attn_tile32<true>(lds, h + ((size_t)b * SEQ + tq) * NC_M + hh * 64, lane, (float)(tq - n * 256), slope2, o, m2, l);
        if (valid) { const size_t pi = (((size_t)b * SEQ + tq) * MB_H + hh) * 4 + slot; float* op = po + pi * 64 + 4 * hf;
#pragma unroll
            for (int dt = 0; dt < 2; ++dt)
#pragma unroll
                for (int g = 0; g < 4; ++g) { const f32x4 v = {o[dt][4 * g], o[dt][4 * g + 1], o[dt][4 * g + 2], o[dt][4 * g + 3]}; *(f32x4*)(op + 32 * dt + 8 * g) = v; }
            if (hf == 0) { pml[pi * 2] = m2; pml[pi * 2 + 1] = l; } }
    }
    __syncthreads();
}
__device__ __forceinline__ void moba_combine(const float* __restrict__ po, const float* __restrict__ pml, const int* __restrict__ selinfo, bf16* __restrict__ mix, int gw, int ngw, int lane) {
    const int sub = lane >> 4, d4 = (lane & 15) * 4;
#pragma unroll 2
    for (int idx = gw * 4 + sub; idx < T * MB_H; idx += ngw * 4) { const int tg = idx / MB_H, hh = idx - tg * MB_H, ns = selinfo[idx]; const size_t p4 = (size_t)idx * 4;
        f32x2 ml[4]; f32x4 ov[4];
#pragma unroll
        for (int j = 0; j < 4; ++j) { ml[j] = ((const f32x2*)pml)[p4 + j]; ov[j] = *(const f32x4*)(po + (p4 + j) * 64 + d4); }
        float M = ml[3].x;
#pragma unroll
        for (int j = 0; j < 3; ++j) { const bool ok = j < ns; ml[j].x = ok ? ml[j].x : -INFINITY; ml[j].y = ok ? ml[j].y : 0.f; M = fmaxf(M, ml[j].x);
            ov[j].x = ok ? ov[j].x : 0.f; ov[j].y = ok ? ov[j].y : 0.f; ov[j].z = ok ? ov[j].z : 0.f; ov[j].w = ok ? ov[j].w : 0.f; }
        float den = 0.f; f32x4 num = {0.f, 0.f, 0.f, 0.f};
#pragma unroll
        for (int j = 0; j < 4; ++j) { const float w = __builtin_amdgcn_exp2f(ml[j].x - M); den += w * ml[j].y; num += ov[j] * w; }
        const float inv = 1.f / den; v2u o; o.x = pk2(num.x * inv, num.y * inv); o.y = pk2(num.z * inv, num.w * inv);
        *(v2u*)(mix + (size_t)tg * 1024 + hh * 64 + d4) = o; }
}

__device__ __forceinline__ void ln_row(f32x4 (&v)[4], const f32x4 (&gv)[4], const f32x4 (&bv)[4]) {
    float s = 0.f;
#pragma unroll
    for (int j = 0; j < 4; ++j) s += (v[j].x + v[j].y) + (v[j].z + v[j].w);
    const float mean = wave_sum(s) * (1.f / D); float s2 = 0.f;
#pragma unroll
    for (int j = 0; j < 4; ++j) { v[j] = v[j] - mean; s2 += (v[j].x * v[j].x + v[j].y * v[j].y) + (v[j].z * v[j].z + v[j].w * v[j].w); }
    const float rstd = 1.f / sqrtf(wave_sum(s2) * (1.f / D) + 1e-5f);
#pragma unroll
    for (int j = 0; j < 4; ++j) v[j] = v[j] * rstd * gv[j] + bv[j];
}
__device__ __forceinline__ void phase_ln1(LAS unsigned char* lds, const bf16* y, const float* g, const float* bb, const float* wr, const float* br,
                                          bf16* xbf, int* tok_e, int* tok_lr, float* tok_w, int* blk_cnt, int blk, int tid, int wave, int lane) {
    LAS float* xst = (LAS float*)lds;
    LAS float* part = (LAS float*)(lds + 32768);
    LAS int* hist = (LAS int*)(lds + 40960);
    if (tid < 32) hist[tid] = 0;
    constexpr int TPB = T / GRID;
    const int e = lane & 31, half = lane >> 5;
    float wreg[64];
    { const float* wp = wr + (size_t)(wave * 128 + half * 64) * NE + e;
#pragma unroll
      for (int k = 0; k < 64; ++k) wreg[k] = wp[k * NE]; }
    const float bre = br[e];
    __syncthreads();
    f32x4 gv[4], bv[4];
#pragma unroll
    for (int j = 0; j < 4; ++j) { gv[j] = ((const f32x4*)g)[lane + 64 * j]; bv[j] = ((const f32x4*)bb)[lane + 64 * j]; }
    v2u xn[4], yn[4];
    { const size_t t0 = (size_t)blk * TPB + wave; const v2u* xr = (const v2u*)(xbf + t0 * D) + lane; const v2u* yr = (const v2u*)(y + t0 * D) + lane;
#pragma unroll
      for (int j = 0; j < 4; ++j) { xn[j] = xr[64 * j]; yn[j] = yr[64 * j]; } }
    for (int grp = 0; grp < TPB / NWAVES; ++grp) { const size_t t = (size_t)blk * TPB + grp * NWAVES + wave;
        { f32x4 v[4];
#pragma unroll
          for (int j = 0; j < 4; ++j) { const v2u xw = xn[j]; const v2u yw = yn[j];
              v[j].x = DN_ALPHA * bflo(xw.x) + bflo(yw.x); v[j].y = DN_ALPHA * bfhi(xw.x) + bfhi(yw.x); v[j].z = DN_ALPHA * bflo(xw.y) + bflo(yw.y); v[j].w = DN_ALPHA * bfhi(xw.y) + bfhi(yw.y); }
          if (grp + 1 < TPB / NWAVES) { const v2u* xr = (const v2u*)(xbf + (t + NWAVES) * D) + lane; const v2u* yr = (const v2u*)(y + (t + NWAVES) * D) + lane;
#pragma unroll
              for (int j = 0; j < 4; ++j) { xn[j] = xr[64 * j]; yn[j] = yr[64 * j]; } }
          ln_row(v, gv, bv);
          v2u* xb = (v2u*)(xbf + t * D) + lane;
#pragma unroll
          for (int j = 0; j < 4; ++j) { v2u w; w.x = pk2(v[j].x, v[j].y); w.y = pk2(v[j].z, v[j].w); xb[64 * j] = w; ((LAS f32x4*)(xst + wave * 1024))[lane + 64 * j] = v[j]; } }
        __syncthreads();
#pragma unroll 2
        for (int tk = 0; tk < 8; ++tk) { float acc = 0.f; const LAS float* xs_ = xst + tk * 1024 + wave * 128 + half * 64;
#pragma unroll
            for (int k4 = 0; k4 < 16; ++k4) { const f32x4 xv = *(const LAS f32x4*)(xs_ + 4 * k4); acc += xv.x * wreg[4 * k4]; acc += xv.y * wreg[4 * k4 + 1]; acc += xv.z * wreg[4 * k4 + 2]; acc += xv.w * wreg[4 * k4 + 3]; }
            acc += xor32f(acc, lane);
            if (half == 0) part[(wave * 8 + tk) * 32 + e] = acc; }
        __syncthreads();
        float logit = bre;
#pragma unroll
        for (int w = 0; w < 8; ++w) logit += part[(w * 8 + wave) * 32 + e];
        int se[4]; float sv[4];
#pragma unroll
        for (int k = 0; k < 4; ++k) { float bvv = logit; int bi = e;
#define ARGMAX_STEP(X) { const float ov = xorf<X>(bvv); const int oi = xori<X>(bi); if (ov > bvv || (ov == bvv && oi < bi)) { bvv = ov; bi = oi; } }
            ARGMAX_STEP(1) ARGMAX_STEP(2) ARGMAX_STEP(4) ARGMAX_STEP(8) ARGMAX_STEP(16)
#undef ARGMAX_STEP
            se[k] = bi; sv[k] = bvv; if (e == bi) logit = -INFINITY; }
        const float e1 = __expf(sv[1] - sv[0]), e2 = __expf(sv[2] - sv[0]), e3 = __expf(sv[3] - sv[0]), inv = 1.f / (1.f + e1 + e2 + e3);
        const float wk[4] = {inv, e1 * inv, e2 * inv, e3 * inv};
        if (lane == 0) {
#pragma unroll
            for (int k = 0; k < 4; ++k) { const int lr = __hip_atomic_fetch_add(hist + se[k], 1, __ATOMIC_RELAXED, __HIP_MEMORY_SCOPE_WORKGROUP);
                tok_e[t * 4 + k] = se[k]; tok_lr[t * 4 + k] = lr; tok_w[t * 4 + k] = wk[k]; } }
    }
    __syncthreads();
    if (tid < 32) blk_cnt[blk * 32 + tid] = hist[tid];
    __syncthreads();
}
__device__ __forceinline__ void phase_dispatch(LAS unsigned char* lds, const int* __restrict__ blk_cnt, const int* __restrict__ tok_e, const int* __restrict__ tok_lr, int* __restrict__ tok_row, int* __restrict__ tab,
                                               const bf16* __restrict__ xbf, bf16* __restrict__ xs, int blk, int tid, int wave, int lane) {
    LAS int* tot = (LAS int*)lds; LAS int* pre = tot + 32; LAS int* pst = pre + 32; LAS int* rows = pst + 64;
    if (tid < 32) { int s = 0, p = 0;
#pragma unroll 8
        for (int bb = 0; bb < GRID; ++bb) { const int c = blk_cnt[bb * 32 + tid]; p += (bb < blk) ? c : 0; s += c; } tot[tid] = s; pre[tid] = p; }
    __syncthreads();
    if (tid == 0) { int acc = 0; for (int e = 0; e < 32; ++e) { pst[e] = acc; acc += ((tot[e] + 255) >> 8) << 8; } pst[32] = acc; }
    __syncthreads();
    if (blk == 0 && tid < 33) tab[tid] = pst[tid] >> 8;
    constexpr int TPB = T / GRID;
    static_assert(TPB * 4 == NTHR, "one (token, k) pair per thread");
    { const size_t ti = (size_t)blk * TPB * 4 + tid; const int e = tok_e[ti]; const int r = pst[e] + pre[e] + tok_lr[ti]; tok_row[ti] = r; rows[tid] = r; }
    __syncthreads();
#pragma unroll 4
    for (int i = wave; i < TPB * 4; i += NWAVES) { const int r = rows[i];
        const v4u* src = (const v4u*)(xbf + ((size_t)blk * TPB + (i >> 2)) * D) + 2 * lane; const v4u a = src[0], b = src[1];
        v4u o; o.x = pk4_fp8(bflo(a.x), bfhi(a.x), bflo(a.y), bfhi(a.y)); o.y = pk4_fp8(bflo(a.z), bfhi(a.z), bflo(a.w), bfhi(a.w)); o.z = pk4_fp8(bflo(b.x), bfhi(b.x), bflo(b.y), bfhi(b.y)); o.w = pk4_fp8(bflo(b.z), bfhi(b.z), bflo(b.w), bfhi(b.w));
        ((v4u*)((unsigned char*)xs + (size_t)r * D))[lane] = o; }
    __syncthreads();
}
__device__ __forceinline__ f32x4 fp8x4_to_f32(unsigned w) {
    const f32x2 lo = __builtin_amdgcn_cvt_pk_f32_fp8((int)w, false), hi = __builtin_amdgcn_cvt_pk_f32_fp8((int)w, true); return (f32x4){lo.x, lo.y, hi.x, hi.y};
}
__device__ __forceinline__ void phase_ln2(const unsigned char* __restrict__ yrows, const int* __restrict__ tok_row, const float* __restrict__ tok_w, const float* __restrict__ g, const float* __restrict__ bb,
                                          float* __restrict__ xout, bf16* xbf, int gw, int ngw, int lane) {
    f32x4 gv[4], bv[4];
#pragma unroll
    for (int j = 0; j < 4; ++j) { gv[j] = ((const f32x4*)g)[lane + 64 * j]; bv[j] = ((const f32x4*)bb)[lane + 64 * j]; }
    static_assert(T % (2 * GRID * NWAVES) == 0, "two tokens per wave per step");
    for (int t0 = gw; t0 < T; t0 += 2 * ngw) {
        f32x4 v[2][4];
#pragma unroll
        for (int u = 0; u < 2; ++u) { const int t = t0 + u * ngw; int r[4]; float w[4];
#pragma unroll
            for (int k = 0; k < 4; ++k) { r[k] = tok_row[(size_t)t * 4 + k]; w[k] = tok_w[(size_t)t * 4 + k] * (1.f / 16.f); }
            const v2u* xr = (const v2u*)(xbf + (size_t)t * D) + lane;
#pragma unroll
            for (int j = 0; j < 4; ++j) { f32x4 f = {0.f, 0.f, 0.f, 0.f};
#pragma unroll
                for (int k = 0; k < 4; ++k) { const unsigned yw = ((const unsigned*)(yrows + (size_t)r[k] * D))[lane + 64 * j]; f += fp8x4_to_f32(yw) * w[k]; }
                const v2u xw = xr[64 * j]; v[u][j].x = DN_ALPHA * bflo(xw.x) + f.x; v[u][j].y = DN_ALPHA * bfhi(xw.x) + f.y; v[u][j].z = DN_ALPHA * bflo(xw.y) + f.z; v[u][j].w = DN_ALPHA * bfhi(xw.y) + f.w; } }
#pragma unroll
        for (int u = 0; u < 2; ++u) { const int t = t0 + u * ngw;
            ln_row(v[u], gv, bv);
            if (xout) { f32x4* xo = (f32x4*)(xout + (size_t)t * D) + lane;
#pragma unroll
                for (int j = 0; j < 4; ++j) xo[64 * j] = v[u][j]; }
            else { v2u* xb = (v2u*)(xbf + (size_t)t * D) + lane;
#pragma unroll
                for (int j = 0; j < 4; ++j) { v2u ww; ww.x = pk2(v[u][j].x, v[u][j].y); ww.y = pk2(v[u][j].z, v[u][j].w); xb[64 * j] = ww; } } } }
}

struct Args { const float* in[20]; float* out; unsigned char* ws; int l_lo, l_hi, ph_lo, ph_hi; };
typedef const __attribute__((address_space(4))) Args* KArgsP;
#define KA_LOAD() ({ KArgsP p_ = (KArgsP)__builtin_amdgcn_kernarg_segment_ptr(); asm volatile("" : "+s"(p_)); p_; })
#ifndef PHMASK
#define PHMASK 0xFFFF
#endif
#ifndef REPEAT_MASK
#define REPEAT_MASK 0
#endif
#ifndef REPEAT_LMASK
#define REPEAT_LMASK 0xF
#endif
#define PH_BEGIN(k) _Pragma("unroll") for (int rep_ = 0; rep_ < ((((REPEAT_MASK >> (k)) & 1) && ((REPEAT_LMASK >> l) & 1)) ? 2 : 1); ++rep_) { if ((PHMASK >> (k)) & 1) { KArgsP ka = KA_LOAD(); unsigned char* ws = ka->ws; int tid = threadIdx.x; asm volatile("" : "+v"(tid)); \
    const int lane = tid & 63, wave = __builtin_amdgcn_readfirstlane(tid >> 6); int blk = blockIdx.x; asm volatile("" : "+s"(blk)); \
    const int gw = blk * NWAVES + wave; const size_t gtid = (size_t)blk * NTHR + tid; (void)lane; (void)gw; (void)gtid; (void)ws;
#if ONE_LAUNCH
#define PH_SEAM() do { XcdBarrier b_; b_.bar = (unsigned*)(KA_LOAD()->ws + WS_CTL) + CW_BAR; b_.x = xb_xcc_id(); b_.st = (volatile LAS unsigned*)(lds + MISC_OFF); xcd_barrier(b_); } while (0)
#else
#define PH_SEAM() do {} while (0)
#endif
#define PH_END() PH_SEAM(); } }
#define PH_END_NOSEAM() } }
#define WSP(type, off) ((type*)(ws + (off)))
constexpr int G = GRID, NGW = GRID * NWAVES; constexpr size_t GTHREADS = (size_t)GRID * NTHR;
template <int L> __device__ __forceinline__ void layer_phases(LAS unsigned char* lds) {
    constexpr int l = L; LAS int* tabL = (LAS int*)(lds + MISC_OFF + 256);

        const int j = l >> 1; const bool moba = (l & 1) != 0;
        const int NC = moba ? NC_M : NC_H, qoff = moba ? 2304 : 3072;

        PH_BEGIN(1)
            const float* win_src = moba ? ka->in[5] + (size_t)j * D * NC_M : ka->in[2] + (size_t)j * D * NC_H;
            const size_t moff = (size_t)l * NE * 1024 * 1024;
            phase_weights((LAS float*)(lds + wave * 16384), gw, NGW, lane, win_src, NC, ka->in[6] + (size_t)l * D * 512, ka->in[7] + (size_t)l * D * D,
                          ka->in[12] + moff, ka->in[14] + moff, ka->in[16] + moff, WSP(bf16, WS_WIN), WSP(bf16, WS_WKV), WSP(bf16, WS_WO), WSP(bf16, WS_WGU), WSP(bf16, WS_WD));
        PH_END()
        PH_BEGIN(2)
            { pg8::Gemm g{WSP(bf16, WS_XBF), WSP(bf16, WS_WIN), T, NC, D, 0, 0}; pg8::StaticOrder S; S.init(T, NC, G, blk); pg8::EpiPlain E{WSP(bf16, WS_H), NC};
              pg8::gemm_phase<pg8::EpiPlain, pg8::StaticOrder, true, true>(lds, g, S, E); }
            { pg8::Gemm g{WSP(bf16, WS_MEMBF), WSP(bf16, WS_WKV), 512, 512, D, 0, 0}; pg8::StaticOrder S; S.init(512, 512, G, blk); pg8::EpiPlain E{WSP(bf16, WS_KV), 512};
              pg8::gemm_phase<pg8::EpiPlain, pg8::StaticOrder, true, true>(lds, g, S, E); }
        PH_END()
        if (!moba) {
            PH_BEGIN(3)
                for (int u = blk; u < NBATCH * HG_H * HNSEG; u += G) hgrn_seg<false>(lds, WSP(bf16, WS_H), ka->in[3], j, ka->in[4] + j * 128, WSP(float, WS_SLOC), WSP(float, WS_DSEG), WSP(bf16, WS_MIX), u, tid, wave, lane);
                for (int u = blk; u < 512; u += G) memattn_unit2(lds, WSP(bf16, WS_H), NC, qoff, WSP(bf16, WS_KV), WSP(bf16, WS_MIX), u, tid, wave, lane);
            PH_END()
            PH_BEGIN(4)
                hgrn_scan(WSP(float, WS_SLOC), WSP(float, WS_DSEG), gtid, GTHREADS);
            PH_END()
            PH_BEGIN(5)
                for (int u = blk; u < NBATCH * HG_H * HNSEG; u += G) hgrn_seg<true>(lds, WSP(bf16, WS_H), ka->in[3], j, ka->in[4] + j * 128, WSP(float, WS_SLOC), WSP(float, WS_DSEG), WSP(bf16, WS_MIX), u, tid, wave, lane);
            PH_END()
        } else {
            PH_BEGIN(3)
                for (int u = blk; u < 24 * MB_NB; u += G) kmean_unit(lds, WSP(bf16, WS_H), WSP(float, WS_KMEAN), u, tid);
                for (int u = blk; u < 512; u += G) memattn_unit2(lds, WSP(bf16, WS_H), NC, qoff, WSP(bf16, WS_KV), WSP(bf16, WS_MIX), u, tid, wave, lane);
            PH_END()
            PH_BEGIN(4)
                for (int u = blk; u < 24 * MB_NB; u += G) moba_gate_unit(lds, WSP(bf16, WS_H), WSP(float, WS_KMEAN), WSP(unsigned, WS_CTL) + CW_GCOUNT + j * 1536, WSP(int, WS_SELINFO), WSP(unsigned, WS_LIST), u, tid);
            PH_END()
            PH_BEGIN(5)
                for (int r = 0; r * G < 24 * MB_NB; ++r) { const int it = r * G + ((r & 1) ? (G - 1 - blk) : blk);
                    if (it < 24 * MB_NB) moba_attn_item2(lds, WSP(bf16, WS_H), WSP(unsigned, WS_CTL) + CW_GCOUNT + j * 1536, WSP(unsigned, WS_LIST), WSP(float, WS_PO), WSP(float, WS_PML), it, tid, wave, lane); }
            PH_END()
            PH_BEGIN(6)
                moba_combine(WSP(float, WS_PO), WSP(float, WS_PML), WSP(int, WS_SELINFO), WSP(bf16, WS_MIX), gw, NGW, lane);
            PH_END()
        }
        PH_BEGIN(7)
            pg8::Gemm g{WSP(bf16, WS_MIX), WSP(bf16, WS_WO), T, D, D, 0, 0}; pg8::StaticOrder S; S.init(T, D, G, blk); pg8::EpiPlain E{WSP(bf16, WS_Y), D};
            pg8::gemm_phase<pg8::EpiPlain, pg8::StaticOrder, true, true>(lds, g, S, E);
        PH_END()
        PH_BEGIN(8)
            phase_ln1(lds, WSP(bf16, WS_Y), ka->in[8] + l * D, ka->in[9] + l * D, ka->in[10] + (size_t)l * D * NE, ka->in[11] + l * NE, WSP(bf16, WS_XBF),
                      WSP(int, WS_TOK + TOK_E), WSP(int, WS_TOK + TOK_LR), WSP(float, WS_TOK + TOK_W), WSP(int, WS_TOK + TOK_BLKCNT), blk, tid, wave, lane);
        PH_END()
        PH_BEGIN(9)
            phase_dispatch(lds, WSP(int, WS_TOK + TOK_BLKCNT), WSP(int, WS_TOK + TOK_E), WSP(int, WS_TOK + TOK_LR), WSP(int, WS_TOK + TOK_ROW), WSP(int, WS_TOK + TOK_TAB), WSP(bf16, WS_XBF), WSP(bf16, WS_XS), blk, tid, wave, lane);
        PH_END()
        PH_BEGIN(10)
            if (tid < 33) tabL[tid] = WSP(int, WS_TOK + TOK_TAB)[tid];
            __syncthreads();
            int sw_ = 0x7A7A7A7A, sx_ = 0x7F7F7F7F; asm volatile("" : "+s"(sw_), "+s"(sx_));
            pg8::Gemm g{WSP(bf16, WS_XS), WSP(bf16, WS_WGU), MOE_MAXROWS, NE * 2048, D / 2, sw_, sx_}; pg8::MoeOrder S{tabL, 8, G, blk, tabL[32] * 8};
            pg8::EpiSwiglu E{WSP(unsigned char, WS_HID), ka->in[13] + (size_t)l * NE * 1024, ka->in[15] + (size_t)l * NE * 1024};
            pg8::gemm_phase<pg8::EpiSwiglu, pg8::MoeOrder, true, true, true>(lds, g, S, E);
        PH_END()
        PH_BEGIN(11)
            if (tid < 33) tabL[tid] = WSP(int, WS_TOK + TOK_TAB)[tid];
            __syncthreads();
            int sw_ = 0x79797979, sx_ = 0x7F7F7F7F; asm volatile("" : "+s"(sw_), "+s"(sx_));
            pg8::Gemm g{WSP(bf16, WS_HID), WSP(bf16, WS_WD), MOE_MAXROWS, NE * 1024, D / 2, sw_, sx_}; pg8::MoeOrder S{tabL, 4, G, blk, tabL[32] * 4};
            pg8::EpiDown E{WSP(unsigned char, WS_XS), ka->in[17] + (size_t)l * NE * 1024};
            pg8::gemm_phase<pg8::EpiDown, pg8::MoeOrder, true, true, true>(lds, g, S, E);
        PH_END()
        PH_BEGIN(12)
            float* x2out = (l == DEPTH - 1) ? ka->out : nullptr;
            phase_ln2(WSP(unsigned char, WS_XS), WSP(int, WS_TOK + TOK_ROW), WSP(float, WS_TOK + TOK_W), ka->in[18] + l * D, ka->in[19] + l * D, x2out, WSP(bf16, WS_XBF), gw, NGW, lane);
            if (l + 1 < DEPTH) PH_SEAM();
        PH_END_NOSEAM()
}
__global__ void __launch_bounds__(NTHR, 2) fwd_kernel(Args args) {
    extern __shared__ __attribute__((aligned(16))) unsigned char lds_raw[];
    LAS unsigned char* lds = (LAS unsigned char*)lds_raw;
    if (threadIdx.x < 4) ((LAS unsigned*)(lds + MISC_OFF))[threadIdx.x] = 0u;
    __syncthreads();
#if ONE_LAUNCH
    (void)xcd_barrier_post((unsigned*)(args.ws + WS_CTL) + CW_BAR, (volatile LAS unsigned*)(lds + MISC_OFF));
#endif
    { const int l = 0; (void)l;
    PH_BEGIN(0)
        cvt_rows_bf16(ka->in[0], WSP(bf16, WS_XBF), (size_t)T * D / 8, gtid, GTHREADS);
        cvt_rows_bf16(ka->in[1], WSP(bf16, WS_MEMBF), (size_t)512 * D / 8, gtid, GTHREADS);
    PH_END_NOSEAM() }
    layer_phases<0>(lds); layer_phases<1>(lds); layer_phases<2>(lds); layer_phases<3>(lds);
}

extern "C" void kernel_launch(void* const* d_in, const int* in_sizes, int n_in, void* d_out, int out_size, void* d_ws, size_t ws_size, hipStream_t stream) {
    static int ready = 0;
    if (ready == 0) {
        if (n_in != 20 || in_sizes[0] != T * D || out_size != T * D || ws_size < WS_END) { fprintf(stderr, "kernel_launch: unexpected shapes (n_in %d, in0 %d, out %d, ws %zu < %zu)\n", n_in, n_in > 0 ? in_sizes[0] : -1, out_size, ws_size, (size_t)WS_END); ready = -1; return; }
        if (hipFuncSetAttribute((const void*)fwd_kernel, hipFuncAttributeMaxDynamicSharedMemorySize, LDS_BYTES) != hipSuccess) { fprintf(stderr, "kernel_launch: hipFuncSetAttribute failed\n"); ready = -1; return; }
        int per_cu = 0;
        if (hipOccupancyMaxActiveBlocksPerMultiprocessor(&per_cu, (const void*)fwd_kernel, NTHR, LDS_BYTES) != hipSuccess || per_cu < 1) fprintf(stderr, "kernel_launch: occupancy query says %d\n", per_cu);
        (void)hipGetLastError();
        ready = 1;
    }
    if (ready < 0) return;
    if (hipMemsetAsync((char*)d_ws + WS_CTL, 0, CTL_ZERO_BYTES, stream) != hipSuccess) return;
    Args a{};
    for (int i = 0; i < 20; ++i) a.in[i] = (const float*)d_in[i];
    a.out = (float*)d_out; a.ws = (unsigned char*)d_ws;
    a.l_lo = 0; a.l_hi = DEPTH; a.ph_lo = 0; a.ph_hi = NPHASE;
    hipLaunchKernelGGL(fwd_kernel, dim3(GRID), dim3(NTHR), LDS_BYTES, stream, a);
}
```

```cpp
#include <hip/hip_runtime.h>
#include <cstdio>
#include <cstdint>
#include <cmath>
namespace pg8 {
#define PG8_LAS __attribute__((address_space(3)))
typedef unsigned short bf16_t;
typedef short bf16x8 __attribute__((ext_vector_type(8)));
typedef float f32x4 __attribute__((ext_vector_type(4)));
typedef unsigned u32x4 __attribute__((ext_vector_type(4)));
constexpr int BM = 256, BK = 64, HALF = 128, HTB = HALF * BK * 2  , STAGE_BYTES = 8 * HTB, NXCD = 8, WGM = 8;

__host__ __device__ __forceinline__ int lds_byte(int r, int c) { const int st = (r >> 4) * 2 + (c >> 5), rr = r & 15, cc = c & 31, ob = rr * 64 + cc * 2; return st * 1024 + (ob ^ (((ob >> 9) & 1) << 5)); }
__host__ __device__ __forceinline__ void stage_rc(int b, int& R, int& C) { const int st = b / 1024, sb = b % 1024, swz = sb ^ (((sb >> 9) & 1) << 5); R = (st >> 1) * 16 + swz / 64; C = (st & 1) * 32 + (swz % 64) / 2; }
__host__ __device__ __forceinline__ int perm32(int rho) { const int n = rho >> 4, i = rho & 15; return 8 * (i >> 2) + 4 * n + (i & 3); }

struct Unit { int pm, pn; };
struct Gemm { const bf16_t* A; const bf16_t* Bt; int M, N, K; int sw, sx; };
typedef int i32x8 __attribute__((ext_vector_type(8))); typedef int i32x4 __attribute__((ext_vector_type(4)));

struct StaticOrder {
    int nM, nN, nwg, G, c;
    __host__ __device__ void init(int M, int N, int G_, int c_) { nM = M / BM; nN = N / BM; nwg = nM * nN; G = G_; c = c_; }
    __host__ __device__ bool next(int i, Unit& u) const {
        const long L = (long)i * G + c; if (L >= nwg) return false;
        int wgid = (int)L; { const int q = nwg / NXCD, r = nwg % NXCD, xcd = wgid % NXCD, off = wgid / NXCD; wgid = (xcd < r ? xcd * (q + 1) : r * (q + 1) + (xcd - r) * q) + off; }
        const int nig = WGM * nN, gid = wgid / nig, fm = gid * WGM, gsz = (nM - fm) < WGM ? (nM - fm) : WGM;
        u.pm = fm + ((wgid % nig) % gsz); u.pn = (wgid % nig) / gsz; return true;
    }
    __device__ __forceinline__ void a_ready(const Unit&) const {}
    __device__ __forceinline__ void done(const Unit&) const {}
};

__device__ __forceinline__ unsigned cvt_pk_bf16(float lo, float hi) { unsigned r; asm volatile("v_cvt_pk_bf16_f32 %0, %1, %2" : "=v"(r) : "v"(lo), "v"(hi)); return r; }
typedef float f32x2 __attribute__((ext_vector_type(2)));
struct EpiPlain {
    static constexpr bool PERM = true, AFTER_DRAIN = false;
    bf16_t* O; int ldc; unsigned smask; float sc;
    __device__ __forceinline__ void operator()(const f32x4 (&acc)[2][2][4][2], const Unit& u, int wr, int wc, int fr, int fq) const {
        const int row0 = u.pm * BM + wr * 64 + fr; const int col0 = u.pn * BM + wc * 32 + 8 * fq; const float s = ((smask >> u.pn) & 1u) ? sc : 1.f;
#pragma unroll
        for (int ai = 0; ai < 2; ++ai)
#pragma unroll
            for (int m = 0; m < 4; ++m) { bf16_t* rowp = O + (size_t)(row0 + ai * HALF + m * 16) * ldc + col0;
#pragma unroll
                for (int bj = 0; bj < 2; ++bj) { const f32x4 v0 = acc[ai][bj][m][0] * s, v1 = acc[ai][bj][m][1] * s;
                    u32x4 w; w.x = cvt_pk_bf16(v0[0], v0[1]); w.y = cvt_pk_bf16(v0[2], v0[3]); w.z = cvt_pk_bf16(v1[0], v1[1]); w.w = cvt_pk_bf16(v1[2], v1[3]);
                    *(u32x4*)(rowp + bj * HALF) = w; } }
    }
};
__device__ __forceinline__ float swiglu1(float g, float u) {
    g = fminf(g, 7.0f); u = fminf(fmaxf(u, -7.0f), 7.0f);
    const float s = __builtin_amdgcn_rcpf(1.0f + __builtin_amdgcn_exp2f(g * (-1.702f * 1.4426950408889634f)));
    return g * s * (u + 1.0f);
}
__device__ __forceinline__ unsigned pk4_fp8e(float a, float b, float c, float d) { int w = 0; w = __builtin_amdgcn_cvt_pk_fp8_f32(a, b, w, false); w = __builtin_amdgcn_cvt_pk_fp8_f32(c, d, w, true); return (unsigned)w; }
struct EpiSwiglu {
    static constexpr bool PERM = true, AFTER_DRAIN = false;
    unsigned char* hid; const float* bg; const float* bu;
    __device__ __forceinline__ void operator()(const f32x4 (&acc)[2][2][4][2], const Unit& u, int wr, int wc, int fr, int fq) const {
        const int e = u.pn >> 3, pn = u.pn & 7;
        const int row0 = u.pm * BM + wr * 64 + fr; const int col0 = pn * 128 + wc * 32 + 8 * fq;
        const f32x4 g0 = *(const f32x4*)(bg + e * 1024 + col0), g1 = *(const f32x4*)(bg + e * 1024 + col0 + 4);
        const f32x4 u0 = *(const f32x4*)(bu + e * 1024 + col0), u1 = *(const f32x4*)(bu + e * 1024 + col0 + 4);
#pragma unroll
        for (int ai = 0; ai < 2; ++ai)
#pragma unroll
            for (int m = 0; m < 4; ++m) { unsigned char* rowp = hid + (size_t)(row0 + ai * HALF + m * 16) * 1024 + col0;
                const f32x4 ga = acc[ai][0][m][0] + g0, gb = acc[ai][0][m][1] + g1, ua = acc[ai][1][m][0] + u0, ub = acc[ai][1][m][1] + u1;
                typedef unsigned u32x2 __attribute__((ext_vector_type(2))); u32x2 w;
                w.x = pk4_fp8e(swiglu1(ga[0], ua[0]), swiglu1(ga[1], ua[1]), swiglu1(ga[2], ua[2]), swiglu1(ga[3], ua[3]));
                w.y = pk4_fp8e(swiglu1(gb[0], ub[0]), swiglu1(gb[1], ub[1]), swiglu1(gb[2], ub[2]), swiglu1(gb[3], ub[3]));
                *(u32x2*)rowp = w; }
    }
};
struct EpiDown {
    static constexpr bool PERM = true, AFTER_DRAIN = false;
    unsigned char* y; const float* bd;
    __device__ __forceinline__ void operator()(const f32x4 (&acc)[2][2][4][2], const Unit& u, int wr, int wc, int fr, int fq) const {
        const int e = u.pn >> 2, pn = u.pn & 3;
        const int row0 = u.pm * BM + wr * 64 + fr; const int col0 = pn * BM + wc * 32 + 8 * fq;
        f32x4 bv[2][2];
#pragma unroll
        for (int bj = 0; bj < 2; ++bj)
#pragma unroll
            for (int n = 0; n < 2; ++n) bv[bj][n] = *(const f32x4*)(bd + e * 1024 + col0 + bj * HALF + 4 * n);
#pragma unroll
        for (int ai = 0; ai < 2; ++ai)
#pragma unroll
            for (int m = 0; m < 4; ++m) { unsigned char* rowp = y + (size_t)(row0 + ai * HALF + m * 16) * 1024 + col0;
#pragma unroll
                for (int bj = 0; bj < 2; ++bj) { const f32x4 v0 = (acc[ai][bj][m][0] + bv[bj][0]) * 16.f, v1 = (acc[ai][bj][m][1] + bv[bj][1]) * 16.f;
                    typedef unsigned u32x2 __attribute__((ext_vector_type(2))); u32x2 w; w.x = pk4_fp8e(v0[0], v0[1], v0[2], v0[3]); w.y = pk4_fp8e(v1[0], v1[1], v1[2], v1[3]);
                    *(u32x2*)(rowp + bj * HALF) = w; } }
    }
};
struct MoeOrder {
    const PG8_LAS int* tab; int npn, G, c, nunits;
    __device__ __forceinline__ bool next(int i, Unit& u) const {
        const int tpx = 32 / npn, s = c >> 3, tile = (i * 8 + (c & 7)) * tpx + s / npn, pn = s % npn;
        if ((i * 8) * tpx >= nunits / npn) return false;
        if (tile >= nunits / npn) { u.pm = 0; u.pn = 0; return false; }
        int e = 0;
#pragma unroll
        for (int k = 1; k < 32; ++k) e += (tab[k] <= tile) ? 1 : 0;
        u.pm = tile; u.pn = __builtin_amdgcn_readfirstlane(e) * npn + pn; return true;
    }
    __device__ __forceinline__ void a_ready(const Unit&) const {}
    __device__ __forceinline__ void done(const Unit&) const {}
};
template <class Epi, class Sched, bool ALIGN_EPI = false, bool SP2 = false, bool F8 = false>
__device__ __forceinline__ void gemm_phase(PG8_LAS unsigned char* lds, const Gemm g, const Sched& S, const Epi& E) {
    int tid_ = threadIdx.x; asm volatile("" : "+v"(tid_));
    const int tid = tid_, wid = __builtin_amdgcn_readfirstlane(tid >> 6), lane = tid & 63, wr = wid >> 2, wc = wid & 3, fr = lane & 15, fq = lane >> 4;
    const int K = g.K, nt = K / BK;
    unsigned voffA, voffB;
    { int R, C; stage_rc(tid * 16, R, C); const int Rb = Epi::PERM ? ((R & ~31) + perm32(R & 31)) : R; voffA = (unsigned)(R * K + C) * 2u; voffB = (unsigned)(Rb * K + C) * 2u; }
    const unsigned qstep = 64u * (unsigned)K * 2u;
    const unsigned kstep = (unsigned)(BK * 2);
    const unsigned hstep = (unsigned)HALF * (unsigned)K * 2u;
    const unsigned tstep = 2u * hstep;
    const __amdgpu_buffer_rsrc_t rA = __builtin_amdgcn_make_buffer_rsrc((void*)g.A, 0, 0x7FFFFFFF, 0x00020000), rB = __builtin_amdgcn_make_buffer_rsrc((void*)g.Bt, 0, 0x7FFFFFFF, 0x00020000);
    const unsigned ldsw = (unsigned)wid * 1024u;
    const int aoff = lds_byte(wr * 64 + fr, fq * 8), boff = lds_byte(wc * 32 + fr, fq * 8);
#define PG8_SA(b, h) (((b) * 2 + (h)) * HTB)
#define PG8_SB(b, h) ((4 + (b) * 2 + (h)) * HTB)
#define PG8_STG(bufoff, rsrc, soff, voff) do { _Pragma("unroll") for (int _i = 0; _i < 2; ++_i) \
        __builtin_amdgcn_raw_ptr_buffer_load_lds((rsrc), (PG8_LAS void*)(lds + (bufoff) + ldsw + _i * 8192), 16, (int)(voff), (int)((soff) + (unsigned)_i * qstep), 0, 0); } while (0)
#define PG8_STGA(bufoff, soff) PG8_STG(bufoff, rA, soff, voffA)
#define PG8_STGB(bufoff, soff) PG8_STG(bufoff, rB, soff, voffB)
#define PG8_LDA(dst, b, h) do { _Pragma("unroll") for (int m = 0; m < 4; ++m) { if constexpr (F8) { const i32x4 lo_ = *(const PG8_LAS i32x4*)(lds + PG8_SA(b, h) + aoff + m * 2048), hi_ = *(const PG8_LAS i32x4*)(lds + PG8_SA(b, h) + aoff + m * 2048 + 1024); \
            dst##_8[m] = __builtin_shufflevector(lo_, hi_, 0, 1, 2, 3, 4, 5, 6, 7); } else { _Pragma("unroll") for (int k = 0; k < 2; ++k) dst[m][k] = *(const PG8_LAS bf16x8*)(lds + PG8_SA(b, h) + aoff + m * 2048 + k * 1024); } } } while (0)
#define PG8_LDB(dst, b, h) do { _Pragma("unroll") for (int n = 0; n < 2; ++n) { if constexpr (F8) { const i32x4 lo_ = *(const PG8_LAS i32x4*)(lds + PG8_SB(b, h) + boff + n * 2048), hi_ = *(const PG8_LAS i32x4*)(lds + PG8_SB(b, h) + boff + n * 2048 + 1024); \
            dst##_8[n] = __builtin_shufflevector(lo_, hi_, 0, 1, 2, 3, 4, 5, 6, 7); } else { _Pragma("unroll") for (int k = 0; k < 2; ++k) dst[n][k] = *(const PG8_LAS bf16x8*)(lds + PG8_SB(b, h) + boff + n * 2048 + k * 1024); } } } while (0)
#define PG8_MMA(ai, bj, At, Bt) do { __builtin_amdgcn_s_setprio(1); _Pragma("unroll") for (int m = 0; m < 4; ++m) _Pragma("unroll") for (int n = 0; n < 2; ++n) { \
        if constexpr (F8) acc[ai][bj][m][n] = __builtin_amdgcn_mfma_scale_f32_16x16x128_f8f6f4(Bt##_8[n], At##_8[m], acc[ai][bj][m][n], 0, 0, 0, g.sw, 0, g.sx); \
        else { _Pragma("unroll") for (int k = 0; k < 2; ++k) acc[ai][bj][m][n] = __builtin_amdgcn_mfma_f32_16x16x32_bf16(Bt[n][k], At[m][k], acc[ai][bj][m][n], 0, 0, 0); } } \
        __builtin_amdgcn_s_setprio(0); } while (0)
#define PG8_WAIT_V(n) asm volatile("s_waitcnt vmcnt(" #n ")" ::: "memory")
#define PG8_WAIT_L(n) asm volatile("s_waitcnt lgkmcnt(" #n ")" ::: "memory")
#define PG8_BAR __builtin_amdgcn_s_barrier()
#define PG8_SCHED __builtin_amdgcn_sched_barrier(0)
    Unit cur, nxt; int ui = 0;
    if (!S.next(0, cur)) return;
    f32x4 acc[2][2][4][2];
#pragma unroll
    for (int a = 0; a < 2; ++a)
#pragma unroll
        for (int b = 0; b < 2; ++b)
#pragma unroll
            for (int m = 0; m < 4; ++m)
#pragma unroll
                for (int n = 0; n < 2; ++n) acc[a][b][m][n] = (f32x4){0.f, 0.f, 0.f, 0.f};
    bf16x8 At[4][2], B0[2][2], B1[2][2]; i32x8 At_8[4], B0_8[2], B1_8[2];
    unsigned cA = (unsigned)cur.pm * tstep, cB = (unsigned)cur.pn * tstep;
    S.a_ready(cur);
    if constexpr (SP2) {
        PG8_STGB(PG8_SB(0, 0), cB); PG8_STGB(PG8_SB(0, 1), cB + hstep); PG8_STGA(PG8_SA(0, 0), cA); PG8_STGA(PG8_SA(0, 1), cA + hstep);
        if (wr == 1) PG8_BAR;
        PG8_WAIT_V(2); PG8_BAR;
        PG8_STGB(PG8_SB(1, 0), cB + kstep); PG8_STGA(PG8_SA(1, 0), cA + kstep); PG8_STGB(PG8_SB(1, 1), cB + hstep + kstep);
        PG8_WAIT_V(6); PG8_BAR;
    } else {
        PG8_STGB(PG8_SB(0, 0), cB); PG8_STGA(PG8_SA(0, 0), cA); PG8_STGB(PG8_SB(0, 1), cB + hstep); PG8_STGA(PG8_SA(0, 1), cA + hstep);
        if (wr == 1) PG8_BAR;
        PG8_WAIT_V(4); PG8_BAR;
        PG8_STGB(PG8_SB(1, 0), cB + kstep); PG8_STGA(PG8_SA(1, 0), cA + kstep); PG8_STGB(PG8_SB(1, 1), cB + hstep + kstep);
        PG8_WAIT_V(6); PG8_BAR;
    }
    for (;;) {
        const bool has_next = S.next(ui + 1, nxt);
        const unsigned nA = has_next ? (unsigned)nxt.pm * tstep : cA, nB = has_next ? (unsigned)nxt.pn * tstep : cB;
#pragma unroll 1
        for (int t = 0; t < nt; t += 2) {
            const bool last = (t == nt - 2);
            const unsigned a1 = cA + (unsigned)(t + 1) * kstep;
            const unsigned a2 = last ? nA : cA + (unsigned)(t + 2) * kstep, b2 = last ? nB : cB + (unsigned)(t + 2) * kstep;
            const unsigned a3 = a2 + kstep, b3 = b2 + kstep;
            if (last && has_next) S.a_ready(nxt);
            if constexpr (SP2) {
            PG8_LDB(B0, 0, 0); PG8_LDB(B1, 0, 1); PG8_SCHED; PG8_LDA(At, 0, 0); PG8_STGA(PG8_SA(1, 1), a1 + hstep);
            PG8_WAIT_V(8); PG8_WAIT_L(0); PG8_BAR; PG8_MMA(0, 0, At, B0); PG8_MMA(0, 1, At, B1); PG8_BAR; PG8_SCHED;
            PG8_LDA(At, 0, 1); PG8_STGB(PG8_SB(0, 0), b2); PG8_STGB(PG8_SB(0, 1), b2 + hstep); PG8_STGA(PG8_SA(0, 0), a2);
            PG8_WAIT_V(8); PG8_WAIT_L(0); PG8_BAR; PG8_MMA(1, 0, At, B0); PG8_MMA(1, 1, At, B1); PG8_BAR; PG8_SCHED;
            PG8_LDB(B0, 1, 0); PG8_LDB(B1, 1, 1); PG8_SCHED; PG8_LDA(At, 1, 0); PG8_STGA(PG8_SA(0, 1), a2 + hstep);
            PG8_WAIT_V(8); PG8_WAIT_L(0); PG8_BAR; PG8_MMA(0, 0, At, B0); PG8_MMA(0, 1, At, B1); PG8_BAR; PG8_SCHED;
            PG8_LDA(At, 1, 1); PG8_STGB(PG8_SB(1, 0), b3); PG8_STGB(PG8_SB(1, 1), b3 + hstep); PG8_STGA(PG8_SA(1, 0), a3);
            PG8_WAIT_V(8); PG8_WAIT_L(0); PG8_BAR; PG8_MMA(1, 0, At, B0); PG8_MMA(1, 1, At, B1); PG8_BAR; PG8_SCHED;
            } else {
            PG8_LDB(B0, 0, 0); PG8_SCHED; PG8_LDA(At, 0, 0); PG8_STGA(PG8_SA(1, 1), a1 + hstep);
            PG8_WAIT_L(8); PG8_BAR; PG8_WAIT_L(0); PG8_MMA(0, 0, At, B0); PG8_BAR; PG8_SCHED;
            PG8_LDB(B1, 0, 1); PG8_STGB(PG8_SB(0, 0), b2);
            PG8_BAR; PG8_WAIT_L(0); PG8_MMA(0, 1, At, B1); PG8_BAR;
            PG8_LDA(At, 0, 1); PG8_STGA(PG8_SA(0, 0), a2);
            PG8_BAR; PG8_WAIT_L(0); PG8_MMA(1, 0, At, B0); PG8_BAR; PG8_SCHED;
            PG8_STGB(PG8_SB(0, 1), b2 + hstep);
            PG8_WAIT_V(6); PG8_BAR; PG8_MMA(1, 1, At, B1); PG8_BAR;
            PG8_LDB(B0, 1, 0); PG8_SCHED; PG8_LDA(At, 1, 0); PG8_STGA(PG8_SA(0, 1), a2 + hstep);
            PG8_WAIT_L(8); PG8_BAR; PG8_WAIT_L(0); PG8_MMA(0, 0, At, B0); PG8_BAR; PG8_SCHED;
            PG8_LDB(B1, 1, 1); PG8_STGB(PG8_SB(1, 0), b3);
            PG8_BAR; PG8_WAIT_L(0); PG8_MMA(0, 1, At, B1); PG8_BAR;
            PG8_LDA(At, 1, 1); PG8_STGA(PG8_SA(1, 0), a3);
            PG8_BAR; PG8_WAIT_L(0); PG8_MMA(1, 0, At, B0); PG8_BAR; PG8_SCHED;
            PG8_STGB(PG8_SB(1, 1), b3 + hstep);
            PG8_WAIT_V(6); PG8_BAR; PG8_MMA(1, 1, At, B1); PG8_BAR;
            }
        }
        if constexpr (ALIGN_EPI) { if (wr == 0) PG8_BAR; }
        if constexpr (!Epi::AFTER_DRAIN) { int t2_ = threadIdx.x; asm volatile("" : "+v"(t2_)); E(acc, cur, wr, wc, t2_ & 15, (t2_ & 63) >> 4); S.done(cur); }
        if (!has_next) break;
#pragma unroll
        for (int a = 0; a < 2; ++a)
#pragma unroll
            for (int b = 0; b < 2; ++b)
#pragma unroll
                for (int m = 0; m < 4; ++m)
#pragma unroll
                    for (int n = 0; n < 2; ++n) acc[a][b][m][n] = (f32x4){0.f, 0.f, 0.f, 0.f};
        cur = nxt; cA = nA; cB = nB; ++ui;
        if constexpr (ALIGN_EPI) { if (wr == 1) PG8_BAR; }
    }
    PG8_WAIT_V(0);
    if constexpr (!ALIGN_EPI) { if (wr == 0) PG8_BAR; }
    PG8_BAR;
    if constexpr (Epi::AFTER_DRAIN) { E.fused(acc, cur, wr, wc, fr, fq, lds, wid, lane); S.done(cur); }
#undef PG8_SA
#undef PG8_SB
#undef PG8_STG
#undef PG8_STGA
#undef PG8_STGB
#undef PG8_LDA
#undef PG8_LDB
#undef PG8_MMA
#undef PG8_WAIT_V
#undef PG8_WAIT_L
#undef PG8_BAR
#undef PG8_SCHED
}
}

constexpr int NWAVES = 8, NTHR = 512, GRID = 256;
constexpr int NBATCH = 2, SEQ = 16384, T = NBATCH * SEQ, D = 1024, DEPTH = 4;
constexpr int MIXW = 768, NC_H = 3328, NC_M = 2560;
constexpr int HG_H = 6;
constexpr int HSEG = 256, HNSEG = SEQ / HSEG;
constexpr int MB_H = 12, MB_NB = 64;
constexpr int NE = 32;
constexpr float DN_ALPHA = 1.6817928305074290f;
constexpr int MOE_MAXROWS = T * 4 + NE * 256;
#ifndef ONE_LAUNCH
#define ONE_LAUNCH 1
#endif
constexpr int NPHASE = 13;

constexpr size_t MiB = 1u << 20;
constexpr size_t WS_CTL = 0, CTL_ZERO_BYTES = 1 * MiB;
constexpr size_t WS_WIN = 1 * MiB, WS_WKV = 9 * MiB, WS_WO = 10 * MiB, WS_WGU = 12 * MiB, WS_WD = 140 * MiB;
constexpr size_t WS_XBF = 204 * MiB, WS_XA = 268 * MiB, WS_XB = 396 * MiB, WS_MEMBF = 524 * MiB, WS_KV = 525 * MiB;
constexpr size_t WS_H = 526 * MiB, WS_MIX = 734 * MiB, WS_Y = 798 * MiB, WS_SLOC = 862 * MiB, WS_DSEG = 910 * MiB, WS_KMEAN = 911 * MiB;
constexpr size_t WS_SELINFO = 912 * MiB, WS_TOK = 914 * MiB, WS_R1 = 918 * MiB;
constexpr size_t WS_LIST = WS_R1, WS_PML = WS_R1 + 96 * MiB, WS_PO = WS_R1 + 108 * MiB;
constexpr size_t WS_XS = WS_R1, WS_HID = WS_R1 + 272 * MiB;
constexpr size_t WS_END = WS_R1 + 544 * MiB;
static_assert((size_t)MOE_MAXROWS * 1024 * 2 <= 272 * MiB, "moe rows");
static_assert((size_t)T * MB_H * 4 * 64 * 4 <= 384 * MiB && (size_t)24 * 64 * 16384 * 4 <= 96 * MiB, "moba bufs");
constexpr size_t TOK_E = 0, TOK_LR = 512 * 1024, TOK_W = 1024 * 1024, TOK_ROW = 1536 * 1024, TOK_BLKCNT = 2048 * 1024, TOK_TAB = 2048 * 1024 + 65536;
constexpr int CW_BAR = 4096, CW_GCOUNT = 8192;

constexpr int RING_BYTES = 131072, LDS_BYTES = 147456, MISC_OFF = LDS_BYTES - 1024;

#define GAS __attribute__((address_space(1)))
#define LAS __attribute__((address_space(3)))
typedef unsigned short bf16;
typedef unsigned v4u __attribute__((ext_vector_type(4)));
typedef unsigned v2u __attribute__((ext_vector_type(2)));
typedef float f32x4 __attribute__((ext_vector_type(4)));
typedef float f32x2 __attribute__((ext_vector_type(2)));
typedef short s16x8 __attribute__((ext_vector_type(8)));
typedef float f32x16 __attribute__((ext_vector_type(16)));
typedef float f32x2_t __attribute__((ext_vector_type(2))); typedef __bf16 bf16x2_t __attribute__((ext_vector_type(2)));
__device__ __forceinline__ unsigned cvtpk(float lo, float hi) { f32x2_t v = {lo, hi}; bf16x2_t b = __builtin_convertvector(v, bf16x2_t); return __builtin_bit_cast(unsigned, b); }
#define LDS_WAIT() asm volatile("s_waitcnt lgkmcnt(0)" ::: "memory")
__device__ __forceinline__ unsigned f2bf(float f) { unsigned u = __builtin_bit_cast(unsigned, f); return (u + 0x7fffu + ((u >> 16) & 1u)) >> 16; }
__device__ __forceinline__ unsigned pk2(float lo, float hi) { return f2bf(lo) | (f2bf(hi) << 16); }
__device__ __forceinline__ float bflo(unsigned w) { return __builtin_bit_cast(float, w << 16); }
__device__ __forceinline__ float bfhi(unsigned w) { return __builtin_bit_cast(float, w & 0xffff0000u); }
__device__ __forceinline__ float bf2f(bf16 h) { return __builtin_bit_cast(float, (unsigned)h << 16); }
__device__ __forceinline__ float sigmoidf_(float z) { return __builtin_amdgcn_rcpf(1.0f + __builtin_amdgcn_exp2f(-1.4426950408889634f * z)); }
template <int X> __device__ __forceinline__ float xorf(float v) { return __builtin_bit_cast(float, __builtin_amdgcn_ds_swizzle(__builtin_bit_cast(int, v), (X << 10) | 0x1F)); }
template <int X> __device__ __forceinline__ int xori(int v) { return __builtin_amdgcn_ds_swizzle(v, (X << 10) | 0x1F); }
__device__ __forceinline__ float wave_sum(float v) {
    v += xorf<1>(v); v += xorf<2>(v); v += xorf<4>(v); v += xorf<8>(v); v += xorf<16>(v);
    return __builtin_bit_cast(float, __builtin_amdgcn_readlane(__builtin_bit_cast(int, v), 0)) + __builtin_bit_cast(float, __builtin_amdgcn_readlane(__builtin_bit_cast(int, v), 32));
}
__device__ __forceinline__ float wave_max(float v) {
    v = fmaxf(v, xorf<1>(v)); v = fmaxf(v, xorf<2>(v)); v = fmaxf(v, xorf<4>(v)); v = fmaxf(v, xorf<8>(v)); v = fmaxf(v, xorf<16>(v));
    return fmaxf(__builtin_bit_cast(float, __builtin_amdgcn_readlane(__builtin_bit_cast(int, v), 0)), __builtin_bit_cast(float, __builtin_amdgcn_readlane(__builtin_bit_cast(int, v), 32)));
}
__device__ __forceinline__ float xor32f(float v, int lane) { return __builtin_bit_cast(float, __builtin_amdgcn_ds_bpermute((lane ^ 32) << 2, __builtin_bit_cast(int, v))); }
#define XB_TMO      128
#define XB_XCNT(j)  (256  + 64 * (j))
#define XB_XSUB(j)  (1280 + 64 * (j))
#define XB_XGEN(j)  (2304 + 64 * (j))
#define XB_TOP      3328
#define XB_TOPGEN   3392
#define XCD_BAR_WORDS 3456
#define XB_SPIN_CAP (1u << 18)

__device__ __forceinline__ unsigned xb_ld(unsigned* p)              { return __hip_atomic_load(p, __ATOMIC_RELAXED, __HIP_MEMORY_SCOPE_AGENT); }
__device__ __forceinline__ unsigned xb_add(unsigned* p, unsigned v) { return __hip_atomic_fetch_add(p, v, __ATOMIC_RELAXED, __HIP_MEMORY_SCOPE_AGENT); }
__device__ __forceinline__ unsigned xb_xcc_id() { return (unsigned)__builtin_amdgcn_s_getreg((3 << 11) | 20) & 0xFu; }
#define XB_SPIN(cond, bar) do { unsigned _sp = 0; while (cond) { __builtin_amdgcn_s_sleep(1); \
    if ((++_sp & 255u) == 0u) { if (xb_ld(&(bar)[XB_TMO])) break; if (_sp > XB_SPIN_CAP) { atomicAdd(&(bar)[XB_TMO], 1u); break; } } } } while (0)

struct XcdBarrier {
    unsigned* bar; unsigned x;
    volatile LAS unsigned* st;
};

__device__ __forceinline__ XcdBarrier xcd_barrier_post(unsigned* bar, volatile LAS unsigned* st) {
    XcdBarrier b; b.bar = bar; b.x = xb_xcc_id(); b.st = st;
    if (threadIdx.x == 0) (void)xb_add(&bar[XB_XCNT(b.x)], 1u);
    return b;
}
__device__ __forceinline__ void xcd_barrier_complete(unsigned* bar, unsigned x, unsigned& nloc, unsigned& nx) {
    const unsigned G = gridDim.x * gridDim.y * gridDim.z;
    unsigned sum, cnt, mine, sp = 0u;
    for (;;) {
        sum = 0u; cnt = 0u; mine = 0u;
#pragma unroll
        for (unsigned j = 0; j < 16; ++j) { const unsigned c = xb_ld(&bar[XB_XCNT(j)]); sum += c; cnt += (c > 0u) ? 1u : 0u; mine = (j == x) ? c : mine; }
        if (sum == G) break;
        __builtin_amdgcn_s_sleep(1);
        if ((++sp & 255u) == 0u) { if (xb_ld(&bar[XB_TMO])) break; if (sp > XB_SPIN_CAP) { atomicAdd(&bar[XB_TMO], 1u); break; } }
    }
    nloc = mine > 0u ? mine : 1u; nx = cnt > 0u ? cnt : 1u;
}

__device__ __forceinline__ void xcd_barrier(const XcdBarrier& b) {
    asm volatile("s_waitcnt vmcnt(0)" ::: "memory");
    __syncthreads();
    if (threadIdx.x == 0) {
        unsigned* bar = b.bar;
        __builtin_amdgcn_s_waitcnt(0);
        unsigned nloc = b.st[0], nx = b.st[1];
        if (nloc == 0u) { xcd_barrier_complete(bar, b.x, nloc, nx); b.st[0] = nloc; b.st[1] = nx; }
        const unsigned old = xb_add(&bar[XB_XSUB(b.x)], 1u);
        const unsigned gen = old / nloc;
        if (old + 1u == (gen + 1u) * nloc) {
            __builtin_amdgcn_fence(__ATOMIC_RELEASE, "agent");
            asm volatile("s_waitcnt vmcnt(0)" ::: "memory");
            const unsigned og = xb_add(&bar[XB_TOP], 1u);
            const unsigned tg = og / nx;
            if (og + 1u == (tg + 1u) * nx) xb_add(&bar[XB_TOPGEN], 1u);
            else XB_SPIN(xb_ld(&bar[XB_TOPGEN]) == tg, bar);
            __builtin_amdgcn_fence(__ATOMIC_ACQUIRE, "agent");
            xb_add(&bar[XB_XGEN(b.x)], 1u);
            asm volatile("s_waitcnt vmcnt(0)" ::: "memory");
        } else {
            XB_SPIN(xb_ld(&bar[XB_XGEN(b.x)]) == gen, bar);
            __builtin_amdgcn_fence(__ATOMIC_ACQUIRE, "agent");
            asm volatile("s_waitcnt vmcnt(0)" ::: "memory");
        }
    }
    __syncthreads();
}

__device__ __forceinline__ void cvt_rows_bf16(const float* src, bf16* dst, size_t n8, size_t gtid, size_t gthreads) {
    for (size_t i = gtid; i < n8; i += gthreads) { const f32x4 a = ((const f32x4*)src)[2 * i], b = ((const f32x4*)src)[2 * i + 1];
        v4u o; o.x = pk2(a.x, a.y); o.y = pk2(a.z, a.w); o.z = pk2(b.x, b.y); o.w = pk2(b.z, b.w); ((v4u*)dst)[i] = o; }
}
__device__ __forceinline__ void transpose_item(const float* W, int N, bf16* WT, int dst_row0, LAS float* scr, int k0, int n0, int lane) {
#pragma unroll 8
    for (int i = 0; i < 32; ++i) { const int kk = 2 * i + (lane >> 5); scr[kk * 33 + (lane & 31)] = W[(size_t)(k0 + kk) * N + n0 + (lane & 31)]; }
    LDS_WAIT(); asm volatile("" ::: "memory");
    const int c = lane & 7;
#pragma unroll
    for (int j = 0; j < 4; ++j) { const int n = (lane >> 3) + 8 * j; const LAS float* s = scr + (8 * c) * 33 + n;
        v4u o; o.x = pk2(s[0 * 33], s[1 * 33]); o.y = pk2(s[2 * 33], s[3 * 33]); o.z = pk2(s[4 * 33], s[5 * 33]); o.w = pk2(s[6 * 33], s[7 * 33]);
        *(v4u*)(WT + (size_t)(dst_row0 + n) * 1024 + k0 + 8 * c) = o; }
    LDS_WAIT(); asm volatile("" ::: "memory");
}
__device__ __forceinline__ unsigned pk4_fp8(float a, float b, float c, float d) { int w = 0; w = __builtin_amdgcn_cvt_pk_fp8_f32(a, b, w, false); w = __builtin_amdgcn_cvt_pk_fp8_f32(c, d, w, true); return (unsigned)w; }
__device__ __forceinline__ void transpose_item_f8(const float* W, int N, unsigned char* WT8, int dst_row0, LAS float* scr, int k0, int n0, int lane, float wscale) {
#pragma unroll 8
    for (int i = 0; i < 32; ++i) { const int kk = 2 * i + (lane >> 5); scr[kk * 33 + (lane & 31)] = W[(size_t)(k0 + kk) * N + n0 + (lane & 31)]; }
    LDS_WAIT(); asm volatile("" ::: "memory");
    const int c = lane & 7;
#pragma unroll
    for (int j = 0; j < 4; ++j) { const int n = (lane >> 3) + 8 * j; const LAS float* s = scr + (8 * c) * 33 + n;
        v2u o; o.x = pk4_fp8(s[0 * 33] * wscale, s[1 * 33] * wscale, s[2 * 33] * wscale, s[3 * 33] * wscale); o.y = pk4_fp8(s[4 * 33] * wscale, s[5 * 33] * wscale, s[6 * 33] * wscale, s[7 * 33] * wscale);
        *(v2u*)(WT8 + (size_t)(dst_row0 + n) * 1024 + k0 + 8 * c) = o; }
    LDS_WAIT(); asm volatile("" ::: "memory");
}
__device__ __forceinline__ void phase_weights(LAS float* scr, int gw, int ngw, int lane, const float* win_src, int NC, const float* wkv_src, const float* wo_src,
                                              const float* wg_src, const float* wu_src, const float* wd_src, bf16* win_t, bf16* wkv_t, bf16* wo_t, bf16* wgu_t, bf16* wd_t) {
    const int nbw = NC / 32, nWin = nbw * 16, NIT = nWin + 256 + 512 + NE * 1536;
    for (int it = gw; it < NIT; it += ngw) {
        int r = it;
        if (r < nWin) { const int kb = r / nbw, nb = r - kb * nbw; transpose_item(win_src, NC, win_t, 32 * nb, scr, 64 * kb, 32 * nb, lane); continue; } r -= nWin;
        if (r < 256) { const int kb = r >> 4, nb = r & 15; transpose_item(wkv_src, 512, wkv_t, 32 * nb, scr, 64 * kb, 32 * nb, lane); continue; } r -= 256;
        if (r < 512) { const int kb = r >> 5, nb = r & 31; transpose_item(wo_src, 1024, wo_t, 32 * nb, scr, 64 * kb, 32 * nb, lane); continue; } r -= 512;
        const int e = r / 1536, q = r - e * 1536, which = q >> 9, rr = q & 511, kb = rr >> 5, nb = rr & 31, n0 = 32 * nb;
        const size_t eoff = (size_t)e * 1024 * 1024;
        if (which == 0) transpose_item_f8(wg_src + eoff, 1024, (unsigned char*)wgu_t + 2 * eoff, (n0 >> 7) * 256 + (n0 & 127), scr, 64 * kb, n0, lane, 32.f);
        else if (which == 1) transpose_item_f8(wu_src + eoff, 1024, (unsigned char*)wgu_t + 2 * eoff, (n0 >> 7) * 256 + 128 + (n0 & 127), scr, 64 * kb, n0, lane, 32.f);
        else transpose_item_f8(wd_src + eoff, 1024, (unsigned char*)wd_t + eoff, n0, scr, 64 * kb, n0, lane, 64.f);
    }
}

template <bool OUT>
__device__ __forceinline__ void hgrn_seg(LAS unsigned char* lds, const bf16* h, const float* lbl, int j, const float* normg, float* Sloc, float* Dseg, bf16* mix, int unit, int tid, int wave, int lane) {
    const int seg = unit & (HNSEG - 1), bh = unit >> 6, hh = bh % HG_H, b = bh / HG_H;
    const int v = tid & 127, dg = tid >> 7;
    LAS float* fgs = (LAS float*)lds; LAS float* vs = fgs + 4096; LAS float* qs = vs + 4096; LAS float* op = qs + 4096;
    f32x2 st[16];
    float* Sp = Sloc + (size_t)unit * 16384 + (size_t)(dg * 32) * 128 + v;
#pragma unroll
    for (int dd = 0; dd < 16; ++dd) { st[dd].x = OUT ? Sp[(2 * dd) * 128] : 0.f; st[dd].y = OUT ? Sp[(2 * dd + 1) * 128] : 0.f; }
    float dprod = 1.f;
    const int stok = tid >> 4, c8 = (tid & 15) * 8;
    float lb[8];
#pragma unroll
    for (int i = 0; i < 8; ++i) { lb[i] = 0.f; if (j > 0) { const float a0 = lbl[hh * 128 + c8 + i], a1 = lbl[MIXW + hh * 128 + c8 + i]; lb[i] = 1.f / (1.f + __expf(a0 - a1)); } }
    for (int ch = 0; ch < HSEG / 32; ++ch) {
        const size_t t0 = (size_t)b * SEQ + seg * HSEG + ch * 32;
        { const bf16* row = h + (t0 + stok) * NC_H + hh * 128 + c8;
          const v4u f8 = *(const v4u*)(row + 768), i8 = *(const v4u*)(row + 1536); v4u q8 = {0u, 0u, 0u, 0u}; if (OUT) q8 = *(const v4u*)row;
#pragma unroll
          for (int w = 0; w < 4; ++w) { const float f0 = bflo(f8[w]), f1 = bfhi(f8[w]); const int o = stok * 128 + c8 + 2 * w;
              fgs[o] = lb[2 * w] + (1.f - lb[2 * w]) * sigmoidf_(f0); fgs[o + 1] = lb[2 * w + 1] + (1.f - lb[2 * w + 1]) * sigmoidf_(f1);
              vs[o] = bflo(i8[w]); vs[o + 1] = bfhi(i8[w]);
              if (OUT) { const float q0 = bflo(q8[w]), q1 = bfhi(q8[w]); qs[o] = q0 * sigmoidf_(q0); qs[o + 1] = q1 * sigmoidf_(q1); } } }
        __syncthreads();
        if (!OUT) { if (tid < 128) { for (int tt = 0; tt < 32; ++tt) dprod *= fgs[tt * 128 + tid]; } }
        f32x4 fA[8], qA[8], fB[8], qB[8]; float vA, vB;
#define HG_LOAD(F, Q, V, tt_) do { V = vs[(tt_) * 128 + v]; _Pragma("unroll") for (int d4 = 0; d4 < 8; ++d4) { F[d4] = *(const LAS f32x4*)(fgs + (tt_) * 128 + dg * 32 + d4 * 4); \
            if (OUT) Q[d4] = *(const LAS f32x4*)(qs + (tt_) * 128 + dg * 32 + d4 * 4); } } while (0)
#define HG_STEP(F, Q, V, tt_) do { const f32x2 vv2 = {V, V}; f32x2 acc2 = {0.f, 0.f}; _Pragma("unroll") for (int d4 = 0; d4 < 8; ++d4) { \
            const f32x2 fa = {F[d4].x, F[d4].y}, fb = {F[d4].z, F[d4].w}; \
            st[2 * d4] = fa * (st[2 * d4] - vv2) + vv2; st[2 * d4 + 1] = fb * (st[2 * d4 + 1] - vv2) + vv2; \
            if (OUT) { const f32x2 qa = {Q[d4].x, Q[d4].y}, qb = {Q[d4].z, Q[d4].w}; acc2 = qa * st[2 * d4] + acc2; acc2 = qb * st[2 * d4 + 1] + acc2; } } \
            if (OUT) op[(dg * 32 + (tt_)) * 128 + v] = acc2.x + acc2.y; } while (0)
        HG_LOAD(fA, qA, vA, 0);
#pragma unroll 1
        for (int tt = 0; tt < 32; tt += 2) {
            HG_LOAD(fB, qB, vB, tt + 1);
            __builtin_amdgcn_sched_barrier(0);
            HG_STEP(fA, qA, vA, tt);
            __builtin_amdgcn_sched_barrier(0);
            if (tt + 2 < 32) HG_LOAD(fA, qA, vA, tt + 2);
            __builtin_amdgcn_sched_barrier(0);
            HG_STEP(fB, qB, vB, tt + 1);
            __builtin_amdgcn_sched_barrier(0);
        }
#undef HG_LOAD
#undef HG_STEP
        if (OUT) {
            __syncthreads();
#pragma unroll
            for (int k = 0; k < 4; ++k) { const int tt = wave + 8 * k; float o0 = 0.f, o1 = 0.f;
#pragma unroll
                for (int g = 0; g < 4; ++g) { o0 += op[(g * 32 + tt) * 128 + lane]; o1 += op[(g * 32 + tt) * 128 + lane + 64]; }
                const float ms = wave_sum(o0 * o0 + o1 * o1) * (1.f / 128.f), r = 1.f / sqrtf(ms + 1e-6f);
                const bf16* grow = h + (t0 + tt) * NC_H + 2304 + hh * 128; const float g0 = bf2f(grow[lane]), g1 = bf2f(grow[lane + 64]);
                bf16* mrow = mix + (t0 + tt) * 1024 + hh * 128;
                mrow[lane] = (bf16)f2bf(o0 * r * normg[lane] * sigmoidf_(g0)); mrow[lane + 64] = (bf16)f2bf(o1 * r * normg[lane + 64] * sigmoidf_(g1)); }
        }
        __syncthreads();
    }
    if (!OUT) {
#pragma unroll
        for (int dd = 0; dd < 16; ++dd) { Sp[(2 * dd) * 128] = st[dd].x; Sp[(2 * dd + 1) * 128] = st[dd].y; }
        if (tid < 128) Dseg[(size_t)unit * 128 + tid] = dprod;
    }
}
constexpr int HG_G = 0, HG_QT = 32768, HG_KT = 50176, HG_KE = 67584, HG_VT = 86016, HG_ST = 104448, HG_GM = 139264, HG_GE = 139776, HG_PART = 140288;
static_assert(HG_PART + 2048 <= MISC_OFF, "HGRN LDS map");
__device__ __forceinline__ int crow16(int i, int hf) { return (i & 3) + 8 * (i >> 2) + 4 * hf; }
template <bool OUT>
__device__ __forceinline__ void hgrn_mfma(LAS unsigned char* lds, const bf16* h, const float* lbl, int j, const float* normg, float* Sloc, float* Dseg, bf16* mix, int unit, int tid, int wave, int lane) {
    const int seg = unit & (HNSEG - 1), bh = unit >> 6, hh = bh % HG_H, b = bh / HG_H;
    const int r = lane & 31, hf = lane >> 5, tr = wave & 1, vq = wave >> 1;
    LAS float* G = (LAS float*)(lds + HG_G); LAS float* GM = (LAS float*)(lds + HG_GM); LAS float* GE = (LAS float*)(lds + HG_GE); LAS float* PART = (LAS float*)(lds + HG_PART);
    const int stok = tid >> 3, c16 = (tid & 7) * 16, sperm = (stok & ~15) | (stok & 3) | ((stok & 4) << 1) | ((stok & 8) >> 1);
    const int cd = tid & 127, cpart = tid >> 7;
    float lb[16];
#pragma unroll
    for (int e = 0; e < 16; ++e) { lb[e] = 0.f; if (j > 0) { const float a0 = lbl[hh * 128 + c16 + e], a1 = lbl[MIXW + hh * 128 + c16 + e]; lb[e] = 1.f / (1.f + __expf(a0 - a1)); } }
    f32x16 S[2];
    float* Sp = Sloc + (size_t)unit * 16384 + 32 * vq + r;
#pragma unroll
    for (int dd = 0; dd < 2; ++dd)
#pragma unroll
        for (int i = 0; i < 16; ++i) S[dd][i] = OUT ? Sp[(32 * (2 * tr + dd) + crow16(i, hf)) * 128] : 0.f;
    float gsum = 0.f;
    for (int ch = 0; ch < HSEG / 64; ++ch) {
        const size_t t0 = (size_t)b * SEQ + seg * HSEG + ch * 64;
        float fg[16], qv[16]; v4u i8[2];
        { const bf16* row = h + (t0 + stok) * NC_H + hh * 128 + c16;
          const v4u f8[2] = {*(const v4u*)(row + 768), *(const v4u*)(row + 776)}; i8[0] = *(const v4u*)(row + 1536); i8[1] = *(const v4u*)(row + 1544);
          v4u q8[2] = {{0u, 0u, 0u, 0u}, {0u, 0u, 0u, 0u}}; if (OUT) { q8[0] = *(const v4u*)row; q8[1] = *(const v4u*)(row + 8); }
#pragma unroll
          for (int w = 0; w < 8; ++w) { const unsigned fw = f8[w >> 2][w & 3]; const float f0 = bflo(fw), f1 = bfhi(fw);
              fg[2 * w] = lb[2 * w] + (1.f - lb[2 * w]) * sigmoidf_(f0); fg[2 * w + 1] = lb[2 * w + 1] + (1.f - lb[2 * w + 1]) * sigmoidf_(f1);
              if (OUT) { const unsigned qw = q8[w >> 2][w & 3]; const float q0 = bflo(qw), q1 = bfhi(qw); qv[2 * w] = q0 * sigmoidf_(q0); qv[2 * w + 1] = q1 * sigmoidf_(q1); } else { qv[2 * w] = 0.f; qv[2 * w + 1] = 0.f; } }
#pragma unroll
          for (int e4 = 0; e4 < 4; ++e4) { f32x4 lg; lg.x = __builtin_amdgcn_logf(fg[4 * e4]); lg.y = __builtin_amdgcn_logf(fg[4 * e4 + 1]); lg.z = __builtin_amdgcn_logf(fg[4 * e4 + 2]); lg.w = __builtin_amdgcn_logf(fg[4 * e4 + 3]);
              *(LAS f32x4*)(G + stok * 128 + c16 + 4 * e4) = lg; } }
        __syncthreads();
        { float run = 0.f;
#pragma unroll
          for (int k = 0; k < 16; ++k) run += G[(16 * cpart + k) * 128 + cd];
          PART[cpart * 128 + cd] = run; }
        __syncthreads();
        { float run = 0.f;
#pragma unroll
          for (int pp = 0; pp < 3; ++pp) run += (pp < cpart) ? PART[pp * 128 + cd] : 0.f;
#pragma unroll
          for (int k = 0; k < 16; ++k) { run += G[(16 * cpart + k) * 128 + cd]; G[(16 * cpart + k) * 128 + cd] = run; }
          if (cpart == 1) GM[cd] = run;
          if (cpart == 3) { GE[cd] = run; gsum += run; } }
        __syncthreads();
        if (OUT) {
#pragma unroll
            for (int dd = 0; dd < 2; ++dd)
#pragma unroll
                for (int g4 = 0; g4 < 4; ++g4) { const int dbase = 32 * (2 * tr + dd) + 8 * g4 + 4 * hf; const f32x4 gm = *(const LAS f32x4*)(GM + dbase);
                    v2u w; w.x = cvtpk(S[dd][4 * g4] * __builtin_amdgcn_exp2f(gm.x), S[dd][4 * g4 + 1] * __builtin_amdgcn_exp2f(gm.y)); w.y = cvtpk(S[dd][4 * g4 + 2] * __builtin_amdgcn_exp2f(gm.z), S[dd][4 * g4 + 3] * __builtin_amdgcn_exp2f(gm.w));
                    *(LAS v2u*)(lds + HG_ST + (32 * vq + r) * 272 + dbase * 2) = w; }
        }
        { unsigned qt[8], kt[8];
#pragma unroll
          for (int e4 = 0; e4 < 4; ++e4) { const f32x4 gv = *(const LAS f32x4*)(G + stok * 128 + c16 + 4 * e4), gm = *(const LAS f32x4*)(GM + c16 + 4 * e4), ge = *(const LAS f32x4*)(GE + c16 + 4 * e4);
              float ke[4];
#pragma unroll
              for (int e = 0; e < 4; ++e) { const float kk = 1.f - fg[4 * e4 + e]; ke[e] = kk * __builtin_amdgcn_exp2f(ge[e] - gv[e]);
                  if (OUT) { const float a = qv[4 * e4 + e] * __builtin_amdgcn_exp2f(gv[e] - gm[e]), c = kk * __builtin_amdgcn_exp2f(gm[e] - gv[e]);
                      if (e & 1) { qt[2 * e4 + (e >> 1)] |= f2bf(a) << 16; kt[2 * e4 + (e >> 1)] |= f2bf(c) << 16; } else { qt[2 * e4 + (e >> 1)] = f2bf(a); kt[2 * e4 + (e >> 1)] = f2bf(c); } } }
#pragma unroll
              for (int e = 0; e < 4; ++e) { const int col = c16 + 4 * e4 + e;
                  *(LAS bf16*)(lds + HG_KE + col * 144 + sperm * 2) = (bf16)f2bf(ke[e]);
                  const unsigned vw = i8[e4 >> 1][(2 * e4 + (e >> 1)) & 3]; *(LAS bf16*)(lds + HG_VT + col * 144 + sperm * 2) = (bf16)((e & 1) ? (vw >> 16) : (vw & 0xffffu)); } }
          if (OUT) { *(LAS v4u*)(lds + HG_QT + stok * 272 + c16 * 2) = (v4u){qt[0], qt[1], qt[2], qt[3]}; *(LAS v4u*)(lds + HG_QT + stok * 272 + c16 * 2 + 16) = (v4u){qt[4], qt[5], qt[6], qt[7]};
                     *(LAS v4u*)(lds + HG_KT + stok * 272 + c16 * 2) = (v4u){kt[0], kt[1], kt[2], kt[3]}; *(LAS v4u*)(lds + HG_KT + stok * 272 + c16 * 2 + 16) = (v4u){kt[4], kt[5], kt[6], kt[7]}; } }
        __syncthreads();
        if (OUT) {
            f32x16 X0, X1, O;
#pragma unroll
            for (int i = 0; i < 16; ++i) { X0[i] = 0.f; X1[i] = 0.f; O[i] = 0.f; }
            const LAS unsigned char* qtp = lds + HG_QT + (32 * tr + r) * 272 + hf * 16;
#pragma unroll
            for (int ks = 0; ks < 8; ++ks) { const s16x8 bq = *(const LAS s16x8*)(qtp + ks * 32);
                const s16x8 a0 = *(const LAS s16x8*)(lds + HG_KT + r * 272 + hf * 16 + ks * 32); X0 = __builtin_amdgcn_mfma_f32_32x32x16_bf16(a0, bq, X0, 0, 0, 0);
                if (tr == 1) { const s16x8 a1 = *(const LAS s16x8*)(lds + HG_KT + (32 + r) * 272 + hf * 16 + ks * 32); X1 = __builtin_amdgcn_mfma_f32_32x32x16_bf16(a1, bq, X1, 0, 0, 0); } }
#pragma unroll
            for (int i = 0; i < 16; ++i) { const bool keep = crow16(i, hf) <= r; if (tr == 0) X0[i] = keep ? X0[i] : 0.f; else X1[i] = keep ? X1[i] : 0.f; }
            const LAS unsigned char* vtp = lds + HG_VT + (32 * vq + r) * 144 + hf * 16;
#pragma unroll
            for (int s2 = 0; s2 < 2; ++s2) { v4u pw; pw.x = cvtpk(X0[8 * s2], X0[8 * s2 + 1]); pw.y = cvtpk(X0[8 * s2 + 2], X0[8 * s2 + 3]); pw.z = cvtpk(X0[8 * s2 + 4], X0[8 * s2 + 5]); pw.w = cvtpk(X0[8 * s2 + 6], X0[8 * s2 + 7]);
                const s16x8 bv = *(const LAS s16x8*)(vtp + (16 * s2) * 2); O = __builtin_amdgcn_mfma_f32_32x32x16_bf16(__builtin_bit_cast(s16x8, pw), bv, O, 0, 0, 0); }
            if (tr == 1) {
#pragma unroll
                for (int s2 = 0; s2 < 2; ++s2) { v4u pw; pw.x = cvtpk(X1[8 * s2], X1[8 * s2 + 1]); pw.y = cvtpk(X1[8 * s2 + 2], X1[8 * s2 + 3]); pw.z = cvtpk(X1[8 * s2 + 4], X1[8 * s2 + 5]); pw.w = cvtpk(X1[8 * s2 + 6], X1[8 * s2 + 7]);
                    const s16x8 bv = *(const LAS s16x8*)(vtp + (32 + 16 * s2) * 2); O = __builtin_amdgcn_mfma_f32_32x32x16_bf16(__builtin_bit_cast(s16x8, pw), bv, O, 0, 0, 0); } }
            const LAS unsigned char* stp = lds + HG_ST + (32 * vq + r) * 272 + hf * 16;
#pragma unroll
            for (int ks = 0; ks < 8; ++ks) { const s16x8 aq = *(const LAS s16x8*)(qtp + ks * 32), bs = *(const LAS s16x8*)(stp + ks * 32); O = __builtin_amdgcn_mfma_f32_32x32x16_bf16(aq, bs, O, 0, 0, 0); }
#pragma unroll
            for (int i = 0; i < 16; ++i) G[(32 * tr + crow16(i, hf)) * 128 + 32 * vq + r] = O[i];
        }
#pragma unroll
        for (int dd = 0; dd < 2; ++dd) { const int dr = 2 * tr + dd;
#pragma unroll
            for (int g4 = 0; g4 < 4; ++g4) { const f32x4 ge = *(const LAS f32x4*)(GE + 32 * dr + 8 * g4 + 4 * hf);
                S[dd][4 * g4] *= __builtin_amdgcn_exp2f(ge.x); S[dd][4 * g4 + 1] *= __builtin_amdgcn_exp2f(ge.y); S[dd][4 * g4 + 2] *= __builtin_amdgcn_exp2f(ge.z); S[dd][4 * g4 + 3] *= __builtin_amdgcn_exp2f(ge.w); }
#pragma unroll
            for (int ks = 0; ks < 4; ++ks) { const s16x8 a = *(const LAS s16x8*)(lds + HG_KE + (32 * dr + r) * 144 + hf * 16 + ks * 32), bv = *(const LAS s16x8*)(lds + HG_VT + (32 * vq + r) * 144 + hf * 16 + ks * 32);
                S[dd] = __builtin_amdgcn_mfma_f32_32x32x16_bf16(a, bv, S[dd], 0, 0, 0); } }
        __syncthreads();
        if (OUT) {
#pragma unroll 2
            for (int k = 0; k < 8; ++k) { const int tt = wave + 8 * k; const float o0 = G[tt * 128 + lane], o1 = G[tt * 128 + lane + 64];
                const float ms = wave_sum(o0 * o0 + o1 * o1) * (1.f / 128.f), rr = 1.f / sqrtf(ms + 1e-6f);
                const bf16* grow = h + (t0 + tt) * NC_H + 2304 + hh * 128; const float g0 = bf2f(grow[lane]), g1 = bf2f(grow[lane + 64]);
                bf16* mrow = mix + (t0 + tt) * 1024 + hh * 128;
                mrow[lane] = (bf16)f2bf(o0 * rr * normg[lane] * sigmoidf_(g0)); mrow[lane + 64] = (bf16)f2bf(o1 * rr * normg[lane + 64] * sigmoidf_(g1)); }
            __syncthreads();
        }
    }
    if (!OUT) {
#pragma unroll
        for (int dd = 0; dd < 2; ++dd)
#pragma unroll
            for (int i = 0; i < 16; ++i) Sp[(32 * (2 * tr + dd) + crow16(i, hf)) * 128] = S[dd][i];
        if (cpart == 3) Dseg[(size_t)unit * 128 + cd] = __builtin_amdgcn_exp2f(gsum);
    }
}
__device__ __forceinline__ void hgrn_scan(float* Sloc, const float* Dseg, size_t gtid, size_t gthreads) {
    for (size_t idx = gtid; idx < (size_t)NBATCH * HG_H * 16384; idx += gthreads) { const int bh = (int)(idx >> 14), e = (int)(idx & 16383), d = e >> 7; float cur = 0.f;
        for (int seg = 0; seg < HNSEG; ++seg) { const size_t u = (size_t)bh * HNSEG + seg; float* p = Sloc + u * 16384 + e; const float tmp = *p; *p = cur; cur = Dseg[u * 128 + d] * cur + tmp; } }
}

template <bool MASK>
__device__ __forceinline__ void attn4(const LAS unsigned* Ks, const LAS bf16* Vs, const LAS float* qst, LAS float* pb, int lane, const int (&tq)[4], int kbase, float slope,
                                      float (&mo)[4], float (&lo)[4], float (&oo)[4]) {
    float sc[4][4];
#pragma unroll
    for (int a = 0; a < 4; ++a)
#pragma unroll
        for (int c = 0; c < 4; ++c) sc[a][c] = 0.f;
#pragma unroll 4
    for (int dd = 0; dd < 32; ++dd) {
        f32x2 qv[4];
#pragma unroll
        for (int qi = 0; qi < 4; ++qi) qv[qi] = *(const LAS f32x2*)(qst + qi * 64 + 2 * dd);
#pragma unroll
        for (int kk = 0; kk < 4; ++kk) { const unsigned kw = Ks[(lane + 64 * kk) * 33 + dd]; const float k0 = bflo(kw), k1 = bfhi(kw);
#pragma unroll
            for (int qi = 0; qi < 4; ++qi) sc[qi][kk] += qv[qi].x * k0 + qv[qi].y * k1; }
    }
#pragma unroll
    for (int qi = 0; qi < 4; ++qi) { float mx = -INFINITY;
#pragma unroll
        for (int kk = 0; kk < 4; ++kk) { const int pos = kbase + lane + 64 * kk; float lg = sc[qi][kk] * 0.125f - slope * (float)(tq[qi] - pos); if (MASK && pos > tq[qi]) lg = -INFINITY; sc[qi][kk] = lg; mx = fmaxf(mx, lg); }
        mx = wave_max(mx); float s = 0.f;
#pragma unroll
        for (int kk = 0; kk < 4; ++kk) { const float p = __builtin_amdgcn_exp2f((sc[qi][kk] - mx) * 1.4426950408889634f); pb[qi * 256 + lane + 64 * kk] = p; s += p; }
        lo[qi] = wave_sum(s); mo[qi] = mx; }
    float o[4] = {0.f, 0.f, 0.f, 0.f};
#pragma unroll 4
    for (int k4 = 0; k4 < 64; ++k4) { f32x4 p4[4];
#pragma unroll
        for (int qi = 0; qi < 4; ++qi) p4[qi] = *(const LAS f32x4*)(pb + qi * 256 + 4 * k4);
#pragma unroll
        for (int jj = 0; jj < 4; ++jj) { const float vv = bf2f(Vs[(4 * k4 + jj) * 64 + lane]);
#pragma unroll
            for (int qi = 0; qi < 4; ++qi) o[qi] += p4[qi][jj] * vv; } }
#pragma unroll
    for (int qi = 0; qi < 4; ++qi) oo[qi] = o[qi];
}
constexpr int AT_KS = 0, AT_VS = 33792, AT_WV = 66560, AT_WVB = 5120;

__device__ __forceinline__ void memattn_unit(LAS unsigned char* lds, const bf16* h, int NC, int qoff, const bf16* kv, bf16* mix, int unit, int tid, int wave, int lane) {
    const int chunk = unit & 31, bm = unit >> 5, mh = bm & 3, b = bm >> 2;
    LAS unsigned* Ks = (LAS unsigned*)(lds + AT_KS); LAS unsigned* Vs32 = (LAS unsigned*)(lds + AT_VS);
    LAS float* qst = (LAS float*)(lds + AT_WV + wave * AT_WVB); LAS float* pb = qst + 256;
    for (int i = 0; i < 16; ++i) { const int idx = tid + 512 * i, r = idx >> 5, dd = idx & 31; const unsigned* src = (const unsigned*)(kv + (size_t)(b * 256 + r) * 512 + mh * 64);
        Ks[r * 33 + dd] = src[dd]; Vs32[r * 32 + dd] = src[128 + dd]; }
    __syncthreads();
    for (int qd = 0; qd < 16; ++qd) { const size_t tg = (size_t)b * SEQ + chunk * 512 + wave * 64 + qd * 4;
#pragma unroll
        for (int qi = 0; qi < 4; ++qi) qst[qi * 64 + lane] = bf2f(h[(tg + qi) * NC + qoff + mh * 64 + lane]);
        const int tq[4] = {0, 0, 0, 0}; float m[4], l[4], o[4];
        attn4<false>(Ks, (const LAS bf16*)Vs32, qst, pb, lane, tq, 0, 0.f, m, l, o);
#pragma unroll
        for (int qi = 0; qi < 4; ++qi) mix[(tg + qi) * 1024 + MIXW + mh * 64 + lane] = (bf16)f2bf(o[qi] / l[qi]); }
    __syncthreads();
}

constexpr int AT2_K = 0, AT2_KROW = 176, AT2_V = 256 * AT2_KROW, AT2_VROW = 528;
__device__ __forceinline__ void stage_kv_images(LAS unsigned char* lds, const bf16* kp, const bf16* vp, size_t row_stride, int tid) {
#pragma unroll
    for (int i = 0; i < 4; ++i) { const int idx = tid + 512 * i, key = idx >> 3, c = idx & 7;
        const v4u kx = *(const v4u*)(kp + (size_t)key * row_stride + 8 * c);
        *(LAS v4u*)(lds + AT2_K + key * AT2_KROW + c * 16) = kx;
        const v4u vx = *(const v4u*)(vp + (size_t)key * row_stride + 8 * c);
        const int pos = (key & ~15) | (key & 3) | ((key & 4) << 1) | ((key & 8) >> 1);
        LAS bf16* vt = (LAS bf16*)(lds + AT2_V) + pos;
#pragma unroll
        for (int w = 0; w < 4; ++w) { vt[(8 * c + 2 * w) * (AT2_VROW / 2)] = (bf16)(vx[w] & 0xffffu); vt[(8 * c + 2 * w + 1) * (AT2_VROW / 2)] = (bf16)(vx[w] >> 16); } }
    if (tid < 256) { const unsigned pb = f2bf((float)tid); const v4u e0 = {pb | (pb << 16), 0u, 0u, 0u}, z = {0u, 0u, 0u, 0u};
        *(LAS v4u*)(lds + AT2_K + tid * AT2_KROW + 128) = e0; *(LAS v4u*)(lds + AT2_K + tid * AT2_KROW + 144) = z; }
}
template <bool MASK>
__device__ __forceinline__ void attn_tile32(const LAS unsigned char* lds, const bf16* qrow, int lane, float dist0, unsigned qx, bool own, f32x16 (&o)[2], float& mrow, float& lrow) {
    const int r = lane & 31, hf = lane >> 5;
    s16x8 qf[4];
#pragma unroll
    for (int s = 0; s < 4; ++s) qf[s] = *(const s16x8*)(qrow + 16 * s + 8 * hf);
    const v4u qxv = {qx, 0u, 0u, 0u}; const s16x8 qe = __builtin_bit_cast(s16x8, qxv);
    f32x16 acc[8];
    const LAS unsigned char* kb = lds + AT2_K + r * AT2_KROW + hf * 16;
#pragma unroll
    for (int kt = 0; kt < 8; ++kt) {
#pragma unroll
        for (int i = 0; i < 16; ++i) acc[kt][i] = 0.f;
#pragma unroll
        for (int s = 0; s < 4; ++s) { const s16x8 kf = *(const LAS s16x8*)(kb + kt * 32 * AT2_KROW + s * 32); acc[kt] = __builtin_amdgcn_mfma_f32_32x32x16_bf16(kf, qf[s], acc[kt], 0, 0, 0); }
        if (MASK) { const s16x8 kf = *(const LAS s16x8*)(kb + kt * 32 * AT2_KROW + 128); acc[kt] = __builtin_amdgcn_mfma_f32_32x32x16_bf16(kf, qe, acc[kt], 0, 0, 0); }
        __builtin_amdgcn_sched_barrier(0); }
    float mx = -INFINITY;
    if (MASK && own) { const float base2 = dist0 - 4.f * (float)hf;
#pragma unroll
        for (int kt = 0; kt < 8; ++kt)
#pragma unroll
            for (int i = 0; i < 16; ++i) { const float dist = base2 - (float)(32 * kt + (i & 3) + 8 * (i >> 2)); const float lg = dist < 0.f ? -INFINITY : acc[kt][i]; acc[kt][i] = lg; mx = fmaxf(mx, lg); }
    } else {
#pragma unroll
        for (int kt = 0; kt < 8; ++kt)
#pragma unroll
            for (int i = 0; i < 16; ++i) mx = fmaxf(mx, acc[kt][i]);
    }
    mx = fmaxf(mx, xor32f(mx, lane));
    float sum = 0.f;
#pragma unroll
    for (int i = 0; i < 16; ++i) { o[0][i] = 0.f; o[1][i] = 0.f; }
    const LAS unsigned char* vb = lds + AT2_V + r * AT2_VROW + hf * 16;
#pragma unroll
    for (int kt = 0; kt < 8; ++kt) {
#pragma unroll
        for (int i = 0; i < 16; ++i) { const float p = __builtin_amdgcn_exp2f(acc[kt][i] - mx); sum += p; acc[kt][i] = p; }
#pragma unroll
        for (int s2 = 0; s2 < 2; ++s2) { v4u pw; pw.x = cvtpk(acc[kt][8 * s2], acc[kt][8 * s2 + 1]); pw.y = cvtpk(acc[kt][8 * s2 + 2], acc[kt][8 * s2 + 3]);
            pw.z = cvtpk(acc[kt][8 * s2 + 4], acc[kt][8 * s2 + 5]); pw.w = cvtpk(acc[kt][8 * s2 + 6], acc[kt][8 * s2 + 7]); const s16x8 pf = __builtin_bit_cast(s16x8, pw);
#pragma unroll
            for (int dt = 0; dt < 2; ++dt) { const s16x8 vf = *(const LAS s16x8*)(vb + dt * 32 * AT2_VROW + (32 * kt + 16 * s2) * 2); o[dt] = __builtin_amdgcn_mfma_f32_32x32x16_bf16(vf, pf, o[dt], 0, 0, 0); } }
        __builtin_amdgcn_sched_barrier(0); }
    sum += xor32f(sum, lane);
    mrow = mx; lrow = sum;
}
__device__ __forceinline__ void memattn_unit2(LAS unsigned char* lds, const bf16* h, int NC, int qoff, const bf16* kv, bf16* mix, int unit, int tid, int wave, int lane) {
    const int chunk = unit & 63, bm = unit >> 6, mh = bm & 3, b = bm >> 2, r = lane & 31, hf = lane >> 5;
    const bf16* kvrow0 = kv + (size_t)(b * 256) * 512 + mh * 64;
    stage_kv_images(lds, kvrow0, kvrow0 + 256, 512, tid);
    __syncthreads();
    { const size_t tg = (size_t)b * SEQ + chunk * 256 + wave * 32 + r;
        f32x16 o[2]; float m2, l;
        attn_tile32<false>(lds, h + tg * NC + qoff + mh * 64, lane, 0.f, 0u, false, o, m2, l);
        const float inv = 1.f / l; bf16* mp = mix + tg * 1024 + MIXW + mh * 64 + 4 * hf;
#pragma unroll
        for (int dt = 0; dt < 2; ++dt)
#pragma unroll
            for (int g = 0; g < 4; ++g) { v2u w; w.x = cvtpk(o[dt][4 * g] * inv, o[dt][4 * g + 1] * inv); w.y = cvtpk(o[dt][4 * g + 2] * inv, o[dt][4 * g + 3] * inv); *(v2u*)(mp + 32 * dt + 8 * g) = w; } }
    __syncthreads();
}
__device__ __forceinline__ void kmean_unit(LAS unsigned char* lds, const bf16* h, float* kmean, int unit, int tid) {
    const int n = unit & 63, bh = unit >> 6, hh = bh % MB_H, b = bh / MB_H, d = tid & 63, part = tid >> 6;
    LAS float* red = (LAS float*)lds;
    float s = 0.f; const bf16* p = h + ((size_t)b * SEQ + n * 256 + part * 32) * NC_M + 768 + hh * 64 + d;
    for (int i = 0; i < 32; ++i) s += bf2f(p[(size_t)i * NC_M]);
    red[part * 64 + d] = s; __syncthreads();
    if (tid < 64) { float a = 0.f; for (int pp = 0; pp < 8; ++pp) a += red[pp * 64 + tid]; kmean[((size_t)bh * 64 + n) * 64 + tid] = a * (1.f / 256.f); }
    __syncthreads();
}
__device__ __forceinline__ void moba_gate_unit(LAS unsigned char* lds, const bf16* h, const float* kmean, unsigned* gcount, int* selinfo, unsigned* list, int unit, int tid) {
    const int c = unit & 63, bh = unit >> 6, hh = bh % MB_H, b = bh / MB_H;
    LAS float* km = (LAS float*)lds; LAS int* hist = (LAS int*)(lds + 16384); LAS int* base = hist + 64;
    for (int i = tid; i < 4096; i += NTHR) km[i] = kmean[(size_t)bh * 4096 + i];
    if (tid < 64) hist[tid] = 0;
    __syncthreads();
    int s0 = 0, s1 = 0, s2 = 0, r0 = 0, r1 = 0, r2 = 0, ns = 0; const int t = c * 256 + tid;
    if (tid < 256) {
        float q[64]; const v4u* qp = (const v4u*)(h + ((size_t)b * SEQ + t) * NC_M + hh * 64);
#pragma unroll
        for (int w = 0; w < 8; ++w) { const v4u x = qp[w]; q[8 * w] = bflo(x.x); q[8 * w + 1] = bfhi(x.x); q[8 * w + 2] = bflo(x.y); q[8 * w + 3] = bfhi(x.y); q[8 * w + 4] = bflo(x.z); q[8 * w + 5] = bfhi(x.z); q[8 * w + 6] = bflo(x.w); q[8 * w + 7] = bfhi(x.w); }
        float v0 = -INFINITY, v1 = -INFINITY, v2 = -INFINITY;
        for (int n = 0; n < c; ++n) { float g = 0.f;
#pragma unroll
            for (int d4 = 0; d4 < 16; ++d4) { const f32x4 k4 = *(const LAS f32x4*)(km + n * 64 + 4 * d4); g += q[4 * d4] * k4.x + q[4 * d4 + 1] * k4.y + q[4 * d4 + 2] * k4.z + q[4 * d4 + 3] * k4.w; }
            if (g > v0) { v2 = v1; s2 = s1; v1 = v0; s1 = s0; v0 = g; s0 = n; } else if (g > v1) { v2 = v1; s2 = s1; v1 = g; s1 = n; } else if (g > v2) { v2 = g; s2 = n; } }
        ns = c < 3 ? c : 3;
        if (ns > 0) r0 = __hip_atomic_fetch_add(hist + s0, 1, __ATOMIC_RELAXED, __HIP_MEMORY_SCOPE_WORKGROUP);
        if (ns > 1) r1 = __hip_atomic_fetch_add(hist + s1, 1, __ATOMIC_RELAXED, __HIP_MEMORY_SCOPE_WORKGROUP);
        if (ns > 2) r2 = __hip_atomic_fetch_add(hist + s2, 1, __ATOMIC_RELAXED, __HIP_MEMORY_SCOPE_WORKGROUP);
        selinfo[((size_t)b * SEQ + t) * MB_H + hh] = ns;
    }
    __syncthreads();
    if (tid < 64) { const int hc = hist[tid]; if (hc > 0) base[tid] = (int)__hip_atomic_fetch_add(gcount + bh * 64 + tid, (unsigned)hc, __ATOMIC_RELAXED, __HIP_MEMORY_SCOPE_AGENT); }
    __syncthreads();
    if (tid < 256) { unsigned* lp = list + ((size_t)bh * 64 << 14);
        if (ns > 0) lp[((size_t)s0 << 14) + base[s0] + r0] = (unsigned)t;
        if (ns > 1) lp[((size_t)s1 << 14) + base[s1] + r1] = (unsigned)t | (1u << 14);
        if (ns > 2) lp[((size_t)s2 << 14) + base[s2] + r2] = (unsigned)t | (2u << 14); }
    __syncthreads();
}
__device__ __forceinline__ void moba_attn_item(LAS unsigned char* lds, const bf16* h, const unsigned* gcount, const unsigned* list, float* po, float* pml, int item, int tid, int wave, int lane) {
    const int n = item / 24, bh = item - n * 24, hh = bh % MB_H, b = bh / MB_H;
    LAS unsigned* Ks = (LAS unsigned*)(lds + AT_KS); LAS unsigned* Vs32 = (LAS unsigned*)(lds + AT_VS);
    LAS float* qst = (LAS float*)(lds + AT_WV + wave * AT_WVB); LAS float* pb = qst + 256;
    for (int i = 0; i < 16; ++i) { const int idx = tid + 512 * i, r = idx >> 5, dd = idx & 31; const unsigned* src = (const unsigned*)(h + ((size_t)b * SEQ + n * 256 + r) * NC_M + hh * 64);
        Ks[r * 33 + dd] = src[384 + dd]; Vs32[r * 32 + dd] = src[768 + dd]; }
    __syncthreads();
    const int cnt = (int)gcount[bh * 64 + n], total = 256 + cnt, nquads = (total + 3) >> 2;
    const float slope = hh < 8 ? ldexpf(1.0f, -(hh + 1)) : ldexpf(0.70710678118654752f, -(hh - 8));
    const unsigned* lp = list + (((size_t)bh * 64 + n) << 14);
    for (int quad = wave; quad < nquads; quad += 8) {
        int tq[4], slot[4];
#pragma unroll
        for (int qi = 0; qi < 4; ++qi) { int idx = quad * 4 + qi; idx = idx < total ? idx : total - 1;
            if (idx < 256) { tq[qi] = n * 256 + idx; slot[qi] = 3; } else { const unsigned e = lp[idx - 256]; tq[qi] = (int)(e & 16383u); slot[qi] = (int)(e >> 14); } }
#pragma unroll
        for (int qi = 0; qi < 4; ++qi) qst[qi * 64 + lane] = bf2f(h[((size_t)b * SEQ + tq[qi]) * NC_M + hh * 64 + lane]);
        float m[4], l[4], o[4];
        attn4<true>(Ks, (const LAS bf16*)Vs32, qst, pb, lane, tq, n * 256, slope, m, l, o);
#pragma unroll
        for (int qi = 0; qi < 4; ++qi) if (quad * 4 + qi < total) { const size_t pi = (((size_t)b * SEQ + tq[qi]) * MB_H + hh) * 4 + slot[qi];
            po[pi * 64 + lane] = o[qi]; if (lane == 0) { pml[pi * 2] = m[qi]; pml[pi * 2 + 1] = l[qi]; } }
    }
    __syncthreads();
}

__device__ __forceinline__ void moba_attn_item2(LAS unsigned char* lds, const bf16* h, const unsigned* gcount, const unsigned* list, bf16* po, float* pml, int item, int tid, int wave, int lane) {
    const int n = item / 24, bh = item - n * 24, hh = bh % MB_H, b = bh / MB_H, r = lane & 31, hf = lane >> 5;
    const bf16* hrow0 = h + ((size_t)b * SEQ + n * 256) * NC_M + hh * 64;
    stage_kv_images(lds, hrow0 + 768, hrow0 + 1536, NC_M, tid);
    __syncthreads();
    const int cnt = (int)gcount[bh * 64 + n], total = 256 + cnt, ntiles = (total + 31) >> 5;
    const float slope2 = (hh < 8 ? ldexpf(1.0f, -(hh + 1)) : ldexpf(0.70710678118654752f, -(hh - 8))) * 1.4426950408889634f;
    const unsigned shi = f2bf(slope2), slo = f2bf(slope2 - __builtin_bit_cast(float, shi << 16)); const unsigned qx = hf == 0 ? (shi | (slo << 16)) : 0u;
    const unsigned* lp = list + (((size_t)bh * 64 + n) << 14);
#pragma unroll 1
    for (int tile = wave; tile < ntiles; tile += NWAVES) {
        int idx = tile * 32 + r; const bool valid = idx < total; idx = valid ? idx : total - 1;
        int tq, slot; if (idx < 256) { tq = n * 256 + idx; slot = 3; } else { const unsigned e = lp[idx - 256]; tq = (int)(e & 16383u); slot = (int)(e >> 14); }
        f32x16 o[2]; float m2, l; const float dist0 = (float)(tq - n * 256);
        attn_tile32<true>(lds, h + ((size_t)b * SEQ + tq) * NC_M + hh * 64, lane, dist0, qx, tile < 8, o, m2, l);
        if (valid) { const size_t pi = (((size_t)b * SEQ + tq) * MB_H + hh) * 4 + slot; bf16* op = po + pi * 64 + 4 * hf;
#pragma unroll
            for (int dt = 0; dt < 2; ++dt)
#pragma unroll
                for (int g = 0; g < 4; ++g) { v2u w; w.x = cvtpk(o[dt][4 * g], o[dt][4 * g + 1]); w.y = cvtpk(o[dt][4 * g + 2], o[dt][4 * g + 3]); *(v2u*)(op + 32 * dt + 8 * g) = w; }
            if (hf == 0) { pml[pi * 2] = m2 - slope2 * dist0; pml[pi * 2 + 1] = l; } }
    }
    __syncthreads();
}
__device__ __forceinline__ void moba_combine(const bf16* __restrict__ po, const float* __restrict__ pml, const int* __restrict__ selinfo, bf16* __restrict__ mix, int gw, int ngw, int lane) {
    const int sub = lane >> 4, d4 = (lane & 15) * 4;
#pragma unroll 2
    for (int idx = gw * 4 + sub; idx < T * MB_H; idx += ngw * 4) { const int tg = idx / MB_H, hh = idx - tg * MB_H, ns = selinfo[idx]; const size_t p4 = (size_t)idx * 4;
        f32x2 ml[4]; f32x4 ov[4];
#pragma unroll
        for (int j = 0; j < 4; ++j) { ml[j] = ((const f32x2*)pml)[p4 + j]; const v2u ow = *(const v2u*)(po + (p4 + j) * 64 + d4); ov[j] = (f32x4){bflo(ow.x), bfhi(ow.x), bflo(ow.y), bfhi(ow.y)}; }
        float M = ml[3].x;
#pragma unroll
        for (int j = 0; j < 3; ++j) { const bool ok = j < ns; ml[j].x = ok ? ml[j].x : -INFINITY; ml[j].y = ok ? ml[j].y : 0.f; M = fmaxf(M, ml[j].x);
            ov[j].x = ok ? ov[j].x : 0.f; ov[j].y = ok ? ov[j].y : 0.f; ov[j].z = ok ? ov[j].z : 0.f; ov[j].w = ok ? ov[j].w : 0.f; }
        float den = 0.f; f32x4 num = {0.f, 0.f, 0.f, 0.f};
#pragma unroll
        for (int j = 0; j < 4; ++j) { const float w = __builtin_amdgcn_exp2f(ml[j].x - M); den += w * ml[j].y; num += ov[j] * w; }
        const float inv = 1.f / den; v2u o; o.x = pk2(num.x * inv, num.y * inv); o.y = pk2(num.z * inv, num.w * inv);
        *(v2u*)(mix + (size_t)tg * 1024 + hh * 64 + d4) = o; }
}

__device__ __forceinline__ void ln_row(f32x4 (&v)[4], const f32x4 (&gv)[4], const f32x4 (&bv)[4]) {
    float s = 0.f;
#pragma unroll
    for (int j = 0; j < 4; ++j) s += (v[j].x + v[j].y) + (v[j].z + v[j].w);
    const float mean = wave_sum(s) * (1.f / D); float s2 = 0.f;
#pragma unroll
    for (int j = 0; j < 4; ++j) { v[j] = v[j] - mean; s2 += (v[j].x * v[j].x + v[j].y * v[j].y) + (v[j].z * v[j].z + v[j].w * v[j].w); }
    const float rstd = 1.f / sqrtf(wave_sum(s2) * (1.f / D) + 1e-5f);
#pragma unroll
    for (int j = 0; j < 4; ++j) v[j] = v[j] * rstd * gv[j] + bv[j];
}
__device__ __forceinline__ void phase_ln1(LAS unsigned char* lds, const bf16* y, const float* g, const float* bb, const float* wr, const float* br,
                                          bf16* xbf, int* tok_e, int* tok_lr, float* tok_w, int* blk_cnt, int blk, int tid, int wave, int lane) {
    LAS float* xst = (LAS float*)lds;
    LAS float* part = (LAS float*)(lds + 32768);
    LAS int* hist = (LAS int*)(lds + 40960);
    if (tid < 32) hist[tid] = 0;
    constexpr int TPB = T / GRID;
    const int e = lane & 31, half = lane >> 5;
    float wreg[64];
    { const float* wp = wr + (size_t)(wave * 128 + half * 64) * NE + e;
#pragma unroll
      for (int k = 0; k < 64; ++k) wreg[k] = wp[k * NE]; }
    const float bre = br[e];
    __syncthreads();
    f32x4 gv[4], bv[4];
#pragma unroll
    for (int j = 0; j < 4; ++j) { gv[j] = ((const f32x4*)g)[lane + 64 * j]; bv[j] = ((const f32x4*)bb)[lane + 64 * j]; }
    v2u xn[4], yn[4];
    { const size_t t0 = (size_t)blk * TPB + wave; const v2u* xr = (const v2u*)(xbf + t0 * D) + lane; const v2u* yr = (const v2u*)(y + t0 * D) + lane;
#pragma unroll
      for (int j = 0; j < 4; ++j) { xn[j] = xr[64 * j]; yn[j] = yr[64 * j]; } }
    for (int grp = 0; grp < TPB / NWAVES; ++grp) { const size_t t = (size_t)blk * TPB + grp * NWAVES + wave;
        { f32x4 v[4];
#pragma unroll
          for (int j = 0; j < 4; ++j) { const v2u xw = xn[j]; const v2u yw = yn[j];
              v[j].x = DN_ALPHA * bflo(xw.x) + bflo(yw.x); v[j].y = DN_ALPHA * bfhi(xw.x) + bfhi(yw.x); v[j].z = DN_ALPHA * bflo(xw.y) + bflo(yw.y); v[j].w = DN_ALPHA * bfhi(xw.y) + bfhi(yw.y); }
          if (grp + 1 < TPB / NWAVES) { const v2u* xr = (const v2u*)(xbf + (t + NWAVES) * D) + lane; const v2u* yr = (const v2u*)(y + (t + NWAVES) * D) + lane;
#pragma unroll
              for (int j = 0; j < 4; ++j) { xn[j] = xr[64 * j]; yn[j] = yr[64 * j]; } }
          ln_row(v, gv, bv);
          v2u* xb = (v2u*)(xbf + t * D) + lane;
#pragma unroll
          for (int j = 0; j < 4; ++j) { v2u w; w.x = pk2(v[j].x, v[j].y); w.y = pk2(v[j].z, v[j].w); xb[64 * j] = w; ((LAS f32x4*)(xst + wave * 1024))[lane + 64 * j] = v[j]; } }
        __syncthreads();
#pragma unroll 2
        for (int tk = 0; tk < 8; ++tk) { float acc = 0.f; const LAS float* xs_ = xst + tk * 1024 + wave * 128 + half * 64;
#pragma unroll
            for (int k4 = 0; k4 < 16; ++k4) { const f32x4 xv = *(const LAS f32x4*)(xs_ + 4 * k4); acc += xv.x * wreg[4 * k4]; acc += xv.y * wreg[4 * k4 + 1]; acc += xv.z * wreg[4 * k4 + 2]; acc += xv.w * wreg[4 * k4 + 3]; }
            acc += xor32f(acc, lane);
            if (half == 0) part[(wave * 8 + tk) * 32 + e] = acc; }
        __syncthreads();
        float logit = bre;
#pragma unroll
        for (int w = 0; w < 8; ++w) logit += part[(w * 8 + wave) * 32 + e];
        int se[4]; float sv[4];
#pragma unroll
        for (int k = 0; k < 4; ++k) { float bvv = logit; int bi = e;
#define ARGMAX_STEP(X) { const float ov = xorf<X>(bvv); const int oi = xori<X>(bi); if (ov > bvv || (ov == bvv && oi < bi)) { bvv = ov; bi = oi; } }
            ARGMAX_STEP(1) ARGMAX_STEP(2) ARGMAX_STEP(4) ARGMAX_STEP(8) ARGMAX_STEP(16)
#undef ARGMAX_STEP
            se[k] = bi; sv[k] = bvv; if (e == bi) logit = -INFINITY; }
        const float e1 = __expf(sv[1] - sv[0]), e2 = __expf(sv[2] - sv[0]), e3 = __expf(sv[3] - sv[0]), inv = 1.f / (1.f + e1 + e2 + e3);
        const float wk[4] = {inv, e1 * inv, e2 * inv, e3 * inv};
        if (lane == 0) {
#pragma unroll
            for (int k = 0; k < 4; ++k) { const int lr = __hip_atomic_fetch_add(hist + se[k], 1, __ATOMIC_RELAXED, __HIP_MEMORY_SCOPE_WORKGROUP);
                tok_e[t * 4 + k] = se[k]; tok_lr[t * 4 + k] = lr; tok_w[t * 4 + k] = wk[k]; } }
    }
    __syncthreads();
    if (tid < 32) blk_cnt[blk * 32 + tid] = hist[tid];
    __syncthreads();
}
__device__ __forceinline__ void phase_dispatch(LAS unsigned char* lds, const int* __restrict__ blk_cnt, const int* __restrict__ tok_e, const int* __restrict__ tok_lr, int* __restrict__ tok_row, int* __restrict__ tab,
                                               const bf16* __restrict__ xbf, bf16* __restrict__ xs, int blk, int tid, int wave, int lane) {
    LAS int* tot = (LAS int*)lds; LAS int* pre = tot + 32; LAS int* pst = pre + 32; LAS int* rows = pst + 64;
    if (tid < 32) { int s = 0, p = 0;
#pragma unroll 8
        for (int bb = 0; bb < GRID; ++bb) { const int c = blk_cnt[bb * 32 + tid]; p += (bb < blk) ? c : 0; s += c; } tot[tid] = s; pre[tid] = p; }
    __syncthreads();
    if (tid == 0) { int acc = 0; for (int e = 0; e < 32; ++e) { pst[e] = acc; acc += ((tot[e] + 255) >> 8) << 8; } pst[32] = acc; }
    __syncthreads();
    if (blk == 0 && tid < 33) tab[tid] = pst[tid] >> 8;
    constexpr int TPB = T / GRID;
    static_assert(TPB * 4 == NTHR, "one (token, k) pair per thread");
    { const size_t ti = (size_t)blk * TPB * 4 + tid; const int e = tok_e[ti]; const int r = pst[e] + pre[e] + tok_lr[ti]; tok_row[ti] = r; rows[tid] = r; }
    __syncthreads();
#pragma unroll 4
    for (int i = wave; i < TPB * 4; i += NWAVES) { const int r = rows[i];
        const v4u* src = (const v4u*)(xbf + ((size_t)blk * TPB + (i >> 2)) * D) + 2 * lane; const v4u a = src[0], b = src[1];
        v4u o; o.x = pk4_fp8(bflo(a.x), bfhi(a.x), bflo(a.y), bfhi(a.y)); o.y = pk4_fp8(bflo(a.z), bfhi(a.z), bflo(a.w), bfhi(a.w)); o.z = pk4_fp8(bflo(b.x), bfhi(b.x), bflo(b.y), bfhi(b.y)); o.w = pk4_fp8(bflo(b.z), bfhi(b.z), bflo(b.w), bfhi(b.w));
        ((v4u*)((unsigned char*)xs + (size_t)r * D))[lane] = o; }
    __syncthreads();
}
__device__ __forceinline__ f32x4 fp8x4_to_f32(unsigned w) {
    const f32x2 lo = __builtin_amdgcn_cvt_pk_f32_fp8((int)w, false), hi = __builtin_amdgcn_cvt_pk_f32_fp8((int)w, true); return (f32x4){lo.x, lo.y, hi.x, hi.y};
}
__device__ __forceinline__ void phase_ln2(const unsigned char* __restrict__ yrows, const int* __restrict__ tok_row, const float* __restrict__ tok_w, const float* __restrict__ g, const float* __restrict__ bb,
                                          float* __restrict__ xout, bf16* xbf, int gw, int ngw, int lane) {
    f32x4 gv[4], bv[4];
#pragma unroll
    for (int j = 0; j < 4; ++j) { gv[j] = ((const f32x4*)g)[lane + 64 * j]; bv[j] = ((const f32x4*)bb)[lane + 64 * j]; }
    static_assert(T % (2 * GRID * NWAVES) == 0, "two tokens per wave per step");
    for (int t0 = gw; t0 < T; t0 += 2 * ngw) {
        f32x4 v[2][4];
#pragma unroll
        for (int u = 0; u < 2; ++u) { const int t = t0 + u * ngw; int r[4]; float w[4];
#pragma unroll
            for (int k = 0; k < 4; ++k) { r[k] = tok_row[(size_t)t * 4 + k]; w[k] = tok_w[(size_t)t * 4 + k] * (1.f / 16.f); }
            const v2u* xr = (const v2u*)(xbf + (size_t)t * D) + lane;
#pragma unroll
            for (int j = 0; j < 4; ++j) { f32x4 f = {0.f, 0.f, 0.f, 0.f};
#pragma unroll
                for (int k = 0; k < 4; ++k) { const unsigned yw = ((const unsigned*)(yrows + (size_t)r[k] * D))[lane + 64 * j]; f += fp8x4_to_f32(yw) * w[k]; }
                const v2u xw = xr[64 * j]; v[u][j].x = DN_ALPHA * bflo(xw.x) + f.x; v[u][j].y = DN_ALPHA * bfhi(xw.x) + f.y; v[u][j].z = DN_ALPHA * bflo(xw.y) + f.z; v[u][j].w = DN_ALPHA * bfhi(xw.y) + f.w; } }
#pragma unroll
        for (int u = 0; u < 2; ++u) { const int t = t0 + u * ngw;
            ln_row(v[u], gv, bv);
            if (xout) { f32x4* xo = (f32x4*)(xout + (size_t)t * D) + lane;
#pragma unroll
                for (int j = 0; j < 4; ++j) xo[64 * j] = v[u][j]; }
            else { v2u* xb = (v2u*)(xbf + (size_t)t * D) + lane;
#pragma unroll
                for (int j = 0; j < 4; ++j) { v2u ww; ww.x = pk2(v[u][j].x, v[u][j].y); ww.y = pk2(v[u][j].z, v[u][j].w); xb[64 * j] = ww; } } } }
}

struct Args { const float* in[20]; float* out; unsigned char* ws; int l_lo, l_hi, ph_lo, ph_hi; };
typedef const __attribute__((address_space(4))) Args* KArgsP;
#define KA_LOAD() ({ KArgsP p_ = (KArgsP)__builtin_amdgcn_kernarg_segment_ptr(); asm volatile("" : "+s"(p_)); p_; })
#ifndef PHMASK
#define PHMASK 0xFFFF
#endif
#ifndef REPEAT_MASK
#define REPEAT_MASK 0
#endif
#ifndef REPEAT_LMASK
#define REPEAT_LMASK 0xF
#endif
#define PH_BEGIN(k) _Pragma("unroll") for (int rep_ = 0; rep_ < ((((REPEAT_MASK >> (k)) & 1) && ((REPEAT_LMASK >> l) & 1)) ? 2 : 1); ++rep_) { if ((PHMASK >> (k)) & 1) { KArgsP ka = KA_LOAD(); unsigned char* ws = ka->ws; int tid = threadIdx.x; asm volatile("" : "+v"(tid)); \
    const int lane = tid & 63, wave = __builtin_amdgcn_readfirstlane(tid >> 6); int blk = blockIdx.x; asm volatile("" : "+s"(blk)); \
    const int gw = blk * NWAVES + wave; const size_t gtid = (size_t)blk * NTHR + tid; (void)lane; (void)gw; (void)gtid; (void)ws;
#if ONE_LAUNCH
#define PH_SEAM() do { XcdBarrier b_; b_.bar = (unsigned*)(KA_LOAD()->ws + WS_CTL) + CW_BAR; b_.x = xb_xcc_id(); b_.st = (volatile LAS unsigned*)(lds + MISC_OFF); xcd_barrier(b_); } while (0)
#else
#define PH_SEAM() do {} while (0)
#endif
#define PH_END() PH_SEAM(); } }
#define PH_END_NOSEAM() } }
#define WSP(type, off) ((type*)(ws + (off)))
constexpr int G = GRID, NGW = GRID * NWAVES; constexpr size_t GTHREADS = (size_t)GRID * NTHR;
template <int L> __device__ __forceinline__ void layer_phases(LAS unsigned char* lds) {
    constexpr int l = L; LAS int* tabL = (LAS int*)(lds + MISC_OFF + 256);

        const int j = l >> 1; const bool moba = (l & 1) != 0;
        const int NC = moba ? NC_M : NC_H, qoff = moba ? 2304 : 3072;

        PH_BEGIN(1)
            const float* win_src = moba ? ka->in[5] + (size_t)j * D * NC_M : ka->in[2] + (size_t)j * D * NC_H;
            const size_t moff = (size_t)l * NE * 1024 * 1024;
            phase_weights((LAS float*)(lds + wave * 16384), gw, NGW, lane, win_src, NC, ka->in[6] + (size_t)l * D * 512, ka->in[7] + (size_t)l * D * D,
                          ka->in[12] + moff, ka->in[14] + moff, ka->in[16] + moff, WSP(bf16, WS_WIN), WSP(bf16, WS_WKV), WSP(bf16, WS_WO), WSP(bf16, WS_WGU), WSP(bf16, WS_WD));
        PH_END()
        PH_BEGIN(2)
            { pg8::Gemm g{WSP(bf16, WS_XBF), WSP(bf16, WS_WIN), T, NC, D, 0, 0}; pg8::StaticOrder S; S.init(T, NC, G, blk); pg8::EpiPlain E{WSP(bf16, WS_H), NC, moba ? 0x207u : 0x1000u, 0.125f * 1.4426950408889634f};
              pg8::gemm_phase<pg8::EpiPlain, pg8::StaticOrder, true, true>(lds, g, S, E); }
            { pg8::Gemm g{WSP(bf16, WS_MEMBF), WSP(bf16, WS_WKV), 512, 512, D, 0, 0}; pg8::StaticOrder S; S.init(512, 512, G, blk); pg8::EpiPlain E{WSP(bf16, WS_KV), 512, 0u, 1.f};
              pg8::gemm_phase<pg8::EpiPlain, pg8::StaticOrder, true, true>(lds, g, S, E); }
        PH_END()
        if (!moba) {
            PH_BEGIN(3)
                for (int u = blk; u < NBATCH * HG_H * HNSEG; u += G) hgrn_mfma<false>(lds, WSP(bf16, WS_H), ka->in[3], j, ka->in[4] + j * 128, WSP(float, WS_SLOC), WSP(float, WS_DSEG), WSP(bf16, WS_MIX), u, tid, wave, lane);
                for (int u = blk; u < 512; u += G) memattn_unit2(lds, WSP(bf16, WS_H), NC, qoff, WSP(bf16, WS_KV), WSP(bf16, WS_MIX), u, tid, wave, lane);
            PH_END()
            PH_BEGIN(4)
                hgrn_scan(WSP(float, WS_SLOC), WSP(float, WS_DSEG), gtid, GTHREADS);
            PH_END()
            PH_BEGIN(5)
                for (int u = blk; u < NBATCH * HG_H * HNSEG; u += G) hgrn_mfma<true>(lds, WSP(bf16, WS_H), ka->in[3], j, ka->in[4] + j * 128, WSP(float, WS_SLOC), WSP(float, WS_DSEG), WSP(bf16, WS_MIX), u, tid, wave, lane);
            PH_END()
        } else {
            PH_BEGIN(3)
                for (int u = blk; u < 24 * MB_NB; u += G) kmean_unit(lds, WSP(bf16, WS_H), WSP(float, WS_KMEAN), u, tid);
                for (int u = blk; u < 512; u += G) memattn_unit2(lds, WSP(bf16, WS_H), NC, qoff, WSP(bf16, WS_KV), WSP(bf16, WS_MIX), u, tid, wave, lane);
            PH_END()
            PH_BEGIN(4)
                for (int u = blk; u < 24 * MB_NB; u += G) moba_gate_unit(lds, WSP(bf16, WS_H), WSP(float, WS_KMEAN), WSP(unsigned, WS_CTL) + CW_GCOUNT + j * 1536, WSP(int, WS_SELINFO), WSP(unsigned, WS_LIST), u, tid);
            PH_END()
            PH_BEGIN(5)
                for (int r = 0; r * G < 24 * MB_NB; ++r) { const int it = r * G + ((r & 1) ? (G - 1 - blk) : blk);
                    if (it < 24 * MB_NB) moba_attn_item2(lds, WSP(bf16, WS_H), WSP(unsigned, WS_CTL) + CW_GCOUNT + j * 1536, WSP(unsigned, WS_LIST), WSP(bf16, WS_PO), WSP(float, WS_PML), it, tid, wave, lane); }
            PH_END()
            PH_BEGIN(6)
                moba_combine(WSP(bf16, WS_PO), WSP(float, WS_PML), WSP(int, WS_SELINFO), WSP(bf16, WS_MIX), gw, NGW, lane);
            PH_END()
        }
        PH_BEGIN(7)
            pg8::Gemm g{WSP(bf16, WS_MIX), WSP(bf16, WS_WO), T, D, D, 0, 0}; pg8::StaticOrder S; S.init(T, D, G, blk); pg8::EpiPlain E{WSP(bf16, WS_Y), D, 0u, 1.f};
            pg8::gemm_phase<pg8::EpiPlain, pg8::StaticOrder, true, true>(lds, g, S, E);
        PH_END()
        PH_BEGIN(8)
            phase_ln1(lds, WSP(bf16, WS_Y), ka->in[8] + l * D, ka->in[9] + l * D, ka->in[10] + (size_t)l * D * NE, ka->in[11] + l * NE, WSP(bf16, WS_XBF),
                      WSP(int, WS_TOK + TOK_E), WSP(int, WS_TOK + TOK_LR), WSP(float, WS_TOK + TOK_W), WSP(int, WS_TOK + TOK_BLKCNT), blk, tid, wave, lane);
        PH_END()
        PH_BEGIN(9)
            phase_dispatch(lds, WSP(int, WS_TOK + TOK_BLKCNT), WSP(int, WS_TOK + TOK_E), WSP(int, WS_TOK + TOK_LR), WSP(int, WS_TOK + TOK_ROW), WSP(int, WS_TOK + TOK_TAB), WSP(bf16, WS_XBF), WSP(bf16, WS_XS), blk, tid, wave, lane);
        PH_END()
        PH_BEGIN(10)
            if (tid < 33) tabL[tid] = WSP(int, WS_TOK + TOK_TAB)[tid];
            __syncthreads();
            int sw_ = 0x7A7A7A7A, sx_ = 0x7F7F7F7F; asm volatile("" : "+s"(sw_), "+s"(sx_));
            pg8::Gemm g{WSP(bf16, WS_XS), WSP(bf16, WS_WGU), MOE_MAXROWS, NE * 2048, D / 2, sw_, sx_}; pg8::MoeOrder S{tabL, 8, G, blk, tabL[32] * 8};
            pg8::EpiSwiglu E{WSP(unsigned char, WS_HID), ka->in[13] + (size_t)l * NE * 1024, ka->in[15] + (size_t)l * NE * 1024};
            pg8::gemm_phase<pg8::EpiSwiglu, pg8::MoeOrder, true, true, true>(lds, g, S, E);
        PH_END()
        PH_BEGIN(11)
            if (tid < 33) tabL[tid] = WSP(int, WS_TOK + TOK_TAB)[tid];
            __syncthreads();
            int sw_ = 0x79797979, sx_ = 0x7F7F7F7F; asm volatile("" : "+s"(sw_), "+s"(sx_));
            pg8::Gemm g{WSP(bf16, WS_HID), WSP(bf16, WS_WD), MOE_MAXROWS, NE * 1024, D / 2, sw_, sx_}; pg8::MoeOrder S{tabL, 4, G, blk, tabL[32] * 4};
            pg8::EpiDown E{WSP(unsigned char, WS_XS), ka->in[17] + (size_t)l * NE * 1024};
            pg8::gemm_phase<pg8::EpiDown, pg8::MoeOrder, true, true, true>(lds, g, S, E);
        PH_END()
        PH_BEGIN(12)
            float* x2out = (l == DEPTH - 1) ? ka->out : nullptr;
            phase_ln2(WSP(unsigned char, WS_XS), WSP(int, WS_TOK + TOK_ROW), WSP(float, WS_TOK + TOK_W), ka->in[18] + l * D, ka->in[19] + l * D, x2out, WSP(bf16, WS_XBF), gw, NGW, lane);
            if (l + 1 < DEPTH) PH_SEAM();
        PH_END_NOSEAM()
}
__global__ void __launch_bounds__(NTHR, 2) fwd_kernel(Args args) {
    extern __shared__ __attribute__((aligned(16))) unsigned char lds_raw[];
    LAS unsigned char* lds = (LAS unsigned char*)lds_raw;
    if (threadIdx.x < 4) ((LAS unsigned*)(lds + MISC_OFF))[threadIdx.x] = 0u;
    __syncthreads();
#if ONE_LAUNCH
    (void)xcd_barrier_post((unsigned*)(args.ws + WS_CTL) + CW_BAR, (volatile LAS unsigned*)(lds + MISC_OFF));
#endif
    { const int l = 0; (void)l;
    PH_BEGIN(0)
        cvt_rows_bf16(ka->in[0], WSP(bf16, WS_XBF), (size_t)T * D / 8, gtid, GTHREADS);
        cvt_rows_bf16(ka->in[1], WSP(bf16, WS_MEMBF), (size_t)512 * D / 8, gtid, GTHREADS);
    PH_END_NOSEAM() }
    layer_phases<0>(lds); layer_phases<1>(lds); layer_phases<2>(lds); layer_phases<3>(lds);
}

extern "C" void kernel_launch(void* const* d_in, const int* in_sizes, int n_in, void* d_out, int out_size, void* d_ws, size_t ws_size, hipStream_t stream) {
    static int ready = 0;
    if (ready == 0) {
        if (n_in != 20 || in_sizes[0] != T * D || out_size != T * D || ws_size < WS_END) { fprintf(stderr, "kernel_launch: unexpected shapes (n_in %d, in0 %d, out %d, ws %zu < %zu)\n", n_in, n_in > 0 ? in_sizes[0] : -1, out_size, ws_size, (size_t)WS_END); ready = -1; return; }
        if (hipFuncSetAttribute((const void*)fwd_kernel, hipFuncAttributeMaxDynamicSharedMemorySize, LDS_BYTES) != hipSuccess) { fprintf(stderr, "kernel_launch: hipFuncSetAttribute failed\n"); ready = -1; return; }
        int per_cu = 0;
        if (hipOccupancyMaxActiveBlocksPerMultiprocessor(&per_cu, (const void*)fwd_kernel, NTHR, LDS_BYTES) != hipSuccess || per_cu < 1) fprintf(stderr, "kernel_launch: occupancy query says %d\n", per_cu);
        (void)hipGetLastError();
        ready = 1;
    }
    if (ready < 0) return;
    if (hipMemsetAsync((char*)d_ws + WS_CTL, 0, CTL_ZERO_BYTES, stream) != hipSuccess) return;
    Args a{};
    for (int i = 0; i < 20; ++i) a.in[i] = (const float*)d_in[i];
    a.out = (float*)d_out; a.ws = (unsigned char*)d_ws;
    a.l_lo = 0; a.l_hi = DEPTH; a.ph_lo = 0; a.ph_hi = NPHASE;
    hipLaunchKernelGGL(fwd_kernel, dim3(GRID), dim3(NTHR), LDS_BYTES, stream, a);
}
```

```cpp
#include <hip/hip_runtime.h>
#include <cstdio>
#include <cstdint>
#include <cmath>
namespace pg8 {
#define PG8_LAS __attribute__((address_space(3)))
typedef unsigned short bf16_t;
typedef short bf16x8 __attribute__((ext_vector_type(8)));
typedef float f32x4 __attribute__((ext_vector_type(4)));
typedef unsigned u32x4 __attribute__((ext_vector_type(4)));
constexpr int BM = 256, BK = 64, HALF = 128, HTB = HALF * BK * 2  , STAGE_BYTES = 8 * HTB, NXCD = 8, WGM = 8;

__host__ __device__ __forceinline__ int lds_byte(int r, int c) { const int st = (r >> 4) * 2 + (c >> 5), rr = r & 15, cc = c & 31, ob = rr * 64 + cc * 2; return st * 1024 + (ob ^ (((ob >> 9) & 1) << 5)); }
__host__ __device__ __forceinline__ void stage_rc(int b, int& R, int& C) { const int st = b / 1024, sb = b % 1024, swz = sb ^ (((sb >> 9) & 1) << 5); R = (st >> 1) * 16 + swz / 64; C = (st & 1) * 32 + (swz % 64) / 2; }
__host__ __device__ __forceinline__ int perm32(int rho) { const int n = rho >> 4, i = rho & 15; return 8 * (i >> 2) + 4 * n + (i & 3); }

struct Unit { int pm, pn; };
struct Gemm { const bf16_t* A; const bf16_t* Bt; int M, N, K; int sw, sx; };
typedef int i32x8 __attribute__((ext_vector_type(8))); typedef int i32x4 __attribute__((ext_vector_type(4)));

struct StaticOrder {
    int nM, nN, nwg, G, c;
    __host__ __device__ void init(int M, int N, int G_, int c_) { nM = M / BM; nN = N / BM; nwg = nM * nN; G = G_; c = c_; }
    __host__ __device__ bool next(int i, Unit& u) const {
        const long L = (long)i * G + c; if (L >= nwg) return false;
        int wgid = (int)L; { const int q = nwg / NXCD, r = nwg % NXCD, xcd = wgid % NXCD, off = wgid / NXCD; wgid = (xcd < r ? xcd * (q + 1) : r * (q + 1) + (xcd - r) * q) + off; }
        const int nig = WGM * nN, gid = wgid / nig, fm = gid * WGM, gsz = (nM - fm) < WGM ? (nM - fm) : WGM;
        u.pm = fm + ((wgid % nig) % gsz); u.pn = (wgid % nig) / gsz; return true;
    }
    __device__ __forceinline__ void a_ready(const Unit&) const {}
    __device__ __forceinline__ void done(const Unit&) const {}
};

__device__ __forceinline__ unsigned cvt_pk_bf16(float lo, float hi) { unsigned r; asm volatile("v_cvt_pk_bf16_f32 %0, %1, %2" : "=v"(r) : "v"(lo), "v"(hi)); return r; }
typedef float f32x2 __attribute__((ext_vector_type(2)));
struct EpiPlain {
    static constexpr bool PERM = true, AFTER_DRAIN = false;
    bf16_t* O; int ldc; unsigned smask; float sc;
    __device__ __forceinline__ void operator()(const f32x4 (&acc)[2][2][4][2], const Unit& u, int wr, int wc, int fr, int fq) const {
        const int row0 = u.pm * BM + wr * 64 + fr; const int col0 = u.pn * BM + wc * 32 + 8 * fq; const float s = ((smask >> u.pn) & 1u) ? sc : 1.f;
#pragma unroll
        for (int ai = 0; ai < 2; ++ai)
#pragma unroll
            for (int m = 0; m < 4; ++m) { bf16_t* rowp = O + (size_t)(row0 + ai * HALF + m * 16) * ldc + col0;
#pragma unroll
                for (int bj = 0; bj < 2; ++bj) { const f32x4 v0 = acc[ai][bj][m][0] * s, v1 = acc[ai][bj][m][1] * s;
                    u32x4 w; w.x = cvt_pk_bf16(v0[0], v0[1]); w.y = cvt_pk_bf16(v0[2], v0[3]); w.z = cvt_pk_bf16(v1[0], v1[1]); w.w = cvt_pk_bf16(v1[2], v1[3]);
                    *(u32x4*)(rowp + bj * HALF) = w; } }
    }
};
__device__ __forceinline__ float swiglu1(float g, float u) {
    g = fminf(g, 7.0f); u = fminf(fmaxf(u, -7.0f), 7.0f);
    const float s = __builtin_amdgcn_rcpf(1.0f + __builtin_amdgcn_exp2f(g * (-1.702f * 1.4426950408889634f)));
    return g * s * (u + 1.0f);
}
__device__ __forceinline__ unsigned pk4_fp8e(float a, float b, float c, float d) { int w = 0; w = __builtin_amdgcn_cvt_pk_fp8_f32(a, b, w, false); w = __builtin_amdgcn_cvt_pk_fp8_f32(c, d, w, true); return (unsigned)w; }
struct EpiSwiglu {
    static constexpr bool PERM = true, AFTER_DRAIN = false;
    unsigned char* hid; const float* bg; const float* bu;
    __device__ __forceinline__ void operator()(const f32x4 (&acc)[2][2][4][2], const Unit& u, int wr, int wc, int fr, int fq) const {
        const int e = u.pn >> 3, pn = u.pn & 7;
        const int row0 = u.pm * BM + wr * 64 + fr; const int col0 = pn * 128 + wc * 32 + 8 * fq;
        const f32x4 g0 = *(const f32x4*)(bg + e * 1024 + col0), g1 = *(const f32x4*)(bg + e * 1024 + col0 + 4);
        const f32x4 u0 = *(const f32x4*)(bu + e * 1024 + col0), u1 = *(const f32x4*)(bu + e * 1024 + col0 + 4);
#pragma unroll
        for (int ai = 0; ai < 2; ++ai)
#pragma unroll
            for (int m = 0; m < 4; ++m) { unsigned char* rowp = hid + (size_t)(row0 + ai * HALF + m * 16) * 1024 + col0;
                const f32x4 ga = acc[ai][0][m][0] + g0, gb = acc[ai][0][m][1] + g1, ua = acc[ai][1][m][0] + u0, ub = acc[ai][1][m][1] + u1;
                typedef unsigned u32x2 __attribute__((ext_vector_type(2))); u32x2 w;
                w.x = pk4_fp8e(swiglu1(ga[0], ua[0]), swiglu1(ga[1], ua[1]), swiglu1(ga[2], ua[2]), swiglu1(ga[3], ua[3]));
                w.y = pk4_fp8e(swiglu1(gb[0], ub[0]), swiglu1(gb[1], ub[1]), swiglu1(gb[2], ub[2]), swiglu1(gb[3], ub[3]));
                *(u32x2*)rowp = w; }
    }
};
struct EpiDown {
    static constexpr bool PERM = true, AFTER_DRAIN = false;
    unsigned char* y; const float* bd;
    __device__ __forceinline__ void operator()(const f32x4 (&acc)[2][2][4][2], const Unit& u, int wr, int wc, int fr, int fq) const {
        const int e = u.pn >> 2, pn = u.pn & 3;
        const int row0 = u.pm * BM + wr * 64 + fr; const int col0 = pn * BM + wc * 32 + 8 * fq;
        f32x4 bv[2][2];
#pragma unroll
        for (int bj = 0; bj < 2; ++bj)
#pragma unroll
            for (int n = 0; n < 2; ++n) bv[bj][n] = *(const f32x4*)(bd + e * 1024 + col0 + bj * HALF + 4 * n);
#pragma unroll
        for (int ai = 0; ai < 2; ++ai)
#pragma unroll
            for (int m = 0; m < 4; ++m) { unsigned char* rowp = y + (size_t)(row0 + ai * HALF + m * 16) * 1024 + col0;
#pragma unroll
                for (int bj = 0; bj < 2; ++bj) { const f32x4 v0 = (acc[ai][bj][m][0] + bv[bj][0]) * 16.f, v1 = (acc[ai][bj][m][1] + bv[bj][1]) * 16.f;
                    typedef unsigned u32x2 __attribute__((ext_vector_type(2))); u32x2 w; w.x = pk4_fp8e(v0[0], v0[1], v0[2], v0[3]); w.y = pk4_fp8e(v1[0], v1[1], v1[2], v1[3]);
                    *(u32x2*)(rowp + bj * HALF) = w; } }
    }
};
struct MoeOrder {
    const PG8_LAS int* tab; int npn, G, c, nunits;
    __device__ __forceinline__ bool next(int i, Unit& u) const {
        const int tpx = 32 / npn, s = c >> 3, tile = (i * 8 + (c & 7)) * tpx + s / npn, pn = s % npn;
        if ((i * 8) * tpx >= nunits / npn) return false;
        if (tile >= nunits / npn) { u.pm = 0; u.pn = 0; return false; }
        int e = 0;
#pragma unroll
        for (int k = 1; k < 32; ++k) e += (tab[k] <= tile) ? 1 : 0;
        u.pm = tile; u.pn = __builtin_amdgcn_readfirstlane(e) * npn + pn; return true;
    }
    __device__ __forceinline__ void a_ready(const Unit&) const {}
    __device__ __forceinline__ void done(const Unit&) const {}
};
template <class Epi, class Sched, bool ALIGN_EPI = false, bool SP2 = false, bool F8 = false>
__device__ __forceinline__ void gemm_phase(PG8_LAS unsigned char* lds, const Gemm g, const Sched& S, const Epi& E) {
    int tid_ = threadIdx.x; asm volatile("" : "+v"(tid_));
    const int tid = tid_, wid = __builtin_amdgcn_readfirstlane(tid >> 6), lane = tid & 63, wr = wid >> 2, wc = wid & 3, fr = lane & 15, fq = lane >> 4;
    const int K = g.K, nt = K / BK;
    unsigned voffA, voffB;
    { int R, C; stage_rc(tid * 16, R, C); const int Rb = Epi::PERM ? ((R & ~31) + perm32(R & 31)) : R; voffA = (unsigned)(R * K + C) * 2u; voffB = (unsigned)(Rb * K + C) * 2u; }
    const unsigned qstep = 64u * (unsigned)K * 2u;
    const unsigned kstep = (unsigned)(BK * 2);
    const unsigned hstep = (unsigned)HALF * (unsigned)K * 2u;
    const unsigned tstep = 2u * hstep;
    const __amdgpu_buffer_rsrc_t rA = __builtin_amdgcn_make_buffer_rsrc((void*)g.A, 0, 0x7FFFFFFF, 0x00020000), rB = __builtin_amdgcn_make_buffer_rsrc((void*)g.Bt, 0, 0x7FFFFFFF, 0x00020000);
    const unsigned ldsw = (unsigned)wid * 1024u;
    const int aoff = lds_byte(wr * 64 + fr, fq * 8), boff = lds_byte(wc * 32 + fr, fq * 8);
#define PG8_SA(b, h) (((b) * 2 + (h)) * HTB)
#define PG8_SB(b, h) ((4 + (b) * 2 + (h)) * HTB)
#define PG8_STG(bufoff, rsrc, soff, voff) do { _Pragma("unroll") for (int _i = 0; _i < 2; ++_i) \
        __builtin_amdgcn_raw_ptr_buffer_load_lds((rsrc), (PG8_LAS void*)(lds + (bufoff) + ldsw + _i * 8192), 16, (int)(voff), (int)((soff) + (unsigned)_i * qstep), 0, 0); } while (0)
#define PG8_STGA(bufoff, soff) PG8_STG(bufoff, rA, soff, voffA)
#define PG8_STGB(bufoff, soff) PG8_STG(bufoff, rB, soff, voffB)
#define PG8_LDA(dst, b, h) do { _Pragma("unroll") for (int m = 0; m < 4; ++m) { if constexpr (F8) { const i32x4 lo_ = *(const PG8_LAS i32x4*)(lds + PG8_SA(b, h) + aoff + m * 2048), hi_ = *(const PG8_LAS i32x4*)(lds + PG8_SA(b, h) + aoff + m * 2048 + 1024); \
            dst##_8[m] = __builtin_shufflevector(lo_, hi_, 0, 1, 2, 3, 4, 5, 6, 7); } else { _Pragma("unroll") for (int k = 0; k < 2; ++k) dst[m][k] = *(const PG8_LAS bf16x8*)(lds + PG8_SA(b, h) + aoff + m * 2048 + k * 1024); } } } while (0)
#define PG8_LDB(dst, b, h) do { _Pragma("unroll") for (int n = 0; n < 2; ++n) { if constexpr (F8) { const i32x4 lo_ = *(const PG8_LAS i32x4*)(lds + PG8_SB(b, h) + boff + n * 2048), hi_ = *(const PG8_LAS i32x4*)(lds + PG8_SB(b, h) + boff + n * 2048 + 1024); \
            dst##_8[n] = __builtin_shufflevector(lo_, hi_, 0, 1, 2, 3, 4, 5, 6, 7); } else { _Pragma("unroll") for (int k = 0; k < 2; ++k) dst[n][k] = *(const PG8_LAS bf16x8*)(lds + PG8_SB(b, h) + boff + n * 2048 + k * 1024); } } } while (0)
#define PG8_MMA(ai, bj, At, Bt) do { __builtin_amdgcn_s_setprio(1); _Pragma("unroll") for (int m = 0; m < 4; ++m) _Pragma("unroll") for (int n = 0; n < 2; ++n) { \
        if constexpr (F8) acc[ai][bj][m][n] = __builtin_amdgcn_mfma_scale_f32_16x16x128_f8f6f4(Bt##_8[n], At##_8[m], acc[ai][bj][m][n], 0, 0, 0, g.sw, 0, g.sx); \
        else { _Pragma("unroll") for (int k = 0; k < 2; ++k) acc[ai][bj][m][n] = __builtin_amdgcn_mfma_f32_16x16x32_bf16(Bt[n][k], At[m][k], acc[ai][bj][m][n], 0, 0, 0); } } \
        __builtin_amdgcn_s_setprio(0); } while (0)
#define PG8_WAIT_V(n) asm volatile("s_waitcnt vmcnt(" #n ")" ::: "memory")
#define PG8_WAIT_L(n) asm volatile("s_waitcnt lgkmcnt(" #n ")" ::: "memory")
#define PG8_BAR __builtin_amdgcn_s_barrier()
#define PG8_SCHED __builtin_amdgcn_sched_barrier(0)
    Unit cur, nxt; int ui = 0;
    if (!S.next(0, cur)) return;
    f32x4 acc[2][2][4][2];
#pragma unroll
    for (int a = 0; a < 2; ++a)
#pragma unroll
        for (int b = 0; b < 2; ++b)
#pragma unroll
            for (int m = 0; m < 4; ++m)
#pragma unroll
                for (int n = 0; n < 2; ++n) acc[a][b][m][n] = (f32x4){0.f, 0.f, 0.f, 0.f};
    bf16x8 At[4][2], B0[2][2], B1[2][2]; i32x8 At_8[4], B0_8[2], B1_8[2];
    unsigned cA = (unsigned)cur.pm * tstep, cB = (unsigned)cur.pn * tstep;
    S.a_ready(cur);
    if constexpr (SP2) {
        PG8_STGB(PG8_SB(0, 0), cB); PG8_STGB(PG8_SB(0, 1), cB + hstep); PG8_STGA(PG8_SA(0, 0), cA); PG8_STGA(PG8_SA(0, 1), cA + hstep);
        if (wr == 1) PG8_BAR;
        PG8_WAIT_V(2); PG8_BAR;
        PG8_STGB(PG8_SB(1, 0), cB + kstep); PG8_STGA(PG8_SA(1, 0), cA + kstep); PG8_STGB(PG8_SB(1, 1), cB + hstep + kstep);
        PG8_WAIT_V(6); PG8_BAR;
    } else {
        PG8_STGB(PG8_SB(0, 0), cB); PG8_STGA(PG8_SA(0, 0), cA); PG8_STGB(PG8_SB(0, 1), cB + hstep); PG8_STGA(PG8_SA(0, 1), cA + hstep);
        if (wr == 1) PG8_BAR;
        PG8_WAIT_V(4); PG8_BAR;
        PG8_STGB(PG8_SB(1, 0), cB + kstep); PG8_STGA(PG8_SA(1, 0), cA + kstep); PG8_STGB(PG8_SB(1, 1), cB + hstep + kstep);
        PG8_WAIT_V(6); PG8_BAR;
    }
    for (;;) {
        const bool has_next = S.next(ui + 1, nxt);
        const unsigned nA = has_next ? (unsigned)nxt.pm * tstep : cA, nB = has_next ? (unsigned)nxt.pn * tstep : cB;
#pragma unroll 1
        for (int t = 0; t < nt; t += 2) {
            const bool last = (t == nt - 2);
            const unsigned a1 = cA + (unsigned)(t + 1) * kstep;
            const unsigned a2 = last ? nA : cA + (unsigned)(t + 2) * kstep, b2 = last ? nB : cB + (unsigned)(t + 2) * kstep;
            const unsigned a3 = a2 + kstep, b3 = b2 + kstep;
            if (last && has_next) S.a_ready(nxt);
            if constexpr (SP2) {
            PG8_LDB(B0, 0, 0); PG8_LDB(B1, 0, 1); PG8_SCHED; PG8_LDA(At, 0, 0); PG8_STGA(PG8_SA(1, 1), a1 + hstep);
            PG8_WAIT_V(8); PG8_WAIT_L(0); PG8_BAR; PG8_MMA(0, 0, At, B0); PG8_MMA(0, 1, At, B1); PG8_BAR; PG8_SCHED;
            PG8_LDA(At, 0, 1); PG8_STGB(PG8_SB(0, 0), b2); PG8_STGB(PG8_SB(0, 1), b2 + hstep); PG8_STGA(PG8_SA(0, 0), a2);
            PG8_WAIT_V(8); PG8_WAIT_L(0); PG8_BAR; PG8_MMA(1, 0, At, B0); PG8_MMA(1, 1, At, B1); PG8_BAR; PG8_SCHED;
            PG8_LDB(B0, 1, 0); PG8_LDB(B1, 1, 1); PG8_SCHED; PG8_LDA(At, 1, 0); PG8_STGA(PG8_SA(0, 1), a2 + hstep);
            PG8_WAIT_V(8); PG8_WAIT_L(0); PG8_BAR; PG8_MMA(0, 0, At, B0); PG8_MMA(0, 1, At, B1); PG8_BAR; PG8_SCHED;
            PG8_LDA(At, 1, 1); PG8_STGB(PG8_SB(1, 0), b3); PG8_STGB(PG8_SB(1, 1), b3 + hstep); PG8_STGA(PG8_SA(1, 0), a3);
            PG8_WAIT_V(8); PG8_WAIT_L(0); PG8_BAR; PG8_MMA(1, 0, At, B0); PG8_MMA(1, 1, At, B1); PG8_BAR; PG8_SCHED;
            } else {
            PG8_LDB(B0, 0, 0); PG8_SCHED; PG8_LDA(At, 0, 0); PG8_STGA(PG8_SA(1, 1), a1 + hstep);
            PG8_WAIT_L(8); PG8_BAR; PG8_WAIT_L(0); PG8_MMA(0, 0, At, B0); PG8_BAR; PG8_SCHED;
            PG8_LDB(B1, 0, 1); PG8_STGB(PG8_SB(0, 0), b2);
            PG8_BAR; PG8_WAIT_L(0); PG8_MMA(0, 1, At, B1); PG8_BAR;
            PG8_LDA(At, 0, 1); PG8_STGA(PG8_SA(0, 0), a2);
            PG8_BAR; PG8_WAIT_L(0); PG8_MMA(1, 0, At, B0); PG8_BAR; PG8_SCHED;
            PG8_STGB(PG8_SB(0, 1), b2 + hstep);
            PG8_WAIT_V(6); PG8_BAR; PG8_MMA(1, 1, At, B1); PG8_BAR;
            PG8_LDB(B0, 1, 0); PG8_SCHED; PG8_LDA(At, 1, 0); PG8_STGA(PG8_SA(0, 1), a2 + hstep);
            PG8_WAIT_L(8); PG8_BAR; PG8_WAIT_L(0); PG8_MMA(0, 0, At, B0); PG8_BAR; PG8_SCHED;
            PG8_LDB(B1, 1, 1); PG8_STGB(PG8_SB(1, 0), b3);
            PG8_BAR; PG8_WAIT_L(0); PG8_MMA(0, 1, At, B1); PG8_BAR;
            PG8_LDA(At, 1, 1); PG8_STGA(PG8_SA(1, 0), a3);
            PG8_BAR; PG8_WAIT_L(0); PG8_MMA(1, 0, At, B0); PG8_BAR; PG8_SCHED;
            PG8_STGB(PG8_SB(1, 1), b3 + hstep);
            PG8_WAIT_V(6); PG8_BAR; PG8_MMA(1, 1, At, B1); PG8_BAR;
            }
        }
        if constexpr (ALIGN_EPI) { if (wr == 0) PG8_BAR; }
        if constexpr (!Epi::AFTER_DRAIN) { int t2_ = threadIdx.x; asm volatile("" : "+v"(t2_)); E(acc, cur, wr, wc, t2_ & 15, (t2_ & 63) >> 4); S.done(cur); }
        if (!has_next) break;
#pragma unroll
        for (int a = 0; a < 2; ++a)
#pragma unroll
            for (int b = 0; b < 2; ++b)
#pragma unroll
                for (int m = 0; m < 4; ++m)
#pragma unroll
                    for (int n = 0; n < 2; ++n) acc[a][b][m][n] = (f32x4){0.f, 0.f, 0.f, 0.f};
        cur = nxt; cA = nA; cB = nB; ++ui;
        if constexpr (ALIGN_EPI) { if (wr == 1) PG8_BAR; }
    }
    PG8_WAIT_V(0);
    if constexpr (!ALIGN_EPI) { if (wr == 0) PG8_BAR; }
    PG8_BAR;
    if constexpr (Epi::AFTER_DRAIN) { E.fused(acc, cur, wr, wc, fr, fq, lds, wid, lane); S.done(cur); }
#undef PG8_SA
#undef PG8_SB
#undef PG8_STG
#undef PG8_STGA
#undef PG8_STGB
#undef PG8_LDA
#undef PG8_LDB
#undef PG8_MMA
#undef PG8_WAIT_V
#undef PG8_WAIT_L
#undef PG8_BAR
#undef PG8_SCHED
}
}

constexpr int NWAVES = 8, NTHR = 512, GRID = 256;
constexpr int NBATCH = 2, SEQ = 16384, T = NBATCH * SEQ, D = 1024, DEPTH = 4;
constexpr int MIXW = 768, NC_H = 3328, NC_M = 2560;
constexpr int HG_H = 6;
constexpr int HSEG = 256, HNSEG = SEQ / HSEG;
constexpr int MB_H = 12, MB_NB = 64;
constexpr int NE = 32;
constexpr float DN_ALPHA = 1.6817928305074290f;
constexpr int MOE_MAXROWS = T * 4 + NE * 256;
#ifndef ONE_LAUNCH
#define ONE_LAUNCH 1
#endif
constexpr int NPHASE = 13;

constexpr size_t MiB = 1u << 20;
constexpr size_t WS_CTL = 0, CTL_ZERO_BYTES = 1 * MiB;
constexpr size_t WS_WIN = 1 * MiB, WS_WKV = 9 * MiB, WS_WO = 10 * MiB, WS_WGU = 12 * MiB, WS_WD = 140 * MiB;
constexpr size_t WS_XBF = 204 * MiB, WS_XA = 268 * MiB, WS_XB = 396 * MiB, WS_MEMBF = 524 * MiB, WS_KV = 525 * MiB;
constexpr size_t WS_H = 526 * MiB, WS_MIX = 734 * MiB, WS_Y = 798 * MiB, WS_SLOC = 862 * MiB, WS_DSEG = 910 * MiB, WS_KMEAN = 911 * MiB;
constexpr size_t WS_SELINFO = 912 * MiB, WS_TOK = 914 * MiB, WS_R1 = 918 * MiB;
constexpr size_t WS_LIST = WS_R1, WS_PML = WS_R1 + 96 * MiB, WS_PO = WS_R1 + 108 * MiB;
constexpr size_t WS_XS = WS_R1, WS_HID = WS_R1 + 272 * MiB;
constexpr size_t WS_END = WS_R1 + 544 * MiB;
static_assert((size_t)MOE_MAXROWS * 1024 * 2 <= 272 * MiB, "moe rows");
static_assert((size_t)T * MB_H * 4 * 64 * 4 <= 384 * MiB && (size_t)24 * 64 * 16384 * 4 <= 96 * MiB, "moba bufs");
constexpr size_t TOK_E = 0, TOK_LR = 512 * 1024, TOK_W = 1024 * 1024, TOK_ROW = 1536 * 1024, TOK_BLKCNT = 2048 * 1024, TOK_TAB = 2048 * 1024 + 65536;
constexpr int CW_BAR = 4096, CW_GCOUNT = 8192;

constexpr int RING_BYTES = 131072, LDS_BYTES = 147456, MISC_OFF = LDS_BYTES - 1024;

#define GAS __attribute__((address_space(1)))
#define LAS __attribute__((address_space(3)))
typedef unsigned short bf16;
typedef unsigned v4u __attribute__((ext_vector_type(4)));
typedef unsigned v2u __attribute__((ext_vector_type(2)));
typedef float f32x4 __attribute__((ext_vector_type(4)));
typedef float f32x2 __attribute__((ext_vector_type(2)));
typedef short s16x8 __attribute__((ext_vector_type(8)));
typedef float f32x16 __attribute__((ext_vector_type(16)));
typedef float f32x2_t __attribute__((ext_vector_type(2))); typedef __bf16 bf16x2_t __attribute__((ext_vector_type(2)));
__device__ __forceinline__ unsigned cvtpk(float lo, float hi) { f32x2_t v = {lo, hi}; bf16x2_t b = __builtin_convertvector(v, bf16x2_t); return __builtin_bit_cast(unsigned, b); }
#define LDS_WAIT() asm volatile("s_waitcnt lgkmcnt(0)" ::: "memory")
__device__ __forceinline__ unsigned f2bf(float f) { unsigned u = __builtin_bit_cast(unsigned, f); return (u + 0x7fffu + ((u >> 16) & 1u)) >> 16; }
__device__ __forceinline__ unsigned pk2(float lo, float hi) { return f2bf(lo) | (f2bf(hi) << 16); }
__device__ __forceinline__ float bflo(unsigned w) { return __builtin_bit_cast(float, w << 16); }
__device__ __forceinline__ float bfhi(unsigned w) { return __builtin_bit_cast(float, w & 0xffff0000u); }
__device__ __forceinline__ float bf2f(bf16 h) { return __builtin_bit_cast(float, (unsigned)h << 16); }
__device__ __forceinline__ float sigmoidf_(float z) { return __builtin_amdgcn_rcpf(1.0f + __builtin_amdgcn_exp2f(-1.4426950408889634f * z)); }
template <int X> __device__ __forceinline__ float xorf(float v) { return __builtin_bit_cast(float, __builtin_amdgcn_ds_swizzle(__builtin_bit_cast(int, v), (X << 10) | 0x1F)); }
template <int X> __device__ __forceinline__ int xori(int v) { return __builtin_amdgcn_ds_swizzle(v, (X << 10) | 0x1F); }
__device__ __forceinline__ float wave_sum(float v) {
    v += xorf<1>(v); v += xorf<2>(v); v += xorf<4>(v); v += xorf<8>(v); v += xorf<16>(v);
    return __builtin_bit_cast(float, __builtin_amdgcn_readlane(__builtin_bit_cast(int, v), 0)) + __builtin_bit_cast(float, __builtin_amdgcn_readlane(__builtin_bit_cast(int, v), 32));
}
__device__ __forceinline__ float wave_max(float v) {
    v = fmaxf(v, xorf<1>(v)); v = fmaxf(v, xorf<2>(v)); v = fmaxf(v, xorf<4>(v)); v = fmaxf(v, xorf<8>(v)); v = fmaxf(v, xorf<16>(v));
    return fmaxf(__builtin_bit_cast(float, __builtin_amdgcn_readlane(__builtin_bit_cast(int, v), 0)), __builtin_bit_cast(float, __builtin_amdgcn_readlane(__builtin_bit_cast(int, v), 32)));
}
__device__ __forceinline__ float xor32f(float v, int lane) { return __builtin_bit_cast(float, __builtin_amdgcn_ds_bpermute((lane ^ 32) << 2, __builtin_bit_cast(int, v))); }
#define XB_TMO      128
#define XB_XCNT(j)  (256  + 64 * (j))
#define XB_XSUB(j)  (1280 + 64 * (j))
#define XB_XGEN(j)  (2304 + 64 * (j))
#define XB_TOP      3328
#define XB_TOPGEN   3392
#define XCD_BAR_WORDS 3456
#define XB_SPIN_CAP (1u << 18)

__device__ __forceinline__ unsigned xb_ld(unsigned* p)              { return __hip_atomic_load(p, __ATOMIC_RELAXED, __HIP_MEMORY_SCOPE_AGENT); }
__device__ __forceinline__ unsigned xb_add(unsigned* p, unsigned v) { return __hip_atomic_fetch_add(p, v, __ATOMIC_RELAXED, __HIP_MEMORY_SCOPE_AGENT); }
__device__ __forceinline__ unsigned xb_xcc_id() { return (unsigned)__builtin_amdgcn_s_getreg((3 << 11) | 20) & 0xFu; }
#define XB_SPIN(cond, bar) do { unsigned _sp = 0; while (cond) { __builtin_amdgcn_s_sleep(1); \
    if ((++_sp & 255u) == 0u) { if (xb_ld(&(bar)[XB_TMO])) break; if (_sp > XB_SPIN_CAP) { atomicAdd(&(bar)[XB_TMO], 1u); break; } } } } while (0)

struct XcdBarrier {
    unsigned* bar; unsigned x;
    volatile LAS unsigned* st;
};

__device__ __forceinline__ XcdBarrier xcd_barrier_post(unsigned* bar, volatile LAS unsigned* st) {
    XcdBarrier b; b.bar = bar; b.x = xb_xcc_id(); b.st = st;
    if (threadIdx.x == 0) (void)xb_add(&bar[XB_XCNT(b.x)], 1u);
    return b;
}
__device__ __forceinline__ void xcd_barrier_complete(unsigned* bar, unsigned x, unsigned& nloc, unsigned& nx) {
    const unsigned G = gridDim.x * gridDim.y * gridDim.z;
    unsigned sum, cnt, mine, sp = 0u;
    for (;;) {
        sum = 0u; cnt = 0u; mine = 0u;
#pragma unroll
        for (unsigned j = 0; j < 16; ++j) { const unsigned c = xb_ld(&bar[XB_XCNT(j)]); sum += c; cnt += (c > 0u) ? 1u : 0u; mine = (j == x) ? c : mine; }
        if (sum == G) break;
        __builtin_amdgcn_s_sleep(1);
        if ((++sp & 255u) == 0u) { if (xb_ld(&bar[XB_TMO])) break; if (sp > XB_SPIN_CAP) { atomicAdd(&bar[XB_TMO], 1u); break; } }
    }
    nloc = mine > 0u ? mine : 1u; nx = cnt > 0u ? cnt : 1u;
}

__device__ __forceinline__ void xcd_barrier(const XcdBarrier& b) {
    asm volatile("s_waitcnt vmcnt(0)" ::: "memory");
    __syncthreads();
    if (threadIdx.x == 0) {
        unsigned* bar = b.bar;
        __builtin_amdgcn_s_waitcnt(0);
        unsigned nloc = b.st[0], nx = b.st[1];
        if (nloc == 0u) { xcd_barrier_complete(bar, b.x, nloc, nx); b.st[0] = nloc; b.st[1] = nx; }
        const unsigned old = xb_add(&bar[XB_XSUB(b.x)], 1u);
        const unsigned gen = old / nloc;
        if (old + 1u == (gen + 1u) * nloc) {
            __builtin_amdgcn_fence(__ATOMIC_RELEASE, "agent");
            asm volatile("s_waitcnt vmcnt(0)" ::: "memory");
            const unsigned og = xb_add(&bar[XB_TOP], 1u);
            const unsigned tg = og / nx;
            if (og + 1u == (tg + 1u) * nx) xb_add(&bar[XB_TOPGEN], 1u);
            else XB_SPIN(xb_ld(&bar[XB_TOPGEN]) == tg, bar);
            __builtin_amdgcn_fence(__ATOMIC_ACQUIRE, "agent");
            xb_add(&bar[XB_XGEN(b.x)], 1u);
            asm volatile("s_waitcnt vmcnt(0)" ::: "memory");
        } else {
            XB_SPIN(xb_ld(&bar[XB_XGEN(b.x)]) == gen, bar);
            __builtin_amdgcn_fence(__ATOMIC_ACQUIRE, "agent");
            asm volatile("s_waitcnt vmcnt(0)" ::: "memory");
        }
    }
    __syncthreads();
}

__device__ __forceinline__ void cvt_rows_bf16(const float* src, bf16* dst, size_t n8, size_t gtid, size_t gthreads) {
    for (size_t i = gtid; i < n8; i += gthreads) { const f32x4 a = ((const f32x4*)src)[2 * i], b = ((const f32x4*)src)[2 * i + 1];
        v4u o; o.x = pk2(a.x, a.y); o.y = pk2(a.z, a.w); o.z = pk2(b.x, b.y); o.w = pk2(b.z, b.w); ((v4u*)dst)[i] = o; }
}
__device__ __forceinline__ void transpose_item(const float* W, int N, bf16* WT, int dst_row0, LAS float* scr, int k0, int n0, int lane) {
#pragma unroll 8
    for (int i = 0; i < 32; ++i) { const int kk = 2 * i + (lane >> 5); scr[kk * 33 + (lane & 31)] = W[(size_t)(k0 + kk) * N + n0 + (lane & 31)]; }
    LDS_WAIT(); asm volatile("" ::: "memory");
    const int c = lane & 7;
#pragma unroll
    for (int j = 0; j < 4; ++j) { const int n = (lane >> 3) + 8 * j; const LAS float* s = scr + (8 * c) * 33 + n;
        v4u o; o.x = pk2(s[0 * 33], s[1 * 33]); o.y = pk2(s[2 * 33], s[3 * 33]); o.z = pk2(s[4 * 33], s[5 * 33]); o.w = pk2(s[6 * 33], s[7 * 33]);
        *(v4u*)(WT + (size_t)(dst_row0 + n) * 1024 + k0 + 8 * c) = o; }
    LDS_WAIT(); asm volatile("" ::: "memory");
}
__device__ __forceinline__ unsigned pk4_fp8(float a, float b, float c, float d) { int w = 0; w = __builtin_amdgcn_cvt_pk_fp8_f32(a, b, w, false); w = __builtin_amdgcn_cvt_pk_fp8_f32(c, d, w, true); return (unsigned)w; }
__device__ __forceinline__ void transpose_item_f8(const float* W, int N, unsigned char* WT8, int dst_row0, LAS float* scr, int k0, int n0, int lane, float wscale) {
#pragma unroll 8
    for (int i = 0; i < 32; ++i) { const int kk = 2 * i + (lane >> 5); scr[kk * 33 + (lane & 31)] = W[(size_t)(k0 + kk) * N + n0 + (lane & 31)]; }
    LDS_WAIT(); asm volatile("" ::: "memory");
    const int c = lane & 7;
#pragma unroll
    for (int j = 0; j < 4; ++j) { const int n = (lane >> 3) + 8 * j; const LAS float* s = scr + (8 * c) * 33 + n;
        v2u o; o.x = pk4_fp8(s[0 * 33] * wscale, s[1 * 33] * wscale, s[2 * 33] * wscale, s[3 * 33] * wscale); o.y = pk4_fp8(s[4 * 33] * wscale, s[5 * 33] * wscale, s[6 * 33] * wscale, s[7 * 33] * wscale);
        *(v2u*)(WT8 + (size_t)(dst_row0 + n) * 1024 + k0 + 8 * c) = o; }
    LDS_WAIT(); asm volatile("" ::: "memory");
}
__device__ __forceinline__ void phase_weights(LAS float* scr, int gw, int ngw, int lane, const float* win_src, int NC, const float* wkv_src, const float* wo_src,
                                              const float* wg_src, const float* wu_src, const float* wd_src, bf16* win_t, bf16* wkv_t, bf16* wo_t, bf16* wgu_t, bf16* wd_t) {
    const int nbw = NC / 32, nWin = nbw * 16, NIT = nWin + 256 + 512 + NE * 1536;
    for (int it = gw; it < NIT; it += ngw) {
        int r = it;
        if (r < nWin) { const int kb = r / nbw, nb = r - kb * nbw; transpose_item(win_src, NC, win_t, 32 * nb, scr, 64 * kb, 32 * nb, lane); continue; } r -= nWin;
        if (r < 256) { const int kb = r >> 4, nb = r & 15; transpose_item(wkv_src, 512, wkv_t, 32 * nb, scr, 64 * kb, 32 * nb, lane); continue; } r -= 256;
        if (r < 512) { const int kb = r >> 5, nb = r & 31; transpose_item(wo_src, 1024, wo_t, 32 * nb, scr, 64 * kb, 32 * nb, lane); continue; } r -= 512;
        const int e = r / 1536, q = r - e * 1536, which = q >> 9, rr = q & 511, kb = rr >> 5, nb = rr & 31, n0 = 32 * nb;
        const size_t eoff = (size_t)e * 1024 * 1024;
        if (which == 0) transpose_item_f8(wg_src + eoff, 1024, (unsigned char*)wgu_t + 2 * eoff, (n0 >> 7) * 256 + (n0 & 127), scr, 64 * kb, n0, lane, 32.f);
        else if (which == 1) transpose_item_f8(wu_src + eoff, 1024, (unsigned char*)wgu_t + 2 * eoff, (n0 >> 7) * 256 + 128 + (n0 & 127), scr, 64 * kb, n0, lane, 32.f);
        else transpose_item_f8(wd_src + eoff, 1024, (unsigned char*)wd_t + eoff, n0, scr, 64 * kb, n0, lane, 64.f);
    }
}

template <bool OUT>
__device__ __forceinline__ void hgrn_seg(LAS unsigned char* lds, const bf16* h, const float* lbl, int j, const float* normg, float* Sloc, float* Dseg, bf16* mix, int unit, int tid, int wave, int lane) {
    const int seg = unit & (HNSEG - 1), bh = unit >> 6, hh = bh % HG_H, b = bh / HG_H;
    const int v = tid & 127, dg = tid >> 7;
    LAS float* fgs = (LAS float*)lds; LAS float* vs = fgs + 4096; LAS float* qs = vs + 4096; LAS float* op = qs + 4096;
    f32x2 st[16];
    float* Sp = Sloc + (size_t)unit * 16384 + (size_t)(dg * 32) * 128 + v;
#pragma unroll
    for (int dd = 0; dd < 16; ++dd) { st[dd].x = OUT ? Sp[(2 * dd) * 128] : 0.f; st[dd].y = OUT ? Sp[(2 * dd + 1) * 128] : 0.f; }
    float dprod = 1.f;
    const int stok = tid >> 4, c8 = (tid & 15) * 8;
    float lb[8];
#pragma unroll
    for (int i = 0; i < 8; ++i) { lb[i] = 0.f; if (j > 0) { const float a0 = lbl[hh * 128 + c8 + i], a1 = lbl[MIXW + hh * 128 + c8 + i]; lb[i] = 1.f / (1.f + __expf(a0 - a1)); } }
    for (int ch = 0; ch < HSEG / 32; ++ch) {
        const size_t t0 = (size_t)b * SEQ + seg * HSEG + ch * 32;
        { const bf16* row = h + (t0 + stok) * NC_H + hh * 128 + c8;
          const v4u f8 = *(const v4u*)(row + 768), i8 = *(const v4u*)(row + 1536); v4u q8 = {0u, 0u, 0u, 0u}; if (OUT) q8 = *(const v4u*)row;
#pragma unroll
          for (int w = 0; w < 4; ++w) { const float f0 = bflo(f8[w]), f1 = bfhi(f8[w]); const int o = stok * 128 + c8 + 2 * w;
              fgs[o] = lb[2 * w] + (1.f - lb[2 * w]) * sigmoidf_(f0); fgs[o + 1] = lb[2 * w + 1] + (1.f - lb[2 * w + 1]) * sigmoidf_(f1);
              vs[o] = bflo(i8[w]); vs[o + 1] = bfhi(i8[w]);
              if (OUT) { const float q0 = bflo(q8[w]), q1 = bfhi(q8[w]); qs[o] = q0 * sigmoidf_(q0); qs[o + 1] = q1 * sigmoidf_(q1); } } }
        __syncthreads();
        if (!OUT) { if (tid < 128) { for (int tt = 0; tt < 32; ++tt) dprod *= fgs[tt * 128 + tid]; } }
        f32x4 fA[8], qA[8], fB[8], qB[8]; float vA, vB;
#define HG_LOAD(F, Q, V, tt_) do { V = vs[(tt_) * 128 + v]; _Pragma("unroll") for (int d4 = 0; d4 < 8; ++d4) { F[d4] = *(const LAS f32x4*)(fgs + (tt_) * 128 + dg * 32 + d4 * 4); \
            if (OUT) Q[d4] = *(const LAS f32x4*)(qs + (tt_) * 128 + dg * 32 + d4 * 4); } } while (0)
#define HG_STEP(F, Q, V, tt_) do { const f32x2 vv2 = {V, V}; f32x2 acc2 = {0.f, 0.f}; _Pragma("unroll") for (int d4 = 0; d4 < 8; ++d4) { \
            const f32x2 fa = {F[d4].x, F[d4].y}, fb = {F[d4].z, F[d4].w}; \
            st[2 * d4] = fa * (st[2 * d4] - vv2) + vv2; st[2 * d4 + 1] = fb * (st[2 * d4 + 1] - vv2) + vv2; \
            if (OUT) { const f32x2 qa = {Q[d4].x, Q[d4].y}, qb = {Q[d4].z, Q[d4].w}; acc2 = qa * st[2 * d4] + acc2; acc2 = qb * st[2 * d4 + 1] + acc2; } } \
            if (OUT) op[(dg * 32 + (tt_)) * 128 + v] = acc2.x + acc2.y; } while (0)
        HG_LOAD(fA, qA, vA, 0);
#pragma unroll 1
        for (int tt = 0; tt < 32; tt += 2) {
            HG_LOAD(fB, qB, vB, tt + 1);
            __builtin_amdgcn_sched_barrier(0);
            HG_STEP(fA, qA, vA, tt);
            __builtin_amdgcn_sched_barrier(0);
            if (tt + 2 < 32) HG_LOAD(fA, qA, vA, tt + 2);
            __builtin_amdgcn_sched_barrier(0);
            HG_STEP(fB, qB, vB, tt + 1);
            __builtin_amdgcn_sched_barrier(0);
        }
#undef HG_LOAD
#undef HG_STEP
        if (OUT) {
            __syncthreads();
#pragma unroll
            for (int k = 0; k < 4; ++k) { const int tt = wave + 8 * k; float o0 = 0.f, o1 = 0.f;
#pragma unroll
                for (int g = 0; g < 4; ++g) { o0 += op[(g * 32 + tt) * 128 + lane]; o1 += op[(g * 32 + tt) * 128 + lane + 64]; }
                const float ms = wave_sum(o0 * o0 + o1 * o1) * (1.f / 128.f), r = 1.f / sqrtf(ms + 1e-6f);
                const bf16* grow = h + (t0 + tt) * NC_H + 2304 + hh * 128; const float g0 = bf2f(grow[lane]), g1 = bf2f(grow[lane + 64]);
                bf16* mrow = mix + (t0 + tt) * 1024 + hh * 128;
                mrow[lane] = (bf16)f2bf(o0 * r * normg[lane] * sigmoidf_(g0)); mrow[lane + 64] = (bf16)f2bf(o1 * r * normg[lane + 64] * sigmoidf_(g1)); }
        }
        __syncthreads();
    }
    if (!OUT) {
#pragma unroll
        for (int dd = 0; dd < 16; ++dd) { Sp[(2 * dd) * 128] = st[dd].x; Sp[(2 * dd + 1) * 128] = st[dd].y; }
        if (tid < 128) Dseg[(size_t)unit * 128 + tid] = dprod;
    }
}
constexpr int HG_G = 0, HG_QT = 32768, HG_KT = 50176, HG_KE = 67584, HG_VT = 86016, HG_ST = 104448, HG_GM = 139264, HG_GE = 139776, HG_PART = 140288;
static_assert(HG_PART + 2048 <= MISC_OFF, "HGRN LDS map");
__device__ __forceinline__ int crow16(int i, int hf) { return (i & 3) + 8 * (i >> 2) + 4 * hf; }
template <bool OUT>
__device__ __forceinline__ void hgrn_mfma(LAS unsigned char* lds, const bf16* h, const float* lbl, int j, const float* normg, float* Sloc, float* Dseg, bf16* mix, int unit, int tid, int wave, int lane) {
    const int seg = unit & (HNSEG - 1), bh = unit >> 6, hh = bh % HG_H, b = bh / HG_H;
    const int r = lane & 31, hf = lane >> 5, tr = wave & 1, vq = wave >> 1;
    LAS float* G = (LAS float*)(lds + HG_G); LAS float* GM = (LAS float*)(lds + HG_GM); LAS float* GE = (LAS float*)(lds + HG_GE); LAS float* PART = (LAS float*)(lds + HG_PART);
    const int stok = tid >> 3, c16 = (tid & 7) * 16, sperm = (stok & ~15) | (stok & 3) | ((stok & 4) << 1) | ((stok & 8) >> 1);
    const int cd = tid & 127, cpart = tid >> 7;
    float lb[16];
#pragma unroll
    for (int e = 0; e < 16; ++e) { lb[e] = 0.f; if (j > 0) { const float a0 = lbl[hh * 128 + c16 + e], a1 = lbl[MIXW + hh * 128 + c16 + e]; lb[e] = 1.f / (1.f + __expf(a0 - a1)); } }
    f32x16 S[2];
    float* Sp = Sloc + (size_t)unit * 16384 + 32 * vq + r;
#pragma unroll
    for (int dd = 0; dd < 2; ++dd)
#pragma unroll
        for (int i = 0; i < 16; ++i) S[dd][i] = OUT ? Sp[(32 * (2 * tr + dd) + crow16(i, hf)) * 128] : 0.f;
    float gsum = 0.f;
    for (int ch = 0; ch < HSEG / 64; ++ch) {
        const size_t t0 = (size_t)b * SEQ + seg * HSEG + ch * 64;
        float fg[16], qv[16]; v4u i8[2];
        { const bf16* row = h + (t0 + stok) * NC_H + hh * 128 + c16;
          const v4u f8[2] = {*(const v4u*)(row + 768), *(const v4u*)(row + 776)}; i8[0] = *(const v4u*)(row + 1536); i8[1] = *(const v4u*)(row + 1544);
          v4u q8[2] = {{0u, 0u, 0u, 0u}, {0u, 0u, 0u, 0u}}; if (OUT) { q8[0] = *(const v4u*)row; q8[1] = *(const v4u*)(row + 8); }
#pragma unroll
          for (int w = 0; w < 8; ++w) { const unsigned fw = f8[w >> 2][w & 3]; const float f0 = bflo(fw), f1 = bfhi(fw);
              fg[2 * w] = lb[2 * w] + (1.f - lb[2 * w]) * sigmoidf_(f0); fg[2 * w + 1] = lb[2 * w + 1] + (1.f - lb[2 * w + 1]) * sigmoidf_(f1);
              if (OUT) { const unsigned qw = q8[w >> 2][w & 3]; const float q0 = bflo(qw), q1 = bfhi(qw); qv[2 * w] = q0 * sigmoidf_(q0); qv[2 * w + 1] = q1 * sigmoidf_(q1); } else { qv[2 * w] = 0.f; qv[2 * w + 1] = 0.f; } }
#pragma unroll
          for (int e4 = 0; e4 < 4; ++e4) { f32x4 lg; lg.x = __builtin_amdgcn_logf(fg[4 * e4]); lg.y = __builtin_amdgcn_logf(fg[4 * e4 + 1]); lg.z = __builtin_amdgcn_logf(fg[4 * e4 + 2]); lg.w = __builtin_amdgcn_logf(fg[4 * e4 + 3]);
              *(LAS f32x4*)(G + stok * 128 + c16 + 4 * e4) = lg; } }
        __syncthreads();
        { float run = 0.f;
#pragma unroll
          for (int k = 0; k < 16; ++k) run += G[(16 * cpart + k) * 128 + cd];
          PART[cpart * 128 + cd] = run; }
        __syncthreads();
        { float run = 0.f;
#pragma unroll
          for (int pp = 0; pp < 3; ++pp) run += (pp < cpart) ? PART[pp * 128 + cd] : 0.f;
#pragma unroll
          for (int k = 0; k < 16; ++k) { run += G[(16 * cpart + k) * 128 + cd]; G[(16 * cpart + k) * 128 + cd] = run; }
          if (cpart == 1) GM[cd] = run;
          if (cpart == 3) { GE[cd] = run; gsum += run; } }
        __syncthreads();
        if (OUT) {
#pragma unroll
            for (int dd = 0; dd < 2; ++dd)
#pragma unroll
                for (int g4 = 0; g4 < 4; ++g4) { const int dbase = 32 * (2 * tr + dd) + 8 * g4 + 4 * hf; const f32x4 gm = *(const LAS f32x4*)(GM + dbase);
                    v2u w; w.x = cvtpk(S[dd][4 * g4] * __builtin_amdgcn_exp2f(gm.x), S[dd][4 * g4 + 1] * __builtin_amdgcn_exp2f(gm.y)); w.y = cvtpk(S[dd][4 * g4 + 2] * __builtin_amdgcn_exp2f(gm.z), S[dd][4 * g4 + 3] * __builtin_amdgcn_exp2f(gm.w));
                    *(LAS v2u*)(lds + HG_ST + (32 * vq + r) * 272 + dbase * 2) = w; }
        }
        { unsigned qt[8], kt[8];
#pragma unroll
          for (int e4 = 0; e4 < 4; ++e4) { const f32x4 gv = *(const LAS f32x4*)(G + stok * 128 + c16 + 4 * e4), gm = *(const LAS f32x4*)(GM + c16 + 4 * e4), ge = *(const LAS f32x4*)(GE + c16 + 4 * e4);
              float ke[4];
#pragma unroll
              for (int e = 0; e < 4; ++e) { const float kk = 1.f - fg[4 * e4 + e]; ke[e] = kk * __builtin_amdgcn_exp2f(ge[e] - gv[e]);
                  if (OUT) { const float a = qv[4 * e4 + e] * __builtin_amdgcn_exp2f(gv[e] - gm[e]), c = kk * __builtin_amdgcn_exp2f(gm[e] - gv[e]);
                      if (e & 1) { qt[2 * e4 + (e >> 1)] |= f2bf(a) << 16; kt[2 * e4 + (e >> 1)] |= f2bf(c) << 16; } else { qt[2 * e4 + (e >> 1)] = f2bf(a); kt[2 * e4 + (e >> 1)] = f2bf(c); } } }
#pragma unroll
              for (int e = 0; e < 4; ++e) { const int col = c16 + 4 * e4 + e;
                  *(LAS bf16*)(lds + HG_KE + col * 144 + sperm * 2) = (bf16)f2bf(ke[e]);
                  const unsigned vw = i8[e4 >> 1][(2 * e4 + (e >> 1)) & 3]; *(LAS bf16*)(lds + HG_VT + col * 144 + sperm * 2) = (bf16)((e & 1) ? (vw >> 16) : (vw & 0xffffu)); } }
          if (OUT) { *(LAS v4u*)(lds + HG_QT + stok * 272 + c16 * 2) = (v4u){qt[0], qt[1], qt[2], qt[3]}; *(LAS v4u*)(lds + HG_QT + stok * 272 + c16 * 2 + 16) = (v4u){qt[4], qt[5], qt[6], qt[7]};
                     *(LAS v4u*)(lds + HG_KT + stok * 272 + c16 * 2) = (v4u){kt[0], kt[1], kt[2], kt[3]}; *(LAS v4u*)(lds + HG_KT + stok * 272 + c16 * 2 + 16) = (v4u){kt[4], kt[5], kt[6], kt[7]}; } }
        __syncthreads();
        if (OUT) {
            f32x16 X0, X1, O;
#pragma unroll
            for (int i = 0; i < 16; ++i) { X0[i] = 0.f; X1[i] = 0.f; O[i] = 0.f; }
            const LAS unsigned char* qtp = lds + HG_QT + (32 * tr + r) * 272 + hf * 16;
#pragma unroll
            for (int ks = 0; ks < 8; ++ks) { const s16x8 bq = *(const LAS s16x8*)(qtp + ks * 32);
                const s16x8 a0 = *(const LAS s16x8*)(lds + HG_KT + r * 272 + hf * 16 + ks * 32); X0 = __builtin_amdgcn_mfma_f32_32x32x16_bf16(a0, bq, X0, 0, 0, 0);
                if (tr == 1) { const s16x8 a1 = *(const LAS s16x8*)(lds + HG_KT + (32 + r) * 272 + hf * 16 + ks * 32); X1 = __builtin_amdgcn_mfma_f32_32x32x16_bf16(a1, bq, X1, 0, 0, 0); } }
#pragma unroll
            for (int i = 0; i < 16; ++i) { const bool keep = crow16(i, hf) <= r; if (tr == 0) X0[i] = keep ? X0[i] : 0.f; else X1[i] = keep ? X1[i] : 0.f; }
            const LAS unsigned char* vtp = lds + HG_VT + (32 * vq + r) * 144 + hf * 16;
#pragma unroll
            for (int s2 = 0; s2 < 2; ++s2) { v4u pw; pw.x = cvtpk(X0[8 * s2], X0[8 * s2 + 1]); pw.y = cvtpk(X0[8 * s2 + 2], X0[8 * s2 + 3]); pw.z = cvtpk(X0[8 * s2 + 4], X0[8 * s2 + 5]); pw.w = cvtpk(X0[8 * s2 + 6], X0[8 * s2 + 7]);
                const s16x8 bv = *(const LAS s16x8*)(vtp + (16 * s2) * 2); O = __builtin_amdgcn_mfma_f32_32x32x16_bf16(__builtin_bit_cast(s16x8, pw), bv, O, 0, 0, 0); }
            if (tr == 1) {
#pragma unroll
                for (int s2 = 0; s2 < 2; ++s2) { v4u pw; pw.x = cvtpk(X1[8 * s2], X1[8 * s2 + 1]); pw.y = cvtpk(X1[8 * s2 + 2], X1[8 * s2 + 3]); pw.z = cvtpk(X1[8 * s2 + 4], X1[8 * s2 + 5]); pw.w = cvtpk(X1[8 * s2 + 6], X1[8 * s2 + 7]);
                    const s16x8 bv = *(const LAS s16x8*)(vtp + (32 + 16 * s2) * 2); O = __builtin_amdgcn_mfma_f32_32x32x16_bf16(__builtin_bit_cast(s16x8, pw), bv, O, 0, 0, 0); } }
            const LAS unsigned char* stp = lds + HG_ST + (32 * vq + r) * 272 + hf * 16;
#pragma unroll
            for (int ks = 0; ks < 8; ++ks) { const s16x8 aq = *(const LAS s16x8*)(qtp + ks * 32), bs = *(const LAS s16x8*)(stp + ks * 32); O = __builtin_amdgcn_mfma_f32_32x32x16_bf16(aq, bs, O, 0, 0, 0); }
#pragma unroll
            for (int i = 0; i < 16; ++i) G[(32 * tr + crow16(i, hf)) * 128 + 32 * vq + r] = O[i];
        }
#pragma unroll
        for (int dd = 0; dd < 2; ++dd) { const int dr = 2 * tr + dd;
#pragma unroll
            for (int g4 = 0; g4 < 4; ++g4) { const f32x4 ge = *(const LAS f32x4*)(GE + 32 * dr + 8 * g4 + 4 * hf);
                S[dd][4 * g4] *= __builtin_amdgcn_exp2f(ge.x); S[dd][4 * g4 + 1] *= __builtin_amdgcn_exp2f(ge.y); S[dd][4 * g4 + 2] *= __builtin_amdgcn_exp2f(ge.z); S[dd][4 * g4 + 3] *= __builtin_amdgcn_exp2f(ge.w); }
#pragma unroll
            for (int ks = 0; ks < 4; ++ks) { const s16x8 a = *(const LAS s16x8*)(lds + HG_KE + (32 * dr + r) * 144 + hf * 16 + ks * 32), bv = *(const LAS s16x8*)(lds + HG_VT + (32 * vq + r) * 144 + hf * 16 + ks * 32);
                S[dd] = __builtin_amdgcn_mfma_f32_32x32x16_bf16(a, bv, S[dd], 0, 0, 0); } }
        __syncthreads();
        if (OUT) {
#pragma unroll 2
            for (int k = 0; k < 8; ++k) { const int tt = wave + 8 * k; const float o0 = G[tt * 128 + lane], o1 = G[tt * 128 + lane + 64];
                const float ms = wave_sum(o0 * o0 + o1 * o1) * (1.f / 128.f), rr = 1.f / sqrtf(ms + 1e-6f);
                const bf16* grow = h + (t0 + tt) * NC_H + 2304 + hh * 128; const float g0 = bf2f(grow[lane]), g1 = bf2f(grow[lane + 64]);
                bf16* mrow = mix + (t0 + tt) * 1024 + hh * 128;
                mrow[lane] = (bf16)f2bf(o0 * rr * normg[lane] * sigmoidf_(g0)); mrow[lane + 64] = (bf16)f2bf(o1 * rr * normg[lane + 64] * sigmoidf_(g1)); }
            __syncthreads();
        }
    }
    if (!OUT) {
#pragma unroll
        for (int dd = 0; dd < 2; ++dd)
#pragma unroll
            for (int i = 0; i < 16; ++i) Sp[(32 * (2 * tr + dd) + crow16(i, hf)) * 128] = S[dd][i];
        if (cpart == 3) Dseg[(size_t)unit * 128 + cd] = __builtin_amdgcn_exp2f(gsum);
    }
}
__device__ __forceinline__ void hgrn_scan(float* Sloc, const float* Dseg, size_t gtid, size_t gthreads) {
    for (size_t idx = gtid; idx < (size_t)NBATCH * HG_H * 16384; idx += gthreads) { const int bh = (int)(idx >> 14), e = (int)(idx & 16383), d = e >> 7; float cur = 0.f;
        for (int seg = 0; seg < HNSEG; ++seg) { const size_t u = (size_t)bh * HNSEG + seg; float* p = Sloc + u * 16384 + e; const float tmp = *p; *p = cur; cur = Dseg[u * 128 + d] * cur + tmp; } }
}

template <bool MASK>
__device__ __forceinline__ void attn4(const LAS unsigned* Ks, const LAS bf16* Vs, const LAS float* qst, LAS float* pb, int lane, const int (&tq)[4], int kbase, float slope,
                                      float (&mo)[4], float (&lo)[4], float (&oo)[4]) {
    float sc[4][4];
#pragma unroll
    for (int a = 0; a < 4; ++a)
#pragma unroll
        for (int c = 0; c < 4; ++c) sc[a][c] = 0.f;
#pragma unroll 4
    for (int dd = 0; dd < 32; ++dd) {
        f32x2 qv[4];
#pragma unroll
        for (int qi = 0; qi < 4; ++qi) qv[qi] = *(const LAS f32x2*)(qst + qi * 64 + 2 * dd);
#pragma unroll
        for (int kk = 0; kk < 4; ++kk) { const unsigned kw = Ks[(lane + 64 * kk) * 33 + dd]; const float k0 = bflo(kw), k1 = bfhi(kw);
#pragma unroll
            for (int qi = 0; qi < 4; ++qi) sc[qi][kk] += qv[qi].x * k0 + qv[qi].y * k1; }
    }
#pragma unroll
    for (int qi = 0; qi < 4; ++qi) { float mx = -INFINITY;
#pragma unroll
        for (int kk = 0; kk < 4; ++kk) { const int pos = kbase + lane + 64 * kk; float lg = sc[qi][kk] * 0.125f - slope * (float)(tq[qi] - pos); if (MASK && pos > tq[qi]) lg = -INFINITY; sc[qi][kk] = lg; mx = fmaxf(mx, lg); }
        mx = wave_max(mx); float s = 0.f;
#pragma unroll
        for (int kk = 0; kk < 4; ++kk) { const float p = __builtin_amdgcn_exp2f((sc[qi][kk] - mx) * 1.4426950408889634f); pb[qi * 256 + lane + 64 * kk] = p; s += p; }
        lo[qi] = wave_sum(s); mo[qi] = mx; }
    float o[4] = {0.f, 0.f, 0.f, 0.f};
#pragma unroll 4
    for (int k4 = 0; k4 < 64; ++k4) { f32x4 p4[4];
#pragma unroll
        for (int qi = 0; qi < 4; ++qi) p4[qi] = *(const LAS f32x4*)(pb + qi * 256 + 4 * k4);
#pragma unroll
        for (int jj = 0; jj < 4; ++jj) { const float vv = bf2f(Vs[(4 * k4 + jj) * 64 + lane]);
#pragma unroll
            for (int qi = 0; qi < 4; ++qi) o[qi] += p4[qi][jj] * vv; } }
#pragma unroll
    for (int qi = 0; qi < 4; ++qi) oo[qi] = o[qi];
}
constexpr int AT_KS = 0, AT_VS = 33792, AT_WV = 66560, AT_WVB = 5120;

__device__ __forceinline__ void memattn_unit(LAS unsigned char* lds, const bf16* h, int NC, int qoff, const bf16* kv, bf16* mix, int unit, int tid, int wave, int lane) {
    const int chunk = unit & 31, bm = unit >> 5, mh = bm & 3, b = bm >> 2;
    LAS unsigned* Ks = (LAS unsigned*)(lds + AT_KS); LAS unsigned* Vs32 = (LAS unsigned*)(lds + AT_VS);
    LAS float* qst = (LAS float*)(lds + AT_WV + wave * AT_WVB); LAS float* pb = qst + 256;
    for (int i = 0; i < 16; ++i) { const int idx = tid + 512 * i, r = idx >> 5, dd = idx & 31; const unsigned* src = (const unsigned*)(kv + (size_t)(b * 256 + r) * 512 + mh * 64);
        Ks[r * 33 + dd] = src[dd]; Vs32[r * 32 + dd] = src[128 + dd]; }
    __syncthreads();
    for (int qd = 0; qd < 16; ++qd) { const size_t tg = (size_t)b * SEQ + chunk * 512 + wave * 64 + qd * 4;
#pragma unroll
        for (int qi = 0; qi < 4; ++qi) qst[qi * 64 + lane] = bf2f(h[(tg + qi) * NC + qoff + mh * 64 + lane]);
        const int tq[4] = {0, 0, 0, 0}; float m[4], l[4], o[4];
        attn4<false>(Ks, (const LAS bf16*)Vs32, qst, pb, lane, tq, 0, 0.f, m, l, o);
#pragma unroll
        for (int qi = 0; qi < 4; ++qi) mix[(tg + qi) * 1024 + MIXW + mh * 64 + lane] = (bf16)f2bf(o[qi] / l[qi]); }
    __syncthreads();
}

constexpr int AT2_K = 0, AT2_KROW = 176, AT2_V = 256 * AT2_KROW, AT2_VROW = 528;
__device__ __forceinline__ void stage_kv_images(LAS unsigned char* lds, const bf16* kp, const bf16* vp, size_t row_stride, int tid) {
    v4u kx[4], vx[4];
#pragma unroll
    for (int i = 0; i < 4; ++i) { const int idx = tid + 512 * i, key = idx >> 3, c = idx & 7; kx[i] = *(const v4u*)(kp + (size_t)key * row_stride + 8 * c); vx[i] = *(const v4u*)(vp + (size_t)key * row_stride + 8 * c); }
    __builtin_amdgcn_sched_barrier(0);
#pragma unroll
    for (int i = 0; i < 4; ++i) { const int idx = tid + 512 * i, key = idx >> 3, c = idx & 7;
        *(LAS v4u*)(lds + AT2_K + key * AT2_KROW + c * 16) = kx[i];
        const int pos = (key & ~15) | (key & 3) | ((key & 4) << 1) | ((key & 8) >> 1);
        LAS bf16* vt = (LAS bf16*)(lds + AT2_V) + pos;
#pragma unroll
        for (int w = 0; w < 4; ++w) { vt[(8 * c + 2 * w) * (AT2_VROW / 2)] = (bf16)(vx[i][w] & 0xffffu); vt[(8 * c + 2 * w + 1) * (AT2_VROW / 2)] = (bf16)(vx[i][w] >> 16); } }
    if (tid < 256) { const unsigned pb = f2bf((float)tid); const v4u e0 = {pb | (pb << 16), 0u, 0u, 0u}, z = {0u, 0u, 0u, 0u};
        *(LAS v4u*)(lds + AT2_K + tid * AT2_KROW + 128) = e0; *(LAS v4u*)(lds + AT2_K + tid * AT2_KROW + 144) = z; }
}
template <bool MASK>
__device__ __forceinline__ void attn_tile32(const LAS unsigned char* lds, const s16x8 (&qf)[4], int lane, float dist0, unsigned qx, bool own, f32x16 (&o)[2], float& mrow, float& lrow) {
    const int r = lane & 31, hf = lane >> 5;
    const v4u qxv = {qx, 0u, 0u, 0u}; const s16x8 qe = __builtin_bit_cast(s16x8, qxv);
    f32x16 acc[8];
    const LAS unsigned char* kb = lds + AT2_K + r * AT2_KROW + hf * 16;
    constexpr int NKS = MASK ? 5 : 4;
    s16x8 kf[NKS];
#pragma unroll
    for (int s = 0; s < NKS; ++s) kf[s] = *(const LAS s16x8*)(kb + s * 32);
#pragma unroll
    for (int kt = 0; kt < 8; ++kt) {
#pragma unroll
        for (int i = 0; i < 16; ++i) acc[kt][i] = 0.f;
#pragma unroll
        for (int s = 0; s < NKS; ++s) { acc[kt] = __builtin_amdgcn_mfma_f32_32x32x16_bf16(kf[s], s < 4 ? qf[s < 4 ? s : 0] : qe, acc[kt], 0, 0, 0);
            if (kt + 1 < 8) kf[s] = *(const LAS s16x8*)(kb + (kt + 1) * 32 * AT2_KROW + s * 32); }
        __builtin_amdgcn_sched_barrier(0); }
    float mx = -INFINITY;
    if (MASK && own) { const float base2 = dist0 - 4.f * (float)hf;
#pragma unroll
        for (int kt = 0; kt < 8; ++kt)
#pragma unroll
            for (int i = 0; i < 16; ++i) { const float dist = base2 - (float)(32 * kt + (i & 3) + 8 * (i >> 2)); const float lg = dist < 0.f ? -INFINITY : acc[kt][i]; acc[kt][i] = lg; mx = fmaxf(mx, lg); }
    } else {
#pragma unroll
        for (int kt = 0; kt < 8; ++kt)
#pragma unroll
            for (int i = 0; i < 16; ++i) mx = fmaxf(mx, acc[kt][i]);
    }
    mx = fmaxf(mx, xor32f(mx, lane));
    float sum = 0.f;
#pragma unroll
    for (int i = 0; i < 16; ++i) { o[0][i] = 0.f; o[1][i] = 0.f; }
    const LAS unsigned char* vb = lds + AT2_V + r * AT2_VROW + hf * 16;
    s16x8 vf[4];
#pragma unroll
    for (int s2 = 0; s2 < 2; ++s2)
#pragma unroll
        for (int dt = 0; dt < 2; ++dt) vf[2 * s2 + dt] = *(const LAS s16x8*)(vb + dt * 32 * AT2_VROW + (16 * s2) * 2);
#pragma unroll
    for (int kt = 0; kt < 8; ++kt) {
#pragma unroll
        for (int i = 0; i < 16; ++i) { const float p = __builtin_amdgcn_exp2f(acc[kt][i] - mx); sum += p; acc[kt][i] = p; }
#pragma unroll
        for (int s2 = 0; s2 < 2; ++s2) { v4u pw; pw.x = cvtpk(acc[kt][8 * s2], acc[kt][8 * s2 + 1]); pw.y = cvtpk(acc[kt][8 * s2 + 2], acc[kt][8 * s2 + 3]);
            pw.z = cvtpk(acc[kt][8 * s2 + 4], acc[kt][8 * s2 + 5]); pw.w = cvtpk(acc[kt][8 * s2 + 6], acc[kt][8 * s2 + 7]); const s16x8 pf = __builtin_bit_cast(s16x8, pw);
#pragma unroll
            for (int dt = 0; dt < 2; ++dt) { o[dt] = __builtin_amdgcn_mfma_f32_32x32x16_bf16(vf[2 * s2 + dt], pf, o[dt], 0, 0, 0);
                if (kt + 1 < 8) vf[2 * s2 + dt] = *(const LAS s16x8*)(vb + dt * 32 * AT2_VROW + (32 * (kt + 1) + 16 * s2) * 2); } }
        __builtin_amdgcn_sched_barrier(0); }
    sum += xor32f(sum, lane);
    mrow = mx; lrow = sum;
}
__device__ __forceinline__ void memattn_unit2(LAS unsigned char* lds, const bf16* h, int NC, int qoff, const bf16* kv, bf16* mix, int unit, int tid, int wave, int lane) {
    const int chunk = unit & 63, bm = unit >> 6, mh = bm & 3, b = bm >> 2, r = lane & 31, hf = lane >> 5;
    const bf16* kvrow0 = kv + (size_t)(b * 256) * 512 + mh * 64;
    stage_kv_images(lds, kvrow0, kvrow0 + 256, 512, tid);
    __syncthreads();
    { const size_t tg = (size_t)b * SEQ + chunk * 256 + wave * 32 + r;
        f32x16 o[2]; float m2, l; s16x8 qf[4];
#pragma unroll
        for (int s = 0; s < 4; ++s) qf[s] = *(const s16x8*)(h + tg * NC + qoff + mh * 64 + 16 * s + 8 * hf);
        attn_tile32<false>(lds, qf, lane, 0.f, 0u, false, o, m2, l);
        const float inv = 1.f / l; bf16* mp = mix + tg * 1024 + MIXW + mh * 64 + 4 * hf;
#pragma unroll
        for (int dt = 0; dt < 2; ++dt)
#pragma unroll
            for (int g = 0; g < 4; ++g) { v2u w; w.x = cvtpk(o[dt][4 * g] * inv, o[dt][4 * g + 1] * inv); w.y = cvtpk(o[dt][4 * g + 2] * inv, o[dt][4 * g + 3] * inv); *(v2u*)(mp + 32 * dt + 8 * g) = w; } }
    __syncthreads();
}
__device__ __forceinline__ void kmean_unit(LAS unsigned char* lds, const bf16* h, float* kmean, int unit, int tid) {
    const int n = unit & 63, bh = unit >> 6, hh = bh % MB_H, b = bh / MB_H, d = tid & 63, part = tid >> 6;
    LAS float* red = (LAS float*)lds;
    float s = 0.f; const bf16* p = h + ((size_t)b * SEQ + n * 256 + part * 32) * NC_M + 768 + hh * 64 + d;
    for (int i = 0; i < 32; ++i) s += bf2f(p[(size_t)i * NC_M]);
    red[part * 64 + d] = s; __syncthreads();
    if (tid < 64) { float a = 0.f; for (int pp = 0; pp < 8; ++pp) a += red[pp * 64 + tid]; kmean[((size_t)bh * 64 + n) * 64 + tid] = a * (1.f / 256.f); }
    __syncthreads();
}
__device__ __forceinline__ void moba_gate_unit(LAS unsigned char* lds, const bf16* h, const float* kmean, unsigned* gcount, int* selinfo, unsigned* list, int unit, int tid) {
    const int c = unit & 63, bh = unit >> 6, hh = bh % MB_H, b = bh / MB_H;
    LAS float* km = (LAS float*)lds; LAS int* hist = (LAS int*)(lds + 16384); LAS int* base = hist + 64;
    for (int i = tid; i < 4096; i += NTHR) km[i] = kmean[(size_t)bh * 4096 + i];
    if (tid < 64) hist[tid] = 0;
    __syncthreads();
    int s0 = 0, s1 = 0, s2 = 0, r0 = 0, r1 = 0, r2 = 0, ns = 0; const int t = c * 256 + tid;
    if (tid < 256) {
        float q[64]; const v4u* qp = (const v4u*)(h + ((size_t)b * SEQ + t) * NC_M + hh * 64);
#pragma unroll
        for (int w = 0; w < 8; ++w) { const v4u x = qp[w]; q[8 * w] = bflo(x.x); q[8 * w + 1] = bfhi(x.x); q[8 * w + 2] = bflo(x.y); q[8 * w + 3] = bfhi(x.y); q[8 * w + 4] = bflo(x.z); q[8 * w + 5] = bfhi(x.z); q[8 * w + 6] = bflo(x.w); q[8 * w + 7] = bfhi(x.w); }
        float v0 = -INFINITY, v1 = -INFINITY, v2 = -INFINITY;
        for (int n = 0; n < c; ++n) { float g = 0.f;
#pragma unroll
            for (int d4 = 0; d4 < 16; ++d4) { const f32x4 k4 = *(const LAS f32x4*)(km + n * 64 + 4 * d4); g += q[4 * d4] * k4.x + q[4 * d4 + 1] * k4.y + q[4 * d4 + 2] * k4.z + q[4 * d4 + 3] * k4.w; }
            if (g > v0) { v2 = v1; s2 = s1; v1 = v0; s1 = s0; v0 = g; s0 = n; } else if (g > v1) { v2 = v1; s2 = s1; v1 = g; s1 = n; } else if (g > v2) { v2 = g; s2 = n; } }
        ns = c < 3 ? c : 3;
        if (ns > 0) r0 = __hip_atomic_fetch_add(hist + s0, 1, __ATOMIC_RELAXED, __HIP_MEMORY_SCOPE_WORKGROUP);
        if (ns > 1) r1 = __hip_atomic_fetch_add(hist + s1, 1, __ATOMIC_RELAXED, __HIP_MEMORY_SCOPE_WORKGROUP);
        if (ns > 2) r2 = __hip_atomic_fetch_add(hist + s2, 1, __ATOMIC_RELAXED, __HIP_MEMORY_SCOPE_WORKGROUP);
        selinfo[((size_t)b * SEQ + t) * MB_H + hh] = ns;
    }
    __syncthreads();
    if (tid < 64) { const int hc = hist[tid]; if (hc > 0) base[tid] = (int)__hip_atomic_fetch_add(gcount + bh * 64 + tid, (unsigned)hc, __ATOMIC_RELAXED, __HIP_MEMORY_SCOPE_AGENT); }
    __syncthreads();
    if (tid < 256) { unsigned* lp = list + ((size_t)bh * 64 << 14);
        if (ns > 0) lp[((size_t)s0 << 14) + base[s0] + r0] = (unsigned)t;
        if (ns > 1) lp[((size_t)s1 << 14) + base[s1] + r1] = (unsigned)t | (1u << 14);
        if (ns > 2) lp[((size_t)s2 << 14) + base[s2] + r2] = (unsigned)t | (2u << 14); }
    __syncthreads();
}
__device__ __forceinline__ void moba_attn_item(LAS unsigned char* lds, const bf16* h, const unsigned* gcount, const unsigned* list, float* po, float* pml, int item, int tid, int wave, int lane) {
    const int n = item / 24, bh = item - n * 24, hh = bh % MB_H, b = bh / MB_H;
    LAS unsigned* Ks = (LAS unsigned*)(lds + AT_KS); LAS unsigned* Vs32 = (LAS unsigned*)(lds + AT_VS);
    LAS float* qst = (LAS float*)(lds + AT_WV + wave * AT_WVB); LAS float* pb = qst + 256;
    for (int i = 0; i < 16; ++i) { const int idx = tid + 512 * i, r = idx >> 5, dd = idx & 31; const unsigned* src = (const unsigned*)(h + ((size_t)b * SEQ + n * 256 + r) * NC_M + hh * 64);
        Ks[r * 33 + dd] = src[384 + dd]; Vs32[r * 32 + dd] = src[768 + dd]; }
    __syncthreads();
    const int cnt = (int)gcount[bh * 64 + n], total = 256 + cnt, nquads = (total + 3) >> 2;
    const float slope = hh < 8 ? ldexpf(1.0f, -(hh + 1)) : ldexpf(0.70710678118654752f, -(hh - 8));
    const unsigned* lp = list + (((size_t)bh * 64 + n) << 14);
    for (int quad = wave; quad < nquads; quad += 8) {
        int tq[4], slot[4];
#pragma unroll
        for (int qi = 0; qi < 4; ++qi) { int idx = quad * 4 + qi; idx = idx < total ? idx : total - 1;
            if (idx < 256) { tq[qi] = n * 256 + idx; slot[qi] = 3; } else { const unsigned e = lp[idx - 256]; tq[qi] = (int)(e & 16383u); slot[qi] = (int)(e >> 14); } }
#pragma unroll
        for (int qi = 0; qi < 4; ++qi) qst[qi * 64 + lane] = bf2f(h[((size_t)b * SEQ + tq[qi]) * NC_M + hh * 64 + lane]);
        float m[4], l[4], o[4];
        attn4<true>(Ks, (const LAS bf16*)Vs32, qst, pb, lane, tq, n * 256, slope, m, l, o);
#pragma unroll
        for (int qi = 0; qi < 4; ++qi) if (quad * 4 + qi < total) { const size_t pi = (((size_t)b * SEQ + tq[qi]) * MB_H + hh) * 4 + slot[qi];
            po[pi * 64 + lane] = o[qi]; if (lane == 0) { pml[pi * 2] = m[qi]; pml[pi * 2 + 1] = l[qi]; } }
    }
    __syncthreads();
}

__device__ __forceinline__ void moba_attn_item2(LAS unsigned char* lds, const bf16* h, const unsigned* gcount, const unsigned* list, bf16* po, float* pml, int item, int tid, int wave, int lane) {
    const int n = item / 24, bh = item - n * 24, hh = bh % MB_H, b = bh / MB_H, r = lane & 31, hf = lane >> 5;
    const bf16* hrow0 = h + ((size_t)b * SEQ + n * 256) * NC_M + hh * 64;
    stage_kv_images(lds, hrow0 + 768, hrow0 + 1536, NC_M, tid);
    __syncthreads();
    const int cnt = (int)gcount[bh * 64 + n], total = 256 + cnt, ntiles = (total + 31) >> 5;
    const float slope2 = (hh < 8 ? ldexpf(1.0f, -(hh + 1)) : ldexpf(0.70710678118654752f, -(hh - 8))) * 1.4426950408889634f;
    const unsigned shi = f2bf(slope2), slo = f2bf(slope2 - __builtin_bit_cast(float, shi << 16)); const unsigned qx = hf == 0 ? (shi | (slo << 16)) : 0u;
    const unsigned* lp = list + (((size_t)bh * 64 + n) << 14);
    const bf16* hq = h + (size_t)b * SEQ * NC_M + hh * 64 + 8 * hf;
#pragma unroll 1
    for (int tile = wave; tile < ntiles; tile += NWAVES) {
        int idx = tile * 32 + r; const bool valid = idx < total; idx = valid ? idx : total - 1;
        int tq, slot; if (idx < 256) { tq = n * 256 + idx; slot = 3; } else { const unsigned e = lp[idx - 256]; tq = (int)(e & 16383u); slot = (int)(e >> 14); }
        s16x8 qf[4]; { const bf16* qp = hq + (size_t)tq * NC_M;
#pragma unroll
            for (int s = 0; s < 4; ++s) qf[s] = *(const s16x8*)(qp + 16 * s); }
        f32x16 o[2]; float m2, l; const float dist0 = (float)(tq - n * 256);
        attn_tile32<true>(lds, qf, lane, dist0, qx, tile < 8, o, m2, l);
        if (valid) { const size_t pi = (((size_t)b * SEQ + tq) * MB_H + hh) * 4 + slot; bf16* op = po + pi * 64 + 4 * hf;
#pragma unroll
            for (int dt = 0; dt < 2; ++dt)
#pragma unroll
                for (int g = 0; g < 4; ++g) { v2u w; w.x = cvtpk(o[dt][4 * g], o[dt][4 * g + 1]); w.y = cvtpk(o[dt][4 * g + 2], o[dt][4 * g + 3]); *(v2u*)(op + 32 * dt + 8 * g) = w; }
            if (hf == 0) { pml[pi * 2] = m2 - slope2 * dist0; pml[pi * 2 + 1] = l; } }
    }
    __syncthreads();
}
__device__ __forceinline__ void moba_combine(const bf16* __restrict__ po, const float* __restrict__ pml, const int* __restrict__ selinfo, bf16* __restrict__ mix, int gw, int ngw, int lane) {
    const int sub = lane >> 4, d4 = (lane & 15) * 4;
#pragma unroll 2
    for (int idx = gw * 4 + sub; idx < T * MB_H; idx += ngw * 4) { const int tg = idx / MB_H, hh = idx - tg * MB_H, ns = selinfo[idx]; const size_t p4 = (size_t)idx * 4;
        f32x2 ml[4]; f32x4 ov[4];
#pragma unroll
        for (int j = 0; j < 4; ++j) { ml[j] = ((const f32x2*)pml)[p4 + j]; const v2u ow = *(const v2u*)(po + (p4 + j) * 64 + d4); ov[j] = (f32x4){bflo(ow.x), bfhi(ow.x), bflo(ow.y), bfhi(ow.y)}; }
        float M = ml[3].x;
#pragma unroll
        for (int j = 0; j < 3; ++j) { const bool ok = j < ns; ml[j].x = ok ? ml[j].x : -INFINITY; ml[j].y = ok ? ml[j].y : 0.f; M = fmaxf(M, ml[j].x);
            ov[j].x = ok ? ov[j].x : 0.f; ov[j].y = ok ? ov[j].y : 0.f; ov[j].z = ok ? ov[j].z : 0.f; ov[j].w = ok ? ov[j].w : 0.f; }
        float den = 0.f; f32x4 num = {0.f, 0.f, 0.f, 0.f};
#pragma unroll
        for (int j = 0; j < 4; ++j) { const float w = __builtin_amdgcn_exp2f(ml[j].x - M); den += w * ml[j].y; num += ov[j] * w; }
        const float inv = 1.f / den; v2u o; o.x = pk2(num.x * inv, num.y * inv); o.y = pk2(num.z * inv, num.w * inv);
        *(v2u*)(mix + (size_t)tg * 1024 + hh * 64 + d4) = o; }
}

__device__ __forceinline__ void ln_row(f32x4 (&v)[4], const f32x4 (&gv)[4], const f32x4 (&bv)[4]) {
    float s = 0.f;
#pragma unroll
    for (int j = 0; j < 4; ++j) s += (v[j].x + v[j].y) + (v[j].z + v[j].w);
    const float mean = wave_sum(s) * (1.f / D); float s2 = 0.f;
#pragma unroll
    for (int j = 0; j < 4; ++j) { v[j] = v[j] - mean; s2 += (v[j].x * v[j].x + v[j].y * v[j].y) + (v[j].z * v[j].z + v[j].w * v[j].w); }
    const float rstd = 1.f / sqrtf(wave_sum(s2) * (1.f / D) + 1e-5f);
#pragma unroll
    for (int j = 0; j < 4; ++j) v[j] = v[j] * rstd * gv[j] + bv[j];
}
__device__ __forceinline__ void phase_ln1(LAS unsigned char* lds, const bf16* y, const float* g, const float* bb, const float* wr, const float* br,
                                          bf16* xbf, int* tok_e, int* tok_lr, float* tok_w, int* blk_cnt, int blk, int tid, int wave, int lane) {
    LAS float* xst = (LAS float*)lds;
    LAS float* part = (LAS float*)(lds + 32768);
    LAS int* hist = (LAS int*)(lds + 40960);
    if (tid < 32) hist[tid] = 0;
    constexpr int TPB = T / GRID;
    const int e = lane & 31, half = lane >> 5;
    float wreg[64];
    { const float* wp = wr + (size_t)(wave * 128 + half * 64) * NE + e;
#pragma unroll
      for (int k = 0; k < 64; ++k) wreg[k] = wp[k * NE]; }
    const float bre = br[e];
    __syncthreads();
    f32x4 gv[4], bv[4];
#pragma unroll
    for (int j = 0; j < 4; ++j) { gv[j] = ((const f32x4*)g)[lane + 64 * j]; bv[j] = ((const f32x4*)bb)[lane + 64 * j]; }
    v2u xn[4], yn[4];
    { const size_t t0 = (size_t)blk * TPB + wave; const v2u* xr = (const v2u*)(xbf + t0 * D) + lane; const v2u* yr = (const v2u*)(y + t0 * D) + lane;
#pragma unroll
      for (int j = 0; j < 4; ++j) { xn[j] = xr[64 * j]; yn[j] = yr[64 * j]; } }
    for (int grp = 0; grp < TPB / NWAVES; ++grp) { const size_t t = (size_t)blk * TPB + grp * NWAVES + wave;
        { f32x4 v[4];
#pragma unroll
          for (int j = 0; j < 4; ++j) { const v2u xw = xn[j]; const v2u yw = yn[j];
              v[j].x = DN_ALPHA * bflo(xw.x) + bflo(yw.x); v[j].y = DN_ALPHA * bfhi(xw.x) + bfhi(yw.x); v[j].z = DN_ALPHA * bflo(xw.y) + bflo(yw.y); v[j].w = DN_ALPHA * bfhi(xw.y) + bfhi(yw.y); }
          if (grp + 1 < TPB / NWAVES) { const v2u* xr = (const v2u*)(xbf + (t + NWAVES) * D) + lane; const v2u* yr = (const v2u*)(y + (t + NWAVES) * D) + lane;
#pragma unroll
              for (int j = 0; j < 4; ++j) { xn[j] = xr[64 * j]; yn[j] = yr[64 * j]; } }
          ln_row(v, gv, bv);
          v2u* xb = (v2u*)(xbf + t * D) + lane;
#pragma unroll
          for (int j = 0; j < 4; ++j) { v2u w; w.x = pk2(v[j].x, v[j].y); w.y = pk2(v[j].z, v[j].w); xb[64 * j] = w; ((LAS f32x4*)(xst + wave * 1024))[lane + 64 * j] = v[j]; } }
        __syncthreads();
#pragma unroll 2
        for (int tk = 0; tk < 8; ++tk) { float acc = 0.f; const LAS float* xs_ = xst + tk * 1024 + wave * 128 + half * 64;
#pragma unroll
            for (int k4 = 0; k4 < 16; ++k4) { const f32x4 xv = *(const LAS f32x4*)(xs_ + 4 * k4); acc += xv.x * wreg[4 * k4]; acc += xv.y * wreg[4 * k4 + 1]; acc += xv.z * wreg[4 * k4 + 2]; acc += xv.w * wreg[4 * k4 + 3]; }
            acc += xor32f(acc, lane);
            if (half == 0) part[(wave * 8 + tk) * 32 + e] = acc; }
        __syncthreads();
        float logit = bre;
#pragma unroll
        for (int w = 0; w < 8; ++w) logit += part[(w * 8 + wave) * 32 + e];
        int rank = 0;
#pragma unroll
        for (int q = 0; q < 32; ++q) { const float oq = __builtin_bit_cast(float, __builtin_amdgcn_readlane(__builtin_bit_cast(int, logit), q)); rank += (oq > logit || (oq == logit && q < e)) ? 1 : 0; }
        int se[4]; float sv[4];
#pragma unroll
        for (int k = 0; k < 4; ++k) { const unsigned long long mk = __ballot(rank == k && lane < 32); const int src = __builtin_ctzll(mk);
            se[k] = src; sv[k] = __builtin_bit_cast(float, __builtin_amdgcn_readlane(__builtin_bit_cast(int, logit), src)); }
        const float e1 = __expf(sv[1] - sv[0]), e2 = __expf(sv[2] - sv[0]), e3 = __expf(sv[3] - sv[0]), inv = 1.f / (1.f + e1 + e2 + e3);
        const float wk[4] = {inv, e1 * inv, e2 * inv, e3 * inv};
        if (lane == 0) {
#pragma unroll
            for (int k = 0; k < 4; ++k) { const int lr = __hip_atomic_fetch_add(hist + se[k], 1, __ATOMIC_RELAXED, __HIP_MEMORY_SCOPE_WORKGROUP);
                tok_e[t * 4 + k] = se[k]; tok_lr[t * 4 + k] = lr; tok_w[t * 4 + k] = wk[k]; } }
    }
    __syncthreads();
    if (tid < 32) blk_cnt[blk * 32 + tid] = hist[tid];
    __syncthreads();
}
__device__ __forceinline__ void phase_dispatch(LAS unsigned char* lds, const int* __restrict__ blk_cnt, const int* __restrict__ tok_e, const int* __restrict__ tok_lr, int* __restrict__ tok_row, int* __restrict__ tab,
                                               const bf16* __restrict__ xbf, bf16* __restrict__ xs, int blk, int tid, int wave, int lane) {
    LAS int* tot = (LAS int*)lds; LAS int* pre = tot + 32; LAS int* pst = pre + 32; LAS int* rows = pst + 64;
    if (tid < 32) { int s = 0, p = 0;
#pragma unroll 8
        for (int bb = 0; bb < GRID; ++bb) { const int c = blk_cnt[bb * 32 + tid]; p += (bb < blk) ? c : 0; s += c; } tot[tid] = s; pre[tid] = p; }
    __syncthreads();
    if (tid == 0) { int acc = 0; for (int e = 0; e < 32; ++e) { pst[e] = acc; acc += ((tot[e] + 255) >> 8) << 8; } pst[32] = acc; }
    __syncthreads();
    if (blk == 0 && tid < 33) tab[tid] = pst[tid] >> 8;
    constexpr int TPB = T / GRID;
    static_assert(TPB * 4 == NTHR, "one (token, k) pair per thread");
    { const size_t ti = (size_t)blk * TPB * 4 + tid; const int e = tok_e[ti]; const int r = pst[e] + pre[e] + tok_lr[ti]; tok_row[ti] = r; rows[tid] = r; }
    __syncthreads();
#pragma unroll 4
    for (int i = wave; i < TPB * 4; i += NWAVES) { const int r = rows[i];
        const v4u* src = (const v4u*)(xbf + ((size_t)blk * TPB + (i >> 2)) * D) + 2 * lane; const v4u a = src[0], b = src[1];
        v4u o; o.x = pk4_fp8(bflo(a.x), bfhi(a.x), bflo(a.y), bfhi(a.y)); o.y = pk4_fp8(bflo(a.z), bfhi(a.z), bflo(a.w), bfhi(a.w)); o.z = pk4_fp8(bflo(b.x), bfhi(b.x), bflo(b.y), bfhi(b.y)); o.w = pk4_fp8(bflo(b.z), bfhi(b.z), bflo(b.w), bfhi(b.w));
        ((v4u*)((unsigned char*)xs + (size_t)r * D))[lane] = o; }
    __syncthreads();
}
__device__ __forceinline__ f32x4 fp8x4_to_f32(unsigned w) {
    const f32x2 lo = __builtin_amdgcn_cvt_pk_f32_fp8((int)w, false), hi = __builtin_amdgcn_cvt_pk_f32_fp8((int)w, true); return (f32x4){lo.x, lo.y, hi.x, hi.y};
}
__device__ __forceinline__ void phase_ln2(const unsigned char* __restrict__ yrows, const int* __restrict__ tok_row, const float* __restrict__ tok_w, const float* __restrict__ g, const float* __restrict__ bb,
                                          float* __restrict__ xout, bf16* xbf, int gw, int ngw, int lane) {
    f32x4 gv[4], bv[4];
#pragma unroll
    for (int j = 0; j < 4; ++j) { gv[j] = ((const f32x4*)g)[lane + 64 * j]; bv[j] = ((const f32x4*)bb)[lane + 64 * j]; }
    static_assert(T % (2 * GRID * NWAVES) == 0, "two tokens per wave per step");
    for (int t0 = gw; t0 < T; t0 += 2 * ngw) {
        f32x4 v[2][4];
#pragma unroll
        for (int u = 0; u < 2; ++u) { const int t = t0 + u * ngw; int r[4]; float w[4];
#pragma unroll
            for (int k = 0; k < 4; ++k) { r[k] = tok_row[(size_t)t * 4 + k]; w[k] = tok_w[(size_t)t * 4 + k] * (1.f / 16.f); }
            const v2u* xr = (const v2u*)(xbf + (size_t)t * D) + lane;
#pragma unroll
            for (int j = 0; j < 4; ++j) { f32x4 f = {0.f, 0.f, 0.f, 0.f};
#pragma unroll
                for (int k = 0; k < 4; ++k) { const unsigned yw = ((const unsigned*)(yrows + (size_t)r[k] * D))[lane + 64 * j]; f += fp8x4_to_f32(yw) * w[k]; }
                const v2u xw = xr[64 * j]; v[u][j].x = DN_ALPHA * bflo(xw.x) + f.x; v[u][j].y = DN_ALPHA * bfhi(xw.x) + f.y; v[u][j].z = DN_ALPHA * bflo(xw.y) + f.z; v[u][j].w = DN_ALPHA * bfhi(xw.y) + f.w; } }
#pragma unroll
        for (int u = 0; u < 2; ++u) { const int t = t0 + u * ngw;
            ln_row(v[u], gv, bv);
            if (xout) { f32x4* xo = (f32x4*)(xout + (size_t)t * D) + lane;
#pragma unroll
                for (int j = 0; j < 4; ++j) xo[64 * j] = v[u][j]; }
            else { v2u* xb = (v2u*)(xbf + (size_t)t * D) + lane;
#pragma unroll
                for (int j = 0; j < 4; ++j) { v2u ww; ww.x = pk2(v[u][j].x, v[u][j].y); ww.y = pk2(v[u][j].z, v[u][j].w); xb[64 * j] = ww; } } } }
}

struct Args { const float* in[20]; float* out; unsigned char* ws; int l_lo, l_hi, ph_lo, ph_hi; };
typedef const __attribute__((address_space(4))) Args* KArgsP;
#define KA_LOAD() ({ KArgsP p_ = (KArgsP)__builtin_amdgcn_kernarg_segment_ptr(); asm volatile("" : "+s"(p_)); p_; })
#ifndef PHMASK
#define PHMASK 0xFFFF
#endif
#ifndef REPEAT_MASK
#define REPEAT_MASK 0
#endif
#ifndef REPEAT_LMASK
#define REPEAT_LMASK 0xF
#endif
#define PH_BEGIN(k) _Pragma("unroll") for (int rep_ = 0; rep_ < ((((REPEAT_MASK >> (k)) & 1) && ((REPEAT_LMASK >> l) & 1)) ? 2 : 1); ++rep_) { if ((PHMASK >> (k)) & 1) { KArgsP ka = KA_LOAD(); unsigned char* ws = ka->ws; int tid = threadIdx.x; asm volatile("" : "+v"(tid)); \
    const int lane = tid & 63, wave = __builtin_amdgcn_readfirstlane(tid >> 6); int blk = blockIdx.x; asm volatile("" : "+s"(blk)); \
    const int gw = blk * NWAVES + wave; const size_t gtid = (size_t)blk * NTHR + tid; (void)lane; (void)gw; (void)gtid; (void)ws;
#if ONE_LAUNCH
#define PH_SEAM() do { XcdBarrier b_; b_.bar = (unsigned*)(KA_LOAD()->ws + WS_CTL) + CW_BAR; b_.x = xb_xcc_id(); b_.st = (volatile LAS unsigned*)(lds + MISC_OFF); xcd_barrier(b_); } while (0)
#else
#define PH_SEAM() do {} while (0)
#endif
#define PH_END() PH_SEAM(); } }
#define PH_END_NOSEAM() } }
#define WSP(type, off) ((type*)(ws + (off)))
constexpr int G = GRID, NGW = GRID * NWAVES; constexpr size_t GTHREADS = (size_t)GRID * NTHR;
template <int L> __device__ __forceinline__ void layer_phases(LAS unsigned char* lds) {
    constexpr int l = L; LAS int* tabL = (LAS int*)(lds + MISC_OFF + 256);

        const int j = l >> 1; const bool moba = (l & 1) != 0;
        const int NC = moba ? NC_M : NC_H, qoff = moba ? 2304 : 3072;

        if (l == 0) {
        PH_BEGIN(1)
            phase_weights((LAS float*)(lds + wave * 16384), gw, NGW, lane, ka->in[2], NC_H, ka->in[6], ka->in[7], ka->in[12], ka->in[14], ka->in[16], WSP(bf16, WS_WIN), WSP(bf16, WS_WKV), WSP(bf16, WS_WO), WSP(bf16, WS_WGU), WSP(bf16, WS_WD));
        PH_END()
        }
        PH_BEGIN(2)
            { pg8::Gemm g{WSP(bf16, WS_XBF), WSP(bf16, WS_WIN), T, NC, D, 0, 0}; pg8::StaticOrder S; S.init(T, NC, G, blk); pg8::EpiPlain E{WSP(bf16, WS_H), NC, moba ? 0x207u : 0x1000u, 0.125f * 1.4426950408889634f};
              pg8::gemm_phase<pg8::EpiPlain, pg8::StaticOrder, true, true>(lds, g, S, E); }
            { pg8::Gemm g{WSP(bf16, WS_MEMBF), WSP(bf16, WS_WKV), 512, 512, D, 0, 0}; pg8::StaticOrder S; S.init(512, 512, G, blk); pg8::EpiPlain E{WSP(bf16, WS_KV), 512, 0u, 1.f};
              pg8::gemm_phase<pg8::EpiPlain, pg8::StaticOrder, true, true>(lds, g, S, E); }
        PH_END()
        if (!moba) {
            PH_BEGIN(3)
                for (int u = blk; u < NBATCH * HG_H * HNSEG; u += G) hgrn_mfma<false>(lds, WSP(bf16, WS_H), ka->in[3], j, ka->in[4] + j * 128, WSP(float, WS_SLOC), WSP(float, WS_DSEG), WSP(bf16, WS_MIX), u, tid, wave, lane);
                for (int u = blk; u < 512; u += G) memattn_unit2(lds, WSP(bf16, WS_H), NC, qoff, WSP(bf16, WS_KV), WSP(bf16, WS_MIX), u, tid, wave, lane);
            PH_END()
            PH_BEGIN(4)
                hgrn_scan(WSP(float, WS_SLOC), WSP(float, WS_DSEG), gtid, GTHREADS);
            PH_END()
            PH_BEGIN(5)
                for (int u = blk; u < NBATCH * HG_H * HNSEG; u += G) hgrn_mfma<true>(lds, WSP(bf16, WS_H), ka->in[3], j, ka->in[4] + j * 128, WSP(float, WS_SLOC), WSP(float, WS_DSEG), WSP(bf16, WS_MIX), u, tid, wave, lane);
            PH_END()
        } else {
            PH_BEGIN(3)
                for (int u = blk; u < 24 * MB_NB; u += G) kmean_unit(lds, WSP(bf16, WS_H), WSP(float, WS_KMEAN), u, tid);
                for (int u = blk; u < 512; u += G) memattn_unit2(lds, WSP(bf16, WS_H), NC, qoff, WSP(bf16, WS_KV), WSP(bf16, WS_MIX), u, tid, wave, lane);
            PH_END()
            PH_BEGIN(4)
                for (int u = blk; u < 24 * MB_NB; u += G) moba_gate_unit(lds, WSP(bf16, WS_H), WSP(float, WS_KMEAN), WSP(unsigned, WS_CTL) + CW_GCOUNT + j * 1536, WSP(int, WS_SELINFO), WSP(unsigned, WS_LIST), u, tid);
            PH_END()
            PH_BEGIN(5)
                for (int r = 0; r * G < 24 * MB_NB; ++r) { const int it = r * G + ((r & 1) ? (G - 1 - blk) : blk);
                    if (it < 24 * MB_NB) moba_attn_item2(lds, WSP(bf16, WS_H), WSP(unsigned, WS_CTL) + CW_GCOUNT + j * 1536, WSP(unsigned, WS_LIST), WSP(bf16, WS_PO), WSP(float, WS_PML), it, tid, wave, lane); }
            PH_END()
            PH_BEGIN(6)
                moba_combine(WSP(bf16, WS_PO), WSP(float, WS_PML), WSP(int, WS_SELINFO), WSP(bf16, WS_MIX), gw, NGW, lane);
            PH_END()
        }
        PH_BEGIN(7)
            pg8::Gemm g{WSP(bf16, WS_MIX), WSP(bf16, WS_WO), T, D, D, 0, 0}; pg8::StaticOrder S; S.init(T, D, G, blk); pg8::EpiPlain E{WSP(bf16, WS_Y), D, 0u, 1.f};
            pg8::gemm_phase<pg8::EpiPlain, pg8::StaticOrder, true, true>(lds, g, S, E);
        PH_END()
        PH_BEGIN(8)
            phase_ln1(lds, WSP(bf16, WS_Y), ka->in[8] + l * D, ka->in[9] + l * D, ka->in[10] + (size_t)l * D * NE, ka->in[11] + l * NE, WSP(bf16, WS_XBF),
                      WSP(int, WS_TOK + TOK_E), WSP(int, WS_TOK + TOK_LR), WSP(float, WS_TOK + TOK_W), WSP(int, WS_TOK + TOK_BLKCNT), blk, tid, wave, lane);
        PH_END()
        PH_BEGIN(9)
            phase_dispatch(lds, WSP(int, WS_TOK + TOK_BLKCNT), WSP(int, WS_TOK + TOK_E), WSP(int, WS_TOK + TOK_LR), WSP(int, WS_TOK + TOK_ROW), WSP(int, WS_TOK + TOK_TAB), WSP(bf16, WS_XBF), WSP(bf16, WS_XS), blk, tid, wave, lane);
        PH_END()
        PH_BEGIN(10)
            if (tid < 33) tabL[tid] = WSP(int, WS_TOK + TOK_TAB)[tid];
            __syncthreads();
            int sw_ = 0x7A7A7A7A, sx_ = 0x7F7F7F7F; asm volatile("" : "+s"(sw_), "+s"(sx_));
            pg8::Gemm g{WSP(bf16, WS_XS), WSP(bf16, WS_WGU), MOE_MAXROWS, NE * 2048, D / 2, sw_, sx_}; pg8::MoeOrder S{tabL, 8, G, blk, tabL[32] * 8};
            pg8::EpiSwiglu E{WSP(unsigned char, WS_HID), ka->in[13] + (size_t)l * NE * 1024, ka->in[15] + (size_t)l * NE * 1024};
            pg8::gemm_phase<pg8::EpiSwiglu, pg8::MoeOrder, true, true, true>(lds, g, S, E);
        PH_END()
        PH_BEGIN(11)
            if (tid < 33) tabL[tid] = WSP(int, WS_TOK + TOK_TAB)[tid];
            __syncthreads();
            int sw_ = 0x79797979, sx_ = 0x7F7F7F7F; asm volatile("" : "+s"(sw_), "+s"(sx_));
            pg8::Gemm g{WSP(bf16, WS_HID), WSP(bf16, WS_WD), MOE_MAXROWS, NE * 1024, D / 2, sw_, sx_}; pg8::MoeOrder S{tabL, 4, G, blk, tabL[32] * 4};
            pg8::EpiDown E{WSP(unsigned char, WS_XS), ka->in[17] + (size_t)l * NE * 1024};
            pg8::gemm_phase<pg8::EpiDown, pg8::MoeOrder, true, true, true>(lds, g, S, E);
        PH_END()
        PH_BEGIN(12)
            float* x2out = (l == DEPTH - 1) ? ka->out : nullptr;
            phase_ln2(WSP(unsigned char, WS_XS), WSP(int, WS_TOK + TOK_ROW), WSP(float, WS_TOK + TOK_W), ka->in[18] + l * D, ka->in[19] + l * D, x2out, WSP(bf16, WS_XBF), gw, NGW, lane);
            if (l + 1 < DEPTH) { constexpr int ln = l + 1, jn = ln >> 1; constexpr bool mn = (ln & 1) != 0;
                const float* win_src = mn ? ka->in[5] + (size_t)jn * D * NC_M : ka->in[2] + (size_t)jn * D * NC_H; const size_t moff = (size_t)ln * NE * 1024 * 1024;
                phase_weights((LAS float*)(lds + wave * 16384), gw, NGW, lane, win_src, mn ? NC_M : NC_H, ka->in[6] + (size_t)ln * D * 512, ka->in[7] + (size_t)ln * D * D,
                              ka->in[12] + moff, ka->in[14] + moff, ka->in[16] + moff, WSP(bf16, WS_WIN), WSP(bf16, WS_WKV), WSP(bf16, WS_WO), WSP(bf16, WS_WGU), WSP(bf16, WS_WD)); }
            if (l + 1 < DEPTH) PH_SEAM();
        PH_END_NOSEAM()
}
__global__ void __launch_bounds__(NTHR, 2) fwd_kernel(Args args) {
    extern __shared__ __attribute__((aligned(16))) unsigned char lds_raw[];
    LAS unsigned char* lds = (LAS unsigned char*)lds_raw;
    if (threadIdx.x < 4) ((LAS unsigned*)(lds + MISC_OFF))[threadIdx.x] = 0u;
    __syncthreads();
#if ONE_LAUNCH
    (void)xcd_barrier_post((unsigned*)(args.ws + WS_CTL) + CW_BAR, (volatile LAS unsigned*)(lds + MISC_OFF));
#endif
    { const int l = 0; (void)l;
    PH_BEGIN(0)
        cvt_rows_bf16(ka->in[0], WSP(bf16, WS_XBF), (size_t)T * D / 8, gtid, GTHREADS);
        cvt_rows_bf16(ka->in[1], WSP(bf16, WS_MEMBF), (size_t)512 * D / 8, gtid, GTHREADS);
    PH_END_NOSEAM() }
    layer_phases<0>(lds); layer_phases<1>(lds); layer_phases<2>(lds); layer_phases<3>(lds);
}

extern "C" void kernel_launch(void* const* d_in, const int* in_sizes, int n_in, void* d_out, int out_size, void* d_ws, size_t ws_size, hipStream_t stream) {
    static int ready = 0;
    if (ready == 0) {
        if (n_in != 20 || in_sizes[0] != T * D || out_size != T * D || ws_size < WS_END) { fprintf(stderr, "kernel_launch: unexpected shapes (n_in %d, in0 %d, out %d, ws %zu < %zu)\n", n_in, n_in > 0 ? in_sizes[0] : -1, out_size, ws_size, (size_t)WS_END); ready = -1; return; }
        if (hipFuncSetAttribute((const void*)fwd_kernel, hipFuncAttributeMaxDynamicSharedMemorySize, LDS_BYTES) != hipSuccess) { fprintf(stderr, "kernel_launch: hipFuncSetAttribute failed\n"); ready = -1; return; }
        int per_cu = 0;
        if (hipOccupancyMaxActiveBlocksPerMultiprocessor(&per_cu, (const void*)fwd_kernel, NTHR, LDS_BYTES) != hipSuccess || per_cu < 1) fprintf(stderr, "kernel_launch: occupancy query says %d\n", per_cu);
        (void)hipGetLastError();
        ready = 1;
    }
    if (ready < 0) return;
    if (hipMemsetAsync((char*)d_ws + WS_CTL, 0, CTL_ZERO_BYTES, stream) != hipSuccess) return;
    Args a{};
    for (int i = 0; i < 20; ++i) a.in[i] = (const float*)d_in[i];
    a.out = (float*)d_out; a.ws = (unsigned char*)d_ws;
    a.l_lo = 0; a.l_hi = DEPTH; a.ph_lo = 0; a.ph_hi = NPHASE;
    hipLaunchKernelGGL(fwd_kernel, dim3(GRID), dim3(NTHR), LDS_BYTES, stream, a);
}
```

```cpp
#include <hip/hip_runtime.h>
#include <cstdio>
#include <cstdint>
#include <cmath>
namespace pg8 {
#define PG8_LAS __attribute__((address_space(3)))
typedef unsigned short bf16_t;
typedef short bf16x8 __attribute__((ext_vector_type(8)));
typedef float f32x4 __attribute__((ext_vector_type(4)));
typedef unsigned u32x4 __attribute__((ext_vector_type(4)));
constexpr int BM = 256, BK = 64, HALF = 128, HTB = HALF * BK * 2  , STAGE_BYTES = 8 * HTB, NXCD = 8, WGM = 8;

__host__ __device__ __forceinline__ int lds_byte(int r, int c) { const int st = (r >> 4) * 2 + (c >> 5), rr = r & 15, cc = c & 31, ob = rr * 64 + cc * 2; return st * 1024 + (ob ^ (((ob >> 9) & 1) << 5)); }
__host__ __device__ __forceinline__ void stage_rc(int b, int& R, int& C) { const int st = b / 1024, sb = b % 1024, swz = sb ^ (((sb >> 9) & 1) << 5); R = (st >> 1) * 16 + swz / 64; C = (st & 1) * 32 + (swz % 64) / 2; }
__host__ __device__ __forceinline__ int perm32(int rho) { const int n = rho >> 4, i = rho & 15; return 8 * (i >> 2) + 4 * n + (i & 3); }

struct Unit { int pm, pn; };
struct Gemm { const bf16_t* A; const bf16_t* Bt; int M, N, K; int sw, sx; };
typedef int i32x8 __attribute__((ext_vector_type(8))); typedef int i32x4 __attribute__((ext_vector_type(4)));

struct StaticOrder {
    int nM, nN, nwg, G, c;
    __host__ __device__ void init(int M, int N, int G_, int c_) { nM = M / BM; nN = N / BM; nwg = nM * nN; G = G_; c = c_; }
    __host__ __device__ bool next(int i, Unit& u) const {
        const long L = (long)i * G + c; if (L >= nwg) return false;
        int wgid = (int)L; { const int q = nwg / NXCD, r = nwg % NXCD, xcd = wgid % NXCD, off = wgid / NXCD; wgid = (xcd < r ? xcd * (q + 1) : r * (q + 1) + (xcd - r) * q) + off; }
        const int nig = WGM * nN, gid = wgid / nig, fm = gid * WGM, gsz = (nM - fm) < WGM ? (nM - fm) : WGM;
        u.pm = fm + ((wgid % nig) % gsz); u.pn = (wgid % nig) / gsz; return true;
    }
    __device__ __forceinline__ void a_ready(const Unit&) const {}
    __device__ __forceinline__ void done(const Unit&) const {}
};

__device__ __forceinline__ unsigned cvt_pk_bf16(float lo, float hi) { unsigned r; asm volatile("v_cvt_pk_bf16_f32 %0, %1, %2" : "=v"(r) : "v"(lo), "v"(hi)); return r; }
typedef float f32x2 __attribute__((ext_vector_type(2)));
struct EpiPlain {
    static constexpr bool PERM = true, AFTER_DRAIN = false;
    bf16_t* O; int ldc; unsigned smask; float sc;
    __device__ __forceinline__ void operator()(const f32x4 (&acc)[2][2][4][2], const Unit& u, int wr, int wc, int fr, int fq) const {
        const int row0 = u.pm * BM + wr * 64 + fr; const int col0 = u.pn * BM + wc * 32 + 8 * fq; const float s = ((smask >> u.pn) & 1u) ? sc : 1.f;
#pragma unroll
        for (int ai = 0; ai < 2; ++ai)
#pragma unroll
            for (int m = 0; m < 4; ++m) { bf16_t* rowp = O + (size_t)(row0 + ai * HALF + m * 16) * ldc + col0;
#pragma unroll
                for (int bj = 0; bj < 2; ++bj) { const f32x4 v0 = acc[ai][bj][m][0] * s, v1 = acc[ai][bj][m][1] * s;
                    u32x4 w; w.x = cvt_pk_bf16(v0[0], v0[1]); w.y = cvt_pk_bf16(v0[2], v0[3]); w.z = cvt_pk_bf16(v1[0], v1[1]); w.w = cvt_pk_bf16(v1[2], v1[3]);
                    *(u32x4*)(rowp + bj * HALF) = w; } }
    }
};
__device__ __forceinline__ float swiglu1(float g, float u) {
    g = fminf(g, 7.0f); u = fminf(fmaxf(u, -7.0f), 7.0f);
    const float s = __builtin_amdgcn_rcpf(1.0f + __builtin_amdgcn_exp2f(g * (-1.702f * 1.4426950408889634f)));
    return g * s * (u + 1.0f);
}
__device__ __forceinline__ unsigned pk4_fp8e(float a, float b, float c, float d) { int w = 0; w = __builtin_amdgcn_cvt_pk_fp8_f32(a, b, w, false); w = __builtin_amdgcn_cvt_pk_fp8_f32(c, d, w, true); return (unsigned)w; }
struct EpiSwiglu {
    static constexpr bool PERM = true, AFTER_DRAIN = false;
    unsigned char* hid; const float* bg; const float* bu;
    __device__ __forceinline__ void operator()(const f32x4 (&acc)[2][2][4][2], const Unit& u, int wr, int wc, int fr, int fq) const {
        const int e = u.pn >> 3, pn = u.pn & 7;
        const int row0 = u.pm * BM + wr * 64 + fr; const int col0 = pn * 128 + wc * 32 + 8 * fq;
        const f32x4 g0 = *(const f32x4*)(bg + e * 1024 + col0), g1 = *(const f32x4*)(bg + e * 1024 + col0 + 4);
        const f32x4 u0 = *(const f32x4*)(bu + e * 1024 + col0), u1 = *(const f32x4*)(bu + e * 1024 + col0 + 4);
#pragma unroll
        for (int ai = 0; ai < 2; ++ai)
#pragma unroll
            for (int m = 0; m < 4; ++m) { unsigned char* rowp = hid + (size_t)(row0 + ai * HALF + m * 16) * 1024 + col0;
                const f32x4 ga = acc[ai][0][m][0] + g0, gb = acc[ai][0][m][1] + g1, ua = acc[ai][1][m][0] + u0, ub = acc[ai][1][m][1] + u1;
                typedef unsigned u32x2 __attribute__((ext_vector_type(2))); u32x2 w;
                w.x = pk4_fp8e(swiglu1(ga[0], ua[0]), swiglu1(ga[1], ua[1]), swiglu1(ga[2], ua[2]), swiglu1(ga[3], ua[3]));
                w.y = pk4_fp8e(swiglu1(gb[0], ub[0]), swiglu1(gb[1], ub[1]), swiglu1(gb[2], ub[2]), swiglu1(gb[3], ub[3]));
                *(u32x2*)rowp = w; }
    }
};
struct EpiDown {
    static constexpr bool PERM = true, AFTER_DRAIN = false;
    unsigned char* y; const float* bd;
    __device__ __forceinline__ void operator()(const f32x4 (&acc)[2][2][4][2], const Unit& u, int wr, int wc, int fr, int fq) const {
        const int e = u.pn >> 2, pn = u.pn & 3;
        const int row0 = u.pm * BM + wr * 64 + fr; const int col0 = pn * BM + wc * 32 + 8 * fq;
        f32x4 bv[2][2];
#pragma unroll
        for (int bj = 0; bj < 2; ++bj)
#pragma unroll
            for (int n = 0; n < 2; ++n) bv[bj][n] = *(const f32x4*)(bd + e * 1024 + col0 + bj * HALF + 4 * n);
#pragma unroll
        for (int ai = 0; ai < 2; ++ai)
#pragma unroll
            for (int m = 0; m < 4; ++m) { unsigned char* rowp = y + (size_t)(row0 + ai * HALF + m * 16) * 1024 + col0;
#pragma unroll
                for (int bj = 0; bj < 2; ++bj) { const f32x4 v0 = (acc[ai][bj][m][0] + bv[bj][0]) * 16.f, v1 = (acc[ai][bj][m][1] + bv[bj][1]) * 16.f;
                    typedef unsigned u32x2 __attribute__((ext_vector_type(2))); u32x2 w; w.x = pk4_fp8e(v0[0], v0[1], v0[2], v0[3]); w.y = pk4_fp8e(v1[0], v1[1], v1[2], v1[3]);
                    *(u32x2*)(rowp + bj * HALF) = w; } }
    }
};
struct MoeOrder {
    const PG8_LAS int* tab; int npn, G, c, nunits;
    __device__ __forceinline__ bool next(int i, Unit& u) const {
        const int tpx = 32 / npn, s = c >> 3, tile = (i * 8 + (c & 7)) * tpx + s / npn, pn = s % npn;
        if ((i * 8) * tpx >= nunits / npn) return false;
        if (tile >= nunits / npn) { u.pm = 0; u.pn = 0; return false; }
        int e = 0;
#pragma unroll
        for (int k = 1; k < 32; ++k) e += (tab[k] <= tile) ? 1 : 0;
        u.pm = tile; u.pn = __builtin_amdgcn_readfirstlane(e) * npn + pn; return true;
    }
    __device__ __forceinline__ void a_ready(const Unit&) const {}
    __device__ __forceinline__ void done(const Unit&) const {}
};
template <class Epi, class Sched, bool ALIGN_EPI = false, bool SP2 = false, bool F8 = false>
__device__ __forceinline__ void gemm_phase(PG8_LAS unsigned char* lds, const Gemm g, const Sched& S, const Epi& E) {
    int tid_ = threadIdx.x; asm volatile("" : "+v"(tid_));
    const int tid = tid_, wid = __builtin_amdgcn_readfirstlane(tid >> 6), lane = tid & 63, wr = wid >> 2, wc = wid & 3, fr = lane & 15, fq = lane >> 4;
    const int K = g.K, nt = K / BK;
    unsigned voffA, voffB;
    { int R, C; stage_rc(tid * 16, R, C); const int Rb = Epi::PERM ? ((R & ~31) + perm32(R & 31)) : R; voffA = (unsigned)(R * K + C) * 2u; voffB = (unsigned)(Rb * K + C) * 2u; }
    const unsigned qstep = 64u * (unsigned)K * 2u;
    const unsigned kstep = (unsigned)(BK * 2);
    const unsigned hstep = (unsigned)HALF * (unsigned)K * 2u;
    const unsigned tstep = 2u * hstep;
    const __amdgpu_buffer_rsrc_t rA = __builtin_amdgcn_make_buffer_rsrc((void*)g.A, 0, 0x7FFFFFFF, 0x00020000), rB = __builtin_amdgcn_make_buffer_rsrc((void*)g.Bt, 0, 0x7FFFFFFF, 0x00020000);
    const unsigned ldsw = (unsigned)wid * 1024u;
    const int aoff = lds_byte(wr * 64 + fr, fq * 8), boff = lds_byte(wc * 32 + fr, fq * 8);
#define PG8_SA(b, h) (((b) * 2 + (h)) * HTB)
#define PG8_SB(b, h) ((4 + (b) * 2 + (h)) * HTB)
#define PG8_STG(bufoff, rsrc, soff, voff) do { _Pragma("unroll") for (int _i = 0; _i < 2; ++_i) \
        __builtin_amdgcn_raw_ptr_buffer_load_lds((rsrc), (PG8_LAS void*)(lds + (bufoff) + ldsw + _i * 8192), 16, (int)(voff), (int)((soff) + (unsigned)_i * qstep), 0, 0); } while (0)
#define PG8_STGA(bufoff, soff) PG8_STG(bufoff, rA, soff, voffA)
#define PG8_STGB(bufoff, soff) PG8_STG(bufoff, rB, soff, voffB)
#define PG8_LDA(dst, b, h) do { _Pragma("unroll") for (int m = 0; m < 4; ++m) { if constexpr (F8) { const i32x4 lo_ = *(const PG8_LAS i32x4*)(lds + PG8_SA(b, h) + aoff + m * 2048), hi_ = *(const PG8_LAS i32x4*)(lds + PG8_SA(b, h) + aoff + m * 2048 + 1024); \
            dst##_8[m] = __builtin_shufflevector(lo_, hi_, 0, 1, 2, 3, 4, 5, 6, 7); } else { _Pragma("unroll") for (int k = 0; k < 2; ++k) dst[m][k] = *(const PG8_LAS bf16x8*)(lds + PG8_SA(b, h) + aoff + m * 2048 + k * 1024); } } } while (0)
#define PG8_LDB(dst, b, h) do { _Pragma("unroll") for (int n = 0; n < 2; ++n) { if constexpr (F8) { const i32x4 lo_ = *(const PG8_LAS i32x4*)(lds + PG8_SB(b, h) + boff + n * 2048), hi_ = *(const PG8_LAS i32x4*)(lds + PG8_SB(b, h) + boff + n * 2048 + 1024); \
            dst##_8[n] = __builtin_shufflevector(lo_, hi_, 0, 1, 2, 3, 4, 5, 6, 7); } else { _Pragma("unroll") for (int k = 0; k < 2; ++k) dst[n][k] = *(const PG8_LAS bf16x8*)(lds + PG8_SB(b, h) + boff + n * 2048 + k * 1024); } } } while (0)
#define PG8_MMA(ai, bj, At, Bt) do { __builtin_amdgcn_s_setprio(1); _Pragma("unroll") for (int m = 0; m < 4; ++m) _Pragma("unroll") for (int n = 0; n < 2; ++n) { \
        if constexpr (F8) acc[ai][bj][m][n] = __builtin_amdgcn_mfma_scale_f32_16x16x128_f8f6f4(Bt##_8[n], At##_8[m], acc[ai][bj][m][n], 0, 0, 0, g.sw, 0, g.sx); \
        else { _Pragma("unroll") for (int k = 0; k < 2; ++k) acc[ai][bj][m][n] = __builtin_amdgcn_mfma_f32_16x16x32_bf16(Bt[n][k], At[m][k], acc[ai][bj][m][n], 0, 0, 0); } } \
        __builtin_amdgcn_s_setprio(0); } while (0)
#define PG8_WAIT_V(n) asm volatile("s_waitcnt vmcnt(" #n ")" ::: "memory")
#define PG8_WAIT_L(n) asm volatile("s_waitcnt lgkmcnt(" #n ")" ::: "memory")
#define PG8_BAR __builtin_amdgcn_s_barrier()
#define PG8_SCHED __builtin_amdgcn_sched_barrier(0)
    Unit cur, nxt; int ui = 0;
    if (!S.next(0, cur)) return;
    f32x4 acc[2][2][4][2];
#pragma unroll
    for (int a = 0; a < 2; ++a)
#pragma unroll
        for (int b = 0; b < 2; ++b)
#pragma unroll
            for (int m = 0; m < 4; ++m)
#pragma unroll
                for (int n = 0; n < 2; ++n) acc[a][b][m][n] = (f32x4){0.f, 0.f, 0.f, 0.f};
    bf16x8 At[4][2], B0[2][2], B1[2][2]; i32x8 At_8[4], B0_8[2], B1_8[2];
    unsigned cA = (unsigned)cur.pm * tstep, cB = (unsigned)cur.pn * tstep;
    S.a_ready(cur);
    if constexpr (SP2) {
        PG8_STGB(PG8_SB(0, 0), cB); PG8_STGB(PG8_SB(0, 1), cB + hstep); PG8_STGA(PG8_SA(0, 0), cA); PG8_STGA(PG8_SA(0, 1), cA + hstep);
        if (wr == 1) PG8_BAR;
        PG8_WAIT_V(2); PG8_BAR;
        PG8_STGB(PG8_SB(1, 0), cB + kstep); PG8_STGA(PG8_SA(1, 0), cA + kstep); PG8_STGB(PG8_SB(1, 1), cB + hstep + kstep);
        PG8_WAIT_V(6); PG8_BAR;
    } else {
        PG8_STGB(PG8_SB(0, 0), cB); PG8_STGA(PG8_SA(0, 0), cA); PG8_STGB(PG8_SB(0, 1), cB + hstep); PG8_STGA(PG8_SA(0, 1), cA + hstep);
        if (wr == 1) PG8_BAR;
        PG8_WAIT_V(4); PG8_BAR;
        PG8_STGB(PG8_SB(1, 0), cB + kstep); PG8_STGA(PG8_SA(1, 0), cA + kstep); PG8_STGB(PG8_SB(1, 1), cB + hstep + kstep);
        PG8_WAIT_V(6); PG8_BAR;
    }
    for (;;) {
        const bool has_next = S.next(ui + 1, nxt);
        const unsigned nA = has_next ? (unsigned)nxt.pm * tstep : cA, nB = has_next ? (unsigned)nxt.pn * tstep : cB;
#pragma unroll 1
        for (int t = 0; t < nt; t += 2) {
            const bool last = (t == nt - 2);
            const unsigned a1 = cA + (unsigned)(t + 1) * kstep;
            const unsigned a2 = last ? nA : cA + (unsigned)(t + 2) * kstep, b2 = last ? nB : cB + (unsigned)(t + 2) * kstep;
            const unsigned a3 = a2 + kstep, b3 = b2 + kstep;
            if (last && has_next) S.a_ready(nxt);
            if constexpr (SP2) {
            PG8_LDB(B0, 0, 0); PG8_LDB(B1, 0, 1); PG8_SCHED; PG8_LDA(At, 0, 0); PG8_STGA(PG8_SA(1, 1), a1 + hstep);
            PG8_WAIT_V(8); PG8_WAIT_L(0); PG8_BAR; PG8_MMA(0, 0, At, B0); PG8_MMA(0, 1, At, B1); PG8_BAR; PG8_SCHED;
            PG8_LDA(At, 0, 1); PG8_STGB(PG8_SB(0, 0), b2); PG8_STGB(PG8_SB(0, 1), b2 + hstep); PG8_STGA(PG8_SA(0, 0), a2);
            PG8_WAIT_V(8); PG8_WAIT_L(0); PG8_BAR; PG8_MMA(1, 0, At, B0); PG8_MMA(1, 1, At, B1); PG8_BAR; PG8_SCHED;
            PG8_LDB(B0, 1, 0); PG8_LDB(B1, 1, 1); PG8_SCHED; PG8_LDA(At, 1, 0); PG8_STGA(PG8_SA(0, 1), a2 + hstep);
            PG8_WAIT_V(8); PG8_WAIT_L(0); PG8_BAR; PG8_MMA(0, 0, At, B0); PG8_MMA(0, 1, At, B1); PG8_BAR; PG8_SCHED;
            PG8_LDA(At, 1, 1); PG8_STGB(PG8_SB(1, 0), b3); PG8_STGB(PG8_SB(1, 1), b3 + hstep); PG8_STGA(PG8_SA(1, 0), a3);
            PG8_WAIT_V(8); PG8_WAIT_L(0); PG8_BAR; PG8_MMA(1, 0, At, B0); PG8_MMA(1, 1, At, B1); PG8_BAR; PG8_SCHED;
            } else {
            PG8_LDB(B0, 0, 0); PG8_SCHED; PG8_LDA(At, 0, 0); PG8_STGA(PG8_SA(1, 1), a1 + hstep);
            PG8_WAIT_L(8); PG8_BAR; PG8_WAIT_L(0); PG8_MMA(0, 0, At, B0); PG8_BAR; PG8_SCHED;
            PG8_LDB(B1, 0, 1); PG8_STGB(PG8_SB(0, 0), b2);
            PG8_BAR; PG8_WAIT_L(0); PG8_MMA(0, 1, At, B1); PG8_BAR;
            PG8_LDA(At, 0, 1); PG8_STGA(PG8_SA(0, 0), a2);
            PG8_BAR; PG8_WAIT_L(0); PG8_MMA(1, 0, At, B0); PG8_BAR; PG8_SCHED;
            PG8_STGB(PG8_SB(0, 1), b2 + hstep);
            PG8_WAIT_V(6); PG8_BAR; PG8_MMA(1, 1, At, B1); PG8_BAR;
            PG8_LDB(B0, 1, 0); PG8_SCHED; PG8_LDA(At, 1, 0); PG8_STGA(PG8_SA(0, 1), a2 + hstep);
            PG8_WAIT_L(8); PG8_BAR; PG8_WAIT_L(0); PG8_MMA(0, 0, At, B0); PG8_BAR; PG8_SCHED;
            PG8_LDB(B1, 1, 1); PG8_STGB(PG8_SB(1, 0), b3);
            PG8_BAR; PG8_WAIT_L(0); PG8_MMA(0, 1, At, B1); PG8_BAR;
            PG8_LDA(At, 1, 1); PG8_STGA(PG8_SA(1, 0), a3);
            PG8_BAR; PG8_WAIT_L(0); PG8_MMA(1, 0, At, B0); PG8_BAR; PG8_SCHED;
            PG8_STGB(PG8_SB(1, 1), b3 + hstep);
            PG8_WAIT_V(6); PG8_BAR; PG8_MMA(1, 1, At, B1); PG8_BAR;
            }
        }
        if constexpr (ALIGN_EPI) { if (wr == 0) PG8_BAR; }
        if constexpr (!Epi::AFTER_DRAIN) { int t2_ = threadIdx.x; asm volatile("" : "+v"(t2_)); E(acc, cur, wr, wc, t2_ & 15, (t2_ & 63) >> 4); S.done(cur); }
        if (!has_next) break;
#pragma unroll
        for (int a = 0; a < 2; ++a)
#pragma unroll
            for (int b = 0; b < 2; ++b)
#pragma unroll
                for (int m = 0; m < 4; ++m)
#pragma unroll
                    for (int n = 0; n < 2; ++n) acc[a][b][m][n] = (f32x4){0.f, 0.f, 0.f, 0.f};
        cur = nxt; cA = nA; cB = nB; ++ui;
        if constexpr (ALIGN_EPI) { if (wr == 1) PG8_BAR; }
    }
    PG8_WAIT_V(0);
    if constexpr (!ALIGN_EPI) { if (wr == 0) PG8_BAR; }
    PG8_BAR;
    if constexpr (Epi::AFTER_DRAIN) { E.fused(acc, cur, wr, wc, fr, fq, lds, wid, lane); S.done(cur); }
#undef PG8_SA
#undef PG8_SB
#undef PG8_STG
#undef PG8_STGA
#undef PG8_STGB
#undef PG8_LDA
#undef PG8_LDB
#undef PG8_MMA
#undef PG8_WAIT_V
#undef PG8_WAIT_L
#undef PG8_BAR
#undef PG8_SCHED
}
}

constexpr int NWAVES = 8, NTHR = 512, GRID = 256;
constexpr int NBATCH = 2, SEQ = 16384, T = NBATCH * SEQ, D = 1024, DEPTH = 4;
constexpr int MIXW = 768, NC_H = 3328, NC_M = 2560;
constexpr int HG_H = 6;
constexpr int HSEG = 256, HNSEG = SEQ / HSEG;
constexpr int MB_H = 12, MB_NB = 64;
constexpr int NE = 32;
constexpr float DN_ALPHA = 1.6817928305074290f;
constexpr int MOE_MAXROWS = T * 4 + NE * 256;
#ifndef ONE_LAUNCH
#define ONE_LAUNCH 1
#endif
constexpr int NPHASE = 13;

constexpr size_t MiB = 1u << 20;
constexpr size_t WS_CTL = 0, CTL_ZERO_BYTES = 1 * MiB;
constexpr size_t WS_WIN = 1 * MiB, WS_WKV = 9 * MiB, WS_WO = 10 * MiB, WS_WGU = 12 * MiB, WS_WD = 140 * MiB;
constexpr size_t WS_XBF = 204 * MiB, WS_WKV4 = 268 * MiB  , WS_KV4 = 272 * MiB  , WS_WRS = 280 * MiB  , WS_MEMBF = 524 * MiB;
constexpr size_t WS_H = 526 * MiB, WS_MIX = 734 * MiB, WS_Y = 798 * MiB, WS_SLOC = 862 * MiB, WS_DSEG = 910 * MiB, WS_KMEAN = 911 * MiB;
constexpr size_t WS_SELINFO = 912 * MiB, WS_TOK = 914 * MiB, WS_R1 = 918 * MiB;
constexpr size_t WS_LIST = WS_R1, WS_PML = WS_R1 + 96 * MiB, WS_PO = WS_R1 + 108 * MiB;
constexpr size_t WS_XS = WS_R1, WS_HID = WS_R1 + 272 * MiB;
constexpr size_t WS_END = WS_R1 + 544 * MiB;
static_assert((size_t)MOE_MAXROWS * 1024 * 2 <= 272 * MiB, "moe rows");
static_assert((size_t)T * MB_H * 4 * 64 * 4 <= 384 * MiB && (size_t)24 * 64 * 16384 * 4 <= 96 * MiB, "moba bufs");
constexpr size_t TOK_E = 0, TOK_LR = 512 * 1024, TOK_W = 1024 * 1024, TOK_ROW = 1536 * 1024, TOK_BLKCNT = 2048 * 1024, TOK_TAB = 2048 * 1024 + 65536;
constexpr int CW_BAR = 4096, CW_GCOUNT = 8192;

constexpr int RING_BYTES = 131072, LDS_BYTES = 147456, MISC_OFF = LDS_BYTES - 1024;

#define GAS __attribute__((address_space(1)))
#define LAS __attribute__((address_space(3)))
typedef unsigned short bf16;
typedef unsigned v4u __attribute__((ext_vector_type(4)));
typedef unsigned v2u __attribute__((ext_vector_type(2)));
typedef float f32x4 __attribute__((ext_vector_type(4)));
typedef float f32x2 __attribute__((ext_vector_type(2)));
typedef short s16x8 __attribute__((ext_vector_type(8)));
typedef float f32x16 __attribute__((ext_vector_type(16)));
typedef float f32x2_t __attribute__((ext_vector_type(2))); typedef __bf16 bf16x2_t __attribute__((ext_vector_type(2)));
__device__ __forceinline__ unsigned cvtpk(float lo, float hi) { f32x2_t v = {lo, hi}; bf16x2_t b = __builtin_convertvector(v, bf16x2_t); return __builtin_bit_cast(unsigned, b); }
#define LDS_WAIT() asm volatile("s_waitcnt lgkmcnt(0)" ::: "memory")
__device__ __forceinline__ unsigned f2bf(float f) { unsigned u = __builtin_bit_cast(unsigned, f); return (u + 0x7fffu + ((u >> 16) & 1u)) >> 16; }
__device__ __forceinline__ unsigned pk2(float lo, float hi) { return f2bf(lo) | (f2bf(hi) << 16); }
__device__ __forceinline__ float bflo(unsigned w) { return __builtin_bit_cast(float, w << 16); }
__device__ __forceinline__ float bfhi(unsigned w) { return __builtin_bit_cast(float, w & 0xffff0000u); }
__device__ __forceinline__ float bf2f(bf16 h) { return __builtin_bit_cast(float, (unsigned)h << 16); }
__device__ __forceinline__ float sigmoidf_(float z) { return __builtin_amdgcn_rcpf(1.0f + __builtin_amdgcn_exp2f(-1.4426950408889634f * z)); }
template <int X> __device__ __forceinline__ float xorf(float v) { return __builtin_bit_cast(float, __builtin_amdgcn_ds_swizzle(__builtin_bit_cast(int, v), (X << 10) | 0x1F)); }
template <int X> __device__ __forceinline__ int xori(int v) { return __builtin_amdgcn_ds_swizzle(v, (X << 10) | 0x1F); }
__device__ __forceinline__ float wave_sum(float v) {
    v += xorf<1>(v); v += xorf<2>(v); v += xorf<4>(v); v += xorf<8>(v); v += xorf<16>(v);
    return __builtin_bit_cast(float, __builtin_amdgcn_readlane(__builtin_bit_cast(int, v), 0)) + __builtin_bit_cast(float, __builtin_amdgcn_readlane(__builtin_bit_cast(int, v), 32));
}
__device__ __forceinline__ float wave_max(float v) {
    v = fmaxf(v, xorf<1>(v)); v = fmaxf(v, xorf<2>(v)); v = fmaxf(v, xorf<4>(v)); v = fmaxf(v, xorf<8>(v)); v = fmaxf(v, xorf<16>(v));
    return fmaxf(__builtin_bit_cast(float, __builtin_amdgcn_readlane(__builtin_bit_cast(int, v), 0)), __builtin_bit_cast(float, __builtin_amdgcn_readlane(__builtin_bit_cast(int, v), 32)));
}
__device__ __forceinline__ float xor32f(float v, int lane) { return __builtin_bit_cast(float, __builtin_amdgcn_ds_bpermute((lane ^ 32) << 2, __builtin_bit_cast(int, v))); }
#define XB_TMO      128
#define XB_XCNT(j)  (256  + 64 * (j))
#define XB_XSUB(j)  (1280 + 64 * (j))
#define XB_XGEN(j)  (2304 + 64 * (j))
#define XB_TOP      3328
#define XB_TOPGEN   3392
#define XCD_BAR_WORDS 3456
#define XB_SPIN_CAP (1u << 18)

__device__ __forceinline__ unsigned xb_ld(unsigned* p)              { return __hip_atomic_load(p, __ATOMIC_RELAXED, __HIP_MEMORY_SCOPE_AGENT); }
__device__ __forceinline__ unsigned xb_add(unsigned* p, unsigned v) { return __hip_atomic_fetch_add(p, v, __ATOMIC_RELAXED, __HIP_MEMORY_SCOPE_AGENT); }
__device__ __forceinline__ unsigned xb_xcc_id() { return (unsigned)__builtin_amdgcn_s_getreg((3 << 11) | 20) & 0xFu; }
#define XB_SPIN(cond, bar) do { unsigned _sp = 0; while (cond) { __builtin_amdgcn_s_sleep(1); \
    if ((++_sp & 255u) == 0u) { if (xb_ld(&(bar)[XB_TMO])) break; if (_sp > XB_SPIN_CAP) { atomicAdd(&(bar)[XB_TMO], 1u); break; } } } } while (0)

struct XcdBarrier {
    unsigned* bar; unsigned x;
    volatile LAS unsigned* st;
};

__device__ __forceinline__ XcdBarrier xcd_barrier_post(unsigned* bar, volatile LAS unsigned* st) {
    XcdBarrier b; b.bar = bar; b.x = xb_xcc_id(); b.st = st;
    if (threadIdx.x == 0) (void)xb_add(&bar[XB_XCNT(b.x)], 1u);
    return b;
}
__device__ __forceinline__ void xcd_barrier_complete(unsigned* bar, unsigned x, unsigned& nloc, unsigned& nx) {
    const unsigned G = gridDim.x * gridDim.y * gridDim.z;
    unsigned sum, cnt, mine, sp = 0u;
    for (;;) {
        sum = 0u; cnt = 0u; mine = 0u;
#pragma unroll
        for (unsigned j = 0; j < 16; ++j) { const unsigned c = xb_ld(&bar[XB_XCNT(j)]); sum += c; cnt += (c > 0u) ? 1u : 0u; mine = (j == x) ? c : mine; }
        if (sum == G) break;
        __builtin_amdgcn_s_sleep(1);
        if ((++sp & 255u) == 0u) { if (xb_ld(&bar[XB_TMO])) break; if (sp > XB_SPIN_CAP) { atomicAdd(&bar[XB_TMO], 1u); break; } }
    }
    nloc = mine > 0u ? mine : 1u; nx = cnt > 0u ? cnt : 1u;
}

__device__ __forceinline__ void xcd_barrier(const XcdBarrier& b) {
    asm volatile("s_waitcnt vmcnt(0)" ::: "memory");
    __syncthreads();
    if (threadIdx.x == 0) {
        unsigned* bar = b.bar;
        __builtin_amdgcn_s_waitcnt(0);
        unsigned nloc = b.st[0], nx = b.st[1];
        if (nloc == 0u) { xcd_barrier_complete(bar, b.x, nloc, nx); b.st[0] = nloc; b.st[1] = nx; }
        const unsigned old = xb_add(&bar[XB_XSUB(b.x)], 1u);
        const unsigned gen = old / nloc;
        if (old + 1u == (gen + 1u) * nloc) {
            __builtin_amdgcn_fence(__ATOMIC_RELEASE, "agent");
            asm volatile("s_waitcnt vmcnt(0)" ::: "memory");
            const unsigned og = xb_add(&bar[XB_TOP], 1u);
            const unsigned tg = og / nx;
            if (og + 1u == (tg + 1u) * nx) xb_add(&bar[XB_TOPGEN], 1u);
            else XB_SPIN(xb_ld(&bar[XB_TOPGEN]) == tg, bar);
            __builtin_amdgcn_fence(__ATOMIC_ACQUIRE, "agent");
            xb_add(&bar[XB_XGEN(b.x)], 1u);
            asm volatile("s_waitcnt vmcnt(0)" ::: "memory");
        } else {
            XB_SPIN(xb_ld(&bar[XB_XGEN(b.x)]) == gen, bar);
            __builtin_amdgcn_fence(__ATOMIC_ACQUIRE, "agent");
            asm volatile("s_waitcnt vmcnt(0)" ::: "memory");
        }
    }
    __syncthreads();
}

__device__ __forceinline__ void cvt_rows_bf16(const float* src, bf16* dst, size_t n8, size_t gtid, size_t gthreads) {
    for (size_t i = gtid; i < n8; i += gthreads) { const f32x4 a = ((const f32x4*)src)[2 * i], b = ((const f32x4*)src)[2 * i + 1];
        v4u o; o.x = pk2(a.x, a.y); o.y = pk2(a.z, a.w); o.z = pk2(b.x, b.y); o.w = pk2(b.z, b.w); ((v4u*)dst)[i] = o; }
}
__device__ __forceinline__ void transpose_item(const float* W, int N, bf16* WT, int dst_row0, LAS float* scr, int k0, int n0, int lane) {
#pragma unroll 8
    for (int i = 0; i < 32; ++i) { const int kk = 2 * i + (lane >> 5); scr[kk * 33 + (lane & 31)] = W[(size_t)(k0 + kk) * N + n0 + (lane & 31)]; }
    LDS_WAIT(); asm volatile("" ::: "memory");
    const int c = lane & 7;
#pragma unroll
    for (int j = 0; j < 4; ++j) { const int n = (lane >> 3) + 8 * j; const LAS float* s = scr + (8 * c) * 33 + n;
        v4u o; o.x = pk2(s[0 * 33], s[1 * 33]); o.y = pk2(s[2 * 33], s[3 * 33]); o.z = pk2(s[4 * 33], s[5 * 33]); o.w = pk2(s[6 * 33], s[7 * 33]);
        *(v4u*)(WT + (size_t)(dst_row0 + n) * 1024 + k0 + 8 * c) = o; }
    LDS_WAIT(); asm volatile("" ::: "memory");
}
__device__ __forceinline__ unsigned pk4_fp8(float a, float b, float c, float d) { int w = 0; w = __builtin_amdgcn_cvt_pk_fp8_f32(a, b, w, false); w = __builtin_amdgcn_cvt_pk_fp8_f32(c, d, w, true); return (unsigned)w; }
__device__ __forceinline__ void transpose_item_f8(const float* W, int N, unsigned char* WT8, int dst_row0, LAS float* scr, int k0, int n0, int lane, float wscale) {
#pragma unroll 8
    for (int i = 0; i < 32; ++i) { const int kk = 2 * i + (lane >> 5); scr[kk * 33 + (lane & 31)] = W[(size_t)(k0 + kk) * N + n0 + (lane & 31)]; }
    LDS_WAIT(); asm volatile("" ::: "memory");
    const int c = lane & 7;
#pragma unroll
    for (int j = 0; j < 4; ++j) { const int n = (lane >> 3) + 8 * j; const LAS float* s = scr + (8 * c) * 33 + n;
        v2u o; o.x = pk4_fp8(s[0 * 33] * wscale, s[1 * 33] * wscale, s[2 * 33] * wscale, s[3 * 33] * wscale); o.y = pk4_fp8(s[4 * 33] * wscale, s[5 * 33] * wscale, s[6 * 33] * wscale, s[7 * 33] * wscale);
        *(v2u*)(WT8 + (size_t)(dst_row0 + n) * 1024 + k0 + 8 * c) = o; }
    LDS_WAIT(); asm volatile("" ::: "memory");
}
__device__ __forceinline__ void phase_weights(LAS float* scr, int gw, int ngw, int lane, const float* win_src, int NC, const float* wkv_src, int nkv, const float* wo_src,
                                              const float* wg_src, const float* wu_src, const float* wd_src, bf16* win_t, bf16* wkv_t, bf16* wo_t, bf16* wgu_t, bf16* wd_t) {
    const int nbw = NC / 32, nWin = nbw * 16, NIT = nWin + 256 * nkv + 512 + NE * 1536;
    for (int it = gw; it < NIT; it += ngw) {
        int r = it;
        if (r < nWin) { const int kb = r / nbw, nb = r - kb * nbw; transpose_item(win_src, NC, win_t, 32 * nb, scr, 64 * kb, 32 * nb, lane); continue; } r -= nWin;
        if (r < 256 * nkv) { const int lay = r >> 8, rr = r & 255, kb = rr >> 4, nb = rr & 15; transpose_item(wkv_src + (size_t)lay * D * 512, 512, wkv_t + (size_t)lay * 512 * 1024, 32 * nb, scr, 64 * kb, 32 * nb, lane); continue; } r -= 256 * nkv;
        if (r < 512) { const int kb = r >> 5, nb = r & 31; transpose_item(wo_src, 1024, wo_t, 32 * nb, scr, 64 * kb, 32 * nb, lane); continue; } r -= 512;
        const int e = r / 1536, q = r - e * 1536, which = q >> 9, rr = q & 511, kb = rr >> 5, nb = rr & 31, n0 = 32 * nb;
        const size_t eoff = (size_t)e * 1024 * 1024;
        if (which == 0) transpose_item_f8(wg_src + eoff, 1024, (unsigned char*)wgu_t + 2 * eoff, (n0 >> 7) * 256 + (n0 & 127), scr, 64 * kb, n0, lane, 32.f);
        else if (which == 1) transpose_item_f8(wu_src + eoff, 1024, (unsigned char*)wgu_t + 2 * eoff, (n0 >> 7) * 256 + 128 + (n0 & 127), scr, 64 * kb, n0, lane, 32.f);
        else transpose_item_f8(wd_src + eoff, 1024, (unsigned char*)wd_t + eoff, n0, scr, 64 * kb, n0, lane, 64.f);
    }
}

template <bool OUT>
__device__ __forceinline__ void hgrn_seg(LAS unsigned char* lds, const bf16* h, const float* lbl, int j, const float* normg, float* Sloc, float* Dseg, bf16* mix, int unit, int tid, int wave, int lane) {
    const int seg = unit & (HNSEG - 1), bh = unit >> 6, hh = bh % HG_H, b = bh / HG_H;
    const int v = tid & 127, dg = tid >> 7;
    LAS float* fgs = (LAS float*)lds; LAS float* vs = fgs + 4096; LAS float* qs = vs + 4096; LAS float* op = qs + 4096;
    f32x2 st[16];
    float* Sp = Sloc + (size_t)unit * 16384 + (size_t)(dg * 32) * 128 + v;
#pragma unroll
    for (int dd = 0; dd < 16; ++dd) { st[dd].x = OUT ? Sp[(2 * dd) * 128] : 0.f; st[dd].y = OUT ? Sp[(2 * dd + 1) * 128] : 0.f; }
    float dprod = 1.f;
    const int stok = tid >> 4, c8 = (tid & 15) * 8;
    float lb[8];
#pragma unroll
    for (int i = 0; i < 8; ++i) { lb[i] = 0.f; if (j > 0) { const float a0 = lbl[hh * 128 + c8 + i], a1 = lbl[MIXW + hh * 128 + c8 + i]; lb[i] = 1.f / (1.f + __expf(a0 - a1)); } }
    for (int ch = 0; ch < HSEG / 32; ++ch) {
        const size_t t0 = (size_t)b * SEQ + seg * HSEG + ch * 32;
        { const bf16* row = h + (t0 + stok) * NC_H + hh * 128 + c8;
          const v4u f8 = *(const v4u*)(row + 768), i8 = *(const v4u*)(row + 1536); v4u q8 = {0u, 0u, 0u, 0u}; if (OUT) q8 = *(const v4u*)row;
#pragma unroll
          for (int w = 0; w < 4; ++w) { const float f0 = bflo(f8[w]), f1 = bfhi(f8[w]); const int o = stok * 128 + c8 + 2 * w;
              fgs[o] = lb[2 * w] + (1.f - lb[2 * w]) * sigmoidf_(f0); fgs[o + 1] = lb[2 * w + 1] + (1.f - lb[2 * w + 1]) * sigmoidf_(f1);
              vs[o] = bflo(i8[w]); vs[o + 1] = bfhi(i8[w]);
              if (OUT) { const float q0 = bflo(q8[w]), q1 = bfhi(q8[w]); qs[o] = q0 * sigmoidf_(q0); qs[o + 1] = q1 * sigmoidf_(q1); } } }
        __syncthreads();
        if (!OUT) { if (tid < 128) { for (int tt = 0; tt < 32; ++tt) dprod *= fgs[tt * 128 + tid]; } }
        f32x4 fA[8], qA[8], fB[8], qB[8]; float vA, vB;
#define HG_LOAD(F, Q, V, tt_) do { V = vs[(tt_) * 128 + v]; _Pragma("unroll") for (int d4 = 0; d4 < 8; ++d4) { F[d4] = *(const LAS f32x4*)(fgs + (tt_) * 128 + dg * 32 + d4 * 4); \
            if (OUT) Q[d4] = *(const LAS f32x4*)(qs + (tt_) * 128 + dg * 32 + d4 * 4); } } while (0)
#define HG_STEP(F, Q, V, tt_) do { const f32x2 vv2 = {V, V}; f32x2 acc2 = {0.f, 0.f}; _Pragma("unroll") for (int d4 = 0; d4 < 8; ++d4) { \
            const f32x2 fa = {F[d4].x, F[d4].y}, fb = {F[d4].z, F[d4].w}; \
            st[2 * d4] = fa * (st[2 * d4] - vv2) + vv2; st[2 * d4 + 1] = fb * (st[2 * d4 + 1] - vv2) + vv2; \
            if (OUT) { const f32x2 qa = {Q[d4].x, Q[d4].y}, qb = {Q[d4].z, Q[d4].w}; acc2 = qa * st[2 * d4] + acc2; acc2 = qb * st[2 * d4 + 1] + acc2; } } \
            if (OUT) op[(dg * 32 + (tt_)) * 128 + v] = acc2.x + acc2.y; } while (0)
        HG_LOAD(fA, qA, vA, 0);
#pragma unroll 1
        for (int tt = 0; tt < 32; tt += 2) {
            HG_LOAD(fB, qB, vB, tt + 1);
            __builtin_amdgcn_sched_barrier(0);
            HG_STEP(fA, qA, vA, tt);
            __builtin_amdgcn_sched_barrier(0);
            if (tt + 2 < 32) HG_LOAD(fA, qA, vA, tt + 2);
            __builtin_amdgcn_sched_barrier(0);
            HG_STEP(fB, qB, vB, tt + 1);
            __builtin_amdgcn_sched_barrier(0);
        }
#undef HG_LOAD
#undef HG_STEP
        if (OUT) {
            __syncthreads();
#pragma unroll
            for (int k = 0; k < 4; ++k) { const int tt = wave + 8 * k; float o0 = 0.f, o1 = 0.f;
#pragma unroll
                for (int g = 0; g < 4; ++g) { o0 += op[(g * 32 + tt) * 128 + lane]; o1 += op[(g * 32 + tt) * 128 + lane + 64]; }
                const float ms = wave_sum(o0 * o0 + o1 * o1) * (1.f / 128.f), r = 1.f / sqrtf(ms + 1e-6f);
                const bf16* grow = h + (t0 + tt) * NC_H + 2304 + hh * 128; const float g0 = bf2f(grow[lane]), g1 = bf2f(grow[lane + 64]);
                bf16* mrow = mix + (t0 + tt) * 1024 + hh * 128;
                mrow[lane] = (bf16)f2bf(o0 * r * normg[lane] * sigmoidf_(g0)); mrow[lane + 64] = (bf16)f2bf(o1 * r * normg[lane + 64] * sigmoidf_(g1)); }
        }
        __syncthreads();
    }
    if (!OUT) {
#pragma unroll
        for (int dd = 0; dd < 16; ++dd) { Sp[(2 * dd) * 128] = st[dd].x; Sp[(2 * dd + 1) * 128] = st[dd].y; }
        if (tid < 128) Dseg[(size_t)unit * 128 + tid] = dprod;
    }
}
constexpr int HG_G = 0, HG_QT = 32768, HG_KT = 50176, HG_KE = 67584, HG_VT = 86016, HG_ST = 104448, HG_GM = 139264, HG_GE = 139776, HG_PART = 140288;
static_assert(HG_PART + 2048 <= MISC_OFF, "HGRN LDS map");
__device__ __forceinline__ int crow16(int i, int hf) { return (i & 3) + 8 * (i >> 2) + 4 * hf; }
template <bool OUT>
__device__ __forceinline__ void hgrn_mfma(LAS unsigned char* lds, const bf16* h, const float* lbl, int j, const float* normg, float* Sloc, float* Dseg, bf16* mix, int unit, int tid, int wave, int lane) {
    const int seg = unit & (HNSEG - 1), bh = unit >> 6, hh = bh % HG_H, b = bh / HG_H;
    const int r = lane & 31, hf = lane >> 5, tr = wave & 1, vq = wave >> 1;
    LAS float* G = (LAS float*)(lds + HG_G); LAS float* GM = (LAS float*)(lds + HG_GM); LAS float* GE = (LAS float*)(lds + HG_GE); LAS float* PART = (LAS float*)(lds + HG_PART);
    const int stok = tid >> 3, c16 = (tid & 7) * 16, sperm = (stok & ~15) | (stok & 3) | ((stok & 4) << 1) | ((stok & 8) >> 1);
    const int cd = tid & 127, cpart = tid >> 7;
    float lb[16];
#pragma unroll
    for (int e = 0; e < 16; ++e) { lb[e] = 0.f; if (j > 0) { const float a0 = lbl[hh * 128 + c16 + e], a1 = lbl[MIXW + hh * 128 + c16 + e]; lb[e] = 1.f / (1.f + __expf(a0 - a1)); } }
    f32x16 S[2];
    float* Sp = Sloc + (size_t)unit * 16384 + 32 * vq + r;
#pragma unroll
    for (int dd = 0; dd < 2; ++dd)
#pragma unroll
        for (int i = 0; i < 16; ++i) S[dd][i] = OUT ? Sp[(32 * (2 * tr + dd) + crow16(i, hf)) * 128] : 0.f;
    float gsum = 0.f;
    for (int ch = 0; ch < HSEG / 64; ++ch) {
        const size_t t0 = (size_t)b * SEQ + seg * HSEG + ch * 64;
        float fg[16], qv[16]; v4u i8[2];
        { const bf16* row = h + (t0 + stok) * NC_H + hh * 128 + c16;
          const v4u f8[2] = {*(const v4u*)(row + 768), *(const v4u*)(row + 776)}; i8[0] = *(const v4u*)(row + 1536); i8[1] = *(const v4u*)(row + 1544);
          v4u q8[2] = {{0u, 0u, 0u, 0u}, {0u, 0u, 0u, 0u}}; if (OUT) { q8[0] = *(const v4u*)row; q8[1] = *(const v4u*)(row + 8); }
#pragma unroll
          for (int w = 0; w < 8; ++w) { const unsigned fw = f8[w >> 2][w & 3]; const float f0 = bflo(fw), f1 = bfhi(fw);
              fg[2 * w] = lb[2 * w] + (1.f - lb[2 * w]) * sigmoidf_(f0); fg[2 * w + 1] = lb[2 * w + 1] + (1.f - lb[2 * w + 1]) * sigmoidf_(f1);
              if (OUT) { const unsigned qw = q8[w >> 2][w & 3]; const float q0 = bflo(qw), q1 = bfhi(qw); qv[2 * w] = q0 * sigmoidf_(q0); qv[2 * w + 1] = q1 * sigmoidf_(q1); } else { qv[2 * w] = 0.f; qv[2 * w + 1] = 0.f; } }
#pragma unroll
          for (int e4 = 0; e4 < 4; ++e4) { f32x4 lg; lg.x = __builtin_amdgcn_logf(fg[4 * e4]); lg.y = __builtin_amdgcn_logf(fg[4 * e4 + 1]); lg.z = __builtin_amdgcn_logf(fg[4 * e4 + 2]); lg.w = __builtin_amdgcn_logf(fg[4 * e4 + 3]);
              *(LAS f32x4*)(G + stok * 128 + c16 + 4 * e4) = lg; } }
        __syncthreads();
        { float run = 0.f;
#pragma unroll
          for (int k = 0; k < 16; ++k) run += G[(16 * cpart + k) * 128 + cd];
          PART[cpart * 128 + cd] = run; }
        __syncthreads();
        { float run = 0.f;
#pragma unroll
          for (int pp = 0; pp < 3; ++pp) run += (pp < cpart) ? PART[pp * 128 + cd] : 0.f;
#pragma unroll
          for (int k = 0; k < 16; ++k) { run += G[(16 * cpart + k) * 128 + cd]; G[(16 * cpart + k) * 128 + cd] = run; }
          if (cpart == 1) GM[cd] = run;
          if (cpart == 3) { GE[cd] = run; gsum += run; } }
        __syncthreads();
        if (OUT) {
#pragma unroll
            for (int dd = 0; dd < 2; ++dd)
#pragma unroll
                for (int g4 = 0; g4 < 4; ++g4) { const int dbase = 32 * (2 * tr + dd) + 8 * g4 + 4 * hf; const f32x4 gm = *(const LAS f32x4*)(GM + dbase);
                    v2u w; w.x = cvtpk(S[dd][4 * g4] * __builtin_amdgcn_exp2f(gm.x), S[dd][4 * g4 + 1] * __builtin_amdgcn_exp2f(gm.y)); w.y = cvtpk(S[dd][4 * g4 + 2] * __builtin_amdgcn_exp2f(gm.z), S[dd][4 * g4 + 3] * __builtin_amdgcn_exp2f(gm.w));
                    *(LAS v2u*)(lds + HG_ST + (32 * vq + r) * 272 + dbase * 2) = w; }
        }
        { unsigned qt[8], kt[8];
#pragma unroll
          for (int e4 = 0; e4 < 4; ++e4) { const f32x4 gv = *(const LAS f32x4*)(G + stok * 128 + c16 + 4 * e4), gm = *(const LAS f32x4*)(GM + c16 + 4 * e4), ge = *(const LAS f32x4*)(GE + c16 + 4 * e4);
              float ke[4];
#pragma unroll
              for (int e = 0; e < 4; ++e) { const float kk = 1.f - fg[4 * e4 + e]; ke[e] = kk * __builtin_amdgcn_exp2f(ge[e] - gv[e]);
                  if (OUT) { const float a = qv[4 * e4 + e] * __builtin_amdgcn_exp2f(gv[e] - gm[e]), c = kk * __builtin_amdgcn_exp2f(gm[e] - gv[e]);
                      if (e & 1) { qt[2 * e4 + (e >> 1)] |= f2bf(a) << 16; kt[2 * e4 + (e >> 1)] |= f2bf(c) << 16; } else { qt[2 * e4 + (e >> 1)] = f2bf(a); kt[2 * e4 + (e >> 1)] = f2bf(c); } } }
#pragma unroll
              for (int e = 0; e < 4; ++e) { const int col = c16 + 4 * e4 + e;
                  *(LAS bf16*)(lds + HG_KE + col * 144 + sperm * 2) = (bf16)f2bf(ke[e]);
                  const unsigned vw = i8[e4 >> 1][(2 * e4 + (e >> 1)) & 3]; *(LAS bf16*)(lds + HG_VT + col * 144 + sperm * 2) = (bf16)((e & 1) ? (vw >> 16) : (vw & 0xffffu)); } }
          if (OUT) { *(LAS v4u*)(lds + HG_QT + stok * 272 + c16 * 2) = (v4u){qt[0], qt[1], qt[2], qt[3]}; *(LAS v4u*)(lds + HG_QT + stok * 272 + c16 * 2 + 16) = (v4u){qt[4], qt[5], qt[6], qt[7]};
                     *(LAS v4u*)(lds + HG_KT + stok * 272 + c16 * 2) = (v4u){kt[0], kt[1], kt[2], kt[3]}; *(LAS v4u*)(lds + HG_KT + stok * 272 + c16 * 2 + 16) = (v4u){kt[4], kt[5], kt[6], kt[7]}; } }
        __syncthreads();
        if (OUT) {
            f32x16 X0, X1, O;
#pragma unroll
            for (int i = 0; i < 16; ++i) { X0[i] = 0.f; X1[i] = 0.f; O[i] = 0.f; }
            const LAS unsigned char* qtp = lds + HG_QT + (32 * tr + r) * 272 + hf * 16;
#pragma unroll
            for (int ks = 0; ks < 8; ++ks) { const s16x8 bq = *(const LAS s16x8*)(qtp + ks * 32);
                const s16x8 a0 = *(const LAS s16x8*)(lds + HG_KT + r * 272 + hf * 16 + ks * 32); X0 = __builtin_amdgcn_mfma_f32_32x32x16_bf16(a0, bq, X0, 0, 0, 0);
                if (tr == 1) { const s16x8 a1 = *(const LAS s16x8*)(lds + HG_KT + (32 + r) * 272 + hf * 16 + ks * 32); X1 = __builtin_amdgcn_mfma_f32_32x32x16_bf16(a1, bq, X1, 0, 0, 0); } }
#pragma unroll
            for (int i = 0; i < 16; ++i) { const bool keep = crow16(i, hf) <= r; if (tr == 0) X0[i] = keep ? X0[i] : 0.f; else X1[i] = keep ? X1[i] : 0.f; }
            const LAS unsigned char* vtp = lds + HG_VT + (32 * vq + r) * 144 + hf * 16;
#pragma unroll
            for (int s2 = 0; s2 < 2; ++s2) { v4u pw; pw.x = cvtpk(X0[8 * s2], X0[8 * s2 + 1]); pw.y = cvtpk(X0[8 * s2 + 2], X0[8 * s2 + 3]); pw.z = cvtpk(X0[8 * s2 + 4], X0[8 * s2 + 5]); pw.w = cvtpk(X0[8 * s2 + 6], X0[8 * s2 + 7]);
                const s16x8 bv = *(const LAS s16x8*)(vtp + (16 * s2) * 2); O = __builtin_amdgcn_mfma_f32_32x32x16_bf16(__builtin_bit_cast(s16x8, pw), bv, O, 0, 0, 0); }
            if (tr == 1) {
#pragma unroll
                for (int s2 = 0; s2 < 2; ++s2) { v4u pw; pw.x = cvtpk(X1[8 * s2], X1[8 * s2 + 1]); pw.y = cvtpk(X1[8 * s2 + 2], X1[8 * s2 + 3]); pw.z = cvtpk(X1[8 * s2 + 4], X1[8 * s2 + 5]); pw.w = cvtpk(X1[8 * s2 + 6], X1[8 * s2 + 7]);
                    const s16x8 bv = *(const LAS s16x8*)(vtp + (32 + 16 * s2) * 2); O = __builtin_amdgcn_mfma_f32_32x32x16_bf16(__builtin_bit_cast(s16x8, pw), bv, O, 0, 0, 0); } }
            const LAS unsigned char* stp = lds + HG_ST + (32 * vq + r) * 272 + hf * 16;
#pragma unroll
            for (int ks = 0; ks < 8; ++ks) { const s16x8 aq = *(const LAS s16x8*)(qtp + ks * 32), bs = *(const LAS s16x8*)(stp + ks * 32); O = __builtin_amdgcn_mfma_f32_32x32x16_bf16(aq, bs, O, 0, 0, 0); }
#pragma unroll
            for (int i = 0; i < 16; ++i) G[(32 * tr + crow16(i, hf)) * 128 + 32 * vq + r] = O[i];
        }
#pragma unroll
        for (int dd = 0; dd < 2; ++dd) { const int dr = 2 * tr + dd;
#pragma unroll
            for (int g4 = 0; g4 < 4; ++g4) { const f32x4 ge = *(const LAS f32x4*)(GE + 32 * dr + 8 * g4 + 4 * hf);
                S[dd][4 * g4] *= __builtin_amdgcn_exp2f(ge.x); S[dd][4 * g4 + 1] *= __builtin_amdgcn_exp2f(ge.y); S[dd][4 * g4 + 2] *= __builtin_amdgcn_exp2f(ge.z); S[dd][4 * g4 + 3] *= __builtin_amdgcn_exp2f(ge.w); }
#pragma unroll
            for (int ks = 0; ks < 4; ++ks) { const s16x8 a = *(const LAS s16x8*)(lds + HG_KE + (32 * dr + r) * 144 + hf * 16 + ks * 32), bv = *(const LAS s16x8*)(lds + HG_VT + (32 * vq + r) * 144 + hf * 16 + ks * 32);
                S[dd] = __builtin_amdgcn_mfma_f32_32x32x16_bf16(a, bv, S[dd], 0, 0, 0); } }
        __syncthreads();
        if (OUT) {
#pragma unroll 2
            for (int k = 0; k < 8; ++k) { const int tt = wave + 8 * k; const float o0 = G[tt * 128 + lane], o1 = G[tt * 128 + lane + 64];
                const float ms = wave_sum(o0 * o0 + o1 * o1) * (1.f / 128.f), rr = 1.f / sqrtf(ms + 1e-6f);
                const bf16* grow = h + (t0 + tt) * NC_H + 2304 + hh * 128; const float g0 = bf2f(grow[lane]), g1 = bf2f(grow[lane + 64]);
                bf16* mrow = mix + (t0 + tt) * 1024 + hh * 128;
                mrow[lane] = (bf16)f2bf(o0 * rr * normg[lane] * sigmoidf_(g0)); mrow[lane + 64] = (bf16)f2bf(o1 * rr * normg[lane + 64] * sigmoidf_(g1)); }
            __syncthreads();
        }
    }
    if (!OUT) {
#pragma unroll
        for (int dd = 0; dd < 2; ++dd)
#pragma unroll
            for (int i = 0; i < 16; ++i) Sp[(32 * (2 * tr + dd) + crow16(i, hf)) * 128] = S[dd][i];
        if (cpart == 3) Dseg[(size_t)unit * 128 + cd] = __builtin_amdgcn_exp2f(gsum);
    }
}
__device__ __forceinline__ void hgrn_scan(float* Sloc, const float* Dseg, size_t gtid, size_t gthreads) {
    for (size_t idx = gtid; idx < (size_t)NBATCH * HG_H * 16384; idx += gthreads) { const int bh = (int)(idx >> 14), e = (int)(idx & 16383), d = e >> 7; float cur = 0.f;
        for (int seg = 0; seg < HNSEG; ++seg) { const size_t u = (size_t)bh * HNSEG + seg; float* p = Sloc + u * 16384 + e; const float tmp = *p; *p = cur; cur = Dseg[u * 128 + d] * cur + tmp; } }
}

template <bool MASK>
__device__ __forceinline__ void attn4(const LAS unsigned* Ks, const LAS bf16* Vs, const LAS float* qst, LAS float* pb, int lane, const int (&tq)[4], int kbase, float slope,
                                      float (&mo)[4], float (&lo)[4], float (&oo)[4]) {
    float sc[4][4];
#pragma unroll
    for (int a = 0; a < 4; ++a)
#pragma unroll
        for (int c = 0; c < 4; ++c) sc[a][c] = 0.f;
#pragma unroll 4
    for (int dd = 0; dd < 32; ++dd) {
        f32x2 qv[4];
#pragma unroll
        for (int qi = 0; qi < 4; ++qi) qv[qi] = *(const LAS f32x2*)(qst + qi * 64 + 2 * dd);
#pragma unroll
        for (int kk = 0; kk < 4; ++kk) { const unsigned kw = Ks[(lane + 64 * kk) * 33 + dd]; const float k0 = bflo(kw), k1 = bfhi(kw);
#pragma unroll
            for (int qi = 0; qi < 4; ++qi) sc[qi][kk] += qv[qi].x * k0 + qv[qi].y * k1; }
    }
#pragma unroll
    for (int qi = 0; qi < 4; ++qi) { float mx = -INFINITY;
#pragma unroll
        for (int kk = 0; kk < 4; ++kk) { const int pos = kbase + lane + 64 * kk; float lg = sc[qi][kk] * 0.125f - slope * (float)(tq[qi] - pos); if (MASK && pos > tq[qi]) lg = -INFINITY; sc[qi][kk] = lg; mx = fmaxf(mx, lg); }
        mx = wave_max(mx); float s = 0.f;
#pragma unroll
        for (int kk = 0; kk < 4; ++kk) { const float p = __builtin_amdgcn_exp2f((sc[qi][kk] - mx) * 1.4426950408889634f); pb[qi * 256 + lane + 64 * kk] = p; s += p; }
        lo[qi] = wave_sum(s); mo[qi] = mx; }
    float o[4] = {0.f, 0.f, 0.f, 0.f};
#pragma unroll 4
    for (int k4 = 0; k4 < 64; ++k4) { f32x4 p4[4];
#pragma unroll
        for (int qi = 0; qi < 4; ++qi) p4[qi] = *(const LAS f32x4*)(pb + qi * 256 + 4 * k4);
#pragma unroll
        for (int jj = 0; jj < 4; ++jj) { const float vv = bf2f(Vs[(4 * k4 + jj) * 64 + lane]);
#pragma unroll
            for (int qi = 0; qi < 4; ++qi) o[qi] += p4[qi][jj] * vv; } }
#pragma unroll
    for (int qi = 0; qi < 4; ++qi) oo[qi] = o[qi];
}
constexpr int AT_KS = 0, AT_VS = 33792, AT_WV = 66560, AT_WVB = 5120;

__device__ __forceinline__ void memattn_unit(LAS unsigned char* lds, const bf16* h, int NC, int qoff, const bf16* kv, bf16* mix, int unit, int tid, int wave, int lane) {
    const int chunk = unit & 31, bm = unit >> 5, mh = bm & 3, b = bm >> 2;
    LAS unsigned* Ks = (LAS unsigned*)(lds + AT_KS); LAS unsigned* Vs32 = (LAS unsigned*)(lds + AT_VS);
    LAS float* qst = (LAS float*)(lds + AT_WV + wave * AT_WVB); LAS float* pb = qst + 256;
    for (int i = 0; i < 16; ++i) { const int idx = tid + 512 * i, r = idx >> 5, dd = idx & 31; const unsigned* src = (const unsigned*)(kv + (size_t)(b * 256 + r) * 512 + mh * 64);
        Ks[r * 33 + dd] = src[dd]; Vs32[r * 32 + dd] = src[128 + dd]; }
    __syncthreads();
    for (int qd = 0; qd < 16; ++qd) { const size_t tg = (size_t)b * SEQ + chunk * 512 + wave * 64 + qd * 4;
#pragma unroll
        for (int qi = 0; qi < 4; ++qi) qst[qi * 64 + lane] = bf2f(h[(tg + qi) * NC + qoff + mh * 64 + lane]);
        const int tq[4] = {0, 0, 0, 0}; float m[4], l[4], o[4];
        attn4<false>(Ks, (const LAS bf16*)Vs32, qst, pb, lane, tq, 0, 0.f, m, l, o);
#pragma unroll
        for (int qi = 0; qi < 4; ++qi) mix[(tg + qi) * 1024 + MIXW + mh * 64 + lane] = (bf16)f2bf(o[qi] / l[qi]); }
    __syncthreads();
}

constexpr int AT2_K = 0, AT2_KROW = 176, AT2_V = 256 * AT2_KROW, AT2_VROW = 528;
__device__ __forceinline__ void stage_kv_images(LAS unsigned char* lds, const bf16* kp, const bf16* vp, size_t row_stride, int tid) {
    v4u kx[4], vx[4];
#pragma unroll
    for (int i = 0; i < 4; ++i) { const int idx = tid + 512 * i, key = idx >> 3, c = idx & 7; kx[i] = *(const v4u*)(kp + (size_t)key * row_stride + 8 * c); vx[i] = *(const v4u*)(vp + (size_t)key * row_stride + 8 * c); }
    __builtin_amdgcn_sched_barrier(0);
#pragma unroll
    for (int i = 0; i < 4; ++i) { const int idx = tid + 512 * i, key = idx >> 3, c = idx & 7;
        *(LAS v4u*)(lds + AT2_K + key * AT2_KROW + c * 16) = kx[i];
        const int pos = (key & ~15) | (key & 3) | ((key & 4) << 1) | ((key & 8) >> 1);
        LAS bf16* vt = (LAS bf16*)(lds + AT2_V) + pos;
#pragma unroll
        for (int w = 0; w < 4; ++w) { vt[(8 * c + 2 * w) * (AT2_VROW / 2)] = (bf16)(vx[i][w] & 0xffffu); vt[(8 * c + 2 * w + 1) * (AT2_VROW / 2)] = (bf16)(vx[i][w] >> 16); } }
    if (tid < 256) { const unsigned pb = f2bf((float)tid); const v4u e0 = {pb | (pb << 16), 0u, 0u, 0u}, z = {0u, 0u, 0u, 0u};
        *(LAS v4u*)(lds + AT2_K + tid * AT2_KROW + 128) = e0; *(LAS v4u*)(lds + AT2_K + tid * AT2_KROW + 144) = z; }
}
template <bool MASK>
__device__ __forceinline__ void attn_tile32(const LAS unsigned char* lds, const s16x8 (&qf)[4], int lane, float dist0, unsigned qx, bool own, f32x16 (&o)[2], float& mrow, float& lrow) {
    const int r = lane & 31, hf = lane >> 5;
    const v4u qxv = {qx, 0u, 0u, 0u}; const s16x8 qe = __builtin_bit_cast(s16x8, qxv);
    f32x16 acc[8];
    const LAS unsigned char* kb = lds + AT2_K + r * AT2_KROW + hf * 16;
    constexpr int NKS = MASK ? 5 : 4;
    s16x8 kf[NKS];
#pragma unroll
    for (int s = 0; s < NKS; ++s) kf[s] = *(const LAS s16x8*)(kb + s * 32);
#pragma unroll
    for (int kt = 0; kt < 8; ++kt) {
#pragma unroll
        for (int i = 0; i < 16; ++i) acc[kt][i] = 0.f;
#pragma unroll
        for (int s = 0; s < NKS; ++s) { acc[kt] = __builtin_amdgcn_mfma_f32_32x32x16_bf16(kf[s], s < 4 ? qf[s < 4 ? s : 0] : qe, acc[kt], 0, 0, 0);
            if (kt + 1 < 8) kf[s] = *(const LAS s16x8*)(kb + (kt + 1) * 32 * AT2_KROW + s * 32); }
        __builtin_amdgcn_sched_barrier(0); }
    float mx = -INFINITY;
    if (MASK && own) { const float base2 = dist0 - 4.f * (float)hf;
#pragma unroll
        for (int kt = 0; kt < 8; ++kt)
#pragma unroll
            for (int i = 0; i < 16; ++i) { const float dist = base2 - (float)(32 * kt + (i & 3) + 8 * (i >> 2)); const float lg = dist < 0.f ? -INFINITY : acc[kt][i]; acc[kt][i] = lg; mx = fmaxf(mx, lg); }
    } else {
#pragma unroll
        for (int kt = 0; kt < 8; ++kt)
#pragma unroll
            for (int i = 0; i < 16; ++i) mx = fmaxf(mx, acc[kt][i]);
    }
    mx = fmaxf(mx, xor32f(mx, lane));
    float sum = 0.f;
#pragma unroll
    for (int i = 0; i < 16; ++i) { o[0][i] = 0.f; o[1][i] = 0.f; }
    const LAS unsigned char* vb = lds + AT2_V + r * AT2_VROW + hf * 16;
    s16x8 vf[4];
#pragma unroll
    for (int s2 = 0; s2 < 2; ++s2)
#pragma unroll
        for (int dt = 0; dt < 2; ++dt) vf[2 * s2 + dt] = *(const LAS s16x8*)(vb + dt * 32 * AT2_VROW + (16 * s2) * 2);
#pragma unroll
    for (int kt = 0; kt < 8; ++kt) {
#pragma unroll
        for (int i = 0; i < 16; ++i) { const float p = __builtin_amdgcn_exp2f(acc[kt][i] - mx); sum += p; acc[kt][i] = p; }
#pragma unroll
        for (int s2 = 0; s2 < 2; ++s2) { v4u pw; pw.x = cvtpk(acc[kt][8 * s2], acc[kt][8 * s2 + 1]); pw.y = cvtpk(acc[kt][8 * s2 + 2], acc[kt][8 * s2 + 3]);
            pw.z = cvtpk(acc[kt][8 * s2 + 4], acc[kt][8 * s2 + 5]); pw.w = cvtpk(acc[kt][8 * s2 + 6], acc[kt][8 * s2 + 7]); const s16x8 pf = __builtin_bit_cast(s16x8, pw);
#pragma unroll
            for (int dt = 0; dt < 2; ++dt) { o[dt] = __builtin_amdgcn_mfma_f32_32x32x16_bf16(vf[2 * s2 + dt], pf, o[dt], 0, 0, 0);
                if (kt + 1 < 8) vf[2 * s2 + dt] = *(const LAS s16x8*)(vb + dt * 32 * AT2_VROW + (32 * (kt + 1) + 16 * s2) * 2); } }
        __builtin_amdgcn_sched_barrier(0); }
    sum += xor32f(sum, lane);
    mrow = mx; lrow = sum;
}
__device__ __forceinline__ void memattn_unit2(LAS unsigned char* lds, const bf16* h, int NC, int qoff, const bf16* kv  , bf16* mix, int unit, int tid, int wave, int lane) {
    const int chunk = unit & 63, bm = unit >> 6, mh = bm & 3, b = bm >> 2, r = lane & 31, hf = lane >> 5;
    const bf16* kvrow0 = kv + (size_t)(b * 256) * 2048 + mh * 64;
    stage_kv_images(lds, kvrow0, kvrow0 + 256, 2048, tid);
    __syncthreads();
    { const size_t tg = (size_t)b * SEQ + chunk * 256 + wave * 32 + r;
        f32x16 o[2]; float m2, l; s16x8 qf[4];
#pragma unroll
        for (int s = 0; s < 4; ++s) qf[s] = *(const s16x8*)(h + tg * NC + qoff + mh * 64 + 16 * s + 8 * hf);
        attn_tile32<false>(lds, qf, lane, 0.f, 0u, false, o, m2, l);
        const float inv = 1.f / l; bf16* mp = mix + tg * 1024 + MIXW + mh * 64 + 4 * hf;
#pragma unroll
        for (int dt = 0; dt < 2; ++dt)
#pragma unroll
            for (int g = 0; g < 4; ++g) { v2u w; w.x = cvtpk(o[dt][4 * g] * inv, o[dt][4 * g + 1] * inv); w.y = cvtpk(o[dt][4 * g + 2] * inv, o[dt][4 * g + 3] * inv); *(v2u*)(mp + 32 * dt + 8 * g) = w; } }
    __syncthreads();
}
__device__ __forceinline__ void kmean_unit(LAS unsigned char* lds, const bf16* h, float* kmean, int unit, int tid) {
    const int n = unit & 63, bh = unit >> 6, hh = bh % MB_H, b = bh / MB_H, d = tid & 63, part = tid >> 6;
    LAS float* red = (LAS float*)lds;
    float s = 0.f; const bf16* p = h + ((size_t)b * SEQ + n * 256 + part * 32) * NC_M + 768 + hh * 64 + d;
    for (int i = 0; i < 32; ++i) s += bf2f(p[(size_t)i * NC_M]);
    red[part * 64 + d] = s; __syncthreads();
    if (tid < 64) { float a = 0.f; for (int pp = 0; pp < 8; ++pp) a += red[pp * 64 + tid]; kmean[((size_t)bh * 64 + n) * 64 + tid] = a * (1.f / 256.f); }
    __syncthreads();
}
__device__ __forceinline__ void moba_gate_unit(LAS unsigned char* lds, const bf16* h, const float* kmean, unsigned* gcount, int* selinfo, unsigned* list, int unit, int tid) {
    const int c = unit & 63, bh = unit >> 6, hh = bh % MB_H, b = bh / MB_H;
    LAS float* km = (LAS float*)lds; LAS int* hist = (LAS int*)(lds + 16384); LAS int* base = hist + 64;
    for (int i = tid; i < 4096; i += NTHR) km[i] = kmean[(size_t)bh * 4096 + i];
    if (tid < 64) hist[tid] = 0;
    __syncthreads();
    int s0 = 0, s1 = 0, s2 = 0, r0 = 0, r1 = 0, r2 = 0, ns = 0; const int t = c * 256 + tid;
    if (tid < 256) {
        float q[64]; const v4u* qp = (const v4u*)(h + ((size_t)b * SEQ + t) * NC_M + hh * 64);
#pragma unroll
        for (int w = 0; w < 8; ++w) { const v4u x = qp[w]; q[8 * w] = bflo(x.x); q[8 * w + 1] = bfhi(x.x); q[8 * w + 2] = bflo(x.y); q[8 * w + 3] = bfhi(x.y); q[8 * w + 4] = bflo(x.z); q[8 * w + 5] = bfhi(x.z); q[8 * w + 6] = bflo(x.w); q[8 * w + 7] = bfhi(x.w); }
        float v0 = -INFINITY, v1 = -INFINITY, v2 = -INFINITY;
        for (int n = 0; n < c; ++n) { float g = 0.f;
#pragma unroll
            for (int d4 = 0; d4 < 16; ++d4) { const f32x4 k4 = *(const LAS f32x4*)(km + n * 64 + 4 * d4); g += q[4 * d4] * k4.x + q[4 * d4 + 1] * k4.y + q[4 * d4 + 2] * k4.z + q[4 * d4 + 3] * k4.w; }
            if (g > v0) { v2 = v1; s2 = s1; v1 = v0; s1 = s0; v0 = g; s0 = n; } else if (g > v1) { v2 = v1; s2 = s1; v1 = g; s1 = n; } else if (g > v2) { v2 = g; s2 = n; } }
        ns = c < 3 ? c : 3;
        if (ns > 0) r0 = __hip_atomic_fetch_add(hist + s0, 1, __ATOMIC_RELAXED, __HIP_MEMORY_SCOPE_WORKGROUP);
        if (ns > 1) r1 = __hip_atomic_fetch_add(hist + s1, 1, __ATOMIC_RELAXED, __HIP_MEMORY_SCOPE_WORKGROUP);
        if (ns > 2) r2 = __hip_atomic_fetch_add(hist + s2, 1, __ATOMIC_RELAXED, __HIP_MEMORY_SCOPE_WORKGROUP);
        selinfo[((size_t)b * SEQ + t) * MB_H + hh] = ns;
    }
    __syncthreads();
    if (tid < 64) { const int hc = hist[tid]; if (hc > 0) base[tid] = (int)__hip_atomic_fetch_add(gcount + bh * 64 + tid, (unsigned)hc, __ATOMIC_RELAXED, __HIP_MEMORY_SCOPE_AGENT); }
    __syncthreads();
    if (tid < 256) { unsigned* lp = list + ((size_t)bh * 64 << 14);
        if (ns > 0) lp[((size_t)s0 << 14) + base[s0] + r0] = (unsigned)t;
        if (ns > 1) lp[((size_t)s1 << 14) + base[s1] + r1] = (unsigned)t | (1u << 14);
        if (ns > 2) lp[((size_t)s2 << 14) + base[s2] + r2] = (unsigned)t | (2u << 14); }
    __syncthreads();
}
__device__ __forceinline__ void moba_attn_item(LAS unsigned char* lds, const bf16* h, const unsigned* gcount, const unsigned* list, float* po, float* pml, int item, int tid, int wave, int lane) {
    const int n = item / 24, bh = item - n * 24, hh = bh % MB_H, b = bh / MB_H;
    LAS unsigned* Ks = (LAS unsigned*)(lds + AT_KS); LAS unsigned* Vs32 = (LAS unsigned*)(lds + AT_VS);
    LAS float* qst = (LAS float*)(lds + AT_WV + wave * AT_WVB); LAS float* pb = qst + 256;
    for (int i = 0; i < 16; ++i) { const int idx = tid + 512 * i, r = idx >> 5, dd = idx & 31; const unsigned* src = (const unsigned*)(h + ((size_t)b * SEQ + n * 256 + r) * NC_M + hh * 64);
        Ks[r * 33 + dd] = src[384 + dd]; Vs32[r * 32 + dd] = src[768 + dd]; }
    __syncthreads();
    const int cnt = (int)gcount[bh * 64 + n], total = 256 + cnt, nquads = (total + 3) >> 2;
    const float slope = hh < 8 ? ldexpf(1.0f, -(hh + 1)) : ldexpf(0.70710678118654752f, -(hh - 8));
    const unsigned* lp = list + (((size_t)bh * 64 + n) << 14);
    for (int quad = wave; quad < nquads; quad += 8) {
        int tq[4], slot[4];
#pragma unroll
        for (int qi = 0; qi < 4; ++qi) { int idx = quad * 4 + qi; idx = idx < total ? idx : total - 1;
            if (idx < 256) { tq[qi] = n * 256 + idx; slot[qi] = 3; } else { const unsigned e = lp[idx - 256]; tq[qi] = (int)(e & 16383u); slot[qi] = (int)(e >> 14); } }
#pragma unroll
        for (int qi = 0; qi < 4; ++qi) qst[qi * 64 + lane] = bf2f(h[((size_t)b * SEQ + tq[qi]) * NC_M + hh * 64 + lane]);
        float m[4], l[4], o[4];
        attn4<true>(Ks, (const LAS bf16*)Vs32, qst, pb, lane, tq, n * 256, slope, m, l, o);
#pragma unroll
        for (int qi = 0; qi < 4; ++qi) if (quad * 4 + qi < total) { const size_t pi = (((size_t)b * SEQ + tq[qi]) * MB_H + hh) * 4 + slot[qi];
            po[pi * 64 + lane] = o[qi]; if (lane == 0) { pml[pi * 2] = m[qi]; pml[pi * 2 + 1] = l[qi]; } }
    }
    __syncthreads();
}

__device__ __forceinline__ void moba_attn_item2(LAS unsigned char* lds, const bf16* h, const unsigned* gcount, const unsigned* list, bf16* po, float* pml, int item, int tid, int wave, int lane) {
    const int n = item / 24, bh = item - n * 24, hh = bh % MB_H, b = bh / MB_H, r = lane & 31, hf = lane >> 5;
    const bf16* hrow0 = h + ((size_t)b * SEQ + n * 256) * NC_M + hh * 64;
    stage_kv_images(lds, hrow0 + 768, hrow0 + 1536, NC_M, tid);
    __syncthreads();
    const int cnt = (int)gcount[bh * 64 + n], total = 256 + cnt, ntiles = (total + 31) >> 5;
    const float slope2 = (hh < 8 ? ldexpf(1.0f, -(hh + 1)) : ldexpf(0.70710678118654752f, -(hh - 8))) * 1.4426950408889634f;
    const unsigned shi = f2bf(slope2), slo = f2bf(slope2 - __builtin_bit_cast(float, shi << 16)); const unsigned qx = hf == 0 ? (shi | (slo << 16)) : 0u;
    const unsigned* lp = list + (((size_t)bh * 64 + n) << 14);
    const bf16* hq = h + (size_t)b * SEQ * NC_M + hh * 64 + 8 * hf;
#pragma unroll 1
    for (int tile = wave; tile < ntiles; tile += NWAVES) {
        int idx = tile * 32 + r; const bool valid = idx < total; idx = valid ? idx : total - 1;
        int tq, slot; if (idx < 256) { tq = n * 256 + idx; slot = 3; } else { const unsigned e = lp[idx - 256]; tq = (int)(e & 16383u); slot = (int)(e >> 14); }
        s16x8 qf[4]; { const bf16* qp = hq + (size_t)tq * NC_M;
#pragma unroll
            for (int s = 0; s < 4; ++s) qf[s] = *(const s16x8*)(qp + 16 * s); }
        f32x16 o[2]; float m2, l; const float dist0 = (float)(tq - n * 256);
        attn_tile32<true>(lds, qf, lane, dist0, qx, tile < 8, o, m2, l);
        if (valid) { const size_t pi = (((size_t)b * SEQ + tq) * MB_H + hh) * 4 + slot; bf16* op = po + pi * 64 + 4 * hf;
#pragma unroll
            for (int dt = 0; dt < 2; ++dt)
#pragma unroll
                for (int g = 0; g < 4; ++g) { v2u w; w.x = cvtpk(o[dt][4 * g], o[dt][4 * g + 1]); w.y = cvtpk(o[dt][4 * g + 2], o[dt][4 * g + 3]); *(v2u*)(op + 32 * dt + 8 * g) = w; }
            if (hf == 0) { pml[pi * 2] = m2 - slope2 * dist0; pml[pi * 2 + 1] = l; } }
    }
    __syncthreads();
}
__device__ __forceinline__ void moba_combine(const bf16* __restrict__ po, const float* __restrict__ pml, const int* __restrict__ selinfo, bf16* __restrict__ mix, int gw, int ngw, int lane) {
    const int sub = lane >> 4, d4 = (lane & 15) * 4;
#pragma unroll 4
    for (int idx = gw * 4 + sub; idx < T * MB_H; idx += ngw * 4) { const int tg = idx / MB_H, hh = idx - tg * MB_H, ns = selinfo[idx]; const size_t p4 = (size_t)idx * 4;
        f32x2 ml[4]; f32x4 ov[4];
#pragma unroll
        for (int j = 0; j < 4; ++j) { ml[j] = ((const f32x2*)pml)[p4 + j]; const v2u ow = *(const v2u*)(po + (p4 + j) * 64 + d4); ov[j] = (f32x4){bflo(ow.x), bfhi(ow.x), bflo(ow.y), bfhi(ow.y)}; }
        float M = ml[3].x;
#pragma unroll
        for (int j = 0; j < 3; ++j) { const bool ok = j < ns; ml[j].x = ok ? ml[j].x : -INFINITY; ml[j].y = ok ? ml[j].y : 0.f; M = fmaxf(M, ml[j].x);
            ov[j].x = ok ? ov[j].x : 0.f; ov[j].y = ok ? ov[j].y : 0.f; ov[j].z = ok ? ov[j].z : 0.f; ov[j].w = ok ? ov[j].w : 0.f; }
        float den = 0.f; f32x4 num = {0.f, 0.f, 0.f, 0.f};
#pragma unroll
        for (int j = 0; j < 4; ++j) { const float w = __builtin_amdgcn_exp2f(ml[j].x - M); den += w * ml[j].y; num += ov[j] * w; }
        const float inv = 1.f / den; v2u o; o.x = pk2(num.x * inv, num.y * inv); o.y = pk2(num.z * inv, num.w * inv);
        *(v2u*)(mix + (size_t)tg * 1024 + hh * 64 + d4) = o; }
}

__device__ __forceinline__ void ln_row(f32x4 (&v)[4], const f32x4 (&gv)[4], const f32x4 (&bv)[4]) {
    float s = 0.f;
#pragma unroll
    for (int j = 0; j < 4; ++j) s += (v[j].x + v[j].y) + (v[j].z + v[j].w);
    const float mean = wave_sum(s) * (1.f / D); float s2 = 0.f;
#pragma unroll
    for (int j = 0; j < 4; ++j) { v[j] = v[j] - mean; s2 += (v[j].x * v[j].x + v[j].y * v[j].y) + (v[j].z * v[j].z + v[j].w * v[j].w); }
    const float rstd = 1.f / sqrtf(wave_sum(s2) * (1.f / D) + 1e-5f);
#pragma unroll
    for (int j = 0; j < 4; ++j) v[j] = v[j] * rstd * gv[j] + bv[j];
}
__device__ __forceinline__ void split_router_weights(const float* wr  , bf16* wrs  , size_t gtid, size_t gthreads) {
    for (size_t i = gtid; i < (size_t)DEPTH * D * NE; i += gthreads) { const int e = (int)(i & 31), d = (int)((i >> 5) & 1023), l = (int)(i >> 15);
        const float w = wr[i]; const unsigned hi = f2bf(w); const unsigned lo = f2bf(w - __builtin_bit_cast(float, hi << 16));
        wrs[(((size_t)l * 2 + 0) * NE + e) * D + d] = (bf16)hi; wrs[(((size_t)l * 2 + 1) * NE + e) * D + d] = (bf16)lo; }
}
constexpr int L1_XH = 0, L1_XL = 33024, L1_ROW = 2064, L1_PART = 66048, L1_HIST = 82432;
__device__ __forceinline__ void phase_ln1(LAS unsigned char* lds, const bf16* y, const float* g, const float* bb, const bf16* wrs  , const float* br,
                                          bf16* xbf, int* tok_e, int* tok_lr, float* tok_w, int* blk_cnt, int blk, int tid, int wave, int lane) {
    LAS float* part = (LAS float*)(lds + L1_PART);
    LAS int* hist = (LAS int*)(lds + L1_HIST);
    if (tid < 32) hist[tid] = 0;
    constexpr int TPB = T / GRID;
    const int e = lane & 31, m16 = lane & 15, quad = lane >> 4;
    s16x8 bw[4][2][2];
#pragma unroll
    for (int ks = 0; ks < 4; ++ks)
#pragma unroll
        for (int nt = 0; nt < 2; ++nt)
#pragma unroll
            for (int pp = 0; pp < 2; ++pp) bw[ks][nt][pp] = *(const s16x8*)(wrs + ((size_t)pp * NE + 16 * nt + m16) * D + wave * 128 + 32 * ks + 8 * quad);
    const float bre = br[e];
    f32x4 gv[4], bv[4];
#pragma unroll
    for (int j = 0; j < 4; ++j) { gv[j] = ((const f32x4*)g)[lane + 64 * j]; bv[j] = ((const f32x4*)bb)[lane + 64 * j]; }
    v2u xn[2][4], yn[2][4];
#pragma unroll
    for (int u = 0; u < 2; ++u) { const size_t t0 = (size_t)blk * TPB + 2 * wave + u; const v2u* xr = (const v2u*)(xbf + t0 * D) + lane; const v2u* yr = (const v2u*)(y + t0 * D) + lane;
#pragma unroll
        for (int j = 0; j < 4; ++j) { xn[u][j] = xr[64 * j]; yn[u][j] = yr[64 * j]; } }
    __syncthreads();
    for (int grp = 0; grp < TPB / 16; ++grp) { const size_t tg0 = (size_t)blk * TPB + grp * 16 + 2 * wave;
        f32x4 v[2][4];
#pragma unroll
        for (int u = 0; u < 2; ++u)
#pragma unroll
            for (int j = 0; j < 4; ++j) { const v2u xw = xn[u][j]; const v2u yw = yn[u][j];
                v[u][j].x = DN_ALPHA * bflo(xw.x) + bflo(yw.x); v[u][j].y = DN_ALPHA * bfhi(xw.x) + bfhi(yw.x); v[u][j].z = DN_ALPHA * bflo(xw.y) + bflo(yw.y); v[u][j].w = DN_ALPHA * bfhi(xw.y) + bfhi(yw.y); }
        if (grp + 1 < TPB / 16) {
#pragma unroll
            for (int u = 0; u < 2; ++u) { const v2u* xr = (const v2u*)(xbf + (tg0 + 16 + u) * D) + lane; const v2u* yr = (const v2u*)(y + (tg0 + 16 + u) * D) + lane;
#pragma unroll
                for (int j = 0; j < 4; ++j) { xn[u][j] = xr[64 * j]; yn[u][j] = yr[64 * j]; } } }
#pragma unroll
        for (int u = 0; u < 2; ++u) { ln_row(v[u], gv, bv);
            v2u* xb = (v2u*)(xbf + (tg0 + u) * D) + lane;
#pragma unroll
            for (int j = 0; j < 4; ++j) { v2u hw; hw.x = cvtpk(v[u][j].x, v[u][j].y); hw.y = cvtpk(v[u][j].z, v[u][j].w); xb[64 * j] = hw;
                v2u lw; lw.x = cvtpk(v[u][j].x - bflo(hw.x), v[u][j].y - bfhi(hw.x)); lw.y = cvtpk(v[u][j].z - bflo(hw.y), v[u][j].w - bfhi(hw.y));
                *(LAS v2u*)(lds + L1_XH + (2 * wave + u) * L1_ROW + (4 * lane + 256 * j) * 2) = hw; *(LAS v2u*)(lds + L1_XL + (2 * wave + u) * L1_ROW + (4 * lane + 256 * j) * 2) = lw; } }
        __syncthreads();
        { f32x4 acc[2] = {{0.f, 0.f, 0.f, 0.f}, {0.f, 0.f, 0.f, 0.f}};
#pragma unroll
          for (int ks = 0; ks < 4; ++ks) { const int off = m16 * L1_ROW + (wave * 128 + 32 * ks + 8 * quad) * 2;
              const s16x8 ah = *(const LAS s16x8*)(lds + L1_XH + off), al = *(const LAS s16x8*)(lds + L1_XL + off);
#pragma unroll
              for (int nt = 0; nt < 2; ++nt) { acc[nt] = __builtin_amdgcn_mfma_f32_16x16x32_bf16(ah, bw[ks][nt][0], acc[nt], 0, 0, 0); acc[nt] = __builtin_amdgcn_mfma_f32_16x16x32_bf16(ah, bw[ks][nt][1], acc[nt], 0, 0, 0);
                  acc[nt] = __builtin_amdgcn_mfma_f32_16x16x32_bf16(al, bw[ks][nt][0], acc[nt], 0, 0, 0); } }
#pragma unroll
          for (int nt = 0; nt < 2; ++nt)
#pragma unroll
              for (int jj = 0; jj < 4; ++jj) part[(wave * 16 + 4 * quad + jj) * 32 + 16 * nt + m16] = acc[nt][jj]; }
        __syncthreads();
#pragma unroll
        for (int u = 0; u < 2; ++u) { const size_t t = tg0 + u;
            float logit = bre;
#pragma unroll
            for (int w = 0; w < 8; ++w) logit += part[(w * 16 + 2 * wave + u) * 32 + e];
            int rank = 0;
#pragma unroll
            for (int q = 0; q < 32; ++q) { const float oq = __builtin_bit_cast(float, __builtin_amdgcn_readlane(__builtin_bit_cast(int, logit), q)); rank += (oq > logit || (oq == logit && q < e)) ? 1 : 0; }
            int se[4]; float sv[4];
#pragma unroll
            for (int k = 0; k < 4; ++k) { const unsigned long long mk = __ballot(rank == k && lane < 32); const int src = __builtin_ctzll(mk);
                se[k] = src; sv[k] = __builtin_bit_cast(float, __builtin_amdgcn_readlane(__builtin_bit_cast(int, logit), src)); }
            const float e1 = __expf(sv[1] - sv[0]), e2 = __expf(sv[2] - sv[0]), e3 = __expf(sv[3] - sv[0]), inv = 1.f / (1.f + e1 + e2 + e3);
            const float wk[4] = {inv, e1 * inv, e2 * inv, e3 * inv};
            if (lane == 0) {
#pragma unroll
                for (int k = 0; k < 4; ++k) { const int lr = __hip_atomic_fetch_add(hist + se[k], 1, __ATOMIC_RELAXED, __HIP_MEMORY_SCOPE_WORKGROUP);
                    tok_e[t * 4 + k] = se[k]; tok_lr[t * 4 + k] = lr; tok_w[t * 4 + k] = wk[k]; } } }
    }
    __syncthreads();
    if (tid < 32) blk_cnt[blk * 32 + tid] = hist[tid];
    __syncthreads();
}
__device__ __forceinline__ void phase_dispatch(LAS unsigned char* lds, const int* __restrict__ blk_cnt, const int* __restrict__ tok_e, const int* __restrict__ tok_lr, int* __restrict__ tok_row, int* __restrict__ tab,
                                               const bf16* __restrict__ xbf, bf16* __restrict__ xs, int blk, int tid, int wave, int lane) {
    LAS int* tot = (LAS int*)lds; LAS int* pre = tot + 32; LAS int* pst = pre + 32; LAS int* rows = pst + 64;
    if (tid < 32) { int s = 0, p = 0;
#pragma unroll 8
        for (int bb = 0; bb < GRID; ++bb) { const int c = blk_cnt[bb * 32 + tid]; p += (bb < blk) ? c : 0; s += c; } tot[tid] = s; pre[tid] = p; }
    __syncthreads();
    if (tid == 0) { int acc = 0; for (int e = 0; e < 32; ++e) { pst[e] = acc; acc += ((tot[e] + 255) >> 8) << 8; } pst[32] = acc; }
    __syncthreads();
    if (blk == 0 && tid < 33) tab[tid] = pst[tid] >> 8;
    constexpr int TPB = T / GRID;
    static_assert(TPB * 4 == NTHR, "one (token, k) pair per thread");
    { const size_t ti = (size_t)blk * TPB * 4 + tid; const int e = tok_e[ti]; const int r = pst[e] + pre[e] + tok_lr[ti]; tok_row[ti] = r; rows[tid] = r; }
    __syncthreads();
#pragma unroll 4
    for (int i = wave; i < TPB * 4; i += NWAVES) { const int r = rows[i];
        const v4u* src = (const v4u*)(xbf + ((size_t)blk * TPB + (i >> 2)) * D) + 2 * lane; const v4u a = src[0], b = src[1];
        v4u o; o.x = pk4_fp8(bflo(a.x), bfhi(a.x), bflo(a.y), bfhi(a.y)); o.y = pk4_fp8(bflo(a.z), bfhi(a.z), bflo(a.w), bfhi(a.w)); o.z = pk4_fp8(bflo(b.x), bfhi(b.x), bflo(b.y), bfhi(b.y)); o.w = pk4_fp8(bflo(b.z), bfhi(b.z), bflo(b.w), bfhi(b.w));
        ((v4u*)((unsigned char*)xs + (size_t)r * D))[lane] = o; }
    __syncthreads();
}
__device__ __forceinline__ f32x4 fp8x4_to_f32(unsigned w) {
    const f32x2 lo = __builtin_amdgcn_cvt_pk_f32_fp8((int)w, false), hi = __builtin_amdgcn_cvt_pk_f32_fp8((int)w, true); return (f32x4){lo.x, lo.y, hi.x, hi.y};
}
__device__ __forceinline__ void phase_ln2(const unsigned char* __restrict__ yrows, const int* __restrict__ tok_row, const float* __restrict__ tok_w, const float* __restrict__ g, const float* __restrict__ bb,
                                          float* __restrict__ xout, bf16* xbf, int gw, int ngw, int lane) {
    f32x4 gv[4], bv[4];
#pragma unroll
    for (int j = 0; j < 4; ++j) { gv[j] = ((const f32x4*)g)[lane + 64 * j]; bv[j] = ((const f32x4*)bb)[lane + 64 * j]; }
    constexpr int NTK = 2;
    static_assert(T % (NTK * GRID * NWAVES) == 0, "NTK tokens per wave per step");
    for (int t0 = gw; t0 < T; t0 += NTK * ngw) {
        f32x4 v[NTK][4];
#pragma unroll
        for (int u = 0; u < NTK; ++u) { const int t = t0 + u * ngw; int r[4]; float w[4];
#pragma unroll
            for (int k = 0; k < 4; ++k) { r[k] = tok_row[(size_t)t * 4 + k]; w[k] = tok_w[(size_t)t * 4 + k] * (1.f / 16.f); }
            const v2u* xr = (const v2u*)(xbf + (size_t)t * D) + lane;
#pragma unroll
            for (int j = 0; j < 4; ++j) { f32x4 f = {0.f, 0.f, 0.f, 0.f};
#pragma unroll
                for (int k = 0; k < 4; ++k) { const unsigned yw = ((const unsigned*)(yrows + (size_t)r[k] * D))[lane + 64 * j]; f += fp8x4_to_f32(yw) * w[k]; }
                const v2u xw = xr[64 * j]; v[u][j].x = DN_ALPHA * bflo(xw.x) + f.x; v[u][j].y = DN_ALPHA * bfhi(xw.x) + f.y; v[u][j].z = DN_ALPHA * bflo(xw.y) + f.z; v[u][j].w = DN_ALPHA * bfhi(xw.y) + f.w; } }
#pragma unroll
        for (int u = 0; u < NTK; ++u) { const int t = t0 + u * ngw;
            ln_row(v[u], gv, bv);
            if (xout) { f32x4* xo = (f32x4*)(xout + (size_t)t * D) + lane;
#pragma unroll
                for (int j = 0; j < 4; ++j) xo[64 * j] = v[u][j]; }
            else { v2u* xb = (v2u*)(xbf + (size_t)t * D) + lane;
#pragma unroll
                for (int j = 0; j < 4; ++j) { v2u ww; ww.x = pk2(v[u][j].x, v[u][j].y); ww.y = pk2(v[u][j].z, v[u][j].w); xb[64 * j] = ww; } } } }
}

struct Args { const float* in[20]; float* out; unsigned char* ws; int l_lo, l_hi, ph_lo, ph_hi; };
typedef const __attribute__((address_space(4))) Args* KArgsP;
#define KA_LOAD() ({ KArgsP p_ = (KArgsP)__builtin_amdgcn_kernarg_segment_ptr(); asm volatile("" : "+s"(p_)); p_; })
#ifndef PHMASK
#define PHMASK 0xFFFF
#endif
#ifndef REPEAT_MASK
#define REPEAT_MASK 0
#endif
#ifndef REPEAT_LMASK
#define REPEAT_LMASK 0xF
#endif
#define PH_BEGIN(k) _Pragma("unroll") for (int rep_ = 0; rep_ < ((((REPEAT_MASK >> (k)) & 1) && ((REPEAT_LMASK >> l) & 1)) ? 2 : 1); ++rep_) { if ((PHMASK >> (k)) & 1) { KArgsP ka = KA_LOAD(); unsigned char* ws = ka->ws; int tid = threadIdx.x; asm volatile("" : "+v"(tid)); \
    const int lane = tid & 63, wave = __builtin_amdgcn_readfirstlane(tid >> 6); int blk = blockIdx.x; asm volatile("" : "+s"(blk)); \
    const int gw = blk * NWAVES + wave; const size_t gtid = (size_t)blk * NTHR + tid; (void)lane; (void)gw; (void)gtid; (void)ws;
#if ONE_LAUNCH
#define PH_SEAM() do { XcdBarrier b_; b_.bar = (unsigned*)(KA_LOAD()->ws + WS_CTL) + CW_BAR; b_.x = xb_xcc_id(); b_.st = (volatile LAS unsigned*)(lds + MISC_OFF); xcd_barrier(b_); } while (0)
#else
#define PH_SEAM() do {} while (0)
#endif
#define PH_END() PH_SEAM(); } }
#define PH_END_NOSEAM() } }
#define WSP(type, off) ((type*)(ws + (off)))
constexpr int G = GRID, NGW = GRID * NWAVES; constexpr size_t GTHREADS = (size_t)GRID * NTHR;
template <int L> __device__ __forceinline__ void layer_phases(LAS unsigned char* lds) {
    constexpr int l = L; LAS int* tabL = (LAS int*)(lds + MISC_OFF + 256);

        const int j = l >> 1; const bool moba = (l & 1) != 0;
        const int NC = moba ? NC_M : NC_H, qoff = moba ? 2304 : 3072;

        if (l == 0) {
        PH_BEGIN(1)
            phase_weights((LAS float*)(lds + wave * 16384), gw, NGW, lane, ka->in[2], NC_H, ka->in[6], 4, ka->in[7], ka->in[12], ka->in[14], ka->in[16], WSP(bf16, WS_WIN), WSP(bf16, WS_WKV4), WSP(bf16, WS_WO), WSP(bf16, WS_WGU), WSP(bf16, WS_WD));
        PH_END()
        }
        PH_BEGIN(2)
            { pg8::Gemm g{WSP(bf16, WS_XBF), WSP(bf16, WS_WIN), T, NC, D, 0, 0}; pg8::StaticOrder S; S.init(T, NC, G, blk); pg8::EpiPlain E{WSP(bf16, WS_H), NC, moba ? 0x207u : 0x1000u, 0.125f * 1.4426950408889634f};
              pg8::gemm_phase<pg8::EpiPlain, pg8::StaticOrder, true, true>(lds, g, S, E); }
            if (l == 0) {
              pg8::Gemm g{WSP(bf16, WS_MEMBF), WSP(bf16, WS_WKV4), 512, 2048, D, 0, 0}; pg8::StaticOrder S; S.init(512, 2048, G, blk >= 128 ? blk - 128 : G); pg8::EpiPlain E{WSP(bf16, WS_KV4), 2048, 0u, 1.f};
              pg8::gemm_phase<pg8::EpiPlain, pg8::StaticOrder, true, true>(lds, g, S, E); }
        PH_END()
        if (!moba) {
            PH_BEGIN(3)
                for (int u = blk; u < NBATCH * HG_H * HNSEG; u += G) hgrn_mfma<false>(lds, WSP(bf16, WS_H), ka->in[3], j, ka->in[4] + j * 128, WSP(float, WS_SLOC), WSP(float, WS_DSEG), WSP(bf16, WS_MIX), u, tid, wave, lane);
                for (int u = blk; u < 512; u += G) memattn_unit2(lds, WSP(bf16, WS_H), NC, qoff, WSP(bf16, WS_KV4) + 512 * l, WSP(bf16, WS_MIX), u, tid, wave, lane);
            PH_END()
            PH_BEGIN(4)
                hgrn_scan(WSP(float, WS_SLOC), WSP(float, WS_DSEG), gtid, GTHREADS);
            PH_END()
            PH_BEGIN(5)
                for (int u = blk; u < NBATCH * HG_H * HNSEG; u += G) hgrn_mfma<true>(lds, WSP(bf16, WS_H), ka->in[3], j, ka->in[4] + j * 128, WSP(float, WS_SLOC), WSP(float, WS_DSEG), WSP(bf16, WS_MIX), u, tid, wave, lane);
            PH_END()
        } else {
            PH_BEGIN(3)
                for (int u = blk; u < 24 * MB_NB; u += G) kmean_unit(lds, WSP(bf16, WS_H), WSP(float, WS_KMEAN), u, tid);
                for (int u = blk; u < 512; u += G) memattn_unit2(lds, WSP(bf16, WS_H), NC, qoff, WSP(bf16, WS_KV4) + 512 * l, WSP(bf16, WS_MIX), u, tid, wave, lane);
            PH_END()
            PH_BEGIN(4)
                for (int u = blk; u < 24 * MB_NB; u += G) moba_gate_unit(lds, WSP(bf16, WS_H), WSP(float, WS_KMEAN), WSP(unsigned, WS_CTL) + CW_GCOUNT + j * 1536, WSP(int, WS_SELINFO), WSP(unsigned, WS_LIST), u, tid);
            PH_END()
            PH_BEGIN(5)
                for (int r = 0; r * G < 24 * MB_NB; ++r) { const int it = r * G + ((r & 1) ? (G - 1 - blk) : blk);
                    if (it < 24 * MB_NB) moba_attn_item2(lds, WSP(bf16, WS_H), WSP(unsigned, WS_CTL) + CW_GCOUNT + j * 1536, WSP(unsigned, WS_LIST), WSP(bf16, WS_PO), WSP(float, WS_PML), it, tid, wave, lane); }
            PH_END()
            PH_BEGIN(6)
                moba_combine(WSP(bf16, WS_PO), WSP(float, WS_PML), WSP(int, WS_SELINFO), WSP(bf16, WS_MIX), gw, NGW, lane);
            PH_END()
        }
        PH_BEGIN(7)
            pg8::Gemm g{WSP(bf16, WS_MIX), WSP(bf16, WS_WO), T, D, D, 0, 0}; pg8::StaticOrder S; S.init(T, D, G, blk); pg8::EpiPlain E{WSP(bf16, WS_Y), D, 0u, 1.f};
            pg8::gemm_phase<pg8::EpiPlain, pg8::StaticOrder, true, true>(lds, g, S, E);
        PH_END()
        PH_BEGIN(8)
            phase_ln1(lds, WSP(bf16, WS_Y), ka->in[8] + l * D, ka->in[9] + l * D, WSP(bf16, WS_WRS) + (size_t)l * 2 * NE * D, ka->in[11] + l * NE, WSP(bf16, WS_XBF),
                      WSP(int, WS_TOK + TOK_E), WSP(int, WS_TOK + TOK_LR), WSP(float, WS_TOK + TOK_W), WSP(int, WS_TOK + TOK_BLKCNT), blk, tid, wave, lane);
        PH_END()
        PH_BEGIN(9)
            phase_dispatch(lds, WSP(int, WS_TOK + TOK_BLKCNT), WSP(int, WS_TOK + TOK_E), WSP(int, WS_TOK + TOK_LR), WSP(int, WS_TOK + TOK_ROW), WSP(int, WS_TOK + TOK_TAB), WSP(bf16, WS_XBF), WSP(bf16, WS_XS), blk, tid, wave, lane);
        PH_END()
        PH_BEGIN(10)
            if (tid < 33) tabL[tid] = WSP(int, WS_TOK + TOK_TAB)[tid];
            __syncthreads();
            int sw_ = 0x7A7A7A7A, sx_ = 0x7F7F7F7F; asm volatile("" : "+s"(sw_), "+s"(sx_));
            pg8::Gemm g{WSP(bf16, WS_XS), WSP(bf16, WS_WGU), MOE_MAXROWS, NE * 2048, D / 2, sw_, sx_}; pg8::MoeOrder S{tabL, 8, G, blk, tabL[32] * 8};
            pg8::EpiSwiglu E{WSP(unsigned char, WS_HID), ka->in[13] + (size_t)l * NE * 1024, ka->in[15] + (size_t)l * NE * 1024};
            pg8::gemm_phase<pg8::EpiSwiglu, pg8::MoeOrder, true, true, true>(lds, g, S, E);
        PH_END()
        PH_BEGIN(11)
            if (tid < 33) tabL[tid] = WSP(int, WS_TOK + TOK_TAB)[tid];
            __syncthreads();
            int sw_ = 0x79797979, sx_ = 0x7F7F7F7F; asm volatile("" : "+s"(sw_), "+s"(sx_));
            pg8::Gemm g{WSP(bf16, WS_HID), WSP(bf16, WS_WD), MOE_MAXROWS, NE * 1024, D / 2, sw_, sx_}; pg8::MoeOrder S{tabL, 4, G, blk, tabL[32] * 4};
            pg8::EpiDown E{WSP(unsigned char, WS_XS), ka->in[17] + (size_t)l * NE * 1024};
            pg8::gemm_phase<pg8::EpiDown, pg8::MoeOrder, true, true, true>(lds, g, S, E);
        PH_END()
        PH_BEGIN(12)
            float* x2out = (l == DEPTH - 1) ? ka->out : nullptr;
            phase_ln2(WSP(unsigned char, WS_XS), WSP(int, WS_TOK + TOK_ROW), WSP(float, WS_TOK + TOK_W), ka->in[18] + l * D, ka->in[19] + l * D, x2out, WSP(bf16, WS_XBF), gw, NGW, lane);
            if (l + 1 < DEPTH) { constexpr int ln = l + 1, jn = ln >> 1; constexpr bool mn = (ln & 1) != 0;
                const float* win_src = mn ? ka->in[5] + (size_t)jn * D * NC_M : ka->in[2] + (size_t)jn * D * NC_H; const size_t moff = (size_t)ln * NE * 1024 * 1024;
                phase_weights((LAS float*)(lds + wave * 16384), gw, NGW, lane, win_src, mn ? NC_M : NC_H, ka->in[6], 0, ka->in[7] + (size_t)ln * D * D,
                              ka->in[12] + moff, ka->in[14] + moff, ka->in[16] + moff, WSP(bf16, WS_WIN), WSP(bf16, WS_WKV4), WSP(bf16, WS_WO), WSP(bf16, WS_WGU), WSP(bf16, WS_WD)); }
            if (l + 1 < DEPTH) PH_SEAM();
        PH_END_NOSEAM()
}
__global__ void __launch_bounds__(NTHR, 2) fwd_kernel(Args args) {
    extern __shared__ __attribute__((aligned(16))) unsigned char lds_raw[];
    LAS unsigned char* lds = (LAS unsigned char*)lds_raw;
    if (threadIdx.x < 4) ((LAS unsigned*)(lds + MISC_OFF))[threadIdx.x] = 0u;
    __syncthreads();
#if ONE_LAUNCH
    (void)xcd_barrier_post((unsigned*)(args.ws + WS_CTL) + CW_BAR, (volatile LAS unsigned*)(lds + MISC_OFF));
#endif
    { const int l = 0; (void)l;
    PH_BEGIN(0)
        cvt_rows_bf16(ka->in[0], WSP(bf16, WS_XBF), (size_t)T * D / 8, gtid, GTHREADS);
        cvt_rows_bf16(ka->in[1], WSP(bf16, WS_MEMBF), (size_t)512 * D / 8, gtid, GTHREADS);
        split_router_weights(ka->in[10], WSP(bf16, WS_WRS), gtid, GTHREADS);
    PH_END_NOSEAM() }
    layer_phases<0>(lds); layer_phases<1>(lds); layer_phases<2>(lds); layer_phases<3>(lds);
}

extern "C" void kernel_launch(void* const* d_in, const int* in_sizes, int n_in, void* d_out, int out_size, void* d_ws, size_t ws_size, hipStream_t stream) {
    static int ready = 0;
    if (ready == 0) {
        if (n_in != 20 || in_sizes[0] != T * D || out_size != T * D || ws_size < WS_END) { fprintf(stderr, "kernel_launch: unexpected shapes (n_in %d, in0 %d, out %d, ws %zu < %zu)\n", n_in, n_in > 0 ? in_sizes[0] : -1, out_size, ws_size, (size_t)WS_END); ready = -1; return; }
        if (hipFuncSetAttribute((const void*)fwd_kernel, hipFuncAttributeMaxDynamicSharedMemorySize, LDS_BYTES) != hipSuccess) { fprintf(stderr, "kernel_launch: hipFuncSetAttribute failed\n"); ready = -1; return; }
        int per_cu = 0;
        if (hipOccupancyMaxActiveBlocksPerMultiprocessor(&per_cu, (const void*)fwd_kernel, NTHR, LDS_BYTES) != hipSuccess || per_cu < 1) fprintf(stderr, "kernel_launch: occupancy query says %d\n", per_cu);
        (void)hipGetLastError();
        ready = 1;
    }
    if (ready < 0) return;
    if (hipMemsetAsync((char*)d_ws + WS_CTL, 0, CTL_ZERO_BYTES, stream) != hipSuccess) return;
    Args a{};
    for (int i = 0; i < 20; ++i) a.in[i] = (const float*)d_in[i];
    a.out = (float*)d_out; a.ws = (unsigned char*)d_ws;
    a.l_lo = 0; a.l_hi = DEPTH; a.ph_lo = 0; a.ph_hi = NPHASE;
    hipLaunchKernelGGL(fwd_kernel, dim3(GRID), dim3(NTHR), LDS_BYTES, stream, a);
}
```

```cpp
#include <hip/hip_runtime.h>
#include <cstdio>
#include <cstdint>
#include <cmath>
namespace pg8 {
#define PG8_LAS __attribute__((address_space(3)))
typedef unsigned short bf16_t;
typedef short bf16x8 __attribute__((ext_vector_type(8)));
typedef float f32x4 __attribute__((ext_vector_type(4)));
typedef unsigned u32x4 __attribute__((ext_vector_type(4)));
constexpr int BM = 256, BK = 64, HALF = 128, HTB = HALF * BK * 2  , STAGE_BYTES = 8 * HTB, NXCD = 8, WGM = 8;

__host__ __device__ __forceinline__ int lds_byte(int r, int c) { const int st = (r >> 4) * 2 + (c >> 5), rr = r & 15, cc = c & 31, ob = rr * 64 + cc * 2; return st * 1024 + (ob ^ (((ob >> 9) & 1) << 5)); }
__host__ __device__ __forceinline__ void stage_rc(int b, int& R, int& C) { const int st = b / 1024, sb = b % 1024, swz = sb ^ (((sb >> 9) & 1) << 5); R = (st >> 1) * 16 + swz / 64; C = (st & 1) * 32 + (swz % 64) / 2; }
__host__ __device__ __forceinline__ int perm32(int rho) { const int n = rho >> 4, i = rho & 15; return 8 * (i >> 2) + 4 * n + (i & 3); }

struct Unit { int pm, pn; };
struct Gemm { const bf16_t* A; const bf16_t* Bt; int M, N, K; int sw, sx; };
typedef int i32x8 __attribute__((ext_vector_type(8))); typedef int i32x4 __attribute__((ext_vector_type(4)));

struct StaticOrder {
    int nM, nN, nwg, G, c;
    __host__ __device__ void init(int M, int N, int G_, int c_) { nM = M / BM; nN = N / BM; nwg = nM * nN; G = G_; c = c_; }
    __host__ __device__ bool next(int i, Unit& u) const {
        const long L = (long)i * G + c; if (L >= nwg) return false;
        int wgid = (int)L; { const int q = nwg / NXCD, r = nwg % NXCD, xcd = wgid % NXCD, off = wgid / NXCD; wgid = (xcd < r ? xcd * (q + 1) : r * (q + 1) + (xcd - r) * q) + off; }
        const int nig = WGM * nN, gid = wgid / nig, fm = gid * WGM, gsz = (nM - fm) < WGM ? (nM - fm) : WGM;
        u.pm = fm + ((wgid % nig) % gsz); u.pn = (wgid % nig) / gsz; return true;
    }
    __device__ __forceinline__ void a_ready(const Unit&) const {}
    __device__ __forceinline__ void done(const Unit&) const {}
};

__device__ __forceinline__ unsigned cvt_pk_bf16(float lo, float hi) { unsigned r; asm volatile("v_cvt_pk_bf16_f32 %0, %1, %2" : "=v"(r) : "v"(lo), "v"(hi)); return r; }
typedef float f32x2 __attribute__((ext_vector_type(2)));
struct EpiPlain {
    static constexpr bool PERM = true, AFTER_DRAIN = false;
    bf16_t* O; int ldc; unsigned smask; float sc;
    __device__ __forceinline__ void operator()(const f32x4 (&acc)[2][2][4][2], const Unit& u, int wr, int wc, int fr, int fq) const {
        const int row0 = u.pm * BM + wr * 64 + fr; const int col0 = u.pn * BM + wc * 32 + 8 * fq; const float s = ((smask >> u.pn) & 1u) ? sc : 1.f;
#pragma unroll
        for (int ai = 0; ai < 2; ++ai)
#pragma unroll
            for (int m = 0; m < 4; ++m) { bf16_t* rowp = O + (size_t)(row0 + ai * HALF + m * 16) * ldc + col0;
#pragma unroll
                for (int bj = 0; bj < 2; ++bj) { const f32x4 v0 = acc[ai][bj][m][0] * s, v1 = acc[ai][bj][m][1] * s;
                    u32x4 w; w.x = cvt_pk_bf16(v0[0], v0[1]); w.y = cvt_pk_bf16(v0[2], v0[3]); w.z = cvt_pk_bf16(v1[0], v1[1]); w.w = cvt_pk_bf16(v1[2], v1[3]);
                    *(u32x4*)(rowp + bj * HALF) = w; } }
    }
};
__device__ __forceinline__ float swiglu1(float g, float u) {
    g = fminf(g, 7.0f); u = fminf(fmaxf(u, -7.0f), 7.0f);
    const float s = __builtin_amdgcn_rcpf(1.0f + __builtin_amdgcn_exp2f(g * (-1.702f * 1.4426950408889634f)));
    return g * s * (u + 1.0f);
}
__device__ __forceinline__ unsigned pk4_fp8e(float a, float b, float c, float d) { int w = 0; w = __builtin_amdgcn_cvt_pk_fp8_f32(a, b, w, false); w = __builtin_amdgcn_cvt_pk_fp8_f32(c, d, w, true); return (unsigned)w; }
struct EpiSwiglu {
    static constexpr bool PERM = true, AFTER_DRAIN = false;
    unsigned char* hid; const float* bg; const float* bu;
    __device__ __forceinline__ void operator()(const f32x4 (&acc)[2][2][4][2], const Unit& u, int wr, int wc, int fr, int fq) const {
        const int e = u.pn >> 3, pn = u.pn & 7;
        const int row0 = u.pm * BM + wr * 64 + fr; const int col0 = pn * 128 + wc * 32 + 8 * fq;
        const f32x4 g0 = *(const f32x4*)(bg + e * 1024 + col0), g1 = *(const f32x4*)(bg + e * 1024 + col0 + 4);
        const f32x4 u0 = *(const f32x4*)(bu + e * 1024 + col0), u1 = *(const f32x4*)(bu + e * 1024 + col0 + 4);
#pragma unroll
        for (int ai = 0; ai < 2; ++ai)
#pragma unroll
            for (int m = 0; m < 4; ++m) { unsigned char* rowp = hid + (size_t)(row0 + ai * HALF + m * 16) * 1024 + col0;
                const f32x4 ga = acc[ai][0][m][0] + g0, gb = acc[ai][0][m][1] + g1, ua = acc[ai][1][m][0] + u0, ub = acc[ai][1][m][1] + u1;
                typedef unsigned u32x2 __attribute__((ext_vector_type(2))); u32x2 w;
                w.x = pk4_fp8e(swiglu1(ga[0], ua[0]), swiglu1(ga[1], ua[1]), swiglu1(ga[2], ua[2]), swiglu1(ga[3], ua[3]));
                w.y = pk4_fp8e(swiglu1(gb[0], ub[0]), swiglu1(gb[1], ub[1]), swiglu1(gb[2], ub[2]), swiglu1(gb[3], ub[3]));
                *(u32x2*)rowp = w; }
    }
};
struct EpiDown {
    static constexpr bool PERM = true, AFTER_DRAIN = false;
    unsigned char* y; const float* bd;
    __device__ __forceinline__ void operator()(const f32x4 (&acc)[2][2][4][2], const Unit& u, int wr, int wc, int fr, int fq) const {
        const int e = u.pn >> 2, pn = u.pn & 3;
        const int row0 = u.pm * BM + wr * 64 + fr; const int col0 = pn * BM + wc * 32 + 8 * fq;
        f32x4 bv[2][2];
#pragma unroll
        for (int bj = 0; bj < 2; ++bj)
#pragma unroll
            for (int n = 0; n < 2; ++n) bv[bj][n] = *(const f32x4*)(bd + e * 1024 + col0 + bj * HALF + 4 * n);
#pragma unroll
        for (int ai = 0; ai < 2; ++ai)
#pragma unroll
            for (int m = 0; m < 4; ++m) { unsigned char* rowp = y + (size_t)(row0 + ai * HALF + m * 16) * 1024 + col0;
#pragma unroll
                for (int bj = 0; bj < 2; ++bj) { const f32x4 v0 = (acc[ai][bj][m][0] + bv[bj][0]) * 16.f, v1 = (acc[ai][bj][m][1] + bv[bj][1]) * 16.f;
                    typedef unsigned u32x2 __attribute__((ext_vector_type(2))); u32x2 w; w.x = pk4_fp8e(v0[0], v0[1], v0[2], v0[3]); w.y = pk4_fp8e(v1[0], v1[1], v1[2], v1[3]);
                    *(u32x2*)(rowp + bj * HALF) = w; } }
    }
};
struct MoeOrder {
    const PG8_LAS int* tab; int npn, G, c, nunits;
    __device__ __forceinline__ bool next(int i, Unit& u) const {
        const int tpx = 32 / npn, s = c >> 3, tile = (i * 8 + (c & 7)) * tpx + s / npn, pn = s % npn;
        if ((i * 8) * tpx >= nunits / npn) return false;
        if (tile >= nunits / npn) { u.pm = 0; u.pn = 0; return false; }
        int e = 0;
#pragma unroll
        for (int k = 1; k < 32; ++k) e += (tab[k] <= tile) ? 1 : 0;
        u.pm = tile; u.pn = __builtin_amdgcn_readfirstlane(e) * npn + pn; return true;
    }
    __device__ __forceinline__ void a_ready(const Unit&) const {}
    __device__ __forceinline__ void done(const Unit&) const {}
};
template <class Epi, class Sched, bool ALIGN_EPI = false, bool SP2 = false, bool F8 = false>
__device__ __forceinline__ void gemm_phase(PG8_LAS unsigned char* lds, const Gemm g, const Sched& S, const Epi& E) {
    int tid_ = threadIdx.x; asm volatile("" : "+v"(tid_));
    const int tid = tid_, wid = __builtin_amdgcn_readfirstlane(tid >> 6), lane = tid & 63, wr = wid >> 2, wc = wid & 3, fr = lane & 15, fq = lane >> 4;
    const int K = g.K, nt = K / BK;
    unsigned voffA, voffB;
    { int R, C; stage_rc(tid * 16, R, C); const int Rb = Epi::PERM ? ((R & ~31) + perm32(R & 31)) : R; voffA = (unsigned)(R * K + C) * 2u; voffB = (unsigned)(Rb * K + C) * 2u; }
    const unsigned qstep = 64u * (unsigned)K * 2u;
    const unsigned kstep = (unsigned)(BK * 2);
    const unsigned hstep = (unsigned)HALF * (unsigned)K * 2u;
    const unsigned tstep = 2u * hstep;
    const __amdgpu_buffer_rsrc_t rA = __builtin_amdgcn_make_buffer_rsrc((void*)g.A, 0, 0x7FFFFFFF, 0x00020000), rB = __builtin_amdgcn_make_buffer_rsrc((void*)g.Bt, 0, 0x7FFFFFFF, 0x00020000);
    const unsigned ldsw = (unsigned)wid * 1024u;
    const int aoff = lds_byte(wr * 64 + fr, fq * 8), boff = lds_byte(wc * 32 + fr, fq * 8);
#define PG8_SA(b, h) (((b) * 2 + (h)) * HTB)
#define PG8_SB(b, h) ((4 + (b) * 2 + (h)) * HTB)
#define PG8_STG(bufoff, rsrc, soff, voff) do { _Pragma("unroll") for (int _i = 0; _i < 2; ++_i) \
        __builtin_amdgcn_raw_ptr_buffer_load_lds((rsrc), (PG8_LAS void*)(lds + (bufoff) + ldsw + _i * 8192), 16, (int)(voff), (int)((soff) + (unsigned)_i * qstep), 0, 0); } while (0)
#define PG8_STGA(bufoff, soff) PG8_STG(bufoff, rA, soff, voffA)
#define PG8_STGB(bufoff, soff) PG8_STG(bufoff, rB, soff, voffB)
#define PG8_LDA(dst, b, h) do { _Pragma("unroll") for (int m = 0; m < 4; ++m) { if constexpr (F8) { const i32x4 lo_ = *(const PG8_LAS i32x4*)(lds + PG8_SA(b, h) + aoff + m * 2048), hi_ = *(const PG8_LAS i32x4*)(lds + PG8_SA(b, h) + aoff + m * 2048 + 1024); \
            dst##_8[m] = __builtin_shufflevector(lo_, hi_, 0, 1, 2, 3, 4, 5, 6, 7); } else { _Pragma("unroll") for (int k = 0; k < 2; ++k) dst[m][k] = *(const PG8_LAS bf16x8*)(lds + PG8_SA(b, h) + aoff + m * 2048 + k * 1024); } } } while (0)
#define PG8_LDB(dst, b, h) do { _Pragma("unroll") for (int n = 0; n < 2; ++n) { if constexpr (F8) { const i32x4 lo_ = *(const PG8_LAS i32x4*)(lds + PG8_SB(b, h) + boff + n * 2048), hi_ = *(const PG8_LAS i32x4*)(lds + PG8_SB(b, h) + boff + n * 2048 + 1024); \
            dst##_8[n] = __builtin_shufflevector(lo_, hi_, 0, 1, 2, 3, 4, 5, 6, 7); } else { _Pragma("unroll") for (int k = 0; k < 2; ++k) dst[n][k] = *(const PG8_LAS bf16x8*)(lds + PG8_SB(b, h) + boff + n * 2048 + k * 1024); } } } while (0)
#define PG8_MMA(ai, bj, At, Bt) do { __builtin_amdgcn_s_setprio(1); _Pragma("unroll") for (int m = 0; m < 4; ++m) _Pragma("unroll") for (int n = 0; n < 2; ++n) { \
        if constexpr (F8) acc[ai][bj][m][n] = __builtin_amdgcn_mfma_scale_f32_16x16x128_f8f6f4(Bt##_8[n], At##_8[m], acc[ai][bj][m][n], 0, 0, 0, g.sw, 0, g.sx); \
        else { _Pragma("unroll") for (int k = 0; k < 2; ++k) acc[ai][bj][m][n] = __builtin_amdgcn_mfma_f32_16x16x32_bf16(Bt[n][k], At[m][k], acc[ai][bj][m][n], 0, 0, 0); } } \
        __builtin_amdgcn_s_setprio(0); } while (0)
#define PG8_WAIT_V(n) asm volatile("s_waitcnt vmcnt(" #n ")" ::: "memory")
#define PG8_WAIT_L(n) asm volatile("s_waitcnt lgkmcnt(" #n ")" ::: "memory")
#define PG8_BAR __builtin_amdgcn_s_barrier()
#define PG8_SCHED __builtin_amdgcn_sched_barrier(0)
    Unit cur, nxt; int ui = 0;
    if (!S.next(0, cur)) return;
    f32x4 acc[2][2][4][2];
#pragma unroll
    for (int a = 0; a < 2; ++a)
#pragma unroll
        for (int b = 0; b < 2; ++b)
#pragma unroll
            for (int m = 0; m < 4; ++m)
#pragma unroll
                for (int n = 0; n < 2; ++n) acc[a][b][m][n] = (f32x4){0.f, 0.f, 0.f, 0.f};
    bf16x8 At[4][2], B0[2][2], B1[2][2]; i32x8 At_8[4], B0_8[2], B1_8[2];
    unsigned cA = (unsigned)cur.pm * tstep, cB = (unsigned)cur.pn * tstep;
    S.a_ready(cur);
    if constexpr (SP2) {
        PG8_STGB(PG8_SB(0, 0), cB); PG8_STGB(PG8_SB(0, 1), cB + hstep); PG8_STGA(PG8_SA(0, 0), cA); PG8_STGA(PG8_SA(0, 1), cA + hstep);
        if (wr == 1) PG8_BAR;
        PG8_WAIT_V(2); PG8_BAR;
        PG8_STGB(PG8_SB(1, 0), cB + kstep); PG8_STGA(PG8_SA(1, 0), cA + kstep); PG8_STGB(PG8_SB(1, 1), cB + hstep + kstep);
        PG8_WAIT_V(6); PG8_BAR;
    } else {
        PG8_STGB(PG8_SB(0, 0), cB); PG8_STGA(PG8_SA(0, 0), cA); PG8_STGB(PG8_SB(0, 1), cB + hstep); PG8_STGA(PG8_SA(0, 1), cA + hstep);
        if (wr == 1) PG8_BAR;
        PG8_WAIT_V(4); PG8_BAR;
        PG8_STGB(PG8_SB(1, 0), cB + kstep); PG8_STGA(PG8_SA(1, 0), cA + kstep); PG8_STGB(PG8_SB(1, 1), cB + hstep + kstep);
        PG8_WAIT_V(6); PG8_BAR;
    }
    for (;;) {
        const bool has_next = S.next(ui + 1, nxt);
        const unsigned nA = has_next ? (unsigned)nxt.pm * tstep : cA, nB = has_next ? (unsigned)nxt.pn * tstep : cB;
#pragma unroll 1
        for (int t = 0; t < nt; t += 2) {
            const bool last = (t == nt - 2);
            const unsigned a1 = cA + (unsigned)(t + 1) * kstep;
            const unsigned a2 = last ? nA : cA + (unsigned)(t + 2) * kstep, b2 = last ? nB : cB + (unsigned)(t + 2) * kstep;
            const unsigned a3 = a2 + kstep, b3 = b2 + kstep;
            if (last && has_next) S.a_ready(nxt);
            if constexpr (SP2) {
            PG8_LDB(B0, 0, 0); PG8_LDB(B1, 0, 1); PG8_SCHED; PG8_LDA(At, 0, 0); PG8_STGA(PG8_SA(1, 1), a1 + hstep);
            PG8_WAIT_V(8); PG8_WAIT_L(0); PG8_BAR; PG8_MMA(0, 0, At, B0); PG8_MMA(0, 1, At, B1); PG8_BAR; PG8_SCHED;
            PG8_LDA(At, 0, 1); PG8_STGB(PG8_SB(0, 0), b2); PG8_STGB(PG8_SB(0, 1), b2 + hstep); PG8_STGA(PG8_SA(0, 0), a2);
            PG8_WAIT_V(8); PG8_WAIT_L(0); PG8_BAR; PG8_MMA(1, 0, At, B0); PG8_MMA(1, 1, At, B1); PG8_BAR; PG8_SCHED;
            PG8_LDB(B0, 1, 0); PG8_LDB(B1, 1, 1); PG8_SCHED; PG8_LDA(At, 1, 0); PG8_STGA(PG8_SA(0, 1), a2 + hstep);
            PG8_WAIT_V(8); PG8_WAIT_L(0); PG8_BAR; PG8_MMA(0, 0, At, B0); PG8_MMA(0, 1, At, B1); PG8_BAR; PG8_SCHED;
            PG8_LDA(At, 1, 1); PG8_STGB(PG8_SB(1, 0), b3); PG8_STGB(PG8_SB(1, 1), b3 + hstep); PG8_STGA(PG8_SA(1, 0), a3);
            PG8_WAIT_V(8); PG8_WAIT_L(0); PG8_BAR; PG8_MMA(1, 0, At, B0); PG8_MMA(1, 1, At, B1); PG8_BAR; PG8_SCHED;
            } else {
            PG8_LDB(B0, 0, 0); PG8_SCHED; PG8_LDA(At, 0, 0); PG8_STGA(PG8_SA(1, 1), a1 + hstep);
            PG8_WAIT_L(8); PG8_BAR; PG8_WAIT_L(0); PG8_MMA(0, 0, At, B0); PG8_BAR; PG8_SCHED;
            PG8_LDB(B1, 0, 1); PG8_STGB(PG8_SB(0, 0), b2);
            PG8_BAR; PG8_WAIT_L(0); PG8_MMA(0, 1, At, B1); PG8_BAR;
            PG8_LDA(At, 0, 1); PG8_STGA(PG8_SA(0, 0), a2);
            PG8_BAR; PG8_WAIT_L(0); PG8_MMA(1, 0, At, B0); PG8_BAR; PG8_SCHED;
            PG8_STGB(PG8_SB(0, 1), b2 + hstep);
            PG8_WAIT_V(6); PG8_BAR; PG8_MMA(1, 1, At, B1); PG8_BAR;
            PG8_LDB(B0, 1, 0); PG8_SCHED; PG8_LDA(At, 1, 0); PG8_STGA(PG8_SA(0, 1), a2 + hstep);
            PG8_WAIT_L(8); PG8_BAR; PG8_WAIT_L(0); PG8_MMA(0, 0, At, B0); PG8_BAR; PG8_SCHED;
            PG8_LDB(B1, 1, 1); PG8_STGB(PG8_SB(1, 0), b3);
            PG8_BAR; PG8_WAIT_L(0); PG8_MMA(0, 1, At, B1); PG8_BAR;
            PG8_LDA(At, 1, 1); PG8_STGA(PG8_SA(1, 0), a3);
            PG8_BAR; PG8_WAIT_L(0); PG8_MMA(1, 0, At, B0); PG8_BAR; PG8_SCHED;
            PG8_STGB(PG8_SB(1, 1), b3 + hstep);
            PG8_WAIT_V(6); PG8_BAR; PG8_MMA(1, 1, At, B1); PG8_BAR;
            }
        }
        if constexpr (ALIGN_EPI) { if (wr == 0) PG8_BAR; }
        if constexpr (!Epi::AFTER_DRAIN) { int t2_ = threadIdx.x; asm volatile("" : "+v"(t2_)); E(acc, cur, wr, wc, t2_ & 15, (t2_ & 63) >> 4); S.done(cur); }
        if (!has_next) break;
#pragma unroll
        for (int a = 0; a < 2; ++a)
#pragma unroll
            for (int b = 0; b < 2; ++b)
#pragma unroll
                for (int m = 0; m < 4; ++m)
#pragma unroll
                    for (int n = 0; n < 2; ++n) acc[a][b][m][n] = (f32x4){0.f, 0.f, 0.f, 0.f};
        cur = nxt; cA = nA; cB = nB; ++ui;
        if constexpr (ALIGN_EPI) { if (wr == 1) PG8_BAR; }
    }
    PG8_WAIT_V(0);
    if constexpr (!ALIGN_EPI) { if (wr == 0) PG8_BAR; }
    PG8_BAR;
    if constexpr (Epi::AFTER_DRAIN) { E.fused(acc, cur, wr, wc, fr, fq, lds, wid, lane); S.done(cur); }
#undef PG8_SA
#undef PG8_SB
#undef PG8_STG
#undef PG8_STGA
#undef PG8_STGB
#undef PG8_LDA
#undef PG8_LDB
#undef PG8_MMA
#undef PG8_WAIT_V
#undef PG8_WAIT_L
#undef PG8_BAR
#undef PG8_SCHED
}
}

constexpr int NWAVES = 8, NTHR = 512, GRID = 256;
constexpr int NBATCH = 2, SEQ = 16384, T = NBATCH * SEQ, D = 1024, DEPTH = 4;
constexpr int MIXW = 768, NC_H = 3328, NC_M = 2560;
constexpr int HG_H = 6;
constexpr int HSEG = 256, HNSEG = SEQ / HSEG;
constexpr int MB_H = 12, MB_NB = 64;
constexpr int NE = 32;
constexpr float DN_ALPHA = 1.6817928305074290f;
constexpr int MOE_MAXROWS = T * 4 + NE * 256;
#ifndef ONE_LAUNCH
#define ONE_LAUNCH 1
#endif
constexpr int NPHASE = 13;

constexpr size_t MiB = 1u << 20;
constexpr size_t WS_CTL = 0, CTL_ZERO_BYTES = 1 * MiB;
constexpr size_t WS_WIN = 1 * MiB, WS_WKV = 9 * MiB, WS_WO = 10 * MiB, WS_WGU = 12 * MiB, WS_WD = 140 * MiB;
constexpr size_t WS_XBF = 204 * MiB, WS_WKV4 = 268 * MiB  , WS_KV4 = 272 * MiB  , WS_WRS = 280 * MiB  , WS_MEMBF = 524 * MiB;
constexpr size_t WS_H = 526 * MiB, WS_MIX = 734 * MiB, WS_Y = 798 * MiB, WS_SLOC = 862 * MiB, WS_DSEG = 910 * MiB, WS_KMEAN = 911 * MiB;
constexpr size_t WS_SELINFO = 912 * MiB, WS_TOK = 914 * MiB, WS_R1 = 918 * MiB;
constexpr size_t WS_LIST = WS_R1, WS_PML = WS_R1 + 96 * MiB, WS_PO = WS_R1 + 108 * MiB;
constexpr size_t WS_XS = WS_R1, WS_HID = WS_R1 + 272 * MiB;
constexpr size_t WS_END = WS_R1 + 544 * MiB;
static_assert((size_t)MOE_MAXROWS * 1024 * 2 <= 272 * MiB, "moe rows");
static_assert((size_t)T * MB_H * 4 * 64 * 4 <= 384 * MiB && (size_t)24 * 64 * 16384 * 4 <= 96 * MiB, "moba bufs");
constexpr size_t TOK_E = 0, TOK_LR = 512 * 1024, TOK_W = 1024 * 1024, TOK_ROW = 1536 * 1024, TOK_BLKCNT = 2048 * 1024, TOK_TAB = 2048 * 1024 + 65536;
constexpr int CW_BAR = 4096, CW_GCOUNT = 8192;

constexpr int RING_BYTES = 131072, LDS_BYTES = 147456, MISC_OFF = LDS_BYTES - 1024;

#define GAS __attribute__((address_space(1)))
#define LAS __attribute__((address_space(3)))
typedef unsigned short bf16;
typedef unsigned v4u __attribute__((ext_vector_type(4)));
typedef unsigned v2u __attribute__((ext_vector_type(2)));
typedef float f32x4 __attribute__((ext_vector_type(4)));
typedef float f32x2 __attribute__((ext_vector_type(2)));
typedef short s16x8 __attribute__((ext_vector_type(8)));
typedef float f32x16 __attribute__((ext_vector_type(16)));
typedef float f32x2_t __attribute__((ext_vector_type(2))); typedef __bf16 bf16x2_t __attribute__((ext_vector_type(2)));
__device__ __forceinline__ unsigned cvtpk(float lo, float hi) { f32x2_t v = {lo, hi}; bf16x2_t b = __builtin_convertvector(v, bf16x2_t); return __builtin_bit_cast(unsigned, b); }
#define LDS_WAIT() asm volatile("s_waitcnt lgkmcnt(0)" ::: "memory")
__device__ __forceinline__ unsigned f2bf(float f) { unsigned u = __builtin_bit_cast(unsigned, f); return (u + 0x7fffu + ((u >> 16) & 1u)) >> 16; }
__device__ __forceinline__ unsigned pk2(float lo, float hi) { return f2bf(lo) | (f2bf(hi) << 16); }
__device__ __forceinline__ float bflo(unsigned w) { return __builtin_bit_cast(float, w << 16); }
__device__ __forceinline__ float bfhi(unsigned w) { return __builtin_bit_cast(float, w & 0xffff0000u); }
__device__ __forceinline__ float bf2f(bf16 h) { return __builtin_bit_cast(float, (unsigned)h << 16); }
__device__ __forceinline__ float sigmoidf_(float z) { return __builtin_amdgcn_rcpf(1.0f + __builtin_amdgcn_exp2f(-1.4426950408889634f * z)); }
template <int X> __device__ __forceinline__ float xorf(float v) { return __builtin_bit_cast(float, __builtin_amdgcn_ds_swizzle(__builtin_bit_cast(int, v), (X << 10) | 0x1F)); }
template <int X> __device__ __forceinline__ int xori(int v) { return __builtin_amdgcn_ds_swizzle(v, (X << 10) | 0x1F); }
__device__ __forceinline__ float wave_sum(float v) {
    v += xorf<1>(v); v += xorf<2>(v); v += xorf<4>(v); v += xorf<8>(v); v += xorf<16>(v);
    return __builtin_bit_cast(float, __builtin_amdgcn_readlane(__builtin_bit_cast(int, v), 0)) + __builtin_bit_cast(float, __builtin_amdgcn_readlane(__builtin_bit_cast(int, v), 32));
}
__device__ __forceinline__ float wave_max(float v) {
    v = fmaxf(v, xorf<1>(v)); v = fmaxf(v, xorf<2>(v)); v = fmaxf(v, xorf<4>(v)); v = fmaxf(v, xorf<8>(v)); v = fmaxf(v, xorf<16>(v));
    return fmaxf(__builtin_bit_cast(float, __builtin_amdgcn_readlane(__builtin_bit_cast(int, v), 0)), __builtin_bit_cast(float, __builtin_amdgcn_readlane(__builtin_bit_cast(int, v), 32)));
}
__device__ __forceinline__ float xor32f(float v, int lane) { return __builtin_bit_cast(float, __builtin_amdgcn_ds_bpermute((lane ^ 32) << 2, __builtin_bit_cast(int, v))); }
#define XB_TMO      128
#define XB_XCNT(j)  (256  + 64 * (j))
#define XB_XSUB(j)  (1280 + 64 * (j))
#define XB_XGEN(j)  (2304 + 64 * (j))
#define XB_TOP      3328
#define XB_TOPGEN   3392
#define XCD_BAR_WORDS 3456
#define XB_SPIN_CAP (1u << 18)

__device__ __forceinline__ unsigned xb_ld(unsigned* p)              { return __hip_atomic_load(p, __ATOMIC_RELAXED, __HIP_MEMORY_SCOPE_AGENT); }
__device__ __forceinline__ unsigned xb_add(unsigned* p, unsigned v) { return __hip_atomic_fetch_add(p, v, __ATOMIC_RELAXED, __HIP_MEMORY_SCOPE_AGENT); }
__device__ __forceinline__ unsigned xb_xcc_id() { return (unsigned)__builtin_amdgcn_s_getreg((3 << 11) | 20) & 0xFu; }
#define XB_SPIN(cond, bar) do { unsigned _sp = 0; while (cond) { __builtin_amdgcn_s_sleep(1); \
    if ((++_sp & 255u) == 0u) { if (xb_ld(&(bar)[XB_TMO])) break; if (_sp > XB_SPIN_CAP) { atomicAdd(&(bar)[XB_TMO], 1u); break; } } } } while (0)

struct XcdBarrier {
    unsigned* bar; unsigned x;
    volatile LAS unsigned* st;
};

__device__ __forceinline__ XcdBarrier xcd_barrier_post(unsigned* bar, volatile LAS unsigned* st) {
    XcdBarrier b; b.bar = bar; b.x = xb_xcc_id(); b.st = st;
    if (threadIdx.x == 0) (void)xb_add(&bar[XB_XCNT(b.x)], 1u);
    return b;
}
__device__ __forceinline__ void xcd_barrier_complete(unsigned* bar, unsigned x, unsigned& nloc, unsigned& nx) {
    const unsigned G = gridDim.x * gridDim.y * gridDim.z;
    unsigned sum, cnt, mine, sp = 0u;
    for (;;) {
        sum = 0u; cnt = 0u; mine = 0u;
#pragma unroll
        for (unsigned j = 0; j < 16; ++j) { const unsigned c = xb_ld(&bar[XB_XCNT(j)]); sum += c; cnt += (c > 0u) ? 1u : 0u; mine = (j == x) ? c : mine; }
        if (sum == G) break;
        __builtin_amdgcn_s_sleep(1);
        if ((++sp & 255u) == 0u) { if (xb_ld(&bar[XB_TMO])) break; if (sp > XB_SPIN_CAP) { atomicAdd(&bar[XB_TMO], 1u); break; } }
    }
    nloc = mine > 0u ? mine : 1u; nx = cnt > 0u ? cnt : 1u;
}

__device__ __forceinline__ void xcd_barrier(const XcdBarrier& b) {
    asm volatile("s_waitcnt vmcnt(0)" ::: "memory");
    __syncthreads();
    if (threadIdx.x == 0) {
        unsigned* bar = b.bar;
        __builtin_amdgcn_s_waitcnt(0);
        unsigned nloc = b.st[0], nx = b.st[1];
        if (nloc == 0u) { xcd_barrier_complete(bar, b.x, nloc, nx); b.st[0] = nloc; b.st[1] = nx; }
        const unsigned old = xb_add(&bar[XB_XSUB(b.x)], 1u);
        const unsigned gen = old / nloc;
        if (old + 1u == (gen + 1u) * nloc) {
            __builtin_amdgcn_fence(__ATOMIC_RELEASE, "agent");
            asm volatile("s_waitcnt vmcnt(0)" ::: "memory");
            const unsigned og = xb_add(&bar[XB_TOP], 1u);
            const unsigned tg = og / nx;
            if (og + 1u == (tg + 1u) * nx) xb_add(&bar[XB_TOPGEN], 1u);
            else XB_SPIN(xb_ld(&bar[XB_TOPGEN]) == tg, bar);
            __builtin_amdgcn_fence(__ATOMIC_ACQUIRE, "agent");
            xb_add(&bar[XB_XGEN(b.x)], 1u);
            asm volatile("s_waitcnt vmcnt(0)" ::: "memory");
        } else {
            XB_SPIN(xb_ld(&bar[XB_XGEN(b.x)]) == gen, bar);
            __builtin_amdgcn_fence(__ATOMIC_ACQUIRE, "agent");
            asm volatile("s_waitcnt vmcnt(0)" ::: "memory");
        }
    }
    __syncthreads();
}

__device__ __forceinline__ void cvt_rows_bf16(const float* src, bf16* dst, size_t n8, size_t gtid, size_t gthreads) {
    for (size_t i = gtid; i < n8; i += gthreads) { const f32x4 a = ((const f32x4*)src)[2 * i], b = ((const f32x4*)src)[2 * i + 1];
        v4u o; o.x = pk2(a.x, a.y); o.y = pk2(a.z, a.w); o.z = pk2(b.x, b.y); o.w = pk2(b.z, b.w); ((v4u*)dst)[i] = o; }
}
__device__ __forceinline__ void transpose_item(const float* W, int N, bf16* WT, int dst_row0, LAS float* scr, int k0, int n0, int lane) {
#pragma unroll 8
    for (int i = 0; i < 32; ++i) { const int kk = 2 * i + (lane >> 5); scr[kk * 33 + (lane & 31)] = W[(size_t)(k0 + kk) * N + n0 + (lane & 31)]; }
    LDS_WAIT(); asm volatile("" ::: "memory");
    const int c = lane & 7;
#pragma unroll
    for (int j = 0; j < 4; ++j) { const int n = (lane >> 3) + 8 * j; const LAS float* s = scr + (8 * c) * 33 + n;
        v4u o; o.x = pk2(s[0 * 33], s[1 * 33]); o.y = pk2(s[2 * 33], s[3 * 33]); o.z = pk2(s[4 * 33], s[5 * 33]); o.w = pk2(s[6 * 33], s[7 * 33]);
        *(v4u*)(WT + (size_t)(dst_row0 + n) * 1024 + k0 + 8 * c) = o; }
    LDS_WAIT(); asm volatile("" ::: "memory");
}
__device__ __forceinline__ unsigned pk4_fp8(float a, float b, float c, float d) { int w = 0; w = __builtin_amdgcn_cvt_pk_fp8_f32(a, b, w, false); w = __builtin_amdgcn_cvt_pk_fp8_f32(c, d, w, true); return (unsigned)w; }
__device__ __forceinline__ void transpose_item_f8(const float* W, int N, unsigned char* WT8, int dst_row0, LAS float* scr, int k0, int n0, int lane, float wscale) {
#pragma unroll 8
    for (int i = 0; i < 32; ++i) { const int kk = 2 * i + (lane >> 5); scr[kk * 33 + (lane & 31)] = W[(size_t)(k0 + kk) * N + n0 + (lane & 31)]; }
    LDS_WAIT(); asm volatile("" ::: "memory");
    const int c = lane & 7;
#pragma unroll
    for (int j = 0; j < 4; ++j) { const int n = (lane >> 3) + 8 * j; const LAS float* s = scr + (8 * c) * 33 + n;
        v2u o; o.x = pk4_fp8(s[0 * 33] * wscale, s[1 * 33] * wscale, s[2 * 33] * wscale, s[3 * 33] * wscale); o.y = pk4_fp8(s[4 * 33] * wscale, s[5 * 33] * wscale, s[6 * 33] * wscale, s[7 * 33] * wscale);
        *(v2u*)(WT8 + (size_t)(dst_row0 + n) * 1024 + k0 + 8 * c) = o; }
    LDS_WAIT(); asm volatile("" ::: "memory");
}
__device__ __forceinline__ void phase_weights(LAS float* scr, int gw, int ngw, int lane, const float* win_src, int NC, const float* wkv_src, int nkv, const float* wo_src,
                                              const float* wg_src, const float* wu_src, const float* wd_src, bf16* win_t, bf16* wkv_t, bf16* wo_t, bf16* wgu_t, bf16* wd_t) {
    const int nbw = NC / 32, nWin = nbw * 16, NIT = nWin + 256 * nkv + 512 + NE * 1536;
    for (int it = gw; it < NIT; it += ngw) {
        int r = it;
        if (r < nWin) { const int kb = r / nbw, nb = r - kb * nbw; transpose_item(win_src, NC, win_t, 32 * nb, scr, 64 * kb, 32 * nb, lane); continue; } r -= nWin;
        if (r < 256 * nkv) { const int lay = r >> 8, rr = r & 255, kb = rr >> 4, nb = rr & 15; transpose_item(wkv_src + (size_t)lay * D * 512, 512, wkv_t + (size_t)lay * 512 * 1024, 32 * nb, scr, 64 * kb, 32 * nb, lane); continue; } r -= 256 * nkv;
        if (r < 512) { const int kb = r >> 5, nb = r & 31; transpose_item(wo_src, 1024, wo_t, 32 * nb, scr, 64 * kb, 32 * nb, lane); continue; } r -= 512;
        const int e = r / 1536, q = r - e * 1536, which = q >> 9, rr = q & 511, kb = rr >> 5, nb = rr & 31, n0 = 32 * nb;
        const size_t eoff = (size_t)e * 1024 * 1024;
        if (which == 0) transpose_item_f8(wg_src + eoff, 1024, (unsigned char*)wgu_t + 2 * eoff, (n0 >> 7) * 256 + (n0 & 127), scr, 64 * kb, n0, lane, 32.f);
        else if (which == 1) transpose_item_f8(wu_src + eoff, 1024, (unsigned char*)wgu_t + 2 * eoff, (n0 >> 7) * 256 + 128 + (n0 & 127), scr, 64 * kb, n0, lane, 32.f);
        else transpose_item_f8(wd_src + eoff, 1024, (unsigned char*)wd_t + eoff, n0, scr, 64 * kb, n0, lane, 64.f);
    }
}

template <bool OUT>
__device__ __forceinline__ void hgrn_seg(LAS unsigned char* lds, const bf16* h, const float* lbl, int j, const float* normg, float* Sloc, float* Dseg, bf16* mix, int unit, int tid, int wave, int lane) {
    const int seg = unit & (HNSEG - 1), bh = unit >> 6, hh = bh % HG_H, b = bh / HG_H;
    const int v = tid & 127, dg = tid >> 7;
    LAS float* fgs = (LAS float*)lds; LAS float* vs = fgs + 4096; LAS float* qs = vs + 4096; LAS float* op = qs + 4096;
    f32x2 st[16];
    float* Sp = Sloc + (size_t)unit * 16384 + (size_t)(dg * 32) * 128 + v;
#pragma unroll
    for (int dd = 0; dd < 16; ++dd) { st[dd].x = OUT ? Sp[(2 * dd) * 128] : 0.f; st[dd].y = OUT ? Sp[(2 * dd + 1) * 128] : 0.f; }
    float dprod = 1.f;
    const int stok = tid >> 4, c8 = (tid & 15) * 8;
    float lb[8];
#pragma unroll
    for (int i = 0; i < 8; ++i) { lb[i] = 0.f; if (j > 0) { const float a0 = lbl[hh * 128 + c8 + i], a1 = lbl[MIXW + hh * 128 + c8 + i]; lb[i] = 1.f / (1.f + __expf(a0 - a1)); } }
    for (int ch = 0; ch < HSEG / 32; ++ch) {
        const size_t t0 = (size_t)b * SEQ + seg * HSEG + ch * 32;
        { const bf16* row = h + (t0 + stok) * NC_H + hh * 128 + c8;
          const v4u f8 = *(const v4u*)(row + 768), i8 = *(const v4u*)(row + 1536); v4u q8 = {0u, 0u, 0u, 0u}; if (OUT) q8 = *(const v4u*)row;
#pragma unroll
          for (int w = 0; w < 4; ++w) { const float f0 = bflo(f8[w]), f1 = bfhi(f8[w]); const int o = stok * 128 + c8 + 2 * w;
              fgs[o] = lb[2 * w] + (1.f - lb[2 * w]) * sigmoidf_(f0); fgs[o + 1] = lb[2 * w + 1] + (1.f - lb[2 * w + 1]) * sigmoidf_(f1);
              vs[o] = bflo(i8[w]); vs[o + 1] = bfhi(i8[w]);
              if (OUT) { const float q0 = bflo(q8[w]), q1 = bfhi(q8[w]); qs[o] = q0 * sigmoidf_(q0); qs[o + 1] = q1 * sigmoidf_(q1); } } }
        __syncthreads();
        if (!OUT) { if (tid < 128) { for (int tt = 0; tt < 32; ++tt) dprod *= fgs[tt * 128 + tid]; } }
        f32x4 fA[8], qA[8], fB[8], qB[8]; float vA, vB;
#define HG_LOAD(F, Q, V, tt_) do { V = vs[(tt_) * 128 + v]; _Pragma("unroll") for (int d4 = 0; d4 < 8; ++d4) { F[d4] = *(const LAS f32x4*)(fgs + (tt_) * 128 + dg * 32 + d4 * 4); \
            if (OUT) Q[d4] = *(const LAS f32x4*)(qs + (tt_) * 128 + dg * 32 + d4 * 4); } } while (0)
#define HG_STEP(F, Q, V, tt_) do { const f32x2 vv2 = {V, V}; f32x2 acc2 = {0.f, 0.f}; _Pragma("unroll") for (int d4 = 0; d4 < 8; ++d4) { \
            const f32x2 fa = {F[d4].x, F[d4].y}, fb = {F[d4].z, F[d4].w}; \
            st[2 * d4] = fa * (st[2 * d4] - vv2) + vv2; st[2 * d4 + 1] = fb * (st[2 * d4 + 1] - vv2) + vv2; \
            if (OUT) { const f32x2 qa = {Q[d4].x, Q[d4].y}, qb = {Q[d4].z, Q[d4].w}; acc2 = qa * st[2 * d4] + acc2; acc2 = qb * st[2 * d4 + 1] + acc2; } } \
            if (OUT) op[(dg * 32 + (tt_)) * 128 + v] = acc2.x + acc2.y; } while (0)
        HG_LOAD(fA, qA, vA, 0);
#pragma unroll 1
        for (int tt = 0; tt < 32; tt += 2) {
            HG_LOAD(fB, qB, vB, tt + 1);
            __builtin_amdgcn_sched_barrier(0);
            HG_STEP(fA, qA, vA, tt);
            __builtin_amdgcn_sched_barrier(0);
            if (tt + 2 < 32) HG_LOAD(fA, qA, vA, tt + 2);
            __builtin_amdgcn_sched_barrier(0);
            HG_STEP(fB, qB, vB, tt + 1);
            __builtin_amdgcn_sched_barrier(0);
        }
#undef HG_LOAD
#undef HG_STEP
        if (OUT) {
            __syncthreads();
#pragma unroll
            for (int k = 0; k < 4; ++k) { const int tt = wave + 8 * k; float o0 = 0.f, o1 = 0.f;
#pragma unroll
                for (int g = 0; g < 4; ++g) { o0 += op[(g * 32 + tt) * 128 + lane]; o1 += op[(g * 32 + tt) * 128 + lane + 64]; }
                const float ms = wave_sum(o0 * o0 + o1 * o1) * (1.f / 128.f), r = 1.f / sqrtf(ms + 1e-6f);
                const bf16* grow = h + (t0 + tt) * NC_H + 2304 + hh * 128; const float g0 = bf2f(grow[lane]), g1 = bf2f(grow[lane + 64]);
                bf16* mrow = mix + (t0 + tt) * 1024 + hh * 128;
                mrow[lane] = (bf16)f2bf(o0 * r * normg[lane] * sigmoidf_(g0)); mrow[lane + 64] = (bf16)f2bf(o1 * r * normg[lane + 64] * sigmoidf_(g1)); }
        }
        __syncthreads();
    }
    if (!OUT) {
#pragma unroll
        for (int dd = 0; dd < 16; ++dd) { Sp[(2 * dd) * 128] = st[dd].x; Sp[(2 * dd + 1) * 128] = st[dd].y; }
        if (tid < 128) Dseg[(size_t)unit * 128 + tid] = dprod;
    }
}
constexpr int HG_G = 0, HG_QT = 32768, HG_KT = 50176, HG_KE = 67584, HG_VT = 86016, HG_ST = 104448, HG_GM = 139264, HG_GE = 139776, HG_PART = 140288;
static_assert(HG_PART + 2048 <= MISC_OFF, "HGRN LDS map");
__device__ __forceinline__ int crow16(int i, int hf) { return (i & 3) + 8 * (i >> 2) + 4 * hf; }
template <bool OUT>
__device__ __forceinline__ void hgrn_mfma(LAS unsigned char* lds, const bf16* h, const float* lbl, int j, const float* normg, float* Sloc, float* Dseg, bf16* mix, int unit, int tid, int wave, int lane) {
    const int seg = unit & (HNSEG - 1), bh = unit >> 6, hh = bh % HG_H, b = bh / HG_H;
    const int r = lane & 31, hf = lane >> 5, tr = wave & 1, vq = wave >> 1;
    LAS float* G = (LAS float*)(lds + HG_G); LAS float* GM = (LAS float*)(lds + HG_GM); LAS float* GE = (LAS float*)(lds + HG_GE); LAS float* PART = (LAS float*)(lds + HG_PART);
    const int stok = tid >> 3, c16 = (tid & 7) * 16, sperm = (stok & ~15) | (stok & 3) | ((stok & 4) << 1) | ((stok & 8) >> 1);
    const int cd = tid & 127, cpart = tid >> 7;
    float lb[16];
#pragma unroll
    for (int e = 0; e < 16; ++e) { lb[e] = 0.f; if (j > 0) { const float a0 = lbl[hh * 128 + c16 + e], a1 = lbl[MIXW + hh * 128 + c16 + e]; lb[e] = 1.f / (1.f + __expf(a0 - a1)); } }
    f32x16 S[2];
    float* Sp = Sloc + (size_t)unit * 16384 + 32 * vq + r;
#pragma unroll
    for (int dd = 0; dd < 2; ++dd)
#pragma unroll
        for (int i = 0; i < 16; ++i) S[dd][i] = OUT ? Sp[(32 * (2 * tr + dd) + crow16(i, hf)) * 128] : 0.f;
    float gsum = 0.f;
    float ng16[16];
#pragma unroll
    for (int e = 0; e < 16; ++e) ng16[e] = OUT ? normg[c16 + e] : 0.f;
    v4u nf8[2], ni8[2], nq8[2] = {{0u, 0u, 0u, 0u}, {0u, 0u, 0u, 0u}}, ng8[2] = {{0u, 0u, 0u, 0u}, {0u, 0u, 0u, 0u}};
#define HG_RAWLOAD(t0_) do { const bf16* row_ = h + ((t0_) + stok) * NC_H + hh * 128 + c16; nf8[0] = *(const v4u*)(row_ + 768); nf8[1] = *(const v4u*)(row_ + 776); ni8[0] = *(const v4u*)(row_ + 1536); ni8[1] = *(const v4u*)(row_ + 1544); \
        if (OUT) { nq8[0] = *(const v4u*)row_; nq8[1] = *(const v4u*)(row_ + 8); ng8[0] = *(const v4u*)(row_ + 2304); ng8[1] = *(const v4u*)(row_ + 2312); } } while (0)
    HG_RAWLOAD((size_t)b * SEQ + seg * HSEG);
    for (int ch = 0; ch < HSEG / 64; ++ch) {
        const size_t t0 = (size_t)b * SEQ + seg * HSEG + ch * 64;
        float fg[16], qv[16]; v4u i8[2], g8[2];
        { const v4u f8[2] = {nf8[0], nf8[1]}; i8[0] = ni8[0]; i8[1] = ni8[1]; const v4u q8[2] = {nq8[0], nq8[1]}; g8[0] = ng8[0]; g8[1] = ng8[1];
#pragma unroll
          for (int w = 0; w < 8; ++w) { const unsigned fw = f8[w >> 2][w & 3]; const float f0 = bflo(fw), f1 = bfhi(fw);
              fg[2 * w] = lb[2 * w] + (1.f - lb[2 * w]) * sigmoidf_(f0); fg[2 * w + 1] = lb[2 * w + 1] + (1.f - lb[2 * w + 1]) * sigmoidf_(f1);
              if (OUT) { const unsigned qw = q8[w >> 2][w & 3]; const float q0 = bflo(qw), q1 = bfhi(qw); qv[2 * w] = q0 * sigmoidf_(q0); qv[2 * w + 1] = q1 * sigmoidf_(q1); } else { qv[2 * w] = 0.f; qv[2 * w + 1] = 0.f; } }
#pragma unroll
          for (int e4 = 0; e4 < 4; ++e4) { f32x4 lg; lg.x = __builtin_amdgcn_logf(fg[4 * e4]); lg.y = __builtin_amdgcn_logf(fg[4 * e4 + 1]); lg.z = __builtin_amdgcn_logf(fg[4 * e4 + 2]); lg.w = __builtin_amdgcn_logf(fg[4 * e4 + 3]);
              *(LAS f32x4*)(G + stok * 128 + c16 + 4 * e4) = lg; } }
        __syncthreads();
        { float run = 0.f;
#pragma unroll
          for (int k = 0; k < 16; ++k) run += G[(16 * cpart + k) * 128 + cd];
          PART[cpart * 128 + cd] = run; }
        __syncthreads();
        { float run = 0.f;
#pragma unroll
          for (int pp = 0; pp < 3; ++pp) run += (pp < cpart) ? PART[pp * 128 + cd] : 0.f;
#pragma unroll
          for (int k = 0; k < 16; ++k) { run += G[(16 * cpart + k) * 128 + cd]; G[(16 * cpart + k) * 128 + cd] = run; }
          if (cpart == 1) GM[cd] = run;
          if (cpart == 3) { GE[cd] = run; gsum += run; } }
        __syncthreads();
        if (OUT) {
#pragma unroll
            for (int dd = 0; dd < 2; ++dd)
#pragma unroll
                for (int g4 = 0; g4 < 4; ++g4) { const int dbase = 32 * (2 * tr + dd) + 8 * g4 + 4 * hf; const f32x4 gm = *(const LAS f32x4*)(GM + dbase);
                    v2u w; w.x = cvtpk(S[dd][4 * g4] * __builtin_amdgcn_exp2f(gm.x), S[dd][4 * g4 + 1] * __builtin_amdgcn_exp2f(gm.y)); w.y = cvtpk(S[dd][4 * g4 + 2] * __builtin_amdgcn_exp2f(gm.z), S[dd][4 * g4 + 3] * __builtin_amdgcn_exp2f(gm.w));
                    *(LAS v2u*)(lds + HG_ST + (32 * vq + r) * 272 + dbase * 2) = w; }
        }
        { unsigned qt[8], kt[8];
#pragma unroll
          for (int e4 = 0; e4 < 4; ++e4) { const f32x4 gv = *(const LAS f32x4*)(G + stok * 128 + c16 + 4 * e4), gm = *(const LAS f32x4*)(GM + c16 + 4 * e4), ge = *(const LAS f32x4*)(GE + c16 + 4 * e4);
              float ke[4];
#pragma unroll
              for (int e = 0; e < 4; ++e) { const float kk = 1.f - fg[4 * e4 + e]; ke[e] = kk * __builtin_amdgcn_exp2f(ge[e] - gv[e]);
                  if (OUT) { const float a = qv[4 * e4 + e] * __builtin_amdgcn_exp2f(gv[e] - gm[e]), c = kk * __builtin_amdgcn_exp2f(gm[e] - gv[e]);
                      if (e & 1) { qt[2 * e4 + (e >> 1)] |= f2bf(a) << 16; kt[2 * e4 + (e >> 1)] |= f2bf(c) << 16; } else { qt[2 * e4 + (e >> 1)] = f2bf(a); kt[2 * e4 + (e >> 1)] = f2bf(c); } } }
#pragma unroll
              for (int e = 0; e < 4; ++e) { const int col = c16 + 4 * e4 + e;
                  *(LAS bf16*)(lds + HG_KE + col * 144 + sperm * 2) = (bf16)f2bf(ke[e]);
                  const unsigned vw = i8[e4 >> 1][(2 * e4 + (e >> 1)) & 3]; *(LAS bf16*)(lds + HG_VT + col * 144 + sperm * 2) = (bf16)((e & 1) ? (vw >> 16) : (vw & 0xffffu)); } }
          if (OUT) { *(LAS v4u*)(lds + HG_QT + stok * 272 + c16 * 2) = (v4u){qt[0], qt[1], qt[2], qt[3]}; *(LAS v4u*)(lds + HG_QT + stok * 272 + c16 * 2 + 16) = (v4u){qt[4], qt[5], qt[6], qt[7]};
                     *(LAS v4u*)(lds + HG_KT + stok * 272 + c16 * 2) = (v4u){kt[0], kt[1], kt[2], kt[3]}; *(LAS v4u*)(lds + HG_KT + stok * 272 + c16 * 2 + 16) = (v4u){kt[4], kt[5], kt[6], kt[7]}; } }
        __syncthreads();
        if (ch + 1 < HSEG / 64) HG_RAWLOAD(t0 + 64);
        if (OUT) {
            f32x16 X0, X1, O;
#pragma unroll
            for (int i = 0; i < 16; ++i) { X0[i] = 0.f; X1[i] = 0.f; O[i] = 0.f; }
            const LAS unsigned char* qtp = lds + HG_QT + (32 * tr + r) * 272 + hf * 16;
#pragma unroll
            for (int ks = 0; ks < 8; ++ks) { const s16x8 bq = *(const LAS s16x8*)(qtp + ks * 32);
                const s16x8 a0 = *(const LAS s16x8*)(lds + HG_KT + r * 272 + hf * 16 + ks * 32); X0 = __builtin_amdgcn_mfma_f32_32x32x16_bf16(a0, bq, X0, 0, 0, 0);
                if (tr == 1) { const s16x8 a1 = *(const LAS s16x8*)(lds + HG_KT + (32 + r) * 272 + hf * 16 + ks * 32); X1 = __builtin_amdgcn_mfma_f32_32x32x16_bf16(a1, bq, X1, 0, 0, 0); } }
#pragma unroll
            for (int i = 0; i < 16; ++i) { const bool keep = crow16(i, hf) <= r; if (tr == 0) X0[i] = keep ? X0[i] : 0.f; else X1[i] = keep ? X1[i] : 0.f; }
            const LAS unsigned char* vtp = lds + HG_VT + (32 * vq + r) * 144 + hf * 16;
#pragma unroll
            for (int s2 = 0; s2 < 2; ++s2) { v4u pw; pw.x = cvtpk(X0[8 * s2], X0[8 * s2 + 1]); pw.y = cvtpk(X0[8 * s2 + 2], X0[8 * s2 + 3]); pw.z = cvtpk(X0[8 * s2 + 4], X0[8 * s2 + 5]); pw.w = cvtpk(X0[8 * s2 + 6], X0[8 * s2 + 7]);
                const s16x8 bv = *(const LAS s16x8*)(vtp + (16 * s2) * 2); O = __builtin_amdgcn_mfma_f32_32x32x16_bf16(__builtin_bit_cast(s16x8, pw), bv, O, 0, 0, 0); }
            if (tr == 1) {
#pragma unroll
                for (int s2 = 0; s2 < 2; ++s2) { v4u pw; pw.x = cvtpk(X1[8 * s2], X1[8 * s2 + 1]); pw.y = cvtpk(X1[8 * s2 + 2], X1[8 * s2 + 3]); pw.z = cvtpk(X1[8 * s2 + 4], X1[8 * s2 + 5]); pw.w = cvtpk(X1[8 * s2 + 6], X1[8 * s2 + 7]);
                    const s16x8 bv = *(const LAS s16x8*)(vtp + (32 + 16 * s2) * 2); O = __builtin_amdgcn_mfma_f32_32x32x16_bf16(__builtin_bit_cast(s16x8, pw), bv, O, 0, 0, 0); } }
            const LAS unsigned char* stp = lds + HG_ST + (32 * vq + r) * 272 + hf * 16;
#pragma unroll
            for (int ks = 0; ks < 8; ++ks) { const s16x8 aq = *(const LAS s16x8*)(qtp + ks * 32), bs = *(const LAS s16x8*)(stp + ks * 32); O = __builtin_amdgcn_mfma_f32_32x32x16_bf16(aq, bs, O, 0, 0, 0); }
#pragma unroll
            for (int i = 0; i < 16; ++i) G[(32 * tr + crow16(i, hf)) * 128 + 32 * vq + r] = O[i];
        }
#pragma unroll
        for (int dd = 0; dd < 2; ++dd) { const int dr = 2 * tr + dd;
#pragma unroll
            for (int g4 = 0; g4 < 4; ++g4) { const f32x4 ge = *(const LAS f32x4*)(GE + 32 * dr + 8 * g4 + 4 * hf);
                S[dd][4 * g4] *= __builtin_amdgcn_exp2f(ge.x); S[dd][4 * g4 + 1] *= __builtin_amdgcn_exp2f(ge.y); S[dd][4 * g4 + 2] *= __builtin_amdgcn_exp2f(ge.z); S[dd][4 * g4 + 3] *= __builtin_amdgcn_exp2f(ge.w); }
#pragma unroll
            for (int ks = 0; ks < 4; ++ks) { const s16x8 a = *(const LAS s16x8*)(lds + HG_KE + (32 * dr + r) * 144 + hf * 16 + ks * 32), bv = *(const LAS s16x8*)(lds + HG_VT + (32 * vq + r) * 144 + hf * 16 + ks * 32);
                S[dd] = __builtin_amdgcn_mfma_f32_32x32x16_bf16(a, bv, S[dd], 0, 0, 0); } }
        __syncthreads();
        if (OUT) {
            float ov[16]; float ss = 0.f;
#pragma unroll
            for (int e4 = 0; e4 < 4; ++e4) { const f32x4 o4 = *(const LAS f32x4*)(G + stok * 128 + c16 + 4 * e4); ov[4 * e4] = o4.x; ov[4 * e4 + 1] = o4.y; ov[4 * e4 + 2] = o4.z; ov[4 * e4 + 3] = o4.w;
                ss += (o4.x * o4.x + o4.y * o4.y) + (o4.z * o4.z + o4.w * o4.w); }
            ss += xorf<1>(ss); ss += xorf<2>(ss); ss += xorf<4>(ss);
            const float rr = 1.f / sqrtf(ss * (1.f / 128.f) + 1e-6f);
            unsigned ow[8];
#pragma unroll
            for (int w = 0; w < 8; ++w) { const unsigned gw_ = g8[w >> 2][w & 3]; ow[w] = cvtpk(ov[2 * w] * rr * ng16[2 * w] * sigmoidf_(bflo(gw_)), ov[2 * w + 1] * rr * ng16[2 * w + 1] * sigmoidf_(bfhi(gw_))); }
            bf16* mrow = mix + (t0 + stok) * 1024 + hh * 128 + c16;
            *(v4u*)mrow = (v4u){ow[0], ow[1], ow[2], ow[3]}; *(v4u*)(mrow + 8) = (v4u){ow[4], ow[5], ow[6], ow[7]};
            __syncthreads();
        }
    }
#undef HG_RAWLOAD
    if (!OUT) {
#pragma unroll
        for (int dd = 0; dd < 2; ++dd)
#pragma unroll
            for (int i = 0; i < 16; ++i) Sp[(32 * (2 * tr + dd) + crow16(i, hf)) * 128] = S[dd][i];
        if (cpart == 3) Dseg[(size_t)unit * 128 + cd] = __builtin_amdgcn_exp2f(gsum);
    }
}
__device__ __forceinline__ void hgrn_scan(float* Sloc, const float* Dseg, size_t gtid, size_t gthreads) {
    for (size_t idx = gtid; idx < (size_t)NBATCH * HG_H * 16384; idx += gthreads) { const int bh = (int)(idx >> 14), e = (int)(idx & 16383), d = e >> 7; float cur = 0.f;
        for (int seg = 0; seg < HNSEG; ++seg) { const size_t u = (size_t)bh * HNSEG + seg; float* p = Sloc + u * 16384 + e; const float tmp = *p; *p = cur; cur = Dseg[u * 128 + d] * cur + tmp; } }
}

template <bool MASK>
__device__ __forceinline__ void attn4(const LAS unsigned* Ks, const LAS bf16* Vs, const LAS float* qst, LAS float* pb, int lane, const int (&tq)[4], int kbase, float slope,
                                      float (&mo)[4], float (&lo)[4], float (&oo)[4]) {
    float sc[4][4];
#pragma unroll
    for (int a = 0; a < 4; ++a)
#pragma unroll
        for (int c = 0; c < 4; ++c) sc[a][c] = 0.f;
#pragma unroll 4
    for (int dd = 0; dd < 32; ++dd) {
        f32x2 qv[4];
#pragma unroll
        for (int qi = 0; qi < 4; ++qi) qv[qi] = *(const LAS f32x2*)(qst + qi * 64 + 2 * dd);
#pragma unroll
        for (int kk = 0; kk < 4; ++kk) { const unsigned kw = Ks[(lane + 64 * kk) * 33 + dd]; const float k0 = bflo(kw), k1 = bfhi(kw);
#pragma unroll
            for (int qi = 0; qi < 4; ++qi) sc[qi][kk] += qv[qi].x * k0 + qv[qi].y * k1; }
    }
#pragma unroll
    for (int qi = 0; qi < 4; ++qi) { float mx = -INFINITY;
#pragma unroll
        for (int kk = 0; kk < 4; ++kk) { const int pos = kbase + lane + 64 * kk; float lg = sc[qi][kk] * 0.125f - slope * (float)(tq[qi] - pos); if (MASK && pos > tq[qi]) lg = -INFINITY; sc[qi][kk] = lg; mx = fmaxf(mx, lg); }
        mx = wave_max(mx); float s = 0.f;
#pragma unroll
        for (int kk = 0; kk < 4; ++kk) { const float p = __builtin_amdgcn_exp2f((sc[qi][kk] - mx) * 1.4426950408889634f); pb[qi * 256 + lane + 64 * kk] = p; s += p; }
        lo[qi] = wave_sum(s); mo[qi] = mx; }
    float o[4] = {0.f, 0.f, 0.f, 0.f};
#pragma unroll 4
    for (int k4 = 0; k4 < 64; ++k4) { f32x4 p4[4];
#pragma unroll
        for (int qi = 0; qi < 4; ++qi) p4[qi] = *(const LAS f32x4*)(pb + qi * 256 + 4 * k4);
#pragma unroll
        for (int jj = 0; jj < 4; ++jj) { const float vv = bf2f(Vs[(4 * k4 + jj) * 64 + lane]);
#pragma unroll
            for (int qi = 0; qi < 4; ++qi) o[qi] += p4[qi][jj] * vv; } }
#pragma unroll
    for (int qi = 0; qi < 4; ++qi) oo[qi] = o[qi];
}
constexpr int AT_KS = 0, AT_VS = 33792, AT_WV = 66560, AT_WVB = 5120;

__device__ __forceinline__ void memattn_unit(LAS unsigned char* lds, const bf16* h, int NC, int qoff, const bf16* kv, bf16* mix, int unit, int tid, int wave, int lane) {
    const int chunk = unit & 31, bm = unit >> 5, mh = bm & 3, b = bm >> 2;
    LAS unsigned* Ks = (LAS unsigned*)(lds + AT_KS); LAS unsigned* Vs32 = (LAS unsigned*)(lds + AT_VS);
    LAS float* qst = (LAS float*)(lds + AT_WV + wave * AT_WVB); LAS float* pb = qst + 256;
    for (int i = 0; i < 16; ++i) { const int idx = tid + 512 * i, r = idx >> 5, dd = idx & 31; const unsigned* src = (const unsigned*)(kv + (size_t)(b * 256 + r) * 512 + mh * 64);
        Ks[r * 33 + dd] = src[dd]; Vs32[r * 32 + dd] = src[128 + dd]; }
    __syncthreads();
    for (int qd = 0; qd < 16; ++qd) { const size_t tg = (size_t)b * SEQ + chunk * 512 + wave * 64 + qd * 4;
#pragma unroll
        for (int qi = 0; qi < 4; ++qi) qst[qi * 64 + lane] = bf2f(h[(tg + qi) * NC + qoff + mh * 64 + lane]);
        const int tq[4] = {0, 0, 0, 0}; float m[4], l[4], o[4];
        attn4<false>(Ks, (const LAS bf16*)Vs32, qst, pb, lane, tq, 0, 0.f, m, l, o);
#pragma unroll
        for (int qi = 0; qi < 4; ++qi) mix[(tg + qi) * 1024 + MIXW + mh * 64 + lane] = (bf16)f2bf(o[qi] / l[qi]); }
    __syncthreads();
}

constexpr int AT2_K = 0, AT2_KROW = 176, AT2_V = 256 * AT2_KROW, AT2_VROW = 528, AT2_SCR = AT2_V + 64 * AT2_VROW, AT2_SCRW = 4864;
__device__ __forceinline__ void stage_kv_images(LAS unsigned char* lds, const bf16* kp, const bf16* vp, size_t row_stride, int tid) {
    v4u kx[4], vx[4];
#pragma unroll
    for (int i = 0; i < 4; ++i) { const int idx = tid + 512 * i, key = idx >> 3, c = idx & 7; kx[i] = *(const v4u*)(kp + (size_t)key * row_stride + 8 * c); vx[i] = *(const v4u*)(vp + (size_t)key * row_stride + 8 * c); }
    __builtin_amdgcn_sched_barrier(0);
#pragma unroll
    for (int i = 0; i < 4; ++i) { const int idx = tid + 512 * i, key = idx >> 3, c = idx & 7;
        *(LAS v4u*)(lds + AT2_K + key * AT2_KROW + c * 16) = kx[i];
        const int pos = (key & ~15) | (key & 3) | ((key & 4) << 1) | ((key & 8) >> 1);
        LAS bf16* vt = (LAS bf16*)(lds + AT2_V) + pos;
#pragma unroll
        for (int w = 0; w < 4; ++w) { vt[(8 * c + 2 * w) * (AT2_VROW / 2)] = (bf16)(vx[i][w] & 0xffffu); vt[(8 * c + 2 * w + 1) * (AT2_VROW / 2)] = (bf16)(vx[i][w] >> 16); } }
    if (tid < 256) { const unsigned pb = f2bf((float)tid); const v4u e0 = {pb | (pb << 16), 0u, 0u, 0u}, z = {0u, 0u, 0u, 0u};
        *(LAS v4u*)(lds + AT2_K + tid * AT2_KROW + 128) = e0; *(LAS v4u*)(lds + AT2_K + tid * AT2_KROW + 144) = z; }
}
template <bool MASK>
__device__ __forceinline__ void attn_tile32(const LAS unsigned char* lds, const s16x8 (&qf)[4], int lane, float dist0, unsigned qx, bool own, f32x16 (&o)[2], float& mrow, float& lrow) {
    const int r = lane & 31, hf = lane >> 5;
    const v4u qxv = {qx, 0u, 0u, 0u}; const s16x8 qe = __builtin_bit_cast(s16x8, qxv);
    f32x16 acc[8];
    const LAS unsigned char* kb = lds + AT2_K + r * AT2_KROW + hf * 16;
    constexpr int NKS = MASK ? 5 : 4;
    s16x8 kf[NKS];
#pragma unroll
    for (int s = 0; s < NKS; ++s) kf[s] = *(const LAS s16x8*)(kb + s * 32);
#pragma unroll
    for (int kt = 0; kt < 8; ++kt) {
#pragma unroll
        for (int i = 0; i < 16; ++i) acc[kt][i] = 0.f;
#pragma unroll
        for (int s = 0; s < NKS; ++s) { acc[kt] = __builtin_amdgcn_mfma_f32_32x32x16_bf16(kf[s], s < 4 ? qf[s < 4 ? s : 0] : qe, acc[kt], 0, 0, 0);
            if (kt + 1 < 8) kf[s] = *(const LAS s16x8*)(kb + (kt + 1) * 32 * AT2_KROW + s * 32); }
        __builtin_amdgcn_sched_barrier(0); }
    float mx = -INFINITY;
    if (MASK && own) { const float base2 = dist0 - 4.f * (float)hf;
#pragma unroll
        for (int kt = 0; kt < 8; ++kt)
#pragma unroll
            for (int i = 0; i < 16; ++i) { const float dist = base2 - (float)(32 * kt + (i & 3) + 8 * (i >> 2)); const float lg = dist < 0.f ? -INFINITY : acc[kt][i]; acc[kt][i] = lg; mx = fmaxf(mx, lg); }
    } else {
#pragma unroll
        for (int kt = 0; kt < 8; ++kt)
#pragma unroll
            for (int i = 0; i < 16; ++i) mx = fmaxf(mx, acc[kt][i]);
    }
    mx = fmaxf(mx, xor32f(mx, lane));
    float sum = 0.f;
#pragma unroll
    for (int i = 0; i < 16; ++i) { o[0][i] = 0.f; o[1][i] = 0.f; }
    const LAS unsigned char* vb = lds + AT2_V + r * AT2_VROW + hf * 16;
    s16x8 vf[4];
#pragma unroll
    for (int s2 = 0; s2 < 2; ++s2)
#pragma unroll
        for (int dt = 0; dt < 2; ++dt) vf[2 * s2 + dt] = *(const LAS s16x8*)(vb + dt * 32 * AT2_VROW + (16 * s2) * 2);
#pragma unroll
    for (int kt = 0; kt < 8; ++kt) {
#pragma unroll
        for (int i = 0; i < 16; ++i) { const float p = __builtin_amdgcn_exp2f(acc[kt][i] - mx); sum += p; acc[kt][i] = p; }
#pragma unroll
        for (int s2 = 0; s2 < 2; ++s2) { v4u pw; pw.x = cvtpk(acc[kt][8 * s2], acc[kt][8 * s2 + 1]); pw.y = cvtpk(acc[kt][8 * s2 + 2], acc[kt][8 * s2 + 3]);
            pw.z = cvtpk(acc[kt][8 * s2 + 4], acc[kt][8 * s2 + 5]); pw.w = cvtpk(acc[kt][8 * s2 + 6], acc[kt][8 * s2 + 7]); const s16x8 pf = __builtin_bit_cast(s16x8, pw);
#pragma unroll
            for (int dt = 0; dt < 2; ++dt) { o[dt] = __builtin_amdgcn_mfma_f32_32x32x16_bf16(vf[2 * s2 + dt], pf, o[dt], 0, 0, 0);
                if (kt + 1 < 8) vf[2 * s2 + dt] = *(const LAS s16x8*)(vb + dt * 32 * AT2_VROW + (32 * (kt + 1) + 16 * s2) * 2); } }
        __builtin_amdgcn_sched_barrier(0); }
    sum += xor32f(sum, lane);
    mrow = mx; lrow = sum;
}
__device__ __forceinline__ void memattn_unit2(LAS unsigned char* lds, const bf16* h, int NC, int qoff, const bf16* kv  , bf16* mix, int unit, int tid, int wave, int lane) {
    const int chunk = unit & 63, bm = unit >> 6, mh = bm & 3, b = bm >> 2, r = lane & 31, hf = lane >> 5;
    const bf16* kvrow0 = kv + (size_t)(b * 256) * 2048 + mh * 64;
    stage_kv_images(lds, kvrow0, kvrow0 + 256, 2048, tid);
    __syncthreads();
    { const size_t tg = (size_t)b * SEQ + chunk * 256 + wave * 32 + r;
        f32x16 o[2]; float m2, l; s16x8 qf[4];
#pragma unroll
        for (int s = 0; s < 4; ++s) qf[s] = *(const s16x8*)(h + tg * NC + qoff + mh * 64 + 16 * s + 8 * hf);
        attn_tile32<false>(lds, qf, lane, 0.f, 0u, false, o, m2, l);
        const float inv = 1.f / l; bf16* mp = mix + tg * 1024 + MIXW + mh * 64 + 4 * hf;
#pragma unroll
        for (int dt = 0; dt < 2; ++dt)
#pragma unroll
            for (int g = 0; g < 4; ++g) { v2u w; w.x = cvtpk(o[dt][4 * g] * inv, o[dt][4 * g + 1] * inv); w.y = cvtpk(o[dt][4 * g + 2] * inv, o[dt][4 * g + 3] * inv); *(v2u*)(mp + 32 * dt + 8 * g) = w; } }
    __syncthreads();
}
__device__ __forceinline__ void kmean_unit(LAS unsigned char* lds, const bf16* h, float* kmean, int unit, int tid) {
    const int n = unit & 63, bh = unit >> 6, hh = bh % MB_H, b = bh / MB_H, d = tid & 63, part = tid >> 6;
    LAS float* red = (LAS float*)lds;
    float s = 0.f; const bf16* p = h + ((size_t)b * SEQ + n * 256 + part * 32) * NC_M + 768 + hh * 64 + d;
    for (int i = 0; i < 32; ++i) s += bf2f(p[(size_t)i * NC_M]);
    red[part * 64 + d] = s; __syncthreads();
    if (tid < 64) { float a = 0.f; for (int pp = 0; pp < 8; ++pp) a += red[pp * 64 + tid]; kmean[((size_t)bh * 64 + n) * 64 + tid] = a * (1.f / 256.f); }
    __syncthreads();
}
__device__ __forceinline__ void moba_gate_unit(LAS unsigned char* lds, const bf16* h, const float* kmean, unsigned* gcount, int* selinfo, unsigned* list, int unit, int tid) {
    const int c = unit & 63, bh = unit >> 6, hh = bh % MB_H, b = bh / MB_H;
    LAS float* km = (LAS float*)lds; LAS int* hist = (LAS int*)(lds + 16384); LAS int* base = hist + 64;
    for (int i = tid; i < 4096; i += NTHR) km[i] = kmean[(size_t)bh * 4096 + i];
    if (tid < 64) hist[tid] = 0;
    __syncthreads();
    int s0 = 0, s1 = 0, s2 = 0, r0 = 0, r1 = 0, r2 = 0, ns = 0; const int t = c * 256 + tid;
    if (tid < 256) {
        float q[64]; const v4u* qp = (const v4u*)(h + ((size_t)b * SEQ + t) * NC_M + hh * 64);
#pragma unroll
        for (int w = 0; w < 8; ++w) { const v4u x = qp[w]; q[8 * w] = bflo(x.x); q[8 * w + 1] = bfhi(x.x); q[8 * w + 2] = bflo(x.y); q[8 * w + 3] = bfhi(x.y); q[8 * w + 4] = bflo(x.z); q[8 * w + 5] = bfhi(x.z); q[8 * w + 6] = bflo(x.w); q[8 * w + 7] = bfhi(x.w); }
        float v0 = -INFINITY, v1 = -INFINITY, v2 = -INFINITY;
        for (int n = 0; n < c; ++n) { float g = 0.f;
#pragma unroll
            for (int d4 = 0; d4 < 16; ++d4) { const f32x4 k4 = *(const LAS f32x4*)(km + n * 64 + 4 * d4); g += q[4 * d4] * k4.x + q[4 * d4 + 1] * k4.y + q[4 * d4 + 2] * k4.z + q[4 * d4 + 3] * k4.w; }
            if (g > v0) { v2 = v1; s2 = s1; v1 = v0; s1 = s0; v0 = g; s0 = n; } else if (g > v1) { v2 = v1; s2 = s1; v1 = g; s1 = n; } else if (g > v2) { v2 = g; s2 = n; } }
        ns = c < 3 ? c : 3;
        if (ns > 0) r0 = __hip_atomic_fetch_add(hist + s0, 1, __ATOMIC_RELAXED, __HIP_MEMORY_SCOPE_WORKGROUP);
        if (ns > 1) r1 = __hip_atomic_fetch_add(hist + s1, 1, __ATOMIC_RELAXED, __HIP_MEMORY_SCOPE_WORKGROUP);
        if (ns > 2) r2 = __hip_atomic_fetch_add(hist + s2, 1, __ATOMIC_RELAXED, __HIP_MEMORY_SCOPE_WORKGROUP);
        selinfo[((size_t)b * SEQ + t) * MB_H + hh] = ns;
    }
    __syncthreads();
    if (tid < 64) { const int hc = hist[tid]; if (hc > 0) base[tid] = (int)__hip_atomic_fetch_add(gcount + bh * 64 + tid, (unsigned)hc, __ATOMIC_RELAXED, __HIP_MEMORY_SCOPE_AGENT); }
    __syncthreads();
    if (tid < 256) { unsigned* lp = list + ((size_t)bh * 64 << 14);
        if (ns > 0) lp[((size_t)s0 << 14) + base[s0] + r0] = (unsigned)t;
        if (ns > 1) lp[((size_t)s1 << 14) + base[s1] + r1] = (unsigned)t | (1u << 14);
        if (ns > 2) lp[((size_t)s2 << 14) + base[s2] + r2] = (unsigned)t | (2u << 14); }
    __syncthreads();
}
__device__ __forceinline__ void moba_attn_item(LAS unsigned char* lds, const bf16* h, const unsigned* gcount, const unsigned* list, float* po, float* pml, int item, int tid, int wave, int lane) {
    const int n = item / 24, bh = item - n * 24, hh = bh % MB_H, b = bh / MB_H;
    LAS unsigned* Ks = (LAS unsigned*)(lds + AT_KS); LAS unsigned* Vs32 = (LAS unsigned*)(lds + AT_VS);
    LAS float* qst = (LAS float*)(lds + AT_WV + wave * AT_WVB); LAS float* pb = qst + 256;
    for (int i = 0; i < 16; ++i) { const int idx = tid + 512 * i, r = idx >> 5, dd = idx & 31; const unsigned* src = (const unsigned*)(h + ((size_t)b * SEQ + n * 256 + r) * NC_M + hh * 64);
        Ks[r * 33 + dd] = src[384 + dd]; Vs32[r * 32 + dd] = src[768 + dd]; }
    __syncthreads();
    const int cnt = (int)gcount[bh * 64 + n], total = 256 + cnt, nquads = (total + 3) >> 2;
    const float slope = hh < 8 ? ldexpf(1.0f, -(hh + 1)) : ldexpf(0.70710678118654752f, -(hh - 8));
    const unsigned* lp = list + (((size_t)bh * 64 + n) << 14);
    for (int quad = wave; quad < nquads; quad += 8) {
        int tq[4], slot[4];
#pragma unroll
        for (int qi = 0; qi < 4; ++qi) { int idx = quad * 4 + qi; idx = idx < total ? idx : total - 1;
            if (idx < 256) { tq[qi] = n * 256 + idx; slot[qi] = 3; } else { const unsigned e = lp[idx - 256]; tq[qi] = (int)(e & 16383u); slot[qi] = (int)(e >> 14); } }
#pragma unroll
        for (int qi = 0; qi < 4; ++qi) qst[qi * 64 + lane] = bf2f(h[((size_t)b * SEQ + tq[qi]) * NC_M + hh * 64 + lane]);
        float m[4], l[4], o[4];
        attn4<true>(Ks, (const LAS bf16*)Vs32, qst, pb, lane, tq, n * 256, slope, m, l, o);
#pragma unroll
        for (int qi = 0; qi < 4; ++qi) if (quad * 4 + qi < total) { const size_t pi = (((size_t)b * SEQ + tq[qi]) * MB_H + hh) * 4 + slot[qi];
            po[pi * 64 + lane] = o[qi]; if (lane == 0) { pml[pi * 2] = m[qi]; pml[pi * 2 + 1] = l[qi]; } }
    }
    __syncthreads();
}

__device__ __forceinline__ void moba_attn_item2(LAS unsigned char* lds, const bf16* h, const unsigned* gcount, const unsigned* list, bf16* po, float* pml, int item, int tid, int wave, int lane) {
    const int n = item / 24, bh = item - n * 24, hh = bh % MB_H, b = bh / MB_H, r = lane & 31, hf = lane >> 5;
    const bf16* hrow0 = h + ((size_t)b * SEQ + n * 256) * NC_M + hh * 64;
    stage_kv_images(lds, hrow0 + 768, hrow0 + 1536, NC_M, tid);
    __syncthreads();
    const int cnt = (int)gcount[bh * 64 + n], total = 256 + cnt, ntiles = (total + 31) >> 5;
    const float slope2 = (hh < 8 ? ldexpf(1.0f, -(hh + 1)) : ldexpf(0.70710678118654752f, -(hh - 8))) * 1.4426950408889634f;
    const unsigned shi = f2bf(slope2), slo = f2bf(slope2 - __builtin_bit_cast(float, shi << 16)); const unsigned qx = hf == 0 ? (shi | (slo << 16)) : 0u;
    const unsigned* lp = list + (((size_t)bh * 64 + n) << 14);
    const bf16* hq = h + (size_t)b * SEQ * NC_M + hh * 64 + 8 * hf;
#pragma unroll 1
    for (int tile = wave; tile < ntiles; tile += NWAVES) {
        int idx = tile * 32 + r; const bool valid = idx < total; idx = valid ? idx : total - 1;
        int tq, slot; if (idx < 256) { tq = n * 256 + idx; slot = 3; } else { const unsigned e = lp[idx - 256]; tq = (int)(e & 16383u); slot = (int)(e >> 14); }
        s16x8 qf[4]; { const bf16* qp = hq + (size_t)tq * NC_M;
#pragma unroll
            for (int s = 0; s < 4; ++s) qf[s] = *(const s16x8*)(qp + 16 * s); }
        f32x16 o[2]; float m2, l; const float dist0 = (float)(tq - n * 256);
        attn_tile32<true>(lds, qf, lane, dist0, qx, tile < 8, o, m2, l);
        { LAS unsigned char* sw = lds + AT2_SCR + wave * AT2_SCRW; const int pi = valid ? (int)((((size_t)b * SEQ + tq) * MB_H + hh) * 4 + slot) : -1;
#pragma unroll
          for (int dt = 0; dt < 2; ++dt)
#pragma unroll
              for (int g = 0; g < 4; ++g) { v2u w; w.x = cvtpk(o[dt][4 * g], o[dt][4 * g + 1]); w.y = cvtpk(o[dt][4 * g + 2], o[dt][4 * g + 3]); *(LAS v2u*)(sw + r * 144 + (32 * dt + 8 * g + 4 * hf) * 2) = w; }
          if (hf == 0) { *(LAS int*)(sw + 4608 + 4 * r) = pi; if (valid) { pml[(size_t)pi * 2] = m2 - slope2 * dist0; pml[(size_t)pi * 2 + 1] = l; } }
#pragma unroll
          for (int it = 0; it < 4; ++it) { const int q = 8 * it + (lane >> 3), c = lane & 7; const int pq = *(const LAS int*)(sw + 4608 + 4 * q); const v4u row = *(const LAS v4u*)(sw + q * 144 + c * 16);
              if (pq >= 0) *(v4u*)(po + (size_t)pq * 64 + c * 8) = row; } }
    }
    __syncthreads();
}
__device__ __forceinline__ void moba_combine(const bf16* __restrict__ po, const float* __restrict__ pml, const int* __restrict__ selinfo, bf16* __restrict__ mix, int gw, int ngw, int lane) {
    const int sub = lane >> 4, d4 = (lane & 15) * 4;
#pragma unroll 4
    for (int idx = gw * 4 + sub; idx < T * MB_H; idx += ngw * 4) { const int tg = idx / MB_H, hh = idx - tg * MB_H, ns = selinfo[idx]; const size_t p4 = (size_t)idx * 4;
        f32x2 ml[4]; f32x4 ov[4];
#pragma unroll
        for (int j = 0; j < 4; ++j) { ml[j] = ((const f32x2*)pml)[p4 + j]; const v2u ow = *(const v2u*)(po + (p4 + j) * 64 + d4); ov[j] = (f32x4){bflo(ow.x), bfhi(ow.x), bflo(ow.y), bfhi(ow.y)}; }
        float M = ml[3].x;
#pragma unroll
        for (int j = 0; j < 3; ++j) { const bool ok = j < ns; ml[j].x = ok ? ml[j].x : -INFINITY; ml[j].y = ok ? ml[j].y : 0.f; M = fmaxf(M, ml[j].x);
            ov[j].x = ok ? ov[j].x : 0.f; ov[j].y = ok ? ov[j].y : 0.f; ov[j].z = ok ? ov[j].z : 0.f; ov[j].w = ok ? ov[j].w : 0.f; }
        float den = 0.f; f32x4 num = {0.f, 0.f, 0.f, 0.f};
#pragma unroll
        for (int j = 0; j < 4; ++j) { const float w = __builtin_amdgcn_exp2f(ml[j].x - M); den += w * ml[j].y; num += ov[j] * w; }
        const float inv = 1.f / den; v2u o; o.x = pk2(num.x * inv, num.y * inv); o.y = pk2(num.z * inv, num.w * inv);
        *(v2u*)(mix + (size_t)tg * 1024 + hh * 64 + d4) = o; }
}

__device__ __forceinline__ void ln_row(f32x4 (&v)[4], const f32x4 (&gv)[4], const f32x4 (&bv)[4]) {
    float s = 0.f;
#pragma unroll
    for (int j = 0; j < 4; ++j) s += (v[j].x + v[j].y) + (v[j].z + v[j].w);
    const float mean = wave_sum(s) * (1.f / D); float s2 = 0.f;
#pragma unroll
    for (int j = 0; j < 4; ++j) { v[j] = v[j] - mean; s2 += (v[j].x * v[j].x + v[j].y * v[j].y) + (v[j].z * v[j].z + v[j].w * v[j].w); }
    const float rstd = 1.f / sqrtf(wave_sum(s2) * (1.f / D) + 1e-5f);
#pragma unroll
    for (int j = 0; j < 4; ++j) v[j] = v[j] * rstd * gv[j] + bv[j];
}
__device__ __forceinline__ void split_router_weights(const float* wr  , bf16* wrs  , size_t gtid, size_t gthreads) {
    for (size_t i = gtid; i < (size_t)DEPTH * D * NE; i += gthreads) { const int e = (int)(i & 31), d = (int)((i >> 5) & 1023), l = (int)(i >> 15);
        const float w = wr[i]; const unsigned hi = f2bf(w); const unsigned lo = f2bf(w - __builtin_bit_cast(float, hi << 16));
        wrs[(((size_t)l * 2 + 0) * NE + e) * D + d] = (bf16)hi; wrs[(((size_t)l * 2 + 1) * NE + e) * D + d] = (bf16)lo; }
}
constexpr int L1_XH = 0, L1_XL = 33024, L1_ROW = 2064, L1_PART = 66048, L1_HIST = 82432;
__device__ __forceinline__ void phase_ln1(LAS unsigned char* lds, const bf16* y, const float* g, const float* bb, const bf16* wrs  , const float* br,
                                          bf16* xbf, int* tok_e, int* tok_lr, float* tok_w, int* blk_cnt, int blk, int tid, int wave, int lane) {
    LAS float* part = (LAS float*)(lds + L1_PART);
    LAS int* hist = (LAS int*)(lds + L1_HIST);
    if (tid < 32) hist[tid] = 0;
    constexpr int TPB = T / GRID;
    const int e = lane & 31, m16 = lane & 15, quad = lane >> 4;
    s16x8 bw[4][2][2];
#pragma unroll
    for (int ks = 0; ks < 4; ++ks)
#pragma unroll
        for (int nt = 0; nt < 2; ++nt)
#pragma unroll
            for (int pp = 0; pp < 2; ++pp) bw[ks][nt][pp] = *(const s16x8*)(wrs + ((size_t)pp * NE + 16 * nt + m16) * D + wave * 128 + 32 * ks + 8 * quad);
    const float bre = br[e];
    f32x4 gv[4], bv[4];
#pragma unroll
    for (int j = 0; j < 4; ++j) { gv[j] = ((const f32x4*)g)[lane + 64 * j]; bv[j] = ((const f32x4*)bb)[lane + 64 * j]; }
    v2u xn[2][4], yn[2][4];
#pragma unroll
    for (int u = 0; u < 2; ++u) { const size_t t0 = (size_t)blk * TPB + 2 * wave + u; const v2u* xr = (const v2u*)(xbf + t0 * D) + lane; const v2u* yr = (const v2u*)(y + t0 * D) + lane;
#pragma unroll
        for (int j = 0; j < 4; ++j) { xn[u][j] = xr[64 * j]; yn[u][j] = yr[64 * j]; } }
    __syncthreads();
    for (int grp = 0; grp < TPB / 16; ++grp) { const size_t tg0 = (size_t)blk * TPB + grp * 16 + 2 * wave;
        f32x4 v[2][4];
#pragma unroll
        for (int u = 0; u < 2; ++u)
#pragma unroll
            for (int j = 0; j < 4; ++j) { const v2u xw = xn[u][j]; const v2u yw = yn[u][j];
                v[u][j].x = DN_ALPHA * bflo(xw.x) + bflo(yw.x); v[u][j].y = DN_ALPHA * bfhi(xw.x) + bfhi(yw.x); v[u][j].z = DN_ALPHA * bflo(xw.y) + bflo(yw.y); v[u][j].w = DN_ALPHA * bfhi(xw.y) + bfhi(yw.y); }
        if (grp + 1 < TPB / 16) {
#pragma unroll
            for (int u = 0; u < 2; ++u) { const v2u* xr = (const v2u*)(xbf + (tg0 + 16 + u) * D) + lane; const v2u* yr = (const v2u*)(y + (tg0 + 16 + u) * D) + lane;
#pragma unroll
                for (int j = 0; j < 4; ++j) { xn[u][j] = xr[64 * j]; yn[u][j] = yr[64 * j]; } } }
#pragma unroll
        for (int u = 0; u < 2; ++u) { ln_row(v[u], gv, bv);
            v2u* xb = (v2u*)(xbf + (tg0 + u) * D) + lane;
#pragma unroll
            for (int j = 0; j < 4; ++j) { v2u hw; hw.x = cvtpk(v[u][j].x, v[u][j].y); hw.y = cvtpk(v[u][j].z, v[u][j].w); xb[64 * j] = hw;
                v2u lw; lw.x = cvtpk(v[u][j].x - bflo(hw.x), v[u][j].y - bfhi(hw.x)); lw.y = cvtpk(v[u][j].z - bflo(hw.y), v[u][j].w - bfhi(hw.y));
                *(LAS v2u*)(lds + L1_XH + (2 * wave + u) * L1_ROW + (4 * lane + 256 * j) * 2) = hw; *(LAS v2u*)(lds + L1_XL + (2 * wave + u) * L1_ROW + (4 * lane + 256 * j) * 2) = lw; } }
        __syncthreads();
        { f32x4 acc[2] = {{0.f, 0.f, 0.f, 0.f}, {0.f, 0.f, 0.f, 0.f}};
#pragma unroll
          for (int ks = 0; ks < 4; ++ks) { const int off = m16 * L1_ROW + (wave * 128 + 32 * ks + 8 * quad) * 2;
              const s16x8 ah = *(const LAS s16x8*)(lds + L1_XH + off), al = *(const LAS s16x8*)(lds + L1_XL + off);
#pragma unroll
              for (int nt = 0; nt < 2; ++nt) { acc[nt] = __builtin_amdgcn_mfma_f32_16x16x32_bf16(ah, bw[ks][nt][0], acc[nt], 0, 0, 0); acc[nt] = __builtin_amdgcn_mfma_f32_16x16x32_bf16(ah, bw[ks][nt][1], acc[nt], 0, 0, 0);
                  acc[nt] = __builtin_amdgcn_mfma_f32_16x16x32_bf16(al, bw[ks][nt][0], acc[nt], 0, 0, 0); } }
#pragma unroll
          for (int nt = 0; nt < 2; ++nt)
#pragma unroll
              for (int jj = 0; jj < 4; ++jj) part[(wave * 16 + 4 * quad + jj) * 32 + 16 * nt + m16] = acc[nt][jj]; }
        __syncthreads();
#pragma unroll
        for (int u = 0; u < 2; ++u) { const size_t t = tg0 + u;
            float logit = bre;
#pragma unroll
            for (int w = 0; w < 8; ++w) logit += part[(w * 16 + 2 * wave + u) * 32 + e];
            int rank = 0;
#pragma unroll
            for (int q = 0; q < 32; ++q) { const float oq = __builtin_bit_cast(float, __builtin_amdgcn_readlane(__builtin_bit_cast(int, logit), q)); rank += (oq > logit || (oq == logit && q < e)) ? 1 : 0; }
            int se[4]; float sv[4];
#pragma unroll
            for (int k = 0; k < 4; ++k) { const unsigned long long mk = __ballot(rank == k && lane < 32); const int src = __builtin_ctzll(mk);
                se[k] = src; sv[k] = __builtin_bit_cast(float, __builtin_amdgcn_readlane(__builtin_bit_cast(int, logit), src)); }
            const float e1 = __expf(sv[1] - sv[0]), e2 = __expf(sv[2] - sv[0]), e3 = __expf(sv[3] - sv[0]), inv = 1.f / (1.f + e1 + e2 + e3);
            const float wk[4] = {inv, e1 * inv, e2 * inv, e3 * inv};
            if (lane == 0) {
#pragma unroll
                for (int k = 0; k < 4; ++k) { const int lr = __hip_atomic_fetch_add(hist + se[k], 1, __ATOMIC_RELAXED, __HIP_MEMORY_SCOPE_WORKGROUP);
                    tok_e[t * 4 + k] = se[k]; tok_lr[t * 4 + k] = lr; tok_w[t * 4 + k] = wk[k]; } } }
    }
    __syncthreads();
    if (tid < 32) blk_cnt[blk * 32 + tid] = hist[tid];
    __syncthreads();
}
__device__ __forceinline__ void phase_dispatch(LAS unsigned char* lds, const int* __restrict__ blk_cnt, const int* __restrict__ tok_e, const int* __restrict__ tok_lr, int* __restrict__ tok_row, int* __restrict__ tab,
                                               const bf16* __restrict__ xbf, bf16* __restrict__ xs, int blk, int tid, int wave, int lane) {
    LAS int* tot = (LAS int*)lds; LAS int* pre = tot + 32; LAS int* pst = pre + 32; LAS int* rows = pst + 64;
    if (tid < 32) { int s = 0, p = 0;
#pragma unroll 8
        for (int bb = 0; bb < GRID; ++bb) { const int c = blk_cnt[bb * 32 + tid]; p += (bb < blk) ? c : 0; s += c; } tot[tid] = s; pre[tid] = p; }
    __syncthreads();
    if (tid == 0) { int acc = 0; for (int e = 0; e < 32; ++e) { pst[e] = acc; acc += ((tot[e] + 255) >> 8) << 8; } pst[32] = acc; }
    __syncthreads();
    if (blk == 0 && tid < 33) tab[tid] = pst[tid] >> 8;
    constexpr int TPB = T / GRID;
    static_assert(TPB * 4 == NTHR, "one (token, k) pair per thread");
    { const size_t ti = (size_t)blk * TPB * 4 + tid; const int e = tok_e[ti]; const int r = pst[e] + pre[e] + tok_lr[ti]; tok_row[ti] = r; rows[tid] = r; }
    __syncthreads();
#pragma unroll 4
    for (int i = wave; i < TPB * 4; i += NWAVES) { const int r = rows[i];
        const v4u* src = (const v4u*)(xbf + ((size_t)blk * TPB + (i >> 2)) * D) + 2 * lane; const v4u a = src[0], b = src[1];
        v4u o; o.x = pk4_fp8(bflo(a.x), bfhi(a.x), bflo(a.y), bfhi(a.y)); o.y = pk4_fp8(bflo(a.z), bfhi(a.z), bflo(a.w), bfhi(a.w)); o.z = pk4_fp8(bflo(b.x), bfhi(b.x), bflo(b.y), bfhi(b.y)); o.w = pk4_fp8(bflo(b.z), bfhi(b.z), bflo(b.w), bfhi(b.w));
        ((v4u*)((unsigned char*)xs + (size_t)r * D))[lane] = o; }
    __syncthreads();
}
__device__ __forceinline__ f32x4 fp8x4_to_f32(unsigned w) {
    const f32x2 lo = __builtin_amdgcn_cvt_pk_f32_fp8((int)w, false), hi = __builtin_amdgcn_cvt_pk_f32_fp8((int)w, true); return (f32x4){lo.x, lo.y, hi.x, hi.y};
}
__device__ __forceinline__ void phase_ln2(const unsigned char* __restrict__ yrows, const int* __restrict__ tok_row, const float* __restrict__ tok_w, const float* __restrict__ g, const float* __restrict__ bb,
                                          float* __restrict__ xout, bf16* xbf, int gw, int ngw, int lane) {
    f32x4 gv[4], bv[4];
#pragma unroll
    for (int j = 0; j < 4; ++j) { gv[j] = ((const f32x4*)g)[lane + 64 * j]; bv[j] = ((const f32x4*)bb)[lane + 64 * j]; }
    constexpr int NTK = 2;
    static_assert(T % (NTK * GRID * NWAVES) == 0, "NTK tokens per wave per step");
    for (int t0 = gw; t0 < T; t0 += NTK * ngw) {
        f32x4 v[NTK][4];
#pragma unroll
        for (int u = 0; u < NTK; ++u) { const int t = t0 + u * ngw; int r[4]; float w[4];
#pragma unroll
            for (int k = 0; k < 4; ++k) { r[k] = tok_row[(size_t)t * 4 + k]; w[k] = tok_w[(size_t)t * 4 + k] * (1.f / 16.f); }
            const v2u* xr = (const v2u*)(xbf + (size_t)t * D) + lane;
#pragma unroll
            for (int j = 0; j < 4; ++j) { f32x4 f = {0.f, 0.f, 0.f, 0.f};
#pragma unroll
                for (int k = 0; k < 4; ++k) { const unsigned yw = ((const unsigned*)(yrows + (size_t)r[k] * D))[lane + 64 * j]; f += fp8x4_to_f32(yw) * w[k]; }
                const v2u xw = xr[64 * j]; v[u][j].x = DN_ALPHA * bflo(xw.x) + f.x; v[u][j].y = DN_ALPHA * bfhi(xw.x) + f.y; v[u][j].z = DN_ALPHA * bflo(xw.y) + f.z; v[u][j].w = DN_ALPHA * bfhi(xw.y) + f.w; } }
#pragma unroll
        for (int u = 0; u < NTK; ++u) { const int t = t0 + u * ngw;
            ln_row(v[u], gv, bv);
            if (xout) { f32x4* xo = (f32x4*)(xout + (size_t)t * D) + lane;
#pragma unroll
                for (int j = 0; j < 4; ++j) xo[64 * j] = v[u][j]; }
            else { v2u* xb = (v2u*)(xbf + (size_t)t * D) + lane;
#pragma unroll
                for (int j = 0; j < 4; ++j) { v2u ww; ww.x = pk2(v[u][j].x, v[u][j].y); ww.y = pk2(v[u][j].z, v[u][j].w); xb[64 * j] = ww; } } } }
}

struct Args { const float* in[20]; float* out; unsigned char* ws; int l_lo, l_hi, ph_lo, ph_hi; };
typedef const __attribute__((address_space(4))) Args* KArgsP;
#define KA_LOAD() ({ KArgsP p_ = (KArgsP)__builtin_amdgcn_kernarg_segment_ptr(); asm volatile("" : "+s"(p_)); p_; })
#ifndef PHMASK
#define PHMASK 0xFFFF
#endif
#ifndef REPEAT_MASK
#define REPEAT_MASK 0
#endif
#ifndef REPEAT_LMASK
#define REPEAT_LMASK 0xF
#endif
#define PH_BEGIN(k) _Pragma("unroll") for (int rep_ = 0; rep_ < ((((REPEAT_MASK >> (k)) & 1) && ((REPEAT_LMASK >> l) & 1)) ? 2 : 1); ++rep_) { if ((PHMASK >> (k)) & 1) { KArgsP ka = KA_LOAD(); unsigned char* ws = ka->ws; int tid = threadIdx.x; asm volatile("" : "+v"(tid)); \
    const int lane = tid & 63, wave = __builtin_amdgcn_readfirstlane(tid >> 6); int blk = blockIdx.x; asm volatile("" : "+s"(blk)); \
    const int gw = blk * NWAVES + wave; const size_t gtid = (size_t)blk * NTHR + tid; (void)lane; (void)gw; (void)gtid; (void)ws;
#if ONE_LAUNCH
#define PH_SEAM() do { XcdBarrier b_; b_.bar = (unsigned*)(KA_LOAD()->ws + WS_CTL) + CW_BAR; b_.x = xb_xcc_id(); b_.st = (volatile LAS unsigned*)(lds + MISC_OFF); xcd_barrier(b_); } while (0)
#else
#define PH_SEAM() do {} while (0)
#endif
#define PH_END() PH_SEAM(); } }
#define PH_END_NOSEAM() } }
#define WSP(type, off) ((type*)(ws + (off)))
constexpr int G = GRID, NGW = GRID * NWAVES; constexpr size_t GTHREADS = (size_t)GRID * NTHR;
template <int L> __device__ __forceinline__ void layer_phases(LAS unsigned char* lds) {
    constexpr int l = L; LAS int* tabL = (LAS int*)(lds + MISC_OFF + 256);

        const int j = l >> 1; const bool moba = (l & 1) != 0;
        const int NC = moba ? NC_M : NC_H, qoff = moba ? 2304 : 3072;

        if (l == 0) {
        PH_BEGIN(1)
            phase_weights((LAS float*)(lds + wave * 16384), gw, NGW, lane, ka->in[2], NC_H, ka->in[6], 4, ka->in[7], ka->in[12], ka->in[14], ka->in[16], WSP(bf16, WS_WIN), WSP(bf16, WS_WKV4), WSP(bf16, WS_WO), WSP(bf16, WS_WGU), WSP(bf16, WS_WD));
        PH_END()
        }
        PH_BEGIN(2)
            { pg8::Gemm g{WSP(bf16, WS_XBF), WSP(bf16, WS_WIN), T, NC, D, 0, 0}; pg8::StaticOrder S; S.init(T, NC, G, blk); pg8::EpiPlain E{WSP(bf16, WS_H), NC, moba ? 0x207u : 0x1000u, 0.125f * 1.4426950408889634f};
              pg8::gemm_phase<pg8::EpiPlain, pg8::StaticOrder, true, true>(lds, g, S, E); }
            if (l == 0) {
              pg8::Gemm g{WSP(bf16, WS_MEMBF), WSP(bf16, WS_WKV4), 512, 2048, D, 0, 0}; pg8::StaticOrder S; S.init(512, 2048, G, blk >= 128 ? blk - 128 : G); pg8::EpiPlain E{WSP(bf16, WS_KV4), 2048, 0u, 1.f};
              pg8::gemm_phase<pg8::EpiPlain, pg8::StaticOrder, true, true>(lds, g, S, E); }
        PH_END()
        if (!moba) {
            PH_BEGIN(3)
                for (int u = blk; u < NBATCH * HG_H * HNSEG; u += G) hgrn_mfma<false>(lds, WSP(bf16, WS_H), ka->in[3], j, ka->in[4] + j * 128, WSP(float, WS_SLOC), WSP(float, WS_DSEG), WSP(bf16, WS_MIX), u, tid, wave, lane);
                for (int u = blk; u < 512; u += G) memattn_unit2(lds, WSP(bf16, WS_H), NC, qoff, WSP(bf16, WS_KV4) + 512 * l, WSP(bf16, WS_MIX), u, tid, wave, lane);
            PH_END()
            PH_BEGIN(4)
                hgrn_scan(WSP(float, WS_SLOC), WSP(float, WS_DSEG), gtid, GTHREADS);
            PH_END()
            PH_BEGIN(5)
                for (int u = blk; u < NBATCH * HG_H * HNSEG; u += G) hgrn_mfma<true>(lds, WSP(bf16, WS_H), ka->in[3], j, ka->in[4] + j * 128, WSP(float, WS_SLOC), WSP(float, WS_DSEG), WSP(bf16, WS_MIX), u, tid, wave, lane);
            PH_END()
        } else {
            PH_BEGIN(3)
                for (int u = blk; u < 24 * MB_NB; u += G) kmean_unit(lds, WSP(bf16, WS_H), WSP(float, WS_KMEAN), u, tid);
                for (int u = blk; u < 512; u += G) memattn_unit2(lds, WSP(bf16, WS_H), NC, qoff, WSP(bf16, WS_KV4) + 512 * l, WSP(bf16, WS_MIX), u, tid, wave, lane);
            PH_END()
            PH_BEGIN(4)
                for (int u = blk; u < 24 * MB_NB; u += G) moba_gate_unit(lds, WSP(bf16, WS_H), WSP(float, WS_KMEAN), WSP(unsigned, WS_CTL) + CW_GCOUNT + j * 1536, WSP(int, WS_SELINFO), WSP(unsigned, WS_LIST), u, tid);
            PH_END()
            PH_BEGIN(5)
                for (int r = 0; r * G < 24 * MB_NB; ++r) { const int it = r * G + ((r & 1) ? (G - 1 - blk) : blk);
                    if (it < 24 * MB_NB) moba_attn_item2(lds, WSP(bf16, WS_H), WSP(unsigned, WS_CTL) + CW_GCOUNT + j * 1536, WSP(unsigned, WS_LIST), WSP(bf16, WS_PO), WSP(float, WS_PML), it, tid, wave, lane); }
            PH_END()
            PH_BEGIN(6)
                moba_combine(WSP(bf16, WS_PO), WSP(float, WS_PML), WSP(int, WS_SELINFO), WSP(bf16, WS_MIX), gw, NGW, lane);
            PH_END()
        }
        PH_BEGIN(7)
            pg8::Gemm g{WSP(bf16, WS_MIX), WSP(bf16, WS_WO), T, D, D, 0, 0}; pg8::StaticOrder S; S.init(T, D, G, blk); pg8::EpiPlain E{WSP(bf16, WS_Y), D, 0u, 1.f};
            pg8::gemm_phase<pg8::EpiPlain, pg8::StaticOrder, true, true>(lds, g, S, E);
        PH_END()
        PH_BEGIN(8)
            phase_ln1(lds, WSP(bf16, WS_Y), ka->in[8] + l * D, ka->in[9] + l * D, WSP(bf16, WS_WRS) + (size_t)l * 2 * NE * D, ka->in[11] + l * NE, WSP(bf16, WS_XBF),
                      WSP(int, WS_TOK + TOK_E), WSP(int, WS_TOK + TOK_LR), WSP(float, WS_TOK + TOK_W), WSP(int, WS_TOK + TOK_BLKCNT), blk, tid, wave, lane);
        PH_END()
        PH_BEGIN(9)
            phase_dispatch(lds, WSP(int, WS_TOK + TOK_BLKCNT), WSP(int, WS_TOK + TOK_E), WSP(int, WS_TOK + TOK_LR), WSP(int, WS_TOK + TOK_ROW), WSP(int, WS_TOK + TOK_TAB), WSP(bf16, WS_XBF), WSP(bf16, WS_XS), blk, tid, wave, lane);
        PH_END()
        PH_BEGIN(10)
            if (tid < 33) tabL[tid] = WSP(int, WS_TOK + TOK_TAB)[tid];
            __syncthreads();
            int sw_ = 0x7A7A7A7A, sx_ = 0x7F7F7F7F; asm volatile("" : "+s"(sw_), "+s"(sx_));
            pg8::Gemm g{WSP(bf16, WS_XS), WSP(bf16, WS_WGU), MOE_MAXROWS, NE * 2048, D / 2, sw_, sx_}; pg8::MoeOrder S{tabL, 8, G, blk, tabL[32] * 8};
            pg8::EpiSwiglu E{WSP(unsigned char, WS_HID), ka->in[13] + (size_t)l * NE * 1024, ka->in[15] + (size_t)l * NE * 1024};
            pg8::gemm_phase<pg8::EpiSwiglu, pg8::MoeOrder, true, true, true>(lds, g, S, E);
        PH_END()
        PH_BEGIN(11)
            if (tid < 33) tabL[tid] = WSP(int, WS_TOK + TOK_TAB)[tid];
            __syncthreads();
            int sw_ = 0x79797979, sx_ = 0x7F7F7F7F; asm volatile("" : "+s"(sw_), "+s"(sx_));
            pg8::Gemm g{WSP(bf16, WS_HID), WSP(bf16, WS_WD), MOE_MAXROWS, NE * 1024, D / 2, sw_, sx_}; pg8::MoeOrder S{tabL, 4, G, blk, tabL[32] * 4};
            pg8::EpiDown E{WSP(unsigned char, WS_XS), ka->in[17] + (size_t)l * NE * 1024};
            pg8::gemm_phase<pg8::EpiDown, pg8::MoeOrder, true, true, true>(lds, g, S, E);
        PH_END()
        PH_BEGIN(12)
            float* x2out = (l == DEPTH - 1) ? ka->out : nullptr;
            phase_ln2(WSP(unsigned char, WS_XS), WSP(int, WS_TOK + TOK_ROW), WSP(float, WS_TOK + TOK_W), ka->in[18] + l * D, ka->in[19] + l * D, x2out, WSP(bf16, WS_XBF), gw, NGW, lane);
            if (l + 1 < DEPTH) { constexpr int ln = l + 1, jn = ln >> 1; constexpr bool mn = (ln & 1) != 0;
                const float* win_src = mn ? ka->in[5] + (size_t)jn * D * NC_M : ka->in[2] + (size_t)jn * D * NC_H; const size_t moff = (size_t)ln * NE * 1024 * 1024;
                phase_weights((LAS float*)(lds + wave * 16384), gw, NGW, lane, win_src, mn ? NC_M : NC_H, ka->in[6], 0, ka->in[7] + (size_t)ln * D * D,
                              ka->in[12] + moff, ka->in[14] + moff, ka->in[16] + moff, WSP(bf16, WS_WIN), WSP(bf16, WS_WKV4), WSP(bf16, WS_WO), WSP(bf16, WS_WGU), WSP(bf16, WS_WD)); }
            if (l + 1 < DEPTH) PH_SEAM();
        PH_END_NOSEAM()
}
__global__ void __launch_bounds__(NTHR, 2) fwd_kernel(Args args) {
    extern __shared__ __attribute__((aligned(16))) unsigned char lds_raw[];
    LAS unsigned char* lds = (LAS unsigned char*)lds_raw;
    if (threadIdx.x < 4) ((LAS unsigned*)(lds + MISC_OFF))[threadIdx.x] = 0u;
    __syncthreads();
#if ONE_LAUNCH
    (void)xcd_barrier_post((unsigned*)(args.ws + WS_CTL) + CW_BAR, (volatile LAS unsigned*)(lds + MISC_OFF));
#endif
    { const int l = 0; (void)l;
    PH_BEGIN(0)
        cvt_rows_bf16(ka->in[0], WSP(bf16, WS_XBF), (size_t)T * D / 8, gtid, GTHREADS);
        cvt_rows_bf16(ka->in[1], WSP(bf16, WS_MEMBF), (size_t)512 * D / 8, gtid, GTHREADS);
        split_router_weights(ka->in[10], WSP(bf16, WS_WRS), gtid, GTHREADS);
    PH_END_NOSEAM() }
    layer_phases<0>(lds); layer_phases<1>(lds); layer_phases<2>(lds); layer_phases<3>(lds);
}

extern "C" void kernel_launch(void* const* d_in, const int* in_sizes, int n_in, void* d_out, int out_size, void* d_ws, size_t ws_size, hipStream_t stream) {
    static int ready = 0;
    if (ready == 0) {
        if (n_in != 20 || in_sizes[0] != T * D || out_size != T * D || ws_size < WS_END) { fprintf(stderr, "kernel_launch: unexpected shapes (n_in %d, in0 %d, out %d, ws %zu < %zu)\n", n_in, n_in > 0 ? in_sizes[0] : -1, out_size, ws_size, (size_t)WS_END); ready = -1; return; }
        if (hipFuncSetAttribute((const void*)fwd_kernel, hipFuncAttributeMaxDynamicSharedMemorySize, LDS_BYTES) != hipSuccess) { fprintf(stderr, "kernel_launch: hipFuncSetAttribute failed\n"); ready = -1; return; }
        int per_cu = 0;
        if (hipOccupancyMaxActiveBlocksPerMultiprocessor(&per_cu, (const void*)fwd_kernel, NTHR, LDS_BYTES) != hipSuccess || per_cu < 1) fprintf(stderr, "kernel_launch: occupancy query says %d\n", per_cu);
        (void)hipGetLastError();
        ready = 1;
    }
    if (ready < 0) return;
    if (hipMemsetAsync((char*)d_ws + WS_CTL, 0, CTL_ZERO_BYTES, stream) != hipSuccess) return;
    Args a{};
    for (int i = 0; i < 20; ++i) a.in[i] = (const float*)d_in[i];
    a.out = (float*)d_out; a.ws = (unsigned char*)d_ws;
    a.l_lo = 0; a.l_hi = DEPTH; a.ph_lo = 0; a.ph_hi = NPHASE;
    hipLaunchKernelGGL(fwd_kernel, dim3(GRID), dim3(NTHR), LDS_BYTES, stream, a);
}
```

```cpp
#include <hip/hip_runtime.h>
#include <cstdio>
#include <cstdint>
#include <cmath>
namespace pg8 {
#define PG8_LAS __attribute__((address_space(3)))
typedef unsigned short bf16_t;
typedef short bf16x8 __attribute__((ext_vector_type(8)));
typedef float f32x4 __attribute__((ext_vector_type(4)));
typedef unsigned u32x4 __attribute__((ext_vector_type(4)));
constexpr int BM = 256, BK = 64, HALF = 128, HTB = HALF * BK * 2  , STAGE_BYTES = 8 * HTB, NXCD = 8, WGM = 8;

__host__ __device__ __forceinline__ int lds_byte(int r, int c) { const int st = (r >> 4) * 2 + (c >> 5), rr = r & 15, cc = c & 31, ob = rr * 64 + cc * 2; return st * 1024 + (ob ^ (((ob >> 9) & 1) << 5)); }
__host__ __device__ __forceinline__ void stage_rc(int b, int& R, int& C) { const int st = b / 1024, sb = b % 1024, swz = sb ^ (((sb >> 9) & 1) << 5); R = (st >> 1) * 16 + swz / 64; C = (st & 1) * 32 + (swz % 64) / 2; }
__host__ __device__ __forceinline__ int perm32(int rho) { const int n = rho >> 4, i = rho & 15; return 8 * (i >> 2) + 4 * n + (i & 3); }

struct Unit { int pm, pn; };
struct Gemm { const bf16_t* A; const bf16_t* Bt; int M, N, K; int sw, sx; };
typedef int i32x8 __attribute__((ext_vector_type(8))); typedef int i32x4 __attribute__((ext_vector_type(4)));

struct StaticOrder {
    int nM, nN, nwg, G, c;
    __host__ __device__ void init(int M, int N, int G_, int c_) { nM = M / BM; nN = N / BM; nwg = nM * nN; G = G_; c = c_; }
    __host__ __device__ bool next(int i, Unit& u) const {
        const long L = (long)i * G + c; if (L >= nwg) return false;
        int wgid = (int)L; { const int q = nwg / NXCD, r = nwg % NXCD, xcd = wgid % NXCD, off = wgid / NXCD; wgid = (xcd < r ? xcd * (q + 1) : r * (q + 1) + (xcd - r) * q) + off; }
        const int nig = WGM * nN, gid = wgid / nig, fm = gid * WGM, gsz = (nM - fm) < WGM ? (nM - fm) : WGM;
        u.pm = fm + ((wgid % nig) % gsz); u.pn = (wgid % nig) / gsz; return true;
    }
    __device__ __forceinline__ void a_ready(const Unit&) const {}
    __device__ __forceinline__ void done(const Unit&) const {}
};

__device__ __forceinline__ unsigned cvt_pk_bf16(float lo, float hi) { unsigned r; asm volatile("v_cvt_pk_bf16_f32 %0, %1, %2" : "=v"(r) : "v"(lo), "v"(hi)); return r; }
typedef float f32x2 __attribute__((ext_vector_type(2)));
struct EpiPlain {
    static constexpr bool PERM = true, AFTER_DRAIN = false;
    bf16_t* O; int ldc; unsigned smask; float sc;
    __device__ __forceinline__ void operator()(const f32x4 (&acc)[2][2][4][2], const Unit& u, int wr, int wc, int fr, int fq) const {
        const int row0 = u.pm * BM + wr * 64 + fr; const int col0 = u.pn * BM + wc * 32 + 8 * fq; const float s = ((smask >> u.pn) & 1u) ? sc : 1.f;
#pragma unroll
        for (int ai = 0; ai < 2; ++ai)
#pragma unroll
            for (int m = 0; m < 4; ++m) { bf16_t* rowp = O + (size_t)(row0 + ai * HALF + m * 16) * ldc + col0;
#pragma unroll
                for (int bj = 0; bj < 2; ++bj) { const f32x4 v0 = acc[ai][bj][m][0] * s, v1 = acc[ai][bj][m][1] * s;
                    u32x4 w; w.x = cvt_pk_bf16(v0[0], v0[1]); w.y = cvt_pk_bf16(v0[2], v0[3]); w.z = cvt_pk_bf16(v1[0], v1[1]); w.w = cvt_pk_bf16(v1[2], v1[3]);
                    *(u32x4*)(rowp + bj * HALF) = w; } }
    }
};
__device__ __forceinline__ float swiglu1(float g, float u) {
    g = fminf(g, 7.0f); u = fminf(fmaxf(u, -7.0f), 7.0f);
    const float s = __builtin_amdgcn_rcpf(1.0f + __builtin_amdgcn_exp2f(g * (-1.702f * 1.4426950408889634f)));
    return g * s * (u + 1.0f);
}
__device__ __forceinline__ unsigned pk4_fp8e(float a, float b, float c, float d) { int w = 0; w = __builtin_amdgcn_cvt_pk_fp8_f32(a, b, w, false); w = __builtin_amdgcn_cvt_pk_fp8_f32(c, d, w, true); return (unsigned)w; }
struct EpiSwiglu {
    static constexpr bool PERM = true, AFTER_DRAIN = false;
    unsigned char* hid; const float* bg; const float* bu;
    __device__ __forceinline__ void operator()(const f32x4 (&acc)[2][2][4][2], const Unit& u, int wr, int wc, int fr, int fq) const {
        const int e = u.pn >> 3, pn = u.pn & 7;
        const int row0 = u.pm * BM + wr * 64 + fr; const int col0 = pn * 128 + wc * 32 + 8 * fq;
        const f32x4 g0 = *(const f32x4*)(bg + e * 1024 + col0), g1 = *(const f32x4*)(bg + e * 1024 + col0 + 4);
        const f32x4 u0 = *(const f32x4*)(bu + e * 1024 + col0), u1 = *(const f32x4*)(bu + e * 1024 + col0 + 4);
#pragma unroll
        for (int ai = 0; ai < 2; ++ai)
#pragma unroll
            for (int m = 0; m < 4; ++m) { unsigned char* rowp = hid + (size_t)(row0 + ai * HALF + m * 16) * 1024 + col0;
                const f32x4 ga = acc[ai][0][m][0] + g0, gb = acc[ai][0][m][1] + g1, ua = acc[ai][1][m][0] + u0, ub = acc[ai][1][m][1] + u1;
                typedef unsigned u32x2 __attribute__((ext_vector_type(2))); u32x2 w;
                w.x = pk4_fp8e(swiglu1(ga[0], ua[0]), swiglu1(ga[1], ua[1]), swiglu1(ga[2], ua[2]), swiglu1(ga[3], ua[3]));
                w.y = pk4_fp8e(swiglu1(gb[0], ub[0]), swiglu1(gb[1], ub[1]), swiglu1(gb[2], ub[2]), swiglu1(gb[3], ub[3]));
                *(u32x2*)rowp = w; }
    }
};
struct EpiDown {
    static constexpr bool PERM = true, AFTER_DRAIN = false;
    unsigned char* y; const float* bd;
    __device__ __forceinline__ void operator()(const f32x4 (&acc)[2][2][4][2], const Unit& u, int wr, int wc, int fr, int fq) const {
        const int e = u.pn >> 2, pn = u.pn & 3;
        const int row0 = u.pm * BM + wr * 64 + fr; const int col0 = pn * BM + wc * 32 + 8 * fq;
        f32x4 bv[2][2];
#pragma unroll
        for (int bj = 0; bj < 2; ++bj)
#pragma unroll
            for (int n = 0; n < 2; ++n) bv[bj][n] = *(const f32x4*)(bd + e * 1024 + col0 + bj * HALF + 4 * n);
#pragma unroll
        for (int ai = 0; ai < 2; ++ai)
#pragma unroll
            for (int m = 0; m < 4; ++m) { unsigned char* rowp = y + (size_t)(row0 + ai * HALF + m * 16) * 1024 + col0;
#pragma unroll
                for (int bj = 0; bj < 2; ++bj) { const f32x4 v0 = (acc[ai][bj][m][0] + bv[bj][0]) * 16.f, v1 = (acc[ai][bj][m][1] + bv[bj][1]) * 16.f;
                    typedef unsigned u32x2 __attribute__((ext_vector_type(2))); u32x2 w; w.x = pk4_fp8e(v0[0], v0[1], v0[2], v0[3]); w.y = pk4_fp8e(v1[0], v1[1], v1[2], v1[3]);
                    *(u32x2*)(rowp + bj * HALF) = w; } }
    }
};
struct MoeOrder {
    const PG8_LAS int* tab; int npn, G, c, nunits;
    __device__ __forceinline__ bool next(int i, Unit& u) const {
        const int tpx = 32 / npn, s = c >> 3, tile = (i * 8 + (c & 7)) * tpx + s / npn, pn = s % npn;
        if ((i * 8) * tpx >= nunits / npn) return false;
        if (tile >= nunits / npn) { u.pm = 0; u.pn = 0; return false; }
        int e = 0;
#pragma unroll
        for (int k = 1; k < 32; ++k) e += (tab[k] <= tile) ? 1 : 0;
        u.pm = tile; u.pn = __builtin_amdgcn_readfirstlane(e) * npn + pn; return true;
    }
    __device__ __forceinline__ void a_ready(const Unit&) const {}
    __device__ __forceinline__ void done(const Unit&) const {}
};
template <class Epi, class Sched, bool ALIGN_EPI = false, bool SP2 = false, bool F8 = false>
__device__ __forceinline__ void gemm_phase(PG8_LAS unsigned char* lds, const Gemm g, const Sched& S, const Epi& E) {
    int tid_ = threadIdx.x; asm volatile("" : "+v"(tid_));
    const int tid = tid_, wid = __builtin_amdgcn_readfirstlane(tid >> 6), lane = tid & 63, wr = wid >> 2, wc = wid & 3, fr = lane & 15, fq = lane >> 4;
    const int K = g.K, nt = K / BK;
    unsigned voffA, voffB;
    { int R, C; stage_rc(tid * 16, R, C); const int Rb = Epi::PERM ? ((R & ~31) + perm32(R & 31)) : R; voffA = (unsigned)(R * K + C) * 2u; voffB = (unsigned)(Rb * K + C) * 2u; }
    const unsigned qstep = 64u * (unsigned)K * 2u;
    const unsigned kstep = (unsigned)(BK * 2);
    const unsigned hstep = (unsigned)HALF * (unsigned)K * 2u;
    const unsigned tstep = 2u * hstep;
    const __amdgpu_buffer_rsrc_t rA = __builtin_amdgcn_make_buffer_rsrc((void*)g.A, 0, 0x7FFFFFFF, 0x00020000), rB = __builtin_amdgcn_make_buffer_rsrc((void*)g.Bt, 0, 0x7FFFFFFF, 0x00020000);
    const unsigned ldsw = (unsigned)wid * 1024u;
    const int aoff = lds_byte(wr * 64 + fr, fq * 8), boff = lds_byte(wc * 32 + fr, fq * 8);
#define PG8_SA(b, h) (((b) * 2 + (h)) * HTB)
#define PG8_SB(b, h) ((4 + (b) * 2 + (h)) * HTB)
#define PG8_STG(bufoff, rsrc, soff, voff) do { _Pragma("unroll") for (int _i = 0; _i < 2; ++_i) \
        __builtin_amdgcn_raw_ptr_buffer_load_lds((rsrc), (PG8_LAS void*)(lds + (bufoff) + ldsw + _i * 8192), 16, (int)(voff), (int)((soff) + (unsigned)_i * qstep), 0, 0); } while (0)
#define PG8_STGA(bufoff, soff) PG8_STG(bufoff, rA, soff, voffA)
#define PG8_STGB(bufoff, soff) PG8_STG(bufoff, rB, soff, voffB)
#define PG8_LDA(dst, b, h) do { _Pragma("unroll") for (int m = 0; m < 4; ++m) { if constexpr (F8) { const i32x4 lo_ = *(const PG8_LAS i32x4*)(lds + PG8_SA(b, h) + aoff + m * 2048), hi_ = *(const PG8_LAS i32x4*)(lds + PG8_SA(b, h) + aoff + m * 2048 + 1024); \
            dst##_8[m] = __builtin_shufflevector(lo_, hi_, 0, 1, 2, 3, 4, 5, 6, 7); } else { _Pragma("unroll") for (int k = 0; k < 2; ++k) dst[m][k] = *(const PG8_LAS bf16x8*)(lds + PG8_SA(b, h) + aoff + m * 2048 + k * 1024); } } } while (0)
#define PG8_LDB(dst, b, h) do { _Pragma("unroll") for (int n = 0; n < 2; ++n) { if constexpr (F8) { const i32x4 lo_ = *(const PG8_LAS i32x4*)(lds + PG8_SB(b, h) + boff + n * 2048), hi_ = *(const PG8_LAS i32x4*)(lds + PG8_SB(b, h) + boff + n * 2048 + 1024); \
            dst##_8[n] = __builtin_shufflevector(lo_, hi_, 0, 1, 2, 3, 4, 5, 6, 7); } else { _Pragma("unroll") for (int k = 0; k < 2; ++k) dst[n][k] = *(const PG8_LAS bf16x8*)(lds + PG8_SB(b, h) + boff + n * 2048 + k * 1024); } } } while (0)
#define PG8_MMA(ai, bj, At, Bt) do { __builtin_amdgcn_s_setprio(1); _Pragma("unroll") for (int m = 0; m < 4; ++m) _Pragma("unroll") for (int n = 0; n < 2; ++n) { \
        if constexpr (F8) acc[ai][bj][m][n] = __builtin_amdgcn_mfma_scale_f32_16x16x128_f8f6f4(Bt##_8[n], At##_8[m], acc[ai][bj][m][n], 0, 0, 0, g.sw, 0, g.sx); \
        else { _Pragma("unroll") for (int k = 0; k < 2; ++k) acc[ai][bj][m][n] = __builtin_amdgcn_mfma_f32_16x16x32_bf16(Bt[n][k], At[m][k], acc[ai][bj][m][n], 0, 0, 0); } } \
        __builtin_amdgcn_s_setprio(0); } while (0)
#define PG8_WAIT_V(n) asm volatile("s_waitcnt vmcnt(" #n ")" ::: "memory")
#define PG8_WAIT_L(n) asm volatile("s_waitcnt lgkmcnt(" #n ")" ::: "memory")
#define PG8_BAR __builtin_amdgcn_s_barrier()
#define PG8_SCHED __builtin_amdgcn_sched_barrier(0)
    Unit cur, nxt; int ui = 0;
    if (!S.next(0, cur)) return;
    f32x4 acc[2][2][4][2];
#pragma unroll
    for (int a = 0; a < 2; ++a)
#pragma unroll
        for (int b = 0; b < 2; ++b)
#pragma unroll
            for (int m = 0; m < 4; ++m)
#pragma unroll
                for (int n = 0; n < 2; ++n) acc[a][b][m][n] = (f32x4){0.f, 0.f, 0.f, 0.f};
    bf16x8 At[4][2], B0[2][2], B1[2][2]; i32x8 At_8[4], B0_8[2], B1_8[2];
    unsigned cA = (unsigned)cur.pm * tstep, cB = (unsigned)cur.pn * tstep;
    S.a_ready(cur);
    if constexpr (SP2) {
        PG8_STGB(PG8_SB(0, 0), cB); PG8_STGB(PG8_SB(0, 1), cB + hstep); PG8_STGA(PG8_SA(0, 0), cA); PG8_STGA(PG8_SA(0, 1), cA + hstep);
        if (wr == 1) PG8_BAR;
        PG8_WAIT_V(2); PG8_BAR;
        PG8_STGB(PG8_SB(1, 0), cB + kstep); PG8_STGA(PG8_SA(1, 0), cA + kstep); PG8_STGB(PG8_SB(1, 1), cB + hstep + kstep);
        PG8_WAIT_V(6); PG8_BAR;
    } else {
        PG8_STGB(PG8_SB(0, 0), cB); PG8_STGA(PG8_SA(0, 0), cA); PG8_STGB(PG8_SB(0, 1), cB + hstep); PG8_STGA(PG8_SA(0, 1), cA + hstep);
        if (wr == 1) PG8_BAR;
        PG8_WAIT_V(4); PG8_BAR;
        PG8_STGB(PG8_SB(1, 0), cB + kstep); PG8_STGA(PG8_SA(1, 0), cA + kstep); PG8_STGB(PG8_SB(1, 1), cB + hstep + kstep);
        PG8_WAIT_V(6); PG8_BAR;
    }
    for (;;) {
        const bool has_next = S.next(ui + 1, nxt);
        const unsigned nA = has_next ? (unsigned)nxt.pm * tstep : cA, nB = has_next ? (unsigned)nxt.pn * tstep : cB;
#pragma unroll 1
        for (int t = 0; t < nt; t += 2) {
            const bool last = (t == nt - 2);
            const unsigned a1 = cA + (unsigned)(t + 1) * kstep;
            const unsigned a2 = last ? nA : cA + (unsigned)(t + 2) * kstep, b2 = last ? nB : cB + (unsigned)(t + 2) * kstep;
            const unsigned a3 = a2 + kstep, b3 = b2 + kstep;
            if (last && has_next) S.a_ready(nxt);
            if constexpr (SP2) {
            PG8_LDB(B0, 0, 0); PG8_LDB(B1, 0, 1); PG8_SCHED; PG8_LDA(At, 0, 0); PG8_STGA(PG8_SA(1, 1), a1 + hstep);
            PG8_WAIT_V(8); PG8_WAIT_L(0); PG8_BAR; PG8_MMA(0, 0, At, B0); PG8_MMA(0, 1, At, B1); PG8_BAR; PG8_SCHED;
            PG8_LDA(At, 0, 1); PG8_STGB(PG8_SB(0, 0), b2); PG8_STGB(PG8_SB(0, 1), b2 + hstep); PG8_STGA(PG8_SA(0, 0), a2);
            PG8_WAIT_V(8); PG8_WAIT_L(0); PG8_BAR; PG8_MMA(1, 0, At, B0); PG8_MMA(1, 1, At, B1); PG8_BAR; PG8_SCHED;
            PG8_LDB(B0, 1, 0); PG8_LDB(B1, 1, 1); PG8_SCHED; PG8_LDA(At, 1, 0); PG8_STGA(PG8_SA(0, 1), a2 + hstep);
            PG8_WAIT_V(8); PG8_WAIT_L(0); PG8_BAR; PG8_MMA(0, 0, At, B0); PG8_MMA(0, 1, At, B1); PG8_BAR; PG8_SCHED;
            PG8_LDA(At, 1, 1); PG8_STGB(PG8_SB(1, 0), b3); PG8_STGB(PG8_SB(1, 1), b3 + hstep); PG8_STGA(PG8_SA(1, 0), a3);
            PG8_WAIT_V(8); PG8_WAIT_L(0); PG8_BAR; PG8_MMA(1, 0, At, B0); PG8_MMA(1, 1, At, B1); PG8_BAR; PG8_SCHED;
            } else {
            PG8_LDB(B0, 0, 0); PG8_SCHED; PG8_LDA(At, 0, 0); PG8_STGA(PG8_SA(1, 1), a1 + hstep);
            PG8_WAIT_L(8); PG8_BAR; PG8_WAIT_L(0); PG8_MMA(0, 0, At, B0); PG8_BAR; PG8_SCHED;
            PG8_LDB(B1, 0, 1); PG8_STGB(PG8_SB(0, 0), b2);
            PG8_BAR; PG8_WAIT_L(0); PG8_MMA(0, 1, At, B1); PG8_BAR;
            PG8_LDA(At, 0, 1); PG8_STGA(PG8_SA(0, 0), a2);
            PG8_BAR; PG8_WAIT_L(0); PG8_MMA(1, 0, At, B0); PG8_BAR; PG8_SCHED;
            PG8_STGB(PG8_SB(0, 1), b2 + hstep);
            PG8_WAIT_V(6); PG8_BAR; PG8_MMA(1, 1, At, B1); PG8_BAR;
            PG8_LDB(B0, 1, 0); PG8_SCHED; PG8_LDA(At, 1, 0); PG8_STGA(PG8_SA(0, 1), a2 + hstep);
            PG8_WAIT_L(8); PG8_BAR; PG8_WAIT_L(0); PG8_MMA(0, 0, At, B0); PG8_BAR; PG8_SCHED;
            PG8_LDB(B1, 1, 1); PG8_STGB(PG8_SB(1, 0), b3);
            PG8_BAR; PG8_WAIT_L(0); PG8_MMA(0, 1, At, B1); PG8_BAR;
            PG8_LDA(At, 1, 1); PG8_STGA(PG8_SA(1, 0), a3);
            PG8_BAR; PG8_WAIT_L(0); PG8_MMA(1, 0, At, B0); PG8_BAR; PG8_SCHED;
            PG8_STGB(PG8_SB(1, 1), b3 + hstep);
            PG8_WAIT_V(6); PG8_BAR; PG8_MMA(1, 1, At, B1); PG8_BAR;
            }
        }
        if constexpr (ALIGN_EPI) { if (wr == 0) PG8_BAR; }
        if constexpr (!Epi::AFTER_DRAIN) { int t2_ = threadIdx.x; asm volatile("" : "+v"(t2_)); E(acc, cur, wr, wc, t2_ & 15, (t2_ & 63) >> 4); S.done(cur); }
        if (!has_next) break;
#pragma unroll
        for (int a = 0; a < 2; ++a)
#pragma unroll
            for (int b = 0; b < 2; ++b)
#pragma unroll
                for (int m = 0; m < 4; ++m)
#pragma unroll
                    for (int n = 0; n < 2; ++n) acc[a][b][m][n] = (f32x4){0.f, 0.f, 0.f, 0.f};
        cur = nxt; cA = nA; cB = nB; ++ui;
        if constexpr (ALIGN_EPI) { if (wr == 1) PG8_BAR; }
    }
    PG8_WAIT_V(0);
    if constexpr (!ALIGN_EPI) { if (wr == 0) PG8_BAR; }
    PG8_BAR;
    if constexpr (Epi::AFTER_DRAIN) { E.fused(acc, cur, wr, wc, fr, fq, lds, wid, lane); S.done(cur); }
#undef PG8_SA
#undef PG8_SB
#undef PG8_STG
#undef PG8_STGA
#undef PG8_STGB
#undef PG8_LDA
#undef PG8_LDB
#undef PG8_MMA
#undef PG8_WAIT_V
#undef PG8_WAIT_L
#undef PG8_BAR
#undef PG8_SCHED
}
}

constexpr int NWAVES = 8, NTHR = 512, GRID = 256;
constexpr int NBATCH = 2, SEQ = 16384, T = NBATCH * SEQ, D = 1024, DEPTH = 4;
constexpr int MIXW = 768, NC_H = 3328, NC_M = 2560;
constexpr int HG_H = 6;
constexpr int HSEG = 256, HNSEG = SEQ / HSEG;
constexpr int MB_H = 12, MB_NB = 64;
constexpr int NE = 32;
constexpr float DN_ALPHA = 1.6817928305074290f;
constexpr int MOE_MAXROWS = T * 4 + NE * 256;
#ifndef ONE_LAUNCH
#define ONE_LAUNCH 1
#endif
constexpr int NPHASE = 13;

constexpr size_t MiB = 1u << 20;
constexpr size_t WS_CTL = 0, CTL_ZERO_BYTES = 1 * MiB;
constexpr size_t WS_WIN = 1 * MiB, WS_WKV = 9 * MiB, WS_WO = 10 * MiB, WS_WGU = 12 * MiB, WS_WD = 140 * MiB;
constexpr size_t WS_XBF = 204 * MiB, WS_WKV4 = 268 * MiB  , WS_KV4 = 272 * MiB  , WS_WRS = 280 * MiB  , WS_MEMBF = 524 * MiB;
constexpr size_t WS_H = 526 * MiB, WS_MIX = 734 * MiB, WS_Y = 798 * MiB, WS_SLOC = 862 * MiB, WS_DSEG = 910 * MiB, WS_KMEAN = 911 * MiB;
constexpr size_t WS_SELINFO = 912 * MiB, WS_TOK = 914 * MiB, WS_R1 = 918 * MiB;
constexpr size_t WS_LIST = WS_R1, WS_PML = WS_R1 + 96 * MiB, WS_PO = WS_R1 + 108 * MiB;
constexpr size_t WS_XS = WS_R1, WS_HID = WS_R1 + 272 * MiB;
constexpr size_t WS_END = WS_R1 + 544 * MiB;
static_assert((size_t)MOE_MAXROWS * 1024 * 2 <= 272 * MiB, "moe rows");
static_assert((size_t)T * MB_H * 4 * 64 * 4 <= 384 * MiB && (size_t)24 * 64 * 16384 * 4 <= 96 * MiB, "moba bufs");
constexpr size_t TOK_E = 0, TOK_LR = 512 * 1024, TOK_W = 1024 * 1024, TOK_ROW = 1536 * 1024, TOK_BLKCNT = 2048 * 1024, TOK_TAB = 2048 * 1024 + 65536;
constexpr int CW_BAR = 4096, CW_GCOUNT = 8192;

constexpr int RING_BYTES = 131072, LDS_BYTES = 147456, MISC_OFF = LDS_BYTES - 1024;

#define GAS __attribute__((address_space(1)))
#define LAS __attribute__((address_space(3)))
typedef unsigned short bf16;
typedef unsigned v4u __attribute__((ext_vector_type(4)));
typedef unsigned v2u __attribute__((ext_vector_type(2)));
typedef float f32x4 __attribute__((ext_vector_type(4)));
typedef float f32x2 __attribute__((ext_vector_type(2)));
typedef short s16x8 __attribute__((ext_vector_type(8)));
typedef float f32x16 __attribute__((ext_vector_type(16)));
typedef float f32x2_t __attribute__((ext_vector_type(2))); typedef __bf16 bf16x2_t __attribute__((ext_vector_type(2)));
__device__ __forceinline__ unsigned cvtpk(float lo, float hi) { f32x2_t v = {lo, hi}; bf16x2_t b = __builtin_convertvector(v, bf16x2_t); return __builtin_bit_cast(unsigned, b); }
#define LDS_WAIT() asm volatile("s_waitcnt lgkmcnt(0)" ::: "memory")
__device__ __forceinline__ unsigned f2bf(float f) { unsigned u = __builtin_bit_cast(unsigned, f); return (u + 0x7fffu + ((u >> 16) & 1u)) >> 16; }
__device__ __forceinline__ unsigned pk2(float lo, float hi) { return f2bf(lo) | (f2bf(hi) << 16); }
__device__ __forceinline__ float bflo(unsigned w) { return __builtin_bit_cast(float, w << 16); }
__device__ __forceinline__ float bfhi(unsigned w) { return __builtin_bit_cast(float, w & 0xffff0000u); }
__device__ __forceinline__ float bf2f(bf16 h) { return __builtin_bit_cast(float, (unsigned)h << 16); }
__device__ __forceinline__ float sigmoidf_(float z) { return __builtin_amdgcn_rcpf(1.0f + __builtin_amdgcn_exp2f(-1.4426950408889634f * z)); }
template <int X> __device__ __forceinline__ float xorf(float v) { return __builtin_bit_cast(float, __builtin_amdgcn_ds_swizzle(__builtin_bit_cast(int, v), (X << 10) | 0x1F)); }
template <int X> __device__ __forceinline__ int xori(int v) { return __builtin_amdgcn_ds_swizzle(v, (X << 10) | 0x1F); }
__device__ __forceinline__ float wave_sum(float v) {
    v += xorf<1>(v); v += xorf<2>(v); v += xorf<4>(v); v += xorf<8>(v); v += xorf<16>(v);
    return __builtin_bit_cast(float, __builtin_amdgcn_readlane(__builtin_bit_cast(int, v), 0)) + __builtin_bit_cast(float, __builtin_amdgcn_readlane(__builtin_bit_cast(int, v), 32));
}
__device__ __forceinline__ float wave_max(float v) {
    v = fmaxf(v, xorf<1>(v)); v = fmaxf(v, xorf<2>(v)); v = fmaxf(v, xorf<4>(v)); v = fmaxf(v, xorf<8>(v)); v = fmaxf(v, xorf<16>(v));
    return fmaxf(__builtin_bit_cast(float, __builtin_amdgcn_readlane(__builtin_bit_cast(int, v), 0)), __builtin_bit_cast(float, __builtin_amdgcn_readlane(__builtin_bit_cast(int, v), 32)));
}
__device__ __forceinline__ float xor32f(float v, int lane) { return __builtin_bit_cast(float, __builtin_amdgcn_ds_bpermute((lane ^ 32) << 2, __builtin_bit_cast(int, v))); }
#define XB_TMO      128
#define XB_XCNT(j)  (256  + 64 * (j))
#define XB_XSUB(j)  (1280 + 64 * (j))
#define XB_XGEN(j)  (2304 + 64 * (j))
#define XB_TOP      3328
#define XB_TOPGEN   3392
#define XCD_BAR_WORDS 3456
#define XB_SPIN_CAP (1u << 18)

__device__ __forceinline__ unsigned xb_ld(unsigned* p)              { return __hip_atomic_load(p, __ATOMIC_RELAXED, __HIP_MEMORY_SCOPE_AGENT); }
__device__ __forceinline__ unsigned xb_add(unsigned* p, unsigned v) { return __hip_atomic_fetch_add(p, v, __ATOMIC_RELAXED, __HIP_MEMORY_SCOPE_AGENT); }
__device__ __forceinline__ unsigned xb_xcc_id() { return (unsigned)__builtin_amdgcn_s_getreg((3 << 11) | 20) & 0xFu; }
#define XB_SPIN(cond, bar) do { unsigned _sp = 0; while (cond) { __builtin_amdgcn_s_sleep(1); \
    if ((++_sp & 255u) == 0u) { if (xb_ld(&(bar)[XB_TMO])) break; if (_sp > XB_SPIN_CAP) { atomicAdd(&(bar)[XB_TMO], 1u); break; } } } } while (0)

struct XcdBarrier {
    unsigned* bar; unsigned x;
    volatile LAS unsigned* st;
};

__device__ __forceinline__ XcdBarrier xcd_barrier_post(unsigned* bar, volatile LAS unsigned* st) {
    XcdBarrier b; b.bar = bar; b.x = xb_xcc_id(); b.st = st;
    if (threadIdx.x == 0) (void)xb_add(&bar[XB_XCNT(b.x)], 1u);
    return b;
}
__device__ __forceinline__ void xcd_barrier_complete(unsigned* bar, unsigned x, unsigned& nloc, unsigned& nx) {
    const unsigned G = gridDim.x * gridDim.y * gridDim.z;
    unsigned sum, cnt, mine, sp = 0u;
    for (;;) {
        sum = 0u; cnt = 0u; mine = 0u;
#pragma unroll
        for (unsigned j = 0; j < 16; ++j) { const unsigned c = xb_ld(&bar[XB_XCNT(j)]); sum += c; cnt += (c > 0u) ? 1u : 0u; mine = (j == x) ? c : mine; }
        if (sum == G) break;
        __builtin_amdgcn_s_sleep(1);
        if ((++sp & 255u) == 0u) { if (xb_ld(&bar[XB_TMO])) break; if (sp > XB_SPIN_CAP) { atomicAdd(&bar[XB_TMO], 1u); break; } }
    }
    nloc = mine > 0u ? mine : 1u; nx = cnt > 0u ? cnt : 1u;
}

__device__ __forceinline__ void xcd_barrier(const XcdBarrier& b) {
    asm volatile("s_waitcnt vmcnt(0)" ::: "memory");
    __syncthreads();
    if (threadIdx.x == 0) {
        unsigned* bar = b.bar;
        __builtin_amdgcn_s_waitcnt(0);
        unsigned nloc = b.st[0], nx = b.st[1];
        if (nloc == 0u) { xcd_barrier_complete(bar, b.x, nloc, nx); b.st[0] = nloc; b.st[1] = nx; }
        const unsigned old = xb_add(&bar[XB_XSUB(b.x)], 1u);
        const unsigned gen = old / nloc;
        if (old + 1u == (gen + 1u) * nloc) {
            __builtin_amdgcn_fence(__ATOMIC_RELEASE, "agent");
            asm volatile("s_waitcnt vmcnt(0)" ::: "memory");
            const unsigned og = xb_add(&bar[XB_TOP], 1u);
            const unsigned tg = og / nx;
            if (og + 1u == (tg + 1u) * nx) xb_add(&bar[XB_TOPGEN], 1u);
            else XB_SPIN(xb_ld(&bar[XB_TOPGEN]) == tg, bar);
            __builtin_amdgcn_fence(__ATOMIC_ACQUIRE, "agent");
            xb_add(&bar[XB_XGEN(b.x)], 1u);
            asm volatile("s_waitcnt vmcnt(0)" ::: "memory");
        } else {
            XB_SPIN(xb_ld(&bar[XB_XGEN(b.x)]) == gen, bar);
            __builtin_amdgcn_fence(__ATOMIC_ACQUIRE, "agent");
            asm volatile("s_waitcnt vmcnt(0)" ::: "memory");
        }
    }
    __syncthreads();
}

__device__ __forceinline__ void cvt_rows_bf16(const float* src, bf16* dst, size_t n8, size_t gtid, size_t gthreads) {
    for (size_t i = gtid; i < n8; i += gthreads) { const f32x4 a = ((const f32x4*)src)[2 * i], b = ((const f32x4*)src)[2 * i + 1];
        v4u o; o.x = pk2(a.x, a.y); o.y = pk2(a.z, a.w); o.z = pk2(b.x, b.y); o.w = pk2(b.z, b.w); ((v4u*)dst)[i] = o; }
}
__device__ __forceinline__ void transpose_item(const float* W, int N, bf16* WT, int dst_row0, LAS float* scr, int k0, int n0, int lane) {
#pragma unroll 8
    for (int i = 0; i < 32; ++i) { const int kk = 2 * i + (lane >> 5); scr[kk * 33 + (lane & 31)] = W[(size_t)(k0 + kk) * N + n0 + (lane & 31)]; }
    LDS_WAIT(); asm volatile("" ::: "memory");
    const int c = lane & 7;
#pragma unroll
    for (int j = 0; j < 4; ++j) { const int n = (lane >> 3) + 8 * j; const LAS float* s = scr + (8 * c) * 33 + n;
        v4u o; o.x = pk2(s[0 * 33], s[1 * 33]); o.y = pk2(s[2 * 33], s[3 * 33]); o.z = pk2(s[4 * 33], s[5 * 33]); o.w = pk2(s[6 * 33], s[7 * 33]);
        *(v4u*)(WT + (size_t)(dst_row0 + n) * 1024 + k0 + 8 * c) = o; }
    LDS_WAIT(); asm volatile("" ::: "memory");
}
__device__ __forceinline__ unsigned pk4_fp8(float a, float b, float c, float d) { int w = 0; w = __builtin_amdgcn_cvt_pk_fp8_f32(a, b, w, false); w = __builtin_amdgcn_cvt_pk_fp8_f32(c, d, w, true); return (unsigned)w; }
__device__ __forceinline__ void transpose_item_f8(const float* W, int N, unsigned char* WT8, int dst_row0, LAS float* scr, int k0, int n0, int lane, float wscale) {
#pragma unroll 8
    for (int i = 0; i < 32; ++i) { const int kk = 2 * i + (lane >> 5); scr[kk * 33 + (lane & 31)] = W[(size_t)(k0 + kk) * N + n0 + (lane & 31)]; }
    LDS_WAIT(); asm volatile("" ::: "memory");
    const int c = lane & 7;
#pragma unroll
    for (int j = 0; j < 4; ++j) { const int n = (lane >> 3) + 8 * j; const LAS float* s = scr + (8 * c) * 33 + n;
        v2u o; o.x = pk4_fp8(s[0 * 33] * wscale, s[1 * 33] * wscale, s[2 * 33] * wscale, s[3 * 33] * wscale); o.y = pk4_fp8(s[4 * 33] * wscale, s[5 * 33] * wscale, s[6 * 33] * wscale, s[7 * 33] * wscale);
        *(v2u*)(WT8 + (size_t)(dst_row0 + n) * 1024 + k0 + 8 * c) = o; }
    LDS_WAIT(); asm volatile("" ::: "memory");
}
__device__ __forceinline__ void phase_weights(LAS float* scr, int gw, int ngw, int lane, const float* win_src, int NC, const float* wkv_src, int nkv, const float* wo_src,
                                              const float* wg_src, const float* wu_src, const float* wd_src, bf16* win_t, bf16* wkv_t, bf16* wo_t, bf16* wgu_t, bf16* wd_t) {
    const int nbw = NC / 32, nWin = nbw * 16, NIT = nWin + 256 * nkv + 512 + NE * 1536;
    for (int it = gw; it < NIT; it += ngw) {
        int r = it;
        if (r < nWin) { const int kb = r / nbw, nb = r - kb * nbw; transpose_item(win_src, NC, win_t, 32 * nb, scr, 64 * kb, 32 * nb, lane); continue; } r -= nWin;
        if (r < 256 * nkv) { const int lay = r >> 8, rr = r & 255, kb = rr >> 4, nb = rr & 15; transpose_item(wkv_src + (size_t)lay * D * 512, 512, wkv_t + (size_t)lay * 512 * 1024, 32 * nb, scr, 64 * kb, 32 * nb, lane); continue; } r -= 256 * nkv;
        if (r < 512) { const int kb = r >> 5, nb = r & 31; transpose_item(wo_src, 1024, wo_t, 32 * nb, scr, 64 * kb, 32 * nb, lane); continue; } r -= 512;
        const int e = r / 1536, q = r - e * 1536, which = q >> 9, rr = q & 511, kb = rr >> 5, nb = rr & 31, n0 = 32 * nb;
        const size_t eoff = (size_t)e * 1024 * 1024;
        if (which == 0) transpose_item_f8(wg_src + eoff, 1024, (unsigned char*)wgu_t + 2 * eoff, (n0 >> 7) * 256 + (n0 & 127), scr, 64 * kb, n0, lane, 32.f);
        else if (which == 1) transpose_item_f8(wu_src + eoff, 1024, (unsigned char*)wgu_t + 2 * eoff, (n0 >> 7) * 256 + 128 + (n0 & 127), scr, 64 * kb, n0, lane, 32.f);
        else transpose_item_f8(wd_src + eoff, 1024, (unsigned char*)wd_t + eoff, n0, scr, 64 * kb, n0, lane, 64.f);
    }
}

template <bool OUT>
__device__ __forceinline__ void hgrn_seg(LAS unsigned char* lds, const bf16* h, const float* lbl, int j, const float* normg, float* Sloc, float* Dseg, bf16* mix, int unit, int tid, int wave, int lane) {
    const int seg = unit & (HNSEG - 1), bh = unit >> 6, hh = bh % HG_H, b = bh / HG_H;
    const int v = tid & 127, dg = tid >> 7;
    LAS float* fgs = (LAS float*)lds; LAS float* vs = fgs + 4096; LAS float* qs = vs + 4096; LAS float* op = qs + 4096;
    f32x2 st[16];
    float* Sp = Sloc + (size_t)unit * 16384 + (size_t)(dg * 32) * 128 + v;
#pragma unroll
    for (int dd = 0; dd < 16; ++dd) { st[dd].x = OUT ? Sp[(2 * dd) * 128] : 0.f; st[dd].y = OUT ? Sp[(2 * dd + 1) * 128] : 0.f; }
    float dprod = 1.f;
    const int stok = tid >> 4, c8 = (tid & 15) * 8;
    float lb[8];
#pragma unroll
    for (int i = 0; i < 8; ++i) { lb[i] = 0.f; if (j > 0) { const float a0 = lbl[hh * 128 + c8 + i], a1 = lbl[MIXW + hh * 128 + c8 + i]; lb[i] = 1.f / (1.f + __expf(a0 - a1)); } }
    for (int ch = 0; ch < HSEG / 32; ++ch) {
        const size_t t0 = (size_t)b * SEQ + seg * HSEG + ch * 32;
        { const bf16* row = h + (t0 + stok) * NC_H + hh * 128 + c8;
          const v4u f8 = *(const v4u*)(row + 768), i8 = *(const v4u*)(row + 1536); v4u q8 = {0u, 0u, 0u, 0u}; if (OUT) q8 = *(const v4u*)row;
#pragma unroll
          for (int w = 0; w < 4; ++w) { const float f0 = bflo(f8[w]), f1 = bfhi(f8[w]); const int o = stok * 128 + c8 + 2 * w;
              fgs[o] = lb[2 * w] + (1.f - lb[2 * w]) * sigmoidf_(f0); fgs[o + 1] = lb[2 * w + 1] + (1.f - lb[2 * w + 1]) * sigmoidf_(f1);
              vs[o] = bflo(i8[w]); vs[o + 1] = bfhi(i8[w]);
              if (OUT) { const float q0 = bflo(q8[w]), q1 = bfhi(q8[w]); qs[o] = q0 * sigmoidf_(q0); qs[o + 1] = q1 * sigmoidf_(q1); } } }
        __syncthreads();
        if (!OUT) { if (tid < 128) { for (int tt = 0; tt < 32; ++tt) dprod *= fgs[tt * 128 + tid]; } }
        f32x4 fA[8], qA[8], fB[8], qB[8]; float vA, vB;
#define HG_LOAD(F, Q, V, tt_) do { V = vs[(tt_) * 128 + v]; _Pragma("unroll") for (int d4 = 0; d4 < 8; ++d4) { F[d4] = *(const LAS f32x4*)(fgs + (tt_) * 128 + dg * 32 + d4 * 4); \
            if (OUT) Q[d4] = *(const LAS f32x4*)(qs + (tt_) * 128 + dg * 32 + d4 * 4); } } while (0)
#define HG_STEP(F, Q, V, tt_) do { const f32x2 vv2 = {V, V}; f32x2 acc2 = {0.f, 0.f}; _Pragma("unroll") for (int d4 = 0; d4 < 8; ++d4) { \
            const f32x2 fa = {F[d4].x, F[d4].y}, fb = {F[d4].z, F[d4].w}; \
            st[2 * d4] = fa * (st[2 * d4] - vv2) + vv2; st[2 * d4 + 1] = fb * (st[2 * d4 + 1] - vv2) + vv2; \
            if (OUT) { const f32x2 qa = {Q[d4].x, Q[d4].y}, qb = {Q[d4].z, Q[d4].w}; acc2 = qa * st[2 * d4] + acc2; acc2 = qb * st[2 * d4 + 1] + acc2; } } \
            if (OUT) op[(dg * 32 + (tt_)) * 128 + v] = acc2.x + acc2.y; } while (0)
        HG_LOAD(fA, qA, vA, 0);
#pragma unroll 1
        for (int tt = 0; tt < 32; tt += 2) {
            HG_LOAD(fB, qB, vB, tt + 1);
            __builtin_amdgcn_sched_barrier(0);
            HG_STEP(fA, qA, vA, tt);
            __builtin_amdgcn_sched_barrier(0);
            if (tt + 2 < 32) HG_LOAD(fA, qA, vA, tt + 2);
            __builtin_amdgcn_sched_barrier(0);
            HG_STEP(fB, qB, vB, tt + 1);
            __builtin_amdgcn_sched_barrier(0);
        }
#undef HG_LOAD
#undef HG_STEP
        if (OUT) {
            __syncthreads();
#pragma unroll
            for (int k = 0; k < 4; ++k) { const int tt = wave + 8 * k; float o0 = 0.f, o1 = 0.f;
#pragma unroll
                for (int g = 0; g < 4; ++g) { o0 += op[(g * 32 + tt) * 128 + lane]; o1 += op[(g * 32 + tt) * 128 + lane + 64]; }
                const float ms = wave_sum(o0 * o0 + o1 * o1) * (1.f / 128.f), r = 1.f / sqrtf(ms + 1e-6f);
                const bf16* grow = h + (t0 + tt) * NC_H + 2304 + hh * 128; const float g0 = bf2f(grow[lane]), g1 = bf2f(grow[lane + 64]);
                bf16* mrow = mix + (t0 + tt) * 1024 + hh * 128;
                mrow[lane] = (bf16)f2bf(o0 * r * normg[lane] * sigmoidf_(g0)); mrow[lane + 64] = (bf16)f2bf(o1 * r * normg[lane + 64] * sigmoidf_(g1)); }
        }
        __syncthreads();
    }
    if (!OUT) {
#pragma unroll
        for (int dd = 0; dd < 16; ++dd) { Sp[(2 * dd) * 128] = st[dd].x; Sp[(2 * dd + 1) * 128] = st[dd].y; }
        if (tid < 128) Dseg[(size_t)unit * 128 + tid] = dprod;
    }
}
constexpr int HG_G = 0, HG_QT = 32768, HG_KT = 50176, HG_KE = 67584, HG_VT = 86016, HG_ST = 104448, HG_GM = 139264, HG_GE = 139776, HG_PART = 140288;
static_assert(HG_PART + 2048 <= MISC_OFF, "HGRN LDS map");
__device__ __forceinline__ int crow16(int i, int hf) { return (i & 3) + 8 * (i >> 2) + 4 * hf; }
template <bool OUT>
__device__ __forceinline__ void hgrn_mfma(LAS unsigned char* lds, const bf16* h, const float* lbl, int j, const float* normg, float* Sloc, float* Dseg, bf16* mix, int unit, int tid, int wave, int lane) {
    const int seg = unit & (HNSEG - 1), bh = unit >> 6, hh = bh % HG_H, b = bh / HG_H;
    const int r = lane & 31, hf = lane >> 5, tr = wave & 1, vq = wave >> 1;
    LAS float* G = (LAS float*)(lds + HG_G); LAS float* GM = (LAS float*)(lds + HG_GM); LAS float* GE = (LAS float*)(lds + HG_GE); LAS float* PART = (LAS float*)(lds + HG_PART);
    const int stok = tid >> 3, c16 = (tid & 7) * 16, sperm = (stok & ~15) | (stok & 3) | ((stok & 4) << 1) | ((stok & 8) >> 1);
    const int cd = tid & 127, cpart = tid >> 7;
    float lb[16];
#pragma unroll
    for (int e = 0; e < 16; ++e) { lb[e] = 0.f; if (j > 0) { const float a0 = lbl[hh * 128 + c16 + e], a1 = lbl[MIXW + hh * 128 + c16 + e]; lb[e] = 1.f / (1.f + __expf(a0 - a1)); } }
    f32x16 S[2];
    float* Sp = Sloc + (size_t)unit * 16384 + 32 * vq + r;
#pragma unroll
    for (int dd = 0; dd < 2; ++dd)
#pragma unroll
        for (int i = 0; i < 16; ++i) S[dd][i] = OUT ? Sp[(32 * (2 * tr + dd) + crow16(i, hf)) * 128] : 0.f;
    float gsum = 0.f;
    float ng16[16];
#pragma unroll
    for (int e = 0; e < 16; ++e) ng16[e] = OUT ? normg[c16 + e] : 0.f;
    v4u nf8[2], ni8[2], nq8[2] = {{0u, 0u, 0u, 0u}, {0u, 0u, 0u, 0u}}, ng8[2] = {{0u, 0u, 0u, 0u}, {0u, 0u, 0u, 0u}};
#define HG_RAWLOAD(t0_) do { const bf16* row_ = h + ((t0_) + stok) * NC_H + hh * 128 + c16; nf8[0] = *(const v4u*)(row_ + 768); nf8[1] = *(const v4u*)(row_ + 776); ni8[0] = *(const v4u*)(row_ + 1536); ni8[1] = *(const v4u*)(row_ + 1544); \
        if (OUT) { nq8[0] = *(const v4u*)row_; nq8[1] = *(const v4u*)(row_ + 8); ng8[0] = *(const v4u*)(row_ + 2304); ng8[1] = *(const v4u*)(row_ + 2312); } } while (0)
    HG_RAWLOAD((size_t)b * SEQ + seg * HSEG);
    for (int ch = 0; ch < HSEG / 64; ++ch) {
        const size_t t0 = (size_t)b * SEQ + seg * HSEG + ch * 64;
        float fg[16], qv[16]; v4u i8[2], g8[2];
        { const v4u f8[2] = {nf8[0], nf8[1]}; i8[0] = ni8[0]; i8[1] = ni8[1]; const v4u q8[2] = {nq8[0], nq8[1]}; g8[0] = ng8[0]; g8[1] = ng8[1];
#pragma unroll
          for (int w = 0; w < 8; ++w) { const unsigned fw = f8[w >> 2][w & 3]; const float f0 = bflo(fw), f1 = bfhi(fw);
              fg[2 * w] = lb[2 * w] + (1.f - lb[2 * w]) * sigmoidf_(f0); fg[2 * w + 1] = lb[2 * w + 1] + (1.f - lb[2 * w + 1]) * sigmoidf_(f1);
              if (OUT) { const unsigned qw = q8[w >> 2][w & 3]; const float q0 = bflo(qw), q1 = bfhi(qw); qv[2 * w] = q0 * sigmoidf_(q0); qv[2 * w + 1] = q1 * sigmoidf_(q1); } else { qv[2 * w] = 0.f; qv[2 * w + 1] = 0.f; } }
#pragma unroll
          for (int e4 = 0; e4 < 4; ++e4) { f32x4 lg; lg.x = __builtin_amdgcn_logf(fg[4 * e4]); lg.y = __builtin_amdgcn_logf(fg[4 * e4 + 1]); lg.z = __builtin_amdgcn_logf(fg[4 * e4 + 2]); lg.w = __builtin_amdgcn_logf(fg[4 * e4 + 3]);
              *(LAS f32x4*)(G + stok * 128 + c16 + 4 * e4) = lg; } }
        __syncthreads();
        { float run = 0.f;
#pragma unroll
          for (int k = 0; k < 16; ++k) run += G[(16 * cpart + k) * 128 + cd];
          PART[cpart * 128 + cd] = run; }
        __syncthreads();
        { float run = 0.f;
#pragma unroll
          for (int pp = 0; pp < 3; ++pp) run += (pp < cpart) ? PART[pp * 128 + cd] : 0.f;
#pragma unroll
          for (int k = 0; k < 16; ++k) { run += G[(16 * cpart + k) * 128 + cd]; G[(16 * cpart + k) * 128 + cd] = run; }
          if (cpart == 1) GM[cd] = run;
          if (cpart == 3) { GE[cd] = run; gsum += run; } }
        __syncthreads();
        if (OUT) {
#pragma unroll
            for (int dd = 0; dd < 2; ++dd)
#pragma unroll
                for (int g4 = 0; g4 < 4; ++g4) { const int dbase = 32 * (2 * tr + dd) + 8 * g4 + 4 * hf; const f32x4 gm = *(const LAS f32x4*)(GM + dbase);
                    v2u w; w.x = cvtpk(S[dd][4 * g4] * __builtin_amdgcn_exp2f(gm.x), S[dd][4 * g4 + 1] * __builtin_amdgcn_exp2f(gm.y)); w.y = cvtpk(S[dd][4 * g4 + 2] * __builtin_amdgcn_exp2f(gm.z), S[dd][4 * g4 + 3] * __builtin_amdgcn_exp2f(gm.w));
                    *(LAS v2u*)(lds + HG_ST + (32 * vq + r) * 272 + dbase * 2) = w; }
        }
        { unsigned qt[8], kt[8];
#pragma unroll
          for (int e4 = 0; e4 < 4; ++e4) { const f32x4 gv = *(const LAS f32x4*)(G + stok * 128 + c16 + 4 * e4), gm = *(const LAS f32x4*)(GM + c16 + 4 * e4), ge = *(const LAS f32x4*)(GE + c16 + 4 * e4);
              float ke[4];
#pragma unroll
              for (int e = 0; e < 4; ++e) { const float kk = 1.f - fg[4 * e4 + e]; ke[e] = kk * __builtin_amdgcn_exp2f(ge[e] - gv[e]);
                  if (OUT) { const float a = qv[4 * e4 + e] * __builtin_amdgcn_exp2f(gv[e] - gm[e]), c = kk * __builtin_amdgcn_exp2f(gm[e] - gv[e]);
                      if (e & 1) { qt[2 * e4 + (e >> 1)] |= f2bf(a) << 16; kt[2 * e4 + (e >> 1)] |= f2bf(c) << 16; } else { qt[2 * e4 + (e >> 1)] = f2bf(a); kt[2 * e4 + (e >> 1)] = f2bf(c); } } }
#pragma unroll
              for (int e = 0; e < 4; ++e) { const int col = c16 + 4 * e4 + e;
                  *(LAS bf16*)(lds + HG_KE + col * 144 + sperm * 2) = (bf16)f2bf(ke[e]);
                  const unsigned vw = i8[e4 >> 1][(2 * e4 + (e >> 1)) & 3]; *(LAS bf16*)(lds + HG_VT + col * 144 + sperm * 2) = (bf16)((e & 1) ? (vw >> 16) : (vw & 0xffffu)); } }
          if (OUT) { *(LAS v4u*)(lds + HG_QT + stok * 272 + c16 * 2) = (v4u){qt[0], qt[1], qt[2], qt[3]}; *(LAS v4u*)(lds + HG_QT + stok * 272 + c16 * 2 + 16) = (v4u){qt[4], qt[5], qt[6], qt[7]};
                     *(LAS v4u*)(lds + HG_KT + stok * 272 + c16 * 2) = (v4u){kt[0], kt[1], kt[2], kt[3]}; *(LAS v4u*)(lds + HG_KT + stok * 272 + c16 * 2 + 16) = (v4u){kt[4], kt[5], kt[6], kt[7]}; } }
        __syncthreads();
        if (ch + 1 < HSEG / 64) HG_RAWLOAD(t0 + 64);
        if (OUT) {
            f32x16 X0, X1, O;
#pragma unroll
            for (int i = 0; i < 16; ++i) { X0[i] = 0.f; X1[i] = 0.f; O[i] = 0.f; }
            const LAS unsigned char* qtp = lds + HG_QT + (32 * tr + r) * 272 + hf * 16;
#pragma unroll
            for (int ks = 0; ks < 8; ++ks) { const s16x8 bq = *(const LAS s16x8*)(qtp + ks * 32);
                const s16x8 a0 = *(const LAS s16x8*)(lds + HG_KT + r * 272 + hf * 16 + ks * 32); X0 = __builtin_amdgcn_mfma_f32_32x32x16_bf16(a0, bq, X0, 0, 0, 0);
                if (tr == 1) { const s16x8 a1 = *(const LAS s16x8*)(lds + HG_KT + (32 + r) * 272 + hf * 16 + ks * 32); X1 = __builtin_amdgcn_mfma_f32_32x32x16_bf16(a1, bq, X1, 0, 0, 0); } }
#pragma unroll
            for (int i = 0; i < 16; ++i) { const bool keep = crow16(i, hf) <= r; if (tr == 0) X0[i] = keep ? X0[i] : 0.f; else X1[i] = keep ? X1[i] : 0.f; }
            const LAS unsigned char* vtp = lds + HG_VT + (32 * vq + r) * 144 + hf * 16;
#pragma unroll
            for (int s2 = 0; s2 < 2; ++s2) { v4u pw; pw.x = cvtpk(X0[8 * s2], X0[8 * s2 + 1]); pw.y = cvtpk(X0[8 * s2 + 2], X0[8 * s2 + 3]); pw.z = cvtpk(X0[8 * s2 + 4], X0[8 * s2 + 5]); pw.w = cvtpk(X0[8 * s2 + 6], X0[8 * s2 + 7]);
                const s16x8 bv = *(const LAS s16x8*)(vtp + (16 * s2) * 2); O = __builtin_amdgcn_mfma_f32_32x32x16_bf16(__builtin_bit_cast(s16x8, pw), bv, O, 0, 0, 0); }
            if (tr == 1) {
#pragma unroll
                for (int s2 = 0; s2 < 2; ++s2) { v4u pw; pw.x = cvtpk(X1[8 * s2], X1[8 * s2 + 1]); pw.y = cvtpk(X1[8 * s2 + 2], X1[8 * s2 + 3]); pw.z = cvtpk(X1[8 * s2 + 4], X1[8 * s2 + 5]); pw.w = cvtpk(X1[8 * s2 + 6], X1[8 * s2 + 7]);
                    const s16x8 bv = *(const LAS s16x8*)(vtp + (32 + 16 * s2) * 2); O = __builtin_amdgcn_mfma_f32_32x32x16_bf16(__builtin_bit_cast(s16x8, pw), bv, O, 0, 0, 0); } }
            const LAS unsigned char* stp = lds + HG_ST + (32 * vq + r) * 272 + hf * 16;
#pragma unroll
            for (int ks = 0; ks < 8; ++ks) { const s16x8 aq = *(const LAS s16x8*)(qtp + ks * 32), bs = *(const LAS s16x8*)(stp + ks * 32); O = __builtin_amdgcn_mfma_f32_32x32x16_bf16(aq, bs, O, 0, 0, 0); }
#pragma unroll
            for (int i = 0; i < 16; ++i) G[(32 * tr + crow16(i, hf)) * 128 + 32 * vq + r] = O[i];
        }
#pragma unroll
        for (int dd = 0; dd < 2; ++dd) { const int dr = 2 * tr + dd;
#pragma unroll
            for (int g4 = 0; g4 < 4; ++g4) { const f32x4 ge = *(const LAS f32x4*)(GE + 32 * dr + 8 * g4 + 4 * hf);
                S[dd][4 * g4] *= __builtin_amdgcn_exp2f(ge.x); S[dd][4 * g4 + 1] *= __builtin_amdgcn_exp2f(ge.y); S[dd][4 * g4 + 2] *= __builtin_amdgcn_exp2f(ge.z); S[dd][4 * g4 + 3] *= __builtin_amdgcn_exp2f(ge.w); }
#pragma unroll
            for (int ks = 0; ks < 4; ++ks) { const s16x8 a = *(const LAS s16x8*)(lds + HG_KE + (32 * dr + r) * 144 + hf * 16 + ks * 32), bv = *(const LAS s16x8*)(lds + HG_VT + (32 * vq + r) * 144 + hf * 16 + ks * 32);
                S[dd] = __builtin_amdgcn_mfma_f32_32x32x16_bf16(a, bv, S[dd], 0, 0, 0); } }
        __syncthreads();
        if (OUT) {
            float ov[16]; float ss = 0.f;
#pragma unroll
            for (int e4 = 0; e4 < 4; ++e4) { const f32x4 o4 = *(const LAS f32x4*)(G + stok * 128 + c16 + 4 * e4); ov[4 * e4] = o4.x; ov[4 * e4 + 1] = o4.y; ov[4 * e4 + 2] = o4.z; ov[4 * e4 + 3] = o4.w;
                ss += (o4.x * o4.x + o4.y * o4.y) + (o4.z * o4.z + o4.w * o4.w); }
            ss += xorf<1>(ss); ss += xorf<2>(ss); ss += xorf<4>(ss);
            const float rr = 1.f / sqrtf(ss * (1.f / 128.f) + 1e-6f);
            unsigned ow[8];
#pragma unroll
            for (int w = 0; w < 8; ++w) { const unsigned gw_ = g8[w >> 2][w & 3]; ow[w] = cvtpk(ov[2 * w] * rr * ng16[2 * w] * sigmoidf_(bflo(gw_)), ov[2 * w + 1] * rr * ng16[2 * w + 1] * sigmoidf_(bfhi(gw_))); }
            bf16* mrow = mix + (t0 + stok) * 1024 + hh * 128 + c16;
            *(v4u*)mrow = (v4u){ow[0], ow[1], ow[2], ow[3]}; *(v4u*)(mrow + 8) = (v4u){ow[4], ow[5], ow[6], ow[7]};
            __syncthreads();
        }
    }
#undef HG_RAWLOAD
    if (!OUT) {
#pragma unroll
        for (int dd = 0; dd < 2; ++dd)
#pragma unroll
            for (int i = 0; i < 16; ++i) Sp[(32 * (2 * tr + dd) + crow16(i, hf)) * 128] = S[dd][i];
        if (cpart == 3) Dseg[(size_t)unit * 128 + cd] = __builtin_amdgcn_exp2f(gsum);
    }
}
__device__ __forceinline__ void hgrn_scan(float* Sloc, const float* Dseg, size_t gtid, size_t gthreads) {
    for (size_t idx = gtid; idx < (size_t)NBATCH * HG_H * 16384; idx += gthreads) { const int bh = (int)(idx >> 14), e = (int)(idx & 16383), d = e >> 7; float cur = 0.f;
        for (int seg = 0; seg < HNSEG; ++seg) { const size_t u = (size_t)bh * HNSEG + seg; float* p = Sloc + u * 16384 + e; const float tmp = *p; *p = cur; cur = Dseg[u * 128 + d] * cur + tmp; } }
}

template <bool MASK>
__device__ __forceinline__ void attn4(const LAS unsigned* Ks, const LAS bf16* Vs, const LAS float* qst, LAS float* pb, int lane, const int (&tq)[4], int kbase, float slope,
                                      float (&mo)[4], float (&lo)[4], float (&oo)[4]) {
    float sc[4][4];
#pragma unroll
    for (int a = 0; a < 4; ++a)
#pragma unroll
        for (int c = 0; c < 4; ++c) sc[a][c] = 0.f;
#pragma unroll 4
    for (int dd = 0; dd < 32; ++dd) {
        f32x2 qv[4];
#pragma unroll
        for (int qi = 0; qi < 4; ++qi) qv[qi] = *(const LAS f32x2*)(qst + qi * 64 + 2 * dd);
#pragma unroll
        for (int kk = 0; kk < 4; ++kk) { const unsigned kw = Ks[(lane + 64 * kk) * 33 + dd]; const float k0 = bflo(kw), k1 = bfhi(kw);
#pragma unroll
            for (int qi = 0; qi < 4; ++qi) sc[qi][kk] += qv[qi].x * k0 + qv[qi].y * k1; }
    }
#pragma unroll
    for (int qi = 0; qi < 4; ++qi) { float mx = -INFINITY;
#pragma unroll
        for (int kk = 0; kk < 4; ++kk) { const int pos = kbase + lane + 64 * kk; float lg = sc[qi][kk] * 0.125f - slope * (float)(tq[qi] - pos); if (MASK && pos > tq[qi]) lg = -INFINITY; sc[qi][kk] = lg; mx = fmaxf(mx, lg); }
        mx = wave_max(mx); float s = 0.f;
#pragma unroll
        for (int kk = 0; kk < 4; ++kk) { const float p = __builtin_amdgcn_exp2f((sc[qi][kk] - mx) * 1.4426950408889634f); pb[qi * 256 + lane + 64 * kk] = p; s += p; }
        lo[qi] = wave_sum(s); mo[qi] = mx; }
    float o[4] = {0.f, 0.f, 0.f, 0.f};
#pragma unroll 4
    for (int k4 = 0; k4 < 64; ++k4) { f32x4 p4[4];
#pragma unroll
        for (int qi = 0; qi < 4; ++qi) p4[qi] = *(const LAS f32x4*)(pb + qi * 256 + 4 * k4);
#pragma unroll
        for (int jj = 0; jj < 4; ++jj) { const float vv = bf2f(Vs[(4 * k4 + jj) * 64 + lane]);
#pragma unroll
            for (int qi = 0; qi < 4; ++qi) o[qi] += p4[qi][jj] * vv; } }
#pragma unroll
    for (int qi = 0; qi < 4; ++qi) oo[qi] = o[qi];
}
constexpr int AT_KS = 0, AT_VS = 33792, AT_WV = 66560, AT_WVB = 5120;

__device__ __forceinline__ void memattn_unit(LAS unsigned char* lds, const bf16* h, int NC, int qoff, const bf16* kv, bf16* mix, int unit, int tid, int wave, int lane) {
    const int chunk = unit & 31, bm = unit >> 5, mh = bm & 3, b = bm >> 2;
    LAS unsigned* Ks = (LAS unsigned*)(lds + AT_KS); LAS unsigned* Vs32 = (LAS unsigned*)(lds + AT_VS);
    LAS float* qst = (LAS float*)(lds + AT_WV + wave * AT_WVB); LAS float* pb = qst + 256;
    for (int i = 0; i < 16; ++i) { const int idx = tid + 512 * i, r = idx >> 5, dd = idx & 31; const unsigned* src = (const unsigned*)(kv + (size_t)(b * 256 + r) * 512 + mh * 64);
        Ks[r * 33 + dd] = src[dd]; Vs32[r * 32 + dd] = src[128 + dd]; }
    __syncthreads();
    for (int qd = 0; qd < 16; ++qd) { const size_t tg = (size_t)b * SEQ + chunk * 512 + wave * 64 + qd * 4;
#pragma unroll
        for (int qi = 0; qi < 4; ++qi) qst[qi * 64 + lane] = bf2f(h[(tg + qi) * NC + qoff + mh * 64 + lane]);
        const int tq[4] = {0, 0, 0, 0}; float m[4], l[4], o[4];
        attn4<false>(Ks, (const LAS bf16*)Vs32, qst, pb, lane, tq, 0, 0.f, m, l, o);
#pragma unroll
        for (int qi = 0; qi < 4; ++qi) mix[(tg + qi) * 1024 + MIXW + mh * 64 + lane] = (bf16)f2bf(o[qi] / l[qi]); }
    __syncthreads();
}

constexpr int AT2_K = 0, AT2_KROW = 176, AT2_V = 256 * AT2_KROW, AT2_VROW = 528, AT2_SCR = AT2_V + 64 * AT2_VROW, AT2_SCRW = 4864;
__device__ __forceinline__ void stage_kv_images(LAS unsigned char* lds, const bf16* kp, const bf16* vp, size_t row_stride, int tid) {
    v4u kx[4], vx[4];
#pragma unroll
    for (int i = 0; i < 4; ++i) { const int idx = tid + 512 * i, key = idx >> 3, c = idx & 7; kx[i] = *(const v4u*)(kp + (size_t)key * row_stride + 8 * c); vx[i] = *(const v4u*)(vp + (size_t)key * row_stride + 8 * c); }
    __builtin_amdgcn_sched_barrier(0);
#pragma unroll
    for (int i = 0; i < 4; ++i) { const int idx = tid + 512 * i, key = idx >> 3, c = idx & 7;
        *(LAS v4u*)(lds + AT2_K + key * AT2_KROW + c * 16) = kx[i];
        const int pos = (key & ~15) | (key & 3) | ((key & 4) << 1) | ((key & 8) >> 1);
        LAS bf16* vt = (LAS bf16*)(lds + AT2_V) + pos;
#pragma unroll
        for (int w = 0; w < 4; ++w) { vt[(8 * c + 2 * w) * (AT2_VROW / 2)] = (bf16)(vx[i][w] & 0xffffu); vt[(8 * c + 2 * w + 1) * (AT2_VROW / 2)] = (bf16)(vx[i][w] >> 16); } }
    if (tid < 256) { const unsigned pb = f2bf((float)tid); const v4u e0 = {pb | (pb << 16), 0u, 0u, 0u}, z = {0u, 0u, 0u, 0u};
        *(LAS v4u*)(lds + AT2_K + tid * AT2_KROW + 128) = e0; *(LAS v4u*)(lds + AT2_K + tid * AT2_KROW + 144) = z; }
}
template <bool MASK>
__device__ __forceinline__ void attn_tile32(const LAS unsigned char* lds, const s16x8 (&qf)[4], int lane, float dist0, unsigned qx, bool own, f32x16 (&o)[2], float& mrow, float& lrow) {
    const int r = lane & 31, hf = lane >> 5;
    const v4u qxv = {qx, 0u, 0u, 0u}; const s16x8 qe = __builtin_bit_cast(s16x8, qxv);
    f32x16 acc[8];
    const LAS unsigned char* kb = lds + AT2_K + r * AT2_KROW + hf * 16;
    constexpr int NKS = MASK ? 5 : 4;
    s16x8 kf[NKS];
#pragma unroll
    for (int s = 0; s < NKS; ++s) kf[s] = *(const LAS s16x8*)(kb + s * 32);
#pragma unroll
    for (int kt = 0; kt < 8; ++kt) {
#pragma unroll
        for (int i = 0; i < 16; ++i) acc[kt][i] = 0.f;
#pragma unroll
        for (int s = 0; s < NKS; ++s) { acc[kt] = __builtin_amdgcn_mfma_f32_32x32x16_bf16(kf[s], s < 4 ? qf[s < 4 ? s : 0] : qe, acc[kt], 0, 0, 0);
            if (kt + 1 < 8) kf[s] = *(const LAS s16x8*)(kb + (kt + 1) * 32 * AT2_KROW + s * 32); }
        __builtin_amdgcn_sched_barrier(0); }
    float mx = -INFINITY;
    if (MASK && own) { const float base2 = dist0 - 4.f * (float)hf;
#pragma unroll
        for (int kt = 0; kt < 8; ++kt)
#pragma unroll
            for (int i = 0; i < 16; ++i) { const float dist = base2 - (float)(32 * kt + (i & 3) + 8 * (i >> 2)); const float lg = dist < 0.f ? -INFINITY : acc[kt][i]; acc[kt][i] = lg; mx = fmaxf(mx, lg); }
    } else {
#pragma unroll
        for (int kt = 0; kt < 8; ++kt)
#pragma unroll
            for (int i = 0; i < 16; ++i) mx = fmaxf(mx, acc[kt][i]);
    }
    mx = fmaxf(mx, xor32f(mx, lane));
    float sum = 0.f;
#pragma unroll
    for (int i = 0; i < 16; ++i) { o[0][i] = 0.f; o[1][i] = 0.f; }
    const LAS unsigned char* vb = lds + AT2_V + r * AT2_VROW + hf * 16;
    s16x8 vf[4];
#pragma unroll
    for (int s2 = 0; s2 < 2; ++s2)
#pragma unroll
        for (int dt = 0; dt < 2; ++dt) vf[2 * s2 + dt] = *(const LAS s16x8*)(vb + dt * 32 * AT2_VROW + (16 * s2) * 2);
#pragma unroll
    for (int kt = 0; kt < 8; ++kt) {
#pragma unroll
        for (int i = 0; i < 16; ++i) { const float p = __builtin_amdgcn_exp2f(acc[kt][i] - mx); sum += p; acc[kt][i] = p; }
#pragma unroll
        for (int s2 = 0; s2 < 2; ++s2) { v4u pw; pw.x = cvtpk(acc[kt][8 * s2], acc[kt][8 * s2 + 1]); pw.y = cvtpk(acc[kt][8 * s2 + 2], acc[kt][8 * s2 + 3]);
            pw.z = cvtpk(acc[kt][8 * s2 + 4], acc[kt][8 * s2 + 5]); pw.w = cvtpk(acc[kt][8 * s2 + 6], acc[kt][8 * s2 + 7]); const s16x8 pf = __builtin_bit_cast(s16x8, pw);
#pragma unroll
            for (int dt = 0; dt < 2; ++dt) { o[dt] = __builtin_amdgcn_mfma_f32_32x32x16_bf16(vf[2 * s2 + dt], pf, o[dt], 0, 0, 0);
                if (kt + 1 < 8) vf[2 * s2 + dt] = *(const LAS s16x8*)(vb + dt * 32 * AT2_VROW + (32 * (kt + 1) + 16 * s2) * 2); } }
        __builtin_amdgcn_sched_barrier(0); }
    sum += xor32f(sum, lane);
    mrow = mx; lrow = sum;
}
__device__ __forceinline__ void memattn_unit2(LAS unsigned char* lds, const bf16* h, int NC, int qoff, const bf16* kv  , bf16* mix, int unit, int tid, int wave, int lane) {
    const int chunk = unit & 63, bm = unit >> 6, mh = bm & 3, b = bm >> 2, r = lane & 31, hf = lane >> 5;
    const bf16* kvrow0 = kv + (size_t)(b * 256) * 2048 + mh * 64;
    stage_kv_images(lds, kvrow0, kvrow0 + 256, 2048, tid);
    __syncthreads();
    { const size_t tg = (size_t)b * SEQ + chunk * 256 + wave * 32 + r;
        f32x16 o[2]; float m2, l; s16x8 qf[4];
#pragma unroll
        for (int s = 0; s < 4; ++s) qf[s] = *(const s16x8*)(h + tg * NC + qoff + mh * 64 + 16 * s + 8 * hf);
        attn_tile32<false>(lds, qf, lane, 0.f, 0u, false, o, m2, l);
        const float inv = 1.f / l; bf16* mp = mix + tg * 1024 + MIXW + mh * 64 + 4 * hf;
#pragma unroll
        for (int dt = 0; dt < 2; ++dt)
#pragma unroll
            for (int g = 0; g < 4; ++g) { v2u w; w.x = cvtpk(o[dt][4 * g] * inv, o[dt][4 * g + 1] * inv); w.y = cvtpk(o[dt][4 * g + 2] * inv, o[dt][4 * g + 3] * inv); *(v2u*)(mp + 32 * dt + 8 * g) = w; } }
    __syncthreads();
}
__device__ __forceinline__ void kmean_unit(LAS unsigned char* lds, const bf16* h, float* kmean, int unit, int tid) {
    const int n = unit & 63, bh = unit >> 6, hh = bh % MB_H, b = bh / MB_H, d = tid & 63, part = tid >> 6;
    LAS float* red = (LAS float*)lds;
    float s = 0.f; const bf16* p = h + ((size_t)b * SEQ + n * 256 + part * 32) * NC_M + 768 + hh * 64 + d;
    for (int i = 0; i < 32; ++i) s += bf2f(p[(size_t)i * NC_M]);
    red[part * 64 + d] = s; __syncthreads();
    if (tid < 64) { float a = 0.f; for (int pp = 0; pp < 8; ++pp) a += red[pp * 64 + tid]; kmean[((size_t)bh * 64 + n) * 64 + tid] = a * (1.f / 256.f); }
    __syncthreads();
}
__device__ __forceinline__ void moba_gate_unit(LAS unsigned char* lds, const bf16* h, const float* kmean, unsigned* gcount, int* selinfo, unsigned* list, int unit, int tid) {
    const int c = unit & 63, bh = unit >> 6, hh = bh % MB_H, b = bh / MB_H;
    LAS float* km = (LAS float*)lds; LAS int* hist = (LAS int*)(lds + 16384); LAS int* base = hist + 64;
    for (int i = tid; i < 4096; i += NTHR) km[i] = kmean[(size_t)bh * 4096 + i];
    if (tid < 64) hist[tid] = 0;
    __syncthreads();
    int s0 = 0, s1 = 0, s2 = 0, r0 = 0, r1 = 0, r2 = 0, ns = 0; const int t = c * 256 + tid;
    if (tid < 256) {
        float q[64]; const v4u* qp = (const v4u*)(h + ((size_t)b * SEQ + t) * NC_M + hh * 64);
#pragma unroll
        for (int w = 0; w < 8; ++w) { const v4u x = qp[w]; q[8 * w] = bflo(x.x); q[8 * w + 1] = bfhi(x.x); q[8 * w + 2] = bflo(x.y); q[8 * w + 3] = bfhi(x.y); q[8 * w + 4] = bflo(x.z); q[8 * w + 5] = bfhi(x.z); q[8 * w + 6] = bflo(x.w); q[8 * w + 7] = bfhi(x.w); }
        float v0 = -INFINITY, v1 = -INFINITY, v2 = -INFINITY;
        for (int n = 0; n < c; ++n) { float g = 0.f;
#pragma unroll
            for (int d4 = 0; d4 < 16; ++d4) { const f32x4 k4 = *(const LAS f32x4*)(km + n * 64 + 4 * d4); g += q[4 * d4] * k4.x + q[4 * d4 + 1] * k4.y + q[4 * d4 + 2] * k4.z + q[4 * d4 + 3] * k4.w; }
            if (g > v0) { v2 = v1; s2 = s1; v1 = v0; s1 = s0; v0 = g; s0 = n; } else if (g > v1) { v2 = v1; s2 = s1; v1 = g; s1 = n; } else if (g > v2) { v2 = g; s2 = n; } }
        ns = c < 3 ? c : 3;
        if (ns > 0) r0 = __hip_atomic_fetch_add(hist + s0, 1, __ATOMIC_RELAXED, __HIP_MEMORY_SCOPE_WORKGROUP);
        if (ns > 1) r1 = __hip_atomic_fetch_add(hist + s1, 1, __ATOMIC_RELAXED, __HIP_MEMORY_SCOPE_WORKGROUP);
        if (ns > 2) r2 = __hip_atomic_fetch_add(hist + s2, 1, __ATOMIC_RELAXED, __HIP_MEMORY_SCOPE_WORKGROUP);
        selinfo[((size_t)b * SEQ + t) * MB_H + hh] = ns;
    }
    __syncthreads();
    if (tid < 64) { const int hc = hist[tid]; if (hc > 0) base[tid] = (int)__hip_atomic_fetch_add(gcount + bh * 64 + tid, (unsigned)hc, __ATOMIC_RELAXED, __HIP_MEMORY_SCOPE_AGENT); }
    __syncthreads();
    if (tid < 256) { unsigned* lp = list + ((size_t)bh * 64 << 14);
        if (ns > 0) lp[((size_t)s0 << 14) + base[s0] + r0] = (unsigned)t;
        if (ns > 1) lp[((size_t)s1 << 14) + base[s1] + r1] = (unsigned)t | (1u << 14);
        if (ns > 2) lp[((size_t)s2 << 14) + base[s2] + r2] = (unsigned)t | (2u << 14); }
    __syncthreads();
}
__device__ __forceinline__ void moba_attn_item(LAS unsigned char* lds, const bf16* h, const unsigned* gcount, const unsigned* list, float* po, float* pml, int item, int tid, int wave, int lane) {
    const int n = item / 24, bh = item - n * 24, hh = bh % MB_H, b = bh / MB_H;
    LAS unsigned* Ks = (LAS unsigned*)(lds + AT_KS); LAS unsigned* Vs32 = (LAS unsigned*)(lds + AT_VS);
    LAS float* qst = (LAS float*)(lds + AT_WV + wave * AT_WVB); LAS float* pb = qst + 256;
    for (int i = 0; i < 16; ++i) { const int idx = tid + 512 * i, r = idx >> 5, dd = idx & 31; const unsigned* src = (const unsigned*)(h + ((size_t)b * SEQ + n * 256 + r) * NC_M + hh * 64);
        Ks[r * 33 + dd] = src[384 + dd]; Vs32[r * 32 + dd] = src[768 + dd]; }
    __syncthreads();
    const int cnt = (int)gcount[bh * 64 + n], total = 256 + cnt, nquads = (total + 3) >> 2;
    const float slope = hh < 8 ? ldexpf(1.0f, -(hh + 1)) : ldexpf(0.70710678118654752f, -(hh - 8));
    const unsigned* lp = list + (((size_t)bh * 64 + n) << 14);
    for (int quad = wave; quad < nquads; quad += 8) {
        int tq[4], slot[4];
#pragma unroll
        for (int qi = 0; qi < 4; ++qi) { int idx = quad * 4 + qi; idx = idx < total ? idx : total - 1;
            if (idx < 256) { tq[qi] = n * 256 + idx; slot[qi] = 3; } else { const unsigned e = lp[idx - 256]; tq[qi] = (int)(e & 16383u); slot[qi] = (int)(e >> 14); } }
#pragma unroll
        for (int qi = 0; qi < 4; ++qi) qst[qi * 64 + lane] = bf2f(h[((size_t)b * SEQ + tq[qi]) * NC_M + hh * 64 + lane]);
        float m[4], l[4], o[4];
        attn4<true>(Ks, (const LAS bf16*)Vs32, qst, pb, lane, tq, n * 256, slope, m, l, o);
#pragma unroll
        for (int qi = 0; qi < 4; ++qi) if (quad * 4 + qi < total) { const size_t pi = (((size_t)b * SEQ + tq[qi]) * MB_H + hh) * 4 + slot[qi];
            po[pi * 64 + lane] = o[qi]; if (lane == 0) { pml[pi * 2] = m[qi]; pml[pi * 2 + 1] = l[qi]; } }
    }
    __syncthreads();
}

__device__ __forceinline__ void moba_attn_item2(LAS unsigned char* lds, const bf16* h, const unsigned* gcount, const unsigned* list, bf16* po, float* pml, int item, int tid, int wave, int lane) {
    const int n = item / 24, bh = item - n * 24, hh = bh % MB_H, b = bh / MB_H, r = lane & 31, hf = lane >> 5;
    const bf16* hrow0 = h + ((size_t)b * SEQ + n * 256) * NC_M + hh * 64;
    stage_kv_images(lds, hrow0 + 768, hrow0 + 1536, NC_M, tid);
    __syncthreads();
    const int cnt = (int)gcount[bh * 64 + n], total = 256 + cnt, ntiles = (total + 31) >> 5;
    const float slope2 = (hh < 8 ? ldexpf(1.0f, -(hh + 1)) : ldexpf(0.70710678118654752f, -(hh - 8))) * 1.4426950408889634f;
    const unsigned shi = f2bf(slope2), slo = f2bf(slope2 - __builtin_bit_cast(float, shi << 16)); const unsigned qx = hf == 0 ? (shi | (slo << 16)) : 0u;
    const unsigned* lp = list + (((size_t)bh * 64 + n) << 14);
    const bf16* hq = h + (size_t)b * SEQ * NC_M + hh * 64 + 8 * hf;
#pragma unroll 1
    for (int tile = wave; tile < ntiles; tile += NWAVES) {
        int idx = tile * 32 + r; const bool valid = idx < total; idx = valid ? idx : total - 1;
        int tq, slot; if (idx < 256) { tq = n * 256 + idx; slot = 3; } else { const unsigned e = lp[idx - 256]; tq = (int)(e & 16383u); slot = (int)(e >> 14); }
        s16x8 qf[4]; { const bf16* qp = hq + (size_t)tq * NC_M;
#pragma unroll
            for (int s = 0; s < 4; ++s) qf[s] = *(const s16x8*)(qp + 16 * s); }
        f32x16 o[2]; float m2, l; const float dist0 = (float)(tq - n * 256);
        attn_tile32<true>(lds, qf, lane, dist0, qx, tile < 8, o, m2, l);
        { LAS unsigned char* sw = lds + AT2_SCR + wave * AT2_SCRW; const int pi = valid ? (int)((((size_t)b * SEQ + tq) * MB_H + hh) * 4 + slot) : -1;
#pragma unroll
          for (int dt = 0; dt < 2; ++dt)
#pragma unroll
              for (int g = 0; g < 4; ++g) { v2u w; w.x = cvtpk(o[dt][4 * g], o[dt][4 * g + 1]); w.y = cvtpk(o[dt][4 * g + 2], o[dt][4 * g + 3]); *(LAS v2u*)(sw + r * 144 + (32 * dt + 8 * g + 4 * hf) * 2) = w; }
          if (hf == 0) { *(LAS int*)(sw + 4608 + 4 * r) = pi; if (valid) { pml[(size_t)pi * 2] = m2 - slope2 * dist0; pml[(size_t)pi * 2 + 1] = l; } }
#pragma unroll
          for (int it = 0; it < 4; ++it) { const int q = 8 * it + (lane >> 3), c = lane & 7; const int pq = *(const LAS int*)(sw + 4608 + 4 * q); const v4u row = *(const LAS v4u*)(sw + q * 144 + c * 16);
              if (pq >= 0) *(v4u*)(po + (size_t)pq * 64 + c * 8) = row; } }
    }
    __syncthreads();
}
__device__ __forceinline__ void moba_combine(const bf16* __restrict__ po, const float* __restrict__ pml, const int* __restrict__ selinfo, bf16* __restrict__ mix, int gw, int ngw, int lane) {
    const int sub = lane >> 4, d4 = (lane & 15) * 4;
#pragma unroll 4
    for (int idx = gw * 4 + sub; idx < T * MB_H; idx += ngw * 4) { const int tg = idx / MB_H, hh = idx - tg * MB_H, ns = selinfo[idx]; const size_t p4 = (size_t)idx * 4;
        f32x2 ml[4]; f32x4 ov[4];
#pragma unroll
        for (int j = 0; j < 4; ++j) { ml[j] = ((const f32x2*)pml)[p4 + j]; const v2u ow = *(const v2u*)(po + (p4 + j) * 64 + d4); ov[j] = (f32x4){bflo(ow.x), bfhi(ow.x), bflo(ow.y), bfhi(ow.y)}; }
        float M = ml[3].x;
#pragma unroll
        for (int j = 0; j < 3; ++j) { const bool ok = j < ns; ml[j].x = ok ? ml[j].x : -INFINITY; ml[j].y = ok ? ml[j].y : 0.f; M = fmaxf(M, ml[j].x);
            ov[j].x = ok ? ov[j].x : 0.f; ov[j].y = ok ? ov[j].y : 0.f; ov[j].z = ok ? ov[j].z : 0.f; ov[j].w = ok ? ov[j].w : 0.f; }
        float den = 0.f; f32x4 num = {0.f, 0.f, 0.f, 0.f};
#pragma unroll
        for (int j = 0; j < 4; ++j) { const float w = __builtin_amdgcn_exp2f(ml[j].x - M); den += w * ml[j].y; num += ov[j] * w; }
        const float inv = 1.f / den; v2u o; o.x = pk2(num.x * inv, num.y * inv); o.y = pk2(num.z * inv, num.w * inv);
        *(v2u*)(mix + (size_t)tg * 1024 + hh * 64 + d4) = o; }
}

__device__ __forceinline__ void ln_row(f32x4 (&v)[4], const f32x4 (&gv)[4], const f32x4 (&bv)[4]) {
    float s = 0.f;
#pragma unroll
    for (int j = 0; j < 4; ++j) s += (v[j].x + v[j].y) + (v[j].z + v[j].w);
    const float mean = wave_sum(s) * (1.f / D); float s2 = 0.f;
#pragma unroll
    for (int j = 0; j < 4; ++j) { v[j] = v[j] - mean; s2 += (v[j].x * v[j].x + v[j].y * v[j].y) + (v[j].z * v[j].z + v[j].w * v[j].w); }
    const float rstd = 1.f / sqrtf(wave_sum(s2) * (1.f / D) + 1e-5f);
#pragma unroll
    for (int j = 0; j < 4; ++j) v[j] = v[j] * rstd * gv[j] + bv[j];
}
__device__ __forceinline__ void split_router_weights(const float* wr  , bf16* wrs  , size_t gtid, size_t gthreads) {
    for (size_t i = gtid; i < (size_t)DEPTH * D * NE; i += gthreads) { const int e = (int)(i & 31), d = (int)((i >> 5) & 1023), l = (int)(i >> 15);
        const float w = wr[i]; const unsigned hi = f2bf(w); const unsigned lo = f2bf(w - __builtin_bit_cast(float, hi << 16));
        wrs[(((size_t)l * 2 + 0) * NE + e) * D + d] = (bf16)hi; wrs[(((size_t)l * 2 + 1) * NE + e) * D + d] = (bf16)lo; }
}
constexpr int L1_XH = 0, L1_XL = 33024, L1_ROW = 2064, L1_PART = 66048, L1_HIST = 82432;
__device__ __forceinline__ void phase_ln1(LAS unsigned char* lds, const bf16* y, const float* g, const float* bb, const bf16* wrs  , const float* br,
                                          bf16* xbf, int* tok_e, int* tok_lr, float* tok_w, int* blk_cnt, int blk, int tid, int wave, int lane) {
    LAS float* part = (LAS float*)(lds + L1_PART);
    LAS int* hist = (LAS int*)(lds + L1_HIST);
    if (tid < 32) hist[tid] = 0;
    constexpr int TPB = T / GRID;
    const int e = lane & 31, m16 = lane & 15, quad = lane >> 4;
    s16x8 bw[4][2][2];
#pragma unroll
    for (int ks = 0; ks < 4; ++ks)
#pragma unroll
        for (int nt = 0; nt < 2; ++nt)
#pragma unroll
            for (int pp = 0; pp < 2; ++pp) bw[ks][nt][pp] = *(const s16x8*)(wrs + ((size_t)pp * NE + 16 * nt + m16) * D + wave * 128 + 32 * ks + 8 * quad);
    const float bre = br[e];
    f32x4 gv[4], bv[4];
#pragma unroll
    for (int j = 0; j < 4; ++j) { gv[j] = ((const f32x4*)g)[lane + 64 * j]; bv[j] = ((const f32x4*)bb)[lane + 64 * j]; }
    v2u xn[2][4], yn[2][4];
#pragma unroll
    for (int u = 0; u < 2; ++u) { const size_t t0 = (size_t)blk * TPB + 2 * wave + u; const v2u* xr = (const v2u*)(xbf + t0 * D) + lane; const v2u* yr = (const v2u*)(y + t0 * D) + lane;
#pragma unroll
        for (int j = 0; j < 4; ++j) { xn[u][j] = xr[64 * j]; yn[u][j] = yr[64 * j]; } }
    __syncthreads();
    for (int grp = 0; grp < TPB / 16; ++grp) { const size_t tg0 = (size_t)blk * TPB + grp * 16 + 2 * wave;
        f32x4 v[2][4];
#pragma unroll
        for (int u = 0; u < 2; ++u)
#pragma unroll
            for (int j = 0; j < 4; ++j) { const v2u xw = xn[u][j]; const v2u yw = yn[u][j];
                v[u][j].x = DN_ALPHA * bflo(xw.x) + bflo(yw.x); v[u][j].y = DN_ALPHA * bfhi(xw.x) + bfhi(yw.x); v[u][j].z = DN_ALPHA * bflo(xw.y) + bflo(yw.y); v[u][j].w = DN_ALPHA * bfhi(xw.y) + bfhi(yw.y); }
        if (grp + 1 < TPB / 16) {
#pragma unroll
            for (int u = 0; u < 2; ++u) { const v2u* xr = (const v2u*)(xbf + (tg0 + 16 + u) * D) + lane; const v2u* yr = (const v2u*)(y + (tg0 + 16 + u) * D) + lane;
#pragma unroll
                for (int j = 0; j < 4; ++j) { xn[u][j] = xr[64 * j]; yn[u][j] = yr[64 * j]; } } }
#pragma unroll
        for (int u = 0; u < 2; ++u) { ln_row(v[u], gv, bv);
            v2u* xb = (v2u*)(xbf + (tg0 + u) * D) + lane;
#pragma unroll
            for (int j = 0; j < 4; ++j) { v2u hw; hw.x = cvtpk(v[u][j].x, v[u][j].y); hw.y = cvtpk(v[u][j].z, v[u][j].w); xb[64 * j] = hw;
                v2u lw; lw.x = cvtpk(v[u][j].x - bflo(hw.x), v[u][j].y - bfhi(hw.x)); lw.y = cvtpk(v[u][j].z - bflo(hw.y), v[u][j].w - bfhi(hw.y));
                *(LAS v2u*)(lds + L1_XH + (2 * wave + u) * L1_ROW + (4 * lane + 256 * j) * 2) = hw; *(LAS v2u*)(lds + L1_XL + (2 * wave + u) * L1_ROW + (4 * lane + 256 * j) * 2) = lw; } }
        __syncthreads();
        { f32x4 acc[2] = {{0.f, 0.f, 0.f, 0.f}, {0.f, 0.f, 0.f, 0.f}};
#pragma unroll
          for (int ks = 0; ks < 4; ++ks) { const int off = m16 * L1_ROW + (wave * 128 + 32 * ks + 8 * quad) * 2;
              const s16x8 ah = *(const LAS s16x8*)(lds + L1_XH + off), al = *(const LAS s16x8*)(lds + L1_XL + off);
#pragma unroll
              for (int nt = 0; nt < 2; ++nt) { acc[nt] = __builtin_amdgcn_mfma_f32_16x16x32_bf16(ah, bw[ks][nt][0], acc[nt], 0, 0, 0); acc[nt] = __builtin_amdgcn_mfma_f32_16x16x32_bf16(ah, bw[ks][nt][1], acc[nt], 0, 0, 0);
                  acc[nt] = __builtin_amdgcn_mfma_f32_16x16x32_bf16(al, bw[ks][nt][0], acc[nt], 0, 0, 0); } }
#pragma unroll
          for (int nt = 0; nt < 2; ++nt)
#pragma unroll
              for (int jj = 0; jj < 4; ++jj) part[(wave * 16 + 4 * quad + jj) * 32 + 16 * nt + m16] = acc[nt][jj]; }
        __syncthreads();
#pragma unroll
        for (int u = 0; u < 2; ++u) { const size_t t = tg0 + u;
            float logit = bre;
#pragma unroll
            for (int w = 0; w < 8; ++w) logit += part[(w * 16 + 2 * wave + u) * 32 + e];
            int rank = 0;
#pragma unroll
            for (int q = 0; q < 32; ++q) { const float oq = __builtin_bit_cast(float, __builtin_amdgcn_readlane(__builtin_bit_cast(int, logit), q)); rank += (oq > logit || (oq == logit && q < e)) ? 1 : 0; }
            int se[4]; float sv[4];
#pragma unroll
            for (int k = 0; k < 4; ++k) { const unsigned long long mk = __ballot(rank == k && lane < 32); const int src = __builtin_ctzll(mk);
                se[k] = src; sv[k] = __builtin_bit_cast(float, __builtin_amdgcn_readlane(__builtin_bit_cast(int, logit), src)); }
            const float e1 = __expf(sv[1] - sv[0]), e2 = __expf(sv[2] - sv[0]), e3 = __expf(sv[3] - sv[0]), inv = 1.f / (1.f + e1 + e2 + e3);
            const float wk[4] = {inv, e1 * inv, e2 * inv, e3 * inv};
            if (lane == 0) {
#pragma unroll
                for (int k = 0; k < 4; ++k) { const int lr = __hip_atomic_fetch_add(hist + se[k], 1, __ATOMIC_RELAXED, __HIP_MEMORY_SCOPE_WORKGROUP);
                    tok_e[t * 4 + k] = se[k]; tok_lr[t * 4 + k] = lr; tok_w[t * 4 + k] = wk[k]; } } }
    }
    __syncthreads();
    if (tid < 32) blk_cnt[blk * 32 + tid] = hist[tid];
    __syncthreads();
}
__device__ __forceinline__ void phase_dispatch(LAS unsigned char* lds, const int* __restrict__ blk_cnt, const int* __restrict__ tok_e, const int* __restrict__ tok_lr, int* __restrict__ tok_row, int* __restrict__ tab,
                                               const bf16* __restrict__ xbf, bf16* __restrict__ xs, int blk, int tid, int wave, int lane) {
    LAS int* tot = (LAS int*)lds; LAS int* pre = tot + 32; LAS int* pst = pre + 32; LAS int* rows = pst + 64;
    if (tid < 32) { int s = 0, p = 0;
#pragma unroll 8
        for (int bb = 0; bb < GRID; ++bb) { const int c = blk_cnt[bb * 32 + tid]; p += (bb < blk) ? c : 0; s += c; } tot[tid] = s; pre[tid] = p; }
    __syncthreads();
    if (tid == 0) { int acc = 0; for (int e = 0; e < 32; ++e) { pst[e] = acc; acc += ((tot[e] + 255) >> 8) << 8; } pst[32] = acc; }
    __syncthreads();
    if (blk == 0 && tid < 33) tab[tid] = pst[tid] >> 8;
    constexpr int TPB = T / GRID;
    static_assert(TPB * 4 == NTHR, "one (token, k) pair per thread");
    { const size_t ti = (size_t)blk * TPB * 4 + tid; const int e = tok_e[ti]; const int r = pst[e] + pre[e] + tok_lr[ti]; tok_row[ti] = r; rows[tid] = r; }
    __syncthreads();
#pragma unroll 4
    for (int i = wave; i < TPB * 4; i += NWAVES) { const int r = rows[i];
        const v4u* src = (const v4u*)(xbf + ((size_t)blk * TPB + (i >> 2)) * D) + 2 * lane; const v4u a = src[0], b = src[1];
        v4u o; o.x = pk4_fp8(bflo(a.x), bfhi(a.x), bflo(a.y), bfhi(a.y)); o.y = pk4_fp8(bflo(a.z), bfhi(a.z), bflo(a.w), bfhi(a.w)); o.z = pk4_fp8(bflo(b.x), bfhi(b.x), bflo(b.y), bfhi(b.y)); o.w = pk4_fp8(bflo(b.z), bfhi(b.z), bflo(b.w), bfhi(b.w));
        ((v4u*)((unsigned char*)xs + (size_t)r * D))[lane] = o; }
    __syncthreads();
}
__device__ __forceinline__ f32x4 fp8x4_to_f32(unsigned w) {
    const f32x2 lo = __builtin_amdgcn_cvt_pk_f32_fp8((int)w, false), hi = __builtin_amdgcn_cvt_pk_f32_fp8((int)w, true); return (f32x4){lo.x, lo.y, hi.x, hi.y};
}
__device__ __forceinline__ void phase_ln2(const unsigned char* __restrict__ yrows, const int* __restrict__ tok_row, const float* __restrict__ tok_w, const float* __restrict__ g, const float* __restrict__ bb,
                                          float* __restrict__ xout, bf16* xbf, int gw, int ngw, int lane) {
    f32x4 gv[4], bv[4];
#pragma unroll
    for (int j = 0; j < 4; ++j) { gv[j] = ((const f32x4*)g)[lane + 64 * j]; bv[j] = ((const f32x4*)bb)[lane + 64 * j]; }
    constexpr int NTK = 2;
    static_assert(T % (NTK * GRID * NWAVES) == 0, "NTK tokens per wave per step");
    for (int t0 = gw; t0 < T; t0 += NTK * ngw) {
        f32x4 v[NTK][4];
#pragma unroll
        for (int u = 0; u < NTK; ++u) { const int t = t0 + u * ngw; int r[4]; float w[4];
#pragma unroll
            for (int k = 0; k < 4; ++k) { r[k] = tok_row[(size_t)t * 4 + k]; w[k] = tok_w[(size_t)t * 4 + k] * (1.f / 16.f); }
            const v2u* xr = (const v2u*)(xbf + (size_t)t * D) + lane;
#pragma unroll
            for (int j = 0; j < 4; ++j) { f32x4 f = {0.f, 0.f, 0.f, 0.f};
#pragma unroll
                for (int k = 0; k < 4; ++k) { const unsigned yw = ((const unsigned*)(yrows + (size_t)r[k] * D))[lane + 64 * j]; f += fp8x4_to_f32(yw) * w[k]; }
                const v2u xw = xr[64 * j]; v[u][j].x = DN_ALPHA * bflo(xw.x) + f.x; v[u][j].y = DN_ALPHA * bfhi(xw.x) + f.y; v[u][j].z = DN_ALPHA * bflo(xw.y) + f.z; v[u][j].w = DN_ALPHA * bfhi(xw.y) + f.w; } }
#pragma unroll
        for (int u = 0; u < NTK; ++u) { const int t = t0 + u * ngw;
            ln_row(v[u], gv, bv);
            if (xout) { f32x4* xo = (f32x4*)(xout + (size_t)t * D) + lane;
#pragma unroll
                for (int j = 0; j < 4; ++j) xo[64 * j] = v[u][j]; }
            else { v2u* xb = (v2u*)(xbf + (size_t)t * D) + lane;
#pragma unroll
                for (int j = 0; j < 4; ++j) { v2u ww; ww.x = pk2(v[u][j].x, v[u][j].y); ww.y = pk2(v[u][j].z, v[u][j].w); xb[64 * j] = ww; } } } }
}

struct Args { const float* in[20]; float* out; unsigned char* ws; int l_lo, l_hi, ph_lo, ph_hi; };
typedef const __attribute__((address_space(4))) Args* KArgsP;
#define KA_LOAD() ({ KArgsP p_ = (KArgsP)__builtin_amdgcn_kernarg_segment_ptr(); asm volatile("" : "+s"(p_)); p_; })
#ifndef PHMASK
#define PHMASK 0xFFFF
#endif
#ifndef REPEAT_MASK
#define REPEAT_MASK 0
#endif
#ifndef REPEAT_LMASK
#define REPEAT_LMASK 0xF
#endif
#define PH_BEGIN(k) _Pragma("unroll") for (int rep_ = 0; rep_ < ((((REPEAT_MASK >> (k)) & 1) && ((REPEAT_LMASK >> l) & 1)) ? 2 : 1); ++rep_) { if ((PHMASK >> (k)) & 1) { KArgsP ka = KA_LOAD(); unsigned char* ws = ka->ws; int tid = threadIdx.x; asm volatile("" : "+v"(tid)); \
    const int lane = tid & 63, wave = __builtin_amdgcn_readfirstlane(tid >> 6); int blk = blockIdx.x; asm volatile("" : "+s"(blk)); \
    const int gw = blk * NWAVES + wave; const size_t gtid = (size_t)blk * NTHR + tid; (void)lane; (void)gw; (void)gtid; (void)ws;
#if ONE_LAUNCH
#define PH_SEAM() do { XcdBarrier b_; b_.bar = (unsigned*)(KA_LOAD()->ws + WS_CTL) + CW_BAR; b_.x = xb_xcc_id(); b_.st = (volatile LAS unsigned*)(lds + MISC_OFF); xcd_barrier(b_); } while (0)
#else
#define PH_SEAM() do {} while (0)
#endif
#define PH_END() PH_SEAM(); } }
#define PH_END_NOSEAM() } }
#define WSP(type, off) ((type*)(ws + (off)))
constexpr int G = GRID, NGW = GRID * NWAVES; constexpr size_t GTHREADS = (size_t)GRID * NTHR;
template <int L> __device__ __forceinline__ void layer_phases(LAS unsigned char* lds) {
    constexpr int l = L; LAS int* tabL = (LAS int*)(lds + MISC_OFF + 256);

        const int j = l >> 1; const bool moba = (l & 1) != 0;
        const int NC = moba ? NC_M : NC_H, qoff = moba ? 2304 : 3072;

        if (l == 0) {
        PH_BEGIN(1)
            phase_weights((LAS float*)(lds + wave * 16384), gw, NGW, lane, ka->in[2], NC_H, ka->in[6], 4, ka->in[7], ka->in[12], ka->in[14], ka->in[16], WSP(bf16, WS_WIN), WSP(bf16, WS_WKV4), WSP(bf16, WS_WO), WSP(bf16, WS_WGU), WSP(bf16, WS_WD));
        PH_END()
        }
        PH_BEGIN(2)
            { pg8::Gemm g{WSP(bf16, WS_XBF), WSP(bf16, WS_WIN), T, NC, D, 0, 0}; pg8::StaticOrder S; S.init(T, NC, G, blk); pg8::EpiPlain E{WSP(bf16, WS_H), NC, moba ? 0x207u : 0x1000u, 0.125f * 1.4426950408889634f};
              pg8::gemm_phase<pg8::EpiPlain, pg8::StaticOrder, true, true>(lds, g, S, E); }
            if (l == 0) {
              pg8::Gemm g{WSP(bf16, WS_MEMBF), WSP(bf16, WS_WKV4), 512, 2048, D, 0, 0}; pg8::StaticOrder S; S.init(512, 2048, G, blk >= 128 ? blk - 128 : G); pg8::EpiPlain E{WSP(bf16, WS_KV4), 2048, 0u, 1.f};
              pg8::gemm_phase<pg8::EpiPlain, pg8::StaticOrder, true, true>(lds, g, S, E); }
        PH_END()
        if (!moba) {
            PH_BEGIN(3)
                for (int u = blk; u < NBATCH * HG_H * HNSEG; u += G) hgrn_mfma<false>(lds, WSP(bf16, WS_H), ka->in[3], j, ka->in[4] + j * 128, WSP(float, WS_SLOC), WSP(float, WS_DSEG), WSP(bf16, WS_MIX), u, tid, wave, lane);
                for (int u = blk; u < 512; u += G) memattn_unit2(lds, WSP(bf16, WS_H), NC, qoff, WSP(bf16, WS_KV4) + 512 * l, WSP(bf16, WS_MIX), u, tid, wave, lane);
            PH_END()
            PH_BEGIN(4)
                hgrn_scan(WSP(float, WS_SLOC), WSP(float, WS_DSEG), gtid, GTHREADS);
            PH_END()
            PH_BEGIN(5)
                for (int u = blk; u < NBATCH * HG_H * HNSEG; u += G) hgrn_mfma<true>(lds, WSP(bf16, WS_H), ka->in[3], j, ka->in[4] + j * 128, WSP(float, WS_SLOC), WSP(float, WS_DSEG), WSP(bf16, WS_MIX), u, tid, wave, lane);
            PH_END()
        } else {
            PH_BEGIN(3)
                for (int u = blk; u < 24 * MB_NB; u += G) kmean_unit(lds, WSP(bf16, WS_H), WSP(float, WS_KMEAN), u, tid);
                for (int u = blk; u < 512; u += G) memattn_unit2(lds, WSP(bf16, WS_H), NC, qoff, WSP(bf16, WS_KV4) + 512 * l, WSP(bf16, WS_MIX), u, tid, wave, lane);
            PH_END()
            PH_BEGIN(4)
                for (int u = blk; u < 24 * MB_NB; u += G) moba_gate_unit(lds, WSP(bf16, WS_H), WSP(float, WS_KMEAN), WSP(unsigned, WS_CTL) + CW_GCOUNT + j * 1536, WSP(int, WS_SELINFO), WSP(unsigned, WS_LIST), u, tid);
            PH_END()
            PH_BEGIN(5)
                { unsigned* qhead = WSP(unsigned, WS_CTL) + CW_GCOUNT + 2 * 1536 + 64 * j; LAS int* itl = (LAS int*)(lds + MISC_OFF + 512);
                  for (;;) { if (tid == 0) *itl = (int)__hip_atomic_fetch_add(qhead, 1u, __ATOMIC_RELAXED, __HIP_MEMORY_SCOPE_AGENT);
                      __syncthreads(); const int it = *itl; __syncthreads();
                      if (it >= 24 * MB_NB) break;
                      moba_attn_item2(lds, WSP(bf16, WS_H), WSP(unsigned, WS_CTL) + CW_GCOUNT + j * 1536, WSP(unsigned, WS_LIST), WSP(bf16, WS_PO), WSP(float, WS_PML), it, tid, wave, lane); } }
            PH_END()
            PH_BEGIN(6)
                moba_combine(WSP(bf16, WS_PO), WSP(float, WS_PML), WSP(int, WS_SELINFO), WSP(bf16, WS_MIX), gw, NGW, lane);
            PH_END()
        }
        PH_BEGIN(7)
            pg8::Gemm g{WSP(bf16, WS_MIX), WSP(bf16, WS_WO), T, D, D, 0, 0}; pg8::StaticOrder S; S.init(T, D, G, blk); pg8::EpiPlain E{WSP(bf16, WS_Y), D, 0u, 1.f};
            pg8::gemm_phase<pg8::EpiPlain, pg8::StaticOrder, true, true>(lds, g, S, E);
        PH_END()
        PH_BEGIN(8)
            phase_ln1(lds, WSP(bf16, WS_Y), ka->in[8] + l * D, ka->in[9] + l * D, WSP(bf16, WS_WRS) + (size_t)l * 2 * NE * D, ka->in[11] + l * NE, WSP(bf16, WS_XBF),
                      WSP(int, WS_TOK + TOK_E), WSP(int, WS_TOK + TOK_LR), WSP(float, WS_TOK + TOK_W), WSP(int, WS_TOK + TOK_BLKCNT), blk, tid, wave, lane);
        PH_END()
        PH_BEGIN(9)
            phase_dispatch(lds, WSP(int, WS_TOK + TOK_BLKCNT), WSP(int, WS_TOK + TOK_E), WSP(int, WS_TOK + TOK_LR), WSP(int, WS_TOK + TOK_ROW), WSP(int, WS_TOK + TOK_TAB), WSP(bf16, WS_XBF), WSP(bf16, WS_XS), blk, tid, wave, lane);
        PH_END()
        PH_BEGIN(10)
            if (tid < 33) tabL[tid] = WSP(int, WS_TOK + TOK_TAB)[tid];
            __syncthreads();
            int sw_ = 0x7A7A7A7A, sx_ = 0x7F7F7F7F; asm volatile("" : "+s"(sw_), "+s"(sx_));
            pg8::Gemm g{WSP(bf16, WS_XS), WSP(bf16, WS_WGU), MOE_MAXROWS, NE * 2048, D / 2, sw_, sx_}; pg8::MoeOrder S{tabL, 8, G, blk, tabL[32] * 8};
            pg8::EpiSwiglu E{WSP(unsigned char, WS_HID), ka->in[13] + (size_t)l * NE * 1024, ka->in[15] + (size_t)l * NE * 1024};
            pg8::gemm_phase<pg8::EpiSwiglu, pg8::MoeOrder, true, true, true>(lds, g, S, E);
        PH_END()
        PH_BEGIN(11)
            if (tid < 33) tabL[tid] = WSP(int, WS_TOK + TOK_TAB)[tid];
            __syncthreads();
            int sw_ = 0x79797979, sx_ = 0x7F7F7F7F; asm volatile("" : "+s"(sw_), "+s"(sx_));
            pg8::Gemm g{WSP(bf16, WS_HID), WSP(bf16, WS_WD), MOE_MAXROWS, NE * 1024, D / 2, sw_, sx_}; pg8::MoeOrder S{tabL, 4, G, blk, tabL[32] * 4};
            pg8::EpiDown E{WSP(unsigned char, WS_XS), ka->in[17] + (size_t)l * NE * 1024};
            pg8::gemm_phase<pg8::EpiDown, pg8::MoeOrder, true, true, true>(lds, g, S, E);
        PH_END()
        PH_BEGIN(12)
            float* x2out = (l == DEPTH - 1) ? ka->out : nullptr;
            phase_ln2(WSP(unsigned char, WS_XS), WSP(int, WS_TOK + TOK_ROW), WSP(float, WS_TOK + TOK_W), ka->in[18] + l * D, ka->in[19] + l * D, x2out, WSP(bf16, WS_XBF), gw, NGW, lane);
            if (l + 1 < DEPTH) { constexpr int ln = l + 1, jn = ln >> 1; constexpr bool mn = (ln & 1) != 0;
                const float* win_src = mn ? ka->in[5] + (size_t)jn * D * NC_M : ka->in[2] + (size_t)jn * D * NC_H; const size_t moff = (size_t)ln * NE * 1024 * 1024;
                phase_weights((LAS float*)(lds + wave * 16384), gw, NGW, lane, win_src, mn ? NC_M : NC_H, ka->in[6], 0, ka->in[7] + (size_t)ln * D * D,
                              ka->in[12] + moff, ka->in[14] + moff, ka->in[16] + moff, WSP(bf16, WS_WIN), WSP(bf16, WS_WKV4), WSP(bf16, WS_WO), WSP(bf16, WS_WGU), WSP(bf16, WS_WD)); }
            if (l + 1 < DEPTH) PH_SEAM();
        PH_END_NOSEAM()
}
__global__ void __launch_bounds__(NTHR, 2) fwd_kernel(Args args) {
    extern __shared__ __attribute__((aligned(16))) unsigned char lds_raw[];
    LAS unsigned char* lds = (LAS unsigned char*)lds_raw;
    if (threadIdx.x < 4) ((LAS unsigned*)(lds + MISC_OFF))[threadIdx.x] = 0u;
    __syncthreads();
#if ONE_LAUNCH
    (void)xcd_barrier_post((unsigned*)(args.ws + WS_CTL) + CW_BAR, (volatile LAS unsigned*)(lds + MISC_OFF));
#endif
    { const int l = 0; (void)l;
    PH_BEGIN(0)
        cvt_rows_bf16(ka->in[0], WSP(bf16, WS_XBF), (size_t)T * D / 8, gtid, GTHREADS);
        cvt_rows_bf16(ka->in[1], WSP(bf16, WS_MEMBF), (size_t)512 * D / 8, gtid, GTHREADS);
        split_router_weights(ka->in[10], WSP(bf16, WS_WRS), gtid, GTHREADS);
    PH_END_NOSEAM() }
    layer_phases<0>(lds); layer_phases<1>(lds); layer_phases<2>(lds); layer_phases<3>(lds);
}

extern "C" void kernel_launch(void* const* d_in, const int* in_sizes, int n_in, void* d_out, int out_size, void* d_ws, size_t ws_size, hipStream_t stream) {
    static int ready = 0;
    if (ready == 0) {
        if (n_in != 20 || in_sizes[0] != T * D || out_size != T * D || ws_size < WS_END) { fprintf(stderr, "kernel_launch: unexpected shapes (n_in %d, in0 %d, out %d, ws %zu < %zu)\n", n_in, n_in > 0 ? in_sizes[0] : -1, out_size, ws_size, (size_t)WS_END); ready = -1; return; }
        if (hipFuncSetAttribute((const void*)fwd_kernel, hipFuncAttributeMaxDynamicSharedMemorySize, LDS_BYTES) != hipSuccess) { fprintf(stderr, "kernel_launch: hipFuncSetAttribute failed\n"); ready = -1; return; }
        int per_cu = 0;
        if (hipOccupancyMaxActiveBlocksPerMultiprocessor(&per_cu, (const void*)fwd_kernel, NTHR, LDS_BYTES) != hipSuccess || per_cu < 1) fprintf(stderr, "kernel_launch: occupancy query says %d\n", per_cu);
        (void)hipGetLastError();
        ready = 1;
    }
    if (ready < 0) return;
    if (hipMemsetAsync((char*)d_ws + WS_CTL, 0, CTL_ZERO_BYTES, stream) != hipSuccess) return;
    Args a{};
    for (int i = 0; i < 20; ++i) a.in[i] = (const float*)d_in[i];
    a.out = (float*)d_out; a.ws = (unsigned char*)d_ws;
    a.l_lo = 0; a.l_hi = DEPTH; a.ph_lo = 0; a.ph_hi = NPHASE;
    hipLaunchKernelGGL(fwd_kernel, dim3(GRID), dim3(NTHR), LDS_BYTES, stream, a);
}
```

```cpp
#include <hip/hip_runtime.h>
#include <cstdio>
#include <cstdint>
#include <cmath>
namespace pg8 {
#define PG8_LAS __attribute__((address_space(3)))
typedef unsigned short bf16_t;
typedef short bf16x8 __attribute__((ext_vector_type(8)));
typedef float f32x4 __attribute__((ext_vector_type(4)));
typedef unsigned u32x4 __attribute__((ext_vector_type(4)));
constexpr int BM = 256, BK = 64, HALF = 128, HTB = HALF * BK * 2  , STAGE_BYTES = 8 * HTB, NXCD = 8, WGM = 8;

__host__ __device__ __forceinline__ int lds_byte(int r, int c) { const int st = (r >> 4) * 2 + (c >> 5), rr = r & 15, cc = c & 31, ob = rr * 64 + cc * 2; return st * 1024 + (ob ^ (((ob >> 9) & 1) << 5)); }
__host__ __device__ __forceinline__ void stage_rc(int b, int& R, int& C) { const int st = b / 1024, sb = b % 1024, swz = sb ^ (((sb >> 9) & 1) << 5); R = (st >> 1) * 16 + swz / 64; C = (st & 1) * 32 + (swz % 64) / 2; }
__host__ __device__ __forceinline__ int perm32(int rho) { const int n = rho >> 4, i = rho & 15; return 8 * (i >> 2) + 4 * n + (i & 3); }

struct Unit { int pm, pn; };
struct Gemm { const bf16_t* A; const bf16_t* Bt; int M, N, K; int sw, sx; };
typedef int i32x8 __attribute__((ext_vector_type(8))); typedef int i32x4 __attribute__((ext_vector_type(4)));

struct StaticOrder {
    int nM, nN, nwg, G, c;
    __host__ __device__ void init(int M, int N, int G_, int c_) { nM = M / BM; nN = N / BM; nwg = nM * nN; G = G_; c = c_; }
    __host__ __device__ bool next(int i, Unit& u) const {
        const long L = (long)i * G + c; if (L >= nwg) return false;
        int wgid = (int)L; { const int q = nwg / NXCD, r = nwg % NXCD, xcd = wgid % NXCD, off = wgid / NXCD; wgid = (xcd < r ? xcd * (q + 1) : r * (q + 1) + (xcd - r) * q) + off; }
        const int nig = WGM * nN, gid = wgid / nig, fm = gid * WGM, gsz = (nM - fm) < WGM ? (nM - fm) : WGM;
        u.pm = fm + ((wgid % nig) % gsz); u.pn = (wgid % nig) / gsz; return true;
    }
    __device__ __forceinline__ void a_ready(const Unit&) const {}
    __device__ __forceinline__ void done(const Unit&) const {}
};

__device__ __forceinline__ unsigned cvt_pk_bf16(float lo, float hi) { unsigned r; asm volatile("v_cvt_pk_bf16_f32 %0, %1, %2" : "=v"(r) : "v"(lo), "v"(hi)); return r; }
typedef float f32x2 __attribute__((ext_vector_type(2)));
struct EpiPlain {
    static constexpr bool PERM = true, AFTER_DRAIN = false;
    bf16_t* O; int ldc; unsigned smask; float sc;
    __device__ __forceinline__ void operator()(const f32x4 (&acc)[2][2][4][2], const Unit& u, int wr, int wc, int fr, int fq) const {
        const int row0 = u.pm * BM + wr * 64 + fr; const int col0 = u.pn * BM + wc * 32 + 8 * fq; const float s = ((smask >> u.pn) & 1u) ? sc : 1.f;
#pragma unroll
        for (int ai = 0; ai < 2; ++ai)
#pragma unroll
            for (int m = 0; m < 4; ++m) { bf16_t* rowp = O + (size_t)(row0 + ai * HALF + m * 16) * ldc + col0;
#pragma unroll
                for (int bj = 0; bj < 2; ++bj) { const f32x4 v0 = acc[ai][bj][m][0] * s, v1 = acc[ai][bj][m][1] * s;
                    u32x4 w; w.x = cvt_pk_bf16(v0[0], v0[1]); w.y = cvt_pk_bf16(v0[2], v0[3]); w.z = cvt_pk_bf16(v1[0], v1[1]); w.w = cvt_pk_bf16(v1[2], v1[3]);
                    *(u32x4*)(rowp + bj * HALF) = w; } }
    }
};
__device__ __forceinline__ float swiglu1(float g, float u) {
    g = fminf(g, 7.0f); u = fminf(fmaxf(u, -7.0f), 7.0f);
    const float s = __builtin_amdgcn_rcpf(1.0f + __builtin_amdgcn_exp2f(g * (-1.702f * 1.4426950408889634f)));
    return g * s * (u + 1.0f);
}
__device__ __forceinline__ unsigned pk4_fp8e(float a, float b, float c, float d) { int w = 0; w = __builtin_amdgcn_cvt_pk_fp8_f32(a, b, w, false); w = __builtin_amdgcn_cvt_pk_fp8_f32(c, d, w, true); return (unsigned)w; }
struct EpiSwiglu {
    static constexpr bool PERM = true, AFTER_DRAIN = false;
    unsigned char* hid; const float* bg; const float* bu;
    __device__ __forceinline__ void operator()(const f32x4 (&acc)[2][2][4][2], const Unit& u, int wr, int wc, int fr, int fq) const {
        const int e = u.pn >> 3, pn = u.pn & 7;
        const int row0 = u.pm * BM + wr * 64 + fr; const int col0 = pn * 128 + wc * 32 + 8 * fq;
        const f32x4 g0 = *(const f32x4*)(bg + e * 1024 + col0), g1 = *(const f32x4*)(bg + e * 1024 + col0 + 4);
        const f32x4 u0 = *(const f32x4*)(bu + e * 1024 + col0), u1 = *(const f32x4*)(bu + e * 1024 + col0 + 4);
#pragma unroll
        for (int ai = 0; ai < 2; ++ai)
#pragma unroll
            for (int m = 0; m < 4; ++m) { unsigned char* rowp = hid + (size_t)(row0 + ai * HALF + m * 16) * 1024 + col0;
                const f32x4 ga = acc[ai][0][m][0] + g0, gb = acc[ai][0][m][1] + g1, ua = acc[ai][1][m][0] + u0, ub = acc[ai][1][m][1] + u1;
                typedef unsigned u32x2 __attribute__((ext_vector_type(2))); u32x2 w;
                w.x = pk4_fp8e(swiglu1(ga[0], ua[0]), swiglu1(ga[1], ua[1]), swiglu1(ga[2], ua[2]), swiglu1(ga[3], ua[3]));
                w.y = pk4_fp8e(swiglu1(gb[0], ub[0]), swiglu1(gb[1], ub[1]), swiglu1(gb[2], ub[2]), swiglu1(gb[3], ub[3]));
                *(u32x2*)rowp = w; }
    }
};
struct EpiDown {
    static constexpr bool PERM = true, AFTER_DRAIN = false;
    unsigned char* y; const float* bd;
    __device__ __forceinline__ void operator()(const f32x4 (&acc)[2][2][4][2], const Unit& u, int wr, int wc, int fr, int fq) const {
        const int e = u.pn >> 2, pn = u.pn & 3;
        const int row0 = u.pm * BM + wr * 64 + fr; const int col0 = pn * BM + wc * 32 + 8 * fq;
        f32x4 bv[2][2];
#pragma unroll
        for (int bj = 0; bj < 2; ++bj)
#pragma unroll
            for (int n = 0; n < 2; ++n) bv[bj][n] = *(const f32x4*)(bd + e * 1024 + col0 + bj * HALF + 4 * n);
#pragma unroll
        for (int ai = 0; ai < 2; ++ai)
#pragma unroll
            for (int m = 0; m < 4; ++m) { unsigned char* rowp = y + (size_t)(row0 + ai * HALF + m * 16) * 1024 + col0;
#pragma unroll
                for (int bj = 0; bj < 2; ++bj) { const f32x4 v0 = (acc[ai][bj][m][0] + bv[bj][0]) * 16.f, v1 = (acc[ai][bj][m][1] + bv[bj][1]) * 16.f;
                    typedef unsigned u32x2 __attribute__((ext_vector_type(2))); u32x2 w; w.x = pk4_fp8e(v0[0], v0[1], v0[2], v0[3]); w.y = pk4_fp8e(v1[0], v1[1], v1[2], v1[3]);
                    *(u32x2*)(rowp + bj * HALF) = w; } }
    }
};
struct MoeOrder {
    const PG8_LAS int* tab; int npn, G, c, nunits;
    __device__ __forceinline__ bool next(int i, Unit& u) const {
        const int tpx = 32 / npn, s = c >> 3, tile = (i * 8 + (c & 7)) * tpx + s / npn, pn = s % npn;
        if ((i * 8) * tpx >= nunits / npn) return false;
        if (tile >= nunits / npn) { u.pm = 0; u.pn = 0; return false; }
        int e = 0;
#pragma unroll
        for (int k = 1; k < 32; ++k) e += (tab[k] <= tile) ? 1 : 0;
        u.pm = tile; u.pn = __builtin_amdgcn_readfirstlane(e) * npn + pn; return true;
    }
    __device__ __forceinline__ void a_ready(const Unit&) const {}
    __device__ __forceinline__ void done(const Unit&) const {}
};
template <class Epi, class Sched, bool ALIGN_EPI = false, bool SP2 = false, bool F8 = false>
__device__ __forceinline__ void gemm_phase(PG8_LAS unsigned char* lds, const Gemm g, const Sched& S, const Epi& E) {
    int tid_ = threadIdx.x; asm volatile("" : "+v"(tid_));
    const int tid = tid_, wid = __builtin_amdgcn_readfirstlane(tid >> 6), lane = tid & 63, wr = wid >> 2, wc = wid & 3, fr = lane & 15, fq = lane >> 4;
    const int K = g.K, nt = K / BK;
    unsigned voffA, voffB;
    { int R, C; stage_rc(tid * 16, R, C); const int Rb = Epi::PERM ? ((R & ~31) + perm32(R & 31)) : R; voffA = (unsigned)(R * K + C) * 2u; voffB = (unsigned)(Rb * K + C) * 2u; }
    const unsigned qstep = 64u * (unsigned)K * 2u;
    const unsigned kstep = (unsigned)(BK * 2);
    const unsigned hstep = (unsigned)HALF * (unsigned)K * 2u;
    const unsigned tstep = 2u * hstep;
    const __amdgpu_buffer_rsrc_t rA = __builtin_amdgcn_make_buffer_rsrc((void*)g.A, 0, 0x7FFFFFFF, 0x00020000), rB = __builtin_amdgcn_make_buffer_rsrc((void*)g.Bt, 0, 0x7FFFFFFF, 0x00020000);
    const unsigned ldsw = (unsigned)wid * 1024u;
    const int aoff = lds_byte(wr * 64 + fr, fq * 8), boff = lds_byte(wc * 32 + fr, fq * 8);
#define PG8_SA(b, h) (((b) * 2 + (h)) * HTB)
#define PG8_SB(b, h) ((4 + (b) * 2 + (h)) * HTB)
#define PG8_STG(bufoff, rsrc, soff, voff) do { _Pragma("unroll") for (int _i = 0; _i < 2; ++_i) \
        __builtin_amdgcn_raw_ptr_buffer_load_lds((rsrc), (PG8_LAS void*)(lds + (bufoff) + ldsw + _i * 8192), 16, (int)(voff), (int)((soff) + (unsigned)_i * qstep), 0, 0); } while (0)
#define PG8_STGA(bufoff, soff) PG8_STG(bufoff, rA, soff, voffA)
#define PG8_STGB(bufoff, soff) PG8_STG(bufoff, rB, soff, voffB)
#define PG8_LDA(dst, b, h) do { _Pragma("unroll") for (int m = 0; m < 4; ++m) { if constexpr (F8) { const i32x4 lo_ = *(const PG8_LAS i32x4*)(lds + PG8_SA(b, h) + aoff + m * 2048), hi_ = *(const PG8_LAS i32x4*)(lds + PG8_SA(b, h) + aoff + m * 2048 + 1024); \
            dst##_8[m] = __builtin_shufflevector(lo_, hi_, 0, 1, 2, 3, 4, 5, 6, 7); } else { _Pragma("unroll") for (int k = 0; k < 2; ++k) dst[m][k] = *(const PG8_LAS bf16x8*)(lds + PG8_SA(b, h) + aoff + m * 2048 + k * 1024); } } } while (0)
#define PG8_LDB(dst, b, h) do { _Pragma("unroll") for (int n = 0; n < 2; ++n) { if constexpr (F8) { const i32x4 lo_ = *(const PG8_LAS i32x4*)(lds + PG8_SB(b, h) + boff + n * 2048), hi_ = *(const PG8_LAS i32x4*)(lds + PG8_SB(b, h) + boff + n * 2048 + 1024); \
            dst##_8[n] = __builtin_shufflevector(lo_, hi_, 0, 1, 2, 3, 4, 5, 6, 7); } else { _Pragma("unroll") for (int k = 0; k < 2; ++k) dst[n][k] = *(const PG8_LAS bf16x8*)(lds + PG8_SB(b, h) + boff + n * 2048 + k * 1024); } } } while (0)
#define PG8_MMA(ai, bj, At, Bt) do { __builtin_amdgcn_s_setprio(1); _Pragma("unroll") for (int m = 0; m < 4; ++m) _Pragma("unroll") for (int n = 0; n < 2; ++n) { \
        if constexpr (F8) acc[ai][bj][m][n] = __builtin_amdgcn_mfma_scale_f32_16x16x128_f8f6f4(Bt##_8[n], At##_8[m], acc[ai][bj][m][n], 0, 0, 0, g.sw, 0, g.sx); \
        else { _Pragma("unroll") for (int k = 0; k < 2; ++k) acc[ai][bj][m][n] = __builtin_amdgcn_mfma_f32_16x16x32_bf16(Bt[n][k], At[m][k], acc[ai][bj][m][n], 0, 0, 0); } } \
        __builtin_amdgcn_s_setprio(0); } while (0)
#define PG8_WAIT_V(n) asm volatile("s_waitcnt vmcnt(" #n ")" ::: "memory")
#define PG8_WAIT_L(n) asm volatile("s_waitcnt lgkmcnt(" #n ")" ::: "memory")
#define PG8_BAR __builtin_amdgcn_s_barrier()
#define PG8_SCHED __builtin_amdgcn_sched_barrier(0)
    Unit cur, nxt; int ui = 0;
    if (!S.next(0, cur)) return;
    f32x4 acc[2][2][4][2];
#pragma unroll
    for (int a = 0; a < 2; ++a)
#pragma unroll
        for (int b = 0; b < 2; ++b)
#pragma unroll
            for (int m = 0; m < 4; ++m)
#pragma unroll
                for (int n = 0; n < 2; ++n) acc[a][b][m][n] = (f32x4){0.f, 0.f, 0.f, 0.f};
    bf16x8 At[4][2], B0[2][2], B1[2][2]; i32x8 At_8[4], B0_8[2], B1_8[2];
    unsigned cA = (unsigned)cur.pm * tstep, cB = (unsigned)cur.pn * tstep;
    S.a_ready(cur);
    if constexpr (SP2) {
        PG8_STGB(PG8_SB(0, 0), cB); PG8_STGB(PG8_SB(0, 1), cB + hstep); PG8_STGA(PG8_SA(0, 0), cA); PG8_STGA(PG8_SA(0, 1), cA + hstep);
        if (wr == 1) PG8_BAR;
        PG8_WAIT_V(2); PG8_BAR;
        PG8_STGB(PG8_SB(1, 0), cB + kstep); PG8_STGA(PG8_SA(1, 0), cA + kstep); PG8_STGB(PG8_SB(1, 1), cB + hstep + kstep);
        PG8_WAIT_V(6); PG8_BAR;
    } else {
        PG8_STGB(PG8_SB(0, 0), cB); PG8_STGA(PG8_SA(0, 0), cA); PG8_STGB(PG8_SB(0, 1), cB + hstep); PG8_STGA(PG8_SA(0, 1), cA + hstep);
        if (wr == 1) PG8_BAR;
        PG8_WAIT_V(4); PG8_BAR;
        PG8_STGB(PG8_SB(1, 0), cB + kstep); PG8_STGA(PG8_SA(1, 0), cA + kstep); PG8_STGB(PG8_SB(1, 1), cB + hstep + kstep);
        PG8_WAIT_V(6); PG8_BAR;
    }
    for (;;) {
        const bool has_next = S.next(ui + 1, nxt);
        const unsigned nA = has_next ? (unsigned)nxt.pm * tstep : cA, nB = has_next ? (unsigned)nxt.pn * tstep : cB;
#pragma unroll 1
        for (int t = 0; t < nt; t += 2) {
            const bool last = (t == nt - 2);
            const unsigned a1 = cA + (unsigned)(t + 1) * kstep;
            const unsigned a2 = last ? nA : cA + (unsigned)(t + 2) * kstep, b2 = last ? nB : cB + (unsigned)(t + 2) * kstep;
            const unsigned a3 = a2 + kstep, b3 = b2 + kstep;
            if (last && has_next) S.a_ready(nxt);
            if constexpr (SP2) {
            PG8_LDB(B0, 0, 0); PG8_LDB(B1, 0, 1); PG8_SCHED; PG8_LDA(At, 0, 0); PG8_STGA(PG8_SA(1, 1), a1 + hstep);
            PG8_WAIT_V(8); PG8_WAIT_L(0); PG8_BAR; PG8_MMA(0, 0, At, B0); PG8_MMA(0, 1, At, B1); PG8_BAR; PG8_SCHED;
            PG8_LDA(At, 0, 1); PG8_STGB(PG8_SB(0, 0), b2); PG8_STGB(PG8_SB(0, 1), b2 + hstep); PG8_STGA(PG8_SA(0, 0), a2);
            PG8_WAIT_V(8); PG8_WAIT_L(0); PG8_BAR; PG8_MMA(1, 0, At, B0); PG8_MMA(1, 1, At, B1); PG8_BAR; PG8_SCHED;
            PG8_LDB(B0, 1, 0); PG8_LDB(B1, 1, 1); PG8_SCHED; PG8_LDA(At, 1, 0); PG8_STGA(PG8_SA(0, 1), a2 + hstep);
            PG8_WAIT_V(8); PG8_WAIT_L(0); PG8_BAR; PG8_MMA(0, 0, At, B0); PG8_MMA(0, 1, At, B1); PG8_BAR; PG8_SCHED;
            PG8_LDA(At, 1, 1); PG8_STGB(PG8_SB(1, 0), b3); PG8_STGB(PG8_SB(1, 1), b3 + hstep); PG8_STGA(PG8_SA(1, 0), a3);
            PG8_WAIT_V(8); PG8_WAIT_L(0); PG8_BAR; PG8_MMA(1, 0, At, B0); PG8_MMA(1, 1, At, B1); PG8_BAR; PG8_SCHED;
            } else {
            PG8_LDB(B0, 0, 0); PG8_SCHED; PG8_LDA(At, 0, 0); PG8_STGA(PG8_SA(1, 1), a1 + hstep);
            PG8_WAIT_L(8); PG8_BAR; PG8_WAIT_L(0); PG8_MMA(0, 0, At, B0); PG8_BAR; PG8_SCHED;
            PG8_LDB(B1, 0, 1); PG8_STGB(PG8_SB(0, 0), b2);
            PG8_BAR; PG8_WAIT_L(0); PG8_MMA(0, 1, At, B1); PG8_BAR;
            PG8_LDA(At, 0, 1); PG8_STGA(PG8_SA(0, 0), a2);
            PG8_BAR; PG8_WAIT_L(0); PG8_MMA(1, 0, At, B0); PG8_BAR; PG8_SCHED;
            PG8_STGB(PG8_SB(0, 1), b2 + hstep);
            PG8_WAIT_V(6); PG8_BAR; PG8_MMA(1, 1, At, B1); PG8_BAR;
            PG8_LDB(B0, 1, 0); PG8_SCHED; PG8_LDA(At, 1, 0); PG8_STGA(PG8_SA(0, 1), a2 + hstep);
            PG8_WAIT_L(8); PG8_BAR; PG8_WAIT_L(0); PG8_MMA(0, 0, At, B0); PG8_BAR; PG8_SCHED;
            PG8_LDB(B1, 1, 1); PG8_STGB(PG8_SB(1, 0), b3);
            PG8_BAR; PG8_WAIT_L(0); PG8_MMA(0, 1, At, B1); PG8_BAR;
            PG8_LDA(At, 1, 1); PG8_STGA(PG8_SA(1, 0), a3);
            PG8_BAR; PG8_WAIT_L(0); PG8_MMA(1, 0, At, B0); PG8_BAR; PG8_SCHED;
            PG8_STGB(PG8_SB(1, 1), b3 + hstep);
            PG8_WAIT_V(6); PG8_BAR; PG8_MMA(1, 1, At, B1); PG8_BAR;
            }
        }
        if constexpr (ALIGN_EPI) { if (wr == 0) PG8_BAR; }
        if constexpr (!Epi::AFTER_DRAIN) { int t2_ = threadIdx.x; asm volatile("" : "+v"(t2_)); E(acc, cur, wr, wc, t2_ & 15, (t2_ & 63) >> 4); S.done(cur); }
        if (!has_next) break;
#pragma unroll
        for (int a = 0; a < 2; ++a)
#pragma unroll
            for (int b = 0; b < 2; ++b)
#pragma unroll
                for (int m = 0; m < 4; ++m)
#pragma unroll
                    for (int n = 0; n < 2; ++n) acc[a][b][m][n] = (f32x4){0.f, 0.f, 0.f, 0.f};
        cur = nxt; cA = nA; cB = nB; ++ui;
        if constexpr (ALIGN_EPI) { if (wr == 1) PG8_BAR; }
    }
    PG8_WAIT_V(0);
    if constexpr (!ALIGN_EPI) { if (wr == 0) PG8_BAR; }
    PG8_BAR;
    if constexpr (Epi::AFTER_DRAIN) { E.fused(acc, cur, wr, wc, fr, fq, lds, wid, lane); S.done(cur); }
#undef PG8_SA
#undef PG8_SB
#undef PG8_STG
#undef PG8_STGA
#undef PG8_STGB
#undef PG8_LDA
#undef PG8_LDB
#undef PG8_MMA
#undef PG8_WAIT_V
#undef PG8_WAIT_L
#undef PG8_BAR
#undef PG8_SCHED
}
}

constexpr int NWAVES = 8, NTHR = 512, GRID = 256;
constexpr int NBATCH = 2, SEQ = 16384, T = NBATCH * SEQ, D = 1024, DEPTH = 4;
constexpr int MIXW = 768, NC_H = 3328, NC_M = 2560;
constexpr int HG_H = 6;
constexpr int HSEG = 256, HNSEG = SEQ / HSEG;
constexpr int MB_H = 12, MB_NB = 64;
constexpr int NE = 32;
constexpr float DN_ALPHA = 1.6817928305074290f;
constexpr int MOE_MAXROWS = T * 4 + NE * 256;
#ifndef ONE_LAUNCH
#define ONE_LAUNCH 1
#endif
constexpr int NPHASE = 13;

constexpr size_t MiB = 1u << 20;
constexpr size_t WS_CTL = 0, CTL_ZERO_BYTES = 1 * MiB;
constexpr size_t WS_WIN = 1 * MiB, WS_WKV = 9 * MiB, WS_WO = 10 * MiB, WS_WGU = 12 * MiB, WS_WD = 140 * MiB;
constexpr size_t WS_XBF = 204 * MiB, WS_WKV4 = 268 * MiB  , WS_KV4 = 272 * MiB  , WS_WRS = 280 * MiB  , WS_MEMBF = 524 * MiB;
constexpr size_t WS_H = 526 * MiB, WS_MIX = 734 * MiB, WS_Y = 798 * MiB, WS_SLOC = 862 * MiB, WS_DSEG = 910 * MiB, WS_KMEAN = 911 * MiB;
constexpr size_t WS_SELINFO = 912 * MiB, WS_TOK = 914 * MiB, WS_R1 = 918 * MiB;
constexpr size_t WS_LIST = WS_R1, WS_PML = WS_R1 + 96 * MiB, WS_PO = WS_R1 + 108 * MiB;
constexpr size_t WS_XS = WS_R1, WS_HID = WS_R1 + 272 * MiB;
constexpr size_t WS_END = WS_R1 + 544 * MiB;
static_assert((size_t)MOE_MAXROWS * 1024 * 2 <= 272 * MiB, "moe rows");
static_assert((size_t)T * MB_H * 4 * 64 * 4 <= 384 * MiB && (size_t)24 * 64 * 16384 * 4 <= 96 * MiB, "moba bufs");
constexpr size_t TOK_E = 0, TOK_LR = 512 * 1024, TOK_W = 1024 * 1024, TOK_ROW = 1536 * 1024, TOK_BLKCNT = 2048 * 1024, TOK_TAB = 2048 * 1024 + 65536;
constexpr int CW_BAR = 4096, CW_GCOUNT = 8192;

constexpr int RING_BYTES = 131072, LDS_BYTES = 147456, MISC_OFF = LDS_BYTES - 1024;

#define GAS __attribute__((address_space(1)))
#define LAS __attribute__((address_space(3)))
typedef unsigned short bf16;
typedef unsigned v4u __attribute__((ext_vector_type(4)));
typedef unsigned v2u __attribute__((ext_vector_type(2)));
typedef float f32x4 __attribute__((ext_vector_type(4)));
typedef float f32x2 __attribute__((ext_vector_type(2)));
typedef short s16x8 __attribute__((ext_vector_type(8)));
typedef float f32x16 __attribute__((ext_vector_type(16)));
typedef float f32x2_t __attribute__((ext_vector_type(2))); typedef __bf16 bf16x2_t __attribute__((ext_vector_type(2)));
__device__ __forceinline__ unsigned cvtpk(float lo, float hi) { f32x2_t v = {lo, hi}; bf16x2_t b = __builtin_convertvector(v, bf16x2_t); return __builtin_bit_cast(unsigned, b); }
#define LDS_WAIT() asm volatile("s_waitcnt lgkmcnt(0)" ::: "memory")
__device__ __forceinline__ unsigned f2bf(float f) { unsigned u = __builtin_bit_cast(unsigned, f); return (u + 0x7fffu + ((u >> 16) & 1u)) >> 16; }
__device__ __forceinline__ unsigned pk2(float lo, float hi) { return f2bf(lo) | (f2bf(hi) << 16); }
__device__ __forceinline__ float bflo(unsigned w) { return __builtin_bit_cast(float, w << 16); }
__device__ __forceinline__ float bfhi(unsigned w) { return __builtin_bit_cast(float, w & 0xffff0000u); }
__device__ __forceinline__ float bf2f(bf16 h) { return __builtin_bit_cast(float, (unsigned)h << 16); }
__device__ __forceinline__ float sigmoidf_(float z) { return __builtin_amdgcn_rcpf(1.0f + __builtin_amdgcn_exp2f(-1.4426950408889634f * z)); }
template <int X> __device__ __forceinline__ float xorf(float v) { return __builtin_bit_cast(float, __builtin_amdgcn_ds_swizzle(__builtin_bit_cast(int, v), (X << 10) | 0x1F)); }
template <int X> __device__ __forceinline__ int xori(int v) { return __builtin_amdgcn_ds_swizzle(v, (X << 10) | 0x1F); }
__device__ __forceinline__ float wave_sum(float v) {
    v += xorf<1>(v); v += xorf<2>(v); v += xorf<4>(v); v += xorf<8>(v); v += xorf<16>(v);
    return __builtin_bit_cast(float, __builtin_amdgcn_readlane(__builtin_bit_cast(int, v), 0)) + __builtin_bit_cast(float, __builtin_amdgcn_readlane(__builtin_bit_cast(int, v), 32));
}
__device__ __forceinline__ float wave_max(float v) {
    v = fmaxf(v, xorf<1>(v)); v = fmaxf(v, xorf<2>(v)); v = fmaxf(v, xorf<4>(v)); v = fmaxf(v, xorf<8>(v)); v = fmaxf(v, xorf<16>(v));
    return fmaxf(__builtin_bit_cast(float, __builtin_amdgcn_readlane(__builtin_bit_cast(int, v), 0)), __builtin_bit_cast(float, __builtin_amdgcn_readlane(__builtin_bit_cast(int, v), 32)));
}
__device__ __forceinline__ float xor32f(float v, int lane) { return __builtin_bit_cast(float, __builtin_amdgcn_ds_bpermute((lane ^ 32) << 2, __builtin_bit_cast(int, v))); }
#define XB_TMO      128
#define XB_XCNT(j)  (256  + 64 * (j))
#define XB_XSUB(j)  (1280 + 64 * (j))
#define XB_XGEN(j)  (2304 + 64 * (j))
#define XB_TOP      3328
#define XB_TOPGEN   3392
#define XCD_BAR_WORDS 3456
#define XB_SPIN_CAP (1u << 18)

__device__ __forceinline__ unsigned xb_ld(unsigned* p)              { return __hip_atomic_load(p, __ATOMIC_RELAXED, __HIP_MEMORY_SCOPE_AGENT); }
__device__ __forceinline__ unsigned xb_add(unsigned* p, unsigned v) { return __hip_atomic_fetch_add(p, v, __ATOMIC_RELAXED, __HIP_MEMORY_SCOPE_AGENT); }
__device__ __forceinline__ unsigned xb_xcc_id() { return (unsigned)__builtin_amdgcn_s_getreg((3 << 11) | 20) & 0xFu; }
#define XB_SPIN(cond, bar) do { unsigned _sp = 0; while (cond) { __builtin_amdgcn_s_sleep(1); \
    if ((++_sp & 255u) == 0u) { if (xb_ld(&(bar)[XB_TMO])) break; if (_sp > XB_SPIN_CAP) { atomicAdd(&(bar)[XB_TMO], 1u); break; } } } } while (0)

struct XcdBarrier {
    unsigned* bar; unsigned x;
    volatile LAS unsigned* st;
};

__device__ __forceinline__ XcdBarrier xcd_barrier_post(unsigned* bar, volatile LAS unsigned* st) {
    XcdBarrier b; b.bar = bar; b.x = xb_xcc_id(); b.st = st;
    if (threadIdx.x == 0) (void)xb_add(&bar[XB_XCNT(b.x)], 1u);
    return b;
}
__device__ __forceinline__ void xcd_barrier_complete(unsigned* bar, unsigned x, unsigned& nloc, unsigned& nx) {
    const unsigned G = gridDim.x * gridDim.y * gridDim.z;
    unsigned sum, cnt, mine, sp = 0u;
    for (;;) {
        sum = 0u; cnt = 0u; mine = 0u;
#pragma unroll
        for (unsigned j = 0; j < 16; ++j) { const unsigned c = xb_ld(&bar[XB_XCNT(j)]); sum += c; cnt += (c > 0u) ? 1u : 0u; mine = (j == x) ? c : mine; }
        if (sum == G) break;
        __builtin_amdgcn_s_sleep(1);
        if ((++sp & 255u) == 0u) { if (xb_ld(&bar[XB_TMO])) break; if (sp > XB_SPIN_CAP) { atomicAdd(&bar[XB_TMO], 1u); break; } }
    }
    nloc = mine > 0u ? mine : 1u; nx = cnt > 0u ? cnt : 1u;
}

__device__ __forceinline__ void xcd_barrier(const XcdBarrier& b) {
    asm volatile("s_waitcnt vmcnt(0)" ::: "memory");
    __syncthreads();
    if (threadIdx.x == 0) {
        unsigned* bar = b.bar;
        __builtin_amdgcn_s_waitcnt(0);
        unsigned nloc = b.st[0], nx = b.st[1];
        if (nloc == 0u) { xcd_barrier_complete(bar, b.x, nloc, nx); b.st[0] = nloc; b.st[1] = nx; }
        const unsigned old = xb_add(&bar[XB_XSUB(b.x)], 1u);
        const unsigned gen = old / nloc;
        if (old + 1u == (gen + 1u) * nloc) {
            __builtin_amdgcn_fence(__ATOMIC_RELEASE, "agent");
            asm volatile("s_waitcnt vmcnt(0)" ::: "memory");
            const unsigned og = xb_add(&bar[XB_TOP], 1u);
            const unsigned tg = og / nx;
            if (og + 1u == (tg + 1u) * nx) xb_add(&bar[XB_TOPGEN], 1u);
            else XB_SPIN(xb_ld(&bar[XB_TOPGEN]) == tg, bar);
            __builtin_amdgcn_fence(__ATOMIC_ACQUIRE, "agent");
            xb_add(&bar[XB_XGEN(b.x)], 1u);
            asm volatile("s_waitcnt vmcnt(0)" ::: "memory");
        } else {
            XB_SPIN(xb_ld(&bar[XB_XGEN(b.x)]) == gen, bar);
            __builtin_amdgcn_fence(__ATOMIC_ACQUIRE, "agent");
            asm volatile("s_waitcnt vmcnt(0)" ::: "memory");
        }
    }
    __syncthreads();
}

__device__ __forceinline__ void cvt_rows_bf16(const float* src, bf16* dst, size_t n8, size_t gtid, size_t gthreads) {
    for (size_t i = gtid; i < n8; i += gthreads) { const f32x4 a = ((const f32x4*)src)[2 * i], b = ((const f32x4*)src)[2 * i + 1];
        v4u o; o.x = pk2(a.x, a.y); o.y = pk2(a.z, a.w); o.z = pk2(b.x, b.y); o.w = pk2(b.z, b.w); ((v4u*)dst)[i] = o; }
}
__device__ __forceinline__ void transpose_item(const float* W, int N, bf16* WT, int dst_row0, LAS float* scr, int k0, int n0, int lane) {
#pragma unroll 8
    for (int i = 0; i < 32; ++i) { const int kk = 2 * i + (lane >> 5); scr[kk * 33 + (lane & 31)] = W[(size_t)(k0 + kk) * N + n0 + (lane & 31)]; }
    LDS_WAIT(); asm volatile("" ::: "memory");
    const int c = lane & 7;
#pragma unroll
    for (int j = 0; j < 4; ++j) { const int n = (lane >> 3) + 8 * j; const LAS float* s = scr + (8 * c) * 33 + n;
        v4u o; o.x = pk2(s[0 * 33], s[1 * 33]); o.y = pk2(s[2 * 33], s[3 * 33]); o.z = pk2(s[4 * 33], s[5 * 33]); o.w = pk2(s[6 * 33], s[7 * 33]);
        *(v4u*)(WT + (size_t)(dst_row0 + n) * 1024 + k0 + 8 * c) = o; }
    LDS_WAIT(); asm volatile("" ::: "memory");
}
__device__ __forceinline__ unsigned pk4_fp8(float a, float b, float c, float d) { int w = 0; w = __builtin_amdgcn_cvt_pk_fp8_f32(a, b, w, false); w = __builtin_amdgcn_cvt_pk_fp8_f32(c, d, w, true); return (unsigned)w; }
__device__ __forceinline__ void transpose_item_f8(const float* W, int N, unsigned char* WT8, int dst_row0, LAS float* scr, int k0, int n0, int lane, float wscale) {
#pragma unroll 8
    for (int i = 0; i < 32; ++i) { const int kk = 2 * i + (lane >> 5); scr[kk * 33 + (lane & 31)] = W[(size_t)(k0 + kk) * N + n0 + (lane & 31)]; }
    LDS_WAIT(); asm volatile("" ::: "memory");
    const int c = lane & 7;
#pragma unroll
    for (int j = 0; j < 4; ++j) { const int n = (lane >> 3) + 8 * j; const LAS float* s = scr + (8 * c) * 33 + n;
        v2u o; o.x = pk4_fp8(s[0 * 33] * wscale, s[1 * 33] * wscale, s[2 * 33] * wscale, s[3 * 33] * wscale); o.y = pk4_fp8(s[4 * 33] * wscale, s[5 * 33] * wscale, s[6 * 33] * wscale, s[7 * 33] * wscale);
        *(v2u*)(WT8 + (size_t)(dst_row0 + n) * 1024 + k0 + 8 * c) = o; }
    LDS_WAIT(); asm volatile("" ::: "memory");
}
__device__ __forceinline__ void phase_weights(LAS float* scr, int gw, int ngw, int lane, const float* win_src, int NC, const float* wkv_src, int nkv, const float* wo_src,
                                              const float* wg_src, const float* wu_src, const float* wd_src, bf16* win_t, bf16* wkv_t, bf16* wo_t, bf16* wgu_t, bf16* wd_t) {
    const int nbw = NC / 32, nWin = nbw * 16, NIT = nWin + 256 * nkv + 512 + NE * 1536;
    for (int it = gw; it < NIT; it += ngw) {
        int r = it;
        if (r < nWin) { const int kb = r / nbw, nb = r - kb * nbw; transpose_item(win_src, NC, win_t, 32 * nb, scr, 64 * kb, 32 * nb, lane); continue; } r -= nWin;
        if (r < 256 * nkv) { const int lay = r >> 8, rr = r & 255, kb = rr >> 4, nb = rr & 15; transpose_item(wkv_src + (size_t)lay * D * 512, 512, wkv_t + (size_t)lay * 512 * 1024, 32 * nb, scr, 64 * kb, 32 * nb, lane); continue; } r -= 256 * nkv;
        if (r < 512) { const int kb = r >> 5, nb = r & 31; transpose_item(wo_src, 1024, wo_t, 32 * nb, scr, 64 * kb, 32 * nb, lane); continue; } r -= 512;
        const int e = r / 1536, q = r - e * 1536, which = q >> 9, rr = q & 511, kb = rr >> 5, nb = rr & 31, n0 = 32 * nb;
        const size_t eoff = (size_t)e * 1024 * 1024;
        if (which == 0) transpose_item_f8(wg_src + eoff, 1024, (unsigned char*)wgu_t + 2 * eoff, (n0 >> 7) * 256 + (n0 & 127), scr, 64 * kb, n0, lane, 32.f);
        else if (which == 1) transpose_item_f8(wu_src + eoff, 1024, (unsigned char*)wgu_t + 2 * eoff, (n0 >> 7) * 256 + 128 + (n0 & 127), scr, 64 * kb, n0, lane, 32.f);
        else transpose_item_f8(wd_src + eoff, 1024, (unsigned char*)wd_t + eoff, n0, scr, 64 * kb, n0, lane, 64.f);
    }
}

template <bool OUT>
__device__ __forceinline__ void hgrn_seg(LAS unsigned char* lds, const bf16* h, const float* lbl, int j, const float* normg, float* Sloc, float* Dseg, bf16* mix, int unit, int tid, int wave, int lane) {
    const int seg = unit & (HNSEG - 1), bh = unit >> 6, hh = bh % HG_H, b = bh / HG_H;
    const int v = tid & 127, dg = tid >> 7;
    LAS float* fgs = (LAS float*)lds; LAS float* vs = fgs + 4096; LAS float* qs = vs + 4096; LAS float* op = qs + 4096;
    f32x2 st[16];
    float* Sp = Sloc + (size_t)unit * 16384 + (size_t)(dg * 32) * 128 + v;
#pragma unroll
    for (int dd = 0; dd < 16; ++dd) { st[dd].x = OUT ? Sp[(2 * dd) * 128] : 0.f; st[dd].y = OUT ? Sp[(2 * dd + 1) * 128] : 0.f; }
    float dprod = 1.f;
    const int stok = tid >> 4, c8 = (tid & 15) * 8;
    float lb[8];
#pragma unroll
    for (int i = 0; i < 8; ++i) { lb[i] = 0.f; if (j > 0) { const float a0 = lbl[hh * 128 + c8 + i], a1 = lbl[MIXW + hh * 128 + c8 + i]; lb[i] = 1.f / (1.f + __expf(a0 - a1)); } }
    for (int ch = 0; ch < HSEG / 32; ++ch) {
        const size_t t0 = (size_t)b * SEQ + seg * HSEG + ch * 32;
        { const bf16* row = h + (t0 + stok) * NC_H + hh * 128 + c8;
          const v4u f8 = *(const v4u*)(row + 768), i8 = *(const v4u*)(row + 1536); v4u q8 = {0u, 0u, 0u, 0u}; if (OUT) q8 = *(const v4u*)row;
#pragma unroll
          for (int w = 0; w < 4; ++w) { const float f0 = bflo(f8[w]), f1 = bfhi(f8[w]); const int o = stok * 128 + c8 + 2 * w;
              fgs[o] = lb[2 * w] + (1.f - lb[2 * w]) * sigmoidf_(f0); fgs[o + 1] = lb[2 * w + 1] + (1.f - lb[2 * w + 1]) * sigmoidf_(f1);
              vs[o] = bflo(i8[w]); vs[o + 1] = bfhi(i8[w]);
              if (OUT) { const float q0 = bflo(q8[w]), q1 = bfhi(q8[w]); qs[o] = q0 * sigmoidf_(q0); qs[o + 1] = q1 * sigmoidf_(q1); } } }
        __syncthreads();
        if (!OUT) { if (tid < 128) { for (int tt = 0; tt < 32; ++tt) dprod *= fgs[tt * 128 + tid]; } }
        f32x4 fA[8], qA[8], fB[8], qB[8]; float vA, vB;
#define HG_LOAD(F, Q, V, tt_) do { V = vs[(tt_) * 128 + v]; _Pragma("unroll") for (int d4 = 0; d4 < 8; ++d4) { F[d4] = *(const LAS f32x4*)(fgs + (tt_) * 128 + dg * 32 + d4 * 4); \
            if (OUT) Q[d4] = *(const LAS f32x4*)(qs + (tt_) * 128 + dg * 32 + d4 * 4); } } while (0)
#define HG_STEP(F, Q, V, tt_) do { const f32x2 vv2 = {V, V}; f32x2 acc2 = {0.f, 0.f}; _Pragma("unroll") for (int d4 = 0; d4 < 8; ++d4) { \
            const f32x2 fa = {F[d4].x, F[d4].y}, fb = {F[d4].z, F[d4].w}; \
            st[2 * d4] = fa * (st[2 * d4] - vv2) + vv2; st[2 * d4 + 1] = fb * (st[2 * d4 + 1] - vv2) + vv2; \
            if (OUT) { const f32x2 qa = {Q[d4].x, Q[d4].y}, qb = {Q[d4].z, Q[d4].w}; acc2 = qa * st[2 * d4] + acc2; acc2 = qb * st[2 * d4 + 1] + acc2; } } \
            if (OUT) op[(dg * 32 + (tt_)) * 128 + v] = acc2.x + acc2.y; } while (0)
        HG_LOAD(fA, qA, vA, 0);
#pragma unroll 1
        for (int tt = 0; tt < 32; tt += 2) {
            HG_LOAD(fB, qB, vB, tt + 1);
            __builtin_amdgcn_sched_barrier(0);
            HG_STEP(fA, qA, vA, tt);
            __builtin_amdgcn_sched_barrier(0);
            if (tt + 2 < 32) HG_LOAD(fA, qA, vA, tt + 2);
            __builtin_amdgcn_sched_barrier(0);
            HG_STEP(fB, qB, vB, tt + 1);
            __builtin_amdgcn_sched_barrier(0);
        }
#undef HG_LOAD
#undef HG_STEP
        if (OUT) {
            __syncthreads();
#pragma unroll
            for (int k = 0; k < 4; ++k) { const int tt = wave + 8 * k; float o0 = 0.f, o1 = 0.f;
#pragma unroll
                for (int g = 0; g < 4; ++g) { o0 += op[(g * 32 + tt) * 128 + lane]; o1 += op[(g * 32 + tt) * 128 + lane + 64]; }
                const float ms = wave_sum(o0 * o0 + o1 * o1) * (1.f / 128.f), r = 1.f / sqrtf(ms + 1e-6f);
                const bf16* grow = h + (t0 + tt) * NC_H + 2304 + hh * 128; const float g0 = bf2f(grow[lane]), g1 = bf2f(grow[lane + 64]);
                bf16* mrow = mix + (t0 + tt) * 1024 + hh * 128;
                mrow[lane] = (bf16)f2bf(o0 * r * normg[lane] * sigmoidf_(g0)); mrow[lane + 64] = (bf16)f2bf(o1 * r * normg[lane + 64] * sigmoidf_(g1)); }
        }
        __syncthreads();
    }
    if (!OUT) {
#pragma unroll
        for (int dd = 0; dd < 16; ++dd) { Sp[(2 * dd) * 128] = st[dd].x; Sp[(2 * dd + 1) * 128] = st[dd].y; }
        if (tid < 128) Dseg[(size_t)unit * 128 + tid] = dprod;
    }
}
constexpr int HG_G = 0, HG_QT = 32768, HG_KT = 50176, HG_KE = 67584, HG_VT = 86016, HG_ST = 104448, HG_GM = 139264, HG_GE = 139776, HG_PART = 140288;
static_assert(HG_PART + 2048 <= MISC_OFF, "HGRN LDS map");
__device__ __forceinline__ int crow16(int i, int hf) { return (i & 3) + 8 * (i >> 2) + 4 * hf; }
template <bool OUT>
__device__ __forceinline__ void hgrn_mfma(LAS unsigned char* lds, const bf16* h, const float* lbl, int j, const float* normg, float* Sloc, float* Dseg, bf16* mix, int unit, int tid, int wave, int lane) {
    const int seg = unit & (HNSEG - 1), bh = unit >> 6, hh = bh % HG_H, b = bh / HG_H;
    const int r = lane & 31, hf = lane >> 5, tr = wave & 1, vq = wave >> 1;
    LAS float* G = (LAS float*)(lds + HG_G); LAS float* GM = (LAS float*)(lds + HG_GM); LAS float* GE = (LAS float*)(lds + HG_GE); LAS float* PART = (LAS float*)(lds + HG_PART);
    const int stok = tid >> 3, c16 = (tid & 7) * 16, sperm = (stok & ~15) | (stok & 3) | ((stok & 4) << 1) | ((stok & 8) >> 1);
    const int cd = tid & 127, cpart = tid >> 7;
    float lb[16];
#pragma unroll
    for (int e = 0; e < 16; ++e) { lb[e] = 0.f; if (j > 0) { const float a0 = lbl[hh * 128 + c16 + e], a1 = lbl[MIXW + hh * 128 + c16 + e]; lb[e] = 1.f / (1.f + __expf(a0 - a1)); } }
    f32x16 S[2];
    float* Sp = Sloc + (size_t)unit * 16384 + 32 * vq + r;
#pragma unroll
    for (int dd = 0; dd < 2; ++dd)
#pragma unroll
        for (int i = 0; i < 16; ++i) S[dd][i] = OUT ? Sp[(32 * (2 * tr + dd) + crow16(i, hf)) * 128] : 0.f;
    float gsum = 0.f;
    float ng16[16];
#pragma unroll
    for (int e = 0; e < 16; ++e) ng16[e] = OUT ? normg[c16 + e] : 0.f;
    v4u nf8[2], ni8[2], nq8[2] = {{0u, 0u, 0u, 0u}, {0u, 0u, 0u, 0u}}, ng8[2] = {{0u, 0u, 0u, 0u}, {0u, 0u, 0u, 0u}};
#define HG_RAWLOAD(t0_) do { const bf16* row_ = h + ((t0_) + stok) * NC_H + hh * 128 + c16; nf8[0] = *(const v4u*)(row_ + 768); nf8[1] = *(const v4u*)(row_ + 776); ni8[0] = *(const v4u*)(row_ + 1536); ni8[1] = *(const v4u*)(row_ + 1544); \
        if (OUT) { nq8[0] = *(const v4u*)row_; nq8[1] = *(const v4u*)(row_ + 8); ng8[0] = *(const v4u*)(row_ + 2304); ng8[1] = *(const v4u*)(row_ + 2312); } } while (0)
    HG_RAWLOAD((size_t)b * SEQ + seg * HSEG);
    for (int ch = 0; ch < HSEG / 64; ++ch) {
        const size_t t0 = (size_t)b * SEQ + seg * HSEG + ch * 64;
        float fg[16], qv[16]; v4u i8[2], g8[2];
        { const v4u f8[2] = {nf8[0], nf8[1]}; i8[0] = ni8[0]; i8[1] = ni8[1]; const v4u q8[2] = {nq8[0], nq8[1]}; g8[0] = ng8[0]; g8[1] = ng8[1];
#pragma unroll
          for (int w = 0; w < 8; ++w) { const unsigned fw = f8[w >> 2][w & 3]; const float f0 = bflo(fw), f1 = bfhi(fw);
              fg[2 * w] = lb[2 * w] + (1.f - lb[2 * w]) * sigmoidf_(f0); fg[2 * w + 1] = lb[2 * w + 1] + (1.f - lb[2 * w + 1]) * sigmoidf_(f1);
              if (OUT) { const unsigned qw = q8[w >> 2][w & 3]; const float q0 = bflo(qw), q1 = bfhi(qw); qv[2 * w] = q0 * sigmoidf_(q0); qv[2 * w + 1] = q1 * sigmoidf_(q1); } else { qv[2 * w] = 0.f; qv[2 * w + 1] = 0.f; } }
#pragma unroll
          for (int e4 = 0; e4 < 4; ++e4) { f32x4 lg; lg.x = __builtin_amdgcn_logf(fg[4 * e4]); lg.y = __builtin_amdgcn_logf(fg[4 * e4 + 1]); lg.z = __builtin_amdgcn_logf(fg[4 * e4 + 2]); lg.w = __builtin_amdgcn_logf(fg[4 * e4 + 3]);
              *(LAS f32x4*)(G + stok * 128 + c16 + 4 * e4) = lg; } }
        __syncthreads();
        { float run = 0.f;
#pragma unroll
          for (int k = 0; k < 16; ++k) run += G[(16 * cpart + k) * 128 + cd];
          PART[cpart * 128 + cd] = run; }
        __syncthreads();
        { float run = 0.f;
#pragma unroll
          for (int pp = 0; pp < 3; ++pp) run += (pp < cpart) ? PART[pp * 128 + cd] : 0.f;
#pragma unroll
          for (int k = 0; k < 16; ++k) { run += G[(16 * cpart + k) * 128 + cd]; G[(16 * cpart + k) * 128 + cd] = run; }
          if (cpart == 1) GM[cd] = run;
          if (cpart == 3) { GE[cd] = run; gsum += run; } }
        __syncthreads();
        if (OUT) {
#pragma unroll
            for (int dd = 0; dd < 2; ++dd)
#pragma unroll
                for (int g4 = 0; g4 < 4; ++g4) { const int dbase = 32 * (2 * tr + dd) + 8 * g4 + 4 * hf; const f32x4 gm = *(const LAS f32x4*)(GM + dbase);
                    v2u w; w.x = cvtpk(S[dd][4 * g4] * __builtin_amdgcn_exp2f(gm.x), S[dd][4 * g4 + 1] * __builtin_amdgcn_exp2f(gm.y)); w.y = cvtpk(S[dd][4 * g4 + 2] * __builtin_amdgcn_exp2f(gm.z), S[dd][4 * g4 + 3] * __builtin_amdgcn_exp2f(gm.w));
                    *(LAS v2u*)(lds + HG_ST + (32 * vq + r) * 272 + dbase * 2) = w; }
        }
        { unsigned qt[8], kt[8];
#pragma unroll
          for (int e4 = 0; e4 < 4; ++e4) { const f32x4 gv = *(const LAS f32x4*)(G + stok * 128 + c16 + 4 * e4), gm = *(const LAS f32x4*)(GM + c16 + 4 * e4), ge = *(const LAS f32x4*)(GE + c16 + 4 * e4);
              float ke[4];
#pragma unroll
              for (int e = 0; e < 4; ++e) { const float kk = 1.f - fg[4 * e4 + e]; ke[e] = kk * __builtin_amdgcn_exp2f(ge[e] - gv[e]);
                  if (OUT) { const float a = qv[4 * e4 + e] * __builtin_amdgcn_exp2f(gv[e] - gm[e]), c = kk * __builtin_amdgcn_exp2f(gm[e] - gv[e]);
                      if (e & 1) { qt[2 * e4 + (e >> 1)] |= f2bf(a) << 16; kt[2 * e4 + (e >> 1)] |= f2bf(c) << 16; } else { qt[2 * e4 + (e >> 1)] = f2bf(a); kt[2 * e4 + (e >> 1)] = f2bf(c); } } }
#pragma unroll
              for (int e = 0; e < 4; ++e) { const int col = c16 + 4 * e4 + e;
                  *(LAS bf16*)(lds + HG_KE + col * 144 + sperm * 2) = (bf16)f2bf(ke[e]);
                  const unsigned vw = i8[e4 >> 1][(2 * e4 + (e >> 1)) & 3]; *(LAS bf16*)(lds + HG_VT + col * 144 + sperm * 2) = (bf16)((e & 1) ? (vw >> 16) : (vw & 0xffffu)); } }
          if (OUT) { *(LAS v4u*)(lds + HG_QT + stok * 272 + c16 * 2) = (v4u){qt[0], qt[1], qt[2], qt[3]}; *(LAS v4u*)(lds + HG_QT + stok * 272 + c16 * 2 + 16) = (v4u){qt[4], qt[5], qt[6], qt[7]};
                     *(LAS v4u*)(lds + HG_KT + stok * 272 + c16 * 2) = (v4u){kt[0], kt[1], kt[2], kt[3]}; *(LAS v4u*)(lds + HG_KT + stok * 272 + c16 * 2 + 16) = (v4u){kt[4], kt[5], kt[6], kt[7]}; } }
        __syncthreads();
        if (ch + 1 < HSEG / 64) HG_RAWLOAD(t0 + 64);
        if (OUT) {
            f32x16 X0, X1, O;
#pragma unroll
            for (int i = 0; i < 16; ++i) { X0[i] = 0.f; X1[i] = 0.f; O[i] = 0.f; }
            const LAS unsigned char* qtp = lds + HG_QT + (32 * tr + r) * 272 + hf * 16;
#pragma unroll
            for (int ks = 0; ks < 8; ++ks) { const s16x8 bq = *(const LAS s16x8*)(qtp + ks * 32);
                const s16x8 a0 = *(const LAS s16x8*)(lds + HG_KT + r * 272 + hf * 16 + ks * 32); X0 = __builtin_amdgcn_mfma_f32_32x32x16_bf16(a0, bq, X0, 0, 0, 0);
                if (tr == 1) { const s16x8 a1 = *(const LAS s16x8*)(lds + HG_KT + (32 + r) * 272 + hf * 16 + ks * 32); X1 = __builtin_amdgcn_mfma_f32_32x32x16_bf16(a1, bq, X1, 0, 0, 0); } }
#pragma unroll
            for (int i = 0; i < 16; ++i) { const bool keep = crow16(i, hf) <= r; if (tr == 0) X0[i] = keep ? X0[i] : 0.f; else X1[i] = keep ? X1[i] : 0.f; }
            const LAS unsigned char* vtp = lds + HG_VT + (32 * vq + r) * 144 + hf * 16;
#pragma unroll
            for (int s2 = 0; s2 < 2; ++s2) { v4u pw; pw.x = cvtpk(X0[8 * s2], X0[8 * s2 + 1]); pw.y = cvtpk(X0[8 * s2 + 2], X0[8 * s2 + 3]); pw.z = cvtpk(X0[8 * s2 + 4], X0[8 * s2 + 5]); pw.w = cvtpk(X0[8 * s2 + 6], X0[8 * s2 + 7]);
                const s16x8 bv = *(const LAS s16x8*)(vtp + (16 * s2) * 2); O = __builtin_amdgcn_mfma_f32_32x32x16_bf16(__builtin_bit_cast(s16x8, pw), bv, O, 0, 0, 0); }
            if (tr == 1) {
#pragma unroll
                for (int s2 = 0; s2 < 2; ++s2) { v4u pw; pw.x = cvtpk(X1[8 * s2], X1[8 * s2 + 1]); pw.y = cvtpk(X1[8 * s2 + 2], X1[8 * s2 + 3]); pw.z = cvtpk(X1[8 * s2 + 4], X1[8 * s2 + 5]); pw.w = cvtpk(X1[8 * s2 + 6], X1[8 * s2 + 7]);
                    const s16x8 bv = *(const LAS s16x8*)(vtp + (32 + 16 * s2) * 2); O = __builtin_amdgcn_mfma_f32_32x32x16_bf16(__builtin_bit_cast(s16x8, pw), bv, O, 0, 0, 0); } }
            const LAS unsigned char* stp = lds + HG_ST + (32 * vq + r) * 272 + hf * 16;
#pragma unroll
            for (int ks = 0; ks < 8; ++ks) { const s16x8 aq = *(const LAS s16x8*)(qtp + ks * 32), bs = *(const LAS s16x8*)(stp + ks * 32); O = __builtin_amdgcn_mfma_f32_32x32x16_bf16(aq, bs, O, 0, 0, 0); }
#pragma unroll
            for (int i = 0; i < 16; ++i) G[(32 * tr + crow16(i, hf)) * 128 + 32 * vq + r] = O[i];
        }
#pragma unroll
        for (int dd = 0; dd < 2; ++dd) { const int dr = 2 * tr + dd;
#pragma unroll
            for (int g4 = 0; g4 < 4; ++g4) { const f32x4 ge = *(const LAS f32x4*)(GE + 32 * dr + 8 * g4 + 4 * hf);
                S[dd][4 * g4] *= __builtin_amdgcn_exp2f(ge.x); S[dd][4 * g4 + 1] *= __builtin_amdgcn_exp2f(ge.y); S[dd][4 * g4 + 2] *= __builtin_amdgcn_exp2f(ge.z); S[dd][4 * g4 + 3] *= __builtin_amdgcn_exp2f(ge.w); }
#pragma unroll
            for (int ks = 0; ks < 4; ++ks) { const s16x8 a = *(const LAS s16x8*)(lds + HG_KE + (32 * dr + r) * 144 + hf * 16 + ks * 32), bv = *(const LAS s16x8*)(lds + HG_VT + (32 * vq + r) * 144 + hf * 16 + ks * 32);
                S[dd] = __builtin_amdgcn_mfma_f32_32x32x16_bf16(a, bv, S[dd], 0, 0, 0); } }
        __syncthreads();
        if (OUT) {
            float ov[16]; float ss = 0.f;
#pragma unroll
            for (int e4 = 0; e4 < 4; ++e4) { const f32x4 o4 = *(const LAS f32x4*)(G + stok * 128 + c16 + 4 * e4); ov[4 * e4] = o4.x; ov[4 * e4 + 1] = o4.y; ov[4 * e4 + 2] = o4.z; ov[4 * e4 + 3] = o4.w;
                ss += (o4.x * o4.x + o4.y * o4.y) + (o4.z * o4.z + o4.w * o4.w); }
            ss += xorf<1>(ss); ss += xorf<2>(ss); ss += xorf<4>(ss);
            const float rr = 1.f / sqrtf(ss * (1.f / 128.f) + 1e-6f);
            unsigned ow[8];
#pragma unroll
            for (int w = 0; w < 8; ++w) { const unsigned gw_ = g8[w >> 2][w & 3]; ow[w] = cvtpk(ov[2 * w] * rr * ng16[2 * w] * sigmoidf_(bflo(gw_)), ov[2 * w + 1] * rr * ng16[2 * w + 1] * sigmoidf_(bfhi(gw_))); }
            bf16* mrow = mix + (t0 + stok) * 1024 + hh * 128 + c16;
            *(v4u*)mrow = (v4u){ow[0], ow[1], ow[2], ow[3]}; *(v4u*)(mrow + 8) = (v4u){ow[4], ow[5], ow[6], ow[7]};
            __syncthreads();
        }
    }
#undef HG_RAWLOAD
    if (!OUT) {
#pragma unroll
        for (int dd = 0; dd < 2; ++dd)
#pragma unroll
            for (int i = 0; i < 16; ++i) Sp[(32 * (2 * tr + dd) + crow16(i, hf)) * 128] = S[dd][i];
        if (cpart == 3) Dseg[(size_t)unit * 128 + cd] = __builtin_amdgcn_exp2f(gsum);
    }
}
__device__ __forceinline__ void hgrn_scan(float* Sloc, const float* Dseg, size_t gtid, size_t gthreads) {
    for (size_t idx = gtid; idx < (size_t)NBATCH * HG_H * 16384; idx += gthreads) { const int bh = (int)(idx >> 14), e = (int)(idx & 16383), d = e >> 7; float cur = 0.f;
        float* __restrict__ sp = Sloc + (size_t)bh * HNSEG * 16384 + e; const float* __restrict__ dp = Dseg + (size_t)bh * HNSEG * 128 + d;
        for (int s0 = 0; s0 < HNSEG; s0 += 16) { float tv[16], dv[16];
#pragma unroll
            for (int k = 0; k < 16; ++k) { tv[k] = sp[(size_t)(s0 + k) * 16384]; dv[k] = dp[(s0 + k) * 128]; }
#pragma unroll
            for (int k = 0; k < 16; ++k) { sp[(size_t)(s0 + k) * 16384] = cur; cur = dv[k] * cur + tv[k]; } } }
}

template <bool MASK>
__device__ __forceinline__ void attn4(const LAS unsigned* Ks, const LAS bf16* Vs, const LAS float* qst, LAS float* pb, int lane, const int (&tq)[4], int kbase, float slope,
                                      float (&mo)[4], float (&lo)[4], float (&oo)[4]) {
    float sc[4][4];
#pragma unroll
    for (int a = 0; a < 4; ++a)
#pragma unroll
        for (int c = 0; c < 4; ++c) sc[a][c] = 0.f;
#pragma unroll 4
    for (int dd = 0; dd < 32; ++dd) {
        f32x2 qv[4];
#pragma unroll
        for (int qi = 0; qi < 4; ++qi) qv[qi] = *(const LAS f32x2*)(qst + qi * 64 + 2 * dd);
#pragma unroll
        for (int kk = 0; kk < 4; ++kk) { const unsigned kw = Ks[(lane + 64 * kk) * 33 + dd]; const float k0 = bflo(kw), k1 = bfhi(kw);
#pragma unroll
            for (int qi = 0; qi < 4; ++qi) sc[qi][kk] += qv[qi].x * k0 + qv[qi].y * k1; }
    }
#pragma unroll
    for (int qi = 0; qi < 4; ++qi) { float mx = -INFINITY;
#pragma unroll
        for (int kk = 0; kk < 4; ++kk) { const int pos = kbase + lane + 64 * kk; float lg = sc[qi][kk] * 0.125f - slope * (float)(tq[qi] - pos); if (MASK && pos > tq[qi]) lg = -INFINITY; sc[qi][kk] = lg; mx = fmaxf(mx, lg); }
        mx = wave_max(mx); float s = 0.f;
#pragma unroll
        for (int kk = 0; kk < 4; ++kk) { const float p = __builtin_amdgcn_exp2f((sc[qi][kk] - mx) * 1.4426950408889634f); pb[qi * 256 + lane + 64 * kk] = p; s += p; }
        lo[qi] = wave_sum(s); mo[qi] = mx; }
    float o[4] = {0.f, 0.f, 0.f, 0.f};
#pragma unroll 4
    for (int k4 = 0; k4 < 64; ++k4) { f32x4 p4[4];
#pragma unroll
        for (int qi = 0; qi < 4; ++qi) p4[qi] = *(const LAS f32x4*)(pb + qi * 256 + 4 * k4);
#pragma unroll
        for (int jj = 0; jj < 4; ++jj) { const float vv = bf2f(Vs[(4 * k4 + jj) * 64 + lane]);
#pragma unroll
            for (int qi = 0; qi < 4; ++qi) o[qi] += p4[qi][jj] * vv; } }
#pragma unroll
    for (int qi = 0; qi < 4; ++qi) oo[qi] = o[qi];
}
constexpr int AT_KS = 0, AT_VS = 33792, AT_WV = 66560, AT_WVB = 5120;

__device__ __forceinline__ void memattn_unit(LAS unsigned char* lds, const bf16* h, int NC, int qoff, const bf16* kv, bf16* mix, int unit, int tid, int wave, int lane) {
    const int chunk = unit & 31, bm = unit >> 5, mh = bm & 3, b = bm >> 2;
    LAS unsigned* Ks = (LAS unsigned*)(lds + AT_KS); LAS unsigned* Vs32 = (LAS unsigned*)(lds + AT_VS);
    LAS float* qst = (LAS float*)(lds + AT_WV + wave * AT_WVB); LAS float* pb = qst + 256;
    for (int i = 0; i < 16; ++i) { const int idx = tid + 512 * i, r = idx >> 5, dd = idx & 31; const unsigned* src = (const unsigned*)(kv + (size_t)(b * 256 + r) * 512 + mh * 64);
        Ks[r * 33 + dd] = src[dd]; Vs32[r * 32 + dd] = src[128 + dd]; }
    __syncthreads();
    for (int qd = 0; qd < 16; ++qd) { const size_t tg = (size_t)b * SEQ + chunk * 512 + wave * 64 + qd * 4;
#pragma unroll
        for (int qi = 0; qi < 4; ++qi) qst[qi * 64 + lane] = bf2f(h[(tg + qi) * NC + qoff + mh * 64 + lane]);
        const int tq[4] = {0, 0, 0, 0}; float m[4], l[4], o[4];
        attn4<false>(Ks, (const LAS bf16*)Vs32, qst, pb, lane, tq, 0, 0.f, m, l, o);
#pragma unroll
        for (int qi = 0; qi < 4; ++qi) mix[(tg + qi) * 1024 + MIXW + mh * 64 + lane] = (bf16)f2bf(o[qi] / l[qi]); }
    __syncthreads();
}

constexpr int AT2_K = 0, AT2_KROW = 176, AT2_V = 256 * AT2_KROW, AT2_VROW = 528, AT2_SCR = AT2_V + 64 * AT2_VROW, AT2_SCRW = 4864;
__device__ __forceinline__ void stage_kv_images(LAS unsigned char* lds, const bf16* kp, const bf16* vp, size_t row_stride, int tid) {
    v4u kx[4], vx[4];
#pragma unroll
    for (int i = 0; i < 4; ++i) { const int idx = tid + 512 * i, key = idx >> 3, c = idx & 7; kx[i] = *(const v4u*)(kp + (size_t)key * row_stride + 8 * c); vx[i] = *(const v4u*)(vp + (size_t)key * row_stride + 8 * c); }
    __builtin_amdgcn_sched_barrier(0);
#pragma unroll
    for (int i = 0; i < 4; ++i) { const int idx = tid + 512 * i, key = idx >> 3, c = idx & 7;
        *(LAS v4u*)(lds + AT2_K + key * AT2_KROW + c * 16) = kx[i];
        const int pos = (key & ~15) | (key & 3) | ((key & 4) << 1) | ((key & 8) >> 1);
        LAS bf16* vt = (LAS bf16*)(lds + AT2_V) + pos;
#pragma unroll
        for (int w = 0; w < 4; ++w) { vt[(8 * c + 2 * w) * (AT2_VROW / 2)] = (bf16)(vx[i][w] & 0xffffu); vt[(8 * c + 2 * w + 1) * (AT2_VROW / 2)] = (bf16)(vx[i][w] >> 16); } }
    if (tid < 256) { const unsigned pb = f2bf((float)tid); const v4u e0 = {pb | (pb << 16), 0u, 0u, 0u}, z = {0u, 0u, 0u, 0u};
        *(LAS v4u*)(lds + AT2_K + tid * AT2_KROW + 128) = e0; *(LAS v4u*)(lds + AT2_K + tid * AT2_KROW + 144) = z; }
}
template <bool MASK>
__device__ __forceinline__ void attn_tile32(const LAS unsigned char* lds, const s16x8 (&qf)[4], int lane, float dist0, unsigned qx, bool own, f32x16 (&o)[2], float& mrow, float& lrow) {
    const int r = lane & 31, hf = lane >> 5;
    const v4u qxv = {qx, 0u, 0u, 0u}; const s16x8 qe = __builtin_bit_cast(s16x8, qxv);
    f32x16 acc[8];
    const LAS unsigned char* kb = lds + AT2_K + r * AT2_KROW + hf * 16;
    constexpr int NKS = MASK ? 5 : 4;
    s16x8 kf[NKS];
#pragma unroll
    for (int s = 0; s < NKS; ++s) kf[s] = *(const LAS s16x8*)(kb + s * 32);
#pragma unroll
    for (int kt = 0; kt < 8; ++kt) {
#pragma unroll
        for (int i = 0; i < 16; ++i) acc[kt][i] = 0.f;
#pragma unroll
        for (int s = 0; s < NKS; ++s) { acc[kt] = __builtin_amdgcn_mfma_f32_32x32x16_bf16(kf[s], s < 4 ? qf[s < 4 ? s : 0] : qe, acc[kt], 0, 0, 0);
            if (kt + 1 < 8) kf[s] = *(const LAS s16x8*)(kb + (kt + 1) * 32 * AT2_KROW + s * 32); }
        __builtin_amdgcn_sched_barrier(0); }
    float mx = -INFINITY;
    if (MASK && own) { const float base2 = dist0 - 4.f * (float)hf;
#pragma unroll
        for (int kt = 0; kt < 8; ++kt)
#pragma unroll
            for (int i = 0; i < 16; ++i) { const float dist = base2 - (float)(32 * kt + (i & 3) + 8 * (i >> 2)); const float lg = dist < 0.f ? -INFINITY : acc[kt][i]; acc[kt][i] = lg; mx = fmaxf(mx, lg); }
    } else {
#pragma unroll
        for (int kt = 0; kt < 8; ++kt)
#pragma unroll
            for (int i = 0; i < 16; ++i) mx = fmaxf(mx, acc[kt][i]);
    }
    mx = fmaxf(mx, xor32f(mx, lane));
    float sum = 0.f;
#pragma unroll
    for (int i = 0; i < 16; ++i) { o[0][i] = 0.f; o[1][i] = 0.f; }
    const LAS unsigned char* vb = lds + AT2_V + r * AT2_VROW + hf * 16;
    s16x8 vf[4];
#pragma unroll
    for (int s2 = 0; s2 < 2; ++s2)
#pragma unroll
        for (int dt = 0; dt < 2; ++dt) vf[2 * s2 + dt] = *(const LAS s16x8*)(vb + dt * 32 * AT2_VROW + (16 * s2) * 2);
#pragma unroll
    for (int kt = 0; kt < 8; ++kt) {
#pragma unroll
        for (int i = 0; i < 16; ++i) { const float p = __builtin_amdgcn_exp2f(acc[kt][i] - mx); sum += p; acc[kt][i] = p; }
#pragma unroll
        for (int s2 = 0; s2 < 2; ++s2) { v4u pw; pw.x = cvtpk(acc[kt][8 * s2], acc[kt][8 * s2 + 1]); pw.y = cvtpk(acc[kt][8 * s2 + 2], acc[kt][8 * s2 + 3]);
            pw.z = cvtpk(acc[kt][8 * s2 + 4], acc[kt][8 * s2 + 5]); pw.w = cvtpk(acc[kt][8 * s2 + 6], acc[kt][8 * s2 + 7]); const s16x8 pf = __builtin_bit_cast(s16x8, pw);
#pragma unroll
            for (int dt = 0; dt < 2; ++dt) { o[dt] = __builtin_amdgcn_mfma_f32_32x32x16_bf16(vf[2 * s2 + dt], pf, o[dt], 0, 0, 0);
                if (kt + 1 < 8) vf[2 * s2 + dt] = *(const LAS s16x8*)(vb + dt * 32 * AT2_VROW + (32 * (kt + 1) + 16 * s2) * 2); } }
        __builtin_amdgcn_sched_barrier(0); }
    sum += xor32f(sum, lane);
    mrow = mx; lrow = sum;
}
__device__ __forceinline__ void memattn_unit2(LAS unsigned char* lds, const bf16* h, int NC, int qoff, const bf16* kv  , bf16* mix, int unit, int tid, int wave, int lane) {
    const int chunk = unit & 63, bm = unit >> 6, mh = bm & 3, b = bm >> 2, r = lane & 31, hf = lane >> 5;
    const bf16* kvrow0 = kv + (size_t)(b * 256) * 2048 + mh * 64;
    stage_kv_images(lds, kvrow0, kvrow0 + 256, 2048, tid);
    __syncthreads();
    { const size_t tg = (size_t)b * SEQ + chunk * 256 + wave * 32 + r;
        f32x16 o[2]; float m2, l; s16x8 qf[4];
#pragma unroll
        for (int s = 0; s < 4; ++s) qf[s] = *(const s16x8*)(h + tg * NC + qoff + mh * 64 + 16 * s + 8 * hf);
        attn_tile32<false>(lds, qf, lane, 0.f, 0u, false, o, m2, l);
        const float inv = 1.f / l; bf16* mp = mix + tg * 1024 + MIXW + mh * 64 + 4 * hf;
#pragma unroll
        for (int dt = 0; dt < 2; ++dt)
#pragma unroll
            for (int g = 0; g < 4; ++g) { v2u w; w.x = cvtpk(o[dt][4 * g] * inv, o[dt][4 * g + 1] * inv); w.y = cvtpk(o[dt][4 * g + 2] * inv, o[dt][4 * g + 3] * inv); *(v2u*)(mp + 32 * dt + 8 * g) = w; } }
    __syncthreads();
}
__device__ __forceinline__ void kmean_unit(LAS unsigned char* lds, const bf16* h, float* kmean, int unit, int tid) {
    const int n = unit & 63, bh = unit >> 6, hh = bh % MB_H, b = bh / MB_H, d = tid & 63, part = tid >> 6;
    LAS float* red = (LAS float*)lds;
    float s = 0.f; const bf16* p = h + ((size_t)b * SEQ + n * 256 + part * 32) * NC_M + 768 + hh * 64 + d;
    for (int i = 0; i < 32; ++i) s += bf2f(p[(size_t)i * NC_M]);
    red[part * 64 + d] = s; __syncthreads();
    if (tid < 64) { float a = 0.f; for (int pp = 0; pp < 8; ++pp) a += red[pp * 64 + tid]; kmean[((size_t)bh * 64 + n) * 64 + tid] = a * (1.f / 256.f); }
    __syncthreads();
}
__device__ __forceinline__ void moba_gate_unit(LAS unsigned char* lds, const bf16* h, const float* kmean, unsigned* gcount, int* selinfo, unsigned* list, int unit, int tid) {
    const int c = unit & 63, bh = unit >> 6, hh = bh % MB_H, b = bh / MB_H;
    LAS float* km = (LAS float*)lds; LAS int* hist = (LAS int*)(lds + 16384); LAS int* base = hist + 64;
    for (int i = tid; i < 4096; i += NTHR) km[i] = kmean[(size_t)bh * 4096 + i];
    if (tid < 64) hist[tid] = 0;
    __syncthreads();
    int s0 = 0, s1 = 0, s2 = 0, r0 = 0, r1 = 0, r2 = 0, ns = 0; const int t = c * 256 + tid;
    if (tid < 256) {
        float q[64]; const v4u* qp = (const v4u*)(h + ((size_t)b * SEQ + t) * NC_M + hh * 64);
#pragma unroll
        for (int w = 0; w < 8; ++w) { const v4u x = qp[w]; q[8 * w] = bflo(x.x); q[8 * w + 1] = bfhi(x.x); q[8 * w + 2] = bflo(x.y); q[8 * w + 3] = bfhi(x.y); q[8 * w + 4] = bflo(x.z); q[8 * w + 5] = bfhi(x.z); q[8 * w + 6] = bflo(x.w); q[8 * w + 7] = bfhi(x.w); }
        float v0 = -INFINITY, v1 = -INFINITY, v2 = -INFINITY;
        for (int n = 0; n < c; ++n) { float g = 0.f;
#pragma unroll
            for (int d4 = 0; d4 < 16; ++d4) { const f32x4 k4 = *(const LAS f32x4*)(km + n * 64 + 4 * d4); g += q[4 * d4] * k4.x + q[4 * d4 + 1] * k4.y + q[4 * d4 + 2] * k4.z + q[4 * d4 + 3] * k4.w; }
            if (g > v0) { v2 = v1; s2 = s1; v1 = v0; s1 = s0; v0 = g; s0 = n; } else if (g > v1) { v2 = v1; s2 = s1; v1 = g; s1 = n; } else if (g > v2) { v2 = g; s2 = n; } }
        ns = c < 3 ? c : 3;
        if (ns > 0) r0 = __hip_atomic_fetch_add(hist + s0, 1, __ATOMIC_RELAXED, __HIP_MEMORY_SCOPE_WORKGROUP);
        if (ns > 1) r1 = __hip_atomic_fetch_add(hist + s1, 1, __ATOMIC_RELAXED, __HIP_MEMORY_SCOPE_WORKGROUP);
        if (ns > 2) r2 = __hip_atomic_fetch_add(hist + s2, 1, __ATOMIC_RELAXED, __HIP_MEMORY_SCOPE_WORKGROUP);
        selinfo[((size_t)b * SEQ + t) * MB_H + hh] = ns;
    }
    __syncthreads();
    if (tid < 64) { const int hc = hist[tid]; if (hc > 0) base[tid] = (int)__hip_atomic_fetch_add(gcount + bh * 64 + tid, (unsigned)hc, __ATOMIC_RELAXED, __HIP_MEMORY_SCOPE_AGENT); }
    __syncthreads();
    if (tid < 256) { unsigned* lp = list + ((size_t)bh * 64 << 14);
        if (ns > 0) lp[((size_t)s0 << 14) + base[s0] + r0] = (unsigned)t;
        if (ns > 1) lp[((size_t)s1 << 14) + base[s1] + r1] = (unsigned)t | (1u << 14);
        if (ns > 2) lp[((size_t)s2 << 14) + base[s2] + r2] = (unsigned)t | (2u << 14); }
    __syncthreads();
}
__device__ __forceinline__ void moba_attn_item(LAS unsigned char* lds, const bf16* h, const unsigned* gcount, const unsigned* list, float* po, float* pml, int item, int tid, int wave, int lane) {
    const int n = item / 24, bh = item - n * 24, hh = bh % MB_H, b = bh / MB_H;
    LAS unsigned* Ks = (LAS unsigned*)(lds + AT_KS); LAS unsigned* Vs32 = (LAS unsigned*)(lds + AT_VS);
    LAS float* qst = (LAS float*)(lds + AT_WV + wave * AT_WVB); LAS float* pb = qst + 256;
    for (int i = 0; i < 16; ++i) { const int idx = tid + 512 * i, r = idx >> 5, dd = idx & 31; const unsigned* src = (const unsigned*)(h + ((size_t)b * SEQ + n * 256 + r) * NC_M + hh * 64);
        Ks[r * 33 + dd] = src[384 + dd]; Vs32[r * 32 + dd] = src[768 + dd]; }
    __syncthreads();
    const int cnt = (int)gcount[bh * 64 + n], total = 256 + cnt, nquads = (total + 3) >> 2;
    const float slope = hh < 8 ? ldexpf(1.0f, -(hh + 1)) : ldexpf(0.70710678118654752f, -(hh - 8));
    const unsigned* lp = list + (((size_t)bh * 64 + n) << 14);
    for (int quad = wave; quad < nquads; quad += 8) {
        int tq[4], slot[4];
#pragma unroll
        for (int qi = 0; qi < 4; ++qi) { int idx = quad * 4 + qi; idx = idx < total ? idx : total - 1;
            if (idx < 256) { tq[qi] = n * 256 + idx; slot[qi] = 3; } else { const unsigned e = lp[idx - 256]; tq[qi] = (int)(e & 16383u); slot[qi] = (int)(e >> 14); } }
#pragma unroll
        for (int qi = 0; qi < 4; ++qi) qst[qi * 64 + lane] = bf2f(h[((size_t)b * SEQ + tq[qi]) * NC_M + hh * 64 + lane]);
        float m[4], l[4], o[4];
        attn4<true>(Ks, (const LAS bf16*)Vs32, qst, pb, lane, tq, n * 256, slope, m, l, o);
#pragma unroll
        for (int qi = 0; qi < 4; ++qi) if (quad * 4 + qi < total) { const size_t pi = (((size_t)b * SEQ + tq[qi]) * MB_H + hh) * 4 + slot[qi];
            po[pi * 64 + lane] = o[qi]; if (lane == 0) { pml[pi * 2] = m[qi]; pml[pi * 2 + 1] = l[qi]; } }
    }
    __syncthreads();
}

__device__ __forceinline__ void moba_attn_item2(LAS unsigned char* lds, const bf16* h, const unsigned* gcount, const unsigned* list, bf16* po, float* pml, int item, int tid, int wave, int lane) {
    const int n = item / 24, bh = item - n * 24, hh = bh % MB_H, b = bh / MB_H, r = lane & 31, hf = lane >> 5;
    const bf16* hrow0 = h + ((size_t)b * SEQ + n * 256) * NC_M + hh * 64;
    stage_kv_images(lds, hrow0 + 768, hrow0 + 1536, NC_M, tid);
    __syncthreads();
    const int cnt = (int)gcount[bh * 64 + n], total = 256 + cnt, ntiles = (total + 31) >> 5;
    const float slope2 = (hh < 8 ? ldexpf(1.0f, -(hh + 1)) : ldexpf(0.70710678118654752f, -(hh - 8))) * 1.4426950408889634f;
    const unsigned shi = f2bf(slope2), slo = f2bf(slope2 - __builtin_bit_cast(float, shi << 16)); const unsigned qx = hf == 0 ? (shi | (slo << 16)) : 0u;
    const unsigned* lp = list + (((size_t)bh * 64 + n) << 14);
    const bf16* hq = h + (size_t)b * SEQ * NC_M + hh * 64 + 8 * hf;
#pragma unroll 1
    for (int tile = wave; tile < ntiles; tile += NWAVES) {
        int idx = tile * 32 + r; const bool valid = idx < total; idx = valid ? idx : total - 1;
        int tq, slot; if (idx < 256) { tq = n * 256 + idx; slot = 3; } else { const unsigned e = lp[idx - 256]; tq = (int)(e & 16383u); slot = (int)(e >> 14); }
        s16x8 qf[4]; { const bf16* qp = hq + (size_t)tq * NC_M;
#pragma unroll
            for (int s = 0; s < 4; ++s) qf[s] = *(const s16x8*)(qp + 16 * s); }
        f32x16 o[2]; float m2, l; const float dist0 = (float)(tq - n * 256);
        attn_tile32<true>(lds, qf, lane, dist0, qx, tile < 8, o, m2, l);
        { LAS unsigned char* sw = lds + AT2_SCR + wave * AT2_SCRW; const int pi = valid ? (int)((((size_t)b * SEQ + tq) * MB_H + hh) * 4 + slot) : -1;
#pragma unroll
          for (int dt = 0; dt < 2; ++dt)
#pragma unroll
              for (int g = 0; g < 4; ++g) { v2u w; w.x = cvtpk(o[dt][4 * g], o[dt][4 * g + 1]); w.y = cvtpk(o[dt][4 * g + 2], o[dt][4 * g + 3]); *(LAS v2u*)(sw + r * 144 + (32 * dt + 8 * g + 4 * hf) * 2) = w; }
          if (hf == 0) { *(LAS int*)(sw + 4608 + 4 * r) = pi; if (valid) { pml[(size_t)pi * 2] = m2 - slope2 * dist0; pml[(size_t)pi * 2 + 1] = l; } }
#pragma unroll
          for (int it = 0; it < 4; ++it) { const int q = 8 * it + (lane >> 3), c = lane & 7; const int pq = *(const LAS int*)(sw + 4608 + 4 * q); const v4u row = *(const LAS v4u*)(sw + q * 144 + c * 16);
              if (pq >= 0) *(v4u*)(po + (size_t)pq * 64 + c * 8) = row; } }
    }
    __syncthreads();
}
__device__ __forceinline__ void moba_combine(const bf16* __restrict__ po, const float* __restrict__ pml, const int* __restrict__ selinfo, bf16* __restrict__ mix, int gw, int ngw, int lane) {
    const int sub = lane >> 4, d4 = (lane & 15) * 4;
#pragma unroll 4
    for (int idx = gw * 4 + sub; idx < T * MB_H; idx += ngw * 4) { const int tg = idx / MB_H, hh = idx - tg * MB_H, ns = selinfo[idx]; const size_t p4 = (size_t)idx * 4;
        f32x2 ml[4]; f32x4 ov[4];
#pragma unroll
        for (int j = 0; j < 4; ++j) { ml[j] = ((const f32x2*)pml)[p4 + j]; const v2u ow = *(const v2u*)(po + (p4 + j) * 64 + d4); ov[j] = (f32x4){bflo(ow.x), bfhi(ow.x), bflo(ow.y), bfhi(ow.y)}; }
        float M = ml[3].x;
#pragma unroll
        for (int j = 0; j < 3; ++j) { const bool ok = j < ns; ml[j].x = ok ? ml[j].x : -INFINITY; ml[j].y = ok ? ml[j].y : 0.f; M = fmaxf(M, ml[j].x);
            ov[j].x = ok ? ov[j].x : 0.f; ov[j].y = ok ? ov[j].y : 0.f; ov[j].z = ok ? ov[j].z : 0.f; ov[j].w = ok ? ov[j].w : 0.f; }
        float den = 0.f; f32x4 num = {0.f, 0.f, 0.f, 0.f};
#pragma unroll
        for (int j = 0; j < 4; ++j) { const float w = __builtin_amdgcn_exp2f(ml[j].x - M); den += w * ml[j].y; num += ov[j] * w; }
        const float inv = 1.f / den; v2u o; o.x = pk2(num.x * inv, num.y * inv); o.y = pk2(num.z * inv, num.w * inv);
        *(v2u*)(mix + (size_t)tg * 1024 + hh * 64 + d4) = o; }
}

__device__ __forceinline__ void ln_row(f32x4 (&v)[4], const f32x4 (&gv)[4], const f32x4 (&bv)[4]) {
    float s = 0.f;
#pragma unroll
    for (int j = 0; j < 4; ++j) s += (v[j].x + v[j].y) + (v[j].z + v[j].w);
    const float mean = wave_sum(s) * (1.f / D); float s2 = 0.f;
#pragma unroll
    for (int j = 0; j < 4; ++j) { v[j] = v[j] - mean; s2 += (v[j].x * v[j].x + v[j].y * v[j].y) + (v[j].z * v[j].z + v[j].w * v[j].w); }
    const float rstd = 1.f / sqrtf(wave_sum(s2) * (1.f / D) + 1e-5f);
#pragma unroll
    for (int j = 0; j < 4; ++j) v[j] = v[j] * rstd * gv[j] + bv[j];
}
__device__ __forceinline__ void split_router_weights(const float* wr  , bf16* wrs  , size_t gtid, size_t gthreads) {
    for (size_t i = gtid; i < (size_t)DEPTH * D * NE; i += gthreads) { const int e = (int)(i & 31), d = (int)((i >> 5) & 1023), l = (int)(i >> 15);
        const float w = wr[i]; const unsigned hi = f2bf(w); const unsigned lo = f2bf(w - __builtin_bit_cast(float, hi << 16));
        wrs[(((size_t)l * 2 + 0) * NE + e) * D + d] = (bf16)hi; wrs[(((size_t)l * 2 + 1) * NE + e) * D + d] = (bf16)lo; }
}
constexpr int L1_XH = 0, L1_XL = 33024, L1_ROW = 2064, L1_PART = 66048, L1_HIST = 82432;
__device__ __forceinline__ void phase_ln1(LAS unsigned char* lds, const bf16* y, const float* g, const float* bb, const bf16* wrs  , const float* br,
                                          bf16* xbf, int* tok_e, int* tok_lr, float* tok_w, int* blk_cnt, int blk, int tid, int wave, int lane) {
    LAS float* part = (LAS float*)(lds + L1_PART);
    LAS int* hist = (LAS int*)(lds + L1_HIST);
    if (tid < 32) hist[tid] = 0;
    constexpr int TPB = T / GRID;
    const int e = lane & 31, m16 = lane & 15, quad = lane >> 4;
    s16x8 bw[4][2][2];
#pragma unroll
    for (int ks = 0; ks < 4; ++ks)
#pragma unroll
        for (int nt = 0; nt < 2; ++nt)
#pragma unroll
            for (int pp = 0; pp < 2; ++pp) bw[ks][nt][pp] = *(const s16x8*)(wrs + ((size_t)pp * NE + 16 * nt + m16) * D + wave * 128 + 32 * ks + 8 * quad);
    const float bre = br[e];
    f32x4 gv[4], bv[4];
#pragma unroll
    for (int j = 0; j < 4; ++j) { gv[j] = ((const f32x4*)g)[lane + 64 * j]; bv[j] = ((const f32x4*)bb)[lane + 64 * j]; }
    v2u xn[2][4], yn[2][4];
#pragma unroll
    for (int u = 0; u < 2; ++u) { const size_t t0 = (size_t)blk * TPB + 2 * wave + u; const v2u* xr = (const v2u*)(xbf + t0 * D) + lane; const v2u* yr = (const v2u*)(y + t0 * D) + lane;
#pragma unroll
        for (int j = 0; j < 4; ++j) { xn[u][j] = xr[64 * j]; yn[u][j] = yr[64 * j]; } }
    __syncthreads();
    for (int grp = 0; grp < TPB / 16; ++grp) { const size_t tg0 = (size_t)blk * TPB + grp * 16 + 2 * wave;
        f32x4 v[2][4];
#pragma unroll
        for (int u = 0; u < 2; ++u)
#pragma unroll
            for (int j = 0; j < 4; ++j) { const v2u xw = xn[u][j]; const v2u yw = yn[u][j];
                v[u][j].x = DN_ALPHA * bflo(xw.x) + bflo(yw.x); v[u][j].y = DN_ALPHA * bfhi(xw.x) + bfhi(yw.x); v[u][j].z = DN_ALPHA * bflo(xw.y) + bflo(yw.y); v[u][j].w = DN_ALPHA * bfhi(xw.y) + bfhi(yw.y); }
        if (grp + 1 < TPB / 16) {
#pragma unroll
            for (int u = 0; u < 2; ++u) { const v2u* xr = (const v2u*)(xbf + (tg0 + 16 + u) * D) + lane; const v2u* yr = (const v2u*)(y + (tg0 + 16 + u) * D) + lane;
#pragma unroll
                for (int j = 0; j < 4; ++j) { xn[u][j] = xr[64 * j]; yn[u][j] = yr[64 * j]; } } }
#pragma unroll
        for (int u = 0; u < 2; ++u) { ln_row(v[u], gv, bv);
            v2u* xb = (v2u*)(xbf + (tg0 + u) * D) + lane;
#pragma unroll
            for (int j = 0; j < 4; ++j) { v2u hw; hw.x = cvtpk(v[u][j].x, v[u][j].y); hw.y = cvtpk(v[u][j].z, v[u][j].w); xb[64 * j] = hw;
                v2u lw; lw.x = cvtpk(v[u][j].x - bflo(hw.x), v[u][j].y - bfhi(hw.x)); lw.y = cvtpk(v[u][j].z - bflo(hw.y), v[u][j].w - bfhi(hw.y));
                *(LAS v2u*)(lds + L1_XH + (2 * wave + u) * L1_ROW + (4 * lane + 256 * j) * 2) = hw; *(LAS v2u*)(lds + L1_XL + (2 * wave + u) * L1_ROW + (4 * lane + 256 * j) * 2) = lw; } }
        __syncthreads();
        { f32x4 acc[2] = {{0.f, 0.f, 0.f, 0.f}, {0.f, 0.f, 0.f, 0.f}};
#pragma unroll
          for (int ks = 0; ks < 4; ++ks) { const int off = m16 * L1_ROW + (wave * 128 + 32 * ks + 8 * quad) * 2;
              const s16x8 ah = *(const LAS s16x8*)(lds + L1_XH + off), al = *(const LAS s16x8*)(lds + L1_XL + off);
#pragma unroll
              for (int nt = 0; nt < 2; ++nt) { acc[nt] = __builtin_amdgcn_mfma_f32_16x16x32_bf16(ah, bw[ks][nt][0], acc[nt], 0, 0, 0); acc[nt] = __builtin_amdgcn_mfma_f32_16x16x32_bf16(ah, bw[ks][nt][1], acc[nt], 0, 0, 0);
                  acc[nt] = __builtin_amdgcn_mfma_f32_16x16x32_bf16(al, bw[ks][nt][0], acc[nt], 0, 0, 0); } }
#pragma unroll
          for (int nt = 0; nt < 2; ++nt)
#pragma unroll
              for (int jj = 0; jj < 4; ++jj) part[(wave * 16 + 4 * quad + jj) * 32 + 16 * nt + m16] = acc[nt][jj]; }
        __syncthreads();
#pragma unroll
        for (int u = 0; u < 2; ++u) { const size_t t = tg0 + u;
            float logit = bre;
#pragma unroll
            for (int w = 0; w < 8; ++w) logit += part[(w * 16 + 2 * wave + u) * 32 + e];
            int rank = 0;
#pragma unroll
            for (int q = 0; q < 32; ++q) { const float oq = __builtin_bit_cast(float, __builtin_amdgcn_readlane(__builtin_bit_cast(int, logit), q)); rank += (oq > logit || (oq == logit && q < e)) ? 1 : 0; }
            int se[4]; float sv[4];
#pragma unroll
            for (int k = 0; k < 4; ++k) { const unsigned long long mk = __ballot(rank == k && lane < 32); const int src = __builtin_ctzll(mk);
                se[k] = src; sv[k] = __builtin_bit_cast(float, __builtin_amdgcn_readlane(__builtin_bit_cast(int, logit), src)); }
            const float e1 = __expf(sv[1] - sv[0]), e2 = __expf(sv[2] - sv[0]), e3 = __expf(sv[3] - sv[0]), inv = 1.f / (1.f + e1 + e2 + e3);
            const float wk[4] = {inv, e1 * inv, e2 * inv, e3 * inv};
            if (lane == 0) {
#pragma unroll
                for (int k = 0; k < 4; ++k) { const int lr = __hip_atomic_fetch_add(hist + se[k], 1, __ATOMIC_RELAXED, __HIP_MEMORY_SCOPE_WORKGROUP);
                    tok_e[t * 4 + k] = se[k]; tok_lr[t * 4 + k] = lr; tok_w[t * 4 + k] = wk[k]; } } }
    }
    __syncthreads();
    if (tid < 32) blk_cnt[blk * 32 + tid] = hist[tid];
    __syncthreads();
}
__device__ __forceinline__ void phase_dispatch(LAS unsigned char* lds, const int* __restrict__ blk_cnt, const int* __restrict__ tok_e, const int* __restrict__ tok_lr, int* __restrict__ tok_row, int* __restrict__ tab,
                                               const bf16* __restrict__ xbf, bf16* __restrict__ xs, int blk, int tid, int wave, int lane) {
    LAS int* tot = (LAS int*)lds; LAS int* pre = tot + 32; LAS int* pst = pre + 32; LAS int* rows = pst + 64;
    if (tid < 32) { int s = 0, p = 0;
#pragma unroll 8
        for (int bb = 0; bb < GRID; ++bb) { const int c = blk_cnt[bb * 32 + tid]; p += (bb < blk) ? c : 0; s += c; } tot[tid] = s; pre[tid] = p; }
    __syncthreads();
    if (tid == 0) { int acc = 0; for (int e = 0; e < 32; ++e) { pst[e] = acc; acc += ((tot[e] + 255) >> 8) << 8; } pst[32] = acc; }
    __syncthreads();
    if (blk == 0 && tid < 33) tab[tid] = pst[tid] >> 8;
    constexpr int TPB = T / GRID;
    static_assert(TPB * 4 == NTHR, "one (token, k) pair per thread");
    { const size_t ti = (size_t)blk * TPB * 4 + tid; const int e = tok_e[ti]; const int r = pst[e] + pre[e] + tok_lr[ti]; tok_row[ti] = r; rows[tid] = r; }
    __syncthreads();
#pragma unroll 4
    for (int i = wave; i < TPB * 4; i += NWAVES) { const int r = rows[i];
        const v4u* src = (const v4u*)(xbf + ((size_t)blk * TPB + (i >> 2)) * D) + 2 * lane; const v4u a = src[0], b = src[1];
        v4u o; o.x = pk4_fp8(bflo(a.x), bfhi(a.x), bflo(a.y), bfhi(a.y)); o.y = pk4_fp8(bflo(a.z), bfhi(a.z), bflo(a.w), bfhi(a.w)); o.z = pk4_fp8(bflo(b.x), bfhi(b.x), bflo(b.y), bfhi(b.y)); o.w = pk4_fp8(bflo(b.z), bfhi(b.z), bflo(b.w), bfhi(b.w));
        ((v4u*)((unsigned char*)xs + (size_t)r * D))[lane] = o; }
    __syncthreads();
}
__device__ __forceinline__ f32x4 fp8x4_to_f32(unsigned w) {
    const f32x2 lo = __builtin_amdgcn_cvt_pk_f32_fp8((int)w, false), hi = __builtin_amdgcn_cvt_pk_f32_fp8((int)w, true); return (f32x4){lo.x, lo.y, hi.x, hi.y};
}
__device__ __forceinline__ void phase_ln2(const unsigned char* __restrict__ yrows, const int* __restrict__ tok_row, const float* __restrict__ tok_w, const float* __restrict__ g, const float* __restrict__ bb,
                                          float* __restrict__ xout, bf16* xbf, int gw, int ngw, int lane) {
    f32x4 gv[4], bv[4];
#pragma unroll
    for (int j = 0; j < 4; ++j) { gv[j] = ((const f32x4*)g)[lane + 64 * j]; bv[j] = ((const f32x4*)bb)[lane + 64 * j]; }
    constexpr int NTK = 2;
    static_assert(T % (NTK * GRID * NWAVES) == 0, "NTK tokens per wave per step");
    for (int t0 = gw; t0 < T; t0 += NTK * ngw) {
        f32x4 v[NTK][4];
#pragma unroll
        for (int u = 0; u < NTK; ++u) { const int t = t0 + u * ngw; int r[4]; float w[4];
#pragma unroll
            for (int k = 0; k < 4; ++k) { r[k] = tok_row[(size_t)t * 4 + k]; w[k] = tok_w[(size_t)t * 4 + k] * (1.f / 16.f); }
            const v2u* xr = (const v2u*)(xbf + (size_t)t * D) + lane;
#pragma unroll
            for (int j = 0; j < 4; ++j) { f32x4 f = {0.f, 0.f, 0.f, 0.f};
#pragma unroll
                for (int k = 0; k < 4; ++k) { const unsigned yw = ((const unsigned*)(yrows + (size_t)r[k] * D))[lane + 64 * j]; f += fp8x4_to_f32(yw) * w[k]; }
                const v2u xw = xr[64 * j]; v[u][j].x = DN_ALPHA * bflo(xw.x) + f.x; v[u][j].y = DN_ALPHA * bfhi(xw.x) + f.y; v[u][j].z = DN_ALPHA * bflo(xw.y) + f.z; v[u][j].w = DN_ALPHA * bfhi(xw.y) + f.w; } }
#pragma unroll
        for (int u = 0; u < NTK; ++u) { const int t = t0 + u * ngw;
            ln_row(v[u], gv, bv);
            if (xout) { f32x4* xo = (f32x4*)(xout + (size_t)t * D) + lane;
#pragma unroll
                for (int j = 0; j < 4; ++j) xo[64 * j] = v[u][j]; }
            else { v2u* xb = (v2u*)(xbf + (size_t)t * D) + lane;
#pragma unroll
                for (int j = 0; j < 4; ++j) { v2u ww; ww.x = pk2(v[u][j].x, v[u][j].y); ww.y = pk2(v[u][j].z, v[u][j].w); xb[64 * j] = ww; } } } }
}

struct Args { const float* in[20]; float* out; unsigned char* ws; int l_lo, l_hi, ph_lo, ph_hi; };
typedef const __attribute__((address_space(4))) Args* KArgsP;
#define KA_LOAD() ({ KArgsP p_ = (KArgsP)__builtin_amdgcn_kernarg_segment_ptr(); asm volatile("" : "+s"(p_)); p_; })
#ifndef PHMASK
#define PHMASK 0xFFFF
#endif
#ifndef REPEAT_MASK
#define REPEAT_MASK 0
#endif
#ifndef REPEAT_LMASK
#define REPEAT_LMASK 0xF
#endif
#define PH_BEGIN(k) _Pragma("unroll") for (int rep_ = 0; rep_ < ((((REPEAT_MASK >> (k)) & 1) && ((REPEAT_LMASK >> l) & 1)) ? 2 : 1); ++rep_) { if ((PHMASK >> (k)) & 1) { KArgsP ka = KA_LOAD(); unsigned char* ws = ka->ws; int tid = threadIdx.x; asm volatile("" : "+v"(tid)); \
    const int lane = tid & 63, wave = __builtin_amdgcn_readfirstlane(tid >> 6); int blk = blockIdx.x; asm volatile("" : "+s"(blk)); \
    const int gw = blk * NWAVES + wave; const size_t gtid = (size_t)blk * NTHR + tid; (void)lane; (void)gw; (void)gtid; (void)ws;
#if ONE_LAUNCH
#define PH_SEAM() do { XcdBarrier b_; b_.bar = (unsigned*)(KA_LOAD()->ws + WS_CTL) + CW_BAR; b_.x = xb_xcc_id(); b_.st = (volatile LAS unsigned*)(lds + MISC_OFF); xcd_barrier(b_); } while (0)
#else
#define PH_SEAM() do {} while (0)
#endif
#define PH_END() PH_SEAM(); } }
#define PH_END_NOSEAM() } }
#define WSP(type, off) ((type*)(ws + (off)))
constexpr int G = GRID, NGW = GRID * NWAVES; constexpr size_t GTHREADS = (size_t)GRID * NTHR;
template <int L> __device__ __forceinline__ void layer_phases(LAS unsigned char* lds) {
    constexpr int l = L; LAS int* tabL = (LAS int*)(lds + MISC_OFF + 256);

        const int j = l >> 1; const bool moba = (l & 1) != 0;
        const int NC = moba ? NC_M : NC_H, qoff = moba ? 2304 : 3072;

        if (l == 0) {
        PH_BEGIN(1)
            phase_weights((LAS float*)(lds + wave * 16384), gw, NGW, lane, ka->in[2], NC_H, ka->in[6], 4, ka->in[7], ka->in[12], ka->in[14], ka->in[16], WSP(bf16, WS_WIN), WSP(bf16, WS_WKV4), WSP(bf16, WS_WO), WSP(bf16, WS_WGU), WSP(bf16, WS_WD));
        PH_END()
        }
        PH_BEGIN(2)
            { pg8::Gemm g{WSP(bf16, WS_XBF), WSP(bf16, WS_WIN), T, NC, D, 0, 0}; pg8::StaticOrder S; S.init(T, NC, G, blk); pg8::EpiPlain E{WSP(bf16, WS_H), NC, moba ? 0x207u : 0x1000u, 0.125f * 1.4426950408889634f};
              pg8::gemm_phase<pg8::EpiPlain, pg8::StaticOrder, true, true>(lds, g, S, E); }
            if (l == 0) {
              pg8::Gemm g{WSP(bf16, WS_MEMBF), WSP(bf16, WS_WKV4), 512, 2048, D, 0, 0}; pg8::StaticOrder S; S.init(512, 2048, G, blk >= 128 ? blk - 128 : G); pg8::EpiPlain E{WSP(bf16, WS_KV4), 2048, 0u, 1.f};
              pg8::gemm_phase<pg8::EpiPlain, pg8::StaticOrder, true, true>(lds, g, S, E); }
        PH_END()
        if (!moba) {
            PH_BEGIN(3)
                for (int u = blk; u < NBATCH * HG_H * HNSEG; u += G) hgrn_mfma<false>(lds, WSP(bf16, WS_H), ka->in[3], j, ka->in[4] + j * 128, WSP(float, WS_SLOC), WSP(float, WS_DSEG), WSP(bf16, WS_MIX), u, tid, wave, lane);
                for (int u = blk; u < 512; u += G) memattn_unit2(lds, WSP(bf16, WS_H), NC, qoff, WSP(bf16, WS_KV4) + 512 * l, WSP(bf16, WS_MIX), u, tid, wave, lane);
            PH_END()
            PH_BEGIN(4)
                hgrn_scan(WSP(float, WS_SLOC), WSP(float, WS_DSEG), gtid, GTHREADS);
            PH_END()
            PH_BEGIN(5)
                for (int u = blk; u < NBATCH * HG_H * HNSEG; u += G) hgrn_mfma<true>(lds, WSP(bf16, WS_H), ka->in[3], j, ka->in[4] + j * 128, WSP(float, WS_SLOC), WSP(float, WS_DSEG), WSP(bf16, WS_MIX), u, tid, wave, lane);
            PH_END()
        } else {
            PH_BEGIN(3)
                for (int u = blk; u < 24 * MB_NB; u += G) kmean_unit(lds, WSP(bf16, WS_H), WSP(float, WS_KMEAN), u, tid);
                for (int u = blk; u < 512; u += G) memattn_unit2(lds, WSP(bf16, WS_H), NC, qoff, WSP(bf16, WS_KV4) + 512 * l, WSP(bf16, WS_MIX), u, tid, wave, lane);
            PH_END()
            PH_BEGIN(4)
                for (int u = blk; u < 24 * MB_NB; u += G) moba_gate_unit(lds, WSP(bf16, WS_H), WSP(float, WS_KMEAN), WSP(unsigned, WS_CTL) + CW_GCOUNT + j * 1536, WSP(int, WS_SELINFO), WSP(unsigned, WS_LIST), u, tid);
            PH_END()
            PH_BEGIN(5)
                { unsigned* qhead = WSP(unsigned, WS_CTL) + CW_GCOUNT + 2 * 1536 + 64 * j; LAS int* itl = (LAS int*)(lds + MISC_OFF + 512);
                  for (;;) { if (tid == 0) *itl = (int)__hip_atomic_fetch_add(qhead, 1u, __ATOMIC_RELAXED, __HIP_MEMORY_SCOPE_AGENT);
                      __syncthreads(); const int it = *itl; __syncthreads();
                      if (it >= 24 * MB_NB) break;
                      moba_attn_item2(lds, WSP(bf16, WS_H), WSP(unsigned, WS_CTL) + CW_GCOUNT + j * 1536, WSP(unsigned, WS_LIST), WSP(bf16, WS_PO), WSP(float, WS_PML), it, tid, wave, lane); } }
            PH_END()
            PH_BEGIN(6)
                moba_combine(WSP(bf16, WS_PO), WSP(float, WS_PML), WSP(int, WS_SELINFO), WSP(bf16, WS_MIX), gw, NGW, lane);
            PH_END()
        }
        PH_BEGIN(7)
            pg8::Gemm g{WSP(bf16, WS_MIX), WSP(bf16, WS_WO), T, D, D, 0, 0}; pg8::StaticOrder S; S.init(T, D, G, blk); pg8::EpiPlain E{WSP(bf16, WS_Y), D, 0u, 1.f};
            pg8::gemm_phase<pg8::EpiPlain, pg8::StaticOrder, true, true>(lds, g, S, E);
        PH_END()
        PH_BEGIN(8)
            phase_ln1(lds, WSP(bf16, WS_Y), ka->in[8] + l * D, ka->in[9] + l * D, WSP(bf16, WS_WRS) + (size_t)l * 2 * NE * D, ka->in[11] + l * NE, WSP(bf16, WS_XBF),
                      WSP(int, WS_TOK + TOK_E), WSP(int, WS_TOK + TOK_LR), WSP(float, WS_TOK + TOK_W), WSP(int, WS_TOK + TOK_BLKCNT), blk, tid, wave, lane);
        PH_END()
        PH_BEGIN(9)
            phase_dispatch(lds, WSP(int, WS_TOK + TOK_BLKCNT), WSP(int, WS_TOK + TOK_E), WSP(int, WS_TOK + TOK_LR), WSP(int, WS_TOK + TOK_ROW), WSP(int, WS_TOK + TOK_TAB), WSP(bf16, WS_XBF), WSP(bf16, WS_XS), blk, tid, wave, lane);
        PH_END()
        PH_BEGIN(10)
            if (tid < 33) tabL[tid] = WSP(int, WS_TOK + TOK_TAB)[tid];
            __syncthreads();
            int sw_ = 0x7A7A7A7A, sx_ = 0x7F7F7F7F; asm volatile("" : "+s"(sw_), "+s"(sx_));
            pg8::Gemm g{WSP(bf16, WS_XS), WSP(bf16, WS_WGU), MOE_MAXROWS, NE * 2048, D / 2, sw_, sx_}; pg8::MoeOrder S{tabL, 8, G, blk, tabL[32] * 8};
            pg8::EpiSwiglu E{WSP(unsigned char, WS_HID), ka->in[13] + (size_t)l * NE * 1024, ka->in[15] + (size_t)l * NE * 1024};
            pg8::gemm_phase<pg8::EpiSwiglu, pg8::MoeOrder, true, true, true>(lds, g, S, E);
        PH_END()
        PH_BEGIN(11)
            if (tid < 33) tabL[tid] = WSP(int, WS_TOK + TOK_TAB)[tid];
            __syncthreads();
            int sw_ = 0x79797979, sx_ = 0x7F7F7F7F; asm volatile("" : "+s"(sw_), "+s"(sx_));
            pg8::Gemm g{WSP(bf16, WS_HID), WSP(bf16, WS_WD), MOE_MAXROWS, NE * 1024, D / 2, sw_, sx_}; pg8::MoeOrder S{tabL, 4, G, blk, tabL[32] * 4};
            pg8::EpiDown E{WSP(unsigned char, WS_XS), ka->in[17] + (size_t)l * NE * 1024};
            pg8::gemm_phase<pg8::EpiDown, pg8::MoeOrder, true, true, true>(lds, g, S, E);
        PH_END()
        PH_BEGIN(12)
            float* x2out = (l == DEPTH - 1) ? ka->out : nullptr;
            phase_ln2(WSP(unsigned char, WS_XS), WSP(int, WS_TOK + TOK_ROW), WSP(float, WS_TOK + TOK_W), ka->in[18] + l * D, ka->in[19] + l * D, x2out, WSP(bf16, WS_XBF), gw, NGW, lane);
            if (l + 1 < DEPTH) { constexpr int ln = l + 1, jn = ln >> 1; constexpr bool mn = (ln & 1) != 0;
                const float* win_src = mn ? ka->in[5] + (size_t)jn * D * NC_M : ka->in[2] + (size_t)jn * D * NC_H; const size_t moff = (size_t)ln * NE * 1024 * 1024;
                phase_weights((LAS float*)(lds + wave * 16384), gw, NGW, lane, win_src, mn ? NC_M : NC_H, ka->in[6], 0, ka->in[7] + (size_t)ln * D * D,
                              ka->in[12] + moff, ka->in[14] + moff, ka->in[16] + moff, WSP(bf16, WS_WIN), WSP(bf16, WS_WKV4), WSP(bf16, WS_WO), WSP(bf16, WS_WGU), WSP(bf16, WS_WD)); }
            if (l + 1 < DEPTH) PH_SEAM();
        PH_END_NOSEAM()
}
__global__ void __launch_bounds__(NTHR, 2) fwd_kernel(Args args) {
    extern __shared__ __attribute__((aligned(16))) unsigned char lds_raw[];
    LAS unsigned char* lds = (LAS unsigned char*)lds_raw;
    if (threadIdx.x < 4) ((LAS unsigned*)(lds + MISC_OFF))[threadIdx.x] = 0u;
    __syncthreads();
#if ONE_LAUNCH
    (void)xcd_barrier_post((unsigned*)(args.ws + WS_CTL) + CW_BAR, (volatile LAS unsigned*)(lds + MISC_OFF));
#endif
    { const int l = 0; (void)l;
    PH_BEGIN(0)
        cvt_rows_bf16(ka->in[0], WSP(bf16, WS_XBF), (size_t)T * D / 8, gtid, GTHREADS);
        cvt_rows_bf16(ka->in[1], WSP(bf16, WS_MEMBF), (size_t)512 * D / 8, gtid, GTHREADS);
        split_router_weights(ka->in[10], WSP(bf16, WS_WRS), gtid, GTHREADS);
    PH_END_NOSEAM() }
    layer_phases<0>(lds); layer_phases<1>(lds); layer_phases<2>(lds); layer_phases<3>(lds);
}

extern "C" void kernel_launch(void* const* d_in, const int* in_sizes, int n_in, void* d_out, int out_size, void* d_ws, size_t ws_size, hipStream_t stream) {
    static int ready = 0;
    if (ready == 0) {
        if (n_in != 20 || in_sizes[0] != T * D || out_size != T * D || ws_size < WS_END) { fprintf(stderr, "kernel_launch: unexpected shapes (n_in %d, in0 %d, out %d, ws %zu < %zu)\n", n_in, n_in > 0 ? in_sizes[0] : -1, out_size, ws_size, (size_t)WS_END); ready = -1; return; }
        if (hipFuncSetAttribute((const void*)fwd_kernel, hipFuncAttributeMaxDynamicSharedMemorySize, LDS_BYTES) != hipSuccess) { fprintf(stderr, "kernel_launch: hipFuncSetAttribute failed\n"); ready = -1; return; }
        int per_cu = 0;
        if (hipOccupancyMaxActiveBlocksPerMultiprocessor(&per_cu, (const void*)fwd_kernel, NTHR, LDS_BYTES) != hipSuccess || per_cu < 1) fprintf(stderr, "kernel_launch: occupancy query says %d\n", per_cu);
        (void)hipGetLastError();
        ready = 1;
    }
    if (ready < 0) return;
    if (hipMemsetAsync((char*)d_ws + WS_CTL, 0, CTL_ZERO_BYTES, stream) != hipSuccess) return;
    Args a{};
    for (int i = 0; i < 20; ++i) a.in[i] = (const float*)d_in[i];
    a.out = (float*)d_out; a.ws = (unsigned char*)d_ws;
    a.l_lo = 0; a.l_hi = DEPTH; a.ph_lo = 0; a.ph_hi = NPHASE;
    hipLaunchKernelGGL(fwd_kernel, dim3(GRID), dim3(NTHR), LDS_BYTES, stream, a);
}
```

```cpp
#include <hip/hip_runtime.h>
#include <cstdio>
#include <cstdint>
#include <cmath>
namespace pg8 {
#define PG8_LAS __attribute__((address_space(3)))
typedef unsigned short bf16_t;
typedef short bf16x8 __attribute__((ext_vector_type(8)));
typedef float f32x4 __attribute__((ext_vector_type(4)));
typedef unsigned u32x4 __attribute__((ext_vector_type(4)));
constexpr int BM = 256, BK = 64, HALF = 128, HTB = HALF * BK * 2  , STAGE_BYTES = 8 * HTB, NXCD = 8, WGM = 8;

__host__ __device__ __forceinline__ int lds_byte(int r, int c) { const int st = (r >> 4) * 2 + (c >> 5), rr = r & 15, cc = c & 31, ob = rr * 64 + cc * 2; return st * 1024 + (ob ^ (((ob >> 9) & 1) << 5)); }
__host__ __device__ __forceinline__ void stage_rc(int b, int& R, int& C) { const int st = b / 1024, sb = b % 1024, swz = sb ^ (((sb >> 9) & 1) << 5); R = (st >> 1) * 16 + swz / 64; C = (st & 1) * 32 + (swz % 64) / 2; }
__host__ __device__ __forceinline__ int perm32(int rho) { const int n = rho >> 4, i = rho & 15; return 8 * (i >> 2) + 4 * n + (i & 3); }

struct Unit { int pm, pn; };
struct Gemm { const bf16_t* A; const bf16_t* Bt; int M, N, K; int sw, sx; };
typedef int i32x8 __attribute__((ext_vector_type(8))); typedef int i32x4 __attribute__((ext_vector_type(4)));

struct StaticOrder {
    int nM, nN, nwg, G, c;
    __host__ __device__ void init(int M, int N, int G_, int c_) { nM = M / BM; nN = N / BM; nwg = nM * nN; G = G_; c = c_; }
    __host__ __device__ bool next(int i, Unit& u) const {
        const long L = (long)i * G + c; if (L >= nwg) return false;
        int wgid = (int)L; { const int q = nwg / NXCD, r = nwg % NXCD, xcd = wgid % NXCD, off = wgid / NXCD; wgid = (xcd < r ? xcd * (q + 1) : r * (q + 1) + (xcd - r) * q) + off; }
        const int nig = WGM * nN, gid = wgid / nig, fm = gid * WGM, gsz = (nM - fm) < WGM ? (nM - fm) : WGM;
        u.pm = fm + ((wgid % nig) % gsz); u.pn = (wgid % nig) / gsz; return true;
    }
    __device__ __forceinline__ void a_ready(const Unit&) const {}
    __device__ __forceinline__ void done(const Unit&) const {}
};

__device__ __forceinline__ unsigned cvt_pk_bf16(float lo, float hi) { unsigned r; asm volatile("v_cvt_pk_bf16_f32 %0, %1, %2" : "=v"(r) : "v"(lo), "v"(hi)); return r; }
typedef float f32x2 __attribute__((ext_vector_type(2)));
struct EpiPlain {
    static constexpr bool PERM = true, AFTER_DRAIN = false;
    bf16_t* O; int ldc; unsigned smask; float sc;
    __device__ __forceinline__ void operator()(const f32x4 (&acc)[2][2][4][2], const Unit& u, int wr, int wc, int fr, int fq) const {
        const int row0 = u.pm * BM + wr * 64 + fr; const int col0 = u.pn * BM + wc * 32 + 8 * fq; const float s = ((smask >> u.pn) & 1u) ? sc : 1.f;
#pragma unroll
        for (int ai = 0; ai < 2; ++ai)
#pragma unroll
            for (int m = 0; m < 4; ++m) { bf16_t* rowp = O + (size_t)(row0 + ai * HALF + m * 16) * ldc + col0;
#pragma unroll
                for (int bj = 0; bj < 2; ++bj) { const f32x4 v0 = acc[ai][bj][m][0] * s, v1 = acc[ai][bj][m][1] * s;
                    u32x4 w; w.x = cvt_pk_bf16(v0[0], v0[1]); w.y = cvt_pk_bf16(v0[2], v0[3]); w.z = cvt_pk_bf16(v1[0], v1[1]); w.w = cvt_pk_bf16(v1[2], v1[3]);
                    *(u32x4*)(rowp + bj * HALF) = w; } }
    }
};
__device__ __forceinline__ float swiglu1(float g, float u) {
    g = fminf(g, 7.0f); u = fminf(fmaxf(u, -7.0f), 7.0f);
    const float s = __builtin_amdgcn_rcpf(1.0f + __builtin_amdgcn_exp2f(g * (-1.702f * 1.4426950408889634f)));
    return g * s * (u + 1.0f);
}
__device__ __forceinline__ unsigned pk4_fp8e(float a, float b, float c, float d) { int w = 0; w = __builtin_amdgcn_cvt_pk_fp8_f32(a, b, w, false); w = __builtin_amdgcn_cvt_pk_fp8_f32(c, d, w, true); return (unsigned)w; }
struct EpiSwiglu {
    static constexpr bool PERM = true, AFTER_DRAIN = false;
    unsigned char* hid; const float* bg; const float* bu;
    __device__ __forceinline__ void operator()(const f32x4 (&acc)[2][2][4][2], const Unit& u, int wr, int wc, int fr, int fq) const {
        const int e = u.pn >> 3, pn = u.pn & 7;
        const int row0 = u.pm * BM + wr * 64 + fr; const int col0 = pn * 128 + wc * 32 + 8 * fq;
        const f32x4 g0 = *(const f32x4*)(bg + e * 1024 + col0), g1 = *(const f32x4*)(bg + e * 1024 + col0 + 4);
        const f32x4 u0 = *(const f32x4*)(bu + e * 1024 + col0), u1 = *(const f32x4*)(bu + e * 1024 + col0 + 4);
#pragma unroll
        for (int ai = 0; ai < 2; ++ai)
#pragma unroll
            for (int m = 0; m < 4; ++m) { unsigned char* rowp = hid + (size_t)(row0 + ai * HALF + m * 16) * 1024 + col0;
                const f32x4 ga = acc[ai][0][m][0] + g0, gb = acc[ai][0][m][1] + g1, ua = acc[ai][1][m][0] + u0, ub = acc[ai][1][m][1] + u1;
                typedef unsigned u32x2 __attribute__((ext_vector_type(2))); u32x2 w;
                w.x = pk4_fp8e(swiglu1(ga[0], ua[0]), swiglu1(ga[1], ua[1]), swiglu1(ga[2], ua[2]), swiglu1(ga[3], ua[3]));
                w.y = pk4_fp8e(swiglu1(gb[0], ub[0]), swiglu1(gb[1], ub[1]), swiglu1(gb[2], ub[2]), swiglu1(gb[3], ub[3]));
                *(u32x2*)rowp = w; }
    }
};
struct EpiDown {
    static constexpr bool PERM = true, AFTER_DRAIN = false;
    unsigned char* y; const float* bd;
    __device__ __forceinline__ void operator()(const f32x4 (&acc)[2][2][4][2], const Unit& u, int wr, int wc, int fr, int fq) const {
        const int e = u.pn >> 2, pn = u.pn & 3;
        const int row0 = u.pm * BM + wr * 64 + fr; const int col0 = pn * BM + wc * 32 + 8 * fq;
        f32x4 bv[2][2];
#pragma unroll
        for (int bj = 0; bj < 2; ++bj)
#pragma unroll
            for (int n = 0; n < 2; ++n) bv[bj][n] = *(const f32x4*)(bd + e * 1024 + col0 + bj * HALF + 4 * n);
#pragma unroll
        for (int ai = 0; ai < 2; ++ai)
#pragma unroll
            for (int m = 0; m < 4; ++m) { unsigned char* rowp = y + (size_t)(row0 + ai * HALF + m * 16) * 1024 + col0;
#pragma unroll
                for (int bj = 0; bj < 2; ++bj) { const f32x4 v0 = (acc[ai][bj][m][0] + bv[bj][0]) * 16.f, v1 = (acc[ai][bj][m][1] + bv[bj][1]) * 16.f;
                    typedef unsigned u32x2 __attribute__((ext_vector_type(2))); u32x2 w; w.x = pk4_fp8e(v0[0], v0[1], v0[2], v0[3]); w.y = pk4_fp8e(v1[0], v1[1], v1[2], v1[3]);
                    *(u32x2*)(rowp + bj * HALF) = w; } }
    }
};
struct MoeOrder {
    const PG8_LAS int* tab; int npn, G, c, nunits;
    __device__ __forceinline__ bool next(int i, Unit& u) const {
        const int tpx = 32 / npn, s = c >> 3, tile = (i * 8 + (c & 7)) * tpx + s / npn, pn = s % npn;
        if ((i * 8) * tpx >= nunits / npn) return false;
        if (tile >= nunits / npn) { u.pm = 0; u.pn = 0; return false; }
        int e = 0;
#pragma unroll
        for (int k = 1; k < 32; ++k) e += (tab[k] <= tile) ? 1 : 0;
        u.pm = tile; u.pn = __builtin_amdgcn_readfirstlane(e) * npn + pn; return true;
    }
    __device__ __forceinline__ void a_ready(const Unit&) const {}
    __device__ __forceinline__ void done(const Unit&) const {}
};
template <class Epi, class Sched, bool ALIGN_EPI = false, bool SP2 = false, bool F8 = false>
__device__ __forceinline__ void gemm_phase(PG8_LAS unsigned char* lds, const Gemm g, const Sched& S, const Epi& E) {
    int tid_ = threadIdx.x; asm volatile("" : "+v"(tid_));
    const int tid = tid_, wid = __builtin_amdgcn_readfirstlane(tid >> 6), lane = tid & 63, wr = wid >> 2, wc = wid & 3, fr = lane & 15, fq = lane >> 4;
    const int K = g.K, nt = K / BK;
    unsigned voffA, voffB;
    { int R, C; stage_rc(tid * 16, R, C); const int Rb = Epi::PERM ? ((R & ~31) + perm32(R & 31)) : R; voffA = (unsigned)(R * K + C) * 2u; voffB = (unsigned)(Rb * K + C) * 2u; }
    const unsigned qstep = 64u * (unsigned)K * 2u;
    const unsigned kstep = (unsigned)(BK * 2);
    const unsigned hstep = (unsigned)HALF * (unsigned)K * 2u;
    const unsigned tstep = 2u * hstep;
    const __amdgpu_buffer_rsrc_t rA = __builtin_amdgcn_make_buffer_rsrc((void*)g.A, 0, 0x7FFFFFFF, 0x00020000), rB = __builtin_amdgcn_make_buffer_rsrc((void*)g.Bt, 0, 0x7FFFFFFF, 0x00020000);
    const unsigned ldsw = (unsigned)wid * 1024u;
    const int aoff = lds_byte(wr * 64 + fr, fq * 8), boff = lds_byte(wc * 32 + fr, fq * 8);
#define PG8_SA(b, h) (((b) * 2 + (h)) * HTB)
#define PG8_SB(b, h) ((4 + (b) * 2 + (h)) * HTB)
#define PG8_STG(bufoff, rsrc, soff, voff) do { _Pragma("unroll") for (int _i = 0; _i < 2; ++_i) \
        __builtin_amdgcn_raw_ptr_buffer_load_lds((rsrc), (PG8_LAS void*)(lds + (bufoff) + ldsw + _i * 8192), 16, (int)(voff), (int)((soff) + (unsigned)_i * qstep), 0, 0); } while (0)
#define PG8_STGA(bufoff, soff) PG8_STG(bufoff, rA, soff, voffA)
#define PG8_STGB(bufoff, soff) PG8_STG(bufoff, rB, soff, voffB)
#define PG8_LDA(dst, b, h) do { _Pragma("unroll") for (int m = 0; m < 4; ++m) { if constexpr (F8) { const i32x4 lo_ = *(const PG8_LAS i32x4*)(lds + PG8_SA(b, h) + aoff + m * 2048), hi_ = *(const PG8_LAS i32x4*)(lds + PG8_SA(b, h) + aoff + m * 2048 + 1024); \
            dst##_8[m] = __builtin_shufflevector(lo_, hi_, 0, 1, 2, 3, 4, 5, 6, 7); } else { _Pragma("unroll") for (int k = 0; k < 2; ++k) dst[m][k] = *(const PG8_LAS bf16x8*)(lds + PG8_SA(b, h) + aoff + m * 2048 + k * 1024); } } } while (0)
#define PG8_LDB(dst, b, h) do { _Pragma("unroll") for (int n = 0; n < 2; ++n) { if constexpr (F8) { const i32x4 lo_ = *(const PG8_LAS i32x4*)(lds + PG8_SB(b, h) + boff + n * 2048), hi_ = *(const PG8_LAS i32x4*)(lds + PG8_SB(b, h) + boff + n * 2048 + 1024); \
            dst##_8[n] = __builtin_shufflevector(lo_, hi_, 0, 1, 2, 3, 4, 5, 6, 7); } else { _Pragma("unroll") for (int k = 0; k < 2; ++k) dst[n][k] = *(const PG8_LAS bf16x8*)(lds + PG8_SB(b, h) + boff + n * 2048 + k * 1024); } } } while (0)
#define PG8_MMA(ai, bj, At, Bt) do { __builtin_amdgcn_s_setprio(1); _Pragma("unroll") for (int m = 0; m < 4; ++m) _Pragma("unroll") for (int n = 0; n < 2; ++n) { \
        if constexpr (F8) acc[ai][bj][m][n] = __builtin_amdgcn_mfma_scale_f32_16x16x128_f8f6f4(Bt##_8[n], At##_8[m], acc[ai][bj][m][n], 0, 0, 0, g.sw, 0, g.sx); \
        else { _Pragma("unroll") for (int k = 0; k < 2; ++k) acc[ai][bj][m][n] = __builtin_amdgcn_mfma_f32_16x16x32_bf16(Bt[n][k], At[m][k], acc[ai][bj][m][n], 0, 0, 0); } } \
        __builtin_amdgcn_s_setprio(0); } while (0)
#define PG8_WAIT_V(n) asm volatile("s_waitcnt vmcnt(" #n ")" ::: "memory")
#define PG8_WAIT_L(n) asm volatile("s_waitcnt lgkmcnt(" #n ")" ::: "memory")
#define PG8_BAR __builtin_amdgcn_s_barrier()
#define PG8_SCHED __builtin_amdgcn_sched_barrier(0)
    Unit cur, nxt; int ui = 0;
    if (!S.next(0, cur)) return;
    f32x4 acc[2][2][4][2];
#pragma unroll
    for (int a = 0; a < 2; ++a)
#pragma unroll
        for (int b = 0; b < 2; ++b)
#pragma unroll
            for (int m = 0; m < 4; ++m)
#pragma unroll
                for (int n = 0; n < 2; ++n) acc[a][b][m][n] = (f32x4){0.f, 0.f, 0.f, 0.f};
    bf16x8 At[4][2], B0[2][2], B1[2][2]; i32x8 At_8[4], B0_8[2], B1_8[2];
    unsigned cA = (unsigned)cur.pm * tstep, cB = (unsigned)cur.pn * tstep;
    S.a_ready(cur);
    if constexpr (SP2) {
        PG8_STGB(PG8_SB(0, 0), cB); PG8_STGB(PG8_SB(0, 1), cB + hstep); PG8_STGA(PG8_SA(0, 0), cA); PG8_STGA(PG8_SA(0, 1), cA + hstep);
        if (wr == 1) PG8_BAR;
        PG8_WAIT_V(2); PG8_BAR;
        PG8_STGB(PG8_SB(1, 0), cB + kstep); PG8_STGA(PG8_SA(1, 0), cA + kstep); PG8_STGB(PG8_SB(1, 1), cB + hstep + kstep);
        PG8_WAIT_V(6); PG8_BAR;
    } else {
        PG8_STGB(PG8_SB(0, 0), cB); PG8_STGA(PG8_SA(0, 0), cA); PG8_STGB(PG8_SB(0, 1), cB + hstep); PG8_STGA(PG8_SA(0, 1), cA + hstep);
        if (wr == 1) PG8_BAR;
        PG8_WAIT_V(4); PG8_BAR;
        PG8_STGB(PG8_SB(1, 0), cB + kstep); PG8_STGA(PG8_SA(1, 0), cA + kstep); PG8_STGB(PG8_SB(1, 1), cB + hstep + kstep);
        PG8_WAIT_V(6); PG8_BAR;
    }
    for (;;) {
        const bool has_next = S.next(ui + 1, nxt);
        const unsigned nA = has_next ? (unsigned)nxt.pm * tstep : cA, nB = has_next ? (unsigned)nxt.pn * tstep : cB;
#pragma unroll 1
        for (int t = 0; t < nt; t += 2) {
            const bool last = (t == nt - 2);
            const unsigned a1 = cA + (unsigned)(t + 1) * kstep;
            const unsigned a2 = last ? nA : cA + (unsigned)(t + 2) * kstep, b2 = last ? nB : cB + (unsigned)(t + 2) * kstep;
            const unsigned a3 = a2 + kstep, b3 = b2 + kstep;
            if (last && has_next) S.a_ready(nxt);
            if constexpr (SP2) {
            PG8_LDB(B0, 0, 0); PG8_LDB(B1, 0, 1); PG8_SCHED; PG8_LDA(At, 0, 0); PG8_STGA(PG8_SA(1, 1), a1 + hstep);
            PG8_WAIT_V(8); PG8_WAIT_L(0); PG8_BAR; PG8_MMA(0, 0, At, B0); PG8_MMA(0, 1, At, B1); PG8_BAR; PG8_SCHED;
            PG8_LDA(At, 0, 1); PG8_STGB(PG8_SB(0, 0), b2); PG8_STGB(PG8_SB(0, 1), b2 + hstep); PG8_STGA(PG8_SA(0, 0), a2);
            PG8_WAIT_V(8); PG8_WAIT_L(0); PG8_BAR; PG8_MMA(1, 0, At, B0); PG8_MMA(1, 1, At, B1); PG8_BAR; PG8_SCHED;
            PG8_LDB(B0, 1, 0); PG8_LDB(B1, 1, 1); PG8_SCHED; PG8_LDA(At, 1, 0); PG8_STGA(PG8_SA(0, 1), a2 + hstep);
            PG8_WAIT_V(8); PG8_WAIT_L(0); PG8_BAR; PG8_MMA(0, 0, At, B0); PG8_MMA(0, 1, At, B1); PG8_BAR; PG8_SCHED;
            PG8_LDA(At, 1, 1); PG8_STGB(PG8_SB(1, 0), b3); PG8_STGB(PG8_SB(1, 1), b3 + hstep); PG8_STGA(PG8_SA(1, 0), a3);
            PG8_WAIT_V(8); PG8_WAIT_L(0); PG8_BAR; PG8_MMA(1, 0, At, B0); PG8_MMA(1, 1, At, B1); PG8_BAR; PG8_SCHED;
            } else {
            PG8_LDB(B0, 0, 0); PG8_SCHED; PG8_LDA(At, 0, 0); PG8_STGA(PG8_SA(1, 1), a1 + hstep);
            PG8_WAIT_L(8); PG8_BAR; PG8_WAIT_L(0); PG8_MMA(0, 0, At, B0); PG8_BAR; PG8_SCHED;
            PG8_LDB(B1, 0, 1); PG8_STGB(PG8_SB(0, 0), b2);
            PG8_BAR; PG8_WAIT_L(0); PG8_MMA(0, 1, At, B1); PG8_BAR;
            PG8_LDA(At, 0, 1); PG8_STGA(PG8_SA(0, 0), a2);
            PG8_BAR; PG8_WAIT_L(0); PG8_MMA(1, 0, At, B0); PG8_BAR; PG8_SCHED;
            PG8_STGB(PG8_SB(0, 1), b2 + hstep);
            PG8_WAIT_V(6); PG8_BAR; PG8_MMA(1, 1, At, B1); PG8_BAR;
            PG8_LDB(B0, 1, 0); PG8_SCHED; PG8_LDA(At, 1, 0); PG8_STGA(PG8_SA(0, 1), a2 + hstep);
            PG8_WAIT_L(8); PG8_BAR; PG8_WAIT_L(0); PG8_MMA(0, 0, At, B0); PG8_BAR; PG8_SCHED;
            PG8_LDB(B1, 1, 1); PG8_STGB(PG8_SB(1, 0), b3);
            PG8_BAR; PG8_WAIT_L(0); PG8_MMA(0, 1, At, B1); PG8_BAR;
            PG8_LDA(At, 1, 1); PG8_STGA(PG8_SA(1, 0), a3);
            PG8_BAR; PG8_WAIT_L(0); PG8_MMA(1, 0, At, B0); PG8_BAR; PG8_SCHED;
            PG8_STGB(PG8_SB(1, 1), b3 + hstep);
            PG8_WAIT_V(6); PG8_BAR; PG8_MMA(1, 1, At, B1); PG8_BAR;
            }
        }
        if constexpr (ALIGN_EPI) { if (wr == 0) PG8_BAR; }
        if constexpr (!Epi::AFTER_DRAIN) { int t2_ = threadIdx.x; asm volatile("" : "+v"(t2_)); E(acc, cur, wr, wc, t2_ & 15, (t2_ & 63) >> 4); S.done(cur); }
        if (!has_next) break;
#pragma unroll
        for (int a = 0; a < 2; ++a)
#pragma unroll
            for (int b = 0; b < 2; ++b)
#pragma unroll
                for (int m = 0; m < 4; ++m)
#pragma unroll
                    for (int n = 0; n < 2; ++n) acc[a][b][m][n] = (f32x4){0.f, 0.f, 0.f, 0.f};
        cur = nxt; cA = nA; cB = nB; ++ui;
        if constexpr (ALIGN_EPI) { if (wr == 1) PG8_BAR; }
    }
    PG8_WAIT_V(0);
    if constexpr (!ALIGN_EPI) { if (wr == 0) PG8_BAR; }
    PG8_BAR;
    if constexpr (Epi::AFTER_DRAIN) { E.fused(acc, cur, wr, wc, fr, fq, lds, wid, lane); S.done(cur); }
#undef PG8_SA
#undef PG8_SB
#undef PG8_STG
#undef PG8_STGA
#undef PG8_STGB
#undef PG8_LDA
#undef PG8_LDB
#undef PG8_MMA
#undef PG8_WAIT_V
#undef PG8_WAIT_L
#undef PG8_BAR
#undef PG8_SCHED
}
}

constexpr int NWAVES = 8, NTHR = 512, GRID = 256;
constexpr int NBATCH = 2, SEQ = 16384, T = NBATCH * SEQ, D = 1024, DEPTH = 4;
constexpr int MIXW = 768, NC_H = 3328, NC_M = 2560;
constexpr int HG_H = 6;
constexpr int HSEG = 256, HNSEG = SEQ / HSEG;
constexpr int MB_H = 12, MB_NB = 64;
constexpr int NE = 32;
constexpr float DN_ALPHA = 1.6817928305074290f;
constexpr int MOE_MAXROWS = T * 4 + NE * 256;
#ifndef ONE_LAUNCH
#define ONE_LAUNCH 1
#endif
constexpr int NPHASE = 13;

constexpr size_t MiB = 1u << 20;
constexpr size_t WS_CTL = 0, CTL_ZERO_BYTES = 1 * MiB;
constexpr size_t WS_WIN = 1 * MiB, WS_WKV = 9 * MiB, WS_WO = 10 * MiB, WS_WGU = 12 * MiB, WS_WD = 140 * MiB;
constexpr size_t WS_XBF = 204 * MiB, WS_WKV4 = 268 * MiB  , WS_KV4 = 272 * MiB  , WS_WRS = 280 * MiB  , WS_MEMBF = 524 * MiB;
constexpr size_t WS_H = 526 * MiB, WS_MIX = 734 * MiB, WS_Y = 798 * MiB, WS_SLOC = 862 * MiB, WS_DSEG = 910 * MiB, WS_KMEAN = 911 * MiB;
constexpr size_t WS_SELINFO = 912 * MiB, WS_TOK = 914 * MiB, WS_R1 = 918 * MiB;
constexpr size_t WS_LIST = WS_R1, WS_PML = WS_R1 + 96 * MiB, WS_PO = WS_R1 + 108 * MiB;
constexpr size_t WS_XS = WS_R1, WS_HID = WS_R1 + 272 * MiB;
constexpr size_t WS_END = WS_R1 + 544 * MiB;
static_assert((size_t)MOE_MAXROWS * 1024 * 2 <= 272 * MiB, "moe rows");
static_assert((size_t)T * MB_H * 4 * 64 * 4 <= 384 * MiB && (size_t)24 * 64 * 16384 * 4 <= 96 * MiB, "moba bufs");
constexpr size_t TOK_E = 0, TOK_LR = 512 * 1024, TOK_W = 1024 * 1024, TOK_ROW = 1536 * 1024, TOK_BLKCNT = 2048 * 1024, TOK_TAB = 2048 * 1024 + 65536;
constexpr int CW_BAR = 4096, CW_GCOUNT = 8192;

constexpr int RING_BYTES = 131072, LDS_BYTES = 147456, MISC_OFF = LDS_BYTES - 1024;

#define GAS __attribute__((address_space(1)))
#define LAS __attribute__((address_space(3)))
typedef unsigned short bf16;
typedef unsigned v4u __attribute__((ext_vector_type(4)));
typedef unsigned v2u __attribute__((ext_vector_type(2)));
typedef float f32x4 __attribute__((ext_vector_type(4)));
typedef float f32x2 __attribute__((ext_vector_type(2)));
typedef short s16x8 __attribute__((ext_vector_type(8)));
typedef float f32x16 __attribute__((ext_vector_type(16)));
typedef float f32x2_t __attribute__((ext_vector_type(2))); typedef __bf16 bf16x2_t __attribute__((ext_vector_type(2)));
__device__ __forceinline__ unsigned cvtpk(float lo, float hi) { f32x2_t v = {lo, hi}; bf16x2_t b = __builtin_convertvector(v, bf16x2_t); return __builtin_bit_cast(unsigned, b); }
#define LDS_WAIT() asm volatile("s_waitcnt lgkmcnt(0)" ::: "memory")
__device__ __forceinline__ unsigned f2bf(float f) { unsigned u = __builtin_bit_cast(unsigned, f); return (u + 0x7fffu + ((u >> 16) & 1u)) >> 16; }
__device__ __forceinline__ unsigned pk2(float lo, float hi) { return f2bf(lo) | (f2bf(hi) << 16); }
__device__ __forceinline__ float bflo(unsigned w) { return __builtin_bit_cast(float, w << 16); }
__device__ __forceinline__ float bfhi(unsigned w) { return __builtin_bit_cast(float, w & 0xffff0000u); }
__device__ __forceinline__ float bf2f(bf16 h) { return __builtin_bit_cast(float, (unsigned)h << 16); }
__device__ __forceinline__ float sigmoidf_(float z) { return __builtin_amdgcn_rcpf(1.0f + __builtin_amdgcn_exp2f(-1.4426950408889634f * z)); }
template <int X> __device__ __forceinline__ float xorf(float v) { return __builtin_bit_cast(float, __builtin_amdgcn_ds_swizzle(__builtin_bit_cast(int, v), (X << 10) | 0x1F)); }
template <int X> __device__ __forceinline__ int xori(int v) { return __builtin_amdgcn_ds_swizzle(v, (X << 10) | 0x1F); }
__device__ __forceinline__ float wave_sum(float v) {
    v += xorf<1>(v); v += xorf<2>(v); v += xorf<4>(v); v += xorf<8>(v); v += xorf<16>(v);
    return __builtin_bit_cast(float, __builtin_amdgcn_readlane(__builtin_bit_cast(int, v), 0)) + __builtin_bit_cast(float, __builtin_amdgcn_readlane(__builtin_bit_cast(int, v), 32));
}
__device__ __forceinline__ float wave_max(float v) {
    v = fmaxf(v, xorf<1>(v)); v = fmaxf(v, xorf<2>(v)); v = fmaxf(v, xorf<4>(v)); v = fmaxf(v, xorf<8>(v)); v = fmaxf(v, xorf<16>(v));
    return fmaxf(__builtin_bit_cast(float, __builtin_amdgcn_readlane(__builtin_bit_cast(int, v), 0)), __builtin_bit_cast(float, __builtin_amdgcn_readlane(__builtin_bit_cast(int, v), 32)));
}
__device__ __forceinline__ float xor32f(float v, int lane) { return __builtin_bit_cast(float, __builtin_amdgcn_ds_bpermute((lane ^ 32) << 2, __builtin_bit_cast(int, v))); }
#define XB_TMO      128
#define XB_XCNT(j)  (256  + 64 * (j))
#define XB_XSUB(j)  (1280 + 64 * (j))
#define XB_XGEN(j)  (2304 + 64 * (j))
#define XB_TOP      3328
#define XB_TOPGEN   3392
#define XCD_BAR_WORDS 3456
#define XB_SPIN_CAP (1u << 18)

__device__ __forceinline__ unsigned xb_ld(unsigned* p)              { return __hip_atomic_load(p, __ATOMIC_RELAXED, __HIP_MEMORY_SCOPE_AGENT); }
__device__ __forceinline__ unsigned xb_add(unsigned* p, unsigned v) { return __hip_atomic_fetch_add(p, v, __ATOMIC_RELAXED, __HIP_MEMORY_SCOPE_AGENT); }
__device__ __forceinline__ unsigned xb_xcc_id() { return (unsigned)__builtin_amdgcn_s_getreg((3 << 11) | 20) & 0xFu; }
#define XB_SPIN(cond, bar) do { unsigned _sp = 0; while (cond) { __builtin_amdgcn_s_sleep(1); \
    if ((++_sp & 255u) == 0u) { if (xb_ld(&(bar)[XB_TMO])) break; if (_sp > XB_SPIN_CAP) { atomicAdd(&(bar)[XB_TMO], 1u); break; } } } } while (0)

struct XcdBarrier {
    unsigned* bar; unsigned x;
    volatile LAS unsigned* st;
};

__device__ __forceinline__ XcdBarrier xcd_barrier_post(unsigned* bar, volatile LAS unsigned* st) {
    XcdBarrier b; b.bar = bar; b.x = xb_xcc_id(); b.st = st;
    if (threadIdx.x == 0) (void)xb_add(&bar[XB_XCNT(b.x)], 1u);
    return b;
}
__device__ __forceinline__ void xcd_barrier_complete(unsigned* bar, unsigned x, unsigned& nloc, unsigned& nx) {
    const unsigned G = gridDim.x * gridDim.y * gridDim.z;
    unsigned sum, cnt, mine, sp = 0u;
    for (;;) {
        sum = 0u; cnt = 0u; mine = 0u;
#pragma unroll
        for (unsigned j = 0; j < 16; ++j) { const unsigned c = xb_ld(&bar[XB_XCNT(j)]); sum += c; cnt += (c > 0u) ? 1u : 0u; mine = (j == x) ? c : mine; }
        if (sum == G) break;
        __builtin_amdgcn_s_sleep(1);
        if ((++sp & 255u) == 0u) { if (xb_ld(&bar[XB_TMO])) break; if (sp > XB_SPIN_CAP) { atomicAdd(&bar[XB_TMO], 1u); break; } }
    }
    nloc = mine > 0u ? mine : 1u; nx = cnt > 0u ? cnt : 1u;
}

__device__ __forceinline__ void xcd_barrier(const XcdBarrier& b) {
    asm volatile("s_waitcnt vmcnt(0)" ::: "memory");
    __syncthreads();
    if (threadIdx.x == 0) {
        unsigned* bar = b.bar;
        __builtin_amdgcn_s_waitcnt(0);
        unsigned nloc = b.st[0], nx = b.st[1];
        if (nloc == 0u) { xcd_barrier_complete(bar, b.x, nloc, nx); b.st[0] = nloc; b.st[1] = nx; }
        const unsigned old = xb_add(&bar[XB_XSUB(b.x)], 1u);
        const unsigned gen = old / nloc;
        if (old + 1u == (gen + 1u) * nloc) {
            __builtin_amdgcn_fence(__ATOMIC_RELEASE, "agent");
            asm volatile("s_waitcnt vmcnt(0)" ::: "memory");
            const unsigned og = xb_add(&bar[XB_TOP], 1u);
            const unsigned tg = og / nx;
            if (og + 1u == (tg + 1u) * nx) xb_add(&bar[XB_TOPGEN], 1u);
            else XB_SPIN(xb_ld(&bar[XB_TOPGEN]) == tg, bar);
            __builtin_amdgcn_fence(__ATOMIC_ACQUIRE, "agent");
            xb_add(&bar[XB_XGEN(b.x)], 1u);
            asm volatile("s_waitcnt vmcnt(0)" ::: "memory");
        } else {
            XB_SPIN(xb_ld(&bar[XB_XGEN(b.x)]) == gen, bar);
            __builtin_amdgcn_fence(__ATOMIC_ACQUIRE, "agent");
            asm volatile("s_waitcnt vmcnt(0)" ::: "memory");
        }
    }
    __syncthreads();
}

__device__ __forceinline__ void cvt_rows_bf16(const float* src, bf16* dst, size_t n8, size_t gtid, size_t gthreads) {
    for (size_t i = gtid; i < n8; i += gthreads) { const f32x4 a = ((const f32x4*)src)[2 * i], b = ((const f32x4*)src)[2 * i + 1];
        v4u o; o.x = pk2(a.x, a.y); o.y = pk2(a.z, a.w); o.z = pk2(b.x, b.y); o.w = pk2(b.z, b.w); ((v4u*)dst)[i] = o; }
}
__device__ __forceinline__ void transpose_item(const float* W, int N, bf16* WT, int dst_row0, LAS float* scr, int k0, int n0, int lane) {
#pragma unroll 8
    for (int i = 0; i < 32; ++i) { const int kk = 2 * i + (lane >> 5); scr[kk * 33 + (lane & 31)] = W[(size_t)(k0 + kk) * N + n0 + (lane & 31)]; }
    LDS_WAIT(); asm volatile("" ::: "memory");
    const int c = lane & 7;
#pragma unroll
    for (int j = 0; j < 4; ++j) { const int n = (lane >> 3) + 8 * j; const LAS float* s = scr + (8 * c) * 33 + n;
        v4u o; o.x = pk2(s[0 * 33], s[1 * 33]); o.y = pk2(s[2 * 33], s[3 * 33]); o.z = pk2(s[4 * 33], s[5 * 33]); o.w = pk2(s[6 * 33], s[7 * 33]);
        *(v4u*)(WT + (size_t)(dst_row0 + n) * 1024 + k0 + 8 * c) = o; }
    LDS_WAIT(); asm volatile("" ::: "memory");
}
__device__ __forceinline__ unsigned pk4_fp8(float a, float b, float c, float d) { int w = 0; w = __builtin_amdgcn_cvt_pk_fp8_f32(a, b, w, false); w = __builtin_amdgcn_cvt_pk_fp8_f32(c, d, w, true); return (unsigned)w; }
__device__ __forceinline__ void transpose_item_f8(const float* W, int N, unsigned char* WT8, int dst_row0, LAS float* scr, int k0, int n0, int lane, float wscale) {
#pragma unroll 8
    for (int i = 0; i < 32; ++i) { const int kk = 2 * i + (lane >> 5); scr[kk * 33 + (lane & 31)] = W[(size_t)(k0 + kk) * N + n0 + (lane & 31)]; }
    LDS_WAIT(); asm volatile("" ::: "memory");
    const int c = lane & 7;
#pragma unroll
    for (int j = 0; j < 4; ++j) { const int n = (lane >> 3) + 8 * j; const LAS float* s = scr + (8 * c) * 33 + n;
        v2u o; o.x = pk4_fp8(s[0 * 33] * wscale, s[1 * 33] * wscale, s[2 * 33] * wscale, s[3 * 33] * wscale); o.y = pk4_fp8(s[4 * 33] * wscale, s[5 * 33] * wscale, s[6 * 33] * wscale, s[7 * 33] * wscale);
        *(v2u*)(WT8 + (size_t)(dst_row0 + n) * 1024 + k0 + 8 * c) = o; }
    LDS_WAIT(); asm volatile("" ::: "memory");
}
__device__ __forceinline__ void phase_weights(LAS float* scr, int gw, int ngw, int lane, const float* win_src, int NC, const float* wkv_src, int nkv, const float* wo_src,
                                              const float* wg_src, const float* wu_src, const float* wd_src, bf16* win_t, bf16* wkv_t, bf16* wo_t, bf16* wgu_t, bf16* wd_t) {
    const int nbw = NC / 32, nWin = nbw * 16, NIT = nWin + 256 * nkv + 512 + NE * 1536;
    for (int it = gw; it < NIT; it += ngw) {
        int r = it;
        if (r < nWin) { const int kb = r / nbw, nb = r - kb * nbw; transpose_item(win_src, NC, win_t, 32 * nb, scr, 64 * kb, 32 * nb, lane); continue; } r -= nWin;
        if (r < 256 * nkv) { const int lay = r >> 8, rr = r & 255, kb = rr >> 4, nb = rr & 15; transpose_item(wkv_src + (size_t)lay * D * 512, 512, wkv_t + (size_t)lay * 512 * 1024, 32 * nb, scr, 64 * kb, 32 * nb, lane); continue; } r -= 256 * nkv;
        if (r < 512) { const int kb = r >> 5, nb = r & 31; transpose_item(wo_src, 1024, wo_t, 32 * nb, scr, 64 * kb, 32 * nb, lane); continue; } r -= 512;
        const int e = r / 1536, q = r - e * 1536, which = q >> 9, rr = q & 511, kb = rr >> 5, nb = rr & 31, n0 = 32 * nb;
        const size_t eoff = (size_t)e * 1024 * 1024;
        if (which == 0) transpose_item_f8(wg_src + eoff, 1024, (unsigned char*)wgu_t + 2 * eoff, (n0 >> 7) * 256 + (n0 & 127), scr, 64 * kb, n0, lane, 32.f);
        else if (which == 1) transpose_item_f8(wu_src + eoff, 1024, (unsigned char*)wgu_t + 2 * eoff, (n0 >> 7) * 256 + 128 + (n0 & 127), scr, 64 * kb, n0, lane, 32.f);
        else transpose_item_f8(wd_src + eoff, 1024, (unsigned char*)wd_t + eoff, n0, scr, 64 * kb, n0, lane, 64.f);
    }
}

template <bool OUT>
__device__ __forceinline__ void hgrn_seg(LAS unsigned char* lds, const bf16* h, const float* lbl, int j, const float* normg, float* Sloc, float* Dseg, bf16* mix, int unit, int tid, int wave, int lane) {
    const int seg = unit & (HNSEG - 1), bh = unit >> 6, hh = bh % HG_H, b = bh / HG_H;
    const int v = tid & 127, dg = tid >> 7;
    LAS float* fgs = (LAS float*)lds; LAS float* vs = fgs + 4096; LAS float* qs = vs + 4096; LAS float* op = qs + 4096;
    f32x2 st[16];
    float* Sp = Sloc + (size_t)unit * 16384 + (size_t)(dg * 32) * 128 + v;
#pragma unroll
    for (int dd = 0; dd < 16; ++dd) { st[dd].x = OUT ? Sp[(2 * dd) * 128] : 0.f; st[dd].y = OUT ? Sp[(2 * dd + 1) * 128] : 0.f; }
    float dprod = 1.f;
    const int stok = tid >> 4, c8 = (tid & 15) * 8;
    float lb[8];
#pragma unroll
    for (int i = 0; i < 8; ++i) { lb[i] = 0.f; if (j > 0) { const float a0 = lbl[hh * 128 + c8 + i], a1 = lbl[MIXW + hh * 128 + c8 + i]; lb[i] = 1.f / (1.f + __expf(a0 - a1)); } }
    for (int ch = 0; ch < HSEG / 32; ++ch) {
        const size_t t0 = (size_t)b * SEQ + seg * HSEG + ch * 32;
        { const bf16* row = h + (t0 + stok) * NC_H + hh * 128 + c8;
          const v4u f8 = *(const v4u*)(row + 768), i8 = *(const v4u*)(row + 1536); v4u q8 = {0u, 0u, 0u, 0u}; if (OUT) q8 = *(const v4u*)row;
#pragma unroll
          for (int w = 0; w < 4; ++w) { const float f0 = bflo(f8[w]), f1 = bfhi(f8[w]); const int o = stok * 128 + c8 + 2 * w;
              fgs[o] = lb[2 * w] + (1.f - lb[2 * w]) * sigmoidf_(f0); fgs[o + 1] = lb[2 * w + 1] + (1.f - lb[2 * w + 1]) * sigmoidf_(f1);
              vs[o] = bflo(i8[w]); vs[o + 1] = bfhi(i8[w]);
              if (OUT) { const float q0 = bflo(q8[w]), q1 = bfhi(q8[w]); qs[o] = q0 * sigmoidf_(q0); qs[o + 1] = q1 * sigmoidf_(q1); } } }
        __syncthreads();
        if (!OUT) { if (tid < 128) { for (int tt = 0; tt < 32; ++tt) dprod *= fgs[tt * 128 + tid]; } }
        f32x4 fA[8], qA[8], fB[8], qB[8]; float vA, vB;
#define HG_LOAD(F, Q, V, tt_) do { V = vs[(tt_) * 128 + v]; _Pragma("unroll") for (int d4 = 0; d4 < 8; ++d4) { F[d4] = *(const LAS f32x4*)(fgs + (tt_) * 128 + dg * 32 + d4 * 4); \
            if (OUT) Q[d4] = *(const LAS f32x4*)(qs + (tt_) * 128 + dg * 32 + d4 * 4); } } while (0)
#define HG_STEP(F, Q, V, tt_) do { const f32x2 vv2 = {V, V}; f32x2 acc2 = {0.f, 0.f}; _Pragma("unroll") for (int d4 = 0; d4 < 8; ++d4) { \
            const f32x2 fa = {F[d4].x, F[d4].y}, fb = {F[d4].z, F[d4].w}; \
            st[2 * d4] = fa * (st[2 * d4] - vv2) + vv2; st[2 * d4 + 1] = fb * (st[2 * d4 + 1] - vv2) + vv2; \
            if (OUT) { const f32x2 qa = {Q[d4].x, Q[d4].y}, qb = {Q[d4].z, Q[d4].w}; acc2 = qa * st[2 * d4] + acc2; acc2 = qb * st[2 * d4 + 1] + acc2; } } \
            if (OUT) op[(dg * 32 + (tt_)) * 128 + v] = acc2.x + acc2.y; } while (0)
        HG_LOAD(fA, qA, vA, 0);
#pragma unroll 1
        for (int tt = 0; tt < 32; tt += 2) {
            HG_LOAD(fB, qB, vB, tt + 1);
            __builtin_amdgcn_sched_barrier(0);
            HG_STEP(fA, qA, vA, tt);
            __builtin_amdgcn_sched_barrier(0);
            if (tt + 2 < 32) HG_LOAD(fA, qA, vA, tt + 2);
            __builtin_amdgcn_sched_barrier(0);
            HG_STEP(fB, qB, vB, tt + 1);
            __builtin_amdgcn_sched_barrier(0);
        }
#undef HG_LOAD
#undef HG_STEP
        if (OUT) {
            __syncthreads();
#pragma unroll
            for (int k = 0; k < 4; ++k) { const int tt = wave + 8 * k; float o0 = 0.f, o1 = 0.f;
#pragma unroll
                for (int g = 0; g < 4; ++g) { o0 += op[(g * 32 + tt) * 128 + lane]; o1 += op[(g * 32 + tt) * 128 + lane + 64]; }
                const float ms = wave_sum(o0 * o0 + o1 * o1) * (1.f / 128.f), r = 1.f / sqrtf(ms + 1e-6f);
                const bf16* grow = h + (t0 + tt) * NC_H + 2304 + hh * 128; const float g0 = bf2f(grow[lane]), g1 = bf2f(grow[lane + 64]);
                bf16* mrow = mix + (t0 + tt) * 1024 + hh * 128;
                mrow[lane] = (bf16)f2bf(o0 * r * normg[lane] * sigmoidf_(g0)); mrow[lane + 64] = (bf16)f2bf(o1 * r * normg[lane + 64] * sigmoidf_(g1)); }
        }
        __syncthreads();
    }
    if (!OUT) {
#pragma unroll
        for (int dd = 0; dd < 16; ++dd) { Sp[(2 * dd) * 128] = st[dd].x; Sp[(2 * dd + 1) * 128] = st[dd].y; }
        if (tid < 128) Dseg[(size_t)unit * 128 + tid] = dprod;
    }
}
constexpr int HG_G = 0, HG_QT = 32768, HG_KT = 50176, HG_KE = 67584, HG_VT = 86016, HG_ST = 104448, HG_GM = 139264, HG_GE = 139776, HG_PART = 140288;
static_assert(HG_PART + 2048 <= MISC_OFF, "HGRN LDS map");
__device__ __forceinline__ int crow16(int i, int hf) { return (i & 3) + 8 * (i >> 2) + 4 * hf; }
template <bool OUT>
__device__ __forceinline__ void hgrn_mfma(LAS unsigned char* lds, const bf16* h, const float* lbl, int j, const float* normg, float* Sloc, float* Dseg, bf16* mix, int unit, int tid, int wave, int lane) {
    const int seg = unit & (HNSEG - 1), bh = unit >> 6, hh = bh % HG_H, b = bh / HG_H;
    const int r = lane & 31, hf = lane >> 5, tr = wave & 1, vq = wave >> 1;
    LAS float* G = (LAS float*)(lds + HG_G); LAS float* GM = (LAS float*)(lds + HG_GM); LAS float* GE = (LAS float*)(lds + HG_GE); LAS float* PART = (LAS float*)(lds + HG_PART);
    const int stok = tid >> 3, c16 = (tid & 7) * 16, sperm = (stok & ~15) | (stok & 3) | ((stok & 4) << 1) | ((stok & 8) >> 1);
    const int cd = tid & 127, cpart = tid >> 7;
    float lb[16];
#pragma unroll
    for (int e = 0; e < 16; ++e) { lb[e] = 0.f; if (j > 0) { const float a0 = lbl[hh * 128 + c16 + e], a1 = lbl[MIXW + hh * 128 + c16 + e]; lb[e] = 1.f / (1.f + __expf(a0 - a1)); } }
    f32x16 S[2];
    float* Sp = Sloc + (size_t)unit * 16384 + 32 * vq + r;
#pragma unroll
    for (int dd = 0; dd < 2; ++dd)
#pragma unroll
        for (int i = 0; i < 16; ++i) S[dd][i] = OUT ? Sp[(32 * (2 * tr + dd) + crow16(i, hf)) * 128] : 0.f;
    float gsum = 0.f;
    float ng16[16];
#pragma unroll
    for (int e = 0; e < 16; ++e) ng16[e] = OUT ? normg[c16 + e] : 0.f;
    v4u nf8[2], ni8[2], nq8[2] = {{0u, 0u, 0u, 0u}, {0u, 0u, 0u, 0u}}, ng8[2] = {{0u, 0u, 0u, 0u}, {0u, 0u, 0u, 0u}};
#define HG_RAWLOAD(t0_) do { const bf16* row_ = h + ((t0_) + stok) * NC_H + hh * 128 + c16; nf8[0] = *(const v4u*)(row_ + 768); nf8[1] = *(const v4u*)(row_ + 776); ni8[0] = *(const v4u*)(row_ + 1536); ni8[1] = *(const v4u*)(row_ + 1544); \
        if (OUT) { nq8[0] = *(const v4u*)row_; nq8[1] = *(const v4u*)(row_ + 8); ng8[0] = *(const v4u*)(row_ + 2304); ng8[1] = *(const v4u*)(row_ + 2312); } } while (0)
    HG_RAWLOAD((size_t)b * SEQ + seg * HSEG);
    for (int ch = 0; ch < HSEG / 64; ++ch) {
        const size_t t0 = (size_t)b * SEQ + seg * HSEG + ch * 64;
        float fg[16], qv[16]; v4u i8[2], g8[2];
        { const v4u f8[2] = {nf8[0], nf8[1]}; i8[0] = ni8[0]; i8[1] = ni8[1]; const v4u q8[2] = {nq8[0], nq8[1]}; g8[0] = ng8[0]; g8[1] = ng8[1];
#pragma unroll
          for (int w = 0; w < 8; ++w) { const unsigned fw = f8[w >> 2][w & 3]; const float f0 = bflo(fw), f1 = bfhi(fw);
              fg[2 * w] = lb[2 * w] + (1.f - lb[2 * w]) * sigmoidf_(f0); fg[2 * w + 1] = lb[2 * w + 1] + (1.f - lb[2 * w + 1]) * sigmoidf_(f1);
              if (OUT) { const unsigned qw = q8[w >> 2][w & 3]; const float q0 = bflo(qw), q1 = bfhi(qw); qv[2 * w] = q0 * sigmoidf_(q0); qv[2 * w + 1] = q1 * sigmoidf_(q1); } else { qv[2 * w] = 0.f; qv[2 * w + 1] = 0.f; } }
#pragma unroll
          for (int e4 = 0; e4 < 4; ++e4) { f32x4 lg; lg.x = __builtin_amdgcn_logf(fg[4 * e4]); lg.y = __builtin_amdgcn_logf(fg[4 * e4 + 1]); lg.z = __builtin_amdgcn_logf(fg[4 * e4 + 2]); lg.w = __builtin_amdgcn_logf(fg[4 * e4 + 3]);
              *(LAS f32x4*)(G + stok * 128 + c16 + 4 * e4) = lg; } }
        __syncthreads();
        { float run = 0.f;
#pragma unroll
          for (int k = 0; k < 16; ++k) run += G[(16 * cpart + k) * 128 + cd];
          PART[cpart * 128 + cd] = run; }
        __syncthreads();
        { float run = 0.f;
#pragma unroll
          for (int pp = 0; pp < 3; ++pp) run += (pp < cpart) ? PART[pp * 128 + cd] : 0.f;
#pragma unroll
          for (int k = 0; k < 16; ++k) { run += G[(16 * cpart + k) * 128 + cd]; G[(16 * cpart + k) * 128 + cd] = run; }
          if (cpart == 1) GM[cd] = run;
          if (cpart == 3) { GE[cd] = run; gsum += run; } }
        __syncthreads();
        if (OUT) {
#pragma unroll
            for (int dd = 0; dd < 2; ++dd)
#pragma unroll
                for (int g4 = 0; g4 < 4; ++g4) { const int dbase = 32 * (2 * tr + dd) + 8 * g4 + 4 * hf; const f32x4 gm = *(const LAS f32x4*)(GM + dbase);
                    v2u w; w.x = cvtpk(S[dd][4 * g4] * __builtin_amdgcn_exp2f(gm.x), S[dd][4 * g4 + 1] * __builtin_amdgcn_exp2f(gm.y)); w.y = cvtpk(S[dd][4 * g4 + 2] * __builtin_amdgcn_exp2f(gm.z), S[dd][4 * g4 + 3] * __builtin_amdgcn_exp2f(gm.w));
                    *(LAS v2u*)(lds + HG_ST + (32 * vq + r) * 272 + dbase * 2) = w; }
        }
        { unsigned qt[8], kt[8];
#pragma unroll
          for (int e4 = 0; e4 < 4; ++e4) { const f32x4 gv = *(const LAS f32x4*)(G + stok * 128 + c16 + 4 * e4), gm = *(const LAS f32x4*)(GM + c16 + 4 * e4), ge = *(const LAS f32x4*)(GE + c16 + 4 * e4);
              float ke[4];
#pragma unroll
              for (int e = 0; e < 4; ++e) { const float kk = 1.f - fg[4 * e4 + e]; ke[e] = kk * __builtin_amdgcn_exp2f(ge[e] - gv[e]);
                  if (OUT) { const float a = qv[4 * e4 + e] * __builtin_amdgcn_exp2f(gv[e] - gm[e]), c = kk * __builtin_amdgcn_exp2f(gm[e] - gv[e]);
                      if (e & 1) { qt[2 * e4 + (e >> 1)] |= f2bf(a) << 16; kt[2 * e4 + (e >> 1)] |= f2bf(c) << 16; } else { qt[2 * e4 + (e >> 1)] = f2bf(a); kt[2 * e4 + (e >> 1)] = f2bf(c); } } }
#pragma unroll
              for (int e = 0; e < 4; ++e) { const int col = c16 + 4 * e4 + e;
                  *(LAS bf16*)(lds + HG_KE + col * 144 + sperm * 2) = (bf16)f2bf(ke[e]);
                  const unsigned vw = i8[e4 >> 1][(2 * e4 + (e >> 1)) & 3]; *(LAS bf16*)(lds + HG_VT + col * 144 + sperm * 2) = (bf16)((e & 1) ? (vw >> 16) : (vw & 0xffffu)); } }
          if (OUT) { *(LAS v4u*)(lds + HG_QT + stok * 272 + c16 * 2) = (v4u){qt[0], qt[1], qt[2], qt[3]}; *(LAS v4u*)(lds + HG_QT + stok * 272 + c16 * 2 + 16) = (v4u){qt[4], qt[5], qt[6], qt[7]};
                     *(LAS v4u*)(lds + HG_KT + stok * 272 + c16 * 2) = (v4u){kt[0], kt[1], kt[2], kt[3]}; *(LAS v4u*)(lds + HG_KT + stok * 272 + c16 * 2 + 16) = (v4u){kt[4], kt[5], kt[6], kt[7]}; } }
        __syncthreads();
        if (ch + 1 < HSEG / 64) HG_RAWLOAD(t0 + 64);
        if (OUT) {
            f32x16 X0, X1, O;
#pragma unroll
            for (int i = 0; i < 16; ++i) { X0[i] = 0.f; X1[i] = 0.f; O[i] = 0.f; }
            const LAS unsigned char* qtp = lds + HG_QT + (32 * tr + r) * 272 + hf * 16;
#pragma unroll
            for (int ks = 0; ks < 8; ++ks) { const s16x8 bq = *(const LAS s16x8*)(qtp + ks * 32);
                const s16x8 a0 = *(const LAS s16x8*)(lds + HG_KT + r * 272 + hf * 16 + ks * 32); X0 = __builtin_amdgcn_mfma_f32_32x32x16_bf16(a0, bq, X0, 0, 0, 0);
                if (tr == 1) { const s16x8 a1 = *(const LAS s16x8*)(lds + HG_KT + (32 + r) * 272 + hf * 16 + ks * 32); X1 = __builtin_amdgcn_mfma_f32_32x32x16_bf16(a1, bq, X1, 0, 0, 0); } }
#pragma unroll
            for (int i = 0; i < 16; ++i) { const bool keep = crow16(i, hf) <= r; if (tr == 0) X0[i] = keep ? X0[i] : 0.f; else X1[i] = keep ? X1[i] : 0.f; }
            const LAS unsigned char* vtp = lds + HG_VT + (32 * vq + r) * 144 + hf * 16;
#pragma unroll
            for (int s2 = 0; s2 < 2; ++s2) { v4u pw; pw.x = cvtpk(X0[8 * s2], X0[8 * s2 + 1]); pw.y = cvtpk(X0[8 * s2 + 2], X0[8 * s2 + 3]); pw.z = cvtpk(X0[8 * s2 + 4], X0[8 * s2 + 5]); pw.w = cvtpk(X0[8 * s2 + 6], X0[8 * s2 + 7]);
                const s16x8 bv = *(const LAS s16x8*)(vtp + (16 * s2) * 2); O = __builtin_amdgcn_mfma_f32_32x32x16_bf16(__builtin_bit_cast(s16x8, pw), bv, O, 0, 0, 0); }
            if (tr == 1) {
#pragma unroll
                for (int s2 = 0; s2 < 2; ++s2) { v4u pw; pw.x = cvtpk(X1[8 * s2], X1[8 * s2 + 1]); pw.y = cvtpk(X1[8 * s2 + 2], X1[8 * s2 + 3]); pw.z = cvtpk(X1[8 * s2 + 4], X1[8 * s2 + 5]); pw.w = cvtpk(X1[8 * s2 + 6], X1[8 * s2 + 7]);
                    const s16x8 bv = *(const LAS s16x8*)(vtp + (32 + 16 * s2) * 2); O = __builtin_amdgcn_mfma_f32_32x32x16_bf16(__builtin_bit_cast(s16x8, pw), bv, O, 0, 0, 0); } }
            const LAS unsigned char* stp = lds + HG_ST + (32 * vq + r) * 272 + hf * 16;
#pragma unroll
            for (int ks = 0; ks < 8; ++ks) { const s16x8 aq = *(const LAS s16x8*)(qtp + ks * 32), bs = *(const LAS s16x8*)(stp + ks * 32); O = __builtin_amdgcn_mfma_f32_32x32x16_bf16(aq, bs, O, 0, 0, 0); }
#pragma unroll
            for (int i = 0; i < 16; ++i) G[(32 * tr + crow16(i, hf)) * 128 + 32 * vq + r] = O[i];
        }
#pragma unroll
        for (int dd = 0; dd < 2; ++dd) { const int dr = 2 * tr + dd;
#pragma unroll
            for (int g4 = 0; g4 < 4; ++g4) { const f32x4 ge = *(const LAS f32x4*)(GE + 32 * dr + 8 * g4 + 4 * hf);
                S[dd][4 * g4] *= __builtin_amdgcn_exp2f(ge.x); S[dd][4 * g4 + 1] *= __builtin_amdgcn_exp2f(ge.y); S[dd][4 * g4 + 2] *= __builtin_amdgcn_exp2f(ge.z); S[dd][4 * g4 + 3] *= __builtin_amdgcn_exp2f(ge.w); }
#pragma unroll
            for (int ks = 0; ks < 4; ++ks) { const s16x8 a = *(const LAS s16x8*)(lds + HG_KE + (32 * dr + r) * 144 + hf * 16 + ks * 32), bv = *(const LAS s16x8*)(lds + HG_VT + (32 * vq + r) * 144 + hf * 16 + ks * 32);
                S[dd] = __builtin_amdgcn_mfma_f32_32x32x16_bf16(a, bv, S[dd], 0, 0, 0); } }
        __syncthreads();
        if (OUT) {
            float ov[16]; float ss = 0.f;
#pragma unroll
            for (int e4 = 0; e4 < 4; ++e4) { const f32x4 o4 = *(const LAS f32x4*)(G + stok * 128 + c16 + 4 * e4); ov[4 * e4] = o4.x; ov[4 * e4 + 1] = o4.y; ov[4 * e4 + 2] = o4.z; ov[4 * e4 + 3] = o4.w;
                ss += (o4.x * o4.x + o4.y * o4.y) + (o4.z * o4.z + o4.w * o4.w); }
            ss += xorf<1>(ss); ss += xorf<2>(ss); ss += xorf<4>(ss);
            const float rr = 1.f / sqrtf(ss * (1.f / 128.f) + 1e-6f);
            unsigned ow[8];
#pragma unroll
            for (int w = 0; w < 8; ++w) { const unsigned gw_ = g8[w >> 2][w & 3]; ow[w] = cvtpk(ov[2 * w] * rr * ng16[2 * w] * sigmoidf_(bflo(gw_)), ov[2 * w + 1] * rr * ng16[2 * w + 1] * sigmoidf_(bfhi(gw_))); }
            bf16* mrow = mix + (t0 + stok) * 1024 + hh * 128 + c16;
            *(v4u*)mrow = (v4u){ow[0], ow[1], ow[2], ow[3]}; *(v4u*)(mrow + 8) = (v4u){ow[4], ow[5], ow[6], ow[7]};
            __syncthreads();
        }
    }
#undef HG_RAWLOAD
    if (!OUT) {
#pragma unroll
        for (int dd = 0; dd < 2; ++dd)
#pragma unroll
            for (int i = 0; i < 16; ++i) Sp[(32 * (2 * tr + dd) + crow16(i, hf)) * 128] = S[dd][i];
        if (cpart == 3) Dseg[(size_t)unit * 128 + cd] = __builtin_amdgcn_exp2f(gsum);
    }
}
__device__ __forceinline__ void hgrn_scan(float* Sloc, const float* Dseg, size_t gtid, size_t gthreads) {
    for (size_t idx = gtid; idx < (size_t)NBATCH * HG_H * 16384; idx += gthreads) { const int bh = (int)(idx >> 14), e = (int)(idx & 16383), d = e >> 7; float cur = 0.f;
        float* __restrict__ sp = Sloc + (size_t)bh * HNSEG * 16384 + e; const float* __restrict__ dp = Dseg + (size_t)bh * HNSEG * 128 + d;
        for (int s0 = 0; s0 < HNSEG; s0 += 16) { float tv[16], dv[16];
#pragma unroll
            for (int k = 0; k < 16; ++k) { tv[k] = sp[(size_t)(s0 + k) * 16384]; dv[k] = dp[(s0 + k) * 128]; }
#pragma unroll
            for (int k = 0; k < 16; ++k) { sp[(size_t)(s0 + k) * 16384] = cur; cur = dv[k] * cur + tv[k]; } } }
}

template <bool MASK>
__device__ __forceinline__ void attn4(const LAS unsigned* Ks, const LAS bf16* Vs, const LAS float* qst, LAS float* pb, int lane, const int (&tq)[4], int kbase, float slope,
                                      float (&mo)[4], float (&lo)[4], float (&oo)[4]) {
    float sc[4][4];
#pragma unroll
    for (int a = 0; a < 4; ++a)
#pragma unroll
        for (int c = 0; c < 4; ++c) sc[a][c] = 0.f;
#pragma unroll 4
    for (int dd = 0; dd < 32; ++dd) {
        f32x2 qv[4];
#pragma unroll
        for (int qi = 0; qi < 4; ++qi) qv[qi] = *(const LAS f32x2*)(qst + qi * 64 + 2 * dd);
#pragma unroll
        for (int kk = 0; kk < 4; ++kk) { const unsigned kw = Ks[(lane + 64 * kk) * 33 + dd]; const float k0 = bflo(kw), k1 = bfhi(kw);
#pragma unroll
            for (int qi = 0; qi < 4; ++qi) sc[qi][kk] += qv[qi].x * k0 + qv[qi].y * k1; }
    }
#pragma unroll
    for (int qi = 0; qi < 4; ++qi) { float mx = -INFINITY;
#pragma unroll
        for (int kk = 0; kk < 4; ++kk) { const int pos = kbase + lane + 64 * kk; float lg = sc[qi][kk] * 0.125f - slope * (float)(tq[qi] - pos); if (MASK && pos > tq[qi]) lg = -INFINITY; sc[qi][kk] = lg; mx = fmaxf(mx, lg); }
        mx = wave_max(mx); float s = 0.f;
#pragma unroll
        for (int kk = 0; kk < 4; ++kk) { const float p = __builtin_amdgcn_exp2f((sc[qi][kk] - mx) * 1.4426950408889634f); pb[qi * 256 + lane + 64 * kk] = p; s += p; }
        lo[qi] = wave_sum(s); mo[qi] = mx; }
    float o[4] = {0.f, 0.f, 0.f, 0.f};
#pragma unroll 4
    for (int k4 = 0; k4 < 64; ++k4) { f32x4 p4[4];
#pragma unroll
        for (int qi = 0; qi < 4; ++qi) p4[qi] = *(const LAS f32x4*)(pb + qi * 256 + 4 * k4);
#pragma unroll
        for (int jj = 0; jj < 4; ++jj) { const float vv = bf2f(Vs[(4 * k4 + jj) * 64 + lane]);
#pragma unroll
            for (int qi = 0; qi < 4; ++qi) o[qi] += p4[qi][jj] * vv; } }
#pragma unroll
    for (int qi = 0; qi < 4; ++qi) oo[qi] = o[qi];
}
constexpr int AT_KS = 0, AT_VS = 33792, AT_WV = 66560, AT_WVB = 5120;

__device__ __forceinline__ void memattn_unit(LAS unsigned char* lds, const bf16* h, int NC, int qoff, const bf16* kv, bf16* mix, int unit, int tid, int wave, int lane) {
    const int chunk = unit & 31, bm = unit >> 5, mh = bm & 3, b = bm >> 2;
    LAS unsigned* Ks = (LAS unsigned*)(lds + AT_KS); LAS unsigned* Vs32 = (LAS unsigned*)(lds + AT_VS);
    LAS float* qst = (LAS float*)(lds + AT_WV + wave * AT_WVB); LAS float* pb = qst + 256;
    for (int i = 0; i < 16; ++i) { const int idx = tid + 512 * i, r = idx >> 5, dd = idx & 31; const unsigned* src = (const unsigned*)(kv + (size_t)(b * 256 + r) * 512 + mh * 64);
        Ks[r * 33 + dd] = src[dd]; Vs32[r * 32 + dd] = src[128 + dd]; }
    __syncthreads();
    for (int qd = 0; qd < 16; ++qd) { const size_t tg = (size_t)b * SEQ + chunk * 512 + wave * 64 + qd * 4;
#pragma unroll
        for (int qi = 0; qi < 4; ++qi) qst[qi * 64 + lane] = bf2f(h[(tg + qi) * NC + qoff + mh * 64 + lane]);
        const int tq[4] = {0, 0, 0, 0}; float m[4], l[4], o[4];
        attn4<false>(Ks, (const LAS bf16*)Vs32, qst, pb, lane, tq, 0, 0.f, m, l, o);
#pragma unroll
        for (int qi = 0; qi < 4; ++qi) mix[(tg + qi) * 1024 + MIXW + mh * 64 + lane] = (bf16)f2bf(o[qi] / l[qi]); }
    __syncthreads();
}

constexpr int AT2_K = 0, AT2_KROW = 176, AT2_V = 256 * AT2_KROW, AT2_VROW = 528, AT2_SCR = AT2_V + 64 * AT2_VROW, AT2_SCRW = 4864;
__device__ __forceinline__ void stage_kv_images(LAS unsigned char* lds, const bf16* kp, const bf16* vp, size_t row_stride, int tid) {
    v4u kx[4], vx[4];
#pragma unroll
    for (int i = 0; i < 4; ++i) { const int idx = tid + 512 * i, key = idx >> 3, c = idx & 7; kx[i] = *(const v4u*)(kp + (size_t)key * row_stride + 8 * c); vx[i] = *(const v4u*)(vp + (size_t)key * row_stride + 8 * c); }
    __builtin_amdgcn_sched_barrier(0);
#pragma unroll
    for (int i = 0; i < 4; ++i) { const int idx = tid + 512 * i, key = idx >> 3, c = idx & 7;
        *(LAS v4u*)(lds + AT2_K + key * AT2_KROW + c * 16) = kx[i];
        const int pos = (key & ~15) | (key & 3) | ((key & 4) << 1) | ((key & 8) >> 1);
        LAS bf16* vt = (LAS bf16*)(lds + AT2_V) + pos;
#pragma unroll
        for (int w = 0; w < 4; ++w) { vt[(8 * c + 2 * w) * (AT2_VROW / 2)] = (bf16)(vx[i][w] & 0xffffu); vt[(8 * c + 2 * w + 1) * (AT2_VROW / 2)] = (bf16)(vx[i][w] >> 16); } }
    if (tid < 256) { const unsigned pb = f2bf((float)tid); const v4u e0 = {pb | (pb << 16), 0u, 0u, 0u}, z = {0u, 0u, 0u, 0u};
        *(LAS v4u*)(lds + AT2_K + tid * AT2_KROW + 128) = e0; *(LAS v4u*)(lds + AT2_K + tid * AT2_KROW + 144) = z; }
}
template <bool MASK>
__device__ __forceinline__ void attn_tile32(const LAS unsigned char* lds, const s16x8 (&qf)[4], int lane, float dist0, unsigned qx, bool own, f32x16 (&o)[2], float& mrow, float& lrow) {
    const int r = lane & 31, hf = lane >> 5;
    const v4u qxv = {qx, 0u, 0u, 0u}; const s16x8 qe = __builtin_bit_cast(s16x8, qxv);
    f32x16 acc[8];
    const LAS unsigned char* kb = lds + AT2_K + r * AT2_KROW + hf * 16;
    constexpr int NKS = MASK ? 5 : 4;
    s16x8 kf[NKS];
#pragma unroll
    for (int s = 0; s < NKS; ++s) kf[s] = *(const LAS s16x8*)(kb + s * 32);
#pragma unroll
    for (int kt = 0; kt < 8; ++kt) {
#pragma unroll
        for (int i = 0; i < 16; ++i) acc[kt][i] = 0.f;
#pragma unroll
        for (int s = 0; s < NKS; ++s) { acc[kt] = __builtin_amdgcn_mfma_f32_32x32x16_bf16(kf[s], s < 4 ? qf[s < 4 ? s : 0] : qe, acc[kt], 0, 0, 0);
            if (kt + 1 < 8) kf[s] = *(const LAS s16x8*)(kb + (kt + 1) * 32 * AT2_KROW + s * 32); }
        __builtin_amdgcn_sched_barrier(0); }
    float mx = -INFINITY;
    if (MASK && own) { const float base2 = dist0 - 4.f * (float)hf;
#pragma unroll
        for (int kt = 0; kt < 8; ++kt)
#pragma unroll
            for (int i = 0; i < 16; ++i) { const float dist = base2 - (float)(32 * kt + (i & 3) + 8 * (i >> 2)); const float lg = dist < 0.f ? -INFINITY : acc[kt][i]; acc[kt][i] = lg; mx = fmaxf(mx, lg); }
    } else {
#pragma unroll
        for (int kt = 0; kt < 8; ++kt)
#pragma unroll
            for (int i = 0; i < 16; ++i) mx = fmaxf(mx, acc[kt][i]);
    }
    mx = fmaxf(mx, xor32f(mx, lane));
    float sum = 0.f;
#pragma unroll
    for (int i = 0; i < 16; ++i) { o[0][i] = 0.f; o[1][i] = 0.f; }
    const LAS unsigned char* vb = lds + AT2_V + r * AT2_VROW + hf * 16;
    s16x8 vf[4];
#pragma unroll
    for (int s2 = 0; s2 < 2; ++s2)
#pragma unroll
        for (int dt = 0; dt < 2; ++dt) vf[2 * s2 + dt] = *(const LAS s16x8*)(vb + dt * 32 * AT2_VROW + (16 * s2) * 2);
#pragma unroll
    for (int kt = 0; kt < 8; ++kt) {
#pragma unroll
        for (int i = 0; i < 16; ++i) { const float p = __builtin_amdgcn_exp2f(acc[kt][i] - mx); sum += p; acc[kt][i] = p; }
#pragma unroll
        for (int s2 = 0; s2 < 2; ++s2) { v4u pw; pw.x = cvtpk(acc[kt][8 * s2], acc[kt][8 * s2 + 1]); pw.y = cvtpk(acc[kt][8 * s2 + 2], acc[kt][8 * s2 + 3]);
            pw.z = cvtpk(acc[kt][8 * s2 + 4], acc[kt][8 * s2 + 5]); pw.w = cvtpk(acc[kt][8 * s2 + 6], acc[kt][8 * s2 + 7]); const s16x8 pf = __builtin_bit_cast(s16x8, pw);
#pragma unroll
            for (int dt = 0; dt < 2; ++dt) { o[dt] = __builtin_amdgcn_mfma_f32_32x32x16_bf16(vf[2 * s2 + dt], pf, o[dt], 0, 0, 0);
                if (kt + 1 < 8) vf[2 * s2 + dt] = *(const LAS s16x8*)(vb + dt * 32 * AT2_VROW + (32 * (kt + 1) + 16 * s2) * 2); } }
        __builtin_amdgcn_sched_barrier(0); }
    sum += xor32f(sum, lane);
    mrow = mx; lrow = sum;
}
__device__ __forceinline__ void memattn_unit2(LAS unsigned char* lds, const bf16* h, int NC, int qoff, const bf16* kv  , bf16* mix, int unit, int tid, int wave, int lane) {
    const int chunk = unit & 63, bm = unit >> 6, mh = bm & 3, b = bm >> 2, r = lane & 31, hf = lane >> 5;
    const bf16* kvrow0 = kv + (size_t)(b * 256) * 2048 + mh * 64;
    stage_kv_images(lds, kvrow0, kvrow0 + 256, 2048, tid);
    __syncthreads();
    { const size_t tg = (size_t)b * SEQ + chunk * 256 + wave * 32 + r;
        f32x16 o[2]; float m2, l; s16x8 qf[4];
#pragma unroll
        for (int s = 0; s < 4; ++s) qf[s] = *(const s16x8*)(h + tg * NC + qoff + mh * 64 + 16 * s + 8 * hf);
        attn_tile32<false>(lds, qf, lane, 0.f, 0u, false, o, m2, l);
        const float inv = 1.f / l; bf16* mp = mix + tg * 1024 + MIXW + mh * 64 + 4 * hf;
#pragma unroll
        for (int dt = 0; dt < 2; ++dt)
#pragma unroll
            for (int g = 0; g < 4; ++g) { v2u w; w.x = cvtpk(o[dt][4 * g] * inv, o[dt][4 * g + 1] * inv); w.y = cvtpk(o[dt][4 * g + 2] * inv, o[dt][4 * g + 3] * inv); *(v2u*)(mp + 32 * dt + 8 * g) = w; } }
    __syncthreads();
}
__device__ __forceinline__ void kmean_unit(LAS unsigned char* lds, const bf16* h, float* kmean, int unit, int tid) {
    const int n = unit & 63, bh = unit >> 6, hh = bh % MB_H, b = bh / MB_H, d = tid & 63, part = tid >> 6;
    LAS float* red = (LAS float*)lds;
    float s = 0.f; const bf16* p = h + ((size_t)b * SEQ + n * 256 + part * 32) * NC_M + 768 + hh * 64 + d;
    for (int i = 0; i < 32; ++i) s += bf2f(p[(size_t)i * NC_M]);
    red[part * 64 + d] = s; __syncthreads();
    if (tid < 64) { float a = 0.f; for (int pp = 0; pp < 8; ++pp) a += red[pp * 64 + tid]; kmean[((size_t)bh * 64 + n) * 64 + tid] = a * (1.f / 256.f); }
    __syncthreads();
}
__device__ __forceinline__ void moba_gate_unit(LAS unsigned char* lds, const bf16* h, const float* kmean, unsigned* gcount, int* selinfo, unsigned* list, int unit, int tid) {
    const int c = unit & 63, bh = unit >> 6, hh = bh % MB_H, b = bh / MB_H;
    LAS float* km = (LAS float*)lds; LAS int* hist = (LAS int*)(lds + 16384); LAS int* base = hist + 64;
    for (int i = tid; i < 4096; i += NTHR) km[i] = kmean[(size_t)bh * 4096 + i];
    if (tid < 64) hist[tid] = 0;
    __syncthreads();
    int s0 = 0, s1 = 0, s2 = 0, r0 = 0, r1 = 0, r2 = 0, ns = 0; const int t = c * 256 + tid;
    if (tid < 256) {
        float q[64]; const v4u* qp = (const v4u*)(h + ((size_t)b * SEQ + t) * NC_M + hh * 64);
#pragma unroll
        for (int w = 0; w < 8; ++w) { const v4u x = qp[w]; q[8 * w] = bflo(x.x); q[8 * w + 1] = bfhi(x.x); q[8 * w + 2] = bflo(x.y); q[8 * w + 3] = bfhi(x.y); q[8 * w + 4] = bflo(x.z); q[8 * w + 5] = bfhi(x.z); q[8 * w + 6] = bflo(x.w); q[8 * w + 7] = bfhi(x.w); }
        float v0 = -INFINITY, v1 = -INFINITY, v2 = -INFINITY;
        for (int n = 0; n < c; ++n) { f32x2 g2 = {0.f, 0.f};
#pragma unroll
            for (int d4 = 0; d4 < 16; ++d4) { const f32x4 k4 = *(const LAS f32x4*)(km + n * 64 + 4 * d4); const f32x2 ka_ = {k4.x, k4.y}, kb_ = {k4.z, k4.w}, qa_ = {q[4 * d4], q[4 * d4 + 1]}, qb_ = {q[4 * d4 + 2], q[4 * d4 + 3]}; g2 = qa_ * ka_ + g2; g2 = qb_ * kb_ + g2; }
            const float g = g2.x + g2.y;
            if (g > v0) { v2 = v1; s2 = s1; v1 = v0; s1 = s0; v0 = g; s0 = n; } else if (g > v1) { v2 = v1; s2 = s1; v1 = g; s1 = n; } else if (g > v2) { v2 = g; s2 = n; } }
        ns = c < 3 ? c : 3;
        if (ns > 0) r0 = __hip_atomic_fetch_add(hist + s0, 1, __ATOMIC_RELAXED, __HIP_MEMORY_SCOPE_WORKGROUP);
        if (ns > 1) r1 = __hip_atomic_fetch_add(hist + s1, 1, __ATOMIC_RELAXED, __HIP_MEMORY_SCOPE_WORKGROUP);
        if (ns > 2) r2 = __hip_atomic_fetch_add(hist + s2, 1, __ATOMIC_RELAXED, __HIP_MEMORY_SCOPE_WORKGROUP);
        selinfo[((size_t)b * SEQ + t) * MB_H + hh] = ns;
    }
    __syncthreads();
    if (tid < 64) { const int hc = hist[tid]; if (hc > 0) base[tid] = (int)__hip_atomic_fetch_add(gcount + bh * 64 + tid, (unsigned)hc, __ATOMIC_RELAXED, __HIP_MEMORY_SCOPE_AGENT); }
    __syncthreads();
    if (tid < 256) { unsigned* lp = list + ((size_t)bh * 64 << 14);
        if (ns > 0) lp[((size_t)s0 << 14) + base[s0] + r0] = (unsigned)t;
        if (ns > 1) lp[((size_t)s1 << 14) + base[s1] + r1] = (unsigned)t | (1u << 14);
        if (ns > 2) lp[((size_t)s2 << 14) + base[s2] + r2] = (unsigned)t | (2u << 14); }
    __syncthreads();
}
__device__ __forceinline__ void moba_attn_item(LAS unsigned char* lds, const bf16* h, const unsigned* gcount, const unsigned* list, float* po, float* pml, int item, int tid, int wave, int lane) {
    const int n = item / 24, bh = item - n * 24, hh = bh % MB_H, b = bh / MB_H;
    LAS unsigned* Ks = (LAS unsigned*)(lds + AT_KS); LAS unsigned* Vs32 = (LAS unsigned*)(lds + AT_VS);
    LAS float* qst = (LAS float*)(lds + AT_WV + wave * AT_WVB); LAS float* pb = qst + 256;
    for (int i = 0; i < 16; ++i) { const int idx = tid + 512 * i, r = idx >> 5, dd = idx & 31; const unsigned* src = (const unsigned*)(h + ((size_t)b * SEQ + n * 256 + r) * NC_M + hh * 64);
        Ks[r * 33 + dd] = src[384 + dd]; Vs32[r * 32 + dd] = src[768 + dd]; }
    __syncthreads();
    const int cnt = (int)gcount[bh * 64 + n], total = 256 + cnt, nquads = (total + 3) >> 2;
    const float slope = hh < 8 ? ldexpf(1.0f, -(hh + 1)) : ldexpf(0.70710678118654752f, -(hh - 8));
    const unsigned* lp = list + (((size_t)bh * 64 + n) << 14);
    for (int quad = wave; quad < nquads; quad += 8) {
        int tq[4], slot[4];
#pragma unroll
        for (int qi = 0; qi < 4; ++qi) { int idx = quad * 4 + qi; idx = idx < total ? idx : total - 1;
            if (idx < 256) { tq[qi] = n * 256 + idx; slot[qi] = 3; } else { const unsigned e = lp[idx - 256]; tq[qi] = (int)(e & 16383u); slot[qi] = (int)(e >> 14); } }
#pragma unroll
        for (int qi = 0; qi < 4; ++qi) qst[qi * 64 + lane] = bf2f(h[((size_t)b * SEQ + tq[qi]) * NC_M + hh * 64 + lane]);
        float m[4], l[4], o[4];
        attn4<true>(Ks, (const LAS bf16*)Vs32, qst, pb, lane, tq, n * 256, slope, m, l, o);
#pragma unroll
        for (int qi = 0; qi < 4; ++qi) if (quad * 4 + qi < total) { const size_t pi = (((size_t)b * SEQ + tq[qi]) * MB_H + hh) * 4 + slot[qi];
            po[pi * 64 + lane] = o[qi]; if (lane == 0) { pml[pi * 2] = m[qi]; pml[pi * 2 + 1] = l[qi]; } }
    }
    __syncthreads();
}

__device__ __forceinline__ void moba_attn_item2(LAS unsigned char* lds, const bf16* h, const unsigned* gcount, const unsigned* list, bf16* po, float* pml, int item, int tid, int wave, int lane) {
    const int n = item / 24, bh = item - n * 24, hh = bh % MB_H, b = bh / MB_H, r = lane & 31, hf = lane >> 5;
    const bf16* hrow0 = h + ((size_t)b * SEQ + n * 256) * NC_M + hh * 64;
    stage_kv_images(lds, hrow0 + 768, hrow0 + 1536, NC_M, tid);
    __syncthreads();
    const int cnt = (int)gcount[bh * 64 + n], total = 256 + cnt, ntiles = (total + 31) >> 5;
    const float slope2 = (hh < 8 ? ldexpf(1.0f, -(hh + 1)) : ldexpf(0.70710678118654752f, -(hh - 8))) * 1.4426950408889634f;
    const unsigned shi = f2bf(slope2), slo = f2bf(slope2 - __builtin_bit_cast(float, shi << 16)); const unsigned qx = hf == 0 ? (shi | (slo << 16)) : 0u;
    const unsigned* lp = list + (((size_t)bh * 64 + n) << 14);
    const bf16* hq = h + (size_t)b * SEQ * NC_M + hh * 64 + 8 * hf;
#pragma unroll 1
    for (int tile = wave; tile < ntiles; tile += NWAVES) {
        int idx = tile * 32 + r; const bool valid = idx < total; idx = valid ? idx : total - 1;
        int tq, slot; if (idx < 256) { tq = n * 256 + idx; slot = 3; } else { const unsigned e = lp[idx - 256]; tq = (int)(e & 16383u); slot = (int)(e >> 14); }
        s16x8 qf[4]; { const bf16* qp = hq + (size_t)tq * NC_M;
#pragma unroll
            for (int s = 0; s < 4; ++s) qf[s] = *(const s16x8*)(qp + 16 * s); }
        f32x16 o[2]; float m2, l; const float dist0 = (float)(tq - n * 256);
        attn_tile32<true>(lds, qf, lane, dist0, qx, tile < 8, o, m2, l);
        { LAS unsigned char* sw = lds + AT2_SCR + wave * AT2_SCRW; const int pi = valid ? (int)((((size_t)b * SEQ + tq) * MB_H + hh) * 4 + slot) : -1;
#pragma unroll
          for (int dt = 0; dt < 2; ++dt)
#pragma unroll
              for (int g = 0; g < 4; ++g) { v2u w; w.x = cvtpk(o[dt][4 * g], o[dt][4 * g + 1]); w.y = cvtpk(o[dt][4 * g + 2], o[dt][4 * g + 3]); *(LAS v2u*)(sw + r * 144 + (32 * dt + 8 * g + 4 * hf) * 2) = w; }
          if (hf == 0) { *(LAS int*)(sw + 4608 + 4 * r) = pi; if (valid) { pml[(size_t)pi * 2] = m2 - slope2 * dist0; pml[(size_t)pi * 2 + 1] = l; } }
#pragma unroll
          for (int it = 0; it < 4; ++it) { const int q = 8 * it + (lane >> 3), c = lane & 7; const int pq = *(const LAS int*)(sw + 4608 + 4 * q); const v4u row = *(const LAS v4u*)(sw + q * 144 + c * 16);
              if (pq >= 0) *(v4u*)(po + (size_t)pq * 64 + c * 8) = row; } }
    }
    __syncthreads();
}
__device__ __forceinline__ void moba_combine(const bf16* __restrict__ po, const float* __restrict__ pml, const int* __restrict__ selinfo, bf16* __restrict__ mix, int gw, int ngw, int lane) {
    const int sub = lane >> 4, d4 = (lane & 15) * 4;
#pragma unroll 4
    for (int idx = gw * 4 + sub; idx < T * MB_H; idx += ngw * 4) { const int tg = idx / MB_H, hh = idx - tg * MB_H, ns = selinfo[idx]; const size_t p4 = (size_t)idx * 4;
        f32x2 ml[4]; f32x4 ov[4];
#pragma unroll
        for (int j = 0; j < 4; ++j) { ml[j] = ((const f32x2*)pml)[p4 + j]; const v2u ow = *(const v2u*)(po + (p4 + j) * 64 + d4); ov[j] = (f32x4){bflo(ow.x), bfhi(ow.x), bflo(ow.y), bfhi(ow.y)}; }
        float M = ml[3].x;
#pragma unroll
        for (int j = 0; j < 3; ++j) { const bool ok = j < ns; ml[j].x = ok ? ml[j].x : -INFINITY; ml[j].y = ok ? ml[j].y : 0.f; M = fmaxf(M, ml[j].x);
            ov[j].x = ok ? ov[j].x : 0.f; ov[j].y = ok ? ov[j].y : 0.f; ov[j].z = ok ? ov[j].z : 0.f; ov[j].w = ok ? ov[j].w : 0.f; }
        float den = 0.f; f32x4 num = {0.f, 0.f, 0.f, 0.f};
#pragma unroll
        for (int j = 0; j < 4; ++j) { const float w = __builtin_amdgcn_exp2f(ml[j].x - M); den += w * ml[j].y; num += ov[j] * w; }
        const float inv = 1.f / den; v2u o; o.x = pk2(num.x * inv, num.y * inv); o.y = pk2(num.z * inv, num.w * inv);
        *(v2u*)(mix + (size_t)tg * 1024 + hh * 64 + d4) = o; }
}

__device__ __forceinline__ void ln_row(f32x4 (&v)[4], const f32x4 (&gv)[4], const f32x4 (&bv)[4]) {
    float s = 0.f;
#pragma unroll
    for (int j = 0; j < 4; ++j) s += (v[j].x + v[j].y) + (v[j].z + v[j].w);
    const float mean = wave_sum(s) * (1.f / D); float s2 = 0.f;
#pragma unroll
    for (int j = 0; j < 4; ++j) { v[j] = v[j] - mean; s2 += (v[j].x * v[j].x + v[j].y * v[j].y) + (v[j].z * v[j].z + v[j].w * v[j].w); }
    const float rstd = 1.f / sqrtf(wave_sum(s2) * (1.f / D) + 1e-5f);
#pragma unroll
    for (int j = 0; j < 4; ++j) v[j] = v[j] * rstd * gv[j] + bv[j];
}
__device__ __forceinline__ void split_router_weights(const float* wr  , bf16* wrs  , size_t gtid, size_t gthreads) {
    for (size_t i = gtid; i < (size_t)DEPTH * D * NE; i += gthreads) { const int e = (int)(i & 31), d = (int)((i >> 5) & 1023), l = (int)(i >> 15);
        const float w = wr[i]; const unsigned hi = f2bf(w); const unsigned lo = f2bf(w - __builtin_bit_cast(float, hi << 16));
        wrs[(((size_t)l * 2 + 0) * NE + e) * D + d] = (bf16)hi; wrs[(((size_t)l * 2 + 1) * NE + e) * D + d] = (bf16)lo; }
}
constexpr int L1_XH = 0, L1_XL = 33024, L1_ROW = 2064, L1_PART = 66048, L1_HIST = 82432;
__device__ __forceinline__ void phase_ln1(LAS unsigned char* lds, const bf16* y, const float* g, const float* bb, const bf16* wrs  , const float* br,
                                          bf16* xbf, int* tok_e, int* tok_lr, float* tok_w, int* blk_cnt, int blk, int tid, int wave, int lane) {
    LAS float* part = (LAS float*)(lds + L1_PART);
    LAS int* hist = (LAS int*)(lds + L1_HIST);
    if (tid < 32) hist[tid] = 0;
    constexpr int TPB = T / GRID;
    const int e = lane & 31, m16 = lane & 15, quad = lane >> 4;
    s16x8 bw[4][2][2];
#pragma unroll
    for (int ks = 0; ks < 4; ++ks)
#pragma unroll
        for (int nt = 0; nt < 2; ++nt)
#pragma unroll
            for (int pp = 0; pp < 2; ++pp) bw[ks][nt][pp] = *(const s16x8*)(wrs + ((size_t)pp * NE + 16 * nt + m16) * D + wave * 128 + 32 * ks + 8 * quad);
    const float bre = br[e];
    f32x4 gv[4], bv[4];
#pragma unroll
    for (int j = 0; j < 4; ++j) { gv[j] = ((const f32x4*)g)[lane + 64 * j]; bv[j] = ((const f32x4*)bb)[lane + 64 * j]; }
    v2u xn[2][4], yn[2][4];
#pragma unroll
    for (int u = 0; u < 2; ++u) { const size_t t0 = (size_t)blk * TPB + 2 * wave + u; const v2u* xr = (const v2u*)(xbf + t0 * D) + lane; const v2u* yr = (const v2u*)(y + t0 * D) + lane;
#pragma unroll
        for (int j = 0; j < 4; ++j) { xn[u][j] = xr[64 * j]; yn[u][j] = yr[64 * j]; } }
    __syncthreads();
    for (int grp = 0; grp < TPB / 16; ++grp) { const size_t tg0 = (size_t)blk * TPB + grp * 16 + 2 * wave;
        f32x4 v[2][4];
#pragma unroll
        for (int u = 0; u < 2; ++u)
#pragma unroll
            for (int j = 0; j < 4; ++j) { const v2u xw = xn[u][j]; const v2u yw = yn[u][j];
                v[u][j].x = DN_ALPHA * bflo(xw.x) + bflo(yw.x); v[u][j].y = DN_ALPHA * bfhi(xw.x) + bfhi(yw.x); v[u][j].z = DN_ALPHA * bflo(xw.y) + bflo(yw.y); v[u][j].w = DN_ALPHA * bfhi(xw.y) + bfhi(yw.y); }
        if (grp + 1 < TPB / 16) {
#pragma unroll
            for (int u = 0; u < 2; ++u) { const v2u* xr = (const v2u*)(xbf + (tg0 + 16 + u) * D) + lane; const v2u* yr = (const v2u*)(y + (tg0 + 16 + u) * D) + lane;
#pragma unroll
                for (int j = 0; j < 4; ++j) { xn[u][j] = xr[64 * j]; yn[u][j] = yr[64 * j]; } } }
#pragma unroll
        for (int u = 0; u < 2; ++u) { ln_row(v[u], gv, bv);
            v2u* xb = (v2u*)(xbf + (tg0 + u) * D) + lane;
#pragma unroll
            for (int j = 0; j < 4; ++j) { v2u hw; hw.x = cvtpk(v[u][j].x, v[u][j].y); hw.y = cvtpk(v[u][j].z, v[u][j].w); xb[64 * j] = hw;
                v2u lw; lw.x = cvtpk(v[u][j].x - bflo(hw.x), v[u][j].y - bfhi(hw.x)); lw.y = cvtpk(v[u][j].z - bflo(hw.y), v[u][j].w - bfhi(hw.y));
                *(LAS v2u*)(lds + L1_XH + (2 * wave + u) * L1_ROW + (4 * lane + 256 * j) * 2) = hw; *(LAS v2u*)(lds + L1_XL + (2 * wave + u) * L1_ROW + (4 * lane + 256 * j) * 2) = lw; } }
        __syncthreads();
        { f32x4 acc[2] = {{0.f, 0.f, 0.f, 0.f}, {0.f, 0.f, 0.f, 0.f}};
#pragma unroll
          for (int ks = 0; ks < 4; ++ks) { const int off = m16 * L1_ROW + (wave * 128 + 32 * ks + 8 * quad) * 2;
              const s16x8 ah = *(const LAS s16x8*)(lds + L1_XH + off), al = *(const LAS s16x8*)(lds + L1_XL + off);
#pragma unroll
              for (int nt = 0; nt < 2; ++nt) { acc[nt] = __builtin_amdgcn_mfma_f32_16x16x32_bf16(ah, bw[ks][nt][0], acc[nt], 0, 0, 0); acc[nt] = __builtin_amdgcn_mfma_f32_16x16x32_bf16(ah, bw[ks][nt][1], acc[nt], 0, 0, 0);
                  acc[nt] = __builtin_amdgcn_mfma_f32_16x16x32_bf16(al, bw[ks][nt][0], acc[nt], 0, 0, 0); } }
#pragma unroll
          for (int nt = 0; nt < 2; ++nt)
#pragma unroll
              for (int jj = 0; jj < 4; ++jj) part[(wave * 16 + 4 * quad + jj) * 32 + 16 * nt + m16] = acc[nt][jj]; }
        __syncthreads();
#pragma unroll
        for (int u = 0; u < 2; ++u) { const size_t t = tg0 + u;
            float logit = bre;
#pragma unroll
            for (int w = 0; w < 8; ++w) logit += part[(w * 16 + 2 * wave + u) * 32 + e];
            int rank = 0;
#pragma unroll
            for (int q = 0; q < 32; ++q) { const float oq = __builtin_bit_cast(float, __builtin_amdgcn_readlane(__builtin_bit_cast(int, logit), q)); rank += (oq > logit || (oq == logit && q < e)) ? 1 : 0; }
            int se[4]; float sv[4];
#pragma unroll
            for (int k = 0; k < 4; ++k) { const unsigned long long mk = __ballot(rank == k && lane < 32); const int src = __builtin_ctzll(mk);
                se[k] = src; sv[k] = __builtin_bit_cast(float, __builtin_amdgcn_readlane(__builtin_bit_cast(int, logit), src)); }
            const float e1 = __expf(sv[1] - sv[0]), e2 = __expf(sv[2] - sv[0]), e3 = __expf(sv[3] - sv[0]), inv = 1.f / (1.f + e1 + e2 + e3);
            const float wk[4] = {inv, e1 * inv, e2 * inv, e3 * inv};
            if (lane == 0) {
#pragma unroll
                for (int k = 0; k < 4; ++k) { const int lr = __hip_atomic_fetch_add(hist + se[k], 1, __ATOMIC_RELAXED, __HIP_MEMORY_SCOPE_WORKGROUP);
                    tok_e[t * 4 + k] = se[k]; tok_lr[t * 4 + k] = lr; tok_w[t * 4 + k] = wk[k]; } } }
    }
    __syncthreads();
    if (tid < 32) blk_cnt[blk * 32 + tid] = hist[tid];
    __syncthreads();
}
__device__ __forceinline__ void phase_dispatch(LAS unsigned char* lds, const int* __restrict__ blk_cnt, const int* __restrict__ tok_e, const int* __restrict__ tok_lr, int* __restrict__ tok_row, int* __restrict__ tab,
                                               const bf16* __restrict__ xbf, bf16* __restrict__ xs, int blk, int tid, int wave, int lane) {
    LAS int* tot = (LAS int*)lds; LAS int* pre = tot + 32; LAS int* pst = pre + 32; LAS int* rows = pst + 64;
    if (tid < 32) { int s = 0, p = 0;
#pragma unroll 8
        for (int bb = 0; bb < GRID; ++bb) { const int c = blk_cnt[bb * 32 + tid]; p += (bb < blk) ? c : 0; s += c; } tot[tid] = s; pre[tid] = p; }
    __syncthreads();
    if (tid == 0) { int acc = 0; for (int e = 0; e < 32; ++e) { pst[e] = acc; acc += ((tot[e] + 255) >> 8) << 8; } pst[32] = acc; }
    __syncthreads();
    if (blk == 0 && tid < 33) tab[tid] = pst[tid] >> 8;
    constexpr int TPB = T / GRID;
    static_assert(TPB * 4 == NTHR, "one (token, k) pair per thread");
    { const size_t ti = (size_t)blk * TPB * 4 + tid; const int e = tok_e[ti]; const int r = pst[e] + pre[e] + tok_lr[ti]; tok_row[ti] = r; rows[tid] = r; }
    __syncthreads();
#pragma unroll 4
    for (int i = wave; i < TPB * 4; i += NWAVES) { const int r = rows[i];
        const v4u* src = (const v4u*)(xbf + ((size_t)blk * TPB + (i >> 2)) * D) + 2 * lane; const v4u a = src[0], b = src[1];
        v4u o; o.x = pk4_fp8(bflo(a.x), bfhi(a.x), bflo(a.y), bfhi(a.y)); o.y = pk4_fp8(bflo(a.z), bfhi(a.z), bflo(a.w), bfhi(a.w)); o.z = pk4_fp8(bflo(b.x), bfhi(b.x), bflo(b.y), bfhi(b.y)); o.w = pk4_fp8(bflo(b.z), bfhi(b.z), bflo(b.w), bfhi(b.w));
        ((v4u*)((unsigned char*)xs + (size_t)r * D))[lane] = o; }
    __syncthreads();
}
__device__ __forceinline__ f32x4 fp8x4_to_f32(unsigned w) {
    const f32x2 lo = __builtin_amdgcn_cvt_pk_f32_fp8((int)w, false), hi = __builtin_amdgcn_cvt_pk_f32_fp8((int)w, true); return (f32x4){lo.x, lo.y, hi.x, hi.y};
}
__device__ __forceinline__ void phase_ln2(const unsigned char* __restrict__ yrows, const int* __restrict__ tok_row, const float* __restrict__ tok_w, const float* __restrict__ g, const float* __restrict__ bb,
                                          float* __restrict__ xout, bf16* xbf, int gw, int ngw, int lane) {
    f32x4 gv[4], bv[4];
#pragma unroll
    for (int j = 0; j < 4; ++j) { gv[j] = ((const f32x4*)g)[lane + 64 * j]; bv[j] = ((const f32x4*)bb)[lane + 64 * j]; }
    constexpr int NTK = 2;
    static_assert(T % (NTK * GRID * NWAVES) == 0, "NTK tokens per wave per step");
    for (int t0 = gw; t0 < T; t0 += NTK * ngw) {
        f32x4 v[NTK][4];
#pragma unroll
        for (int u = 0; u < NTK; ++u) { const int t = t0 + u * ngw; int r[4]; float w[4];
#pragma unroll
            for (int k = 0; k < 4; ++k) { r[k] = tok_row[(size_t)t * 4 + k]; w[k] = tok_w[(size_t)t * 4 + k] * (1.f / 16.f); }
            const v2u* xr = (const v2u*)(xbf + (size_t)t * D) + lane;
#pragma unroll
            for (int j = 0; j < 4; ++j) { f32x4 f = {0.f, 0.f, 0.f, 0.f};
#pragma unroll
                for (int k = 0; k < 4; ++k) { const unsigned yw = ((const unsigned*)(yrows + (size_t)r[k] * D))[lane + 64 * j]; f += fp8x4_to_f32(yw) * w[k]; }
                const v2u xw = xr[64 * j]; v[u][j].x = DN_ALPHA * bflo(xw.x) + f.x; v[u][j].y = DN_ALPHA * bfhi(xw.x) + f.y; v[u][j].z = DN_ALPHA * bflo(xw.y) + f.z; v[u][j].w = DN_ALPHA * bfhi(xw.y) + f.w; } }
#pragma unroll
        for (int u = 0; u < NTK; ++u) { const int t = t0 + u * ngw;
            ln_row(v[u], gv, bv);
            if (xout) { f32x4* xo = (f32x4*)(xout + (size_t)t * D) + lane;
#pragma unroll
                for (int j = 0; j < 4; ++j) xo[64 * j] = v[u][j]; }
            else { v2u* xb = (v2u*)(xbf + (size_t)t * D) + lane;
#pragma unroll
                for (int j = 0; j < 4; ++j) { v2u ww; ww.x = pk2(v[u][j].x, v[u][j].y); ww.y = pk2(v[u][j].z, v[u][j].w); xb[64 * j] = ww; } } } }
}

struct Args { const float* in[20]; float* out; unsigned char* ws; int l_lo, l_hi, ph_lo, ph_hi; };
typedef const __attribute__((address_space(4))) Args* KArgsP;
#define KA_LOAD() ({ KArgsP p_ = (KArgsP)__builtin_amdgcn_kernarg_segment_ptr(); asm volatile("" : "+s"(p_)); p_; })
#ifndef PHMASK
#define PHMASK 0xFFFF
#endif
#ifndef REPEAT_MASK
#define REPEAT_MASK 0
#endif
#ifndef REPEAT_LMASK
#define REPEAT_LMASK 0xF
#endif
#define PH_BEGIN(k) _Pragma("unroll") for (int rep_ = 0; rep_ < ((((REPEAT_MASK >> (k)) & 1) && ((REPEAT_LMASK >> l) & 1)) ? 2 : 1); ++rep_) { if ((PHMASK >> (k)) & 1) { KArgsP ka = KA_LOAD(); unsigned char* ws = ka->ws; int tid = threadIdx.x; asm volatile("" : "+v"(tid)); \
    const int lane = tid & 63, wave = __builtin_amdgcn_readfirstlane(tid >> 6); int blk = blockIdx.x; asm volatile("" : "+s"(blk)); \
    const int gw = blk * NWAVES + wave; const size_t gtid = (size_t)blk * NTHR + tid; (void)lane; (void)gw; (void)gtid; (void)ws;
#if ONE_LAUNCH
#define PH_SEAM() do { XcdBarrier b_; b_.bar = (unsigned*)(KA_LOAD()->ws + WS_CTL) + CW_BAR; b_.x = xb_xcc_id(); b_.st = (volatile LAS unsigned*)(lds + MISC_OFF); xcd_barrier(b_); } while (0)
#else
#define PH_SEAM() do {} while (0)
#endif
#define PH_END() PH_SEAM(); } }
#define PH_END_NOSEAM() } }
#define WSP(type, off) ((type*)(ws + (off)))
constexpr int G = GRID, NGW = GRID * NWAVES; constexpr size_t GTHREADS = (size_t)GRID * NTHR;
template <int L> __device__ __forceinline__ void layer_phases(LAS unsigned char* lds) {
    constexpr int l = L; LAS int* tabL = (LAS int*)(lds + MISC_OFF + 256);

        const int j = l >> 1; const bool moba = (l & 1) != 0;
        const int NC = moba ? NC_M : NC_H, qoff = moba ? 2304 : 3072;

        if (l == 0) {
        PH_BEGIN(1)
            phase_weights((LAS float*)(lds + wave * 16384), gw, NGW, lane, ka->in[2], NC_H, ka->in[6], 4, ka->in[7], ka->in[12], ka->in[14], ka->in[16], WSP(bf16, WS_WIN), WSP(bf16, WS_WKV4), WSP(bf16, WS_WO), WSP(bf16, WS_WGU), WSP(bf16, WS_WD));
        PH_END()
        }
        PH_BEGIN(2)
            { pg8::Gemm g{WSP(bf16, WS_XBF), WSP(bf16, WS_WIN), T, NC, D, 0, 0}; pg8::StaticOrder S; S.init(T, NC, G, blk); pg8::EpiPlain E{WSP(bf16, WS_H), NC, moba ? 0x207u : 0x1000u, 0.125f * 1.4426950408889634f};
              pg8::gemm_phase<pg8::EpiPlain, pg8::StaticOrder, true, true>(lds, g, S, E); }
            if (l == 0) {
              pg8::Gemm g{WSP(bf16, WS_MEMBF), WSP(bf16, WS_WKV4), 512, 2048, D, 0, 0}; pg8::StaticOrder S; S.init(512, 2048, G, blk >= 128 ? blk - 128 : G); pg8::EpiPlain E{WSP(bf16, WS_KV4), 2048, 0u, 1.f};
              pg8::gemm_phase<pg8::EpiPlain, pg8::StaticOrder, true, true>(lds, g, S, E); }
        PH_END()
        if (!moba) {
            PH_BEGIN(3)
                for (int u = blk; u < NBATCH * HG_H * HNSEG; u += G) hgrn_mfma<false>(lds, WSP(bf16, WS_H), ka->in[3], j, ka->in[4] + j * 128, WSP(float, WS_SLOC), WSP(float, WS_DSEG), WSP(bf16, WS_MIX), u, tid, wave, lane);
                for (int u = blk; u < 512; u += G) memattn_unit2(lds, WSP(bf16, WS_H), NC, qoff, WSP(bf16, WS_KV4) + 512 * l, WSP(bf16, WS_MIX), u, tid, wave, lane);
            PH_END()
            PH_BEGIN(4)
                hgrn_scan(WSP(float, WS_SLOC), WSP(float, WS_DSEG), gtid, GTHREADS);
            PH_END()
            PH_BEGIN(5)
                for (int u = blk; u < NBATCH * HG_H * HNSEG; u += G) hgrn_mfma<true>(lds, WSP(bf16, WS_H), ka->in[3], j, ka->in[4] + j * 128, WSP(float, WS_SLOC), WSP(float, WS_DSEG), WSP(bf16, WS_MIX), u, tid, wave, lane);
            PH_END()
        } else {
            PH_BEGIN(3)
                for (int u = blk; u < 24 * MB_NB; u += G) kmean_unit(lds, WSP(bf16, WS_H), WSP(float, WS_KMEAN), u, tid);
                for (int u = blk; u < 512; u += G) memattn_unit2(lds, WSP(bf16, WS_H), NC, qoff, WSP(bf16, WS_KV4) + 512 * l, WSP(bf16, WS_MIX), u, tid, wave, lane);
            PH_END()
            PH_BEGIN(4)
                for (int u = blk; u < 24 * MB_NB; u += G) moba_gate_unit(lds, WSP(bf16, WS_H), WSP(float, WS_KMEAN), WSP(unsigned, WS_CTL) + CW_GCOUNT + j * 1536, WSP(int, WS_SELINFO), WSP(unsigned, WS_LIST), u, tid);
            PH_END()
            PH_BEGIN(5)
                { unsigned* qhead = WSP(unsigned, WS_CTL) + CW_GCOUNT + 2 * 1536 + 64 * j; LAS int* itl = (LAS int*)(lds + MISC_OFF + 512);
                  for (;;) { if (tid == 0) *itl = (int)__hip_atomic_fetch_add(qhead, 1u, __ATOMIC_RELAXED, __HIP_MEMORY_SCOPE_AGENT);
                      __syncthreads(); const int it = *itl; __syncthreads();
                      if (it >= 24 * MB_NB) break;
                      moba_attn_item2(lds, WSP(bf16, WS_H), WSP(unsigned, WS_CTL) + CW_GCOUNT + j * 1536, WSP(unsigned, WS_LIST), WSP(bf16, WS_PO), WSP(float, WS_PML), it, tid, wave, lane); } }
            PH_END()
            PH_BEGIN(6)
                moba_combine(WSP(bf16, WS_PO), WSP(float, WS_PML), WSP(int, WS_SELINFO), WSP(bf16, WS_MIX), gw, NGW, lane);
            PH_END()
        }
        PH_BEGIN(7)
            pg8::Gemm g{WSP(bf16, WS_MIX), WSP(bf16, WS_WO), T, D, D, 0, 0}; pg8::StaticOrder S; S.init(T, D, G, blk); pg8::EpiPlain E{WSP(bf16, WS_Y), D, 0u, 1.f};
            pg8::gemm_phase<pg8::EpiPlain, pg8::StaticOrder, true, true>(lds, g, S, E);
        PH_END()
        PH_BEGIN(8)
            phase_ln1(lds, WSP(bf16, WS_Y), ka->in[8] + l * D, ka->in[9] + l * D, WSP(bf16, WS_WRS) + (size_t)l * 2 * NE * D, ka->in[11] + l * NE, WSP(bf16, WS_XBF),
                      WSP(int, WS_TOK + TOK_E), WSP(int, WS_TOK + TOK_LR), WSP(float, WS_TOK + TOK_W), WSP(int, WS_TOK + TOK_BLKCNT), blk, tid, wave, lane);
        PH_END()
        PH_BEGIN(9)
            phase_dispatch(lds, WSP(int, WS_TOK + TOK_BLKCNT), WSP(int, WS_TOK + TOK_E), WSP(int, WS_TOK + TOK_LR), WSP(int, WS_TOK + TOK_ROW), WSP(int, WS_TOK + TOK_TAB), WSP(bf16, WS_XBF), WSP(bf16, WS_XS), blk, tid, wave, lane);
        PH_END()
        PH_BEGIN(10)
            if (tid < 33) tabL[tid] = WSP(int, WS_TOK + TOK_TAB)[tid];
            __syncthreads();
            int sw_ = 0x7A7A7A7A, sx_ = 0x7F7F7F7F; asm volatile("" : "+s"(sw_), "+s"(sx_));
            pg8::Gemm g{WSP(bf16, WS_XS), WSP(bf16, WS_WGU), MOE_MAXROWS, NE * 2048, D / 2, sw_, sx_}; pg8::MoeOrder S{tabL, 8, G, blk, tabL[32] * 8};
            pg8::EpiSwiglu E{WSP(unsigned char, WS_HID), ka->in[13] + (size_t)l * NE * 1024, ka->in[15] + (size_t)l * NE * 1024};
            pg8::gemm_phase<pg8::EpiSwiglu, pg8::MoeOrder, true, true, true>(lds, g, S, E);
        PH_END()
        PH_BEGIN(11)
            if (tid < 33) tabL[tid] = WSP(int, WS_TOK + TOK_TAB)[tid];
            __syncthreads();
            int sw_ = 0x79797979, sx_ = 0x7F7F7F7F; asm volatile("" : "+s"(sw_), "+s"(sx_));
            pg8::Gemm g{WSP(bf16, WS_HID), WSP(bf16, WS_WD), MOE_MAXROWS, NE * 1024, D / 2, sw_, sx_}; pg8::MoeOrder S{tabL, 4, G, blk, tabL[32] * 4};
            pg8::EpiDown E{WSP(unsigned char, WS_XS), ka->in[17] + (size_t)l * NE * 1024};
            pg8::gemm_phase<pg8::EpiDown, pg8::MoeOrder, true, true, true>(lds, g, S, E);
        PH_END()
        PH_BEGIN(12)
            float* x2out = (l == DEPTH - 1) ? ka->out : nullptr;
            phase_ln2(WSP(unsigned char, WS_XS), WSP(int, WS_TOK + TOK_ROW), WSP(float, WS_TOK + TOK_W), ka->in[18] + l * D, ka->in[19] + l * D, x2out, WSP(bf16, WS_XBF), gw, NGW, lane);
            if (l + 1 < DEPTH) { constexpr int ln = l + 1, jn = ln >> 1; constexpr bool mn = (ln & 1) != 0;
                const float* win_src = mn ? ka->in[5] + (size_t)jn * D * NC_M : ka->in[2] + (size_t)jn * D * NC_H; const size_t moff = (size_t)ln * NE * 1024 * 1024;
                phase_weights((LAS float*)(lds + wave * 16384), gw, NGW, lane, win_src, mn ? NC_M : NC_H, ka->in[6], 0, ka->in[7] + (size_t)ln * D * D,
                              ka->in[12] + moff, ka->in[14] + moff, ka->in[16] + moff, WSP(bf16, WS_WIN), WSP(bf16, WS_WKV4), WSP(bf16, WS_WO), WSP(bf16, WS_WGU), WSP(bf16, WS_WD)); }
            if (l + 1 < DEPTH) PH_SEAM();
        PH_END_NOSEAM()
}
__global__ void __launch_bounds__(NTHR, 2) fwd_kernel(Args args) {
    extern __shared__ __attribute__((aligned(16))) unsigned char lds_raw[];
    LAS unsigned char* lds = (LAS unsigned char*)lds_raw;
    if (threadIdx.x < 4) ((LAS unsigned*)(lds + MISC_OFF))[threadIdx.x] = 0u;
    __syncthreads();
#if ONE_LAUNCH
    (void)xcd_barrier_post((unsigned*)(args.ws + WS_CTL) + CW_BAR, (volatile LAS unsigned*)(lds + MISC_OFF));
#endif
    { const int l = 0; (void)l;
    PH_BEGIN(0)
        cvt_rows_bf16(ka->in[0], WSP(bf16, WS_XBF), (size_t)T * D / 8, gtid, GTHREADS);
        cvt_rows_bf16(ka->in[1], WSP(bf16, WS_MEMBF), (size_t)512 * D / 8, gtid, GTHREADS);
        split_router_weights(ka->in[10], WSP(bf16, WS_WRS), gtid, GTHREADS);
    PH_END_NOSEAM() }
    layer_phases<0>(lds); layer_phases<1>(lds); layer_phases<2>(lds); layer_phases<3>(lds);
}

extern "C" void kernel_launch(void* const* d_in, const int* in_sizes, int n_in, void* d_out, int out_size, void* d_ws, size_t ws_size, hipStream_t stream) {
    static int ready = 0;
    if (ready == 0) {
        if (n_in != 20 || in_sizes[0] != T * D || out_size != T * D || ws_size < WS_END) { fprintf(stderr, "kernel_launch: unexpected shapes (n_in %d, in0 %d, out %d, ws %zu < %zu)\n", n_in, n_in > 0 ? in_sizes[0] : -1, out_size, ws_size, (size_t)WS_END); ready = -1; return; }
        if (hipFuncSetAttribute((const void*)fwd_kernel, hipFuncAttributeMaxDynamicSharedMemorySize, LDS_BYTES) != hipSuccess) { fprintf(stderr, "kernel_launch: hipFuncSetAttribute failed\n"); ready = -1; return; }
        int per_cu = 0;
        if (hipOccupancyMaxActiveBlocksPerMultiprocessor(&per_cu, (const void*)fwd_kernel, NTHR, LDS_BYTES) != hipSuccess || per_cu < 1) fprintf(stderr, "kernel_launch: occupancy query says %d\n", per_cu);
        (void)hipGetLastError();
        ready = 1;
    }
    if (ready < 0) return;
    if (hipMemsetAsync((char*)d_ws + WS_CTL, 0, CTL_ZERO_BYTES, stream) != hipSuccess) return;
    Args a{};
    for (int i = 0; i < 20; ++i) a.in[i] = (const float*)d_in[i];
    a.out = (float*)d_out; a.ws = (unsigned char*)d_ws;
    a.l_lo = 0; a.l_hi = DEPTH; a.ph_lo = 0; a.ph_hi = NPHASE;
    hipLaunchKernelGGL(fwd_kernel, dim3(GRID), dim3(NTHR), LDS_BYTES, stream, a);
}
```

```cpp
#include <hip/hip_runtime.h>
#include <cstdio>
#include <cstdint>
#include <cmath>
namespace pg8 {
#define PG8_LAS __attribute__((address_space(3)))
typedef unsigned short bf16_t;
typedef short bf16x8 __attribute__((ext_vector_type(8)));
typedef float f32x4 __attribute__((ext_vector_type(4)));
typedef unsigned u32x4 __attribute__((ext_vector_type(4)));
constexpr int BM = 256, BK = 64, HALF = 128, HTB = HALF * BK * 2  , STAGE_BYTES = 8 * HTB, NXCD = 8, WGM = 8;

__host__ __device__ __forceinline__ int lds_byte(int r, int c) { const int st = (r >> 4) * 2 + (c >> 5), rr = r & 15, cc = c & 31, ob = rr * 64 + cc * 2; return st * 1024 + (ob ^ (((ob >> 9) & 1) << 5)); }
__host__ __device__ __forceinline__ void stage_rc(int b, int& R, int& C) { const int st = b / 1024, sb = b % 1024, swz = sb ^ (((sb >> 9) & 1) << 5); R = (st >> 1) * 16 + swz / 64; C = (st & 1) * 32 + (swz % 64) / 2; }
__host__ __device__ __forceinline__ int perm32(int rho) { const int n = rho >> 4, i = rho & 15; return 8 * (i >> 2) + 4 * n + (i & 3); }

struct Unit { int pm, pn; };
struct Gemm { const bf16_t* A; const bf16_t* Bt; int M, N, K; int sw, sx; };
typedef int i32x8 __attribute__((ext_vector_type(8))); typedef int i32x4 __attribute__((ext_vector_type(4)));

struct StaticOrder {
    int nM, nN, nwg, G, c;
    __host__ __device__ void init(int M, int N, int G_, int c_) { nM = M / BM; nN = N / BM; nwg = nM * nN; G = G_; c = c_; }
    __host__ __device__ bool next(int i, Unit& u) const {
        const long L = (long)i * G + c; if (L >= nwg) return false;
        int wgid = (int)L; { const int q = nwg / NXCD, r = nwg % NXCD, xcd = wgid % NXCD, off = wgid / NXCD; wgid = (xcd < r ? xcd * (q + 1) : r * (q + 1) + (xcd - r) * q) + off; }
        const int nig = WGM * nN, gid = wgid / nig, fm = gid * WGM, gsz = (nM - fm) < WGM ? (nM - fm) : WGM;
        u.pm = fm + ((wgid % nig) % gsz); u.pn = (wgid % nig) / gsz; return true;
    }
    __device__ __forceinline__ void a_ready(const Unit&) const {}
    __device__ __forceinline__ void done(const Unit&) const {}
};

__device__ __forceinline__ unsigned cvt_pk_bf16(float lo, float hi) { unsigned r; asm volatile("v_cvt_pk_bf16_f32 %0, %1, %2" : "=v"(r) : "v"(lo), "v"(hi)); return r; }
typedef float f32x2 __attribute__((ext_vector_type(2)));
struct EpiPlain {
    static constexpr bool PERM = true, AFTER_DRAIN = false;
    bf16_t* O; int ldc; unsigned smask; float sc;
    __device__ __forceinline__ void operator()(const f32x4 (&acc)[2][2][4][2], const Unit& u, int wr, int wc, int fr, int fq) const {
        const int row0 = u.pm * BM + wr * 64 + fr; const int col0 = u.pn * BM + wc * 32 + 8 * fq; const float s = ((smask >> u.pn) & 1u) ? sc : 1.f;
#pragma unroll
        for (int ai = 0; ai < 2; ++ai)
#pragma unroll
            for (int m = 0; m < 4; ++m) { bf16_t* rowp = O + (size_t)(row0 + ai * HALF + m * 16) * ldc + col0;
#pragma unroll
                for (int bj = 0; bj < 2; ++bj) { const f32x4 v0 = acc[ai][bj][m][0] * s, v1 = acc[ai][bj][m][1] * s;
                    u32x4 w; w.x = cvt_pk_bf16(v0[0], v0[1]); w.y = cvt_pk_bf16(v0[2], v0[3]); w.z = cvt_pk_bf16(v1[0], v1[1]); w.w = cvt_pk_bf16(v1[2], v1[3]);
                    *(u32x4*)(rowp + bj * HALF) = w; } }
    }
};
__device__ __forceinline__ float swiglu1(float g, float u) {
    g = fminf(g, 7.0f); u = fminf(fmaxf(u, -7.0f), 7.0f);
    const float s = __builtin_amdgcn_rcpf(1.0f + __builtin_amdgcn_exp2f(g * (-1.702f * 1.4426950408889634f)));
    return g * s * (u + 1.0f);
}
__device__ __forceinline__ unsigned pk4_fp8e(float a, float b, float c, float d) { int w = 0; w = __builtin_amdgcn_cvt_pk_fp8_f32(a, b, w, false); w = __builtin_amdgcn_cvt_pk_fp8_f32(c, d, w, true); return (unsigned)w; }
struct EpiSwiglu {
    static constexpr bool PERM = true, AFTER_DRAIN = false;
    unsigned char* hid; const float* bg; const float* bu;
    __device__ __forceinline__ void operator()(const f32x4 (&acc)[2][2][4][2], const Unit& u, int wr, int wc, int fr, int fq) const {
        const int e = u.pn >> 3, pn = u.pn & 7;
        const int row0 = u.pm * BM + wr * 64 + fr; const int col0 = pn * 128 + wc * 32 + 8 * fq;
        const f32x4 g0 = *(const f32x4*)(bg + e * 1024 + col0), g1 = *(const f32x4*)(bg + e * 1024 + col0 + 4);
        const f32x4 u0 = *(const f32x4*)(bu + e * 1024 + col0), u1 = *(const f32x4*)(bu + e * 1024 + col0 + 4);
#pragma unroll
        for (int ai = 0; ai < 2; ++ai)
#pragma unroll
            for (int m = 0; m < 4; ++m) { unsigned char* rowp = hid + (size_t)(row0 + ai * HALF + m * 16) * 1024 + col0;
                const f32x4 ga = acc[ai][0][m][0] + g0, gb = acc[ai][0][m][1] + g1, ua = acc[ai][1][m][0] + u0, ub = acc[ai][1][m][1] + u1;
                typedef unsigned u32x2 __attribute__((ext_vector_type(2))); u32x2 w;
                w.x = pk4_fp8e(swiglu1(ga[0], ua[0]), swiglu1(ga[1], ua[1]), swiglu1(ga[2], ua[2]), swiglu1(ga[3], ua[3]));
                w.y = pk4_fp8e(swiglu1(gb[0], ub[0]), swiglu1(gb[1], ub[1]), swiglu1(gb[2], ub[2]), swiglu1(gb[3], ub[3]));
                *(u32x2*)rowp = w; }
    }
};
struct EpiDown {
    static constexpr bool PERM = true, AFTER_DRAIN = false;
    unsigned char* y; const float* bd;
    __device__ __forceinline__ void operator()(const f32x4 (&acc)[2][2][4][2], const Unit& u, int wr, int wc, int fr, int fq) const {
        const int e = u.pn >> 2, pn = u.pn & 3;
        const int row0 = u.pm * BM + wr * 64 + fr; const int col0 = pn * BM + wc * 32 + 8 * fq;
        f32x4 bv[2][2];
#pragma unroll
        for (int bj = 0; bj < 2; ++bj)
#pragma unroll
            for (int n = 0; n < 2; ++n) bv[bj][n] = *(const f32x4*)(bd + e * 1024 + col0 + bj * HALF + 4 * n);
#pragma unroll
        for (int ai = 0; ai < 2; ++ai)
#pragma unroll
            for (int m = 0; m < 4; ++m) { unsigned char* rowp = y + (size_t)(row0 + ai * HALF + m * 16) * 1024 + col0;
#pragma unroll
                for (int bj = 0; bj < 2; ++bj) { const f32x4 v0 = (acc[ai][bj][m][0] + bv[bj][0]) * 16.f, v1 = (acc[ai][bj][m][1] + bv[bj][1]) * 16.f;
                    typedef unsigned u32x2 __attribute__((ext_vector_type(2))); u32x2 w; w.x = pk4_fp8e(v0[0], v0[1], v0[2], v0[3]); w.y = pk4_fp8e(v1[0], v1[1], v1[2], v1[3]);
                    *(u32x2*)(rowp + bj * HALF) = w; } }
    }
};
struct MoeOrder {
    const PG8_LAS int* tab; int npn, G, c, nunits;
    __device__ __forceinline__ bool next(int i, Unit& u) const {
        const int tpx = 32 / npn, s = c >> 3, tile = (i * 8 + (c & 7)) * tpx + s / npn, pn = s % npn;
        if ((i * 8) * tpx >= nunits / npn) return false;
        if (tile >= nunits / npn) { u.pm = 0; u.pn = 0; return false; }
        int e = 0;
#pragma unroll
        for (int k = 1; k < 32; ++k) e += (tab[k] <= tile) ? 1 : 0;
        u.pm = tile; u.pn = __builtin_amdgcn_readfirstlane(e) * npn + pn; return true;
    }
    __device__ __forceinline__ void a_ready(const Unit&) const {}
    __device__ __forceinline__ void done(const Unit&) const {}
};
template <class Epi, class Sched, bool ALIGN_EPI = false, bool SP2 = false, bool F8 = false>
__device__ __forceinline__ void gemm_phase(PG8_LAS unsigned char* lds, const Gemm g, const Sched& S, const Epi& E) {
    int tid_ = threadIdx.x; asm volatile("" : "+v"(tid_));
    const int tid = tid_, wid = __builtin_amdgcn_readfirstlane(tid >> 6), lane = tid & 63, wr = wid >> 2, wc = wid & 3, fr = lane & 15, fq = lane >> 4;
    const int K = g.K, nt = K / BK;
    unsigned voffA, voffB;
    { int R, C; stage_rc(tid * 16, R, C); const int Rb = Epi::PERM ? ((R & ~31) + perm32(R & 31)) : R; voffA = (unsigned)(R * K + C) * 2u; voffB = (unsigned)(Rb * K + C) * 2u; }
    const unsigned qstep = 64u * (unsigned)K * 2u;
    const unsigned kstep = (unsigned)(BK * 2);
    const unsigned hstep = (unsigned)HALF * (unsigned)K * 2u;
    const unsigned tstep = 2u * hstep;
    const __amdgpu_buffer_rsrc_t rA = __builtin_amdgcn_make_buffer_rsrc((void*)g.A, 0, 0x7FFFFFFF, 0x00020000), rB = __builtin_amdgcn_make_buffer_rsrc((void*)g.Bt, 0, 0x7FFFFFFF, 0x00020000);
    const unsigned ldsw = (unsigned)wid * 1024u;
    const int aoff = lds_byte(wr * 64 + fr, fq * 8), boff = lds_byte(wc * 32 + fr, fq * 8);
#define PG8_SA(b, h) (((b) * 2 + (h)) * HTB)
#define PG8_SB(b, h) ((4 + (b) * 2 + (h)) * HTB)
#define PG8_STG(bufoff, rsrc, soff, voff) do { _Pragma("unroll") for (int _i = 0; _i < 2; ++_i) \
        __builtin_amdgcn_raw_ptr_buffer_load_lds((rsrc), (PG8_LAS void*)(lds + (bufoff) + ldsw + _i * 8192), 16, (int)(voff), (int)((soff) + (unsigned)_i * qstep), 0, 0); } while (0)
#define PG8_STGA(bufoff, soff) PG8_STG(bufoff, rA, soff, voffA)
#define PG8_STGB(bufoff, soff) PG8_STG(bufoff, rB, soff, voffB)
#define PG8_LDA(dst, b, h) do { _Pragma("unroll") for (int m = 0; m < 4; ++m) { if constexpr (F8) { const i32x4 lo_ = *(const PG8_LAS i32x4*)(lds + PG8_SA(b, h) + aoff + m * 2048), hi_ = *(const PG8_LAS i32x4*)(lds + PG8_SA(b, h) + aoff + m * 2048 + 1024); \
            dst##_8[m] = __builtin_shufflevector(lo_, hi_, 0, 1, 2, 3, 4, 5, 6, 7); } else { _Pragma("unroll") for (int k = 0; k < 2; ++k) dst[m][k] = *(const PG8_LAS bf16x8*)(lds + PG8_SA(b, h) + aoff + m * 2048 + k * 1024); } } } while (0)
#define PG8_LDB(dst, b, h) do { _Pragma("unroll") for (int n = 0; n < 2; ++n) { if constexpr (F8) { const i32x4 lo_ = *(const PG8_LAS i32x4*)(lds + PG8_SB(b, h) + boff + n * 2048), hi_ = *(const PG8_LAS i32x4*)(lds + PG8_SB(b, h) + boff + n * 2048 + 1024); \
            dst##_8[n] = __builtin_shufflevector(lo_, hi_, 0, 1, 2, 3, 4, 5, 6, 7); } else { _Pragma("unroll") for (int k = 0; k < 2; ++k) dst[n][k] = *(const PG8_LAS bf16x8*)(lds + PG8_SB(b, h) + boff + n * 2048 + k * 1024); } } } while (0)
#define PG8_MMA(ai, bj, At, Bt) do { __builtin_amdgcn_s_setprio(1); _Pragma("unroll") for (int m = 0; m < 4; ++m) _Pragma("unroll") for (int n = 0; n < 2; ++n) { \
        if constexpr (F8) acc[ai][bj][m][n] = __builtin_amdgcn_mfma_scale_f32_16x16x128_f8f6f4(Bt##_8[n], At##_8[m], acc[ai][bj][m][n], 0, 0, 0, g.sw, 0, g.sx); \
        else { _Pragma("unroll") for (int k = 0; k < 2; ++k) acc[ai][bj][m][n] = __builtin_amdgcn_mfma_f32_16x16x32_bf16(Bt[n][k], At[m][k], acc[ai][bj][m][n], 0, 0, 0); } } \
        __builtin_amdgcn_s_setprio(0); } while (0)
#define PG8_WAIT_V(n) asm volatile("s_waitcnt vmcnt(" #n ")" ::: "memory")
#define PG8_WAIT_L(n) asm volatile("s_waitcnt lgkmcnt(" #n ")" ::: "memory")
#define PG8_BAR __builtin_amdgcn_s_barrier()
#define PG8_SCHED __builtin_amdgcn_sched_barrier(0)
    Unit cur, nxt; int ui = 0;
    if (!S.next(0, cur)) return;
    f32x4 acc[2][2][4][2];
#pragma unroll
    for (int a = 0; a < 2; ++a)
#pragma unroll
        for (int b = 0; b < 2; ++b)
#pragma unroll
            for (int m = 0; m < 4; ++m)
#pragma unroll
                for (int n = 0; n < 2; ++n) acc[a][b][m][n] = (f32x4){0.f, 0.f, 0.f, 0.f};
    bf16x8 At[4][2], B0[2][2], B1[2][2]; i32x8 At_8[4], B0_8[2], B1_8[2];
    unsigned cA = (unsigned)cur.pm * tstep, cB = (unsigned)cur.pn * tstep;
    S.a_ready(cur);
    if constexpr (SP2) {
        PG8_STGB(PG8_SB(0, 0), cB); PG8_STGB(PG8_SB(0, 1), cB + hstep); PG8_STGA(PG8_SA(0, 0), cA); PG8_STGA(PG8_SA(0, 1), cA + hstep);
        if (wr == 1) PG8_BAR;
        PG8_WAIT_V(2); PG8_BAR;
        PG8_STGB(PG8_SB(1, 0), cB + kstep); PG8_STGA(PG8_SA(1, 0), cA + kstep); PG8_STGB(PG8_SB(1, 1), cB + hstep + kstep);
        PG8_WAIT_V(6); PG8_BAR;
    } else {
        PG8_STGB(PG8_SB(0, 0), cB); PG8_STGA(PG8_SA(0, 0), cA); PG8_STGB(PG8_SB(0, 1), cB + hstep); PG8_STGA(PG8_SA(0, 1), cA + hstep);
        if (wr == 1) PG8_BAR;
        PG8_WAIT_V(4); PG8_BAR;
        PG8_STGB(PG8_SB(1, 0), cB + kstep); PG8_STGA(PG8_SA(1, 0), cA + kstep); PG8_STGB(PG8_SB(1, 1), cB + hstep + kstep);
        PG8_WAIT_V(6); PG8_BAR;
    }
    for (;;) {
        const bool has_next = S.next(ui + 1, nxt);
        const unsigned nA = has_next ? (unsigned)nxt.pm * tstep : cA, nB = has_next ? (unsigned)nxt.pn * tstep : cB;
#pragma unroll 1
        for (int t = 0; t < nt; t += 2) {
            const bool last = (t == nt - 2);
            const unsigned a1 = cA + (unsigned)(t + 1) * kstep;
            const unsigned a2 = last ? nA : cA + (unsigned)(t + 2) * kstep, b2 = last ? nB : cB + (unsigned)(t + 2) * kstep;
            const unsigned a3 = a2 + kstep, b3 = b2 + kstep;
            if (last && has_next) S.a_ready(nxt);
            if constexpr (SP2) {
            PG8_LDB(B0, 0, 0); PG8_LDB(B1, 0, 1); PG8_SCHED; PG8_LDA(At, 0, 0); PG8_STGA(PG8_SA(1, 1), a1 + hstep);
            PG8_WAIT_V(8); PG8_WAIT_L(0); PG8_BAR; PG8_MMA(0, 0, At, B0); PG8_MMA(0, 1, At, B1); PG8_BAR; PG8_SCHED;
            PG8_LDA(At, 0, 1); PG8_STGB(PG8_SB(0, 0), b2); PG8_STGB(PG8_SB(0, 1), b2 + hstep); PG8_STGA(PG8_SA(0, 0), a2);
            PG8_WAIT_V(8); PG8_WAIT_L(0); PG8_BAR; PG8_MMA(1, 0, At, B0); PG8_MMA(1, 1, At, B1); PG8_BAR; PG8_SCHED;
            PG8_LDB(B0, 1, 0); PG8_LDB(B1, 1, 1); PG8_SCHED; PG8_LDA(At, 1, 0); PG8_STGA(PG8_SA(0, 1), a2 + hstep);
            PG8_WAIT_V(8); PG8_WAIT_L(0); PG8_BAR; PG8_MMA(0, 0, At, B0); PG8_MMA(0, 1, At, B1); PG8_BAR; PG8_SCHED;
            PG8_LDA(At, 1, 1); PG8_STGB(PG8_SB(1, 0), b3); PG8_STGB(PG8_SB(1, 1), b3 + hstep); PG8_STGA(PG8_SA(1, 0), a3);
            PG8_WAIT_V(8); PG8_WAIT_L(0); PG8_BAR; PG8_MMA(1, 0, At, B0); PG8_MMA(1, 1, At, B1); PG8_BAR; PG8_SCHED;
            } else {
            PG8_LDB(B0, 0, 0); PG8_SCHED; PG8_LDA(At, 0, 0); PG8_STGA(PG8_SA(1, 1), a1 + hstep);
            PG8_WAIT_L(8); PG8_BAR; PG8_WAIT_L(0); PG8_MMA(0, 0, At, B0); PG8_BAR; PG8_SCHED;
            PG8_LDB(B1, 0, 1); PG8_STGB(PG8_SB(0, 0), b2);
            PG8_BAR; PG8_WAIT_L(0); PG8_MMA(0, 1, At, B1); PG8_BAR;
            PG8_LDA(At, 0, 1); PG8_STGA(PG8_SA(0, 0), a2);
            PG8_BAR; PG8_WAIT_L(0); PG8_MMA(1, 0, At, B0); PG8_BAR; PG8_SCHED;
            PG8_STGB(PG8_SB(0, 1), b2 + hstep);
            PG8_WAIT_V(6); PG8_BAR; PG8_MMA(1, 1, At, B1); PG8_BAR;
            PG8_LDB(B0, 1, 0); PG8_SCHED; PG8_LDA(At, 1, 0); PG8_STGA(PG8_SA(0, 1), a2 + hstep);
            PG8_WAIT_L(8); PG8_BAR; PG8_WAIT_L(0); PG8_MMA(0, 0, At, B0); PG8_BAR; PG8_SCHED;
            PG8_LDB(B1, 1, 1); PG8_STGB(PG8_SB(1, 0), b3);
            PG8_BAR; PG8_WAIT_L(0); PG8_MMA(0, 1, At, B1); PG8_BAR;
            PG8_LDA(At, 1, 1); PG8_STGA(PG8_SA(1, 0), a3);
            PG8_BAR; PG8_WAIT_L(0); PG8_MMA(1, 0, At, B0); PG8_BAR; PG8_SCHED;
            PG8_STGB(PG8_SB(1, 1), b3 + hstep);
            PG8_WAIT_V(6); PG8_BAR; PG8_MMA(1, 1, At, B1); PG8_BAR;
            }
        }
        if constexpr (ALIGN_EPI) { if (wr == 0) PG8_BAR; }
        if constexpr (!Epi::AFTER_DRAIN) { int t2_ = threadIdx.x; asm volatile("" : "+v"(t2_)); E(acc, cur, wr, wc, t2_ & 15, (t2_ & 63) >> 4); S.done(cur); }
        if (!has_next) break;
#pragma unroll
        for (int a = 0; a < 2; ++a)
#pragma unroll
            for (int b = 0; b < 2; ++b)
#pragma unroll
                for (int m = 0; m < 4; ++m)
#pragma unroll
                    for (int n = 0; n < 2; ++n) acc[a][b][m][n] = (f32x4){0.f, 0.f, 0.f, 0.f};
        cur = nxt; cA = nA; cB = nB; ++ui;
        if constexpr (ALIGN_EPI) { if (wr == 1) PG8_BAR; }
    }
    PG8_WAIT_V(0);
    if constexpr (!ALIGN_EPI) { if (wr == 0) PG8_BAR; }
    PG8_BAR;
    if constexpr (Epi::AFTER_DRAIN) { E.fused(acc, cur, wr, wc, fr, fq, lds, wid, lane); S.done(cur); }
#undef PG8_SA
#undef PG8_SB
#undef PG8_STG
#undef PG8_STGA
#undef PG8_STGB
#undef PG8_LDA
#undef PG8_LDB
#undef PG8_MMA
#undef PG8_WAIT_V
#undef PG8_WAIT_L
#undef PG8_BAR
#undef PG8_SCHED
}
}

constexpr int NWAVES = 8, NTHR = 512, GRID = 256;
constexpr int NBATCH = 2, SEQ = 16384, T = NBATCH * SEQ, D = 1024, DEPTH = 4;
constexpr int MIXW = 768, NC_H = 3328, NC_M = 2560;
constexpr int HG_H = 6;
constexpr int HSEG = 256, HNSEG = SEQ / HSEG;
constexpr int MB_H = 12, MB_NB = 64;
constexpr int NE = 32;
constexpr float DN_ALPHA = 1.6817928305074290f;
constexpr int MOE_MAXROWS = T * 4 + NE * 256;
#ifndef ONE_LAUNCH
#define ONE_LAUNCH 1
#endif
constexpr int NPHASE = 13;

constexpr size_t MiB = 1u << 20;
constexpr size_t WS_CTL = 0, CTL_ZERO_BYTES = 1 * MiB;
constexpr size_t WS_WIN = 1 * MiB, WS_WKV = 9 * MiB, WS_WO = 10 * MiB, WS_WGU = 12 * MiB, WS_WD = 140 * MiB;
constexpr size_t WS_XBF = 204 * MiB, WS_WKV4 = 268 * MiB  , WS_KV4 = 272 * MiB  , WS_WRS = 280 * MiB  , WS_MEMBF = 524 * MiB;
constexpr size_t WS_H = 526 * MiB, WS_MIX = 734 * MiB, WS_Y = 798 * MiB, WS_SLOC = 862 * MiB, WS_DSEG = 910 * MiB, WS_KMEAN = 911 * MiB;
constexpr size_t WS_SELINFO = 912 * MiB, WS_TOK = 914 * MiB, WS_R1 = 918 * MiB;
constexpr size_t WS_LIST = WS_R1, WS_PML = WS_R1 + 96 * MiB, WS_PO = WS_R1 + 108 * MiB;
constexpr size_t WS_XS = WS_R1, WS_HID = WS_R1 + 272 * MiB;
constexpr size_t WS_END = WS_R1 + 544 * MiB;
static_assert((size_t)MOE_MAXROWS * 1024 * 2 <= 272 * MiB, "moe rows");
static_assert((size_t)T * MB_H * 4 * 64 * 4 <= 384 * MiB && (size_t)24 * 64 * 16384 * 4 <= 96 * MiB, "moba bufs");
constexpr size_t TOK_E = 0, TOK_LR = 512 * 1024, TOK_W = 1024 * 1024, TOK_ROW = 1536 * 1024, TOK_BLKCNT = 2048 * 1024, TOK_TAB = 2048 * 1024 + 65536;
constexpr int CW_BAR = 4096, CW_GCOUNT = 8192;

constexpr int RING_BYTES = 131072, LDS_BYTES = 147456, MISC_OFF = LDS_BYTES - 1024;

#define GAS __attribute__((address_space(1)))
#define LAS __attribute__((address_space(3)))
typedef unsigned short bf16;
typedef unsigned v4u __attribute__((ext_vector_type(4)));
typedef unsigned v2u __attribute__((ext_vector_type(2)));
typedef float f32x4 __attribute__((ext_vector_type(4)));
typedef float f32x2 __attribute__((ext_vector_type(2)));
typedef short s16x8 __attribute__((ext_vector_type(8)));
typedef float f32x16 __attribute__((ext_vector_type(16)));
typedef float f32x2_t __attribute__((ext_vector_type(2))); typedef __bf16 bf16x2_t __attribute__((ext_vector_type(2)));
__device__ __forceinline__ unsigned cvtpk(float lo, float hi) { f32x2_t v = {lo, hi}; bf16x2_t b = __builtin_convertvector(v, bf16x2_t); return __builtin_bit_cast(unsigned, b); }
#define LDS_WAIT() asm volatile("s_waitcnt lgkmcnt(0)" ::: "memory")
__device__ __forceinline__ unsigned f2bf(float f) { unsigned u = __builtin_bit_cast(unsigned, f); return (u + 0x7fffu + ((u >> 16) & 1u)) >> 16; }
__device__ __forceinline__ unsigned pk2(float lo, float hi) { return f2bf(lo) | (f2bf(hi) << 16); }
__device__ __forceinline__ float bflo(unsigned w) { return __builtin_bit_cast(float, w << 16); }
__device__ __forceinline__ float bfhi(unsigned w) { return __builtin_bit_cast(float, w & 0xffff0000u); }
__device__ __forceinline__ float bf2f(bf16 h) { return __builtin_bit_cast(float, (unsigned)h << 16); }
__device__ __forceinline__ float sigmoidf_(float z) { return __builtin_amdgcn_rcpf(1.0f + __builtin_amdgcn_exp2f(-1.4426950408889634f * z)); }
template <int X> __device__ __forceinline__ float xorf(float v) { return __builtin_bit_cast(float, __builtin_amdgcn_ds_swizzle(__builtin_bit_cast(int, v), (X << 10) | 0x1F)); }
template <int X> __device__ __forceinline__ int xori(int v) { return __builtin_amdgcn_ds_swizzle(v, (X << 10) | 0x1F); }
__device__ __forceinline__ float wave_sum(float v) {
    v += xorf<1>(v); v += xorf<2>(v); v += xorf<4>(v); v += xorf<8>(v); v += xorf<16>(v);
    return __builtin_bit_cast(float, __builtin_amdgcn_readlane(__builtin_bit_cast(int, v), 0)) + __builtin_bit_cast(float, __builtin_amdgcn_readlane(__builtin_bit_cast(int, v), 32));
}
__device__ __forceinline__ float wave_max(float v) {
    v = fmaxf(v, xorf<1>(v)); v = fmaxf(v, xorf<2>(v)); v = fmaxf(v, xorf<4>(v)); v = fmaxf(v, xorf<8>(v)); v = fmaxf(v, xorf<16>(v));
    return fmaxf(__builtin_bit_cast(float, __builtin_amdgcn_readlane(__builtin_bit_cast(int, v), 0)), __builtin_bit_cast(float, __builtin_amdgcn_readlane(__builtin_bit_cast(int, v), 32)));
}
__device__ __forceinline__ float xor32f(float v, int lane) { return __builtin_bit_cast(float, __builtin_amdgcn_ds_bpermute((lane ^ 32) << 2, __builtin_bit_cast(int, v))); }
#define XB_TMO      128
#define XB_XCNT(j)  (256  + 64 * (j))
#define XB_XSUB(j)  (1280 + 64 * (j))
#define XB_XGEN(j)  (2304 + 64 * (j))
#define XB_TOP      3328
#define XB_TOPGEN   3392
#define XCD_BAR_WORDS 3456
#define XB_SPIN_CAP (1u << 18)

__device__ __forceinline__ unsigned xb_ld(unsigned* p)              { return __hip_atomic_load(p, __ATOMIC_RELAXED, __HIP_MEMORY_SCOPE_AGENT); }
__device__ __forceinline__ unsigned xb_add(unsigned* p, unsigned v) { return __hip_atomic_fetch_add(p, v, __ATOMIC_RELAXED, __HIP_MEMORY_SCOPE_AGENT); }
__device__ __forceinline__ unsigned xb_xcc_id() { return (unsigned)__builtin_amdgcn_s_getreg((3 << 11) | 20) & 0xFu; }
#define XB_SPIN(cond, bar) do { unsigned _sp = 0; while (cond) { __builtin_amdgcn_s_sleep(1); \
    if ((++_sp & 255u) == 0u) { if (xb_ld(&(bar)[XB_TMO])) break; if (_sp > XB_SPIN_CAP) { atomicAdd(&(bar)[XB_TMO], 1u); break; } } } } while (0)

struct XcdBarrier {
    unsigned* bar; unsigned x;
    volatile LAS unsigned* st;
};

__device__ __forceinline__ XcdBarrier xcd_barrier_post(unsigned* bar, volatile LAS unsigned* st) {
    XcdBarrier b; b.bar = bar; b.x = xb_xcc_id(); b.st = st;
    if (threadIdx.x == 0) (void)xb_add(&bar[XB_XCNT(b.x)], 1u);
    return b;
}
__device__ __forceinline__ void xcd_barrier_complete(unsigned* bar, unsigned x, unsigned& nloc, unsigned& nx) {
    const unsigned G = gridDim.x * gridDim.y * gridDim.z;
    unsigned sum, cnt, mine, sp = 0u;
    for (;;) {
        sum = 0u; cnt = 0u; mine = 0u;
#pragma unroll
        for (unsigned j = 0; j < 16; ++j) { const unsigned c = xb_ld(&bar[XB_XCNT(j)]); sum += c; cnt += (c > 0u) ? 1u : 0u; mine = (j == x) ? c : mine; }
        if (sum == G) break;
        __builtin_amdgcn_s_sleep(1);
        if ((++sp & 255u) == 0u) { if (xb_ld(&bar[XB_TMO])) break; if (sp > XB_SPIN_CAP) { atomicAdd(&bar[XB_TMO], 1u); break; } }
    }
    nloc = mine > 0u ? mine : 1u; nx = cnt > 0u ? cnt : 1u;
}

__device__ __forceinline__ void xcd_barrier(const XcdBarrier& b) {
    asm volatile("s_waitcnt vmcnt(0)" ::: "memory");
    __syncthreads();
    if (threadIdx.x == 0) {
        unsigned* bar = b.bar;
        __builtin_amdgcn_s_waitcnt(0);
        unsigned nloc = b.st[0], nx = b.st[1];
        if (nloc == 0u) { xcd_barrier_complete(bar, b.x, nloc, nx); b.st[0] = nloc; b.st[1] = nx; }
        const unsigned old = xb_add(&bar[XB_XSUB(b.x)], 1u);
        const unsigned gen = old / nloc;
        if (old + 1u == (gen + 1u) * nloc) {
            __builtin_amdgcn_fence(__ATOMIC_RELEASE, "agent");
            asm volatile("s_waitcnt vmcnt(0)" ::: "memory");
            const unsigned og = xb_add(&bar[XB_TOP], 1u);
            const unsigned tg = og / nx;
            if (og + 1u == (tg + 1u) * nx) xb_add(&bar[XB_TOPGEN], 1u);
            else XB_SPIN(xb_ld(&bar[XB_TOPGEN]) == tg, bar);
            __builtin_amdgcn_fence(__ATOMIC_ACQUIRE, "agent");
            xb_add(&bar[XB_XGEN(b.x)], 1u);
            asm volatile("s_waitcnt vmcnt(0)" ::: "memory");
        } else {
            XB_SPIN(xb_ld(&bar[XB_XGEN(b.x)]) == gen, bar);
            __builtin_amdgcn_fence(__ATOMIC_ACQUIRE, "agent");
            asm volatile("s_waitcnt vmcnt(0)" ::: "memory");
        }
    }
    __syncthreads();
}

__device__ __forceinline__ void cvt_rows_bf16(const float* src, bf16* dst, size_t n8, size_t gtid, size_t gthreads) {
    for (size_t i = gtid; i < n8; i += gthreads) { const f32x4 a = ((const f32x4*)src)[2 * i], b = ((const f32x4*)src)[2 * i + 1];
        v4u o; o.x = pk2(a.x, a.y); o.y = pk2(a.z, a.w); o.z = pk2(b.x, b.y); o.w = pk2(b.z, b.w); ((v4u*)dst)[i] = o; }
}
__device__ __forceinline__ void transpose_item(const float* W, int N, bf16* WT, int dst_row0, LAS float* scr, int k0, int n0, int lane) {
#pragma unroll 8
    for (int i = 0; i < 32; ++i) { const int kk = 2 * i + (lane >> 5); scr[kk * 33 + (lane & 31)] = W[(size_t)(k0 + kk) * N + n0 + (lane & 31)]; }
    LDS_WAIT(); asm volatile("" ::: "memory");
    const int c = lane & 7;
#pragma unroll
    for (int j = 0; j < 4; ++j) { const int n = (lane >> 3) + 8 * j; const LAS float* s = scr + (8 * c) * 33 + n;
        v4u o; o.x = pk2(s[0 * 33], s[1 * 33]); o.y = pk2(s[2 * 33], s[3 * 33]); o.z = pk2(s[4 * 33], s[5 * 33]); o.w = pk2(s[6 * 33], s[7 * 33]);
        *(v4u*)(WT + (size_t)(dst_row0 + n) * 1024 + k0 + 8 * c) = o; }
    LDS_WAIT(); asm volatile("" ::: "memory");
}
__device__ __forceinline__ unsigned pk4_fp8(float a, float b, float c, float d) { int w = 0; w = __builtin_amdgcn_cvt_pk_fp8_f32(a, b, w, false); w = __builtin_amdgcn_cvt_pk_fp8_f32(c, d, w, true); return (unsigned)w; }
__device__ __forceinline__ void transpose_item_f8(const float* W, int N, unsigned char* WT8, int dst_row0, LAS float* scr, int k0, int n0, int lane, float wscale) {
#pragma unroll 8
    for (int i = 0; i < 32; ++i) { const int kk = 2 * i + (lane >> 5); scr[kk * 33 + (lane & 31)] = W[(size_t)(k0 + kk) * N + n0 + (lane & 31)]; }
    LDS_WAIT(); asm volatile("" ::: "memory");
    const int c = lane & 7;
#pragma unroll
    for (int j = 0; j < 4; ++j) { const int n = (lane >> 3) + 8 * j; const LAS float* s = scr + (8 * c) * 33 + n;
        v2u o; o.x = pk4_fp8(s[0 * 33] * wscale, s[1 * 33] * wscale, s[2 * 33] * wscale, s[3 * 33] * wscale); o.y = pk4_fp8(s[4 * 33] * wscale, s[5 * 33] * wscale, s[6 * 33] * wscale, s[7 * 33] * wscale);
        *(v2u*)(WT8 + (size_t)(dst_row0 + n) * 1024 + k0 + 8 * c) = o; }
    LDS_WAIT(); asm volatile("" ::: "memory");
}
__device__ __forceinline__ void phase_weights(LAS float* scr, int gw, int ngw, int lane, const float* win_src, int NC, const float* wkv_src, int nkv, const float* wo_src,
                                              const float* wg_src, const float* wu_src, const float* wd_src, bf16* win_t, bf16* wkv_t, bf16* wo_t, bf16* wgu_t, bf16* wd_t) {
    const int nbw = NC / 32, nWin = nbw * 16, NIT = nWin + 256 * nkv + 512 + NE * 1536;
    for (int it = gw; it < NIT; it += ngw) {
        int r = it;
        if (r < nWin) { const int kb = r / nbw, nb = r - kb * nbw; transpose_item(win_src, NC, win_t, 32 * nb, scr, 64 * kb, 32 * nb, lane); continue; } r -= nWin;
        if (r < 256 * nkv) { const int lay = r >> 8, rr = r & 255, kb = rr >> 4, nb = rr & 15; transpose_item(wkv_src + (size_t)lay * D * 512, 512, wkv_t + (size_t)lay * 512 * 1024, 32 * nb, scr, 64 * kb, 32 * nb, lane); continue; } r -= 256 * nkv;
        if (r < 512) { const int kb = r >> 5, nb = r & 31; transpose_item(wo_src, 1024, wo_t, 32 * nb, scr, 64 * kb, 32 * nb, lane); continue; } r -= 512;
        const int e = r / 1536, q = r - e * 1536, which = q >> 9, rr = q & 511, kb = rr >> 5, nb = rr & 31, n0 = 32 * nb;
        const size_t eoff = (size_t)e * 1024 * 1024;
        if (which == 0) transpose_item_f8(wg_src + eoff, 1024, (unsigned char*)wgu_t + 2 * eoff, (n0 >> 7) * 256 + (n0 & 127), scr, 64 * kb, n0, lane, 32.f);
        else if (which == 1) transpose_item_f8(wu_src + eoff, 1024, (unsigned char*)wgu_t + 2 * eoff, (n0 >> 7) * 256 + 128 + (n0 & 127), scr, 64 * kb, n0, lane, 32.f);
        else transpose_item_f8(wd_src + eoff, 1024, (unsigned char*)wd_t + eoff, n0, scr, 64 * kb, n0, lane, 64.f);
    }
}

template <bool OUT>
__device__ __forceinline__ void hgrn_seg(LAS unsigned char* lds, const bf16* h, const float* lbl, int j, const float* normg, float* Sloc, float* Dseg, bf16* mix, int unit, int tid, int wave, int lane) {
    const int seg = unit & (HNSEG - 1), bh = unit >> 6, hh = bh % HG_H, b = bh / HG_H;
    const int v = tid & 127, dg = tid >> 7;
    LAS float* fgs = (LAS float*)lds; LAS float* vs = fgs + 4096; LAS float* qs = vs + 4096; LAS float* op = qs + 4096;
    f32x2 st[16];
    float* Sp = Sloc + (size_t)unit * 16384 + (size_t)(dg * 32) * 128 + v;
#pragma unroll
    for (int dd = 0; dd < 16; ++dd) { st[dd].x = OUT ? Sp[(2 * dd) * 128] : 0.f; st[dd].y = OUT ? Sp[(2 * dd + 1) * 128] : 0.f; }
    float dprod = 1.f;
    const int stok = tid >> 4, c8 = (tid & 15) * 8;
    float lb[8];
#pragma unroll
    for (int i = 0; i < 8; ++i) { lb[i] = 0.f; if (j > 0) { const float a0 = lbl[hh * 128 + c8 + i], a1 = lbl[MIXW + hh * 128 + c8 + i]; lb[i] = 1.f / (1.f + __expf(a0 - a1)); } }
    for (int ch = 0; ch < HSEG / 32; ++ch) {
        const size_t t0 = (size_t)b * SEQ + seg * HSEG + ch * 32;
        { const bf16* row = h + (t0 + stok) * NC_H + hh * 128 + c8;
          const v4u f8 = *(const v4u*)(row + 768), i8 = *(const v4u*)(row + 1536); v4u q8 = {0u, 0u, 0u, 0u}; if (OUT) q8 = *(const v4u*)row;
#pragma unroll
          for (int w = 0; w < 4; ++w) { const float f0 = bflo(f8[w]), f1 = bfhi(f8[w]); const int o = stok * 128 + c8 + 2 * w;
              fgs[o] = lb[2 * w] + (1.f - lb[2 * w]) * sigmoidf_(f0); fgs[o + 1] = lb[2 * w + 1] + (1.f - lb[2 * w + 1]) * sigmoidf_(f1);
              vs[o] = bflo(i8[w]); vs[o + 1] = bfhi(i8[w]);
              if (OUT) { const float q0 = bflo(q8[w]), q1 = bfhi(q8[w]); qs[o] = q0 * sigmoidf_(q0); qs[o + 1] = q1 * sigmoidf_(q1); } } }
        __syncthreads();
        if (!OUT) { if (tid < 128) { for (int tt = 0; tt < 32; ++tt) dprod *= fgs[tt * 128 + tid]; } }
        f32x4 fA[8], qA[8], fB[8], qB[8]; float vA, vB;
#define HG_LOAD(F, Q, V, tt_) do { V = vs[(tt_) * 128 + v]; _Pragma("unroll") for (int d4 = 0; d4 < 8; ++d4) { F[d4] = *(const LAS f32x4*)(fgs + (tt_) * 128 + dg * 32 + d4 * 4); \
            if (OUT) Q[d4] = *(const LAS f32x4*)(qs + (tt_) * 128 + dg * 32 + d4 * 4); } } while (0)
#define HG_STEP(F, Q, V, tt_) do { const f32x2 vv2 = {V, V}; f32x2 acc2 = {0.f, 0.f}; _Pragma("unroll") for (int d4 = 0; d4 < 8; ++d4) { \
            const f32x2 fa = {F[d4].x, F[d4].y}, fb = {F[d4].z, F[d4].w}; \
            st[2 * d4] = fa * (st[2 * d4] - vv2) + vv2; st[2 * d4 + 1] = fb * (st[2 * d4 + 1] - vv2) + vv2; \
            if (OUT) { const f32x2 qa = {Q[d4].x, Q[d4].y}, qb = {Q[d4].z, Q[d4].w}; acc2 = qa * st[2 * d4] + acc2; acc2 = qb * st[2 * d4 + 1] + acc2; } } \
            if (OUT) op[(dg * 32 + (tt_)) * 128 + v] = acc2.x + acc2.y; } while (0)
        HG_LOAD(fA, qA, vA, 0);
#pragma unroll 1
        for (int tt = 0; tt < 32; tt += 2) {
            HG_LOAD(fB, qB, vB, tt + 1);
            __builtin_amdgcn_sched_barrier(0);
            HG_STEP(fA, qA, vA, tt);
            __builtin_amdgcn_sched_barrier(0);
            if (tt + 2 < 32) HG_LOAD(fA, qA, vA, tt + 2);
            __builtin_amdgcn_sched_barrier(0);
            HG_STEP(fB, qB, vB, tt + 1);
            __builtin_amdgcn_sched_barrier(0);
        }
#undef HG_LOAD
#undef HG_STEP
        if (OUT) {
            __syncthreads();
#pragma unroll
            for (int k = 0; k < 4; ++k) { const int tt = wave + 8 * k; float o0 = 0.f, o1 = 0.f;
#pragma unroll
                for (int g = 0; g < 4; ++g) { o0 += op[(g * 32 + tt) * 128 + lane]; o1 += op[(g * 32 + tt) * 128 + lane + 64]; }
                const float ms = wave_sum(o0 * o0 + o1 * o1) * (1.f / 128.f), r = 1.f / sqrtf(ms + 1e-6f);
                const bf16* grow = h + (t0 + tt) * NC_H + 2304 + hh * 128; const float g0 = bf2f(grow[lane]), g1 = bf2f(grow[lane + 64]);
                bf16* mrow = mix + (t0 + tt) * 1024 + hh * 128;
                mrow[lane] = (bf16)f2bf(o0 * r * normg[lane] * sigmoidf_(g0)); mrow[lane + 64] = (bf16)f2bf(o1 * r * normg[lane + 64] * sigmoidf_(g1)); }
        }
        __syncthreads();
    }
    if (!OUT) {
#pragma unroll
        for (int dd = 0; dd < 16; ++dd) { Sp[(2 * dd) * 128] = st[dd].x; Sp[(2 * dd + 1) * 128] = st[dd].y; }
        if (tid < 128) Dseg[(size_t)unit * 128 + tid] = dprod;
    }
}
constexpr int HG_G = 0, HG_QT = 32768, HG_KT = 50176, HG_KE = 67584, HG_VT = 86016, HG_ST = 104448, HG_GM = 139264, HG_GE = 139776, HG_PART = 140288;
static_assert(HG_PART + 2048 <= MISC_OFF, "HGRN LDS map");
__device__ __forceinline__ int crow16(int i, int hf) { return (i & 3) + 8 * (i >> 2) + 4 * hf; }
template <bool OUT>
__device__ __forceinline__ void hgrn_mfma(LAS unsigned char* lds, const bf16* h, const float* lbl, int j, const float* normg, float* Sloc, float* Dseg, bf16* mix, int unit, int tid, int wave, int lane) {
    const int seg = unit & (HNSEG - 1), bh = unit >> 6, hh = bh % HG_H, b = bh / HG_H;
    const int r = lane & 31, hf = lane >> 5, tr = wave & 1, vq = wave >> 1;
    LAS float* G = (LAS float*)(lds + HG_G); LAS float* GM = (LAS float*)(lds + HG_GM); LAS float* GE = (LAS float*)(lds + HG_GE); LAS float* PART = (LAS float*)(lds + HG_PART);
    const int stok = tid >> 3, c16 = (tid & 7) * 16, sperm = (stok & ~15) | (stok & 3) | ((stok & 4) << 1) | ((stok & 8) >> 1);
    const int cd = tid & 127, cpart = tid >> 7;
    float lb[16];
#pragma unroll
    for (int e = 0; e < 16; ++e) { lb[e] = 0.f; if (j > 0) { const float a0 = lbl[hh * 128 + c16 + e], a1 = lbl[MIXW + hh * 128 + c16 + e]; lb[e] = 1.f / (1.f + __expf(a0 - a1)); } }
    f32x16 S[2];
    float* Sp = Sloc + (size_t)unit * 16384 + 32 * vq + r;
#pragma unroll
    for (int dd = 0; dd < 2; ++dd)
#pragma unroll
        for (int i = 0; i < 16; ++i) S[dd][i] = OUT ? Sp[(32 * (2 * tr + dd) + crow16(i, hf)) * 128] : 0.f;
    float gsum = 0.f;
    float ng16[16];
#pragma unroll
    for (int e = 0; e < 16; ++e) ng16[e] = OUT ? normg[c16 + e] : 0.f;
    v4u nf8[2], ni8[2], nq8[2] = {{0u, 0u, 0u, 0u}, {0u, 0u, 0u, 0u}}, ng8[2] = {{0u, 0u, 0u, 0u}, {0u, 0u, 0u, 0u}};
#define HG_RAWLOAD(t0_) do { const bf16* row_ = h + ((t0_) + stok) * NC_H + hh * 128 + c16; nf8[0] = *(const v4u*)(row_ + 768); nf8[1] = *(const v4u*)(row_ + 776); ni8[0] = *(const v4u*)(row_ + 1536); ni8[1] = *(const v4u*)(row_ + 1544); \
        if (OUT) { nq8[0] = *(const v4u*)row_; nq8[1] = *(const v4u*)(row_ + 8); ng8[0] = *(const v4u*)(row_ + 2304); ng8[1] = *(const v4u*)(row_ + 2312); } } while (0)
    HG_RAWLOAD((size_t)b * SEQ + seg * HSEG);
    for (int ch = 0; ch < HSEG / 64; ++ch) {
        const size_t t0 = (size_t)b * SEQ + seg * HSEG + ch * 64;
        float fg[16], qv[16]; v4u i8[2], g8[2];
        { const v4u f8[2] = {nf8[0], nf8[1]}; i8[0] = ni8[0]; i8[1] = ni8[1]; const v4u q8[2] = {nq8[0], nq8[1]}; g8[0] = ng8[0]; g8[1] = ng8[1];
#pragma unroll
          for (int w = 0; w < 8; ++w) { const unsigned fw = f8[w >> 2][w & 3]; const float f0 = bflo(fw), f1 = bfhi(fw);
              fg[2 * w] = lb[2 * w] + (1.f - lb[2 * w]) * sigmoidf_(f0); fg[2 * w + 1] = lb[2 * w + 1] + (1.f - lb[2 * w + 1]) * sigmoidf_(f1);
              if (OUT) { const unsigned qw = q8[w >> 2][w & 3]; const float q0 = bflo(qw), q1 = bfhi(qw); qv[2 * w] = q0 * sigmoidf_(q0); qv[2 * w + 1] = q1 * sigmoidf_(q1); } else { qv[2 * w] = 0.f; qv[2 * w + 1] = 0.f; } }
#pragma unroll
          for (int e4 = 0; e4 < 4; ++e4) { f32x4 lg; lg.x = __builtin_amdgcn_logf(fg[4 * e4]); lg.y = __builtin_amdgcn_logf(fg[4 * e4 + 1]); lg.z = __builtin_amdgcn_logf(fg[4 * e4 + 2]); lg.w = __builtin_amdgcn_logf(fg[4 * e4 + 3]);
              *(LAS f32x4*)(G + stok * 128 + c16 + 4 * e4) = lg; } }
        __syncthreads();
        { float run = 0.f;
#pragma unroll
          for (int k = 0; k < 16; ++k) run += G[(16 * cpart + k) * 128 + cd];
          PART[cpart * 128 + cd] = run; }
        __syncthreads();
        { float run = 0.f;
#pragma unroll
          for (int pp = 0; pp < 3; ++pp) run += (pp < cpart) ? PART[pp * 128 + cd] : 0.f;
#pragma unroll
          for (int k = 0; k < 16; ++k) { run += G[(16 * cpart + k) * 128 + cd]; G[(16 * cpart + k) * 128 + cd] = run; }
          if (cpart == 1) GM[cd] = run;
          if (cpart == 3) { GE[cd] = run; gsum += run; } }
        __syncthreads();
        if (OUT) {
#pragma unroll
            for (int dd = 0; dd < 2; ++dd)
#pragma unroll
                for (int g4 = 0; g4 < 4; ++g4) { const int dbase = 32 * (2 * tr + dd) + 8 * g4 + 4 * hf; const f32x4 gm = *(const LAS f32x4*)(GM + dbase);
                    v2u w; w.x = cvtpk(S[dd][4 * g4] * __builtin_amdgcn_exp2f(gm.x), S[dd][4 * g4 + 1] * __builtin_amdgcn_exp2f(gm.y)); w.y = cvtpk(S[dd][4 * g4 + 2] * __builtin_amdgcn_exp2f(gm.z), S[dd][4 * g4 + 3] * __builtin_amdgcn_exp2f(gm.w));
                    *(LAS v2u*)(lds + HG_ST + (32 * vq + r) * 272 + dbase * 2) = w; }
        }
        { unsigned qt[8], kt[8];
#pragma unroll
          for (int e4 = 0; e4 < 4; ++e4) { const f32x4 gv = *(const LAS f32x4*)(G + stok * 128 + c16 + 4 * e4), gm = *(const LAS f32x4*)(GM + c16 + 4 * e4), ge = *(const LAS f32x4*)(GE + c16 + 4 * e4);
              float ke[4];
#pragma unroll
              for (int e = 0; e < 4; ++e) { const float kk = 1.f - fg[4 * e4 + e]; ke[e] = kk * __builtin_amdgcn_exp2f(ge[e] - gv[e]);
                  if (OUT) { const float a = qv[4 * e4 + e] * __builtin_amdgcn_exp2f(gv[e] - gm[e]), c = kk * __builtin_amdgcn_exp2f(gm[e] - gv[e]);
                      if (e & 1) { qt[2 * e4 + (e >> 1)] |= f2bf(a) << 16; kt[2 * e4 + (e >> 1)] |= f2bf(c) << 16; } else { qt[2 * e4 + (e >> 1)] = f2bf(a); kt[2 * e4 + (e >> 1)] = f2bf(c); } } }
#pragma unroll
              for (int e = 0; e < 4; ++e) { const int col = c16 + 4 * e4 + e;
                  *(LAS bf16*)(lds + HG_KE + col * 144 + sperm * 2) = (bf16)f2bf(ke[e]);
                  const unsigned vw = i8[e4 >> 1][(2 * e4 + (e >> 1)) & 3]; *(LAS bf16*)(lds + HG_VT + col * 144 + sperm * 2) = (bf16)((e & 1) ? (vw >> 16) : (vw & 0xffffu)); } }
          if (OUT) { *(LAS v4u*)(lds + HG_QT + stok * 272 + c16 * 2) = (v4u){qt[0], qt[1], qt[2], qt[3]}; *(LAS v4u*)(lds + HG_QT + stok * 272 + c16 * 2 + 16) = (v4u){qt[4], qt[5], qt[6], qt[7]};
                     *(LAS v4u*)(lds + HG_KT + stok * 272 + c16 * 2) = (v4u){kt[0], kt[1], kt[2], kt[3]}; *(LAS v4u*)(lds + HG_KT + stok * 272 + c16 * 2 + 16) = (v4u){kt[4], kt[5], kt[6], kt[7]}; } }
        __syncthreads();
        if (ch + 1 < HSEG / 64) HG_RAWLOAD(t0 + 64);
        if (OUT) {
            f32x16 X0, X1, O;
#pragma unroll
            for (int i = 0; i < 16; ++i) { X0[i] = 0.f; X1[i] = 0.f; O[i] = 0.f; }
            const LAS unsigned char* qtp = lds + HG_QT + (32 * tr + r) * 272 + hf * 16;
#pragma unroll
            for (int ks = 0; ks < 8; ++ks) { const s16x8 bq = *(const LAS s16x8*)(qtp + ks * 32);
                const s16x8 a0 = *(const LAS s16x8*)(lds + HG_KT + r * 272 + hf * 16 + ks * 32); X0 = __builtin_amdgcn_mfma_f32_32x32x16_bf16(a0, bq, X0, 0, 0, 0);
                if (tr == 1) { const s16x8 a1 = *(const LAS s16x8*)(lds + HG_KT + (32 + r) * 272 + hf * 16 + ks * 32); X1 = __builtin_amdgcn_mfma_f32_32x32x16_bf16(a1, bq, X1, 0, 0, 0); } }
#pragma unroll
            for (int i = 0; i < 16; ++i) { const bool keep = crow16(i, hf) <= r; if (tr == 0) X0[i] = keep ? X0[i] : 0.f; else X1[i] = keep ? X1[i] : 0.f; }
            const LAS unsigned char* vtp = lds + HG_VT + (32 * vq + r) * 144 + hf * 16;
#pragma unroll
            for (int s2 = 0; s2 < 2; ++s2) { v4u pw; pw.x = cvtpk(X0[8 * s2], X0[8 * s2 + 1]); pw.y = cvtpk(X0[8 * s2 + 2], X0[8 * s2 + 3]); pw.z = cvtpk(X0[8 * s2 + 4], X0[8 * s2 + 5]); pw.w = cvtpk(X0[8 * s2 + 6], X0[8 * s2 + 7]);
                const s16x8 bv = *(const LAS s16x8*)(vtp + (16 * s2) * 2); O = __builtin_amdgcn_mfma_f32_32x32x16_bf16(__builtin_bit_cast(s16x8, pw), bv, O, 0, 0, 0); }
            if (tr == 1) {
#pragma unroll
                for (int s2 = 0; s2 < 2; ++s2) { v4u pw; pw.x = cvtpk(X1[8 * s2], X1[8 * s2 + 1]); pw.y = cvtpk(X1[8 * s2 + 2], X1[8 * s2 + 3]); pw.z = cvtpk(X1[8 * s2 + 4], X1[8 * s2 + 5]); pw.w = cvtpk(X1[8 * s2 + 6], X1[8 * s2 + 7]);
                    const s16x8 bv = *(const LAS s16x8*)(vtp + (32 + 16 * s2) * 2); O = __builtin_amdgcn_mfma_f32_32x32x16_bf16(__builtin_bit_cast(s16x8, pw), bv, O, 0, 0, 0); } }
            const LAS unsigned char* stp = lds + HG_ST + (32 * vq + r) * 272 + hf * 16;
#pragma unroll
            for (int ks = 0; ks < 8; ++ks) { const s16x8 aq = *(const LAS s16x8*)(qtp + ks * 32), bs = *(const LAS s16x8*)(stp + ks * 32); O = __builtin_amdgcn_mfma_f32_32x32x16_bf16(aq, bs, O, 0, 0, 0); }
#pragma unroll
            for (int i = 0; i < 16; ++i) G[(32 * tr + crow16(i, hf)) * 128 + 32 * vq + r] = O[i];
        }
#pragma unroll
        for (int dd = 0; dd < 2; ++dd) { const int dr = 2 * tr + dd;
#pragma unroll
            for (int g4 = 0; g4 < 4; ++g4) { const f32x4 ge = *(const LAS f32x4*)(GE + 32 * dr + 8 * g4 + 4 * hf);
                S[dd][4 * g4] *= __builtin_amdgcn_exp2f(ge.x); S[dd][4 * g4 + 1] *= __builtin_amdgcn_exp2f(ge.y); S[dd][4 * g4 + 2] *= __builtin_amdgcn_exp2f(ge.z); S[dd][4 * g4 + 3] *= __builtin_amdgcn_exp2f(ge.w); }
#pragma unroll
            for (int ks = 0; ks < 4; ++ks) { const s16x8 a = *(const LAS s16x8*)(lds + HG_KE + (32 * dr + r) * 144 + hf * 16 + ks * 32), bv = *(const LAS s16x8*)(lds + HG_VT + (32 * vq + r) * 144 + hf * 16 + ks * 32);
                S[dd] = __builtin_amdgcn_mfma_f32_32x32x16_bf16(a, bv, S[dd], 0, 0, 0); } }
        __syncthreads();
        if (OUT) {
            float ov[16]; float ss = 0.f;
#pragma unroll
            for (int e4 = 0; e4 < 4; ++e4) { const f32x4 o4 = *(const LAS f32x4*)(G + stok * 128 + c16 + 4 * e4); ov[4 * e4] = o4.x; ov[4 * e4 + 1] = o4.y; ov[4 * e4 + 2] = o4.z; ov[4 * e4 + 3] = o4.w;
                ss += (o4.x * o4.x + o4.y * o4.y) + (o4.z * o4.z + o4.w * o4.w); }
            ss += xorf<1>(ss); ss += xorf<2>(ss); ss += xorf<4>(ss);
            const float rr = 1.f / sqrtf(ss * (1.f / 128.f) + 1e-6f);
            unsigned ow[8];
#pragma unroll
            for (int w = 0; w < 8; ++w) { const unsigned gw_ = g8[w >> 2][w & 3]; ow[w] = cvtpk(ov[2 * w] * rr * ng16[2 * w] * sigmoidf_(bflo(gw_)), ov[2 * w + 1] * rr * ng16[2 * w + 1] * sigmoidf_(bfhi(gw_))); }
            bf16* mrow = mix + (t0 + stok) * 1024 + hh * 128 + c16;
            *(v4u*)mrow = (v4u){ow[0], ow[1], ow[2], ow[3]}; *(v4u*)(mrow + 8) = (v4u){ow[4], ow[5], ow[6], ow[7]};
            __syncthreads();
        }
    }
#undef HG_RAWLOAD
    if (!OUT) {
#pragma unroll
        for (int dd = 0; dd < 2; ++dd)
#pragma unroll
            for (int i = 0; i < 16; ++i) Sp[(32 * (2 * tr + dd) + crow16(i, hf)) * 128] = S[dd][i];
        if (cpart == 3) Dseg[(size_t)unit * 128 + cd] = __builtin_amdgcn_exp2f(gsum);
    }
}
__device__ __forceinline__ void hgrn_scan(float* Sloc, const float* Dseg, size_t gtid, size_t gthreads) {
    for (size_t idx = gtid; idx < (size_t)NBATCH * HG_H * 16384; idx += gthreads) { const int bh = (int)(idx >> 14), e = (int)(idx & 16383), d = e >> 7; float cur = 0.f;
        float* __restrict__ sp = Sloc + (size_t)bh * HNSEG * 16384 + e; const float* __restrict__ dp = Dseg + (size_t)bh * HNSEG * 128 + d;
        for (int s0 = 0; s0 < HNSEG; s0 += 16) { float tv[16], dv[16];
#pragma unroll
            for (int k = 0; k < 16; ++k) { tv[k] = sp[(size_t)(s0 + k) * 16384]; dv[k] = dp[(s0 + k) * 128]; }
#pragma unroll
            for (int k = 0; k < 16; ++k) { sp[(size_t)(s0 + k) * 16384] = cur; cur = dv[k] * cur + tv[k]; } } }
}

template <bool MASK>
__device__ __forceinline__ void attn4(const LAS unsigned* Ks, const LAS bf16* Vs, const LAS float* qst, LAS float* pb, int lane, const int (&tq)[4], int kbase, float slope,
                                      float (&mo)[4], float (&lo)[4], float (&oo)[4]) {
    float sc[4][4];
#pragma unroll
    for (int a = 0; a < 4; ++a)
#pragma unroll
        for (int c = 0; c < 4; ++c) sc[a][c] = 0.f;
#pragma unroll 4
    for (int dd = 0; dd < 32; ++dd) {
        f32x2 qv[4];
#pragma unroll
        for (int qi = 0; qi < 4; ++qi) qv[qi] = *(const LAS f32x2*)(qst + qi * 64 + 2 * dd);
#pragma unroll
        for (int kk = 0; kk < 4; ++kk) { const unsigned kw = Ks[(lane + 64 * kk) * 33 + dd]; const float k0 = bflo(kw), k1 = bfhi(kw);
#pragma unroll
            for (int qi = 0; qi < 4; ++qi) sc[qi][kk] += qv[qi].x * k0 + qv[qi].y * k1; }
    }
#pragma unroll
    for (int qi = 0; qi < 4; ++qi) { float mx = -INFINITY;
#pragma unroll
        for (int kk = 0; kk < 4; ++kk) { const int pos = kbase + lane + 64 * kk; float lg = sc[qi][kk] * 0.125f - slope * (float)(tq[qi] - pos); if (MASK && pos > tq[qi]) lg = -INFINITY; sc[qi][kk] = lg; mx = fmaxf(mx, lg); }
        mx = wave_max(mx); float s = 0.f;
#pragma unroll
        for (int kk = 0; kk < 4; ++kk) { const float p = __builtin_amdgcn_exp2f((sc[qi][kk] - mx) * 1.4426950408889634f); pb[qi * 256 + lane + 64 * kk] = p; s += p; }
        lo[qi] = wave_sum(s); mo[qi] = mx; }
    float o[4] = {0.f, 0.f, 0.f, 0.f};
#pragma unroll 4
    for (int k4 = 0; k4 < 64; ++k4) { f32x4 p4[4];
#pragma unroll
        for (int qi = 0; qi < 4; ++qi) p4[qi] = *(const LAS f32x4*)(pb + qi * 256 + 4 * k4);
#pragma unroll
        for (int jj = 0; jj < 4; ++jj) { const float vv = bf2f(Vs[(4 * k4 + jj) * 64 + lane]);
#pragma unroll
            for (int qi = 0; qi < 4; ++qi) o[qi] += p4[qi][jj] * vv; } }
#pragma unroll
    for (int qi = 0; qi < 4; ++qi) oo[qi] = o[qi];
}
constexpr int AT_KS = 0, AT_VS = 33792, AT_WV = 66560, AT_WVB = 5120;

__device__ __forceinline__ void memattn_unit(LAS unsigned char* lds, const bf16* h, int NC, int qoff, const bf16* kv, bf16* mix, int unit, int tid, int wave, int lane) {
    const int chunk = unit & 31, bm = unit >> 5, mh = bm & 3, b = bm >> 2;
    LAS unsigned* Ks = (LAS unsigned*)(lds + AT_KS); LAS unsigned* Vs32 = (LAS unsigned*)(lds + AT_VS);
    LAS float* qst = (LAS float*)(lds + AT_WV + wave * AT_WVB); LAS float* pb = qst + 256;
    for (int i = 0; i < 16; ++i) { const int idx = tid + 512 * i, r = idx >> 5, dd = idx & 31; const unsigned* src = (const unsigned*)(kv + (size_t)(b * 256 + r) * 512 + mh * 64);
        Ks[r * 33 + dd] = src[dd]; Vs32[r * 32 + dd] = src[128 + dd]; }
    __syncthreads();
    for (int qd = 0; qd < 16; ++qd) { const size_t tg = (size_t)b * SEQ + chunk * 512 + wave * 64 + qd * 4;
#pragma unroll
        for (int qi = 0; qi < 4; ++qi) qst[qi * 64 + lane] = bf2f(h[(tg + qi) * NC + qoff + mh * 64 + lane]);
        const int tq[4] = {0, 0, 0, 0}; float m[4], l[4], o[4];
        attn4<false>(Ks, (const LAS bf16*)Vs32, qst, pb, lane, tq, 0, 0.f, m, l, o);
#pragma unroll
        for (int qi = 0; qi < 4; ++qi) mix[(tg + qi) * 1024 + MIXW + mh * 64 + lane] = (bf16)f2bf(o[qi] / l[qi]); }
    __syncthreads();
}

constexpr int AT2_K = 0, AT2_KROW = 176, AT2_V = 256 * AT2_KROW, AT2_VROW = 528, AT2_SCR = AT2_V + 64 * AT2_VROW, AT2_SCRW = 4864;
__device__ __forceinline__ void stage_kv_images(LAS unsigned char* lds, const bf16* kp, const bf16* vp, size_t row_stride, int tid) {
    v4u kx[4], vx[4];
#pragma unroll
    for (int i = 0; i < 4; ++i) { const int idx = tid + 512 * i, key = idx >> 3, c = idx & 7; kx[i] = *(const v4u*)(kp + (size_t)key * row_stride + 8 * c); vx[i] = *(const v4u*)(vp + (size_t)key * row_stride + 8 * c); }
    __builtin_amdgcn_sched_barrier(0);
#pragma unroll
    for (int i = 0; i < 4; ++i) { const int idx = tid + 512 * i, key = idx >> 3, c = idx & 7;
        *(LAS v4u*)(lds + AT2_K + key * AT2_KROW + c * 16) = kx[i];
        const int pos = (key & ~15) | (key & 3) | ((key & 4) << 1) | ((key & 8) >> 1);
        LAS bf16* vt = (LAS bf16*)(lds + AT2_V) + pos;
#pragma unroll
        for (int w = 0; w < 4; ++w) { vt[(8 * c + 2 * w) * (AT2_VROW / 2)] = (bf16)(vx[i][w] & 0xffffu); vt[(8 * c + 2 * w + 1) * (AT2_VROW / 2)] = (bf16)(vx[i][w] >> 16); } }
    if (tid < 256) { const unsigned pb = f2bf((float)tid); const v4u e0 = {pb | (pb << 16), 0u, 0u, 0u}, z = {0u, 0u, 0u, 0u};
        *(LAS v4u*)(lds + AT2_K + tid * AT2_KROW + 128) = e0; *(LAS v4u*)(lds + AT2_K + tid * AT2_KROW + 144) = z; }
}
template <bool MASK>
__device__ __forceinline__ void attn_tile32(const LAS unsigned char* lds, const s16x8 (&qf)[4], int lane, float dist0, unsigned qx, bool own, f32x16 (&o)[2], float& mrow, float& lrow) {
    const int r = lane & 31, hf = lane >> 5;
    const v4u qxv = {qx, 0u, 0u, 0u}; const s16x8 qe = __builtin_bit_cast(s16x8, qxv);
    f32x16 acc[8];
    const LAS unsigned char* kb = lds + AT2_K + r * AT2_KROW + hf * 16;
    constexpr int NKS = MASK ? 5 : 4;
    s16x8 kf[NKS];
#pragma unroll
    for (int s = 0; s < NKS; ++s) kf[s] = *(const LAS s16x8*)(kb + s * 32);
#pragma unroll
    for (int kt = 0; kt < 8; ++kt) {
#pragma unroll
        for (int i = 0; i < 16; ++i) acc[kt][i] = 0.f;
#pragma unroll
        for (int s = 0; s < NKS; ++s) { acc[kt] = __builtin_amdgcn_mfma_f32_32x32x16_bf16(kf[s], s < 4 ? qf[s < 4 ? s : 0] : qe, acc[kt], 0, 0, 0);
            if (kt + 1 < 8) kf[s] = *(const LAS s16x8*)(kb + (kt + 1) * 32 * AT2_KROW + s * 32); }
        __builtin_amdgcn_sched_barrier(0); }
    float mx = -INFINITY;
    if (MASK && own) { const float base2 = dist0 - 4.f * (float)hf;
#pragma unroll
        for (int kt = 0; kt < 8; ++kt)
#pragma unroll
            for (int i = 0; i < 16; ++i) { const float dist = base2 - (float)(32 * kt + (i & 3) + 8 * (i >> 2)); const float lg = dist < 0.f ? -INFINITY : acc[kt][i]; acc[kt][i] = lg; mx = fmaxf(mx, lg); }
    } else {
#pragma unroll
        for (int kt = 0; kt < 8; ++kt)
#pragma unroll
            for (int i = 0; i < 16; ++i) mx = fmaxf(mx, acc[kt][i]);
    }
    mx = fmaxf(mx, xor32f(mx, lane));
    float sum = 0.f;
#pragma unroll
    for (int i = 0; i < 16; ++i) { o[0][i] = 0.f; o[1][i] = 0.f; }
    const LAS unsigned char* vb = lds + AT2_V + r * AT2_VROW + hf * 16;
    s16x8 vf[4];
#pragma unroll
    for (int s2 = 0; s2 < 2; ++s2)
#pragma unroll
        for (int dt = 0; dt < 2; ++dt) vf[2 * s2 + dt] = *(const LAS s16x8*)(vb + dt * 32 * AT2_VROW + (16 * s2) * 2);
#pragma unroll
    for (int kt = 0; kt < 8; ++kt) {
#pragma unroll
        for (int i = 0; i < 16; ++i) { const float p = __builtin_amdgcn_exp2f(acc[kt][i] - mx); sum += p; acc[kt][i] = p; }
#pragma unroll
        for (int s2 = 0; s2 < 2; ++s2) { v4u pw; pw.x = cvtpk(acc[kt][8 * s2], acc[kt][8 * s2 + 1]); pw.y = cvtpk(acc[kt][8 * s2 + 2], acc[kt][8 * s2 + 3]);
            pw.z = cvtpk(acc[kt][8 * s2 + 4], acc[kt][8 * s2 + 5]); pw.w = cvtpk(acc[kt][8 * s2 + 6], acc[kt][8 * s2 + 7]); const s16x8 pf = __builtin_bit_cast(s16x8, pw);
#pragma unroll
            for (int dt = 0; dt < 2; ++dt) { o[dt] = __builtin_amdgcn_mfma_f32_32x32x16_bf16(vf[2 * s2 + dt], pf, o[dt], 0, 0, 0);
                if (kt + 1 < 8) vf[2 * s2 + dt] = *(const LAS s16x8*)(vb + dt * 32 * AT2_VROW + (32 * (kt + 1) + 16 * s2) * 2); } }
        __builtin_amdgcn_sched_barrier(0); }
    sum += xor32f(sum, lane);
    mrow = mx; lrow = sum;
}
__device__ __forceinline__ void memattn_unit2(LAS unsigned char* lds, const bf16* h, int NC, int qoff, const bf16* kv  , bf16* mix, int unit, int tid, int wave, int lane) {
    const int chunk = unit & 63, bm = unit >> 6, mh = bm & 3, b = bm >> 2, r = lane & 31, hf = lane >> 5;
    const bf16* kvrow0 = kv + (size_t)(b * 256) * 2048 + mh * 64;
    stage_kv_images(lds, kvrow0, kvrow0 + 256, 2048, tid);
    __syncthreads();
    { const size_t tg = (size_t)b * SEQ + chunk * 256 + wave * 32 + r;
        f32x16 o[2]; float m2, l; s16x8 qf[4];
#pragma unroll
        for (int s = 0; s < 4; ++s) qf[s] = *(const s16x8*)(h + tg * NC + qoff + mh * 64 + 16 * s + 8 * hf);
        attn_tile32<false>(lds, qf, lane, 0.f, 0u, false, o, m2, l);
        const float inv = 1.f / l; bf16* mp = mix + tg * 1024 + MIXW + mh * 64 + 4 * hf;
#pragma unroll
        for (int dt = 0; dt < 2; ++dt)
#pragma unroll
            for (int g = 0; g < 4; ++g) { v2u w; w.x = cvtpk(o[dt][4 * g] * inv, o[dt][4 * g + 1] * inv); w.y = cvtpk(o[dt][4 * g + 2] * inv, o[dt][4 * g + 3] * inv); *(v2u*)(mp + 32 * dt + 8 * g) = w; } }
    __syncthreads();
}
__device__ __forceinline__ void kmean_unit(LAS unsigned char* lds, const bf16* h, float* kmean, int unit, int tid) {
    const int n = unit & 63, bh = unit >> 6, hh = bh % MB_H, b = bh / MB_H, d = tid & 63, part = tid >> 6;
    LAS float* red = (LAS float*)lds;
    float s = 0.f; const bf16* p = h + ((size_t)b * SEQ + n * 256 + part * 32) * NC_M + 768 + hh * 64 + d;
    for (int i = 0; i < 32; ++i) s += bf2f(p[(size_t)i * NC_M]);
    red[part * 64 + d] = s; __syncthreads();
    if (tid < 64) { float a = 0.f; for (int pp = 0; pp < 8; ++pp) a += red[pp * 64 + tid]; kmean[((size_t)bh * 64 + n) * 64 + tid] = a * (1.f / 256.f); }
    __syncthreads();
}
__device__ __forceinline__ void moba_gate_unit(LAS unsigned char* lds, const bf16* h, const float* kmean, unsigned* gcount, int* selinfo, unsigned* list, int unit, int tid) {
    const int c = unit & 63, bh = unit >> 6, hh = bh % MB_H, b = bh / MB_H;
    LAS float* km = (LAS float*)lds; LAS int* hist = (LAS int*)(lds + 16384); LAS int* base = hist + 64;
    for (int i = tid; i < 4096; i += NTHR) km[i] = kmean[(size_t)bh * 4096 + i];
    if (tid < 64) hist[tid] = 0;
    __syncthreads();
    int s0 = 0, s1 = 0, s2 = 0, r0 = 0, r1 = 0, r2 = 0, ns = 0; const int hb = tid >> 8, t = c * 256 + (tid & 255);
    float v0 = -INFINITY, v1 = -INFINITY, v2 = -INFINITY;
    {
        float q[64]; const v4u* qp = (const v4u*)(h + ((size_t)b * SEQ + t) * NC_M + hh * 64);
#pragma unroll
        for (int w = 0; w < 8; ++w) { const v4u x = qp[w]; q[8 * w] = bflo(x.x); q[8 * w + 1] = bfhi(x.x); q[8 * w + 2] = bflo(x.y); q[8 * w + 3] = bfhi(x.y); q[8 * w + 4] = bflo(x.z); q[8 * w + 5] = bfhi(x.z); q[8 * w + 6] = bflo(x.w); q[8 * w + 7] = bfhi(x.w); }
        for (int n = hb; n < c; n += 2) { f32x2 g2 = {0.f, 0.f};
#pragma unroll
            for (int d4 = 0; d4 < 16; ++d4) { const f32x4 k4 = *(const LAS f32x4*)(km + n * 64 + 4 * d4); const f32x2 ka_ = {k4.x, k4.y}, kb_ = {k4.z, k4.w}, qa_ = {q[4 * d4], q[4 * d4 + 1]}, qb_ = {q[4 * d4 + 2], q[4 * d4 + 3]}; g2 = qa_ * ka_ + g2; g2 = qb_ * kb_ + g2; }
            const float g = g2.x + g2.y;
            if (g > v0) { v2 = v1; s2 = s1; v1 = v0; s1 = s0; v0 = g; s0 = n; } else if (g > v1) { v2 = v1; s2 = s1; v1 = g; s1 = n; } else if (g > v2) { v2 = g; s2 = n; } }
    }
    LAS float* cv = (LAS float*)(lds + 20480); LAS int* cs = (LAS int*)(lds + 20480 + 3072);
    if (hb == 1) { cv[tid & 255] = v0; cv[256 + (tid & 255)] = v1; cv[512 + (tid & 255)] = v2; cs[tid & 255] = s0; cs[256 + (tid & 255)] = s1; cs[512 + (tid & 255)] = s2; }
    __syncthreads();
    if (tid < 256) {
#pragma unroll
        for (int k = 0; k < 3; ++k) { const float g = cv[256 * k + tid]; const int n = cs[256 * k + tid];
            if (g > v0 || (g == v0 && n < s0)) { v2 = v1; s2 = s1; v1 = v0; s1 = s0; v0 = g; s0 = n; } else if (g > v1 || (g == v1 && n < s1)) { v2 = v1; s2 = s1; v1 = g; s1 = n; } else if (g > v2 || (g == v2 && n < s2)) { v2 = g; s2 = n; } }
        ns = c < 3 ? c : 3;
        if (ns > 0) r0 = __hip_atomic_fetch_add(hist + s0, 1, __ATOMIC_RELAXED, __HIP_MEMORY_SCOPE_WORKGROUP);
        if (ns > 1) r1 = __hip_atomic_fetch_add(hist + s1, 1, __ATOMIC_RELAXED, __HIP_MEMORY_SCOPE_WORKGROUP);
        if (ns > 2) r2 = __hip_atomic_fetch_add(hist + s2, 1, __ATOMIC_RELAXED, __HIP_MEMORY_SCOPE_WORKGROUP);
        selinfo[((size_t)b * SEQ + t) * MB_H + hh] = ns;
    }
    __syncthreads();
    if (tid < 64) { const int hc = hist[tid]; if (hc > 0) base[tid] = (int)__hip_atomic_fetch_add(gcount + bh * 64 + tid, (unsigned)hc, __ATOMIC_RELAXED, __HIP_MEMORY_SCOPE_AGENT); }
    __syncthreads();
    if (tid < 256) { unsigned* lp = list + ((size_t)bh * 64 << 14);
        if (ns > 0) lp[((size_t)s0 << 14) + base[s0] + r0] = (unsigned)t;
        if (ns > 1) lp[((size_t)s1 << 14) + base[s1] + r1] = (unsigned)t | (1u << 14);
        if (ns > 2) lp[((size_t)s2 << 14) + base[s2] + r2] = (unsigned)t | (2u << 14); }
    __syncthreads();
}
__device__ __forceinline__ void moba_attn_item(LAS unsigned char* lds, const bf16* h, const unsigned* gcount, const unsigned* list, float* po, float* pml, int item, int tid, int wave, int lane) {
    const int n = item / 24, bh = item - n * 24, hh = bh % MB_H, b = bh / MB_H;
    LAS unsigned* Ks = (LAS unsigned*)(lds + AT_KS); LAS unsigned* Vs32 = (LAS unsigned*)(lds + AT_VS);
    LAS float* qst = (LAS float*)(lds + AT_WV + wave * AT_WVB); LAS float* pb = qst + 256;
    for (int i = 0; i < 16; ++i) { const int idx = tid + 512 * i, r = idx >> 5, dd = idx & 31; const unsigned* src = (const unsigned*)(h + ((size_t)b * SEQ + n * 256 + r) * NC_M + hh * 64);
        Ks[r * 33 + dd] = src[384 + dd]; Vs32[r * 32 + dd] = src[768 + dd]; }
    __syncthreads();
    const int cnt = (int)gcount[bh * 64 + n], total = 256 + cnt, nquads = (total + 3) >> 2;
    const float slope = hh < 8 ? ldexpf(1.0f, -(hh + 1)) : ldexpf(0.70710678118654752f, -(hh - 8));
    const unsigned* lp = list + (((size_t)bh * 64 + n) << 14);
    for (int quad = wave; quad < nquads; quad += 8) {
        int tq[4], slot[4];
#pragma unroll
        for (int qi = 0; qi < 4; ++qi) { int idx = quad * 4 + qi; idx = idx < total ? idx : total - 1;
            if (idx < 256) { tq[qi] = n * 256 + idx; slot[qi] = 3; } else { const unsigned e = lp[idx - 256]; tq[qi] = (int)(e & 16383u); slot[qi] = (int)(e >> 14); } }
#pragma unroll
        for (int qi = 0; qi < 4; ++qi) qst[qi * 64 + lane] = bf2f(h[((size_t)b * SEQ + tq[qi]) * NC_M + hh * 64 + lane]);
        float m[4], l[4], o[4];
        attn4<true>(Ks, (const LAS bf16*)Vs32, qst, pb, lane, tq, n * 256, slope, m, l, o);
#pragma unroll
        for (int qi = 0; qi < 4; ++qi) if (quad * 4 + qi < total) { const size_t pi = (((size_t)b * SEQ + tq[qi]) * MB_H + hh) * 4 + slot[qi];
            po[pi * 64 + lane] = o[qi]; if (lane == 0) { pml[pi * 2] = m[qi]; pml[pi * 2 + 1] = l[qi]; } }
    }
    __syncthreads();
}

__device__ __forceinline__ void moba_attn_item2(LAS unsigned char* lds, const bf16* h, const unsigned* gcount, const unsigned* list, bf16* po, float* pml, int item, int tid, int wave, int lane) {
    const int n = item / 24, bh = item - n * 24, hh = bh % MB_H, b = bh / MB_H, r = lane & 31, hf = lane >> 5;
    const bf16* hrow0 = h + ((size_t)b * SEQ + n * 256) * NC_M + hh * 64;
    stage_kv_images(lds, hrow0 + 768, hrow0 + 1536, NC_M, tid);
    __syncthreads();
    const int cnt = (int)gcount[bh * 64 + n], total = 256 + cnt, ntiles = (total + 31) >> 5;
    const float slope2 = (hh < 8 ? ldexpf(1.0f, -(hh + 1)) : ldexpf(0.70710678118654752f, -(hh - 8))) * 1.4426950408889634f;
    const unsigned shi = f2bf(slope2), slo = f2bf(slope2 - __builtin_bit_cast(float, shi << 16)); const unsigned qx = hf == 0 ? (shi | (slo << 16)) : 0u;
    const unsigned* lp = list + (((size_t)bh * 64 + n) << 14);
    const bf16* hq = h + (size_t)b * SEQ * NC_M + hh * 64 + 8 * hf;
#pragma unroll 1
    for (int tile = wave; tile < ntiles; tile += NWAVES) {
        int idx = tile * 32 + r; const bool valid = idx < total; idx = valid ? idx : total - 1;
        int tq, slot; if (idx < 256) { tq = n * 256 + idx; slot = 3; } else { const unsigned e = lp[idx - 256]; tq = (int)(e & 16383u); slot = (int)(e >> 14); }
        s16x8 qf[4]; { const bf16* qp = hq + (size_t)tq * NC_M;
#pragma unroll
            for (int s = 0; s < 4; ++s) qf[s] = *(const s16x8*)(qp + 16 * s); }
        f32x16 o[2]; float m2, l; const float dist0 = (float)(tq - n * 256);
        attn_tile32<true>(lds, qf, lane, dist0, qx, tile < 8, o, m2, l);
        { LAS unsigned char* sw = lds + AT2_SCR + wave * AT2_SCRW; const int pi = valid ? (int)((((size_t)b * SEQ + tq) * MB_H + hh) * 4 + slot) : -1;
#pragma unroll
          for (int dt = 0; dt < 2; ++dt)
#pragma unroll
              for (int g = 0; g < 4; ++g) { v2u w; w.x = cvtpk(o[dt][4 * g], o[dt][4 * g + 1]); w.y = cvtpk(o[dt][4 * g + 2], o[dt][4 * g + 3]); *(LAS v2u*)(sw + r * 144 + (32 * dt + 8 * g + 4 * hf) * 2) = w; }
          if (hf == 0) { *(LAS int*)(sw + 4608 + 4 * r) = pi; if (valid) { pml[(size_t)pi * 2] = m2 - slope2 * dist0; pml[(size_t)pi * 2 + 1] = l; } }
#pragma unroll
          for (int it = 0; it < 4; ++it) { const int q = 8 * it + (lane >> 3), c = lane & 7; const int pq = *(const LAS int*)(sw + 4608 + 4 * q); const v4u row = *(const LAS v4u*)(sw + q * 144 + c * 16);
              if (pq >= 0) *(v4u*)(po + (size_t)pq * 64 + c * 8) = row; } }
    }
    __syncthreads();
}
__device__ __forceinline__ void moba_combine(const bf16* __restrict__ po, const float* __restrict__ pml, const int* __restrict__ selinfo, bf16* __restrict__ mix, int gw, int ngw, int lane) {
    const int sub = lane >> 4, d4 = (lane & 15) * 4;
#pragma unroll 4
    for (int idx = gw * 4 + sub; idx < T * MB_H; idx += ngw * 4) { const int tg = idx / MB_H, hh = idx - tg * MB_H, ns = selinfo[idx]; const size_t p4 = (size_t)idx * 4;
        f32x2 ml[4]; f32x4 ov[4];
#pragma unroll
        for (int j = 0; j < 4; ++j) { ml[j] = ((const f32x2*)pml)[p4 + j]; const v2u ow = *(const v2u*)(po + (p4 + j) * 64 + d4); ov[j] = (f32x4){bflo(ow.x), bfhi(ow.x), bflo(ow.y), bfhi(ow.y)}; }
        float M = ml[3].x;
#pragma unroll
        for (int j = 0; j < 3; ++j) { const bool ok = j < ns; ml[j].x = ok ? ml[j].x : -INFINITY; ml[j].y = ok ? ml[j].y : 0.f; M = fmaxf(M, ml[j].x);
            ov[j].x = ok ? ov[j].x : 0.f; ov[j].y = ok ? ov[j].y : 0.f; ov[j].z = ok ? ov[j].z : 0.f; ov[j].w = ok ? ov[j].w : 0.f; }
        float den = 0.f; f32x4 num = {0.f, 0.f, 0.f, 0.f};
#pragma unroll
        for (int j = 0; j < 4; ++j) { const float w = __builtin_amdgcn_exp2f(ml[j].x - M); den += w * ml[j].y; num += ov[j] * w; }
        const float inv = 1.f / den; v2u o; o.x = pk2(num.x * inv, num.y * inv); o.y = pk2(num.z * inv, num.w * inv);
        *(v2u*)(mix + (size_t)tg * 1024 + hh * 64 + d4) = o; }
}

__device__ __forceinline__ void ln_row(f32x4 (&v)[4], const f32x4 (&gv)[4], const f32x4 (&bv)[4]) {
    float s = 0.f;
#pragma unroll
    for (int j = 0; j < 4; ++j) s += (v[j].x + v[j].y) + (v[j].z + v[j].w);
    const float mean = wave_sum(s) * (1.f / D); float s2 = 0.f;
#pragma unroll
    for (int j = 0; j < 4; ++j) { v[j] = v[j] - mean; s2 += (v[j].x * v[j].x + v[j].y * v[j].y) + (v[j].z * v[j].z + v[j].w * v[j].w); }
    const float rstd = 1.f / sqrtf(wave_sum(s2) * (1.f / D) + 1e-5f);
#pragma unroll
    for (int j = 0; j < 4; ++j) v[j] = v[j] * rstd * gv[j] + bv[j];
}
__device__ __forceinline__ void split_router_weights(const float* wr  , bf16* wrs  , size_t gtid, size_t gthreads) {
    for (size_t i = gtid; i < (size_t)DEPTH * D * NE; i += gthreads) { const int e = (int)(i & 31), d = (int)((i >> 5) & 1023), l = (int)(i >> 15);
        const float w = wr[i]; const unsigned hi = f2bf(w); const unsigned lo = f2bf(w - __builtin_bit_cast(float, hi << 16));
        wrs[(((size_t)l * 2 + 0) * NE + e) * D + d] = (bf16)hi; wrs[(((size_t)l * 2 + 1) * NE + e) * D + d] = (bf16)lo; }
}
constexpr int L1_XH = 0, L1_XL = 33024, L1_ROW = 2064, L1_PART = 66048, L1_HIST = 82432;
__device__ __forceinline__ void phase_ln1(LAS unsigned char* lds, const bf16* y, const float* g, const float* bb, const bf16* wrs  , const float* br,
                                          bf16* xbf, int* tok_e, int* tok_lr, float* tok_w, int* blk_cnt, int blk, int tid, int wave, int lane) {
    LAS float* part = (LAS float*)(lds + L1_PART);
    LAS int* hist = (LAS int*)(lds + L1_HIST);
    if (tid < 32) hist[tid] = 0;
    constexpr int TPB = T / GRID;
    const int e = lane & 31, m16 = lane & 15, quad = lane >> 4;
    s16x8 bw[4][2][2];
#pragma unroll
    for (int ks = 0; ks < 4; ++ks)
#pragma unroll
        for (int nt = 0; nt < 2; ++nt)
#pragma unroll
            for (int pp = 0; pp < 2; ++pp) bw[ks][nt][pp] = *(const s16x8*)(wrs + ((size_t)pp * NE + 16 * nt + m16) * D + wave * 128 + 32 * ks + 8 * quad);
    const float bre = br[e];
    f32x4 gv[4], bv[4];
#pragma unroll
    for (int j = 0; j < 4; ++j) { gv[j] = ((const f32x4*)g)[lane + 64 * j]; bv[j] = ((const f32x4*)bb)[lane + 64 * j]; }
    v2u xn[2][4], yn[2][4];
#pragma unroll
    for (int u = 0; u < 2; ++u) { const size_t t0 = (size_t)blk * TPB + 2 * wave + u; const v2u* xr = (const v2u*)(xbf + t0 * D) + lane; const v2u* yr = (const v2u*)(y + t0 * D) + lane;
#pragma unroll
        for (int j = 0; j < 4; ++j) { xn[u][j] = xr[64 * j]; yn[u][j] = yr[64 * j]; } }
    __syncthreads();
    for (int grp = 0; grp < TPB / 16; ++grp) { const size_t tg0 = (size_t)blk * TPB + grp * 16 + 2 * wave;
        f32x4 v[2][4];
#pragma unroll
        for (int u = 0; u < 2; ++u)
#pragma unroll
            for (int j = 0; j < 4; ++j) { const v2u xw = xn[u][j]; const v2u yw = yn[u][j];
                v[u][j].x = DN_ALPHA * bflo(xw.x) + bflo(yw.x); v[u][j].y = DN_ALPHA * bfhi(xw.x) + bfhi(yw.x); v[u][j].z = DN_ALPHA * bflo(xw.y) + bflo(yw.y); v[u][j].w = DN_ALPHA * bfhi(xw.y) + bfhi(yw.y); }
        if (grp + 1 < TPB / 16) {
#pragma unroll
            for (int u = 0; u < 2; ++u) { const v2u* xr = (const v2u*)(xbf + (tg0 + 16 + u) * D) + lane; const v2u* yr = (const v2u*)(y + (tg0 + 16 + u) * D) + lane;
#pragma unroll
                for (int j = 0; j < 4; ++j) { xn[u][j] = xr[64 * j]; yn[u][j] = yr[64 * j]; } } }
#pragma unroll
        for (int u = 0; u < 2; ++u) { ln_row(v[u], gv, bv);
            v2u* xb = (v2u*)(xbf + (tg0 + u) * D) + lane;
#pragma unroll
            for (int j = 0; j < 4; ++j) { v2u hw; hw.x = cvtpk(v[u][j].x, v[u][j].y); hw.y = cvtpk(v[u][j].z, v[u][j].w); xb[64 * j] = hw;
                v2u lw; lw.x = cvtpk(v[u][j].x - bflo(hw.x), v[u][j].y - bfhi(hw.x)); lw.y = cvtpk(v[u][j].z - bflo(hw.y), v[u][j].w - bfhi(hw.y));
                *(LAS v2u*)(lds + L1_XH + (2 * wave + u) * L1_ROW + (4 * lane + 256 * j) * 2) = hw; *(LAS v2u*)(lds + L1_XL + (2 * wave + u) * L1_ROW + (4 * lane + 256 * j) * 2) = lw; } }
        __syncthreads();
        { f32x4 acc[2] = {{0.f, 0.f, 0.f, 0.f}, {0.f, 0.f, 0.f, 0.f}};
#pragma unroll
          for (int ks = 0; ks < 4; ++ks) { const int off = m16 * L1_ROW + (wave * 128 + 32 * ks + 8 * quad) * 2;
              const s16x8 ah = *(const LAS s16x8*)(lds + L1_XH + off), al = *(const LAS s16x8*)(lds + L1_XL + off);
#pragma unroll
              for (int nt = 0; nt < 2; ++nt) { acc[nt] = __builtin_amdgcn_mfma_f32_16x16x32_bf16(ah, bw[ks][nt][0], acc[nt], 0, 0, 0); acc[nt] = __builtin_amdgcn_mfma_f32_16x16x32_bf16(ah, bw[ks][nt][1], acc[nt], 0, 0, 0);
                  acc[nt] = __builtin_amdgcn_mfma_f32_16x16x32_bf16(al, bw[ks][nt][0], acc[nt], 0, 0, 0); } }
#pragma unroll
          for (int nt = 0; nt < 2; ++nt)
#pragma unroll
              for (int jj = 0; jj < 4; ++jj) part[(wave * 16 + 4 * quad + jj) * 32 + 16 * nt + m16] = acc[nt][jj]; }
        __syncthreads();
#pragma unroll
        for (int u = 0; u < 2; ++u) { const size_t t = tg0 + u;
            float logit = bre;
#pragma unroll
            for (int w = 0; w < 8; ++w) logit += part[(w * 16 + 2 * wave + u) * 32 + e];
            int rank = 0;
#pragma unroll
            for (int q = 0; q < 32; ++q) { const float oq = __builtin_bit_cast(float, __builtin_amdgcn_readlane(__builtin_bit_cast(int, logit), q)); rank += (oq > logit || (oq == logit && q < e)) ? 1 : 0; }
            int se[4]; float sv[4];
#pragma unroll
            for (int k = 0; k < 4; ++k) { const unsigned long long mk = __ballot(rank == k && lane < 32); const int src = __builtin_ctzll(mk);
                se[k] = src; sv[k] = __builtin_bit_cast(float, __builtin_amdgcn_readlane(__builtin_bit_cast(int, logit), src)); }
            const float e1 = __expf(sv[1] - sv[0]), e2 = __expf(sv[2] - sv[0]), e3 = __expf(sv[3] - sv[0]), inv = 1.f / (1.f + e1 + e2 + e3);
            const float wk[4] = {inv, e1 * inv, e2 * inv, e3 * inv};
            if (lane == 0) {
#pragma unroll
                for (int k = 0; k < 4; ++k) { const int lr = __hip_atomic_fetch_add(hist + se[k], 1, __ATOMIC_RELAXED, __HIP_MEMORY_SCOPE_WORKGROUP);
                    tok_e[t * 4 + k] = se[k]; tok_lr[t * 4 + k] = lr; tok_w[t * 4 + k] = wk[k]; } } }
    }
    __syncthreads();
    if (tid < 32) blk_cnt[blk * 32 + tid] = hist[tid];
    __syncthreads();
}
__device__ __forceinline__ void phase_dispatch(LAS unsigned char* lds, const int* __restrict__ blk_cnt, const int* __restrict__ tok_e, const int* __restrict__ tok_lr, int* __restrict__ tok_row, int* __restrict__ tab,
                                               const bf16* __restrict__ xbf, bf16* __restrict__ xs, int blk, int tid, int wave, int lane) {
    LAS int* tot = (LAS int*)lds; LAS int* pre = tot + 32; LAS int* pst = pre + 32; LAS int* rows = pst + 64;
    if (tid < 32) { int s = 0, p = 0;
#pragma unroll 8
        for (int bb = 0; bb < GRID; ++bb) { const int c = blk_cnt[bb * 32 + tid]; p += (bb < blk) ? c : 0; s += c; } tot[tid] = s; pre[tid] = p; }
    __syncthreads();
    if (tid == 0) { int acc = 0; for (int e = 0; e < 32; ++e) { pst[e] = acc; acc += ((tot[e] + 255) >> 8) << 8; } pst[32] = acc; }
    __syncthreads();
    if (blk == 0 && tid < 33) tab[tid] = pst[tid] >> 8;
    constexpr int TPB = T / GRID;
    static_assert(TPB * 4 == NTHR, "one (token, k) pair per thread");
    { const size_t ti = (size_t)blk * TPB * 4 + tid; const int e = tok_e[ti]; const int r = pst[e] + pre[e] + tok_lr[ti]; tok_row[ti] = r; rows[tid] = r; }
    __syncthreads();
#pragma unroll 4
    for (int i = wave; i < TPB * 4; i += NWAVES) { const int r = rows[i];
        const v4u* src = (const v4u*)(xbf + ((size_t)blk * TPB + (i >> 2)) * D) + 2 * lane; const v4u a = src[0], b = src[1];
        v4u o; o.x = pk4_fp8(bflo(a.x), bfhi(a.x), bflo(a.y), bfhi(a.y)); o.y = pk4_fp8(bflo(a.z), bfhi(a.z), bflo(a.w), bfhi(a.w)); o.z = pk4_fp8(bflo(b.x), bfhi(b.x), bflo(b.y), bfhi(b.y)); o.w = pk4_fp8(bflo(b.z), bfhi(b.z), bflo(b.w), bfhi(b.w));
        ((v4u*)((unsigned char*)xs + (size_t)r * D))[lane] = o; }
    __syncthreads();
}
__device__ __forceinline__ f32x4 fp8x4_to_f32(unsigned w) {
    const f32x2 lo = __builtin_amdgcn_cvt_pk_f32_fp8((int)w, false), hi = __builtin_amdgcn_cvt_pk_f32_fp8((int)w, true); return (f32x4){lo.x, lo.y, hi.x, hi.y};
}
__device__ __forceinline__ void phase_ln2(const unsigned char* __restrict__ yrows, const int* __restrict__ tok_row, const float* __restrict__ tok_w, const float* __restrict__ g, const float* __restrict__ bb,
                                          float* __restrict__ xout, bf16* xbf, int gw, int ngw, int lane) {
    f32x4 gv[4], bv[4];
#pragma unroll
    for (int j = 0; j < 4; ++j) { gv[j] = ((const f32x4*)g)[lane + 64 * j]; bv[j] = ((const f32x4*)bb)[lane + 64 * j]; }
    constexpr int NTK = 2;
    static_assert(T % (NTK * GRID * NWAVES) == 0, "NTK tokens per wave per step");
    for (int t0 = gw; t0 < T; t0 += NTK * ngw) {
        f32x4 v[NTK][4];
#pragma unroll
        for (int u = 0; u < NTK; ++u) { const int t = t0 + u * ngw; int r[4]; float w[4];
#pragma unroll
            for (int k = 0; k < 4; ++k) { r[k] = tok_row[(size_t)t * 4 + k]; w[k] = tok_w[(size_t)t * 4 + k] * (1.f / 16.f); }
            const v2u* xr = (const v2u*)(xbf + (size_t)t * D) + lane;
#pragma unroll
            for (int j = 0; j < 4; ++j) { f32x4 f = {0.f, 0.f, 0.f, 0.f};
#pragma unroll
                for (int k = 0; k < 4; ++k) { const unsigned yw = ((const unsigned*)(yrows + (size_t)r[k] * D))[lane + 64 * j]; f += fp8x4_to_f32(yw) * w[k]; }
                const v2u xw = xr[64 * j]; v[u][j].x = DN_ALPHA * bflo(xw.x) + f.x; v[u][j].y = DN_ALPHA * bfhi(xw.x) + f.y; v[u][j].z = DN_ALPHA * bflo(xw.y) + f.z; v[u][j].w = DN_ALPHA * bfhi(xw.y) + f.w; } }
#pragma unroll
        for (int u = 0; u < NTK; ++u) { const int t = t0 + u * ngw;
            ln_row(v[u], gv, bv);
            if (xout) { f32x4* xo = (f32x4*)(xout + (size_t)t * D) + lane;
#pragma unroll
                for (int j = 0; j < 4; ++j) xo[64 * j] = v[u][j]; }
            else { v2u* xb = (v2u*)(xbf + (size_t)t * D) + lane;
#pragma unroll
                for (int j = 0; j < 4; ++j) { v2u ww; ww.x = pk2(v[u][j].x, v[u][j].y); ww.y = pk2(v[u][j].z, v[u][j].w); xb[64 * j] = ww; } } } }
}

struct Args { const float* in[20]; float* out; unsigned char* ws; int l_lo, l_hi, ph_lo, ph_hi; };
typedef const __attribute__((address_space(4))) Args* KArgsP;
#define KA_LOAD() ({ KArgsP p_ = (KArgsP)__builtin_amdgcn_kernarg_segment_ptr(); asm volatile("" : "+s"(p_)); p_; })
#ifndef PHMASK
#define PHMASK 0xFFFF
#endif
#ifndef REPEAT_MASK
#define REPEAT_MASK 0
#endif
#ifndef REPEAT_LMASK
#define REPEAT_LMASK 0xF
#endif
#define PH_BEGIN(k) _Pragma("unroll") for (int rep_ = 0; rep_ < ((((REPEAT_MASK >> (k)) & 1) && ((REPEAT_LMASK >> l) & 1)) ? 2 : 1); ++rep_) { if ((PHMASK >> (k)) & 1) { KArgsP ka = KA_LOAD(); unsigned char* ws = ka->ws; int tid = threadIdx.x; asm volatile("" : "+v"(tid)); \
    const int lane = tid & 63, wave = __builtin_amdgcn_readfirstlane(tid >> 6); int blk = blockIdx.x; asm volatile("" : "+s"(blk)); \
    const int gw = blk * NWAVES + wave; const size_t gtid = (size_t)blk * NTHR + tid; (void)lane; (void)gw; (void)gtid; (void)ws;
#if ONE_LAUNCH
#define PH_SEAM() do { XcdBarrier b_; b_.bar = (unsigned*)(KA_LOAD()->ws + WS_CTL) + CW_BAR; b_.x = xb_xcc_id(); b_.st = (volatile LAS unsigned*)(lds + MISC_OFF); xcd_barrier(b_); } while (0)
#else
#define PH_SEAM() do {} while (0)
#endif
#define PH_END() PH_SEAM(); } }
#define PH_END_NOSEAM() } }
#define WSP(type, off) ((type*)(ws + (off)))
constexpr int G = GRID, NGW = GRID * NWAVES; constexpr size_t GTHREADS = (size_t)GRID * NTHR;
template <int L> __device__ __forceinline__ void layer_phases(LAS unsigned char* lds) {
    constexpr int l = L; LAS int* tabL = (LAS int*)(lds + MISC_OFF + 256);

        const int j = l >> 1; const bool moba = (l & 1) != 0;
        const int NC = moba ? NC_M : NC_H, qoff = moba ? 2304 : 3072;

        if (l == 0) {
        PH_BEGIN(1)
            phase_weights((LAS float*)(lds + wave * 16384), gw, NGW, lane, ka->in[2], NC_H, ka->in[6], 4, ka->in[7], ka->in[12], ka->in[14], ka->in[16], WSP(bf16, WS_WIN), WSP(bf16, WS_WKV4), WSP(bf16, WS_WO), WSP(bf16, WS_WGU), WSP(bf16, WS_WD));
        PH_END()
        }
        PH_BEGIN(2)
            { pg8::Gemm g{WSP(bf16, WS_XBF), WSP(bf16, WS_WIN), T, NC, D, 0, 0}; pg8::StaticOrder S; S.init(T, NC, G, blk); pg8::EpiPlain E{WSP(bf16, WS_H), NC, moba ? 0x207u : 0x1000u, 0.125f * 1.4426950408889634f};
              pg8::gemm_phase<pg8::EpiPlain, pg8::StaticOrder, true, true>(lds, g, S, E); }
            if (l == 0) {
              pg8::Gemm g{WSP(bf16, WS_MEMBF), WSP(bf16, WS_WKV4), 512, 2048, D, 0, 0}; pg8::StaticOrder S; S.init(512, 2048, G, blk >= 128 ? blk - 128 : G); pg8::EpiPlain E{WSP(bf16, WS_KV4), 2048, 0u, 1.f};
              pg8::gemm_phase<pg8::EpiPlain, pg8::StaticOrder, true, true>(lds, g, S, E); }
        PH_END()
        if (!moba) {
            PH_BEGIN(3)
                for (int u = blk; u < NBATCH * HG_H * HNSEG; u += G) hgrn_mfma<false>(lds, WSP(bf16, WS_H), ka->in[3], j, ka->in[4] + j * 128, WSP(float, WS_SLOC), WSP(float, WS_DSEG), WSP(bf16, WS_MIX), u, tid, wave, lane);
                for (int u = blk; u < 512; u += G) memattn_unit2(lds, WSP(bf16, WS_H), NC, qoff, WSP(bf16, WS_KV4) + 512 * l, WSP(bf16, WS_MIX), u, tid, wave, lane);
            PH_END()
            PH_BEGIN(4)
                hgrn_scan(WSP(float, WS_SLOC), WSP(float, WS_DSEG), gtid, GTHREADS);
            PH_END()
            PH_BEGIN(5)
                for (int u = blk; u < NBATCH * HG_H * HNSEG; u += G) hgrn_mfma<true>(lds, WSP(bf16, WS_H), ka->in[3], j, ka->in[4] + j * 128, WSP(float, WS_SLOC), WSP(float, WS_DSEG), WSP(bf16, WS_MIX), u, tid, wave, lane);
            PH_END()
        } else {
            PH_BEGIN(3)
                for (int u = blk; u < 24 * MB_NB; u += G) kmean_unit(lds, WSP(bf16, WS_H), WSP(float, WS_KMEAN), u, tid);
                for (int u = blk; u < 512; u += G) memattn_unit2(lds, WSP(bf16, WS_H), NC, qoff, WSP(bf16, WS_KV4) + 512 * l, WSP(bf16, WS_MIX), u, tid, wave, lane);
            PH_END()
            PH_BEGIN(4)
                for (int u = blk; u < 24 * MB_NB; u += G) moba_gate_unit(lds, WSP(bf16, WS_H), WSP(float, WS_KMEAN), WSP(unsigned, WS_CTL) + CW_GCOUNT + j * 1536, WSP(int, WS_SELINFO), WSP(unsigned, WS_LIST), u, tid);
            PH_END()
            PH_BEGIN(5)
                { unsigned* qhead = WSP(unsigned, WS_CTL) + CW_GCOUNT + 2 * 1536 + 64 * j; LAS int* itl = (LAS int*)(lds + MISC_OFF + 512);
                  for (;;) { if (tid == 0) *itl = (int)__hip_atomic_fetch_add(qhead, 1u, __ATOMIC_RELAXED, __HIP_MEMORY_SCOPE_AGENT);
                      __syncthreads(); const int it = *itl; __syncthreads();
                      if (it >= 24 * MB_NB) break;
                      moba_attn_item2(lds, WSP(bf16, WS_H), WSP(unsigned, WS_CTL) + CW_GCOUNT + j * 1536, WSP(unsigned, WS_LIST), WSP(bf16, WS_PO), WSP(float, WS_PML), it, tid, wave, lane); } }
            PH_END()
            PH_BEGIN(6)
                moba_combine(WSP(bf16, WS_PO), WSP(float, WS_PML), WSP(int, WS_SELINFO), WSP(bf16, WS_MIX), gw, NGW, lane);
            PH_END()
        }
        PH_BEGIN(7)
            pg8::Gemm g{WSP(bf16, WS_MIX), WSP(bf16, WS_WO), T, D, D, 0, 0}; pg8::StaticOrder S; S.init(T, D, G, blk); pg8::EpiPlain E{WSP(bf16, WS_Y), D, 0u, 1.f};
            pg8::gemm_phase<pg8::EpiPlain, pg8::StaticOrder, true, true>(lds, g, S, E);
        PH_END()
        PH_BEGIN(8)
            phase_ln1(lds, WSP(bf16, WS_Y), ka->in[8] + l * D, ka->in[9] + l * D, WSP(bf16, WS_WRS) + (size_t)l * 2 * NE * D, ka->in[11] + l * NE, WSP(bf16, WS_XBF),
                      WSP(int, WS_TOK + TOK_E), WSP(int, WS_TOK + TOK_LR), WSP(float, WS_TOK + TOK_W), WSP(int, WS_TOK + TOK_BLKCNT), blk, tid, wave, lane);
        PH_END()
        PH_BEGIN(9)
            phase_dispatch(lds, WSP(int, WS_TOK + TOK_BLKCNT), WSP(int, WS_TOK + TOK_E), WSP(int, WS_TOK + TOK_LR), WSP(int, WS_TOK + TOK_ROW), WSP(int, WS_TOK + TOK_TAB), WSP(bf16, WS_XBF), WSP(bf16, WS_XS), blk, tid, wave, lane);
        PH_END()
        PH_BEGIN(10)
            if (tid < 33) tabL[tid] = WSP(int, WS_TOK + TOK_TAB)[tid];
            __syncthreads();
            int sw_ = 0x7A7A7A7A, sx_ = 0x7F7F7F7F; asm volatile("" : "+s"(sw_), "+s"(sx_));
            pg8::Gemm g{WSP(bf16, WS_XS), WSP(bf16, WS_WGU), MOE_MAXROWS, NE * 2048, D / 2, sw_, sx_}; pg8::MoeOrder S{tabL, 8, G, blk, tabL[32] * 8};
            pg8::EpiSwiglu E{WSP(unsigned char, WS_HID), ka->in[13] + (size_t)l * NE * 1024, ka->in[15] + (size_t)l * NE * 1024};
            pg8::gemm_phase<pg8::EpiSwiglu, pg8::MoeOrder, true, true, true>(lds, g, S, E);
        PH_END()
        PH_BEGIN(11)
            if (tid < 33) tabL[tid] = WSP(int, WS_TOK + TOK_TAB)[tid];
            __syncthreads();
            int sw_ = 0x79797979, sx_ = 0x7F7F7F7F; asm volatile("" : "+s"(sw_), "+s"(sx_));
            pg8::Gemm g{WSP(bf16, WS_HID), WSP(bf16, WS_WD), MOE_MAXROWS, NE * 1024, D / 2, sw_, sx_}; pg8::MoeOrder S{tabL, 4, G, blk, tabL[32] * 4};
            pg8::EpiDown E{WSP(unsigned char, WS_XS), ka->in[17] + (size_t)l * NE * 1024};
            pg8::gemm_phase<pg8::EpiDown, pg8::MoeOrder, true, true, true>(lds, g, S, E);
        PH_END()
        PH_BEGIN(12)
            float* x2out = (l == DEPTH - 1) ? ka->out : nullptr;
            phase_ln2(WSP(unsigned char, WS_XS), WSP(int, WS_TOK + TOK_ROW), WSP(float, WS_TOK + TOK_W), ka->in[18] + l * D, ka->in[19] + l * D, x2out, WSP(bf16, WS_XBF), gw, NGW, lane);
            if (l + 1 < DEPTH) { constexpr int ln = l + 1, jn = ln >> 1; constexpr bool mn = (ln & 1) != 0;
                const float* win_src = mn ? ka->in[5] + (size_t)jn * D * NC_M : ka->in[2] + (size_t)jn * D * NC_H; const size_t moff = (size_t)ln * NE * 1024 * 1024;
                phase_weights((LAS float*)(lds + wave * 16384), gw, NGW, lane, win_src, mn ? NC_M : NC_H, ka->in[6], 0, ka->in[7] + (size_t)ln * D * D,
                              ka->in[12] + moff, ka->in[14] + moff, ka->in[16] + moff, WSP(bf16, WS_WIN), WSP(bf16, WS_WKV4), WSP(bf16, WS_WO), WSP(bf16, WS_WGU), WSP(bf16, WS_WD)); }
            if (l + 1 < DEPTH) PH_SEAM();
        PH_END_NOSEAM()
}
__global__ void __launch_bounds__(NTHR, 2) fwd_kernel(Args args) {
    extern __shared__ __attribute__((aligned(16))) unsigned char lds_raw[];
    LAS unsigned char* lds = (LAS unsigned char*)lds_raw;
    if (threadIdx.x < 4) ((LAS unsigned*)(lds + MISC_OFF))[threadIdx.x] = 0u;
    __syncthreads();
#if ONE_LAUNCH
    (void)xcd_barrier_post((unsigned*)(args.ws + WS_CTL) + CW_BAR, (volatile LAS unsigned*)(lds + MISC_OFF));
#endif
    { const int l = 0; (void)l;
    PH_BEGIN(0)
        cvt_rows_bf16(ka->in[0], WSP(bf16, WS_XBF), (size_t)T * D / 8, gtid, GTHREADS);
        cvt_rows_bf16(ka->in[1], WSP(bf16, WS_MEMBF), (size_t)512 * D / 8, gtid, GTHREADS);
        split_router_weights(ka->in[10], WSP(bf16, WS_WRS), gtid, GTHREADS);
    PH_END_NOSEAM() }
    layer_phases<0>(lds); layer_phases<1>(lds); layer_phases<2>(lds); layer_phases<3>(lds);
}

extern "C" void kernel_launch(void* const* d_in, const int* in_sizes, int n_in, void* d_out, int out_size, void* d_ws, size_t ws_size, hipStream_t stream) {
    static int ready = 0;
    if (ready == 0) {
        if (n_in != 20 || in_sizes[0] != T * D || out_size != T * D || ws_size < WS_END) { fprintf(stderr, "kernel_launch: unexpected shapes (n_in %d, in0 %d, out %d, ws %zu < %zu)\n", n_in, n_in > 0 ? in_sizes[0] : -1, out_size, ws_size, (size_t)WS_END); ready = -1; return; }
        if (hipFuncSetAttribute((const void*)fwd_kernel, hipFuncAttributeMaxDynamicSharedMemorySize, LDS_BYTES) != hipSuccess) { fprintf(stderr, "kernel_launch: hipFuncSetAttribute failed\n"); ready = -1; return; }
        int per_cu = 0;
        if (hipOccupancyMaxActiveBlocksPerMultiprocessor(&per_cu, (const void*)fwd_kernel, NTHR, LDS_BYTES) != hipSuccess || per_cu < 1) fprintf(stderr, "kernel_launch: occupancy query says %d\n", per_cu);
        (void)hipGetLastError();
        ready = 1;
    }
    if (ready < 0) return;
    if (hipMemsetAsync((char*)d_ws + WS_CTL, 0, CTL_ZERO_BYTES, stream) != hipSuccess) return;
    Args a{};
    for (int i = 0; i < 20; ++i) a.in[i] = (const float*)d_in[i];
    a.out = (float*)d_out; a.ws = (unsigned char*)d_ws;
    a.l_lo = 0; a.l_hi = DEPTH; a.ph_lo = 0; a.ph_hi = NPHASE;
    hipLaunchKernelGGL(fwd_kernel, dim3(GRID), dim3(NTHR), LDS_BYTES, stream, a);
}
```

```cpp
#include <hip/hip_runtime.h>
#include <cstdio>
#include <cstdint>
#include <cmath>
namespace pg8 {
#define PG8_LAS __attribute__((address_space(3)))
typedef unsigned short bf16_t;
typedef short bf16x8 __attribute__((ext_vector_type(8)));
typedef float f32x4 __attribute__((ext_vector_type(4)));
typedef unsigned u32x4 __attribute__((ext_vector_type(4)));
constexpr int BM = 256, BK = 64, HALF = 128, HTB = HALF * BK * 2  , STAGE_BYTES = 8 * HTB, NXCD = 8, WGM = 8;

__host__ __device__ __forceinline__ int lds_byte(int r, int c) { const int st = (r >> 4) * 2 + (c >> 5), rr = r & 15, cc = c & 31, ob = rr * 64 + cc * 2; return st * 1024 + (ob ^ (((ob >> 9) & 1) << 5)); }
__host__ __device__ __forceinline__ void stage_rc(int b, int& R, int& C) { const int st = b / 1024, sb = b % 1024, swz = sb ^ (((sb >> 9) & 1) << 5); R = (st >> 1) * 16 + swz / 64; C = (st & 1) * 32 + (swz % 64) / 2; }
__host__ __device__ __forceinline__ int perm32(int rho) { const int n = rho >> 4, i = rho & 15; return 8 * (i >> 2) + 4 * n + (i & 3); }

struct Unit { int pm, pn; };
struct Gemm { const bf16_t* A; const bf16_t* Bt; int M, N, K; int sw, sx; };
typedef int i32x8 __attribute__((ext_vector_type(8))); typedef int i32x4 __attribute__((ext_vector_type(4)));

struct StaticOrder {
    int nM, nN, nwg, G, c;
    __host__ __device__ void init(int M, int N, int G_, int c_) { nM = M / BM; nN = N / BM; nwg = nM * nN; G = G_; c = c_; }
    __host__ __device__ bool next(int i, Unit& u) const {
        const long L = (long)i * G + c; if (L >= nwg) return false;
        int wgid = (int)L; { const int q = nwg / NXCD, r = nwg % NXCD, xcd = wgid % NXCD, off = wgid / NXCD; wgid = (xcd < r ? xcd * (q + 1) : r * (q + 1) + (xcd - r) * q) + off; }
        const int nig = WGM * nN, gid = wgid / nig, fm = gid * WGM, gsz = (nM - fm) < WGM ? (nM - fm) : WGM;
        u.pm = fm + ((wgid % nig) % gsz); u.pn = (wgid % nig) / gsz; return true;
    }
    __device__ __forceinline__ void a_ready(const Unit&) const {}
    __device__ __forceinline__ void done(const Unit&) const {}
};

__device__ __forceinline__ unsigned cvt_pk_bf16(float lo, float hi) { unsigned r; asm volatile("v_cvt_pk_bf16_f32 %0, %1, %2" : "=v"(r) : "v"(lo), "v"(hi)); return r; }
typedef float f32x2 __attribute__((ext_vector_type(2)));
struct EpiPlain {
    static constexpr bool PERM = true, AFTER_DRAIN = false;
    bf16_t* O; int ldc; unsigned smask; float sc;
    __device__ __forceinline__ void operator()(const f32x4 (&acc)[2][2][4][2], const Unit& u, int wr, int wc, int fr, int fq) const {
        const int row0 = u.pm * BM + wr * 64 + fr; const int col0 = u.pn * BM + wc * 32 + 8 * fq; const float s = ((smask >> u.pn) & 1u) ? sc : 1.f;
#pragma unroll
        for (int ai = 0; ai < 2; ++ai)
#pragma unroll
            for (int m = 0; m < 4; ++m) { bf16_t* rowp = O + (size_t)(row0 + ai * HALF + m * 16) * ldc + col0;
#pragma unroll
                for (int bj = 0; bj < 2; ++bj) { const f32x4 v0 = acc[ai][bj][m][0] * s, v1 = acc[ai][bj][m][1] * s;
                    u32x4 w; w.x = cvt_pk_bf16(v0[0], v0[1]); w.y = cvt_pk_bf16(v0[2], v0[3]); w.z = cvt_pk_bf16(v1[0], v1[1]); w.w = cvt_pk_bf16(v1[2], v1[3]);
                    *(u32x4*)(rowp + bj * HALF) = w; } }
    }
};
__device__ __forceinline__ float swiglu1(float g, float u) {
    g = fminf(g, 7.0f); u = fminf(fmaxf(u, -7.0f), 7.0f);
    const float s = __builtin_amdgcn_rcpf(1.0f + __builtin_amdgcn_exp2f(g * (-1.702f * 1.4426950408889634f)));
    return g * s * (u + 1.0f);
}
__device__ __forceinline__ unsigned pk4_fp8e(float a, float b, float c, float d) { int w = 0; w = __builtin_amdgcn_cvt_pk_fp8_f32(a, b, w, false); w = __builtin_amdgcn_cvt_pk_fp8_f32(c, d, w, true); return (unsigned)w; }
struct EpiSwiglu {
    static constexpr bool PERM = true, AFTER_DRAIN = false;
    unsigned char* hid; const float* bg; const float* bu;
    __device__ __forceinline__ void operator()(const f32x4 (&acc)[2][2][4][2], const Unit& u, int wr, int wc, int fr, int fq) const {
        const int e = u.pn >> 3, pn = u.pn & 7;
        const int row0 = u.pm * BM + wr * 64 + fr; const int col0 = pn * 128 + wc * 32 + 8 * fq;
        const f32x4 g0 = *(const f32x4*)(bg + e * 1024 + col0), g1 = *(const f32x4*)(bg + e * 1024 + col0 + 4);
        const f32x4 u0 = *(const f32x4*)(bu + e * 1024 + col0), u1 = *(const f32x4*)(bu + e * 1024 + col0 + 4);
#pragma unroll
        for (int ai = 0; ai < 2; ++ai)
#pragma unroll
            for (int m = 0; m < 4; ++m) { unsigned char* rowp = hid + (size_t)(row0 + ai * HALF + m * 16) * 1024 + col0;
                const f32x4 ga = acc[ai][0][m][0] + g0, gb = acc[ai][0][m][1] + g1, ua = acc[ai][1][m][0] + u0, ub = acc[ai][1][m][1] + u1;
                typedef unsigned u32x2 __attribute__((ext_vector_type(2))); u32x2 w;
                w.x = pk4_fp8e(swiglu1(ga[0], ua[0]), swiglu1(ga[1], ua[1]), swiglu1(ga[2], ua[2]), swiglu1(ga[3], ua[3]));
                w.y = pk4_fp8e(swiglu1(gb[0], ub[0]), swiglu1(gb[1], ub[1]), swiglu1(gb[2], ub[2]), swiglu1(gb[3], ub[3]));
                *(u32x2*)rowp = w; }
    }
};
struct EpiDown {
    static constexpr bool PERM = true, AFTER_DRAIN = false;
    unsigned char* y; const float* bd;
    __device__ __forceinline__ void operator()(const f32x4 (&acc)[2][2][4][2], const Unit& u, int wr, int wc, int fr, int fq) const {
        const int e = u.pn >> 2, pn = u.pn & 3;
        const int row0 = u.pm * BM + wr * 64 + fr; const int col0 = pn * BM + wc * 32 + 8 * fq;
        f32x4 bv[2][2];
#pragma unroll
        for (int bj = 0; bj < 2; ++bj)
#pragma unroll
            for (int n = 0; n < 2; ++n) bv[bj][n] = *(const f32x4*)(bd + e * 1024 + col0 + bj * HALF + 4 * n);
#pragma unroll
        for (int ai = 0; ai < 2; ++ai)
#pragma unroll
            for (int m = 0; m < 4; ++m) { unsigned char* rowp = y + (size_t)(row0 + ai * HALF + m * 16) * 1024 + col0;
#pragma unroll
                for (int bj = 0; bj < 2; ++bj) { const f32x4 v0 = (acc[ai][bj][m][0] + bv[bj][0]) * 16.f, v1 = (acc[ai][bj][m][1] + bv[bj][1]) * 16.f;
                    typedef unsigned u32x2 __attribute__((ext_vector_type(2))); u32x2 w; w.x = pk4_fp8e(v0[0], v0[1], v0[2], v0[3]); w.y = pk4_fp8e(v1[0], v1[1], v1[2], v1[3]);
                    *(u32x2*)(rowp + bj * HALF) = w; } }
    }
};
struct MoeOrder {
    const PG8_LAS int* tab; int npn, G, c, nunits;
    __device__ __forceinline__ bool next(int i, Unit& u) const {
        const int tpx = 32 / npn, s = c >> 3, tile = (i * 8 + (c & 7)) * tpx + s / npn, pn = s % npn;
        if ((i * 8) * tpx >= nunits / npn) return false;
        if (tile >= nunits / npn) { u.pm = 0; u.pn = 0; return false; }
        int e = 0;
#pragma unroll
        for (int k = 1; k < 32; ++k) e += (tab[k] <= tile) ? 1 : 0;
        u.pm = tile; u.pn = __builtin_amdgcn_readfirstlane(e) * npn + pn; return true;
    }
    __device__ __forceinline__ void a_ready(const Unit&) const {}
    __device__ __forceinline__ void done(const Unit&) const {}
};
template <class Epi, class Sched, bool ALIGN_EPI = false, bool SP2 = false, bool F8 = false>
__device__ __forceinline__ void gemm_phase(PG8_LAS unsigned char* lds, const Gemm g, const Sched& S, const Epi& E) {
    int tid_ = threadIdx.x; asm volatile("" : "+v"(tid_));
    const int tid = tid_, wid = __builtin_amdgcn_readfirstlane(tid >> 6), lane = tid & 63, wr = wid >> 2, wc = wid & 3, fr = lane & 15, fq = lane >> 4;
    const int K = g.K, nt = K / BK;
    unsigned voffA, voffB;
    { int R, C; stage_rc(tid * 16, R, C); const int Rb = Epi::PERM ? ((R & ~31) + perm32(R & 31)) : R; voffA = (unsigned)(R * K + C) * 2u; voffB = (unsigned)(Rb * K + C) * 2u; }
    const unsigned qstep = 64u * (unsigned)K * 2u;
    const unsigned kstep = (unsigned)(BK * 2);
    const unsigned hstep = (unsigned)HALF * (unsigned)K * 2u;
    const unsigned tstep = 2u * hstep;
    const __amdgpu_buffer_rsrc_t rA = __builtin_amdgcn_make_buffer_rsrc((void*)g.A, 0, 0x7FFFFFFF, 0x00020000), rB = __builtin_amdgcn_make_buffer_rsrc((void*)g.Bt, 0, 0x7FFFFFFF, 0x00020000);
    const unsigned ldsw = (unsigned)wid * 1024u;
    const int aoff = lds_byte(wr * 64 + fr, fq * 8), boff = lds_byte(wc * 32 + fr, fq * 8);
#define PG8_SA(b, h) (((b) * 2 + (h)) * HTB)
#define PG8_SB(b, h) ((4 + (b) * 2 + (h)) * HTB)
#define PG8_STG(bufoff, rsrc, soff, voff) do { _Pragma("unroll") for (int _i = 0; _i < 2; ++_i) \
        __builtin_amdgcn_raw_ptr_buffer_load_lds((rsrc), (PG8_LAS void*)(lds + (bufoff) + ldsw + _i * 8192), 16, (int)(voff), (int)((soff) + (unsigned)_i * qstep), 0, 0); } while (0)
#define PG8_STGA(bufoff, soff) PG8_STG(bufoff, rA, soff, voffA)
#define PG8_STGB(bufoff, soff) PG8_STG(bufoff, rB, soff, voffB)
#define PG8_LDA(dst, b, h) do { _Pragma("unroll") for (int m = 0; m < 4; ++m) { if constexpr (F8) { const i32x4 lo_ = *(const PG8_LAS i32x4*)(lds + PG8_SA(b, h) + aoff + m * 2048), hi_ = *(const PG8_LAS i32x4*)(lds + PG8_SA(b, h) + aoff + m * 2048 + 1024); \
            dst##_8[m] = __builtin_shufflevector(lo_, hi_, 0, 1, 2, 3, 4, 5, 6, 7); } else { _Pragma("unroll") for (int k = 0; k < 2; ++k) dst[m][k] = *(const PG8_LAS bf16x8*)(lds + PG8_SA(b, h) + aoff + m * 2048 + k * 1024); } } } while (0)
#define PG8_LDB(dst, b, h) do { _Pragma("unroll") for (int n = 0; n < 2; ++n) { if constexpr (F8) { const i32x4 lo_ = *(const PG8_LAS i32x4*)(lds + PG8_SB(b, h) + boff + n * 2048), hi_ = *(const PG8_LAS i32x4*)(lds + PG8_SB(b, h) + boff + n * 2048 + 1024); \
            dst##_8[n] = __builtin_shufflevector(lo_, hi_, 0, 1, 2, 3, 4, 5, 6, 7); } else { _Pragma("unroll") for (int k = 0; k < 2; ++k) dst[n][k] = *(const PG8_LAS bf16x8*)(lds + PG8_SB(b, h) + boff + n * 2048 + k * 1024); } } } while (0)
#define PG8_MMA(ai, bj, At, Bt) do { __builtin_amdgcn_s_setprio(1); _Pragma("unroll") for (int m = 0; m < 4; ++m) _Pragma("unroll") for (int n = 0; n < 2; ++n) { \
        if constexpr (F8) acc[ai][bj][m][n] = __builtin_amdgcn_mfma_scale_f32_16x16x128_f8f6f4(Bt##_8[n], At##_8[m], acc[ai][bj][m][n], 0, 0, 0, g.sw, 0, g.sx); \
        else { _Pragma("unroll") for (int k = 0; k < 2; ++k) acc[ai][bj][m][n] = __builtin_amdgcn_mfma_f32_16x16x32_bf16(Bt[n][k], At[m][k], acc[ai][bj][m][n], 0, 0, 0); } } \
        __builtin_amdgcn_s_setprio(0); } while (0)
#define PG8_WAIT_V(n) asm volatile("s_waitcnt vmcnt(" #n ")" ::: "memory")
#define PG8_WAIT_L(n) asm volatile("s_waitcnt lgkmcnt(" #n ")" ::: "memory")
#define PG8_BAR __builtin_amdgcn_s_barrier()
#define PG8_SCHED __builtin_amdgcn_sched_barrier(0)
    Unit cur, nxt; int ui = 0;
    if (!S.next(0, cur)) return;
    f32x4 acc[2][2][4][2];
#pragma unroll
    for (int a = 0; a < 2; ++a)
#pragma unroll
        for (int b = 0; b < 2; ++b)
#pragma unroll
            for (int m = 0; m < 4; ++m)
#pragma unroll
                for (int n = 0; n < 2; ++n) acc[a][b][m][n] = (f32x4){0.f, 0.f, 0.f, 0.f};
    bf16x8 At[4][2], B0[2][2], B1[2][2]; i32x8 At_8[4], B0_8[2], B1_8[2];
    unsigned cA = (unsigned)cur.pm * tstep, cB = (unsigned)cur.pn * tstep;
    S.a_ready(cur);
    if constexpr (SP2) {
        PG8_STGB(PG8_SB(0, 0), cB); PG8_STGB(PG8_SB(0, 1), cB + hstep); PG8_STGA(PG8_SA(0, 0), cA); PG8_STGA(PG8_SA(0, 1), cA + hstep);
        if (wr == 1) PG8_BAR;
        PG8_WAIT_V(2); PG8_BAR;
        PG8_STGB(PG8_SB(1, 0), cB + kstep); PG8_STGA(PG8_SA(1, 0), cA + kstep); PG8_STGB(PG8_SB(1, 1), cB + hstep + kstep);
        PG8_WAIT_V(6); PG8_BAR;
    } else {
        PG8_STGB(PG8_SB(0, 0), cB); PG8_STGA(PG8_SA(0, 0), cA); PG8_STGB(PG8_SB(0, 1), cB + hstep); PG8_STGA(PG8_SA(0, 1), cA + hstep);
        if (wr == 1) PG8_BAR;
        PG8_WAIT_V(4); PG8_BAR;
        PG8_STGB(PG8_SB(1, 0), cB + kstep); PG8_STGA(PG8_SA(1, 0), cA + kstep); PG8_STGB(PG8_SB(1, 1), cB + hstep + kstep);
        PG8_WAIT_V(6); PG8_BAR;
    }
    for (;;) {
        const bool has_next = S.next(ui + 1, nxt);
        const unsigned nA = has_next ? (unsigned)nxt.pm * tstep : cA, nB = has_next ? (unsigned)nxt.pn * tstep : cB;
#pragma unroll 1
        for (int t = 0; t < nt; t += 2) {
            const bool last = (t == nt - 2);
            const unsigned a1 = cA + (unsigned)(t + 1) * kstep;
            const unsigned a2 = last ? nA : cA + (unsigned)(t + 2) * kstep, b2 = last ? nB : cB + (unsigned)(t + 2) * kstep;
            const unsigned a3 = a2 + kstep, b3 = b2 + kstep;
            if (last && has_next) S.a_ready(nxt);
            if constexpr (SP2) {
            PG8_LDB(B0, 0, 0); PG8_LDB(B1, 0, 1); PG8_SCHED; PG8_LDA(At, 0, 0); PG8_STGA(PG8_SA(1, 1), a1 + hstep);
            PG8_WAIT_V(8); PG8_WAIT_L(0); PG8_BAR; PG8_MMA(0, 0, At, B0); PG8_MMA(0, 1, At, B1); PG8_BAR; PG8_SCHED;
            PG8_LDA(At, 0, 1); PG8_STGB(PG8_SB(0, 0), b2); PG8_STGB(PG8_SB(0, 1), b2 + hstep); PG8_STGA(PG8_SA(0, 0), a2);
            PG8_WAIT_V(8); PG8_WAIT_L(0); PG8_BAR; PG8_MMA(1, 0, At, B0); PG8_MMA(1, 1, At, B1); PG8_BAR; PG8_SCHED;
            PG8_LDB(B0, 1, 0); PG8_LDB(B1, 1, 1); PG8_SCHED; PG8_LDA(At, 1, 0); PG8_STGA(PG8_SA(0, 1), a2 + hstep);
            PG8_WAIT_V(8); PG8_WAIT_L(0); PG8_BAR; PG8_MMA(0, 0, At, B0); PG8_MMA(0, 1, At, B1); PG8_BAR; PG8_SCHED;
            PG8_LDA(At, 1, 1); PG8_STGB(PG8_SB(1, 0), b3); PG8_STGB(PG8_SB(1, 1), b3 + hstep); PG8_STGA(PG8_SA(1, 0), a3);
            PG8_WAIT_V(8); PG8_WAIT_L(0); PG8_BAR; PG8_MMA(1, 0, At, B0); PG8_MMA(1, 1, At, B1); PG8_BAR; PG8_SCHED;
            } else {
            PG8_LDB(B0, 0, 0); PG8_SCHED; PG8_LDA(At, 0, 0); PG8_STGA(PG8_SA(1, 1), a1 + hstep);
            PG8_WAIT_L(8); PG8_BAR; PG8_WAIT_L(0); PG8_MMA(0, 0, At, B0); PG8_BAR; PG8_SCHED;
            PG8_LDB(B1, 0, 1); PG8_STGB(PG8_SB(0, 0), b2);
            PG8_BAR; PG8_WAIT_L(0); PG8_MMA(0, 1, At, B1); PG8_BAR;
            PG8_LDA(At, 0, 1); PG8_STGA(PG8_SA(0, 0), a2);
            PG8_BAR; PG8_WAIT_L(0); PG8_MMA(1, 0, At, B0); PG8_BAR; PG8_SCHED;
            PG8_STGB(PG8_SB(0, 1), b2 + hstep);
            PG8_WAIT_V(6); PG8_BAR; PG8_MMA(1, 1, At, B1); PG8_BAR;
            PG8_LDB(B0, 1, 0); PG8_SCHED; PG8_LDA(At, 1, 0); PG8_STGA(PG8_SA(0, 1), a2 + hstep);
            PG8_WAIT_L(8); PG8_BAR; PG8_WAIT_L(0); PG8_MMA(0, 0, At, B0); PG8_BAR; PG8_SCHED;
            PG8_LDB(B1, 1, 1); PG8_STGB(PG8_SB(1, 0), b3);
            PG8_BAR; PG8_WAIT_L(0); PG8_MMA(0, 1, At, B1); PG8_BAR;
            PG8_LDA(At, 1, 1); PG8_STGA(PG8_SA(1, 0), a3);
            PG8_BAR; PG8_WAIT_L(0); PG8_MMA(1, 0, At, B0); PG8_BAR; PG8_SCHED;
            PG8_STGB(PG8_SB(1, 1), b3 + hstep);
            PG8_WAIT_V(6); PG8_BAR; PG8_MMA(1, 1, At, B1); PG8_BAR;
            }
        }
        if constexpr (ALIGN_EPI) { if (wr == 0) PG8_BAR; }
        if constexpr (!Epi::AFTER_DRAIN) { int t2_ = threadIdx.x; asm volatile("" : "+v"(t2_)); E(acc, cur, wr, wc, t2_ & 15, (t2_ & 63) >> 4); S.done(cur); }
        if (!has_next) break;
#pragma unroll
        for (int a = 0; a < 2; ++a)
#pragma unroll
            for (int b = 0; b < 2; ++b)
#pragma unroll
                for (int m = 0; m < 4; ++m)
#pragma unroll
                    for (int n = 0; n < 2; ++n) acc[a][b][m][n] = (f32x4){0.f, 0.f, 0.f, 0.f};
        cur = nxt; cA = nA; cB = nB; ++ui;
        if constexpr (ALIGN_EPI) { if (wr == 1) PG8_BAR; }
    }
    PG8_WAIT_V(0);
    if constexpr (!ALIGN_EPI) { if (wr == 0) PG8_BAR; }
    PG8_BAR;
    if constexpr (Epi::AFTER_DRAIN) { E.fused(acc, cur, wr, wc, fr, fq, lds, wid, lane); S.done(cur); }
#undef PG8_SA
#undef PG8_SB
#undef PG8_STG
#undef PG8_STGA
#undef PG8_STGB
#undef PG8_LDA
#undef PG8_LDB
#undef PG8_MMA
#undef PG8_WAIT_V
#undef PG8_WAIT_L
#undef PG8_BAR
#undef PG8_SCHED
}
}

constexpr int NWAVES = 8, NTHR = 512, GRID = 256;
constexpr int NBATCH = 2, SEQ = 16384, T = NBATCH * SEQ, D = 1024, DEPTH = 4;
constexpr int MIXW = 768, NC_H = 3328, NC_M = 2560;
constexpr int HG_H = 6;
constexpr int HSEG = 256, HNSEG = SEQ / HSEG;
constexpr int MB_H = 12, MB_NB = 64;
constexpr int NE = 32;
constexpr float DN_ALPHA = 1.6817928305074290f;
constexpr int MOE_MAXROWS = T * 4 + NE * 256;
#ifndef ONE_LAUNCH
#define ONE_LAUNCH 1
#endif
constexpr int NPHASE = 13;

constexpr size_t MiB = 1u << 20;
constexpr size_t WS_CTL = 0, CTL_ZERO_BYTES = 1 * MiB;
constexpr size_t WS_WIN = 1 * MiB, WS_WKV = 9 * MiB, WS_WO = 10 * MiB, WS_WGU = 12 * MiB, WS_WD = 140 * MiB;
constexpr size_t WS_XBF = 204 * MiB, WS_WKV4 = 268 * MiB  , WS_KV4 = 272 * MiB  , WS_WRS = 280 * MiB  , WS_MEMBF = 524 * MiB;
constexpr size_t WS_H = 526 * MiB, WS_MIX = 734 * MiB, WS_Y = 798 * MiB, WS_SLOC = 862 * MiB, WS_DSEG = 910 * MiB, WS_KMEAN = 911 * MiB;
constexpr size_t WS_SELINFO = 912 * MiB, WS_TOK = 914 * MiB, WS_R1 = 918 * MiB;
constexpr size_t WS_LIST = WS_R1, WS_PML = WS_R1 + 96 * MiB, WS_PO = WS_R1 + 108 * MiB;
constexpr size_t WS_XS = WS_R1, WS_HID = WS_R1 + 272 * MiB;
constexpr size_t WS_END = WS_R1 + 544 * MiB;
static_assert((size_t)MOE_MAXROWS * 1024 * 2 <= 272 * MiB, "moe rows");
static_assert((size_t)T * MB_H * 4 * 64 * 4 <= 384 * MiB && (size_t)24 * 64 * 16384 * 4 <= 96 * MiB, "moba bufs");
constexpr size_t TOK_E = 0, TOK_LR = 512 * 1024, TOK_W = 1024 * 1024, TOK_ROW = 1536 * 1024, TOK_BLKCNT = 2048 * 1024, TOK_TAB = 2048 * 1024 + 65536;
constexpr int CW_BAR = 4096, CW_GCOUNT = 8192;

constexpr int RING_BYTES = 131072, LDS_BYTES = 147456, MISC_OFF = LDS_BYTES - 1024;

#define GAS __attribute__((address_space(1)))
#define LAS __attribute__((address_space(3)))
typedef unsigned short bf16;
typedef unsigned v4u __attribute__((ext_vector_type(4)));
typedef unsigned v2u __attribute__((ext_vector_type(2)));
typedef float f32x4 __attribute__((ext_vector_type(4)));
typedef float f32x2 __attribute__((ext_vector_type(2)));
typedef short s16x8 __attribute__((ext_vector_type(8)));
typedef float f32x16 __attribute__((ext_vector_type(16)));
typedef float f32x2_t __attribute__((ext_vector_type(2))); typedef __bf16 bf16x2_t __attribute__((ext_vector_type(2)));
__device__ __forceinline__ unsigned cvtpk(float lo, float hi) { f32x2_t v = {lo, hi}; bf16x2_t b = __builtin_convertvector(v, bf16x2_t); return __builtin_bit_cast(unsigned, b); }
#define LDS_WAIT() asm volatile("s_waitcnt lgkmcnt(0)" ::: "memory")
__device__ __forceinline__ unsigned f2bf(float f) { unsigned u = __builtin_bit_cast(unsigned, f); return (u + 0x7fffu + ((u >> 16) & 1u)) >> 16; }
__device__ __forceinline__ unsigned pk2(float lo, float hi) { return f2bf(lo) | (f2bf(hi) << 16); }
__device__ __forceinline__ float bflo(unsigned w) { return __builtin_bit_cast(float, w << 16); }
__device__ __forceinline__ float bfhi(unsigned w) { return __builtin_bit_cast(float, w & 0xffff0000u); }
__device__ __forceinline__ float bf2f(bf16 h) { return __builtin_bit_cast(float, (unsigned)h << 16); }
__device__ __forceinline__ float sigmoidf_(float z) { return __builtin_amdgcn_rcpf(1.0f + __builtin_amdgcn_exp2f(-1.4426950408889634f * z)); }
template <int X> __device__ __forceinline__ float xorf(float v) { return __builtin_bit_cast(float, __builtin_amdgcn_ds_swizzle(__builtin_bit_cast(int, v), (X << 10) | 0x1F)); }
template <int X> __device__ __forceinline__ int xori(int v) { return __builtin_amdgcn_ds_swizzle(v, (X << 10) | 0x1F); }
__device__ __forceinline__ float wave_sum(float v) {
    v += xorf<1>(v); v += xorf<2>(v); v += xorf<4>(v); v += xorf<8>(v); v += xorf<16>(v);
    return __builtin_bit_cast(float, __builtin_amdgcn_readlane(__builtin_bit_cast(int, v), 0)) + __builtin_bit_cast(float, __builtin_amdgcn_readlane(__builtin_bit_cast(int, v), 32));
}
__device__ __forceinline__ float wave_max(float v) {
    v = fmaxf(v, xorf<1>(v)); v = fmaxf(v, xorf<2>(v)); v = fmaxf(v, xorf<4>(v)); v = fmaxf(v, xorf<8>(v)); v = fmaxf(v, xorf<16>(v));
    return fmaxf(__builtin_bit_cast(float, __builtin_amdgcn_readlane(__builtin_bit_cast(int, v), 0)), __builtin_bit_cast(float, __builtin_amdgcn_readlane(__builtin_bit_cast(int, v), 32)));
}
__device__ __forceinline__ float xor32f(float v, int lane) { return __builtin_bit_cast(float, __builtin_amdgcn_ds_bpermute((lane ^ 32) << 2, __builtin_bit_cast(int, v))); }
#define XB_TMO      128
#define XB_XCNT(j)  (256  + 64 * (j))
#define XB_XSUB(j)  (1280 + 64 * (j))
#define XB_XGEN(j)  (2304 + 64 * (j))
#define XB_TOP      3328
#define XB_TOPGEN   3392
#define XCD_BAR_WORDS 3456
#define XB_SPIN_CAP (1u << 18)

__device__ __forceinline__ unsigned xb_ld(unsigned* p)              { return __hip_atomic_load(p, __ATOMIC_RELAXED, __HIP_MEMORY_SCOPE_AGENT); }
__device__ __forceinline__ unsigned xb_add(unsigned* p, unsigned v) { return __hip_atomic_fetch_add(p, v, __ATOMIC_RELAXED, __HIP_MEMORY_SCOPE_AGENT); }
__device__ __forceinline__ unsigned xb_xcc_id() { return (unsigned)__builtin_amdgcn_s_getreg((3 << 11) | 20) & 0xFu; }
#define XB_SPIN(cond, bar) do { unsigned _sp = 0; while (cond) { __builtin_amdgcn_s_sleep(1); \
    if ((++_sp & 255u) == 0u) { if (xb_ld(&(bar)[XB_TMO])) break; if (_sp > XB_SPIN_CAP) { atomicAdd(&(bar)[XB_TMO], 1u); break; } } } } while (0)

struct XcdBarrier {
    unsigned* bar; unsigned x;
    volatile LAS unsigned* st;
};

__device__ __forceinline__ XcdBarrier xcd_barrier_post(unsigned* bar, volatile LAS unsigned* st) {
    XcdBarrier b; b.bar = bar; b.x = xb_xcc_id(); b.st = st;
    if (threadIdx.x == 0) (void)xb_add(&bar[XB_XCNT(b.x)], 1u);
    return b;
}
__device__ __forceinline__ void xcd_barrier_complete(unsigned* bar, unsigned x, unsigned& nloc, unsigned& nx) {
    const unsigned G = gridDim.x * gridDim.y * gridDim.z;
    unsigned sum, cnt, mine, sp = 0u;
    for (;;) {
        sum = 0u; cnt = 0u; mine = 0u;
#pragma unroll
        for (unsigned j = 0; j < 16; ++j) { const unsigned c = xb_ld(&bar[XB_XCNT(j)]); sum += c; cnt += (c > 0u) ? 1u : 0u; mine = (j == x) ? c : mine; }
        if (sum == G) break;
        __builtin_amdgcn_s_sleep(1);
        if ((++sp & 255u) == 0u) { if (xb_ld(&bar[XB_TMO])) break; if (sp > XB_SPIN_CAP) { atomicAdd(&bar[XB_TMO], 1u); break; } }
    }
    nloc = mine > 0u ? mine : 1u; nx = cnt > 0u ? cnt : 1u;
}

__device__ __forceinline__ void xcd_barrier(const XcdBarrier& b) {
    asm volatile("s_waitcnt vmcnt(0)" ::: "memory");
    __syncthreads();
    if (threadIdx.x == 0) {
        unsigned* bar = b.bar;
        __builtin_amdgcn_s_waitcnt(0);
        unsigned nloc = b.st[0], nx = b.st[1];
        if (nloc == 0u) { xcd_barrier_complete(bar, b.x, nloc, nx); b.st[0] = nloc; b.st[1] = nx; }
        const unsigned old = xb_add(&bar[XB_XSUB(b.x)], 1u);
        const unsigned gen = old / nloc;
        if (old + 1u == (gen + 1u) * nloc) {
            __builtin_amdgcn_fence(__ATOMIC_RELEASE, "agent");
            asm volatile("s_waitcnt vmcnt(0)" ::: "memory");
            const unsigned og = xb_add(&bar[XB_TOP], 1u);
            const unsigned tg = og / nx;
            if (og + 1u == (tg + 1u) * nx) xb_add(&bar[XB_TOPGEN], 1u);
            else XB_SPIN(xb_ld(&bar[XB_TOPGEN]) == tg, bar);
            __builtin_amdgcn_fence(__ATOMIC_ACQUIRE, "agent");
            xb_add(&bar[XB_XGEN(b.x)], 1u);
            asm volatile("s_waitcnt vmcnt(0)" ::: "memory");
        } else {
            XB_SPIN(xb_ld(&bar[XB_XGEN(b.x)]) == gen, bar);
            __builtin_amdgcn_fence(__ATOMIC_ACQUIRE, "agent");
            asm volatile("s_waitcnt vmcnt(0)" ::: "memory");
        }
    }
    __syncthreads();
}

__device__ __forceinline__ void cvt_rows_bf16(const float* src, bf16* dst, size_t n8, size_t gtid, size_t gthreads) {
    for (size_t i = gtid; i < n8; i += gthreads) { const f32x4 a = ((const f32x4*)src)[2 * i], b = ((const f32x4*)src)[2 * i + 1];
        v4u o; o.x = pk2(a.x, a.y); o.y = pk2(a.z, a.w); o.z = pk2(b.x, b.y); o.w = pk2(b.z, b.w); ((v4u*)dst)[i] = o; }
}
__device__ __forceinline__ void transpose_item(const float* W, int N, bf16* WT, int dst_row0, LAS float* scr, int k0, int n0, int lane) {
#pragma unroll 8
    for (int i = 0; i < 32; ++i) { const int kk = 2 * i + (lane >> 5); scr[kk * 33 + (lane & 31)] = W[(size_t)(k0 + kk) * N + n0 + (lane & 31)]; }
    LDS_WAIT(); asm volatile("" ::: "memory");
    const int c = lane & 7;
#pragma unroll
    for (int j = 0; j < 4; ++j) { const int n = (lane >> 3) + 8 * j; const LAS float* s = scr + (8 * c) * 33 + n;
        v4u o; o.x = pk2(s[0 * 33], s[1 * 33]); o.y = pk2(s[2 * 33], s[3 * 33]); o.z = pk2(s[4 * 33], s[5 * 33]); o.w = pk2(s[6 * 33], s[7 * 33]);
        *(v4u*)(WT + (size_t)(dst_row0 + n) * 1024 + k0 + 8 * c) = o; }
    LDS_WAIT(); asm volatile("" ::: "memory");
}
__device__ __forceinline__ unsigned pk4_fp8(float a, float b, float c, float d) { int w = 0; w = __builtin_amdgcn_cvt_pk_fp8_f32(a, b, w, false); w = __builtin_amdgcn_cvt_pk_fp8_f32(c, d, w, true); return (unsigned)w; }
__device__ __forceinline__ void transpose_item_f8(const float* W, int N, unsigned char* WT8, int dst_row0, LAS float* scr, int k0, int n0, int lane, float wscale) {
#pragma unroll 8
    for (int i = 0; i < 32; ++i) { const int kk = 2 * i + (lane >> 5); scr[kk * 33 + (lane & 31)] = W[(size_t)(k0 + kk) * N + n0 + (lane & 31)]; }
    LDS_WAIT(); asm volatile("" ::: "memory");
    const int c = lane & 7;
#pragma unroll
    for (int j = 0; j < 4; ++j) { const int n = (lane >> 3) + 8 * j; const LAS float* s = scr + (8 * c) * 33 + n;
        v2u o; o.x = pk4_fp8(s[0 * 33] * wscale, s[1 * 33] * wscale, s[2 * 33] * wscale, s[3 * 33] * wscale); o.y = pk4_fp8(s[4 * 33] * wscale, s[5 * 33] * wscale, s[6 * 33] * wscale, s[7 * 33] * wscale);
        *(v2u*)(WT8 + (size_t)(dst_row0 + n) * 1024 + k0 + 8 * c) = o; }
    LDS_WAIT(); asm volatile("" ::: "memory");
}
__device__ __forceinline__ void phase_weights(LAS float* scr, int gw, int ngw, int lane, const float* win_src, int NC, const float* wkv_src, int nkv, const float* wo_src,
                                              const float* wg_src, const float* wu_src, const float* wd_src, bf16* win_t, bf16* wkv_t, bf16* wo_t, bf16* wgu_t, bf16* wd_t) {
    const int nbw = NC / 32, nWin = nbw * 16, NIT = nWin + 256 * nkv + 512 + NE * 1536;
    for (int it = gw; it < NIT; it += ngw) {
        int r = it;
        if (r < nWin) { const int kb = r / nbw, nb = r - kb * nbw; transpose_item(win_src, NC, win_t, 32 * nb, scr, 64 * kb, 32 * nb, lane); continue; } r -= nWin;
        if (r < 256 * nkv) { const int lay = r >> 8, rr = r & 255, kb = rr >> 4, nb = rr & 15; transpose_item(wkv_src + (size_t)lay * D * 512, 512, wkv_t + (size_t)lay * 512 * 1024, 32 * nb, scr, 64 * kb, 32 * nb, lane); continue; } r -= 256 * nkv;
        if (r < 512) { const int kb = r >> 5, nb = r & 31; transpose_item(wo_src, 1024, wo_t, 32 * nb, scr, 64 * kb, 32 * nb, lane); continue; } r -= 512;
        const int e = r / 1536, q = r - e * 1536, which = q >> 9, rr = q & 511, kb = rr >> 5, nb = rr & 31, n0 = 32 * nb;
        const size_t eoff = (size_t)e * 1024 * 1024;
        if (which == 0) transpose_item_f8(wg_src + eoff, 1024, (unsigned char*)wgu_t + 2 * eoff, (n0 >> 7) * 256 + (n0 & 127), scr, 64 * kb, n0, lane, 32.f);
        else if (which == 1) transpose_item_f8(wu_src + eoff, 1024, (unsigned char*)wgu_t + 2 * eoff, (n0 >> 7) * 256 + 128 + (n0 & 127), scr, 64 * kb, n0, lane, 32.f);
        else transpose_item_f8(wd_src + eoff, 1024, (unsigned char*)wd_t + eoff, n0, scr, 64 * kb, n0, lane, 64.f);
    }
}

template <bool OUT>
__device__ __forceinline__ void hgrn_seg(LAS unsigned char* lds, const bf16* h, const float* lbl, int j, const float* normg, float* Sloc, float* Dseg, bf16* mix, int unit, int tid, int wave, int lane) {
    const int seg = unit & (HNSEG - 1), bh = unit >> 6, hh = bh % HG_H, b = bh / HG_H;
    const int v = tid & 127, dg = tid >> 7;
    LAS float* fgs = (LAS float*)lds; LAS float* vs = fgs + 4096; LAS float* qs = vs + 4096; LAS float* op = qs + 4096;
    f32x2 st[16];
    float* Sp = Sloc + (size_t)unit * 16384 + (size_t)(dg * 32) * 128 + v;
#pragma unroll
    for (int dd = 0; dd < 16; ++dd) { st[dd].x = OUT ? Sp[(2 * dd) * 128] : 0.f; st[dd].y = OUT ? Sp[(2 * dd + 1) * 128] : 0.f; }
    float dprod = 1.f;
    const int stok = tid >> 4, c8 = (tid & 15) * 8;
    float lb[8];
#pragma unroll
    for (int i = 0; i < 8; ++i) { lb[i] = 0.f; if (j > 0) { const float a0 = lbl[hh * 128 + c8 + i], a1 = lbl[MIXW + hh * 128 + c8 + i]; lb[i] = 1.f / (1.f + __expf(a0 - a1)); } }
    for (int ch = 0; ch < HSEG / 32; ++ch) {
        const size_t t0 = (size_t)b * SEQ + seg * HSEG + ch * 32;
        { const bf16* row = h + (t0 + stok) * NC_H + hh * 128 + c8;
          const v4u f8 = *(const v4u*)(row + 768), i8 = *(const v4u*)(row + 1536); v4u q8 = {0u, 0u, 0u, 0u}; if (OUT) q8 = *(const v4u*)row;
#pragma unroll
          for (int w = 0; w < 4; ++w) { const float f0 = bflo(f8[w]), f1 = bfhi(f8[w]); const int o = stok * 128 + c8 + 2 * w;
              fgs[o] = lb[2 * w] + (1.f - lb[2 * w]) * sigmoidf_(f0); fgs[o + 1] = lb[2 * w + 1] + (1.f - lb[2 * w + 1]) * sigmoidf_(f1);
              vs[o] = bflo(i8[w]); vs[o + 1] = bfhi(i8[w]);
              if (OUT) { const float q0 = bflo(q8[w]), q1 = bfhi(q8[w]); qs[o] = q0 * sigmoidf_(q0); qs[o + 1] = q1 * sigmoidf_(q1); } } }
        __syncthreads();
        if (!OUT) { if (tid < 128) { for (int tt = 0; tt < 32; ++tt) dprod *= fgs[tt * 128 + tid]; } }
        f32x4 fA[8], qA[8], fB[8], qB[8]; float vA, vB;
#define HG_LOAD(F, Q, V, tt_) do { V = vs[(tt_) * 128 + v]; _Pragma("unroll") for (int d4 = 0; d4 < 8; ++d4) { F[d4] = *(const LAS f32x4*)(fgs + (tt_) * 128 + dg * 32 + d4 * 4); \
            if (OUT) Q[d4] = *(const LAS f32x4*)(qs + (tt_) * 128 + dg * 32 + d4 * 4); } } while (0)
#define HG_STEP(F, Q, V, tt_) do { const f32x2 vv2 = {V, V}; f32x2 acc2 = {0.f, 0.f}; _Pragma("unroll") for (int d4 = 0; d4 < 8; ++d4) { \
            const f32x2 fa = {F[d4].x, F[d4].y}, fb = {F[d4].z, F[d4].w}; \
            st[2 * d4] = fa * (st[2 * d4] - vv2) + vv2; st[2 * d4 + 1] = fb * (st[2 * d4 + 1] - vv2) + vv2; \
            if (OUT) { const f32x2 qa = {Q[d4].x, Q[d4].y}, qb = {Q[d4].z, Q[d4].w}; acc2 = qa * st[2 * d4] + acc2; acc2 = qb * st[2 * d4 + 1] + acc2; } } \
            if (OUT) op[(dg * 32 + (tt_)) * 128 + v] = acc2.x + acc2.y; } while (0)
        HG_LOAD(fA, qA, vA, 0);
#pragma unroll 1
        for (int tt = 0; tt < 32; tt += 2) {
            HG_LOAD(fB, qB, vB, tt + 1);
            __builtin_amdgcn_sched_barrier(0);
            HG_STEP(fA, qA, vA, tt);
            __builtin_amdgcn_sched_barrier(0);
            if (tt + 2 < 32) HG_LOAD(fA, qA, vA, tt + 2);
            __builtin_amdgcn_sched_barrier(0);
            HG_STEP(fB, qB, vB, tt + 1);
            __builtin_amdgcn_sched_barrier(0);
        }
#undef HG_LOAD
#undef HG_STEP
        if (OUT) {
            __syncthreads();
#pragma unroll
            for (int k = 0; k < 4; ++k) { const int tt = wave + 8 * k; float o0 = 0.f, o1 = 0.f;
#pragma unroll
                for (int g = 0; g < 4; ++g) { o0 += op[(g * 32 + tt) * 128 + lane]; o1 += op[(g * 32 + tt) * 128 + lane + 64]; }
                const float ms = wave_sum(o0 * o0 + o1 * o1) * (1.f / 128.f), r = 1.f / sqrtf(ms + 1e-6f);
                const bf16* grow = h + (t0 + tt) * NC_H + 2304 + hh * 128; const float g0 = bf2f(grow[lane]), g1 = bf2f(grow[lane + 64]);
                bf16* mrow = mix + (t0 + tt) * 1024 + hh * 128;
                mrow[lane] = (bf16)f2bf(o0 * r * normg[lane] * sigmoidf_(g0)); mrow[lane + 64] = (bf16)f2bf(o1 * r * normg[lane + 64] * sigmoidf_(g1)); }
        }
        __syncthreads();
    }
    if (!OUT) {
#pragma unroll
        for (int dd = 0; dd < 16; ++dd) { Sp[(2 * dd) * 128] = st[dd].x; Sp[(2 * dd + 1) * 128] = st[dd].y; }
        if (tid < 128) Dseg[(size_t)unit * 128 + tid] = dprod;
    }
}
constexpr int HG_G = 0, HG_QT = 32768, HG_KT = 50176, HG_KE = 67584, HG_VT = 86016, HG_ST = 104448, HG_GM = 139264, HG_GE = 139776, HG_PART = 140288;
static_assert(HG_PART + 2048 <= MISC_OFF, "HGRN LDS map");
__device__ __forceinline__ int crow16(int i, int hf) { return (i & 3) + 8 * (i >> 2) + 4 * hf; }
template <bool OUT>
__device__ __forceinline__ void hgrn_mfma(LAS unsigned char* lds, const bf16* h, const float* lbl, int j, const float* normg, float* Sloc, float* Dseg, bf16* mix, int unit, int tid, int wave, int lane) {
    const int seg = unit & (HNSEG - 1), bh = unit >> 6, hh = bh % HG_H, b = bh / HG_H;
    const int r = lane & 31, hf = lane >> 5, tr = wave & 1, vq = wave >> 1;
    LAS float* G = (LAS float*)(lds + HG_G); LAS float* GM = (LAS float*)(lds + HG_GM); LAS float* GE = (LAS float*)(lds + HG_GE); LAS float* PART = (LAS float*)(lds + HG_PART);
    const int stok = tid >> 3, c16 = (tid & 7) * 16, sperm = (stok & ~15) | (stok & 3) | ((stok & 4) << 1) | ((stok & 8) >> 1);
    const int cd = tid & 127, cpart = tid >> 7;
    float lb[16];
#pragma unroll
    for (int e = 0; e < 16; ++e) { lb[e] = 0.f; if (j > 0) { const float a0 = lbl[hh * 128 + c16 + e], a1 = lbl[MIXW + hh * 128 + c16 + e]; lb[e] = 1.f / (1.f + __expf(a0 - a1)); } }
    f32x16 S[2];
    float* Sp = Sloc + (size_t)unit * 16384 + 32 * vq + r;
#pragma unroll
    for (int dd = 0; dd < 2; ++dd)
#pragma unroll
        for (int i = 0; i < 16; ++i) S[dd][i] = OUT ? Sp[(32 * (2 * tr + dd) + crow16(i, hf)) * 128] : 0.f;
    float gsum = 0.f;
    float ng16[16];
#pragma unroll
    for (int e = 0; e < 16; ++e) ng16[e] = OUT ? normg[c16 + e] : 0.f;
    v4u nf8[2], ni8[2], nq8[2] = {{0u, 0u, 0u, 0u}, {0u, 0u, 0u, 0u}}, ng8[2] = {{0u, 0u, 0u, 0u}, {0u, 0u, 0u, 0u}};
#define HG_RAWLOAD(t0_) do { const bf16* row_ = h + ((t0_) + stok) * NC_H + hh * 128 + c16; nf8[0] = *(const v4u*)(row_ + 768); nf8[1] = *(const v4u*)(row_ + 776); ni8[0] = *(const v4u*)(row_ + 1536); ni8[1] = *(const v4u*)(row_ + 1544); \
        if (OUT) { nq8[0] = *(const v4u*)row_; nq8[1] = *(const v4u*)(row_ + 8); ng8[0] = *(const v4u*)(row_ + 2304); ng8[1] = *(const v4u*)(row_ + 2312); } } while (0)
    HG_RAWLOAD((size_t)b * SEQ + seg * HSEG);
    for (int ch = 0; ch < HSEG / 64; ++ch) {
        const size_t t0 = (size_t)b * SEQ + seg * HSEG + ch * 64;
        float fg[16], qv[16]; v4u i8[2], g8[2];
        { const v4u f8[2] = {nf8[0], nf8[1]}; i8[0] = ni8[0]; i8[1] = ni8[1]; const v4u q8[2] = {nq8[0], nq8[1]}; g8[0] = ng8[0]; g8[1] = ng8[1];
#pragma unroll
          for (int w = 0; w < 8; ++w) { const unsigned fw = f8[w >> 2][w & 3]; const float f0 = bflo(fw), f1 = bfhi(fw);
              fg[2 * w] = lb[2 * w] + (1.f - lb[2 * w]) * sigmoidf_(f0); fg[2 * w + 1] = lb[2 * w + 1] + (1.f - lb[2 * w + 1]) * sigmoidf_(f1);
              if (OUT) { const unsigned qw = q8[w >> 2][w & 3]; const float q0 = bflo(qw), q1 = bfhi(qw); qv[2 * w] = q0 * sigmoidf_(q0); qv[2 * w + 1] = q1 * sigmoidf_(q1); } else { qv[2 * w] = 0.f; qv[2 * w + 1] = 0.f; } }
#pragma unroll
          for (int e4 = 0; e4 < 4; ++e4) { f32x4 lg; lg.x = __builtin_amdgcn_logf(fg[4 * e4]); lg.y = __builtin_amdgcn_logf(fg[4 * e4 + 1]); lg.z = __builtin_amdgcn_logf(fg[4 * e4 + 2]); lg.w = __builtin_amdgcn_logf(fg[4 * e4 + 3]);
              *(LAS f32x4*)(G + stok * 128 + c16 + 4 * e4) = lg; } }
        __syncthreads();
        { float run = 0.f;
#pragma unroll
          for (int k = 0; k < 16; ++k) run += G[(16 * cpart + k) * 128 + cd];
          PART[cpart * 128 + cd] = run; }
        __syncthreads();
        { float run = 0.f;
#pragma unroll
          for (int pp = 0; pp < 3; ++pp) run += (pp < cpart) ? PART[pp * 128 + cd] : 0.f;
#pragma unroll
          for (int k = 0; k < 16; ++k) { run += G[(16 * cpart + k) * 128 + cd]; G[(16 * cpart + k) * 128 + cd] = run; }
          if (cpart == 1) GM[cd] = run;
          if (cpart == 3) { GE[cd] = run; gsum += run; } }
        __syncthreads();
        if (OUT) {
#pragma unroll
            for (int dd = 0; dd < 2; ++dd)
#pragma unroll
                for (int g4 = 0; g4 < 4; ++g4) { const int dbase = 32 * (2 * tr + dd) + 8 * g4 + 4 * hf; const f32x4 gm = *(const LAS f32x4*)(GM + dbase);
                    v2u w; w.x = cvtpk(S[dd][4 * g4] * __builtin_amdgcn_exp2f(gm.x), S[dd][4 * g4 + 1] * __builtin_amdgcn_exp2f(gm.y)); w.y = cvtpk(S[dd][4 * g4 + 2] * __builtin_amdgcn_exp2f(gm.z), S[dd][4 * g4 + 3] * __builtin_amdgcn_exp2f(gm.w));
                    *(LAS v2u*)(lds + HG_ST + (32 * vq + r) * 272 + dbase * 2) = w; }
        }
        { unsigned qt[8], kt[8];
#pragma unroll
          for (int e4 = 0; e4 < 4; ++e4) { const f32x4 gv = *(const LAS f32x4*)(G + stok * 128 + c16 + 4 * e4), gm = *(const LAS f32x4*)(GM + c16 + 4 * e4), ge = *(const LAS f32x4*)(GE + c16 + 4 * e4);
              float ke[4];
#pragma unroll
              for (int e = 0; e < 4; ++e) { const float kk = 1.f - fg[4 * e4 + e]; ke[e] = kk * __builtin_amdgcn_exp2f(ge[e] - gv[e]);
                  if (OUT) { const float a = qv[4 * e4 + e] * __builtin_amdgcn_exp2f(gv[e] - gm[e]), c = kk * __builtin_amdgcn_exp2f(gm[e] - gv[e]);
                      if (e & 1) { qt[2 * e4 + (e >> 1)] |= f2bf(a) << 16; kt[2 * e4 + (e >> 1)] |= f2bf(c) << 16; } else { qt[2 * e4 + (e >> 1)] = f2bf(a); kt[2 * e4 + (e >> 1)] = f2bf(c); } } }
#pragma unroll
              for (int e = 0; e < 4; ++e) { const int col = c16 + 4 * e4 + e;
                  *(LAS bf16*)(lds + HG_KE + col * 144 + sperm * 2) = (bf16)f2bf(ke[e]);
                  const unsigned vw = i8[e4 >> 1][(2 * e4 + (e >> 1)) & 3]; *(LAS bf16*)(lds + HG_VT + col * 144 + sperm * 2) = (bf16)((e & 1) ? (vw >> 16) : (vw & 0xffffu)); } }
          if (OUT) { *(LAS v4u*)(lds + HG_QT + stok * 272 + c16 * 2) = (v4u){qt[0], qt[1], qt[2], qt[3]}; *(LAS v4u*)(lds + HG_QT + stok * 272 + c16 * 2 + 16) = (v4u){qt[4], qt[5], qt[6], qt[7]};
                     *(LAS v4u*)(lds + HG_KT + stok * 272 + c16 * 2) = (v4u){kt[0], kt[1], kt[2], kt[3]}; *(LAS v4u*)(lds + HG_KT + stok * 272 + c16 * 2 + 16) = (v4u){kt[4], kt[5], kt[6], kt[7]}; } }
        __syncthreads();
        if (ch + 1 < HSEG / 64) HG_RAWLOAD(t0 + 64);
        if (OUT) {
            f32x16 X0, X1, O;
#pragma unroll
            for (int i = 0; i < 16; ++i) { X0[i] = 0.f; X1[i] = 0.f; O[i] = 0.f; }
            const LAS unsigned char* qtp = lds + HG_QT + (32 * tr + r) * 272 + hf * 16;
#pragma unroll
            for (int ks = 0; ks < 8; ++ks) { const s16x8 bq = *(const LAS s16x8*)(qtp + ks * 32);
                const s16x8 a0 = *(const LAS s16x8*)(lds + HG_KT + r * 272 + hf * 16 + ks * 32); X0 = __builtin_amdgcn_mfma_f32_32x32x16_bf16(a0, bq, X0, 0, 0, 0);
                if (tr == 1) { const s16x8 a1 = *(const LAS s16x8*)(lds + HG_KT + (32 + r) * 272 + hf * 16 + ks * 32); X1 = __builtin_amdgcn_mfma_f32_32x32x16_bf16(a1, bq, X1, 0, 0, 0); } }
#pragma unroll
            for (int i = 0; i < 16; ++i) { const bool keep = crow16(i, hf) <= r; if (tr == 0) X0[i] = keep ? X0[i] : 0.f; else X1[i] = keep ? X1[i] : 0.f; }
            const LAS unsigned char* vtp = lds + HG_VT + (32 * vq + r) * 144 + hf * 16;
#pragma unroll
            for (int s2 = 0; s2 < 2; ++s2) { v4u pw; pw.x = cvtpk(X0[8 * s2], X0[8 * s2 + 1]); pw.y = cvtpk(X0[8 * s2 + 2], X0[8 * s2 + 3]); pw.z = cvtpk(X0[8 * s2 + 4], X0[8 * s2 + 5]); pw.w = cvtpk(X0[8 * s2 + 6], X0[8 * s2 + 7]);
                const s16x8 bv = *(const LAS s16x8*)(vtp + (16 * s2) * 2); O = __builtin_amdgcn_mfma_f32_32x32x16_bf16(__builtin_bit_cast(s16x8, pw), bv, O, 0, 0, 0); }
            if (tr == 1) {
#pragma unroll
                for (int s2 = 0; s2 < 2; ++s2) { v4u pw; pw.x = cvtpk(X1[8 * s2], X1[8 * s2 + 1]); pw.y = cvtpk(X1[8 * s2 + 2], X1[8 * s2 + 3]); pw.z = cvtpk(X1[8 * s2 + 4], X1[8 * s2 + 5]); pw.w = cvtpk(X1[8 * s2 + 6], X1[8 * s2 + 7]);
                    const s16x8 bv = *(const LAS s16x8*)(vtp + (32 + 16 * s2) * 2); O = __builtin_amdgcn_mfma_f32_32x32x16_bf16(__builtin_bit_cast(s16x8, pw), bv, O, 0, 0, 0); } }
            const LAS unsigned char* stp = lds + HG_ST + (32 * vq + r) * 272 + hf * 16;
#pragma unroll
            for (int ks = 0; ks < 8; ++ks) { const s16x8 aq = *(const LAS s16x8*)(qtp + ks * 32), bs = *(const LAS s16x8*)(stp + ks * 32); O = __builtin_amdgcn_mfma_f32_32x32x16_bf16(aq, bs, O, 0, 0, 0); }
#pragma unroll
            for (int i = 0; i < 16; ++i) G[(32 * tr + crow16(i, hf)) * 128 + 32 * vq + r] = O[i];
        }
#pragma unroll
        for (int dd = 0; dd < 2; ++dd) { const int dr = 2 * tr + dd;
#pragma unroll
            for (int g4 = 0; g4 < 4; ++g4) { const f32x4 ge = *(const LAS f32x4*)(GE + 32 * dr + 8 * g4 + 4 * hf);
                S[dd][4 * g4] *= __builtin_amdgcn_exp2f(ge.x); S[dd][4 * g4 + 1] *= __builtin_amdgcn_exp2f(ge.y); S[dd][4 * g4 + 2] *= __builtin_amdgcn_exp2f(ge.z); S[dd][4 * g4 + 3] *= __builtin_amdgcn_exp2f(ge.w); }
#pragma unroll
            for (int ks = 0; ks < 4; ++ks) { const s16x8 a = *(const LAS s16x8*)(lds + HG_KE + (32 * dr + r) * 144 + hf * 16 + ks * 32), bv = *(const LAS s16x8*)(lds + HG_VT + (32 * vq + r) * 144 + hf * 16 + ks * 32);
                S[dd] = __builtin_amdgcn_mfma_f32_32x32x16_bf16(a, bv, S[dd], 0, 0, 0); } }
        __syncthreads();
        if (OUT) {
            float ov[16]; float ss = 0.f;
#pragma unroll
            for (int e4 = 0; e4 < 4; ++e4) { const f32x4 o4 = *(const LAS f32x4*)(G + stok * 128 + c16 + 4 * e4); ov[4 * e4] = o4.x; ov[4 * e4 + 1] = o4.y; ov[4 * e4 + 2] = o4.z; ov[4 * e4 + 3] = o4.w;
                ss += (o4.x * o4.x + o4.y * o4.y) + (o4.z * o4.z + o4.w * o4.w); }
            ss += xorf<1>(ss); ss += xorf<2>(ss); ss += xorf<4>(ss);
            const float rr = 1.f / sqrtf(ss * (1.f / 128.f) + 1e-6f);
            unsigned ow[8];
#pragma unroll
            for (int w = 0; w < 8; ++w) { const unsigned gw_ = g8[w >> 2][w & 3]; ow[w] = cvtpk(ov[2 * w] * rr * ng16[2 * w] * sigmoidf_(bflo(gw_)), ov[2 * w + 1] * rr * ng16[2 * w + 1] * sigmoidf_(bfhi(gw_))); }
            bf16* mrow = mix + (t0 + stok) * 1024 + hh * 128 + c16;
            *(v4u*)mrow = (v4u){ow[0], ow[1], ow[2], ow[3]}; *(v4u*)(mrow + 8) = (v4u){ow[4], ow[5], ow[6], ow[7]};
            __syncthreads();
        }
    }
#undef HG_RAWLOAD
    if (!OUT) {
#pragma unroll
        for (int dd = 0; dd < 2; ++dd)
#pragma unroll
            for (int i = 0; i < 16; ++i) Sp[(32 * (2 * tr + dd) + crow16(i, hf)) * 128] = S[dd][i];
        if (cpart == 3) Dseg[(size_t)unit * 128 + cd] = __builtin_amdgcn_exp2f(gsum);
    }
}
__device__ __forceinline__ void hgrn_scan(float* Sloc, const float* Dseg, size_t gtid, size_t gthreads) {
    for (size_t idx = gtid; idx < (size_t)NBATCH * HG_H * 16384; idx += gthreads) { const int bh = (int)(idx >> 14), e = (int)(idx & 16383), d = e >> 7; float cur = 0.f;
        float* __restrict__ sp = Sloc + (size_t)bh * HNSEG * 16384 + e; const float* __restrict__ dp = Dseg + (size_t)bh * HNSEG * 128 + d;
        for (int s0 = 0; s0 < HNSEG; s0 += 16) { float tv[16], dv[16];
#pragma unroll
            for (int k = 0; k < 16; ++k) { tv[k] = sp[(size_t)(s0 + k) * 16384]; dv[k] = dp[(s0 + k) * 128]; }
#pragma unroll
            for (int k = 0; k < 16; ++k) { sp[(size_t)(s0 + k) * 16384] = cur; cur = dv[k] * cur + tv[k]; } } }
}

template <bool MASK>
__device__ __forceinline__ void attn4(const LAS unsigned* Ks, const LAS bf16* Vs, const LAS float* qst, LAS float* pb, int lane, const int (&tq)[4], int kbase, float slope,
                                      float (&mo)[4], float (&lo)[4], float (&oo)[4]) {
    float sc[4][4];
#pragma unroll
    for (int a = 0; a < 4; ++a)
#pragma unroll
        for (int c = 0; c < 4; ++c) sc[a][c] = 0.f;
#pragma unroll 4
    for (int dd = 0; dd < 32; ++dd) {
        f32x2 qv[4];
#pragma unroll
        for (int qi = 0; qi < 4; ++qi) qv[qi] = *(const LAS f32x2*)(qst + qi * 64 + 2 * dd);
#pragma unroll
        for (int kk = 0; kk < 4; ++kk) { const unsigned kw = Ks[(lane + 64 * kk) * 33 + dd]; const float k0 = bflo(kw), k1 = bfhi(kw);
#pragma unroll
            for (int qi = 0; qi < 4; ++qi) sc[qi][kk] += qv[qi].x * k0 + qv[qi].y * k1; }
    }
#pragma unroll
    for (int qi = 0; qi < 4; ++qi) { float mx = -INFINITY;
#pragma unroll
        for (int kk = 0; kk < 4; ++kk) { const int pos = kbase + lane + 64 * kk; float lg = sc[qi][kk] * 0.125f - slope * (float)(tq[qi] - pos); if (MASK && pos > tq[qi]) lg = -INFINITY; sc[qi][kk] = lg; mx = fmaxf(mx, lg); }
        mx = wave_max(mx); float s = 0.f;
#pragma unroll
        for (int kk = 0; kk < 4; ++kk) { const float p = __builtin_amdgcn_exp2f((sc[qi][kk] - mx) * 1.4426950408889634f); pb[qi * 256 + lane + 64 * kk] = p; s += p; }
        lo[qi] = wave_sum(s); mo[qi] = mx; }
    float o[4] = {0.f, 0.f, 0.f, 0.f};
#pragma unroll 4
    for (int k4 = 0; k4 < 64; ++k4) { f32x4 p4[4];
#pragma unroll
        for (int qi = 0; qi < 4; ++qi) p4[qi] = *(const LAS f32x4*)(pb + qi * 256 + 4 * k4);
#pragma unroll
        for (int jj = 0; jj < 4; ++jj) { const float vv = bf2f(Vs[(4 * k4 + jj) * 64 + lane]);
#pragma unroll
            for (int qi = 0; qi < 4; ++qi) o[qi] += p4[qi][jj] * vv; } }
#pragma unroll
    for (int qi = 0; qi < 4; ++qi) oo[qi] = o[qi];
}
constexpr int AT_KS = 0, AT_VS = 33792, AT_WV = 66560, AT_WVB = 5120;

__device__ __forceinline__ void memattn_unit(LAS unsigned char* lds, const bf16* h, int NC, int qoff, const bf16* kv, bf16* mix, int unit, int tid, int wave, int lane) {
    const int chunk = unit & 31, bm = unit >> 5, mh = bm & 3, b = bm >> 2;
    LAS unsigned* Ks = (LAS unsigned*)(lds + AT_KS); LAS unsigned* Vs32 = (LAS unsigned*)(lds + AT_VS);
    LAS float* qst = (LAS float*)(lds + AT_WV + wave * AT_WVB); LAS float* pb = qst + 256;
    for (int i = 0; i < 16; ++i) { const int idx = tid + 512 * i, r = idx >> 5, dd = idx & 31; const unsigned* src = (const unsigned*)(kv + (size_t)(b * 256 + r) * 512 + mh * 64);
        Ks[r * 33 + dd] = src[dd]; Vs32[r * 32 + dd] = src[128 + dd]; }
    __syncthreads();
    for (int qd = 0; qd < 16; ++qd) { const size_t tg = (size_t)b * SEQ + chunk * 512 + wave * 64 + qd * 4;
#pragma unroll
        for (int qi = 0; qi < 4; ++qi) qst[qi * 64 + lane] = bf2f(h[(tg + qi) * NC + qoff + mh * 64 + lane]);
        const int tq[4] = {0, 0, 0, 0}; float m[4], l[4], o[4];
        attn4<false>(Ks, (const LAS bf16*)Vs32, qst, pb, lane, tq, 0, 0.f, m, l, o);
#pragma unroll
        for (int qi = 0; qi < 4; ++qi) mix[(tg + qi) * 1024 + MIXW + mh * 64 + lane] = (bf16)f2bf(o[qi] / l[qi]); }
    __syncthreads();
}

constexpr int AT2_K = 0, AT2_KROW = 176, AT2_V = 256 * AT2_KROW, AT2_VROW = 528, AT2_SCR = AT2_V + 64 * AT2_VROW, AT2_SCRW = 4864;
__device__ __forceinline__ void stage_kv_images(LAS unsigned char* lds, const bf16* kp, const bf16* vp, size_t row_stride, int tid) {
    v4u kx[4], vx[4];
#pragma unroll
    for (int i = 0; i < 4; ++i) { const int idx = tid + 512 * i, key = idx >> 3, c = idx & 7; kx[i] = *(const v4u*)(kp + (size_t)key * row_stride + 8 * c); vx[i] = *(const v4u*)(vp + (size_t)key * row_stride + 8 * c); }
    __builtin_amdgcn_sched_barrier(0);
#pragma unroll
    for (int i = 0; i < 4; ++i) { const int idx = tid + 512 * i, key = idx >> 3, c = idx & 7;
        *(LAS v4u*)(lds + AT2_K + key * AT2_KROW + c * 16) = kx[i];
        const int pos = (key & ~15) | (key & 3) | ((key & 4) << 1) | ((key & 8) >> 1);
        LAS bf16* vt = (LAS bf16*)(lds + AT2_V) + pos;
#pragma unroll
        for (int w = 0; w < 4; ++w) { vt[(8 * c + 2 * w) * (AT2_VROW / 2)] = (bf16)(vx[i][w] & 0xffffu); vt[(8 * c + 2 * w + 1) * (AT2_VROW / 2)] = (bf16)(vx[i][w] >> 16); } }
    if (tid < 256) { const unsigned pb = f2bf((float)tid); const v4u e0 = {pb | (pb << 16), 0u, 0u, 0u}, z = {0u, 0u, 0u, 0u};
        *(LAS v4u*)(lds + AT2_K + tid * AT2_KROW + 128) = e0; *(LAS v4u*)(lds + AT2_K + tid * AT2_KROW + 144) = z; }
}
template <bool MASK>
__device__ __forceinline__ void attn_tile32(const LAS unsigned char* lds, const s16x8 (&qf)[4], int lane, float dist0, unsigned qx, bool own, f32x16 (&o)[2], float& mrow, float& lrow) {
    const int r = lane & 31, hf = lane >> 5;
    const v4u qxv = {qx, 0u, 0u, 0u}; const s16x8 qe = __builtin_bit_cast(s16x8, qxv);
    f32x16 acc[8];
    const LAS unsigned char* kb = lds + AT2_K + r * AT2_KROW + hf * 16;
    constexpr int NKS = MASK ? 5 : 4;
    s16x8 kf[NKS];
#pragma unroll
    for (int s = 0; s < NKS; ++s) kf[s] = *(const LAS s16x8*)(kb + s * 32);
#pragma unroll
    for (int kt = 0; kt < 8; ++kt) {
#pragma unroll
        for (int i = 0; i < 16; ++i) acc[kt][i] = 0.f;
#pragma unroll
        for (int s = 0; s < NKS; ++s) { acc[kt] = __builtin_amdgcn_mfma_f32_32x32x16_bf16(kf[s], s < 4 ? qf[s < 4 ? s : 0] : qe, acc[kt], 0, 0, 0);
            if (kt + 1 < 8) kf[s] = *(const LAS s16x8*)(kb + (kt + 1) * 32 * AT2_KROW + s * 32); }
        __builtin_amdgcn_sched_barrier(0); }
    float mx = -INFINITY;
    if (MASK && own) { const float base2 = dist0 - 4.f * (float)hf;
#pragma unroll
        for (int kt = 0; kt < 8; ++kt)
#pragma unroll
            for (int i = 0; i < 16; ++i) { const float dist = base2 - (float)(32 * kt + (i & 3) + 8 * (i >> 2)); const float lg = dist < 0.f ? -INFINITY : acc[kt][i]; acc[kt][i] = lg; mx = fmaxf(mx, lg); }
    } else {
#pragma unroll
        for (int kt = 0; kt < 8; ++kt)
#pragma unroll
            for (int i = 0; i < 16; ++i) mx = fmaxf(mx, acc[kt][i]);
    }
    mx = fmaxf(mx, xor32f(mx, lane));
    float sum = 0.f;
#pragma unroll
    for (int i = 0; i < 16; ++i) { o[0][i] = 0.f; o[1][i] = 0.f; }
    const LAS unsigned char* vb = lds + AT2_V + r * AT2_VROW + hf * 16;
    s16x8 vf[4];
#pragma unroll
    for (int s2 = 0; s2 < 2; ++s2)
#pragma unroll
        for (int dt = 0; dt < 2; ++dt) vf[2 * s2 + dt] = *(const LAS s16x8*)(vb + dt * 32 * AT2_VROW + (16 * s2) * 2);
#pragma unroll
    for (int kt = 0; kt < 8; ++kt) {
#pragma unroll
        for (int i = 0; i < 16; ++i) { const float p = __builtin_amdgcn_exp2f(acc[kt][i] - mx); sum += p; acc[kt][i] = p; }
#pragma unroll
        for (int s2 = 0; s2 < 2; ++s2) { v4u pw; pw.x = cvtpk(acc[kt][8 * s2], acc[kt][8 * s2 + 1]); pw.y = cvtpk(acc[kt][8 * s2 + 2], acc[kt][8 * s2 + 3]);
            pw.z = cvtpk(acc[kt][8 * s2 + 4], acc[kt][8 * s2 + 5]); pw.w = cvtpk(acc[kt][8 * s2 + 6], acc[kt][8 * s2 + 7]); const s16x8 pf = __builtin_bit_cast(s16x8, pw);
#pragma unroll
            for (int dt = 0; dt < 2; ++dt) { o[dt] = __builtin_amdgcn_mfma_f32_32x32x16_bf16(vf[2 * s2 + dt], pf, o[dt], 0, 0, 0);
                if (kt + 1 < 8) vf[2 * s2 + dt] = *(const LAS s16x8*)(vb + dt * 32 * AT2_VROW + (32 * (kt + 1) + 16 * s2) * 2); } }
        __builtin_amdgcn_sched_barrier(0); }
    sum += xor32f(sum, lane);
    mrow = mx; lrow = sum;
}
__device__ __forceinline__ void memattn_unit2(LAS unsigned char* lds, const bf16* h, int NC, int qoff, const bf16* kv  , bf16* mix, int unit, int tid, int wave, int lane) {
    const int chunk = unit & 63, bm = unit >> 6, mh = bm & 3, b = bm >> 2, r = lane & 31, hf = lane >> 5;
    const bf16* kvrow0 = kv + (size_t)(b * 256) * 2048 + mh * 64;
    stage_kv_images(lds, kvrow0, kvrow0 + 256, 2048, tid);
    __syncthreads();
    { const size_t tg = (size_t)b * SEQ + chunk * 256 + wave * 32 + r;
        f32x16 o[2]; float m2, l; s16x8 qf[4];
#pragma unroll
        for (int s = 0; s < 4; ++s) qf[s] = *(const s16x8*)(h + tg * NC + qoff + mh * 64 + 16 * s + 8 * hf);
        attn_tile32<false>(lds, qf, lane, 0.f, 0u, false, o, m2, l);
        const float inv = 1.f / l; bf16* mp = mix + tg * 1024 + MIXW + mh * 64 + 4 * hf;
#pragma unroll
        for (int dt = 0; dt < 2; ++dt)
#pragma unroll
            for (int g = 0; g < 4; ++g) { v2u w; w.x = cvtpk(o[dt][4 * g] * inv, o[dt][4 * g + 1] * inv); w.y = cvtpk(o[dt][4 * g + 2] * inv, o[dt][4 * g + 3] * inv); *(v2u*)(mp + 32 * dt + 8 * g) = w; } }
    __syncthreads();
}
__device__ __forceinline__ void kmean_unit(LAS unsigned char* lds, const bf16* h, float* kmean, int unit, int tid) {
    const int n = unit & 63, bh = unit >> 6, hh = bh % MB_H, b = bh / MB_H, d = tid & 63, part = tid >> 6;
    LAS float* red = (LAS float*)lds;
    float s = 0.f; const bf16* p = h + ((size_t)b * SEQ + n * 256 + part * 32) * NC_M + 768 + hh * 64 + d;
    for (int i = 0; i < 32; ++i) s += bf2f(p[(size_t)i * NC_M]);
    red[part * 64 + d] = s; __syncthreads();
    if (tid < 64) { float a = 0.f; for (int pp = 0; pp < 8; ++pp) a += red[pp * 64 + tid]; kmean[((size_t)bh * 64 + n) * 64 + tid] = a * (1.f / 256.f); }
    __syncthreads();
}
__device__ __forceinline__ void moba_gate_unit(LAS unsigned char* lds, const bf16* h, const float* kmean, unsigned* gcount, int* selinfo, unsigned* list, int unit, int tid) {
    const int bh = unit >> 6, c = ((bh >> 2) & 1) ? 63 - (unit & 63) : (unit & 63), hh = bh % MB_H, b = bh / MB_H;
    LAS float* km = (LAS float*)lds; LAS int* hist = (LAS int*)(lds + 16384); LAS int* base = hist + 64;
    for (int i = tid; i < 4096; i += NTHR) km[i] = kmean[(size_t)bh * 4096 + i];
    if (tid < 64) hist[tid] = 0;
    __syncthreads();
    int s0 = 0, s1 = 0, s2 = 0, r0 = 0, r1 = 0, r2 = 0, ns = 0; const int hb = tid >> 8, t = c * 256 + (tid & 255);
    float v0 = -INFINITY, v1 = -INFINITY, v2 = -INFINITY;
    {
        float q[64]; const v4u* qp = (const v4u*)(h + ((size_t)b * SEQ + t) * NC_M + hh * 64);
#pragma unroll
        for (int w = 0; w < 8; ++w) { const v4u x = qp[w]; q[8 * w] = bflo(x.x); q[8 * w + 1] = bfhi(x.x); q[8 * w + 2] = bflo(x.y); q[8 * w + 3] = bfhi(x.y); q[8 * w + 4] = bflo(x.z); q[8 * w + 5] = bfhi(x.z); q[8 * w + 6] = bflo(x.w); q[8 * w + 7] = bfhi(x.w); }
        for (int n = hb; n < c; n += 2) { f32x2 g2 = {0.f, 0.f};
#pragma unroll
            for (int d4 = 0; d4 < 16; ++d4) { const f32x4 k4 = *(const LAS f32x4*)(km + n * 64 + 4 * d4); const f32x2 ka_ = {k4.x, k4.y}, kb_ = {k4.z, k4.w}, qa_ = {q[4 * d4], q[4 * d4 + 1]}, qb_ = {q[4 * d4 + 2], q[4 * d4 + 3]}; g2 = qa_ * ka_ + g2; g2 = qb_ * kb_ + g2; }
            const float g = g2.x + g2.y;
            if (g > v0) { v2 = v1; s2 = s1; v1 = v0; s1 = s0; v0 = g; s0 = n; } else if (g > v1) { v2 = v1; s2 = s1; v1 = g; s1 = n; } else if (g > v2) { v2 = g; s2 = n; } }
    }
    LAS float* cv = (LAS float*)(lds + 20480); LAS int* cs = (LAS int*)(lds + 20480 + 3072);
    if (hb == 1) { cv[tid & 255] = v0; cv[256 + (tid & 255)] = v1; cv[512 + (tid & 255)] = v2; cs[tid & 255] = s0; cs[256 + (tid & 255)] = s1; cs[512 + (tid & 255)] = s2; }
    __syncthreads();
    if (tid < 256) {
#pragma unroll
        for (int k = 0; k < 3; ++k) { const float g = cv[256 * k + tid]; const int n = cs[256 * k + tid];
            if (g > v0 || (g == v0 && n < s0)) { v2 = v1; s2 = s1; v1 = v0; s1 = s0; v0 = g; s0 = n; } else if (g > v1 || (g == v1 && n < s1)) { v2 = v1; s2 = s1; v1 = g; s1 = n; } else if (g > v2 || (g == v2 && n < s2)) { v2 = g; s2 = n; } }
        ns = c < 3 ? c : 3;
        if (ns > 0) r0 = __hip_atomic_fetch_add(hist + s0, 1, __ATOMIC_RELAXED, __HIP_MEMORY_SCOPE_WORKGROUP);
        if (ns > 1) r1 = __hip_atomic_fetch_add(hist + s1, 1, __ATOMIC_RELAXED, __HIP_MEMORY_SCOPE_WORKGROUP);
        if (ns > 2) r2 = __hip_atomic_fetch_add(hist + s2, 1, __ATOMIC_RELAXED, __HIP_MEMORY_SCOPE_WORKGROUP);
        selinfo[((size_t)b * SEQ + t) * MB_H + hh] = ns;
    }
    __syncthreads();
    if (tid < 64) { const int hc = hist[tid]; if (hc > 0) base[tid] = (int)__hip_atomic_fetch_add(gcount + bh * 64 + tid, (unsigned)hc, __ATOMIC_RELAXED, __HIP_MEMORY_SCOPE_AGENT); }
    __syncthreads();
    if (tid < 256) { unsigned* lp = list + ((size_t)bh * 64 << 14);
        if (ns > 0) lp[((size_t)s0 << 14) + base[s0] + r0] = (unsigned)t;
        if (ns > 1) lp[((size_t)s1 << 14) + base[s1] + r1] = (unsigned)t | (1u << 14);
        if (ns > 2) lp[((size_t)s2 << 14) + base[s2] + r2] = (unsigned)t | (2u << 14); }
    __syncthreads();
}
__device__ __forceinline__ void moba_attn_item(LAS unsigned char* lds, const bf16* h, const unsigned* gcount, const unsigned* list, float* po, float* pml, int item, int tid, int wave, int lane) {
    const int n = item / 24, bh = item - n * 24, hh = bh % MB_H, b = bh / MB_H;
    LAS unsigned* Ks = (LAS unsigned*)(lds + AT_KS); LAS unsigned* Vs32 = (LAS unsigned*)(lds + AT_VS);
    LAS float* qst = (LAS float*)(lds + AT_WV + wave * AT_WVB); LAS float* pb = qst + 256;
    for (int i = 0; i < 16; ++i) { const int idx = tid + 512 * i, r = idx >> 5, dd = idx & 31; const unsigned* src = (const unsigned*)(h + ((size_t)b * SEQ + n * 256 + r) * NC_M + hh * 64);
        Ks[r * 33 + dd] = src[384 + dd]; Vs32[r * 32 + dd] = src[768 + dd]; }
    __syncthreads();
    const int cnt = (int)gcount[bh * 64 + n], total = 256 + cnt, nquads = (total + 3) >> 2;
    const float slope = hh < 8 ? ldexpf(1.0f, -(hh + 1)) : ldexpf(0.70710678118654752f, -(hh - 8));
    const unsigned* lp = list + (((size_t)bh * 64 + n) << 14);
    for (int quad = wave; quad < nquads; quad += 8) {
        int tq[4], slot[4];
#pragma unroll
        for (int qi = 0; qi < 4; ++qi) { int idx = quad * 4 + qi; idx = idx < total ? idx : total - 1;
            if (idx < 256) { tq[qi] = n * 256 + idx; slot[qi] = 3; } else { const unsigned e = lp[idx - 256]; tq[qi] = (int)(e & 16383u); slot[qi] = (int)(e >> 14); } }
#pragma unroll
        for (int qi = 0; qi < 4; ++qi) qst[qi * 64 + lane] = bf2f(h[((size_t)b * SEQ + tq[qi]) * NC_M + hh * 64 + lane]);
        float m[4], l[4], o[4];
        attn4<true>(Ks, (const LAS bf16*)Vs32, qst, pb, lane, tq, n * 256, slope, m, l, o);
#pragma unroll
        for (int qi = 0; qi < 4; ++qi) if (quad * 4 + qi < total) { const size_t pi = (((size_t)b * SEQ + tq[qi]) * MB_H + hh) * 4 + slot[qi];
            po[pi * 64 + lane] = o[qi]; if (lane == 0) { pml[pi * 2] = m[qi]; pml[pi * 2 + 1] = l[qi]; } }
    }
    __syncthreads();
}

__device__ __forceinline__ void moba_attn_item2(LAS unsigned char* lds, const bf16* h, const unsigned* gcount, const unsigned* list, bf16* po, float* pml, int item, int tid, int wave, int lane) {
    const int n = item / 24, bh = item - n * 24, hh = bh % MB_H, b = bh / MB_H, r = lane & 31, hf = lane >> 5;
    const bf16* hrow0 = h + ((size_t)b * SEQ + n * 256) * NC_M + hh * 64;
    stage_kv_images(lds, hrow0 + 768, hrow0 + 1536, NC_M, tid);
    __syncthreads();
    const int cnt = (int)gcount[bh * 64 + n], total = 256 + cnt, ntiles = (total + 31) >> 5;
    const float slope2 = (hh < 8 ? ldexpf(1.0f, -(hh + 1)) : ldexpf(0.70710678118654752f, -(hh - 8))) * 1.4426950408889634f;
    const unsigned shi = f2bf(slope2), slo = f2bf(slope2 - __builtin_bit_cast(float, shi << 16)); const unsigned qx = hf == 0 ? (shi | (slo << 16)) : 0u;
    const unsigned* lp = list + (((size_t)bh * 64 + n) << 14);
    const bf16* hq = h + (size_t)b * SEQ * NC_M + hh * 64 + 8 * hf;
#pragma unroll 1
    for (int tile = wave; tile < ntiles; tile += NWAVES) {
        int idx = tile * 32 + r; const bool valid = idx < total; idx = valid ? idx : total - 1;
        int tq, slot; if (idx < 256) { tq = n * 256 + idx; slot = 3; } else { const unsigned e = lp[idx - 256]; tq = (int)(e & 16383u); slot = (int)(e >> 14); }
        s16x8 qf[4]; { const bf16* qp = hq + (size_t)tq * NC_M;
#pragma unroll
            for (int s = 0; s < 4; ++s) qf[s] = *(const s16x8*)(qp + 16 * s); }
        f32x16 o[2]; float m2, l; const float dist0 = (float)(tq - n * 256);
        attn_tile32<true>(lds, qf, lane, dist0, qx, tile < 8, o, m2, l);
        { LAS unsigned char* sw = lds + AT2_SCR + wave * AT2_SCRW; const int pi = valid ? (int)((((size_t)b * SEQ + tq) * MB_H + hh) * 4 + slot) : -1;
#pragma unroll
          for (int dt = 0; dt < 2; ++dt)
#pragma unroll
              for (int g = 0; g < 4; ++g) { v2u w; w.x = cvtpk(o[dt][4 * g], o[dt][4 * g + 1]); w.y = cvtpk(o[dt][4 * g + 2], o[dt][4 * g + 3]); *(LAS v2u*)(sw + r * 144 + (32 * dt + 8 * g + 4 * hf) * 2) = w; }
          if (hf == 0) { *(LAS int*)(sw + 4608 + 4 * r) = pi; if (valid) { pml[(size_t)pi * 2] = m2 - slope2 * dist0; pml[(size_t)pi * 2 + 1] = l; } }
#pragma unroll
          for (int it = 0; it < 4; ++it) { const int q = 8 * it + (lane >> 3), c = lane & 7; const int pq = *(const LAS int*)(sw + 4608 + 4 * q); const v4u row = *(const LAS v4u*)(sw + q * 144 + c * 16);
              if (pq >= 0) *(v4u*)(po + (size_t)pq * 64 + c * 8) = row; } }
    }
    __syncthreads();
}
__device__ __forceinline__ void moba_combine(const bf16* __restrict__ po, const float* __restrict__ pml, const int* __restrict__ selinfo, bf16* __restrict__ mix, int gw, int ngw, int lane) {
    const int sub = lane >> 4, d4 = (lane & 15) * 4;
#pragma unroll 4
    for (int idx = gw * 4 + sub; idx < T * MB_H; idx += ngw * 4) { const int tg = idx / MB_H, hh = idx - tg * MB_H, ns = selinfo[idx]; const size_t p4 = (size_t)idx * 4;
        f32x2 ml[4]; f32x4 ov[4];
#pragma unroll
        for (int j = 0; j < 4; ++j) { ml[j] = ((const f32x2*)pml)[p4 + j]; const v2u ow = *(const v2u*)(po + (p4 + j) * 64 + d4); ov[j] = (f32x4){bflo(ow.x), bfhi(ow.x), bflo(ow.y), bfhi(ow.y)}; }
        float M = ml[3].x;
#pragma unroll
        for (int j = 0; j < 3; ++j) { const bool ok = j < ns; ml[j].x = ok ? ml[j].x : -INFINITY; ml[j].y = ok ? ml[j].y : 0.f; M = fmaxf(M, ml[j].x);
            ov[j].x = ok ? ov[j].x : 0.f; ov[j].y = ok ? ov[j].y : 0.f; ov[j].z = ok ? ov[j].z : 0.f; ov[j].w = ok ? ov[j].w : 0.f; }
        float den = 0.f; f32x4 num = {0.f, 0.f, 0.f, 0.f};
#pragma unroll
        for (int j = 0; j < 4; ++j) { const float w = __builtin_amdgcn_exp2f(ml[j].x - M); den += w * ml[j].y; num += ov[j] * w; }
        const float inv = 1.f / den; v2u o; o.x = pk2(num.x * inv, num.y * inv); o.y = pk2(num.z * inv, num.w * inv);
        *(v2u*)(mix + (size_t)tg * 1024 + hh * 64 + d4) = o; }
}

__device__ __forceinline__ void ln_row(f32x4 (&v)[4], const f32x4 (&gv)[4], const f32x4 (&bv)[4]) {
    float s = 0.f;
#pragma unroll
    for (int j = 0; j < 4; ++j) s += (v[j].x + v[j].y) + (v[j].z + v[j].w);
    const float mean = wave_sum(s) * (1.f / D); float s2 = 0.f;
#pragma unroll
    for (int j = 0; j < 4; ++j) { v[j] = v[j] - mean; s2 += (v[j].x * v[j].x + v[j].y * v[j].y) + (v[j].z * v[j].z + v[j].w * v[j].w); }
    const float rstd = 1.f / sqrtf(wave_sum(s2) * (1.f / D) + 1e-5f);
#pragma unroll
    for (int j = 0; j < 4; ++j) v[j] = v[j] * rstd * gv[j] + bv[j];
}
__device__ __forceinline__ void split_router_weights(const float* wr  , bf16* wrs  , size_t gtid, size_t gthreads) {
    for (size_t i = gtid; i < (size_t)DEPTH * D * NE; i += gthreads) { const int e = (int)(i & 31), d = (int)((i >> 5) & 1023), l = (int)(i >> 15);
        const float w = wr[i]; const unsigned hi = f2bf(w); const unsigned lo = f2bf(w - __builtin_bit_cast(float, hi << 16));
        wrs[(((size_t)l * 2 + 0) * NE + e) * D + d] = (bf16)hi; wrs[(((size_t)l * 2 + 1) * NE + e) * D + d] = (bf16)lo; }
}
constexpr int L1_XH = 0, L1_XL = 33024, L1_ROW = 2064, L1_PART = 66048, L1_HIST = 82432;
__device__ __forceinline__ void phase_ln1(LAS unsigned char* lds, const bf16* y, const float* g, const float* bb, const bf16* wrs  , const float* br,
                                          bf16* xbf, int* tok_e, int* tok_lr, float* tok_w, int* blk_cnt, int blk, int tid, int wave, int lane) {
    LAS float* part = (LAS float*)(lds + L1_PART);
    LAS int* hist = (LAS int*)(lds + L1_HIST);
    if (tid < 32) hist[tid] = 0;
    constexpr int TPB = T / GRID;
    const int e = lane & 31, m16 = lane & 15, quad = lane >> 4;
    s16x8 bw[4][2][2];
#pragma unroll
    for (int ks = 0; ks < 4; ++ks)
#pragma unroll
        for (int nt = 0; nt < 2; ++nt)
#pragma unroll
            for (int pp = 0; pp < 2; ++pp) bw[ks][nt][pp] = *(const s16x8*)(wrs + ((size_t)pp * NE + 16 * nt + m16) * D + wave * 128 + 32 * ks + 8 * quad);
    const float bre = br[e];
    f32x4 gv[4], bv[4];
#pragma unroll
    for (int j = 0; j < 4; ++j) { gv[j] = ((const f32x4*)g)[lane + 64 * j]; bv[j] = ((const f32x4*)bb)[lane + 64 * j]; }
    v2u xn[2][4], yn[2][4];
#pragma unroll
    for (int u = 0; u < 2; ++u) { const size_t t0 = (size_t)blk * TPB + 2 * wave + u; const v2u* xr = (const v2u*)(xbf + t0 * D) + lane; const v2u* yr = (const v2u*)(y + t0 * D) + lane;
#pragma unroll
        for (int j = 0; j < 4; ++j) { xn[u][j] = xr[64 * j]; yn[u][j] = yr[64 * j]; } }
    __syncthreads();
    for (int grp = 0; grp < TPB / 16; ++grp) { const size_t tg0 = (size_t)blk * TPB + grp * 16 + 2 * wave;
        f32x4 v[2][4];
#pragma unroll
        for (int u = 0; u < 2; ++u)
#pragma unroll
            for (int j = 0; j < 4; ++j) { const v2u xw = xn[u][j]; const v2u yw = yn[u][j];
                v[u][j].x = DN_ALPHA * bflo(xw.x) + bflo(yw.x); v[u][j].y = DN_ALPHA * bfhi(xw.x) + bfhi(yw.x); v[u][j].z = DN_ALPHA * bflo(xw.y) + bflo(yw.y); v[u][j].w = DN_ALPHA * bfhi(xw.y) + bfhi(yw.y); }
        if (grp + 1 < TPB / 16) {
#pragma unroll
            for (int u = 0; u < 2; ++u) { const v2u* xr = (const v2u*)(xbf + (tg0 + 16 + u) * D) + lane; const v2u* yr = (const v2u*)(y + (tg0 + 16 + u) * D) + lane;
#pragma unroll
                for (int j = 0; j < 4; ++j) { xn[u][j] = xr[64 * j]; yn[u][j] = yr[64 * j]; } } }
#pragma unroll
        for (int u = 0; u < 2; ++u) { ln_row(v[u], gv, bv);
            v2u* xb = (v2u*)(xbf + (tg0 + u) * D) + lane;
#pragma unroll
            for (int j = 0; j < 4; ++j) { v2u hw; hw.x = cvtpk(v[u][j].x, v[u][j].y); hw.y = cvtpk(v[u][j].z, v[u][j].w); xb[64 * j] = hw;
                v2u lw; lw.x = cvtpk(v[u][j].x - bflo(hw.x), v[u][j].y - bfhi(hw.x)); lw.y = cvtpk(v[u][j].z - bflo(hw.y), v[u][j].w - bfhi(hw.y));
                *(LAS v2u*)(lds + L1_XH + (2 * wave + u) * L1_ROW + (4 * lane + 256 * j) * 2) = hw; *(LAS v2u*)(lds + L1_XL + (2 * wave + u) * L1_ROW + (4 * lane + 256 * j) * 2) = lw; } }
        __syncthreads();
        { f32x4 acc[2] = {{0.f, 0.f, 0.f, 0.f}, {0.f, 0.f, 0.f, 0.f}};
#pragma unroll
          for (int ks = 0; ks < 4; ++ks) { const int off = m16 * L1_ROW + (wave * 128 + 32 * ks + 8 * quad) * 2;
              const s16x8 ah = *(const LAS s16x8*)(lds + L1_XH + off), al = *(const LAS s16x8*)(lds + L1_XL + off);
#pragma unroll
              for (int nt = 0; nt < 2; ++nt) { acc[nt] = __builtin_amdgcn_mfma_f32_16x16x32_bf16(ah, bw[ks][nt][0], acc[nt], 0, 0, 0); acc[nt] = __builtin_amdgcn_mfma_f32_16x16x32_bf16(ah, bw[ks][nt][1], acc[nt], 0, 0, 0);
                  acc[nt] = __builtin_amdgcn_mfma_f32_16x16x32_bf16(al, bw[ks][nt][0], acc[nt], 0, 0, 0); } }
#pragma unroll
          for (int nt = 0; nt < 2; ++nt)
#pragma unroll
              for (int jj = 0; jj < 4; ++jj) part[(wave * 16 + 4 * quad + jj) * 32 + 16 * nt + m16] = acc[nt][jj]; }
        __syncthreads();
#pragma unroll
        for (int u = 0; u < 2; ++u) { const size_t t = tg0 + u;
            float logit = bre;
#pragma unroll
            for (int w = 0; w < 8; ++w) logit += part[(w * 16 + 2 * wave + u) * 32 + e];
            int rank = 0;
#pragma unroll
            for (int q = 0; q < 32; ++q) { const float oq = __builtin_bit_cast(float, __builtin_amdgcn_readlane(__builtin_bit_cast(int, logit), q)); rank += (oq > logit || (oq == logit && q < e)) ? 1 : 0; }
            int se[4]; float sv[4];
#pragma unroll
            for (int k = 0; k < 4; ++k) { const unsigned long long mk = __ballot(rank == k && lane < 32); const int src = __builtin_ctzll(mk);
                se[k] = src; sv[k] = __builtin_bit_cast(float, __builtin_amdgcn_readlane(__builtin_bit_cast(int, logit), src)); }
            const float e1 = __expf(sv[1] - sv[0]), e2 = __expf(sv[2] - sv[0]), e3 = __expf(sv[3] - sv[0]), inv = 1.f / (1.f + e1 + e2 + e3);
            const float wk[4] = {inv, e1 * inv, e2 * inv, e3 * inv};
            if (lane == 0) {
#pragma unroll
                for (int k = 0; k < 4; ++k) { const int lr = __hip_atomic_fetch_add(hist + se[k], 1, __ATOMIC_RELAXED, __HIP_MEMORY_SCOPE_WORKGROUP);
                    tok_e[t * 4 + k] = se[k]; tok_lr[t * 4 + k] = lr; tok_w[t * 4 + k] = wk[k]; } } }
    }
    __syncthreads();
    if (tid < 32) blk_cnt[blk * 32 + tid] = hist[tid];
    __syncthreads();
}
__device__ __forceinline__ void phase_dispatch(LAS unsigned char* lds, const int* __restrict__ blk_cnt, const int* __restrict__ tok_e, const int* __restrict__ tok_lr, int* __restrict__ tok_row, int* __restrict__ tab,
                                               const bf16* __restrict__ xbf, bf16* __restrict__ xs, int blk, int tid, int wave, int lane) {
    LAS int* tot = (LAS int*)lds; LAS int* pre = tot + 32; LAS int* pst = pre + 32; LAS int* rows = pst + 64;
    if (tid < 32) { int s = 0, p = 0;
#pragma unroll 8
        for (int bb = 0; bb < GRID; ++bb) { const int c = blk_cnt[bb * 32 + tid]; p += (bb < blk) ? c : 0; s += c; } tot[tid] = s; pre[tid] = p; }
    __syncthreads();
    if (tid == 0) { int acc = 0; for (int e = 0; e < 32; ++e) { pst[e] = acc; acc += ((tot[e] + 255) >> 8) << 8; } pst[32] = acc; }
    __syncthreads();
    if (blk == 0 && tid < 33) tab[tid] = pst[tid] >> 8;
    constexpr int TPB = T / GRID;
    static_assert(TPB * 4 == NTHR, "one (token, k) pair per thread");
    { const size_t ti = (size_t)blk * TPB * 4 + tid; const int e = tok_e[ti]; const int r = pst[e] + pre[e] + tok_lr[ti]; tok_row[ti] = r; rows[tid] = r; }
    __syncthreads();
#pragma unroll 4
    for (int i = wave; i < TPB * 4; i += NWAVES) { const int r = rows[i];
        const v4u* src = (const v4u*)(xbf + ((size_t)blk * TPB + (i >> 2)) * D) + 2 * lane; const v4u a = src[0], b = src[1];
        v4u o; o.x = pk4_fp8(bflo(a.x), bfhi(a.x), bflo(a.y), bfhi(a.y)); o.y = pk4_fp8(bflo(a.z), bfhi(a.z), bflo(a.w), bfhi(a.w)); o.z = pk4_fp8(bflo(b.x), bfhi(b.x), bflo(b.y), bfhi(b.y)); o.w = pk4_fp8(bflo(b.z), bfhi(b.z), bflo(b.w), bfhi(b.w));
        ((v4u*)((unsigned char*)xs + (size_t)r * D))[lane] = o; }
    __syncthreads();
}
__device__ __forceinline__ f32x4 fp8x4_to_f32(unsigned w) {
    const f32x2 lo = __builtin_amdgcn_cvt_pk_f32_fp8((int)w, false), hi = __builtin_amdgcn_cvt_pk_f32_fp8((int)w, true); return (f32x4){lo.x, lo.y, hi.x, hi.y};
}
__device__ __forceinline__ void phase_ln2(const unsigned char* __restrict__ yrows, const int* __restrict__ tok_row, const float* __restrict__ tok_w, const float* __restrict__ g, const float* __restrict__ bb,
                                          float* __restrict__ xout, bf16* xbf, int gw, int ngw, int lane) {
    f32x4 gv[4], bv[4];
#pragma unroll
    for (int j = 0; j < 4; ++j) { gv[j] = ((const f32x4*)g)[lane + 64 * j]; bv[j] = ((const f32x4*)bb)[lane + 64 * j]; }
    constexpr int NTK = 2;
    static_assert(T % (NTK * GRID * NWAVES) == 0, "NTK tokens per wave per step");
    for (int t0 = gw; t0 < T; t0 += NTK * ngw) {
        f32x4 v[NTK][4];
#pragma unroll
        for (int u = 0; u < NTK; ++u) { const int t = t0 + u * ngw; int r[4]; float w[4];
#pragma unroll
            for (int k = 0; k < 4; ++k) { r[k] = tok_row[(size_t)t * 4 + k]; w[k] = tok_w[(size_t)t * 4 + k] * (1.f / 16.f); }
            const v2u* xr = (const v2u*)(xbf + (size_t)t * D) + lane;
#pragma unroll
            for (int j = 0; j < 4; ++j) { f32x4 f = {0.f, 0.f, 0.f, 0.f};
#pragma unroll
                for (int k = 0; k < 4; ++k) { const unsigned yw = ((const unsigned*)(yrows + (size_t)r[k] * D))[lane + 64 * j]; f += fp8x4_to_f32(yw) * w[k]; }
                const v2u xw = xr[64 * j]; v[u][j].x = DN_ALPHA * bflo(xw.x) + f.x; v[u][j].y = DN_ALPHA * bfhi(xw.x) + f.y; v[u][j].z = DN_ALPHA * bflo(xw.y) + f.z; v[u][j].w = DN_ALPHA * bfhi(xw.y) + f.w; } }
#pragma unroll
        for (int u = 0; u < NTK; ++u) { const int t = t0 + u * ngw;
            ln_row(v[u], gv, bv);
            if (xout) { f32x4* xo = (f32x4*)(xout + (size_t)t * D) + lane;
#pragma unroll
                for (int j = 0; j < 4; ++j) xo[64 * j] = v[u][j]; }
            else { v2u* xb = (v2u*)(xbf + (size_t)t * D) + lane;
#pragma unroll
                for (int j = 0; j < 4; ++j) { v2u ww; ww.x = pk2(v[u][j].x, v[u][j].y); ww.y = pk2(v[u][j].z, v[u][j].w); xb[64 * j] = ww; } } } }
}

struct Args { const float* in[20]; float* out; unsigned char* ws; int l_lo, l_hi, ph_lo, ph_hi; };
typedef const __attribute__((address_space(4))) Args* KArgsP;
#define KA_LOAD() ({ KArgsP p_ = (KArgsP)__builtin_amdgcn_kernarg_segment_ptr(); asm volatile("" : "+s"(p_)); p_; })
#ifndef PHMASK
#define PHMASK 0xFFFF
#endif
#ifndef REPEAT_MASK
#define REPEAT_MASK 0
#endif
#ifndef REPEAT_LMASK
#define REPEAT_LMASK 0xF
#endif
#define PH_BEGIN(k) _Pragma("unroll") for (int rep_ = 0; rep_ < ((((REPEAT_MASK >> (k)) & 1) && ((REPEAT_LMASK >> l) & 1)) ? 2 : 1); ++rep_) { if ((PHMASK >> (k)) & 1) { KArgsP ka = KA_LOAD(); unsigned char* ws = ka->ws; int tid = threadIdx.x; asm volatile("" : "+v"(tid)); \
    const int lane = tid & 63, wave = __builtin_amdgcn_readfirstlane(tid >> 6); int blk = blockIdx.x; asm volatile("" : "+s"(blk)); \
    const int gw = blk * NWAVES + wave; const size_t gtid = (size_t)blk * NTHR + tid; (void)lane; (void)gw; (void)gtid; (void)ws;
#if ONE_LAUNCH
#define PH_SEAM() do { XcdBarrier b_; b_.bar = (unsigned*)(KA_LOAD()->ws + WS_CTL) + CW_BAR; b_.x = xb_xcc_id(); b_.st = (volatile LAS unsigned*)(lds + MISC_OFF); xcd_barrier(b_); } while (0)
#else
#define PH_SEAM() do {} while (0)
#endif
#define PH_END() PH_SEAM(); } }
#define PH_END_NOSEAM() } }
#define WSP(type, off) ((type*)(ws + (off)))
constexpr int G = GRID, NGW = GRID * NWAVES; constexpr size_t GTHREADS = (size_t)GRID * NTHR;
template <int L> __device__ __forceinline__ void layer_phases(LAS unsigned char* lds) {
    constexpr int l = L; LAS int* tabL = (LAS int*)(lds + MISC_OFF + 256);

        const int j = l >> 1; const bool moba = (l & 1) != 0;
        const int NC = moba ? NC_M : NC_H, qoff = moba ? 2304 : 3072;

        if (l == 0) {
        PH_BEGIN(1)
            phase_weights((LAS float*)(lds + wave * 16384), gw, NGW, lane, ka->in[2], NC_H, ka->in[6], 4, ka->in[7], ka->in[12], ka->in[14], ka->in[16], WSP(bf16, WS_WIN), WSP(bf16, WS_WKV4), WSP(bf16, WS_WO), WSP(bf16, WS_WGU), WSP(bf16, WS_WD));
        PH_END()
        }
        PH_BEGIN(2)
            { pg8::Gemm g{WSP(bf16, WS_XBF), WSP(bf16, WS_WIN), T, NC, D, 0, 0}; pg8::StaticOrder S; S.init(T, NC, G, blk); pg8::EpiPlain E{WSP(bf16, WS_H), NC, moba ? 0x207u : 0x1000u, 0.125f * 1.4426950408889634f};
              pg8::gemm_phase<pg8::EpiPlain, pg8::StaticOrder, true, true>(lds, g, S, E); }
            if (l == 0) {
              pg8::Gemm g{WSP(bf16, WS_MEMBF), WSP(bf16, WS_WKV4), 512, 2048, D, 0, 0}; pg8::StaticOrder S; S.init(512, 2048, G, blk >= 128 ? blk - 128 : G); pg8::EpiPlain E{WSP(bf16, WS_KV4), 2048, 0u, 1.f};
              pg8::gemm_phase<pg8::EpiPlain, pg8::StaticOrder, true, true>(lds, g, S, E); }
        PH_END()
        if (!moba) {
            PH_BEGIN(3)
                for (int u = blk; u < NBATCH * HG_H * HNSEG; u += G) hgrn_mfma<false>(lds, WSP(bf16, WS_H), ka->in[3], j, ka->in[4] + j * 128, WSP(float, WS_SLOC), WSP(float, WS_DSEG), WSP(bf16, WS_MIX), u, tid, wave, lane);
                for (int u = blk; u < 512; u += G) memattn_unit2(lds, WSP(bf16, WS_H), NC, qoff, WSP(bf16, WS_KV4) + 512 * l, WSP(bf16, WS_MIX), u, tid, wave, lane);
            PH_END()
            PH_BEGIN(4)
                hgrn_scan(WSP(float, WS_SLOC), WSP(float, WS_DSEG), gtid, GTHREADS);
            PH_END()
            PH_BEGIN(5)
                for (int u = blk; u < NBATCH * HG_H * HNSEG; u += G) hgrn_mfma<true>(lds, WSP(bf16, WS_H), ka->in[3], j, ka->in[4] + j * 128, WSP(float, WS_SLOC), WSP(float, WS_DSEG), WSP(bf16, WS_MIX), u, tid, wave, lane);
            PH_END()
        } else {
            PH_BEGIN(3)
                for (int u = blk; u < 24 * MB_NB; u += G) kmean_unit(lds, WSP(bf16, WS_H), WSP(float, WS_KMEAN), u, tid);
                for (int u = blk; u < 512; u += G) memattn_unit2(lds, WSP(bf16, WS_H), NC, qoff, WSP(bf16, WS_KV4) + 512 * l, WSP(bf16, WS_MIX), u, tid, wave, lane);
            PH_END()
            PH_BEGIN(4)
                for (int u = blk; u < 24 * MB_NB; u += G) moba_gate_unit(lds, WSP(bf16, WS_H), WSP(float, WS_KMEAN), WSP(unsigned, WS_CTL) + CW_GCOUNT + j * 1536, WSP(int, WS_SELINFO), WSP(unsigned, WS_LIST), u, tid);
            PH_END()
            PH_BEGIN(5)
                { unsigned* qhead = WSP(unsigned, WS_CTL) + CW_GCOUNT + 2 * 1536 + 64 * j; LAS int* itl = (LAS int*)(lds + MISC_OFF + 512);
                  for (;;) { if (tid == 0) *itl = (int)__hip_atomic_fetch_add(qhead, 1u, __ATOMIC_RELAXED, __HIP_MEMORY_SCOPE_AGENT);
                      __syncthreads(); const int it = *itl; __syncthreads();
                      if (it >= 24 * MB_NB) break;
                      moba_attn_item2(lds, WSP(bf16, WS_H), WSP(unsigned, WS_CTL) + CW_GCOUNT + j * 1536, WSP(unsigned, WS_LIST), WSP(bf16, WS_PO), WSP(float, WS_PML), it, tid, wave, lane); } }
            PH_END()
            PH_BEGIN(6)
                moba_combine(WSP(bf16, WS_PO), WSP(float, WS_PML), WSP(int, WS_SELINFO), WSP(bf16, WS_MIX), gw, NGW, lane);
            PH_END()
        }
        PH_BEGIN(7)
            pg8::Gemm g{WSP(bf16, WS_MIX), WSP(bf16, WS_WO), T, D, D, 0, 0}; pg8::StaticOrder S; S.init(T, D, G, blk); pg8::EpiPlain E{WSP(bf16, WS_Y), D, 0u, 1.f};
            pg8::gemm_phase<pg8::EpiPlain, pg8::StaticOrder, true, true>(lds, g, S, E);
        PH_END()
        PH_BEGIN(8)
            phase_ln1(lds, WSP(bf16, WS_Y), ka->in[8] + l * D, ka->in[9] + l * D, WSP(bf16, WS_WRS) + (size_t)l * 2 * NE * D, ka->in[11] + l * NE, WSP(bf16, WS_XBF),
                      WSP(int, WS_TOK + TOK_E), WSP(int, WS_TOK + TOK_LR), WSP(float, WS_TOK + TOK_W), WSP(int, WS_TOK + TOK_BLKCNT), blk, tid, wave, lane);
        PH_END()
        PH_BEGIN(9)
            phase_dispatch(lds, WSP(int, WS_TOK + TOK_BLKCNT), WSP(int, WS_TOK + TOK_E), WSP(int, WS_TOK + TOK_LR), WSP(int, WS_TOK + TOK_ROW), WSP(int, WS_TOK + TOK_TAB), WSP(bf16, WS_XBF), WSP(bf16, WS_XS), blk, tid, wave, lane);
        PH_END()
        PH_BEGIN(10)
            if (tid < 33) tabL[tid] = WSP(int, WS_TOK + TOK_TAB)[tid];
            __syncthreads();
            int sw_ = 0x7A7A7A7A, sx_ = 0x7F7F7F7F; asm volatile("" : "+s"(sw_), "+s"(sx_));
            pg8::Gemm g{WSP(bf16, WS_XS), WSP(bf16, WS_WGU), MOE_MAXROWS, NE * 2048, D / 2, sw_, sx_}; pg8::MoeOrder S{tabL, 8, G, blk, tabL[32] * 8};
            pg8::EpiSwiglu E{WSP(unsigned char, WS_HID), ka->in[13] + (size_t)l * NE * 1024, ka->in[15] + (size_t)l * NE * 1024};
            pg8::gemm_phase<pg8::EpiSwiglu, pg8::MoeOrder, true, true, true>(lds, g, S, E);
        PH_END()
        PH_BEGIN(11)
            if (tid < 33) tabL[tid] = WSP(int, WS_TOK + TOK_TAB)[tid];
            __syncthreads();
            int sw_ = 0x79797979, sx_ = 0x7F7F7F7F; asm volatile("" : "+s"(sw_), "+s"(sx_));
            pg8::Gemm g{WSP(bf16, WS_HID), WSP(bf16, WS_WD), MOE_MAXROWS, NE * 1024, D / 2, sw_, sx_}; pg8::MoeOrder S{tabL, 4, G, blk, tabL[32] * 4};
            pg8::EpiDown E{WSP(unsigned char, WS_XS), ka->in[17] + (size_t)l * NE * 1024};
            pg8::gemm_phase<pg8::EpiDown, pg8::MoeOrder, true, true, true>(lds, g, S, E);
        PH_END()
        PH_BEGIN(12)
            float* x2out = (l == DEPTH - 1) ? ka->out : nullptr;
            phase_ln2(WSP(unsigned char, WS_XS), WSP(int, WS_TOK + TOK_ROW), WSP(float, WS_TOK + TOK_W), ka->in[18] + l * D, ka->in[19] + l * D, x2out, WSP(bf16, WS_XBF), gw, NGW, lane);
            if (l + 1 < DEPTH) { constexpr int ln = l + 1, jn = ln >> 1; constexpr bool mn = (ln & 1) != 0;
                const float* win_src = mn ? ka->in[5] + (size_t)jn * D * NC_M : ka->in[2] + (size_t)jn * D * NC_H; const size_t moff = (size_t)ln * NE * 1024 * 1024;
                phase_weights((LAS float*)(lds + wave * 16384), gw, NGW, lane, win_src, mn ? NC_M : NC_H, ka->in[6], 0, ka->in[7] + (size_t)ln * D * D,
                              ka->in[12] + moff, ka->in[14] + moff, ka->in[16] + moff, WSP(bf16, WS_WIN), WSP(bf16, WS_WKV4), WSP(bf16, WS_WO), WSP(bf16, WS_WGU), WSP(bf16, WS_WD)); }
            if (l + 1 < DEPTH) PH_SEAM();
        PH_END_NOSEAM()
}
__global__ void __launch_bounds__(NTHR, 2) fwd_kernel(Args args) {
    extern __shared__ __attribute__((aligned(16))) unsigned char lds_raw[];
    LAS unsigned char* lds = (LAS unsigned char*)lds_raw;
    if (threadIdx.x < 4) ((LAS unsigned*)(lds + MISC_OFF))[threadIdx.x] = 0u;
    __syncthreads();
#if ONE_LAUNCH
    (void)xcd_barrier_post((unsigned*)(args.ws + WS_CTL) + CW_BAR, (volatile LAS unsigned*)(lds + MISC_OFF));
#endif
    { const int l = 0; (void)l;
    PH_BEGIN(0)
        cvt_rows_bf16(ka->in[0], WSP(bf16, WS_XBF), (size_t)T * D / 8, gtid, GTHREADS);
        cvt_rows_bf16(ka->in[1], WSP(bf16, WS_MEMBF), (size_t)512 * D / 8, gtid, GTHREADS);
        split_router_weights(ka->in[10], WSP(bf16, WS_WRS), gtid, GTHREADS);
    PH_END_NOSEAM() }
    layer_phases<0>(lds); layer_phases<1>(lds); layer_phases<2>(lds); layer_phases<3>(lds);
}

extern "C" void kernel_launch(void* const* d_in, const int* in_sizes, int n_in, void* d_out, int out_size, void* d_ws, size_t ws_size, hipStream_t stream) {
    static int ready = 0;
    if (ready == 0) {
        if (n_in != 20 || in_sizes[0] != T * D || out_size != T * D || ws_size < WS_END) { fprintf(stderr, "kernel_launch: unexpected shapes (n_in %d, in0 %d, out %d, ws %zu < %zu)\n", n_in, n_in > 0 ? in_sizes[0] : -1, out_size, ws_size, (size_t)WS_END); ready = -1; return; }
        if (hipFuncSetAttribute((const void*)fwd_kernel, hipFuncAttributeMaxDynamicSharedMemorySize, LDS_BYTES) != hipSuccess) { fprintf(stderr, "kernel_launch: hipFuncSetAttribute failed\n"); ready = -1; return; }
        int per_cu = 0;
        if (hipOccupancyMaxActiveBlocksPerMultiprocessor(&per_cu, (const void*)fwd_kernel, NTHR, LDS_BYTES) != hipSuccess || per_cu < 1) fprintf(stderr, "kernel_launch: occupancy query says %d\n", per_cu);
        (void)hipGetLastError();
        ready = 1;
    }
    if (ready < 0) return;
    if (hipMemsetAsync((char*)d_ws + WS_CTL, 0, CTL_ZERO_BYTES, stream) != hipSuccess) return;
    Args a{};
    for (int i = 0; i < 20; ++i) a.in[i] = (const float*)d_in[i];
    a.out = (float*)d_out; a.ws = (unsigned char*)d_ws;
    a.l_lo = 0; a.l_hi = DEPTH; a.ph_lo = 0; a.ph_hi = NPHASE;
    hipLaunchKernelGGL(fwd_kernel, dim3(GRID), dim3(NTHR), LDS_BYTES, stream, a);
}
```

```cpp
#include <hip/hip_runtime.h>
#include <cstdio>
#include <cstdint>
#include <cmath>
namespace pg8 {
#define PG8_LAS __attribute__((address_space(3)))
typedef unsigned short bf16_t;
typedef short bf16x8 __attribute__((ext_vector_type(8)));
typedef float f32x4 __attribute__((ext_vector_type(4)));
typedef unsigned u32x4 __attribute__((ext_vector_type(4)));
constexpr int BM = 256, BK = 64, HALF = 128, HTB = HALF * BK * 2  , STAGE_BYTES = 8 * HTB, NXCD = 8, WGM = 8;

__host__ __device__ __forceinline__ int lds_byte(int r, int c) { const int st = (r >> 4) * 2 + (c >> 5), rr = r & 15, cc = c & 31, ob = rr * 64 + cc * 2; return st * 1024 + (ob ^ (((ob >> 9) & 1) << 5)); }
__host__ __device__ __forceinline__ void stage_rc(int b, int& R, int& C) { const int st = b / 1024, sb = b % 1024, swz = sb ^ (((sb >> 9) & 1) << 5); R = (st >> 1) * 16 + swz / 64; C = (st & 1) * 32 + (swz % 64) / 2; }
__host__ __device__ __forceinline__ int perm32(int rho) { const int n = rho >> 4, i = rho & 15; return 8 * (i >> 2) + 4 * n + (i & 3); }

struct Unit { int pm, pn; };
struct Gemm { const bf16_t* A; const bf16_t* Bt; int M, N, K; int sw, sx; };
typedef int i32x8 __attribute__((ext_vector_type(8))); typedef int i32x4 __attribute__((ext_vector_type(4)));

struct StaticOrder {
    int nM, nN, nwg, G, c;
    __host__ __device__ void init(int M, int N, int G_, int c_) { nM = M / BM; nN = N / BM; nwg = nM * nN; G = G_; c = c_; }
    __host__ __device__ bool next(int i, Unit& u) const {
        const long L = (long)i * G + c; if (L >= nwg) return false;
        int wgid = (int)L; { const int q = nwg / NXCD, r = nwg % NXCD, xcd = wgid % NXCD, off = wgid / NXCD; wgid = (xcd < r ? xcd * (q + 1) : r * (q + 1) + (xcd - r) * q) + off; }
        const int nig = WGM * nN, gid = wgid / nig, fm = gid * WGM, gsz = (nM - fm) < WGM ? (nM - fm) : WGM;
        u.pm = fm + ((wgid % nig) % gsz); u.pn = (wgid % nig) / gsz; return true;
    }
    __device__ __forceinline__ void a_ready(const Unit&) const {}
    __device__ __forceinline__ void done(const Unit&) const {}
};

__device__ __forceinline__ unsigned cvt_pk_bf16(float lo, float hi) { unsigned r; asm volatile("v_cvt_pk_bf16_f32 %0, %1, %2" : "=v"(r) : "v"(lo), "v"(hi)); return r; }
typedef float f32x2 __attribute__((ext_vector_type(2)));
struct EpiPlain {
    static constexpr bool PERM = true, AFTER_DRAIN = false;
    bf16_t* O; int ldc; unsigned smask; float sc;
    struct Pre {};
    __device__ __forceinline__ void pre_load(const Unit&, int, int, Pre&) const {}
    __device__ __forceinline__ void acc_init(f32x4 (&acc)[2][2][4][2], const Pre&) const {
#pragma unroll
        for (int a = 0; a < 2; ++a)
#pragma unroll
            for (int b = 0; b < 2; ++b)
#pragma unroll
                for (int m = 0; m < 4; ++m)
#pragma unroll
                    for (int n = 0; n < 2; ++n) acc[a][b][m][n] = (f32x4){0.f, 0.f, 0.f, 0.f}; }
    __device__ __forceinline__ void operator()(const f32x4 (&acc)[2][2][4][2], const Unit& u, int wr, int wc, int fr, int fq) const {
        const int row0 = u.pm * BM + wr * 64 + fr; const int col0 = u.pn * BM + wc * 32 + 8 * fq; const float s = ((smask >> u.pn) & 1u) ? sc : 1.f;
#pragma unroll
        for (int ai = 0; ai < 2; ++ai)
#pragma unroll
            for (int m = 0; m < 4; ++m) { bf16_t* rowp = O + (size_t)(row0 + ai * HALF + m * 16) * ldc + col0;
#pragma unroll
                for (int bj = 0; bj < 2; ++bj) { const f32x4 v0 = acc[ai][bj][m][0] * s, v1 = acc[ai][bj][m][1] * s;
                    u32x4 w; w.x = cvt_pk_bf16(v0[0], v0[1]); w.y = cvt_pk_bf16(v0[2], v0[3]); w.z = cvt_pk_bf16(v1[0], v1[1]); w.w = cvt_pk_bf16(v1[2], v1[3]);
                    *(u32x4*)(rowp + bj * HALF) = w; } }
    }
};
__device__ __forceinline__ float swiglu1(float g, float u) {
    g = fminf(g, 7.0f); u = fminf(fmaxf(u, -7.0f), 7.0f);
    const float s = __builtin_amdgcn_rcpf(1.0f + __builtin_amdgcn_exp2f(g * (-1.702f * 1.4426950408889634f)));
    return g * s * (u + 1.0f);
}
__device__ __forceinline__ unsigned pk4_fp8e(float a, float b, float c, float d) { int w = 0; w = __builtin_amdgcn_cvt_pk_fp8_f32(a, b, w, false); w = __builtin_amdgcn_cvt_pk_fp8_f32(c, d, w, true); return (unsigned)w; }
struct EpiSwiglu {
    static constexpr bool PERM = true, AFTER_DRAIN = false;
    unsigned char* hid; const float* bg; const float* bu;
    struct Pre { f32x4 g0, g1, u0, u1; };
    __device__ __forceinline__ void pre_load(const Unit& u, int wc, int fq, Pre& p) const { const int e = u.pn >> 3, col0 = (u.pn & 7) * 128 + wc * 32 + 8 * fq;
        p.g0 = *(const f32x4*)(bg + e * 1024 + col0); p.g1 = *(const f32x4*)(bg + e * 1024 + col0 + 4); p.u0 = *(const f32x4*)(bu + e * 1024 + col0); p.u1 = *(const f32x4*)(bu + e * 1024 + col0 + 4); }
    __device__ __forceinline__ void acc_init(f32x4 (&acc)[2][2][4][2], const Pre& p) const {
#pragma unroll
        for (int a = 0; a < 2; ++a)
#pragma unroll
            for (int m = 0; m < 4; ++m) { acc[a][0][m][0] = p.g0; acc[a][0][m][1] = p.g1; acc[a][1][m][0] = p.u0; acc[a][1][m][1] = p.u1; } }
    __device__ __forceinline__ void operator()(const f32x4 (&acc)[2][2][4][2], const Unit& u, int wr, int wc, int fr, int fq) const {
        const int pn = u.pn & 7;
        const int row0 = u.pm * BM + wr * 64 + fr; const int col0 = pn * 128 + wc * 32 + 8 * fq;
#pragma unroll
        for (int ai = 0; ai < 2; ++ai)
#pragma unroll
            for (int m = 0; m < 4; ++m) { unsigned char* rowp = hid + (size_t)(row0 + ai * HALF + m * 16) * 1024 + col0;
                const f32x4 ga = acc[ai][0][m][0], gb = acc[ai][0][m][1], ua = acc[ai][1][m][0], ub = acc[ai][1][m][1];
                typedef unsigned u32x2 __attribute__((ext_vector_type(2))); u32x2 w;
                w.x = pk4_fp8e(swiglu1(ga[0], ua[0]), swiglu1(ga[1], ua[1]), swiglu1(ga[2], ua[2]), swiglu1(ga[3], ua[3]));
                w.y = pk4_fp8e(swiglu1(gb[0], ub[0]), swiglu1(gb[1], ub[1]), swiglu1(gb[2], ub[2]), swiglu1(gb[3], ub[3]));
                *(u32x2*)rowp = w; }
    }
};
struct EpiDown {
    static constexpr bool PERM = true, AFTER_DRAIN = false;
    unsigned char* y; const float* bd;
    struct Pre { f32x4 b[2][2]; };
    __device__ __forceinline__ void pre_load(const Unit& u, int wc, int fq, Pre& p) const { const int e = u.pn >> 2, col0 = (u.pn & 3) * BM + wc * 32 + 8 * fq;
#pragma unroll
        for (int bj = 0; bj < 2; ++bj)
#pragma unroll
            for (int n = 0; n < 2; ++n) p.b[bj][n] = *(const f32x4*)(bd + e * 1024 + col0 + bj * HALF + 4 * n); }
    __device__ __forceinline__ void acc_init(f32x4 (&acc)[2][2][4][2], const Pre& p) const {
#pragma unroll
        for (int a = 0; a < 2; ++a)
#pragma unroll
            for (int bj = 0; bj < 2; ++bj)
#pragma unroll
                for (int m = 0; m < 4; ++m) { acc[a][bj][m][0] = p.b[bj][0]; acc[a][bj][m][1] = p.b[bj][1]; } }
    __device__ __forceinline__ void operator()(const f32x4 (&acc)[2][2][4][2], const Unit& u, int wr, int wc, int fr, int fq) const {
        const int pn = u.pn & 3;
        const int row0 = u.pm * BM + wr * 64 + fr; const int col0 = pn * BM + wc * 32 + 8 * fq;
#pragma unroll
        for (int ai = 0; ai < 2; ++ai)
#pragma unroll
            for (int m = 0; m < 4; ++m) { unsigned char* rowp = y + (size_t)(row0 + ai * HALF + m * 16) * 1024 + col0;
#pragma unroll
                for (int bj = 0; bj < 2; ++bj) { const f32x4 v0 = acc[ai][bj][m][0] * 16.f, v1 = acc[ai][bj][m][1] * 16.f;
                    typedef unsigned u32x2 __attribute__((ext_vector_type(2))); u32x2 w; w.x = pk4_fp8e(v0[0], v0[1], v0[2], v0[3]); w.y = pk4_fp8e(v1[0], v1[1], v1[2], v1[3]);
                    *(u32x2*)(rowp + bj * HALF) = w; } }
    }
};
struct MoeOrder {
    const PG8_LAS int* tab; int npn, G, c, nunits;
    __device__ __forceinline__ bool next(int i, Unit& u) const {
        const int tpx = 32 / npn, s = c >> 3, tile = (i * 8 + (c & 7)) * tpx + s / npn, pn = s % npn;
        if ((i * 8) * tpx >= nunits / npn) return false;
        if (tile >= nunits / npn) { u.pm = 0; u.pn = 0; return false; }
        int e = 0;
#pragma unroll
        for (int k = 1; k < 32; ++k) e += (tab[k] <= tile) ? 1 : 0;
        u.pm = tile; u.pn = __builtin_amdgcn_readfirstlane(e) * npn + pn; return true;
    }
    __device__ __forceinline__ void a_ready(const Unit&) const {}
    __device__ __forceinline__ void done(const Unit&) const {}
};
template <class Epi, class Sched, bool ALIGN_EPI = false, bool SP2 = false, bool F8 = false>
__device__ __forceinline__ void gemm_phase(PG8_LAS unsigned char* lds, const Gemm g, const Sched& S, const Epi& E) {
    int tid_ = threadIdx.x; asm volatile("" : "+v"(tid_));
    const int tid = tid_, wid = __builtin_amdgcn_readfirstlane(tid >> 6), lane = tid & 63, wr = wid >> 2, wc = wid & 3, fr = lane & 15, fq = lane >> 4;
    const int K = g.K, nt = K / BK;
    unsigned voffA, voffB;
    { int R, C; stage_rc(tid * 16, R, C); const int Rb = Epi::PERM ? ((R & ~31) + perm32(R & 31)) : R; voffA = (unsigned)(R * K + C) * 2u; voffB = (unsigned)(Rb * K + C) * 2u; }
    const unsigned qstep = 64u * (unsigned)K * 2u;
    const unsigned kstep = (unsigned)(BK * 2);
    const unsigned hstep = (unsigned)HALF * (unsigned)K * 2u;
    const unsigned tstep = 2u * hstep;
    const __amdgpu_buffer_rsrc_t rA = __builtin_amdgcn_make_buffer_rsrc((void*)g.A, 0, 0x7FFFFFFF, 0x00020000), rB = __builtin_amdgcn_make_buffer_rsrc((void*)g.Bt, 0, 0x7FFFFFFF, 0x00020000);
    const unsigned ldsw = (unsigned)wid * 1024u;
    const int aoff = lds_byte(wr * 64 + fr, fq * 8), boff = lds_byte(wc * 32 + fr, fq * 8);
#define PG8_SA(b, h) (((b) * 2 + (h)) * HTB)
#define PG8_SB(b, h) ((4 + (b) * 2 + (h)) * HTB)
#define PG8_STG(bufoff, rsrc, soff, voff) do { _Pragma("unroll") for (int _i = 0; _i < 2; ++_i) \
        __builtin_amdgcn_raw_ptr_buffer_load_lds((rsrc), (PG8_LAS void*)(lds + (bufoff) + ldsw + _i * 8192), 16, (int)(voff), (int)((soff) + (unsigned)_i * qstep), 0, 0); } while (0)
#define PG8_STGA(bufoff, soff) PG8_STG(bufoff, rA, soff, voffA)
#define PG8_STGB(bufoff, soff) PG8_STG(bufoff, rB, soff, voffB)
#define PG8_LDA(dst, b, h) do { _Pragma("unroll") for (int m = 0; m < 4; ++m) { if constexpr (F8) { const i32x4 lo_ = *(const PG8_LAS i32x4*)(lds + PG8_SA(b, h) + aoff + m * 2048), hi_ = *(const PG8_LAS i32x4*)(lds + PG8_SA(b, h) + aoff + m * 2048 + 1024); \
            dst##_8[m] = __builtin_shufflevector(lo_, hi_, 0, 1, 2, 3, 4, 5, 6, 7); } else { _Pragma("unroll") for (int k = 0; k < 2; ++k) dst[m][k] = *(const PG8_LAS bf16x8*)(lds + PG8_SA(b, h) + aoff + m * 2048 + k * 1024); } } } while (0)
#define PG8_LDB(dst, b, h) do { _Pragma("unroll") for (int n = 0; n < 2; ++n) { if constexpr (F8) { const i32x4 lo_ = *(const PG8_LAS i32x4*)(lds + PG8_SB(b, h) + boff + n * 2048), hi_ = *(const PG8_LAS i32x4*)(lds + PG8_SB(b, h) + boff + n * 2048 + 1024); \
            dst##_8[n] = __builtin_shufflevector(lo_, hi_, 0, 1, 2, 3, 4, 5, 6, 7); } else { _Pragma("unroll") for (int k = 0; k < 2; ++k) dst[n][k] = *(const PG8_LAS bf16x8*)(lds + PG8_SB(b, h) + boff + n * 2048 + k * 1024); } } } while (0)
#define PG8_MMA(ai, bj, At, Bt) do { __builtin_amdgcn_s_setprio(1); _Pragma("unroll") for (int m = 0; m < 4; ++m) _Pragma("unroll") for (int n = 0; n < 2; ++n) { \
        if constexpr (F8) acc[ai][bj][m][n] = __builtin_amdgcn_mfma_scale_f32_16x16x128_f8f6f4(Bt##_8[n], At##_8[m], acc[ai][bj][m][n], 0, 0, 0, g.sw, 0, g.sx); \
        else { _Pragma("unroll") for (int k = 0; k < 2; ++k) acc[ai][bj][m][n] = __builtin_amdgcn_mfma_f32_16x16x32_bf16(Bt[n][k], At[m][k], acc[ai][bj][m][n], 0, 0, 0); } } \
        __builtin_amdgcn_s_setprio(0); } while (0)
#define PG8_WAIT_V(n) asm volatile("s_waitcnt vmcnt(" #n ")" ::: "memory")
#define PG8_WAIT_L(n) asm volatile("s_waitcnt lgkmcnt(" #n ")" ::: "memory")
#define PG8_BAR __builtin_amdgcn_s_barrier()
#define PG8_SCHED __builtin_amdgcn_sched_barrier(0)
    Unit cur, nxt; int ui = 0;
    if (!S.next(0, cur)) return;
    f32x4 acc[2][2][4][2];
    typename Epi::Pre pre; E.pre_load(cur, wc, fq, pre); E.acc_init(acc, pre);
    bf16x8 At[4][2], B0[2][2], B1[2][2]; i32x8 At_8[4], B0_8[2], B1_8[2];
    unsigned cA = (unsigned)cur.pm * tstep, cB = (unsigned)cur.pn * tstep;
    S.a_ready(cur);
    if constexpr (SP2) {
        PG8_STGB(PG8_SB(0, 0), cB); PG8_STGB(PG8_SB(0, 1), cB + hstep); PG8_STGA(PG8_SA(0, 0), cA); PG8_STGA(PG8_SA(0, 1), cA + hstep);
        if (wr == 1) PG8_BAR;
        PG8_WAIT_V(2); PG8_BAR;
        PG8_STGB(PG8_SB(1, 0), cB + kstep); PG8_STGA(PG8_SA(1, 0), cA + kstep); PG8_STGB(PG8_SB(1, 1), cB + hstep + kstep);
        PG8_WAIT_V(6); PG8_BAR;
    } else {
        PG8_STGB(PG8_SB(0, 0), cB); PG8_STGA(PG8_SA(0, 0), cA); PG8_STGB(PG8_SB(0, 1), cB + hstep); PG8_STGA(PG8_SA(0, 1), cA + hstep);
        if (wr == 1) PG8_BAR;
        PG8_WAIT_V(4); PG8_BAR;
        PG8_STGB(PG8_SB(1, 0), cB + kstep); PG8_STGA(PG8_SA(1, 0), cA + kstep); PG8_STGB(PG8_SB(1, 1), cB + hstep + kstep);
        PG8_WAIT_V(6); PG8_BAR;
    }
    for (;;) {
        const bool has_next = S.next(ui + 1, nxt);
        const unsigned nA = has_next ? (unsigned)nxt.pm * tstep : cA, nB = has_next ? (unsigned)nxt.pn * tstep : cB;
#pragma unroll 1
        for (int t = 0; t < nt; t += 2) {
            const bool last = (t == nt - 2);
            const unsigned a1 = cA + (unsigned)(t + 1) * kstep;
            const unsigned a2 = last ? nA : cA + (unsigned)(t + 2) * kstep, b2 = last ? nB : cB + (unsigned)(t + 2) * kstep;
            const unsigned a3 = a2 + kstep, b3 = b2 + kstep;
            if (last && has_next) S.a_ready(nxt);
            if constexpr (SP2) {
            PG8_LDB(B0, 0, 0); PG8_LDB(B1, 0, 1); PG8_SCHED; PG8_LDA(At, 0, 0); PG8_STGA(PG8_SA(1, 1), a1 + hstep);
            PG8_WAIT_V(8); PG8_WAIT_L(0); PG8_BAR; PG8_MMA(0, 0, At, B0); PG8_MMA(0, 1, At, B1); PG8_BAR; PG8_SCHED;
            PG8_LDA(At, 0, 1); PG8_STGB(PG8_SB(0, 0), b2); PG8_STGB(PG8_SB(0, 1), b2 + hstep); PG8_STGA(PG8_SA(0, 0), a2);
            PG8_WAIT_V(8); PG8_WAIT_L(0); PG8_BAR; PG8_MMA(1, 0, At, B0); PG8_MMA(1, 1, At, B1); PG8_BAR; PG8_SCHED;
            PG8_LDB(B0, 1, 0); PG8_LDB(B1, 1, 1); PG8_SCHED; PG8_LDA(At, 1, 0); PG8_STGA(PG8_SA(0, 1), a2 + hstep);
            PG8_WAIT_V(8); PG8_WAIT_L(0); PG8_BAR; PG8_MMA(0, 0, At, B0); PG8_MMA(0, 1, At, B1); PG8_BAR; PG8_SCHED;
            PG8_LDA(At, 1, 1); PG8_STGB(PG8_SB(1, 0), b3); PG8_STGB(PG8_SB(1, 1), b3 + hstep); PG8_STGA(PG8_SA(1, 0), a3);
            PG8_WAIT_V(8); PG8_WAIT_L(0); PG8_BAR; PG8_MMA(1, 0, At, B0); PG8_MMA(1, 1, At, B1); PG8_BAR; PG8_SCHED;
            } else {
            PG8_LDB(B0, 0, 0); PG8_SCHED; PG8_LDA(At, 0, 0); PG8_STGA(PG8_SA(1, 1), a1 + hstep);
            PG8_WAIT_L(8); PG8_BAR; PG8_WAIT_L(0); PG8_MMA(0, 0, At, B0); PG8_BAR; PG8_SCHED;
            PG8_LDB(B1, 0, 1); PG8_STGB(PG8_SB(0, 0), b2);
            PG8_BAR; PG8_WAIT_L(0); PG8_MMA(0, 1, At, B1); PG8_BAR;
            PG8_LDA(At, 0, 1); PG8_STGA(PG8_SA(0, 0), a2);
            PG8_BAR; PG8_WAIT_L(0); PG8_MMA(1, 0, At, B0); PG8_BAR; PG8_SCHED;
            PG8_STGB(PG8_SB(0, 1), b2 + hstep);
            PG8_WAIT_V(6); PG8_BAR; PG8_MMA(1, 1, At, B1); PG8_BAR;
            PG8_LDB(B0, 1, 0); PG8_SCHED; PG8_LDA(At, 1, 0); PG8_STGA(PG8_SA(0, 1), a2 + hstep);
            PG8_WAIT_L(8); PG8_BAR; PG8_WAIT_L(0); PG8_MMA(0, 0, At, B0); PG8_BAR; PG8_SCHED;
            PG8_LDB(B1, 1, 1); PG8_STGB(PG8_SB(1, 0), b3);
            PG8_BAR; PG8_WAIT_L(0); PG8_MMA(0, 1, At, B1); PG8_BAR;
            PG8_LDA(At, 1, 1); PG8_STGA(PG8_SA(1, 0), a3);
            PG8_BAR; PG8_WAIT_L(0); PG8_MMA(1, 0, At, B0); PG8_BAR; PG8_SCHED;
            PG8_STGB(PG8_SB(1, 1), b3 + hstep);
            PG8_WAIT_V(6); PG8_BAR; PG8_MMA(1, 1, At, B1); PG8_BAR;
            }
        }
        if constexpr (ALIGN_EPI) { if (wr == 0) PG8_BAR; }
        if constexpr (!Epi::AFTER_DRAIN) { int t2_ = threadIdx.x; asm volatile("" : "+v"(t2_)); { const Unit pu_ = has_next ? nxt : cur; E.pre_load(pu_, wc, (t2_ & 63) >> 4, pre); }     E(acc, cur, wr, wc, t2_ & 15, (t2_ & 63) >> 4); S.done(cur); }
        if (!has_next) break;
        E.acc_init(acc, pre);
        cur = nxt; cA = nA; cB = nB; ++ui;
        if constexpr (ALIGN_EPI) { if (wr == 1) PG8_BAR; }
    }
    PG8_WAIT_V(0);
    if constexpr (!ALIGN_EPI) { if (wr == 0) PG8_BAR; }
    PG8_BAR;
    if constexpr (Epi::AFTER_DRAIN) { E.fused(acc, cur, wr, wc, fr, fq, lds, wid, lane); S.done(cur); }
#undef PG8_SA
#undef PG8_SB
#undef PG8_STG
#undef PG8_STGA
#undef PG8_STGB
#undef PG8_LDA
#undef PG8_LDB
#undef PG8_MMA
#undef PG8_WAIT_V
#undef PG8_WAIT_L
#undef PG8_BAR
#undef PG8_SCHED
}
}

constexpr int NWAVES = 8, NTHR = 512, GRID = 256;
constexpr int NBATCH = 2, SEQ = 16384, T = NBATCH * SEQ, D = 1024, DEPTH = 4;
constexpr int MIXW = 768, NC_H = 3328, NC_M = 2560;
constexpr int HG_H = 6;
constexpr int HSEG = 256, HNSEG = SEQ / HSEG;
constexpr int MB_H = 12, MB_NB = 64;
constexpr int NE = 32;
constexpr float DN_ALPHA = 1.6817928305074290f;
constexpr int MOE_MAXROWS = T * 4 + NE * 256;
#ifndef ONE_LAUNCH
#define ONE_LAUNCH 1
#endif
constexpr int NPHASE = 13;

constexpr size_t MiB = 1u << 20;
constexpr size_t WS_CTL = 0, CTL_ZERO_BYTES = 1 * MiB;
constexpr size_t WS_WIN = 1 * MiB, WS_WKV = 9 * MiB, WS_WO = 10 * MiB, WS_WGU = 12 * MiB, WS_WD = 140 * MiB;
constexpr size_t WS_XBF = 204 * MiB, WS_WKV4 = 268 * MiB  , WS_KV4 = 272 * MiB  , WS_WRS = 280 * MiB  , WS_MEMBF = 524 * MiB;
constexpr size_t WS_H = 526 * MiB, WS_MIX = 734 * MiB, WS_Y = 798 * MiB, WS_SLOC = 862 * MiB, WS_DSEG = 910 * MiB, WS_KMEAN = 911 * MiB;
constexpr size_t WS_SELINFO = 912 * MiB, WS_TOK = 914 * MiB, WS_R1 = 918 * MiB;
constexpr size_t WS_LIST = WS_R1, WS_PML = WS_R1 + 96 * MiB, WS_PO = WS_R1 + 108 * MiB;
constexpr size_t WS_XS = WS_R1, WS_HID = WS_R1 + 272 * MiB;
constexpr size_t WS_END = WS_R1 + 544 * MiB;
static_assert((size_t)MOE_MAXROWS * 1024 * 2 <= 272 * MiB, "moe rows");
static_assert((size_t)T * MB_H * 4 * 64 * 4 <= 384 * MiB && (size_t)24 * 64 * 16384 * 4 <= 96 * MiB, "moba bufs");
constexpr size_t TOK_E = 0, TOK_LR = 512 * 1024, TOK_W = 1024 * 1024, TOK_ROW = 1536 * 1024, TOK_BLKCNT = 2048 * 1024, TOK_TAB = 2048 * 1024 + 65536;
constexpr int CW_BAR = 4096, CW_GCOUNT = 8192;

constexpr int RING_BYTES = 131072, LDS_BYTES = 147456, MISC_OFF = LDS_BYTES - 1024;

#define GAS __attribute__((address_space(1)))
#define LAS __attribute__((address_space(3)))
typedef unsigned short bf16;
typedef unsigned v4u __attribute__((ext_vector_type(4)));
typedef unsigned v2u __attribute__((ext_vector_type(2)));
typedef float f32x4 __attribute__((ext_vector_type(4)));
typedef float f32x2 __attribute__((ext_vector_type(2)));
typedef short s16x8 __attribute__((ext_vector_type(8)));
typedef float f32x16 __attribute__((ext_vector_type(16)));
typedef float f32x2_t __attribute__((ext_vector_type(2))); typedef __bf16 bf16x2_t __attribute__((ext_vector_type(2)));
__device__ __forceinline__ unsigned cvtpk(float lo, float hi) { f32x2_t v = {lo, hi}; bf16x2_t b = __builtin_convertvector(v, bf16x2_t); return __builtin_bit_cast(unsigned, b); }
#define LDS_WAIT() asm volatile("s_waitcnt lgkmcnt(0)" ::: "memory")
__device__ __forceinline__ unsigned f2bf(float f) { unsigned u = __builtin_bit_cast(unsigned, f); return (u + 0x7fffu + ((u >> 16) & 1u)) >> 16; }
__device__ __forceinline__ unsigned pk2(float lo, float hi) { return f2bf(lo) | (f2bf(hi) << 16); }
__device__ __forceinline__ float bflo(unsigned w) { return __builtin_bit_cast(float, w << 16); }
__device__ __forceinline__ float bfhi(unsigned w) { return __builtin_bit_cast(float, w & 0xffff0000u); }
__device__ __forceinline__ float bf2f(bf16 h) { return __builtin_bit_cast(float, (unsigned)h << 16); }
__device__ __forceinline__ float sigmoidf_(float z) { return __builtin_amdgcn_rcpf(1.0f + __builtin_amdgcn_exp2f(-1.4426950408889634f * z)); }
template <int X> __device__ __forceinline__ float xorf(float v) { return __builtin_bit_cast(float, __builtin_amdgcn_ds_swizzle(__builtin_bit_cast(int, v), (X << 10) | 0x1F)); }
template <int X> __device__ __forceinline__ int xori(int v) { return __builtin_amdgcn_ds_swizzle(v, (X << 10) | 0x1F); }
__device__ __forceinline__ float wave_sum(float v) {
    v += xorf<1>(v); v += xorf<2>(v); v += xorf<4>(v); v += xorf<8>(v); v += xorf<16>(v);
    return __builtin_bit_cast(float, __builtin_amdgcn_readlane(__builtin_bit_cast(int, v), 0)) + __builtin_bit_cast(float, __builtin_amdgcn_readlane(__builtin_bit_cast(int, v), 32));
}
__device__ __forceinline__ float wave_max(float v) {
    v = fmaxf(v, xorf<1>(v)); v = fmaxf(v, xorf<2>(v)); v = fmaxf(v, xorf<4>(v)); v = fmaxf(v, xorf<8>(v)); v = fmaxf(v, xorf<16>(v));
    return fmaxf(__builtin_bit_cast(float, __builtin_amdgcn_readlane(__builtin_bit_cast(int, v), 0)), __builtin_bit_cast(float, __builtin_amdgcn_readlane(__builtin_bit_cast(int, v), 32)));
}
__device__ __forceinline__ float xor32f(float v, int lane) { return __builtin_bit_cast(float, __builtin_amdgcn_ds_bpermute((lane ^ 32) << 2, __builtin_bit_cast(int, v))); }
#define XB_TMO      128
#define XB_XCNT(j)  (256  + 64 * (j))
#define XB_XSUB(j)  (1280 + 64 * (j))
#define XB_XGEN(j)  (2304 + 64 * (j))
#define XB_TOP      3328
#define XB_TOPGEN   3392
#define XCD_BAR_WORDS 3456
#define XB_SPIN_CAP (1u << 18)

__device__ __forceinline__ unsigned xb_ld(unsigned* p)              { return __hip_atomic_load(p, __ATOMIC_RELAXED, __HIP_MEMORY_SCOPE_AGENT); }
__device__ __forceinline__ unsigned xb_add(unsigned* p, unsigned v) { return __hip_atomic_fetch_add(p, v, __ATOMIC_RELAXED, __HIP_MEMORY_SCOPE_AGENT); }
__device__ __forceinline__ unsigned xb_xcc_id() { return (unsigned)__builtin_amdgcn_s_getreg((3 << 11) | 20) & 0xFu; }
#define XB_SPIN(cond, bar) do { unsigned _sp = 0; while (cond) { __builtin_amdgcn_s_sleep(1); \
    if ((++_sp & 255u) == 0u) { if (xb_ld(&(bar)[XB_TMO])) break; if (_sp > XB_SPIN_CAP) { atomicAdd(&(bar)[XB_TMO], 1u); break; } } } } while (0)

struct XcdBarrier {
    unsigned* bar; unsigned x;
    volatile LAS unsigned* st;
};

__device__ __forceinline__ XcdBarrier xcd_barrier_post(unsigned* bar, volatile LAS unsigned* st) {
    XcdBarrier b; b.bar = bar; b.x = xb_xcc_id(); b.st = st;
    if (threadIdx.x == 0) (void)xb_add(&bar[XB_XCNT(b.x)], 1u);
    return b;
}
__device__ __forceinline__ void xcd_barrier_complete(unsigned* bar, unsigned x, unsigned& nloc, unsigned& nx) {
    const unsigned G = gridDim.x * gridDim.y * gridDim.z;
    unsigned sum, cnt, mine, sp = 0u;
    for (;;) {
        sum = 0u; cnt = 0u; mine = 0u;
#pragma unroll
        for (unsigned j = 0; j < 16; ++j) { const unsigned c = xb_ld(&bar[XB_XCNT(j)]); sum += c; cnt += (c > 0u) ? 1u : 0u; mine = (j == x) ? c : mine; }
        if (sum == G) break;
        __builtin_amdgcn_s_sleep(1);
        if ((++sp & 255u) == 0u) { if (xb_ld(&bar[XB_TMO])) break; if (sp > XB_SPIN_CAP) { atomicAdd(&bar[XB_TMO], 1u); break; } }
    }
    nloc = mine > 0u ? mine : 1u; nx = cnt > 0u ? cnt : 1u;
}

__device__ __forceinline__ void xcd_barrier(const XcdBarrier& b) {
    asm volatile("s_waitcnt vmcnt(0)" ::: "memory");
    __syncthreads();
    if (threadIdx.x == 0) {
        unsigned* bar = b.bar;
        __builtin_amdgcn_s_waitcnt(0);
        unsigned nloc = b.st[0], nx = b.st[1];
        if (nloc == 0u) { xcd_barrier_complete(bar, b.x, nloc, nx); b.st[0] = nloc; b.st[1] = nx; }
        const unsigned old = xb_add(&bar[XB_XSUB(b.x)], 1u);
        const unsigned gen = old / nloc;
        if (old + 1u == (gen + 1u) * nloc) {
            __builtin_amdgcn_fence(__ATOMIC_RELEASE, "agent");
            asm volatile("s_waitcnt vmcnt(0)" ::: "memory");
            const unsigned og = xb_add(&bar[XB_TOP], 1u);
            const unsigned tg = og / nx;
            if (og + 1u == (tg + 1u) * nx) xb_add(&bar[XB_TOPGEN], 1u);
            else XB_SPIN(xb_ld(&bar[XB_TOPGEN]) == tg, bar);
            __builtin_amdgcn_fence(__ATOMIC_ACQUIRE, "agent");
            xb_add(&bar[XB_XGEN(b.x)], 1u);
            asm volatile("s_waitcnt vmcnt(0)" ::: "memory");
        } else {
            XB_SPIN(xb_ld(&bar[XB_XGEN(b.x)]) == gen, bar);
            __builtin_amdgcn_fence(__ATOMIC_ACQUIRE, "agent");
            asm volatile("s_waitcnt vmcnt(0)" ::: "memory");
        }
    }
    __syncthreads();
}

__device__ __forceinline__ void cvt_rows_bf16(const float* src, bf16* dst, size_t n8, size_t gtid, size_t gthreads) {
    for (size_t i = gtid; i < n8; i += gthreads) { const f32x4 a = ((const f32x4*)src)[2 * i], b = ((const f32x4*)src)[2 * i + 1];
        v4u o; o.x = pk2(a.x, a.y); o.y = pk2(a.z, a.w); o.z = pk2(b.x, b.y); o.w = pk2(b.z, b.w); ((v4u*)dst)[i] = o; }
}
__device__ __forceinline__ void transpose_item(const float* W, int N, bf16* WT, int dst_row0, LAS float* scr, int k0, int n0, int lane) {
#pragma unroll 8
    for (int i = 0; i < 32; ++i) { const int kk = 2 * i + (lane >> 5); scr[kk * 33 + (lane & 31)] = W[(size_t)(k0 + kk) * N + n0 + (lane & 31)]; }
    LDS_WAIT(); asm volatile("" ::: "memory");
    const int c = lane & 7;
#pragma unroll
    for (int j = 0; j < 4; ++j) { const int n = (lane >> 3) + 8 * j; const LAS float* s = scr + (8 * c) * 33 + n;
        v4u o; o.x = pk2(s[0 * 33], s[1 * 33]); o.y = pk2(s[2 * 33], s[3 * 33]); o.z = pk2(s[4 * 33], s[5 * 33]); o.w = pk2(s[6 * 33], s[7 * 33]);
        *(v4u*)(WT + (size_t)(dst_row0 + n) * 1024 + k0 + 8 * c) = o; }
    LDS_WAIT(); asm volatile("" ::: "memory");
}
__device__ __forceinline__ unsigned pk4_fp8(float a, float b, float c, float d) { int w = 0; w = __builtin_amdgcn_cvt_pk_fp8_f32(a, b, w, false); w = __builtin_amdgcn_cvt_pk_fp8_f32(c, d, w, true); return (unsigned)w; }
__device__ __forceinline__ void transpose_item_f8(const float* W, int N, unsigned char* WT8, int dst_row0, LAS float* scr, int k0, int n0, int lane, float wscale) {
#pragma unroll 8
    for (int i = 0; i < 32; ++i) { const int kk = 2 * i + (lane >> 5); scr[kk * 33 + (lane & 31)] = W[(size_t)(k0 + kk) * N + n0 + (lane & 31)]; }
    LDS_WAIT(); asm volatile("" ::: "memory");
    const int c = lane & 7;
#pragma unroll
    for (int j = 0; j < 4; ++j) { const int n = (lane >> 3) + 8 * j; const LAS float* s = scr + (8 * c) * 33 + n;
        v2u o; o.x = pk4_fp8(s[0 * 33] * wscale, s[1 * 33] * wscale, s[2 * 33] * wscale, s[3 * 33] * wscale); o.y = pk4_fp8(s[4 * 33] * wscale, s[5 * 33] * wscale, s[6 * 33] * wscale, s[7 * 33] * wscale);
        *(v2u*)(WT8 + (size_t)(dst_row0 + n) * 1024 + k0 + 8 * c) = o; }
    LDS_WAIT(); asm volatile("" ::: "memory");
}
__device__ __forceinline__ void phase_weights(LAS float* scr, int gw, int ngw, int lane, const float* win_src, int NC, const float* wkv_src, int nkv, const float* wo_src,
                                              const float* wg_src, const float* wu_src, const float* wd_src, bf16* win_t, bf16* wkv_t, bf16* wo_t, bf16* wgu_t, bf16* wd_t) {
    const int nbw = NC / 32, nWin = nbw * 16, NIT = nWin + 256 * nkv + 512 + NE * 1536;
    for (int it = gw; it < NIT; it += ngw) {
        int r = it;
        if (r < nWin) { const int kb = r / nbw, nb = r - kb * nbw; transpose_item(win_src, NC, win_t, 32 * nb, scr, 64 * kb, 32 * nb, lane); continue; } r -= nWin;
        if (r < 256 * nkv) { const int lay = r >> 8, rr = r & 255, kb = rr >> 4, nb = rr & 15; transpose_item(wkv_src + (size_t)lay * D * 512, 512, wkv_t + (size_t)lay * 512 * 1024, 32 * nb, scr, 64 * kb, 32 * nb, lane); continue; } r -= 256 * nkv;
        if (r < 512) { const int kb = r >> 5, nb = r & 31; transpose_item(wo_src, 1024, wo_t, 32 * nb, scr, 64 * kb, 32 * nb, lane); continue; } r -= 512;
        const int e = r / 1536, q = r - e * 1536, which = q >> 9, rr = q & 511, kb = rr >> 5, nb = rr & 31, n0 = 32 * nb;
        const size_t eoff = (size_t)e * 1024 * 1024;
        if (which == 0) transpose_item_f8(wg_src + eoff, 1024, (unsigned char*)wgu_t + 2 * eoff, (n0 >> 7) * 256 + (n0 & 127), scr, 64 * kb, n0, lane, 32.f);
        else if (which == 1) transpose_item_f8(wu_src + eoff, 1024, (unsigned char*)wgu_t + 2 * eoff, (n0 >> 7) * 256 + 128 + (n0 & 127), scr, 64 * kb, n0, lane, 32.f);
        else transpose_item_f8(wd_src + eoff, 1024, (unsigned char*)wd_t + eoff, n0, scr, 64 * kb, n0, lane, 64.f);
    }
}

template <bool OUT>
__device__ __forceinline__ void hgrn_seg(LAS unsigned char* lds, const bf16* h, const float* lbl, int j, const float* normg, float* Sloc, float* Dseg, bf16* mix, int unit, int tid, int wave, int lane) {
    const int seg = unit & (HNSEG - 1), bh = unit >> 6, hh = bh % HG_H, b = bh / HG_H;
    const int v = tid & 127, dg = tid >> 7;
    LAS float* fgs = (LAS float*)lds; LAS float* vs = fgs + 4096; LAS float* qs = vs + 4096; LAS float* op = qs + 4096;
    f32x2 st[16];
    float* Sp = Sloc + (size_t)unit * 16384 + (size_t)(dg * 32) * 128 + v;
#pragma unroll
    for (int dd = 0; dd < 16; ++dd) { st[dd].x = OUT ? Sp[(2 * dd) * 128] : 0.f; st[dd].y = OUT ? Sp[(2 * dd + 1) * 128] : 0.f; }
    float dprod = 1.f;
    const int stok = tid >> 4, c8 = (tid & 15) * 8;
    float lb[8];
#pragma unroll
    for (int i = 0; i < 8; ++i) { lb[i] = 0.f; if (j > 0) { const float a0 = lbl[hh * 128 + c8 + i], a1 = lbl[MIXW + hh * 128 + c8 + i]; lb[i] = 1.f / (1.f + __expf(a0 - a1)); } }
    for (int ch = 0; ch < HSEG / 32; ++ch) {
        const size_t t0 = (size_t)b * SEQ + seg * HSEG + ch * 32;
        { const bf16* row = h + (t0 + stok) * NC_H + hh * 128 + c8;
          const v4u f8 = *(const v4u*)(row + 768), i8 = *(const v4u*)(row + 1536); v4u q8 = {0u, 0u, 0u, 0u}; if (OUT) q8 = *(const v4u*)row;
#pragma unroll
          for (int w = 0; w < 4; ++w) { const float f0 = bflo(f8[w]), f1 = bfhi(f8[w]); const int o = stok * 128 + c8 + 2 * w;
              fgs[o] = lb[2 * w] + (1.f - lb[2 * w]) * sigmoidf_(f0); fgs[o + 1] = lb[2 * w + 1] + (1.f - lb[2 * w + 1]) * sigmoidf_(f1);
              vs[o] = bflo(i8[w]); vs[o + 1] = bfhi(i8[w]);
              if (OUT) { const float q0 = bflo(q8[w]), q1 = bfhi(q8[w]); qs[o] = q0 * sigmoidf_(q0); qs[o + 1] = q1 * sigmoidf_(q1); } } }
        __syncthreads();
        if (!OUT) { if (tid < 128) { for (int tt = 0; tt < 32; ++tt) dprod *= fgs[tt * 128 + tid]; } }
        f32x4 fA[8], qA[8], fB[8], qB[8]; float vA, vB;
#define HG_LOAD(F, Q, V, tt_) do { V = vs[(tt_) * 128 + v]; _Pragma("unroll") for (int d4 = 0; d4 < 8; ++d4) { F[d4] = *(const LAS f32x4*)(fgs + (tt_) * 128 + dg * 32 + d4 * 4); \
            if (OUT) Q[d4] = *(const LAS f32x4*)(qs + (tt_) * 128 + dg * 32 + d4 * 4); } } while (0)
#define HG_STEP(F, Q, V, tt_) do { const f32x2 vv2 = {V, V}; f32x2 acc2 = {0.f, 0.f}; _Pragma("unroll") for (int d4 = 0; d4 < 8; ++d4) { \
            const f32x2 fa = {F[d4].x, F[d4].y}, fb = {F[d4].z, F[d4].w}; \
            st[2 * d4] = fa * (st[2 * d4] - vv2) + vv2; st[2 * d4 + 1] = fb * (st[2 * d4 + 1] - vv2) + vv2; \
            if (OUT) { const f32x2 qa = {Q[d4].x, Q[d4].y}, qb = {Q[d4].z, Q[d4].w}; acc2 = qa * st[2 * d4] + acc2; acc2 = qb * st[2 * d4 + 1] + acc2; } } \
            if (OUT) op[(dg * 32 + (tt_)) * 128 + v] = acc2.x + acc2.y; } while (0)
        HG_LOAD(fA, qA, vA, 0);
#pragma unroll 1
        for (int tt = 0; tt < 32; tt += 2) {
            HG_LOAD(fB, qB, vB, tt + 1);
            __builtin_amdgcn_sched_barrier(0);
            HG_STEP(fA, qA, vA, tt);
            __builtin_amdgcn_sched_barrier(0);
            if (tt + 2 < 32) HG_LOAD(fA, qA, vA, tt + 2);
            __builtin_amdgcn_sched_barrier(0);
            HG_STEP(fB, qB, vB, tt + 1);
            __builtin_amdgcn_sched_barrier(0);
        }
#undef HG_LOAD
#undef HG_STEP
        if (OUT) {
            __syncthreads();
#pragma unroll
            for (int k = 0; k < 4; ++k) { const int tt = wave + 8 * k; float o0 = 0.f, o1 = 0.f;
#pragma unroll
                for (int g = 0; g < 4; ++g) { o0 += op[(g * 32 + tt) * 128 + lane]; o1 += op[(g * 32 + tt) * 128 + lane + 64]; }
                const float ms = wave_sum(o0 * o0 + o1 * o1) * (1.f / 128.f), r = 1.f / sqrtf(ms + 1e-6f);
                const bf16* grow = h + (t0 + tt) * NC_H + 2304 + hh * 128; const float g0 = bf2f(grow[lane]), g1 = bf2f(grow[lane + 64]);
                bf16* mrow = mix + (t0 + tt) * 1024 + hh * 128;
                mrow[lane] = (bf16)f2bf(o0 * r * normg[lane] * sigmoidf_(g0)); mrow[lane + 64] = (bf16)f2bf(o1 * r * normg[lane + 64] * sigmoidf_(g1)); }
        }
        __syncthreads();
    }
    if (!OUT) {
#pragma unroll
        for (int dd = 0; dd < 16; ++dd) { Sp[(2 * dd) * 128] = st[dd].x; Sp[(2 * dd + 1) * 128] = st[dd].y; }
        if (tid < 128) Dseg[(size_t)unit * 128 + tid] = dprod;
    }
}
constexpr int HG_G = 0, HG_QT = 32768, HG_KT = 50176, HG_KE = 67584, HG_VT = 86016, HG_ST = 104448, HG_GM = 139264, HG_GE = 139776, HG_PART = 140288;
static_assert(HG_PART + 2048 <= MISC_OFF, "HGRN LDS map");
__device__ __forceinline__ int crow16(int i, int hf) { return (i & 3) + 8 * (i >> 2) + 4 * hf; }
template <bool OUT>
__device__ __forceinline__ void hgrn_mfma(LAS unsigned char* lds, const bf16* h, const float* lbl, int j, const float* normg, float* Sloc, float* Dseg, bf16* mix, int unit, int tid, int wave, int lane) {
    const int seg = unit & (HNSEG - 1), bh = unit >> 6, hh = bh % HG_H, b = bh / HG_H;
    const int r = lane & 31, hf = lane >> 5, tr = wave & 1, vq = wave >> 1;
    LAS float* G = (LAS float*)(lds + HG_G); LAS float* GM = (LAS float*)(lds + HG_GM); LAS float* GE = (LAS float*)(lds + HG_GE); LAS float* PART = (LAS float*)(lds + HG_PART);
    const int stok = tid >> 3, c16 = (tid & 7) * 16, sperm = (stok & ~15) | (stok & 3) | ((stok & 4) << 1) | ((stok & 8) >> 1);
    const int cd = tid & 127, cpart = tid >> 7;
    float lb[16];
#pragma unroll
    for (int e = 0; e < 16; ++e) { lb[e] = 0.f; if (j > 0) { const float a0 = lbl[hh * 128 + c16 + e], a1 = lbl[MIXW + hh * 128 + c16 + e]; lb[e] = 1.f / (1.f + __expf(a0 - a1)); } }
    f32x16 S[2];
    float* Sp = Sloc + (size_t)unit * 16384 + 32 * vq + r;
#pragma unroll
    for (int dd = 0; dd < 2; ++dd)
#pragma unroll
        for (int i = 0; i < 16; ++i) S[dd][i] = OUT ? Sp[(32 * (2 * tr + dd) + crow16(i, hf)) * 128] : 0.f;
    float gsum = 0.f;
    float ng16[16];
#pragma unroll
    for (int e = 0; e < 16; ++e) ng16[e] = OUT ? normg[c16 + e] : 0.f;
    v4u nf8[2], ni8[2], nq8[2] = {{0u, 0u, 0u, 0u}, {0u, 0u, 0u, 0u}}, ng8[2] = {{0u, 0u, 0u, 0u}, {0u, 0u, 0u, 0u}};
#define HG_RAWLOAD(t0_) do { const bf16* row_ = h + ((t0_) + stok) * NC_H + hh * 128 + c16; nf8[0] = *(const v4u*)(row_ + 768); nf8[1] = *(const v4u*)(row_ + 776); ni8[0] = *(const v4u*)(row_ + 1536); ni8[1] = *(const v4u*)(row_ + 1544); \
        if (OUT) { nq8[0] = *(const v4u*)row_; nq8[1] = *(const v4u*)(row_ + 8); ng8[0] = *(const v4u*)(row_ + 2304); ng8[1] = *(const v4u*)(row_ + 2312); } } while (0)
    HG_RAWLOAD((size_t)b * SEQ + seg * HSEG);
    for (int ch = 0; ch < HSEG / 64; ++ch) {
        const size_t t0 = (size_t)b * SEQ + seg * HSEG + ch * 64;
        float fg[16], qv[16]; v4u i8[2], g8[2];
        { const v4u f8[2] = {nf8[0], nf8[1]}; i8[0] = ni8[0]; i8[1] = ni8[1]; const v4u q8[2] = {nq8[0], nq8[1]}; g8[0] = ng8[0]; g8[1] = ng8[1];
#pragma unroll
          for (int w = 0; w < 8; ++w) { const unsigned fw = f8[w >> 2][w & 3]; const float f0 = bflo(fw), f1 = bfhi(fw);
              fg[2 * w] = lb[2 * w] + (1.f - lb[2 * w]) * sigmoidf_(f0); fg[2 * w + 1] = lb[2 * w + 1] + (1.f - lb[2 * w + 1]) * sigmoidf_(f1);
              if (OUT) { const unsigned qw = q8[w >> 2][w & 3]; const float q0 = bflo(qw), q1 = bfhi(qw); qv[2 * w] = q0 * sigmoidf_(q0); qv[2 * w + 1] = q1 * sigmoidf_(q1); } else { qv[2 * w] = 0.f; qv[2 * w + 1] = 0.f; } }
#pragma unroll
          for (int e4 = 0; e4 < 4; ++e4) { f32x4 lg; lg.x = __builtin_amdgcn_logf(fg[4 * e4]); lg.y = __builtin_amdgcn_logf(fg[4 * e4 + 1]); lg.z = __builtin_amdgcn_logf(fg[4 * e4 + 2]); lg.w = __builtin_amdgcn_logf(fg[4 * e4 + 3]);
              *(LAS f32x4*)(G + stok * 128 + c16 + 4 * e4) = lg; } }
        __syncthreads();
        { float run = 0.f;
#pragma unroll
          for (int k = 0; k < 16; ++k) run += G[(16 * cpart + k) * 128 + cd];
          PART[cpart * 128 + cd] = run; }
        __syncthreads();
        { float run = 0.f;
#pragma unroll
          for (int pp = 0; pp < 3; ++pp) run += (pp < cpart) ? PART[pp * 128 + cd] : 0.f;
#pragma unroll
          for (int k = 0; k < 16; ++k) { run += G[(16 * cpart + k) * 128 + cd]; G[(16 * cpart + k) * 128 + cd] = run; }
          if (cpart == 1) GM[cd] = run;
          if (cpart == 3) { GE[cd] = run; gsum += run; } }
        __syncthreads();
        if (OUT) {
#pragma unroll
            for (int dd = 0; dd < 2; ++dd)
#pragma unroll
                for (int g4 = 0; g4 < 4; ++g4) { const int dbase = 32 * (2 * tr + dd) + 8 * g4 + 4 * hf; const f32x4 gm = *(const LAS f32x4*)(GM + dbase);
                    v2u w; w.x = cvtpk(S[dd][4 * g4] * __builtin_amdgcn_exp2f(gm.x), S[dd][4 * g4 + 1] * __builtin_amdgcn_exp2f(gm.y)); w.y = cvtpk(S[dd][4 * g4 + 2] * __builtin_amdgcn_exp2f(gm.z), S[dd][4 * g4 + 3] * __builtin_amdgcn_exp2f(gm.w));
                    *(LAS v2u*)(lds + HG_ST + (32 * vq + r) * 272 + dbase * 2) = w; }
        }
        { unsigned qt[8], kt[8];
#pragma unroll
          for (int e4 = 0; e4 < 4; ++e4) { const f32x4 gv = *(const LAS f32x4*)(G + stok * 128 + c16 + 4 * e4), gm = *(const LAS f32x4*)(GM + c16 + 4 * e4), ge = *(const LAS f32x4*)(GE + c16 + 4 * e4);
              float ke[4];
#pragma unroll
              for (int e = 0; e < 4; ++e) { const float kk = 1.f - fg[4 * e4 + e]; ke[e] = kk * __builtin_amdgcn_exp2f(ge[e] - gv[e]);
                  if (OUT) { const float a = qv[4 * e4 + e] * __builtin_amdgcn_exp2f(gv[e] - gm[e]), c = kk * __builtin_amdgcn_exp2f(gm[e] - gv[e]);
                      if (e & 1) { qt[2 * e4 + (e >> 1)] |= f2bf(a) << 16; kt[2 * e4 + (e >> 1)] |= f2bf(c) << 16; } else { qt[2 * e4 + (e >> 1)] = f2bf(a); kt[2 * e4 + (e >> 1)] = f2bf(c); } } }
#pragma unroll
              for (int e = 0; e < 4; ++e) { const int col = c16 + 4 * e4 + e;
                  *(LAS bf16*)(lds + HG_KE + col * 144 + sperm * 2) = (bf16)f2bf(ke[e]);
                  const unsigned vw = i8[e4 >> 1][(2 * e4 + (e >> 1)) & 3]; *(LAS bf16*)(lds + HG_VT + col * 144 + sperm * 2) = (bf16)((e & 1) ? (vw >> 16) : (vw & 0xffffu)); } }
          if (OUT) { *(LAS v4u*)(lds + HG_QT + stok * 272 + c16 * 2) = (v4u){qt[0], qt[1], qt[2], qt[3]}; *(LAS v4u*)(lds + HG_QT + stok * 272 + c16 * 2 + 16) = (v4u){qt[4], qt[5], qt[6], qt[7]};
                     *(LAS v4u*)(lds + HG_KT + stok * 272 + c16 * 2) = (v4u){kt[0], kt[1], kt[2], kt[3]}; *(LAS v4u*)(lds + HG_KT + stok * 272 + c16 * 2 + 16) = (v4u){kt[4], kt[5], kt[6], kt[7]}; } }
        __syncthreads();
        if (ch + 1 < HSEG / 64) HG_RAWLOAD(t0 + 64);
        if (OUT) {
            f32x16 X0, X1, O;
#pragma unroll
            for (int i = 0; i < 16; ++i) { X0[i] = 0.f; X1[i] = 0.f; O[i] = 0.f; }
            const LAS unsigned char* qtp = lds + HG_QT + (32 * tr + r) * 272 + hf * 16;
#pragma unroll
            for (int ks = 0; ks < 8; ++ks) { const s16x8 bq = *(const LAS s16x8*)(qtp + ks * 32);
                const s16x8 a0 = *(const LAS s16x8*)(lds + HG_KT + r * 272 + hf * 16 + ks * 32); X0 = __builtin_amdgcn_mfma_f32_32x32x16_bf16(a0, bq, X0, 0, 0, 0);
                if (tr == 1) { const s16x8 a1 = *(const LAS s16x8*)(lds + HG_KT + (32 + r) * 272 + hf * 16 + ks * 32); X1 = __builtin_amdgcn_mfma_f32_32x32x16_bf16(a1, bq, X1, 0, 0, 0); } }
#pragma unroll
            for (int i = 0; i < 16; ++i) { const bool keep = crow16(i, hf) <= r; if (tr == 0) X0[i] = keep ? X0[i] : 0.f; else X1[i] = keep ? X1[i] : 0.f; }
            const LAS unsigned char* vtp = lds + HG_VT + (32 * vq + r) * 144 + hf * 16;
#pragma unroll
            for (int s2 = 0; s2 < 2; ++s2) { v4u pw; pw.x = cvtpk(X0[8 * s2], X0[8 * s2 + 1]); pw.y = cvtpk(X0[8 * s2 + 2], X0[8 * s2 + 3]); pw.z = cvtpk(X0[8 * s2 + 4], X0[8 * s2 + 5]); pw.w = cvtpk(X0[8 * s2 + 6], X0[8 * s2 + 7]);
                const s16x8 bv = *(const LAS s16x8*)(vtp + (16 * s2) * 2); O = __builtin_amdgcn_mfma_f32_32x32x16_bf16(__builtin_bit_cast(s16x8, pw), bv, O, 0, 0, 0); }
            if (tr == 1) {
#pragma unroll
                for (int s2 = 0; s2 < 2; ++s2) { v4u pw; pw.x = cvtpk(X1[8 * s2], X1[8 * s2 + 1]); pw.y = cvtpk(X1[8 * s2 + 2], X1[8 * s2 + 3]); pw.z = cvtpk(X1[8 * s2 + 4], X1[8 * s2 + 5]); pw.w = cvtpk(X1[8 * s2 + 6], X1[8 * s2 + 7]);
                    const s16x8 bv = *(const LAS s16x8*)(vtp + (32 + 16 * s2) * 2); O = __builtin_amdgcn_mfma_f32_32x32x16_bf16(__builtin_bit_cast(s16x8, pw), bv, O, 0, 0, 0); } }
            const LAS unsigned char* stp = lds + HG_ST + (32 * vq + r) * 272 + hf * 16;
#pragma unroll
            for (int ks = 0; ks < 8; ++ks) { const s16x8 aq = *(const LAS s16x8*)(qtp + ks * 32), bs = *(const LAS s16x8*)(stp + ks * 32); O = __builtin_amdgcn_mfma_f32_32x32x16_bf16(aq, bs, O, 0, 0, 0); }
#pragma unroll
            for (int i = 0; i < 16; ++i) G[(32 * tr + crow16(i, hf)) * 128 + 32 * vq + r] = O[i];
        }
#pragma unroll
        for (int dd = 0; dd < 2; ++dd) { const int dr = 2 * tr + dd;
#pragma unroll
            for (int g4 = 0; g4 < 4; ++g4) { const f32x4 ge = *(const LAS f32x4*)(GE + 32 * dr + 8 * g4 + 4 * hf);
                S[dd][4 * g4] *= __builtin_amdgcn_exp2f(ge.x); S[dd][4 * g4 + 1] *= __builtin_amdgcn_exp2f(ge.y); S[dd][4 * g4 + 2] *= __builtin_amdgcn_exp2f(ge.z); S[dd][4 * g4 + 3] *= __builtin_amdgcn_exp2f(ge.w); }
#pragma unroll
            for (int ks = 0; ks < 4; ++ks) { const s16x8 a = *(const LAS s16x8*)(lds + HG_KE + (32 * dr + r) * 144 + hf * 16 + ks * 32), bv = *(const LAS s16x8*)(lds + HG_VT + (32 * vq + r) * 144 + hf * 16 + ks * 32);
                S[dd] = __builtin_amdgcn_mfma_f32_32x32x16_bf16(a, bv, S[dd], 0, 0, 0); } }
        __syncthreads();
        if (OUT) {
            float ov[16]; float ss = 0.f;
#pragma unroll
            for (int e4 = 0; e4 < 4; ++e4) { const f32x4 o4 = *(const LAS f32x4*)(G + stok * 128 + c16 + 4 * e4); ov[4 * e4] = o4.x; ov[4 * e4 + 1] = o4.y; ov[4 * e4 + 2] = o4.z; ov[4 * e4 + 3] = o4.w;
                ss += (o4.x * o4.x + o4.y * o4.y) + (o4.z * o4.z + o4.w * o4.w); }
            ss += xorf<1>(ss); ss += xorf<2>(ss); ss += xorf<4>(ss);
            const float rr = 1.f / sqrtf(ss * (1.f / 128.f) + 1e-6f);
            unsigned ow[8];
#pragma unroll
            for (int w = 0; w < 8; ++w) { const unsigned gw_ = g8[w >> 2][w & 3]; ow[w] = cvtpk(ov[2 * w] * rr * ng16[2 * w] * sigmoidf_(bflo(gw_)), ov[2 * w + 1] * rr * ng16[2 * w + 1] * sigmoidf_(bfhi(gw_))); }
            bf16* mrow = mix + (t0 + stok) * 1024 + hh * 128 + c16;
            *(v4u*)mrow = (v4u){ow[0], ow[1], ow[2], ow[3]}; *(v4u*)(mrow + 8) = (v4u){ow[4], ow[5], ow[6], ow[7]};
            __syncthreads();
        }
    }
#undef HG_RAWLOAD
    if (!OUT) {
#pragma unroll
        for (int dd = 0; dd < 2; ++dd)
#pragma unroll
            for (int i = 0; i < 16; ++i) Sp[(32 * (2 * tr + dd) + crow16(i, hf)) * 128] = S[dd][i];
        if (cpart == 3) Dseg[(size_t)unit * 128 + cd] = __builtin_amdgcn_exp2f(gsum);
    }
}
__device__ __forceinline__ void hgrn_scan(float* Sloc, const float* Dseg, size_t gtid, size_t gthreads) {
    for (size_t idx = gtid; idx < (size_t)NBATCH * HG_H * 16384; idx += gthreads) { const int bh = (int)(idx >> 14), e = (int)(idx & 16383), d = e >> 7; float cur = 0.f;
        float* __restrict__ sp = Sloc + (size_t)bh * HNSEG * 16384 + e; const float* __restrict__ dp = Dseg + (size_t)bh * HNSEG * 128 + d;
        for (int s0 = 0; s0 < HNSEG; s0 += 16) { float tv[16], dv[16];
#pragma unroll
            for (int k = 0; k < 16; ++k) { tv[k] = sp[(size_t)(s0 + k) * 16384]; dv[k] = dp[(s0 + k) * 128]; }
#pragma unroll
            for (int k = 0; k < 16; ++k) { sp[(size_t)(s0 + k) * 16384] = cur; cur = dv[k] * cur + tv[k]; } } }
}

template <bool MASK>
__device__ __forceinline__ void attn4(const LAS unsigned* Ks, const LAS bf16* Vs, const LAS float* qst, LAS float* pb, int lane, const int (&tq)[4], int kbase, float slope,
                                      float (&mo)[4], float (&lo)[4], float (&oo)[4]) {
    float sc[4][4];
#pragma unroll
    for (int a = 0; a < 4; ++a)
#pragma unroll
        for (int c = 0; c < 4; ++c) sc[a][c] = 0.f;
#pragma unroll 4
    for (int dd = 0; dd < 32; ++dd) {
        f32x2 qv[4];
#pragma unroll
        for (int qi = 0; qi < 4; ++qi) qv[qi] = *(const LAS f32x2*)(qst + qi * 64 + 2 * dd);
#pragma unroll
        for (int kk = 0; kk < 4; ++kk) { const unsigned kw = Ks[(lane + 64 * kk) * 33 + dd]; const float k0 = bflo(kw), k1 = bfhi(kw);
#pragma unroll
            for (int qi = 0; qi < 4; ++qi) sc[qi][kk] += qv[qi].x * k0 + qv[qi].y * k1; }
    }
#pragma unroll
    for (int qi = 0; qi < 4; ++qi) { float mx = -INFINITY;
#pragma unroll
        for (int kk = 0; kk < 4; ++kk) { const int pos = kbase + lane + 64 * kk; float lg = sc[qi][kk] * 0.125f - slope * (float)(tq[qi] - pos); if (MASK && pos > tq[qi]) lg = -INFINITY; sc[qi][kk] = lg; mx = fmaxf(mx, lg); }
        mx = wave_max(mx); float s = 0.f;
#pragma unroll
        for (int kk = 0; kk < 4; ++kk) { const float p = __builtin_amdgcn_exp2f((sc[qi][kk] - mx) * 1.4426950408889634f); pb[qi * 256 + lane + 64 * kk] = p; s += p; }
        lo[qi] = wave_sum(s); mo[qi] = mx; }
    float o[4] = {0.f, 0.f, 0.f, 0.f};
#pragma unroll 4
    for (int k4 = 0; k4 < 64; ++k4) { f32x4 p4[4];
#pragma unroll
        for (int qi = 0; qi < 4; ++qi) p4[qi] = *(const LAS f32x4*)(pb + qi * 256 + 4 * k4);
#pragma unroll
        for (int jj = 0; jj < 4; ++jj) { const float vv = bf2f(Vs[(4 * k4 + jj) * 64 + lane]);
#pragma unroll
            for (int qi = 0; qi < 4; ++qi) o[qi] += p4[qi][jj] * vv; } }
#pragma unroll
    for (int qi = 0; qi < 4; ++qi) oo[qi] = o[qi];
}
constexpr int AT_KS = 0, AT_VS = 33792, AT_WV = 66560, AT_WVB = 5120;

__device__ __forceinline__ void memattn_unit(LAS unsigned char* lds, const bf16* h, int NC, int qoff, const bf16* kv, bf16* mix, int unit, int tid, int wave, int lane) {
    const int chunk = unit & 31, bm = unit >> 5, mh = bm & 3, b = bm >> 2;
    LAS unsigned* Ks = (LAS unsigned*)(lds + AT_KS); LAS unsigned* Vs32 = (LAS unsigned*)(lds + AT_VS);
    LAS float* qst = (LAS float*)(lds + AT_WV + wave * AT_WVB); LAS float* pb = qst + 256;
    for (int i = 0; i < 16; ++i) { const int idx = tid + 512 * i, r = idx >> 5, dd = idx & 31; const unsigned* src = (const unsigned*)(kv + (size_t)(b * 256 + r) * 512 + mh * 64);
        Ks[r * 33 + dd] = src[dd]; Vs32[r * 32 + dd] = src[128 + dd]; }
    __syncthreads();
    for (int qd = 0; qd < 16; ++qd) { const size_t tg = (size_t)b * SEQ + chunk * 512 + wave * 64 + qd * 4;
#pragma unroll
        for (int qi = 0; qi < 4; ++qi) qst[qi * 64 + lane] = bf2f(h[(tg + qi) * NC + qoff + mh * 64 + lane]);
        const int tq[4] = {0, 0, 0, 0}; float m[4], l[4], o[4];
        attn4<false>(Ks, (const LAS bf16*)Vs32, qst, pb, lane, tq, 0, 0.f, m, l, o);
#pragma unroll
        for (int qi = 0; qi < 4; ++qi) mix[(tg + qi) * 1024 + MIXW + mh * 64 + lane] = (bf16)f2bf(o[qi] / l[qi]); }
    __syncthreads();
}

constexpr int AT2_K = 0, AT2_KROW = 176, AT2_V = 256 * AT2_KROW, AT2_VROW = 528, AT2_SCR = AT2_V + 64 * AT2_VROW, AT2_SCRW = 4864;
__device__ __forceinline__ void stage_kv_images(LAS unsigned char* lds, const bf16* kp, const bf16* vp, size_t row_stride, int tid) {
    v4u kx[4], vx[4];
#pragma unroll
    for (int i = 0; i < 4; ++i) { const int idx = tid + 512 * i, key = idx >> 3, c = idx & 7; kx[i] = *(const v4u*)(kp + (size_t)key * row_stride + 8 * c); vx[i] = *(const v4u*)(vp + (size_t)key * row_stride + 8 * c); }
    __builtin_amdgcn_sched_barrier(0);
#pragma unroll
    for (int i = 0; i < 4; ++i) { const int idx = tid + 512 * i, key = idx >> 3, c = idx & 7;
        *(LAS v4u*)(lds + AT2_K + key * AT2_KROW + c * 16) = kx[i];
        const int pos = (key & ~15) | (key & 3) | ((key & 4) << 1) | ((key & 8) >> 1);
        LAS bf16* vt = (LAS bf16*)(lds + AT2_V) + pos;
#pragma unroll
        for (int w = 0; w < 4; ++w) { vt[(8 * c + 2 * w) * (AT2_VROW / 2)] = (bf16)(vx[i][w] & 0xffffu); vt[(8 * c + 2 * w + 1) * (AT2_VROW / 2)] = (bf16)(vx[i][w] >> 16); } }
    if (tid < 256) { const unsigned pb = f2bf((float)tid); const v4u e0 = {pb | (pb << 16), 0u, 0u, 0u}, z = {0u, 0u, 0u, 0u};
        *(LAS v4u*)(lds + AT2_K + tid * AT2_KROW + 128) = e0; *(LAS v4u*)(lds + AT2_K + tid * AT2_KROW + 144) = z; }
}
template <bool MASK>
__device__ __forceinline__ void attn_tile32(const LAS unsigned char* lds, const s16x8 (&qf)[4], int lane, float dist0, unsigned qx, bool own, f32x16 (&o)[2], float& mrow, float& lrow) {
    const int r = lane & 31, hf = lane >> 5;
    const v4u qxv = {qx, 0u, 0u, 0u}; const s16x8 qe = __builtin_bit_cast(s16x8, qxv);
    f32x16 acc[8];
    const LAS unsigned char* kb = lds + AT2_K + r * AT2_KROW + hf * 16;
    constexpr int NKS = MASK ? 5 : 4;
    s16x8 kf[NKS];
#pragma unroll
    for (int s = 0; s < NKS; ++s) kf[s] = *(const LAS s16x8*)(kb + s * 32);
#pragma unroll
    for (int kt = 0; kt < 8; ++kt) {
#pragma unroll
        for (int i = 0; i < 16; ++i) acc[kt][i] = 0.f;
#pragma unroll
        for (int s = 0; s < NKS; ++s) { acc[kt] = __builtin_amdgcn_mfma_f32_32x32x16_bf16(kf[s], s < 4 ? qf[s < 4 ? s : 0] : qe, acc[kt], 0, 0, 0);
            if (kt + 1 < 8) kf[s] = *(const LAS s16x8*)(kb + (kt + 1) * 32 * AT2_KROW + s * 32); }
        __builtin_amdgcn_sched_barrier(0); }
    float mx = -INFINITY;
    if (MASK && own) { const float base2 = dist0 - 4.f * (float)hf;
#pragma unroll
        for (int kt = 0; kt < 8; ++kt)
#pragma unroll
            for (int i = 0; i < 16; ++i) { const float dist = base2 - (float)(32 * kt + (i & 3) + 8 * (i >> 2)); const float lg = dist < 0.f ? -INFINITY : acc[kt][i]; acc[kt][i] = lg; mx = fmaxf(mx, lg); }
    } else {
#pragma unroll
        for (int kt = 0; kt < 8; ++kt)
#pragma unroll
            for (int i = 0; i < 16; ++i) mx = fmaxf(mx, acc[kt][i]);
    }
    mx = fmaxf(mx, xor32f(mx, lane));
    float sum = 0.f;
#pragma unroll
    for (int i = 0; i < 16; ++i) { o[0][i] = 0.f; o[1][i] = 0.f; }
    const LAS unsigned char* vb = lds + AT2_V + r * AT2_VROW + hf * 16;
    s16x8 vf[4];
#pragma unroll
    for (int s2 = 0; s2 < 2; ++s2)
#pragma unroll
        for (int dt = 0; dt < 2; ++dt) vf[2 * s2 + dt] = *(const LAS s16x8*)(vb + dt * 32 * AT2_VROW + (16 * s2) * 2);
#pragma unroll
    for (int kt = 0; kt < 8; ++kt) {
#pragma unroll
        for (int i = 0; i < 16; ++i) { const float p = __builtin_amdgcn_exp2f(acc[kt][i] - mx); sum += p; acc[kt][i] = p; }
#pragma unroll
        for (int s2 = 0; s2 < 2; ++s2) { v4u pw; pw.x = cvtpk(acc[kt][8 * s2], acc[kt][8 * s2 + 1]); pw.y = cvtpk(acc[kt][8 * s2 + 2], acc[kt][8 * s2 + 3]);
            pw.z = cvtpk(acc[kt][8 * s2 + 4], acc[kt][8 * s2 + 5]); pw.w = cvtpk(acc[kt][8 * s2 + 6], acc[kt][8 * s2 + 7]); const s16x8 pf = __builtin_bit_cast(s16x8, pw);
#pragma unroll
            for (int dt = 0; dt < 2; ++dt) { o[dt] = __builtin_amdgcn_mfma_f32_32x32x16_bf16(vf[2 * s2 + dt], pf, o[dt], 0, 0, 0);
                if (kt + 1 < 8) vf[2 * s2 + dt] = *(const LAS s16x8*)(vb + dt * 32 * AT2_VROW + (32 * (kt + 1) + 16 * s2) * 2); } }
        __builtin_amdgcn_sched_barrier(0); }
    sum += xor32f(sum, lane);
    mrow = mx; lrow = sum;
}
__device__ __forceinline__ void memattn_unit2(LAS unsigned char* lds, const bf16* h, int NC, int qoff, const bf16* kv  , bf16* mix, int unit, int tid, int wave, int lane) {
    const int chunk = unit & 63, bm = unit >> 6, mh = bm & 3, b = bm >> 2, r = lane & 31, hf = lane >> 5;
    const bf16* kvrow0 = kv + (size_t)(b * 256) * 2048 + mh * 64;
    stage_kv_images(lds, kvrow0, kvrow0 + 256, 2048, tid);
    __syncthreads();
    { const size_t tg = (size_t)b * SEQ + chunk * 256 + wave * 32 + r;
        f32x16 o[2]; float m2, l; s16x8 qf[4];
#pragma unroll
        for (int s = 0; s < 4; ++s) qf[s] = *(const s16x8*)(h + tg * NC + qoff + mh * 64 + 16 * s + 8 * hf);
        attn_tile32<false>(lds, qf, lane, 0.f, 0u, false, o, m2, l);
        const float inv = 1.f / l; bf16* mp = mix + tg * 1024 + MIXW + mh * 64 + 4 * hf;
#pragma unroll
        for (int dt = 0; dt < 2; ++dt)
#pragma unroll
            for (int g = 0; g < 4; ++g) { v2u w; w.x = cvtpk(o[dt][4 * g] * inv, o[dt][4 * g + 1] * inv); w.y = cvtpk(o[dt][4 * g + 2] * inv, o[dt][4 * g + 3] * inv); *(v2u*)(mp + 32 * dt + 8 * g) = w; } }
    __syncthreads();
}
__device__ __forceinline__ void kmean_unit(LAS unsigned char* lds, const bf16* h, float* kmean, float* kmaxg, int unit, int tid, int wave) {
    const int n = unit & 63, bh = unit >> 6, hh = bh % MB_H, b = bh / MB_H, d = tid & 63, part = tid >> 6;
    LAS float* red = (LAS float*)lds;
    float s = 0.f; const bf16* p = h + ((size_t)b * SEQ + n * 256 + part * 32) * NC_M + 768 + hh * 64 + d;
    for (int i = 0; i < 32; ++i) s += bf2f(p[(size_t)i * NC_M]);
    float ss = 0.f; { const v4u* kp = (const v4u*)(h + ((size_t)b * SEQ + n * 256 + (tid >> 1)) * NC_M + 768 + hh * 64 + (tid & 1) * 32);
#pragma unroll
        for (int w = 0; w < 4; ++w) { const v4u x = kp[w]; ss += bflo(x.x) * bflo(x.x) + bfhi(x.x) * bfhi(x.x) + bflo(x.y) * bflo(x.y) + bfhi(x.y) * bfhi(x.y) + bflo(x.z) * bflo(x.z) + bfhi(x.z) * bfhi(x.z) + bflo(x.w) * bflo(x.w) + bfhi(x.w) * bfhi(x.w); } }
    ss += xorf<1>(ss); ss = wave_max(ss);
    red[part * 64 + d] = s; if ((tid & 63) == 0) red[512 + wave] = ss; __syncthreads();
    if (tid < 64) { float a = 0.f; for (int pp = 0; pp < 8; ++pp) a += red[pp * 64 + tid]; kmean[((size_t)bh * 64 + n) * 64 + tid] = a * (1.f / 256.f); }
    if (tid == 0) { float mx = 0.f; for (int w = 0; w < 8; ++w) mx = fmaxf(mx, red[512 + w]); kmaxg[bh * 64 + n] = sqrtf(mx) * 1.001f; }
    __syncthreads();
}
__device__ __forceinline__ void moba_gate_unit(LAS unsigned char* lds, const bf16* h, const float* kmean, const float* kmaxg, unsigned* gcount, int* selinfo, unsigned* list, int unit, int tid) {
    const int bh = unit >> 6, c = ((bh >> 2) & 1) ? 63 - (unit & 63) : (unit & 63), hh = bh % MB_H, b = bh / MB_H;
    LAS float* km = (LAS float*)lds; LAS int* hist = (LAS int*)(lds + 16384); LAS int* base = hist + 64;
    for (int i = tid; i < 4096; i += NTHR) km[i] = kmean[(size_t)bh * 4096 + i];
    LAS float* kmx = (LAS float*)(lds + 16384 + 512);
    if (tid < 64) { hist[tid] = 0; kmx[tid] = kmaxg[bh * 64 + tid]; }
    __syncthreads();
    int s0 = 0, s1 = 0, s2 = 0, r0 = 0, r1 = 0, r2 = 0, ns = 0; const int hb = tid >> 8, t = c * 256 + (tid & 255);
    float v0 = -INFINITY, v1 = -INFINITY, v2 = -INFINITY, qn = 0.f, lown = 0.f;
    {
        float q[64]; const v4u* qp = (const v4u*)(h + ((size_t)b * SEQ + t) * NC_M + hh * 64);
#pragma unroll
        for (int w = 0; w < 8; ++w) { const v4u x = qp[w]; q[8 * w] = bflo(x.x); q[8 * w + 1] = bfhi(x.x); q[8 * w + 2] = bflo(x.y); q[8 * w + 3] = bfhi(x.y); q[8 * w + 4] = bflo(x.z); q[8 * w + 5] = bfhi(x.z); q[8 * w + 6] = bflo(x.w); q[8 * w + 7] = bfhi(x.w); }
        { const v4u* kp = (const v4u*)(h + ((size_t)b * SEQ + t) * NC_M + 768 + hh * 64); float qq = 0.f, qk = 0.f;
#pragma unroll
          for (int w = 0; w < 8; ++w) { const v4u x = kp[w]; qk += q[8 * w] * bflo(x.x) + q[8 * w + 1] * bfhi(x.x) + q[8 * w + 2] * bflo(x.y) + q[8 * w + 3] * bfhi(x.y) + q[8 * w + 4] * bflo(x.z) + q[8 * w + 5] * bfhi(x.z) + q[8 * w + 6] * bflo(x.w) + q[8 * w + 7] * bfhi(x.w); }
#pragma unroll
          for (int d = 0; d < 64; ++d) qq += q[d] * q[d];
          qn = sqrtf(qq) * 1.001f; lown = qk; }
        for (int n = hb; n < c; n += 2) { f32x2 g2 = {0.f, 0.f};
#pragma unroll
            for (int d4 = 0; d4 < 16; ++d4) { const f32x4 k4 = *(const LAS f32x4*)(km + n * 64 + 4 * d4); const f32x2 ka_ = {k4.x, k4.y}, kb_ = {k4.z, k4.w}, qa_ = {q[4 * d4], q[4 * d4 + 1]}, qb_ = {q[4 * d4 + 2], q[4 * d4 + 3]}; g2 = qa_ * ka_ + g2; g2 = qb_ * kb_ + g2; }
            const float g = g2.x + g2.y;
            if (g > v0) { v2 = v1; s2 = s1; v1 = v0; s1 = s0; v0 = g; s0 = n; } else if (g > v1) { v2 = v1; s2 = s1; v1 = g; s1 = n; } else if (g > v2) { v2 = g; s2 = n; } }
    }
    LAS float* cv = (LAS float*)(lds + 20480); LAS int* cs = (LAS int*)(lds + 20480 + 3072);
    if (hb == 1) { cv[tid & 255] = v0; cv[256 + (tid & 255)] = v1; cv[512 + (tid & 255)] = v2; cs[tid & 255] = s0; cs[256 + (tid & 255)] = s1; cs[512 + (tid & 255)] = s2; }
    __syncthreads();
    if (tid < 256) {
#pragma unroll
        for (int k = 0; k < 3; ++k) { const float g = cv[256 * k + tid]; const int n = cs[256 * k + tid];
            if (g > v0 || (g == v0 && n < s0)) { v2 = v1; s2 = s1; v1 = v0; s1 = s0; v0 = g; s0 = n; } else if (g > v1 || (g == v1 && n < s1)) { v2 = v1; s2 = s1; v1 = g; s1 = n; } else if (g > v2 || (g == v2 && n < s2)) { v2 = g; s2 = n; } }
        ns = c < 3 ? c : 3;
        { const float slope2 = (hh < 8 ? ldexpf(1.0f, -(hh + 1)) : ldexpf(0.70710678118654752f, -(hh - 8))) * 1.4426950408889634f;
          const bool k0 = ns > 0 && (qn * kmx[s0] - slope2 * (float)(t - (s0 * 256 + 255)) - lown) > -160.f;
          const bool k1 = ns > 1 && (qn * kmx[s1] - slope2 * (float)(t - (s1 * 256 + 255)) - lown) > -160.f;
          const bool k2 = ns > 2 && (qn * kmx[s2] - slope2 * (float)(t - (s2 * 256 + 255)) - lown) > -160.f;
          ns = (k0 ? 1 : 0) | (k1 ? 2 : 0) | (k2 ? 4 : 0); }
        if (ns & 1) r0 = __hip_atomic_fetch_add(hist + s0, 1, __ATOMIC_RELAXED, __HIP_MEMORY_SCOPE_WORKGROUP);
        if (ns & 2) r1 = __hip_atomic_fetch_add(hist + s1, 1, __ATOMIC_RELAXED, __HIP_MEMORY_SCOPE_WORKGROUP);
        if (ns & 4) r2 = __hip_atomic_fetch_add(hist + s2, 1, __ATOMIC_RELAXED, __HIP_MEMORY_SCOPE_WORKGROUP);
        selinfo[((size_t)b * SEQ + t) * MB_H + hh] = ns;
    }
    __syncthreads();
    if (tid < 64) { const int hc = hist[tid]; if (hc > 0) base[tid] = (int)__hip_atomic_fetch_add(gcount + bh * 64 + tid, (unsigned)hc, __ATOMIC_RELAXED, __HIP_MEMORY_SCOPE_AGENT); }
    __syncthreads();
    if (tid < 256) { unsigned* lp = list + ((size_t)bh * 64 << 14);
        if (ns & 1) lp[((size_t)s0 << 14) + base[s0] + r0] = (unsigned)t;
        if (ns & 2) lp[((size_t)s1 << 14) + base[s1] + r1] = (unsigned)t | (1u << 14);
        if (ns & 4) lp[((size_t)s2 << 14) + base[s2] + r2] = (unsigned)t | (2u << 14); }
    __syncthreads();
}
__device__ __forceinline__ void moba_attn_item(LAS unsigned char* lds, const bf16* h, const unsigned* gcount, const unsigned* list, float* po, float* pml, int item, int tid, int wave, int lane) {
    const int n = item / 24, bh = item - n * 24, hh = bh % MB_H, b = bh / MB_H;
    LAS unsigned* Ks = (LAS unsigned*)(lds + AT_KS); LAS unsigned* Vs32 = (LAS unsigned*)(lds + AT_VS);
    LAS float* qst = (LAS float*)(lds + AT_WV + wave * AT_WVB); LAS float* pb = qst + 256;
    for (int i = 0; i < 16; ++i) { const int idx = tid + 512 * i, r = idx >> 5, dd = idx & 31; const unsigned* src = (const unsigned*)(h + ((size_t)b * SEQ + n * 256 + r) * NC_M + hh * 64);
        Ks[r * 33 + dd] = src[384 + dd]; Vs32[r * 32 + dd] = src[768 + dd]; }
    __syncthreads();
    const int cnt = (int)gcount[bh * 64 + n], total = 256 + cnt, nquads = (total + 3) >> 2;
    const float slope = hh < 8 ? ldexpf(1.0f, -(hh + 1)) : ldexpf(0.70710678118654752f, -(hh - 8));
    const unsigned* lp = list + (((size_t)bh * 64 + n) << 14);
    for (int quad = wave; quad < nquads; quad += 8) {
        int tq[4], slot[4];
#pragma unroll
        for (int qi = 0; qi < 4; ++qi) { int idx = quad * 4 + qi; idx = idx < total ? idx : total - 1;
            if (idx < 256) { tq[qi] = n * 256 + idx; slot[qi] = 3; } else { const unsigned e = lp[idx - 256]; tq[qi] = (int)(e & 16383u); slot[qi] = (int)(e >> 14); } }
#pragma unroll
        for (int qi = 0; qi < 4; ++qi) qst[qi * 64 + lane] = bf2f(h[((size_t)b * SEQ + tq[qi]) * NC_M + hh * 64 + lane]);
        float m[4], l[4], o[4];
        attn4<true>(Ks, (const LAS bf16*)Vs32, qst, pb, lane, tq, n * 256, slope, m, l, o);
#pragma unroll
        for (int qi = 0; qi < 4; ++qi) if (quad * 4 + qi < total) { const size_t pi = (((size_t)b * SEQ + tq[qi]) * MB_H + hh) * 4 + slot[qi];
            po[pi * 64 + lane] = o[qi]; if (lane == 0) { pml[pi * 2] = m[qi]; pml[pi * 2 + 1] = l[qi]; } }
    }
    __syncthreads();
}

__device__ __forceinline__ void moba_attn_item2(LAS unsigned char* lds, const bf16* h, const unsigned* gcount, const unsigned* list, bf16* po, float* pml, int item, int tid, int wave, int lane) {
    const int n = item / 24, bh = item - n * 24, hh = bh % MB_H, b = bh / MB_H, r = lane & 31, hf = lane >> 5;
    const bf16* hrow0 = h + ((size_t)b * SEQ + n * 256) * NC_M + hh * 64;
    stage_kv_images(lds, hrow0 + 768, hrow0 + 1536, NC_M, tid);
    __syncthreads();
    const int cnt = (int)gcount[bh * 64 + n], total = 256 + cnt, ntiles = (total + 31) >> 5;
    const float slope2 = (hh < 8 ? ldexpf(1.0f, -(hh + 1)) : ldexpf(0.70710678118654752f, -(hh - 8))) * 1.4426950408889634f;
    const unsigned shi = f2bf(slope2), slo = f2bf(slope2 - __builtin_bit_cast(float, shi << 16)); const unsigned qx = hf == 0 ? (shi | (slo << 16)) : 0u;
    const unsigned* lp = list + (((size_t)bh * 64 + n) << 14);
    const bf16* hq = h + (size_t)b * SEQ * NC_M + hh * 64 + 8 * hf;
#pragma unroll 1
    for (int tile = wave; tile < ntiles; tile += NWAVES) {
        int idx = tile * 32 + r; const bool valid = idx < total; idx = valid ? idx : total - 1;
        int tq, slot; if (idx < 256) { tq = n * 256 + idx; slot = 3; } else { const unsigned e = lp[idx - 256]; tq = (int)(e & 16383u); slot = (int)(e >> 14); }
        s16x8 qf[4]; { const bf16* qp = hq + (size_t)tq * NC_M;
#pragma unroll
            for (int s = 0; s < 4; ++s) qf[s] = *(const s16x8*)(qp + 16 * s); }
        f32x16 o[2]; float m2, l; const float dist0 = (float)(tq - n * 256);
        attn_tile32<true>(lds, qf, lane, dist0, qx, tile < 8, o, m2, l);
        { LAS unsigned char* sw = lds + AT2_SCR + wave * AT2_SCRW; const int pi = valid ? (int)((((size_t)b * SEQ + tq) * MB_H + hh) * 4 + slot) : -1;
#pragma unroll
          for (int dt = 0; dt < 2; ++dt)
#pragma unroll
              for (int g = 0; g < 4; ++g) { v2u w; w.x = cvtpk(o[dt][4 * g], o[dt][4 * g + 1]); w.y = cvtpk(o[dt][4 * g + 2], o[dt][4 * g + 3]); *(LAS v2u*)(sw + r * 144 + (32 * dt + 8 * g + 4 * hf) * 2) = w; }
          if (hf == 0) { *(LAS int*)(sw + 4608 + 4 * r) = pi; if (valid) { pml[(size_t)pi * 2] = m2 - slope2 * dist0; pml[(size_t)pi * 2 + 1] = l; } }
#pragma unroll
          for (int it = 0; it < 4; ++it) { const int q = 8 * it + (lane >> 3), c = lane & 7; const int pq = *(const LAS int*)(sw + 4608 + 4 * q); const v4u row = *(const LAS v4u*)(sw + q * 144 + c * 16);
              if (pq >= 0) *(v4u*)(po + (size_t)pq * 64 + c * 8) = row; } }
    }
    __syncthreads();
}
__device__ __forceinline__ void moba_combine(const bf16* __restrict__ po, const float* __restrict__ pml, const int* __restrict__ selinfo, bf16* __restrict__ mix, int gw, int ngw, int lane) {
    const int sub = lane >> 4, d4 = (lane & 15) * 4;
#pragma unroll 4
    for (int idx = gw * 4 + sub; idx < T * MB_H; idx += ngw * 4) { const int tg = idx / MB_H, hh = idx - tg * MB_H, ns = selinfo[idx]; const size_t p4 = (size_t)idx * 4;
        f32x2 ml[4]; f32x4 ov[4];
#pragma unroll
        for (int j = 0; j < 4; ++j) { ml[j] = ((const f32x2*)pml)[p4 + j]; const v2u ow = *(const v2u*)(po + (p4 + j) * 64 + d4); ov[j] = (f32x4){bflo(ow.x), bfhi(ow.x), bflo(ow.y), bfhi(ow.y)}; }
        float M = ml[3].x;
#pragma unroll
        for (int j = 0; j < 3; ++j) { const bool ok = (ns >> j) & 1; ml[j].x = ok ? ml[j].x : -INFINITY; ml[j].y = ok ? ml[j].y : 0.f; M = fmaxf(M, ml[j].x);
            ov[j].x = ok ? ov[j].x : 0.f; ov[j].y = ok ? ov[j].y : 0.f; ov[j].z = ok ? ov[j].z : 0.f; ov[j].w = ok ? ov[j].w : 0.f; }
        float den = 0.f; f32x4 num = {0.f, 0.f, 0.f, 0.f};
#pragma unroll
        for (int j = 0; j < 4; ++j) { const float w = __builtin_amdgcn_exp2f(ml[j].x - M); den += w * ml[j].y; num += ov[j] * w; }
        const float inv = 1.f / den; v2u o; o.x = pk2(num.x * inv, num.y * inv); o.y = pk2(num.z * inv, num.w * inv);
        *(v2u*)(mix + (size_t)tg * 1024 + hh * 64 + d4) = o; }
}

__device__ __forceinline__ void ln_row(f32x4 (&v)[4], const f32x4 (&gv)[4], const f32x4 (&bv)[4]) {
    float s = 0.f;
#pragma unroll
    for (int j = 0; j < 4; ++j) s += (v[j].x + v[j].y) + (v[j].z + v[j].w);
    const float mean = wave_sum(s) * (1.f / D); float s2 = 0.f;
#pragma unroll
    for (int j = 0; j < 4; ++j) { v[j] = v[j] - mean; s2 += (v[j].x * v[j].x + v[j].y * v[j].y) + (v[j].z * v[j].z + v[j].w * v[j].w); }
    const float rstd = 1.f / sqrtf(wave_sum(s2) * (1.f / D) + 1e-5f);
#pragma unroll
    for (int j = 0; j < 4; ++j) v[j] = v[j] * rstd * gv[j] + bv[j];
}
__device__ __forceinline__ void split_router_weights(const float* wr  , bf16* wrs  , size_t gtid, size_t gthreads) {
    for (size_t i = gtid; i < (size_t)DEPTH * D * NE; i += gthreads) { const int e = (int)(i & 31), d = (int)((i >> 5) & 1023), l = (int)(i >> 15);
        const float w = wr[i]; const unsigned hi = f2bf(w); const unsigned lo = f2bf(w - __builtin_bit_cast(float, hi << 16));
        wrs[(((size_t)l * 2 + 0) * NE + e) * D + d] = (bf16)hi; wrs[(((size_t)l * 2 + 1) * NE + e) * D + d] = (bf16)lo; }
}
constexpr int L1_XH = 0, L1_XL = 33024, L1_ROW = 2064, L1_PART = 66048, L1_HIST = 82432;
__device__ __forceinline__ void phase_ln1(LAS unsigned char* lds, const bf16* y, const float* g, const float* bb, const bf16* wrs  , const float* br,
                                          bf16* xbf, int* tok_e, int* tok_lr, float* tok_w, int* blk_cnt, int blk, int tid, int wave, int lane) {
    LAS float* part = (LAS float*)(lds + L1_PART);
    LAS int* hist = (LAS int*)(lds + L1_HIST);
    if (tid < 32) hist[tid] = 0;
    constexpr int TPB = T / GRID;
    const int e = lane & 31, m16 = lane & 15, quad = lane >> 4;
    s16x8 bw[4][2][2];
#pragma unroll
    for (int ks = 0; ks < 4; ++ks)
#pragma unroll
        for (int nt = 0; nt < 2; ++nt)
#pragma unroll
            for (int pp = 0; pp < 2; ++pp) bw[ks][nt][pp] = *(const s16x8*)(wrs + ((size_t)pp * NE + 16 * nt + m16) * D + wave * 128 + 32 * ks + 8 * quad);
    const float bre = br[e];
    f32x4 gv[4], bv[4];
#pragma unroll
    for (int j = 0; j < 4; ++j) { gv[j] = ((const f32x4*)g)[lane + 64 * j]; bv[j] = ((const f32x4*)bb)[lane + 64 * j]; }
    v2u xn[2][4], yn[2][4];
#pragma unroll
    for (int u = 0; u < 2; ++u) { const size_t t0 = (size_t)blk * TPB + 2 * wave + u; const v2u* xr = (const v2u*)(xbf + t0 * D) + lane; const v2u* yr = (const v2u*)(y + t0 * D) + lane;
#pragma unroll
        for (int j = 0; j < 4; ++j) { xn[u][j] = xr[64 * j]; yn[u][j] = yr[64 * j]; } }
    __syncthreads();
    for (int grp = 0; grp < TPB / 16; ++grp) { const size_t tg0 = (size_t)blk * TPB + grp * 16 + 2 * wave;
        f32x4 v[2][4];
#pragma unroll
        for (int u = 0; u < 2; ++u)
#pragma unroll
            for (int j = 0; j < 4; ++j) { const v2u xw = xn[u][j]; const v2u yw = yn[u][j];
                v[u][j].x = DN_ALPHA * bflo(xw.x) + bflo(yw.x); v[u][j].y = DN_ALPHA * bfhi(xw.x) + bfhi(yw.x); v[u][j].z = DN_ALPHA * bflo(xw.y) + bflo(yw.y); v[u][j].w = DN_ALPHA * bfhi(xw.y) + bfhi(yw.y); }
        if (grp + 1 < TPB / 16) {
#pragma unroll
            for (int u = 0; u < 2; ++u) { const v2u* xr = (const v2u*)(xbf + (tg0 + 16 + u) * D) + lane; const v2u* yr = (const v2u*)(y + (tg0 + 16 + u) * D) + lane;
#pragma unroll
                for (int j = 0; j < 4; ++j) { xn[u][j] = xr[64 * j]; yn[u][j] = yr[64 * j]; } } }
#pragma unroll
        for (int u = 0; u < 2; ++u) { ln_row(v[u], gv, bv);
            v2u* xb = (v2u*)(xbf + (tg0 + u) * D) + lane;
#pragma unroll
            for (int j = 0; j < 4; ++j) { v2u hw; hw.x = cvtpk(v[u][j].x, v[u][j].y); hw.y = cvtpk(v[u][j].z, v[u][j].w); xb[64 * j] = hw;
                v2u lw; lw.x = cvtpk(v[u][j].x - bflo(hw.x), v[u][j].y - bfhi(hw.x)); lw.y = cvtpk(v[u][j].z - bflo(hw.y), v[u][j].w - bfhi(hw.y));
                *(LAS v2u*)(lds + L1_XH + (2 * wave + u) * L1_ROW + (4 * lane + 256 * j) * 2) = hw; *(LAS v2u*)(lds + L1_XL + (2 * wave + u) * L1_ROW + (4 * lane + 256 * j) * 2) = lw; } }
        __syncthreads();
        { f32x4 acc[2] = {{0.f, 0.f, 0.f, 0.f}, {0.f, 0.f, 0.f, 0.f}};
#pragma unroll
          for (int ks = 0; ks < 4; ++ks) { const int off = m16 * L1_ROW + (wave * 128 + 32 * ks + 8 * quad) * 2;
              const s16x8 ah = *(const LAS s16x8*)(lds + L1_XH + off), al = *(const LAS s16x8*)(lds + L1_XL + off);
#pragma unroll
              for (int nt = 0; nt < 2; ++nt) { acc[nt] = __builtin_amdgcn_mfma_f32_16x16x32_bf16(ah, bw[ks][nt][0], acc[nt], 0, 0, 0); acc[nt] = __builtin_amdgcn_mfma_f32_16x16x32_bf16(ah, bw[ks][nt][1], acc[nt], 0, 0, 0);
                  acc[nt] = __builtin_amdgcn_mfma_f32_16x16x32_bf16(al, bw[ks][nt][0], acc[nt], 0, 0, 0); } }
#pragma unroll
          for (int nt = 0; nt < 2; ++nt)
#pragma unroll
              for (int jj = 0; jj < 4; ++jj) part[(wave * 16 + 4 * quad + jj) * 32 + 16 * nt + m16] = acc[nt][jj]; }
        __syncthreads();
#pragma unroll
        for (int u = 0; u < 2; ++u) { const size_t t = tg0 + u;
            float logit = bre;
#pragma unroll
            for (int w = 0; w < 8; ++w) logit += part[(w * 16 + 2 * wave + u) * 32 + e];
            int rank = 0;
#pragma unroll
            for (int q = 0; q < 32; ++q) { const float oq = __builtin_bit_cast(float, __builtin_amdgcn_readlane(__builtin_bit_cast(int, logit), q)); rank += (oq > logit || (oq == logit && q < e)) ? 1 : 0; }
            int se[4]; float sv[4];
#pragma unroll
            for (int k = 0; k < 4; ++k) { const unsigned long long mk = __ballot(rank == k && lane < 32); const int src = __builtin_ctzll(mk);
                se[k] = src; sv[k] = __builtin_bit_cast(float, __builtin_amdgcn_readlane(__builtin_bit_cast(int, logit), src)); }
            const float e1 = __expf(sv[1] - sv[0]), e2 = __expf(sv[2] - sv[0]), e3 = __expf(sv[3] - sv[0]), inv = 1.f / (1.f + e1 + e2 + e3);
            const float wk[4] = {inv, e1 * inv, e2 * inv, e3 * inv};
            if (lane == 0) {
#pragma unroll
                for (int k = 0; k < 4; ++k) { const int lr = __hip_atomic_fetch_add(hist + se[k], 1, __ATOMIC_RELAXED, __HIP_MEMORY_SCOPE_WORKGROUP);
                    tok_e[t * 4 + k] = se[k]; tok_lr[t * 4 + k] = lr; tok_w[t * 4 + k] = wk[k]; } } }
    }
    __syncthreads();
    if (tid < 32) blk_cnt[blk * 32 + tid] = hist[tid];
    __syncthreads();
}
__device__ __forceinline__ void phase_dispatch(LAS unsigned char* lds, const int* __restrict__ blk_cnt, const int* __restrict__ tok_e, const int* __restrict__ tok_lr, int* __restrict__ tok_row, int* __restrict__ tab,
                                               const bf16* __restrict__ xbf, bf16* __restrict__ xs, int blk, int tid, int wave, int lane) {
    LAS int* tot = (LAS int*)lds; LAS int* pre = tot + 32; LAS int* pst = pre + 32; LAS int* rows = pst + 64;
    if (tid < 32) { int s = 0, p = 0;
#pragma unroll 8
        for (int bb = 0; bb < GRID; ++bb) { const int c = blk_cnt[bb * 32 + tid]; p += (bb < blk) ? c : 0; s += c; } tot[tid] = s; pre[tid] = p; }
    __syncthreads();
    if (tid == 0) { int acc = 0; for (int e = 0; e < 32; ++e) { pst[e] = acc; acc += ((tot[e] + 255) >> 8) << 8; } pst[32] = acc; }
    __syncthreads();
    if (blk == 0 && tid < 33) tab[tid] = pst[tid] >> 8;
    constexpr int TPB = T / GRID;
    static_assert(TPB * 4 == NTHR, "one (token, k) pair per thread");
    { const size_t ti = (size_t)blk * TPB * 4 + tid; const int e = tok_e[ti]; const int r = pst[e] + pre[e] + tok_lr[ti]; tok_row[ti] = r; rows[tid] = r; }
    __syncthreads();
#pragma unroll 4
    for (int i = wave; i < TPB * 4; i += NWAVES) { const int r = rows[i];
        const v4u* src = (const v4u*)(xbf + ((size_t)blk * TPB + (i >> 2)) * D) + 2 * lane; const v4u a = src[0], b = src[1];
        v4u o; o.x = pk4_fp8(bflo(a.x), bfhi(a.x), bflo(a.y), bfhi(a.y)); o.y = pk4_fp8(bflo(a.z), bfhi(a.z), bflo(a.w), bfhi(a.w)); o.z = pk4_fp8(bflo(b.x), bfhi(b.x), bflo(b.y), bfhi(b.y)); o.w = pk4_fp8(bflo(b.z), bfhi(b.z), bflo(b.w), bfhi(b.w));
        ((v4u*)((unsigned char*)xs + (size_t)r * D))[lane] = o; }
    __syncthreads();
}
__device__ __forceinline__ f32x4 fp8x4_to_f32(unsigned w) {
    const f32x2 lo = __builtin_amdgcn_cvt_pk_f32_fp8((int)w, false), hi = __builtin_amdgcn_cvt_pk_f32_fp8((int)w, true); return (f32x4){lo.x, lo.y, hi.x, hi.y};
}
__device__ __forceinline__ void phase_ln2(const unsigned char* __restrict__ yrows, const int* __restrict__ tok_row, const float* __restrict__ tok_w, const float* __restrict__ g, const float* __restrict__ bb,
                                          float* __restrict__ xout, bf16* xbf, int gw, int ngw, int lane) {
    f32x4 gv[4], bv[4];
#pragma unroll
    for (int j = 0; j < 4; ++j) { gv[j] = ((const f32x4*)g)[lane + 64 * j]; bv[j] = ((const f32x4*)bb)[lane + 64 * j]; }
    constexpr int NTK = 2;
    static_assert(T % (NTK * GRID * NWAVES) == 0, "NTK tokens per wave per step");
    for (int t0 = gw; t0 < T; t0 += NTK * ngw) {
        f32x4 v[NTK][4];
#pragma unroll
        for (int u = 0; u < NTK; ++u) { const int t = t0 + u * ngw; int r[4]; float w[4];
#pragma unroll
            for (int k = 0; k < 4; ++k) { r[k] = tok_row[(size_t)t * 4 + k]; w[k] = tok_w[(size_t)t * 4 + k] * (1.f / 16.f); }
            const v2u* xr = (const v2u*)(xbf + (size_t)t * D) + lane;
#pragma unroll
            for (int j = 0; j < 4; ++j) { f32x4 f = {0.f, 0.f, 0.f, 0.f};
#pragma unroll
                for (int k = 0; k < 4; ++k) { const unsigned yw = ((const unsigned*)(yrows + (size_t)r[k] * D))[lane + 64 * j]; f += fp8x4_to_f32(yw) * w[k]; }
                const v2u xw = xr[64 * j]; v[u][j].x = DN_ALPHA * bflo(xw.x) + f.x; v[u][j].y = DN_ALPHA * bfhi(xw.x) + f.y; v[u][j].z = DN_ALPHA * bflo(xw.y) + f.z; v[u][j].w = DN_ALPHA * bfhi(xw.y) + f.w; } }
#pragma unroll
        for (int u = 0; u < NTK; ++u) { const int t = t0 + u * ngw;
            ln_row(v[u], gv, bv);
            if (xout) { f32x4* xo = (f32x4*)(xout + (size_t)t * D) + lane;
#pragma unroll
                for (int j = 0; j < 4; ++j) xo[64 * j] = v[u][j]; }
            else { v2u* xb = (v2u*)(xbf + (size_t)t * D) + lane;
#pragma unroll
                for (int j = 0; j < 4; ++j) { v2u ww; ww.x = pk2(v[u][j].x, v[u][j].y); ww.y = pk2(v[u][j].z, v[u][j].w); xb[64 * j] = ww; } } } }
}

struct Args { const float* in[20]; float* out; unsigned char* ws; int l_lo, l_hi, ph_lo, ph_hi; };
typedef const __attribute__((address_space(4))) Args* KArgsP;
#define KA_LOAD() ({ KArgsP p_ = (KArgsP)__builtin_amdgcn_kernarg_segment_ptr(); asm volatile("" : "+s"(p_)); p_; })
#ifndef PHMASK
#define PHMASK 0xFFFF
#endif
#ifndef REPEAT_MASK
#define REPEAT_MASK 0
#endif
#ifndef REPEAT_LMASK
#define REPEAT_LMASK 0xF
#endif
#define PH_BEGIN(k) _Pragma("unroll") for (int rep_ = 0; rep_ < ((((REPEAT_MASK >> (k)) & 1) && ((REPEAT_LMASK >> l) & 1)) ? 2 : 1); ++rep_) { if ((PHMASK >> (k)) & 1) { KArgsP ka = KA_LOAD(); unsigned char* ws = ka->ws; int tid = threadIdx.x; asm volatile("" : "+v"(tid)); \
    const int lane = tid & 63, wave = __builtin_amdgcn_readfirstlane(tid >> 6); int blk = blockIdx.x; asm volatile("" : "+s"(blk)); \
    const int gw = blk * NWAVES + wave; const size_t gtid = (size_t)blk * NTHR + tid; (void)lane; (void)gw; (void)gtid; (void)ws;
#if ONE_LAUNCH
#define PH_SEAM() do { XcdBarrier b_; b_.bar = (unsigned*)(KA_LOAD()->ws + WS_CTL) + CW_BAR; b_.x = xb_xcc_id(); b_.st = (volatile LAS unsigned*)(lds + MISC_OFF); xcd_barrier(b_); } while (0)
#else
#define PH_SEAM() do {} while (0)
#endif
#define PH_END() PH_SEAM(); } }
#define PH_END_NOSEAM() } }
#define WSP(type, off) ((type*)(ws + (off)))
constexpr int G = GRID, NGW = GRID * NWAVES; constexpr size_t GTHREADS = (size_t)GRID * NTHR;
template <int L> __device__ __forceinline__ void layer_phases(LAS unsigned char* lds) {
    constexpr int l = L; LAS int* tabL = (LAS int*)(lds + MISC_OFF + 256);

        const int j = l >> 1; const bool moba = (l & 1) != 0;
        const int NC = moba ? NC_M : NC_H, qoff = moba ? 2304 : 3072;

        if (l == 0) {
        PH_BEGIN(1)
            phase_weights((LAS float*)(lds + wave * 16384), gw, NGW, lane, ka->in[2], NC_H, ka->in[6], 4, ka->in[7], ka->in[12], ka->in[14], ka->in[16], WSP(bf16, WS_WIN), WSP(bf16, WS_WKV4), WSP(bf16, WS_WO), WSP(bf16, WS_WGU), WSP(bf16, WS_WD));
        PH_END()
        }
        PH_BEGIN(2)
            { pg8::Gemm g{WSP(bf16, WS_XBF), WSP(bf16, WS_WIN), T, NC, D, 0, 0}; pg8::StaticOrder S; S.init(T, NC, G, blk); pg8::EpiPlain E{WSP(bf16, WS_H), NC, moba ? 0x207u : 0x1000u, 0.125f * 1.4426950408889634f};
              pg8::gemm_phase<pg8::EpiPlain, pg8::StaticOrder, true, true>(lds, g, S, E); }
            if (l == 0) {
              pg8::Gemm g{WSP(bf16, WS_MEMBF), WSP(bf16, WS_WKV4), 512, 2048, D, 0, 0}; pg8::StaticOrder S; S.init(512, 2048, G, blk >= 128 ? blk - 128 : G); pg8::EpiPlain E{WSP(bf16, WS_KV4), 2048, 0u, 1.f};
              pg8::gemm_phase<pg8::EpiPlain, pg8::StaticOrder, true, true>(lds, g, S, E); }
        PH_END()
        if (!moba) {
            PH_BEGIN(3)
                for (int u = blk; u < NBATCH * HG_H * HNSEG; u += G) hgrn_mfma<false>(lds, WSP(bf16, WS_H), ka->in[3], j, ka->in[4] + j * 128, WSP(float, WS_SLOC), WSP(float, WS_DSEG), WSP(bf16, WS_MIX), u, tid, wave, lane);
                for (int u = blk; u < 512; u += G) memattn_unit2(lds, WSP(bf16, WS_H), NC, qoff, WSP(bf16, WS_KV4) + 512 * l, WSP(bf16, WS_MIX), u, tid, wave, lane);
            PH_END()
            PH_BEGIN(4)
                hgrn_scan(WSP(float, WS_SLOC), WSP(float, WS_DSEG), gtid, GTHREADS);
            PH_END()
            PH_BEGIN(5)
                for (int u = blk; u < NBATCH * HG_H * HNSEG; u += G) hgrn_mfma<true>(lds, WSP(bf16, WS_H), ka->in[3], j, ka->in[4] + j * 128, WSP(float, WS_SLOC), WSP(float, WS_DSEG), WSP(bf16, WS_MIX), u, tid, wave, lane);
            PH_END()
        } else {
            PH_BEGIN(3)
                for (int u = blk; u < 24 * MB_NB; u += G) kmean_unit(lds, WSP(bf16, WS_H), WSP(float, WS_KMEAN), WSP(float, WS_KMEAN + 512 * 1024), u, tid, wave);
                for (int u = blk; u < 512; u += G) memattn_unit2(lds, WSP(bf16, WS_H), NC, qoff, WSP(bf16, WS_KV4) + 512 * l, WSP(bf16, WS_MIX), u, tid, wave, lane);
            PH_END()
            PH_BEGIN(4)
                for (int u = blk; u < 24 * MB_NB; u += G) moba_gate_unit(lds, WSP(bf16, WS_H), WSP(float, WS_KMEAN), WSP(float, WS_KMEAN + 512 * 1024), WSP(unsigned, WS_CTL) + CW_GCOUNT + j * 1536, WSP(int, WS_SELINFO), WSP(unsigned, WS_LIST), u, tid);
            PH_END()
            PH_BEGIN(5)
                { unsigned* qhead = WSP(unsigned, WS_CTL) + CW_GCOUNT + 2 * 1536 + 64 * j; LAS int* itl = (LAS int*)(lds + MISC_OFF + 512);
                  for (;;) { if (tid == 0) *itl = (int)__hip_atomic_fetch_add(qhead, 1u, __ATOMIC_RELAXED, __HIP_MEMORY_SCOPE_AGENT);
                      __syncthreads(); const int it = *itl; __syncthreads();
                      if (it >= 24 * MB_NB) break;
                      moba_attn_item2(lds, WSP(bf16, WS_H), WSP(unsigned, WS_CTL) + CW_GCOUNT + j * 1536, WSP(unsigned, WS_LIST), WSP(bf16, WS_PO), WSP(float, WS_PML), it, tid, wave, lane); } }
            PH_END()
            PH_BEGIN(6)
                moba_combine(WSP(bf16, WS_PO), WSP(float, WS_PML), WSP(int, WS_SELINFO), WSP(bf16, WS_MIX), gw, NGW, lane);
            PH_END()
        }
        PH_BEGIN(7)
            pg8::Gemm g{WSP(bf16, WS_MIX), WSP(bf16, WS_WO), T, D, D, 0, 0}; pg8::StaticOrder S; S.init(T, D, G, blk); pg8::EpiPlain E{WSP(bf16, WS_Y), D, 0u, 1.f};
            pg8::gemm_phase<pg8::EpiPlain, pg8::StaticOrder, true, true>(lds, g, S, E);
        PH_END()
        PH_BEGIN(8)
            phase_ln1(lds, WSP(bf16, WS_Y), ka->in[8] + l * D, ka->in[9] + l * D, WSP(bf16, WS_WRS) + (size_t)l * 2 * NE * D, ka->in[11] + l * NE, WSP(bf16, WS_XBF),
                      WSP(int, WS_TOK + TOK_E), WSP(int, WS_TOK + TOK_LR), WSP(float, WS_TOK + TOK_W), WSP(int, WS_TOK + TOK_BLKCNT), blk, tid, wave, lane);
        PH_END()
        PH_BEGIN(9)
            phase_dispatch(lds, WSP(int, WS_TOK + TOK_BLKCNT), WSP(int, WS_TOK + TOK_E), WSP(int, WS_TOK + TOK_LR), WSP(int, WS_TOK + TOK_ROW), WSP(int, WS_TOK + TOK_TAB), WSP(bf16, WS_XBF), WSP(bf16, WS_XS), blk, tid, wave, lane);
        PH_END()
        PH_BEGIN(10)
            if (tid < 33) tabL[tid] = WSP(int, WS_TOK + TOK_TAB)[tid];
            __syncthreads();
            int sw_ = 0x7A7A7A7A, sx_ = 0x7F7F7F7F; asm volatile("" : "+s"(sw_), "+s"(sx_));
            pg8::Gemm g{WSP(bf16, WS_XS), WSP(bf16, WS_WGU), MOE_MAXROWS, NE * 2048, D / 2, sw_, sx_}; pg8::MoeOrder S{tabL, 8, G, blk, tabL[32] * 8};
            pg8::EpiSwiglu E{WSP(unsigned char, WS_HID), ka->in[13] + (size_t)l * NE * 1024, ka->in[15] + (size_t)l * NE * 1024};
            pg8::gemm_phase<pg8::EpiSwiglu, pg8::MoeOrder, true, true, true>(lds, g, S, E);
        PH_END()
        PH_BEGIN(11)
            if (tid < 33) tabL[tid] = WSP(int, WS_TOK + TOK_TAB)[tid];
            __syncthreads();
            int sw_ = 0x79797979, sx_ = 0x7F7F7F7F; asm volatile("" : "+s"(sw_), "+s"(sx_));
            pg8::Gemm g{WSP(bf16, WS_HID), WSP(bf16, WS_WD), MOE_MAXROWS, NE * 1024, D / 2, sw_, sx_}; pg8::MoeOrder S{tabL, 4, G, blk, tabL[32] * 4};
            pg8::EpiDown E{WSP(unsigned char, WS_XS), ka->in[17] + (size_t)l * NE * 1024};
            pg8::gemm_phase<pg8::EpiDown, pg8::MoeOrder, true, true, true>(lds, g, S, E);
        PH_END()
        PH_BEGIN(12)
            float* x2out = (l == DEPTH - 1) ? ka->out : nullptr;
            phase_ln2(WSP(unsigned char, WS_XS), WSP(int, WS_TOK + TOK_ROW), WSP(float, WS_TOK + TOK_W), ka->in[18] + l * D, ka->in[19] + l * D, x2out, WSP(bf16, WS_XBF), gw, NGW, lane);
            if (l + 1 < DEPTH) { constexpr int ln = l + 1, jn = ln >> 1; constexpr bool mn = (ln & 1) != 0;
                const float* win_src = mn ? ka->in[5] + (size_t)jn * D * NC_M : ka->in[2] + (size_t)jn * D * NC_H; const size_t moff = (size_t)ln * NE * 1024 * 1024;
                phase_weights((LAS float*)(lds + wave * 16384), gw, NGW, lane, win_src, mn ? NC_M : NC_H, ka->in[6], 0, ka->in[7] + (size_t)ln * D * D,
                              ka->in[12] + moff, ka->in[14] + moff, ka->in[16] + moff, WSP(bf16, WS_WIN), WSP(bf16, WS_WKV4), WSP(bf16, WS_WO), WSP(bf16, WS_WGU), WSP(bf16, WS_WD)); }
            if (l + 1 < DEPTH) PH_SEAM();
        PH_END_NOSEAM()
}
__global__ void __launch_bounds__(NTHR, 2) fwd_kernel(Args args) {
    extern __shared__ __attribute__((aligned(16))) unsigned char lds_raw[];
    LAS unsigned char* lds = (LAS unsigned char*)lds_raw;
    if (threadIdx.x < 4) ((LAS unsigned*)(lds + MISC_OFF))[threadIdx.x] = 0u;
    __syncthreads();
#if ONE_LAUNCH
    (void)xcd_barrier_post((unsigned*)(args.ws + WS_CTL) + CW_BAR, (volatile LAS unsigned*)(lds + MISC_OFF));
#endif
    { const int l = 0; (void)l;
    PH_BEGIN(0)
        cvt_rows_bf16(ka->in[0], WSP(bf16, WS_XBF), (size_t)T * D / 8, gtid, GTHREADS);
        cvt_rows_bf16(ka->in[1], WSP(bf16, WS_MEMBF), (size_t)512 * D / 8, gtid, GTHREADS);
        split_router_weights(ka->in[10], WSP(bf16, WS_WRS), gtid, GTHREADS);
    PH_END_NOSEAM() }
    layer_phases<0>(lds); layer_phases<1>(lds); layer_phases<2>(lds); layer_phases<3>(lds);
}

extern "C" void kernel_launch(void* const* d_in, const int* in_sizes, int n_in, void* d_out, int out_size, void* d_ws, size_t ws_size, hipStream_t stream) {
    static int ready = 0;
    if (ready == 0) {
        if (n_in != 20 || in_sizes[0] != T * D || out_size != T * D || ws_size < WS_END) { fprintf(stderr, "kernel_launch: unexpected shapes (n_in %d, in0 %d, out %d, ws %zu < %zu)\n", n_in, n_in > 0 ? in_sizes[0] : -1, out_size, ws_size, (size_t)WS_END); ready = -1; return; }
        if (hipFuncSetAttribute((const void*)fwd_kernel, hipFuncAttributeMaxDynamicSharedMemorySize, LDS_BYTES) != hipSuccess) { fprintf(stderr, "kernel_launch: hipFuncSetAttribute failed\n"); ready = -1; return; }
        int per_cu = 0;
        if (hipOccupancyMaxActiveBlocksPerMultiprocessor(&per_cu, (const void*)fwd_kernel, NTHR, LDS_BYTES) != hipSuccess || per_cu < 1) fprintf(stderr, "kernel_launch: occupancy query says %d\n", per_cu);
        (void)hipGetLastError();
        ready = 1;
    }
    if (ready < 0) return;
    if (hipMemsetAsync((char*)d_ws + WS_CTL, 0, CTL_ZERO_BYTES, stream) != hipSuccess) return;
    Args a{};
    for (int i = 0; i < 20; ++i) a.in[i] = (const float*)d_in[i];
    a.out = (float*)d_out; a.ws = (unsigned char*)d_ws;
    a.l_lo = 0; a.l_hi = DEPTH; a.ph_lo = 0; a.ph_hi = NPHASE;
    hipLaunchKernelGGL(fwd_kernel, dim3(GRID), dim3(NTHR), LDS_BYTES, stream, a);
}
```

```cpp
#include <hip/hip_runtime.h>
#include <cstdio>
#include <cstdint>
#include <cmath>
namespace pg8 {
#define PG8_LAS __attribute__((address_space(3)))
typedef unsigned short bf16_t;
typedef short bf16x8 __attribute__((ext_vector_type(8)));
typedef float f32x4 __attribute__((ext_vector_type(4)));
typedef unsigned u32x4 __attribute__((ext_vector_type(4)));
constexpr int BM = 256, BK = 64, HALF = 128, HTB = HALF * BK * 2  , STAGE_BYTES = 8 * HTB, NXCD = 8, WGM = 8;

__host__ __device__ __forceinline__ int lds_byte(int r, int c) { const int st = (r >> 4) * 2 + (c >> 5), rr = r & 15, cc = c & 31, ob = rr * 64 + cc * 2; return st * 1024 + (ob ^ (((ob >> 9) & 1) << 5)); }
__host__ __device__ __forceinline__ void stage_rc(int b, int& R, int& C) { const int st = b / 1024, sb = b % 1024, swz = sb ^ (((sb >> 9) & 1) << 5); R = (st >> 1) * 16 + swz / 64; C = (st & 1) * 32 + (swz % 64) / 2; }
__host__ __device__ __forceinline__ int perm32(int rho) { const int n = rho >> 4, i = rho & 15; return 8 * (i >> 2) + 4 * n + (i & 3); }

struct Unit { int pm, pn; };
struct Gemm { const bf16_t* A; const bf16_t* Bt; int M, N, K; int sw, sx; };
typedef int i32x8 __attribute__((ext_vector_type(8))); typedef int i32x4 __attribute__((ext_vector_type(4)));

struct StaticOrder {
    int nM, nN, nwg, G, c;
    __host__ __device__ void init(int M, int N, int G_, int c_) { nM = M / BM; nN = N / BM; nwg = nM * nN; G = G_; c = c_; }
    __host__ __device__ bool next(int i, Unit& u) const {
        const long L = (long)i * G + c; if (L >= nwg) return false;
        int wgid = (int)L; { const int q = nwg / NXCD, r = nwg % NXCD, xcd = wgid % NXCD, off = wgid / NXCD; wgid = (xcd < r ? xcd * (q + 1) : r * (q + 1) + (xcd - r) * q) + off; }
        const int nig = WGM * nN, gid = wgid / nig, fm = gid * WGM, gsz = (nM - fm) < WGM ? (nM - fm) : WGM;
        u.pm = fm + ((wgid % nig) % gsz); u.pn = (wgid % nig) / gsz; return true;
    }
    __device__ __forceinline__ void a_ready(const Unit&) const {}
    __device__ __forceinline__ void done(const Unit&) const {}
};

__device__ __forceinline__ unsigned cvt_pk_bf16(float lo, float hi) { unsigned r; asm volatile("v_cvt_pk_bf16_f32 %0, %1, %2" : "=v"(r) : "v"(lo), "v"(hi)); return r; }
typedef float f32x2 __attribute__((ext_vector_type(2)));
struct EpiPlain {
    static constexpr bool PERM = true, AFTER_DRAIN = false;
    bf16_t* O; int ldc; unsigned smask; float sc;
    struct Pre {};
    __device__ __forceinline__ void pre_load(const Unit&, int, int, Pre&) const {}
    __device__ __forceinline__ void acc_init(f32x4 (&acc)[2][2][4][2], const Pre&) const {
#pragma unroll
        for (int a = 0; a < 2; ++a)
#pragma unroll
            for (int b = 0; b < 2; ++b)
#pragma unroll
                for (int m = 0; m < 4; ++m)
#pragma unroll
                    for (int n = 0; n < 2; ++n) acc[a][b][m][n] = (f32x4){0.f, 0.f, 0.f, 0.f}; }
    __device__ __forceinline__ void operator()(const f32x4 (&acc)[2][2][4][2], const Unit& u, int wr, int wc, int fr, int fq) const {
        const int row0 = u.pm * BM + wr * 64 + fr; const int col0 = u.pn * BM + wc * 32 + 8 * fq; const float s = ((smask >> u.pn) & 1u) ? sc : 1.f;
#pragma unroll
        for (int ai = 0; ai < 2; ++ai)
#pragma unroll
            for (int m = 0; m < 4; ++m) { bf16_t* rowp = O + (size_t)(row0 + ai * HALF + m * 16) * ldc + col0;
#pragma unroll
                for (int bj = 0; bj < 2; ++bj) { const f32x4 v0 = acc[ai][bj][m][0] * s, v1 = acc[ai][bj][m][1] * s;
                    u32x4 w; w.x = cvt_pk_bf16(v0[0], v0[1]); w.y = cvt_pk_bf16(v0[2], v0[3]); w.z = cvt_pk_bf16(v1[0], v1[1]); w.w = cvt_pk_bf16(v1[2], v1[3]);
                    *(u32x4*)(rowp + bj * HALF) = w; } }
    }
};
__device__ __forceinline__ float swiglu1(float g, float u) {
    g = fminf(g, 7.0f); u = fminf(fmaxf(u, -7.0f), 7.0f);
    const float s = __builtin_amdgcn_rcpf(1.0f + __builtin_amdgcn_exp2f(g * (-1.702f * 1.4426950408889634f)));
    return g * s * (u + 1.0f);
}
__device__ __forceinline__ unsigned pk4_fp8e(float a, float b, float c, float d) { int w = 0; w = __builtin_amdgcn_cvt_pk_fp8_f32(a, b, w, false); w = __builtin_amdgcn_cvt_pk_fp8_f32(c, d, w, true); return (unsigned)w; }
struct EpiSwiglu {
    static constexpr bool PERM = true, AFTER_DRAIN = false;
    unsigned char* hid; const float* bg; const float* bu;
    struct Pre { f32x4 g0, g1, u0, u1; };
    __device__ __forceinline__ void pre_load(const Unit& u, int wc, int fq, Pre& p) const { const int e = u.pn >> 3, col0 = (u.pn & 7) * 128 + wc * 32 + 8 * fq;
        p.g0 = *(const f32x4*)(bg + e * 1024 + col0); p.g1 = *(const f32x4*)(bg + e * 1024 + col0 + 4); p.u0 = *(const f32x4*)(bu + e * 1024 + col0); p.u1 = *(const f32x4*)(bu + e * 1024 + col0 + 4); }
    __device__ __forceinline__ void acc_init(f32x4 (&acc)[2][2][4][2], const Pre& p) const {
#pragma unroll
        for (int a = 0; a < 2; ++a)
#pragma unroll
            for (int m = 0; m < 4; ++m) { acc[a][0][m][0] = p.g0; acc[a][0][m][1] = p.g1; acc[a][1][m][0] = p.u0; acc[a][1][m][1] = p.u1; } }
    __device__ __forceinline__ void operator()(const f32x4 (&acc)[2][2][4][2], const Unit& u, int wr, int wc, int fr, int fq) const {
        const int pn = u.pn & 7;
        const int row0 = u.pm * BM + wr * 64 + fr; const int col0 = pn * 128 + wc * 32 + 8 * fq;
#pragma unroll
        for (int ai = 0; ai < 2; ++ai)
#pragma unroll
            for (int m = 0; m < 4; ++m) { unsigned char* rowp = hid + (size_t)(row0 + ai * HALF + m * 16) * 1024 + col0;
                const f32x4 ga = acc[ai][0][m][0], gb = acc[ai][0][m][1], ua = acc[ai][1][m][0], ub = acc[ai][1][m][1];
                typedef unsigned u32x2 __attribute__((ext_vector_type(2))); u32x2 w;
                w.x = pk4_fp8e(swiglu1(ga[0], ua[0]), swiglu1(ga[1], ua[1]), swiglu1(ga[2], ua[2]), swiglu1(ga[3], ua[3]));
                w.y = pk4_fp8e(swiglu1(gb[0], ub[0]), swiglu1(gb[1], ub[1]), swiglu1(gb[2], ub[2]), swiglu1(gb[3], ub[3]));
                *(u32x2*)rowp = w; }
    }
};
struct EpiDown {
    static constexpr bool PERM = true, AFTER_DRAIN = false;
    unsigned char* y; const float* bd;
    struct Pre { f32x4 b[2][2]; };
    __device__ __forceinline__ void pre_load(const Unit& u, int wc, int fq, Pre& p) const { const int e = u.pn >> 2, col0 = (u.pn & 3) * BM + wc * 32 + 8 * fq;
#pragma unroll
        for (int bj = 0; bj < 2; ++bj)
#pragma unroll
            for (int n = 0; n < 2; ++n) p.b[bj][n] = *(const f32x4*)(bd + e * 1024 + col0 + bj * HALF + 4 * n); }
    __device__ __forceinline__ void acc_init(f32x4 (&acc)[2][2][4][2], const Pre& p) const {
#pragma unroll
        for (int a = 0; a < 2; ++a)
#pragma unroll
            for (int bj = 0; bj < 2; ++bj)
#pragma unroll
                for (int m = 0; m < 4; ++m) { acc[a][bj][m][0] = p.b[bj][0]; acc[a][bj][m][1] = p.b[bj][1]; } }
    __device__ __forceinline__ void operator()(const f32x4 (&acc)[2][2][4][2], const Unit& u, int wr, int wc, int fr, int fq) const {
        const int pn = u.pn & 3;
        const int row0 = u.pm * BM + wr * 64 + fr; const int col0 = pn * BM + wc * 32 + 8 * fq;
#pragma unroll
        for (int ai = 0; ai < 2; ++ai)
#pragma unroll
            for (int m = 0; m < 4; ++m) { unsigned char* rowp = y + (size_t)(row0 + ai * HALF + m * 16) * 1024 + col0;
#pragma unroll
                for (int bj = 0; bj < 2; ++bj) { const f32x4 v0 = acc[ai][bj][m][0] * 16.f, v1 = acc[ai][bj][m][1] * 16.f;
                    typedef unsigned u32x2 __attribute__((ext_vector_type(2))); u32x2 w; w.x = pk4_fp8e(v0[0], v0[1], v0[2], v0[3]); w.y = pk4_fp8e(v1[0], v1[1], v1[2], v1[3]);
                    *(u32x2*)(rowp + bj * HALF) = w; } }
    }
};
struct MoeOrder {
    const PG8_LAS int* tab; int npn, G, c, nunits;
    __device__ __forceinline__ bool next(int i, Unit& u) const {
        const int tpx = 32 / npn, s = c >> 3, tile = (i * 8 + (c & 7)) * tpx + s / npn, pn = s % npn;
        if ((i * 8) * tpx >= nunits / npn) return false;
        if (tile >= nunits / npn) { u.pm = 0; u.pn = 0; return false; }
        int e = 0;
#pragma unroll
        for (int k = 1; k < 32; ++k) e += (tab[k] <= tile) ? 1 : 0;
        u.pm = tile; u.pn = __builtin_amdgcn_readfirstlane(e) * npn + pn; return true;
    }
    __device__ __forceinline__ void a_ready(const Unit&) const {}
    __device__ __forceinline__ void done(const Unit&) const {}
};
template <class Epi, class Sched, bool ALIGN_EPI = false, bool SP2 = false, bool F8 = false>
__device__ __forceinline__ void gemm_phase(PG8_LAS unsigned char* lds, const Gemm g, const Sched& S, const Epi& E) {
    int tid_ = threadIdx.x; asm volatile("" : "+v"(tid_));
    const int tid = tid_, wid = __builtin_amdgcn_readfirstlane(tid >> 6), lane = tid & 63, wr = wid >> 2, wc = wid & 3, fr = lane & 15, fq = lane >> 4;
    const int K = g.K, nt = K / BK;
    unsigned voffA, voffB;
    { int R, C; stage_rc(tid * 16, R, C); const int Rb = Epi::PERM ? ((R & ~31) + perm32(R & 31)) : R; voffA = (unsigned)(R * K + C) * 2u; voffB = (unsigned)(Rb * K + C) * 2u; }
    const unsigned qstep = 64u * (unsigned)K * 2u;
    const unsigned kstep = (unsigned)(BK * 2);
    const unsigned hstep = (unsigned)HALF * (unsigned)K * 2u;
    const unsigned tstep = 2u * hstep;
    const __amdgpu_buffer_rsrc_t rA = __builtin_amdgcn_make_buffer_rsrc((void*)g.A, 0, 0x7FFFFFFF, 0x00020000), rB = __builtin_amdgcn_make_buffer_rsrc((void*)g.Bt, 0, 0x7FFFFFFF, 0x00020000);
    const unsigned ldsw = (unsigned)wid * 1024u;
    const int aoff = lds_byte(wr * 64 + fr, fq * 8), boff = lds_byte(wc * 32 + fr, fq * 8);
#define PG8_SA(b, h) (((b) * 2 + (h)) * HTB)
#define PG8_SB(b, h) ((4 + (b) * 2 + (h)) * HTB)
#define PG8_STG(bufoff, rsrc, soff, voff) do { _Pragma("unroll") for (int _i = 0; _i < 2; ++_i) \
        __builtin_amdgcn_raw_ptr_buffer_load_lds((rsrc), (PG8_LAS void*)(lds + (bufoff) + ldsw + _i * 8192), 16, (int)(voff), (int)((soff) + (unsigned)_i * qstep), 0, 0); } while (0)
#define PG8_STGA(bufoff, soff) PG8_STG(bufoff, rA, soff, voffA)
#define PG8_STGB(bufoff, soff) PG8_STG(bufoff, rB, soff, voffB)
#define PG8_LDA(dst, b, h) do { _Pragma("unroll") for (int m = 0; m < 4; ++m) { if constexpr (F8) { const i32x4 lo_ = *(const PG8_LAS i32x4*)(lds + PG8_SA(b, h) + aoff + m * 2048), hi_ = *(const PG8_LAS i32x4*)(lds + PG8_SA(b, h) + aoff + m * 2048 + 1024); \
            dst##_8[m] = __builtin_shufflevector(lo_, hi_, 0, 1, 2, 3, 4, 5, 6, 7); } else { _Pragma("unroll") for (int k = 0; k < 2; ++k) dst[m][k] = *(const PG8_LAS bf16x8*)(lds + PG8_SA(b, h) + aoff + m * 2048 + k * 1024); } } } while (0)
#define PG8_LDB(dst, b, h) do { _Pragma("unroll") for (int n = 0; n < 2; ++n) { if constexpr (F8) { const i32x4 lo_ = *(const PG8_LAS i32x4*)(lds + PG8_SB(b, h) + boff + n * 2048), hi_ = *(const PG8_LAS i32x4*)(lds + PG8_SB(b, h) + boff + n * 2048 + 1024); \
            dst##_8[n] = __builtin_shufflevector(lo_, hi_, 0, 1, 2, 3, 4, 5, 6, 7); } else { _Pragma("unroll") for (int k = 0; k < 2; ++k) dst[n][k] = *(const PG8_LAS bf16x8*)(lds + PG8_SB(b, h) + boff + n * 2048 + k * 1024); } } } while (0)
#define PG8_MMA(ai, bj, At, Bt) do { __builtin_amdgcn_s_setprio(1); _Pragma("unroll") for (int m = 0; m < 4; ++m) _Pragma("unroll") for (int n = 0; n < 2; ++n) { \
        if constexpr (F8) acc[ai][bj][m][n] = __builtin_amdgcn_mfma_scale_f32_16x16x128_f8f6f4(Bt##_8[n], At##_8[m], acc[ai][bj][m][n], 0, 0, 0, g.sw, 0, g.sx); \
        else { _Pragma("unroll") for (int k = 0; k < 2; ++k) acc[ai][bj][m][n] = __builtin_amdgcn_mfma_f32_16x16x32_bf16(Bt[n][k], At[m][k], acc[ai][bj][m][n], 0, 0, 0); } } \
        __builtin_amdgcn_s_setprio(0); } while (0)
#define PG8_WAIT_V(n) asm volatile("s_waitcnt vmcnt(" #n ")" ::: "memory")
#define PG8_WAIT_L(n) asm volatile("s_waitcnt lgkmcnt(" #n ")" ::: "memory")
#define PG8_BAR __builtin_amdgcn_s_barrier()
#define PG8_SCHED __builtin_amdgcn_sched_barrier(0)
    Unit cur, nxt; int ui = 0;
    if (!S.next(0, cur)) return;
    f32x4 acc[2][2][4][2];
    typename Epi::Pre pre; E.pre_load(cur, wc, fq, pre); E.acc_init(acc, pre);
    bf16x8 At[4][2], B0[2][2], B1[2][2]; i32x8 At_8[4], B0_8[2], B1_8[2];
    unsigned cA = (unsigned)cur.pm * tstep, cB = (unsigned)cur.pn * tstep;
    S.a_ready(cur);
    if constexpr (SP2) {
        PG8_STGB(PG8_SB(0, 0), cB); PG8_STGB(PG8_SB(0, 1), cB + hstep); PG8_STGA(PG8_SA(0, 0), cA); PG8_STGA(PG8_SA(0, 1), cA + hstep);
        if (wr == 1) PG8_BAR;
        PG8_WAIT_V(2); PG8_BAR;
        PG8_STGB(PG8_SB(1, 0), cB + kstep); PG8_STGA(PG8_SA(1, 0), cA + kstep); PG8_STGB(PG8_SB(1, 1), cB + hstep + kstep);
        PG8_WAIT_V(6); PG8_BAR;
    } else {
        PG8_STGB(PG8_SB(0, 0), cB); PG8_STGA(PG8_SA(0, 0), cA); PG8_STGB(PG8_SB(0, 1), cB + hstep); PG8_STGA(PG8_SA(0, 1), cA + hstep);
        if (wr == 1) PG8_BAR;
        PG8_WAIT_V(4); PG8_BAR;
        PG8_STGB(PG8_SB(1, 0), cB + kstep); PG8_STGA(PG8_SA(1, 0), cA + kstep); PG8_STGB(PG8_SB(1, 1), cB + hstep + kstep);
        PG8_WAIT_V(6); PG8_BAR;
    }
    for (;;) {
        const bool has_next = S.next(ui + 1, nxt);
        const unsigned nA = has_next ? (unsigned)nxt.pm * tstep : cA, nB = has_next ? (unsigned)nxt.pn * tstep : cB;
#pragma unroll 1
        for (int t = 0; t < nt; t += 2) {
            const bool last = (t == nt - 2);
            const unsigned a1 = cA + (unsigned)(t + 1) * kstep;
            const unsigned a2 = last ? nA : cA + (unsigned)(t + 2) * kstep, b2 = last ? nB : cB + (unsigned)(t + 2) * kstep;
            const unsigned a3 = a2 + kstep, b3 = b2 + kstep;
            if (last && has_next) S.a_ready(nxt);
            if constexpr (SP2) {
            PG8_LDB(B0, 0, 0); PG8_LDB(B1, 0, 1); PG8_SCHED; PG8_LDA(At, 0, 0); PG8_STGA(PG8_SA(1, 1), a1 + hstep);
            PG8_WAIT_V(8); PG8_WAIT_L(0); PG8_BAR; PG8_MMA(0, 0, At, B0); PG8_MMA(0, 1, At, B1); PG8_BAR; PG8_SCHED;
            PG8_LDA(At, 0, 1); PG8_STGB(PG8_SB(0, 0), b2); PG8_STGB(PG8_SB(0, 1), b2 + hstep); PG8_STGA(PG8_SA(0, 0), a2);
            PG8_WAIT_V(8); PG8_WAIT_L(0); PG8_BAR; PG8_MMA(1, 0, At, B0); PG8_MMA(1, 1, At, B1); PG8_BAR; PG8_SCHED;
            PG8_LDB(B0, 1, 0); PG8_LDB(B1, 1, 1); PG8_SCHED; PG8_LDA(At, 1, 0); PG8_STGA(PG8_SA(0, 1), a2 + hstep);
            PG8_WAIT_V(8); PG8_WAIT_L(0); PG8_BAR; PG8_MMA(0, 0, At, B0); PG8_MMA(0, 1, At, B1); PG8_BAR; PG8_SCHED;
            PG8_LDA(At, 1, 1); PG8_STGB(PG8_SB(1, 0), b3); PG8_STGB(PG8_SB(1, 1), b3 + hstep); PG8_STGA(PG8_SA(1, 0), a3);
            PG8_WAIT_V(8); PG8_WAIT_L(0); PG8_BAR; PG8_MMA(1, 0, At, B0); PG8_MMA(1, 1, At, B1); PG8_BAR; PG8_SCHED;
            } else {
            PG8_LDB(B0, 0, 0); PG8_SCHED; PG8_LDA(At, 0, 0); PG8_STGA(PG8_SA(1, 1), a1 + hstep);
            PG8_WAIT_L(8); PG8_BAR; PG8_WAIT_L(0); PG8_MMA(0, 0, At, B0); PG8_BAR; PG8_SCHED;
            PG8_LDB(B1, 0, 1); PG8_STGB(PG8_SB(0, 0), b2);
            PG8_BAR; PG8_WAIT_L(0); PG8_MMA(0, 1, At, B1); PG8_BAR;
            PG8_LDA(At, 0, 1); PG8_STGA(PG8_SA(0, 0), a2);
            PG8_BAR; PG8_WAIT_L(0); PG8_MMA(1, 0, At, B0); PG8_BAR; PG8_SCHED;
            PG8_STGB(PG8_SB(0, 1), b2 + hstep);
            PG8_WAIT_V(6); PG8_BAR; PG8_MMA(1, 1, At, B1); PG8_BAR;
            PG8_LDB(B0, 1, 0); PG8_SCHED; PG8_LDA(At, 1, 0); PG8_STGA(PG8_SA(0, 1), a2 + hstep);
            PG8_WAIT_L(8); PG8_BAR; PG8_WAIT_L(0); PG8_MMA(0, 0, At, B0); PG8_BAR; PG8_SCHED;
            PG8_LDB(B1, 1, 1); PG8_STGB(PG8_SB(1, 0), b3);
            PG8_BAR; PG8_WAIT_L(0); PG8_MMA(0, 1, At, B1); PG8_BAR;
            PG8_LDA(At, 1, 1); PG8_STGA(PG8_SA(1, 0), a3);
            PG8_BAR; PG8_WAIT_L(0); PG8_MMA(1, 0, At, B0); PG8_BAR; PG8_SCHED;
            PG8_STGB(PG8_SB(1, 1), b3 + hstep);
            PG8_WAIT_V(6); PG8_BAR; PG8_MMA(1, 1, At, B1); PG8_BAR;
            }
        }
        if constexpr (ALIGN_EPI) { if (wr == 0) PG8_BAR; }
        if constexpr (!Epi::AFTER_DRAIN) { int t2_ = threadIdx.x; asm volatile("" : "+v"(t2_)); { const Unit pu_ = has_next ? nxt : cur; E.pre_load(pu_, wc, (t2_ & 63) >> 4, pre); }     E(acc, cur, wr, wc, t2_ & 15, (t2_ & 63) >> 4); S.done(cur); }
        if (!has_next) break;
        E.acc_init(acc, pre);
        cur = nxt; cA = nA; cB = nB; ++ui;
        if constexpr (ALIGN_EPI) { if (wr == 1) PG8_BAR; }
    }
    PG8_WAIT_V(0);
    if constexpr (!ALIGN_EPI) { if (wr == 0) PG8_BAR; }
    PG8_BAR;
    if constexpr (Epi::AFTER_DRAIN) { E.fused(acc, cur, wr, wc, fr, fq, lds, wid, lane); S.done(cur); }
#undef PG8_SA
#undef PG8_SB
#undef PG8_STG
#undef PG8_STGA
#undef PG8_STGB
#undef PG8_LDA
#undef PG8_LDB
#undef PG8_MMA
#undef PG8_WAIT_V
#undef PG8_WAIT_L
#undef PG8_BAR
#undef PG8_SCHED
}
}

constexpr int NWAVES = 8, NTHR = 512, GRID = 256;
constexpr int NBATCH = 2, SEQ = 16384, T = NBATCH * SEQ, D = 1024, DEPTH = 4;
constexpr int MIXW = 768, NC_H = 3328, NC_M = 2560;
constexpr int HG_H = 6;
constexpr int HSEG = 256, HNSEG = SEQ / HSEG;
constexpr int MB_H = 12, MB_NB = 64;
constexpr int NE = 32;
constexpr float DN_ALPHA = 1.6817928305074290f;
constexpr int MOE_MAXROWS = T * 4 + NE * 256;
#ifndef ONE_LAUNCH
#define ONE_LAUNCH 1
#endif
constexpr int NPHASE = 13;

constexpr size_t MiB = 1u << 20;
constexpr size_t WS_CTL = 0, CTL_ZERO_BYTES = 1 * MiB;
constexpr size_t WS_WIN = 1 * MiB, WS_WKV = 9 * MiB, WS_WO = 10 * MiB, WS_WGU = 12 * MiB, WS_WD = 140 * MiB;
constexpr size_t WS_XBF = 204 * MiB, WS_WKV4 = 268 * MiB  , WS_KV4 = 272 * MiB  , WS_WRS = 280 * MiB  , WS_MEMBF = 524 * MiB;
constexpr size_t WS_H = 526 * MiB, WS_MIX = 734 * MiB, WS_Y = 798 * MiB, WS_SLOC = 862 * MiB, WS_DSEG = 910 * MiB, WS_KMEAN = 911 * MiB;
constexpr size_t WS_SELINFO = 912 * MiB, WS_TOK = 914 * MiB, WS_R1 = 918 * MiB;
constexpr size_t WS_LIST = WS_R1, WS_PML = WS_R1 + 96 * MiB, WS_PO = WS_R1 + 108 * MiB;
constexpr size_t WS_XS = WS_R1, WS_HID = WS_R1 + 272 * MiB;
constexpr size_t WS_END = WS_R1 + 544 * MiB;
static_assert((size_t)MOE_MAXROWS * 1024 * 2 <= 272 * MiB, "moe rows");
static_assert((size_t)T * MB_H * 4 * 64 * 4 <= 384 * MiB && (size_t)24 * 64 * 16384 * 4 <= 96 * MiB, "moba bufs");
constexpr size_t TOK_E = 0, TOK_LR = 512 * 1024, TOK_W = 1024 * 1024, TOK_ROW = 1536 * 1024, TOK_BLKCNT = 2048 * 1024, TOK_TAB = 2048 * 1024 + 65536;
constexpr int CW_BAR = 4096, CW_GCOUNT = 8192;

constexpr int RING_BYTES = 131072, LDS_BYTES = 147456, MISC_OFF = LDS_BYTES - 1024;

#define GAS __attribute__((address_space(1)))
#define LAS __attribute__((address_space(3)))
typedef unsigned short bf16;
typedef unsigned v4u __attribute__((ext_vector_type(4)));
typedef unsigned v2u __attribute__((ext_vector_type(2)));
typedef float f32x4 __attribute__((ext_vector_type(4)));
typedef float f32x2 __attribute__((ext_vector_type(2)));
typedef short s16x8 __attribute__((ext_vector_type(8)));
typedef float f32x16 __attribute__((ext_vector_type(16)));
typedef float f32x2_t __attribute__((ext_vector_type(2))); typedef __bf16 bf16x2_t __attribute__((ext_vector_type(2)));
__device__ __forceinline__ unsigned cvtpk(float lo, float hi) { f32x2_t v = {lo, hi}; bf16x2_t b = __builtin_convertvector(v, bf16x2_t); return __builtin_bit_cast(unsigned, b); }
#define LDS_WAIT() asm volatile("s_waitcnt lgkmcnt(0)" ::: "memory")
__device__ __forceinline__ unsigned f2bf(float f) { unsigned u = __builtin_bit_cast(unsigned, f); return (u + 0x7fffu + ((u >> 16) & 1u)) >> 16; }
__device__ __forceinline__ unsigned pk2(float lo, float hi) { return f2bf(lo) | (f2bf(hi) << 16); }
__device__ __forceinline__ float bflo(unsigned w) { return __builtin_bit_cast(float, w << 16); }
__device__ __forceinline__ float bfhi(unsigned w) { return __builtin_bit_cast(float, w & 0xffff0000u); }
__device__ __forceinline__ float bf2f(bf16 h) { return __builtin_bit_cast(float, (unsigned)h << 16); }
__device__ __forceinline__ float sigmoidf_(float z) { return __builtin_amdgcn_rcpf(1.0f + __builtin_amdgcn_exp2f(-1.4426950408889634f * z)); }
template <int X> __device__ __forceinline__ float xorf(float v) { return __builtin_bit_cast(float, __builtin_amdgcn_ds_swizzle(__builtin_bit_cast(int, v), (X << 10) | 0x1F)); }
template <int X> __device__ __forceinline__ int xori(int v) { return __builtin_amdgcn_ds_swizzle(v, (X << 10) | 0x1F); }
__device__ __forceinline__ float wave_sum(float v) {
    v += xorf<1>(v); v += xorf<2>(v); v += xorf<4>(v); v += xorf<8>(v); v += xorf<16>(v);
    return __builtin_bit_cast(float, __builtin_amdgcn_readlane(__builtin_bit_cast(int, v), 0)) + __builtin_bit_cast(float, __builtin_amdgcn_readlane(__builtin_bit_cast(int, v), 32));
}
__device__ __forceinline__ float wave_max(float v) {
    v = fmaxf(v, xorf<1>(v)); v = fmaxf(v, xorf<2>(v)); v = fmaxf(v, xorf<4>(v)); v = fmaxf(v, xorf<8>(v)); v = fmaxf(v, xorf<16>(v));
    return fmaxf(__builtin_bit_cast(float, __builtin_amdgcn_readlane(__builtin_bit_cast(int, v), 0)), __builtin_bit_cast(float, __builtin_amdgcn_readlane(__builtin_bit_cast(int, v), 32)));
}
__device__ __forceinline__ float xor32f(float v, int lane) { return __builtin_bit_cast(float, __builtin_amdgcn_ds_bpermute((lane ^ 32) << 2, __builtin_bit_cast(int, v))); }
#define XB_TMO      128
#define XB_XCNT(j)  (256  + 64 * (j))
#define XB_XSUB(j)  (1280 + 64 * (j))
#define XB_XGEN(j)  (2304 + 64 * (j))
#define XB_TOP      3328
#define XB_TOPGEN   3392
#define XCD_BAR_WORDS 3456
#define XB_SPIN_CAP (1u << 18)

__device__ __forceinline__ unsigned xb_ld(unsigned* p)              { return __hip_atomic_load(p, __ATOMIC_RELAXED, __HIP_MEMORY_SCOPE_AGENT); }
__device__ __forceinline__ unsigned xb_add(unsigned* p, unsigned v) { return __hip_atomic_fetch_add(p, v, __ATOMIC_RELAXED, __HIP_MEMORY_SCOPE_AGENT); }
__device__ __forceinline__ unsigned xb_xcc_id() { return (unsigned)__builtin_amdgcn_s_getreg((3 << 11) | 20) & 0xFu; }
#define XB_SPIN(cond, bar) do { unsigned _sp = 0; while (cond) { __builtin_amdgcn_s_sleep(1); \
    if ((++_sp & 255u) == 0u) { if (xb_ld(&(bar)[XB_TMO])) break; if (_sp > XB_SPIN_CAP) { atomicAdd(&(bar)[XB_TMO], 1u); break; } } } } while (0)

struct XcdBarrier {
    unsigned* bar; unsigned x;
    volatile LAS unsigned* st;
};

__device__ __forceinline__ XcdBarrier xcd_barrier_post(unsigned* bar, volatile LAS unsigned* st) {
    XcdBarrier b; b.bar = bar; b.x = xb_xcc_id(); b.st = st;
    if (threadIdx.x == 0) (void)xb_add(&bar[XB_XCNT(b.x)], 1u);
    return b;
}
__device__ __forceinline__ void xcd_barrier_complete(unsigned* bar, unsigned x, unsigned& nloc, unsigned& nx) {
    const unsigned G = gridDim.x * gridDim.y * gridDim.z;
    unsigned sum, cnt, mine, sp = 0u;
    for (;;) {
        sum = 0u; cnt = 0u; mine = 0u;
#pragma unroll
        for (unsigned j = 0; j < 16; ++j) { const unsigned c = xb_ld(&bar[XB_XCNT(j)]); sum += c; cnt += (c > 0u) ? 1u : 0u; mine = (j == x) ? c : mine; }
        if (sum == G) break;
        __builtin_amdgcn_s_sleep(1);
        if ((++sp & 255u) == 0u) { if (xb_ld(&bar[XB_TMO])) break; if (sp > XB_SPIN_CAP) { atomicAdd(&bar[XB_TMO], 1u); break; } }
    }
    nloc = mine > 0u ? mine : 1u; nx = cnt > 0u ? cnt : 1u;
}

__device__ __forceinline__ void xcd_barrier(const XcdBarrier& b) {
    asm volatile("s_waitcnt vmcnt(0)" ::: "memory");
    __syncthreads();
    if (threadIdx.x == 0) {
        unsigned* bar = b.bar;
        __builtin_amdgcn_s_waitcnt(0);
        unsigned nloc = b.st[0], nx = b.st[1];
        if (nloc == 0u) { xcd_barrier_complete(bar, b.x, nloc, nx); b.st[0] = nloc; b.st[1] = nx; }
        const unsigned old = xb_add(&bar[XB_XSUB(b.x)], 1u);
        const unsigned gen = old / nloc;
        if (old + 1u == (gen + 1u) * nloc) {
            __builtin_amdgcn_fence(__ATOMIC_RELEASE, "agent");
            asm volatile("s_waitcnt vmcnt(0)" ::: "memory");
            const unsigned og = xb_add(&bar[XB_TOP], 1u);
            const unsigned tg = og / nx;
            if (og + 1u == (tg + 1u) * nx) xb_add(&bar[XB_TOPGEN], 1u);
            else XB_SPIN(xb_ld(&bar[XB_TOPGEN]) == tg, bar);
            __builtin_amdgcn_fence(__ATOMIC_ACQUIRE, "agent");
            xb_add(&bar[XB_XGEN(b.x)], 1u);
            asm volatile("s_waitcnt vmcnt(0)" ::: "memory");
        } else {
            XB_SPIN(xb_ld(&bar[XB_XGEN(b.x)]) == gen, bar);
            __builtin_amdgcn_fence(__ATOMIC_ACQUIRE, "agent");
            asm volatile("s_waitcnt vmcnt(0)" ::: "memory");
        }
    }
    __syncthreads();
}

__device__ __forceinline__ void cvt_rows_bf16(const float* src, bf16* dst, size_t n8, size_t gtid, size_t gthreads) {
    for (size_t i = gtid; i < n8; i += gthreads) { const f32x4 a = ((const f32x4*)src)[2 * i], b = ((const f32x4*)src)[2 * i + 1];
        v4u o; o.x = pk2(a.x, a.y); o.y = pk2(a.z, a.w); o.z = pk2(b.x, b.y); o.w = pk2(b.z, b.w); ((v4u*)dst)[i] = o; }
}
__device__ __forceinline__ void transpose_item(const float* W, int N, bf16* WT, int dst_row0, LAS float* scr, int k0, int n0, int lane) {
#pragma unroll 8
    for (int i = 0; i < 32; ++i) { const int kk = 2 * i + (lane >> 5); scr[kk * 33 + (lane & 31)] = W[(size_t)(k0 + kk) * N + n0 + (lane & 31)]; }
    LDS_WAIT(); asm volatile("" ::: "memory");
    const int c = lane & 7;
#pragma unroll
    for (int j = 0; j < 4; ++j) { const int n = (lane >> 3) + 8 * j; const LAS float* s = scr + (8 * c) * 33 + n;
        v4u o; o.x = pk2(s[0 * 33], s[1 * 33]); o.y = pk2(s[2 * 33], s[3 * 33]); o.z = pk2(s[4 * 33], s[5 * 33]); o.w = pk2(s[6 * 33], s[7 * 33]);
        *(v4u*)(WT + (size_t)(dst_row0 + n) * 1024 + k0 + 8 * c) = o; }
    LDS_WAIT(); asm volatile("" ::: "memory");
}
__device__ __forceinline__ unsigned pk4_fp8(float a, float b, float c, float d) { int w = 0; w = __builtin_amdgcn_cvt_pk_fp8_f32(a, b, w, false); w = __builtin_amdgcn_cvt_pk_fp8_f32(c, d, w, true); return (unsigned)w; }
__device__ __forceinline__ void transpose_item_f8(const float* W, int N, unsigned char* WT8, int dst_row0, LAS float* scr, int k0, int n0, int lane, float wscale) {
#pragma unroll 8
    for (int i = 0; i < 32; ++i) { const int kk = 2 * i + (lane >> 5); scr[kk * 33 + (lane & 31)] = W[(size_t)(k0 + kk) * N + n0 + (lane & 31)]; }
    LDS_WAIT(); asm volatile("" ::: "memory");
    const int c = lane & 7;
#pragma unroll
    for (int j = 0; j < 4; ++j) { const int n = (lane >> 3) + 8 * j; const LAS float* s = scr + (8 * c) * 33 + n;
        v2u o; o.x = pk4_fp8(s[0 * 33] * wscale, s[1 * 33] * wscale, s[2 * 33] * wscale, s[3 * 33] * wscale); o.y = pk4_fp8(s[4 * 33] * wscale, s[5 * 33] * wscale, s[6 * 33] * wscale, s[7 * 33] * wscale);
        *(v2u*)(WT8 + (size_t)(dst_row0 + n) * 1024 + k0 + 8 * c) = o; }
    LDS_WAIT(); asm volatile("" ::: "memory");
}
__device__ __forceinline__ void phase_weights(LAS float* scr, int gw, int ngw, int lane, const float* win_src, int NC, const float* wkv_src, int nkv, const float* wo_src,
                                              const float* wg_src, const float* wu_src, const float* wd_src, bf16* win_t, bf16* wkv_t, bf16* wo_t, bf16* wgu_t, bf16* wd_t) {
    const int nbw = NC / 32, nWin = nbw * 16, NIT = nWin + 256 * nkv + 512 + NE * 1536;
    for (int it = gw; it < NIT; it += ngw) {
        int r = it;
        if (r < nWin) { const int kb = r / nbw, nb = r - kb * nbw; transpose_item(win_src, NC, win_t, 32 * nb, scr, 64 * kb, 32 * nb, lane); continue; } r -= nWin;
        if (r < 256 * nkv) { const int lay = r >> 8, rr = r & 255, kb = rr >> 4, nb = rr & 15; transpose_item(wkv_src + (size_t)lay * D * 512, 512, wkv_t + (size_t)lay * 512 * 1024, 32 * nb, scr, 64 * kb, 32 * nb, lane); continue; } r -= 256 * nkv;
        if (r < 512) { const int kb = r >> 5, nb = r & 31; transpose_item(wo_src, 1024, wo_t, 32 * nb, scr, 64 * kb, 32 * nb, lane); continue; } r -= 512;
        const int e = r / 1536, q = r - e * 1536, which = q >> 9, rr = q & 511, kb = rr >> 5, nb = rr & 31, n0 = 32 * nb;
        const size_t eoff = (size_t)e * 1024 * 1024;
        if (which == 0) transpose_item_f8(wg_src + eoff, 1024, (unsigned char*)wgu_t + 2 * eoff, (n0 >> 7) * 256 + (n0 & 127), scr, 64 * kb, n0, lane, 32.f);
        else if (which == 1) transpose_item_f8(wu_src + eoff, 1024, (unsigned char*)wgu_t + 2 * eoff, (n0 >> 7) * 256 + 128 + (n0 & 127), scr, 64 * kb, n0, lane, 32.f);
        else transpose_item_f8(wd_src + eoff, 1024, (unsigned char*)wd_t + eoff, n0, scr, 64 * kb, n0, lane, 64.f);
    }
}

template <bool OUT>
__device__ __forceinline__ void hgrn_seg(LAS unsigned char* lds, const bf16* h, const float* lbl, int j, const float* normg, float* Sloc, float* Dseg, bf16* mix, int unit, int tid, int wave, int lane) {
    const int seg = unit & (HNSEG - 1), bh = unit >> 6, hh = bh % HG_H, b = bh / HG_H;
    const int v = tid & 127, dg = tid >> 7;
    LAS float* fgs = (LAS float*)lds; LAS float* vs = fgs + 4096; LAS float* qs = vs + 4096; LAS float* op = qs + 4096;
    f32x2 st[16];
    float* Sp = Sloc + (size_t)unit * 16384 + (size_t)(dg * 32) * 128 + v;
#pragma unroll
    for (int dd = 0; dd < 16; ++dd) { st[dd].x = OUT ? Sp[(2 * dd) * 128] : 0.f; st[dd].y = OUT ? Sp[(2 * dd + 1) * 128] : 0.f; }
    float dprod = 1.f;
    const int stok = tid >> 4, c8 = (tid & 15) * 8;
    float lb[8];
#pragma unroll
    for (int i = 0; i < 8; ++i) { lb[i] = 0.f; if (j > 0) { const float a0 = lbl[hh * 128 + c8 + i], a1 = lbl[MIXW + hh * 128 + c8 + i]; lb[i] = 1.f / (1.f + __expf(a0 - a1)); } }
    for (int ch = 0; ch < HSEG / 32; ++ch) {
        const size_t t0 = (size_t)b * SEQ + seg * HSEG + ch * 32;
        { const bf16* row = h + (t0 + stok) * NC_H + hh * 128 + c8;
          const v4u f8 = *(const v4u*)(row + 768), i8 = *(const v4u*)(row + 1536); v4u q8 = {0u, 0u, 0u, 0u}; if (OUT) q8 = *(const v4u*)row;
#pragma unroll
          for (int w = 0; w < 4; ++w) { const float f0 = bflo(f8[w]), f1 = bfhi(f8[w]); const int o = stok * 128 + c8 + 2 * w;
              fgs[o] = lb[2 * w] + (1.f - lb[2 * w]) * sigmoidf_(f0); fgs[o + 1] = lb[2 * w + 1] + (1.f - lb[2 * w + 1]) * sigmoidf_(f1);
              vs[o] = bflo(i8[w]); vs[o + 1] = bfhi(i8[w]);
              if (OUT) { const float q0 = bflo(q8[w]), q1 = bfhi(q8[w]); qs[o] = q0 * sigmoidf_(q0); qs[o + 1] = q1 * sigmoidf_(q1); } } }
        __syncthreads();
        if (!OUT) { if (tid < 128) { for (int tt = 0; tt < 32; ++tt) dprod *= fgs[tt * 128 + tid]; } }
        f32x4 fA[8], qA[8], fB[8], qB[8]; float vA, vB;
#define HG_LOAD(F, Q, V, tt_) do { V = vs[(tt_) * 128 + v]; _Pragma("unroll") for (int d4 = 0; d4 < 8; ++d4) { F[d4] = *(const LAS f32x4*)(fgs + (tt_) * 128 + dg * 32 + d4 * 4); \
            if (OUT) Q[d4] = *(const LAS f32x4*)(qs + (tt_) * 128 + dg * 32 + d4 * 4); } } while (0)
#define HG_STEP(F, Q, V, tt_) do { const f32x2 vv2 = {V, V}; f32x2 acc2 = {0.f, 0.f}; _Pragma("unroll") for (int d4 = 0; d4 < 8; ++d4) { \
            const f32x2 fa = {F[d4].x, F[d4].y}, fb = {F[d4].z, F[d4].w}; \
            st[2 * d4] = fa * (st[2 * d4] - vv2) + vv2; st[2 * d4 + 1] = fb * (st[2 * d4 + 1] - vv2) + vv2; \
            if (OUT) { const f32x2 qa = {Q[d4].x, Q[d4].y}, qb = {Q[d4].z, Q[d4].w}; acc2 = qa * st[2 * d4] + acc2; acc2 = qb * st[2 * d4 + 1] + acc2; } } \
            if (OUT) op[(dg * 32 + (tt_)) * 128 + v] = acc2.x + acc2.y; } while (0)
        HG_LOAD(fA, qA, vA, 0);
#pragma unroll 1
        for (int tt = 0; tt < 32; tt += 2) {
            HG_LOAD(fB, qB, vB, tt + 1);
            __builtin_amdgcn_sched_barrier(0);
            HG_STEP(fA, qA, vA, tt);
            __builtin_amdgcn_sched_barrier(0);
            if (tt + 2 < 32) HG_LOAD(fA, qA, vA, tt + 2);
            __builtin_amdgcn_sched_barrier(0);
            HG_STEP(fB, qB, vB, tt + 1);
            __builtin_amdgcn_sched_barrier(0);
        }
#undef HG_LOAD
#undef HG_STEP
        if (OUT) {
            __syncthreads();
#pragma unroll
            for (int k = 0; k < 4; ++k) { const int tt = wave + 8 * k; float o0 = 0.f, o1 = 0.f;
#pragma unroll
                for (int g = 0; g < 4; ++g) { o0 += op[(g * 32 + tt) * 128 + lane]; o1 += op[(g * 32 + tt) * 128 + lane + 64]; }
                const float ms = wave_sum(o0 * o0 + o1 * o1) * (1.f / 128.f), r = 1.f / sqrtf(ms + 1e-6f);
                const bf16* grow = h + (t0 + tt) * NC_H + 2304 + hh * 128; const float g0 = bf2f(grow[lane]), g1 = bf2f(grow[lane + 64]);
                bf16* mrow = mix + (t0 + tt) * 1024 + hh * 128;
                mrow[lane] = (bf16)f2bf(o0 * r * normg[lane] * sigmoidf_(g0)); mrow[lane + 64] = (bf16)f2bf(o1 * r * normg[lane + 64] * sigmoidf_(g1)); }
        }
        __syncthreads();
    }
    if (!OUT) {
#pragma unroll
        for (int dd = 0; dd < 16; ++dd) { Sp[(2 * dd) * 128] = st[dd].x; Sp[(2 * dd + 1) * 128] = st[dd].y; }
        if (tid < 128) Dseg[(size_t)unit * 128 + tid] = dprod;
    }
}
constexpr int HG_G = 0, HG_QT = 32768, HG_KT = 50176, HG_KE = 67584, HG_VT = 86016, HG_ST = 104448, HG_GM = 139264, HG_GE = 139776, HG_PART = 140288;
static_assert(HG_PART + 2048 <= MISC_OFF, "HGRN LDS map");
__device__ __forceinline__ int crow16(int i, int hf) { return (i & 3) + 8 * (i >> 2) + 4 * hf; }
template <bool OUT>
__device__ __forceinline__ void hgrn_mfma(LAS unsigned char* lds, const bf16* h, const float* lbl, int j, const float* normg, float* Sloc, float* Dseg, bf16* mix, int unit, int tid, int wave, int lane) {
    const int seg = unit & (HNSEG - 1), bh = unit >> 6, hh = bh % HG_H, b = bh / HG_H;
    const int r = lane & 31, hf = lane >> 5, tr = wave & 1, vq = wave >> 1;
    LAS float* G = (LAS float*)(lds + HG_G); LAS float* GM = (LAS float*)(lds + HG_GM); LAS float* GE = (LAS float*)(lds + HG_GE); LAS float* PART = (LAS float*)(lds + HG_PART);
    const int stok = tid >> 3, c16 = (tid & 7) * 16, sperm = (stok & ~15) | (stok & 3) | ((stok & 4) << 1) | ((stok & 8) >> 1);
    const int cd = tid & 127, cpart = tid >> 7;
    float lb[16];
#pragma unroll
    for (int e = 0; e < 16; ++e) { lb[e] = 0.f; if (j > 0) { const float a0 = lbl[hh * 128 + c16 + e], a1 = lbl[MIXW + hh * 128 + c16 + e]; lb[e] = 1.f / (1.f + __expf(a0 - a1)); } }
    f32x16 S[2];
    float* Sp = Sloc + (size_t)unit * 16384 + 32 * vq + r;
#pragma unroll
    for (int dd = 0; dd < 2; ++dd)
#pragma unroll
        for (int i = 0; i < 16; ++i) S[dd][i] = OUT ? Sp[(32 * (2 * tr + dd) + crow16(i, hf)) * 128] : 0.f;
    float gsum = 0.f;
    float ng16[16];
#pragma unroll
    for (int e = 0; e < 16; ++e) ng16[e] = OUT ? normg[c16 + e] : 0.f;
    v4u nf8[2], ni8[2], nq8[2] = {{0u, 0u, 0u, 0u}, {0u, 0u, 0u, 0u}}, ng8[2] = {{0u, 0u, 0u, 0u}, {0u, 0u, 0u, 0u}};
#define HG_RAWLOAD(t0_) do { const bf16* row_ = h + ((t0_) + stok) * NC_H + hh * 128 + c16; nf8[0] = *(const v4u*)(row_ + 768); nf8[1] = *(const v4u*)(row_ + 776); ni8[0] = *(const v4u*)(row_ + 1536); ni8[1] = *(const v4u*)(row_ + 1544); \
        if (OUT) { nq8[0] = *(const v4u*)row_; nq8[1] = *(const v4u*)(row_ + 8); ng8[0] = *(const v4u*)(row_ + 2304); ng8[1] = *(const v4u*)(row_ + 2312); } } while (0)
    HG_RAWLOAD((size_t)b * SEQ + seg * HSEG);
    for (int ch = 0; ch < HSEG / 64; ++ch) {
        const size_t t0 = (size_t)b * SEQ + seg * HSEG + ch * 64;
        float fg[16], qv[16]; v4u i8[2], g8[2];
        { const v4u f8[2] = {nf8[0], nf8[1]}; i8[0] = ni8[0]; i8[1] = ni8[1]; const v4u q8[2] = {nq8[0], nq8[1]}; g8[0] = ng8[0]; g8[1] = ng8[1];
#pragma unroll
          for (int w = 0; w < 8; ++w) { const unsigned fw = f8[w >> 2][w & 3]; const float f0 = bflo(fw), f1 = bfhi(fw);
              fg[2 * w] = lb[2 * w] + (1.f - lb[2 * w]) * sigmoidf_(f0); fg[2 * w + 1] = lb[2 * w + 1] + (1.f - lb[2 * w + 1]) * sigmoidf_(f1);
              if (OUT) { const unsigned qw = q8[w >> 2][w & 3]; const float q0 = bflo(qw), q1 = bfhi(qw); qv[2 * w] = q0 * sigmoidf_(q0); qv[2 * w + 1] = q1 * sigmoidf_(q1); } else { qv[2 * w] = 0.f; qv[2 * w + 1] = 0.f; } }
#pragma unroll
          for (int e4 = 0; e4 < 4; ++e4) { f32x4 lg; lg.x = __builtin_amdgcn_logf(fg[4 * e4]); lg.y = __builtin_amdgcn_logf(fg[4 * e4 + 1]); lg.z = __builtin_amdgcn_logf(fg[4 * e4 + 2]); lg.w = __builtin_amdgcn_logf(fg[4 * e4 + 3]);
              *(LAS f32x4*)(G + stok * 128 + c16 + 4 * e4) = lg; } }
        __syncthreads();
        { float run = 0.f;
#pragma unroll
          for (int k = 0; k < 16; ++k) run += G[(16 * cpart + k) * 128 + cd];
          PART[cpart * 128 + cd] = run; }
        __syncthreads();
        { float run = 0.f;
#pragma unroll
          for (int pp = 0; pp < 3; ++pp) run += (pp < cpart) ? PART[pp * 128 + cd] : 0.f;
#pragma unroll
          for (int k = 0; k < 16; ++k) { run += G[(16 * cpart + k) * 128 + cd]; G[(16 * cpart + k) * 128 + cd] = run; }
          if (cpart == 1) GM[cd] = run;
          if (cpart == 3) { GE[cd] = run; gsum += run; } }
        __syncthreads();
        if (OUT) {
#pragma unroll
            for (int dd = 0; dd < 2; ++dd)
#pragma unroll
                for (int g4 = 0; g4 < 4; ++g4) { const int dbase = 32 * (2 * tr + dd) + 8 * g4 + 4 * hf; const f32x4 gm = *(const LAS f32x4*)(GM + dbase);
                    v2u w; w.x = cvtpk(S[dd][4 * g4] * __builtin_amdgcn_exp2f(gm.x), S[dd][4 * g4 + 1] * __builtin_amdgcn_exp2f(gm.y)); w.y = cvtpk(S[dd][4 * g4 + 2] * __builtin_amdgcn_exp2f(gm.z), S[dd][4 * g4 + 3] * __builtin_amdgcn_exp2f(gm.w));
                    *(LAS v2u*)(lds + HG_ST + (32 * vq + r) * 272 + dbase * 2) = w; }
        }
        { unsigned qt[8], kt[8];
#pragma unroll
          for (int e4 = 0; e4 < 4; ++e4) { const f32x4 gv = *(const LAS f32x4*)(G + stok * 128 + c16 + 4 * e4), gm = *(const LAS f32x4*)(GM + c16 + 4 * e4), ge = *(const LAS f32x4*)(GE + c16 + 4 * e4);
              float ke[4];
#pragma unroll
              for (int e = 0; e < 4; ++e) { const float kk = 1.f - fg[4 * e4 + e]; ke[e] = kk * __builtin_amdgcn_exp2f(ge[e] - gv[e]);
                  if (OUT) { const float a = qv[4 * e4 + e] * __builtin_amdgcn_exp2f(gv[e] - gm[e]), c = kk * __builtin_amdgcn_exp2f(gm[e] - gv[e]);
                      if (e & 1) { qt[2 * e4 + (e >> 1)] |= f2bf(a) << 16; kt[2 * e4 + (e >> 1)] |= f2bf(c) << 16; } else { qt[2 * e4 + (e >> 1)] = f2bf(a); kt[2 * e4 + (e >> 1)] = f2bf(c); } } }
#pragma unroll
              for (int e = 0; e < 4; ++e) { const int col = c16 + 4 * e4 + e;
                  *(LAS bf16*)(lds + HG_KE + col * 144 + sperm * 2) = (bf16)f2bf(ke[e]);
                  const unsigned vw = i8[e4 >> 1][(2 * e4 + (e >> 1)) & 3]; *(LAS bf16*)(lds + HG_VT + col * 144 + sperm * 2) = (bf16)((e & 1) ? (vw >> 16) : (vw & 0xffffu)); } }
          if (OUT) { *(LAS v4u*)(lds + HG_QT + stok * 272 + c16 * 2) = (v4u){qt[0], qt[1], qt[2], qt[3]}; *(LAS v4u*)(lds + HG_QT + stok * 272 + c16 * 2 + 16) = (v4u){qt[4], qt[5], qt[6], qt[7]};
                     *(LAS v4u*)(lds + HG_KT + stok * 272 + c16 * 2) = (v4u){kt[0], kt[1], kt[2], kt[3]}; *(LAS v4u*)(lds + HG_KT + stok * 272 + c16 * 2 + 16) = (v4u){kt[4], kt[5], kt[6], kt[7]}; } }
        __syncthreads();
        if (ch + 1 < HSEG / 64) HG_RAWLOAD(t0 + 64);
        if (OUT) {
            f32x16 X0, X1, O;
#pragma unroll
            for (int i = 0; i < 16; ++i) { X0[i] = 0.f; X1[i] = 0.f; O[i] = 0.f; }
            const LAS unsigned char* qtp = lds + HG_QT + (32 * tr + r) * 272 + hf * 16;
#pragma unroll
            for (int ks = 0; ks < 8; ++ks) { const s16x8 bq = *(const LAS s16x8*)(qtp + ks * 32);
                const s16x8 a0 = *(const LAS s16x8*)(lds + HG_KT + r * 272 + hf * 16 + ks * 32); X0 = __builtin_amdgcn_mfma_f32_32x32x16_bf16(a0, bq, X0, 0, 0, 0);
                if (tr == 1) { const s16x8 a1 = *(const LAS s16x8*)(lds + HG_KT + (32 + r) * 272 + hf * 16 + ks * 32); X1 = __builtin_amdgcn_mfma_f32_32x32x16_bf16(a1, bq, X1, 0, 0, 0); } }
#pragma unroll
            for (int i = 0; i < 16; ++i) { const bool keep = crow16(i, hf) <= r; if (tr == 0) X0[i] = keep ? X0[i] : 0.f; else X1[i] = keep ? X1[i] : 0.f; }
            const LAS unsigned char* vtp = lds + HG_VT + (32 * vq + r) * 144 + hf * 16;
#pragma unroll
            for (int s2 = 0; s2 < 2; ++s2) { v4u pw; pw.x = cvtpk(X0[8 * s2], X0[8 * s2 + 1]); pw.y = cvtpk(X0[8 * s2 + 2], X0[8 * s2 + 3]); pw.z = cvtpk(X0[8 * s2 + 4], X0[8 * s2 + 5]); pw.w = cvtpk(X0[8 * s2 + 6], X0[8 * s2 + 7]);
                const s16x8 bv = *(const LAS s16x8*)(vtp + (16 * s2) * 2); O = __builtin_amdgcn_mfma_f32_32x32x16_bf16(__builtin_bit_cast(s16x8, pw), bv, O, 0, 0, 0); }
            if (tr == 1) {
#pragma unroll
                for (int s2 = 0; s2 < 2; ++s2) { v4u pw; pw.x = cvtpk(X1[8 * s2], X1[8 * s2 + 1]); pw.y = cvtpk(X1[8 * s2 + 2], X1[8 * s2 + 3]); pw.z = cvtpk(X1[8 * s2 + 4], X1[8 * s2 + 5]); pw.w = cvtpk(X1[8 * s2 + 6], X1[8 * s2 + 7]);
                    const s16x8 bv = *(const LAS s16x8*)(vtp + (32 + 16 * s2) * 2); O = __builtin_amdgcn_mfma_f32_32x32x16_bf16(__builtin_bit_cast(s16x8, pw), bv, O, 0, 0, 0); } }
            const LAS unsigned char* stp = lds + HG_ST + (32 * vq + r) * 272 + hf * 16;
#pragma unroll
            for (int ks = 0; ks < 8; ++ks) { const s16x8 aq = *(const LAS s16x8*)(qtp + ks * 32), bs = *(const LAS s16x8*)(stp + ks * 32); O = __builtin_amdgcn_mfma_f32_32x32x16_bf16(aq, bs, O, 0, 0, 0); }
#pragma unroll
            for (int i = 0; i < 16; ++i) G[(32 * tr + crow16(i, hf)) * 128 + 32 * vq + r] = O[i];
        }
#pragma unroll
        for (int dd = 0; dd < 2; ++dd) { const int dr = 2 * tr + dd;
#pragma unroll
            for (int g4 = 0; g4 < 4; ++g4) { const f32x4 ge = *(const LAS f32x4*)(GE + 32 * dr + 8 * g4 + 4 * hf);
                S[dd][4 * g4] *= __builtin_amdgcn_exp2f(ge.x); S[dd][4 * g4 + 1] *= __builtin_amdgcn_exp2f(ge.y); S[dd][4 * g4 + 2] *= __builtin_amdgcn_exp2f(ge.z); S[dd][4 * g4 + 3] *= __builtin_amdgcn_exp2f(ge.w); }
#pragma unroll
            for (int ks = 0; ks < 4; ++ks) { const s16x8 a = *(const LAS s16x8*)(lds + HG_KE + (32 * dr + r) * 144 + hf * 16 + ks * 32), bv = *(const LAS s16x8*)(lds + HG_VT + (32 * vq + r) * 144 + hf * 16 + ks * 32);
                S[dd] = __builtin_amdgcn_mfma_f32_32x32x16_bf16(a, bv, S[dd], 0, 0, 0); } }
        __syncthreads();
        if (OUT) {
            float ov[16]; float ss = 0.f;
#pragma unroll
            for (int e4 = 0; e4 < 4; ++e4) { const f32x4 o4 = *(const LAS f32x4*)(G + stok * 128 + c16 + 4 * e4); ov[4 * e4] = o4.x; ov[4 * e4 + 1] = o4.y; ov[4 * e4 + 2] = o4.z; ov[4 * e4 + 3] = o4.w;
                ss += (o4.x * o4.x + o4.y * o4.y) + (o4.z * o4.z + o4.w * o4.w); }
            ss += xorf<1>(ss); ss += xorf<2>(ss); ss += xorf<4>(ss);
            const float rr = 1.f / sqrtf(ss * (1.f / 128.f) + 1e-6f);
            unsigned ow[8];
#pragma unroll
            for (int w = 0; w < 8; ++w) { const unsigned gw_ = g8[w >> 2][w & 3]; ow[w] = cvtpk(ov[2 * w] * rr * ng16[2 * w] * sigmoidf_(bflo(gw_)), ov[2 * w + 1] * rr * ng16[2 * w + 1] * sigmoidf_(bfhi(gw_))); }
            bf16* mrow = mix + (t0 + stok) * 1024 + hh * 128 + c16;
            *(v4u*)mrow = (v4u){ow[0], ow[1], ow[2], ow[3]}; *(v4u*)(mrow + 8) = (v4u){ow[4], ow[5], ow[6], ow[7]};
            __syncthreads();
        }
    }
#undef HG_RAWLOAD
    if (!OUT) {
#pragma unroll
        for (int dd = 0; dd < 2; ++dd)
#pragma unroll
            for (int i = 0; i < 16; ++i) Sp[(32 * (2 * tr + dd) + crow16(i, hf)) * 128] = S[dd][i];
        if (cpart == 3) Dseg[(size_t)unit * 128 + cd] = __builtin_amdgcn_exp2f(gsum);
    }
}
__device__ __forceinline__ void hgrn_scan(float* Sloc, const float* Dseg, size_t gtid, size_t gthreads) {
    for (size_t idx = gtid; idx < (size_t)NBATCH * HG_H * 16384; idx += gthreads) { const int bh = (int)(idx >> 14), e = (int)(idx & 16383), d = e >> 7; float cur = 0.f;
        float* __restrict__ sp = Sloc + (size_t)bh * HNSEG * 16384 + e; const float* __restrict__ dp = Dseg + (size_t)bh * HNSEG * 128 + d;
        for (int s0 = 0; s0 < HNSEG; s0 += 16) { float tv[16], dv[16];
#pragma unroll
            for (int k = 0; k < 16; ++k) { tv[k] = sp[(size_t)(s0 + k) * 16384]; dv[k] = dp[(s0 + k) * 128]; }
#pragma unroll
            for (int k = 0; k < 16; ++k) { sp[(size_t)(s0 + k) * 16384] = cur; cur = dv[k] * cur + tv[k]; } } }
}

template <bool MASK>
__device__ __forceinline__ void attn4(const LAS unsigned* Ks, const LAS bf16* Vs, const LAS float* qst, LAS float* pb, int lane, const int (&tq)[4], int kbase, float slope,
                                      float (&mo)[4], float (&lo)[4], float (&oo)[4]) {
    float sc[4][4];
#pragma unroll
    for (int a = 0; a < 4; ++a)
#pragma unroll
        for (int c = 0; c < 4; ++c) sc[a][c] = 0.f;
#pragma unroll 4
    for (int dd = 0; dd < 32; ++dd) {
        f32x2 qv[4];
#pragma unroll
        for (int qi = 0; qi < 4; ++qi) qv[qi] = *(const LAS f32x2*)(qst + qi * 64 + 2 * dd);
#pragma unroll
        for (int kk = 0; kk < 4; ++kk) { const unsigned kw = Ks[(lane + 64 * kk) * 33 + dd]; const float k0 = bflo(kw), k1 = bfhi(kw);
#pragma unroll
            for (int qi = 0; qi < 4; ++qi) sc[qi][kk] += qv[qi].x * k0 + qv[qi].y * k1; }
    }
#pragma unroll
    for (int qi = 0; qi < 4; ++qi) { float mx = -INFINITY;
#pragma unroll
        for (int kk = 0; kk < 4; ++kk) { const int pos = kbase + lane + 64 * kk; float lg = sc[qi][kk] * 0.125f - slope * (float)(tq[qi] - pos); if (MASK && pos > tq[qi]) lg = -INFINITY; sc[qi][kk] = lg; mx = fmaxf(mx, lg); }
        mx = wave_max(mx); float s = 0.f;
#pragma unroll
        for (int kk = 0; kk < 4; ++kk) { const float p = __builtin_amdgcn_exp2f((sc[qi][kk] - mx) * 1.4426950408889634f); pb[qi * 256 + lane + 64 * kk] = p; s += p; }
        lo[qi] = wave_sum(s); mo[qi] = mx; }
    float o[4] = {0.f, 0.f, 0.f, 0.f};
#pragma unroll 4
    for (int k4 = 0; k4 < 64; ++k4) { f32x4 p4[4];
#pragma unroll
        for (int qi = 0; qi < 4; ++qi) p4[qi] = *(const LAS f32x4*)(pb + qi * 256 + 4 * k4);
#pragma unroll
        for (int jj = 0; jj < 4; ++jj) { const float vv = bf2f(Vs[(4 * k4 + jj) * 64 + lane]);
#pragma unroll
            for (int qi = 0; qi < 4; ++qi) o[qi] += p4[qi][jj] * vv; } }
#pragma unroll
    for (int qi = 0; qi < 4; ++qi) oo[qi] = o[qi];
}
constexpr int AT_KS = 0, AT_VS = 33792, AT_WV = 66560, AT_WVB = 5120;

__device__ __forceinline__ void memattn_unit(LAS unsigned char* lds, const bf16* h, int NC, int qoff, const bf16* kv, bf16* mix, int unit, int tid, int wave, int lane) {
    const int chunk = unit & 31, bm = unit >> 5, mh = bm & 3, b = bm >> 2;
    LAS unsigned* Ks = (LAS unsigned*)(lds + AT_KS); LAS unsigned* Vs32 = (LAS unsigned*)(lds + AT_VS);
    LAS float* qst = (LAS float*)(lds + AT_WV + wave * AT_WVB); LAS float* pb = qst + 256;
    for (int i = 0; i < 16; ++i) { const int idx = tid + 512 * i, r = idx >> 5, dd = idx & 31; const unsigned* src = (const unsigned*)(kv + (size_t)(b * 256 + r) * 512 + mh * 64);
        Ks[r * 33 + dd] = src[dd]; Vs32[r * 32 + dd] = src[128 + dd]; }
    __syncthreads();
    for (int qd = 0; qd < 16; ++qd) { const size_t tg = (size_t)b * SEQ + chunk * 512 + wave * 64 + qd * 4;
#pragma unroll
        for (int qi = 0; qi < 4; ++qi) qst[qi * 64 + lane] = bf2f(h[(tg + qi) * NC + qoff + mh * 64 + lane]);
        const int tq[4] = {0, 0, 0, 0}; float m[4], l[4], o[4];
        attn4<false>(Ks, (const LAS bf16*)Vs32, qst, pb, lane, tq, 0, 0.f, m, l, o);
#pragma unroll
        for (int qi = 0; qi < 4; ++qi) mix[(tg + qi) * 1024 + MIXW + mh * 64 + lane] = (bf16)f2bf(o[qi] / l[qi]); }
    __syncthreads();
}

constexpr int AT2_K = 0, AT2_KROW = 176, AT2_V = 256 * AT2_KROW, AT2_VROW = 528, AT2_SCR = AT2_V + 64 * AT2_VROW, AT2_SCRW = 4864;
__device__ __forceinline__ void stage_kv_images(LAS unsigned char* lds, const bf16* kp, const bf16* vp, size_t row_stride, int tid) {
    v4u kx[4], vx[4];
#pragma unroll
    for (int i = 0; i < 4; ++i) { const int idx = tid + 512 * i, key = idx >> 3, c = idx & 7; kx[i] = *(const v4u*)(kp + (size_t)key * row_stride + 8 * c); vx[i] = *(const v4u*)(vp + (size_t)key * row_stride + 8 * c); }
    __builtin_amdgcn_sched_barrier(0);
#pragma unroll
    for (int i = 0; i < 4; ++i) { const int idx = tid + 512 * i, key = idx >> 3, c = idx & 7;
        *(LAS v4u*)(lds + AT2_K + key * AT2_KROW + c * 16) = kx[i];
        const int pos = (key & ~15) | (key & 3) | ((key & 4) << 1) | ((key & 8) >> 1);
        LAS bf16* vt = (LAS bf16*)(lds + AT2_V) + pos;
#pragma unroll
        for (int w = 0; w < 4; ++w) { vt[(8 * c + 2 * w) * (AT2_VROW / 2)] = (bf16)(vx[i][w] & 0xffffu); vt[(8 * c + 2 * w + 1) * (AT2_VROW / 2)] = (bf16)(vx[i][w] >> 16); } }
    if (tid < 256) { const unsigned pb = f2bf((float)tid); const v4u e0 = {pb | (pb << 16), 0u, 0u, 0u}, z = {0u, 0u, 0u, 0u};
        *(LAS v4u*)(lds + AT2_K + tid * AT2_KROW + 128) = e0; *(LAS v4u*)(lds + AT2_K + tid * AT2_KROW + 144) = z; }
}
template <bool MASK>
__device__ __forceinline__ void attn_tile32(const LAS unsigned char* lds, const s16x8 (&qf)[4], int lane, float dist0, unsigned qx, bool own, f32x16 (&o)[2], float& mrow, float& lrow) {
    const int r = lane & 31, hf = lane >> 5;
    const v4u qxv = {qx, 0u, 0u, 0u}; const s16x8 qe = __builtin_bit_cast(s16x8, qxv);
    f32x16 acc[8];
    const LAS unsigned char* kb = lds + AT2_K + r * AT2_KROW + hf * 16;
    constexpr int NKS = MASK ? 5 : 4;
    s16x8 kf[NKS];
#pragma unroll
    for (int s = 0; s < NKS; ++s) kf[s] = *(const LAS s16x8*)(kb + s * 32);
#pragma unroll
    for (int kt = 0; kt < 8; ++kt) {
#pragma unroll
        for (int i = 0; i < 16; ++i) acc[kt][i] = 0.f;
#pragma unroll
        for (int s = 0; s < NKS; ++s) { acc[kt] = __builtin_amdgcn_mfma_f32_32x32x16_bf16(kf[s], s < 4 ? qf[s < 4 ? s : 0] : qe, acc[kt], 0, 0, 0);
            if (kt + 1 < 8) kf[s] = *(const LAS s16x8*)(kb + (kt + 1) * 32 * AT2_KROW + s * 32); }
        __builtin_amdgcn_sched_barrier(0); }
    float mx = -INFINITY;
    if (MASK && own) { const float base2 = dist0 - 4.f * (float)hf;
#pragma unroll
        for (int kt = 0; kt < 8; ++kt)
#pragma unroll
            for (int i = 0; i < 16; ++i) { const float dist = base2 - (float)(32 * kt + (i & 3) + 8 * (i >> 2)); const float lg = dist < 0.f ? -INFINITY : acc[kt][i]; acc[kt][i] = lg; mx = fmaxf(mx, lg); }
    } else {
#pragma unroll
        for (int kt = 0; kt < 8; ++kt)
#pragma unroll
            for (int i = 0; i < 16; ++i) mx = fmaxf(mx, acc[kt][i]);
    }
    mx = fmaxf(mx, xor32f(mx, lane));
    float sum = 0.f;
#pragma unroll
    for (int i = 0; i < 16; ++i) { o[0][i] = 0.f; o[1][i] = 0.f; }
    const LAS unsigned char* vb = lds + AT2_V + r * AT2_VROW + hf * 16;
    s16x8 vf[4];
#pragma unroll
    for (int s2 = 0; s2 < 2; ++s2)
#pragma unroll
        for (int dt = 0; dt < 2; ++dt) vf[2 * s2 + dt] = *(const LAS s16x8*)(vb + dt * 32 * AT2_VROW + (16 * s2) * 2);
#pragma unroll
    for (int kt = 0; kt < 8; ++kt) {
#pragma unroll
        for (int i = 0; i < 16; ++i) { const float p = __builtin_amdgcn_exp2f(acc[kt][i] - mx); sum += p; acc[kt][i] = p; }
#pragma unroll
        for (int s2 = 0; s2 < 2; ++s2) { v4u pw; pw.x = cvtpk(acc[kt][8 * s2], acc[kt][8 * s2 + 1]); pw.y = cvtpk(acc[kt][8 * s2 + 2], acc[kt][8 * s2 + 3]);
            pw.z = cvtpk(acc[kt][8 * s2 + 4], acc[kt][8 * s2 + 5]); pw.w = cvtpk(acc[kt][8 * s2 + 6], acc[kt][8 * s2 + 7]); const s16x8 pf = __builtin_bit_cast(s16x8, pw);
#pragma unroll
            for (int dt = 0; dt < 2; ++dt) { o[dt] = __builtin_amdgcn_mfma_f32_32x32x16_bf16(vf[2 * s2 + dt], pf, o[dt], 0, 0, 0);
                if (kt + 1 < 8) vf[2 * s2 + dt] = *(const LAS s16x8*)(vb + dt * 32 * AT2_VROW + (32 * (kt + 1) + 16 * s2) * 2); } }
        __builtin_amdgcn_sched_barrier(0); }
    sum += xor32f(sum, lane);
    mrow = mx; lrow = sum;
}
__device__ __forceinline__ void memattn_unit2(LAS unsigned char* lds, const bf16* h, int NC, int qoff, const bf16* kv  , bf16* mix, int unit, int tid, int wave, int lane) {
    const int chunk = unit & 63, bm = unit >> 6, mh = bm & 3, b = bm >> 2, r = lane & 31, hf = lane >> 5;
    const bf16* kvrow0 = kv + (size_t)(b * 256) * 2048 + mh * 64;
    stage_kv_images(lds, kvrow0, kvrow0 + 256, 2048, tid);
    __syncthreads();
    { const size_t tg = (size_t)b * SEQ + chunk * 256 + wave * 32 + r;
        f32x16 o[2]; float m2, l; s16x8 qf[4];
#pragma unroll
        for (int s = 0; s < 4; ++s) qf[s] = *(const s16x8*)(h + tg * NC + qoff + mh * 64 + 16 * s + 8 * hf);
        attn_tile32<false>(lds, qf, lane, 0.f, 0u, false, o, m2, l);
        const float inv = 1.f / l; bf16* mp = mix + tg * 1024 + MIXW + mh * 64 + 4 * hf;
#pragma unroll
        for (int dt = 0; dt < 2; ++dt)
#pragma unroll
            for (int g = 0; g < 4; ++g) { v2u w; w.x = cvtpk(o[dt][4 * g] * inv, o[dt][4 * g + 1] * inv); w.y = cvtpk(o[dt][4 * g + 2] * inv, o[dt][4 * g + 3] * inv); *(v2u*)(mp + 32 * dt + 8 * g) = w; } }
    __syncthreads();
}
__device__ __forceinline__ void kmean_unit(LAS unsigned char* lds, const bf16* h, float* kmean, float* kmaxg, int unit, int tid, int wave) {
    const int n = unit & 63, bh = unit >> 6, hh = bh % MB_H, b = bh / MB_H, d = tid & 63, part = tid >> 6;
    LAS float* red = (LAS float*)lds;
    float s = 0.f; const bf16* p = h + ((size_t)b * SEQ + n * 256 + part * 32) * NC_M + 768 + hh * 64 + d;
    for (int i = 0; i < 32; ++i) s += bf2f(p[(size_t)i * NC_M]);
    float ss = 0.f; { const v4u* kp = (const v4u*)(h + ((size_t)b * SEQ + n * 256 + (tid >> 1)) * NC_M + 768 + hh * 64 + (tid & 1) * 32);
#pragma unroll
        for (int w = 0; w < 4; ++w) { const v4u x = kp[w]; ss += bflo(x.x) * bflo(x.x) + bfhi(x.x) * bfhi(x.x) + bflo(x.y) * bflo(x.y) + bfhi(x.y) * bfhi(x.y) + bflo(x.z) * bflo(x.z) + bfhi(x.z) * bfhi(x.z) + bflo(x.w) * bflo(x.w) + bfhi(x.w) * bfhi(x.w); } }
    ss += xorf<1>(ss); ss = wave_max(ss);
    red[part * 64 + d] = s; if ((tid & 63) == 0) red[512 + wave] = ss; __syncthreads();
    if (tid < 64) { float a = 0.f; for (int pp = 0; pp < 8; ++pp) a += red[pp * 64 + tid]; kmean[((size_t)bh * 64 + n) * 64 + tid] = a * (1.f / 256.f); }
    if (tid == 0) { float mx = 0.f; for (int w = 0; w < 8; ++w) mx = fmaxf(mx, red[512 + w]); kmaxg[bh * 64 + n] = sqrtf(mx) * 1.001f; }
    __syncthreads();
}
__device__ __forceinline__ void moba_gate_unit(LAS unsigned char* lds, const bf16* h, const float* kmean, const float* kmaxg, unsigned* gcount, int* selinfo, unsigned* list, int unit, int tid) {
    const int bh = unit >> 6, c = ((bh >> 2) & 1) ? 63 - (unit & 63) : (unit & 63), hh = bh % MB_H, b = bh / MB_H;
    LAS float* km = (LAS float*)lds; LAS int* hist = (LAS int*)(lds + 16384); LAS int* base = hist + 64;
    for (int i = tid; i < 4096; i += NTHR) km[i] = kmean[(size_t)bh * 4096 + i];
    LAS float* kmx = (LAS float*)(lds + 16384 + 512);
    if (tid < 64) { hist[tid] = 0; kmx[tid] = kmaxg[bh * 64 + tid]; }
    __syncthreads();
    int s0 = 0, s1 = 0, s2 = 0, r0 = 0, r1 = 0, r2 = 0, ns = 0; const int hb = tid >> 8, t = c * 256 + (tid & 255);
    float v0 = -INFINITY, v1 = -INFINITY, v2 = -INFINITY, qn = 0.f, lown = 0.f;
    {
        float q[64]; const v4u* qp = (const v4u*)(h + ((size_t)b * SEQ + t) * NC_M + hh * 64);
#pragma unroll
        for (int w = 0; w < 8; ++w) { const v4u x = qp[w]; q[8 * w] = bflo(x.x); q[8 * w + 1] = bfhi(x.x); q[8 * w + 2] = bflo(x.y); q[8 * w + 3] = bfhi(x.y); q[8 * w + 4] = bflo(x.z); q[8 * w + 5] = bfhi(x.z); q[8 * w + 6] = bflo(x.w); q[8 * w + 7] = bfhi(x.w); }
        { const v4u* kp = (const v4u*)(h + ((size_t)b * SEQ + t) * NC_M + 768 + hh * 64); float qq = 0.f, qk = 0.f;
#pragma unroll
          for (int w = 0; w < 8; ++w) { const v4u x = kp[w]; qk += q[8 * w] * bflo(x.x) + q[8 * w + 1] * bfhi(x.x) + q[8 * w + 2] * bflo(x.y) + q[8 * w + 3] * bfhi(x.y) + q[8 * w + 4] * bflo(x.z) + q[8 * w + 5] * bfhi(x.z) + q[8 * w + 6] * bflo(x.w) + q[8 * w + 7] * bfhi(x.w); }
#pragma unroll
          for (int d = 0; d < 64; ++d) qq += q[d] * q[d];
          qn = sqrtf(qq) * 1.001f; lown = qk; }
        for (int n = hb; n < c; n += 2) { f32x2 g2 = {0.f, 0.f};
#pragma unroll
            for (int d4 = 0; d4 < 16; ++d4) { const f32x4 k4 = *(const LAS f32x4*)(km + n * 64 + 4 * d4); const f32x2 ka_ = {k4.x, k4.y}, kb_ = {k4.z, k4.w}, qa_ = {q[4 * d4], q[4 * d4 + 1]}, qb_ = {q[4 * d4 + 2], q[4 * d4 + 3]}; g2 = qa_ * ka_ + g2; g2 = qb_ * kb_ + g2; }
            const float g = g2.x + g2.y;
            if (g > v0) { v2 = v1; s2 = s1; v1 = v0; s1 = s0; v0 = g; s0 = n; } else if (g > v1) { v2 = v1; s2 = s1; v1 = g; s1 = n; } else if (g > v2) { v2 = g; s2 = n; } }
    }
    LAS float* cv = (LAS float*)(lds + 20480); LAS int* cs = (LAS int*)(lds + 20480 + 3072);
    if (hb == 1) { cv[tid & 255] = v0; cv[256 + (tid & 255)] = v1; cv[512 + (tid & 255)] = v2; cs[tid & 255] = s0; cs[256 + (tid & 255)] = s1; cs[512 + (tid & 255)] = s2; }
    __syncthreads();
    if (tid < 256) {
#pragma unroll
        for (int k = 0; k < 3; ++k) { const float g = cv[256 * k + tid]; const int n = cs[256 * k + tid];
            if (g > v0 || (g == v0 && n < s0)) { v2 = v1; s2 = s1; v1 = v0; s1 = s0; v0 = g; s0 = n; } else if (g > v1 || (g == v1 && n < s1)) { v2 = v1; s2 = s1; v1 = g; s1 = n; } else if (g > v2 || (g == v2 && n < s2)) { v2 = g; s2 = n; } }
        ns = c < 3 ? c : 3;
        { const float slope2 = (hh < 8 ? ldexpf(1.0f, -(hh + 1)) : ldexpf(0.70710678118654752f, -(hh - 8))) * 1.4426950408889634f;
          const bool k0 = ns > 0 && (qn * kmx[s0] - slope2 * (float)(t - (s0 * 256 + 255)) - lown) > -64.f;
          const bool k1 = ns > 1 && (qn * kmx[s1] - slope2 * (float)(t - (s1 * 256 + 255)) - lown) > -64.f;
          const bool k2 = ns > 2 && (qn * kmx[s2] - slope2 * (float)(t - (s2 * 256 + 255)) - lown) > -64.f;
          ns = (k0 ? 1 : 0) | (k1 ? 2 : 0) | (k2 ? 4 : 0); }
        if (ns & 1) r0 = __hip_atomic_fetch_add(hist + s0, 1, __ATOMIC_RELAXED, __HIP_MEMORY_SCOPE_WORKGROUP);
        if (ns & 2) r1 = __hip_atomic_fetch_add(hist + s1, 1, __ATOMIC_RELAXED, __HIP_MEMORY_SCOPE_WORKGROUP);
        if (ns & 4) r2 = __hip_atomic_fetch_add(hist + s2, 1, __ATOMIC_RELAXED, __HIP_MEMORY_SCOPE_WORKGROUP);
        selinfo[((size_t)b * SEQ + t) * MB_H + hh] = ns;
    }
    __syncthreads();
    if (tid < 64) { const int hc = hist[tid]; if (hc > 0) base[tid] = (int)__hip_atomic_fetch_add(gcount + bh * 64 + tid, (unsigned)hc, __ATOMIC_RELAXED, __HIP_MEMORY_SCOPE_AGENT); }
    __syncthreads();
    if (tid < 256) { unsigned* lp = list + ((size_t)bh * 64 << 14);
        if (ns & 1) lp[((size_t)s0 << 14) + base[s0] + r0] = (unsigned)t;
        if (ns & 2) lp[((size_t)s1 << 14) + base[s1] + r1] = (unsigned)t | (1u << 14);
        if (ns & 4) lp[((size_t)s2 << 14) + base[s2] + r2] = (unsigned)t | (2u << 14); }
    __syncthreads();
}
__device__ __forceinline__ void moba_attn_item(LAS unsigned char* lds, const bf16* h, const unsigned* gcount, const unsigned* list, float* po, float* pml, int item, int tid, int wave, int lane) {
    const int n = item / 24, bh = item - n * 24, hh = bh % MB_H, b = bh / MB_H;
    LAS unsigned* Ks = (LAS unsigned*)(lds + AT_KS); LAS unsigned* Vs32 = (LAS unsigned*)(lds + AT_VS);
    LAS float* qst = (LAS float*)(lds + AT_WV + wave * AT_WVB); LAS float* pb = qst + 256;
    for (int i = 0; i < 16; ++i) { const int idx = tid + 512 * i, r = idx >> 5, dd = idx & 31; const unsigned* src = (const unsigned*)(h + ((size_t)b * SEQ + n * 256 + r) * NC_M + hh * 64);
        Ks[r * 33 + dd] = src[384 + dd]; Vs32[r * 32 + dd] = src[768 + dd]; }
    __syncthreads();
    const int cnt = (int)gcount[bh * 64 + n], total = 256 + cnt, nquads = (total + 3) >> 2;
    const float slope = hh < 8 ? ldexpf(1.0f, -(hh + 1)) : ldexpf(0.70710678118654752f, -(hh - 8));
    const unsigned* lp = list + (((size_t)bh * 64 + n) << 14);
    for (int quad = wave; quad < nquads; quad += 8) {
        int tq[4], slot[4];
#pragma unroll
        for (int qi = 0; qi < 4; ++qi) { int idx = quad * 4 + qi; idx = idx < total ? idx : total - 1;
            if (idx < 256) { tq[qi] = n * 256 + idx; slot[qi] = 3; } else { const unsigned e = lp[idx - 256]; tq[qi] = (int)(e & 16383u); slot[qi] = (int)(e >> 14); } }
#pragma unroll
        for (int qi = 0; qi < 4; ++qi) qst[qi * 64 + lane] = bf2f(h[((size_t)b * SEQ + tq[qi]) * NC_M + hh * 64 + lane]);
        float m[4], l[4], o[4];
        attn4<true>(Ks, (const LAS bf16*)Vs32, qst, pb, lane, tq, n * 256, slope, m, l, o);
#pragma unroll
        for (int qi = 0; qi < 4; ++qi) if (quad * 4 + qi < total) { const size_t pi = (((size_t)b * SEQ + tq[qi]) * MB_H + hh) * 4 + slot[qi];
            po[pi * 64 + lane] = o[qi]; if (lane == 0) { pml[pi * 2] = m[qi]; pml[pi * 2 + 1] = l[qi]; } }
    }
    __syncthreads();
}

__device__ __forceinline__ void moba_attn_item2(LAS unsigned char* lds, const bf16* h, const unsigned* gcount, const unsigned* list, bf16* po, float* pml, int item, int tid, int wave, int lane) {
    const int n = item / 24, bh = item - n * 24, hh = bh % MB_H, b = bh / MB_H, r = lane & 31, hf = lane >> 5;
    const bf16* hrow0 = h + ((size_t)b * SEQ + n * 256) * NC_M + hh * 64;
    stage_kv_images(lds, hrow0 + 768, hrow0 + 1536, NC_M, tid);
    __syncthreads();
    const int cnt = (int)gcount[bh * 64 + n], total = 256 + cnt, ntiles = (total + 31) >> 5;
    const float slope2 = (hh < 8 ? ldexpf(1.0f, -(hh + 1)) : ldexpf(0.70710678118654752f, -(hh - 8))) * 1.4426950408889634f;
    const unsigned shi = f2bf(slope2), slo = f2bf(slope2 - __builtin_bit_cast(float, shi << 16)); const unsigned qx = hf == 0 ? (shi | (slo << 16)) : 0u;
    const unsigned* lp = list + (((size_t)bh * 64 + n) << 14);
    const bf16* hq = h + (size_t)b * SEQ * NC_M + hh * 64 + 8 * hf;
#pragma unroll 1
    for (int tile = wave; tile < ntiles; tile += NWAVES) {
        int idx = tile * 32 + r; const bool valid = idx < total; idx = valid ? idx : total - 1;
        int tq, slot; if (idx < 256) { tq = n * 256 + idx; slot = 3; } else { const unsigned e = lp[idx - 256]; tq = (int)(e & 16383u); slot = (int)(e >> 14); }
        s16x8 qf[4]; { const bf16* qp = hq + (size_t)tq * NC_M;
#pragma unroll
            for (int s = 0; s < 4; ++s) qf[s] = *(const s16x8*)(qp + 16 * s); }
        f32x16 o[2]; float m2, l; const float dist0 = (float)(tq - n * 256);
        attn_tile32<true>(lds, qf, lane, dist0, qx, tile < 8, o, m2, l);
        { LAS unsigned char* sw = lds + AT2_SCR + wave * AT2_SCRW; const int pi = valid ? (int)((((size_t)b * SEQ + tq) * MB_H + hh) * 4 + slot) : -1;
#pragma unroll
          for (int dt = 0; dt < 2; ++dt)
#pragma unroll
              for (int g = 0; g < 4; ++g) { v2u w; w.x = cvtpk(o[dt][4 * g], o[dt][4 * g + 1]); w.y = cvtpk(o[dt][4 * g + 2], o[dt][4 * g + 3]); *(LAS v2u*)(sw + r * 144 + (32 * dt + 8 * g + 4 * hf) * 2) = w; }
          if (hf == 0) { *(LAS int*)(sw + 4608 + 4 * r) = pi; if (valid) { pml[(size_t)pi * 2] = m2 - slope2 * dist0; pml[(size_t)pi * 2 + 1] = l; } }
#pragma unroll
          for (int it = 0; it < 4; ++it) { const int q = 8 * it + (lane >> 3), c = lane & 7; const int pq = *(const LAS int*)(sw + 4608 + 4 * q); const v4u row = *(const LAS v4u*)(sw + q * 144 + c * 16);
              if (pq >= 0) *(v4u*)(po + (size_t)pq * 64 + c * 8) = row; } }
    }
    __syncthreads();
}
__device__ __forceinline__ void moba_combine(const bf16* __restrict__ po, const float* __restrict__ pml, const int* __restrict__ selinfo, bf16* __restrict__ mix, int gw, int ngw, int lane) {
    const int sub = lane >> 4, d4 = (lane & 15) * 4;
#pragma unroll 4
    for (int idx = gw * 4 + sub; idx < T * MB_H; idx += ngw * 4) { const int tg = idx / MB_H, hh = idx - tg * MB_H, ns = selinfo[idx]; const size_t p4 = (size_t)idx * 4;
        f32x2 ml[4]; f32x4 ov[4];
#pragma unroll
        for (int j = 0; j < 4; ++j) { ml[j] = ((const f32x2*)pml)[p4 + j]; const v2u ow = *(const v2u*)(po + (p4 + j) * 64 + d4); ov[j] = (f32x4){bflo(ow.x), bfhi(ow.x), bflo(ow.y), bfhi(ow.y)}; }
        float M = ml[3].x;
#pragma unroll
        for (int j = 0; j < 3; ++j) { const bool ok = (ns >> j) & 1; ml[j].x = ok ? ml[j].x : -INFINITY; ml[j].y = ok ? ml[j].y : 0.f; M = fmaxf(M, ml[j].x);
            ov[j].x = ok ? ov[j].x : 0.f; ov[j].y = ok ? ov[j].y : 0.f; ov[j].z = ok ? ov[j].z : 0.f; ov[j].w = ok ? ov[j].w : 0.f; }
        float den = 0.f; f32x4 num = {0.f, 0.f, 0.f, 0.f};
#pragma unroll
        for (int j = 0; j < 4; ++j) { const float w = __builtin_amdgcn_exp2f(ml[j].x - M); den += w * ml[j].y; num += ov[j] * w; }
        const float inv = 1.f / den; v2u o; o.x = pk2(num.x * inv, num.y * inv); o.y = pk2(num.z * inv, num.w * inv);
        *(v2u*)(mix + (size_t)tg * 1024 + hh * 64 + d4) = o; }
}

__device__ __forceinline__ void ln_row(f32x4 (&v)[4], const f32x4 (&gv)[4], const f32x4 (&bv)[4]) {
    float s = 0.f;
#pragma unroll
    for (int j = 0; j < 4; ++j) s += (v[j].x + v[j].y) + (v[j].z + v[j].w);
    const float mean = wave_sum(s) * (1.f / D); float s2 = 0.f;
#pragma unroll
    for (int j = 0; j < 4; ++j) { v[j] = v[j] - mean; s2 += (v[j].x * v[j].x + v[j].y * v[j].y) + (v[j].z * v[j].z + v[j].w * v[j].w); }
    const float rstd = 1.f / sqrtf(wave_sum(s2) * (1.f / D) + 1e-5f);
#pragma unroll
    for (int j = 0; j < 4; ++j) v[j] = v[j] * rstd * gv[j] + bv[j];
}
__device__ __forceinline__ void split_router_weights(const float* wr  , bf16* wrs  , size_t gtid, size_t gthreads) {
    for (size_t i = gtid; i < (size_t)DEPTH * D * NE; i += gthreads) { const int e = (int)(i & 31), d = (int)((i >> 5) & 1023), l = (int)(i >> 15);
        const float w = wr[i]; const unsigned hi = f2bf(w); const unsigned lo = f2bf(w - __builtin_bit_cast(float, hi << 16));
        wrs[(((size_t)l * 2 + 0) * NE + e) * D + d] = (bf16)hi; wrs[(((size_t)l * 2 + 1) * NE + e) * D + d] = (bf16)lo; }
}
constexpr int L1_XH = 0, L1_XL = 33024, L1_ROW = 2064, L1_PART = 66048, L1_HIST = 82432;
__device__ __forceinline__ void phase_ln1(LAS unsigned char* lds, const bf16* y, const float* g, const float* bb, const bf16* wrs  , const float* br,
                                          bf16* xbf, int* tok_e, int* tok_lr, float* tok_w, int* blk_cnt, int blk, int tid, int wave, int lane) {
    LAS float* part = (LAS float*)(lds + L1_PART);
    LAS int* hist = (LAS int*)(lds + L1_HIST);
    if (tid < 32) hist[tid] = 0;
    constexpr int TPB = T / GRID;
    const int e = lane & 31, m16 = lane & 15, quad = lane >> 4;
    s16x8 bw[4][2][2];
#pragma unroll
    for (int ks = 0; ks < 4; ++ks)
#pragma unroll
        for (int nt = 0; nt < 2; ++nt)
#pragma unroll
            for (int pp = 0; pp < 2; ++pp) bw[ks][nt][pp] = *(const s16x8*)(wrs + ((size_t)pp * NE + 16 * nt + m16) * D + wave * 128 + 32 * ks + 8 * quad);
    const float bre = br[e];
    f32x4 gv[4], bv[4];
#pragma unroll
    for (int j = 0; j < 4; ++j) { gv[j] = ((const f32x4*)g)[lane + 64 * j]; bv[j] = ((const f32x4*)bb)[lane + 64 * j]; }
    v2u xn[2][4], yn[2][4];
#pragma unroll
    for (int u = 0; u < 2; ++u) { const size_t t0 = (size_t)blk * TPB + 2 * wave + u; const v2u* xr = (const v2u*)(xbf + t0 * D) + lane; const v2u* yr = (const v2u*)(y + t0 * D) + lane;
#pragma unroll
        for (int j = 0; j < 4; ++j) { xn[u][j] = xr[64 * j]; yn[u][j] = yr[64 * j]; } }
    __syncthreads();
    for (int grp = 0; grp < TPB / 16; ++grp) { const size_t tg0 = (size_t)blk * TPB + grp * 16 + 2 * wave;
        f32x4 v[2][4];
#pragma unroll
        for (int u = 0; u < 2; ++u)
#pragma unroll
            for (int j = 0; j < 4; ++j) { const v2u xw = xn[u][j]; const v2u yw = yn[u][j];
                v[u][j].x = DN_ALPHA * bflo(xw.x) + bflo(yw.x); v[u][j].y = DN_ALPHA * bfhi(xw.x) + bfhi(yw.x); v[u][j].z = DN_ALPHA * bflo(xw.y) + bflo(yw.y); v[u][j].w = DN_ALPHA * bfhi(xw.y) + bfhi(yw.y); }
        if (grp + 1 < TPB / 16) {
#pragma unroll
            for (int u = 0; u < 2; ++u) { const v2u* xr = (const v2u*)(xbf + (tg0 + 16 + u) * D) + lane; const v2u* yr = (const v2u*)(y + (tg0 + 16 + u) * D) + lane;
#pragma unroll
                for (int j = 0; j < 4; ++j) { xn[u][j] = xr[64 * j]; yn[u][j] = yr[64 * j]; } } }
#pragma unroll
        for (int u = 0; u < 2; ++u) { ln_row(v[u], gv, bv);
            v2u* xb = (v2u*)(xbf + (tg0 + u) * D) + lane;
#pragma unroll
            for (int j = 0; j < 4; ++j) { v2u hw; hw.x = cvtpk(v[u][j].x, v[u][j].y); hw.y = cvtpk(v[u][j].z, v[u][j].w); xb[64 * j] = hw;
                v2u lw; lw.x = cvtpk(v[u][j].x - bflo(hw.x), v[u][j].y - bfhi(hw.x)); lw.y = cvtpk(v[u][j].z - bflo(hw.y), v[u][j].w - bfhi(hw.y));
                *(LAS v2u*)(lds + L1_XH + (2 * wave + u) * L1_ROW + (4 * lane + 256 * j) * 2) = hw; *(LAS v2u*)(lds + L1_XL + (2 * wave + u) * L1_ROW + (4 * lane + 256 * j) * 2) = lw; } }
        __syncthreads();
        { f32x4 acc[2] = {{0.f, 0.f, 0.f, 0.f}, {0.f, 0.f, 0.f, 0.f}};
#pragma unroll
          for (int ks = 0; ks < 4; ++ks) { const int off = m16 * L1_ROW + (wave * 128 + 32 * ks + 8 * quad) * 2;
              const s16x8 ah = *(const LAS s16x8*)(lds + L1_XH + off), al = *(const LAS s16x8*)(lds + L1_XL + off);
#pragma unroll
              for (int nt = 0; nt < 2; ++nt) { acc[nt] = __builtin_amdgcn_mfma_f32_16x16x32_bf16(ah, bw[ks][nt][0], acc[nt], 0, 0, 0); acc[nt] = __builtin_amdgcn_mfma_f32_16x16x32_bf16(ah, bw[ks][nt][1], acc[nt], 0, 0, 0);
                  acc[nt] = __builtin_amdgcn_mfma_f32_16x16x32_bf16(al, bw[ks][nt][0], acc[nt], 0, 0, 0); } }
#pragma unroll
          for (int nt = 0; nt < 2; ++nt)
#pragma unroll
              for (int jj = 0; jj < 4; ++jj) part[(wave * 16 + 4 * quad + jj) * 32 + 16 * nt + m16] = acc[nt][jj]; }
        __syncthreads();
#pragma unroll
        for (int u = 0; u < 2; ++u) { const size_t t = tg0 + u;
            float logit = bre;
#pragma unroll
            for (int w = 0; w < 8; ++w) logit += part[(w * 16 + 2 * wave + u) * 32 + e];
            int rank = 0;
#pragma unroll
            for (int q = 0; q < 32; ++q) { const float oq = __builtin_bit_cast(float, __builtin_amdgcn_readlane(__builtin_bit_cast(int, logit), q)); rank += (oq > logit || (oq == logit && q < e)) ? 1 : 0; }
            int se[4]; float sv[4];
#pragma unroll
            for (int k = 0; k < 4; ++k) { const unsigned long long mk = __ballot(rank == k && lane < 32); const int src = __builtin_ctzll(mk);
                se[k] = src; sv[k] = __builtin_bit_cast(float, __builtin_amdgcn_readlane(__builtin_bit_cast(int, logit), src)); }
            const float e1 = __expf(sv[1] - sv[0]), e2 = __expf(sv[2] - sv[0]), e3 = __expf(sv[3] - sv[0]), inv = 1.f / (1.f + e1 + e2 + e3);
            const float wk[4] = {inv, e1 * inv, e2 * inv, e3 * inv};
            if (lane == 0) {
#pragma unroll
                for (int k = 0; k < 4; ++k) { const int lr = __hip_atomic_fetch_add(hist + se[k], 1, __ATOMIC_RELAXED, __HIP_MEMORY_SCOPE_WORKGROUP);
                    tok_e[t * 4 + k] = se[k]; tok_lr[t * 4 + k] = lr; tok_w[t * 4 + k] = wk[k]; } } }
    }
    __syncthreads();
    if (tid < 32) blk_cnt[blk * 32 + tid] = hist[tid];
    __syncthreads();
}
__device__ __forceinline__ void phase_dispatch(LAS unsigned char* lds, const int* __restrict__ blk_cnt, const int* __restrict__ tok_e, const int* __restrict__ tok_lr, int* __restrict__ tok_row, int* __restrict__ tab,
                                               const bf16* __restrict__ xbf, bf16* __restrict__ xs, int blk, int tid, int wave, int lane) {
    LAS int* tot = (LAS int*)lds; LAS int* pre = tot + 32; LAS int* pst = pre + 32; LAS int* rows = pst + 64;
    if (tid < 32) { int s = 0, p = 0;
#pragma unroll 8
        for (int bb = 0; bb < GRID; ++bb) { const int c = blk_cnt[bb * 32 + tid]; p += (bb < blk) ? c : 0; s += c; } tot[tid] = s; pre[tid] = p; }
    __syncthreads();
    if (tid == 0) { int acc = 0; for (int e = 0; e < 32; ++e) { pst[e] = acc; acc += ((tot[e] + 255) >> 8) << 8; } pst[32] = acc; }
    __syncthreads();
    if (blk == 0 && tid < 33) tab[tid] = pst[tid] >> 8;
    constexpr int TPB = T / GRID;
    static_assert(TPB * 4 == NTHR, "one (token, k) pair per thread");
    { const size_t ti = (size_t)blk * TPB * 4 + tid; const int e = tok_e[ti]; const int r = pst[e] + pre[e] + tok_lr[ti]; tok_row[ti] = r; rows[tid] = r; }
    __syncthreads();
#pragma unroll 4
    for (int i = wave; i < TPB * 4; i += NWAVES) { const int r = rows[i];
        const v4u* src = (const v4u*)(xbf + ((size_t)blk * TPB + (i >> 2)) * D) + 2 * lane; const v4u a = src[0], b = src[1];
        v4u o; o.x = pk4_fp8(bflo(a.x), bfhi(a.x), bflo(a.y), bfhi(a.y)); o.y = pk4_fp8(bflo(a.z), bfhi(a.z), bflo(a.w), bfhi(a.w)); o.z = pk4_fp8(bflo(b.x), bfhi(b.x), bflo(b.y), bfhi(b.y)); o.w = pk4_fp8(bflo(b.z), bfhi(b.z), bflo(b.w), bfhi(b.w));
        ((v4u*)((unsigned char*)xs + (size_t)r * D))[lane] = o; }
    __syncthreads();
}
__device__ __forceinline__ f32x4 fp8x4_to_f32(unsigned w) {
    const f32x2 lo = __builtin_amdgcn_cvt_pk_f32_fp8((int)w, false), hi = __builtin_amdgcn_cvt_pk_f32_fp8((int)w, true); return (f32x4){lo.x, lo.y, hi.x, hi.y};
}
__device__ __forceinline__ void phase_ln2(const unsigned char* __restrict__ yrows, const int* __restrict__ tok_row, const float* __restrict__ tok_w, const float* __restrict__ g, const float* __restrict__ bb,
                                          float* __restrict__ xout, bf16* xbf, int gw, int ngw, int lane) {
    f32x4 gv[4], bv[4];
#pragma unroll
    for (int j = 0; j < 4; ++j) { gv[j] = ((const f32x4*)g)[lane + 64 * j]; bv[j] = ((const f32x4*)bb)[lane + 64 * j]; }
    constexpr int NTK = 2;
    static_assert(T % (NTK * GRID * NWAVES) == 0, "NTK tokens per wave per step");
    for (int t0 = gw; t0 < T; t0 += NTK * ngw) {
        f32x4 v[NTK][4];
#pragma unroll
        for (int u = 0; u < NTK; ++u) { const int t = t0 + u * ngw; int r[4]; float w[4];
#pragma unroll
            for (int k = 0; k < 4; ++k) { r[k] = tok_row[(size_t)t * 4 + k]; w[k] = tok_w[(size_t)t * 4 + k] * (1.f / 16.f); }
            const v2u* xr = (const v2u*)(xbf + (size_t)t * D) + lane;
#pragma unroll
            for (int j = 0; j < 4; ++j) { f32x4 f = {0.f, 0.f, 0.f, 0.f};
#pragma unroll
                for (int k = 0; k < 4; ++k) { const unsigned yw = ((const unsigned*)(yrows + (size_t)r[k] * D))[lane + 64 * j]; f += fp8x4_to_f32(yw) * w[k]; }
                const v2u xw = xr[64 * j]; v[u][j].x = DN_ALPHA * bflo(xw.x) + f.x; v[u][j].y = DN_ALPHA * bfhi(xw.x) + f.y; v[u][j].z = DN_ALPHA * bflo(xw.y) + f.z; v[u][j].w = DN_ALPHA * bfhi(xw.y) + f.w; } }
#pragma unroll
        for (int u = 0; u < NTK; ++u) { const int t = t0 + u * ngw;
            ln_row(v[u], gv, bv);
            if (xout) { f32x4* xo = (f32x4*)(xout + (size_t)t * D) + lane;
#pragma unroll
                for (int j = 0; j < 4; ++j) xo[64 * j] = v[u][j]; }
            else { v2u* xb = (v2u*)(xbf + (size_t)t * D) + lane;
#pragma unroll
                for (int j = 0; j < 4; ++j) { v2u ww; ww.x = pk2(v[u][j].x, v[u][j].y); ww.y = pk2(v[u][j].z, v[u][j].w); xb[64 * j] = ww; } } } }
}

struct Args { const float* in[20]; float* out; unsigned char* ws; int l_lo, l_hi, ph_lo, ph_hi; };
typedef const __attribute__((address_space(4))) Args* KArgsP;
#define KA_LOAD() ({ KArgsP p_ = (KArgsP)__builtin_amdgcn_kernarg_segment_ptr(); asm volatile("" : "+s"(p_)); p_; })
#ifndef PHMASK
#define PHMASK 0xFFFF
#endif
#ifndef REPEAT_MASK
#define REPEAT_MASK 0
#endif
#ifndef REPEAT_LMASK
#define REPEAT_LMASK 0xF
#endif
#define PH_BEGIN(k) _Pragma("unroll") for (int rep_ = 0; rep_ < ((((REPEAT_MASK >> (k)) & 1) && ((REPEAT_LMASK >> l) & 1)) ? 2 : 1); ++rep_) { if ((PHMASK >> (k)) & 1) { KArgsP ka = KA_LOAD(); unsigned char* ws = ka->ws; int tid = threadIdx.x; asm volatile("" : "+v"(tid)); \
    const int lane = tid & 63, wave = __builtin_amdgcn_readfirstlane(tid >> 6); int blk = blockIdx.x; asm volatile("" : "+s"(blk)); \
    const int gw = blk * NWAVES + wave; const size_t gtid = (size_t)blk * NTHR + tid; (void)lane; (void)gw; (void)gtid; (void)ws;
#if ONE_LAUNCH
#define PH_SEAM() do { XcdBarrier b_; b_.bar = (unsigned*)(KA_LOAD()->ws + WS_CTL) + CW_BAR; b_.x = xb_xcc_id(); b_.st = (volatile LAS unsigned*)(lds + MISC_OFF); xcd_barrier(b_); } while (0)
#else
#define PH_SEAM() do {} while (0)
#endif
#define PH_END() PH_SEAM(); } }
#define PH_END_NOSEAM() } }
#define WSP(type, off) ((type*)(ws + (off)))
constexpr int G = GRID, NGW = GRID * NWAVES; constexpr size_t GTHREADS = (size_t)GRID * NTHR;
template <int L> __device__ __forceinline__ void layer_phases(LAS unsigned char* lds) {
    constexpr int l = L; LAS int* tabL = (LAS int*)(lds + MISC_OFF + 256);

        const int j = l >> 1; const bool moba = (l & 1) != 0;
        const int NC = moba ? NC_M : NC_H, qoff = moba ? 2304 : 3072;

        if (l == 0) {
        PH_BEGIN(1)
            phase_weights((LAS float*)(lds + wave * 16384), gw, NGW, lane, ka->in[2], NC_H, ka->in[6], 4, ka->in[7], ka->in[12], ka->in[14], ka->in[16], WSP(bf16, WS_WIN), WSP(bf16, WS_WKV4), WSP(bf16, WS_WO), WSP(bf16, WS_WGU), WSP(bf16, WS_WD));
        PH_END()
        }
        PH_BEGIN(2)
            { pg8::Gemm g{WSP(bf16, WS_XBF), WSP(bf16, WS_WIN), T, NC, D, 0, 0}; pg8::StaticOrder S; S.init(T, NC, G, blk); pg8::EpiPlain E{WSP(bf16, WS_H), NC, moba ? 0x207u : 0x1000u, 0.125f * 1.4426950408889634f};
              pg8::gemm_phase<pg8::EpiPlain, pg8::StaticOrder, true, true>(lds, g, S, E); }
            if (l == 0) {
              pg8::Gemm g{WSP(bf16, WS_MEMBF), WSP(bf16, WS_WKV4), 512, 2048, D, 0, 0}; pg8::StaticOrder S; S.init(512, 2048, G, blk >= 128 ? blk - 128 : G); pg8::EpiPlain E{WSP(bf16, WS_KV4), 2048, 0u, 1.f};
              pg8::gemm_phase<pg8::EpiPlain, pg8::StaticOrder, true, true>(lds, g, S, E); }
        PH_END()
        if (!moba) {
            PH_BEGIN(3)
                for (int u = blk; u < NBATCH * HG_H * HNSEG; u += G) hgrn_mfma<false>(lds, WSP(bf16, WS_H), ka->in[3], j, ka->in[4] + j * 128, WSP(float, WS_SLOC), WSP(float, WS_DSEG), WSP(bf16, WS_MIX), u, tid, wave, lane);
                for (int u = blk; u < 512; u += G) memattn_unit2(lds, WSP(bf16, WS_H), NC, qoff, WSP(bf16, WS_KV4) + 512 * l, WSP(bf16, WS_MIX), u, tid, wave, lane);
            PH_END()
            PH_BEGIN(4)
                hgrn_scan(WSP(float, WS_SLOC), WSP(float, WS_DSEG), gtid, GTHREADS);
            PH_END()
            PH_BEGIN(5)
                for (int u = blk; u < NBATCH * HG_H * HNSEG; u += G) hgrn_mfma<true>(lds, WSP(bf16, WS_H), ka->in[3], j, ka->in[4] + j * 128, WSP(float, WS_SLOC), WSP(float, WS_DSEG), WSP(bf16, WS_MIX), u, tid, wave, lane);
            PH_END()
        } else {
            PH_BEGIN(3)
                for (int u = blk; u < 24 * MB_NB; u += G) kmean_unit(lds, WSP(bf16, WS_H), WSP(float, WS_KMEAN), WSP(float, WS_KMEAN + 512 * 1024), u, tid, wave);
                for (int u = blk; u < 512; u += G) memattn_unit2(lds, WSP(bf16, WS_H), NC, qoff, WSP(bf16, WS_KV4) + 512 * l, WSP(bf16, WS_MIX), u, tid, wave, lane);
            PH_END()
            PH_BEGIN(4)
                for (int u = blk; u < 24 * MB_NB; u += G) moba_gate_unit(lds, WSP(bf16, WS_H), WSP(float, WS_KMEAN), WSP(float, WS_KMEAN + 512 * 1024), WSP(unsigned, WS_CTL) + CW_GCOUNT + j * 1536, WSP(int, WS_SELINFO), WSP(unsigned, WS_LIST), u, tid);
            PH_END()
            PH_BEGIN(5)
                { unsigned* qhead = WSP(unsigned, WS_CTL) + CW_GCOUNT + 2 * 1536 + 64 * j; LAS int* itl = (LAS int*)(lds + MISC_OFF + 512);
                  for (;;) { if (tid == 0) *itl = (int)__hip_atomic_fetch_add(qhead, 1u, __ATOMIC_RELAXED, __HIP_MEMORY_SCOPE_AGENT);
                      __syncthreads(); const int it = *itl; __syncthreads();
                      if (it >= 24 * MB_NB) break;
                      moba_attn_item2(lds, WSP(bf16, WS_H), WSP(unsigned, WS_CTL) + CW_GCOUNT + j * 1536, WSP(unsigned, WS_LIST), WSP(bf16, WS_PO), WSP(float, WS_PML), it, tid, wave, lane); } }
            PH_END()
            PH_BEGIN(6)
                moba_combine(WSP(bf16, WS_PO), WSP(float, WS_PML), WSP(int, WS_SELINFO), WSP(bf16, WS_MIX), gw, NGW, lane);
            PH_END()
        }
        PH_BEGIN(7)
            pg8::Gemm g{WSP(bf16, WS_MIX), WSP(bf16, WS_WO), T, D, D, 0, 0}; pg8::StaticOrder S; S.init(T, D, G, blk); pg8::EpiPlain E{WSP(bf16, WS_Y), D, 0u, 1.f};
            pg8::gemm_phase<pg8::EpiPlain, pg8::StaticOrder, true, true>(lds, g, S, E);
        PH_END()
        PH_BEGIN(8)
            phase_ln1(lds, WSP(bf16, WS_Y), ka->in[8] + l * D, ka->in[9] + l * D, WSP(bf16, WS_WRS) + (size_t)l * 2 * NE * D, ka->in[11] + l * NE, WSP(bf16, WS_XBF),
                      WSP(int, WS_TOK + TOK_E), WSP(int, WS_TOK + TOK_LR), WSP(float, WS_TOK + TOK_W), WSP(int, WS_TOK + TOK_BLKCNT), blk, tid, wave, lane);
        PH_END()
        PH_BEGIN(9)
            phase_dispatch(lds, WSP(int, WS_TOK + TOK_BLKCNT), WSP(int, WS_TOK + TOK_E), WSP(int, WS_TOK + TOK_LR), WSP(int, WS_TOK + TOK_ROW), WSP(int, WS_TOK + TOK_TAB), WSP(bf16, WS_XBF), WSP(bf16, WS_XS), blk, tid, wave, lane);
        PH_END()
        PH_BEGIN(10)
            if (tid < 33) tabL[tid] = WSP(int, WS_TOK + TOK_TAB)[tid];
            __syncthreads();
            int sw_ = 0x7A7A7A7A, sx_ = 0x7F7F7F7F; asm volatile("" : "+s"(sw_), "+s"(sx_));
            pg8::Gemm g{WSP(bf16, WS_XS), WSP(bf16, WS_WGU), MOE_MAXROWS, NE * 2048, D / 2, sw_, sx_}; pg8::MoeOrder S{tabL, 8, G, blk, tabL[32] * 8};
            pg8::EpiSwiglu E{WSP(unsigned char, WS_HID), ka->in[13] + (size_t)l * NE * 1024, ka->in[15] + (size_t)l * NE * 1024};
            pg8::gemm_phase<pg8::EpiSwiglu, pg8::MoeOrder, true, true, true>(lds, g, S, E);
        PH_END()
        PH_BEGIN(11)
            if (tid < 33) tabL[tid] = WSP(int, WS_TOK + TOK_TAB)[tid];
            __syncthreads();
            int sw_ = 0x79797979, sx_ = 0x7F7F7F7F; asm volatile("" : "+s"(sw_), "+s"(sx_));
            pg8::Gemm g{WSP(bf16, WS_HID), WSP(bf16, WS_WD), MOE_MAXROWS, NE * 1024, D / 2, sw_, sx_}; pg8::MoeOrder S{tabL, 4, G, blk, tabL[32] * 4};
            pg8::EpiDown E{WSP(unsigned char, WS_XS), ka->in[17] + (size_t)l * NE * 1024};
            pg8::gemm_phase<pg8::EpiDown, pg8::MoeOrder, true, true, true>(lds, g, S, E);
        PH_END()
        PH_BEGIN(12)
            float* x2out = (l == DEPTH - 1) ? ka->out : nullptr;
            phase_ln2(WSP(unsigned char, WS_XS), WSP(int, WS_TOK + TOK_ROW), WSP(float, WS_TOK + TOK_W), ka->in[18] + l * D, ka->in[19] + l * D, x2out, WSP(bf16, WS_XBF), gw, NGW, lane);
            if (l + 1 < DEPTH) { constexpr int ln = l + 1, jn = ln >> 1; constexpr bool mn = (ln & 1) != 0;
                const float* win_src = mn ? ka->in[5] + (size_t)jn * D * NC_M : ka->in[2] + (size_t)jn * D * NC_H; const size_t moff = (size_t)ln * NE * 1024 * 1024;
                phase_weights((LAS float*)(lds + wave * 16384), gw, NGW, lane, win_src, mn ? NC_M : NC_H, ka->in[6], 0, ka->in[7] + (size_t)ln * D * D,
                              ka->in[12] + moff, ka->in[14] + moff, ka->in[16] + moff, WSP(bf16, WS_WIN), WSP(bf16, WS_WKV4), WSP(bf16, WS_WO), WSP(bf16, WS_WGU), WSP(bf16, WS_WD)); }
            if (l + 1 < DEPTH) PH_SEAM();
        PH_END_NOSEAM()
}
__global__ void __launch_bounds__(NTHR, 2) fwd_kernel(Args args) {
    extern __shared__ __attribute__((aligned(16))) unsigned char lds_raw[];
    LAS unsigned char* lds = (LAS unsigned char*)lds_raw;
    if (threadIdx.x < 4) ((LAS unsigned*)(lds + MISC_OFF))[threadIdx.x] = 0u;
    __syncthreads();
#if ONE_LAUNCH
    (void)xcd_barrier_post((unsigned*)(args.ws + WS_CTL) + CW_BAR, (volatile LAS unsigned*)(lds + MISC_OFF));
#endif
    { const int l = 0; (void)l;
    PH_BEGIN(0)
        cvt_rows_bf16(ka->in[0], WSP(bf16, WS_XBF), (size_t)T * D / 8, gtid, GTHREADS);
        cvt_rows_bf16(ka->in[1], WSP(bf16, WS_MEMBF), (size_t)512 * D / 8, gtid, GTHREADS);
        split_router_weights(ka->in[10], WSP(bf16, WS_WRS), gtid, GTHREADS);
    PH_END_NOSEAM() }
    layer_phases<0>(lds); layer_phases<1>(lds); layer_phases<2>(lds); layer_phases<3>(lds);
}

extern "C" void kernel_launch(void* const* d_in, const int* in_sizes, int n_in, void* d_out, int out_size, void* d_ws, size_t ws_size, hipStream_t stream) {
    static int ready = 0;
    if (ready == 0) {
        if (n_in != 20 || in_sizes[0] != T * D || out_size != T * D || ws_size < WS_END) { fprintf(stderr, "kernel_launch: unexpected shapes (n_in %d, in0 %d, out %d, ws %zu < %zu)\n", n_in, n_in > 0 ? in_sizes[0] : -1, out_size, ws_size, (size_t)WS_END); ready = -1; return; }
        if (hipFuncSetAttribute((const void*)fwd_kernel, hipFuncAttributeMaxDynamicSharedMemorySize, LDS_BYTES) != hipSuccess) { fprintf(stderr, "kernel_launch: hipFuncSetAttribute failed\n"); ready = -1; return; }
        int per_cu = 0;
        if (hipOccupancyMaxActiveBlocksPerMultiprocessor(&per_cu, (const void*)fwd_kernel, NTHR, LDS_BYTES) != hipSuccess || per_cu < 1) fprintf(stderr, "kernel_launch: occupancy query says %d\n", per_cu);
        (void)hipGetLastError();
        ready = 1;
    }
    if (ready < 0) return;
    if (hipMemsetAsync((char*)d_ws + WS_CTL, 0, CTL_ZERO_BYTES, stream) != hipSuccess) return;
    Args a{};
    for (int i = 0; i < 20; ++i) a.in[i] = (const float*)d_in[i];
    a.out = (float*)d_out; a.ws = (unsigned char*)d_ws;
    a.l_lo = 0; a.l_hi = DEPTH; a.ph_lo = 0; a.ph_hi = NPHASE;
    hipLaunchKernelGGL(fwd_kernel, dim3(GRID), dim3(NTHR), LDS_BYTES, stream, a);
}
```

```cpp
#include <hip/hip_runtime.h>
#include <cstdio>
#include <cstdint>
#include <cmath>
namespace pg8 {
#define PG8_LAS __attribute__((address_space(3)))
typedef unsigned short bf16_t;
typedef short bf16x8 __attribute__((ext_vector_type(8)));
typedef float f32x4 __attribute__((ext_vector_type(4)));
typedef unsigned u32x4 __attribute__((ext_vector_type(4)));
constexpr int BM = 256, BK = 64, HALF = 128, HTB = HALF * BK * 2  , STAGE_BYTES = 8 * HTB, NXCD = 8, WGM = 8;

__host__ __device__ __forceinline__ int lds_byte(int r, int c) { const int st = (r >> 4) * 2 + (c >> 5), rr = r & 15, cc = c & 31, ob = rr * 64 + cc * 2; return st * 1024 + (ob ^ (((ob >> 9) & 1) << 5)); }
__host__ __device__ __forceinline__ void stage_rc(int b, int& R, int& C) { const int st = b / 1024, sb = b % 1024, swz = sb ^ (((sb >> 9) & 1) << 5); R = (st >> 1) * 16 + swz / 64; C = (st & 1) * 32 + (swz % 64) / 2; }
__host__ __device__ __forceinline__ int perm32(int rho) { const int n = rho >> 4, i = rho & 15; return 8 * (i >> 2) + 4 * n + (i & 3); }

struct Unit { int pm, pn; };
struct Gemm { const bf16_t* A; const bf16_t* Bt; int M, N, K; int sw, sx; };
typedef int i32x8 __attribute__((ext_vector_type(8))); typedef int i32x4 __attribute__((ext_vector_type(4)));

struct StaticOrder {
    int nM, nN, nwg, G, c;
    __host__ __device__ void init(int M, int N, int G_, int c_) { nM = M / BM; nN = N / BM; nwg = nM * nN; G = G_; c = c_; }
    __host__ __device__ bool next(int i, Unit& u) const {
        const long L = (long)i * G + c; if (L >= nwg) return false;
        int wgid = (int)L; { const int q = nwg / NXCD, r = nwg % NXCD, xcd = wgid % NXCD, off = wgid / NXCD; wgid = (xcd < r ? xcd * (q + 1) : r * (q + 1) + (xcd - r) * q) + off; }
        const int nig = WGM * nN, gid = wgid / nig, fm = gid * WGM, gsz = (nM - fm) < WGM ? (nM - fm) : WGM;
        u.pm = fm + ((wgid % nig) % gsz); u.pn = (wgid % nig) / gsz; return true;
    }
    __device__ __forceinline__ void a_ready(const Unit&) const {}
    __device__ __forceinline__ void done(const Unit&) const {}
};

__device__ __forceinline__ unsigned cvt_pk_bf16(float lo, float hi) { unsigned r; asm volatile("v_cvt_pk_bf16_f32 %0, %1, %2" : "=v"(r) : "v"(lo), "v"(hi)); return r; }
typedef float f32x2 __attribute__((ext_vector_type(2)));
struct EpiPlain {
    static constexpr bool PERM = true, AFTER_DRAIN = false;
    bf16_t* O; int ldc; unsigned smask; float sc;
    struct Pre {};
    __device__ __forceinline__ void pre_load(const Unit&, int, int, Pre&) const {}
    __device__ __forceinline__ void acc_init(f32x4 (&acc)[2][2][4][2], const Pre&) const {
#pragma unroll
        for (int a = 0; a < 2; ++a)
#pragma unroll
            for (int b = 0; b < 2; ++b)
#pragma unroll
                for (int m = 0; m < 4; ++m)
#pragma unroll
                    for (int n = 0; n < 2; ++n) acc[a][b][m][n] = (f32x4){0.f, 0.f, 0.f, 0.f}; }
    __device__ __forceinline__ void operator()(const f32x4 (&acc)[2][2][4][2], const Unit& u, int wr, int wc, int fr, int fq) const {
        const int row0 = u.pm * BM + wr * 64 + fr; const int col0 = u.pn * BM + wc * 32 + 8 * fq; const float s = ((smask >> u.pn) & 1u) ? sc : 1.f;
#pragma unroll
        for (int ai = 0; ai < 2; ++ai)
#pragma unroll
            for (int m = 0; m < 4; ++m) { bf16_t* rowp = O + (size_t)(row0 + ai * HALF + m * 16) * ldc + col0;
#pragma unroll
                for (int bj = 0; bj < 2; ++bj) { const f32x4 v0 = acc[ai][bj][m][0] * s, v1 = acc[ai][bj][m][1] * s;
                    u32x4 w; w.x = cvt_pk_bf16(v0[0], v0[1]); w.y = cvt_pk_bf16(v0[2], v0[3]); w.z = cvt_pk_bf16(v1[0], v1[1]); w.w = cvt_pk_bf16(v1[2], v1[3]);
                    *(u32x4*)(rowp + bj * HALF) = w; } }
    }
};
__device__ __forceinline__ float swiglu1(float g, float u) {
    g = fminf(g, 7.0f); u = fminf(fmaxf(u, -7.0f), 7.0f);
    const float s = __builtin_amdgcn_rcpf(1.0f + __builtin_amdgcn_exp2f(g * (-1.702f * 1.4426950408889634f)));
    return g * s * (u + 1.0f);
}
__device__ __forceinline__ unsigned pk4_fp8e(float a, float b, float c, float d) { int w = 0; w = __builtin_amdgcn_cvt_pk_fp8_f32(a, b, w, false); w = __builtin_amdgcn_cvt_pk_fp8_f32(c, d, w, true); return (unsigned)w; }
struct EpiSwiglu {
    static constexpr bool PERM = true, AFTER_DRAIN = false;
    unsigned char* hid; const float* bg; const float* bu;
    struct Pre { f32x4 g0, g1, u0, u1; };
    __device__ __forceinline__ void pre_load(const Unit& u, int wc, int fq, Pre& p) const { const int e = u.pn >> 3, col0 = (u.pn & 7) * 128 + wc * 32 + 8 * fq;
        p.g0 = *(const f32x4*)(bg + e * 1024 + col0); p.g1 = *(const f32x4*)(bg + e * 1024 + col0 + 4); p.u0 = *(const f32x4*)(bu + e * 1024 + col0); p.u1 = *(const f32x4*)(bu + e * 1024 + col0 + 4); }
    __device__ __forceinline__ void acc_init(f32x4 (&acc)[2][2][4][2], const Pre& p) const {
#pragma unroll
        for (int a = 0; a < 2; ++a)
#pragma unroll
            for (int m = 0; m < 4; ++m) { acc[a][0][m][0] = p.g0; acc[a][0][m][1] = p.g1; acc[a][1][m][0] = p.u0; acc[a][1][m][1] = p.u1; } }
    __device__ __forceinline__ void operator()(const f32x4 (&acc)[2][2][4][2], const Unit& u, int wr, int wc, int fr, int fq) const {
        const int pn = u.pn & 7;
        const int row0 = u.pm * BM + wr * 64 + fr; const int col0 = pn * 128 + wc * 32 + 8 * fq;
#pragma unroll
        for (int ai = 0; ai < 2; ++ai)
#pragma unroll
            for (int m = 0; m < 4; ++m) { unsigned char* rowp = hid + (size_t)(row0 + ai * HALF + m * 16) * 1024 + col0;
                const f32x4 ga = acc[ai][0][m][0], gb = acc[ai][0][m][1], ua = acc[ai][1][m][0], ub = acc[ai][1][m][1];
                typedef unsigned u32x2 __attribute__((ext_vector_type(2))); u32x2 w;
                w.x = pk4_fp8e(swiglu1(ga[0], ua[0]), swiglu1(ga[1], ua[1]), swiglu1(ga[2], ua[2]), swiglu1(ga[3], ua[3]));
                w.y = pk4_fp8e(swiglu1(gb[0], ub[0]), swiglu1(gb[1], ub[1]), swiglu1(gb[2], ub[2]), swiglu1(gb[3], ub[3]));
                *(u32x2*)rowp = w; }
    }
};
struct EpiDown {
    static constexpr bool PERM = true, AFTER_DRAIN = false;
    unsigned char* y; const float* bd;
    struct Pre { f32x4 b[2][2]; };
    __device__ __forceinline__ void pre_load(const Unit& u, int wc, int fq, Pre& p) const { const int e = u.pn >> 2, col0 = (u.pn & 3) * BM + wc * 32 + 8 * fq;
#pragma unroll
        for (int bj = 0; bj < 2; ++bj)
#pragma unroll
            for (int n = 0; n < 2; ++n) p.b[bj][n] = *(const f32x4*)(bd + e * 1024 + col0 + bj * HALF + 4 * n); }
    __device__ __forceinline__ void acc_init(f32x4 (&acc)[2][2][4][2], const Pre& p) const {
#pragma unroll
        for (int a = 0; a < 2; ++a)
#pragma unroll
            for (int bj = 0; bj < 2; ++bj)
#pragma unroll
                for (int m = 0; m < 4; ++m) { acc[a][bj][m][0] = p.b[bj][0]; acc[a][bj][m][1] = p.b[bj][1]; } }
    __device__ __forceinline__ void operator()(const f32x4 (&acc)[2][2][4][2], const Unit& u, int wr, int wc, int fr, int fq) const {
        const int pn = u.pn & 3;
        const int row0 = u.pm * BM + wr * 64 + fr; const int col0 = pn * BM + wc * 32 + 8 * fq;
#pragma unroll
        for (int ai = 0; ai < 2; ++ai)
#pragma unroll
            for (int m = 0; m < 4; ++m) { unsigned char* rowp = y + (size_t)(row0 + ai * HALF + m * 16) * 1024 + col0;
#pragma unroll
                for (int bj = 0; bj < 2; ++bj) { const f32x4 v0 = acc[ai][bj][m][0] * 16.f, v1 = acc[ai][bj][m][1] * 16.f;
                    typedef unsigned u32x2 __attribute__((ext_vector_type(2))); u32x2 w; w.x = pk4_fp8e(v0[0], v0[1], v0[2], v0[3]); w.y = pk4_fp8e(v1[0], v1[1], v1[2], v1[3]);
                    *(u32x2*)(rowp + bj * HALF) = w; } }
    }
};
struct MoeOrder {
    const PG8_LAS int* tab; int npn, G, c, nunits;
    __device__ __forceinline__ bool next(int i, Unit& u) const {
        const int tpx = 32 / npn, s = c >> 3, tile = (i * 8 + (c & 7)) * tpx + s / npn, pn = s % npn;
        if ((i * 8) * tpx >= nunits / npn) return false;
        if (tile >= nunits / npn) { u.pm = 0; u.pn = 0; return false; }
        int e = 0;
#pragma unroll
        for (int k = 1; k < 32; ++k) e += (tab[k] <= tile) ? 1 : 0;
        u.pm = tile; u.pn = __builtin_amdgcn_readfirstlane(e) * npn + pn; return true;
    }
    __device__ __forceinline__ void a_ready(const Unit&) const {}
    __device__ __forceinline__ void done(const Unit&) const {}
};
template <class Epi, class Sched, bool ALIGN_EPI = false, bool SP2 = false, bool F8 = false>
__device__ __forceinline__ void gemm_phase(PG8_LAS unsigned char* lds, const Gemm g, const Sched& S, const Epi& E) {
    int tid_ = threadIdx.x; asm volatile("" : "+v"(tid_));
    const int tid = tid_, wid = __builtin_amdgcn_readfirstlane(tid >> 6), lane = tid & 63, wr = wid >> 2, wc = wid & 3, fr = lane & 15, fq = lane >> 4;
    const int K = g.K, nt = K / BK;
    unsigned voffA, voffB;
    { int R, C; stage_rc(tid * 16, R, C); const int Rb = Epi::PERM ? ((R & ~31) + perm32(R & 31)) : R; voffA = (unsigned)(R * K + C) * 2u; voffB = (unsigned)(Rb * K + C) * 2u; }
    const unsigned qstep = 64u * (unsigned)K * 2u;
    const unsigned kstep = (unsigned)(BK * 2);
    const unsigned hstep = (unsigned)HALF * (unsigned)K * 2u;
    const unsigned tstep = 2u * hstep;
    const __amdgpu_buffer_rsrc_t rA = __builtin_amdgcn_make_buffer_rsrc((void*)g.A, 0, 0x7FFFFFFF, 0x00020000), rB = __builtin_amdgcn_make_buffer_rsrc((void*)g.Bt, 0, 0x7FFFFFFF, 0x00020000);
    const unsigned ldsw = (unsigned)wid * 1024u;
    const int aoff = lds_byte(wr * 64 + fr, fq * 8), boff = lds_byte(wc * 32 + fr, fq * 8);
#define PG8_SA(b, h) (((b) * 2 + (h)) * HTB)
#define PG8_SB(b, h) ((4 + (b) * 2 + (h)) * HTB)
#define PG8_STG(bufoff, rsrc, soff, voff) do { _Pragma("unroll") for (int _i = 0; _i < 2; ++_i) \
        __builtin_amdgcn_raw_ptr_buffer_load_lds((rsrc), (PG8_LAS void*)(lds + (bufoff) + ldsw + _i * 8192), 16, (int)(voff), (int)((soff) + (unsigned)_i * qstep), 0, 0); } while (0)
#define PG8_STGA(bufoff, soff) PG8_STG(bufoff, rA, soff, voffA)
#define PG8_STGB(bufoff, soff) PG8_STG(bufoff, rB, soff, voffB)
#define PG8_LDA(dst, b, h) do { _Pragma("unroll") for (int m = 0; m < 4; ++m) { if constexpr (F8) { const i32x4 lo_ = *(const PG8_LAS i32x4*)(lds + PG8_SA(b, h) + aoff + m * 2048), hi_ = *(const PG8_LAS i32x4*)(lds + PG8_SA(b, h) + aoff + m * 2048 + 1024); \
            dst##_8[m] = __builtin_shufflevector(lo_, hi_, 0, 1, 2, 3, 4, 5, 6, 7); } else { _Pragma("unroll") for (int k = 0; k < 2; ++k) dst[m][k] = *(const PG8_LAS bf16x8*)(lds + PG8_SA(b, h) + aoff + m * 2048 + k * 1024); } } } while (0)
#define PG8_LDB(dst, b, h) do { _Pragma("unroll") for (int n = 0; n < 2; ++n) { if constexpr (F8) { const i32x4 lo_ = *(const PG8_LAS i32x4*)(lds + PG8_SB(b, h) + boff + n * 2048), hi_ = *(const PG8_LAS i32x4*)(lds + PG8_SB(b, h) + boff + n * 2048 + 1024); \
            dst##_8[n] = __builtin_shufflevector(lo_, hi_, 0, 1, 2, 3, 4, 5, 6, 7); } else { _Pragma("unroll") for (int k = 0; k < 2; ++k) dst[n][k] = *(const PG8_LAS bf16x8*)(lds + PG8_SB(b, h) + boff + n * 2048 + k * 1024); } } } while (0)
#define PG8_MMA(ai, bj, At, Bt) do { __builtin_amdgcn_s_setprio(1); _Pragma("unroll") for (int m = 0; m < 4; ++m) _Pragma("unroll") for (int n = 0; n < 2; ++n) { \
        if constexpr (F8) acc[ai][bj][m][n] = __builtin_amdgcn_mfma_scale_f32_16x16x128_f8f6f4(Bt##_8[n], At##_8[m], acc[ai][bj][m][n], 0, 0, 0, g.sw, 0, g.sx); \
        else { _Pragma("unroll") for (int k = 0; k < 2; ++k) acc[ai][bj][m][n] = __builtin_amdgcn_mfma_f32_16x16x32_bf16(Bt[n][k], At[m][k], acc[ai][bj][m][n], 0, 0, 0); } } \
        __builtin_amdgcn_s_setprio(0); } while (0)
#define PG8_WAIT_V(n) asm volatile("s_waitcnt vmcnt(" #n ")" ::: "memory")
#define PG8_WAIT_L(n) asm volatile("s_waitcnt lgkmcnt(" #n ")" ::: "memory")
#define PG8_BAR __builtin_amdgcn_s_barrier()
#define PG8_SCHED __builtin_amdgcn_sched_barrier(0)
    Unit cur, nxt; int ui = 0;
    if (!S.next(0, cur)) return;
    f32x4 acc[2][2][4][2];
    typename Epi::Pre pre; E.pre_load(cur, wc, fq, pre); E.acc_init(acc, pre);
    bf16x8 At[4][2], B0[2][2], B1[2][2]; i32x8 At_8[4], B0_8[2], B1_8[2];
    unsigned cA = (unsigned)cur.pm * tstep, cB = (unsigned)cur.pn * tstep;
    S.a_ready(cur);
    if constexpr (SP2) {
        PG8_STGB(PG8_SB(0, 0), cB); PG8_STGB(PG8_SB(0, 1), cB + hstep); PG8_STGA(PG8_SA(0, 0), cA); PG8_STGA(PG8_SA(0, 1), cA + hstep);
        if (wr == 1) PG8_BAR;
        PG8_WAIT_V(2); PG8_BAR;
        PG8_STGB(PG8_SB(1, 0), cB + kstep); PG8_STGA(PG8_SA(1, 0), cA + kstep); PG8_STGB(PG8_SB(1, 1), cB + hstep + kstep);
        PG8_WAIT_V(6); PG8_BAR;
    } else {
        PG8_STGB(PG8_SB(0, 0), cB); PG8_STGA(PG8_SA(0, 0), cA); PG8_STGB(PG8_SB(0, 1), cB + hstep); PG8_STGA(PG8_SA(0, 1), cA + hstep);
        if (wr == 1) PG8_BAR;
        PG8_WAIT_V(4); PG8_BAR;
        PG8_STGB(PG8_SB(1, 0), cB + kstep); PG8_STGA(PG8_SA(1, 0), cA + kstep); PG8_STGB(PG8_SB(1, 1), cB + hstep + kstep);
        PG8_WAIT_V(6); PG8_BAR;
    }
    for (;;) {
        const bool has_next = S.next(ui + 1, nxt);
        const unsigned nA = has_next ? (unsigned)nxt.pm * tstep : cA, nB = has_next ? (unsigned)nxt.pn * tstep : cB;
#pragma unroll 1
        for (int t = 0; t < nt; t += 2) {
            const bool last = (t == nt - 2);
            const unsigned a1 = cA + (unsigned)(t + 1) * kstep;
            const unsigned a2 = last ? nA : cA + (unsigned)(t + 2) * kstep, b2 = last ? nB : cB + (unsigned)(t + 2) * kstep;
            const unsigned a3 = a2 + kstep, b3 = b2 + kstep;
            if (last && has_next) S.a_ready(nxt);
            if constexpr (SP2) {
            PG8_LDB(B0, 0, 0); PG8_LDB(B1, 0, 1); PG8_SCHED; PG8_LDA(At, 0, 0); PG8_STGA(PG8_SA(1, 1), a1 + hstep);
            PG8_WAIT_V(8); PG8_WAIT_L(0); PG8_BAR; PG8_MMA(0, 0, At, B0); PG8_MMA(0, 1, At, B1); PG8_BAR; PG8_SCHED;
            PG8_LDA(At, 0, 1); PG8_STGB(PG8_SB(0, 0), b2); PG8_STGB(PG8_SB(0, 1), b2 + hstep); PG8_STGA(PG8_SA(0, 0), a2);
            PG8_WAIT_V(8); PG8_WAIT_L(0); PG8_BAR; PG8_MMA(1, 0, At, B0); PG8_MMA(1, 1, At, B1); PG8_BAR; PG8_SCHED;
            PG8_LDB(B0, 1, 0); PG8_LDB(B1, 1, 1); PG8_SCHED; PG8_LDA(At, 1, 0); PG8_STGA(PG8_SA(0, 1), a2 + hstep);
            PG8_WAIT_V(8); PG8_WAIT_L(0); PG8_BAR; PG8_MMA(0, 0, At, B0); PG8_MMA(0, 1, At, B1); PG8_BAR; PG8_SCHED;
            PG8_LDA(At, 1, 1); PG8_STGB(PG8_SB(1, 0), b3); PG8_STGB(PG8_SB(1, 1), b3 + hstep); PG8_STGA(PG8_SA(1, 0), a3);
            PG8_WAIT_V(8); PG8_WAIT_L(0); PG8_BAR; PG8_MMA(1, 0, At, B0); PG8_MMA(1, 1, At, B1); PG8_BAR; PG8_SCHED;
            } else {
            PG8_LDB(B0, 0, 0); PG8_SCHED; PG8_LDA(At, 0, 0); PG8_STGA(PG8_SA(1, 1), a1 + hstep);
            PG8_WAIT_L(8); PG8_BAR; PG8_WAIT_L(0); PG8_MMA(0, 0, At, B0); PG8_BAR; PG8_SCHED;
            PG8_LDB(B1, 0, 1); PG8_STGB(PG8_SB(0, 0), b2);
            PG8_BAR; PG8_WAIT_L(0); PG8_MMA(0, 1, At, B1); PG8_BAR;
            PG8_LDA(At, 0, 1); PG8_STGA(PG8_SA(0, 0), a2);
            PG8_BAR; PG8_WAIT_L(0); PG8_MMA(1, 0, At, B0); PG8_BAR; PG8_SCHED;
            PG8_STGB(PG8_SB(0, 1), b2 + hstep);
            PG8_WAIT_V(6); PG8_BAR; PG8_MMA(1, 1, At, B1); PG8_BAR;
            PG8_LDB(B0, 1, 0); PG8_SCHED; PG8_LDA(At, 1, 0); PG8_STGA(PG8_SA(0, 1), a2 + hstep);
            PG8_WAIT_L(8); PG8_BAR; PG8_WAIT_L(0); PG8_MMA(0, 0, At, B0); PG8_BAR; PG8_SCHED;
            PG8_LDB(B1, 1, 1); PG8_STGB(PG8_SB(1, 0), b3);
            PG8_BAR; PG8_WAIT_L(0); PG8_MMA(0, 1, At, B1); PG8_BAR;
            PG8_LDA(At, 1, 1); PG8_STGA(PG8_SA(1, 0), a3);
            PG8_BAR; PG8_WAIT_L(0); PG8_MMA(1, 0, At, B0); PG8_BAR; PG8_SCHED;
            PG8_STGB(PG8_SB(1, 1), b3 + hstep);
            PG8_WAIT_V(6); PG8_BAR; PG8_MMA(1, 1, At, B1); PG8_BAR;
            }
        }
        if constexpr (ALIGN_EPI) { if (wr == 0) PG8_BAR; }
        if constexpr (!Epi::AFTER_DRAIN) { int t2_ = threadIdx.x; asm volatile("" : "+v"(t2_)); { const Unit pu_ = has_next ? nxt : cur; E.pre_load(pu_, wc, (t2_ & 63) >> 4, pre); }     E(acc, cur, wr, wc, t2_ & 15, (t2_ & 63) >> 4); S.done(cur); }
        if (!has_next) break;
        E.acc_init(acc, pre);
        cur = nxt; cA = nA; cB = nB; ++ui;
        if constexpr (ALIGN_EPI) { if (wr == 1) PG8_BAR; }
    }
    PG8_WAIT_V(0);
    if constexpr (!ALIGN_EPI) { if (wr == 0) PG8_BAR; }
    PG8_BAR;
    if constexpr (Epi::AFTER_DRAIN) { E.fused(acc, cur, wr, wc, fr, fq, lds, wid, lane); S.done(cur); }
#undef PG8_SA
#undef PG8_SB
#undef PG8_STG
#undef PG8_STGA
#undef PG8_STGB
#undef PG8_LDA
#undef PG8_LDB
#undef PG8_MMA
#undef PG8_WAIT_V
#undef PG8_WAIT_L
#undef PG8_BAR
#undef PG8_SCHED
}
}

constexpr int NWAVES = 8, NTHR = 512, GRID = 256;
constexpr int NBATCH = 2, SEQ = 16384, T = NBATCH * SEQ, D = 1024, DEPTH = 4;
constexpr int MIXW = 768, NC_H = 3328, NC_M = 2560;
constexpr int HG_H = 6;
constexpr int HSEG = 256, HNSEG = SEQ / HSEG;
constexpr int MB_H = 12, MB_NB = 64;
constexpr int NE = 32;
constexpr float DN_ALPHA = 1.6817928305074290f;
constexpr int MOE_MAXROWS = T * 4 + NE * 256;
#ifndef ONE_LAUNCH
#define ONE_LAUNCH 1
#endif
constexpr int NPHASE = 13;

constexpr size_t MiB = 1u << 20;
constexpr size_t WS_CTL = 0, CTL_ZERO_BYTES = 1 * MiB;
constexpr size_t WS_WIN = 1 * MiB, WS_WKV = 9 * MiB, WS_WO = 10 * MiB, WS_WGU = 12 * MiB, WS_WD = 140 * MiB;
constexpr size_t WS_XBF = 204 * MiB, WS_WKV4 = 268 * MiB  , WS_KV4 = 272 * MiB  , WS_WRS = 280 * MiB  , WS_MEMBF = 524 * MiB;
constexpr size_t WS_H = 526 * MiB, WS_MIX = 734 * MiB, WS_Y = 798 * MiB, WS_SLOC = 862 * MiB, WS_DSEG = 910 * MiB, WS_KMEAN = 911 * MiB;
constexpr size_t WS_SELINFO = 912 * MiB, WS_TOK = 914 * MiB, WS_R1 = 918 * MiB;
constexpr size_t WS_LIST = WS_R1, WS_PML = WS_R1 + 96 * MiB, WS_PO = WS_R1 + 108 * MiB;
constexpr size_t WS_XS = WS_R1, WS_HID = WS_R1 + 272 * MiB;
constexpr size_t WS_END = WS_R1 + 544 * MiB;
static_assert((size_t)MOE_MAXROWS * 1024 * 2 <= 272 * MiB, "moe rows");
static_assert((size_t)T * MB_H * 4 * 64 * 4 <= 384 * MiB && (size_t)24 * 64 * 16384 * 4 <= 96 * MiB, "moba bufs");
constexpr size_t TOK_E = 0, TOK_LR = 512 * 1024, TOK_W = 1024 * 1024, TOK_ROW = 1536 * 1024, TOK_BLKCNT = 2048 * 1024, TOK_TAB = 2048 * 1024 + 65536;
constexpr int CW_BAR = 4096, CW_GCOUNT = 8192;

constexpr int RING_BYTES = 131072, LDS_BYTES = 147456, MISC_OFF = LDS_BYTES - 1024;

#define GAS __attribute__((address_space(1)))
#define LAS __attribute__((address_space(3)))
typedef unsigned short bf16;
typedef unsigned v4u __attribute__((ext_vector_type(4)));
typedef unsigned v2u __attribute__((ext_vector_type(2)));
typedef float f32x4 __attribute__((ext_vector_type(4)));
typedef float f32x2 __attribute__((ext_vector_type(2)));
typedef short s16x8 __attribute__((ext_vector_type(8)));
typedef float f32x16 __attribute__((ext_vector_type(16)));
typedef float f32x2_t __attribute__((ext_vector_type(2))); typedef __bf16 bf16x2_t __attribute__((ext_vector_type(2)));
__device__ __forceinline__ unsigned cvtpk(float lo, float hi) { f32x2_t v = {lo, hi}; bf16x2_t b = __builtin_convertvector(v, bf16x2_t); return __builtin_bit_cast(unsigned, b); }
#define LDS_WAIT() asm volatile("s_waitcnt lgkmcnt(0)" ::: "memory")
__device__ __forceinline__ unsigned f2bf(float f) { unsigned u = __builtin_bit_cast(unsigned, f); return (u + 0x7fffu + ((u >> 16) & 1u)) >> 16; }
__device__ __forceinline__ unsigned pk2(float lo, float hi) { return f2bf(lo) | (f2bf(hi) << 16); }
__device__ __forceinline__ float bflo(unsigned w) { return __builtin_bit_cast(float, w << 16); }
__device__ __forceinline__ float bfhi(unsigned w) { return __builtin_bit_cast(float, w & 0xffff0000u); }
__device__ __forceinline__ float bf2f(bf16 h) { return __builtin_bit_cast(float, (unsigned)h << 16); }
__device__ __forceinline__ float sigmoidf_(float z) { return __builtin_amdgcn_rcpf(1.0f + __builtin_amdgcn_exp2f(-1.4426950408889634f * z)); }
template <int X> __device__ __forceinline__ float xorf(float v) { return __builtin_bit_cast(float, __builtin_amdgcn_ds_swizzle(__builtin_bit_cast(int, v), (X << 10) | 0x1F)); }
template <int X> __device__ __forceinline__ int xori(int v) { return __builtin_amdgcn_ds_swizzle(v, (X << 10) | 0x1F); }
__device__ __forceinline__ float wave_sum(float v) {
    v += xorf<1>(v); v += xorf<2>(v); v += xorf<4>(v); v += xorf<8>(v); v += xorf<16>(v);
    return __builtin_bit_cast(float, __builtin_amdgcn_readlane(__builtin_bit_cast(int, v), 0)) + __builtin_bit_cast(float, __builtin_amdgcn_readlane(__builtin_bit_cast(int, v), 32));
}
__device__ __forceinline__ float wave_max(float v) {
    v = fmaxf(v, xorf<1>(v)); v = fmaxf(v, xorf<2>(v)); v = fmaxf(v, xorf<4>(v)); v = fmaxf(v, xorf<8>(v)); v = fmaxf(v, xorf<16>(v));
    return fmaxf(__builtin_bit_cast(float, __builtin_amdgcn_readlane(__builtin_bit_cast(int, v), 0)), __builtin_bit_cast(float, __builtin_amdgcn_readlane(__builtin_bit_cast(int, v), 32)));
}
__device__ __forceinline__ float xor32f(float v, int lane) { return __builtin_bit_cast(float, __builtin_amdgcn_ds_bpermute((lane ^ 32) << 2, __builtin_bit_cast(int, v))); }
#define XB_TMO      128
#define XB_XCNT(j)  (256  + 64 * (j))
#define XB_XSUB(j)  (1280 + 64 * (j))
#define XB_XGEN(j)  (2304 + 64 * (j))
#define XB_TOP      3328
#define XB_TOPGEN   3392
#define XCD_BAR_WORDS 3456
#define XB_SPIN_CAP (1u << 18)

__device__ __forceinline__ unsigned xb_ld(unsigned* p)              { return __hip_atomic_load(p, __ATOMIC_RELAXED, __HIP_MEMORY_SCOPE_AGENT); }
__device__ __forceinline__ unsigned xb_add(unsigned* p, unsigned v) { return __hip_atomic_fetch_add(p, v, __ATOMIC_RELAXED, __HIP_MEMORY_SCOPE_AGENT); }
__device__ __forceinline__ unsigned xb_xcc_id() { return (unsigned)__builtin_amdgcn_s_getreg((3 << 11) | 20) & 0xFu; }
#define XB_SPIN(cond, bar) do { unsigned _sp = 0; while (cond) { __builtin_amdgcn_s_sleep(1); \
    if ((++_sp & 255u) == 0u) { if (xb_ld(&(bar)[XB_TMO])) break; if (_sp > XB_SPIN_CAP) { atomicAdd(&(bar)[XB_TMO], 1u); break; } } } } while (0)

struct XcdBarrier {
    unsigned* bar; unsigned x;
    volatile LAS unsigned* st;
};

__device__ __forceinline__ XcdBarrier xcd_barrier_post(unsigned* bar, volatile LAS unsigned* st) {
    XcdBarrier b; b.bar = bar; b.x = xb_xcc_id(); b.st = st;
    if (threadIdx.x == 0) (void)xb_add(&bar[XB_XCNT(b.x)], 1u);
    return b;
}
__device__ __forceinline__ void xcd_barrier_complete(unsigned* bar, unsigned x, unsigned& nloc, unsigned& nx) {
    const unsigned G = gridDim.x * gridDim.y * gridDim.z;
    unsigned sum, cnt, mine, sp = 0u;
    for (;;) {
        sum = 0u; cnt = 0u; mine = 0u;
#pragma unroll
        for (unsigned j = 0; j < 16; ++j) { const unsigned c = xb_ld(&bar[XB_XCNT(j)]); sum += c; cnt += (c > 0u) ? 1u : 0u; mine = (j == x) ? c : mine; }
        if (sum == G) break;
        __builtin_amdgcn_s_sleep(1);
        if ((++sp & 255u) == 0u) { if (xb_ld(&bar[XB_TMO])) break; if (sp > XB_SPIN_CAP) { atomicAdd(&bar[XB_TMO], 1u); break; } }
    }
    nloc = mine > 0u ? mine : 1u; nx = cnt > 0u ? cnt : 1u;
}

__device__ __forceinline__ void xcd_barrier(const XcdBarrier& b) {
    asm volatile("s_waitcnt vmcnt(0)" ::: "memory");
    __syncthreads();
    if (threadIdx.x == 0) {
        unsigned* bar = b.bar;
        __builtin_amdgcn_s_waitcnt(0);
        unsigned nloc = b.st[0], nx = b.st[1];
        if (nloc == 0u) { xcd_barrier_complete(bar, b.x, nloc, nx); b.st[0] = nloc; b.st[1] = nx; }
        const unsigned old = xb_add(&bar[XB_XSUB(b.x)], 1u);
        const unsigned gen = old / nloc;
        if (old + 1u == (gen + 1u) * nloc) {
            __builtin_amdgcn_fence(__ATOMIC_RELEASE, "agent");
            asm volatile("s_waitcnt vmcnt(0)" ::: "memory");
            const unsigned og = xb_add(&bar[XB_TOP], 1u);
            const unsigned tg = og / nx;
            if (og + 1u == (tg + 1u) * nx) xb_add(&bar[XB_TOPGEN], 1u);
            else XB_SPIN(xb_ld(&bar[XB_TOPGEN]) == tg, bar);
            __builtin_amdgcn_fence(__ATOMIC_ACQUIRE, "agent");
            xb_add(&bar[XB_XGEN(b.x)], 1u);
            asm volatile("s_waitcnt vmcnt(0)" ::: "memory");
        } else {
            XB_SPIN(xb_ld(&bar[XB_XGEN(b.x)]) == gen, bar);
            __builtin_amdgcn_fence(__ATOMIC_ACQUIRE, "agent");
            asm volatile("s_waitcnt vmcnt(0)" ::: "memory");
        }
    }
    __syncthreads();
}
__device__ __forceinline__ void cvt_rows_bf16(const float* src, bf16* dst, size_t n8, size_t gtid, size_t gthreads) {
    for (size_t i = gtid; i < n8; i += gthreads) { const f32x4 a = ((const f32x4*)src)[2 * i], b = ((const f32x4*)src)[2 * i + 1];
        v4u o; o.x = pk2(a.x, a.y); o.y = pk2(a.z, a.w); o.z = pk2(b.x, b.y); o.w = pk2(b.z, b.w); ((v4u*)dst)[i] = o; }
}
__device__ __forceinline__ void transpose_item(const float* W, int N, bf16* WT, int dst_row0, LAS float* scr, int k0, int n0, int lane) {
#pragma unroll 8
    for (int i = 0; i < 32; ++i) { const int kk = 2 * i + (lane >> 5); scr[kk * 33 + (lane & 31)] = W[(size_t)(k0 + kk) * N + n0 + (lane & 31)]; }
    LDS_WAIT(); asm volatile("" ::: "memory");
    const int c = lane & 7;
#pragma unroll
    for (int j = 0; j < 4; ++j) { const int n = (lane >> 3) + 8 * j; const LAS float* s = scr + (8 * c) * 33 + n;
        v4u o; o.x = pk2(s[0 * 33], s[1 * 33]); o.y = pk2(s[2 * 33], s[3 * 33]); o.z = pk2(s[4 * 33], s[5 * 33]); o.w = pk2(s[6 * 33], s[7 * 33]);
        *(v4u*)(WT + (size_t)(dst_row0 + n) * 1024 + k0 + 8 * c) = o; }
    LDS_WAIT(); asm volatile("" ::: "memory");
}
__device__ __forceinline__ unsigned pk4_fp8(float a, float b, float c, float d) { int w = 0; w = __builtin_amdgcn_cvt_pk_fp8_f32(a, b, w, false); w = __builtin_amdgcn_cvt_pk_fp8_f32(c, d, w, true); return (unsigned)w; }
__device__ __forceinline__ void transpose_item_f8(const float* W, int N, unsigned char* WT8, int dst_row0, LAS float* scr, int k0, int n0, int lane, float wscale) {
#pragma unroll 8
    for (int i = 0; i < 32; ++i) { const int kk = 2 * i + (lane >> 5); scr[kk * 33 + (lane & 31)] = W[(size_t)(k0 + kk) * N + n0 + (lane & 31)]; }
    LDS_WAIT(); asm volatile("" ::: "memory");
    const int c = lane & 7;
#pragma unroll
    for (int j = 0; j < 4; ++j) { const int n = (lane >> 3) + 8 * j; const LAS float* s = scr + (8 * c) * 33 + n;
        v2u o; o.x = pk4_fp8(s[0 * 33] * wscale, s[1 * 33] * wscale, s[2 * 33] * wscale, s[3 * 33] * wscale); o.y = pk4_fp8(s[4 * 33] * wscale, s[5 * 33] * wscale, s[6 * 33] * wscale, s[7 * 33] * wscale);
        *(v2u*)(WT8 + (size_t)(dst_row0 + n) * 1024 + k0 + 8 * c) = o; }
    LDS_WAIT(); asm volatile("" ::: "memory");
}
__device__ __forceinline__ void phase_weights(LAS float* scr, int gw, int ngw, int lane, const float* win_src, int NC, const float* wkv_src, int nkv, const float* wo_src,
                                              const float* wg_src, const float* wu_src, const float* wd_src, bf16* win_t, bf16* wkv_t, bf16* wo_t, bf16* wgu_t, bf16* wd_t) {
    const int nbw = NC / 32, nWin = nbw * 16, NIT = nWin + 256 * nkv + 512 + NE * 1536;
    for (int it = gw; it < NIT; it += ngw) {
        int r = it;
        if (r < nWin) { const int kb = r / nbw, nb = r - kb * nbw; transpose_item(win_src, NC, win_t, 32 * nb, scr, 64 * kb, 32 * nb, lane); continue; } r -= nWin;
        if (r < 256 * nkv) { const int lay = r >> 8, rr = r & 255, kb = rr >> 4, nb = rr & 15; transpose_item(wkv_src + (size_t)lay * D * 512, 512, wkv_t + (size_t)lay * 512 * 1024, 32 * nb, scr, 64 * kb, 32 * nb, lane); continue; } r -= 256 * nkv;
        if (r < 512) { const int kb = r >> 5, nb = r & 31; transpose_item(wo_src, 1024, wo_t, 32 * nb, scr, 64 * kb, 32 * nb, lane); continue; } r -= 512;
        const int e = r / 1536, q = r - e * 1536, which = q >> 9, rr = q & 511, kb = rr >> 5, nb = rr & 31, n0 = 32 * nb;
        const size_t eoff = (size_t)e * 1024 * 1024;
        if (which == 0) transpose_item_f8(wg_src + eoff, 1024, (unsigned char*)wgu_t + 2 * eoff, (n0 >> 7) * 256 + (n0 & 127), scr, 64 * kb, n0, lane, 32.f);
        else if (which == 1) transpose_item_f8(wu_src + eoff, 1024, (unsigned char*)wgu_t + 2 * eoff, (n0 >> 7) * 256 + 128 + (n0 & 127), scr, 64 * kb, n0, lane, 32.f);
        else transpose_item_f8(wd_src + eoff, 1024, (unsigned char*)wd_t + eoff, n0, scr, 64 * kb, n0, lane, 64.f);
    }
}

template <bool OUT>
__device__ __forceinline__ void hgrn_seg(LAS unsigned char* lds, const bf16* h, const float* lbl, int j, const float* normg, float* Sloc, float* Dseg, bf16* mix, int unit, int tid, int wave, int lane) {
    const int seg = unit & (HNSEG - 1), bh = unit >> 6, hh = bh % HG_H, b = bh / HG_H;
    const int v = tid & 127, dg = tid >> 7;
    LAS float* fgs = (LAS float*)lds; LAS float* vs = fgs + 4096; LAS float* qs = vs + 4096; LAS float* op = qs + 4096;
    f32x2 st[16];
    float* Sp = Sloc + (size_t)unit * 16384 + (size_t)(dg * 32) * 128 + v;
#pragma unroll
    for (int dd = 0; dd < 16; ++dd) { st[dd].x = OUT ? Sp[(2 * dd) * 128] : 0.f; st[dd].y = OUT ? Sp[(2 * dd + 1) * 128] : 0.f; }
    float dprod = 1.f;
    const int stok = tid >> 4, c8 = (tid & 15) * 8;
    float lb[8];
#pragma unroll
    for (int i = 0; i < 8; ++i) { lb[i] = 0.f; if (j > 0) { const float a0 = lbl[hh * 128 + c8 + i], a1 = lbl[MIXW + hh * 128 + c8 + i]; lb[i] = 1.f / (1.f + __expf(a0 - a1)); } }
    for (int ch = 0; ch < HSEG / 32; ++ch) {
        const size_t t0 = (size_t)b * SEQ + seg * HSEG + ch * 32;
        { const bf16* row = h + (t0 + stok) * NC_H + hh * 128 + c8;
          const v4u f8 = *(const v4u*)(row + 768), i8 = *(const v4u*)(row + 1536); v4u q8 = {0u, 0u, 0u, 0u}; if (OUT) q8 = *(const v4u*)row;
#pragma unroll
          for (int w = 0; w < 4; ++w) { const float f0 = bflo(f8[w]), f1 = bfhi(f8[w]); const int o = stok * 128 + c8 + 2 * w;
              fgs[o] = lb[2 * w] + (1.f - lb[2 * w]) * sigmoidf_(f0); fgs[o + 1] = lb[2 * w + 1] + (1.f - lb[2 * w + 1]) * sigmoidf_(f1);
              vs[o] = bflo(i8[w]); vs[o + 1] = bfhi(i8[w]);
              if (OUT) { const float q0 = bflo(q8[w]), q1 = bfhi(q8[w]); qs[o] = q0 * sigmoidf_(q0); qs[o + 1] = q1 * sigmoidf_(q1); } } }
        __syncthreads();
        if (!OUT) { if (tid < 128) { for (int tt = 0; tt < 32; ++tt) dprod *= fgs[tt * 128 + tid]; } }
        f32x4 fA[8], qA[8], fB[8], qB[8]; float vA, vB;
#define HG_LOAD(F, Q, V, tt_) do { V = vs[(tt_) * 128 + v]; _Pragma("unroll") for (int d4 = 0; d4 < 8; ++d4) { F[d4] = *(const LAS f32x4*)(fgs + (tt_) * 128 + dg * 32 + d4 * 4); \
            if (OUT) Q[d4] = *(const LAS f32x4*)(qs + (tt_) * 128 + dg * 32 + d4 * 4); } } while (0)
#define HG_STEP(F, Q, V, tt_) do { const f32x2 vv2 = {V, V}; f32x2 acc2 = {0.f, 0.f}; _Pragma("unroll") for (int d4 = 0; d4 < 8; ++d4) { \
            const f32x2 fa = {F[d4].x, F[d4].y}, fb = {F[d4].z, F[d4].w}; \
            st[2 * d4] = fa * (st[2 * d4] - vv2) + vv2; st[2 * d4 + 1] = fb * (st[2 * d4 + 1] - vv2) + vv2; \
            if (OUT) { const f32x2 qa = {Q[d4].x, Q[d4].y}, qb = {Q[d4].z, Q[d4].w}; acc2 = qa * st[2 * d4] + acc2; acc2 = qb * st[2 * d4 + 1] + acc2; } } \
            if (OUT) op[(dg * 32 + (tt_)) * 128 + v] = acc2.x + acc2.y; } while (0)
        HG_LOAD(fA, qA, vA, 0);
#pragma unroll 1
        for (int tt = 0; tt < 32; tt += 2) {
            HG_LOAD(fB, qB, vB, tt + 1);
            __builtin_amdgcn_sched_barrier(0);
            HG_STEP(fA, qA, vA, tt);
            __builtin_amdgcn_sched_barrier(0);
            if (tt + 2 < 32) HG_LOAD(fA, qA, vA, tt + 2);
            __builtin_amdgcn_sched_barrier(0);
            HG_STEP(fB, qB, vB, tt + 1);
            __builtin_amdgcn_sched_barrier(0);
        }
#undef HG_LOAD
#undef HG_STEP
        if (OUT) {
            __syncthreads();
#pragma unroll
            for (int k = 0; k < 4; ++k) { const int tt = wave + 8 * k; float o0 = 0.f, o1 = 0.f;
#pragma unroll
                for (int g = 0; g < 4; ++g) { o0 += op[(g * 32 + tt) * 128 + lane]; o1 += op[(g * 32 + tt) * 128 + lane + 64]; }
                const float ms = wave_sum(o0 * o0 + o1 * o1) * (1.f / 128.f), r = 1.f / sqrtf(ms + 1e-6f);
                const bf16* grow = h + (t0 + tt) * NC_H + 2304 + hh * 128; const float g0 = bf2f(grow[lane]), g1 = bf2f(grow[lane + 64]);
                bf16* mrow = mix + (t0 + tt) * 1024 + hh * 128;
                mrow[lane] = (bf16)f2bf(o0 * r * normg[lane] * sigmoidf_(g0)); mrow[lane + 64] = (bf16)f2bf(o1 * r * normg[lane + 64] * sigmoidf_(g1)); }
        }
        __syncthreads();
    }
    if (!OUT) {
#pragma unroll
        for (int dd = 0; dd < 16; ++dd) { Sp[(2 * dd) * 128] = st[dd].x; Sp[(2 * dd + 1) * 128] = st[dd].y; }
        if (tid < 128) Dseg[(size_t)unit * 128 + tid] = dprod;
    }
}
constexpr int HG_G = 0, HG_QT = 32768, HG_KT = 50176, HG_KE = 67584, HG_VT = 86016, HG_ST = 104448, HG_GM = 139264, HG_GE = 139776, HG_PART = 140288;
static_assert(HG_PART + 2048 <= MISC_OFF, "HGRN LDS map");
__device__ __forceinline__ int crow16(int i, int hf) { return (i & 3) + 8 * (i >> 2) + 4 * hf; }
template <bool OUT>
__device__ __forceinline__ void hgrn_mfma(LAS unsigned char* lds, const bf16* h, const float* lbl, int j, const float* normg, float* Sloc, float* Dseg, bf16* mix, int unit, int tid, int wave, int lane) {
    const int seg = unit & (HNSEG - 1), bh = unit >> 6, hh = bh % HG_H, b = bh / HG_H;
    const int r = lane & 31, hf = lane >> 5, tr = wave & 1, vq = wave >> 1;
    LAS float* G = (LAS float*)(lds + HG_G); LAS float* GM = (LAS float*)(lds + HG_GM); LAS float* GE = (LAS float*)(lds + HG_GE); LAS float* PART = (LAS float*)(lds + HG_PART);
    const int stok = tid >> 3, c16 = (tid & 7) * 16, sperm = (stok & ~15) | (stok & 3) | ((stok & 4) << 1) | ((stok & 8) >> 1);
    const int cd = tid & 127, cpart = tid >> 7;
    float lb[16];
#pragma unroll
    for (int e = 0; e < 16; ++e) { lb[e] = 0.f; if (j > 0) { const float a0 = lbl[hh * 128 + c16 + e], a1 = lbl[MIXW + hh * 128 + c16 + e]; lb[e] = 1.f / (1.f + __expf(a0 - a1)); } }
    f32x16 S[2];
    float* Sp = Sloc + (size_t)unit * 16384 + 32 * vq + r;
#pragma unroll
    for (int dd = 0; dd < 2; ++dd)
#pragma unroll
        for (int i = 0; i < 16; ++i) S[dd][i] = OUT ? Sp[(32 * (2 * tr + dd) + crow16(i, hf)) * 128] : 0.f;
    float gsum = 0.f;
    float ng16[16];
#pragma unroll
    for (int e = 0; e < 16; ++e) ng16[e] = OUT ? normg[c16 + e] : 0.f;
    v4u nf8[2], ni8[2], nq8[2] = {{0u, 0u, 0u, 0u}, {0u, 0u, 0u, 0u}}, ng8[2] = {{0u, 0u, 0u, 0u}, {0u, 0u, 0u, 0u}};
#define HG_RAWLOAD(t0_) do { const bf16* row_ = h + ((t0_) + stok) * NC_H + hh * 128 + c16; nf8[0] = *(const v4u*)(row_ + 768); nf8[1] = *(const v4u*)(row_ + 776); ni8[0] = *(const v4u*)(row_ + 1536); ni8[1] = *(const v4u*)(row_ + 1544); \
        if (OUT) { nq8[0] = *(const v4u*)row_; nq8[1] = *(const v4u*)(row_ + 8); ng8[0] = *(const v4u*)(row_ + 2304); ng8[1] = *(const v4u*)(row_ + 2312); } } while (0)
    HG_RAWLOAD((size_t)b * SEQ + seg * HSEG);
    for (int ch = 0; ch < HSEG / 64; ++ch) {
        const size_t t0 = (size_t)b * SEQ + seg * HSEG + ch * 64;
        float fg[16], qv[16]; v4u i8[2], g8[2];
        { const v4u f8[2] = {nf8[0], nf8[1]}; i8[0] = ni8[0]; i8[1] = ni8[1]; const v4u q8[2] = {nq8[0], nq8[1]}; g8[0] = ng8[0]; g8[1] = ng8[1];
#pragma unroll
          for (int w = 0; w < 8; ++w) { const unsigned fw = f8[w >> 2][w & 3]; const float f0 = bflo(fw), f1 = bfhi(fw);
              fg[2 * w] = lb[2 * w] + (1.f - lb[2 * w]) * sigmoidf_(f0); fg[2 * w + 1] = lb[2 * w + 1] + (1.f - lb[2 * w + 1]) * sigmoidf_(f1);
              if (OUT) { const unsigned qw = q8[w >> 2][w & 3]; const float q0 = bflo(qw), q1 = bfhi(qw); qv[2 * w] = q0 * sigmoidf_(q0); qv[2 * w + 1] = q1 * sigmoidf_(q1); } else { qv[2 * w] = 0.f; qv[2 * w + 1] = 0.f; } }
#pragma unroll
          for (int e4 = 0; e4 < 4; ++e4) { f32x4 lg; lg.x = __builtin_amdgcn_logf(fg[4 * e4]); lg.y = __builtin_amdgcn_logf(fg[4 * e4 + 1]); lg.z = __builtin_amdgcn_logf(fg[4 * e4 + 2]); lg.w = __builtin_amdgcn_logf(fg[4 * e4 + 3]);
              *(LAS f32x4*)(G + stok * 128 + c16 + 4 * e4) = lg; } }
        __syncthreads();
        { float run = 0.f;
#pragma unroll
          for (int k = 0; k < 16; ++k) run += G[(16 * cpart + k) * 128 + cd];
          PART[cpart * 128 + cd] = run; }
        __syncthreads();
        { float run = 0.f;
#pragma unroll
          for (int pp = 0; pp < 3; ++pp) run += (pp < cpart) ? PART[pp * 128 + cd] : 0.f;
#pragma unroll
          for (int k = 0; k < 16; ++k) { run += G[(16 * cpart + k) * 128 + cd]; G[(16 * cpart + k) * 128 + cd] = run; }
          if (cpart == 1) GM[cd] = run;
          if (cpart == 3) { GE[cd] = run; gsum += run; } }
        __syncthreads();
        if (OUT) {
#pragma unroll
            for (int dd = 0; dd < 2; ++dd)
#pragma unroll
                for (int g4 = 0; g4 < 4; ++g4) { const int dbase = 32 * (2 * tr + dd) + 8 * g4 + 4 * hf; const f32x4 gm = *(const LAS f32x4*)(GM + dbase);
                    v2u w; w.x = cvtpk(S[dd][4 * g4] * __builtin_amdgcn_exp2f(gm.x), S[dd][4 * g4 + 1] * __builtin_amdgcn_exp2f(gm.y)); w.y = cvtpk(S[dd][4 * g4 + 2] * __builtin_amdgcn_exp2f(gm.z), S[dd][4 * g4 + 3] * __builtin_amdgcn_exp2f(gm.w));
                    *(LAS v2u*)(lds + HG_ST + (32 * vq + r) * 272 + dbase * 2) = w; }
        }
        { unsigned qt[8], kt[8];
#pragma unroll
          for (int e4 = 0; e4 < 4; ++e4) { const f32x4 gv = *(const LAS f32x4*)(G + stok * 128 + c16 + 4 * e4), gm = *(const LAS f32x4*)(GM + c16 + 4 * e4), ge = *(const LAS f32x4*)(GE + c16 + 4 * e4);
              float ke[4];
#pragma unroll
              for (int e = 0; e < 4; ++e) { const float kk = 1.f - fg[4 * e4 + e]; ke[e] = kk * __builtin_amdgcn_exp2f(ge[e] - gv[e]);
                  if (OUT) { const float a = qv[4 * e4 + e] * __builtin_amdgcn_exp2f(gv[e] - gm[e]), c = kk * __builtin_amdgcn_exp2f(gm[e] - gv[e]);
                      if (e & 1) { qt[2 * e4 + (e >> 1)] |= f2bf(a) << 16; kt[2 * e4 + (e >> 1)] |= f2bf(c) << 16; } else { qt[2 * e4 + (e >> 1)] = f2bf(a); kt[2 * e4 + (e >> 1)] = f2bf(c); } } }
#pragma unroll
              for (int e = 0; e < 4; ++e) { const int col = c16 + 4 * e4 + e;
                  *(LAS bf16*)(lds + HG_KE + col * 144 + sperm * 2) = (bf16)f2bf(ke[e]);
                  const unsigned vw = i8[e4 >> 1][(2 * e4 + (e >> 1)) & 3]; *(LAS bf16*)(lds + HG_VT + col * 144 + sperm * 2) = (bf16)((e & 1) ? (vw >> 16) : (vw & 0xffffu)); } }
          if (OUT) { *(LAS v4u*)(lds + HG_QT + stok * 272 + c16 * 2) = (v4u){qt[0], qt[1], qt[2], qt[3]}; *(LAS v4u*)(lds + HG_QT + stok * 272 + c16 * 2 + 16) = (v4u){qt[4], qt[5], qt[6], qt[7]};
                     *(LAS v4u*)(lds + HG_KT + stok * 272 + c16 * 2) = (v4u){kt[0], kt[1], kt[2], kt[3]}; *(LAS v4u*)(lds + HG_KT + stok * 272 + c16 * 2 + 16) = (v4u){kt[4], kt[5], kt[6], kt[7]}; } }
        __syncthreads();
        if (ch + 1 < HSEG / 64) HG_RAWLOAD(t0 + 64);
        if (OUT) {
            f32x16 X0, X1, O;
#pragma unroll
            for (int i = 0; i < 16; ++i) { X0[i] = 0.f; X1[i] = 0.f; O[i] = 0.f; }
            const LAS unsigned char* qtp = lds + HG_QT + (32 * tr + r) * 272 + hf * 16;
#pragma unroll
            for (int ks = 0; ks < 8; ++ks) { const s16x8 bq = *(const LAS s16x8*)(qtp + ks * 32);
                const s16x8 a0 = *(const LAS s16x8*)(lds + HG_KT + r * 272 + hf * 16 + ks * 32); X0 = __builtin_amdgcn_mfma_f32_32x32x16_bf16(a0, bq, X0, 0, 0, 0);
                if (tr == 1) { const s16x8 a1 = *(const LAS s16x8*)(lds + HG_KT + (32 + r) * 272 + hf * 16 + ks * 32); X1 = __builtin_amdgcn_mfma_f32_32x32x16_bf16(a1, bq, X1, 0, 0, 0); } }
#pragma unroll
            for (int i = 0; i < 16; ++i) { const bool keep = crow16(i, hf) <= r; if (tr == 0) X0[i] = keep ? X0[i] : 0.f; else X1[i] = keep ? X1[i] : 0.f; }
            const LAS unsigned char* vtp = lds + HG_VT + (32 * vq + r) * 144 + hf * 16;
#pragma unroll
            for (int s2 = 0; s2 < 2; ++s2) { v4u pw; pw.x = cvtpk(X0[8 * s2], X0[8 * s2 + 1]); pw.y = cvtpk(X0[8 * s2 + 2], X0[8 * s2 + 3]); pw.z = cvtpk(X0[8 * s2 + 4], X0[8 * s2 + 5]); pw.w = cvtpk(X0[8 * s2 + 6], X0[8 * s2 + 7]);
                const s16x8 bv = *(const LAS s16x8*)(vtp + (16 * s2) * 2); O = __builtin_amdgcn_mfma_f32_32x32x16_bf16(__builtin_bit_cast(s16x8, pw), bv, O, 0, 0, 0); }
            if (tr == 1) {
#pragma unroll
                for (int s2 = 0; s2 < 2; ++s2) { v4u pw; pw.x = cvtpk(X1[8 * s2], X1[8 * s2 + 1]); pw.y = cvtpk(X1[8 * s2 + 2], X1[8 * s2 + 3]); pw.z = cvtpk(X1[8 * s2 + 4], X1[8 * s2 + 5]); pw.w = cvtpk(X1[8 * s2 + 6], X1[8 * s2 + 7]);
                    const s16x8 bv = *(const LAS s16x8*)(vtp + (32 + 16 * s2) * 2); O = __builtin_amdgcn_mfma_f32_32x32x16_bf16(__builtin_bit_cast(s16x8, pw), bv, O, 0, 0, 0); } }
            const LAS unsigned char* stp = lds + HG_ST + (32 * vq + r) * 272 + hf * 16;
#pragma unroll
            for (int ks = 0; ks < 8; ++ks) { const s16x8 aq = *(const LAS s16x8*)(qtp + ks * 32), bs = *(const LAS s16x8*)(stp + ks * 32); O = __builtin_amdgcn_mfma_f32_32x32x16_bf16(aq, bs, O, 0, 0, 0); }
#pragma unroll
            for (int i = 0; i < 16; ++i) G[(32 * tr + crow16(i, hf)) * 128 + 32 * vq + r] = O[i];
        }
#pragma unroll
        for (int dd = 0; dd < 2; ++dd) { const int dr = 2 * tr + dd;
#pragma unroll
            for (int g4 = 0; g4 < 4; ++g4) { const f32x4 ge = *(const LAS f32x4*)(GE + 32 * dr + 8 * g4 + 4 * hf);
                S[dd][4 * g4] *= __builtin_amdgcn_exp2f(ge.x); S[dd][4 * g4 + 1] *= __builtin_amdgcn_exp2f(ge.y); S[dd][4 * g4 + 2] *= __builtin_amdgcn_exp2f(ge.z); S[dd][4 * g4 + 3] *= __builtin_amdgcn_exp2f(ge.w); }
#pragma unroll
            for (int ks = 0; ks < 4; ++ks) { const s16x8 a = *(const LAS s16x8*)(lds + HG_KE + (32 * dr + r) * 144 + hf * 16 + ks * 32), bv = *(const LAS s16x8*)(lds + HG_VT + (32 * vq + r) * 144 + hf * 16 + ks * 32);
                S[dd] = __builtin_amdgcn_mfma_f32_32x32x16_bf16(a, bv, S[dd], 0, 0, 0); } }
        __syncthreads();
        if (OUT) {
            float ov[16]; float ss = 0.f;
#pragma unroll
            for (int e4 = 0; e4 < 4; ++e4) { const f32x4 o4 = *(const LAS f32x4*)(G + stok * 128 + c16 + 4 * e4); ov[4 * e4] = o4.x; ov[4 * e4 + 1] = o4.y; ov[4 * e4 + 2] = o4.z; ov[4 * e4 + 3] = o4.w;
                ss += (o4.x * o4.x + o4.y * o4.y) + (o4.z * o4.z + o4.w * o4.w); }
            ss += xorf<1>(ss); ss += xorf<2>(ss); ss += xorf<4>(ss);
            const float rr = 1.f / sqrtf(ss * (1.f / 128.f) + 1e-6f);
            unsigned ow[8];
#pragma unroll
            for (int w = 0; w < 8; ++w) { const unsigned gw_ = g8[w >> 2][w & 3]; ow[w] = cvtpk(ov[2 * w] * rr * ng16[2 * w] * sigmoidf_(bflo(gw_)), ov[2 * w + 1] * rr * ng16[2 * w + 1] * sigmoidf_(bfhi(gw_))); }
            bf16* mrow = mix + (t0 + stok) * 1024 + hh * 128 + c16;
            *(v4u*)mrow = (v4u){ow[0], ow[1], ow[2], ow[3]}; *(v4u*)(mrow + 8) = (v4u){ow[4], ow[5], ow[6], ow[7]};
            __syncthreads();
        }
    }
#undef HG_RAWLOAD
    if (!OUT) {
#pragma unroll
        for (int dd = 0; dd < 2; ++dd)
#pragma unroll
            for (int i = 0; i < 16; ++i) Sp[(32 * (2 * tr + dd) + crow16(i, hf)) * 128] = S[dd][i];
        if (cpart == 3) Dseg[(size_t)unit * 128 + cd] = __builtin_amdgcn_exp2f(gsum);
    }
}
__device__ __forceinline__ void hgrn_scan(float* Sloc, const float* Dseg, size_t gtid, size_t gthreads) {
    for (size_t idx = gtid; idx < (size_t)NBATCH * HG_H * 16384; idx += gthreads) { const int bh = (int)(idx >> 14), e = (int)(idx & 16383), d = e >> 7; float cur = 0.f;
        float* __restrict__ sp = Sloc + (size_t)bh * HNSEG * 16384 + e; const float* __restrict__ dp = Dseg + (size_t)bh * HNSEG * 128 + d;
        for (int s0 = 0; s0 < HNSEG; s0 += 16) { float tv[16], dv[16];
#pragma unroll
            for (int k = 0; k < 16; ++k) { tv[k] = sp[(size_t)(s0 + k) * 16384]; dv[k] = dp[(s0 + k) * 128]; }
#pragma unroll
            for (int k = 0; k < 16; ++k) { sp[(size_t)(s0 + k) * 16384] = cur; cur = dv[k] * cur + tv[k]; } } }
}

template <bool MASK>
__device__ __forceinline__ void attn4(const LAS unsigned* Ks, const LAS bf16* Vs, const LAS float* qst, LAS float* pb, int lane, const int (&tq)[4], int kbase, float slope,
                                      float (&mo)[4], float (&lo)[4], float (&oo)[4]) {
    float sc[4][4];
#pragma unroll
    for (int a = 0; a < 4; ++a)
#pragma unroll
        for (int c = 0; c < 4; ++c) sc[a][c] = 0.f;
#pragma unroll 4
    for (int dd = 0; dd < 32; ++dd) {
        f32x2 qv[4];
#pragma unroll
        for (int qi = 0; qi < 4; ++qi) qv[qi] = *(const LAS f32x2*)(qst + qi * 64 + 2 * dd);
#pragma unroll
        for (int kk = 0; kk < 4; ++kk) { const unsigned kw = Ks[(lane + 64 * kk) * 33 + dd]; const float k0 = bflo(kw), k1 = bfhi(kw);
#pragma unroll
            for (int qi = 0; qi < 4; ++qi) sc[qi][kk] += qv[qi].x * k0 + qv[qi].y * k1; }
    }
#pragma unroll
    for (int qi = 0; qi < 4; ++qi) { float mx = -INFINITY;
#pragma unroll
        for (int kk = 0; kk < 4; ++kk) { const int pos = kbase + lane + 64 * kk; float lg = sc[qi][kk] * 0.125f - slope * (float)(tq[qi] - pos); if (MASK && pos > tq[qi]) lg = -INFINITY; sc[qi][kk] = lg; mx = fmaxf(mx, lg); }
        mx = wave_max(mx); float s = 0.f;
#pragma unroll
        for (int kk = 0; kk < 4; ++kk) { const float p = __builtin_amdgcn_exp2f((sc[qi][kk] - mx) * 1.4426950408889634f); pb[qi * 256 + lane + 64 * kk] = p; s += p; }
        lo[qi] = wave_sum(s); mo[qi] = mx; }
    float o[4] = {0.f, 0.f, 0.f, 0.f};
#pragma unroll 4
    for (int k4 = 0; k4 < 64; ++k4) { f32x4 p4[4];
#pragma unroll
        for (int qi = 0; qi < 4; ++qi) p4[qi] = *(const LAS f32x4*)(pb + qi * 256 + 4 * k4);
#pragma unroll
        for (int jj = 0; jj < 4; ++jj) { const float vv = bf2f(Vs[(4 * k4 + jj) * 64 + lane]);
#pragma unroll
            for (int qi = 0; qi < 4; ++qi) o[qi] += p4[qi][jj] * vv; } }
#pragma unroll
    for (int qi = 0; qi < 4; ++qi) oo[qi] = o[qi];
}
constexpr int AT_KS = 0, AT_VS = 33792, AT_WV = 66560, AT_WVB = 5120;

__device__ __forceinline__ void memattn_unit(LAS unsigned char* lds, const bf16* h, int NC, int qoff, const bf16* kv, bf16* mix, int unit, int tid, int wave, int lane) {
    const int chunk = unit & 31, bm = unit >> 5, mh = bm & 3, b = bm >> 2;
    LAS unsigned* Ks = (LAS unsigned*)(lds + AT_KS); LAS unsigned* Vs32 = (LAS unsigned*)(lds + AT_VS);
    LAS float* qst = (LAS float*)(lds + AT_WV + wave * AT_WVB); LAS float* pb = qst + 256;
    for (int i = 0; i < 16; ++i) { const int idx = tid + 512 * i, r = idx >> 5, dd = idx & 31; const unsigned* src = (const unsigned*)(kv + (size_t)(b * 256 + r) * 512 + mh * 64);
        Ks[r * 33 + dd] = src[dd]; Vs32[r * 32 + dd] = src[128 + dd]; }
    __syncthreads();
    for (int qd = 0; qd < 16; ++qd) { const size_t tg = (size_t)b * SEQ + chunk * 512 + wave * 64 + qd * 4;
#pragma unroll
        for (int qi = 0; qi < 4; ++qi) qst[qi * 64 + lane] = bf2f(h[(tg + qi) * NC + qoff + mh * 64 + lane]);
        const int tq[4] = {0, 0, 0, 0}; float m[4], l[4], o[4];
        attn4<false>(Ks, (const LAS bf16*)Vs32, qst, pb, lane, tq, 0, 0.f, m, l, o);
#pragma unroll
        for (int qi = 0; qi < 4; ++qi) mix[(tg + qi) * 1024 + MIXW + mh * 64 + lane] = (bf16)f2bf(o[qi] / l[qi]); }
    __syncthreads();
}

constexpr int AT2_K = 0, AT2_KROW = 176, AT2_V = 256 * AT2_KROW, AT2_VROW = 528, AT2_SCR = AT2_V + 64 * AT2_VROW, AT2_SCRW = 4864;
__device__ __forceinline__ void stage_kv_images(LAS unsigned char* lds, const bf16* kp, const bf16* vp, size_t row_stride, int tid) {
    v4u kx[4], vx[4];
#pragma unroll
    for (int i = 0; i < 4; ++i) { const int idx = tid + 512 * i, key = idx >> 3, c = idx & 7; kx[i] = *(const v4u*)(kp + (size_t)key * row_stride + 8 * c); vx[i] = *(const v4u*)(vp + (size_t)key * row_stride + 8 * c); }
    __builtin_amdgcn_sched_barrier(0);
#pragma unroll
    for (int i = 0; i < 4; ++i) { const int idx = tid + 512 * i, key = idx >> 3, c = idx & 7;
        *(LAS v4u*)(lds + AT2_K + key * AT2_KROW + c * 16) = kx[i];
        const int pos = (key & ~15) | (key & 3) | ((key & 4) << 1) | ((key & 8) >> 1);
        LAS bf16* vt = (LAS bf16*)(lds + AT2_V) + pos;
#pragma unroll
        for (int w = 0; w < 4; ++w) { vt[(8 * c + 2 * w) * (AT2_VROW / 2)] = (bf16)(vx[i][w] & 0xffffu); vt[(8 * c + 2 * w + 1) * (AT2_VROW / 2)] = (bf16)(vx[i][w] >> 16); } }
    if (tid < 256) { const unsigned pb = f2bf((float)tid); const v4u e0 = {pb | (pb << 16), 0u, 0u, 0u}, z = {0u, 0u, 0u, 0u};
        *(LAS v4u*)(lds + AT2_K + tid * AT2_KROW + 128) = e0; *(LAS v4u*)(lds + AT2_K + tid * AT2_KROW + 144) = z; }
}
template <bool MASK>
__device__ __forceinline__ void attn_tile32(const LAS unsigned char* lds, const s16x8 (&qf)[4], int lane, float dist0, unsigned qx, bool own, f32x16 (&o)[2], float& mrow, float& lrow) {
    const int r = lane & 31, hf = lane >> 5;
    const v4u qxv = {qx, 0u, 0u, 0u}; const s16x8 qe = __builtin_bit_cast(s16x8, qxv);
    f32x16 acc[8];
    const LAS unsigned char* kb = lds + AT2_K + r * AT2_KROW + hf * 16;
    constexpr int NKS = MASK ? 5 : 4;
    s16x8 kf[NKS];
#pragma unroll
    for (int s = 0; s < NKS; ++s) kf[s] = *(const LAS s16x8*)(kb + s * 32);
#pragma unroll
    for (int kt = 0; kt < 8; ++kt) {
#pragma unroll
        for (int i = 0; i < 16; ++i) acc[kt][i] = 0.f;
#pragma unroll
        for (int s = 0; s < NKS; ++s) { acc[kt] = __builtin_amdgcn_mfma_f32_32x32x16_bf16(kf[s], s < 4 ? qf[s < 4 ? s : 0] : qe, acc[kt], 0, 0, 0);
            if (kt + 1 < 8) kf[s] = *(const LAS s16x8*)(kb + (kt + 1) * 32 * AT2_KROW + s * 32); }
        __builtin_amdgcn_sched_barrier(0); }
    float mx = -INFINITY;
    if (MASK && own) { const float base2 = dist0 - 4.f * (float)hf;
#pragma unroll
        for (int kt = 0; kt < 8; ++kt)
#pragma unroll
            for (int i = 0; i < 16; ++i) { const float dist = base2 - (float)(32 * kt + (i & 3) + 8 * (i >> 2)); const float lg = dist < 0.f ? -INFINITY : acc[kt][i]; acc[kt][i] = lg; mx = fmaxf(mx, lg); }
    } else {
#pragma unroll
        for (int kt = 0; kt < 8; ++kt)
#pragma unroll
            for (int i = 0; i < 16; ++i) mx = fmaxf(mx, acc[kt][i]);
    }
    mx = fmaxf(mx, xor32f(mx, lane));
    float sum = 0.f;
#pragma unroll
    for (int i = 0; i < 16; ++i) { o[0][i] = 0.f; o[1][i] = 0.f; }
    const LAS unsigned char* vb = lds + AT2_V + r * AT2_VROW + hf * 16;
    s16x8 vf[4];
#pragma unroll
    for (int s2 = 0; s2 < 2; ++s2)
#pragma unroll
        for (int dt = 0; dt < 2; ++dt) vf[2 * s2 + dt] = *(const LAS s16x8*)(vb + dt * 32 * AT2_VROW + (16 * s2) * 2);
#pragma unroll
    for (int kt = 0; kt < 8; ++kt) {
#pragma unroll
        for (int i = 0; i < 16; ++i) { const float p = __builtin_amdgcn_exp2f(acc[kt][i] - mx); sum += p; acc[kt][i] = p; }
#pragma unroll
        for (int s2 = 0; s2 < 2; ++s2) { v4u pw; pw.x = cvtpk(acc[kt][8 * s2], acc[kt][8 * s2 + 1]); pw.y = cvtpk(acc[kt][8 * s2 + 2], acc[kt][8 * s2 + 3]);
            pw.z = cvtpk(acc[kt][8 * s2 + 4], acc[kt][8 * s2 + 5]); pw.w = cvtpk(acc[kt][8 * s2 + 6], acc[kt][8 * s2 + 7]); const s16x8 pf = __builtin_bit_cast(s16x8, pw);
#pragma unroll
            for (int dt = 0; dt < 2; ++dt) { o[dt] = __builtin_amdgcn_mfma_f32_32x32x16_bf16(vf[2 * s2 + dt], pf, o[dt], 0, 0, 0);
                if (kt + 1 < 8) vf[2 * s2 + dt] = *(const LAS s16x8*)(vb + dt * 32 * AT2_VROW + (32 * (kt + 1) + 16 * s2) * 2); } }
        __builtin_amdgcn_sched_barrier(0); }
    sum += xor32f(sum, lane);
    mrow = mx; lrow = sum;
}
__device__ __forceinline__ void memattn_unit2(LAS unsigned char* lds, const bf16* h, int NC, int qoff, const bf16* kv  , bf16* mix, int unit, int tid, int wave, int lane) {
    const int chunk = unit & 63, bm = unit >> 6, mh = bm & 3, b = bm >> 2, r = lane & 31, hf = lane >> 5;
    const bf16* kvrow0 = kv + (size_t)(b * 256) * 2048 + mh * 64;
    stage_kv_images(lds, kvrow0, kvrow0 + 256, 2048, tid);
    __syncthreads();
    { const size_t tg = (size_t)b * SEQ + chunk * 256 + wave * 32 + r;
        f32x16 o[2]; float m2, l; s16x8 qf[4];
#pragma unroll
        for (int s = 0; s < 4; ++s) qf[s] = *(const s16x8*)(h + tg * NC + qoff + mh * 64 + 16 * s + 8 * hf);
        attn_tile32<false>(lds, qf, lane, 0.f, 0u, false, o, m2, l);
        const float inv = 1.f / l; bf16* mp = mix + tg * 1024 + MIXW + mh * 64 + 4 * hf;
#pragma unroll
        for (int dt = 0; dt < 2; ++dt)
#pragma unroll
            for (int g = 0; g < 4; ++g) { v2u w; w.x = cvtpk(o[dt][4 * g] * inv, o[dt][4 * g + 1] * inv); w.y = cvtpk(o[dt][4 * g + 2] * inv, o[dt][4 * g + 3] * inv); *(v2u*)(mp + 32 * dt + 8 * g) = w; } }
    __syncthreads();
}
__device__ __forceinline__ void kmean_unit(LAS unsigned char* lds, const bf16* h, float* kmean, float* kmaxg, int unit, int tid, int wave) {
    const int n = unit & 63, bh = unit >> 6, hh = bh % MB_H, b = bh / MB_H, d = tid & 63, part = tid >> 6;
    LAS float* red = (LAS float*)lds;
    float s = 0.f; const bf16* p = h + ((size_t)b * SEQ + n * 256 + part * 32) * NC_M + 768 + hh * 64 + d;
    for (int i = 0; i < 32; ++i) s += bf2f(p[(size_t)i * NC_M]);
    float ss = 0.f; { const v4u* kp = (const v4u*)(h + ((size_t)b * SEQ + n * 256 + (tid >> 1)) * NC_M + 768 + hh * 64 + (tid & 1) * 32);
#pragma unroll
        for (int w = 0; w < 4; ++w) { const v4u x = kp[w]; ss += bflo(x.x) * bflo(x.x) + bfhi(x.x) * bfhi(x.x) + bflo(x.y) * bflo(x.y) + bfhi(x.y) * bfhi(x.y) + bflo(x.z) * bflo(x.z) + bfhi(x.z) * bfhi(x.z) + bflo(x.w) * bflo(x.w) + bfhi(x.w) * bfhi(x.w); } }
    ss += xorf<1>(ss); ss = wave_max(ss);
    red[part * 64 + d] = s; if ((tid & 63) == 0) red[512 + wave] = ss; __syncthreads();
    if (tid < 64) { float a = 0.f; for (int pp = 0; pp < 8; ++pp) a += red[pp * 64 + tid]; a *= (1.f / 256.f);
        const unsigned hi = f2bf(a), lo = f2bf(a - __builtin_bit_cast(float, hi << 16)); bf16* kmh = (bf16*)kmean; kmh[((size_t)bh * 64 + n) * 64 + tid] = (bf16)hi; kmh[(size_t)24 * 4096 + ((size_t)bh * 64 + n) * 64 + tid] = (bf16)lo; }
    if (tid == 0) { float mx = 0.f; for (int w = 0; w < 8; ++w) mx = fmaxf(mx, red[512 + w]); kmaxg[bh * 64 + n] = sqrtf(mx) * 1.001f; }
    __syncthreads();
}
__device__ __forceinline__ void gate_unit_core(const s16x8 (&qf)[4], const s16x8 (&kf)[4], const bf16* kmh, const bf16* kml, LAS int* hist, const LAS float* kmx, int* selinfo, int bh, int c, int t, int lane, unsigned& sel, unsigned& rr) {
    const int hh = bh % MB_H, b = bh / MB_H, hf = lane >> 5, r = lane & 31;
    int s0 = 0, s1 = 0, s2 = 0, r0 = 0, r1 = 0, r2 = 0, ns = 0;
    float v0 = -INFINITY, v1 = -INFINITY, v2 = -INFINITY, qn = 0.f, lown = 0.f;
    if (c > 0) {
        const int ntile = (c + 31) >> 5, ch = c - 4 * hf;
        s16x8 ah[2][4], al[2][4];
#pragma unroll
        for (int tile = 0; tile < 2; ++tile) if (tile < ntile) { const size_t ko = ((size_t)bh * 64 + 32 * tile + r) * 64 + 8 * hf;
#pragma unroll
            for (int ks = 0; ks < 4; ++ks) { ah[tile][ks] = *(const s16x8*)(kmh + ko + 16 * ks); al[tile][ks] = *(const s16x8*)(kml + ko + 16 * ks); } }
#pragma unroll
        for (int tile = 0; tile < 2; ++tile) if (tile < ntile) {
            f32x16 X;
#pragma unroll
            for (int i = 0; i < 16; ++i) X[i] = 0.f;
#pragma unroll
            for (int ks = 0; ks < 4; ++ks) { X = __builtin_amdgcn_mfma_f32_32x32x16_bf16(ah[tile][ks], qf[ks], X, 0, 0, 0); X = __builtin_amdgcn_mfma_f32_32x32x16_bf16(al[tile][ks], qf[ks], X, 0, 0, 0); }
#pragma unroll
            for (int i = 0; i < 16; ++i) { const int n = 32 * tile + (i & 3) + 8 * (i >> 2); const float g = (n < ch) ? X[i] : -INFINITY;
                if (g > v0) { v2 = v1; s2 = s1; v1 = v0; s1 = s0; v0 = g; s0 = n; } else if (g > v1) { v2 = v1; s2 = s1; v1 = g; s1 = n; } else if (g > v2) { v2 = g; s2 = n; } }
        }
        s0 += 4 * hf; s1 += 4 * hf; s2 += 4 * hf;
        { float qq = 0.f, qk = 0.f;
#pragma unroll
          for (int s = 0; s < 4; ++s)
#pragma unroll
              for (int jj = 0; jj < 8; ++jj) { const float qv = bf2f((bf16)qf[s][jj]), kv = bf2f((bf16)kf[s][jj]); qq += qv * qv; qk += qv * kv; }
          qq += xor32f(qq, lane); qk += xor32f(qk, lane);
          qn = sqrtf(qq) * 1.001f; lown = qk; }
        { float pv[3]; int ps[3]; const int pl = (lane ^ 32) << 2;
          pv[0] = __builtin_bit_cast(float, __builtin_amdgcn_ds_bpermute(pl, __builtin_bit_cast(int, v0))); pv[1] = __builtin_bit_cast(float, __builtin_amdgcn_ds_bpermute(pl, __builtin_bit_cast(int, v1)));
          pv[2] = __builtin_bit_cast(float, __builtin_amdgcn_ds_bpermute(pl, __builtin_bit_cast(int, v2)));
          ps[0] = __builtin_amdgcn_ds_bpermute(pl, s0); ps[1] = __builtin_amdgcn_ds_bpermute(pl, s1); ps[2] = __builtin_amdgcn_ds_bpermute(pl, s2);
#pragma unroll
          for (int k = 0; k < 3; ++k) { const float g = pv[k]; const int n = ps[k];
              if (g > v0 || (g == v0 && n < s0)) { v2 = v1; s2 = s1; v1 = v0; s1 = s0; v0 = g; s0 = n; } else if (g > v1 || (g == v1 && n < s1)) { v2 = v1; s2 = s1; v1 = g; s1 = n; } else if (g > v2 || (g == v2 && n < s2)) { v2 = g; s2 = n; } } }
    }
    sel = 0u; rr = 0u;
    if (hf == 0) {
        ns = c < 3 ? c : 3; s0 &= 63; s1 &= 63; s2 &= 63;
        { const float slope2 = (hh < 8 ? ldexpf(1.0f, -(hh + 1)) : ldexpf(0.70710678118654752f, -(hh - 8))) * 1.4426950408889634f;
          const bool k0 = ns > 0 && (qn * kmx[s0] - slope2 * (float)(t - (s0 * 256 + 255)) - lown) > -64.f;
          const bool k1 = ns > 1 && (qn * kmx[s1] - slope2 * (float)(t - (s1 * 256 + 255)) - lown) > -64.f;
          const bool k2 = ns > 2 && (qn * kmx[s2] - slope2 * (float)(t - (s2 * 256 + 255)) - lown) > -64.f;
          ns = (k0 ? 1 : 0) | (k1 ? 2 : 0) | (k2 ? 4 : 0); }
        if (ns & 1) r0 = __hip_atomic_fetch_add(hist + s0, 1, __ATOMIC_RELAXED, __HIP_MEMORY_SCOPE_WORKGROUP);
        if (ns & 2) r1 = __hip_atomic_fetch_add(hist + s1, 1, __ATOMIC_RELAXED, __HIP_MEMORY_SCOPE_WORKGROUP);
        if (ns & 4) r2 = __hip_atomic_fetch_add(hist + s2, 1, __ATOMIC_RELAXED, __HIP_MEMORY_SCOPE_WORKGROUP);
        selinfo[((size_t)b * SEQ + t) * MB_H + hh] = ns;
        sel = (unsigned)s0 | ((unsigned)s1 << 6) | ((unsigned)s2 << 12) | ((unsigned)ns << 18); rr = (unsigned)r0 | ((unsigned)r1 << 8) | ((unsigned)r2 << 16);
    }
}
__device__ __forceinline__ void moba_gate_wg(LAS unsigned char* lds, const bf16* h, const float* kmean, const float* kmaxg, unsigned* gcount, int* selinfo, unsigned* list, int blk, int tid) {
    constexpr int NU = 24 * MB_NB / GRID;
    static_assert(NU * GRID == 24 * MB_NB && GRID % 64 == 0 && NU * 64 <= NTHR, "gate deal");
    const int lane = tid & 63, r = lane & 31, hf = lane >> 5, wv = tid >> 6;
    const bf16* kmh = (const bf16*)kmean; const bf16* kml = kmh + (size_t)24 * 4096;
    LAS int* hist = (LAS int*)(lds + 16384); LAS int* base = hist + NU * 64; LAS float* kmx = (LAS float*)(base + NU * 64);
    if (tid < NU * 64) { const int bh = (blk >> 6) + 4 * (tid >> 6); hist[tid] = 0; kmx[tid] = kmaxg[bh * 64 + (tid & 63)]; }
    unsigned sel[NU], rr[NU];
    s16x8 qf[4], kf[4];
#define GU_BH(k) ((blk >> 6) + 4 * (k))
#define GU_C(k) (((k) & 1) ? 63 - (blk & 63) : (blk & 63))
#define GU_T(k) (GU_C(k) * 256 + wv * 32 + r)
    { const bf16* qp = h + ((size_t)(GU_BH(0) / MB_H) * SEQ + GU_T(0)) * NC_M + (GU_BH(0) % MB_H) * 64 + 8 * hf;
#pragma unroll
      for (int s = 0; s < 4; ++s) { qf[s] = *(const s16x8*)(qp + 16 * s); kf[s] = *(const s16x8*)(qp + 768 + 16 * s); } }
    __syncthreads();
#pragma unroll
    for (int k = 0; k < NU; ++k) {
        s16x8 qn_[4], kn_[4];
        if (k + 1 < NU) { const bf16* qp = h + ((size_t)(GU_BH(k + 1) / MB_H) * SEQ + GU_T(k + 1)) * NC_M + (GU_BH(k + 1) % MB_H) * 64 + 8 * hf;
#pragma unroll
            for (int s = 0; s < 4; ++s) { qn_[s] = *(const s16x8*)(qp + 16 * s); kn_[s] = *(const s16x8*)(qp + 768 + 16 * s); } }
        gate_unit_core(qf, kf, kmh, kml, hist + k * 64, kmx + k * 64, selinfo, GU_BH(k), GU_C(k), GU_T(k), lane, sel[k], rr[k]);
        if (k + 1 < NU) {
#pragma unroll
            for (int s = 0; s < 4; ++s) { qf[s] = qn_[s]; kf[s] = kn_[s]; } }
    }
    __syncthreads();
    if (tid < NU * 64) { const int hc = hist[tid]; if (hc > 0) base[tid] = (int)__hip_atomic_fetch_add(gcount + GU_BH(tid >> 6) * 64 + (tid & 63), (unsigned)hc, __ATOMIC_RELAXED, __HIP_MEMORY_SCOPE_AGENT); }
    __syncthreads();
    if (hf == 0) {
#pragma unroll
        for (int k = 0; k < NU; ++k) { unsigned* lp = list + ((size_t)GU_BH(k) * 64 << 14); const unsigned sl = sel[k], rk = rr[k], t = (unsigned)GU_T(k); const int s0 = sl & 63, s1 = (sl >> 6) & 63, s2 = (sl >> 12) & 63;
            if (sl & (1u << 18)) lp[((size_t)s0 << 14) + base[k * 64 + s0] + (rk & 255u)] = t;
            if (sl & (2u << 18)) lp[((size_t)s1 << 14) + base[k * 64 + s1] + ((rk >> 8) & 255u)] = t | (1u << 14);
            if (sl & (4u << 18)) lp[((size_t)s2 << 14) + base[k * 64 + s2] + ((rk >> 16) & 255u)] = t | (2u << 14); } }
#undef GU_BH
#undef GU_C
#undef GU_T
    __syncthreads();
}
__device__ __forceinline__ void moba_attn_item(LAS unsigned char* lds, const bf16* h, const unsigned* gcount, const unsigned* list, float* po, float* pml, int item, int tid, int wave, int lane) {
    const int n = item / 24, bh = item - n * 24, hh = bh % MB_H, b = bh / MB_H;
    LAS unsigned* Ks = (LAS unsigned*)(lds + AT_KS); LAS unsigned* Vs32 = (LAS unsigned*)(lds + AT_VS);
    LAS float* qst = (LAS float*)(lds + AT_WV + wave * AT_WVB); LAS float* pb = qst + 256;
    for (int i = 0; i < 16; ++i) { const int idx = tid + 512 * i, r = idx >> 5, dd = idx & 31; const unsigned* src = (const unsigned*)(h + ((size_t)b * SEQ + n * 256 + r) * NC_M + hh * 64);
        Ks[r * 33 + dd] = src[384 + dd]; Vs32[r * 32 + dd] = src[768 + dd]; }
    __syncthreads();
    const int cnt = (int)gcount[bh * 64 + n], total = 256 + cnt, nquads = (total + 3) >> 2;
    const float slope = hh < 8 ? ldexpf(1.0f, -(hh + 1)) : ldexpf(0.70710678118654752f, -(hh - 8));
    const unsigned* lp = list + (((size_t)bh * 64 + n) << 14);
    for (int quad = wave; quad < nquads; quad += 8) {
        int tq[4], slot[4];
#pragma unroll
        for (int qi = 0; qi < 4; ++qi) { int idx = quad * 4 + qi; idx = idx < total ? idx : total - 1;
            if (idx < 256) { tq[qi] = n * 256 + idx; slot[qi] = 3; } else { const unsigned e = lp[idx - 256]; tq[qi] = (int)(e & 16383u); slot[qi] = (int)(e >> 14); } }
#pragma unroll
        for (int qi = 0; qi < 4; ++qi) qst[qi * 64 + lane] = bf2f(h[((size_t)b * SEQ + tq[qi]) * NC_M + hh * 64 + lane]);
        float m[4], l[4], o[4];
        attn4<true>(Ks, (const LAS bf16*)Vs32, qst, pb, lane, tq, n * 256, slope, m, l, o);
#pragma unroll
        for (int qi = 0; qi < 4; ++qi) if (quad * 4 + qi < total) { const size_t pi = (((size_t)b * SEQ + tq[qi]) * MB_H + hh) * 4 + slot[qi];
            po[pi * 64 + lane] = o[qi]; if (lane == 0) { pml[pi * 2] = m[qi]; pml[pi * 2 + 1] = l[qi]; } }
    }
    __syncthreads();
}

__device__ __forceinline__ void moba_attn_item2(LAS unsigned char* lds, const bf16* h, const unsigned* gcount, const unsigned* list, bf16* po, float* pml, int item, int tid, int wave, int lane) {
    const int n = item / 24, bh = item - n * 24, hh = bh % MB_H, b = bh / MB_H, r = lane & 31, hf = lane >> 5;
    const bf16* hrow0 = h + ((size_t)b * SEQ + n * 256) * NC_M + hh * 64;
    stage_kv_images(lds, hrow0 + 768, hrow0 + 1536, NC_M, tid);
    __syncthreads();
    const int cnt = (int)gcount[bh * 64 + n], total = 256 + cnt, ntiles = (total + 31) >> 5;
    const float slope2 = (hh < 8 ? ldexpf(1.0f, -(hh + 1)) : ldexpf(0.70710678118654752f, -(hh - 8))) * 1.4426950408889634f;
    const unsigned shi = f2bf(slope2), slo = f2bf(slope2 - __builtin_bit_cast(float, shi << 16)); const unsigned qx = hf == 0 ? (shi | (slo << 16)) : 0u;
    const unsigned* lp = list + (((size_t)bh * 64 + n) << 14);
    const bf16* hq = h + (size_t)b * SEQ * NC_M + hh * 64 + 8 * hf;
#pragma unroll 1
    for (int tile = wave; tile < ntiles; tile += NWAVES) {
        int idx = tile * 32 + r; const bool valid = idx < total; idx = valid ? idx : total - 1;
        int tq, slot; if (idx < 256) { tq = n * 256 + idx; slot = 3; } else { const unsigned e = lp[idx - 256]; tq = (int)(e & 16383u); slot = (int)(e >> 14); }
        s16x8 qf[4]; { const bf16* qp = hq + (size_t)tq * NC_M;
#pragma unroll
            for (int s = 0; s < 4; ++s) qf[s] = *(const s16x8*)(qp + 16 * s); }
        f32x16 o[2]; float m2, l; const float dist0 = (float)(tq - n * 256);
        attn_tile32<true>(lds, qf, lane, dist0, qx, tile < 8, o, m2, l);
        { LAS unsigned char* sw = lds + AT2_SCR + wave * AT2_SCRW; const int pi = valid ? (int)((((size_t)b * SEQ + tq) * MB_H + hh) * 4 + slot) : -1;
#pragma unroll
          for (int dt = 0; dt < 2; ++dt)
#pragma unroll
              for (int g = 0; g < 4; ++g) { v2u w; w.x = cvtpk(o[dt][4 * g], o[dt][4 * g + 1]); w.y = cvtpk(o[dt][4 * g + 2], o[dt][4 * g + 3]); *(LAS v2u*)(sw + r * 144 + (32 * dt + 8 * g + 4 * hf) * 2) = w; }
          if (hf == 0) { *(LAS int*)(sw + 4608 + 4 * r) = pi; if (valid) { pml[(size_t)pi * 2] = m2 - slope2 * dist0; pml[(size_t)pi * 2 + 1] = l; } }
#pragma unroll
          for (int it = 0; it < 4; ++it) { const int q = 8 * it + (lane >> 3), c = lane & 7; const int pq = *(const LAS int*)(sw + 4608 + 4 * q); const v4u row = *(const LAS v4u*)(sw + q * 144 + c * 16);
              if (pq >= 0) *(v4u*)(po + (size_t)pq * 64 + c * 8) = row; } }
    }
    __syncthreads();
}
__device__ __forceinline__ void moba_combine(const bf16* __restrict__ po, const float* __restrict__ pml, const int* __restrict__ selinfo, bf16* __restrict__ mix, int gw, int ngw, int lane) {
    const int sub = lane >> 4, d4 = (lane & 15) * 4;
#pragma unroll 4
    for (int idx = gw * 4 + sub; idx < T * MB_H; idx += ngw * 4) { const int tg = idx / MB_H, hh = idx - tg * MB_H, ns = selinfo[idx]; const size_t p4 = (size_t)idx * 4;
        f32x2 ml[4]; f32x4 ov[4];
#pragma unroll
        for (int j = 0; j < 4; ++j) { ml[j] = ((const f32x2*)pml)[p4 + j]; const v2u ow = *(const v2u*)(po + (p4 + j) * 64 + d4); ov[j] = (f32x4){bflo(ow.x), bfhi(ow.x), bflo(ow.y), bfhi(ow.y)}; }
        float M = ml[3].x;
#pragma unroll
        for (int j = 0; j < 3; ++j) { const bool ok = (ns >> j) & 1; ml[j].x = ok ? ml[j].x : -INFINITY; ml[j].y = ok ? ml[j].y : 0.f; M = fmaxf(M, ml[j].x);
            ov[j].x = ok ? ov[j].x : 0.f; ov[j].y = ok ? ov[j].y : 0.f; ov[j].z = ok ? ov[j].z : 0.f; ov[j].w = ok ? ov[j].w : 0.f; }
        float den = 0.f; f32x4 num = {0.f, 0.f, 0.f, 0.f};
#pragma unroll
        for (int j = 0; j < 4; ++j) { const float w = __builtin_amdgcn_exp2f(ml[j].x - M); den += w * ml[j].y; num += ov[j] * w; }
        const float inv = 1.f / den; v2u o; o.x = pk2(num.x * inv, num.y * inv); o.y = pk2(num.z * inv, num.w * inv);
        *(v2u*)(mix + (size_t)tg * 1024 + hh * 64 + d4) = o; }
}

__device__ __forceinline__ void ln_row(f32x4 (&v)[4], const f32x4 (&gv)[4], const f32x4 (&bv)[4]) {
    float s = 0.f;
#pragma unroll
    for (int j = 0; j < 4; ++j) s += (v[j].x + v[j].y) + (v[j].z + v[j].w);
    const float mean = wave_sum(s) * (1.f / D); float s2 = 0.f;
#pragma unroll
    for (int j = 0; j < 4; ++j) { v[j] = v[j] - mean; s2 += (v[j].x * v[j].x + v[j].y * v[j].y) + (v[j].z * v[j].z + v[j].w * v[j].w); }
    const float rstd = 1.f / sqrtf(wave_sum(s2) * (1.f / D) + 1e-5f);
#pragma unroll
    for (int j = 0; j < 4; ++j) v[j] = v[j] * rstd * gv[j] + bv[j];
}
__device__ __forceinline__ void split_router_weights(const float* wr  , bf16* wrs  , size_t gtid, size_t gthreads) {
    for (size_t i = gtid; i < (size_t)DEPTH * D * NE; i += gthreads) { const int e = (int)(i & 31), d = (int)((i >> 5) & 1023), l = (int)(i >> 15);
        const float w = wr[i]; const unsigned hi = f2bf(w); const unsigned lo = f2bf(w - __builtin_bit_cast(float, hi << 16));
        wrs[(((size_t)l * 2 + 0) * NE + e) * D + d] = (bf16)hi; wrs[(((size_t)l * 2 + 1) * NE + e) * D + d] = (bf16)lo; }
}
constexpr int L1_XH = 0, L1_XL = 33024, L1_ROW = 2064, L1_PART = 66048, L1_HIST = 82432;
__device__ __forceinline__ void phase_ln1(LAS unsigned char* lds, const bf16* y, const float* g, const float* bb, const bf16* wrs  , const float* br,
                                          bf16* xbf, int* tok_e, int* tok_lr, float* tok_w, int* blk_cnt, int blk, int tid, int wave, int lane) {
    LAS float* part = (LAS float*)(lds + L1_PART);
    LAS int* hist = (LAS int*)(lds + L1_HIST);
    if (tid < 32) hist[tid] = 0;
    constexpr int TPB = T / GRID;
    const int e = lane & 31, m16 = lane & 15, quad = lane >> 4;
    s16x8 bw[4][2][2];
#pragma unroll
    for (int ks = 0; ks < 4; ++ks)
#pragma unroll
        for (int nt = 0; nt < 2; ++nt)
#pragma unroll
            for (int pp = 0; pp < 2; ++pp) bw[ks][nt][pp] = *(const s16x8*)(wrs + ((size_t)pp * NE + 16 * nt + m16) * D + wave * 128 + 32 * ks + 8 * quad);
    const float bre = br[e];
    f32x4 gv[4], bv[4];
#pragma unroll
    for (int j = 0; j < 4; ++j) { gv[j] = ((const f32x4*)g)[lane + 64 * j]; bv[j] = ((const f32x4*)bb)[lane + 64 * j]; }
    v2u xn[2][4], yn[2][4];
#pragma unroll
    for (int u = 0; u < 2; ++u) { const size_t t0 = (size_t)blk * TPB + 2 * wave + u; const v2u* xr = (const v2u*)(xbf + t0 * D) + lane; const v2u* yr = (const v2u*)(y + t0 * D) + lane;
#pragma unroll
        for (int j = 0; j < 4; ++j) { xn[u][j] = xr[64 * j]; yn[u][j] = yr[64 * j]; } }
    __syncthreads();
    for (int grp = 0; grp < TPB / 16; ++grp) { const size_t tg0 = (size_t)blk * TPB + grp * 16 + 2 * wave;
        f32x4 v[2][4];
#pragma unroll
        for (int u = 0; u < 2; ++u)
#pragma unroll
            for (int j = 0; j < 4; ++j) { const v2u xw = xn[u][j]; const v2u yw = yn[u][j];
                v[u][j].x = DN_ALPHA * bflo(xw.x) + bflo(yw.x); v[u][j].y = DN_ALPHA * bfhi(xw.x) + bfhi(yw.x); v[u][j].z = DN_ALPHA * bflo(xw.y) + bflo(yw.y); v[u][j].w = DN_ALPHA * bfhi(xw.y) + bfhi(yw.y); }
        if (grp + 1 < TPB / 16) {
#pragma unroll
            for (int u = 0; u < 2; ++u) { const v2u* xr = (const v2u*)(xbf + (tg0 + 16 + u) * D) + lane; const v2u* yr = (const v2u*)(y + (tg0 + 16 + u) * D) + lane;
#pragma unroll
                for (int j = 0; j < 4; ++j) { xn[u][j] = xr[64 * j]; yn[u][j] = yr[64 * j]; } } }
#pragma unroll
        for (int u = 0; u < 2; ++u) { ln_row(v[u], gv, bv);
            v2u* xb = (v2u*)(xbf + (tg0 + u) * D) + lane;
#pragma unroll
            for (int j = 0; j < 4; ++j) { v2u hw; hw.x = cvtpk(v[u][j].x, v[u][j].y); hw.y = cvtpk(v[u][j].z, v[u][j].w); xb[64 * j] = hw;
                v2u lw; lw.x = cvtpk(v[u][j].x - bflo(hw.x), v[u][j].y - bfhi(hw.x)); lw.y = cvtpk(v[u][j].z - bflo(hw.y), v[u][j].w - bfhi(hw.y));
                *(LAS v2u*)(lds + L1_XH + (2 * wave + u) * L1_ROW + (4 * lane + 256 * j) * 2) = hw; *(LAS v2u*)(lds + L1_XL + (2 * wave + u) * L1_ROW + (4 * lane + 256 * j) * 2) = lw; } }
        __syncthreads();
        { f32x4 acc[2] = {{0.f, 0.f, 0.f, 0.f}, {0.f, 0.f, 0.f, 0.f}};
#pragma unroll
          for (int ks = 0; ks < 4; ++ks) { const int off = m16 * L1_ROW + (wave * 128 + 32 * ks + 8 * quad) * 2;
              const s16x8 ah = *(const LAS s16x8*)(lds + L1_XH + off), al = *(const LAS s16x8*)(lds + L1_XL + off);
#pragma unroll
              for (int nt = 0; nt < 2; ++nt) { acc[nt] = __builtin_amdgcn_mfma_f32_16x16x32_bf16(ah, bw[ks][nt][0], acc[nt], 0, 0, 0); acc[nt] = __builtin_amdgcn_mfma_f32_16x16x32_bf16(ah, bw[ks][nt][1], acc[nt], 0, 0, 0);
                  acc[nt] = __builtin_amdgcn_mfma_f32_16x16x32_bf16(al, bw[ks][nt][0], acc[nt], 0, 0, 0); } }
#pragma unroll
          for (int nt = 0; nt < 2; ++nt)
#pragma unroll
              for (int jj = 0; jj < 4; ++jj) part[(wave * 16 + 4 * quad + jj) * 32 + 16 * nt + m16] = acc[nt][jj]; }
        __syncthreads();
#pragma unroll
        for (int u = 0; u < 2; ++u) { const size_t t = tg0 + u;
            float logit = bre;
#pragma unroll
            for (int w = 0; w < 8; ++w) logit += part[(w * 16 + 2 * wave + u) * 32 + e];
            int rank = 0;
#pragma unroll
            for (int q = 0; q < 32; ++q) { const float oq = __builtin_bit_cast(float, __builtin_amdgcn_readlane(__builtin_bit_cast(int, logit), q)); rank += (oq > logit || (oq == logit && q < e)) ? 1 : 0; }
            int se[4]; float sv[4];
#pragma unroll
            for (int k = 0; k < 4; ++k) { const unsigned long long mk = __ballot(rank == k && lane < 32); const int src = __builtin_ctzll(mk);
                se[k] = src; sv[k] = __builtin_bit_cast(float, __builtin_amdgcn_readlane(__builtin_bit_cast(int, logit), src)); }
            const float e1 = __expf(sv[1] - sv[0]), e2 = __expf(sv[2] - sv[0]), e3 = __expf(sv[3] - sv[0]), inv = 1.f / (1.f + e1 + e2 + e3);
            const float wk[4] = {inv, e1 * inv, e2 * inv, e3 * inv};
            if (lane == 0) {
#pragma unroll
                for (int k = 0; k < 4; ++k) { const int lr = __hip_atomic_fetch_add(hist + se[k], 1, __ATOMIC_RELAXED, __HIP_MEMORY_SCOPE_WORKGROUP);
                    tok_e[t * 4 + k] = se[k]; tok_lr[t * 4 + k] = lr; tok_w[t * 4 + k] = wk[k]; } } }
    }
    __syncthreads();
    if (tid < 32) blk_cnt[blk * 32 + tid] = hist[tid];
    __syncthreads();
}
__device__ __forceinline__ void phase_dispatch(LAS unsigned char* lds, const int* __restrict__ blk_cnt, const int* __restrict__ tok_e, const int* __restrict__ tok_lr, int* __restrict__ tok_row, int* __restrict__ tab,
                                               const bf16* __restrict__ xbf, bf16* __restrict__ xs, int blk, int tid, int wave, int lane) {
    LAS int* tot = (LAS int*)lds; LAS int* pre = tot + 32; LAS int* pst = pre + 32; LAS int* rows = pst + 64;
    if (tid < 32) { int s = 0, p = 0;
#pragma unroll 8
        for (int bb = 0; bb < GRID; ++bb) { const int c = blk_cnt[bb * 32 + tid]; p += (bb < blk) ? c : 0; s += c; } tot[tid] = s; pre[tid] = p; }
    __syncthreads();
    if (tid == 0) { int acc = 0; for (int e = 0; e < 32; ++e) { pst[e] = acc; acc += ((tot[e] + 255) >> 8) << 8; } pst[32] = acc; }
    __syncthreads();
    if (blk == 0 && tid < 33) tab[tid] = pst[tid] >> 8;
    constexpr int TPB = T / GRID;
    static_assert(TPB * 4 == NTHR, "one (token, k) pair per thread");
    { const size_t ti = (size_t)blk * TPB * 4 + tid; const int e = tok_e[ti]; const int r = pst[e] + pre[e] + tok_lr[ti]; tok_row[ti] = r; rows[tid] = r; }
    __syncthreads();
#pragma unroll 4
    for (int i = wave; i < TPB * 4; i += NWAVES) { const int r = rows[i];
        const v4u* src = (const v4u*)(xbf + ((size_t)blk * TPB + (i >> 2)) * D) + 2 * lane; const v4u a = src[0], b = src[1];
        v4u o; o.x = pk4_fp8(bflo(a.x), bfhi(a.x), bflo(a.y), bfhi(a.y)); o.y = pk4_fp8(bflo(a.z), bfhi(a.z), bflo(a.w), bfhi(a.w)); o.z = pk4_fp8(bflo(b.x), bfhi(b.x), bflo(b.y), bfhi(b.y)); o.w = pk4_fp8(bflo(b.z), bfhi(b.z), bflo(b.w), bfhi(b.w));
        ((v4u*)((unsigned char*)xs + (size_t)r * D))[lane] = o; }
    __syncthreads();
}
__device__ __forceinline__ f32x4 fp8x4_to_f32(unsigned w) {
    const f32x2 lo = __builtin_amdgcn_cvt_pk_f32_fp8((int)w, false), hi = __builtin_amdgcn_cvt_pk_f32_fp8((int)w, true); return (f32x4){lo.x, lo.y, hi.x, hi.y};
}
__device__ __forceinline__ void phase_ln2(const unsigned char* __restrict__ yrows, const int* __restrict__ tok_row, const float* __restrict__ tok_w, const float* __restrict__ g, const float* __restrict__ bb,
                                          float* __restrict__ xout, bf16* xbf, int gw, int ngw, int lane) {
    f32x4 gv[4], bv[4];
#pragma unroll
    for (int j = 0; j < 4; ++j) { gv[j] = ((const f32x4*)g)[lane + 64 * j]; bv[j] = ((const f32x4*)bb)[lane + 64 * j]; }
    constexpr int NTK = 2;
    static_assert(T % (NTK * GRID * NWAVES) == 0, "NTK tokens per wave per step");
    for (int t0 = gw; t0 < T; t0 += NTK * ngw) {
        f32x4 v[NTK][4];
#pragma unroll
        for (int u = 0; u < NTK; ++u) { const int t = t0 + u * ngw; int r[4]; float w[4];
#pragma unroll
            for (int k = 0; k < 4; ++k) { r[k] = tok_row[(size_t)t * 4 + k]; w[k] = tok_w[(size_t)t * 4 + k] * (1.f / 16.f); }
            const v2u* xr = (const v2u*)(xbf + (size_t)t * D) + lane;
#pragma unroll
            for (int j = 0; j < 4; ++j) { f32x4 f = {0.f, 0.f, 0.f, 0.f};
#pragma unroll
                for (int k = 0; k < 4; ++k) { const unsigned yw = ((const unsigned*)(yrows + (size_t)r[k] * D))[lane + 64 * j]; f += fp8x4_to_f32(yw) * w[k]; }
                const v2u xw = xr[64 * j]; v[u][j].x = DN_ALPHA * bflo(xw.x) + f.x; v[u][j].y = DN_ALPHA * bfhi(xw.x) + f.y; v[u][j].z = DN_ALPHA * bflo(xw.y) + f.z; v[u][j].w = DN_ALPHA * bfhi(xw.y) + f.w; } }
#pragma unroll
        for (int u = 0; u < NTK; ++u) { const int t = t0 + u * ngw;
            ln_row(v[u], gv, bv);
            if (xout) { f32x4* xo = (f32x4*)(xout + (size_t)t * D) + lane;
#pragma unroll
                for (int j = 0; j < 4; ++j) xo[64 * j] = v[u][j]; }
            else { v2u* xb = (v2u*)(xbf + (size_t)t * D) + lane;
#pragma unroll
                for (int j = 0; j < 4; ++j) { v2u ww; ww.x = pk2(v[u][j].x, v[u][j].y); ww.y = pk2(v[u][j].z, v[u][j].w); xb[64 * j] = ww; } } } }
}


struct Args { const float* in[20]; float* out; unsigned char* ws; int l_lo, l_hi, ph_lo, ph_hi; };
typedef const __attribute__((address_space(4))) Args* KArgsP;
#define KA_LOAD() ({ KArgsP p_ = (KArgsP)__builtin_amdgcn_kernarg_segment_ptr(); asm volatile("" : "+s"(p_)); p_; })
#ifndef PHMASK
#define PHMASK 0xFFFF
#endif
#ifndef REPEAT_MASK
#define REPEAT_MASK 0
#endif
#ifndef REPEAT_LMASK
#define REPEAT_LMASK 0xF
#endif
#define PH_BEGIN(k) _Pragma("unroll") for (int rep_ = 0; rep_ < ((((REPEAT_MASK >> (k)) & 1) && ((REPEAT_LMASK >> l) & 1)) ? 2 : 1); ++rep_) { if ((PHMASK >> (k)) & 1) { KArgsP ka = KA_LOAD(); unsigned char* ws = ka->ws; int tid = threadIdx.x; asm volatile("" : "+v"(tid)); \
    const int lane = tid & 63, wave = __builtin_amdgcn_readfirstlane(tid >> 6); int blk = blockIdx.x; asm volatile("" : "+s"(blk)); \
    const int gw = blk * NWAVES + wave; const size_t gtid = (size_t)blk * NTHR + tid; (void)lane; (void)gw; (void)gtid; (void)ws;
#if ONE_LAUNCH
#define PH_SEAM() do { XcdBarrier b_; b_.bar = (unsigned*)(KA_LOAD()->ws + WS_CTL) + CW_BAR; b_.x = xb_xcc_id(); b_.st = (volatile LAS unsigned*)(lds + MISC_OFF); xcd_barrier(b_); } while (0)
#else
#define PH_SEAM() do {} while (0)
#endif
#define PH_END() PH_SEAM(); } }
#define PH_END_NOSEAM() } }
#define WSP(type, off) ((type*)(ws + (off)))
constexpr int G = GRID, NGW = GRID * NWAVES; constexpr size_t GTHREADS = (size_t)GRID * NTHR;
template <int L> __device__ __forceinline__ void layer_phases(LAS unsigned char* lds) {
    constexpr int l = L; LAS int* tabL = (LAS int*)(lds + MISC_OFF + 256);

        const int j = l >> 1; const bool moba = (l & 1) != 0;
        const int NC = moba ? NC_M : NC_H, qoff = moba ? 2304 : 3072;

        if (l == 0) {
        PH_BEGIN(1)
            phase_weights((LAS float*)(lds + wave * 16384), gw, NGW, lane, ka->in[2], NC_H, ka->in[6], 4, ka->in[7], ka->in[12], ka->in[14], ka->in[16], WSP(bf16, WS_WIN), WSP(bf16, WS_WKV4), WSP(bf16, WS_WO), WSP(bf16, WS_WGU), WSP(bf16, WS_WD));
        PH_END()
        }
        PH_BEGIN(2)
            { pg8::Gemm g{WSP(bf16, WS_XBF), WSP(bf16, WS_WIN), T, NC, D, 0, 0}; pg8::StaticOrder S; S.init(T, NC, G, blk); pg8::EpiPlain E{WSP(bf16, WS_H), NC, moba ? 0x207u : 0x1000u, 0.125f * 1.4426950408889634f};
              pg8::gemm_phase<pg8::EpiPlain, pg8::StaticOrder, true, true>(lds, g, S, E); }
            if (l == 0) {
              pg8::Gemm g{WSP(bf16, WS_MEMBF), WSP(bf16, WS_WKV4), 512, 2048, D, 0, 0}; pg8::StaticOrder S; S.init(512, 2048, G, blk >= 128 ? blk - 128 : G); pg8::EpiPlain E{WSP(bf16, WS_KV4), 2048, 0u, 1.f};
              pg8::gemm_phase<pg8::EpiPlain, pg8::StaticOrder, true, true>(lds, g, S, E); }
        PH_END()
        if (!moba) {
            PH_BEGIN(3)
                for (int u = blk; u < NBATCH * HG_H * HNSEG; u += G) hgrn_mfma<false>(lds, WSP(bf16, WS_H), ka->in[3], j, ka->in[4] + j * 128, WSP(float, WS_SLOC), WSP(float, WS_DSEG), WSP(bf16, WS_MIX), u, tid, wave, lane);
                for (int u = blk; u < 512; u += G) memattn_unit2(lds, WSP(bf16, WS_H), NC, qoff, WSP(bf16, WS_KV4) + 512 * l, WSP(bf16, WS_MIX), u, tid, wave, lane);
            PH_END()
            PH_BEGIN(4)
                hgrn_scan(WSP(float, WS_SLOC), WSP(float, WS_DSEG), gtid, GTHREADS);
            PH_END()
            PH_BEGIN(5)
                for (int u = blk; u < NBATCH * HG_H * HNSEG; u += G) hgrn_mfma<true>(lds, WSP(bf16, WS_H), ka->in[3], j, ka->in[4] + j * 128, WSP(float, WS_SLOC), WSP(float, WS_DSEG), WSP(bf16, WS_MIX), u, tid, wave, lane);
            PH_END()
        } else {
            PH_BEGIN(3)
                for (int u = blk; u < 24 * MB_NB; u += G) kmean_unit(lds, WSP(bf16, WS_H), WSP(float, WS_KMEAN), WSP(float, WS_KMEAN + 512 * 1024), u, tid, wave);
                for (int u = blk; u < 512; u += G) memattn_unit2(lds, WSP(bf16, WS_H), NC, qoff, WSP(bf16, WS_KV4) + 512 * l, WSP(bf16, WS_MIX), u, tid, wave, lane);
            PH_END()
            PH_BEGIN(4)
                moba_gate_wg(lds, WSP(bf16, WS_H), WSP(float, WS_KMEAN), WSP(float, WS_KMEAN + 512 * 1024), WSP(unsigned, WS_CTL) + CW_GCOUNT + j * 1536, WSP(int, WS_SELINFO), WSP(unsigned, WS_LIST), blk, tid);
            PH_END()
            PH_BEGIN(5)
                { unsigned* qhead = WSP(unsigned, WS_CTL) + CW_GCOUNT + 2 * 1536 + 64 * j; LAS int* itl = (LAS int*)(lds + MISC_OFF + 512);
                  for (;;) { if (tid == 0) *itl = (int)__hip_atomic_fetch_add(qhead, 1u, __ATOMIC_RELAXED, __HIP_MEMORY_SCOPE_AGENT);
                      __syncthreads(); const int it = *itl; __syncthreads();
                      if (it >= 24 * MB_NB) break;
                      moba_attn_item2(lds, WSP(bf16, WS_H), WSP(unsigned, WS_CTL) + CW_GCOUNT + j * 1536, WSP(unsigned, WS_LIST), WSP(bf16, WS_PO), WSP(float, WS_PML), it, tid, wave, lane); } }
            PH_END()
            PH_BEGIN(6)
                moba_combine(WSP(bf16, WS_PO), WSP(float, WS_PML), WSP(int, WS_SELINFO), WSP(bf16, WS_MIX), gw, NGW, lane);
            PH_END()
        }
        PH_BEGIN(7)
            pg8::Gemm g{WSP(bf16, WS_MIX), WSP(bf16, WS_WO), T, D, D, 0, 0}; pg8::StaticOrder S; S.init(T, D, G, blk); pg8::EpiPlain E{WSP(bf16, WS_Y), D, 0u, 1.f};
            pg8::gemm_phase<pg8::EpiPlain, pg8::StaticOrder, true, true>(lds, g, S, E);
        PH_END()
        PH_BEGIN(8)
            phase_ln1(lds, WSP(bf16, WS_Y), ka->in[8] + l * D, ka->in[9] + l * D, WSP(bf16, WS_WRS) + (size_t)l * 2 * NE * D, ka->in[11] + l * NE, WSP(bf16, WS_XBF),
                      WSP(int, WS_TOK + TOK_E), WSP(int, WS_TOK + TOK_LR), WSP(float, WS_TOK + TOK_W), WSP(int, WS_TOK + TOK_BLKCNT), blk, tid, wave, lane);
        PH_END()
        PH_BEGIN(9)
            phase_dispatch(lds, WSP(int, WS_TOK + TOK_BLKCNT), WSP(int, WS_TOK + TOK_E), WSP(int, WS_TOK + TOK_LR), WSP(int, WS_TOK + TOK_ROW), WSP(int, WS_TOK + TOK_TAB), WSP(bf16, WS_XBF), WSP(bf16, WS_XS), blk, tid, wave, lane);
        PH_END()
        PH_BEGIN(10)
            if (tid < 33) tabL[tid] = WSP(int, WS_TOK + TOK_TAB)[tid];
            __syncthreads();
            int sw_ = 0x7A7A7A7A, sx_ = 0x7F7F7F7F; asm volatile("" : "+s"(sw_), "+s"(sx_));
            pg8::Gemm g{WSP(bf16, WS_XS), WSP(bf16, WS_WGU), MOE_MAXROWS, NE * 2048, D / 2, sw_, sx_}; pg8::MoeOrder S{tabL, 8, G, blk, tabL[32] * 8};
            pg8::EpiSwiglu E{WSP(unsigned char, WS_HID), ka->in[13] + (size_t)l * NE * 1024, ka->in[15] + (size_t)l * NE * 1024};
            pg8::gemm_phase<pg8::EpiSwiglu, pg8::MoeOrder, true, true, true>(lds, g, S, E);
        PH_END()
        PH_BEGIN(11)
            if (tid < 33) tabL[tid] = WSP(int, WS_TOK + TOK_TAB)[tid];
            __syncthreads();
            int sw_ = 0x79797979, sx_ = 0x7F7F7F7F; asm volatile("" : "+s"(sw_), "+s"(sx_));
            pg8::Gemm g{WSP(bf16, WS_HID), WSP(bf16, WS_WD), MOE_MAXROWS, NE * 1024, D / 2, sw_, sx_}; pg8::MoeOrder S{tabL, 4, G, blk, tabL[32] * 4};
            pg8::EpiDown E{WSP(unsigned char, WS_XS), ka->in[17] + (size_t)l * NE * 1024};
            pg8::gemm_phase<pg8::EpiDown, pg8::MoeOrder, true, true, true>(lds, g, S, E);
        PH_END()
        PH_BEGIN(12)
            float* x2out = (l == DEPTH - 1) ? ka->out : nullptr;
            phase_ln2(WSP(unsigned char, WS_XS), WSP(int, WS_TOK + TOK_ROW), WSP(float, WS_TOK + TOK_W), ka->in[18] + l * D, ka->in[19] + l * D, x2out, WSP(bf16, WS_XBF), gw, NGW, lane);
            if (l + 1 < DEPTH) { constexpr int ln = l + 1, jn = ln >> 1; constexpr bool mn = (ln & 1) != 0;
                const float* win_src = mn ? ka->in[5] + (size_t)jn * D * NC_M : ka->in[2] + (size_t)jn * D * NC_H; const size_t moff = (size_t)ln * NE * 1024 * 1024;
                phase_weights((LAS float*)(lds + wave * 16384), gw, NGW, lane, win_src, mn ? NC_M : NC_H, ka->in[6], 0, ka->in[7] + (size_t)ln * D * D,
                              ka->in[12] + moff, ka->in[14] + moff, ka->in[16] + moff, WSP(bf16, WS_WIN), WSP(bf16, WS_WKV4), WSP(bf16, WS_WO), WSP(bf16, WS_WGU), WSP(bf16, WS_WD)); }
            if (l + 1 < DEPTH) PH_SEAM();
        PH_END_NOSEAM()
}
__global__ void __launch_bounds__(NTHR, 2) fwd_kernel(Args args) {
    extern __shared__ __attribute__((aligned(16))) unsigned char lds_raw[];
    LAS unsigned char* lds = (LAS unsigned char*)lds_raw;
    if (threadIdx.x < 4) ((LAS unsigned*)(lds + MISC_OFF))[threadIdx.x] = 0u;
    __syncthreads();
#if ONE_LAUNCH
    (void)xcd_barrier_post((unsigned*)(args.ws + WS_CTL) + CW_BAR, (volatile LAS unsigned*)(lds + MISC_OFF));
#endif
    { const int l = 0; (void)l;
    PH_BEGIN(0)
        cvt_rows_bf16(ka->in[0], WSP(bf16, WS_XBF), (size_t)T * D / 8, gtid, GTHREADS);
        cvt_rows_bf16(ka->in[1], WSP(bf16, WS_MEMBF), (size_t)512 * D / 8, gtid, GTHREADS);
        split_router_weights(ka->in[10], WSP(bf16, WS_WRS), gtid, GTHREADS);
    PH_END_NOSEAM() }
    layer_phases<0>(lds); layer_phases<1>(lds); layer_phases<2>(lds); layer_phases<3>(lds);
}

extern "C" void kernel_launch(void* const* d_in, const int* in_sizes, int n_in, void* d_out, int out_size, void* d_ws, size_t ws_size, hipStream_t stream) {
    static int ready = 0;
    if (ready == 0) {
        if (n_in != 20 || in_sizes[0] != T * D || out_size != T * D || ws_size < WS_END) { fprintf(stderr, "kernel_launch: unexpected shapes (n_in %d, in0 %d, out %d, ws %zu < %zu)\n", n_in, n_in > 0 ? in_sizes[0] : -1, out_size, ws_size, (size_t)WS_END); ready = -1; return; }
        if (hipFuncSetAttribute((const void*)fwd_kernel, hipFuncAttributeMaxDynamicSharedMemorySize, LDS_BYTES) != hipSuccess) { fprintf(stderr, "kernel_launch: hipFuncSetAttribute failed\n"); ready = -1; return; }
        int per_cu = 0;
        if (hipOccupancyMaxActiveBlocksPerMultiprocessor(&per_cu, (const void*)fwd_kernel, NTHR, LDS_BYTES) != hipSuccess || per_cu < 1) fprintf(stderr, "kernel_launch: occupancy query says %d\n", per_cu);
        (void)hipGetLastError();
        ready = 1;
    }
    if (ready < 0) return;
    if (hipMemsetAsync((char*)d_ws + WS_CTL, 0, CTL_ZERO_BYTES, stream) != hipSuccess) return;
    Args a{};
    for (int i = 0; i < 20; ++i) a.in[i] = (const float*)d_in[i];
    a.out = (float*)d_out; a.ws = (unsigned char*)d_ws;
    a.l_lo = 0; a.l_hi = DEPTH; a.ph_lo = 0; a.ph_hi = NPHASE;
    hipLaunchKernelGGL(fwd_kernel, dim3(GRID), dim3(NTHR), LDS_BYTES, stream, a);
}
```

```cpp
#include <hip/hip_runtime.h>
#include <cstdio>
#include <cstdint>
#include <cmath>
namespace pg8 {
#define PG8_LAS __attribute__((address_space(3)))
typedef unsigned short bf16_t;
typedef short bf16x8 __attribute__((ext_vector_type(8)));
typedef float f32x4 __attribute__((ext_vector_type(4)));
typedef unsigned u32x4 __attribute__((ext_vector_type(4)));
constexpr int BM = 256, BK = 64, HALF = 128, HTB = HALF * BK * 2  , STAGE_BYTES = 8 * HTB, NXCD = 8, WGM = 8;

__host__ __device__ __forceinline__ int lds_byte(int r, int c) { const int st = (r >> 4) * 2 + (c >> 5), rr = r & 15, cc = c & 31, ob = rr * 64 + cc * 2; return st * 1024 + (ob ^ (((ob >> 9) & 1) << 5)); }
__host__ __device__ __forceinline__ void stage_rc(int b, int& R, int& C) { const int st = b / 1024, sb = b % 1024, swz = sb ^ (((sb >> 9) & 1) << 5); R = (st >> 1) * 16 + swz / 64; C = (st & 1) * 32 + (swz % 64) / 2; }
__host__ __device__ __forceinline__ int perm32(int rho) { const int n = rho >> 4, i = rho & 15; return 8 * (i >> 2) + 4 * n + (i & 3); }

struct Unit { int pm, pn; };
struct Gemm { const bf16_t* A; const bf16_t* Bt; int M, N, K; int sw, sx; };
typedef int i32x8 __attribute__((ext_vector_type(8))); typedef int i32x4 __attribute__((ext_vector_type(4)));

struct StaticOrder {
    int nM, nN, nwg, G, c;
    __host__ __device__ void init(int M, int N, int G_, int c_) { nM = M / BM; nN = N / BM; nwg = nM * nN; G = G_; c = c_; }
    __host__ __device__ bool next(int i, Unit& u) const {
        const long L = (long)i * G + c; if (L >= nwg) return false;
        int wgid = (int)L; { const int q = nwg / NXCD, r = nwg % NXCD, xcd = wgid % NXCD, off = wgid / NXCD; wgid = (xcd < r ? xcd * (q + 1) : r * (q + 1) + (xcd - r) * q) + off; }
        const int nig = WGM * nN, gid = wgid / nig, fm = gid * WGM, gsz = (nM - fm) < WGM ? (nM - fm) : WGM;
        u.pm = fm + ((wgid % nig) % gsz); u.pn = (wgid % nig) / gsz; return true;
    }
    __device__ __forceinline__ void a_ready(const Unit&) const {}
    __device__ __forceinline__ void done(const Unit&) const {}
};

__device__ __forceinline__ unsigned cvt_pk_bf16(float lo, float hi) { unsigned r; asm volatile("v_cvt_pk_bf16_f32 %0, %1, %2" : "=v"(r) : "v"(lo), "v"(hi)); return r; }
typedef float f32x2 __attribute__((ext_vector_type(2)));
struct EpiPlain {
    static constexpr bool PERM = true, AFTER_DRAIN = false;
    bf16_t* O; int ldc; unsigned smask; float sc;
    struct Pre {};
    __device__ __forceinline__ void pre_load(const Unit&, int, int, Pre&) const {}
    __device__ __forceinline__ void acc_init(f32x4 (&acc)[2][2][4][2], const Pre&) const {
#pragma unroll
        for (int a = 0; a < 2; ++a)
#pragma unroll
            for (int b = 0; b < 2; ++b)
#pragma unroll
                for (int m = 0; m < 4; ++m)
#pragma unroll
                    for (int n = 0; n < 2; ++n) acc[a][b][m][n] = (f32x4){0.f, 0.f, 0.f, 0.f}; }
    __device__ __forceinline__ void operator()(const f32x4 (&acc)[2][2][4][2], const Unit& u, int wr, int wc, int fr, int fq) const {
        const int row0 = u.pm * BM + wr * 64 + fr; const int col0 = u.pn * BM + wc * 32 + 8 * fq; const float s = ((smask >> u.pn) & 1u) ? sc : 1.f;
#pragma unroll
        for (int ai = 0; ai < 2; ++ai)
#pragma unroll
            for (int m = 0; m < 4; ++m) { bf16_t* rowp = O + (size_t)(row0 + ai * HALF + m * 16) * ldc + col0;
#pragma unroll
                for (int bj = 0; bj < 2; ++bj) { const f32x4 v0 = acc[ai][bj][m][0] * s, v1 = acc[ai][bj][m][1] * s;
                    u32x4 w; w.x = cvt_pk_bf16(v0[0], v0[1]); w.y = cvt_pk_bf16(v0[2], v0[3]); w.z = cvt_pk_bf16(v1[0], v1[1]); w.w = cvt_pk_bf16(v1[2], v1[3]);
                    *(u32x4*)(rowp + bj * HALF) = w; } }
    }
};
__device__ __forceinline__ float swiglu1(float g, float u) {
    float gm; asm("v_min_f32 %0, 0x40e00000, %1" : "=v"(gm) : "v"(g));
    const float um = __builtin_amdgcn_fmed3f(u, -7.0f, 7.0f);
    const float s = __builtin_amdgcn_rcpf(1.0f + __builtin_amdgcn_exp2f(gm * (-1.702f * 1.4426950408889634f)));
    const float gs = gm * s;
    return __builtin_fmaf(gs, um, gs);
}
__device__ __forceinline__ unsigned pk4_fp8e(float a, float b, float c, float d) { int w = 0; w = __builtin_amdgcn_cvt_pk_fp8_f32(a, b, w, false); w = __builtin_amdgcn_cvt_pk_fp8_f32(c, d, w, true); return (unsigned)w; }
struct EpiSwiglu {
    static constexpr bool PERM = true, AFTER_DRAIN = false;
    unsigned char* hid; const float* bg; const float* bu;
    struct Pre { f32x4 g0, g1, u0, u1; };
    __device__ __forceinline__ void pre_load(const Unit& u, int wc, int fq, Pre& p) const { const int e = u.pn >> 3, col0 = (u.pn & 7) * 128 + wc * 32 + 8 * fq;
        p.g0 = *(const f32x4*)(bg + e * 1024 + col0); p.g1 = *(const f32x4*)(bg + e * 1024 + col0 + 4); p.u0 = *(const f32x4*)(bu + e * 1024 + col0); p.u1 = *(const f32x4*)(bu + e * 1024 + col0 + 4); }
    __device__ __forceinline__ void acc_init(f32x4 (&acc)[2][2][4][2], const Pre& p) const {
#pragma unroll
        for (int a = 0; a < 2; ++a)
#pragma unroll
            for (int m = 0; m < 4; ++m) { acc[a][0][m][0] = p.g0; acc[a][0][m][1] = p.g1; acc[a][1][m][0] = p.u0; acc[a][1][m][1] = p.u1; } }
    __device__ __forceinline__ void operator()(const f32x4 (&acc)[2][2][4][2], const Unit& u, int wr, int wc, int fr, int fq) const {
        const int pn = u.pn & 7;
        const int row0 = u.pm * BM + wr * 64 + fr; const int col0 = pn * 128 + wc * 32 + 8 * fq;
#pragma unroll
        for (int ai = 0; ai < 2; ++ai)
#pragma unroll
            for (int m = 0; m < 4; ++m) { unsigned char* rowp = hid + (size_t)(row0 + ai * HALF + m * 16) * 1024 + col0;
                const f32x4 ga = acc[ai][0][m][0], gb = acc[ai][0][m][1], ua = acc[ai][1][m][0], ub = acc[ai][1][m][1];
                typedef unsigned u32x2 __attribute__((ext_vector_type(2))); u32x2 w;
                w.x = pk4_fp8e(swiglu1(ga[0], ua[0]), swiglu1(ga[1], ua[1]), swiglu1(ga[2], ua[2]), swiglu1(ga[3], ua[3]));
                w.y = pk4_fp8e(swiglu1(gb[0], ub[0]), swiglu1(gb[1], ub[1]), swiglu1(gb[2], ub[2]), swiglu1(gb[3], ub[3]));
                *(u32x2*)rowp = w; }
    }
};
struct EpiDown {
    static constexpr bool PERM = true, AFTER_DRAIN = false;
    unsigned char* y; const float* bd;
    struct Pre { f32x4 b[2][2]; };
    __device__ __forceinline__ void pre_load(const Unit& u, int wc, int fq, Pre& p) const { const int e = u.pn >> 2, col0 = (u.pn & 3) * BM + wc * 32 + 8 * fq;
#pragma unroll
        for (int bj = 0; bj < 2; ++bj)
#pragma unroll
            for (int n = 0; n < 2; ++n) p.b[bj][n] = *(const f32x4*)(bd + e * 1024 + col0 + bj * HALF + 4 * n); }
    __device__ __forceinline__ void acc_init(f32x4 (&acc)[2][2][4][2], const Pre& p) const {
#pragma unroll
        for (int a = 0; a < 2; ++a)
#pragma unroll
            for (int bj = 0; bj < 2; ++bj)
#pragma unroll
                for (int m = 0; m < 4; ++m) { acc[a][bj][m][0] = p.b[bj][0] * 16.f; acc[a][bj][m][1] = p.b[bj][1] * 16.f; } }
    __device__ __forceinline__ void operator()(const f32x4 (&acc)[2][2][4][2], const Unit& u, int wr, int wc, int fr, int fq) const {
        const int pn = u.pn & 3;
        const int row0 = u.pm * BM + wr * 64 + fr; const int col0 = pn * BM + wc * 32 + 8 * fq;
#pragma unroll
        for (int ai = 0; ai < 2; ++ai)
#pragma unroll
            for (int m = 0; m < 4; ++m) { unsigned char* rowp = y + (size_t)(row0 + ai * HALF + m * 16) * 1024 + col0;
#pragma unroll
                for (int bj = 0; bj < 2; ++bj) { const f32x4 v0 = acc[ai][bj][m][0], v1 = acc[ai][bj][m][1];
                    typedef unsigned u32x2 __attribute__((ext_vector_type(2))); u32x2 w; w.x = pk4_fp8e(v0[0], v0[1], v0[2], v0[3]); w.y = pk4_fp8e(v1[0], v1[1], v1[2], v1[3]);
                    *(u32x2*)(rowp + bj * HALF) = w; } }
    }
};
struct MoeOrder {
    const PG8_LAS int* tab; int npn, G, c, nunits;
    __device__ __forceinline__ bool next(int i, Unit& u) const {
        const int tpx = 32 / npn, s = c >> 3, tile = (i * 8 + (c & 7)) * tpx + s / npn, pn = s % npn;
        if ((i * 8) * tpx >= nunits / npn) return false;
        if (tile >= nunits / npn) { u.pm = 0; u.pn = 0; return false; }
        int e = 0;
#pragma unroll
        for (int k = 1; k < 32; ++k) e += (tab[k] <= tile) ? 1 : 0;
        u.pm = tile; u.pn = __builtin_amdgcn_readfirstlane(e) * npn + pn; return true;
    }
    __device__ __forceinline__ void a_ready(const Unit&) const {}
    __device__ __forceinline__ void done(const Unit&) const {}
};
template <class Epi, class Sched, bool ALIGN_EPI = false, bool SP2 = false, bool F8 = false>
__device__ __forceinline__ void gemm_phase(PG8_LAS unsigned char* lds, const Gemm g, const Sched& S, const Epi& E) {
    int tid_ = threadIdx.x; asm volatile("" : "+v"(tid_));
    const int tid = tid_, wid = __builtin_amdgcn_readfirstlane(tid >> 6), lane = tid & 63, wr = wid >> 2, wc = wid & 3, fr = lane & 15, fq = lane >> 4;
    const int K = g.K, nt = K / BK;
    unsigned voffA, voffB;
    { int R, C; stage_rc(tid * 16, R, C); const int Rb = Epi::PERM ? ((R & ~31) + perm32(R & 31)) : R; voffA = (unsigned)(R * K + C) * 2u; voffB = (unsigned)(Rb * K + C) * 2u; }
    const unsigned qstep = 64u * (unsigned)K * 2u;
    const unsigned kstep = (unsigned)(BK * 2);
    const unsigned hstep = (unsigned)HALF * (unsigned)K * 2u;
    const unsigned tstep = 2u * hstep;
    const __amdgpu_buffer_rsrc_t rA = __builtin_amdgcn_make_buffer_rsrc((void*)g.A, 0, 0x7FFFFFFF, 0x00020000), rB = __builtin_amdgcn_make_buffer_rsrc((void*)g.Bt, 0, 0x7FFFFFFF, 0x00020000);
    const unsigned ldsw = (unsigned)wid * 1024u;
    const int aoff = lds_byte(wr * 64 + fr, fq * 8), boff = lds_byte(wc * 32 + fr, fq * 8);
#define PG8_SA(b, h) (((b) * 2 + (h)) * HTB)
#define PG8_SB(b, h) ((4 + (b) * 2 + (h)) * HTB)
#define PG8_STG(bufoff, rsrc, soff, voff) do { _Pragma("unroll") for (int _i = 0; _i < 2; ++_i) \
        __builtin_amdgcn_raw_ptr_buffer_load_lds((rsrc), (PG8_LAS void*)(lds + (bufoff) + ldsw + _i * 8192), 16, (int)(voff), (int)((soff) + (unsigned)_i * qstep), 0, 0); } while (0)
#define PG8_STGA(bufoff, soff) PG8_STG(bufoff, rA, soff, voffA)
#define PG8_STGB(bufoff, soff) PG8_STG(bufoff, rB, soff, voffB)
#define PG8_LDA(dst, b, h) do { _Pragma("unroll") for (int m = 0; m < 4; ++m) { if constexpr (F8) { const i32x4 lo_ = *(const PG8_LAS i32x4*)(lds + PG8_SA(b, h) + aoff + m * 2048), hi_ = *(const PG8_LAS i32x4*)(lds + PG8_SA(b, h) + aoff + m * 2048 + 1024); \
            dst##_8[m] = __builtin_shufflevector(lo_, hi_, 0, 1, 2, 3, 4, 5, 6, 7); } else { _Pragma("unroll") for (int k = 0; k < 2; ++k) dst[m][k] = *(const PG8_LAS bf16x8*)(lds + PG8_SA(b, h) + aoff + m * 2048 + k * 1024); } } } while (0)
#define PG8_LDB(dst, b, h) do { _Pragma("unroll") for (int n = 0; n < 2; ++n) { if constexpr (F8) { const i32x4 lo_ = *(const PG8_LAS i32x4*)(lds + PG8_SB(b, h) + boff + n * 2048), hi_ = *(const PG8_LAS i32x4*)(lds + PG8_SB(b, h) + boff + n * 2048 + 1024); \
            dst##_8[n] = __builtin_shufflevector(lo_, hi_, 0, 1, 2, 3, 4, 5, 6, 7); } else { _Pragma("unroll") for (int k = 0; k < 2; ++k) dst[n][k] = *(const PG8_LAS bf16x8*)(lds + PG8_SB(b, h) + boff + n * 2048 + k * 1024); } } } while (0)
#define PG8_MMA(ai, bj, At, Bt) do { __builtin_amdgcn_s_setprio(1); _Pragma("unroll") for (int m = 0; m < 4; ++m) _Pragma("unroll") for (int n = 0; n < 2; ++n) { \
        if constexpr (F8) acc[ai][bj][m][n] = __builtin_amdgcn_mfma_scale_f32_16x16x128_f8f6f4(Bt##_8[n], At##_8[m], acc[ai][bj][m][n], 0, 0, 0, g.sw, 0, g.sx); \
        else { _Pragma("unroll") for (int k = 0; k < 2; ++k) acc[ai][bj][m][n] = __builtin_amdgcn_mfma_f32_16x16x32_bf16(Bt[n][k], At[m][k], acc[ai][bj][m][n], 0, 0, 0); } } \
        __builtin_amdgcn_s_setprio(0); } while (0)
#define PG8_WAIT_V(n) asm volatile("s_waitcnt vmcnt(" #n ")" ::: "memory")
#define PG8_WAIT_L(n) asm volatile("s_waitcnt lgkmcnt(" #n ")" ::: "memory")
#define PG8_BAR __builtin_amdgcn_s_barrier()
#define PG8_SCHED __builtin_amdgcn_sched_barrier(0)
    Unit cur, nxt; int ui = 0;
    if (!S.next(0, cur)) return;
    f32x4 acc[2][2][4][2];
    typename Epi::Pre pre; E.pre_load(cur, wc, fq, pre); E.acc_init(acc, pre);
    bf16x8 At[4][2], B0[2][2], B1[2][2]; i32x8 At_8[4], B0_8[2], B1_8[2];
    unsigned cA = (unsigned)cur.pm * tstep, cB = (unsigned)cur.pn * tstep;
    S.a_ready(cur);
    if constexpr (SP2) {
        PG8_STGB(PG8_SB(0, 0), cB); PG8_STGB(PG8_SB(0, 1), cB + hstep); PG8_STGA(PG8_SA(0, 0), cA); PG8_STGA(PG8_SA(0, 1), cA + hstep);
        if (wr == 1) PG8_BAR;
        PG8_WAIT_V(2); PG8_BAR;
        PG8_STGB(PG8_SB(1, 0), cB + kstep); PG8_STGA(PG8_SA(1, 0), cA + kstep); PG8_STGB(PG8_SB(1, 1), cB + hstep + kstep);
        PG8_WAIT_V(6); PG8_BAR;
    } else {
        PG8_STGB(PG8_SB(0, 0), cB); PG8_STGA(PG8_SA(0, 0), cA); PG8_STGB(PG8_SB(0, 1), cB + hstep); PG8_STGA(PG8_SA(0, 1), cA + hstep);
        if (wr == 1) PG8_BAR;
        PG8_WAIT_V(4); PG8_BAR;
        PG8_STGB(PG8_SB(1, 0), cB + kstep); PG8_STGA(PG8_SA(1, 0), cA + kstep); PG8_STGB(PG8_SB(1, 1), cB + hstep + kstep);
        PG8_WAIT_V(6); PG8_BAR;
    }
    for (;;) {
        const bool has_next = S.next(ui + 1, nxt);
        const unsigned nA = has_next ? (unsigned)nxt.pm * tstep : cA, nB = has_next ? (unsigned)nxt.pn * tstep : cB;
#pragma unroll 1
        for (int t = 0; t < nt; t += 2) {
            const bool last = (t == nt - 2);
            const unsigned a1 = cA + (unsigned)(t + 1) * kstep;
            const unsigned a2 = last ? nA : cA + (unsigned)(t + 2) * kstep, b2 = last ? nB : cB + (unsigned)(t + 2) * kstep;
            const unsigned a3 = a2 + kstep, b3 = b2 + kstep;
            if (last && has_next) S.a_ready(nxt);
            if constexpr (SP2) {
            PG8_LDB(B0, 0, 0); PG8_LDB(B1, 0, 1); PG8_SCHED; PG8_LDA(At, 0, 0); PG8_STGA(PG8_SA(1, 1), a1 + hstep);
            PG8_WAIT_V(8); PG8_WAIT_L(0); PG8_BAR; PG8_MMA(0, 0, At, B0); PG8_MMA(0, 1, At, B1); PG8_BAR; PG8_SCHED;
            PG8_LDA(At, 0, 1); PG8_STGB(PG8_SB(0, 0), b2); PG8_STGB(PG8_SB(0, 1), b2 + hstep); PG8_STGA(PG8_SA(0, 0), a2);
            PG8_WAIT_V(8); PG8_WAIT_L(0); PG8_BAR; PG8_MMA(1, 0, At, B0); PG8_MMA(1, 1, At, B1); PG8_BAR; PG8_SCHED;
            PG8_LDB(B0, 1, 0); PG8_LDB(B1, 1, 1); PG8_SCHED; PG8_LDA(At, 1, 0); PG8_STGA(PG8_SA(0, 1), a2 + hstep);
            PG8_WAIT_V(8); PG8_WAIT_L(0); PG8_BAR; PG8_MMA(0, 0, At, B0); PG8_MMA(0, 1, At, B1); PG8_BAR; PG8_SCHED;
            PG8_LDA(At, 1, 1); PG8_STGB(PG8_SB(1, 0), b3); PG8_STGB(PG8_SB(1, 1), b3 + hstep); PG8_STGA(PG8_SA(1, 0), a3);
            PG8_WAIT_V(8); PG8_WAIT_L(0); PG8_BAR; PG8_MMA(1, 0, At, B0); PG8_MMA(1, 1, At, B1); PG8_BAR; PG8_SCHED;
            } else {
            PG8_LDB(B0, 0, 0); PG8_SCHED; PG8_LDA(At, 0, 0); PG8_STGA(PG8_SA(1, 1), a1 + hstep);
            PG8_WAIT_L(8); PG8_BAR; PG8_WAIT_L(0); PG8_MMA(0, 0, At, B0); PG8_BAR; PG8_SCHED;
            PG8_LDB(B1, 0, 1); PG8_STGB(PG8_SB(0, 0), b2);
            PG8_BAR; PG8_WAIT_L(0); PG8_MMA(0, 1, At, B1); PG8_BAR;
            PG8_LDA(At, 0, 1); PG8_STGA(PG8_SA(0, 0), a2);
            PG8_BAR; PG8_WAIT_L(0); PG8_MMA(1, 0, At, B0); PG8_BAR; PG8_SCHED;
            PG8_STGB(PG8_SB(0, 1), b2 + hstep);
            PG8_WAIT_V(6); PG8_BAR; PG8_MMA(1, 1, At, B1); PG8_BAR;
            PG8_LDB(B0, 1, 0); PG8_SCHED; PG8_LDA(At, 1, 0); PG8_STGA(PG8_SA(0, 1), a2 + hstep);
            PG8_WAIT_L(8); PG8_BAR; PG8_WAIT_L(0); PG8_MMA(0, 0, At, B0); PG8_BAR; PG8_SCHED;
            PG8_LDB(B1, 1, 1); PG8_STGB(PG8_SB(1, 0), b3);
            PG8_BAR; PG8_WAIT_L(0); PG8_MMA(0, 1, At, B1); PG8_BAR;
            PG8_LDA(At, 1, 1); PG8_STGA(PG8_SA(1, 0), a3);
            PG8_BAR; PG8_WAIT_L(0); PG8_MMA(1, 0, At, B0); PG8_BAR; PG8_SCHED;
            PG8_STGB(PG8_SB(1, 1), b3 + hstep);
            PG8_WAIT_V(6); PG8_BAR; PG8_MMA(1, 1, At, B1); PG8_BAR;
            }
        }
        if constexpr (ALIGN_EPI) { if (wr == 0) PG8_BAR; }
        if constexpr (!Epi::AFTER_DRAIN) { int t2_ = threadIdx.x; asm volatile("" : "+v"(t2_)); { const Unit pu_ = has_next ? nxt : cur; E.pre_load(pu_, wc, (t2_ & 63) >> 4, pre); }     E(acc, cur, wr, wc, t2_ & 15, (t2_ & 63) >> 4); S.done(cur); }
        if (!has_next) break;
        E.acc_init(acc, pre);
        cur = nxt; cA = nA; cB = nB; ++ui;
        if constexpr (ALIGN_EPI) { if (wr == 1) PG8_BAR; }
    }
    PG8_WAIT_V(0);
    if constexpr (!ALIGN_EPI) { if (wr == 0) PG8_BAR; }
    PG8_BAR;
    if constexpr (Epi::AFTER_DRAIN) { E.fused(acc, cur, wr, wc, fr, fq, lds, wid, lane); S.done(cur); }
#undef PG8_SA
#undef PG8_SB
#undef PG8_STG
#undef PG8_STGA
#undef PG8_STGB
#undef PG8_LDA
#undef PG8_LDB
#undef PG8_MMA
#undef PG8_WAIT_V
#undef PG8_WAIT_L
#undef PG8_BAR
#undef PG8_SCHED
}
}

constexpr int NWAVES = 8, NTHR = 512, GRID = 256;
constexpr int NBATCH = 2, SEQ = 16384, T = NBATCH * SEQ, D = 1024, DEPTH = 4;
constexpr int MIXW = 768, NC_H = 3328, NC_M = 2560;
constexpr int HG_H = 6;
constexpr int HSEG = 256, HNSEG = SEQ / HSEG;
constexpr int MB_H = 12, MB_NB = 64;
constexpr int NE = 32;
constexpr float DN_ALPHA = 1.6817928305074290f;
constexpr int MOE_MAXROWS = T * 4 + NE * 256;
#ifndef ONE_LAUNCH
#define ONE_LAUNCH 1
#endif
constexpr int NPHASE = 13;

constexpr size_t MiB = 1u << 20;
constexpr size_t WS_CTL = 0, CTL_ZERO_BYTES = 1 * MiB;
constexpr size_t WS_WIN = 1 * MiB, WS_WKV = 9 * MiB, WS_WO = 10 * MiB, WS_WGU = 12 * MiB, WS_WD = 140 * MiB;
constexpr size_t WS_XBF = 204 * MiB, WS_WKV4 = 268 * MiB  , WS_KV4 = 272 * MiB  , WS_WRS = 280 * MiB  , WS_MEMBF = 524 * MiB;
constexpr size_t WS_H = 526 * MiB, WS_MIX = 734 * MiB, WS_Y = 798 * MiB, WS_SLOC = 862 * MiB, WS_DSEG = 910 * MiB, WS_KMEAN = 911 * MiB;
constexpr size_t WS_SELINFO = 912 * MiB, WS_TOK = 914 * MiB, WS_R1 = 918 * MiB;
constexpr size_t WS_LIST = WS_R1, WS_PML = WS_R1 + 96 * MiB, WS_PO = WS_R1 + 108 * MiB;
constexpr size_t WS_XS = WS_R1, WS_HID = WS_R1 + 272 * MiB;
constexpr size_t WS_END = WS_R1 + 544 * MiB;
static_assert((size_t)MOE_MAXROWS * 1024 * 2 <= 272 * MiB, "moe rows");
static_assert((size_t)T * MB_H * 4 * 64 * 4 <= 384 * MiB && (size_t)24 * 64 * 16384 * 4 <= 96 * MiB, "moba bufs");
constexpr size_t TOK_E = 0, TOK_LR = 512 * 1024, TOK_W = 1024 * 1024, TOK_ROW = 1536 * 1024, TOK_BLKCNT = 2048 * 1024, TOK_TAB = 2048 * 1024 + 65536;
constexpr int CW_BAR = 4096, CW_GCOUNT = 8192;

constexpr int RING_BYTES = 131072, LDS_BYTES = 147456, MISC_OFF = LDS_BYTES - 1024;

#define GAS __attribute__((address_space(1)))
#define LAS __attribute__((address_space(3)))
typedef unsigned short bf16;
typedef unsigned v4u __attribute__((ext_vector_type(4)));
typedef unsigned v2u __attribute__((ext_vector_type(2)));
typedef float f32x4 __attribute__((ext_vector_type(4)));
typedef float f32x2 __attribute__((ext_vector_type(2)));
typedef short s16x8 __attribute__((ext_vector_type(8)));
typedef float f32x16 __attribute__((ext_vector_type(16)));
typedef float f32x2_t __attribute__((ext_vector_type(2))); typedef __bf16 bf16x2_t __attribute__((ext_vector_type(2)));
__device__ __forceinline__ unsigned cvtpk(float lo, float hi) { f32x2_t v = {lo, hi}; bf16x2_t b = __builtin_convertvector(v, bf16x2_t); return __builtin_bit_cast(unsigned, b); }
#define LDS_WAIT() asm volatile("s_waitcnt lgkmcnt(0)" ::: "memory")
__device__ __forceinline__ unsigned f2bf(float f) { unsigned u = __builtin_bit_cast(unsigned, f); return (u + 0x7fffu + ((u >> 16) & 1u)) >> 16; }
__device__ __forceinline__ unsigned pk2(float lo, float hi) { return f2bf(lo) | (f2bf(hi) << 16); }
__device__ __forceinline__ float bflo(unsigned w) { return __builtin_bit_cast(float, w << 16); }
__device__ __forceinline__ float bfhi(unsigned w) { return __builtin_bit_cast(float, w & 0xffff0000u); }
__device__ __forceinline__ float bf2f(bf16 h) { return __builtin_bit_cast(float, (unsigned)h << 16); }
__device__ __forceinline__ float sigmoidf_(float z) { return __builtin_amdgcn_rcpf(1.0f + __builtin_amdgcn_exp2f(-1.4426950408889634f * z)); }
template <int X> __device__ __forceinline__ float xorf(float v) { return __builtin_bit_cast(float, __builtin_amdgcn_ds_swizzle(__builtin_bit_cast(int, v), (X << 10) | 0x1F)); }
template <int X> __device__ __forceinline__ int xori(int v) { return __builtin_amdgcn_ds_swizzle(v, (X << 10) | 0x1F); }
__device__ __forceinline__ float wave_sum(float v) {
    v += xorf<1>(v); v += xorf<2>(v); v += xorf<4>(v); v += xorf<8>(v); v += xorf<16>(v);
    return __builtin_bit_cast(float, __builtin_amdgcn_readlane(__builtin_bit_cast(int, v), 0)) + __builtin_bit_cast(float, __builtin_amdgcn_readlane(__builtin_bit_cast(int, v), 32));
}
__device__ __forceinline__ float wave_max(float v) {
    v = fmaxf(v, xorf<1>(v)); v = fmaxf(v, xorf<2>(v)); v = fmaxf(v, xorf<4>(v)); v = fmaxf(v, xorf<8>(v)); v = fmaxf(v, xorf<16>(v));
    return fmaxf(__builtin_bit_cast(float, __builtin_amdgcn_readlane(__builtin_bit_cast(int, v), 0)), __builtin_bit_cast(float, __builtin_amdgcn_readlane(__builtin_bit_cast(int, v), 32)));
}
__device__ __forceinline__ float xor32f(float v, int lane) { return __builtin_bit_cast(float, __builtin_amdgcn_ds_bpermute((lane ^ 32) << 2, __builtin_bit_cast(int, v))); }
#define XB_TMO      128
#define XB_XCNT(j)  (256  + 64 * (j))
#define XB_XSUB(j)  (1280 + 64 * (j))
#define XB_XGEN(j)  (2304 + 64 * (j))
#define XB_TOP      3328
#define XB_TOPGEN   3392
#define XCD_BAR_WORDS 3456
#define XB_SPIN_CAP (1u << 18)

__device__ __forceinline__ unsigned xb_ld(unsigned* p)              { return __hip_atomic_load(p, __ATOMIC_RELAXED, __HIP_MEMORY_SCOPE_AGENT); }
__device__ __forceinline__ unsigned xb_add(unsigned* p, unsigned v) { return __hip_atomic_fetch_add(p, v, __ATOMIC_RELAXED, __HIP_MEMORY_SCOPE_AGENT); }
__device__ __forceinline__ unsigned xb_xcc_id() { return (unsigned)__builtin_amdgcn_s_getreg((3 << 11) | 20) & 0xFu; }
#define XB_SPIN(cond, bar) do { unsigned _sp = 0; while (cond) { __builtin_amdgcn_s_sleep(1); \
    if ((++_sp & 255u) == 0u) { if (xb_ld(&(bar)[XB_TMO])) break; if (_sp > XB_SPIN_CAP) { atomicAdd(&(bar)[XB_TMO], 1u); break; } } } } while (0)

struct XcdBarrier {
    unsigned* bar; unsigned x;
    volatile LAS unsigned* st;
};

__device__ __forceinline__ XcdBarrier xcd_barrier_post(unsigned* bar, volatile LAS unsigned* st) {
    XcdBarrier b; b.bar = bar; b.x = xb_xcc_id(); b.st = st;
    if (threadIdx.x == 0) (void)xb_add(&bar[XB_XCNT(b.x)], 1u);
    return b;
}
__device__ __forceinline__ void xcd_barrier_complete(unsigned* bar, unsigned x, unsigned& nloc, unsigned& nx) {
    const unsigned G = gridDim.x * gridDim.y * gridDim.z;
    unsigned sum, cnt, mine, sp = 0u;
    for (;;) {
        sum = 0u; cnt = 0u; mine = 0u;
#pragma unroll
        for (unsigned j = 0; j < 16; ++j) { const unsigned c = xb_ld(&bar[XB_XCNT(j)]); sum += c; cnt += (c > 0u) ? 1u : 0u; mine = (j == x) ? c : mine; }
        if (sum == G) break;
        __builtin_amdgcn_s_sleep(1);
        if ((++sp & 255u) == 0u) { if (xb_ld(&bar[XB_TMO])) break; if (sp > XB_SPIN_CAP) { atomicAdd(&bar[XB_TMO], 1u); break; } }
    }
    nloc = mine > 0u ? mine : 1u; nx = cnt > 0u ? cnt : 1u;
}

__device__ __forceinline__ void xcd_barrier(const XcdBarrier& b) {
    asm volatile("s_waitcnt vmcnt(0)" ::: "memory");
    __syncthreads();
    if (threadIdx.x == 0) {
        unsigned* bar = b.bar;
        __builtin_amdgcn_s_waitcnt(0);
        unsigned nloc = b.st[0], nx = b.st[1];
        if (nloc == 0u) { xcd_barrier_complete(bar, b.x, nloc, nx); b.st[0] = nloc; b.st[1] = nx; }
        const unsigned old = xb_add(&bar[XB_XSUB(b.x)], 1u);
        const unsigned gen = old / nloc;
        if (old + 1u == (gen + 1u) * nloc) {
            __builtin_amdgcn_fence(__ATOMIC_RELEASE, "agent");
            asm volatile("s_waitcnt vmcnt(0)" ::: "memory");
            const unsigned og = xb_add(&bar[XB_TOP], 1u);
            const unsigned tg = og / nx;
            if (og + 1u == (tg + 1u) * nx) xb_add(&bar[XB_TOPGEN], 1u);
            else XB_SPIN(xb_ld(&bar[XB_TOPGEN]) == tg, bar);
            __builtin_amdgcn_fence(__ATOMIC_ACQUIRE, "agent");
            xb_add(&bar[XB_XGEN(b.x)], 1u);
            asm volatile("s_waitcnt vmcnt(0)" ::: "memory");
        } else {
            XB_SPIN(xb_ld(&bar[XB_XGEN(b.x)]) == gen, bar);
            __builtin_amdgcn_fence(__ATOMIC_ACQUIRE, "agent");
            asm volatile("s_waitcnt vmcnt(0)" ::: "memory");
        }
    }
    __syncthreads();
}
__device__ __forceinline__ void cvt_rows_bf16(const float* src, bf16* dst, size_t n8, size_t gtid, size_t gthreads) {
    for (size_t i = gtid; i < n8; i += gthreads) { const f32x4 a = ((const f32x4*)src)[2 * i], b = ((const f32x4*)src)[2 * i + 1];
        v4u o; o.x = pk2(a.x, a.y); o.y = pk2(a.z, a.w); o.z = pk2(b.x, b.y); o.w = pk2(b.z, b.w); ((v4u*)dst)[i] = o; }
}
__device__ __forceinline__ void transpose_item(const float* W, int N, bf16* WT, int dst_row0, LAS float* scr, int k0, int n0, int lane) {
#pragma unroll 8
    for (int i = 0; i < 32; ++i) { const int kk = 2 * i + (lane >> 5); scr[kk * 33 + (lane & 31)] = W[(size_t)(k0 + kk) * N + n0 + (lane & 31)]; }
    LDS_WAIT(); asm volatile("" ::: "memory");
    const int c = lane & 7;
#pragma unroll
    for (int j = 0; j < 4; ++j) { const int n = (lane >> 3) + 8 * j; const LAS float* s = scr + (8 * c) * 33 + n;
        v4u o; o.x = pk2(s[0 * 33], s[1 * 33]); o.y = pk2(s[2 * 33], s[3 * 33]); o.z = pk2(s[4 * 33], s[5 * 33]); o.w = pk2(s[6 * 33], s[7 * 33]);
        *(v4u*)(WT + (size_t)(dst_row0 + n) * 1024 + k0 + 8 * c) = o; }
    LDS_WAIT(); asm volatile("" ::: "memory");
}
__device__ __forceinline__ unsigned pk4_fp8(float a, float b, float c, float d) { int w = 0; w = __builtin_amdgcn_cvt_pk_fp8_f32(a, b, w, false); w = __builtin_amdgcn_cvt_pk_fp8_f32(c, d, w, true); return (unsigned)w; }
__device__ __forceinline__ void transpose_item_f8(const float* W, int N, unsigned char* WT8, int dst_row0, LAS float* scr, int k0, int n0, int lane, float wscale) {
#pragma unroll 8
    for (int i = 0; i < 32; ++i) { const int kk = 2 * i + (lane >> 5); scr[kk * 33 + (lane & 31)] = W[(size_t)(k0 + kk) * N + n0 + (lane & 31)]; }
    LDS_WAIT(); asm volatile("" ::: "memory");
    const int c = lane & 7;
#pragma unroll
    for (int j = 0; j < 4; ++j) { const int n = (lane >> 3) + 8 * j; const LAS float* s = scr + (8 * c) * 33 + n;
        v2u o; o.x = pk4_fp8(s[0 * 33] * wscale, s[1 * 33] * wscale, s[2 * 33] * wscale, s[3 * 33] * wscale); o.y = pk4_fp8(s[4 * 33] * wscale, s[5 * 33] * wscale, s[6 * 33] * wscale, s[7 * 33] * wscale);
        *(v2u*)(WT8 + (size_t)(dst_row0 + n) * 1024 + k0 + 8 * c) = o; }
    LDS_WAIT(); asm volatile("" ::: "memory");
}
__device__ __forceinline__ void phase_weights(LAS float* scr, int gw, int ngw, int lane, const float* win_src, int NC, const float* wkv_src, int nkv, const float* wo_src,
                                              const float* wg_src, const float* wu_src, const float* wd_src, bf16* win_t, bf16* wkv_t, bf16* wo_t, bf16* wgu_t, bf16* wd_t) {
    const int nbw = NC / 32, nWin = nbw * 16, NIT = nWin + 256 * nkv + 512 + NE * 1536;
    for (int it = gw; it < NIT; it += ngw) {
        int r = it;
        if (r < nWin) { const int kb = r / nbw, nb = r - kb * nbw; transpose_item(win_src, NC, win_t, 32 * nb, scr, 64 * kb, 32 * nb, lane); continue; } r -= nWin;
        if (r < 256 * nkv) { const int lay = r >> 8, rr = r & 255, kb = rr >> 4, nb = rr & 15; transpose_item(wkv_src + (size_t)lay * D * 512, 512, wkv_t + (size_t)lay * 512 * 1024, 32 * nb, scr, 64 * kb, 32 * nb, lane); continue; } r -= 256 * nkv;
        if (r < 512) { const int kb = r >> 5, nb = r & 31; transpose_item(wo_src, 1024, wo_t, 32 * nb, scr, 64 * kb, 32 * nb, lane); continue; } r -= 512;
        const int e = r / 1536, q = r - e * 1536, which = q >> 9, rr = q & 511, kb = rr >> 5, nb = rr & 31, n0 = 32 * nb;
        const size_t eoff = (size_t)e * 1024 * 1024;
        if (which == 0) transpose_item_f8(wg_src + eoff, 1024, (unsigned char*)wgu_t + 2 * eoff, (n0 >> 7) * 256 + (n0 & 127), scr, 64 * kb, n0, lane, 32.f);
        else if (which == 1) transpose_item_f8(wu_src + eoff, 1024, (unsigned char*)wgu_t + 2 * eoff, (n0 >> 7) * 256 + 128 + (n0 & 127), scr, 64 * kb, n0, lane, 32.f);
        else transpose_item_f8(wd_src + eoff, 1024, (unsigned char*)wd_t + eoff, n0, scr, 64 * kb, n0, lane, 64.f);
    }
}

template <bool OUT>
__device__ __forceinline__ void hgrn_seg(LAS unsigned char* lds, const bf16* h, const float* lbl, int j, const float* normg, float* Sloc, float* Dseg, bf16* mix, int unit, int tid, int wave, int lane) {
    const int seg = unit & (HNSEG - 1), bh = unit >> 6, hh = bh % HG_H, b = bh / HG_H;
    const int v = tid & 127, dg = tid >> 7;
    LAS float* fgs = (LAS float*)lds; LAS float* vs = fgs + 4096; LAS float* qs = vs + 4096; LAS float* op = qs + 4096;
    f32x2 st[16];
    float* Sp = Sloc + (size_t)unit * 16384 + (size_t)(dg * 32) * 128 + v;
#pragma unroll
    for (int dd = 0; dd < 16; ++dd) { st[dd].x = OUT ? Sp[(2 * dd) * 128] : 0.f; st[dd].y = OUT ? Sp[(2 * dd + 1) * 128] : 0.f; }
    float dprod = 1.f;
    const int stok = tid >> 4, c8 = (tid & 15) * 8;
    float lb[8];
#pragma unroll
    for (int i = 0; i < 8; ++i) { lb[i] = 0.f; if (j > 0) { const float a0 = lbl[hh * 128 + c8 + i], a1 = lbl[MIXW + hh * 128 + c8 + i]; lb[i] = 1.f / (1.f + __expf(a0 - a1)); } }
    for (int ch = 0; ch < HSEG / 32; ++ch) {
        const size_t t0 = (size_t)b * SEQ + seg * HSEG + ch * 32;
        { const bf16* row = h + (t0 + stok) * NC_H + hh * 128 + c8;
          const v4u f8 = *(const v4u*)(row + 768), i8 = *(const v4u*)(row + 1536); v4u q8 = {0u, 0u, 0u, 0u}; if (OUT) q8 = *(const v4u*)row;
#pragma unroll
          for (int w = 0; w < 4; ++w) { const float f0 = bflo(f8[w]), f1 = bfhi(f8[w]); const int o = stok * 128 + c8 + 2 * w;
              fgs[o] = lb[2 * w] + (1.f - lb[2 * w]) * sigmoidf_(f0); fgs[o + 1] = lb[2 * w + 1] + (1.f - lb[2 * w + 1]) * sigmoidf_(f1);
              vs[o] = bflo(i8[w]); vs[o + 1] = bfhi(i8[w]);
              if (OUT) { const float q0 = bflo(q8[w]), q1 = bfhi(q8[w]); qs[o] = q0 * sigmoidf_(q0); qs[o + 1] = q1 * sigmoidf_(q1); } } }
        __syncthreads();
        if (!OUT) { if (tid < 128) { for (int tt = 0; tt < 32; ++tt) dprod *= fgs[tt * 128 + tid]; } }
        f32x4 fA[8], qA[8], fB[8], qB[8]; float vA, vB;
#define HG_LOAD(F, Q, V, tt_) do { V = vs[(tt_) * 128 + v]; _Pragma("unroll") for (int d4 = 0; d4 < 8; ++d4) { F[d4] = *(const LAS f32x4*)(fgs + (tt_) * 128 + dg * 32 + d4 * 4); \
            if (OUT) Q[d4] = *(const LAS f32x4*)(qs + (tt_) * 128 + dg * 32 + d4 * 4); } } while (0)
#define HG_STEP(F, Q, V, tt_) do { const f32x2 vv2 = {V, V}; f32x2 acc2 = {0.f, 0.f}; _Pragma("unroll") for (int d4 = 0; d4 < 8; ++d4) { \
            const f32x2 fa = {F[d4].x, F[d4].y}, fb = {F[d4].z, F[d4].w}; \
            st[2 * d4] = fa * (st[2 * d4] - vv2) + vv2; st[2 * d4 + 1] = fb * (st[2 * d4 + 1] - vv2) + vv2; \
            if (OUT) { const f32x2 qa = {Q[d4].x, Q[d4].y}, qb = {Q[d4].z, Q[d4].w}; acc2 = qa * st[2 * d4] + acc2; acc2 = qb * st[2 * d4 + 1] + acc2; } } \
            if (OUT) op[(dg * 32 + (tt_)) * 128 + v] = acc2.x + acc2.y; } while (0)
        HG_LOAD(fA, qA, vA, 0);
#pragma unroll 1
        for (int tt = 0; tt < 32; tt += 2) {
            HG_LOAD(fB, qB, vB, tt + 1);
            __builtin_amdgcn_sched_barrier(0);
            HG_STEP(fA, qA, vA, tt);
            __builtin_amdgcn_sched_barrier(0);
            if (tt + 2 < 32) HG_LOAD(fA, qA, vA, tt + 2);
            __builtin_amdgcn_sched_barrier(0);
            HG_STEP(fB, qB, vB, tt + 1);
            __builtin_amdgcn_sched_barrier(0);
        }
#undef HG_LOAD
#undef HG_STEP
        if (OUT) {
            __syncthreads();
#pragma unroll
            for (int k = 0; k < 4; ++k) { const int tt = wave + 8 * k; float o0 = 0.f, o1 = 0.f;
#pragma unroll
                for (int g = 0; g < 4; ++g) { o0 += op[(g * 32 + tt) * 128 + lane]; o1 += op[(g * 32 + tt) * 128 + lane + 64]; }
                const float ms = wave_sum(o0 * o0 + o1 * o1) * (1.f / 128.f), r = 1.f / sqrtf(ms + 1e-6f);
                const bf16* grow = h + (t0 + tt) * NC_H + 2304 + hh * 128; const float g0 = bf2f(grow[lane]), g1 = bf2f(grow[lane + 64]);
                bf16* mrow = mix + (t0 + tt) * 1024 + hh * 128;
                mrow[lane] = (bf16)f2bf(o0 * r * normg[lane] * sigmoidf_(g0)); mrow[lane + 64] = (bf16)f2bf(o1 * r * normg[lane + 64] * sigmoidf_(g1)); }
        }
        __syncthreads();
    }
    if (!OUT) {
#pragma unroll
        for (int dd = 0; dd < 16; ++dd) { Sp[(2 * dd) * 128] = st[dd].x; Sp[(2 * dd + 1) * 128] = st[dd].y; }
        if (tid < 128) Dseg[(size_t)unit * 128 + tid] = dprod;
    }
}
constexpr int HG_G = 0, HG_QT = 32768, HG_KT = 50176, HG_KE = 67584, HG_VT = 86016, HG_ST = 104448, HG_GM = 139264, HG_GE = 139776, HG_PART = 140288;
static_assert(HG_PART + 2048 <= MISC_OFF, "HGRN LDS map");
__device__ __forceinline__ int crow16(int i, int hf) { return (i & 3) + 8 * (i >> 2) + 4 * hf; }
template <bool OUT>
__device__ __forceinline__ void hgrn_mfma(LAS unsigned char* lds, const bf16* h, const float* lbl, int j, const float* normg, float* Sloc, float* Dseg, bf16* mix, int unit, int tid, int wave, int lane) {
    const int seg = unit & (HNSEG - 1), bh = unit >> 6, hh = bh % HG_H, b = bh / HG_H;
    const int r = lane & 31, hf = lane >> 5, tr = wave & 1, vq = wave >> 1;
    LAS float* G = (LAS float*)(lds + HG_G); LAS float* GM = (LAS float*)(lds + HG_GM); LAS float* GE = (LAS float*)(lds + HG_GE); LAS float* PART = (LAS float*)(lds + HG_PART);
    const int stok = tid >> 3, c16 = (tid & 7) * 16, sperm = (stok & ~15) | (stok & 3) | ((stok & 4) << 1) | ((stok & 8) >> 1);
    const int cd = tid & 127, cpart = tid >> 7;
    float lb[16];
#pragma unroll
    for (int e = 0; e < 16; ++e) { lb[e] = 0.f; if (j > 0) { const float a0 = lbl[hh * 128 + c16 + e], a1 = lbl[MIXW + hh * 128 + c16 + e]; lb[e] = 1.f / (1.f + __expf(a0 - a1)); } }
    f32x16 S[2];
    float* Sp = Sloc + (size_t)unit * 16384 + 32 * vq + r;
#pragma unroll
    for (int dd = 0; dd < 2; ++dd)
#pragma unroll
        for (int i = 0; i < 16; ++i) S[dd][i] = OUT ? Sp[(32 * (2 * tr + dd) + crow16(i, hf)) * 128] : 0.f;
    float gsum = 0.f;
    float ng16[16];
#pragma unroll
    for (int e = 0; e < 16; ++e) ng16[e] = OUT ? normg[c16 + e] : 0.f;
    v4u nf8[2], ni8[2], nq8[2] = {{0u, 0u, 0u, 0u}, {0u, 0u, 0u, 0u}}, ng8[2] = {{0u, 0u, 0u, 0u}, {0u, 0u, 0u, 0u}};
#define HG_RAWLOAD(t0_) do { const bf16* row_ = h + ((t0_) + stok) * NC_H + hh * 128 + c16; nf8[0] = *(const v4u*)(row_ + 768); nf8[1] = *(const v4u*)(row_ + 776); ni8[0] = *(const v4u*)(row_ + 1536); ni8[1] = *(const v4u*)(row_ + 1544); \
        if (OUT) { nq8[0] = *(const v4u*)row_; nq8[1] = *(const v4u*)(row_ + 8); ng8[0] = *(const v4u*)(row_ + 2304); ng8[1] = *(const v4u*)(row_ + 2312); } } while (0)
    HG_RAWLOAD((size_t)b * SEQ + seg * HSEG);
    for (int ch = 0; ch < HSEG / 64; ++ch) {
        const size_t t0 = (size_t)b * SEQ + seg * HSEG + ch * 64;
        float fg[16], qv[16]; v4u i8[2], g8[2];
        { const v4u f8[2] = {nf8[0], nf8[1]}; i8[0] = ni8[0]; i8[1] = ni8[1]; const v4u q8[2] = {nq8[0], nq8[1]}; g8[0] = ng8[0]; g8[1] = ng8[1];
#pragma unroll
          for (int w = 0; w < 8; ++w) { const unsigned fw = f8[w >> 2][w & 3]; const float f0 = bflo(fw), f1 = bfhi(fw);
              fg[2 * w] = lb[2 * w] + (1.f - lb[2 * w]) * sigmoidf_(f0); fg[2 * w + 1] = lb[2 * w + 1] + (1.f - lb[2 * w + 1]) * sigmoidf_(f1);
              if (OUT) { const unsigned qw = q8[w >> 2][w & 3]; const float q0 = bflo(qw), q1 = bfhi(qw); qv[2 * w] = q0 * sigmoidf_(q0); qv[2 * w + 1] = q1 * sigmoidf_(q1); } else { qv[2 * w] = 0.f; qv[2 * w + 1] = 0.f; } }
#pragma unroll
          for (int e4 = 0; e4 < 4; ++e4) { f32x4 lg; lg.x = __builtin_amdgcn_logf(fg[4 * e4]); lg.y = __builtin_amdgcn_logf(fg[4 * e4 + 1]); lg.z = __builtin_amdgcn_logf(fg[4 * e4 + 2]); lg.w = __builtin_amdgcn_logf(fg[4 * e4 + 3]);
              *(LAS f32x4*)(G + stok * 128 + c16 + 4 * e4) = lg; } }
        __syncthreads();
        { float run = 0.f;
#pragma unroll
          for (int k = 0; k < 16; ++k) run += G[(16 * cpart + k) * 128 + cd];
          PART[cpart * 128 + cd] = run; }
        __syncthreads();
        { float run = 0.f;
#pragma unroll
          for (int pp = 0; pp < 3; ++pp) run += (pp < cpart) ? PART[pp * 128 + cd] : 0.f;
#pragma unroll
          for (int k = 0; k < 16; ++k) { run += G[(16 * cpart + k) * 128 + cd]; G[(16 * cpart + k) * 128 + cd] = run; }
          if (cpart == 1) GM[cd] = run;
          if (cpart == 3) { GE[cd] = run; gsum += run; } }
        __syncthreads();
        if (OUT) {
#pragma unroll
            for (int dd = 0; dd < 2; ++dd)
#pragma unroll
                for (int g4 = 0; g4 < 4; ++g4) { const int dbase = 32 * (2 * tr + dd) + 8 * g4 + 4 * hf; const f32x4 gm = *(const LAS f32x4*)(GM + dbase);
                    v2u w; w.x = cvtpk(S[dd][4 * g4] * __builtin_amdgcn_exp2f(gm.x), S[dd][4 * g4 + 1] * __builtin_amdgcn_exp2f(gm.y)); w.y = cvtpk(S[dd][4 * g4 + 2] * __builtin_amdgcn_exp2f(gm.z), S[dd][4 * g4 + 3] * __builtin_amdgcn_exp2f(gm.w));
                    *(LAS v2u*)(lds + HG_ST + (32 * vq + r) * 272 + dbase * 2) = w; }
        }
        { unsigned qt[8], kt[8];
#pragma unroll
          for (int e4 = 0; e4 < 4; ++e4) { const f32x4 gv = *(const LAS f32x4*)(G + stok * 128 + c16 + 4 * e4), gm = *(const LAS f32x4*)(GM + c16 + 4 * e4), ge = *(const LAS f32x4*)(GE + c16 + 4 * e4);
              float ke[4];
#pragma unroll
              for (int e = 0; e < 4; ++e) { const float kk = 1.f - fg[4 * e4 + e]; ke[e] = kk * __builtin_amdgcn_exp2f(ge[e] - gv[e]);
                  if (OUT) { const float a = qv[4 * e4 + e] * __builtin_amdgcn_exp2f(gv[e] - gm[e]), c = kk * __builtin_amdgcn_exp2f(gm[e] - gv[e]);
                      if (e & 1) { qt[2 * e4 + (e >> 1)] |= f2bf(a) << 16; kt[2 * e4 + (e >> 1)] |= f2bf(c) << 16; } else { qt[2 * e4 + (e >> 1)] = f2bf(a); kt[2 * e4 + (e >> 1)] = f2bf(c); } } }
#pragma unroll
              for (int e = 0; e < 4; ++e) { const int col = c16 + 4 * e4 + e;
                  *(LAS bf16*)(lds + HG_KE + col * 144 + sperm * 2) = (bf16)f2bf(ke[e]);
                  const unsigned vw = i8[e4 >> 1][(2 * e4 + (e >> 1)) & 3]; *(LAS bf16*)(lds + HG_VT + col * 144 + sperm * 2) = (bf16)((e & 1) ? (vw >> 16) : (vw & 0xffffu)); } }
          if (OUT) { *(LAS v4u*)(lds + HG_QT + stok * 272 + c16 * 2) = (v4u){qt[0], qt[1], qt[2], qt[3]}; *(LAS v4u*)(lds + HG_QT + stok * 272 + c16 * 2 + 16) = (v4u){qt[4], qt[5], qt[6], qt[7]};
                     *(LAS v4u*)(lds + HG_KT + stok * 272 + c16 * 2) = (v4u){kt[0], kt[1], kt[2], kt[3]}; *(LAS v4u*)(lds + HG_KT + stok * 272 + c16 * 2 + 16) = (v4u){kt[4], kt[5], kt[6], kt[7]}; } }
        __syncthreads();
        if (ch + 1 < HSEG / 64) HG_RAWLOAD(t0 + 64);
        if (OUT) {
            f32x16 X0, X1, O;
#pragma unroll
            for (int i = 0; i < 16; ++i) { X0[i] = 0.f; X1[i] = 0.f; O[i] = 0.f; }
            const LAS unsigned char* qtp = lds + HG_QT + (32 * tr + r) * 272 + hf * 16;
#pragma unroll
            for (int ks = 0; ks < 8; ++ks) { const s16x8 bq = *(const LAS s16x8*)(qtp + ks * 32);
                const s16x8 a0 = *(const LAS s16x8*)(lds + HG_KT + r * 272 + hf * 16 + ks * 32); X0 = __builtin_amdgcn_mfma_f32_32x32x16_bf16(a0, bq, X0, 0, 0, 0);
                if (tr == 1) { const s16x8 a1 = *(const LAS s16x8*)(lds + HG_KT + (32 + r) * 272 + hf * 16 + ks * 32); X1 = __builtin_amdgcn_mfma_f32_32x32x16_bf16(a1, bq, X1, 0, 0, 0); } }
#pragma unroll
            for (int i = 0; i < 16; ++i) { const bool keep = crow16(i, hf) <= r; if (tr == 0) X0[i] = keep ? X0[i] : 0.f; else X1[i] = keep ? X1[i] : 0.f; }
            const LAS unsigned char* vtp = lds + HG_VT + (32 * vq + r) * 144 + hf * 16;
#pragma unroll
            for (int s2 = 0; s2 < 2; ++s2) { v4u pw; pw.x = cvtpk(X0[8 * s2], X0[8 * s2 + 1]); pw.y = cvtpk(X0[8 * s2 + 2], X0[8 * s2 + 3]); pw.z = cvtpk(X0[8 * s2 + 4], X0[8 * s2 + 5]); pw.w = cvtpk(X0[8 * s2 + 6], X0[8 * s2 + 7]);
                const s16x8 bv = *(const LAS s16x8*)(vtp + (16 * s2) * 2); O = __builtin_amdgcn_mfma_f32_32x32x16_bf16(__builtin_bit_cast(s16x8, pw), bv, O, 0, 0, 0); }
            if (tr == 1) {
#pragma unroll
                for (int s2 = 0; s2 < 2; ++s2) { v4u pw; pw.x = cvtpk(X1[8 * s2], X1[8 * s2 + 1]); pw.y = cvtpk(X1[8 * s2 + 2], X1[8 * s2 + 3]); pw.z = cvtpk(X1[8 * s2 + 4], X1[8 * s2 + 5]); pw.w = cvtpk(X1[8 * s2 + 6], X1[8 * s2 + 7]);
                    const s16x8 bv = *(const LAS s16x8*)(vtp + (32 + 16 * s2) * 2); O = __builtin_amdgcn_mfma_f32_32x32x16_bf16(__builtin_bit_cast(s16x8, pw), bv, O, 0, 0, 0); } }
            const LAS unsigned char* stp = lds + HG_ST + (32 * vq + r) * 272 + hf * 16;
#pragma unroll
            for (int ks = 0; ks < 8; ++ks) { const s16x8 aq = *(const LAS s16x8*)(qtp + ks * 32), bs = *(const LAS s16x8*)(stp + ks * 32); O = __builtin_amdgcn_mfma_f32_32x32x16_bf16(aq, bs, O, 0, 0, 0); }
#pragma unroll
            for (int i = 0; i < 16; ++i) G[(32 * tr + crow16(i, hf)) * 128 + 32 * vq + r] = O[i];
        }
#pragma unroll
        for (int dd = 0; dd < 2; ++dd) { const int dr = 2 * tr + dd;
#pragma unroll
            for (int g4 = 0; g4 < 4; ++g4) { const f32x4 ge = *(const LAS f32x4*)(GE + 32 * dr + 8 * g4 + 4 * hf);
                S[dd][4 * g4] *= __builtin_amdgcn_exp2f(ge.x); S[dd][4 * g4 + 1] *= __builtin_amdgcn_exp2f(ge.y); S[dd][4 * g4 + 2] *= __builtin_amdgcn_exp2f(ge.z); S[dd][4 * g4 + 3] *= __builtin_amdgcn_exp2f(ge.w); }
#pragma unroll
            for (int ks = 0; ks < 4; ++ks) { const s16x8 a = *(const LAS s16x8*)(lds + HG_KE + (32 * dr + r) * 144 + hf * 16 + ks * 32), bv = *(const LAS s16x8*)(lds + HG_VT + (32 * vq + r) * 144 + hf * 16 + ks * 32);
                S[dd] = __builtin_amdgcn_mfma_f32_32x32x16_bf16(a, bv, S[dd], 0, 0, 0); } }
        __syncthreads();
        if (OUT) {
            float ov[16]; float ss = 0.f;
#pragma unroll
            for (int e4 = 0; e4 < 4; ++e4) { const f32x4 o4 = *(const LAS f32x4*)(G + stok * 128 + c16 + 4 * e4); ov[4 * e4] = o4.x; ov[4 * e4 + 1] = o4.y; ov[4 * e4 + 2] = o4.z; ov[4 * e4 + 3] = o4.w;
                ss += (o4.x * o4.x + o4.y * o4.y) + (o4.z * o4.z + o4.w * o4.w); }
            ss += xorf<1>(ss); ss += xorf<2>(ss); ss += xorf<4>(ss);
            const float rr = 1.f / sqrtf(ss * (1.f / 128.f) + 1e-6f);
            unsigned ow[8];
#pragma unroll
            for (int w = 0; w < 8; ++w) { const unsigned gw_ = g8[w >> 2][w & 3]; ow[w] = cvtpk(ov[2 * w] * rr * ng16[2 * w] * sigmoidf_(bflo(gw_)), ov[2 * w + 1] * rr * ng16[2 * w + 1] * sigmoidf_(bfhi(gw_))); }
            bf16* mrow = mix + (t0 + stok) * 1024 + hh * 128 + c16;
            *(v4u*)mrow = (v4u){ow[0], ow[1], ow[2], ow[3]}; *(v4u*)(mrow + 8) = (v4u){ow[4], ow[5], ow[6], ow[7]};
            __syncthreads();
        }
    }
#undef HG_RAWLOAD
    if (!OUT) {
#pragma unroll
        for (int dd = 0; dd < 2; ++dd)
#pragma unroll
            for (int i = 0; i < 16; ++i) Sp[(32 * (2 * tr + dd) + crow16(i, hf)) * 128] = S[dd][i];
        if (cpart == 3) Dseg[(size_t)unit * 128 + cd] = __builtin_amdgcn_exp2f(gsum);
    }
}
__device__ __forceinline__ void hgrn_scan(float* Sloc, const float* Dseg, size_t gtid, size_t gthreads) {
    for (size_t idx = gtid; idx < (size_t)NBATCH * HG_H * 16384; idx += gthreads) { const int bh = (int)(idx >> 14), e = (int)(idx & 16383), d = e >> 7; float cur = 0.f;
        float* __restrict__ sp = Sloc + (size_t)bh * HNSEG * 16384 + e; const float* __restrict__ dp = Dseg + (size_t)bh * HNSEG * 128 + d;
        for (int s0 = 0; s0 < HNSEG; s0 += 16) { float tv[16], dv[16];
#pragma unroll
            for (int k = 0; k < 16; ++k) { tv[k] = sp[(size_t)(s0 + k) * 16384]; dv[k] = dp[(s0 + k) * 128]; }
#pragma unroll
            for (int k = 0; k < 16; ++k) { sp[(size_t)(s0 + k) * 16384] = cur; cur = dv[k] * cur + tv[k]; } } }
}

template <bool MASK>
__device__ __forceinline__ void attn4(const LAS unsigned* Ks, const LAS bf16* Vs, const LAS float* qst, LAS float* pb, int lane, const int (&tq)[4], int kbase, float slope,
                                      float (&mo)[4], float (&lo)[4], float (&oo)[4]) {
    float sc[4][4];
#pragma unroll
    for (int a = 0; a < 4; ++a)
#pragma unroll
        for (int c = 0; c < 4; ++c) sc[a][c] = 0.f;
#pragma unroll 4
    for (int dd = 0; dd < 32; ++dd) {
        f32x2 qv[4];
#pragma unroll
        for (int qi = 0; qi < 4; ++qi) qv[qi] = *(const LAS f32x2*)(qst + qi * 64 + 2 * dd);
#pragma unroll
        for (int kk = 0; kk < 4; ++kk) { const unsigned kw = Ks[(lane + 64 * kk) * 33 + dd]; const float k0 = bflo(kw), k1 = bfhi(kw);
#pragma unroll
            for (int qi = 0; qi < 4; ++qi) sc[qi][kk] += qv[qi].x * k0 + qv[qi].y * k1; }
    }
#pragma unroll
    for (int qi = 0; qi < 4; ++qi) { float mx = -INFINITY;
#pragma unroll
        for (int kk = 0; kk < 4; ++kk) { const int pos = kbase + lane + 64 * kk; float lg = sc[qi][kk] * 0.125f - slope * (float)(tq[qi] - pos); if (MASK && pos > tq[qi]) lg = -INFINITY; sc[qi][kk] = lg; mx = fmaxf(mx, lg); }
        mx = wave_max(mx); float s = 0.f;
#pragma unroll
        for (int kk = 0; kk < 4; ++kk) { const float p = __builtin_amdgcn_exp2f((sc[qi][kk] - mx) * 1.4426950408889634f); pb[qi * 256 + lane + 64 * kk] = p; s += p; }
        lo[qi] = wave_sum(s); mo[qi] = mx; }
    float o[4] = {0.f, 0.f, 0.f, 0.f};
#pragma unroll 4
    for (int k4 = 0; k4 < 64; ++k4) { f32x4 p4[4];
#pragma unroll
        for (int qi = 0; qi < 4; ++qi) p4[qi] = *(const LAS f32x4*)(pb + qi * 256 + 4 * k4);
#pragma unroll
        for (int jj = 0; jj < 4; ++jj) { const float vv = bf2f(Vs[(4 * k4 + jj) * 64 + lane]);
#pragma unroll
            for (int qi = 0; qi < 4; ++qi) o[qi] += p4[qi][jj] * vv; } }
#pragma unroll
    for (int qi = 0; qi < 4; ++qi) oo[qi] = o[qi];
}
constexpr int AT_KS = 0, AT_VS = 33792, AT_WV = 66560, AT_WVB = 5120;

__device__ __forceinline__ void memattn_unit(LAS unsigned char* lds, const bf16* h, int NC, int qoff, const bf16* kv, bf16* mix, int unit, int tid, int wave, int lane) {
    const int chunk = unit & 31, bm = unit >> 5, mh = bm & 3, b = bm >> 2;
    LAS unsigned* Ks = (LAS unsigned*)(lds + AT_KS); LAS unsigned* Vs32 = (LAS unsigned*)(lds + AT_VS);
    LAS float* qst = (LAS float*)(lds + AT_WV + wave * AT_WVB); LAS float* pb = qst + 256;
    for (int i = 0; i < 16; ++i) { const int idx = tid + 512 * i, r = idx >> 5, dd = idx & 31; const unsigned* src = (const unsigned*)(kv + (size_t)(b * 256 + r) * 512 + mh * 64);
        Ks[r * 33 + dd] = src[dd]; Vs32[r * 32 + dd] = src[128 + dd]; }
    __syncthreads();
    for (int qd = 0; qd < 16; ++qd) { const size_t tg = (size_t)b * SEQ + chunk * 512 + wave * 64 + qd * 4;
#pragma unroll
        for (int qi = 0; qi < 4; ++qi) qst[qi * 64 + lane] = bf2f(h[(tg + qi) * NC + qoff + mh * 64 + lane]);
        const int tq[4] = {0, 0, 0, 0}; float m[4], l[4], o[4];
        attn4<false>(Ks, (const LAS bf16*)Vs32, qst, pb, lane, tq, 0, 0.f, m, l, o);
#pragma unroll
        for (int qi = 0; qi < 4; ++qi) mix[(tg + qi) * 1024 + MIXW + mh * 64 + lane] = (bf16)f2bf(o[qi] / l[qi]); }
    __syncthreads();
}

constexpr int AT2_K = 0, AT2_KROW = 176, AT2_V = 256 * AT2_KROW, AT2_VROW = 528, AT2_SCR = AT2_V + 64 * AT2_VROW, AT2_SCRW = 4864;
__device__ __forceinline__ void stage_kv_images(LAS unsigned char* lds, const bf16* kp, const bf16* vp, size_t row_stride, int tid) {
    v4u kx[4], vx[4];
#pragma unroll
    for (int i = 0; i < 4; ++i) { const int idx = tid + 512 * i, key = idx >> 3, c = idx & 7; kx[i] = *(const v4u*)(kp + (size_t)key * row_stride + 8 * c); vx[i] = *(const v4u*)(vp + (size_t)key * row_stride + 8 * c); }
    __builtin_amdgcn_sched_barrier(0);
#pragma unroll
    for (int i = 0; i < 4; ++i) { const int idx = tid + 512 * i, key = idx >> 3, c = idx & 7;
        *(LAS v4u*)(lds + AT2_K + key * AT2_KROW + c * 16) = kx[i];
        const int pos = (key & ~15) | (key & 3) | ((key & 4) << 1) | ((key & 8) >> 1);
        LAS bf16* vt = (LAS bf16*)(lds + AT2_V) + pos;
#pragma unroll
        for (int w = 0; w < 4; ++w) { vt[(8 * c + 2 * w) * (AT2_VROW / 2)] = (bf16)(vx[i][w] & 0xffffu); vt[(8 * c + 2 * w + 1) * (AT2_VROW / 2)] = (bf16)(vx[i][w] >> 16); } }
    if (tid < 256) { const unsigned pb = f2bf((float)tid); const v4u e0 = {pb | (pb << 16), 0u, 0u, 0u}, z = {0u, 0u, 0u, 0u};
        *(LAS v4u*)(lds + AT2_K + tid * AT2_KROW + 128) = e0; *(LAS v4u*)(lds + AT2_K + tid * AT2_KROW + 144) = z; }
}
template <bool MASK>
__device__ __forceinline__ void attn_tile32(const LAS unsigned char* lds, const s16x8 (&qf)[4], int lane, float dist0, unsigned qx, bool own, f32x16 (&o)[2], float& mrow, float& lrow) {
    const int r = lane & 31, hf = lane >> 5;
    const v4u qxv = {qx, 0u, 0u, 0u}; const s16x8 qe = __builtin_bit_cast(s16x8, qxv);
    f32x16 acc[8];
    const LAS unsigned char* kb = lds + AT2_K + r * AT2_KROW + hf * 16;
    constexpr int NKS = MASK ? 5 : 4;
    s16x8 kf[NKS];
#pragma unroll
    for (int s = 0; s < NKS; ++s) kf[s] = *(const LAS s16x8*)(kb + s * 32);
#pragma unroll
    for (int kt = 0; kt < 8; ++kt) {
#pragma unroll
        for (int i = 0; i < 16; ++i) acc[kt][i] = 0.f;
#pragma unroll
        for (int s = 0; s < NKS; ++s) { acc[kt] = __builtin_amdgcn_mfma_f32_32x32x16_bf16(kf[s], s < 4 ? qf[s < 4 ? s : 0] : qe, acc[kt], 0, 0, 0);
            if (kt + 1 < 8) kf[s] = *(const LAS s16x8*)(kb + (kt + 1) * 32 * AT2_KROW + s * 32); }
        __builtin_amdgcn_sched_barrier(0); }
    float mx = -INFINITY;
    if (MASK && own) { const float base2 = dist0 - 4.f * (float)hf;
#pragma unroll
        for (int kt = 0; kt < 8; ++kt)
#pragma unroll
            for (int i = 0; i < 16; ++i) { const float dist = base2 - (float)(32 * kt + (i & 3) + 8 * (i >> 2)); const float lg = dist < 0.f ? -INFINITY : acc[kt][i]; acc[kt][i] = lg; mx = fmaxf(mx, lg); }
    } else {
#pragma unroll
        for (int kt = 0; kt < 8; ++kt)
#pragma unroll
            for (int i = 0; i < 16; ++i) mx = fmaxf(mx, acc[kt][i]);
    }
    mx = fmaxf(mx, xor32f(mx, lane));
    float sum = 0.f;
#pragma unroll
    for (int i = 0; i < 16; ++i) { o[0][i] = 0.f; o[1][i] = 0.f; }
    const LAS unsigned char* vb = lds + AT2_V + r * AT2_VROW + hf * 16;
    s16x8 vf[4];
#pragma unroll
    for (int s2 = 0; s2 < 2; ++s2)
#pragma unroll
        for (int dt = 0; dt < 2; ++dt) vf[2 * s2 + dt] = *(const LAS s16x8*)(vb + dt * 32 * AT2_VROW + (16 * s2) * 2);
#pragma unroll
    for (int kt = 0; kt < 8; ++kt) {
#pragma unroll
        for (int i = 0; i < 16; ++i) { const float p = __builtin_amdgcn_exp2f(acc[kt][i] - mx); sum += p; acc[kt][i] = p; }
#pragma unroll
        for (int s2 = 0; s2 < 2; ++s2) { v4u pw; pw.x = cvtpk(acc[kt][8 * s2], acc[kt][8 * s2 + 1]); pw.y = cvtpk(acc[kt][8 * s2 + 2], acc[kt][8 * s2 + 3]);
            pw.z = cvtpk(acc[kt][8 * s2 + 4], acc[kt][8 * s2 + 5]); pw.w = cvtpk(acc[kt][8 * s2 + 6], acc[kt][8 * s2 + 7]); const s16x8 pf = __builtin_bit_cast(s16x8, pw);
#pragma unroll
            for (int dt = 0; dt < 2; ++dt) { o[dt] = __builtin_amdgcn_mfma_f32_32x32x16_bf16(vf[2 * s2 + dt], pf, o[dt], 0, 0, 0);
                if (kt + 1 < 8) vf[2 * s2 + dt] = *(const LAS s16x8*)(vb + dt * 32 * AT2_VROW + (32 * (kt + 1) + 16 * s2) * 2); } }
        __builtin_amdgcn_sched_barrier(0); }
    sum += xor32f(sum, lane);
    mrow = mx; lrow = sum;
}
__device__ __forceinline__ void memattn_unit2(LAS unsigned char* lds, const bf16* h, int NC, int qoff, const bf16* kv  , bf16* mix, int unit, int tid, int wave, int lane) {
    const int chunk = unit & 63, bm = unit >> 6, mh = bm & 3, b = bm >> 2, r = lane & 31, hf = lane >> 5;
    const bf16* kvrow0 = kv + (size_t)(b * 256) * 2048 + mh * 64;
    stage_kv_images(lds, kvrow0, kvrow0 + 256, 2048, tid);
    __syncthreads();
    { const size_t tg = (size_t)b * SEQ + chunk * 256 + wave * 32 + r;
        f32x16 o[2]; float m2, l; s16x8 qf[4];
#pragma unroll
        for (int s = 0; s < 4; ++s) qf[s] = *(const s16x8*)(h + tg * NC + qoff + mh * 64 + 16 * s + 8 * hf);
        attn_tile32<false>(lds, qf, lane, 0.f, 0u, false, o, m2, l);
        const float inv = 1.f / l; bf16* mp = mix + tg * 1024 + MIXW + mh * 64 + 4 * hf;
#pragma unroll
        for (int dt = 0; dt < 2; ++dt)
#pragma unroll
            for (int g = 0; g < 4; ++g) { v2u w; w.x = cvtpk(o[dt][4 * g] * inv, o[dt][4 * g + 1] * inv); w.y = cvtpk(o[dt][4 * g + 2] * inv, o[dt][4 * g + 3] * inv); *(v2u*)(mp + 32 * dt + 8 * g) = w; } }
    __syncthreads();
}
__device__ __forceinline__ void kmean_unit(LAS unsigned char* lds, const bf16* h, float* kmean, float* kmaxg, int unit, int tid, int wave) {
    const int n = unit & 63, bh = unit >> 6, hh = bh % MB_H, b = bh / MB_H, d = tid & 63, part = tid >> 6;
    LAS float* red = (LAS float*)lds;
    float s = 0.f; const bf16* p = h + ((size_t)b * SEQ + n * 256 + part * 32) * NC_M + 768 + hh * 64 + d;
    for (int i = 0; i < 32; ++i) s += bf2f(p[(size_t)i * NC_M]);
    float ss = 0.f; { const v4u* kp = (const v4u*)(h + ((size_t)b * SEQ + n * 256 + (tid >> 1)) * NC_M + 768 + hh * 64 + (tid & 1) * 32);
#pragma unroll
        for (int w = 0; w < 4; ++w) { const v4u x = kp[w]; ss += bflo(x.x) * bflo(x.x) + bfhi(x.x) * bfhi(x.x) + bflo(x.y) * bflo(x.y) + bfhi(x.y) * bfhi(x.y) + bflo(x.z) * bflo(x.z) + bfhi(x.z) * bfhi(x.z) + bflo(x.w) * bflo(x.w) + bfhi(x.w) * bfhi(x.w); } }
    ss += xorf<1>(ss); ss = wave_max(ss);
    red[part * 64 + d] = s; if ((tid & 63) == 0) red[512 + wave] = ss; __syncthreads();
    if (tid < 64) { float a = 0.f; for (int pp = 0; pp < 8; ++pp) a += red[pp * 64 + tid]; a *= (1.f / 256.f);
        const unsigned hi = f2bf(a), lo = f2bf(a - __builtin_bit_cast(float, hi << 16)); bf16* kmh = (bf16*)kmean; kmh[((size_t)bh * 64 + n) * 64 + tid] = (bf16)hi; kmh[(size_t)24 * 4096 + ((size_t)bh * 64 + n) * 64 + tid] = (bf16)lo; }
    if (tid == 0) { float mx = 0.f; for (int w = 0; w < 8; ++w) mx = fmaxf(mx, red[512 + w]); kmaxg[bh * 64 + n] = sqrtf(mx) * 1.001f; }
    __syncthreads();
}
__device__ __forceinline__ void gate_unit_core(const s16x8 (&qf)[4], const s16x8 (&kf)[4], const bf16* kmh, const bf16* kml, LAS int* hist, const LAS float* kmx, int* selinfo, int bh, int c, int t, int lane, unsigned& sel, unsigned& rr) {
    const int hh = bh % MB_H, b = bh / MB_H, hf = lane >> 5, r = lane & 31;
    int s0 = 0, s1 = 0, s2 = 0, r0 = 0, r1 = 0, r2 = 0, ns = 0;
    float v0 = -INFINITY, v1 = -INFINITY, v2 = -INFINITY, qn = 0.f, lown = 0.f;
    if (c > 0) {
        const int ntile = (c + 31) >> 5, ch = c - 4 * hf;
        s16x8 ah[2][4], al[2][4];
#pragma unroll
        for (int tile = 0; tile < 2; ++tile) if (tile < ntile) { const size_t ko = ((size_t)bh * 64 + 32 * tile + r) * 64 + 8 * hf;
#pragma unroll
            for (int ks = 0; ks < 4; ++ks) { ah[tile][ks] = *(const s16x8*)(kmh + ko + 16 * ks); al[tile][ks] = *(const s16x8*)(kml + ko + 16 * ks); } }
#pragma unroll
        for (int tile = 0; tile < 2; ++tile) if (tile < ntile) {
            f32x16 X;
#pragma unroll
            for (int i = 0; i < 16; ++i) X[i] = 0.f;
#pragma unroll
            for (int ks = 0; ks < 4; ++ks) { X = __builtin_amdgcn_mfma_f32_32x32x16_bf16(ah[tile][ks], qf[ks], X, 0, 0, 0); X = __builtin_amdgcn_mfma_f32_32x32x16_bf16(al[tile][ks], qf[ks], X, 0, 0, 0); }
#pragma unroll
            for (int i = 0; i < 16; ++i) { const int n = 32 * tile + (i & 3) + 8 * (i >> 2); const float g = (n < ch) ? X[i] : -INFINITY;
                if (g > v0) { v2 = v1; s2 = s1; v1 = v0; s1 = s0; v0 = g; s0 = n; } else if (g > v1) { v2 = v1; s2 = s1; v1 = g; s1 = n; } else if (g > v2) { v2 = g; s2 = n; } }
        }
        s0 += 4 * hf; s1 += 4 * hf; s2 += 4 * hf;
        { float qq = 0.f, qk = 0.f;
#pragma unroll
          for (int s = 0; s < 4; ++s)
#pragma unroll
              for (int jj = 0; jj < 8; ++jj) { const float qv = bf2f((bf16)qf[s][jj]), kv = bf2f((bf16)kf[s][jj]); qq += qv * qv; qk += qv * kv; }
          qq += xor32f(qq, lane); qk += xor32f(qk, lane);
          qn = sqrtf(qq) * 1.001f; lown = qk; }
        { float pv[3]; int ps[3]; const int pl = (lane ^ 32) << 2;
          pv[0] = __builtin_bit_cast(float, __builtin_amdgcn_ds_bpermute(pl, __builtin_bit_cast(int, v0))); pv[1] = __builtin_bit_cast(float, __builtin_amdgcn_ds_bpermute(pl, __builtin_bit_cast(int, v1)));
          pv[2] = __builtin_bit_cast(float, __builtin_amdgcn_ds_bpermute(pl, __builtin_bit_cast(int, v2)));
          ps[0] = __builtin_amdgcn_ds_bpermute(pl, s0); ps[1] = __builtin_amdgcn_ds_bpermute(pl, s1); ps[2] = __builtin_amdgcn_ds_bpermute(pl, s2);
#pragma unroll
          for (int k = 0; k < 3; ++k) { const float g = pv[k]; const int n = ps[k];
              if (g > v0 || (g == v0 && n < s0)) { v2 = v1; s2 = s1; v1 = v0; s1 = s0; v0 = g; s0 = n; } else if (g > v1 || (g == v1 && n < s1)) { v2 = v1; s2 = s1; v1 = g; s1 = n; } else if (g > v2 || (g == v2 && n < s2)) { v2 = g; s2 = n; } } }
    }
    sel = 0u; rr = 0u;
    if (hf == 0) {
        ns = c < 3 ? c : 3; s0 &= 63; s1 &= 63; s2 &= 63;
        { const float slope2 = (hh < 8 ? ldexpf(1.0f, -(hh + 1)) : ldexpf(0.70710678118654752f, -(hh - 8))) * 1.4426950408889634f;
          const bool k0 = ns > 0 && (qn * kmx[s0] - slope2 * (float)(t - (s0 * 256 + 255)) - lown) > -64.f;
          const bool k1 = ns > 1 && (qn * kmx[s1] - slope2 * (float)(t - (s1 * 256 + 255)) - lown) > -64.f;
          const bool k2 = ns > 2 && (qn * kmx[s2] - slope2 * (float)(t - (s2 * 256 + 255)) - lown) > -64.f;
          ns = (k0 ? 1 : 0) | (k1 ? 2 : 0) | (k2 ? 4 : 0); }
        if (ns & 1) r0 = __hip_atomic_fetch_add(hist + s0, 1, __ATOMIC_RELAXED, __HIP_MEMORY_SCOPE_WORKGROUP);
        if (ns & 2) r1 = __hip_atomic_fetch_add(hist + s1, 1, __ATOMIC_RELAXED, __HIP_MEMORY_SCOPE_WORKGROUP);
        if (ns & 4) r2 = __hip_atomic_fetch_add(hist + s2, 1, __ATOMIC_RELAXED, __HIP_MEMORY_SCOPE_WORKGROUP);
        selinfo[((size_t)b * SEQ + t) * MB_H + hh] = ns;
        sel = (unsigned)s0 | ((unsigned)s1 << 6) | ((unsigned)s2 << 12) | ((unsigned)ns << 18); rr = (unsigned)r0 | ((unsigned)r1 << 8) | ((unsigned)r2 << 16);
    }
}
__device__ __forceinline__ void moba_gate_wg(LAS unsigned char* lds, const bf16* h, const float* kmean, const float* kmaxg, unsigned* gcount, int* selinfo, unsigned* list, int blk, int tid) {
    constexpr int NU = 24 * MB_NB / GRID;
    static_assert(NU * GRID == 24 * MB_NB && GRID % 64 == 0 && NU * 64 <= NTHR, "gate deal");
    const int lane = tid & 63, r = lane & 31, hf = lane >> 5, wv = tid >> 6;
    const bf16* kmh = (const bf16*)kmean; const bf16* kml = kmh + (size_t)24 * 4096;
    LAS int* hist = (LAS int*)(lds + 16384); LAS int* base = hist + NU * 64; LAS float* kmx = (LAS float*)(base + NU * 64);
    if (tid < NU * 64) { const int bh = (blk >> 6) + 4 * (tid >> 6); hist[tid] = 0; kmx[tid] = kmaxg[bh * 64 + (tid & 63)]; }
    unsigned sel[NU], rr[NU];
    s16x8 qf[4], kf[4];
#define GU_BH(k) ((blk >> 6) + 4 * (k))
#define GU_C(k) (((k) & 1) ? 63 - (blk & 63) : (blk & 63))
#define GU_T(k) (GU_C(k) * 256 + wv * 32 + r)
    { const bf16* qp = h + ((size_t)(GU_BH(0) / MB_H) * SEQ + GU_T(0)) * NC_M + (GU_BH(0) % MB_H) * 64 + 8 * hf;
#pragma unroll
      for (int s = 0; s < 4; ++s) { qf[s] = *(const s16x8*)(qp + 16 * s); kf[s] = *(const s16x8*)(qp + 768 + 16 * s); } }
    __syncthreads();
#pragma unroll
    for (int k = 0; k < NU; ++k) {
        s16x8 qn_[4], kn_[4];
        if (k + 1 < NU) { const bf16* qp = h + ((size_t)(GU_BH(k + 1) / MB_H) * SEQ + GU_T(k + 1)) * NC_M + (GU_BH(k + 1) % MB_H) * 64 + 8 * hf;
#pragma unroll
            for (int s = 0; s < 4; ++s) { qn_[s] = *(const s16x8*)(qp + 16 * s); kn_[s] = *(const s16x8*)(qp + 768 + 16 * s); } }
        gate_unit_core(qf, kf, kmh, kml, hist + k * 64, kmx + k * 64, selinfo, GU_BH(k), GU_C(k), GU_T(k), lane, sel[k], rr[k]);
        if (k + 1 < NU) {
#pragma unroll
            for (int s = 0; s < 4; ++s) { qf[s] = qn_[s]; kf[s] = kn_[s]; } }
    }
    __syncthreads();
    if (tid < NU * 64) { const int hc = hist[tid]; if (hc > 0) base[tid] = (int)__hip_atomic_fetch_add(gcount + GU_BH(tid >> 6) * 64 + (tid & 63), (unsigned)hc, __ATOMIC_RELAXED, __HIP_MEMORY_SCOPE_AGENT); }
    __syncthreads();
    if (hf == 0) {
#pragma unroll
        for (int k = 0; k < NU; ++k) { unsigned* lp = list + ((size_t)GU_BH(k) * 64 << 14); const unsigned sl = sel[k], rk = rr[k], t = (unsigned)GU_T(k); const int s0 = sl & 63, s1 = (sl >> 6) & 63, s2 = (sl >> 12) & 63;
            if (sl & (1u << 18)) lp[((size_t)s0 << 14) + base[k * 64 + s0] + (rk & 255u)] = t;
            if (sl & (2u << 18)) lp[((size_t)s1 << 14) + base[k * 64 + s1] + ((rk >> 8) & 255u)] = t | (1u << 14);
            if (sl & (4u << 18)) lp[((size_t)s2 << 14) + base[k * 64 + s2] + ((rk >> 16) & 255u)] = t | (2u << 14); } }
#undef GU_BH
#undef GU_C
#undef GU_T
    __syncthreads();
}
__device__ __forceinline__ void moba_attn_item(LAS unsigned char* lds, const bf16* h, const unsigned* gcount, const unsigned* list, float* po, float* pml, int item, int tid, int wave, int lane) {
    const int n = item / 24, bh = item - n * 24, hh = bh % MB_H, b = bh / MB_H;
    LAS unsigned* Ks = (LAS unsigned*)(lds + AT_KS); LAS unsigned* Vs32 = (LAS unsigned*)(lds + AT_VS);
    LAS float* qst = (LAS float*)(lds + AT_WV + wave * AT_WVB); LAS float* pb = qst + 256;
    for (int i = 0; i < 16; ++i) { const int idx = tid + 512 * i, r = idx >> 5, dd = idx & 31; const unsigned* src = (const unsigned*)(h + ((size_t)b * SEQ + n * 256 + r) * NC_M + hh * 64);
        Ks[r * 33 + dd] = src[384 + dd]; Vs32[r * 32 + dd] = src[768 + dd]; }
    __syncthreads();
    const int cnt = (int)gcount[bh * 64 + n], total = 256 + cnt, nquads = (total + 3) >> 2;
    const float slope = hh < 8 ? ldexpf(1.0f, -(hh + 1)) : ldexpf(0.70710678118654752f, -(hh - 8));
    const unsigned* lp = list + (((size_t)bh * 64 + n) << 14);
    for (int quad = wave; quad < nquads; quad += 8) {
        int tq[4], slot[4];
#pragma unroll
        for (int qi = 0; qi < 4; ++qi) { int idx = quad * 4 + qi; idx = idx < total ? idx : total - 1;
            if (idx < 256) { tq[qi] = n * 256 + idx; slot[qi] = 3; } else { const unsigned e = lp[idx - 256]; tq[qi] = (int)(e & 16383u); slot[qi] = (int)(e >> 14); } }
#pragma unroll
        for (int qi = 0; qi < 4; ++qi) qst[qi * 64 + lane] = bf2f(h[((size_t)b * SEQ + tq[qi]) * NC_M + hh * 64 + lane]);
        float m[4], l[4], o[4];
        attn4<true>(Ks, (const LAS bf16*)Vs32, qst, pb, lane, tq, n * 256, slope, m, l, o);
#pragma unroll
        for (int qi = 0; qi < 4; ++qi) if (quad * 4 + qi < total) { const size_t pi = (((size_t)b * SEQ + tq[qi]) * MB_H + hh) * 4 + slot[qi];
            po[pi * 64 + lane] = o[qi]; if (lane == 0) { pml[pi * 2] = m[qi]; pml[pi * 2 + 1] = l[qi]; } }
    }
    __syncthreads();
}

__device__ __forceinline__ void moba_attn_item2(LAS unsigned char* lds, const bf16* h, const unsigned* gcount, const unsigned* list, bf16* po, float* pml, int item, int tid, int wave, int lane) {
    const int n = item / 24, bh = item - n * 24, hh = bh % MB_H, b = bh / MB_H, r = lane & 31, hf = lane >> 5;
    const bf16* hrow0 = h + ((size_t)b * SEQ + n * 256) * NC_M + hh * 64;
    stage_kv_images(lds, hrow0 + 768, hrow0 + 1536, NC_M, tid);
    __syncthreads();
    const int cnt = (int)gcount[bh * 64 + n], total = 256 + cnt, ntiles = (total + 31) >> 5;
    const float slope2 = (hh < 8 ? ldexpf(1.0f, -(hh + 1)) : ldexpf(0.70710678118654752f, -(hh - 8))) * 1.4426950408889634f;
    const unsigned shi = f2bf(slope2), slo = f2bf(slope2 - __builtin_bit_cast(float, shi << 16)); const unsigned qx = hf == 0 ? (shi | (slo << 16)) : 0u;
    const unsigned* lp = list + (((size_t)bh * 64 + n) << 14);
    const bf16* hq = h + (size_t)b * SEQ * NC_M + hh * 64 + 8 * hf;
#pragma unroll 1
    for (int tile = wave; tile < ntiles; tile += NWAVES) {
        int idx = tile * 32 + r; const bool valid = idx < total; idx = valid ? idx : total - 1;
        int tq, slot; if (idx < 256) { tq = n * 256 + idx; slot = 3; } else { const unsigned e = lp[idx - 256]; tq = (int)(e & 16383u); slot = (int)(e >> 14); }
        s16x8 qf[4]; { const bf16* qp = hq + (size_t)tq * NC_M;
#pragma unroll
            for (int s = 0; s < 4; ++s) qf[s] = *(const s16x8*)(qp + 16 * s); }
        f32x16 o[2]; float m2, l; const float dist0 = (float)(tq - n * 256);
        attn_tile32<true>(lds, qf, lane, dist0, qx, tile < 8, o, m2, l);
        { LAS unsigned char* sw = lds + AT2_SCR + wave * AT2_SCRW; const int pi = valid ? (int)((((size_t)b * SEQ + tq) * MB_H + hh) * 4 + slot) : -1;
#pragma unroll
          for (int dt = 0; dt < 2; ++dt)
#pragma unroll
              for (int g = 0; g < 4; ++g) { v2u w; w.x = cvtpk(o[dt][4 * g], o[dt][4 * g + 1]); w.y = cvtpk(o[dt][4 * g + 2], o[dt][4 * g + 3]); *(LAS v2u*)(sw + r * 144 + (32 * dt + 8 * g + 4 * hf) * 2) = w; }
          if (hf == 0) { *(LAS int*)(sw + 4608 + 4 * r) = pi; if (valid) { pml[(size_t)pi * 2] = m2 - slope2 * dist0; pml[(size_t)pi * 2 + 1] = l; } }
#pragma unroll
          for (int it = 0; it < 4; ++it) { const int q = 8 * it + (lane >> 3), c = lane & 7; const int pq = *(const LAS int*)(sw + 4608 + 4 * q); const v4u row = *(const LAS v4u*)(sw + q * 144 + c * 16);
              if (pq >= 0) *(v4u*)(po + (size_t)pq * 64 + c * 8) = row; } }
    }
    __syncthreads();
}
__device__ __forceinline__ void moba_combine(const bf16* __restrict__ po, const float* __restrict__ pml, const int* __restrict__ selinfo, bf16* __restrict__ mix, int gw, int ngw, int lane) {
    const int sub = lane >> 4, d4 = (lane & 15) * 4;
#pragma unroll 4
    for (int idx = gw * 4 + sub; idx < T * MB_H; idx += ngw * 4) { const int tg = idx / MB_H, hh = idx - tg * MB_H, ns = selinfo[idx]; const size_t p4 = (size_t)idx * 4;
        f32x2 ml[4]; f32x4 ov[4];
#pragma unroll
        for (int j = 0; j < 4; ++j) { ml[j] = ((const f32x2*)pml)[p4 + j]; const v2u ow = *(const v2u*)(po + (p4 + j) * 64 + d4); ov[j] = (f32x4){bflo(ow.x), bfhi(ow.x), bflo(ow.y), bfhi(ow.y)}; }
        float M = ml[3].x;
#pragma unroll
        for (int j = 0; j < 3; ++j) { const bool ok = (ns >> j) & 1; ml[j].x = ok ? ml[j].x : -INFINITY; ml[j].y = ok ? ml[j].y : 0.f; M = fmaxf(M, ml[j].x);
            ov[j].x = ok ? ov[j].x : 0.f; ov[j].y = ok ? ov[j].y : 0.f; ov[j].z = ok ? ov[j].z : 0.f; ov[j].w = ok ? ov[j].w : 0.f; }
        float den = 0.f; f32x4 num = {0.f, 0.f, 0.f, 0.f};
#pragma unroll
        for (int j = 0; j < 4; ++j) { const float w = __builtin_amdgcn_exp2f(ml[j].x - M); den += w * ml[j].y; num += ov[j] * w; }
        const float inv = 1.f / den; v2u o; o.x = pk2(num.x * inv, num.y * inv); o.y = pk2(num.z * inv, num.w * inv);
        *(v2u*)(mix + (size_t)tg * 1024 + hh * 64 + d4) = o; }
}

__device__ __forceinline__ void ln_row(f32x4 (&v)[4], const f32x4 (&gv)[4], const f32x4 (&bv)[4]) {
    float s = 0.f;
#pragma unroll
    for (int j = 0; j < 4; ++j) s += (v[j].x + v[j].y) + (v[j].z + v[j].w);
    const float mean = wave_sum(s) * (1.f / D); float s2 = 0.f;
#pragma unroll
    for (int j = 0; j < 4; ++j) { v[j] = v[j] - mean; s2 += (v[j].x * v[j].x + v[j].y * v[j].y) + (v[j].z * v[j].z + v[j].w * v[j].w); }
    const float rstd = 1.f / sqrtf(wave_sum(s2) * (1.f / D) + 1e-5f);
#pragma unroll
    for (int j = 0; j < 4; ++j) v[j] = v[j] * rstd * gv[j] + bv[j];
}
__device__ __forceinline__ void split_router_weights(const float* wr  , bf16* wrs  , size_t gtid, size_t gthreads) {
    for (size_t i = gtid; i < (size_t)DEPTH * D * NE; i += gthreads) { const int e = (int)(i & 31), d = (int)((i >> 5) & 1023), l = (int)(i >> 15);
        const float w = wr[i]; const unsigned hi = f2bf(w); const unsigned lo = f2bf(w - __builtin_bit_cast(float, hi << 16));
        wrs[(((size_t)l * 2 + 0) * NE + e) * D + d] = (bf16)hi; wrs[(((size_t)l * 2 + 1) * NE + e) * D + d] = (bf16)lo; }
}
constexpr int L1_XH = 0, L1_XL = 33024, L1_ROW = 2064, L1_PART = 66048, L1_HIST = 82432;
__device__ __forceinline__ void phase_ln1(LAS unsigned char* lds, const bf16* y, const float* g, const float* bb, const bf16* wrs  , const float* br,
                                          bf16* xbf, int* tok_e, int* tok_lr, float* tok_w, int* blk_cnt, int blk, int tid, int wave, int lane) {
    LAS float* part = (LAS float*)(lds + L1_PART);
    LAS int* hist = (LAS int*)(lds + L1_HIST);
    if (tid < 32) hist[tid] = 0;
    constexpr int TPB = T / GRID;
    const int e = lane & 31, m16 = lane & 15, quad = lane >> 4;
    s16x8 bw[4][2][2];
#pragma unroll
    for (int ks = 0; ks < 4; ++ks)
#pragma unroll
        for (int nt = 0; nt < 2; ++nt)
#pragma unroll
            for (int pp = 0; pp < 2; ++pp) bw[ks][nt][pp] = *(const s16x8*)(wrs + ((size_t)pp * NE + 16 * nt + m16) * D + wave * 128 + 32 * ks + 8 * quad);
    const float bre = br[e];
    f32x4 gv[4], bv[4];
#pragma unroll
    for (int j = 0; j < 4; ++j) { gv[j] = ((const f32x4*)g)[lane + 64 * j]; bv[j] = ((const f32x4*)bb)[lane + 64 * j]; }
    v2u xn[2][4], yn[2][4];
#pragma unroll
    for (int u = 0; u < 2; ++u) { const size_t t0 = (size_t)blk * TPB + 2 * wave + u; const v2u* xr = (const v2u*)(xbf + t0 * D) + lane; const v2u* yr = (const v2u*)(y + t0 * D) + lane;
#pragma unroll
        for (int j = 0; j < 4; ++j) { xn[u][j] = xr[64 * j]; yn[u][j] = yr[64 * j]; } }
    __syncthreads();
    for (int grp = 0; grp < TPB / 16; ++grp) { const size_t tg0 = (size_t)blk * TPB + grp * 16 + 2 * wave;
        f32x4 v[2][4];
#pragma unroll
        for (int u = 0; u < 2; ++u)
#pragma unroll
            for (int j = 0; j < 4; ++j) { const v2u xw = xn[u][j]; const v2u yw = yn[u][j];
                v[u][j].x = DN_ALPHA * bflo(xw.x) + bflo(yw.x); v[u][j].y = DN_ALPHA * bfhi(xw.x) + bfhi(yw.x); v[u][j].z = DN_ALPHA * bflo(xw.y) + bflo(yw.y); v[u][j].w = DN_ALPHA * bfhi(xw.y) + bfhi(yw.y); }
        if (grp + 1 < TPB / 16) {
#pragma unroll
            for (int u = 0; u < 2; ++u) { const v2u* xr = (const v2u*)(xbf + (tg0 + 16 + u) * D) + lane; const v2u* yr = (const v2u*)(y + (tg0 + 16 + u) * D) + lane;
#pragma unroll
                for (int j = 0; j < 4; ++j) { xn[u][j] = xr[64 * j]; yn[u][j] = yr[64 * j]; } } }
#pragma unroll
        for (int u = 0; u < 2; ++u) { ln_row(v[u], gv, bv);
            v2u* xb = (v2u*)(xbf + (tg0 + u) * D) + lane;
#pragma unroll
            for (int j = 0; j < 4; ++j) { v2u hw; hw.x = cvtpk(v[u][j].x, v[u][j].y); hw.y = cvtpk(v[u][j].z, v[u][j].w); xb[64 * j] = hw;
                v2u lw; lw.x = cvtpk(v[u][j].x - bflo(hw.x), v[u][j].y - bfhi(hw.x)); lw.y = cvtpk(v[u][j].z - bflo(hw.y), v[u][j].w - bfhi(hw.y));
                *(LAS v2u*)(lds + L1_XH + (2 * wave + u) * L1_ROW + (4 * lane + 256 * j) * 2) = hw; *(LAS v2u*)(lds + L1_XL + (2 * wave + u) * L1_ROW + (4 * lane + 256 * j) * 2) = lw; } }
        __syncthreads();
        { f32x4 acc[2] = {{0.f, 0.f, 0.f, 0.f}, {0.f, 0.f, 0.f, 0.f}};
#pragma unroll
          for (int ks = 0; ks < 4; ++ks) { const int off = m16 * L1_ROW + (wave * 128 + 32 * ks + 8 * quad) * 2;
              const s16x8 ah = *(const LAS s16x8*)(lds + L1_XH + off), al = *(const LAS s16x8*)(lds + L1_XL + off);
#pragma unroll
              for (int nt = 0; nt < 2; ++nt) { acc[nt] = __builtin_amdgcn_mfma_f32_16x16x32_bf16(ah, bw[ks][nt][0], acc[nt], 0, 0, 0); acc[nt] = __builtin_amdgcn_mfma_f32_16x16x32_bf16(ah, bw[ks][nt][1], acc[nt], 0, 0, 0);
                  acc[nt] = __builtin_amdgcn_mfma_f32_16x16x32_bf16(al, bw[ks][nt][0], acc[nt], 0, 0, 0); } }
#pragma unroll
          for (int nt = 0; nt < 2; ++nt)
#pragma unroll
              for (int jj = 0; jj < 4; ++jj) part[(wave * 16 + 4 * quad + jj) * 32 + 16 * nt + m16] = acc[nt][jj]; }
        __syncthreads();
#pragma unroll
        for (int u = 0; u < 2; ++u) { const size_t t = tg0 + u;
            float logit = bre;
#pragma unroll
            for (int w = 0; w < 8; ++w) logit += part[(w * 16 + 2 * wave + u) * 32 + e];
            int rank = 0;
#pragma unroll
            for (int q = 0; q < 32; ++q) { const float oq = __builtin_bit_cast(float, __builtin_amdgcn_readlane(__builtin_bit_cast(int, logit), q)); rank += (oq > logit || (oq == logit && q < e)) ? 1 : 0; }
            int se[4]; float sv[4];
#pragma unroll
            for (int k = 0; k < 4; ++k) { const unsigned long long mk = __ballot(rank == k && lane < 32); const int src = __builtin_ctzll(mk);
                se[k] = src; sv[k] = __builtin_bit_cast(float, __builtin_amdgcn_readlane(__builtin_bit_cast(int, logit), src)); }
            const float e1 = __expf(sv[1] - sv[0]), e2 = __expf(sv[2] - sv[0]), e3 = __expf(sv[3] - sv[0]), inv = 1.f / (1.f + e1 + e2 + e3);
            const float wk[4] = {inv, e1 * inv, e2 * inv, e3 * inv};
            if (lane == 0) {
#pragma unroll
                for (int k = 0; k < 4; ++k) { const int lr = __hip_atomic_fetch_add(hist + se[k], 1, __ATOMIC_RELAXED, __HIP_MEMORY_SCOPE_WORKGROUP);
                    tok_e[t * 4 + k] = se[k]; tok_lr[t * 4 + k] = lr; tok_w[t * 4 + k] = wk[k]; } } }
    }
    __syncthreads();
    if (tid < 32) blk_cnt[blk * 32 + tid] = hist[tid];
    __syncthreads();
}
__device__ __forceinline__ void phase_dispatch(LAS unsigned char* lds, const int* __restrict__ blk_cnt, const int* __restrict__ tok_e, const int* __restrict__ tok_lr, int* __restrict__ tok_row, int* __restrict__ tab,
                                               const bf16* __restrict__ xbf, bf16* __restrict__ xs, int blk, int tid, int wave, int lane) {
    LAS int* tot = (LAS int*)lds; LAS int* pre = tot + 32; LAS int* pst = pre + 32; LAS int* rows = pst + 64;
    if (tid < 32) { int s = 0, p = 0;
#pragma unroll 8
        for (int bb = 0; bb < GRID; ++bb) { const int c = blk_cnt[bb * 32 + tid]; p += (bb < blk) ? c : 0; s += c; } tot[tid] = s; pre[tid] = p; }
    __syncthreads();
    if (tid == 0) { int acc = 0; for (int e = 0; e < 32; ++e) { pst[e] = acc; acc += ((tot[e] + 255) >> 8) << 8; } pst[32] = acc; }
    __syncthreads();
    if (blk == 0 && tid < 33) tab[tid] = pst[tid] >> 8;
    constexpr int TPB = T / GRID;
    static_assert(TPB * 4 == NTHR, "one (token, k) pair per thread");
    { const size_t ti = (size_t)blk * TPB * 4 + tid; const int e = tok_e[ti]; const int r = pst[e] + pre[e] + tok_lr[ti]; tok_row[ti] = r; rows[tid] = r; }
    __syncthreads();
#pragma unroll 4
    for (int i = wave; i < TPB * 4; i += NWAVES) { const int r = rows[i];
        const v4u* src = (const v4u*)(xbf + ((size_t)blk * TPB + (i >> 2)) * D) + 2 * lane; const v4u a = src[0], b = src[1];
        v4u o; o.x = pk4_fp8(bflo(a.x), bfhi(a.x), bflo(a.y), bfhi(a.y)); o.y = pk4_fp8(bflo(a.z), bfhi(a.z), bflo(a.w), bfhi(a.w)); o.z = pk4_fp8(bflo(b.x), bfhi(b.x), bflo(b.y), bfhi(b.y)); o.w = pk4_fp8(bflo(b.z), bfhi(b.z), bflo(b.w), bfhi(b.w));
        ((v4u*)((unsigned char*)xs + (size_t)r * D))[lane] = o; }
    __syncthreads();
}
__device__ __forceinline__ f32x4 fp8x4_to_f32(unsigned w) {
    const f32x2 lo = __builtin_amdgcn_cvt_pk_f32_fp8((int)w, false), hi = __builtin_amdgcn_cvt_pk_f32_fp8((int)w, true); return (f32x4){lo.x, lo.y, hi.x, hi.y};
}
__device__ __forceinline__ void phase_ln2(const unsigned char* __restrict__ yrows, const int* __restrict__ tok_row, const float* __restrict__ tok_w, const float* __restrict__ g, const float* __restrict__ bb,
                                          float* __restrict__ xout, bf16* xbf, int gw, int ngw, int lane) {
    f32x4 gv[4], bv[4];
#pragma unroll
    for (int j = 0; j < 4; ++j) { gv[j] = ((const f32x4*)g)[lane + 64 * j]; bv[j] = ((const f32x4*)bb)[lane + 64 * j]; }
    constexpr int NTK = 2;
    static_assert(T % (NTK * GRID * NWAVES) == 0, "NTK tokens per wave per step");
    for (int t0 = gw; t0 < T; t0 += NTK * ngw) {
        f32x4 v[NTK][4];
#pragma unroll
        for (int u = 0; u < NTK; ++u) { const int t = t0 + u * ngw; int r[4]; float w[4];
#pragma unroll
            for (int k = 0; k < 4; ++k) { r[k] = tok_row[(size_t)t * 4 + k]; w[k] = tok_w[(size_t)t * 4 + k] * (1.f / 16.f); }
            const v2u* xr = (const v2u*)(xbf + (size_t)t * D) + lane;
#pragma unroll
            for (int j = 0; j < 4; ++j) { f32x4 f = {0.f, 0.f, 0.f, 0.f};
#pragma unroll
                for (int k = 0; k < 4; ++k) { const unsigned yw = ((const unsigned*)(yrows + (size_t)r[k] * D))[lane + 64 * j]; f += fp8x4_to_f32(yw) * w[k]; }
                const v2u xw = xr[64 * j]; v[u][j].x = DN_ALPHA * bflo(xw.x) + f.x; v[u][j].y = DN_ALPHA * bfhi(xw.x) + f.y; v[u][j].z = DN_ALPHA * bflo(xw.y) + f.z; v[u][j].w = DN_ALPHA * bfhi(xw.y) + f.w; } }
#pragma unroll
        for (int u = 0; u < NTK; ++u) { const int t = t0 + u * ngw;
            ln_row(v[u], gv, bv);
            if (xout) { f32x4* xo = (f32x4*)(xout + (size_t)t * D) + lane;
#pragma unroll
                for (int j = 0; j < 4; ++j) xo[64 * j] = v[u][j]; }
            else { v2u* xb = (v2u*)(xbf + (size_t)t * D) + lane;
#pragma unroll
                for (int j = 0; j < 4; ++j) { v2u ww; ww.x = pk2(v[u][j].x, v[u][j].y); ww.y = pk2(v[u][j].z, v[u][j].w); xb[64 * j] = ww; } } } }
}


struct Args { const float* in[20]; float* out; unsigned char* ws; int l_lo, l_hi, ph_lo, ph_hi; };
typedef const __attribute__((address_space(4))) Args* KArgsP;
#define KA_LOAD() ({ KArgsP p_ = (KArgsP)__builtin_amdgcn_kernarg_segment_ptr(); asm volatile("" : "+s"(p_)); p_; })
#ifndef PHMASK
#define PHMASK 0xFFFF
#endif
#ifndef REPEAT_MASK
#define REPEAT_MASK 0
#endif
#ifndef REPEAT_LMASK
#define REPEAT_LMASK 0xF
#endif
#define PH_BEGIN(k) _Pragma("unroll") for (int rep_ = 0; rep_ < ((((REPEAT_MASK >> (k)) & 1) && ((REPEAT_LMASK >> l) & 1)) ? 2 : 1); ++rep_) { if ((PHMASK >> (k)) & 1) { KArgsP ka = KA_LOAD(); unsigned char* ws = ka->ws; int tid = threadIdx.x; asm volatile("" : "+v"(tid)); \
    const int lane = tid & 63, wave = __builtin_amdgcn_readfirstlane(tid >> 6); int blk = blockIdx.x; asm volatile("" : "+s"(blk)); \
    const int gw = blk * NWAVES + wave; const size_t gtid = (size_t)blk * NTHR + tid; (void)lane; (void)gw; (void)gtid; (void)ws;
#if ONE_LAUNCH
#define PH_SEAM() do { XcdBarrier b_; b_.bar = (unsigned*)(KA_LOAD()->ws + WS_CTL) + CW_BAR; b_.x = xb_xcc_id(); b_.st = (volatile LAS unsigned*)(lds + MISC_OFF); xcd_barrier(b_); } while (0)
#else
#define PH_SEAM() do {} while (0)
#endif
#define PH_END() PH_SEAM(); } }
#define PH_END_NOSEAM() } }
#define WSP(type, off) ((type*)(ws + (off)))
constexpr int G = GRID, NGW = GRID * NWAVES; constexpr size_t GTHREADS = (size_t)GRID * NTHR;
template <int L> __device__ __forceinline__ void layer_phases(LAS unsigned char* lds) {
    constexpr int l = L; LAS int* tabL = (LAS int*)(lds + MISC_OFF + 256);

        const int j = l >> 1; const bool moba = (l & 1) != 0;
        const int NC = moba ? NC_M : NC_H, qoff = moba ? 2304 : 3072;

        if (l == 0) {
        PH_BEGIN(1)
            phase_weights((LAS float*)(lds + wave * 16384), gw, NGW, lane, ka->in[2], NC_H, ka->in[6], 4, ka->in[7], ka->in[12], ka->in[14], ka->in[16], WSP(bf16, WS_WIN), WSP(bf16, WS_WKV4), WSP(bf16, WS_WO), WSP(bf16, WS_WGU), WSP(bf16, WS_WD));
        PH_END()
        }
        PH_BEGIN(2)
            { pg8::Gemm g{WSP(bf16, WS_XBF), WSP(bf16, WS_WIN), T, NC, D, 0, 0}; pg8::StaticOrder S; S.init(T, NC, G, blk); pg8::EpiPlain E{WSP(bf16, WS_H), NC, moba ? 0x207u : 0x1000u, 0.125f * 1.4426950408889634f};
              pg8::gemm_phase<pg8::EpiPlain, pg8::StaticOrder, true, true>(lds, g, S, E); }
            if (l == 0) {
              pg8::Gemm g{WSP(bf16, WS_MEMBF), WSP(bf16, WS_WKV4), 512, 2048, D, 0, 0}; pg8::StaticOrder S; S.init(512, 2048, G, blk >= 128 ? blk - 128 : G); pg8::EpiPlain E{WSP(bf16, WS_KV4), 2048, 0u, 1.f};
              pg8::gemm_phase<pg8::EpiPlain, pg8::StaticOrder, true, true>(lds, g, S, E); }
        PH_END()
        if (!moba) {
            PH_BEGIN(3)
                for (int u = blk; u < NBATCH * HG_H * HNSEG; u += G) hgrn_mfma<false>(lds, WSP(bf16, WS_H), ka->in[3], j, ka->in[4] + j * 128, WSP(float, WS_SLOC), WSP(float, WS_DSEG), WSP(bf16, WS_MIX), u, tid, wave, lane);
                for (int u = blk; u < 512; u += G) memattn_unit2(lds, WSP(bf16, WS_H), NC, qoff, WSP(bf16, WS_KV4) + 512 * l, WSP(bf16, WS_MIX), u, tid, wave, lane);
            PH_END()
            PH_BEGIN(4)
                hgrn_scan(WSP(float, WS_SLOC), WSP(float, WS_DSEG), gtid, GTHREADS);
            PH_END()
            PH_BEGIN(5)
                for (int u = blk; u < NBATCH * HG_H * HNSEG; u += G) hgrn_mfma<true>(lds, WSP(bf16, WS_H), ka->in[3], j, ka->in[4] + j * 128, WSP(float, WS_SLOC), WSP(float, WS_DSEG), WSP(bf16, WS_MIX), u, tid, wave, lane);
            PH_END()
        } else {
            PH_BEGIN(3)
                for (int u = blk; u < 24 * MB_NB; u += G) kmean_unit(lds, WSP(bf16, WS_H), WSP(float, WS_KMEAN), WSP(float, WS_KMEAN + 512 * 1024), u, tid, wave);
                for (int u = blk; u < 512; u += G) memattn_unit2(lds, WSP(bf16, WS_H), NC, qoff, WSP(bf16, WS_KV4) + 512 * l, WSP(bf16, WS_MIX), u, tid, wave, lane);
            PH_END()
            PH_BEGIN(4)
                moba_gate_wg(lds, WSP(bf16, WS_H), WSP(float, WS_KMEAN), WSP(float, WS_KMEAN + 512 * 1024), WSP(unsigned, WS_CTL) + CW_GCOUNT + j * 1536, WSP(int, WS_SELINFO), WSP(unsigned, WS_LIST), blk, tid);
            PH_END()
            PH_BEGIN(5)
                { unsigned* qhead = WSP(unsigned, WS_CTL) + CW_GCOUNT + 2 * 1536 + 64 * j; LAS int* itl = (LAS int*)(lds + MISC_OFF + 512);
                  for (;;) { if (tid == 0) *itl = (int)__hip_atomic_fetch_add(qhead, 1u, __ATOMIC_RELAXED, __HIP_MEMORY_SCOPE_AGENT);
                      __syncthreads(); const int it = *itl; __syncthreads();
                      if (it >= 24 * MB_NB) break;
                      moba_attn_item2(lds, WSP(bf16, WS_H), WSP(unsigned, WS_CTL) + CW_GCOUNT + j * 1536, WSP(unsigned, WS_LIST), WSP(bf16, WS_PO), WSP(float, WS_PML), it, tid, wave, lane); } }
            PH_END()
            PH_BEGIN(6)
                moba_combine(WSP(bf16, WS_PO), WSP(float, WS_PML), WSP(int, WS_SELINFO), WSP(bf16, WS_MIX), gw, NGW, lane);
            PH_END()
        }
        PH_BEGIN(7)
            pg8::Gemm g{WSP(bf16, WS_MIX), WSP(bf16, WS_WO), T, D, D, 0, 0}; pg8::StaticOrder S; S.init(T, D, G, blk); pg8::EpiPlain E{WSP(bf16, WS_Y), D, 0u, 1.f};
            pg8::gemm_phase<pg8::EpiPlain, pg8::StaticOrder, true, true>(lds, g, S, E);
        PH_END()
        PH_BEGIN(8)
            phase_ln1(lds, WSP(bf16, WS_Y), ka->in[8] + l * D, ka->in[9] + l * D, WSP(bf16, WS_WRS) + (size_t)l * 2 * NE * D, ka->in[11] + l * NE, WSP(bf16, WS_XBF),
                      WSP(int, WS_TOK + TOK_E), WSP(int, WS_TOK + TOK_LR), WSP(float, WS_TOK + TOK_W), WSP(int, WS_TOK + TOK_BLKCNT), blk, tid, wave, lane);
        PH_END()
        PH_BEGIN(9)
            phase_dispatch(lds, WSP(int, WS_TOK + TOK_BLKCNT), WSP(int, WS_TOK + TOK_E), WSP(int, WS_TOK + TOK_LR), WSP(int, WS_TOK + TOK_ROW), WSP(int, WS_TOK + TOK_TAB), WSP(bf16, WS_XBF), WSP(bf16, WS_XS), blk, tid, wave, lane);
        PH_END()
        PH_BEGIN(10)
            if (tid < 33) tabL[tid] = WSP(int, WS_TOK + TOK_TAB)[tid];
            __syncthreads();
            int sw_ = 0x7A7A7A7A, sx_ = 0x7F7F7F7F; asm volatile("" : "+s"(sw_), "+s"(sx_));
            pg8::Gemm g{WSP(bf16, WS_XS), WSP(bf16, WS_WGU), MOE_MAXROWS, NE * 2048, D / 2, sw_, sx_}; pg8::MoeOrder S{tabL, 8, G, blk, tabL[32] * 8};
            pg8::EpiSwiglu E{WSP(unsigned char, WS_HID), ka->in[13] + (size_t)l * NE * 1024, ka->in[15] + (size_t)l * NE * 1024};
            pg8::gemm_phase<pg8::EpiSwiglu, pg8::MoeOrder, true, true, true>(lds, g, S, E);
        PH_END()
        PH_BEGIN(11)
            if (tid < 33) tabL[tid] = WSP(int, WS_TOK + TOK_TAB)[tid];
            __syncthreads();
            int sw_ = 0x79797979, sx_ = 0x83838383; asm volatile("" : "+s"(sw_), "+s"(sx_));
            pg8::Gemm g{WSP(bf16, WS_HID), WSP(bf16, WS_WD), MOE_MAXROWS, NE * 1024, D / 2, sw_, sx_}; pg8::MoeOrder S{tabL, 4, G, blk, tabL[32] * 4};
            pg8::EpiDown E{WSP(unsigned char, WS_XS), ka->in[17] + (size_t)l * NE * 1024};
            pg8::gemm_phase<pg8::EpiDown, pg8::MoeOrder, true, true, true>(lds, g, S, E);
        PH_END()
        PH_BEGIN(12)
            float* x2out = (l == DEPTH - 1) ? ka->out : nullptr;
            phase_ln2(WSP(unsigned char, WS_XS), WSP(int, WS_TOK + TOK_ROW), WSP(float, WS_TOK + TOK_W), ka->in[18] + l * D, ka->in[19] + l * D, x2out, WSP(bf16, WS_XBF), gw, NGW, lane);
            if (l + 1 < DEPTH) { constexpr int ln = l + 1, jn = ln >> 1; constexpr bool mn = (ln & 1) != 0;
                const float* win_src = mn ? ka->in[5] + (size_t)jn * D * NC_M : ka->in[2] + (size_t)jn * D * NC_H; const size_t moff = (size_t)ln * NE * 1024 * 1024;
                phase_weights((LAS float*)(lds + wave * 16384), gw, NGW, lane, win_src, mn ? NC_M : NC_H, ka->in[6], 0, ka->in[7] + (size_t)ln * D * D,
                              ka->in[12] + moff, ka->in[14] + moff, ka->in[16] + moff, WSP(bf16, WS_WIN), WSP(bf16, WS_WKV4), WSP(bf16, WS_WO), WSP(bf16, WS_WGU), WSP(bf16, WS_WD)); }
            if (l + 1 < DEPTH) PH_SEAM();
        PH_END_NOSEAM()
}
__global__ void __launch_bounds__(NTHR, 2) fwd_kernel(Args args) {
    extern __shared__ __attribute__((aligned(16))) unsigned char lds_raw[];
    LAS unsigned char* lds = (LAS unsigned char*)lds_raw;
    if (threadIdx.x < 4) ((LAS unsigned*)(lds + MISC_OFF))[threadIdx.x] = 0u;
    __syncthreads();
#if ONE_LAUNCH
    (void)xcd_barrier_post((unsigned*)(args.ws + WS_CTL) + CW_BAR, (volatile LAS unsigned*)(lds + MISC_OFF));
#endif
    { const int l = 0; (void)l;
    PH_BEGIN(0)
        cvt_rows_bf16(ka->in[0], WSP(bf16, WS_XBF), (size_t)T * D / 8, gtid, GTHREADS);
        cvt_rows_bf16(ka->in[1], WSP(bf16, WS_MEMBF), (size_t)512 * D / 8, gtid, GTHREADS);
        split_router_weights(ka->in[10], WSP(bf16, WS_WRS), gtid, GTHREADS);
    PH_END_NOSEAM() }
    layer_phases<0>(lds); layer_phases<1>(lds); layer_phases<2>(lds); layer_phases<3>(lds);
}

extern "C" void kernel_launch(void* const* d_in, const int* in_sizes, int n_in, void* d_out, int out_size, void* d_ws, size_t ws_size, hipStream_t stream) {
    static int ready = 0;
    if (ready == 0) {
        if (n_in != 20 || in_sizes[0] != T * D || out_size != T * D || ws_size < WS_END) { fprintf(stderr, "kernel_launch: unexpected shapes (n_in %d, in0 %d, out %d, ws %zu < %zu)\n", n_in, n_in > 0 ? in_sizes[0] : -1, out_size, ws_size, (size_t)WS_END); ready = -1; return; }
        if (hipFuncSetAttribute((const void*)fwd_kernel, hipFuncAttributeMaxDynamicSharedMemorySize, LDS_BYTES) != hipSuccess) { fprintf(stderr, "kernel_launch: hipFuncSetAttribute failed\n"); ready = -1; return; }
        int per_cu = 0;
        if (hipOccupancyMaxActiveBlocksPerMultiprocessor(&per_cu, (const void*)fwd_kernel, NTHR, LDS_BYTES) != hipSuccess || per_cu < 1) fprintf(stderr, "kernel_launch: occupancy query says %d\n", per_cu);
        (void)hipGetLastError();
        ready = 1;
    }
    if (ready < 0) return;
    if (hipMemsetAsync((char*)d_ws + WS_CTL, 0, CTL_ZERO_BYTES, stream) != hipSuccess) return;
    Args a{};
    for (int i = 0; i < 20; ++i) a.in[i] = (const float*)d_in[i];
    a.out = (float*)d_out; a.ws = (unsigned char*)d_ws;
    a.l_lo = 0; a.l_hi = DEPTH; a.ph_lo = 0; a.ph_hi = NPHASE;
    hipLaunchKernelGGL(fwd_kernel, dim3(GRID), dim3(NTHR), LDS_BYTES, stream, a);
}
```

```cpp
#include <hip/hip_runtime.h>
#include <cstdio>
#include <cstdint>
#include <cmath>
namespace pg8 {
#define PG8_LAS __attribute__((address_space(3)))
typedef unsigned short bf16_t;
typedef short bf16x8 __attribute__((ext_vector_type(8)));
typedef float f32x4 __attribute__((ext_vector_type(4)));
typedef unsigned u32x4 __attribute__((ext_vector_type(4)));
constexpr int BM = 256, BK = 64, HALF = 128, HTB = HALF * BK * 2  , STAGE_BYTES = 8 * HTB, NXCD = 8, WGM = 8;

__host__ __device__ __forceinline__ int lds_byte(int r, int c) { const int st = (r >> 4) * 2 + (c >> 5), rr = r & 15, cc = c & 31, ob = rr * 64 + cc * 2; return st * 1024 + (ob ^ (((ob >> 9) & 1) << 5)); }
__host__ __device__ __forceinline__ void stage_rc(int b, int& R, int& C) { const int st = b / 1024, sb = b % 1024, swz = sb ^ (((sb >> 9) & 1) << 5); R = (st >> 1) * 16 + swz / 64; C = (st & 1) * 32 + (swz % 64) / 2; }
__host__ __device__ __forceinline__ int perm32(int rho) { const int n = rho >> 4, i = rho & 15; return 8 * (i >> 2) + 4 * n + (i & 3); }

struct Unit { int pm, pn; };
struct Gemm { const bf16_t* A; const bf16_t* Bt; int M, N, K; int sw, sx; };
typedef int i32x8 __attribute__((ext_vector_type(8))); typedef int i32x4 __attribute__((ext_vector_type(4)));

struct StaticOrder {
    int nM, nN, nwg, G, c;
    __host__ __device__ void init(int M, int N, int G_, int c_) { nM = M / BM; nN = N / BM; nwg = nM * nN; G = G_; c = c_; }
    __host__ __device__ bool next(int i, Unit& u) const {
        const long L = (long)i * G + c; if (L >= nwg) return false;
        int wgid = (int)L; { const int q = nwg / NXCD, r = nwg % NXCD, xcd = wgid % NXCD, off = wgid / NXCD; wgid = (xcd < r ? xcd * (q + 1) : r * (q + 1) + (xcd - r) * q) + off; }
        const int nig = WGM * nN, gid = wgid / nig, fm = gid * WGM, gsz = (nM - fm) < WGM ? (nM - fm) : WGM;
        u.pm = fm + ((wgid % nig) % gsz); u.pn = (wgid % nig) / gsz; return true;
    }
    __device__ __forceinline__ void a_ready(const Unit&) const {}
    __device__ __forceinline__ void done(const Unit&) const {}
};

__device__ __forceinline__ unsigned cvt_pk_bf16(float lo, float hi) { unsigned r; asm volatile("v_cvt_pk_bf16_f32 %0, %1, %2" : "=v"(r) : "v"(lo), "v"(hi)); return r; }
typedef float f32x2 __attribute__((ext_vector_type(2)));
struct EpiPlain {
    static constexpr bool PERM = true, AFTER_DRAIN = false;
    bf16_t* O; int ldc; unsigned smask; float sc;
    struct Pre {};
    __device__ __forceinline__ void pre_load(const Unit&, int, int, Pre&) const {}
    __device__ __forceinline__ void acc_init(f32x4 (&acc)[2][2][4][2], const Pre&) const {
#pragma unroll
        for (int a = 0; a < 2; ++a)
#pragma unroll
            for (int b = 0; b < 2; ++b)
#pragma unroll
                for (int m = 0; m < 4; ++m)
#pragma unroll
                    for (int n = 0; n < 2; ++n) acc[a][b][m][n] = (f32x4){0.f, 0.f, 0.f, 0.f}; }
    __device__ __forceinline__ void operator()(const f32x4 (&acc)[2][2][4][2], const Unit& u, int wr, int wc, int fr, int fq) const {
        const int row0 = u.pm * BM + wr * 64 + fr; const int col0 = u.pn * BM + wc * 32 + 8 * fq; const float s = ((smask >> u.pn) & 1u) ? sc : 1.f;
#pragma unroll
        for (int ai = 0; ai < 2; ++ai)
#pragma unroll
            for (int m = 0; m < 4; ++m) { bf16_t* rowp = O + (size_t)(row0 + ai * HALF + m * 16) * ldc + col0;
#pragma unroll
                for (int bj = 0; bj < 2; ++bj) { const f32x4 v0 = acc[ai][bj][m][0] * s, v1 = acc[ai][bj][m][1] * s;
                    u32x4 w; w.x = cvt_pk_bf16(v0[0], v0[1]); w.y = cvt_pk_bf16(v0[2], v0[3]); w.z = cvt_pk_bf16(v1[0], v1[1]); w.w = cvt_pk_bf16(v1[2], v1[3]);
                    *(u32x4*)(rowp + bj * HALF) = w; } }
    }
};
__device__ __forceinline__ float swiglu1(float g, float u) {
    float gm; asm("v_min_f32 %0, 0x40e00000, %1" : "=v"(gm) : "v"(g));
    const float um = __builtin_amdgcn_fmed3f(u, -7.0f, 7.0f);
    const float s = __builtin_amdgcn_rcpf(1.0f + __builtin_amdgcn_exp2f(gm * (-1.702f * 1.4426950408889634f)));
    const float gs = gm * s;
    return __builtin_fmaf(gs, um, gs);
}
__device__ __forceinline__ void swiglu4(const f32x4 g, const f32x4 u, float (&o)[4]) {
    typedef float f32x2_ __attribute__((ext_vector_type(2)));
#pragma unroll
    for (int h = 0; h < 2; ++h) { f32x2_ gm, um;
        asm("v_min_f32 %0, 0x40e00000, %1" : "=v"(gm.x) : "v"(g[2 * h])); asm("v_min_f32 %0, 0x40e00000, %1" : "=v"(gm.y) : "v"(g[2 * h + 1]));
        um.x = __builtin_amdgcn_fmed3f(u[2 * h], -7.0f, 7.0f); um.y = __builtin_amdgcn_fmed3f(u[2 * h + 1], -7.0f, 7.0f);
        const f32x2_ t = gm * (-1.702f * 1.4426950408889634f);
        f32x2_ e; e.x = __builtin_amdgcn_exp2f(t.x); e.y = __builtin_amdgcn_exp2f(t.y);
        const f32x2_ d = e + 1.0f;
        f32x2_ s; s.x = __builtin_amdgcn_rcpf(d.x); s.y = __builtin_amdgcn_rcpf(d.y);
        const f32x2_ gs = gm * s; const f32x2_ r = gs * um + gs;
        o[2 * h] = r.x; o[2 * h + 1] = r.y; }
}
__device__ __forceinline__ unsigned pk4_fp8e(float a, float b, float c, float d) { int w = 0; w = __builtin_amdgcn_cvt_pk_fp8_f32(a, b, w, false); w = __builtin_amdgcn_cvt_pk_fp8_f32(c, d, w, true); return (unsigned)w; }
struct EpiSwiglu {
    static constexpr bool PERM = true, AFTER_DRAIN = false;
    unsigned char* hid; const float* bg; const float* bu;
    struct Pre { f32x4 g0, g1, u0, u1; };
    __device__ __forceinline__ void pre_load(const Unit& u, int wc, int fq, Pre& p) const { const int e = u.pn >> 3, col0 = (u.pn & 7) * 128 + wc * 32 + 8 * fq;
        p.g0 = *(const f32x4*)(bg + e * 1024 + col0); p.g1 = *(const f32x4*)(bg + e * 1024 + col0 + 4); p.u0 = *(const f32x4*)(bu + e * 1024 + col0); p.u1 = *(const f32x4*)(bu + e * 1024 + col0 + 4); }
    __device__ __forceinline__ void acc_init(f32x4 (&acc)[2][2][4][2], const Pre& p) const {
#pragma unroll
        for (int a = 0; a < 2; ++a)
#pragma unroll
            for (int m = 0; m < 4; ++m) { acc[a][0][m][0] = p.g0; acc[a][0][m][1] = p.g1; acc[a][1][m][0] = p.u0; acc[a][1][m][1] = p.u1; } }
    __device__ __forceinline__ void operator()(const f32x4 (&acc)[2][2][4][2], const Unit& u, int wr, int wc, int fr, int fq) const {
        const int pn = u.pn & 7;
        const int row0 = u.pm * BM + wr * 64 + fr; const int col0 = pn * 128 + wc * 32 + 8 * fq;
#pragma unroll
        for (int ai = 0; ai < 2; ++ai)
#pragma unroll
            for (int m = 0; m < 4; ++m) { unsigned char* rowp = hid + (size_t)(row0 + ai * HALF + m * 16) * 1024 + col0;
                const f32x4 ga = acc[ai][0][m][0], gb = acc[ai][0][m][1], ua = acc[ai][1][m][0], ub = acc[ai][1][m][1];
                typedef unsigned u32x2 __attribute__((ext_vector_type(2))); u32x2 w;
                float oa[4], ob[4]; swiglu4(ga, ua, oa); swiglu4(gb, ub, ob);
                w.x = pk4_fp8e(oa[0], oa[1], oa[2], oa[3]); w.y = pk4_fp8e(ob[0], ob[1], ob[2], ob[3]);
                *(u32x2*)rowp = w; }
    }
};
struct EpiDown {
    static constexpr bool PERM = true, AFTER_DRAIN = false;
    unsigned char* y; const float* bd;
    struct Pre { f32x4 b[2][2]; };
    __device__ __forceinline__ void pre_load(const Unit& u, int wc, int fq, Pre& p) const { const int e = u.pn >> 2, col0 = (u.pn & 3) * BM + wc * 32 + 8 * fq;
#pragma unroll
        for (int bj = 0; bj < 2; ++bj)
#pragma unroll
            for (int n = 0; n < 2; ++n) p.b[bj][n] = *(const f32x4*)(bd + e * 1024 + col0 + bj * HALF + 4 * n); }
    __device__ __forceinline__ void acc_init(f32x4 (&acc)[2][2][4][2], const Pre& p) const {
#pragma unroll
        for (int a = 0; a < 2; ++a)
#pragma unroll
            for (int bj = 0; bj < 2; ++bj)
#pragma unroll
                for (int m = 0; m < 4; ++m) { acc[a][bj][m][0] = p.b[bj][0] * 16.f; acc[a][bj][m][1] = p.b[bj][1] * 16.f; } }
    __device__ __forceinline__ void operator()(const f32x4 (&acc)[2][2][4][2], const Unit& u, int wr, int wc, int fr, int fq) const {
        const int pn = u.pn & 3;
        const int row0 = u.pm * BM + wr * 64 + fr; const int col0 = pn * BM + wc * 32 + 8 * fq;
#pragma unroll
        for (int ai = 0; ai < 2; ++ai)
#pragma unroll
            for (int m = 0; m < 4; ++m) { unsigned char* rowp = y + (size_t)(row0 + ai * HALF + m * 16) * 1024 + col0;
#pragma unroll
                for (int bj = 0; bj < 2; ++bj) { const f32x4 v0 = acc[ai][bj][m][0], v1 = acc[ai][bj][m][1];
                    typedef unsigned u32x2 __attribute__((ext_vector_type(2))); u32x2 w; w.x = pk4_fp8e(v0[0], v0[1], v0[2], v0[3]); w.y = pk4_fp8e(v1[0], v1[1], v1[2], v1[3]);
                    *(u32x2*)(rowp + bj * HALF) = w; } }
    }
};
struct MoeOrder {
    const PG8_LAS int* tab; int npn, G, c, nunits;
    __device__ __forceinline__ bool next(int i, Unit& u) const {
        const int tpx = 32 / npn, s = c >> 3, tile = (i * 8 + (c & 7)) * tpx + s / npn, pn = s % npn;
        if ((i * 8) * tpx >= nunits / npn) return false;
        if (tile >= nunits / npn) { u.pm = 0; u.pn = 0; return false; }
        int e = 0;
#pragma unroll
        for (int k = 1; k < 32; ++k) e += (tab[k] <= tile) ? 1 : 0;
        u.pm = tile; u.pn = __builtin_amdgcn_readfirstlane(e) * npn + pn; return true;
    }
    __device__ __forceinline__ void a_ready(const Unit&) const {}
    __device__ __forceinline__ void done(const Unit&) const {}
};
template <class Epi, class Sched, bool ALIGN_EPI = false, bool SP2 = false, bool F8 = false>
__device__ __forceinline__ void gemm_phase(PG8_LAS unsigned char* lds, const Gemm g, const Sched& S, const Epi& E) {
    int tid_ = threadIdx.x; asm volatile("" : "+v"(tid_));
    const int tid = tid_, wid = __builtin_amdgcn_readfirstlane(tid >> 6), lane = tid & 63, wr = wid >> 2, wc = wid & 3, fr = lane & 15, fq = lane >> 4;
    const int K = g.K, nt = K / BK;
    unsigned voffA, voffB;
    { int R, C; stage_rc(tid * 16, R, C); const int Rb = Epi::PERM ? ((R & ~31) + perm32(R & 31)) : R; voffA = (unsigned)(R * K + C) * 2u; voffB = (unsigned)(Rb * K + C) * 2u; }
    const unsigned qstep = 64u * (unsigned)K * 2u;
    const unsigned kstep = (unsigned)(BK * 2);
    const unsigned hstep = (unsigned)HALF * (unsigned)K * 2u;
    const unsigned tstep = 2u * hstep;
    const __amdgpu_buffer_rsrc_t rA = __builtin_amdgcn_make_buffer_rsrc((void*)g.A, 0, 0x7FFFFFFF, 0x00020000), rB = __builtin_amdgcn_make_buffer_rsrc((void*)g.Bt, 0, 0x7FFFFFFF, 0x00020000);
    const unsigned ldsw = (unsigned)wid * 1024u;
    const int aoff = lds_byte(wr * 64 + fr, fq * 8), boff = lds_byte(wc * 32 + fr, fq * 8);
#define PG8_SA(b, h) (((b) * 2 + (h)) * HTB)
#define PG8_SB(b, h) ((4 + (b) * 2 + (h)) * HTB)
#define PG8_STG(bufoff, rsrc, soff, voff) do { _Pragma("unroll") for (int _i = 0; _i < 2; ++_i) \
        __builtin_amdgcn_raw_ptr_buffer_load_lds((rsrc), (PG8_LAS void*)(lds + (bufoff) + ldsw + _i * 8192), 16, (int)(voff), (int)((soff) + (unsigned)_i * qstep), 0, 0); } while (0)
#define PG8_STGA(bufoff, soff) PG8_STG(bufoff, rA, soff, voffA)
#define PG8_STGB(bufoff, soff) PG8_STG(bufoff, rB, soff, voffB)
#define PG8_LDA(dst, b, h) do { _Pragma("unroll") for (int m = 0; m < 4; ++m) { if constexpr (F8) { const i32x4 lo_ = *(const PG8_LAS i32x4*)(lds + PG8_SA(b, h) + aoff + m * 2048), hi_ = *(const PG8_LAS i32x4*)(lds + PG8_SA(b, h) + aoff + m * 2048 + 1024); \
            dst##_8[m] = __builtin_shufflevector(lo_, hi_, 0, 1, 2, 3, 4, 5, 6, 7); } else { _Pragma("unroll") for (int k = 0; k < 2; ++k) dst[m][k] = *(const PG8_LAS bf16x8*)(lds + PG8_SA(b, h) + aoff + m * 2048 + k * 1024); } } } while (0)
#define PG8_LDB(dst, b, h) do { _Pragma("unroll") for (int n = 0; n < 2; ++n) { if constexpr (F8) { const i32x4 lo_ = *(const PG8_LAS i32x4*)(lds + PG8_SB(b, h) + boff + n * 2048), hi_ = *(const PG8_LAS i32x4*)(lds + PG8_SB(b, h) + boff + n * 2048 + 1024); \
            dst##_8[n] = __builtin_shufflevector(lo_, hi_, 0, 1, 2, 3, 4, 5, 6, 7); } else { _Pragma("unroll") for (int k = 0; k < 2; ++k) dst[n][k] = *(const PG8_LAS bf16x8*)(lds + PG8_SB(b, h) + boff + n * 2048 + k * 1024); } } } while (0)
#define PG8_MMA(ai, bj, At, Bt) do { __builtin_amdgcn_s_setprio(1); _Pragma("unroll") for (int m = 0; m < 4; ++m) _Pragma("unroll") for (int n = 0; n < 2; ++n) { \
        if constexpr (F8) acc[ai][bj][m][n] = __builtin_amdgcn_mfma_scale_f32_16x16x128_f8f6f4(Bt##_8[n], At##_8[m], acc[ai][bj][m][n], 0, 0, 0, g.sw, 0, g.sx); \
        else { _Pragma("unroll") for (int k = 0; k < 2; ++k) acc[ai][bj][m][n] = __builtin_amdgcn_mfma_f32_16x16x32_bf16(Bt[n][k], At[m][k], acc[ai][bj][m][n], 0, 0, 0); } } \
        __builtin_amdgcn_s_setprio(0); } while (0)
#define PG8_WAIT_V(n) asm volatile("s_waitcnt vmcnt(" #n ")" ::: "memory")
#define PG8_WAIT_L(n) asm volatile("s_waitcnt lgkmcnt(" #n ")" ::: "memory")
#define PG8_BAR __builtin_amdgcn_s_barrier()
#define PG8_SCHED __builtin_amdgcn_sched_barrier(0)
    Unit cur, nxt; int ui = 0;
    if (!S.next(0, cur)) return;
    f32x4 acc[2][2][4][2];
    typename Epi::Pre pre; E.pre_load(cur, wc, fq, pre); E.acc_init(acc, pre);
    bf16x8 At[4][2], B0[2][2], B1[2][2]; i32x8 At_8[4], B0_8[2], B1_8[2];
    unsigned cA = (unsigned)cur.pm * tstep, cB = (unsigned)cur.pn * tstep;
    S.a_ready(cur);
    if constexpr (SP2) {
        PG8_STGB(PG8_SB(0, 0), cB); PG8_STGB(PG8_SB(0, 1), cB + hstep); PG8_STGA(PG8_SA(0, 0), cA); PG8_STGA(PG8_SA(0, 1), cA + hstep);
        if (wr == 1) PG8_BAR;
        PG8_WAIT_V(2); PG8_BAR;
        PG8_STGB(PG8_SB(1, 0), cB + kstep); PG8_STGA(PG8_SA(1, 0), cA + kstep); PG8_STGB(PG8_SB(1, 1), cB + hstep + kstep);
        PG8_WAIT_V(6); PG8_BAR;
    } else {
        PG8_STGB(PG8_SB(0, 0), cB); PG8_STGA(PG8_SA(0, 0), cA); PG8_STGB(PG8_SB(0, 1), cB + hstep); PG8_STGA(PG8_SA(0, 1), cA + hstep);
        if (wr == 1) PG8_BAR;
        PG8_WAIT_V(4); PG8_BAR;
        PG8_STGB(PG8_SB(1, 0), cB + kstep); PG8_STGA(PG8_SA(1, 0), cA + kstep); PG8_STGB(PG8_SB(1, 1), cB + hstep + kstep);
        PG8_WAIT_V(6); PG8_BAR;
    }
    for (;;) {
        const bool has_next = S.next(ui + 1, nxt);
        const unsigned nA = has_next ? (unsigned)nxt.pm * tstep : cA, nB = has_next ? (unsigned)nxt.pn * tstep : cB;
#pragma unroll 1
        for (int t = 0; t < nt; t += 2) {
            const bool last = (t == nt - 2);
            const unsigned a1 = cA + (unsigned)(t + 1) * kstep;
            const unsigned a2 = last ? nA : cA + (unsigned)(t + 2) * kstep, b2 = last ? nB : cB + (unsigned)(t + 2) * kstep;
            const unsigned a3 = a2 + kstep, b3 = b2 + kstep;
            if (last && has_next) S.a_ready(nxt);
            if constexpr (SP2) {
            PG8_LDB(B0, 0, 0); PG8_LDB(B1, 0, 1); PG8_SCHED; PG8_LDA(At, 0, 0); PG8_STGA(PG8_SA(1, 1), a1 + hstep);
            PG8_WAIT_V(8); PG8_WAIT_L(0); PG8_BAR; PG8_MMA(0, 0, At, B0); PG8_MMA(0, 1, At, B1); PG8_BAR; PG8_SCHED;
            PG8_LDA(At, 0, 1); PG8_STGB(PG8_SB(0, 0), b2); PG8_STGB(PG8_SB(0, 1), b2 + hstep); PG8_STGA(PG8_SA(0, 0), a2);
            PG8_WAIT_V(8); PG8_WAIT_L(0); PG8_BAR; PG8_MMA(1, 0, At, B0); PG8_MMA(1, 1, At, B1); PG8_BAR; PG8_SCHED;
            PG8_LDB(B0, 1, 0); PG8_LDB(B1, 1, 1); PG8_SCHED; PG8_LDA(At, 1, 0); PG8_STGA(PG8_SA(0, 1), a2 + hstep);
            PG8_WAIT_V(8); PG8_WAIT_L(0); PG8_BAR; PG8_MMA(0, 0, At, B0); PG8_MMA(0, 1, At, B1); PG8_BAR; PG8_SCHED;
            PG8_LDA(At, 1, 1); PG8_STGB(PG8_SB(1, 0), b3); PG8_STGB(PG8_SB(1, 1), b3 + hstep); PG8_STGA(PG8_SA(1, 0), a3);
            PG8_WAIT_V(8); PG8_WAIT_L(0); PG8_BAR; PG8_MMA(1, 0, At, B0); PG8_MMA(1, 1, At, B1); PG8_BAR; PG8_SCHED;
            } else {
            PG8_LDB(B0, 0, 0); PG8_SCHED; PG8_LDA(At, 0, 0); PG8_STGA(PG8_SA(1, 1), a1 + hstep);
            PG8_WAIT_L(8); PG8_BAR; PG8_WAIT_L(0); PG8_MMA(0, 0, At, B0); PG8_BAR; PG8_SCHED;
            PG8_LDB(B1, 0, 1); PG8_STGB(PG8_SB(0, 0), b2);
            PG8_BAR; PG8_WAIT_L(0); PG8_MMA(0, 1, At, B1); PG8_BAR;
            PG8_LDA(At, 0, 1); PG8_STGA(PG8_SA(0, 0), a2);
            PG8_BAR; PG8_WAIT_L(0); PG8_MMA(1, 0, At, B0); PG8_BAR; PG8_SCHED;
            PG8_STGB(PG8_SB(0, 1), b2 + hstep);
            PG8_WAIT_V(6); PG8_BAR; PG8_MMA(1, 1, At, B1); PG8_BAR;
            PG8_LDB(B0, 1, 0); PG8_SCHED; PG8_LDA(At, 1, 0); PG8_STGA(PG8_SA(0, 1), a2 + hstep);
            PG8_WAIT_L(8); PG8_BAR; PG8_WAIT_L(0); PG8_MMA(0, 0, At, B0); PG8_BAR; PG8_SCHED;
            PG8_LDB(B1, 1, 1); PG8_STGB(PG8_SB(1, 0), b3);
            PG8_BAR; PG8_WAIT_L(0); PG8_MMA(0, 1, At, B1); PG8_BAR;
            PG8_LDA(At, 1, 1); PG8_STGA(PG8_SA(1, 0), a3);
            PG8_BAR; PG8_WAIT_L(0); PG8_MMA(1, 0, At, B0); PG8_BAR; PG8_SCHED;
            PG8_STGB(PG8_SB(1, 1), b3 + hstep);
            PG8_WAIT_V(6); PG8_BAR; PG8_MMA(1, 1, At, B1); PG8_BAR;
            }
        }
        if constexpr (ALIGN_EPI) { if (wr == 0) PG8_BAR; }
        if constexpr (!Epi::AFTER_DRAIN) { int t2_ = threadIdx.x; asm volatile("" : "+v"(t2_)); { const Unit pu_ = has_next ? nxt : cur; E.pre_load(pu_, wc, (t2_ & 63) >> 4, pre); }     E(acc, cur, wr, wc, t2_ & 15, (t2_ & 63) >> 4); S.done(cur); }
        if (!has_next) break;
        E.acc_init(acc, pre);
        cur = nxt; cA = nA; cB = nB; ++ui;
        if constexpr (ALIGN_EPI) { if (wr == 1) PG8_BAR; }
    }
    PG8_WAIT_V(0);
    if constexpr (!ALIGN_EPI) { if (wr == 0) PG8_BAR; }
    PG8_BAR;
    if constexpr (Epi::AFTER_DRAIN) { E.fused(acc, cur, wr, wc, fr, fq, lds, wid, lane); S.done(cur); }
#undef PG8_SA
#undef PG8_SB
#undef PG8_STG
#undef PG8_STGA
#undef PG8_STGB
#undef PG8_LDA
#undef PG8_LDB
#undef PG8_MMA
#undef PG8_WAIT_V
#undef PG8_WAIT_L
#undef PG8_BAR
#undef PG8_SCHED
}
}

constexpr int NWAVES = 8, NTHR = 512, GRID = 256;
constexpr int NBATCH = 2, SEQ = 16384, T = NBATCH * SEQ, D = 1024, DEPTH = 4;
constexpr int MIXW = 768, NC_H = 3328, NC_M = 2560;
constexpr int HG_H = 6;
constexpr int HSEG = 256, HNSEG = SEQ / HSEG;
constexpr int MB_H = 12, MB_NB = 64;
constexpr int NE = 32;
constexpr float DN_ALPHA = 1.6817928305074290f;
constexpr int MOE_MAXROWS = T * 4 + NE * 256;
#ifndef ONE_LAUNCH
#define ONE_LAUNCH 1
#endif
constexpr int NPHASE = 13;

constexpr size_t MiB = 1u << 20;
constexpr size_t WS_CTL = 0, CTL_ZERO_BYTES = 1 * MiB;
constexpr size_t WS_WIN = 1 * MiB, WS_WKV = 9 * MiB, WS_WO = 10 * MiB, WS_WGU = 12 * MiB, WS_WD = 140 * MiB;
constexpr size_t WS_XBF = 204 * MiB, WS_WKV4 = 268 * MiB  , WS_KV4 = 272 * MiB  , WS_WRS = 280 * MiB  , WS_MEMBF = 524 * MiB;
constexpr size_t WS_H = 526 * MiB, WS_MIX = 734 * MiB, WS_Y = 798 * MiB, WS_SLOC = 862 * MiB, WS_DSEG = 910 * MiB, WS_KMEAN = 911 * MiB;
constexpr size_t WS_SELINFO = 912 * MiB, WS_TOK = 914 * MiB, WS_R1 = 918 * MiB;
constexpr size_t WS_LIST = WS_R1, WS_PML = WS_R1 + 96 * MiB, WS_PO = WS_R1 + 108 * MiB;
constexpr size_t WS_XS = WS_R1, WS_HID = WS_R1 + 272 * MiB;
constexpr size_t WS_END = WS_R1 + 544 * MiB;
static_assert((size_t)MOE_MAXROWS * 1024 * 2 <= 272 * MiB, "moe rows");
static_assert((size_t)T * MB_H * 4 * 64 * 4 <= 384 * MiB && (size_t)24 * 64 * 16384 * 4 <= 96 * MiB, "moba bufs");
constexpr size_t TOK_E = 0, TOK_LR = 512 * 1024, TOK_W = 1024 * 1024, TOK_ROW = 1536 * 1024, TOK_BLKCNT = 2048 * 1024, TOK_TAB = 2048 * 1024 + 65536;
constexpr int CW_BAR = 4096, CW_GCOUNT = 8192;

constexpr int RING_BYTES = 131072, LDS_BYTES = 147456, MISC_OFF = LDS_BYTES - 1024;

#define GAS __attribute__((address_space(1)))
#define LAS __attribute__((address_space(3)))
typedef unsigned short bf16;
typedef unsigned v4u __attribute__((ext_vector_type(4)));
typedef unsigned v2u __attribute__((ext_vector_type(2)));
typedef float f32x4 __attribute__((ext_vector_type(4)));
typedef float f32x2 __attribute__((ext_vector_type(2)));
typedef short s16x8 __attribute__((ext_vector_type(8)));
typedef float f32x16 __attribute__((ext_vector_type(16)));
typedef float f32x2_t __attribute__((ext_vector_type(2))); typedef __bf16 bf16x2_t __attribute__((ext_vector_type(2)));
__device__ __forceinline__ unsigned cvtpk(float lo, float hi) { f32x2_t v = {lo, hi}; bf16x2_t b = __builtin_convertvector(v, bf16x2_t); return __builtin_bit_cast(unsigned, b); }
#define LDS_WAIT() asm volatile("s_waitcnt lgkmcnt(0)" ::: "memory")
__device__ __forceinline__ unsigned f2bf(float f) { unsigned u = __builtin_bit_cast(unsigned, f); return (u + 0x7fffu + ((u >> 16) & 1u)) >> 16; }
__device__ __forceinline__ unsigned pk2(float lo, float hi) { return f2bf(lo) | (f2bf(hi) << 16); }
__device__ __forceinline__ float bflo(unsigned w) { return __builtin_bit_cast(float, w << 16); }
__device__ __forceinline__ float bfhi(unsigned w) { return __builtin_bit_cast(float, w & 0xffff0000u); }
__device__ __forceinline__ float bf2f(bf16 h) { return __builtin_bit_cast(float, (unsigned)h << 16); }
__device__ __forceinline__ float sigmoidf_(float z) { return __builtin_amdgcn_rcpf(1.0f + __builtin_amdgcn_exp2f(-1.4426950408889634f * z)); }
template <int X> __device__ __forceinline__ float xorf(float v) { return __builtin_bit_cast(float, __builtin_amdgcn_ds_swizzle(__builtin_bit_cast(int, v), (X << 10) | 0x1F)); }
template <int X> __device__ __forceinline__ int xori(int v) { return __builtin_amdgcn_ds_swizzle(v, (X << 10) | 0x1F); }
__device__ __forceinline__ float wave_sum(float v) {
    v += xorf<1>(v); v += xorf<2>(v); v += xorf<4>(v); v += xorf<8>(v); v += xorf<16>(v);
    return __builtin_bit_cast(float, __builtin_amdgcn_readlane(__builtin_bit_cast(int, v), 0)) + __builtin_bit_cast(float, __builtin_amdgcn_readlane(__builtin_bit_cast(int, v), 32));
}
__device__ __forceinline__ float wave_max(float v) {
    v = fmaxf(v, xorf<1>(v)); v = fmaxf(v, xorf<2>(v)); v = fmaxf(v, xorf<4>(v)); v = fmaxf(v, xorf<8>(v)); v = fmaxf(v, xorf<16>(v));
    return fmaxf(__builtin_bit_cast(float, __builtin_amdgcn_readlane(__builtin_bit_cast(int, v), 0)), __builtin_bit_cast(float, __builtin_amdgcn_readlane(__builtin_bit_cast(int, v), 32)));
}
__device__ __forceinline__ float xor32f(float v, int lane) { return __builtin_bit_cast(float, __builtin_amdgcn_ds_bpermute((lane ^ 32) << 2, __builtin_bit_cast(int, v))); }
#define XB_TMO      128
#define XB_XCNT(j)  (256  + 64 * (j))
#define XB_XSUB(j)  (1280 + 64 * (j))
#define XB_XGEN(j)  (2304 + 64 * (j))
#define XB_TOP      3328
#define XB_TOPGEN   3392
#define XCD_BAR_WORDS 3456
#define XB_SPIN_CAP (1u << 18)

__device__ __forceinline__ unsigned xb_ld(unsigned* p)              { return __hip_atomic_load(p, __ATOMIC_RELAXED, __HIP_MEMORY_SCOPE_AGENT); }
__device__ __forceinline__ unsigned xb_add(unsigned* p, unsigned v) { return __hip_atomic_fetch_add(p, v, __ATOMIC_RELAXED, __HIP_MEMORY_SCOPE_AGENT); }
__device__ __forceinline__ unsigned xb_xcc_id() { return (unsigned)__builtin_amdgcn_s_getreg((3 << 11) | 20) & 0xFu; }
#define XB_SPIN(cond, bar) do { unsigned _sp = 0; while (cond) { __builtin_amdgcn_s_sleep(1); \
    if ((++_sp & 255u) == 0u) { if (xb_ld(&(bar)[XB_TMO])) break; if (_sp > XB_SPIN_CAP) { atomicAdd(&(bar)[XB_TMO], 1u); break; } } } } while (0)

struct XcdBarrier {
    unsigned* bar; unsigned x;
    volatile LAS unsigned* st;
};

__device__ __forceinline__ XcdBarrier xcd_barrier_post(unsigned* bar, volatile LAS unsigned* st) {
    XcdBarrier b; b.bar = bar; b.x = xb_xcc_id(); b.st = st;
    if (threadIdx.x == 0) (void)xb_add(&bar[XB_XCNT(b.x)], 1u);
    return b;
}
__device__ __forceinline__ void xcd_barrier_complete(unsigned* bar, unsigned x, unsigned& nloc, unsigned& nx) {
    const unsigned G = gridDim.x * gridDim.y * gridDim.z;
    unsigned sum, cnt, mine, sp = 0u;
    for (;;) {
        sum = 0u; cnt = 0u; mine = 0u;
#pragma unroll
        for (unsigned j = 0; j < 16; ++j) { const unsigned c = xb_ld(&bar[XB_XCNT(j)]); sum += c; cnt += (c > 0u) ? 1u : 0u; mine = (j == x) ? c : mine; }
        if (sum == G) break;
        __builtin_amdgcn_s_sleep(1);
        if ((++sp & 255u) == 0u) { if (xb_ld(&bar[XB_TMO])) break; if (sp > XB_SPIN_CAP) { atomicAdd(&bar[XB_TMO], 1u); break; } }
    }
    nloc = mine > 0u ? mine : 1u; nx = cnt > 0u ? cnt : 1u;
}

__device__ __forceinline__ void xcd_barrier(const XcdBarrier& b) {
    asm volatile("s_waitcnt vmcnt(0)" ::: "memory");
    __syncthreads();
    if (threadIdx.x == 0) {
        unsigned* bar = b.bar;
        __builtin_amdgcn_s_waitcnt(0);
        unsigned nloc = b.st[0], nx = b.st[1];
        if (nloc == 0u) { xcd_barrier_complete(bar, b.x, nloc, nx); b.st[0] = nloc; b.st[1] = nx; }
        const unsigned old = xb_add(&bar[XB_XSUB(b.x)], 1u);
        const unsigned gen = old / nloc;
        if (old + 1u == (gen + 1u) * nloc) {
            __builtin_amdgcn_fence(__ATOMIC_RELEASE, "agent");
            asm volatile("s_waitcnt vmcnt(0)" ::: "memory");
            const unsigned og = xb_add(&bar[XB_TOP], 1u);
            const unsigned tg = og / nx;
            if (og + 1u == (tg + 1u) * nx) xb_add(&bar[XB_TOPGEN], 1u);
            else XB_SPIN(xb_ld(&bar[XB_TOPGEN]) == tg, bar);
            __builtin_amdgcn_fence(__ATOMIC_ACQUIRE, "agent");
            xb_add(&bar[XB_XGEN(b.x)], 1u);
            asm volatile("s_waitcnt vmcnt(0)" ::: "memory");
        } else {
            XB_SPIN(xb_ld(&bar[XB_XGEN(b.x)]) == gen, bar);
            __builtin_amdgcn_fence(__ATOMIC_ACQUIRE, "agent");
            asm volatile("s_waitcnt vmcnt(0)" ::: "memory");
        }
    }
    __syncthreads();
}
__device__ __forceinline__ void cvt_rows_bf16(const float* src, bf16* dst, size_t n8, size_t gtid, size_t gthreads) {
    for (size_t i = gtid; i < n8; i += gthreads) { const f32x4 a = ((const f32x4*)src)[2 * i], b = ((const f32x4*)src)[2 * i + 1];
        v4u o; o.x = pk2(a.x, a.y); o.y = pk2(a.z, a.w); o.z = pk2(b.x, b.y); o.w = pk2(b.z, b.w); ((v4u*)dst)[i] = o; }
}
__device__ __forceinline__ void transpose_item(const float* W, int N, bf16* WT, int dst_row0, LAS float* scr, int k0, int n0, int lane) {
#pragma unroll 8
    for (int i = 0; i < 32; ++i) { const int kk = 2 * i + (lane >> 5); scr[kk * 33 + (lane & 31)] = W[(size_t)(k0 + kk) * N + n0 + (lane & 31)]; }
    LDS_WAIT(); asm volatile("" ::: "memory");
    const int c = lane & 7;
#pragma unroll
    for (int j = 0; j < 4; ++j) { const int n = (lane >> 3) + 8 * j; const LAS float* s = scr + (8 * c) * 33 + n;
        v4u o; o.x = pk2(s[0 * 33], s[1 * 33]); o.y = pk2(s[2 * 33], s[3 * 33]); o.z = pk2(s[4 * 33], s[5 * 33]); o.w = pk2(s[6 * 33], s[7 * 33]);
        *(v4u*)(WT + (size_t)(dst_row0 + n) * 1024 + k0 + 8 * c) = o; }
    LDS_WAIT(); asm volatile("" ::: "memory");
}
__device__ __forceinline__ unsigned pk4_fp8(float a, float b, float c, float d) { int w = 0; w = __builtin_amdgcn_cvt_pk_fp8_f32(a, b, w, false); w = __builtin_amdgcn_cvt_pk_fp8_f32(c, d, w, true); return (unsigned)w; }
__device__ __forceinline__ void transpose_item_f8(const float* W, int N, unsigned char* WT8, int dst_row0, LAS float* scr, int k0, int n0, int lane, float wscale) {
#pragma unroll 8
    for (int i = 0; i < 32; ++i) { const int kk = 2 * i + (lane >> 5); scr[kk * 33 + (lane & 31)] = W[(size_t)(k0 + kk) * N + n0 + (lane & 31)]; }
    LDS_WAIT(); asm volatile("" ::: "memory");
    const int c = lane & 7;
#pragma unroll
    for (int j = 0; j < 4; ++j) { const int n = (lane >> 3) + 8 * j; const LAS float* s = scr + (8 * c) * 33 + n;
        v2u o; o.x = pk4_fp8(s[0 * 33] * wscale, s[1 * 33] * wscale, s[2 * 33] * wscale, s[3 * 33] * wscale); o.y = pk4_fp8(s[4 * 33] * wscale, s[5 * 33] * wscale, s[6 * 33] * wscale, s[7 * 33] * wscale);
        *(v2u*)(WT8 + (size_t)(dst_row0 + n) * 1024 + k0 + 8 * c) = o; }
    LDS_WAIT(); asm volatile("" ::: "memory");
}
__device__ __forceinline__ void phase_weights(LAS float* scr, int gw, int ngw, int lane, const float* win_src, int NC, const float* wkv_src, int nkv, const float* wo_src,
                                              const float* wg_src, const float* wu_src, const float* wd_src, bf16* win_t, bf16* wkv_t, bf16* wo_t, bf16* wgu_t, bf16* wd_t) {
    const int nbw = NC / 32, nWin = nbw * 16, NIT = nWin + 256 * nkv + 512 + NE * 1536;
    for (int it = gw; it < NIT; it += ngw) {
        int r = it;
        if (r < nWin) { const int kb = r / nbw, nb = r - kb * nbw; transpose_item(win_src, NC, win_t, 32 * nb, scr, 64 * kb, 32 * nb, lane); continue; } r -= nWin;
        if (r < 256 * nkv) { const int lay = r >> 8, rr = r & 255, kb = rr >> 4, nb = rr & 15; transpose_item(wkv_src + (size_t)lay * D * 512, 512, wkv_t + (size_t)lay * 512 * 1024, 32 * nb, scr, 64 * kb, 32 * nb, lane); continue; } r -= 256 * nkv;
        if (r < 512) { const int kb = r >> 5, nb = r & 31; transpose_item(wo_src, 1024, wo_t, 32 * nb, scr, 64 * kb, 32 * nb, lane); continue; } r -= 512;
        const int e = r / 1536, q = r - e * 1536, which = q >> 9, rr = q & 511, kb = rr >> 5, nb = rr & 31, n0 = 32 * nb;
        const size_t eoff = (size_t)e * 1024 * 1024;
        if (which == 0) transpose_item_f8(wg_src + eoff, 1024, (unsigned char*)wgu_t + 2 * eoff, (n0 >> 7) * 256 + (n0 & 127), scr, 64 * kb, n0, lane, 32.f);
        else if (which == 1) transpose_item_f8(wu_src + eoff, 1024, (unsigned char*)wgu_t + 2 * eoff, (n0 >> 7) * 256 + 128 + (n0 & 127), scr, 64 * kb, n0, lane, 32.f);
        else transpose_item_f8(wd_src + eoff, 1024, (unsigned char*)wd_t + eoff, n0, scr, 64 * kb, n0, lane, 64.f);
    }
}

template <bool OUT>
__device__ __forceinline__ void hgrn_seg(LAS unsigned char* lds, const bf16* h, const float* lbl, int j, const float* normg, float* Sloc, float* Dseg, bf16* mix, int unit, int tid, int wave, int lane) {
    const int seg = unit & (HNSEG - 1), bh = unit >> 6, hh = bh % HG_H, b = bh / HG_H;
    const int v = tid & 127, dg = tid >> 7;
    LAS float* fgs = (LAS float*)lds; LAS float* vs = fgs + 4096; LAS float* qs = vs + 4096; LAS float* op = qs + 4096;
    f32x2 st[16];
    float* Sp = Sloc + (size_t)unit * 16384 + (size_t)(dg * 32) * 128 + v;
#pragma unroll
    for (int dd = 0; dd < 16; ++dd) { st[dd].x = OUT ? Sp[(2 * dd) * 128] : 0.f; st[dd].y = OUT ? Sp[(2 * dd + 1) * 128] : 0.f; }
    float dprod = 1.f;
    const int stok = tid >> 4, c8 = (tid & 15) * 8;
    float lb[8];
#pragma unroll
    for (int i = 0; i < 8; ++i) { lb[i] = 0.f; if (j > 0) { const float a0 = lbl[hh * 128 + c8 + i], a1 = lbl[MIXW + hh * 128 + c8 + i]; lb[i] = 1.f / (1.f + __expf(a0 - a1)); } }
    for (int ch = 0; ch < HSEG / 32; ++ch) {
        const size_t t0 = (size_t)b * SEQ + seg * HSEG + ch * 32;
        { const bf16* row = h + (t0 + stok) * NC_H + hh * 128 + c8;
          const v4u f8 = *(const v4u*)(row + 768), i8 = *(const v4u*)(row + 1536); v4u q8 = {0u, 0u, 0u, 0u}; if (OUT) q8 = *(const v4u*)row;
#pragma unroll
          for (int w = 0; w < 4; ++w) { const float f0 = bflo(f8[w]), f1 = bfhi(f8[w]); const int o = stok * 128 + c8 + 2 * w;
              fgs[o] = lb[2 * w] + (1.f - lb[2 * w]) * sigmoidf_(f0); fgs[o + 1] = lb[2 * w + 1] + (1.f - lb[2 * w + 1]) * sigmoidf_(f1);
              vs[o] = bflo(i8[w]); vs[o + 1] = bfhi(i8[w]);
              if (OUT) { const float q0 = bflo(q8[w]), q1 = bfhi(q8[w]); qs[o] = q0 * sigmoidf_(q0); qs[o + 1] = q1 * sigmoidf_(q1); } } }
        __syncthreads();
        if (!OUT) { if (tid < 128) { for (int tt = 0; tt < 32; ++tt) dprod *= fgs[tt * 128 + tid]; } }
        f32x4 fA[8], qA[8], fB[8], qB[8]; float vA, vB;
#define HG_LOAD(F, Q, V, tt_) do { V = vs[(tt_) * 128 + v]; _Pragma("unroll") for (int d4 = 0; d4 < 8; ++d4) { F[d4] = *(const LAS f32x4*)(fgs + (tt_) * 128 + dg * 32 + d4 * 4); \
            if (OUT) Q[d4] = *(const LAS f32x4*)(qs + (tt_) * 128 + dg * 32 + d4 * 4); } } while (0)
#define HG_STEP(F, Q, V, tt_) do { const f32x2 vv2 = {V, V}; f32x2 acc2 = {0.f, 0.f}; _Pragma("unroll") for (int d4 = 0; d4 < 8; ++d4) { \
            const f32x2 fa = {F[d4].x, F[d4].y}, fb = {F[d4].z, F[d4].w}; \
            st[2 * d4] = fa * (st[2 * d4] - vv2) + vv2; st[2 * d4 + 1] = fb * (st[2 * d4 + 1] - vv2) + vv2; \
            if (OUT) { const f32x2 qa = {Q[d4].x, Q[d4].y}, qb = {Q[d4].z, Q[d4].w}; acc2 = qa * st[2 * d4] + acc2; acc2 = qb * st[2 * d4 + 1] + acc2; } } \
            if (OUT) op[(dg * 32 + (tt_)) * 128 + v] = acc2.x + acc2.y; } while (0)
        HG_LOAD(fA, qA, vA, 0);
#pragma unroll 1
        for (int tt = 0; tt < 32; tt += 2) {
            HG_LOAD(fB, qB, vB, tt + 1);
            __builtin_amdgcn_sched_barrier(0);
            HG_STEP(fA, qA, vA, tt);
            __builtin_amdgcn_sched_barrier(0);
            if (tt + 2 < 32) HG_LOAD(fA, qA, vA, tt + 2);
            __builtin_amdgcn_sched_barrier(0);
            HG_STEP(fB, qB, vB, tt + 1);
            __builtin_amdgcn_sched_barrier(0);
        }
#undef HG_LOAD
#undef HG_STEP
        if (OUT) {
            __syncthreads();
#pragma unroll
            for (int k = 0; k < 4; ++k) { const int tt = wave + 8 * k; float o0 = 0.f, o1 = 0.f;
#pragma unroll
                for (int g = 0; g < 4; ++g) { o0 += op[(g * 32 + tt) * 128 + lane]; o1 += op[(g * 32 + tt) * 128 + lane + 64]; }
                const float ms = wave_sum(o0 * o0 + o1 * o1) * (1.f / 128.f), r = 1.f / sqrtf(ms + 1e-6f);
                const bf16* grow = h + (t0 + tt) * NC_H + 2304 + hh * 128; const float g0 = bf2f(grow[lane]), g1 = bf2f(grow[lane + 64]);
                bf16* mrow = mix + (t0 + tt) * 1024 + hh * 128;
                mrow[lane] = (bf16)f2bf(o0 * r * normg[lane] * sigmoidf_(g0)); mrow[lane + 64] = (bf16)f2bf(o1 * r * normg[lane + 64] * sigmoidf_(g1)); }
        }
        __syncthreads();
    }
    if (!OUT) {
#pragma unroll
        for (int dd = 0; dd < 16; ++dd) { Sp[(2 * dd) * 128] = st[dd].x; Sp[(2 * dd + 1) * 128] = st[dd].y; }
        if (tid < 128) Dseg[(size_t)unit * 128 + tid] = dprod;
    }
}
constexpr int HG_G = 0, HG_QT = 32768, HG_KT = 50176, HG_KE = 67584, HG_VT = 86016, HG_ST = 104448, HG_GM = 139264, HG_GE = 139776, HG_PART = 140288;
static_assert(HG_PART + 2048 <= MISC_OFF, "HGRN LDS map");
__device__ __forceinline__ int crow16(int i, int hf) { return (i & 3) + 8 * (i >> 2) + 4 * hf; }
template <bool OUT>
__device__ __forceinline__ void hgrn_mfma(LAS unsigned char* lds, const bf16* h, const float* lbl, int j, const float* normg, float* Sloc, float* Dseg, bf16* mix, int unit, int tid, int wave, int lane) {
    const int seg = unit & (HNSEG - 1), bh = unit >> 6, hh = bh % HG_H, b = bh / HG_H;
    const int r = lane & 31, hf = lane >> 5, tr = wave & 1, vq = wave >> 1;
    LAS float* G = (LAS float*)(lds + HG_G); LAS float* GM = (LAS float*)(lds + HG_GM); LAS float* GE = (LAS float*)(lds + HG_GE); LAS float* PART = (LAS float*)(lds + HG_PART);
    const int stok = tid >> 3, c16 = (tid & 7) * 16, sperm = (stok & ~15) | (stok & 3) | ((stok & 4) << 1) | ((stok & 8) >> 1);
    const int cd = tid & 127, cpart = tid >> 7;
    float lb[16];
#pragma unroll
    for (int e = 0; e < 16; ++e) { lb[e] = 0.f; if (j > 0) { const float a0 = lbl[hh * 128 + c16 + e], a1 = lbl[MIXW + hh * 128 + c16 + e]; lb[e] = 1.f / (1.f + __expf(a0 - a1)); } }
    f32x16 S[2];
    float* Sp = Sloc + (size_t)unit * 16384 + 32 * vq + r;
#pragma unroll
    for (int dd = 0; dd < 2; ++dd)
#pragma unroll
        for (int i = 0; i < 16; ++i) S[dd][i] = OUT ? Sp[(32 * (2 * tr + dd) + crow16(i, hf)) * 128] : 0.f;
    float gsum = 0.f;
    float ng16[16];
#pragma unroll
    for (int e = 0; e < 16; ++e) ng16[e] = OUT ? normg[c16 + e] : 0.f;
    v4u nf8[2], ni8[2], nq8[2] = {{0u, 0u, 0u, 0u}, {0u, 0u, 0u, 0u}}, ng8[2] = {{0u, 0u, 0u, 0u}, {0u, 0u, 0u, 0u}};
#define HG_RAWLOAD(t0_) do { const bf16* row_ = h + ((t0_) + stok) * NC_H + hh * 128 + c16; nf8[0] = *(const v4u*)(row_ + 768); nf8[1] = *(const v4u*)(row_ + 776); ni8[0] = *(const v4u*)(row_ + 1536); ni8[1] = *(const v4u*)(row_ + 1544); \
        if (OUT) { nq8[0] = *(const v4u*)row_; nq8[1] = *(const v4u*)(row_ + 8); ng8[0] = *(const v4u*)(row_ + 2304); ng8[1] = *(const v4u*)(row_ + 2312); } } while (0)
    HG_RAWLOAD((size_t)b * SEQ + seg * HSEG);
    for (int ch = 0; ch < HSEG / 64; ++ch) {
        const size_t t0 = (size_t)b * SEQ + seg * HSEG + ch * 64;
        float fg[16], qv[16]; v4u i8[2], g8[2];
        { const v4u f8[2] = {nf8[0], nf8[1]}; i8[0] = ni8[0]; i8[1] = ni8[1]; const v4u q8[2] = {nq8[0], nq8[1]}; g8[0] = ng8[0]; g8[1] = ng8[1];
#pragma unroll
          for (int w = 0; w < 8; ++w) { const unsigned fw = f8[w >> 2][w & 3]; const float f0 = bflo(fw), f1 = bfhi(fw);
              fg[2 * w] = lb[2 * w] + (1.f - lb[2 * w]) * sigmoidf_(f0); fg[2 * w + 1] = lb[2 * w + 1] + (1.f - lb[2 * w + 1]) * sigmoidf_(f1);
              if (OUT) { const unsigned qw = q8[w >> 2][w & 3]; const float q0 = bflo(qw), q1 = bfhi(qw); qv[2 * w] = q0 * sigmoidf_(q0); qv[2 * w + 1] = q1 * sigmoidf_(q1); } else { qv[2 * w] = 0.f; qv[2 * w + 1] = 0.f; } }
#pragma unroll
          for (int e4 = 0; e4 < 4; ++e4) { f32x4 lg; lg.x = __builtin_amdgcn_logf(fg[4 * e4]); lg.y = __builtin_amdgcn_logf(fg[4 * e4 + 1]); lg.z = __builtin_amdgcn_logf(fg[4 * e4 + 2]); lg.w = __builtin_amdgcn_logf(fg[4 * e4 + 3]);
              *(LAS f32x4*)(G + stok * 128 + c16 + 4 * e4) = lg; } }
        __syncthreads();
        { float run = 0.f;
#pragma unroll
          for (int k = 0; k < 16; ++k) run += G[(16 * cpart + k) * 128 + cd];
          PART[cpart * 128 + cd] = run; }
        __syncthreads();
        { float run = 0.f;
#pragma unroll
          for (int pp = 0; pp < 3; ++pp) run += (pp < cpart) ? PART[pp * 128 + cd] : 0.f;
#pragma unroll
          for (int k = 0; k < 16; ++k) { run += G[(16 * cpart + k) * 128 + cd]; G[(16 * cpart + k) * 128 + cd] = run; }
          if (cpart == 1) GM[cd] = run;
          if (cpart == 3) { GE[cd] = run; gsum += run; } }
        __syncthreads();
        if (OUT) {
#pragma unroll
            for (int dd = 0; dd < 2; ++dd)
#pragma unroll
                for (int g4 = 0; g4 < 4; ++g4) { const int dbase = 32 * (2 * tr + dd) + 8 * g4 + 4 * hf; const f32x4 gm = *(const LAS f32x4*)(GM + dbase);
                    v2u w; w.x = cvtpk(S[dd][4 * g4] * __builtin_amdgcn_exp2f(gm.x), S[dd][4 * g4 + 1] * __builtin_amdgcn_exp2f(gm.y)); w.y = cvtpk(S[dd][4 * g4 + 2] * __builtin_amdgcn_exp2f(gm.z), S[dd][4 * g4 + 3] * __builtin_amdgcn_exp2f(gm.w));
                    *(LAS v2u*)(lds + HG_ST + (32 * vq + r) * 272 + dbase * 2) = w; }
        }
        { unsigned qt[8], kt[8];
#pragma unroll
          for (int e4 = 0; e4 < 4; ++e4) { const f32x4 gv = *(const LAS f32x4*)(G + stok * 128 + c16 + 4 * e4), gm = *(const LAS f32x4*)(GM + c16 + 4 * e4), ge = *(const LAS f32x4*)(GE + c16 + 4 * e4);
              float ke[4];
#pragma unroll
              for (int e = 0; e < 4; ++e) { const float kk = 1.f - fg[4 * e4 + e]; ke[e] = kk * __builtin_amdgcn_exp2f(ge[e] - gv[e]);
                  if (OUT) { const float a = qv[4 * e4 + e] * __builtin_amdgcn_exp2f(gv[e] - gm[e]), c = kk * __builtin_amdgcn_exp2f(gm[e] - gv[e]);
                      if (e & 1) { qt[2 * e4 + (e >> 1)] |= f2bf(a) << 16; kt[2 * e4 + (e >> 1)] |= f2bf(c) << 16; } else { qt[2 * e4 + (e >> 1)] = f2bf(a); kt[2 * e4 + (e >> 1)] = f2bf(c); } } }
#pragma unroll
              for (int e = 0; e < 4; ++e) { const int col = c16 + 4 * e4 + e;
                  *(LAS bf16*)(lds + HG_KE + col * 144 + sperm * 2) = (bf16)f2bf(ke[e]);
                  const unsigned vw = i8[e4 >> 1][(2 * e4 + (e >> 1)) & 3]; *(LAS bf16*)(lds + HG_VT + col * 144 + sperm * 2) = (bf16)((e & 1) ? (vw >> 16) : (vw & 0xffffu)); } }
          if (OUT) { *(LAS v4u*)(lds + HG_QT + stok * 272 + c16 * 2) = (v4u){qt[0], qt[1], qt[2], qt[3]}; *(LAS v4u*)(lds + HG_QT + stok * 272 + c16 * 2 + 16) = (v4u){qt[4], qt[5], qt[6], qt[7]};
                     *(LAS v4u*)(lds + HG_KT + stok * 272 + c16 * 2) = (v4u){kt[0], kt[1], kt[2], kt[3]}; *(LAS v4u*)(lds + HG_KT + stok * 272 + c16 * 2 + 16) = (v4u){kt[4], kt[5], kt[6], kt[7]}; } }
        __syncthreads();
        if (ch + 1 < HSEG / 64) HG_RAWLOAD(t0 + 64);
        if (OUT) {
            f32x16 X0, X1, O;
#pragma unroll
            for (int i = 0; i < 16; ++i) { X0[i] = 0.f; X1[i] = 0.f; O[i] = 0.f; }
            const LAS unsigned char* qtp = lds + HG_QT + (32 * tr + r) * 272 + hf * 16;
#pragma unroll
            for (int ks = 0; ks < 8; ++ks) { const s16x8 bq = *(const LAS s16x8*)(qtp + ks * 32);
                const s16x8 a0 = *(const LAS s16x8*)(lds + HG_KT + r * 272 + hf * 16 + ks * 32); X0 = __builtin_amdgcn_mfma_f32_32x32x16_bf16(a0, bq, X0, 0, 0, 0);
                if (tr == 1) { const s16x8 a1 = *(const LAS s16x8*)(lds + HG_KT + (32 + r) * 272 + hf * 16 + ks * 32); X1 = __builtin_amdgcn_mfma_f32_32x32x16_bf16(a1, bq, X1, 0, 0, 0); } }
#pragma unroll
            for (int i = 0; i < 16; ++i) { const bool keep = crow16(i, hf) <= r; if (tr == 0) X0[i] = keep ? X0[i] : 0.f; else X1[i] = keep ? X1[i] : 0.f; }
            const LAS unsigned char* vtp = lds + HG_VT + (32 * vq + r) * 144 + hf * 16;
#pragma unroll
            for (int s2 = 0; s2 < 2; ++s2) { v4u pw; pw.x = cvtpk(X0[8 * s2], X0[8 * s2 + 1]); pw.y = cvtpk(X0[8 * s2 + 2], X0[8 * s2 + 3]); pw.z = cvtpk(X0[8 * s2 + 4], X0[8 * s2 + 5]); pw.w = cvtpk(X0[8 * s2 + 6], X0[8 * s2 + 7]);
                const s16x8 bv = *(const LAS s16x8*)(vtp + (16 * s2) * 2); O = __builtin_amdgcn_mfma_f32_32x32x16_bf16(__builtin_bit_cast(s16x8, pw), bv, O, 0, 0, 0); }
            if (tr == 1) {
#pragma unroll
                for (int s2 = 0; s2 < 2; ++s2) { v4u pw; pw.x = cvtpk(X1[8 * s2], X1[8 * s2 + 1]); pw.y = cvtpk(X1[8 * s2 + 2], X1[8 * s2 + 3]); pw.z = cvtpk(X1[8 * s2 + 4], X1[8 * s2 + 5]); pw.w = cvtpk(X1[8 * s2 + 6], X1[8 * s2 + 7]);
                    const s16x8 bv = *(const LAS s16x8*)(vtp + (32 + 16 * s2) * 2); O = __builtin_amdgcn_mfma_f32_32x32x16_bf16(__builtin_bit_cast(s16x8, pw), bv, O, 0, 0, 0); } }
            const LAS unsigned char* stp = lds + HG_ST + (32 * vq + r) * 272 + hf * 16;
#pragma unroll
            for (int ks = 0; ks < 8; ++ks) { const s16x8 aq = *(const LAS s16x8*)(qtp + ks * 32), bs = *(const LAS s16x8*)(stp + ks * 32); O = __builtin_amdgcn_mfma_f32_32x32x16_bf16(aq, bs, O, 0, 0, 0); }
#pragma unroll
            for (int i = 0; i < 16; ++i) G[(32 * tr + crow16(i, hf)) * 128 + 32 * vq + r] = O[i];
        }
#pragma unroll
        for (int dd = 0; dd < 2; ++dd) { const int dr = 2 * tr + dd;
#pragma unroll
            for (int g4 = 0; g4 < 4; ++g4) { const f32x4 ge = *(const LAS f32x4*)(GE + 32 * dr + 8 * g4 + 4 * hf);
                S[dd][4 * g4] *= __builtin_amdgcn_exp2f(ge.x); S[dd][4 * g4 + 1] *= __builtin_amdgcn_exp2f(ge.y); S[dd][4 * g4 + 2] *= __builtin_amdgcn_exp2f(ge.z); S[dd][4 * g4 + 3] *= __builtin_amdgcn_exp2f(ge.w); }
#pragma unroll
            for (int ks = 0; ks < 4; ++ks) { const s16x8 a = *(const LAS s16x8*)(lds + HG_KE + (32 * dr + r) * 144 + hf * 16 + ks * 32), bv = *(const LAS s16x8*)(lds + HG_VT + (32 * vq + r) * 144 + hf * 16 + ks * 32);
                S[dd] = __builtin_amdgcn_mfma_f32_32x32x16_bf16(a, bv, S[dd], 0, 0, 0); } }
        __syncthreads();
        if (OUT) {
            float ov[16]; float ss = 0.f;
#pragma unroll
            for (int e4 = 0; e4 < 4; ++e4) { const f32x4 o4 = *(const LAS f32x4*)(G + stok * 128 + c16 + 4 * e4); ov[4 * e4] = o4.x; ov[4 * e4 + 1] = o4.y; ov[4 * e4 + 2] = o4.z; ov[4 * e4 + 3] = o4.w;
                ss += (o4.x * o4.x + o4.y * o4.y) + (o4.z * o4.z + o4.w * o4.w); }
            ss += xorf<1>(ss); ss += xorf<2>(ss); ss += xorf<4>(ss);
            const float rr = 1.f / sqrtf(ss * (1.f / 128.f) + 1e-6f);
            unsigned ow[8];
#pragma unroll
            for (int w = 0; w < 8; ++w) { const unsigned gw_ = g8[w >> 2][w & 3]; ow[w] = cvtpk(ov[2 * w] * rr * ng16[2 * w] * sigmoidf_(bflo(gw_)), ov[2 * w + 1] * rr * ng16[2 * w + 1] * sigmoidf_(bfhi(gw_))); }
            bf16* mrow = mix + (t0 + stok) * 1024 + hh * 128 + c16;
            *(v4u*)mrow = (v4u){ow[0], ow[1], ow[2], ow[3]}; *(v4u*)(mrow + 8) = (v4u){ow[4], ow[5], ow[6], ow[7]};
            __syncthreads();
        }
    }
#undef HG_RAWLOAD
    if (!OUT) {
#pragma unroll
        for (int dd = 0; dd < 2; ++dd)
#pragma unroll
            for (int i = 0; i < 16; ++i) Sp[(32 * (2 * tr + dd) + crow16(i, hf)) * 128] = S[dd][i];
        if (cpart == 3) Dseg[(size_t)unit * 128 + cd] = __builtin_amdgcn_exp2f(gsum);
    }
}
__device__ __forceinline__ void hgrn_scan(float* Sloc, const float* Dseg, size_t gtid, size_t gthreads) {
    for (size_t idx = gtid; idx < (size_t)NBATCH * HG_H * 16384; idx += gthreads) { const int bh = (int)(idx >> 14), e = (int)(idx & 16383), d = e >> 7; float cur = 0.f;
        float* __restrict__ sp = Sloc + (size_t)bh * HNSEG * 16384 + e; const float* __restrict__ dp = Dseg + (size_t)bh * HNSEG * 128 + d;
        for (int s0 = 0; s0 < HNSEG; s0 += 16) { float tv[16], dv[16];
#pragma unroll
            for (int k = 0; k < 16; ++k) { tv[k] = sp[(size_t)(s0 + k) * 16384]; dv[k] = dp[(s0 + k) * 128]; }
#pragma unroll
            for (int k = 0; k < 16; ++k) { sp[(size_t)(s0 + k) * 16384] = cur; cur = dv[k] * cur + tv[k]; } } }
}

template <bool MASK>
__device__ __forceinline__ void attn4(const LAS unsigned* Ks, const LAS bf16* Vs, const LAS float* qst, LAS float* pb, int lane, const int (&tq)[4], int kbase, float slope,
                                      float (&mo)[4], float (&lo)[4], float (&oo)[4]) {
    float sc[4][4];
#pragma unroll
    for (int a = 0; a < 4; ++a)
#pragma unroll
        for (int c = 0; c < 4; ++c) sc[a][c] = 0.f;
#pragma unroll 4
    for (int dd = 0; dd < 32; ++dd) {
        f32x2 qv[4];
#pragma unroll
        for (int qi = 0; qi < 4; ++qi) qv[qi] = *(const LAS f32x2*)(qst + qi * 64 + 2 * dd);
#pragma unroll
        for (int kk = 0; kk < 4; ++kk) { const unsigned kw = Ks[(lane + 64 * kk) * 33 + dd]; const float k0 = bflo(kw), k1 = bfhi(kw);
#pragma unroll
            for (int qi = 0; qi < 4; ++qi) sc[qi][kk] += qv[qi].x * k0 + qv[qi].y * k1; }
    }
#pragma unroll
    for (int qi = 0; qi < 4; ++qi) { float mx = -INFINITY;
#pragma unroll
        for (int kk = 0; kk < 4; ++kk) { const int pos = kbase + lane + 64 * kk; float lg = sc[qi][kk] * 0.125f - slope * (float)(tq[qi] - pos); if (MASK && pos > tq[qi]) lg = -INFINITY; sc[qi][kk] = lg; mx = fmaxf(mx, lg); }
        mx = wave_max(mx); float s = 0.f;
#pragma unroll
        for (int kk = 0; kk < 4; ++kk) { const float p = __builtin_amdgcn_exp2f((sc[qi][kk] - mx) * 1.4426950408889634f); pb[qi * 256 + lane + 64 * kk] = p; s += p; }
        lo[qi] = wave_sum(s); mo[qi] = mx; }
    float o[4] = {0.f, 0.f, 0.f, 0.f};
#pragma unroll 4
    for (int k4 = 0; k4 < 64; ++k4) { f32x4 p4[4];
#pragma unroll
        for (int qi = 0; qi < 4; ++qi) p4[qi] = *(const LAS f32x4*)(pb + qi * 256 + 4 * k4);
#pragma unroll
        for (int jj = 0; jj < 4; ++jj) { const float vv = bf2f(Vs[(4 * k4 + jj) * 64 + lane]);
#pragma unroll
            for (int qi = 0; qi < 4; ++qi) o[qi] += p4[qi][jj] * vv; } }
#pragma unroll
    for (int qi = 0; qi < 4; ++qi) oo[qi] = o[qi];
}
constexpr int AT_KS = 0, AT_VS = 33792, AT_WV = 66560, AT_WVB = 5120;

__device__ __forceinline__ void memattn_unit(LAS unsigned char* lds, const bf16* h, int NC, int qoff, const bf16* kv, bf16* mix, int unit, int tid, int wave, int lane) {
    const int chunk = unit & 31, bm = unit >> 5, mh = bm & 3, b = bm >> 2;
    LAS unsigned* Ks = (LAS unsigned*)(lds + AT_KS); LAS unsigned* Vs32 = (LAS unsigned*)(lds + AT_VS);
    LAS float* qst = (LAS float*)(lds + AT_WV + wave * AT_WVB); LAS float* pb = qst + 256;
    for (int i = 0; i < 16; ++i) { const int idx = tid + 512 * i, r = idx >> 5, dd = idx & 31; const unsigned* src = (const unsigned*)(kv + (size_t)(b * 256 + r) * 512 + mh * 64);
        Ks[r * 33 + dd] = src[dd]; Vs32[r * 32 + dd] = src[128 + dd]; }
    __syncthreads();
    for (int qd = 0; qd < 16; ++qd) { const size_t tg = (size_t)b * SEQ + chunk * 512 + wave * 64 + qd * 4;
#pragma unroll
        for (int qi = 0; qi < 4; ++qi) qst[qi * 64 + lane] = bf2f(h[(tg + qi) * NC + qoff + mh * 64 + lane]);
        const int tq[4] = {0, 0, 0, 0}; float m[4], l[4], o[4];
        attn4<false>(Ks, (const LAS bf16*)Vs32, qst, pb, lane, tq, 0, 0.f, m, l, o);
#pragma unroll
        for (int qi = 0; qi < 4; ++qi) mix[(tg + qi) * 1024 + MIXW + mh * 64 + lane] = (bf16)f2bf(o[qi] / l[qi]); }
    __syncthreads();
}

constexpr int AT2_K = 0, AT2_KROW = 176, AT2_V = 256 * AT2_KROW, AT2_VROW = 528, AT2_SCR = AT2_V + 64 * AT2_VROW, AT2_SCRW = 4864;
__device__ __forceinline__ void stage_kv_images(LAS unsigned char* lds, const bf16* kp, const bf16* vp, size_t row_stride, int tid) {
    v4u kx[4], vx[4];
#pragma unroll
    for (int i = 0; i < 4; ++i) { const int idx = tid + 512 * i, key = idx >> 3, c = idx & 7; kx[i] = *(const v4u*)(kp + (size_t)key * row_stride + 8 * c); vx[i] = *(const v4u*)(vp + (size_t)key * row_stride + 8 * c); }
    __builtin_amdgcn_sched_barrier(0);
#pragma unroll
    for (int i = 0; i < 4; ++i) { const int idx = tid + 512 * i, key = idx >> 3, c = idx & 7;
        *(LAS v4u*)(lds + AT2_K + key * AT2_KROW + c * 16) = kx[i];
        const int pos = (key & ~15) | (key & 3) | ((key & 4) << 1) | ((key & 8) >> 1);
        LAS bf16* vt = (LAS bf16*)(lds + AT2_V) + pos;
#pragma unroll
        for (int w = 0; w < 4; ++w) { vt[(8 * c + 2 * w) * (AT2_VROW / 2)] = (bf16)(vx[i][w] & 0xffffu); vt[(8 * c + 2 * w + 1) * (AT2_VROW / 2)] = (bf16)(vx[i][w] >> 16); } }
    if (tid < 256) { const unsigned pb = f2bf((float)tid); const v4u e0 = {pb | (pb << 16), 0x3F803F80u, 0u, 0u}, z = {0u, 0u, 0u, 0u};
        *(LAS v4u*)(lds + AT2_K + tid * AT2_KROW + 128) = e0; *(LAS v4u*)(lds + AT2_K + tid * AT2_KROW + 144) = z; }
}
template <bool MASK>
__device__ __forceinline__ void attn_tile32(const LAS unsigned char* lds, const s16x8 (&qf)[4], int lane, float dist0, unsigned qx, unsigned qx2, bool own, f32x16 (&o)[2], float& mrow, float& lrow) {
    const int r = lane & 31, hf = lane >> 5;
    const v4u qxv = {qx, qx2, 0u, 0u}; const s16x8 qe = __builtin_bit_cast(s16x8, qxv);
    f32x16 acc[8];
    const LAS unsigned char* kb = lds + AT2_K + r * AT2_KROW + hf * 16;
    constexpr int NKS = MASK ? 5 : 4;
    s16x8 kf[NKS];
#pragma unroll
    for (int s = 0; s < NKS; ++s) kf[s] = *(const LAS s16x8*)(kb + s * 32);
#pragma unroll
    for (int kt = 0; kt < 8; ++kt) {
#pragma unroll
        for (int i = 0; i < 16; ++i) acc[kt][i] = 0.f;
#pragma unroll
        for (int s = 0; s < NKS; ++s) { acc[kt] = __builtin_amdgcn_mfma_f32_32x32x16_bf16(kf[s], s < 4 ? qf[s < 4 ? s : 0] : qe, acc[kt], 0, 0, 0);
            if (kt + 1 < 8) kf[s] = *(const LAS s16x8*)(kb + (kt + 1) * 32 * AT2_KROW + s * 32); }
        __builtin_amdgcn_sched_barrier(0); }
    float mx = -INFINITY;
    if (MASK) { mx = 0.f;
        if (own) { const float base2 = dist0 - 4.f * (float)hf;
#pragma unroll
            for (int kt = 0; kt < 8; ++kt)
#pragma unroll
                for (int i = 0; i < 16; ++i) { const float dist = base2 - (float)(32 * kt + (i & 3) + 8 * (i >> 2)); acc[kt][i] = dist < 0.f ? -INFINITY : acc[kt][i]; } }
    } else {
#pragma unroll
        for (int kt = 0; kt < 8; ++kt)
#pragma unroll
            for (int i = 0; i < 16; ++i) mx = fmaxf(mx, acc[kt][i]);
        mx = fmaxf(mx, xor32f(mx, lane));
    }
    f32x2 sum2 = {0.f, 0.f};
#pragma unroll
    for (int i = 0; i < 16; ++i) { o[0][i] = 0.f; o[1][i] = 0.f; }
    const LAS unsigned char* vb = lds + AT2_V + r * AT2_VROW + hf * 16;
    s16x8 vf[4];
#pragma unroll
    for (int s2 = 0; s2 < 2; ++s2)
#pragma unroll
        for (int dt = 0; dt < 2; ++dt) vf[2 * s2 + dt] = *(const LAS s16x8*)(vb + dt * 32 * AT2_VROW + (16 * s2) * 2);
#pragma unroll
    for (int kt = 0; kt < 8; ++kt) {
#pragma unroll
        for (int i = 0; i < 16; ++i) acc[kt][i] = __builtin_amdgcn_exp2f(MASK ? acc[kt][i] : acc[kt][i] - mx);
#pragma unroll
        for (int i = 0; i < 8; ++i) sum2 += (f32x2){acc[kt][2 * i], acc[kt][2 * i + 1]};
#pragma unroll
        for (int s2 = 0; s2 < 2; ++s2) { v4u pw; pw.x = cvtpk(acc[kt][8 * s2], acc[kt][8 * s2 + 1]); pw.y = cvtpk(acc[kt][8 * s2 + 2], acc[kt][8 * s2 + 3]);
            pw.z = cvtpk(acc[kt][8 * s2 + 4], acc[kt][8 * s2 + 5]); pw.w = cvtpk(acc[kt][8 * s2 + 6], acc[kt][8 * s2 + 7]); const s16x8 pf = __builtin_bit_cast(s16x8, pw);
#pragma unroll
            for (int dt = 0; dt < 2; ++dt) { o[dt] = __builtin_amdgcn_mfma_f32_32x32x16_bf16(vf[2 * s2 + dt], pf, o[dt], 0, 0, 0);
                if (kt + 1 < 8) vf[2 * s2 + dt] = *(const LAS s16x8*)(vb + dt * 32 * AT2_VROW + (32 * (kt + 1) + 16 * s2) * 2); } }
        __builtin_amdgcn_sched_barrier(0); }
    float sum = sum2.x + sum2.y; sum += xor32f(sum, lane);
    if (!MASK) mrow = mx;
    lrow = sum;
}
__device__ __forceinline__ void memattn_unit2(LAS unsigned char* lds, const bf16* h, int NC, int qoff, const bf16* kv  , bf16* mix, int unit, int tid, int wave, int lane) {
    const int chunk = unit & 63, bm = unit >> 6, mh = bm & 3, b = bm >> 2, r = lane & 31, hf = lane >> 5;
    const bf16* kvrow0 = kv + (size_t)(b * 256) * 2048 + mh * 64;
    stage_kv_images(lds, kvrow0, kvrow0 + 256, 2048, tid);
    __syncthreads();
    { const size_t tg = (size_t)b * SEQ + chunk * 256 + wave * 32 + r;
        f32x16 o[2]; float m2, l; s16x8 qf[4];
#pragma unroll
        for (int s = 0; s < 4; ++s) qf[s] = *(const s16x8*)(h + tg * NC + qoff + mh * 64 + 16 * s + 8 * hf);
        attn_tile32<false>(lds, qf, lane, 0.f, 0u, 0u, false, o, m2, l);
        const float inv = 1.f / l; bf16* mp = mix + tg * 1024 + MIXW + mh * 64 + 4 * hf;
#pragma unroll
        for (int dt = 0; dt < 2; ++dt)
#pragma unroll
            for (int g = 0; g < 4; ++g) { v2u w; w.x = cvtpk(o[dt][4 * g] * inv, o[dt][4 * g + 1] * inv); w.y = cvtpk(o[dt][4 * g + 2] * inv, o[dt][4 * g + 3] * inv); *(v2u*)(mp + 32 * dt + 8 * g) = w; } }
    __syncthreads();
}
__device__ __forceinline__ void kmean_unit(LAS unsigned char* lds, const bf16* h, float* kmean, float* kmaxg, int unit, int tid, int wave) {
    const int n = unit & 63, bh = unit >> 6, hh = bh % MB_H, b = bh / MB_H, d = tid & 63, part = tid >> 6;
    LAS float* red = (LAS float*)lds;
    float s = 0.f; const bf16* p = h + ((size_t)b * SEQ + n * 256 + part * 32) * NC_M + 768 + hh * 64 + d;
    for (int i = 0; i < 32; ++i) s += bf2f(p[(size_t)i * NC_M]);
    float ss = 0.f; { const v4u* kp = (const v4u*)(h + ((size_t)b * SEQ + n * 256 + (tid >> 1)) * NC_M + 768 + hh * 64 + (tid & 1) * 32);
#pragma unroll
        for (int w = 0; w < 4; ++w) { const v4u x = kp[w]; ss += bflo(x.x) * bflo(x.x) + bfhi(x.x) * bfhi(x.x) + bflo(x.y) * bflo(x.y) + bfhi(x.y) * bfhi(x.y) + bflo(x.z) * bflo(x.z) + bfhi(x.z) * bfhi(x.z) + bflo(x.w) * bflo(x.w) + bfhi(x.w) * bfhi(x.w); } }
    ss += xorf<1>(ss); ss = wave_max(ss);
    red[part * 64 + d] = s; if ((tid & 63) == 0) red[512 + wave] = ss; __syncthreads();
    if (tid < 64) { float a = 0.f; for (int pp = 0; pp < 8; ++pp) a += red[pp * 64 + tid]; a *= (1.f / 256.f);
        const unsigned hi = f2bf(a), lo = f2bf(a - __builtin_bit_cast(float, hi << 16)); bf16* kmh = (bf16*)kmean; kmh[((size_t)bh * 64 + n) * 64 + tid] = (bf16)hi; kmh[(size_t)24 * 4096 + ((size_t)bh * 64 + n) * 64 + tid] = (bf16)lo; }
    if (tid == 0) { float mx = 0.f; for (int w = 0; w < 8; ++w) mx = fmaxf(mx, red[512 + w]); kmaxg[bh * 64 + n] = sqrtf(mx) * 1.001f; }
    __syncthreads();
}
__device__ __forceinline__ void gate_unit_core(const s16x8 (&qf)[4], const s16x8 (&kf)[4], const bf16* kmh, const bf16* kml, LAS int* hist, const LAS float* kmx, int* selinfo, int bh, int c, int t, int lane, unsigned& sel, unsigned& rr) {
    const int hh = bh % MB_H, b = bh / MB_H, hf = lane >> 5, r = lane & 31;
    int s0 = 0, s1 = 0, s2 = 0, r0 = 0, r1 = 0, r2 = 0, ns = 0;
    float v0 = -INFINITY, v1 = -INFINITY, v2 = -INFINITY, qn = 0.f, lown = 0.f;
    if (c > 0) {
        const int ntile = (c + 31) >> 5, ch = c - 4 * hf;
        s16x8 ah[2][4], al[2][4];
#pragma unroll
        for (int tile = 0; tile < 2; ++tile) if (tile < ntile) { const size_t ko = ((size_t)bh * 64 + 32 * tile + r) * 64 + 8 * hf;
#pragma unroll
            for (int ks = 0; ks < 4; ++ks) { ah[tile][ks] = *(const s16x8*)(kmh + ko + 16 * ks); al[tile][ks] = *(const s16x8*)(kml + ko + 16 * ks); } }
#pragma unroll
        for (int tile = 0; tile < 2; ++tile) if (tile < ntile) {
            f32x16 X;
#pragma unroll
            for (int i = 0; i < 16; ++i) X[i] = 0.f;
#pragma unroll
            for (int ks = 0; ks < 4; ++ks) { X = __builtin_amdgcn_mfma_f32_32x32x16_bf16(ah[tile][ks], qf[ks], X, 0, 0, 0); X = __builtin_amdgcn_mfma_f32_32x32x16_bf16(al[tile][ks], qf[ks], X, 0, 0, 0); }
#pragma unroll
            for (int i = 0; i < 16; ++i) { const int n = 32 * tile + (i & 3) + 8 * (i >> 2); const float g = (n < ch) ? X[i] : -INFINITY;
                if (g > v0) { v2 = v1; s2 = s1; v1 = v0; s1 = s0; v0 = g; s0 = n; } else if (g > v1) { v2 = v1; s2 = s1; v1 = g; s1 = n; } else if (g > v2) { v2 = g; s2 = n; } }
        }
        s0 += 4 * hf; s1 += 4 * hf; s2 += 4 * hf;
        { float qq = 0.f, qk = 0.f;
#pragma unroll
          for (int s = 0; s < 4; ++s)
#pragma unroll
              for (int jj = 0; jj < 8; ++jj) { const float qv = bf2f((bf16)qf[s][jj]), kv = bf2f((bf16)kf[s][jj]); qq += qv * qv; qk += qv * kv; }
          qq += xor32f(qq, lane); qk += xor32f(qk, lane);
          qn = sqrtf(qq) * 1.001f; lown = qk; }
        { float pv[3]; int ps[3]; const int pl = (lane ^ 32) << 2;
          pv[0] = __builtin_bit_cast(float, __builtin_amdgcn_ds_bpermute(pl, __builtin_bit_cast(int, v0))); pv[1] = __builtin_bit_cast(float, __builtin_amdgcn_ds_bpermute(pl, __builtin_bit_cast(int, v1)));
          pv[2] = __builtin_bit_cast(float, __builtin_amdgcn_ds_bpermute(pl, __builtin_bit_cast(int, v2)));
          ps[0] = __builtin_amdgcn_ds_bpermute(pl, s0); ps[1] = __builtin_amdgcn_ds_bpermute(pl, s1); ps[2] = __builtin_amdgcn_ds_bpermute(pl, s2);
#pragma unroll
          for (int k = 0; k < 3; ++k) { const float g = pv[k]; const int n = ps[k];
              if (g > v0 || (g == v0 && n < s0)) { v2 = v1; s2 = s1; v1 = v0; s1 = s0; v0 = g; s0 = n; } else if (g > v1 || (g == v1 && n < s1)) { v2 = v1; s2 = s1; v1 = g; s1 = n; } else if (g > v2 || (g == v2 && n < s2)) { v2 = g; s2 = n; } } }
    }
    sel = 0u; rr = 0u;
    if (hf == 0) {
        ns = c < 3 ? c : 3; s0 &= 63; s1 &= 63; s2 &= 63;
        { const float slope2 = (hh < 8 ? ldexpf(1.0f, -(hh + 1)) : ldexpf(0.70710678118654752f, -(hh - 8))) * 1.4426950408889634f;
          const bool k0 = ns > 0 && (qn * kmx[s0] - slope2 * (float)(t - (s0 * 256 + 255)) - lown) > -64.f;
          const bool k1 = ns > 1 && (qn * kmx[s1] - slope2 * (float)(t - (s1 * 256 + 255)) - lown) > -64.f;
          const bool k2 = ns > 2 && (qn * kmx[s2] - slope2 * (float)(t - (s2 * 256 + 255)) - lown) > -64.f;
          ns = (k0 ? 1 : 0) | (k1 ? 2 : 0) | (k2 ? 4 : 0); }
        if (ns & 1) r0 = __hip_atomic_fetch_add(hist + s0, 1, __ATOMIC_RELAXED, __HIP_MEMORY_SCOPE_WORKGROUP);
        if (ns & 2) r1 = __hip_atomic_fetch_add(hist + s1, 1, __ATOMIC_RELAXED, __HIP_MEMORY_SCOPE_WORKGROUP);
        if (ns & 4) r2 = __hip_atomic_fetch_add(hist + s2, 1, __ATOMIC_RELAXED, __HIP_MEMORY_SCOPE_WORKGROUP);
        selinfo[((size_t)b * SEQ + t) * MB_H + hh] = ns;
        sel = (unsigned)s0 | ((unsigned)s1 << 6) | ((unsigned)s2 << 12) | ((unsigned)ns << 18); rr = (unsigned)r0 | ((unsigned)r1 << 8) | ((unsigned)r2 << 16);
    }
}
__device__ __forceinline__ void moba_gate_wg(LAS unsigned char* lds, const bf16* h, const float* kmean, const float* kmaxg, unsigned* gcount, int* selinfo, unsigned* list, int blk, int tid) {
    constexpr int NU = 24 * MB_NB / GRID;
    static_assert(NU * GRID == 24 * MB_NB && GRID % 64 == 0 && NU * 64 <= NTHR, "gate deal");
    const int lane = tid & 63, r = lane & 31, hf = lane >> 5, wv = tid >> 6;
    const bf16* kmh = (const bf16*)kmean; const bf16* kml = kmh + (size_t)24 * 4096;
    LAS int* hist = (LAS int*)(lds + 16384); LAS int* base = hist + NU * 64; LAS float* kmx = (LAS float*)(base + NU * 64);
    if (tid < NU * 64) { const int bh = (blk >> 6) + 4 * (tid >> 6); hist[tid] = 0; kmx[tid] = kmaxg[bh * 64 + (tid & 63)]; }
    unsigned sel[NU], rr[NU];
    s16x8 qf[4], kf[4];
#define GU_BH(k) ((blk >> 6) + 4 * (k))
#define GU_C(k) (((k) & 1) ? 63 - (blk & 63) : (blk & 63))
#define GU_T(k) (GU_C(k) * 256 + wv * 32 + r)
    { const bf16* qp = h + ((size_t)(GU_BH(0) / MB_H) * SEQ + GU_T(0)) * NC_M + (GU_BH(0) % MB_H) * 64 + 8 * hf;
#pragma unroll
      for (int s = 0; s < 4; ++s) { qf[s] = *(const s16x8*)(qp + 16 * s); kf[s] = *(const s16x8*)(qp + 768 + 16 * s); } }
    __syncthreads();
#pragma unroll
    for (int k = 0; k < NU; ++k) {
        s16x8 qn_[4], kn_[4];
        if (k + 1 < NU) { const bf16* qp = h + ((size_t)(GU_BH(k + 1) / MB_H) * SEQ + GU_T(k + 1)) * NC_M + (GU_BH(k + 1) % MB_H) * 64 + 8 * hf;
#pragma unroll
            for (int s = 0; s < 4; ++s) { qn_[s] = *(const s16x8*)(qp + 16 * s); kn_[s] = *(const s16x8*)(qp + 768 + 16 * s); } }
        gate_unit_core(qf, kf, kmh, kml, hist + k * 64, kmx + k * 64, selinfo, GU_BH(k), GU_C(k), GU_T(k), lane, sel[k], rr[k]);
        if (k + 1 < NU) {
#pragma unroll
            for (int s = 0; s < 4; ++s) { qf[s] = qn_[s]; kf[s] = kn_[s]; } }
    }
    __syncthreads();
    if (tid < NU * 64) { const int hc = hist[tid]; if (hc > 0) base[tid] = (int)__hip_atomic_fetch_add(gcount + GU_BH(tid >> 6) * 64 + (tid & 63), (unsigned)hc, __ATOMIC_RELAXED, __HIP_MEMORY_SCOPE_AGENT); }
    __syncthreads();
    if (hf == 0) {
#pragma unroll
        for (int k = 0; k < NU; ++k) { unsigned* lp = list + ((size_t)GU_BH(k) * 64 << 14); const unsigned sl = sel[k], rk = rr[k], t = (unsigned)GU_T(k); const int s0 = sl & 63, s1 = (sl >> 6) & 63, s2 = (sl >> 12) & 63;
            if (sl & (1u << 18)) lp[((size_t)s0 << 14) + base[k * 64 + s0] + (rk & 255u)] = t;
            if (sl & (2u << 18)) lp[((size_t)s1 << 14) + base[k * 64 + s1] + ((rk >> 8) & 255u)] = t | (1u << 14);
            if (sl & (4u << 18)) lp[((size_t)s2 << 14) + base[k * 64 + s2] + ((rk >> 16) & 255u)] = t | (2u << 14); } }
#undef GU_BH
#undef GU_C
#undef GU_T
    __syncthreads();
}
__device__ __forceinline__ void moba_attn_item(LAS unsigned char* lds, const bf16* h, const unsigned* gcount, const unsigned* list, float* po, float* pml, int item, int tid, int wave, int lane) {
    const int n = item / 24, bh = item - n * 24, hh = bh % MB_H, b = bh / MB_H;
    LAS unsigned* Ks = (LAS unsigned*)(lds + AT_KS); LAS unsigned* Vs32 = (LAS unsigned*)(lds + AT_VS);
    LAS float* qst = (LAS float*)(lds + AT_WV + wave * AT_WVB); LAS float* pb = qst + 256;
    for (int i = 0; i < 16; ++i) { const int idx = tid + 512 * i, r = idx >> 5, dd = idx & 31; const unsigned* src = (const unsigned*)(h + ((size_t)b * SEQ + n * 256 + r) * NC_M + hh * 64);
        Ks[r * 33 + dd] = src[384 + dd]; Vs32[r * 32 + dd] = src[768 + dd]; }
    __syncthreads();
    const int cnt = (int)gcount[bh * 64 + n], total = 256 + cnt, nquads = (total + 3) >> 2;
    const float slope = hh < 8 ? ldexpf(1.0f, -(hh + 1)) : ldexpf(0.70710678118654752f, -(hh - 8));
    const unsigned* lp = list + (((size_t)bh * 64 + n) << 14);
    for (int quad = wave; quad < nquads; quad += 8) {
        int tq[4], slot[4];
#pragma unroll
        for (int qi = 0; qi < 4; ++qi) { int idx = quad * 4 + qi; idx = idx < total ? idx : total - 1;
            if (idx < 256) { tq[qi] = n * 256 + idx; slot[qi] = 3; } else { const unsigned e = lp[idx - 256]; tq[qi] = (int)(e & 16383u); slot[qi] = (int)(e >> 14); } }
#pragma unroll
        for (int qi = 0; qi < 4; ++qi) qst[qi * 64 + lane] = bf2f(h[((size_t)b * SEQ + tq[qi]) * NC_M + hh * 64 + lane]);
        float m[4], l[4], o[4];
        attn4<true>(Ks, (const LAS bf16*)Vs32, qst, pb, lane, tq, n * 256, slope, m, l, o);
#pragma unroll
        for (int qi = 0; qi < 4; ++qi) if (quad * 4 + qi < total) { const size_t pi = (((size_t)b * SEQ + tq[qi]) * MB_H + hh) * 4 + slot[qi];
            po[pi * 64 + lane] = o[qi]; if (lane == 0) { pml[pi * 2] = m[qi]; pml[pi * 2 + 1] = l[qi]; } }
    }
    __syncthreads();
}

__device__ __forceinline__ void moba_attn_item2(LAS unsigned char* lds, const bf16* h, const float* kmaxg, const unsigned* gcount, const unsigned* list, bf16* po, float* pml, int item, int tid, int wave, int lane) {
    const int n = item / 24, bh = item - n * 24, hh = bh % MB_H, b = bh / MB_H, r = lane & 31, hf = lane >> 5;
    const bf16* hrow0 = h + ((size_t)b * SEQ + n * 256) * NC_M + hh * 64;
    stage_kv_images(lds, hrow0 + 768, hrow0 + 1536, NC_M, tid);
    __syncthreads();
    const int cnt = (int)gcount[bh * 64 + n], total = 256 + cnt, ntiles = (total + 31) >> 5;
    const float slope2 = (hh < 8 ? ldexpf(1.0f, -(hh + 1)) : ldexpf(0.70710678118654752f, -(hh - 8))) * 1.4426950408889634f;
    const unsigned shi = f2bf(slope2), slo = f2bf(slope2 - __builtin_bit_cast(float, shi << 16)); const unsigned qx = hf == 0 ? (shi | (slo << 16)) : 0u;
    const unsigned* lp = list + (((size_t)bh * 64 + n) << 14);
    const float kmx1 = kmaxg[bh * 64 + n];
    const bf16* hq = h + (size_t)b * SEQ * NC_M + hh * 64 + 8 * hf;
#pragma unroll 1
    for (int tile = wave; tile < ntiles; tile += NWAVES) {
        int idx = tile * 32 + r; const bool valid = idx < total; idx = valid ? idx : total - 1;
        int tq, slot; if (idx < 256) { tq = n * 256 + idx; slot = 3; } else { const unsigned e = lp[idx - 256]; tq = (int)(e & 16383u); slot = (int)(e >> 14); }
        s16x8 qf[4]; { const bf16* qp = hq + (size_t)tq * NC_M;
#pragma unroll
            for (int s = 0; s < 4; ++s) qf[s] = *(const s16x8*)(qp + 16 * s); }
        f32x16 o[2]; float m2, l; const float dist0 = (float)(tq - n * 256);
        unsigned qx2;
        { float qq = 0.f;
#pragma unroll
          for (int s = 0; s < 4; ++s)
#pragma unroll
              for (int jj = 0; jj < 8; ++jj) { const float qv = bf2f((bf16)qf[s][jj]); qq += qv * qv; }
          qq += xor32f(qq, lane);
          const float sh = sqrtf(qq) * kmx1 + slope2 * fminf(dist0, 255.f);
          const unsigned nh = f2bf(-sh), nl = f2bf(-sh - __builtin_bit_cast(float, nh << 16)); qx2 = hf == 0 ? (nh | (nl << 16)) : 0u;
          m2 = -(__builtin_bit_cast(float, nh << 16) + __builtin_bit_cast(float, nl << 16)); }
        attn_tile32<true>(lds, qf, lane, dist0, qx, qx2, tile < 8, o, m2, l);
        { LAS unsigned char* sw = lds + AT2_SCR + wave * AT2_SCRW; const int pi = valid ? (int)((((size_t)b * SEQ + tq) * MB_H + hh) * 4 + slot) : -1;
#pragma unroll
          for (int dt = 0; dt < 2; ++dt)
#pragma unroll
              for (int g = 0; g < 4; ++g) { v2u w; w.x = cvtpk(o[dt][4 * g], o[dt][4 * g + 1]); w.y = cvtpk(o[dt][4 * g + 2], o[dt][4 * g + 3]); *(LAS v2u*)(sw + r * 144 + (32 * dt + 8 * g + 4 * hf) * 2) = w; }
          if (hf == 0) { *(LAS int*)(sw + 4608 + 4 * r) = pi; if (valid) { pml[(size_t)pi * 2] = m2 - slope2 * dist0; pml[(size_t)pi * 2 + 1] = l; } }
#pragma unroll
          for (int it = 0; it < 4; ++it) { const int q = 8 * it + (lane >> 3), c = lane & 7; const int pq = *(const LAS int*)(sw + 4608 + 4 * q); const v4u row = *(const LAS v4u*)(sw + q * 144 + c * 16);
              if (pq >= 0) *(v4u*)(po + (size_t)pq * 64 + c * 8) = row; } }
    }
    __syncthreads();
}
__device__ __forceinline__ void moba_combine(const bf16* __restrict__ po, const float* __restrict__ pml, const int* __restrict__ selinfo, bf16* __restrict__ mix, int gw, int ngw, int lane) {
    const int sub = lane >> 4, d4 = (lane & 15) * 4;
#pragma unroll 4
    for (int idx = gw * 4 + sub; idx < T * MB_H; idx += ngw * 4) { const int tg = idx / MB_H, hh = idx - tg * MB_H, ns = selinfo[idx]; const size_t p4 = (size_t)idx * 4;
        f32x2 ml[4]; f32x4 ov[4];
#pragma unroll
        for (int j = 0; j < 4; ++j) { ml[j] = ((const f32x2*)pml)[p4 + j]; const v2u ow = *(const v2u*)(po + (p4 + j) * 64 + d4); ov[j] = (f32x4){bflo(ow.x), bfhi(ow.x), bflo(ow.y), bfhi(ow.y)}; }
        float M = ml[3].x;
#pragma unroll
        for (int j = 0; j < 3; ++j) { const bool ok = (ns >> j) & 1; ml[j].x = ok ? ml[j].x : -INFINITY; ml[j].y = ok ? ml[j].y : 0.f; M = fmaxf(M, ml[j].x);
            ov[j].x = ok ? ov[j].x : 0.f; ov[j].y = ok ? ov[j].y : 0.f; ov[j].z = ok ? ov[j].z : 0.f; ov[j].w = ok ? ov[j].w : 0.f; }
        float den = 0.f; f32x4 num = {0.f, 0.f, 0.f, 0.f};
#pragma unroll
        for (int j = 0; j < 4; ++j) { const float w = __builtin_amdgcn_exp2f(ml[j].x - M); den += w * ml[j].y; num += ov[j] * w; }
        const float inv = 1.f / den; v2u o; o.x = pk2(num.x * inv, num.y * inv); o.y = pk2(num.z * inv, num.w * inv);
        *(v2u*)(mix + (size_t)tg * 1024 + hh * 64 + d4) = o; }
}

__device__ __forceinline__ void ln_row(f32x4 (&v)[4], const f32x4 (&gv)[4], const f32x4 (&bv)[4]) {
    float s = 0.f;
#pragma unroll
    for (int j = 0; j < 4; ++j) s += (v[j].x + v[j].y) + (v[j].z + v[j].w);
    const float mean = wave_sum(s) * (1.f / D); float s2 = 0.f;
#pragma unroll
    for (int j = 0; j < 4; ++j) { v[j] = v[j] - mean; s2 += (v[j].x * v[j].x + v[j].y * v[j].y) + (v[j].z * v[j].z + v[j].w * v[j].w); }
    const float rstd = 1.f / sqrtf(wave_sum(s2) * (1.f / D) + 1e-5f);
#pragma unroll
    for (int j = 0; j < 4; ++j) v[j] = v[j] * rstd * gv[j] + bv[j];
}
__device__ __forceinline__ void split_router_weights(const float* wr  , bf16* wrs  , size_t gtid, size_t gthreads) {
    for (size_t i = gtid; i < (size_t)DEPTH * D * NE; i += gthreads) { const int e = (int)(i & 31), d = (int)((i >> 5) & 1023), l = (int)(i >> 15);
        const float w = wr[i]; const unsigned hi = f2bf(w); const unsigned lo = f2bf(w - __builtin_bit_cast(float, hi << 16));
        wrs[(((size_t)l * 2 + 0) * NE + e) * D + d] = (bf16)hi; wrs[(((size_t)l * 2 + 1) * NE + e) * D + d] = (bf16)lo; }
}
constexpr int L1_XH = 0, L1_XL = 33024, L1_ROW = 2064, L1_PART = 66048, L1_HIST = 82432;
__device__ __forceinline__ void phase_ln1(LAS unsigned char* lds, const bf16* y, const float* g, const float* bb, const bf16* wrs  , const float* br,
                                          bf16* xbf, int* tok_e, int* tok_lr, float* tok_w, int* blk_cnt, int blk, int tid, int wave, int lane) {
    LAS float* part = (LAS float*)(lds + L1_PART);
    LAS int* hist = (LAS int*)(lds + L1_HIST);
    if (tid < 32) hist[tid] = 0;
    constexpr int TPB = T / GRID;
    const int e = lane & 31, m16 = lane & 15, quad = lane >> 4;
    s16x8 bw[4][2][2];
#pragma unroll
    for (int ks = 0; ks < 4; ++ks)
#pragma unroll
        for (int nt = 0; nt < 2; ++nt)
#pragma unroll
            for (int pp = 0; pp < 2; ++pp) bw[ks][nt][pp] = *(const s16x8*)(wrs + ((size_t)pp * NE + 16 * nt + m16) * D + wave * 128 + 32 * ks + 8 * quad);
    const float bre = br[e];
    f32x4 gv[4], bv[4];
#pragma unroll
    for (int j = 0; j < 4; ++j) { gv[j] = ((const f32x4*)g)[lane + 64 * j]; bv[j] = ((const f32x4*)bb)[lane + 64 * j]; }
    v2u xn[2][4], yn[2][4];
#pragma unroll
    for (int u = 0; u < 2; ++u) { const size_t t0 = (size_t)blk * TPB + 2 * wave + u; const v2u* xr = (const v2u*)(xbf + t0 * D) + lane; const v2u* yr = (const v2u*)(y + t0 * D) + lane;
#pragma unroll
        for (int j = 0; j < 4; ++j) { xn[u][j] = xr[64 * j]; yn[u][j] = yr[64 * j]; } }
    __syncthreads();
    for (int grp = 0; grp < TPB / 16; ++grp) { const size_t tg0 = (size_t)blk * TPB + grp * 16 + 2 * wave;
        f32x4 v[2][4];
#pragma unroll
        for (int u = 0; u < 2; ++u)
#pragma unroll
            for (int j = 0; j < 4; ++j) { const v2u xw = xn[u][j]; const v2u yw = yn[u][j];
                v[u][j].x = DN_ALPHA * bflo(xw.x) + bflo(yw.x); v[u][j].y = DN_ALPHA * bfhi(xw.x) + bfhi(yw.x); v[u][j].z = DN_ALPHA * bflo(xw.y) + bflo(yw.y); v[u][j].w = DN_ALPHA * bfhi(xw.y) + bfhi(yw.y); }
        if (grp + 1 < TPB / 16) {
#pragma unroll
            for (int u = 0; u < 2; ++u) { const v2u* xr = (const v2u*)(xbf + (tg0 + 16 + u) * D) + lane; const v2u* yr = (const v2u*)(y + (tg0 + 16 + u) * D) + lane;
#pragma unroll
                for (int j = 0; j < 4; ++j) { xn[u][j] = xr[64 * j]; yn[u][j] = yr[64 * j]; } } }
#pragma unroll
        for (int u = 0; u < 2; ++u) { ln_row(v[u], gv, bv);
            v2u* xb = (v2u*)(xbf + (tg0 + u) * D) + lane;
#pragma unroll
            for (int j = 0; j < 4; ++j) { v2u hw; hw.x = cvtpk(v[u][j].x, v[u][j].y); hw.y = cvtpk(v[u][j].z, v[u][j].w); xb[64 * j] = hw;
                v2u lw; lw.x = cvtpk(v[u][j].x - bflo(hw.x), v[u][j].y - bfhi(hw.x)); lw.y = cvtpk(v[u][j].z - bflo(hw.y), v[u][j].w - bfhi(hw.y));
                *(LAS v2u*)(lds + L1_XH + (2 * wave + u) * L1_ROW + (4 * lane + 256 * j) * 2) = hw; *(LAS v2u*)(lds + L1_XL + (2 * wave + u) * L1_ROW + (4 * lane + 256 * j) * 2) = lw; } }
        __syncthreads();
        { f32x4 acc[2] = {{0.f, 0.f, 0.f, 0.f}, {0.f, 0.f, 0.f, 0.f}};
#pragma unroll
          for (int ks = 0; ks < 4; ++ks) { const int off = m16 * L1_ROW + (wave * 128 + 32 * ks + 8 * quad) * 2;
              const s16x8 ah = *(const LAS s16x8*)(lds + L1_XH + off), al = *(const LAS s16x8*)(lds + L1_XL + off);
#pragma unroll
              for (int nt = 0; nt < 2; ++nt) { acc[nt] = __builtin_amdgcn_mfma_f32_16x16x32_bf16(ah, bw[ks][nt][0], acc[nt], 0, 0, 0); acc[nt] = __builtin_amdgcn_mfma_f32_16x16x32_bf16(ah, bw[ks][nt][1], acc[nt], 0, 0, 0);
                  acc[nt] = __builtin_amdgcn_mfma_f32_16x16x32_bf16(al, bw[ks][nt][0], acc[nt], 0, 0, 0); } }
#pragma unroll
          for (int nt = 0; nt < 2; ++nt)
#pragma unroll
              for (int jj = 0; jj < 4; ++jj) part[(wave * 16 + 4 * quad + jj) * 32 + 16 * nt + m16] = acc[nt][jj]; }
        __syncthreads();
#pragma unroll
        for (int u = 0; u < 2; ++u) { const size_t t = tg0 + u;
            float logit = bre;
#pragma unroll
            for (int w = 0; w < 8; ++w) logit += part[(w * 16 + 2 * wave + u) * 32 + e];
            int rank = 0;
#pragma unroll
            for (int q = 0; q < 32; ++q) { const float oq = __builtin_bit_cast(float, __builtin_amdgcn_readlane(__builtin_bit_cast(int, logit), q)); rank += (oq > logit || (oq == logit && q < e)) ? 1 : 0; }
            int se[4]; float sv[4];
#pragma unroll
            for (int k = 0; k < 4; ++k) { const unsigned long long mk = __ballot(rank == k && lane < 32); const int src = __builtin_ctzll(mk);
                se[k] = src; sv[k] = __builtin_bit_cast(float, __builtin_amdgcn_readlane(__builtin_bit_cast(int, logit), src)); }
            const float e1 = __expf(sv[1] - sv[0]), e2 = __expf(sv[2] - sv[0]), e3 = __expf(sv[3] - sv[0]), inv = 1.f / (1.f + e1 + e2 + e3);
            const float wk[4] = {inv, e1 * inv, e2 * inv, e3 * inv};
            if (lane == 0) {
#pragma unroll
                for (int k = 0; k < 4; ++k) { const int lr = __hip_atomic_fetch_add(hist + se[k], 1, __ATOMIC_RELAXED, __HIP_MEMORY_SCOPE_WORKGROUP);
                    tok_e[t * 4 + k] = se[k]; tok_lr[t * 4 + k] = lr; tok_w[t * 4 + k] = wk[k]; } } }
    }
    __syncthreads();
    if (tid < 32) blk_cnt[blk * 32 + tid] = hist[tid];
    __syncthreads();
}
__device__ __forceinline__ void phase_dispatch(LAS unsigned char* lds, const int* __restrict__ blk_cnt, const int* __restrict__ tok_e, const int* __restrict__ tok_lr, int* __restrict__ tok_row, int* __restrict__ tab,
                                               const bf16* __restrict__ xbf, bf16* __restrict__ xs, int blk, int tid, int wave, int lane) {
    LAS int* tot = (LAS int*)lds; LAS int* pre = tot + 32; LAS int* pst = pre + 32; LAS int* rows = pst + 64;
    if (tid < 32) { int s = 0, p = 0;
#pragma unroll 8
        for (int bb = 0; bb < GRID; ++bb) { const int c = blk_cnt[bb * 32 + tid]; p += (bb < blk) ? c : 0; s += c; } tot[tid] = s; pre[tid] = p; }
    __syncthreads();
    if (tid == 0) { int acc = 0; for (int e = 0; e < 32; ++e) { pst[e] = acc; acc += ((tot[e] + 255) >> 8) << 8; } pst[32] = acc; }
    __syncthreads();
    if (blk == 0 && tid < 33) tab[tid] = pst[tid] >> 8;
    constexpr int TPB = T / GRID;
    static_assert(TPB * 4 == NTHR, "one (token, k) pair per thread");
    { const size_t ti = (size_t)blk * TPB * 4 + tid; const int e = tok_e[ti]; const int r = pst[e] + pre[e] + tok_lr[ti]; tok_row[ti] = r; rows[tid] = r; }
    __syncthreads();
#pragma unroll 4
    for (int i = wave; i < TPB * 4; i += NWAVES) { const int r = rows[i];
        const v4u* src = (const v4u*)(xbf + ((size_t)blk * TPB + (i >> 2)) * D) + 2 * lane; const v4u a = src[0], b = src[1];
        v4u o; o.x = pk4_fp8(bflo(a.x), bfhi(a.x), bflo(a.y), bfhi(a.y)); o.y = pk4_fp8(bflo(a.z), bfhi(a.z), bflo(a.w), bfhi(a.w)); o.z = pk4_fp8(bflo(b.x), bfhi(b.x), bflo(b.y), bfhi(b.y)); o.w = pk4_fp8(bflo(b.z), bfhi(b.z), bflo(b.w), bfhi(b.w));
        ((v4u*)((unsigned char*)xs + (size_t)r * D))[lane] = o; }
    __syncthreads();
}
__device__ __forceinline__ f32x4 fp8x4_to_f32(unsigned w) {
    const f32x2 lo = __builtin_amdgcn_cvt_pk_f32_fp8((int)w, false), hi = __builtin_amdgcn_cvt_pk_f32_fp8((int)w, true); return (f32x4){lo.x, lo.y, hi.x, hi.y};
}
__device__ __forceinline__ void phase_ln2(const unsigned char* __restrict__ yrows, const int* __restrict__ tok_row, const float* __restrict__ tok_w, const float* __restrict__ g, const float* __restrict__ bb,
                                          float* __restrict__ xout, bf16* xbf, int gw, int ngw, int lane) {
    f32x4 gv[4], bv[4];
#pragma unroll
    for (int j = 0; j < 4; ++j) { gv[j] = ((const f32x4*)g)[lane + 64 * j]; bv[j] = ((const f32x4*)bb)[lane + 64 * j]; }
    constexpr int NTK = 2;
    static_assert(T % (NTK * GRID * NWAVES) == 0, "NTK tokens per wave per step");
    for (int t0 = gw; t0 < T; t0 += NTK * ngw) {
        f32x4 v[NTK][4];
#pragma unroll
        for (int u = 0; u < NTK; ++u) { const int t = t0 + u * ngw; int r[4]; float w[4];
#pragma unroll
            for (int k = 0; k < 4; ++k) { r[k] = tok_row[(size_t)t * 4 + k]; w[k] = tok_w[(size_t)t * 4 + k] * (1.f / 16.f); }
            const v2u* xr = (const v2u*)(xbf + (size_t)t * D) + lane;
#pragma unroll
            for (int j = 0; j < 4; ++j) { f32x4 f = {0.f, 0.f, 0.f, 0.f};
#pragma unroll
                for (int k = 0; k < 4; ++k) { const unsigned yw = ((const unsigned*)(yrows + (size_t)r[k] * D))[lane + 64 * j]; f += fp8x4_to_f32(yw) * w[k]; }
                const v2u xw = xr[64 * j]; v[u][j].x = DN_ALPHA * bflo(xw.x) + f.x; v[u][j].y = DN_ALPHA * bfhi(xw.x) + f.y; v[u][j].z = DN_ALPHA * bflo(xw.y) + f.z; v[u][j].w = DN_ALPHA * bfhi(xw.y) + f.w; } }
#pragma unroll
        for (int u = 0; u < NTK; ++u) { const int t = t0 + u * ngw;
            ln_row(v[u], gv, bv);
            if (xout) { f32x4* xo = (f32x4*)(xout + (size_t)t * D) + lane;
#pragma unroll
                for (int j = 0; j < 4; ++j) xo[64 * j] = v[u][j]; }
            else { v2u* xb = (v2u*)(xbf + (size_t)t * D) + lane;
#pragma unroll
                for (int j = 0; j < 4; ++j) { v2u ww; ww.x = pk2(v[u][j].x, v[u][j].y); ww.y = pk2(v[u][j].z, v[u][j].w); xb[64 * j] = ww; } } } }
}


struct Args { const float* in[20]; float* out; unsigned char* ws; int l_lo, l_hi, ph_lo, ph_hi; };
typedef const __attribute__((address_space(4))) Args* KArgsP;
#define KA_LOAD() ({ KArgsP p_ = (KArgsP)__builtin_amdgcn_kernarg_segment_ptr(); asm volatile("" : "+s"(p_)); p_; })
#ifndef PHMASK
#define PHMASK 0xFFFF
#endif
#ifndef REPEAT_MASK
#define REPEAT_MASK 0
#endif
#ifndef REPEAT_LMASK
#define REPEAT_LMASK 0xF
#endif
#define PH_BEGIN(k) _Pragma("unroll") for (int rep_ = 0; rep_ < ((((REPEAT_MASK >> (k)) & 1) && ((REPEAT_LMASK >> l) & 1)) ? 2 : 1); ++rep_) { if ((PHMASK >> (k)) & 1) { KArgsP ka = KA_LOAD(); unsigned char* ws = ka->ws; int tid = threadIdx.x; asm volatile("" : "+v"(tid)); \
    const int lane = tid & 63, wave = __builtin_amdgcn_readfirstlane(tid >> 6); int blk = blockIdx.x; asm volatile("" : "+s"(blk)); \
    const int gw = blk * NWAVES + wave; const size_t gtid = (size_t)blk * NTHR + tid; (void)lane; (void)gw; (void)gtid; (void)ws;
#if ONE_LAUNCH
#define PH_SEAM() do { XcdBarrier b_; b_.bar = (unsigned*)(KA_LOAD()->ws + WS_CTL) + CW_BAR; b_.x = xb_xcc_id(); b_.st = (volatile LAS unsigned*)(lds + MISC_OFF); xcd_barrier(b_); } while (0)
#else
#define PH_SEAM() do {} while (0)
#endif
#define PH_END() PH_SEAM(); } }
#define PH_END_NOSEAM() } }
#define WSP(type, off) ((type*)(ws + (off)))
constexpr int G = GRID, NGW = GRID * NWAVES; constexpr size_t GTHREADS = (size_t)GRID * NTHR;
template <int L> __device__ __forceinline__ void layer_phases(LAS unsigned char* lds) {
    constexpr int l = L; LAS int* tabL = (LAS int*)(lds + MISC_OFF + 256);

        const int j = l >> 1; const bool moba = (l & 1) != 0;
        const int NC = moba ? NC_M : NC_H, qoff = moba ? 2304 : 3072;

        if (l == 0) {
        PH_BEGIN(1)
            phase_weights((LAS float*)(lds + wave * 16384), gw, NGW, lane, ka->in[2], NC_H, ka->in[6], 4, ka->in[7], ka->in[12], ka->in[14], ka->in[16], WSP(bf16, WS_WIN), WSP(bf16, WS_WKV4), WSP(bf16, WS_WO), WSP(bf16, WS_WGU), WSP(bf16, WS_WD));
        PH_END()
        }
        PH_BEGIN(2)
            { pg8::Gemm g{WSP(bf16, WS_XBF), WSP(bf16, WS_WIN), T, NC, D, 0, 0}; pg8::StaticOrder S; S.init(T, NC, G, blk); pg8::EpiPlain E{WSP(bf16, WS_H), NC, moba ? 0x207u : 0x1000u, 0.125f * 1.4426950408889634f};
              pg8::gemm_phase<pg8::EpiPlain, pg8::StaticOrder, true, true>(lds, g, S, E); }
            if (l == 0) {
              pg8::Gemm g{WSP(bf16, WS_MEMBF), WSP(bf16, WS_WKV4), 512, 2048, D, 0, 0}; pg8::StaticOrder S; S.init(512, 2048, G, blk >= 128 ? blk - 128 : G); pg8::EpiPlain E{WSP(bf16, WS_KV4), 2048, 0u, 1.f};
              pg8::gemm_phase<pg8::EpiPlain, pg8::StaticOrder, true, true>(lds, g, S, E); }
        PH_END()
        if (!moba) {
            PH_BEGIN(3)
                for (int u = blk; u < NBATCH * HG_H * HNSEG; u += G) hgrn_mfma<false>(lds, WSP(bf16, WS_H), ka->in[3], j, ka->in[4] + j * 128, WSP(float, WS_SLOC), WSP(float, WS_DSEG), WSP(bf16, WS_MIX), u, tid, wave, lane);
                for (int u = blk; u < 512; u += G) memattn_unit2(lds, WSP(bf16, WS_H), NC, qoff, WSP(bf16, WS_KV4) + 512 * l, WSP(bf16, WS_MIX), u, tid, wave, lane);
            PH_END()
            PH_BEGIN(4)
                hgrn_scan(WSP(float, WS_SLOC), WSP(float, WS_DSEG), gtid, GTHREADS);
            PH_END()
            PH_BEGIN(5)
                for (int u = blk; u < NBATCH * HG_H * HNSEG; u += G) hgrn_mfma<true>(lds, WSP(bf16, WS_H), ka->in[3], j, ka->in[4] + j * 128, WSP(float, WS_SLOC), WSP(float, WS_DSEG), WSP(bf16, WS_MIX), u, tid, wave, lane);
            PH_END()
        } else {
            PH_BEGIN(3)
                for (int u = blk; u < 24 * MB_NB; u += G) kmean_unit(lds, WSP(bf16, WS_H), WSP(float, WS_KMEAN), WSP(float, WS_KMEAN + 512 * 1024), u, tid, wave);
                for (int u = blk; u < 512; u += G) memattn_unit2(lds, WSP(bf16, WS_H), NC, qoff, WSP(bf16, WS_KV4) + 512 * l, WSP(bf16, WS_MIX), u, tid, wave, lane);
            PH_END()
            PH_BEGIN(4)
                moba_gate_wg(lds, WSP(bf16, WS_H), WSP(float, WS_KMEAN), WSP(float, WS_KMEAN + 512 * 1024), WSP(unsigned, WS_CTL) + CW_GCOUNT + j * 1536, WSP(int, WS_SELINFO), WSP(unsigned, WS_LIST), blk, tid);
            PH_END()
            PH_BEGIN(5)
                { unsigned* qhead = WSP(unsigned, WS_CTL) + CW_GCOUNT + 2 * 1536 + 64 * j; LAS int* itl = (LAS int*)(lds + MISC_OFF + 512);
                  for (;;) { if (tid == 0) *itl = (int)__hip_atomic_fetch_add(qhead, 1u, __ATOMIC_RELAXED, __HIP_MEMORY_SCOPE_AGENT);
                      __syncthreads(); const int it = *itl; __syncthreads();
                      if (it >= 24 * MB_NB) break;
                      moba_attn_item2(lds, WSP(bf16, WS_H), WSP(float, WS_KMEAN + 512 * 1024), WSP(unsigned, WS_CTL) + CW_GCOUNT + j * 1536, WSP(unsigned, WS_LIST), WSP(bf16, WS_PO), WSP(float, WS_PML), it, tid, wave, lane); } }
            PH_END()
            PH_BEGIN(6)
                moba_combine(WSP(bf16, WS_PO), WSP(float, WS_PML), WSP(int, WS_SELINFO), WSP(bf16, WS_MIX), gw, NGW, lane);
            PH_END()
        }
        PH_BEGIN(7)
            pg8::Gemm g{WSP(bf16, WS_MIX), WSP(bf16, WS_WO), T, D, D, 0, 0}; pg8::StaticOrder S; S.init(T, D, G, blk); pg8::EpiPlain E{WSP(bf16, WS_Y), D, 0u, 1.f};
            pg8::gemm_phase<pg8::EpiPlain, pg8::StaticOrder, true, true>(lds, g, S, E);
        PH_END()
        PH_BEGIN(8)
            phase_ln1(lds, WSP(bf16, WS_Y), ka->in[8] + l * D, ka->in[9] + l * D, WSP(bf16, WS_WRS) + (size_t)l * 2 * NE * D, ka->in[11] + l * NE, WSP(bf16, WS_XBF),
                      WSP(int, WS_TOK + TOK_E), WSP(int, WS_TOK + TOK_LR), WSP(float, WS_TOK + TOK_W), WSP(int, WS_TOK + TOK_BLKCNT), blk, tid, wave, lane);
        PH_END()
        PH_BEGIN(9)
            phase_dispatch(lds, WSP(int, WS_TOK + TOK_BLKCNT), WSP(int, WS_TOK + TOK_E), WSP(int, WS_TOK + TOK_LR), WSP(int, WS_TOK + TOK_ROW), WSP(int, WS_TOK + TOK_TAB), WSP(bf16, WS_XBF), WSP(bf16, WS_XS), blk, tid, wave, lane);
        PH_END()
        PH_BEGIN(10)
            if (tid < 33) tabL[tid] = WSP(int, WS_TOK + TOK_TAB)[tid];
            __syncthreads();
            int sw_ = 0x7A7A7A7A, sx_ = 0x7F7F7F7F; asm volatile("" : "+s"(sw_), "+s"(sx_));
            pg8::Gemm g{WSP(bf16, WS_XS), WSP(bf16, WS_WGU), MOE_MAXROWS, NE * 2048, D / 2, sw_, sx_}; pg8::MoeOrder S{tabL, 8, G, blk, tabL[32] * 8};
            pg8::EpiSwiglu E{WSP(unsigned char, WS_HID), ka->in[13] + (size_t)l * NE * 1024, ka->in[15] + (size_t)l * NE * 1024};
            pg8::gemm_phase<pg8::EpiSwiglu, pg8::MoeOrder, true, true, true>(lds, g, S, E);
        PH_END()
        PH_BEGIN(11)
            if (tid < 33) tabL[tid] = WSP(int, WS_TOK + TOK_TAB)[tid];
            __syncthreads();
            int sw_ = 0x79797979, sx_ = 0x83838383; asm volatile("" : "+s"(sw_), "+s"(sx_));
            pg8::Gemm g{WSP(bf16, WS_HID), WSP(bf16, WS_WD), MOE_MAXROWS, NE * 1024, D / 2, sw_, sx_}; pg8::MoeOrder S{tabL, 4, G, blk, tabL[32] * 4};
            pg8::EpiDown E{WSP(unsigned char, WS_XS), ka->in[17] + (size_t)l * NE * 1024};
            pg8::gemm_phase<pg8::EpiDown, pg8::MoeOrder, true, true, true>(lds, g, S, E);
        PH_END()
        PH_BEGIN(12)
            float* x2out = (l == DEPTH - 1) ? ka->out : nullptr;
            phase_ln2(WSP(unsigned char, WS_XS), WSP(int, WS_TOK + TOK_ROW), WSP(float, WS_TOK + TOK_W), ka->in[18] + l * D, ka->in[19] + l * D, x2out, WSP(bf16, WS_XBF), gw, NGW, lane);
            if (l + 1 < DEPTH) { constexpr int ln = l + 1, jn = ln >> 1; constexpr bool mn = (ln & 1) != 0;
                const float* win_src = mn ? ka->in[5] + (size_t)jn * D * NC_M : ka->in[2] + (size_t)jn * D * NC_H; const size_t moff = (size_t)ln * NE * 1024 * 1024;
                phase_weights((LAS float*)(lds + wave * 16384), gw, NGW, lane, win_src, mn ? NC_M : NC_H, ka->in[6], 0, ka->in[7] + (size_t)ln * D * D,
                              ka->in[12] + moff, ka->in[14] + moff, ka->in[16] + moff, WSP(bf16, WS_WIN), WSP(bf16, WS_WKV4), WSP(bf16, WS_WO), WSP(bf16, WS_WGU), WSP(bf16, WS_WD)); }
            if (l + 1 < DEPTH) PH_SEAM();
        PH_END_NOSEAM()
}
__global__ void __launch_bounds__(NTHR, 2) fwd_kernel(Args args) {
    extern __shared__ __attribute__((aligned(16))) unsigned char lds_raw[];
    LAS unsigned char* lds = (LAS unsigned char*)lds_raw;
    if (threadIdx.x < 4) ((LAS unsigned*)(lds + MISC_OFF))[threadIdx.x] = 0u;
    __syncthreads();
#if ONE_LAUNCH
    (void)xcd_barrier_post((unsigned*)(args.ws + WS_CTL) + CW_BAR, (volatile LAS unsigned*)(lds + MISC_OFF));
#endif
    { const int l = 0; (void)l;
    PH_BEGIN(0)
        cvt_rows_bf16(ka->in[0], WSP(bf16, WS_XBF), (size_t)T * D / 8, gtid, GTHREADS);
        cvt_rows_bf16(ka->in[1], WSP(bf16, WS_MEMBF), (size_t)512 * D / 8, gtid, GTHREADS);
        split_router_weights(ka->in[10], WSP(bf16, WS_WRS), gtid, GTHREADS);
    PH_END_NOSEAM() }
    layer_phases<0>(lds); layer_phases<1>(lds); layer_phases<2>(lds); layer_phases<3>(lds);
}

extern "C" void kernel_launch(void* const* d_in, const int* in_sizes, int n_in, void* d_out, int out_size, void* d_ws, size_t ws_size, hipStream_t stream) {
    static int ready = 0;
    if (ready == 0) {
        if (n_in != 20 || in_sizes[0] != T * D || out_size != T * D || ws_size < WS_END) { fprintf(stderr, "kernel_launch: unexpected shapes (n_in %d, in0 %d, out %d, ws %zu < %zu)\n", n_in, n_in > 0 ? in_sizes[0] : -1, out_size, ws_size, (size_t)WS_END); ready = -1; return; }
        if (hipFuncSetAttribute((const void*)fwd_kernel, hipFuncAttributeMaxDynamicSharedMemorySize, LDS_BYTES) != hipSuccess) { fprintf(stderr, "kernel_launch: hipFuncSetAttribute failed\n"); ready = -1; return; }
        int per_cu = 0;
        if (hipOccupancyMaxActiveBlocksPerMultiprocessor(&per_cu, (const void*)fwd_kernel, NTHR, LDS_BYTES) != hipSuccess || per_cu < 1) fprintf(stderr, "kernel_launch: occupancy query says %d\n", per_cu);
        (void)hipGetLastError();
        ready = 1;
    }
    if (ready < 0) return;
    if (hipMemsetAsync((char*)d_ws + WS_CTL, 0, CTL_ZERO_BYTES, stream) != hipSuccess) return;
    Args a{};
    for (int i = 0; i < 20; ++i) a.in[i] = (const float*)d_in[i];
    a.out = (float*)d_out; a.ws = (unsigned char*)d_ws;
    a.l_lo = 0; a.l_hi = DEPTH; a.ph_lo = 0; a.ph_hi = NPHASE;
    hipLaunchKernelGGL(fwd_kernel, dim3(GRID), dim3(NTHR), LDS_BYTES, stream, a);
}
```

```cpp
#include <hip/hip_runtime.h>
#include <cstdio>
#include <cstdint>
#include <cmath>
namespace pg8 {
#define PG8_LAS __attribute__((address_space(3)))
typedef unsigned short bf16_t;
typedef short bf16x8 __attribute__((ext_vector_type(8)));
typedef float f32x4 __attribute__((ext_vector_type(4)));
typedef unsigned u32x4 __attribute__((ext_vector_type(4)));
constexpr int BM = 256, BK = 64, HALF = 128, HTB = HALF * BK * 2  , STAGE_BYTES = 8 * HTB, NXCD = 8, WGM = 8;

__host__ __device__ __forceinline__ int lds_byte(int r, int c) { const int st = (r >> 4) * 2 + (c >> 5), rr = r & 15, cc = c & 31, ob = rr * 64 + cc * 2; return st * 1024 + (ob ^ (((ob >> 9) & 1) << 5)); }
__host__ __device__ __forceinline__ void stage_rc(int b, int& R, int& C) { const int st = b / 1024, sb = b % 1024, swz = sb ^ (((sb >> 9) & 1) << 5); R = (st >> 1) * 16 + swz / 64; C = (st & 1) * 32 + (swz % 64) / 2; }
__host__ __device__ __forceinline__ int perm32(int rho) { const int n = rho >> 4, i = rho & 15; return 8 * (i >> 2) + 4 * n + (i & 3); }

struct Unit { int pm, pn; };
struct Gemm { const bf16_t* A; const bf16_t* Bt; int M, N, K; int sw, sx; };
typedef int i32x8 __attribute__((ext_vector_type(8))); typedef int i32x4 __attribute__((ext_vector_type(4)));

struct StaticOrder {
    int nM, nN, nwg, G, c;
    __host__ __device__ void init(int M, int N, int G_, int c_) { nM = M / BM; nN = N / BM; nwg = nM * nN; G = G_; c = c_; }
    __host__ __device__ bool next(int i, Unit& u) const {
        const long L = (long)i * G + c; if (L >= nwg) return false;
        int wgid = (int)L; { const int q = nwg / NXCD, r = nwg % NXCD, xcd = wgid % NXCD, off = wgid / NXCD; wgid = (xcd < r ? xcd * (q + 1) : r * (q + 1) + (xcd - r) * q) + off; }
        const int nig = WGM * nN, gid = wgid / nig, fm = gid * WGM, gsz = (nM - fm) < WGM ? (nM - fm) : WGM;
        u.pm = fm + ((wgid % nig) % gsz); u.pn = (wgid % nig) / gsz; return true;
    }
    __device__ __forceinline__ void a_ready(const Unit&) const {}
    __device__ __forceinline__ void done(const Unit&) const {}
};

__device__ __forceinline__ unsigned cvt_pk_bf16(float lo, float hi) { unsigned r; asm volatile("v_cvt_pk_bf16_f32 %0, %1, %2" : "=v"(r) : "v"(lo), "v"(hi)); return r; }
typedef float f32x2 __attribute__((ext_vector_type(2)));
struct EpiPlain {
    static constexpr bool PERM = true, AFTER_DRAIN = false;
    bf16_t* O; int ldc; unsigned smask; float sc;
    struct Pre {};
    __device__ __forceinline__ void pre_load(const Unit&, int, int, Pre&) const {}
    __device__ __forceinline__ void acc_init(f32x4 (&acc)[2][2][4][2], const Pre&) const {
#pragma unroll
        for (int a = 0; a < 2; ++a)
#pragma unroll
            for (int b = 0; b < 2; ++b)
#pragma unroll
                for (int m = 0; m < 4; ++m)
#pragma unroll
                    for (int n = 0; n < 2; ++n) acc[a][b][m][n] = (f32x4){0.f, 0.f, 0.f, 0.f}; }
    __device__ __forceinline__ void operator()(const f32x4 (&acc)[2][2][4][2], const Unit& u, int wr, int wc, int fr, int fq) const {
        const int row0 = u.pm * BM + wr * 64 + fr; const int col0 = u.pn * BM + wc * 32 + 8 * fq; const float s = ((smask >> u.pn) & 1u) ? sc : 1.f;
#pragma unroll
        for (int ai = 0; ai < 2; ++ai)
#pragma unroll
            for (int m = 0; m < 4; ++m) { bf16_t* rowp = O + (size_t)(row0 + ai * HALF + m * 16) * ldc + col0;
#pragma unroll
                for (int bj = 0; bj < 2; ++bj) { const f32x4 v0 = acc[ai][bj][m][0] * s, v1 = acc[ai][bj][m][1] * s;
                    u32x4 w; w.x = cvt_pk_bf16(v0[0], v0[1]); w.y = cvt_pk_bf16(v0[2], v0[3]); w.z = cvt_pk_bf16(v1[0], v1[1]); w.w = cvt_pk_bf16(v1[2], v1[3]);
                    *(u32x4*)(rowp + bj * HALF) = w; } }
    }
};
__device__ __forceinline__ float swiglu1(float g, float u) {
    float gm; asm("v_min_f32 %0, 0x40e00000, %1" : "=v"(gm) : "v"(g));
    const float um = __builtin_amdgcn_fmed3f(u, -7.0f, 7.0f);
    const float s = __builtin_amdgcn_rcpf(1.0f + __builtin_amdgcn_exp2f(gm * (-1.702f * 1.4426950408889634f)));
    const float gs = gm * s;
    return __builtin_fmaf(gs, um, gs);
}
__device__ __forceinline__ void swiglu4(const f32x4 g, const f32x4 u, float (&o)[4]) {
    typedef float f32x2_ __attribute__((ext_vector_type(2)));
#pragma unroll
    for (int h = 0; h < 2; ++h) { f32x2_ gm, um;
        asm("v_min_f32 %0, 0x40e00000, %1" : "=v"(gm.x) : "v"(g[2 * h])); asm("v_min_f32 %0, 0x40e00000, %1" : "=v"(gm.y) : "v"(g[2 * h + 1]));
        um.x = __builtin_amdgcn_fmed3f(u[2 * h], -7.0f, 7.0f); um.y = __builtin_amdgcn_fmed3f(u[2 * h + 1], -7.0f, 7.0f);
        const f32x2_ t = gm * (-1.702f * 1.4426950408889634f);
        f32x2_ e; e.x = __builtin_amdgcn_exp2f(t.x); e.y = __builtin_amdgcn_exp2f(t.y);
        const f32x2_ d = e + 1.0f;
        f32x2_ s; s.x = __builtin_amdgcn_rcpf(d.x); s.y = __builtin_amdgcn_rcpf(d.y);
        const f32x2_ gs = gm * s; const f32x2_ r = gs * um + gs;
        o[2 * h] = r.x; o[2 * h + 1] = r.y; }
}
__device__ __forceinline__ unsigned pk4_fp8e(float a, float b, float c, float d) { int w = 0; w = __builtin_amdgcn_cvt_pk_fp8_f32(a, b, w, false); w = __builtin_amdgcn_cvt_pk_fp8_f32(c, d, w, true); return (unsigned)w; }
struct EpiSwiglu {
    static constexpr bool PERM = true, AFTER_DRAIN = false;
    unsigned char* hid; const float* bg; const float* bu;
    struct Pre { f32x4 g0, g1, u0, u1; };
    __device__ __forceinline__ void pre_load(const Unit& u, int wc, int fq, Pre& p) const { const int e = u.pn >> 3, col0 = (u.pn & 7) * 128 + wc * 32 + 8 * fq;
        p.g0 = *(const f32x4*)(bg + e * 1024 + col0); p.g1 = *(const f32x4*)(bg + e * 1024 + col0 + 4); p.u0 = *(const f32x4*)(bu + e * 1024 + col0); p.u1 = *(const f32x4*)(bu + e * 1024 + col0 + 4); }
    __device__ __forceinline__ void acc_init(f32x4 (&acc)[2][2][4][2], const Pre& p) const {
#pragma unroll
        for (int a = 0; a < 2; ++a)
#pragma unroll
            for (int m = 0; m < 4; ++m) { acc[a][0][m][0] = p.g0; acc[a][0][m][1] = p.g1; acc[a][1][m][0] = p.u0; acc[a][1][m][1] = p.u1; } }
    __device__ __forceinline__ void operator()(const f32x4 (&acc)[2][2][4][2], const Unit& u, int wr, int wc, int fr, int fq) const {
        const int pn = u.pn & 7;
        const int row0 = u.pm * BM + wr * 64 + fr; const int col0 = pn * 128 + wc * 32 + 8 * fq;
#pragma unroll
        for (int ai = 0; ai < 2; ++ai)
#pragma unroll
            for (int m = 0; m < 4; ++m) { unsigned char* rowp = hid + (size_t)(row0 + ai * HALF + m * 16) * 1024 + col0;
                const f32x4 ga = acc[ai][0][m][0], gb = acc[ai][0][m][1], ua = acc[ai][1][m][0], ub = acc[ai][1][m][1];
                typedef unsigned u32x2 __attribute__((ext_vector_type(2))); u32x2 w;
                float oa[4], ob[4]; swiglu4(ga, ua, oa); swiglu4(gb, ub, ob);
                w.x = pk4_fp8e(oa[0], oa[1], oa[2], oa[3]); w.y = pk4_fp8e(ob[0], ob[1], ob[2], ob[3]);
                *(u32x2*)rowp = w; }
    }
};
struct EpiDown {
    static constexpr bool PERM = true, AFTER_DRAIN = false;
    unsigned char* y; const float* bd;
    struct Pre { f32x4 b[2][2]; };
    __device__ __forceinline__ void pre_load(const Unit& u, int wc, int fq, Pre& p) const { const int e = u.pn >> 2, col0 = (u.pn & 3) * BM + wc * 32 + 8 * fq;
#pragma unroll
        for (int bj = 0; bj < 2; ++bj)
#pragma unroll
            for (int n = 0; n < 2; ++n) p.b[bj][n] = *(const f32x4*)(bd + e * 1024 + col0 + bj * HALF + 4 * n); }
    __device__ __forceinline__ void acc_init(f32x4 (&acc)[2][2][4][2], const Pre& p) const {
#pragma unroll
        for (int a = 0; a < 2; ++a)
#pragma unroll
            for (int bj = 0; bj < 2; ++bj)
#pragma unroll
                for (int m = 0; m < 4; ++m) { acc[a][bj][m][0] = p.b[bj][0] * 16.f; acc[a][bj][m][1] = p.b[bj][1] * 16.f; } }
    __device__ __forceinline__ void operator()(const f32x4 (&acc)[2][2][4][2], const Unit& u, int wr, int wc, int fr, int fq) const {
        const int pn = u.pn & 3;
        const int row0 = u.pm * BM + wr * 64 + fr; const int col0 = pn * BM + wc * 32 + 8 * fq;
#pragma unroll
        for (int ai = 0; ai < 2; ++ai)
#pragma unroll
            for (int m = 0; m < 4; ++m) { unsigned char* rowp = y + (size_t)(row0 + ai * HALF + m * 16) * 1024 + col0;
#pragma unroll
                for (int bj = 0; bj < 2; ++bj) { const f32x4 v0 = acc[ai][bj][m][0], v1 = acc[ai][bj][m][1];
                    typedef unsigned u32x2 __attribute__((ext_vector_type(2))); u32x2 w; w.x = pk4_fp8e(v0[0], v0[1], v0[2], v0[3]); w.y = pk4_fp8e(v1[0], v1[1], v1[2], v1[3]);
                    *(u32x2*)(rowp + bj * HALF) = w; } }
    }
};
struct MoeOrder {
    const PG8_LAS int* tab; int npn, G, c, nunits;
    __device__ __forceinline__ bool next(int i, Unit& u) const {
        const int tpx = 32 / npn, s = c >> 3, tile = (i * 8 + (c & 7)) * tpx + s / npn, pn = s % npn;
        if ((i * 8) * tpx >= nunits / npn) return false;
        if (tile >= nunits / npn) { u.pm = 0; u.pn = 0; return false; }
        int e = 0;
#pragma unroll
        for (int k = 1; k < 32; ++k) e += (tab[k] <= tile) ? 1 : 0;
        u.pm = tile; u.pn = __builtin_amdgcn_readfirstlane(e) * npn + pn; return true;
    }
    __device__ __forceinline__ void a_ready(const Unit&) const {}
    __device__ __forceinline__ void done(const Unit&) const {}
};
template <class Epi, class Sched, bool ALIGN_EPI = false, bool SP2 = false, bool F8 = false>
__device__ __forceinline__ void gemm_phase(PG8_LAS unsigned char* lds, const Gemm g, const Sched& S, const Epi& E) {
    int tid_ = threadIdx.x; asm volatile("" : "+v"(tid_));
    const int tid = tid_, wid = __builtin_amdgcn_readfirstlane(tid >> 6), lane = tid & 63, wr = wid >> 2, wc = wid & 3, fr = lane & 15, fq = lane >> 4;
    const int K = g.K, nt = K / BK;
    unsigned voffA, voffB;
    { int R, C; stage_rc(tid * 16, R, C); const int Rb = Epi::PERM ? ((R & ~31) + perm32(R & 31)) : R; voffA = (unsigned)(R * K + C) * 2u; voffB = (unsigned)(Rb * K + C) * 2u; }
    const unsigned qstep = 64u * (unsigned)K * 2u;
    const unsigned kstep = (unsigned)(BK * 2);
    const unsigned hstep = (unsigned)HALF * (unsigned)K * 2u;
    const unsigned tstep = 2u * hstep;
    const __amdgpu_buffer_rsrc_t rA = __builtin_amdgcn_make_buffer_rsrc((void*)g.A, 0, 0x7FFFFFFF, 0x00020000), rB = __builtin_amdgcn_make_buffer_rsrc((void*)g.Bt, 0, 0x7FFFFFFF, 0x00020000);
    const unsigned ldsw = (unsigned)wid * 1024u;
    const int aoff = lds_byte(wr * 64 + fr, fq * 8), boff = lds_byte(wc * 32 + fr, fq * 8);
#define PG8_SA(b, h) (((b) * 2 + (h)) * HTB)
#define PG8_SB(b, h) ((4 + (b) * 2 + (h)) * HTB)
#define PG8_STG(bufoff, rsrc, soff, voff) do { _Pragma("unroll") for (int _i = 0; _i < 2; ++_i) \
        __builtin_amdgcn_raw_ptr_buffer_load_lds((rsrc), (PG8_LAS void*)(lds + (bufoff) + ldsw + _i * 8192), 16, (int)(voff), (int)((soff) + (unsigned)_i * qstep), 0, 0); } while (0)
#define PG8_STGA(bufoff, soff) PG8_STG(bufoff, rA, soff, voffA)
#define PG8_STGB(bufoff, soff) PG8_STG(bufoff, rB, soff, voffB)
#define PG8_LDA(dst, b, h) do { _Pragma("unroll") for (int m = 0; m < 4; ++m) { if constexpr (F8) { const i32x4 lo_ = *(const PG8_LAS i32x4*)(lds + PG8_SA(b, h) + aoff + m * 2048), hi_ = *(const PG8_LAS i32x4*)(lds + PG8_SA(b, h) + aoff + m * 2048 + 1024); \
            dst##_8[m] = __builtin_shufflevector(lo_, hi_, 0, 1, 2, 3, 4, 5, 6, 7); } else { _Pragma("unroll") for (int k = 0; k < 2; ++k) dst[m][k] = *(const PG8_LAS bf16x8*)(lds + PG8_SA(b, h) + aoff + m * 2048 + k * 1024); } } } while (0)
#define PG8_LDB(dst, b, h) do { _Pragma("unroll") for (int n = 0; n < 2; ++n) { if constexpr (F8) { const i32x4 lo_ = *(const PG8_LAS i32x4*)(lds + PG8_SB(b, h) + boff + n * 2048), hi_ = *(const PG8_LAS i32x4*)(lds + PG8_SB(b, h) + boff + n * 2048 + 1024); \
            dst##_8[n] = __builtin_shufflevector(lo_, hi_, 0, 1, 2, 3, 4, 5, 6, 7); } else { _Pragma("unroll") for (int k = 0; k < 2; ++k) dst[n][k] = *(const PG8_LAS bf16x8*)(lds + PG8_SB(b, h) + boff + n * 2048 + k * 1024); } } } while (0)
#define PG8_MMA(ai, bj, At, Bt) do { __builtin_amdgcn_s_setprio(1); _Pragma("unroll") for (int m = 0; m < 4; ++m) _Pragma("unroll") for (int n = 0; n < 2; ++n) { \
        if constexpr (F8) acc[ai][bj][m][n] = __builtin_amdgcn_mfma_scale_f32_16x16x128_f8f6f4(Bt##_8[n], At##_8[m], acc[ai][bj][m][n], 0, 0, 0, g.sw, 0, g.sx); \
        else { _Pragma("unroll") for (int k = 0; k < 2; ++k) acc[ai][bj][m][n] = __builtin_amdgcn_mfma_f32_16x16x32_bf16(Bt[n][k], At[m][k], acc[ai][bj][m][n], 0, 0, 0); } } \
        __builtin_amdgcn_s_setprio(0); } while (0)
#define PG8_WAIT_V(n) asm volatile("s_waitcnt vmcnt(" #n ")" ::: "memory")
#define PG8_WAIT_L(n) asm volatile("s_waitcnt lgkmcnt(" #n ")" ::: "memory")
#define PG8_BAR __builtin_amdgcn_s_barrier()
#define PG8_SCHED __builtin_amdgcn_sched_barrier(0)
    Unit cur, nxt; int ui = 0;
    if (!S.next(0, cur)) return;
    f32x4 acc[2][2][4][2];
    typename Epi::Pre pre; E.pre_load(cur, wc, fq, pre); E.acc_init(acc, pre);
    bf16x8 At[4][2], B0[2][2], B1[2][2]; i32x8 At_8[4], B0_8[2], B1_8[2];
    unsigned cA = (unsigned)cur.pm * tstep, cB = (unsigned)cur.pn * tstep;
    S.a_ready(cur);
    if constexpr (SP2) {
        PG8_STGB(PG8_SB(0, 0), cB); PG8_STGB(PG8_SB(0, 1), cB + hstep); PG8_STGA(PG8_SA(0, 0), cA); PG8_STGA(PG8_SA(0, 1), cA + hstep);
        if (wr == 1) PG8_BAR;
        PG8_WAIT_V(2); PG8_BAR;
        PG8_STGB(PG8_SB(1, 0), cB + kstep); PG8_STGA(PG8_SA(1, 0), cA + kstep); PG8_STGB(PG8_SB(1, 1), cB + hstep + kstep);
        PG8_WAIT_V(6); PG8_BAR;
    } else {
        PG8_STGB(PG8_SB(0, 0), cB); PG8_STGA(PG8_SA(0, 0), cA); PG8_STGB(PG8_SB(0, 1), cB + hstep); PG8_STGA(PG8_SA(0, 1), cA + hstep);
        if (wr == 1) PG8_BAR;
        PG8_WAIT_V(4); PG8_BAR;
        PG8_STGB(PG8_SB(1, 0), cB + kstep); PG8_STGA(PG8_SA(1, 0), cA + kstep); PG8_STGB(PG8_SB(1, 1), cB + hstep + kstep);
        PG8_WAIT_V(6); PG8_BAR;
    }
    for (;;) {
        const bool has_next = S.next(ui + 1, nxt);
        const unsigned nA = has_next ? (unsigned)nxt.pm * tstep : cA, nB = has_next ? (unsigned)nxt.pn * tstep : cB;
#pragma unroll 1
        for (int t = 0; t < nt; t += 2) {
            const bool last = (t == nt - 2);
            const unsigned a1 = cA + (unsigned)(t + 1) * kstep;
            const unsigned a2 = last ? nA : cA + (unsigned)(t + 2) * kstep, b2 = last ? nB : cB + (unsigned)(t + 2) * kstep;
            const unsigned a3 = a2 + kstep, b3 = b2 + kstep;
            if (last && has_next) S.a_ready(nxt);
            if constexpr (SP2) {
            PG8_LDB(B0, 0, 0); PG8_LDB(B1, 0, 1); PG8_SCHED; PG8_LDA(At, 0, 0); PG8_STGA(PG8_SA(1, 1), a1 + hstep);
            PG8_WAIT_V(8); PG8_WAIT_L(0); PG8_BAR; PG8_MMA(0, 0, At, B0); PG8_MMA(0, 1, At, B1); PG8_BAR; PG8_SCHED;
            PG8_LDA(At, 0, 1); PG8_STGB(PG8_SB(0, 0), b2); PG8_STGB(PG8_SB(0, 1), b2 + hstep); PG8_STGA(PG8_SA(0, 0), a2);
            PG8_WAIT_V(8); PG8_WAIT_L(0); PG8_BAR; PG8_MMA(1, 0, At, B0); PG8_MMA(1, 1, At, B1); PG8_BAR; PG8_SCHED;
            PG8_LDB(B0, 1, 0); PG8_LDB(B1, 1, 1); PG8_SCHED; PG8_LDA(At, 1, 0); PG8_STGA(PG8_SA(0, 1), a2 + hstep);
            PG8_WAIT_V(8); PG8_WAIT_L(0); PG8_BAR; PG8_MMA(0, 0, At, B0); PG8_MMA(0, 1, At, B1); PG8_BAR; PG8_SCHED;
            PG8_LDA(At, 1, 1); PG8_STGB(PG8_SB(1, 0), b3); PG8_STGB(PG8_SB(1, 1), b3 + hstep); PG8_STGA(PG8_SA(1, 0), a3);
            PG8_WAIT_V(8); PG8_WAIT_L(0); PG8_BAR; PG8_MMA(1, 0, At, B0); PG8_MMA(1, 1, At, B1); PG8_BAR; PG8_SCHED;
            } else {
            PG8_LDB(B0, 0, 0); PG8_SCHED; PG8_LDA(At, 0, 0); PG8_STGA(PG8_SA(1, 1), a1 + hstep);
            PG8_WAIT_L(8); PG8_BAR; PG8_WAIT_L(0); PG8_MMA(0, 0, At, B0); PG8_BAR; PG8_SCHED;
            PG8_LDB(B1, 0, 1); PG8_STGB(PG8_SB(0, 0), b2);
            PG8_BAR; PG8_WAIT_L(0); PG8_MMA(0, 1, At, B1); PG8_BAR;
            PG8_LDA(At, 0, 1); PG8_STGA(PG8_SA(0, 0), a2);
            PG8_BAR; PG8_WAIT_L(0); PG8_MMA(1, 0, At, B0); PG8_BAR; PG8_SCHED;
            PG8_STGB(PG8_SB(0, 1), b2 + hstep);
            PG8_WAIT_V(6); PG8_BAR; PG8_MMA(1, 1, At, B1); PG8_BAR;
            PG8_LDB(B0, 1, 0); PG8_SCHED; PG8_LDA(At, 1, 0); PG8_STGA(PG8_SA(0, 1), a2 + hstep);
            PG8_WAIT_L(8); PG8_BAR; PG8_WAIT_L(0); PG8_MMA(0, 0, At, B0); PG8_BAR; PG8_SCHED;
            PG8_LDB(B1, 1, 1); PG8_STGB(PG8_SB(1, 0), b3);
            PG8_BAR; PG8_WAIT_L(0); PG8_MMA(0, 1, At, B1); PG8_BAR;
            PG8_LDA(At, 1, 1); PG8_STGA(PG8_SA(1, 0), a3);
            PG8_BAR; PG8_WAIT_L(0); PG8_MMA(1, 0, At, B0); PG8_BAR; PG8_SCHED;
            PG8_STGB(PG8_SB(1, 1), b3 + hstep);
            PG8_WAIT_V(6); PG8_BAR; PG8_MMA(1, 1, At, B1); PG8_BAR;
            }
        }
        if constexpr (ALIGN_EPI) { if (wr == 0) PG8_BAR; }
        if constexpr (!Epi::AFTER_DRAIN) { int t2_ = threadIdx.x; asm volatile("" : "+v"(t2_)); { const Unit pu_ = has_next ? nxt : cur; E.pre_load(pu_, wc, (t2_ & 63) >> 4, pre); }     E(acc, cur, wr, wc, t2_ & 15, (t2_ & 63) >> 4); S.done(cur); }
        if (!has_next) break;
        E.acc_init(acc, pre);
        cur = nxt; cA = nA; cB = nB; ++ui;
        if constexpr (ALIGN_EPI) { if (wr == 1) PG8_BAR; }
    }
    PG8_WAIT_V(0);
    if constexpr (!ALIGN_EPI) { if (wr == 0) PG8_BAR; }
    PG8_BAR;
    if constexpr (Epi::AFTER_DRAIN) { E.fused(acc, cur, wr, wc, fr, fq, lds, wid, lane); S.done(cur); }
#undef PG8_SA
#undef PG8_SB
#undef PG8_STG
#undef PG8_STGA
#undef PG8_STGB
#undef PG8_LDA
#undef PG8_LDB
#undef PG8_MMA
#undef PG8_WAIT_V
#undef PG8_WAIT_L
#undef PG8_BAR
#undef PG8_SCHED
}
}

constexpr int NWAVES = 8, NTHR = 512, GRID = 256;
constexpr int NBATCH = 2, SEQ = 16384, T = NBATCH * SEQ, D = 1024, DEPTH = 4;
constexpr int MIXW = 768, NC_H = 3328, NC_M = 2560;
constexpr int HG_H = 6;
constexpr int HSEG = 256, HNSEG = SEQ / HSEG;
constexpr int MB_H = 12, MB_NB = 64;
constexpr int NE = 32;
constexpr float DN_ALPHA = 1.6817928305074290f;
constexpr int MOE_MAXROWS = T * 4 + NE * 256;
#ifndef ONE_LAUNCH
#define ONE_LAUNCH 1
#endif
constexpr int NPHASE = 13;

constexpr size_t MiB = 1u << 20;
constexpr size_t WS_CTL = 0, CTL_ZERO_BYTES = 1 * MiB;
constexpr size_t WS_WIN = 1 * MiB, WS_WKV = 9 * MiB, WS_WO = 10 * MiB, WS_WGU = 12 * MiB, WS_WD = 140 * MiB;
constexpr size_t WS_XBF = 204 * MiB, WS_WKV4 = 268 * MiB  , WS_KV4 = 272 * MiB  , WS_WRS = 280 * MiB  , WS_MEMBF = 524 * MiB;
constexpr size_t WS_H = 526 * MiB, WS_MIX = 734 * MiB, WS_Y = 798 * MiB, WS_SLOC = 862 * MiB, WS_DSEG = 910 * MiB, WS_KMEAN = 911 * MiB;
constexpr size_t WS_SELINFO = 912 * MiB, WS_TOK = 914 * MiB, WS_R1 = 918 * MiB;
constexpr size_t WS_LIST = WS_R1, WS_PML = WS_R1 + 96 * MiB, WS_PO = WS_R1 + 108 * MiB;
constexpr size_t WS_XS = WS_R1, WS_HID = WS_R1 + 272 * MiB;
constexpr size_t WS_END = WS_R1 + 544 * MiB;
static_assert((size_t)MOE_MAXROWS * 1024 * 2 <= 272 * MiB, "moe rows");
static_assert((size_t)T * MB_H * 4 * 64 * 4 <= 384 * MiB && (size_t)24 * 64 * 16384 * 4 <= 96 * MiB, "moba bufs");
constexpr size_t TOK_E = 0, TOK_LR = 512 * 1024, TOK_W = 1024 * 1024, TOK_ROW = 1536 * 1024, TOK_BLKCNT = 2048 * 1024, TOK_TAB = 2048 * 1024 + 65536;
constexpr int CW_BAR = 4096, CW_GCOUNT = 8192;

constexpr int RING_BYTES = 131072, LDS_BYTES = 147456, MISC_OFF = LDS_BYTES - 1024;

#define GAS __attribute__((address_space(1)))
#define LAS __attribute__((address_space(3)))
typedef unsigned short bf16;
typedef unsigned v4u __attribute__((ext_vector_type(4)));
typedef unsigned v2u __attribute__((ext_vector_type(2)));
typedef float f32x4 __attribute__((ext_vector_type(4)));
typedef float f32x2 __attribute__((ext_vector_type(2)));
typedef short s16x8 __attribute__((ext_vector_type(8)));
typedef float f32x16 __attribute__((ext_vector_type(16)));
typedef float f32x2_t __attribute__((ext_vector_type(2))); typedef __bf16 bf16x2_t __attribute__((ext_vector_type(2)));
__device__ __forceinline__ unsigned cvtpk(float lo, float hi) { f32x2_t v = {lo, hi}; bf16x2_t b = __builtin_convertvector(v, bf16x2_t); return __builtin_bit_cast(unsigned, b); }
#define LDS_WAIT() asm volatile("s_waitcnt lgkmcnt(0)" ::: "memory")
__device__ __forceinline__ unsigned f2bf(float f) { unsigned u = __builtin_bit_cast(unsigned, f); return (u + 0x7fffu + ((u >> 16) & 1u)) >> 16; }
__device__ __forceinline__ unsigned pk2(float lo, float hi) { return f2bf(lo) | (f2bf(hi) << 16); }
__device__ __forceinline__ float bflo(unsigned w) { return __builtin_bit_cast(float, w << 16); }
__device__ __forceinline__ float bfhi(unsigned w) { return __builtin_bit_cast(float, w & 0xffff0000u); }
__device__ __forceinline__ float bf2f(bf16 h) { return __builtin_bit_cast(float, (unsigned)h << 16); }
__device__ __forceinline__ float sigmoidf_(float z) { return __builtin_amdgcn_rcpf(1.0f + __builtin_amdgcn_exp2f(-1.4426950408889634f * z)); }
template <int X> __device__ __forceinline__ float xorf(float v) { return __builtin_bit_cast(float, __builtin_amdgcn_ds_swizzle(__builtin_bit_cast(int, v), (X << 10) | 0x1F)); }
template <int X> __device__ __forceinline__ int xori(int v) { return __builtin_amdgcn_ds_swizzle(v, (X << 10) | 0x1F); }
__device__ __forceinline__ float wave_sum(float v) {
    v += xorf<1>(v); v += xorf<2>(v); v += xorf<4>(v); v += xorf<8>(v); v += xorf<16>(v);
    return __builtin_bit_cast(float, __builtin_amdgcn_readlane(__builtin_bit_cast(int, v), 0)) + __builtin_bit_cast(float, __builtin_amdgcn_readlane(__builtin_bit_cast(int, v), 32));
}
__device__ __forceinline__ float wave_max(float v) {
    v = fmaxf(v, xorf<1>(v)); v = fmaxf(v, xorf<2>(v)); v = fmaxf(v, xorf<4>(v)); v = fmaxf(v, xorf<8>(v)); v = fmaxf(v, xorf<16>(v));
    return fmaxf(__builtin_bit_cast(float, __builtin_amdgcn_readlane(__builtin_bit_cast(int, v), 0)), __builtin_bit_cast(float, __builtin_amdgcn_readlane(__builtin_bit_cast(int, v), 32)));
}
__device__ __forceinline__ float xor32f(float v, int lane) { return __builtin_bit_cast(float, __builtin_amdgcn_ds_bpermute((lane ^ 32) << 2, __builtin_bit_cast(int, v))); }
#define XB_TMO      128
#define XB_XCNT(j)  (256  + 64 * (j))
#define XB_XSUB(j)  (1280 + 64 * (j))
#define XB_XGEN(j)  (2304 + 64 * (j))
#define XB_TOP      3328
#define XB_TOPGEN   3392
#define XCD_BAR_WORDS 3456
#define XB_SPIN_CAP (1u << 18)

__device__ __forceinline__ unsigned xb_ld(unsigned* p)              { return __hip_atomic_load(p, __ATOMIC_RELAXED, __HIP_MEMORY_SCOPE_AGENT); }
__device__ __forceinline__ unsigned xb_add(unsigned* p, unsigned v) { return __hip_atomic_fetch_add(p, v, __ATOMIC_RELAXED, __HIP_MEMORY_SCOPE_AGENT); }
__device__ __forceinline__ unsigned xb_xcc_id() { return (unsigned)__builtin_amdgcn_s_getreg((3 << 11) | 20) & 0xFu; }
#define XB_SPIN(cond, bar) do { unsigned _sp = 0; while (cond) { __builtin_amdgcn_s_sleep(1); \
    if ((++_sp & 255u) == 0u) { if (xb_ld(&(bar)[XB_TMO])) break; if (_sp > XB_SPIN_CAP) { atomicAdd(&(bar)[XB_TMO], 1u); break; } } } } while (0)

struct XcdBarrier {
    unsigned* bar; unsigned x;
    volatile LAS unsigned* st;
};

__device__ __forceinline__ XcdBarrier xcd_barrier_post(unsigned* bar, volatile LAS unsigned* st) {
    XcdBarrier b; b.bar = bar; b.x = xb_xcc_id(); b.st = st;
    if (threadIdx.x == 0) (void)xb_add(&bar[XB_XCNT(b.x)], 1u);
    return b;
}
__device__ __forceinline__ void xcd_barrier_complete(unsigned* bar, unsigned x, unsigned& nloc, unsigned& nx) {
    const unsigned G = gridDim.x * gridDim.y * gridDim.z;
    unsigned sum, cnt, mine, sp = 0u;
    for (;;) {
        sum = 0u; cnt = 0u; mine = 0u;
#pragma unroll
        for (unsigned j = 0; j < 16; ++j) { const unsigned c = xb_ld(&bar[XB_XCNT(j)]); sum += c; cnt += (c > 0u) ? 1u : 0u; mine = (j == x) ? c : mine; }
        if (sum == G) break;
        __builtin_amdgcn_s_sleep(1);
        if ((++sp & 255u) == 0u) { if (xb_ld(&bar[XB_TMO])) break; if (sp > XB_SPIN_CAP) { atomicAdd(&bar[XB_TMO], 1u); break; } }
    }
    nloc = mine > 0u ? mine : 1u; nx = cnt > 0u ? cnt : 1u;
}

__device__ __forceinline__ void xcd_barrier(const XcdBarrier& b) {
    asm volatile("s_waitcnt vmcnt(0)" ::: "memory");
    __syncthreads();
    if (threadIdx.x == 0) {
        unsigned* bar = b.bar;
        __builtin_amdgcn_s_waitcnt(0);
        unsigned nloc = b.st[0], nx = b.st[1];
        if (nloc == 0u) { xcd_barrier_complete(bar, b.x, nloc, nx); b.st[0] = nloc; b.st[1] = nx; }
        const unsigned old = xb_add(&bar[XB_XSUB(b.x)], 1u);
        const unsigned gen = old / nloc;
        if (old + 1u == (gen + 1u) * nloc) {
            __builtin_amdgcn_fence(__ATOMIC_RELEASE, "agent");
            asm volatile("s_waitcnt vmcnt(0)" ::: "memory");
            const unsigned og = xb_add(&bar[XB_TOP], 1u);
            const unsigned tg = og / nx;
            if (og + 1u == (tg + 1u) * nx) xb_add(&bar[XB_TOPGEN], 1u);
            else XB_SPIN(xb_ld(&bar[XB_TOPGEN]) == tg, bar);
            __builtin_amdgcn_fence(__ATOMIC_ACQUIRE, "agent");
            xb_add(&bar[XB_XGEN(b.x)], 1u);
            asm volatile("s_waitcnt vmcnt(0)" ::: "memory");
        } else {
            XB_SPIN(xb_ld(&bar[XB_XGEN(b.x)]) == gen, bar);
            __builtin_amdgcn_fence(__ATOMIC_ACQUIRE, "agent");
            asm volatile("s_waitcnt vmcnt(0)" ::: "memory");
        }
    }
    __syncthreads();
}
__device__ __forceinline__ void cvt_rows_bf16(const float* src, bf16* dst, size_t n8, size_t gtid, size_t gthreads) {
    for (size_t i = gtid; i < n8; i += gthreads) { const f32x4 a = ((const f32x4*)src)[2 * i], b = ((const f32x4*)src)[2 * i + 1];
        v4u o; o.x = pk2(a.x, a.y); o.y = pk2(a.z, a.w); o.z = pk2(b.x, b.y); o.w = pk2(b.z, b.w); ((v4u*)dst)[i] = o; }
}
__device__ __forceinline__ void transpose_item(const float* W, int N, bf16* WT, int dst_row0, LAS float* scr, int k0, int n0, int lane) {
#pragma unroll 8
    for (int i = 0; i < 32; ++i) { const int kk = 2 * i + (lane >> 5); scr[kk * 33 + (lane & 31)] = W[(size_t)(k0 + kk) * N + n0 + (lane & 31)]; }
    LDS_WAIT(); asm volatile("" ::: "memory");
    const int c = lane & 7;
#pragma unroll
    for (int j = 0; j < 4; ++j) { const int n = (lane >> 3) + 8 * j; const LAS float* s = scr + (8 * c) * 33 + n;
        v4u o; o.x = pk2(s[0 * 33], s[1 * 33]); o.y = pk2(s[2 * 33], s[3 * 33]); o.z = pk2(s[4 * 33], s[5 * 33]); o.w = pk2(s[6 * 33], s[7 * 33]);
        *(v4u*)(WT + (size_t)(dst_row0 + n) * 1024 + k0 + 8 * c) = o; }
    LDS_WAIT(); asm volatile("" ::: "memory");
}
__device__ __forceinline__ unsigned pk4_fp8(float a, float b, float c, float d) { int w = 0; w = __builtin_amdgcn_cvt_pk_fp8_f32(a, b, w, false); w = __builtin_amdgcn_cvt_pk_fp8_f32(c, d, w, true); return (unsigned)w; }
__device__ __forceinline__ void transpose_item_f8(const float* W, int N, unsigned char* WT8, int dst_row0, LAS float* scr, int k0, int n0, int lane, float wscale) {
#pragma unroll 8
    for (int i = 0; i < 32; ++i) { const int kk = 2 * i + (lane >> 5); scr[kk * 33 + (lane & 31)] = W[(size_t)(k0 + kk) * N + n0 + (lane & 31)]; }
    LDS_WAIT(); asm volatile("" ::: "memory");
    const int c = lane & 7;
#pragma unroll
    for (int j = 0; j < 4; ++j) { const int n = (lane >> 3) + 8 * j; const LAS float* s = scr + (8 * c) * 33 + n;
        v2u o; o.x = pk4_fp8(s[0 * 33] * wscale, s[1 * 33] * wscale, s[2 * 33] * wscale, s[3 * 33] * wscale); o.y = pk4_fp8(s[4 * 33] * wscale, s[5 * 33] * wscale, s[6 * 33] * wscale, s[7 * 33] * wscale);
        *(v2u*)(WT8 + (size_t)(dst_row0 + n) * 1024 + k0 + 8 * c) = o; }
    LDS_WAIT(); asm volatile("" ::: "memory");
}
__device__ __forceinline__ void phase_weights(LAS float* scr, int gw, int ngw, int lane, const float* win_src, int NC, const float* wkv_src, int nkv, const float* wo_src,
                                              const float* wg_src, const float* wu_src, const float* wd_src, bf16* win_t, bf16* wkv_t, bf16* wo_t, bf16* wgu_t, bf16* wd_t) {
    const int nbw = NC / 32, nWin = nbw * 16, NIT = nWin + 256 * nkv + 512 + NE * 1536;
    for (int it = gw; it < NIT; it += ngw) {
        int r = it;
        if (r < nWin) { const int kb = r / nbw, nb = r - kb * nbw; transpose_item(win_src, NC, win_t, 32 * nb, scr, 64 * kb, 32 * nb, lane); continue; } r -= nWin;
        if (r < 256 * nkv) { const int lay = r >> 8, rr = r & 255, kb = rr >> 4, nb = rr & 15; transpose_item(wkv_src + (size_t)lay * D * 512, 512, wkv_t + (size_t)lay * 512 * 1024, 32 * nb, scr, 64 * kb, 32 * nb, lane); continue; } r -= 256 * nkv;
        if (r < 512) { const int kb = r >> 5, nb = r & 31; transpose_item(wo_src, 1024, wo_t, 32 * nb, scr, 64 * kb, 32 * nb, lane); continue; } r -= 512;
        const int e = r / 1536, q = r - e * 1536, which = q >> 9, rr = q & 511, kb = rr >> 5, nb = rr & 31, n0 = 32 * nb;
        const size_t eoff = (size_t)e * 1024 * 1024;
        if (which == 0) transpose_item_f8(wg_src + eoff, 1024, (unsigned char*)wgu_t + 2 * eoff, (n0 >> 7) * 256 + (n0 & 127), scr, 64 * kb, n0, lane, 32.f);
        else if (which == 1) transpose_item_f8(wu_src + eoff, 1024, (unsigned char*)wgu_t + 2 * eoff, (n0 >> 7) * 256 + 128 + (n0 & 127), scr, 64 * kb, n0, lane, 32.f);
        else transpose_item_f8(wd_src + eoff, 1024, (unsigned char*)wd_t + eoff, n0, scr, 64 * kb, n0, lane, 64.f);
    }
}

template <bool OUT>
__device__ __forceinline__ void hgrn_seg(LAS unsigned char* lds, const bf16* h, const float* lbl, int j, const float* normg, float* Sloc, float* Dseg, bf16* mix, int unit, int tid, int wave, int lane) {
    const int seg = unit & (HNSEG - 1), bh = unit >> 6, hh = bh % HG_H, b = bh / HG_H;
    const int v = tid & 127, dg = tid >> 7;
    LAS float* fgs = (LAS float*)lds; LAS float* vs = fgs + 4096; LAS float* qs = vs + 4096; LAS float* op = qs + 4096;
    f32x2 st[16];
    float* Sp = Sloc + (size_t)unit * 16384 + (size_t)(dg * 32) * 128 + v;
#pragma unroll
    for (int dd = 0; dd < 16; ++dd) { st[dd].x = OUT ? Sp[(2 * dd) * 128] : 0.f; st[dd].y = OUT ? Sp[(2 * dd + 1) * 128] : 0.f; }
    float dprod = 1.f;
    const int stok = tid >> 4, c8 = (tid & 15) * 8;
    float lb[8];
#pragma unroll
    for (int i = 0; i < 8; ++i) { lb[i] = 0.f; if (j > 0) { const float a0 = lbl[hh * 128 + c8 + i], a1 = lbl[MIXW + hh * 128 + c8 + i]; lb[i] = 1.f / (1.f + __expf(a0 - a1)); } }
    for (int ch = 0; ch < HSEG / 32; ++ch) {
        const size_t t0 = (size_t)b * SEQ + seg * HSEG + ch * 32;
        { const bf16* row = h + (t0 + stok) * NC_H + hh * 128 + c8;
          const v4u f8 = *(const v4u*)(row + 768), i8 = *(const v4u*)(row + 1536); v4u q8 = {0u, 0u, 0u, 0u}; if (OUT) q8 = *(const v4u*)row;
#pragma unroll
          for (int w = 0; w < 4; ++w) { const float f0 = bflo(f8[w]), f1 = bfhi(f8[w]); const int o = stok * 128 + c8 + 2 * w;
              fgs[o] = lb[2 * w] + (1.f - lb[2 * w]) * sigmoidf_(f0); fgs[o + 1] = lb[2 * w + 1] + (1.f - lb[2 * w + 1]) * sigmoidf_(f1);
              vs[o] = bflo(i8[w]); vs[o + 1] = bfhi(i8[w]);
              if (OUT) { const float q0 = bflo(q8[w]), q1 = bfhi(q8[w]); qs[o] = q0 * sigmoidf_(q0); qs[o + 1] = q1 * sigmoidf_(q1); } } }
        __syncthreads();
        if (!OUT) { if (tid < 128) { for (int tt = 0; tt < 32; ++tt) dprod *= fgs[tt * 128 + tid]; } }
        f32x4 fA[8], qA[8], fB[8], qB[8]; float vA, vB;
#define HG_LOAD(F, Q, V, tt_) do { V = vs[(tt_) * 128 + v]; _Pragma("unroll") for (int d4 = 0; d4 < 8; ++d4) { F[d4] = *(const LAS f32x4*)(fgs + (tt_) * 128 + dg * 32 + d4 * 4); \
            if (OUT) Q[d4] = *(const LAS f32x4*)(qs + (tt_) * 128 + dg * 32 + d4 * 4); } } while (0)
#define HG_STEP(F, Q, V, tt_) do { const f32x2 vv2 = {V, V}; f32x2 acc2 = {0.f, 0.f}; _Pragma("unroll") for (int d4 = 0; d4 < 8; ++d4) { \
            const f32x2 fa = {F[d4].x, F[d4].y}, fb = {F[d4].z, F[d4].w}; \
            st[2 * d4] = fa * (st[2 * d4] - vv2) + vv2; st[2 * d4 + 1] = fb * (st[2 * d4 + 1] - vv2) + vv2; \
            if (OUT) { const f32x2 qa = {Q[d4].x, Q[d4].y}, qb = {Q[d4].z, Q[d4].w}; acc2 = qa * st[2 * d4] + acc2; acc2 = qb * st[2 * d4 + 1] + acc2; } } \
            if (OUT) op[(dg * 32 + (tt_)) * 128 + v] = acc2.x + acc2.y; } while (0)
        HG_LOAD(fA, qA, vA, 0);
#pragma unroll 1
        for (int tt = 0; tt < 32; tt += 2) {
            HG_LOAD(fB, qB, vB, tt + 1);
            __builtin_amdgcn_sched_barrier(0);
            HG_STEP(fA, qA, vA, tt);
            __builtin_amdgcn_sched_barrier(0);
            if (tt + 2 < 32) HG_LOAD(fA, qA, vA, tt + 2);
            __builtin_amdgcn_sched_barrier(0);
            HG_STEP(fB, qB, vB, tt + 1);
            __builtin_amdgcn_sched_barrier(0);
        }
#undef HG_LOAD
#undef HG_STEP
        if (OUT) {
            __syncthreads();
#pragma unroll
            for (int k = 0; k < 4; ++k) { const int tt = wave + 8 * k; float o0 = 0.f, o1 = 0.f;
#pragma unroll
                for (int g = 0; g < 4; ++g) { o0 += op[(g * 32 + tt) * 128 + lane]; o1 += op[(g * 32 + tt) * 128 + lane + 64]; }
                const float ms = wave_sum(o0 * o0 + o1 * o1) * (1.f / 128.f), r = 1.f / sqrtf(ms + 1e-6f);
                const bf16* grow = h + (t0 + tt) * NC_H + 2304 + hh * 128; const float g0 = bf2f(grow[lane]), g1 = bf2f(grow[lane + 64]);
                bf16* mrow = mix + (t0 + tt) * 1024 + hh * 128;
                mrow[lane] = (bf16)f2bf(o0 * r * normg[lane] * sigmoidf_(g0)); mrow[lane + 64] = (bf16)f2bf(o1 * r * normg[lane + 64] * sigmoidf_(g1)); }
        }
        __syncthreads();
    }
    if (!OUT) {
#pragma unroll
        for (int dd = 0; dd < 16; ++dd) { Sp[(2 * dd) * 128] = st[dd].x; Sp[(2 * dd + 1) * 128] = st[dd].y; }
        if (tid < 128) Dseg[(size_t)unit * 128 + tid] = dprod;
    }
}
constexpr int HG_G = 0, HG_QT = 32768, HG_KT = 50176, HG_KE = 67584, HG_VT = 86016, HG_ST = 104448, HG_GM = 139264, HG_GE = 139776, HG_PART = 140288, HG_EGM = 142336, HG_EGE = 142848;
static_assert(HG_EGE + 512 <= MISC_OFF, "HGRN LDS map");
__device__ __forceinline__ int crow16(int i, int hf) { return (i & 3) + 8 * (i >> 2) + 4 * hf; }
template <bool OUT>
__device__ __forceinline__ void hgrn_mfma(LAS unsigned char* lds, const bf16* h, const float* lbl, int j, const float* normg, float* Sloc, float* Dseg, bf16* mix, int unit, int tid, int wave, int lane) {
    const int seg = unit & (HNSEG - 1), bh = unit >> 6, hh = bh % HG_H, b = bh / HG_H;
    const int r = lane & 31, hf = lane >> 5, tr = wave & 1, vq = wave >> 1;
    LAS float* G = (LAS float*)(lds + HG_G); LAS float* GM = (LAS float*)(lds + HG_GM); LAS float* GE = (LAS float*)(lds + HG_GE); LAS float* PART = (LAS float*)(lds + HG_PART); LAS float* EGM = (LAS float*)(lds + HG_EGM); LAS float* EGE = (LAS float*)(lds + HG_EGE);
    const int stok = tid >> 3, c16 = (tid & 7) * 16, sperm = (stok & ~15) | (stok & 3) | ((stok & 4) << 1) | ((stok & 8) >> 1);
    const int cd = tid & 127, cpart = tid >> 7;
    float lb[16];
#pragma unroll
    for (int e = 0; e < 16; ++e) { lb[e] = 0.f; if (j > 0) { const float a0 = lbl[hh * 128 + c16 + e], a1 = lbl[MIXW + hh * 128 + c16 + e]; lb[e] = 1.f / (1.f + __expf(a0 - a1)); } }
    f32x16 S[2];
    float* Sp = Sloc + (size_t)unit * 16384 + 32 * vq + r;
#pragma unroll
    for (int dd = 0; dd < 2; ++dd)
#pragma unroll
        for (int i = 0; i < 16; ++i) S[dd][i] = OUT ? Sp[(32 * (2 * tr + dd) + crow16(i, hf)) * 128] : 0.f;
    float gsum = 0.f;
    float ng16[16];
#pragma unroll
    for (int e = 0; e < 16; ++e) ng16[e] = OUT ? normg[c16 + e] : 0.f;
    v4u nf8[2], ni8[2], nq8[2] = {{0u, 0u, 0u, 0u}, {0u, 0u, 0u, 0u}}, ng8[2] = {{0u, 0u, 0u, 0u}, {0u, 0u, 0u, 0u}};
#define HG_RAWLOAD(t0_) do { const bf16* row_ = h + ((t0_) + stok) * NC_H + hh * 128 + c16; nf8[0] = *(const v4u*)(row_ + 768); nf8[1] = *(const v4u*)(row_ + 776); ni8[0] = *(const v4u*)(row_ + 1536); ni8[1] = *(const v4u*)(row_ + 1544); \
        if (OUT) { nq8[0] = *(const v4u*)row_; nq8[1] = *(const v4u*)(row_ + 8); ng8[0] = *(const v4u*)(row_ + 2304); ng8[1] = *(const v4u*)(row_ + 2312); } } while (0)
    HG_RAWLOAD((size_t)b * SEQ + seg * HSEG);
    for (int ch = 0; ch < HSEG / 64; ++ch) {
        const size_t t0 = (size_t)b * SEQ + seg * HSEG + ch * 64;
        float fg[16], qv[16]; v4u i8[2], g8[2];
        { const v4u f8[2] = {nf8[0], nf8[1]}; i8[0] = ni8[0]; i8[1] = ni8[1]; const v4u q8[2] = {nq8[0], nq8[1]}; g8[0] = ng8[0]; g8[1] = ng8[1];
#pragma unroll
          for (int w = 0; w < 8; ++w) { const unsigned fw = f8[w >> 2][w & 3]; const float f0 = bflo(fw), f1 = bfhi(fw);
              fg[2 * w] = lb[2 * w] + (1.f - lb[2 * w]) * sigmoidf_(f0); fg[2 * w + 1] = lb[2 * w + 1] + (1.f - lb[2 * w + 1]) * sigmoidf_(f1);
              if (OUT) { const unsigned qw = q8[w >> 2][w & 3]; const float q0 = bflo(qw), q1 = bfhi(qw); qv[2 * w] = q0 * sigmoidf_(q0); qv[2 * w + 1] = q1 * sigmoidf_(q1); } else { qv[2 * w] = 0.f; qv[2 * w + 1] = 0.f; } }
#pragma unroll
          for (int e4 = 0; e4 < 4; ++e4) { f32x4 lg; lg.x = __builtin_amdgcn_logf(fg[4 * e4]); lg.y = __builtin_amdgcn_logf(fg[4 * e4 + 1]); lg.z = __builtin_amdgcn_logf(fg[4 * e4 + 2]); lg.w = __builtin_amdgcn_logf(fg[4 * e4 + 3]);
              *(LAS f32x4*)(G + stok * 128 + c16 + 4 * e4) = lg; } }
        __syncthreads();
        { float run = 0.f;
#pragma unroll
          for (int k = 0; k < 16; ++k) run += G[(16 * cpart + k) * 128 + cd];
          PART[cpart * 128 + cd] = run; }
        __syncthreads();
        { float run = 0.f;
#pragma unroll
          for (int pp = 0; pp < 3; ++pp) run += (pp < cpart) ? PART[pp * 128 + cd] : 0.f;
#pragma unroll
          for (int k = 0; k < 16; ++k) { run += G[(16 * cpart + k) * 128 + cd]; G[(16 * cpart + k) * 128 + cd] = run; }
          if (cpart == 1) { GM[cd] = run; EGM[cd] = __builtin_amdgcn_exp2f(run); }
          if (cpart == 3) { GE[cd] = run; EGE[cd] = __builtin_amdgcn_exp2f(run); gsum += run; } }
        __syncthreads();
        if (OUT) {
#pragma unroll
            for (int dd = 0; dd < 2; ++dd)
#pragma unroll
                for (int g4 = 0; g4 < 4; ++g4) { const int dbase = 32 * (2 * tr + dd) + 8 * g4 + 4 * hf; const f32x4 gm = *(const LAS f32x4*)(EGM + dbase);
                    v2u w; w.x = cvtpk(S[dd][4 * g4] * gm.x, S[dd][4 * g4 + 1] * gm.y); w.y = cvtpk(S[dd][4 * g4 + 2] * gm.z, S[dd][4 * g4 + 3] * gm.w);
                    *(LAS v2u*)(lds + HG_ST + (32 * vq + r) * 272 + dbase * 2) = w; }
        }
        { unsigned qt[8], kt[8];
#pragma unroll
          for (int e4 = 0; e4 < 4; ++e4) { const f32x4 gv = *(const LAS f32x4*)(G + stok * 128 + c16 + 4 * e4), gm = *(const LAS f32x4*)(GM + c16 + 4 * e4), ge = *(const LAS f32x4*)(GE + c16 + 4 * e4);
              float ke[4];
#pragma unroll
              for (int e = 0; e < 4; ++e) { const float kk = 1.f - fg[4 * e4 + e]; ke[e] = kk * __builtin_amdgcn_exp2f(ge[e] - gv[e]);
                  if (OUT) { const float a = qv[4 * e4 + e] * __builtin_amdgcn_exp2f(gv[e] - gm[e]), c = kk * __builtin_amdgcn_exp2f(gm[e] - gv[e]);
                      if (e & 1) { qt[2 * e4 + (e >> 1)] |= f2bf(a) << 16; kt[2 * e4 + (e >> 1)] |= f2bf(c) << 16; } else { qt[2 * e4 + (e >> 1)] = f2bf(a); kt[2 * e4 + (e >> 1)] = f2bf(c); } } }
#pragma unroll
              for (int e = 0; e < 4; ++e) { const int col = c16 + 4 * e4 + e;
                  *(LAS bf16*)(lds + HG_KE + col * 144 + sperm * 2) = (bf16)f2bf(ke[e]);
                  const unsigned vw = i8[e4 >> 1][(2 * e4 + (e >> 1)) & 3]; *(LAS bf16*)(lds + HG_VT + col * 144 + sperm * 2) = (bf16)((e & 1) ? (vw >> 16) : (vw & 0xffffu)); } }
          if (OUT) { *(LAS v4u*)(lds + HG_QT + stok * 272 + c16 * 2) = (v4u){qt[0], qt[1], qt[2], qt[3]}; *(LAS v4u*)(lds + HG_QT + stok * 272 + c16 * 2 + 16) = (v4u){qt[4], qt[5], qt[6], qt[7]};
                     *(LAS v4u*)(lds + HG_KT + stok * 272 + c16 * 2) = (v4u){kt[0], kt[1], kt[2], kt[3]}; *(LAS v4u*)(lds + HG_KT + stok * 272 + c16 * 2 + 16) = (v4u){kt[4], kt[5], kt[6], kt[7]}; } }
        __syncthreads();
        if (ch + 1 < HSEG / 64) HG_RAWLOAD(t0 + 64);
        if (OUT) {
            f32x16 X0, X1, O;
#pragma unroll
            for (int i = 0; i < 16; ++i) { X0[i] = 0.f; X1[i] = 0.f; O[i] = 0.f; }
            const LAS unsigned char* qtp = lds + HG_QT + (32 * tr + r) * 272 + hf * 16;
#pragma unroll
            for (int ks = 0; ks < 8; ++ks) { const s16x8 bq = *(const LAS s16x8*)(qtp + ks * 32);
                const s16x8 a0 = *(const LAS s16x8*)(lds + HG_KT + r * 272 + hf * 16 + ks * 32); X0 = __builtin_amdgcn_mfma_f32_32x32x16_bf16(a0, bq, X0, 0, 0, 0);
                if (tr == 1) { const s16x8 a1 = *(const LAS s16x8*)(lds + HG_KT + (32 + r) * 272 + hf * 16 + ks * 32); X1 = __builtin_amdgcn_mfma_f32_32x32x16_bf16(a1, bq, X1, 0, 0, 0); } }
#pragma unroll
            for (int i = 0; i < 16; ++i) { const bool keep = crow16(i, hf) <= r; if (tr == 0) X0[i] = keep ? X0[i] : 0.f; else X1[i] = keep ? X1[i] : 0.f; }
            const LAS unsigned char* vtp = lds + HG_VT + (32 * vq + r) * 144 + hf * 16;
#pragma unroll
            for (int s2 = 0; s2 < 2; ++s2) { v4u pw; pw.x = cvtpk(X0[8 * s2], X0[8 * s2 + 1]); pw.y = cvtpk(X0[8 * s2 + 2], X0[8 * s2 + 3]); pw.z = cvtpk(X0[8 * s2 + 4], X0[8 * s2 + 5]); pw.w = cvtpk(X0[8 * s2 + 6], X0[8 * s2 + 7]);
                const s16x8 bv = *(const LAS s16x8*)(vtp + (16 * s2) * 2); O = __builtin_amdgcn_mfma_f32_32x32x16_bf16(__builtin_bit_cast(s16x8, pw), bv, O, 0, 0, 0); }
            if (tr == 1) {
#pragma unroll
                for (int s2 = 0; s2 < 2; ++s2) { v4u pw; pw.x = cvtpk(X1[8 * s2], X1[8 * s2 + 1]); pw.y = cvtpk(X1[8 * s2 + 2], X1[8 * s2 + 3]); pw.z = cvtpk(X1[8 * s2 + 4], X1[8 * s2 + 5]); pw.w = cvtpk(X1[8 * s2 + 6], X1[8 * s2 + 7]);
                    const s16x8 bv = *(const LAS s16x8*)(vtp + (32 + 16 * s2) * 2); O = __builtin_amdgcn_mfma_f32_32x32x16_bf16(__builtin_bit_cast(s16x8, pw), bv, O, 0, 0, 0); } }
            const LAS unsigned char* stp = lds + HG_ST + (32 * vq + r) * 272 + hf * 16;
#pragma unroll
            for (int ks = 0; ks < 8; ++ks) { const s16x8 aq = *(const LAS s16x8*)(qtp + ks * 32), bs = *(const LAS s16x8*)(stp + ks * 32); O = __builtin_amdgcn_mfma_f32_32x32x16_bf16(aq, bs, O, 0, 0, 0); }
#pragma unroll
            for (int i = 0; i < 16; ++i) G[(32 * tr + crow16(i, hf)) * 128 + 32 * vq + r] = O[i];
        }
#pragma unroll
        for (int dd = 0; dd < 2; ++dd) { const int dr = 2 * tr + dd;
#pragma unroll
            for (int g4 = 0; g4 < 4; ++g4) { const f32x4 ge = *(const LAS f32x4*)(EGE + 32 * dr + 8 * g4 + 4 * hf);
                S[dd][4 * g4] *= ge.x; S[dd][4 * g4 + 1] *= ge.y; S[dd][4 * g4 + 2] *= ge.z; S[dd][4 * g4 + 3] *= ge.w; }
#pragma unroll
            for (int ks = 0; ks < 4; ++ks) { const s16x8 a = *(const LAS s16x8*)(lds + HG_KE + (32 * dr + r) * 144 + hf * 16 + ks * 32), bv = *(const LAS s16x8*)(lds + HG_VT + (32 * vq + r) * 144 + hf * 16 + ks * 32);
                S[dd] = __builtin_amdgcn_mfma_f32_32x32x16_bf16(a, bv, S[dd], 0, 0, 0); } }
        __syncthreads();
        if (OUT) {
            float ov[16]; float ss = 0.f;
#pragma unroll
            for (int e4 = 0; e4 < 4; ++e4) { const f32x4 o4 = *(const LAS f32x4*)(G + stok * 128 + c16 + 4 * e4); ov[4 * e4] = o4.x; ov[4 * e4 + 1] = o4.y; ov[4 * e4 + 2] = o4.z; ov[4 * e4 + 3] = o4.w;
                ss += (o4.x * o4.x + o4.y * o4.y) + (o4.z * o4.z + o4.w * o4.w); }
            ss += xorf<1>(ss); ss += xorf<2>(ss); ss += xorf<4>(ss);
            const float rr = 1.f / sqrtf(ss * (1.f / 128.f) + 1e-6f);
            unsigned ow[8];
#pragma unroll
            for (int w = 0; w < 8; ++w) { const unsigned gw_ = g8[w >> 2][w & 3]; ow[w] = cvtpk(ov[2 * w] * rr * ng16[2 * w] * sigmoidf_(bflo(gw_)), ov[2 * w + 1] * rr * ng16[2 * w + 1] * sigmoidf_(bfhi(gw_))); }
            bf16* mrow = mix + (t0 + stok) * 1024 + hh * 128 + c16;
            *(v4u*)mrow = (v4u){ow[0], ow[1], ow[2], ow[3]}; *(v4u*)(mrow + 8) = (v4u){ow[4], ow[5], ow[6], ow[7]};
            __syncthreads();
        }
    }
#undef HG_RAWLOAD
    if (!OUT) {
#pragma unroll
        for (int dd = 0; dd < 2; ++dd)
#pragma unroll
            for (int i = 0; i < 16; ++i) Sp[(32 * (2 * tr + dd) + crow16(i, hf)) * 128] = S[dd][i];
        if (cpart == 3) Dseg[(size_t)unit * 128 + cd] = __builtin_amdgcn_exp2f(gsum);
    }
}
__device__ __forceinline__ void hgrn_scan(float* Sloc, const float* Dseg, size_t gtid, size_t gthreads) {
    for (size_t idx = gtid; idx < (size_t)NBATCH * HG_H * 16384; idx += gthreads) { const int bh = (int)(idx >> 14), e = (int)(idx & 16383), d = e >> 7; float cur = 0.f;
        float* __restrict__ sp = Sloc + (size_t)bh * HNSEG * 16384 + e; const float* __restrict__ dp = Dseg + (size_t)bh * HNSEG * 128 + d;
        for (int s0 = 0; s0 < HNSEG; s0 += 16) { float tv[16], dv[16];
#pragma unroll
            for (int k = 0; k < 16; ++k) { tv[k] = sp[(size_t)(s0 + k) * 16384]; dv[k] = dp[(s0 + k) * 128]; }
#pragma unroll
            for (int k = 0; k < 16; ++k) { sp[(size_t)(s0 + k) * 16384] = cur; cur = dv[k] * cur + tv[k]; } } }
}

template <bool MASK>
__device__ __forceinline__ void attn4(const LAS unsigned* Ks, const LAS bf16* Vs, const LAS float* qst, LAS float* pb, int lane, const int (&tq)[4], int kbase, float slope,
                                      float (&mo)[4], float (&lo)[4], float (&oo)[4]) {
    float sc[4][4];
#pragma unroll
    for (int a = 0; a < 4; ++a)
#pragma unroll
        for (int c = 0; c < 4; ++c) sc[a][c] = 0.f;
#pragma unroll 4
    for (int dd = 0; dd < 32; ++dd) {
        f32x2 qv[4];
#pragma unroll
        for (int qi = 0; qi < 4; ++qi) qv[qi] = *(const LAS f32x2*)(qst + qi * 64 + 2 * dd);
#pragma unroll
        for (int kk = 0; kk < 4; ++kk) { const unsigned kw = Ks[(lane + 64 * kk) * 33 + dd]; const float k0 = bflo(kw), k1 = bfhi(kw);
#pragma unroll
            for (int qi = 0; qi < 4; ++qi) sc[qi][kk] += qv[qi].x * k0 + qv[qi].y * k1; }
    }
#pragma unroll
    for (int qi = 0; qi < 4; ++qi) { float mx = -INFINITY;
#pragma unroll
        for (int kk = 0; kk < 4; ++kk) { const int pos = kbase + lane + 64 * kk; float lg = sc[qi][kk] * 0.125f - slope * (float)(tq[qi] - pos); if (MASK && pos > tq[qi]) lg = -INFINITY; sc[qi][kk] = lg; mx = fmaxf(mx, lg); }
        mx = wave_max(mx); float s = 0.f;
#pragma unroll
        for (int kk = 0; kk < 4; ++kk) { const float p = __builtin_amdgcn_exp2f((sc[qi][kk] - mx) * 1.4426950408889634f); pb[qi * 256 + lane + 64 * kk] = p; s += p; }
        lo[qi] = wave_sum(s); mo[qi] = mx; }
    float o[4] = {0.f, 0.f, 0.f, 0.f};
#pragma unroll 4
    for (int k4 = 0; k4 < 64; ++k4) { f32x4 p4[4];
#pragma unroll
        for (int qi = 0; qi < 4; ++qi) p4[qi] = *(const LAS f32x4*)(pb + qi * 256 + 4 * k4);
#pragma unroll
        for (int jj = 0; jj < 4; ++jj) { const float vv = bf2f(Vs[(4 * k4 + jj) * 64 + lane]);
#pragma unroll
            for (int qi = 0; qi < 4; ++qi) o[qi] += p4[qi][jj] * vv; } }
#pragma unroll
    for (int qi = 0; qi < 4; ++qi) oo[qi] = o[qi];
}
constexpr int AT_KS = 0, AT_VS = 33792, AT_WV = 66560, AT_WVB = 5120;

__device__ __forceinline__ void memattn_unit(LAS unsigned char* lds, const bf16* h, int NC, int qoff, const bf16* kv, bf16* mix, int unit, int tid, int wave, int lane) {
    const int chunk = unit & 31, bm = unit >> 5, mh = bm & 3, b = bm >> 2;
    LAS unsigned* Ks = (LAS unsigned*)(lds + AT_KS); LAS unsigned* Vs32 = (LAS unsigned*)(lds + AT_VS);
    LAS float* qst = (LAS float*)(lds + AT_WV + wave * AT_WVB); LAS float* pb = qst + 256;
    for (int i = 0; i < 16; ++i) { const int idx = tid + 512 * i, r = idx >> 5, dd = idx & 31; const unsigned* src = (const unsigned*)(kv + (size_t)(b * 256 + r) * 512 + mh * 64);
        Ks[r * 33 + dd] = src[dd]; Vs32[r * 32 + dd] = src[128 + dd]; }
    __syncthreads();
    for (int qd = 0; qd < 16; ++qd) { const size_t tg = (size_t)b * SEQ + chunk * 512 + wave * 64 + qd * 4;
#pragma unroll
        for (int qi = 0; qi < 4; ++qi) qst[qi * 64 + lane] = bf2f(h[(tg + qi) * NC + qoff + mh * 64 + lane]);
        const int tq[4] = {0, 0, 0, 0}; float m[4], l[4], o[4];
        attn4<false>(Ks, (const LAS bf16*)Vs32, qst, pb, lane, tq, 0, 0.f, m, l, o);
#pragma unroll
        for (int qi = 0; qi < 4; ++qi) mix[(tg + qi) * 1024 + MIXW + mh * 64 + lane] = (bf16)f2bf(o[qi] / l[qi]); }
    __syncthreads();
}

constexpr int AT2_K = 0, AT2_KROW = 176, AT2_V = 256 * AT2_KROW, AT2_VROW = 528, AT2_SCR = AT2_V + 64 * AT2_VROW, AT2_SCRW = 4864;
__device__ __forceinline__ void stage_kv_images(LAS unsigned char* lds, const bf16* kp, const bf16* vp, size_t row_stride, int tid) {
    v4u kx[4], vx[4];
#pragma unroll
    for (int i = 0; i < 4; ++i) { const int idx = tid + 512 * i, key = idx >> 3, c = idx & 7; kx[i] = *(const v4u*)(kp + (size_t)key * row_stride + 8 * c); vx[i] = *(const v4u*)(vp + (size_t)key * row_stride + 8 * c); }
    __builtin_amdgcn_sched_barrier(0);
#pragma unroll
    for (int i = 0; i < 4; ++i) { const int idx = tid + 512 * i, key = idx >> 3, c = idx & 7;
        *(LAS v4u*)(lds + AT2_K + key * AT2_KROW + c * 16) = kx[i];
        const int pos = (key & ~15) | (key & 3) | ((key & 4) << 1) | ((key & 8) >> 1);
        LAS bf16* vt = (LAS bf16*)(lds + AT2_V) + pos;
#pragma unroll
        for (int w = 0; w < 4; ++w) { vt[(8 * c + 2 * w) * (AT2_VROW / 2)] = (bf16)(vx[i][w] & 0xffffu); vt[(8 * c + 2 * w + 1) * (AT2_VROW / 2)] = (bf16)(vx[i][w] >> 16); } }
    if (tid < 256) { const unsigned pb = f2bf((float)tid); const v4u e0 = {pb | (pb << 16), 0x3F803F80u, 0u, 0u}, z = {0u, 0u, 0u, 0u};
        *(LAS v4u*)(lds + AT2_K + tid * AT2_KROW + 128) = e0; *(LAS v4u*)(lds + AT2_K + tid * AT2_KROW + 144) = z; }
}
template <bool MASK>
__device__ __forceinline__ void attn_tile32(const LAS unsigned char* lds, const s16x8 (&qf)[4], int lane, float dist0, unsigned qx, unsigned qx2, bool own, f32x16 (&o)[2], float& mrow, float& lrow) {
    const int r = lane & 31, hf = lane >> 5;
    const v4u qxv = {qx, qx2, 0u, 0u}; const s16x8 qe = __builtin_bit_cast(s16x8, qxv);
    f32x16 acc[8];
    const LAS unsigned char* kb = lds + AT2_K + r * AT2_KROW + hf * 16;
    constexpr int NKS = MASK ? 5 : 4;
    s16x8 kf[NKS];
#pragma unroll
    for (int s = 0; s < NKS; ++s) kf[s] = *(const LAS s16x8*)(kb + s * 32);
#pragma unroll
    for (int kt = 0; kt < 8; ++kt) {
#pragma unroll
        for (int i = 0; i < 16; ++i) acc[kt][i] = 0.f;
#pragma unroll
        for (int s = 0; s < NKS; ++s) { acc[kt] = __builtin_amdgcn_mfma_f32_32x32x16_bf16(kf[s], s < 4 ? qf[s < 4 ? s : 0] : qe, acc[kt], 0, 0, 0);
            if (kt + 1 < 8) kf[s] = *(const LAS s16x8*)(kb + (kt + 1) * 32 * AT2_KROW + s * 32); }
        __builtin_amdgcn_sched_barrier(0); }
    float mx = -INFINITY;
    if (MASK) { mx = 0.f;
        if (own) { const float base2 = dist0 - 4.f * (float)hf;
#pragma unroll
            for (int kt = 0; kt < 8; ++kt)
#pragma unroll
                for (int i = 0; i < 16; ++i) { const float dist = base2 - (float)(32 * kt + (i & 3) + 8 * (i >> 2)); acc[kt][i] = dist < 0.f ? -INFINITY : acc[kt][i]; } }
    } else {
#pragma unroll
        for (int kt = 0; kt < 8; ++kt)
#pragma unroll
            for (int i = 0; i < 16; ++i) mx = fmaxf(mx, acc[kt][i]);
        mx = fmaxf(mx, xor32f(mx, lane));
    }
    f32x2 sum2 = {0.f, 0.f};
#pragma unroll
    for (int i = 0; i < 16; ++i) { o[0][i] = 0.f; o[1][i] = 0.f; }
    const LAS unsigned char* vb = lds + AT2_V + r * AT2_VROW + hf * 16;
    s16x8 vf[4];
#pragma unroll
    for (int s2 = 0; s2 < 2; ++s2)
#pragma unroll
        for (int dt = 0; dt < 2; ++dt) vf[2 * s2 + dt] = *(const LAS s16x8*)(vb + dt * 32 * AT2_VROW + (16 * s2) * 2);
#pragma unroll
    for (int kt = 0; kt < 8; ++kt) {
#pragma unroll
        for (int i = 0; i < 16; ++i) acc[kt][i] = __builtin_amdgcn_exp2f(MASK ? acc[kt][i] : acc[kt][i] - mx);
#pragma unroll
        for (int i = 0; i < 8; ++i) sum2 += (f32x2){acc[kt][2 * i], acc[kt][2 * i + 1]};
#pragma unroll
        for (int s2 = 0; s2 < 2; ++s2) { v4u pw; pw.x = cvtpk(acc[kt][8 * s2], acc[kt][8 * s2 + 1]); pw.y = cvtpk(acc[kt][8 * s2 + 2], acc[kt][8 * s2 + 3]);
            pw.z = cvtpk(acc[kt][8 * s2 + 4], acc[kt][8 * s2 + 5]); pw.w = cvtpk(acc[kt][8 * s2 + 6], acc[kt][8 * s2 + 7]); const s16x8 pf = __builtin_bit_cast(s16x8, pw);
#pragma unroll
            for (int dt = 0; dt < 2; ++dt) { o[dt] = __builtin_amdgcn_mfma_f32_32x32x16_bf16(vf[2 * s2 + dt], pf, o[dt], 0, 0, 0);
                if (kt + 1 < 8) vf[2 * s2 + dt] = *(const LAS s16x8*)(vb + dt * 32 * AT2_VROW + (32 * (kt + 1) + 16 * s2) * 2); } }
        __builtin_amdgcn_sched_barrier(0); }
    float sum = sum2.x + sum2.y; sum += xor32f(sum, lane);
    if (!MASK) mrow = mx;
    lrow = sum;
}
__device__ __forceinline__ void memattn_unit2(LAS unsigned char* lds, const bf16* h, int NC, int qoff, const bf16* kv  , bf16* mix, int unit, int tid, int wave, int lane) {
    const int chunk = unit & 63, bm = unit >> 6, mh = bm & 3, b = bm >> 2, r = lane & 31, hf = lane >> 5;
    const bf16* kvrow0 = kv + (size_t)(b * 256) * 2048 + mh * 64;
    stage_kv_images(lds, kvrow0, kvrow0 + 256, 2048, tid);
    __syncthreads();
    { const size_t tg = (size_t)b * SEQ + chunk * 256 + wave * 32 + r;
        f32x16 o[2]; float m2, l; s16x8 qf[4];
#pragma unroll
        for (int s = 0; s < 4; ++s) qf[s] = *(const s16x8*)(h + tg * NC + qoff + mh * 64 + 16 * s + 8 * hf);
        attn_tile32<false>(lds, qf, lane, 0.f, 0u, 0u, false, o, m2, l);
        const float inv = 1.f / l; bf16* mp = mix + tg * 1024 + MIXW + mh * 64 + 4 * hf;
#pragma unroll
        for (int dt = 0; dt < 2; ++dt)
#pragma unroll
            for (int g = 0; g < 4; ++g) { v2u w; w.x = cvtpk(o[dt][4 * g] * inv, o[dt][4 * g + 1] * inv); w.y = cvtpk(o[dt][4 * g + 2] * inv, o[dt][4 * g + 3] * inv); *(v2u*)(mp + 32 * dt + 8 * g) = w; } }
    __syncthreads();
}
__device__ __forceinline__ void kmean_unit(LAS unsigned char* lds, const bf16* h, float* kmean, float* kmaxg, int unit, int tid, int wave) {
    const int n = unit & 63, bh = unit >> 6, hh = bh % MB_H, b = bh / MB_H, d = tid & 63, part = tid >> 6;
    LAS float* red = (LAS float*)lds;
    float s = 0.f; const bf16* p = h + ((size_t)b * SEQ + n * 256 + part * 32) * NC_M + 768 + hh * 64 + d;
    for (int i = 0; i < 32; ++i) s += bf2f(p[(size_t)i * NC_M]);
    float ss = 0.f; { const v4u* kp = (const v4u*)(h + ((size_t)b * SEQ + n * 256 + (tid >> 1)) * NC_M + 768 + hh * 64 + (tid & 1) * 32);
#pragma unroll
        for (int w = 0; w < 4; ++w) { const v4u x = kp[w]; ss += bflo(x.x) * bflo(x.x) + bfhi(x.x) * bfhi(x.x) + bflo(x.y) * bflo(x.y) + bfhi(x.y) * bfhi(x.y) + bflo(x.z) * bflo(x.z) + bfhi(x.z) * bfhi(x.z) + bflo(x.w) * bflo(x.w) + bfhi(x.w) * bfhi(x.w); } }
    ss += xorf<1>(ss); ss = wave_max(ss);
    red[part * 64 + d] = s; if ((tid & 63) == 0) red[512 + wave] = ss; __syncthreads();
    if (tid < 64) { float a = 0.f; for (int pp = 0; pp < 8; ++pp) a += red[pp * 64 + tid]; a *= (1.f / 256.f);
        const unsigned hi = f2bf(a), lo = f2bf(a - __builtin_bit_cast(float, hi << 16)); bf16* kmh = (bf16*)kmean; kmh[((size_t)bh * 64 + n) * 64 + tid] = (bf16)hi; kmh[(size_t)24 * 4096 + ((size_t)bh * 64 + n) * 64 + tid] = (bf16)lo; }
    if (tid == 0) { float mx = 0.f; for (int w = 0; w < 8; ++w) mx = fmaxf(mx, red[512 + w]); kmaxg[bh * 64 + n] = sqrtf(mx) * 1.001f; }
    __syncthreads();
}
__device__ __forceinline__ void gate_unit_core(const s16x8 (&qf)[4], const s16x8 (&kf)[4], const bf16* kmh, const bf16* kml, LAS int* hist, const LAS float* kmx, int* selinfo, int bh, int c, int t, int lane, unsigned& sel, unsigned& rr) {
    const int hh = bh % MB_H, b = bh / MB_H, hf = lane >> 5, r = lane & 31;
    int s0 = 0, s1 = 0, s2 = 0, r0 = 0, r1 = 0, r2 = 0, ns = 0;
    float v0 = -INFINITY, v1 = -INFINITY, v2 = -INFINITY, qn = 0.f, lown = 0.f;
    if (c > 0) {
        const int ntile = (c + 31) >> 5, ch = c - 4 * hf;
        s16x8 ah[2][4], al[2][4];
#pragma unroll
        for (int tile = 0; tile < 2; ++tile) if (tile < ntile) { const size_t ko = ((size_t)bh * 64 + 32 * tile + r) * 64 + 8 * hf;
#pragma unroll
            for (int ks = 0; ks < 4; ++ks) { ah[tile][ks] = *(const s16x8*)(kmh + ko + 16 * ks); al[tile][ks] = *(const s16x8*)(kml + ko + 16 * ks); } }
#pragma unroll
        for (int tile = 0; tile < 2; ++tile) if (tile < ntile) {
            f32x16 X;
#pragma unroll
            for (int i = 0; i < 16; ++i) X[i] = 0.f;
#pragma unroll
            for (int ks = 0; ks < 4; ++ks) { X = __builtin_amdgcn_mfma_f32_32x32x16_bf16(ah[tile][ks], qf[ks], X, 0, 0, 0); X = __builtin_amdgcn_mfma_f32_32x32x16_bf16(al[tile][ks], qf[ks], X, 0, 0, 0); }
#pragma unroll
            for (int i = 0; i < 16; ++i) { const int n = 32 * tile + (i & 3) + 8 * (i >> 2); const float g = (n < ch) ? X[i] : -INFINITY;
                if (g > v0) { v2 = v1; s2 = s1; v1 = v0; s1 = s0; v0 = g; s0 = n; } else if (g > v1) { v2 = v1; s2 = s1; v1 = g; s1 = n; } else if (g > v2) { v2 = g; s2 = n; } }
        }
        s0 += 4 * hf; s1 += 4 * hf; s2 += 4 * hf;
        { float qq = 0.f, qk = 0.f;
#pragma unroll
          for (int s = 0; s < 4; ++s)
#pragma unroll
              for (int jj = 0; jj < 8; ++jj) { const float qv = bf2f((bf16)qf[s][jj]), kv = bf2f((bf16)kf[s][jj]); qq += qv * qv; qk += qv * kv; }
          qq += xor32f(qq, lane); qk += xor32f(qk, lane);
          qn = sqrtf(qq) * 1.001f; lown = qk; }
        { float pv[3]; int ps[3]; const int pl = (lane ^ 32) << 2;
          pv[0] = __builtin_bit_cast(float, __builtin_amdgcn_ds_bpermute(pl, __builtin_bit_cast(int, v0))); pv[1] = __builtin_bit_cast(float, __builtin_amdgcn_ds_bpermute(pl, __builtin_bit_cast(int, v1)));
          pv[2] = __builtin_bit_cast(float, __builtin_amdgcn_ds_bpermute(pl, __builtin_bit_cast(int, v2)));
          ps[0] = __builtin_amdgcn_ds_bpermute(pl, s0); ps[1] = __builtin_amdgcn_ds_bpermute(pl, s1); ps[2] = __builtin_amdgcn_ds_bpermute(pl, s2);
#pragma unroll
          for (int k = 0; k < 3; ++k) { const float g = pv[k]; const int n = ps[k];
              if (g > v0 || (g == v0 && n < s0)) { v2 = v1; s2 = s1; v1 = v0; s1 = s0; v0 = g; s0 = n; } else if (g > v1 || (g == v1 && n < s1)) { v2 = v1; s2 = s1; v1 = g; s1 = n; } else if (g > v2 || (g == v2 && n < s2)) { v2 = g; s2 = n; } } }
    }
    sel = 0u; rr = 0u;
    if (hf == 0) {
        ns = c < 3 ? c : 3; s0 &= 63; s1 &= 63; s2 &= 63;
        { const float slope2 = (hh < 8 ? ldexpf(1.0f, -(hh + 1)) : ldexpf(0.70710678118654752f, -(hh - 8))) * 1.4426950408889634f;
          const bool k0 = ns > 0 && (qn * kmx[s0] - slope2 * (float)(t - (s0 * 256 + 255)) - lown) > -64.f;
          const bool k1 = ns > 1 && (qn * kmx[s1] - slope2 * (float)(t - (s1 * 256 + 255)) - lown) > -64.f;
          const bool k2 = ns > 2 && (qn * kmx[s2] - slope2 * (float)(t - (s2 * 256 + 255)) - lown) > -64.f;
          ns = (k0 ? 1 : 0) | (k1 ? 2 : 0) | (k2 ? 4 : 0); }
        if (ns & 1) r0 = __hip_atomic_fetch_add(hist + s0, 1, __ATOMIC_RELAXED, __HIP_MEMORY_SCOPE_WORKGROUP);
        if (ns & 2) r1 = __hip_atomic_fetch_add(hist + s1, 1, __ATOMIC_RELAXED, __HIP_MEMORY_SCOPE_WORKGROUP);
        if (ns & 4) r2 = __hip_atomic_fetch_add(hist + s2, 1, __ATOMIC_RELAXED, __HIP_MEMORY_SCOPE_WORKGROUP);
        selinfo[((size_t)b * SEQ + t) * MB_H + hh] = ns;
        sel = (unsigned)s0 | ((unsigned)s1 << 6) | ((unsigned)s2 << 12) | ((unsigned)ns << 18); rr = (unsigned)r0 | ((unsigned)r1 << 8) | ((unsigned)r2 << 16);
    }
}
__device__ __forceinline__ void moba_gate_wg(LAS unsigned char* lds, const bf16* h, const float* kmean, const float* kmaxg, unsigned* gcount, int* selinfo, unsigned* list, int blk, int tid) {
    constexpr int NU = 24 * MB_NB / GRID;
    static_assert(NU * GRID == 24 * MB_NB && GRID % 64 == 0 && NU * 64 <= NTHR, "gate deal");
    const int lane = tid & 63, r = lane & 31, hf = lane >> 5, wv = tid >> 6;
    const bf16* kmh = (const bf16*)kmean; const bf16* kml = kmh + (size_t)24 * 4096;
    LAS int* hist = (LAS int*)(lds + 16384); LAS int* base = hist + NU * 64; LAS float* kmx = (LAS float*)(base + NU * 64);
    if (tid < NU * 64) { const int bh = (blk >> 6) + 4 * (tid >> 6); hist[tid] = 0; kmx[tid] = kmaxg[bh * 64 + (tid & 63)]; }
    unsigned sel[NU], rr[NU];
    s16x8 qf[4], kf[4];
#define GU_BH(k) ((blk >> 6) + 4 * (k))
#define GU_C(k) (((k) & 1) ? 63 - (blk & 63) : (blk & 63))
#define GU_T(k) (GU_C(k) * 256 + wv * 32 + r)
    { const bf16* qp = h + ((size_t)(GU_BH(0) / MB_H) * SEQ + GU_T(0)) * NC_M + (GU_BH(0) % MB_H) * 64 + 8 * hf;
#pragma unroll
      for (int s = 0; s < 4; ++s) { qf[s] = *(const s16x8*)(qp + 16 * s); kf[s] = *(const s16x8*)(qp + 768 + 16 * s); } }
    __syncthreads();
#pragma unroll
    for (int k = 0; k < NU; ++k) {
        s16x8 qn_[4], kn_[4];
        if (k + 1 < NU) { const bf16* qp = h + ((size_t)(GU_BH(k + 1) / MB_H) * SEQ + GU_T(k + 1)) * NC_M + (GU_BH(k + 1) % MB_H) * 64 + 8 * hf;
#pragma unroll
            for (int s = 0; s < 4; ++s) { qn_[s] = *(const s16x8*)(qp + 16 * s); kn_[s] = *(const s16x8*)(qp + 768 + 16 * s); } }
        gate_unit_core(qf, kf, kmh, kml, hist + k * 64, kmx + k * 64, selinfo, GU_BH(k), GU_C(k), GU_T(k), lane, sel[k], rr[k]);
        if (k + 1 < NU) {
#pragma unroll
            for (int s = 0; s < 4; ++s) { qf[s] = qn_[s]; kf[s] = kn_[s]; } }
    }
    __syncthreads();
    if (tid < NU * 64) { const int hc = hist[tid]; if (hc > 0) base[tid] = (int)__hip_atomic_fetch_add(gcount + GU_BH(tid >> 6) * 64 + (tid & 63), (unsigned)hc, __ATOMIC_RELAXED, __HIP_MEMORY_SCOPE_AGENT); }
    __syncthreads();
    if (hf == 0) {
#pragma unroll
        for (int k = 0; k < NU; ++k) { unsigned* lp = list + ((size_t)GU_BH(k) * 64 << 14); const unsigned sl = sel[k], rk = rr[k], t = (unsigned)GU_T(k); const int s0 = sl & 63, s1 = (sl >> 6) & 63, s2 = (sl >> 12) & 63;
            if (sl & (1u << 18)) lp[((size_t)s0 << 14) + base[k * 64 + s0] + (rk & 255u)] = t;
            if (sl & (2u << 18)) lp[((size_t)s1 << 14) + base[k * 64 + s1] + ((rk >> 8) & 255u)] = t | (1u << 14);
            if (sl & (4u << 18)) lp[((size_t)s2 << 14) + base[k * 64 + s2] + ((rk >> 16) & 255u)] = t | (2u << 14); } }
#undef GU_BH
#undef GU_C
#undef GU_T
    __syncthreads();
}
__device__ __forceinline__ void moba_attn_item(LAS unsigned char* lds, const bf16* h, const unsigned* gcount, const unsigned* list, float* po, float* pml, int item, int tid, int wave, int lane) {
    const int n = item / 24, bh = item - n * 24, hh = bh % MB_H, b = bh / MB_H;
    LAS unsigned* Ks = (LAS unsigned*)(lds + AT_KS); LAS unsigned* Vs32 = (LAS unsigned*)(lds + AT_VS);
    LAS float* qst = (LAS float*)(lds + AT_WV + wave * AT_WVB); LAS float* pb = qst + 256;
    for (int i = 0; i < 16; ++i) { const int idx = tid + 512 * i, r = idx >> 5, dd = idx & 31; const unsigned* src = (const unsigned*)(h + ((size_t)b * SEQ + n * 256 + r) * NC_M + hh * 64);
        Ks[r * 33 + dd] = src[384 + dd]; Vs32[r * 32 + dd] = src[768 + dd]; }
    __syncthreads();
    const int cnt = (int)gcount[bh * 64 + n], total = 256 + cnt, nquads = (total + 3) >> 2;
    const float slope = hh < 8 ? ldexpf(1.0f, -(hh + 1)) : ldexpf(0.70710678118654752f, -(hh - 8));
    const unsigned* lp = list + (((size_t)bh * 64 + n) << 14);
    for (int quad = wave; quad < nquads; quad += 8) {
        int tq[4], slot[4];
#pragma unroll
        for (int qi = 0; qi < 4; ++qi) { int idx = quad * 4 + qi; idx = idx < total ? idx : total - 1;
            if (idx < 256) { tq[qi] = n * 256 + idx; slot[qi] = 3; } else { const unsigned e = lp[idx - 256]; tq[qi] = (int)(e & 16383u); slot[qi] = (int)(e >> 14); } }
#pragma unroll
        for (int qi = 0; qi < 4; ++qi) qst[qi * 64 + lane] = bf2f(h[((size_t)b * SEQ + tq[qi]) * NC_M + hh * 64 + lane]);
        float m[4], l[4], o[4];
        attn4<true>(Ks, (const LAS bf16*)Vs32, qst, pb, lane, tq, n * 256, slope, m, l, o);
#pragma unroll
        for (int qi = 0; qi < 4; ++qi) if (quad * 4 + qi < total) { const size_t pi = (((size_t)b * SEQ + tq[qi]) * MB_H + hh) * 4 + slot[qi];
            po[pi * 64 + lane] = o[qi]; if (lane == 0) { pml[pi * 2] = m[qi]; pml[pi * 2 + 1] = l[qi]; } }
    }
    __syncthreads();
}

__device__ __forceinline__ void moba_attn_item2(LAS unsigned char* lds, const bf16* h, const float* kmaxg, const unsigned* gcount, const unsigned* list, bf16* po, float* pml, int item, int tid, int wave, int lane) {
    const int n = item / 24, bh = item - n * 24, hh = bh % MB_H, b = bh / MB_H, r = lane & 31, hf = lane >> 5;
    const bf16* hrow0 = h + ((size_t)b * SEQ + n * 256) * NC_M + hh * 64;
    stage_kv_images(lds, hrow0 + 768, hrow0 + 1536, NC_M, tid);
    __syncthreads();
    const int cnt = (int)gcount[bh * 64 + n], total = 256 + cnt, ntiles = (total + 31) >> 5;
    const float slope2 = (hh < 8 ? ldexpf(1.0f, -(hh + 1)) : ldexpf(0.70710678118654752f, -(hh - 8))) * 1.4426950408889634f;
    const unsigned shi = f2bf(slope2), slo = f2bf(slope2 - __builtin_bit_cast(float, shi << 16)); const unsigned qx = hf == 0 ? (shi | (slo << 16)) : 0u;
    const unsigned* lp = list + (((size_t)bh * 64 + n) << 14);
    const float kmx1 = kmaxg[bh * 64 + n];
    const bf16* hq = h + (size_t)b * SEQ * NC_M + hh * 64 + 8 * hf;
#pragma unroll 1
    for (int tile = wave; tile < ntiles; tile += NWAVES) {
        int idx = tile * 32 + r; const bool valid = idx < total; idx = valid ? idx : total - 1;
        int tq, slot; if (idx < 256) { tq = n * 256 + idx; slot = 3; } else { const unsigned e = lp[idx - 256]; tq = (int)(e & 16383u); slot = (int)(e >> 14); }
        s16x8 qf[4]; { const bf16* qp = hq + (size_t)tq * NC_M;
#pragma unroll
            for (int s = 0; s < 4; ++s) qf[s] = *(const s16x8*)(qp + 16 * s); }
        f32x16 o[2]; float m2, l; const float dist0 = (float)(tq - n * 256);
        unsigned qx2;
        { float qq = 0.f;
#pragma unroll
          for (int s = 0; s < 4; ++s)
#pragma unroll
              for (int jj = 0; jj < 8; ++jj) { const float qv = bf2f((bf16)qf[s][jj]); qq += qv * qv; }
          qq += xor32f(qq, lane);
          const float sh = sqrtf(qq) * kmx1 + slope2 * fminf(dist0, 255.f);
          const unsigned nh = f2bf(-sh), nl = f2bf(-sh - __builtin_bit_cast(float, nh << 16)); qx2 = hf == 0 ? (nh | (nl << 16)) : 0u;
          m2 = -(__builtin_bit_cast(float, nh << 16) + __builtin_bit_cast(float, nl << 16)); }
        attn_tile32<true>(lds, qf, lane, dist0, qx, qx2, tile < 8, o, m2, l);
        { LAS unsigned char* sw = lds + AT2_SCR + wave * AT2_SCRW; const int pi = valid ? (int)((((size_t)b * SEQ + tq) * MB_H + hh) * 4 + slot) : -1;
#pragma unroll
          for (int dt = 0; dt < 2; ++dt)
#pragma unroll
              for (int g = 0; g < 4; ++g) { v2u w; w.x = cvtpk(o[dt][4 * g], o[dt][4 * g + 1]); w.y = cvtpk(o[dt][4 * g + 2], o[dt][4 * g + 3]); *(LAS v2u*)(sw + r * 144 + (32 * dt + 8 * g + 4 * hf) * 2) = w; }
          if (hf == 0) { *(LAS int*)(sw + 4608 + 4 * r) = pi; if (valid) { pml[(size_t)pi * 2] = m2 - slope2 * dist0; pml[(size_t)pi * 2 + 1] = l; } }
#pragma unroll
          for (int it = 0; it < 4; ++it) { const int q = 8 * it + (lane >> 3), c = lane & 7; const int pq = *(const LAS int*)(sw + 4608 + 4 * q); const v4u row = *(const LAS v4u*)(sw + q * 144 + c * 16);
              if (pq >= 0) *(v4u*)(po + (size_t)pq * 64 + c * 8) = row; } }
    }
    __syncthreads();
}
__device__ __forceinline__ void moba_combine(const bf16* __restrict__ po, const float* __restrict__ pml, const int* __restrict__ selinfo, bf16* __restrict__ mix, int gw, int ngw, int lane) {
    const int sub = lane >> 4, d4 = (lane & 15) * 4;
#pragma unroll 4
    for (int idx = gw * 4 + sub; idx < T * MB_H; idx += ngw * 4) { const int tg = idx / MB_H, hh = idx - tg * MB_H, ns = selinfo[idx]; const size_t p4 = (size_t)idx * 4;
        f32x2 ml[4]; f32x4 ov[4];
#pragma unroll
        for (int j = 0; j < 4; ++j) { ml[j] = ((const f32x2*)pml)[p4 + j]; const v2u ow = *(const v2u*)(po + (p4 + j) * 64 + d4); ov[j] = (f32x4){bflo(ow.x), bfhi(ow.x), bflo(ow.y), bfhi(ow.y)}; }
        float M = ml[3].x;
#pragma unroll
        for (int j = 0; j < 3; ++j) { const bool ok = (ns >> j) & 1; ml[j].x = ok ? ml[j].x : -INFINITY; ml[j].y = ok ? ml[j].y : 0.f; M = fmaxf(M, ml[j].x);
            ov[j].x = ok ? ov[j].x : 0.f; ov[j].y = ok ? ov[j].y : 0.f; ov[j].z = ok ? ov[j].z : 0.f; ov[j].w = ok ? ov[j].w : 0.f; }
        float den = 0.f; f32x4 num = {0.f, 0.f, 0.f, 0.f};
#pragma unroll
        for (int j = 0; j < 4; ++j) { const float w = __builtin_amdgcn_exp2f(ml[j].x - M); den += w * ml[j].y; num += ov[j] * w; }
        const float inv = 1.f / den; v2u o; o.x = pk2(num.x * inv, num.y * inv); o.y = pk2(num.z * inv, num.w * inv);
        *(v2u*)(mix + (size_t)tg * 1024 + hh * 64 + d4) = o; }
}

template <int CTRL> __device__ __forceinline__ float dppf(float v) { return __builtin_bit_cast(float, __builtin_amdgcn_update_dpp(0, __builtin_bit_cast(int, v), CTRL, 0xF, 0xF, true)); }
template <int CTRL> __device__ __forceinline__ int dppi(int v) { return __builtin_amdgcn_update_dpp(0, v, CTRL, 0xF, 0xF, true); }
__device__ __forceinline__ float wave_sum_dpp(float v) {
    v += dppf<0xB1>(v); v += dppf<0x4E>(v); v += dppf<0x141>(v); v += dppf<0x140>(v);
    v += __builtin_bit_cast(float, __builtin_amdgcn_update_dpp(0, __builtin_bit_cast(int, v), 0x142, 0xA, 0xF, false));
    v += __builtin_bit_cast(float, __builtin_amdgcn_update_dpp(0, __builtin_bit_cast(int, v), 0x143, 0xC, 0xF, false));
    return __builtin_bit_cast(float, __builtin_amdgcn_readlane(__builtin_bit_cast(int, v), 63));
}
__device__ __forceinline__ void ln_row(f32x4 (&v)[4], const f32x4 (&gv)[4], const f32x4 (&bv)[4]) {
    float s = 0.f;
#pragma unroll
    for (int j = 0; j < 4; ++j) s += (v[j].x + v[j].y) + (v[j].z + v[j].w);
    const float mean = wave_sum_dpp(s) * (1.f / D); float s2 = 0.f;
#pragma unroll
    for (int j = 0; j < 4; ++j) { v[j] = v[j] - mean; s2 += (v[j].x * v[j].x + v[j].y * v[j].y) + (v[j].z * v[j].z + v[j].w * v[j].w); }
    const float rstd = __builtin_amdgcn_rsqf(wave_sum_dpp(s2) * (1.f / D) + 1e-5f);
#pragma unroll
    for (int j = 0; j < 4; ++j) v[j] = v[j] * rstd * gv[j] + bv[j];
}
__device__ __forceinline__ void split_router_weights(const float* wr  , bf16* wrs  , size_t gtid, size_t gthreads) {
    for (size_t i = gtid; i < (size_t)DEPTH * D * NE; i += gthreads) { const int e = (int)(i & 31), d = (int)((i >> 5) & 1023), l = (int)(i >> 15);
        const float w = wr[i]; const unsigned hi = f2bf(w); const unsigned lo = f2bf(w - __builtin_bit_cast(float, hi << 16));
        wrs[(((size_t)l * 2 + 0) * NE + e) * D + d] = (bf16)hi; wrs[(((size_t)l * 2 + 1) * NE + e) * D + d] = (bf16)lo; }
}
constexpr int L1_XH = 0, L1_XL = 33024, L1_ROW = 2064, L1_PART = 66048, L1_HIST = 82432, L1_TOK = 82944;
__device__ __forceinline__ void phase_ln1(LAS unsigned char* lds, const bf16* y, const float* g, const float* bb, const bf16* wrs  , const float* br,
                                          bf16* xbf, int* tok_e, int* tok_lr, float* tok_w, int* blk_cnt, int blk, int tid, int wave, int lane) {
    LAS float* part = (LAS float*)(lds + L1_PART);
    LAS int* hist = (LAS int*)(lds + L1_HIST); LAS int* tokl = (LAS int*)(lds + L1_TOK);
    if (tid < 32) hist[tid] = 0;
    constexpr int TPB = T / GRID;
    const int e = lane & 31, m16 = lane & 15, quad = lane >> 4;
    s16x8 bw[4][2][2];
#pragma unroll
    for (int ks = 0; ks < 4; ++ks)
#pragma unroll
        for (int nt = 0; nt < 2; ++nt)
#pragma unroll
            for (int pp = 0; pp < 2; ++pp) bw[ks][nt][pp] = *(const s16x8*)(wrs + ((size_t)pp * NE + 16 * nt + m16) * D + wave * 128 + 32 * ks + 8 * quad);
    const float bre = br[e];
    f32x4 gv[4], bv[4];
#pragma unroll
    for (int j = 0; j < 4; ++j) { gv[j] = ((const f32x4*)g)[lane + 64 * j]; bv[j] = ((const f32x4*)bb)[lane + 64 * j]; }
    v2u xn[2][4], yn[2][4];
#pragma unroll
    for (int u = 0; u < 2; ++u) { const size_t t0 = (size_t)blk * TPB + 2 * wave + u; const v2u* xr = (const v2u*)(xbf + t0 * D) + lane; const v2u* yr = (const v2u*)(y + t0 * D) + lane;
#pragma unroll
        for (int j = 0; j < 4; ++j) { xn[u][j] = xr[64 * j]; yn[u][j] = yr[64 * j]; } }
#pragma unroll
    for (int j = 0; j < 4; ++j) asm volatile("" :: "v"(gv[j]), "v"(bv[j]), "v"(xn[0][j]), "v"(xn[1][j]), "v"(yn[0][j]), "v"(yn[1][j]));
#pragma unroll
    for (int ks = 0; ks < 4; ++ks) asm volatile("" :: "v"(bw[ks][0][0]), "v"(bw[ks][0][1]), "v"(bw[ks][1][0]), "v"(bw[ks][1][1]));
    asm volatile("" :: "v"(bre));
    __syncthreads();
    for (int grp = 0; grp < TPB / 16; ++grp) { const size_t tg0 = (size_t)blk * TPB + grp * 16 + 2 * wave;
        f32x4 v[2][4];
#pragma unroll
        for (int u = 0; u < 2; ++u)
#pragma unroll
            for (int j = 0; j < 4; ++j) { const v2u xw = xn[u][j]; const v2u yw = yn[u][j];
                v[u][j].x = DN_ALPHA * bflo(xw.x) + bflo(yw.x); v[u][j].y = DN_ALPHA * bfhi(xw.x) + bfhi(yw.x); v[u][j].z = DN_ALPHA * bflo(xw.y) + bflo(yw.y); v[u][j].w = DN_ALPHA * bfhi(xw.y) + bfhi(yw.y); }
        if (grp + 1 < TPB / 16) {
#pragma unroll
            for (int u = 0; u < 2; ++u) { const v2u* xr = (const v2u*)(xbf + (tg0 + 16 + u) * D) + lane; const v2u* yr = (const v2u*)(y + (tg0 + 16 + u) * D) + lane;
#pragma unroll
                for (int j = 0; j < 4; ++j) { xn[u][j] = xr[64 * j]; yn[u][j] = yr[64 * j]; } } }
#pragma unroll
        for (int u = 0; u < 2; ++u) { ln_row(v[u], gv, bv);
            v2u* xb = (v2u*)(xbf + (tg0 + u) * D) + lane;
#pragma unroll
            for (int j = 0; j < 4; ++j) { v2u hw; hw.x = cvtpk(v[u][j].x, v[u][j].y); hw.y = cvtpk(v[u][j].z, v[u][j].w); xb[64 * j] = hw;
                v2u lw; lw.x = cvtpk(v[u][j].x - bflo(hw.x), v[u][j].y - bfhi(hw.x)); lw.y = cvtpk(v[u][j].z - bflo(hw.y), v[u][j].w - bfhi(hw.y));
                *(LAS v2u*)(lds + L1_XH + (2 * wave + u) * L1_ROW + (4 * lane + 256 * j) * 2) = hw; *(LAS v2u*)(lds + L1_XL + (2 * wave + u) * L1_ROW + (4 * lane + 256 * j) * 2) = lw; } }
        __syncthreads();
        { f32x4 acc[2] = {{0.f, 0.f, 0.f, 0.f}, {0.f, 0.f, 0.f, 0.f}};
#pragma unroll
          for (int ks = 0; ks < 4; ++ks) { const int off = m16 * L1_ROW + (wave * 128 + 32 * ks + 8 * quad) * 2;
              const s16x8 ah = *(const LAS s16x8*)(lds + L1_XH + off), al = *(const LAS s16x8*)(lds + L1_XL + off);
#pragma unroll
              for (int nt = 0; nt < 2; ++nt) { acc[nt] = __builtin_amdgcn_mfma_f32_16x16x32_bf16(ah, bw[ks][nt][0], acc[nt], 0, 0, 0); acc[nt] = __builtin_amdgcn_mfma_f32_16x16x32_bf16(ah, bw[ks][nt][1], acc[nt], 0, 0, 0);
                  acc[nt] = __builtin_amdgcn_mfma_f32_16x16x32_bf16(al, bw[ks][nt][0], acc[nt], 0, 0, 0); } }
#pragma unroll
          for (int nt = 0; nt < 2; ++nt)
#pragma unroll
              for (int jj = 0; jj < 4; ++jj) part[(wave * 16 + 4 * quad + jj) * 32 + 16 * nt + m16] = acc[nt][jj]; }
        __syncthreads();
#pragma unroll
        for (int u = 0; u < 2; ++u) { const size_t t = tg0 + u;
            float logit = bre;
#pragma unroll
            for (int w = 0; w < 8; ++w) logit += part[(w * 16 + 2 * wave + u) * 32 + e];
            int se[4]; float sv[4]; int cur = __builtin_bit_cast(int, logit); cur ^= (cur >> 31) & 0x7fffffff;
#pragma unroll
            for (int k = 0; k < 4; ++k) { int m = cur;
                m = max(m, dppi<0xB1>(m)); m = max(m, dppi<0x4E>(m)); m = max(m, dppi<0x141>(m)); m = max(m, dppi<0x140>(m));
                const int mm = max(__builtin_amdgcn_readlane(m, 0), __builtin_amdgcn_readlane(m, 16));
                const unsigned long long mk = __ballot(cur == mm); const int src = __builtin_ctzll(mk);
                se[k] = src; sv[k] = __builtin_bit_cast(float, mm ^ ((mm >> 31) & 0x7fffffff)); cur = (e == src) ? (int)0x80000000 : cur; }
            const float e1 = __expf(sv[1] - sv[0]), e2 = __expf(sv[2] - sv[0]), e3 = __expf(sv[3] - sv[0]), inv = __builtin_amdgcn_rcpf(1.f + e1 + e2 + e3);
            const float wk[4] = {inv, e1 * inv, e2 * inv, e3 * inv};
            if (lane == 0) { const int tl = (grp * 16 + 2 * wave + u) * 4;
#pragma unroll
                for (int k = 0; k < 4; ++k) { const int lr = __hip_atomic_fetch_add(hist + se[k], 1, __ATOMIC_RELAXED, __HIP_MEMORY_SCOPE_WORKGROUP);
                    tokl[tl + k] = se[k]; tokl[512 + tl + k] = lr; tokl[1024 + tl + k] = __builtin_bit_cast(int, wk[k]); } } }
    }
    __syncthreads();
    if (tid < 32) blk_cnt[blk * 32 + tid] = hist[tid];
    { const size_t ti = (size_t)blk * TPB * 4 + tid; tok_e[ti] = tokl[tid]; tok_lr[ti] = tokl[512 + tid]; tok_w[ti] = __builtin_bit_cast(float, tokl[1024 + tid]); }
    __syncthreads();
}
__device__ __forceinline__ void phase_dispatch(LAS unsigned char* lds, const int* __restrict__ blk_cnt, const int* __restrict__ tok_e, const int* __restrict__ tok_lr, int* __restrict__ tok_row, int* __restrict__ tab,
                                               const bf16* __restrict__ xbf, bf16* __restrict__ xs, int blk, int tid, int wave, int lane) {
    LAS int* tot = (LAS int*)lds; LAS int* pre = tot + 32; LAS int* pst = pre + 32; LAS int* rows = pst + 64;
    if (tid < 32) { int s = 0, p = 0;
#pragma unroll 8
        for (int bb = 0; bb < GRID; ++bb) { const int c = blk_cnt[bb * 32 + tid]; p += (bb < blk) ? c : 0; s += c; } tot[tid] = s; pre[tid] = p; }
    __syncthreads();
    if (tid == 0) { int acc = 0; for (int e = 0; e < 32; ++e) { pst[e] = acc; acc += ((tot[e] + 255) >> 8) << 8; } pst[32] = acc; }
    __syncthreads();
    if (blk == 0 && tid < 33) tab[tid] = pst[tid] >> 8;
    constexpr int TPB = T / GRID;
    static_assert(TPB * 4 == NTHR, "one (token, k) pair per thread");
    { const size_t ti = (size_t)blk * TPB * 4 + tid; const int e = tok_e[ti]; const int r = pst[e] + pre[e] + tok_lr[ti]; tok_row[ti] = r; rows[tid] = r; }
    __syncthreads();
#pragma unroll 4
    for (int i = wave; i < TPB * 4; i += NWAVES) { const int r = rows[i];
        const v4u* src = (const v4u*)(xbf + ((size_t)blk * TPB + (i >> 2)) * D) + 2 * lane; const v4u a = src[0], b = src[1];
        v4u o; o.x = pk4_fp8(bflo(a.x), bfhi(a.x), bflo(a.y), bfhi(a.y)); o.y = pk4_fp8(bflo(a.z), bfhi(a.z), bflo(a.w), bfhi(a.w)); o.z = pk4_fp8(bflo(b.x), bfhi(b.x), bflo(b.y), bfhi(b.y)); o.w = pk4_fp8(bflo(b.z), bfhi(b.z), bflo(b.w), bfhi(b.w));
        ((v4u*)((unsigned char*)xs + (size_t)r * D))[lane] = o; }
    __syncthreads();
}
__device__ __forceinline__ f32x4 fp8x4_to_f32(unsigned w) {
    const f32x2 lo = __builtin_amdgcn_cvt_pk_f32_fp8((int)w, false), hi = __builtin_amdgcn_cvt_pk_f32_fp8((int)w, true); return (f32x4){lo.x, lo.y, hi.x, hi.y};
}
__device__ __forceinline__ void phase_ln2(const unsigned char* __restrict__ yrows, const int* __restrict__ tok_row, const float* __restrict__ tok_w, const float* __restrict__ g, const float* __restrict__ bb,
                                          float* __restrict__ xout, bf16* xbf, int gw, int ngw, int lane) {
    f32x4 gv[4], bv[4];
#pragma unroll
    for (int j = 0; j < 4; ++j) { gv[j] = ((const f32x4*)g)[lane + 64 * j]; bv[j] = ((const f32x4*)bb)[lane + 64 * j]; }
    constexpr int NTK = 2;
    static_assert(T % (NTK * GRID * NWAVES) == 0, "NTK tokens per wave per step");
    for (int t0 = gw; t0 < T; t0 += NTK * ngw) {
        f32x4 v[NTK][4];
#pragma unroll
        for (int u = 0; u < NTK; ++u) { const int t = t0 + u * ngw; int r[4]; float w[4];
#pragma unroll
            for (int k = 0; k < 4; ++k) { r[k] = tok_row[(size_t)t * 4 + k]; w[k] = tok_w[(size_t)t * 4 + k] * (1.f / 16.f); }
            const v2u* xr = (const v2u*)(xbf + (size_t)t * D) + lane;
#pragma unroll
            for (int j = 0; j < 4; ++j) { f32x4 f = {0.f, 0.f, 0.f, 0.f};
#pragma unroll
                for (int k = 0; k < 4; ++k) { const unsigned yw = ((const unsigned*)(yrows + (size_t)r[k] * D))[lane + 64 * j]; f += fp8x4_to_f32(yw) * w[k]; }
                const v2u xw = xr[64 * j]; v[u][j].x = DN_ALPHA * bflo(xw.x) + f.x; v[u][j].y = DN_ALPHA * bfhi(xw.x) + f.y; v[u][j].z = DN_ALPHA * bflo(xw.y) + f.z; v[u][j].w = DN_ALPHA * bfhi(xw.y) + f.w; } }
#pragma unroll
        for (int u = 0; u < NTK; ++u) { const int t = t0 + u * ngw;
            ln_row(v[u], gv, bv);
            if (xout) { f32x4* xo = (f32x4*)(xout + (size_t)t * D) + lane;
#pragma unroll
                for (int j = 0; j < 4; ++j) xo[64 * j] = v[u][j]; }
            else { v2u* xb = (v2u*)(xbf + (size_t)t * D) + lane;
#pragma unroll
                for (int j = 0; j < 4; ++j) { v2u ww; ww.x = pk2(v[u][j].x, v[u][j].y); ww.y = pk2(v[u][j].z, v[u][j].w); xb[64 * j] = ww; } } } }
}


struct Args { const float* in[20]; float* out; unsigned char* ws; int l_lo, l_hi, ph_lo, ph_hi; };
typedef const __attribute__((address_space(4))) Args* KArgsP;
#define KA_LOAD() ({ KArgsP p_ = (KArgsP)__builtin_amdgcn_kernarg_segment_ptr(); asm volatile("" : "+s"(p_)); p_; })
#ifndef PHMASK
#define PHMASK 0xFFFF
#endif
#ifndef REPEAT_MASK
#define REPEAT_MASK 0
#endif
#ifndef REPEAT_LMASK
#define REPEAT_LMASK 0xF
#endif
#define PH_BEGIN(k) _Pragma("unroll") for (int rep_ = 0; rep_ < ((((REPEAT_MASK >> (k)) & 1) && ((REPEAT_LMASK >> l) & 1)) ? 2 : 1); ++rep_) { if ((PHMASK >> (k)) & 1) { KArgsP ka = KA_LOAD(); unsigned char* ws = ka->ws; int tid = threadIdx.x; asm volatile("" : "+v"(tid)); \
    const int lane = tid & 63, wave = __builtin_amdgcn_readfirstlane(tid >> 6); int blk = blockIdx.x; asm volatile("" : "+s"(blk)); \
    const int gw = blk * NWAVES + wave; const size_t gtid = (size_t)blk * NTHR + tid; (void)lane; (void)gw; (void)gtid; (void)ws;
#if ONE_LAUNCH
#define PH_SEAM() do { XcdBarrier b_; b_.bar = (unsigned*)(KA_LOAD()->ws + WS_CTL) + CW_BAR; b_.x = xb_xcc_id(); b_.st = (volatile LAS unsigned*)(lds + MISC_OFF); xcd_barrier(b_); } while (0)
#else
#define PH_SEAM() do {} while (0)
#endif
#define PH_END() PH_SEAM(); } }
#define PH_END_NOSEAM() } }
#define WSP(type, off) ((type*)(ws + (off)))
constexpr int G = GRID, NGW = GRID * NWAVES; constexpr size_t GTHREADS = (size_t)GRID * NTHR;
template <int L> __device__ __forceinline__ void layer_phases(LAS unsigned char* lds) {
    constexpr int l = L; LAS int* tabL = (LAS int*)(lds + MISC_OFF + 256);

        const int j = l >> 1; const bool moba = (l & 1) != 0;
        const int NC = moba ? NC_M : NC_H, qoff = moba ? 2304 : 3072;

        if (l == 0) {
        PH_BEGIN(1)
            phase_weights((LAS float*)(lds + wave * 16384), gw, NGW, lane, ka->in[2], NC_H, ka->in[6], 4, ka->in[7], ka->in[12], ka->in[14], ka->in[16], WSP(bf16, WS_WIN), WSP(bf16, WS_WKV4), WSP(bf16, WS_WO), WSP(bf16, WS_WGU), WSP(bf16, WS_WD));
        PH_END()
        }
        PH_BEGIN(2)
            { pg8::Gemm g{WSP(bf16, WS_XBF), WSP(bf16, WS_WIN), T, NC, D, 0, 0}; pg8::StaticOrder S; S.init(T, NC, G, blk); pg8::EpiPlain E{WSP(bf16, WS_H), NC, moba ? 0x207u : 0x1000u, 0.125f * 1.4426950408889634f};
              pg8::gemm_phase<pg8::EpiPlain, pg8::StaticOrder, true, true>(lds, g, S, E); }
            if (l == 0) {
              pg8::Gemm g{WSP(bf16, WS_MEMBF), WSP(bf16, WS_WKV4), 512, 2048, D, 0, 0}; pg8::StaticOrder S; S.init(512, 2048, G, blk >= 128 ? blk - 128 : G); pg8::EpiPlain E{WSP(bf16, WS_KV4), 2048, 0u, 1.f};
              pg8::gemm_phase<pg8::EpiPlain, pg8::StaticOrder, true, true>(lds, g, S, E); }
        PH_END()
        if (!moba) {
            PH_BEGIN(3)
                for (int u = blk; u < NBATCH * HG_H * HNSEG; u += G) hgrn_mfma<false>(lds, WSP(bf16, WS_H), ka->in[3], j, ka->in[4] + j * 128, WSP(float, WS_SLOC), WSP(float, WS_DSEG), WSP(bf16, WS_MIX), u, tid, wave, lane);
                for (int u = blk; u < 512; u += G) memattn_unit2(lds, WSP(bf16, WS_H), NC, qoff, WSP(bf16, WS_KV4) + 512 * l, WSP(bf16, WS_MIX), u, tid, wave, lane);
            PH_END()
            PH_BEGIN(4)
                hgrn_scan(WSP(float, WS_SLOC), WSP(float, WS_DSEG), gtid, GTHREADS);
            PH_END()
            PH_BEGIN(5)
                for (int u = blk; u < NBATCH * HG_H * HNSEG; u += G) hgrn_mfma<true>(lds, WSP(bf16, WS_H), ka->in[3], j, ka->in[4] + j * 128, WSP(float, WS_SLOC), WSP(float, WS_DSEG), WSP(bf16, WS_MIX), u, tid, wave, lane);
            PH_END()
        } else {
            PH_BEGIN(3)
                for (int u = blk; u < 24 * MB_NB; u += G) kmean_unit(lds, WSP(bf16, WS_H), WSP(float, WS_KMEAN), WSP(float, WS_KMEAN + 512 * 1024), u, tid, wave);
                for (int u = blk; u < 512; u += G) memattn_unit2(lds, WSP(bf16, WS_H), NC, qoff, WSP(bf16, WS_KV4) + 512 * l, WSP(bf16, WS_MIX), u, tid, wave, lane);
            PH_END()
            PH_BEGIN(4)
                moba_gate_wg(lds, WSP(bf16, WS_H), WSP(float, WS_KMEAN), WSP(float, WS_KMEAN + 512 * 1024), WSP(unsigned, WS_CTL) + CW_GCOUNT + j * 1536, WSP(int, WS_SELINFO), WSP(unsigned, WS_LIST), blk, tid);
            PH_END()
            PH_BEGIN(5)
                { unsigned* qhead = WSP(unsigned, WS_CTL) + CW_GCOUNT + 2 * 1536 + 64 * j; LAS int* itl = (LAS int*)(lds + MISC_OFF + 512);
                  for (;;) { if (tid == 0) *itl = (int)__hip_atomic_fetch_add(qhead, 1u, __ATOMIC_RELAXED, __HIP_MEMORY_SCOPE_AGENT);
                      __syncthreads(); const int it = *itl; __syncthreads();
                      if (it >= 24 * MB_NB) break;
                      moba_attn_item2(lds, WSP(bf16, WS_H), WSP(float, WS_KMEAN + 512 * 1024), WSP(unsigned, WS_CTL) + CW_GCOUNT + j * 1536, WSP(unsigned, WS_LIST), WSP(bf16, WS_PO), WSP(float, WS_PML), it, tid, wave, lane); } }
            PH_END()
            PH_BEGIN(6)
                moba_combine(WSP(bf16, WS_PO), WSP(float, WS_PML), WSP(int, WS_SELINFO), WSP(bf16, WS_MIX), gw, NGW, lane);
            PH_END()
        }
        PH_BEGIN(7)
            pg8::Gemm g{WSP(bf16, WS_MIX), WSP(bf16, WS_WO), T, D, D, 0, 0}; pg8::StaticOrder S; S.init(T, D, G, blk); pg8::EpiPlain E{WSP(bf16, WS_Y), D, 0u, 1.f};
            pg8::gemm_phase<pg8::EpiPlain, pg8::StaticOrder, true, true>(lds, g, S, E);
        PH_END()
        PH_BEGIN(8)
            phase_ln1(lds, WSP(bf16, WS_Y), ka->in[8] + l * D, ka->in[9] + l * D, WSP(bf16, WS_WRS) + (size_t)l * 2 * NE * D, ka->in[11] + l * NE, WSP(bf16, WS_XBF),
                      WSP(int, WS_TOK + TOK_E), WSP(int, WS_TOK + TOK_LR), WSP(float, WS_TOK + TOK_W), WSP(int, WS_TOK + TOK_BLKCNT), blk, tid, wave, lane);
        PH_END()
        PH_BEGIN(9)
            phase_dispatch(lds, WSP(int, WS_TOK + TOK_BLKCNT), WSP(int, WS_TOK + TOK_E), WSP(int, WS_TOK + TOK_LR), WSP(int, WS_TOK + TOK_ROW), WSP(int, WS_TOK + TOK_TAB), WSP(bf16, WS_XBF), WSP(bf16, WS_XS), blk, tid, wave, lane);
        PH_END()
        PH_BEGIN(10)
            if (tid < 33) tabL[tid] = WSP(int, WS_TOK + TOK_TAB)[tid];
            __syncthreads();
            int sw_ = 0x7A7A7A7A, sx_ = 0x7F7F7F7F; asm volatile("" : "+s"(sw_), "+s"(sx_));
            pg8::Gemm g{WSP(bf16, WS_XS), WSP(bf16, WS_WGU), MOE_MAXROWS, NE * 2048, D / 2, sw_, sx_}; pg8::MoeOrder S{tabL, 8, G, blk, tabL[32] * 8};
            pg8::EpiSwiglu E{WSP(unsigned char, WS_HID), ka->in[13] + (size_t)l * NE * 1024, ka->in[15] + (size_t)l * NE * 1024};
            pg8::gemm_phase<pg8::EpiSwiglu, pg8::MoeOrder, true, true, true>(lds, g, S, E);
        PH_END()
        PH_BEGIN(11)
            if (tid < 33) tabL[tid] = WSP(int, WS_TOK + TOK_TAB)[tid];
            __syncthreads();
            int sw_ = 0x79797979, sx_ = 0x83838383; asm volatile("" : "+s"(sw_), "+s"(sx_));
            pg8::Gemm g{WSP(bf16, WS_HID), WSP(bf16, WS_WD), MOE_MAXROWS, NE * 1024, D / 2, sw_, sx_}; pg8::MoeOrder S{tabL, 4, G, blk, tabL[32] * 4};
            pg8::EpiDown E{WSP(unsigned char, WS_XS), ka->in[17] + (size_t)l * NE * 1024};
            pg8::gemm_phase<pg8::EpiDown, pg8::MoeOrder, true, true, true>(lds, g, S, E);
        PH_END()
        PH_BEGIN(12)
            float* x2out = (l == DEPTH - 1) ? ka->out : nullptr;
            phase_ln2(WSP(unsigned char, WS_XS), WSP(int, WS_TOK + TOK_ROW), WSP(float, WS_TOK + TOK_W), ka->in[18] + l * D, ka->in[19] + l * D, x2out, WSP(bf16, WS_XBF), gw, NGW, lane);
            if (l + 1 < DEPTH) { constexpr int ln = l + 1, jn = ln >> 1; constexpr bool mn = (ln & 1) != 0;
                const float* win_src = mn ? ka->in[5] + (size_t)jn * D * NC_M : ka->in[2] + (size_t)jn * D * NC_H; const size_t moff = (size_t)ln * NE * 1024 * 1024;
                phase_weights((LAS float*)(lds + wave * 16384), gw, NGW, lane, win_src, mn ? NC_M : NC_H, ka->in[6], 0, ka->in[7] + (size_t)ln * D * D,
                              ka->in[12] + moff, ka->in[14] + moff, ka->in[16] + moff, WSP(bf16, WS_WIN), WSP(bf16, WS_WKV4), WSP(bf16, WS_WO), WSP(bf16, WS_WGU), WSP(bf16, WS_WD)); }
            if (l + 1 < DEPTH) PH_SEAM();
        PH_END_NOSEAM()
}
__global__ void __launch_bounds__(NTHR, 2) fwd_kernel(Args args) {
    extern __shared__ __attribute__((aligned(16))) unsigned char lds_raw[];
    LAS unsigned char* lds = (LAS unsigned char*)lds_raw;
    if (threadIdx.x < 4) ((LAS unsigned*)(lds + MISC_OFF))[threadIdx.x] = 0u;
    __syncthreads();
#if ONE_LAUNCH
    (void)xcd_barrier_post((unsigned*)(args.ws + WS_CTL) + CW_BAR, (volatile LAS unsigned*)(lds + MISC_OFF));
#endif
    { const int l = 0; (void)l;
    PH_BEGIN(0)
        cvt_rows_bf16(ka->in[0], WSP(bf16, WS_XBF), (size_t)T * D / 8, gtid, GTHREADS);
        cvt_rows_bf16(ka->in[1], WSP(bf16, WS_MEMBF), (size_t)512 * D / 8, gtid, GTHREADS);
        split_router_weights(ka->in[10], WSP(bf16, WS_WRS), gtid, GTHREADS);
    PH_END_NOSEAM() }
    layer_phases<0>(lds); layer_phases<1>(lds); layer_phases<2>(lds); layer_phases<3>(lds);
}

extern "C" void kernel_launch(void* const* d_in, const int* in_sizes, int n_in, void* d_out, int out_size, void* d_ws, size_t ws_size, hipStream_t stream) {
    static int ready = 0;
    if (ready == 0) {
        if (n_in != 20 || in_sizes[0] != T * D || out_size != T * D || ws_size < WS_END) { fprintf(stderr, "kernel_launch: unexpected shapes (n_in %d, in0 %d, out %d, ws %zu < %zu)\n", n_in, n_in > 0 ? in_sizes[0] : -1, out_size, ws_size, (size_t)WS_END); ready = -1; return; }
        if (hipFuncSetAttribute((const void*)fwd_kernel, hipFuncAttributeMaxDynamicSharedMemorySize, LDS_BYTES) != hipSuccess) { fprintf(stderr, "kernel_launch: hipFuncSetAttribute failed\n"); ready = -1; return; }
        int per_cu = 0;
        if (hipOccupancyMaxActiveBlocksPerMultiprocessor(&per_cu, (const void*)fwd_kernel, NTHR, LDS_BYTES) != hipSuccess || per_cu < 1) fprintf(stderr, "kernel_launch: occupancy query says %d\n", per_cu);
        (void)hipGetLastError();
        ready = 1;
    }
    if (ready < 0) return;
    if (hipMemsetAsync((char*)d_ws + WS_CTL, 0, CTL_ZERO_BYTES, stream) != hipSuccess) return;
    Args a{};
    for (int i = 0; i < 20; ++i) a.in[i] = (const float*)d_in[i];
    a.out = (float*)d_out; a.ws = (unsigned char*)d_ws;
    a.l_lo = 0; a.l_hi = DEPTH; a.ph_lo = 0; a.ph_hi = NPHASE;
    hipLaunchKernelGGL(fwd_kernel, dim3(GRID), dim3(NTHR), LDS_BYTES, stream, a);
}
```

```cpp
#include <hip/hip_runtime.h>
#include <cstdio>
#include <cstdint>
#include <cmath>
namespace pg8 {
#define PG8_LAS __attribute__((address_space(3)))
typedef unsigned short bf16_t;
typedef short bf16x8 __attribute__((ext_vector_type(8)));
typedef float f32x4 __attribute__((ext_vector_type(4)));
typedef unsigned u32x4 __attribute__((ext_vector_type(4)));
constexpr int BM = 256, BK = 64, HALF = 128, HTB = HALF * BK * 2  , STAGE_BYTES = 8 * HTB, NXCD = 8, WGM = 8;

__host__ __device__ __forceinline__ int lds_byte(int r, int c) { const int st = (r >> 4) * 2 + (c >> 5), rr = r & 15, cc = c & 31, ob = rr * 64 + cc * 2; return st * 1024 + (ob ^ (((ob >> 9) & 1) << 5)); }
__host__ __device__ __forceinline__ void stage_rc(int b, int& R, int& C) { const int st = b / 1024, sb = b % 1024, swz = sb ^ (((sb >> 9) & 1) << 5); R = (st >> 1) * 16 + swz / 64; C = (st & 1) * 32 + (swz % 64) / 2; }
__host__ __device__ __forceinline__ int perm32(int rho) { const int n = rho >> 4, i = rho & 15; return 8 * (i >> 2) + 4 * n + (i & 3); }

struct Unit { int pm, pn; };
struct Gemm { const bf16_t* A; const bf16_t* Bt; int M, N, K; int sw, sx; const int* rowtok; };
typedef int i32x8 __attribute__((ext_vector_type(8))); typedef int i32x4 __attribute__((ext_vector_type(4)));

struct StaticOrder {
    int nM, nN, nwg, G, c;
    __host__ __device__ void init(int M, int N, int G_, int c_) { nM = M / BM; nN = N / BM; nwg = nM * nN; G = G_; c = c_; }
    __host__ __device__ bool next(int i, Unit& u) const {
        const long L = (long)i * G + c; if (L >= nwg) return false;
        int wgid = (int)L; { const int q = nwg / NXCD, r = nwg % NXCD, xcd = wgid % NXCD, off = wgid / NXCD; wgid = (xcd < r ? xcd * (q + 1) : r * (q + 1) + (xcd - r) * q) + off; }
        const int nig = WGM * nN, gid = wgid / nig, fm = gid * WGM, gsz = (nM - fm) < WGM ? (nM - fm) : WGM;
        u.pm = fm + ((wgid % nig) % gsz); u.pn = (wgid % nig) / gsz; return true;
    }
    __device__ __forceinline__ void a_ready(const Unit&) const {}
    __device__ __forceinline__ void done(const Unit&) const {}
};

__device__ __forceinline__ unsigned cvt_pk_bf16(float lo, float hi) { unsigned r; asm volatile("v_cvt_pk_bf16_f32 %0, %1, %2" : "=v"(r) : "v"(lo), "v"(hi)); return r; }
typedef float f32x2 __attribute__((ext_vector_type(2)));
struct EpiPlain {
    static constexpr bool PERM = true, AFTER_DRAIN = false;
    bf16_t* O; int ldc; unsigned smask; float sc;
    struct Pre {};
    __device__ __forceinline__ void pre_load(const Unit&, int, int, Pre&) const {}
    __device__ __forceinline__ void acc_init(f32x4 (&acc)[2][2][4][2], const Pre&) const {
#pragma unroll
        for (int a = 0; a < 2; ++a)
#pragma unroll
            for (int b = 0; b < 2; ++b)
#pragma unroll
                for (int m = 0; m < 4; ++m)
#pragma unroll
                    for (int n = 0; n < 2; ++n) acc[a][b][m][n] = (f32x4){0.f, 0.f, 0.f, 0.f}; }
    __device__ __forceinline__ void operator()(const f32x4 (&acc)[2][2][4][2], const Unit& u, int wr, int wc, int fr, int fq) const {
        const int row0 = u.pm * BM + wr * 64 + fr; const int col0 = u.pn * BM + wc * 32 + 8 * fq; const float s = ((smask >> u.pn) & 1u) ? sc : 1.f;
#pragma unroll
        for (int ai = 0; ai < 2; ++ai)
#pragma unroll
            for (int m = 0; m < 4; ++m) { bf16_t* rowp = O + (size_t)(row0 + ai * HALF + m * 16) * ldc + col0;
#pragma unroll
                for (int bj = 0; bj < 2; ++bj) { const f32x4 v0 = acc[ai][bj][m][0] * s, v1 = acc[ai][bj][m][1] * s;
                    u32x4 w; w.x = cvt_pk_bf16(v0[0], v0[1]); w.y = cvt_pk_bf16(v0[2], v0[3]); w.z = cvt_pk_bf16(v1[0], v1[1]); w.w = cvt_pk_bf16(v1[2], v1[3]);
                    *(u32x4*)(rowp + bj * HALF) = w; } }
    }
};
__device__ __forceinline__ float swiglu1(float g, float u) {
    float gm; asm("v_min_f32 %0, 0x40e00000, %1" : "=v"(gm) : "v"(g));
    const float um = __builtin_amdgcn_fmed3f(u, -7.0f, 7.0f);
    const float s = __builtin_amdgcn_rcpf(1.0f + __builtin_amdgcn_exp2f(gm * (-1.702f * 1.4426950408889634f)));
    const float gs = gm * s;
    return __builtin_fmaf(gs, um, gs);
}
__device__ __forceinline__ void swiglu4(const f32x4 g, const f32x4 u, float (&o)[4]) {
    typedef float f32x2_ __attribute__((ext_vector_type(2)));
#pragma unroll
    for (int h = 0; h < 2; ++h) { f32x2_ gm, um;
        asm("v_min_f32 %0, 0x40e00000, %1" : "=v"(gm.x) : "v"(g[2 * h])); asm("v_min_f32 %0, 0x40e00000, %1" : "=v"(gm.y) : "v"(g[2 * h + 1]));
        um.x = __builtin_amdgcn_fmed3f(u[2 * h], -7.0f, 7.0f); um.y = __builtin_amdgcn_fmed3f(u[2 * h + 1], -7.0f, 7.0f);
        const f32x2_ t = gm * (-1.702f * 1.4426950408889634f);
        f32x2_ e; e.x = __builtin_amdgcn_exp2f(t.x); e.y = __builtin_amdgcn_exp2f(t.y);
        const f32x2_ d = e + 1.0f;
        f32x2_ s; s.x = __builtin_amdgcn_rcpf(d.x); s.y = __builtin_amdgcn_rcpf(d.y);
        const f32x2_ gs = gm * s; const f32x2_ r = gs * um + gs;
        o[2 * h] = r.x; o[2 * h + 1] = r.y; }
}
__device__ __forceinline__ unsigned pk4_fp8e(float a, float b, float c, float d) { int w = 0; w = __builtin_amdgcn_cvt_pk_fp8_f32(a, b, w, false); w = __builtin_amdgcn_cvt_pk_fp8_f32(c, d, w, true); return (unsigned)w; }
struct EpiSwiglu {
    static constexpr bool PERM = true, AFTER_DRAIN = false;
    unsigned char* hid; const float* bg; const float* bu;
    struct Pre { f32x4 g0, g1, u0, u1; };
    __device__ __forceinline__ void pre_load(const Unit& u, int wc, int fq, Pre& p) const { const int e = u.pn >> 3, col0 = (u.pn & 7) * 128 + wc * 32 + 8 * fq;
        p.g0 = *(const f32x4*)(bg + e * 1024 + col0); p.g1 = *(const f32x4*)(bg + e * 1024 + col0 + 4); p.u0 = *(const f32x4*)(bu + e * 1024 + col0); p.u1 = *(const f32x4*)(bu + e * 1024 + col0 + 4); }
    __device__ __forceinline__ void acc_init(f32x4 (&acc)[2][2][4][2], const Pre& p) const {
#pragma unroll
        for (int a = 0; a < 2; ++a)
#pragma unroll
            for (int m = 0; m < 4; ++m) { acc[a][0][m][0] = p.g0; acc[a][0][m][1] = p.g1; acc[a][1][m][0] = p.u0; acc[a][1][m][1] = p.u1; } }
    __device__ __forceinline__ void operator()(const f32x4 (&acc)[2][2][4][2], const Unit& u, int wr, int wc, int fr, int fq) const {
        const int pn = u.pn & 7;
        const int row0 = u.pm * BM + wr * 64 + fr; const int col0 = pn * 128 + wc * 32 + 8 * fq;
#pragma unroll
        for (int ai = 0; ai < 2; ++ai)
#pragma unroll
            for (int m = 0; m < 4; ++m) { unsigned char* rowp = hid + (size_t)(row0 + ai * HALF + m * 16) * 1024 + col0;
                const f32x4 ga = acc[ai][0][m][0], gb = acc[ai][0][m][1], ua = acc[ai][1][m][0], ub = acc[ai][1][m][1];
                typedef unsigned u32x2 __attribute__((ext_vector_type(2))); u32x2 w;
                float oa[4], ob[4]; swiglu4(ga, ua, oa); swiglu4(gb, ub, ob);
                w.x = pk4_fp8e(oa[0], oa[1], oa[2], oa[3]); w.y = pk4_fp8e(ob[0], ob[1], ob[2], ob[3]);
                *(u32x2*)rowp = w; }
    }
};
struct EpiDown {
    static constexpr bool PERM = true, AFTER_DRAIN = false;
    unsigned char* y; const float* bd;
    struct Pre { f32x4 b[2][2]; };
    __device__ __forceinline__ void pre_load(const Unit& u, int wc, int fq, Pre& p) const { const int e = u.pn >> 2, col0 = (u.pn & 3) * BM + wc * 32 + 8 * fq;
#pragma unroll
        for (int bj = 0; bj < 2; ++bj)
#pragma unroll
            for (int n = 0; n < 2; ++n) p.b[bj][n] = *(const f32x4*)(bd + e * 1024 + col0 + bj * HALF + 4 * n); }
    __device__ __forceinline__ void acc_init(f32x4 (&acc)[2][2][4][2], const Pre& p) const {
#pragma unroll
        for (int a = 0; a < 2; ++a)
#pragma unroll
            for (int bj = 0; bj < 2; ++bj)
#pragma unroll
                for (int m = 0; m < 4; ++m) { acc[a][bj][m][0] = p.b[bj][0] * 16.f; acc[a][bj][m][1] = p.b[bj][1] * 16.f; } }
    __device__ __forceinline__ void operator()(const f32x4 (&acc)[2][2][4][2], const Unit& u, int wr, int wc, int fr, int fq) const {
        const int pn = u.pn & 3;
        const int row0 = u.pm * BM + wr * 64 + fr; const int col0 = pn * BM + wc * 32 + 8 * fq;
#pragma unroll
        for (int ai = 0; ai < 2; ++ai)
#pragma unroll
            for (int m = 0; m < 4; ++m) { unsigned char* rowp = y + (size_t)(row0 + ai * HALF + m * 16) * 1024 + col0;
#pragma unroll
                for (int bj = 0; bj < 2; ++bj) { const f32x4 v0 = acc[ai][bj][m][0], v1 = acc[ai][bj][m][1];
                    typedef unsigned u32x2 __attribute__((ext_vector_type(2))); u32x2 w; w.x = pk4_fp8e(v0[0], v0[1], v0[2], v0[3]); w.y = pk4_fp8e(v1[0], v1[1], v1[2], v1[3]);
                    *(u32x2*)(rowp + bj * HALF) = w; } }
    }
};
struct MoeOrder {
    const PG8_LAS int* tab; int npn, G, c, nunits; bool rev;
    __device__ __forceinline__ bool next(int i, Unit& u) const {
        const int tpx = 32 / npn, s = c >> 3, tile = (i * 8 + (c & 7)) * tpx + s / npn, pn = s % npn;
        if ((i * 8) * tpx >= nunits / npn) return false;
        if (tile >= nunits / npn) { u.pm = 0; u.pn = 0; return false; }
        const int tl_ = rev ? nunits / npn - 1 - tile : tile;
        int e = 0;
#pragma unroll
        for (int k = 1; k < 32; ++k) e += (tab[k] <= tl_) ? 1 : 0;
        u.pm = tl_; u.pn = __builtin_amdgcn_readfirstlane(e) * npn + pn; return true;
    }
    __device__ __forceinline__ void a_ready(const Unit&) const {}
    __device__ __forceinline__ void done(const Unit&) const {}
};
template <class Epi, class Sched, bool ALIGN_EPI = false, bool SP2 = false, bool F8 = false, bool GATHER = false>
__device__ __forceinline__ void gemm_phase(PG8_LAS unsigned char* lds, const Gemm g, const Sched& S, const Epi& E) {
    int tid_ = threadIdx.x; asm volatile("" : "+v"(tid_));
    const int tid = tid_, wid = __builtin_amdgcn_readfirstlane(tid >> 6), lane = tid & 63, wr = wid >> 2, wc = wid & 3, fr = lane & 15, fq = lane >> 4;
    const int K = g.K, nt = K / BK;
    unsigned voffA, voffB;
    { int R, C; stage_rc(tid * 16, R, C); const int Rb = Epi::PERM ? ((R & ~31) + perm32(R & 31)) : R; voffA = (unsigned)(R * K + C) * 2u; voffB = (unsigned)(Rb * K + C) * 2u; }
    const unsigned qstep = 64u * (unsigned)K * 2u;
    const unsigned kstep = (unsigned)(BK * 2);
    const unsigned hstep = (unsigned)HALF * (unsigned)K * 2u;
    const unsigned tstep = 2u * hstep;
    const __amdgpu_buffer_rsrc_t rA = __builtin_amdgcn_make_buffer_rsrc((void*)g.A, 0, 0x7FFFFFFF, 0x00020000), rB = __builtin_amdgcn_make_buffer_rsrc((void*)g.Bt, 0, 0x7FFFFFFF, 0x00020000);
    const unsigned ldsw = (unsigned)wid * 1024u;
    const int aoff = lds_byte(wr * 64 + fr, fq * 8), boff = lds_byte(wc * 32 + fr, fq * 8);
#define PG8_SA(b, h) (((b) * 2 + (h)) * HTB)
#define PG8_SB(b, h) ((4 + (b) * 2 + (h)) * HTB)
#define PG8_STG(bufoff, rsrc, soff, voff) do { _Pragma("unroll") for (int _i = 0; _i < 2; ++_i) \
        __builtin_amdgcn_raw_ptr_buffer_load_lds((rsrc), (PG8_LAS void*)(lds + (bufoff) + ldsw + _i * 8192), 16, (int)(voff), (int)((soff) + (unsigned)_i * qstep), 0, 0); } while (0)
#define PG8_STGA(bufoff, soff) PG8_STG(bufoff, rA, soff, voffA)
#define PG8_STGB(bufoff, soff) PG8_STG(bufoff, rB, soff, voffB)
#define PG8_STGAG(bufoff, h, soff_plain, kb) do { if constexpr (GATHER) { _Pragma("unroll") for (int _i = 0; _i < 2; ++_i) \
        __builtin_amdgcn_raw_ptr_buffer_load_lds(rA, (PG8_LAS void*)(lds + (bufoff) + ldsw + _i * 8192), 16, (int)gc[h][_i], (int)(kb), 0, 0); } else PG8_STGA(bufoff, soff_plain); } while (0)
#define PG8_GLOAD(gv, pm_) do { int t3_ = threadIdx.x; asm volatile("" : "+v"(t3_)); int R_, C_; stage_rc(t3_ * 16, R_, C_); const int* rt_ = g.rowtok + (pm_) * BM + R_; \
        _Pragma("unroll") for (int h_ = 0; h_ < 2; ++h_) _Pragma("unroll") for (int i_ = 0; i_ < 2; ++i_) gv[h_][i_] = (unsigned)rt_[h_ * HALF + i_ * 64] * (unsigned)(K * 2) + (unsigned)(C_ * 2); } while (0)
#define PG8_LDA(dst, b, h) do { _Pragma("unroll") for (int m = 0; m < 4; ++m) { if constexpr (F8) { const i32x4 lo_ = *(const PG8_LAS i32x4*)(lds + PG8_SA(b, h) + aoff + m * 2048), hi_ = *(const PG8_LAS i32x4*)(lds + PG8_SA(b, h) + aoff + m * 2048 + 1024); \
            dst##_8[m] = __builtin_shufflevector(lo_, hi_, 0, 1, 2, 3, 4, 5, 6, 7); } else { _Pragma("unroll") for (int k = 0; k < 2; ++k) dst[m][k] = *(const PG8_LAS bf16x8*)(lds + PG8_SA(b, h) + aoff + m * 2048 + k * 1024); } } } while (0)
#define PG8_LDB(dst, b, h) do { _Pragma("unroll") for (int n = 0; n < 2; ++n) { if constexpr (F8) { const i32x4 lo_ = *(const PG8_LAS i32x4*)(lds + PG8_SB(b, h) + boff + n * 2048), hi_ = *(const PG8_LAS i32x4*)(lds + PG8_SB(b, h) + boff + n * 2048 + 1024); \
            dst##_8[n] = __builtin_shufflevector(lo_, hi_, 0, 1, 2, 3, 4, 5, 6, 7); } else { _Pragma("unroll") for (int k = 0; k < 2; ++k) dst[n][k] = *(const PG8_LAS bf16x8*)(lds + PG8_SB(b, h) + boff + n * 2048 + k * 1024); } } } while (0)
#define PG8_MMA(ai, bj, At, Bt) do { __builtin_amdgcn_s_setprio(1); _Pragma("unroll") for (int m = 0; m < 4; ++m) _Pragma("unroll") for (int n = 0; n < 2; ++n) { \
        if constexpr (F8) acc[ai][bj][m][n] = __builtin_amdgcn_mfma_scale_f32_16x16x128_f8f6f4(Bt##_8[n], At##_8[m], acc[ai][bj][m][n], 0, 0, 0, g.sw, 0, g.sx); \
        else { _Pragma("unroll") for (int k = 0; k < 2; ++k) acc[ai][bj][m][n] = __builtin_amdgcn_mfma_f32_16x16x32_bf16(Bt[n][k], At[m][k], acc[ai][bj][m][n], 0, 0, 0); } } \
        __builtin_amdgcn_s_setprio(0); } while (0)
#define PG8_WAIT_V(n) asm volatile("s_waitcnt vmcnt(" #n ")" ::: "memory")
#define PG8_WAIT_L(n) asm volatile("s_waitcnt lgkmcnt(" #n ")" ::: "memory")
#define PG8_BAR __builtin_amdgcn_s_barrier()
#define PG8_SCHED __builtin_amdgcn_sched_barrier(0)
    Unit cur, nxt; int ui = 0;
    if (!S.next(0, cur)) return;
    f32x4 acc[2][2][4][2];
    typename Epi::Pre pre; E.pre_load(cur, wc, fq, pre); E.acc_init(acc, pre);
    bf16x8 At[4][2], B0[2][2], B1[2][2]; i32x8 At_8[4], B0_8[2], B1_8[2];
    unsigned cA = (unsigned)cur.pm * tstep, cB = (unsigned)cur.pn * tstep;
    S.a_ready(cur);
    unsigned gc[2][2]; PG8_LAS unsigned* gl_ = (PG8_LAS unsigned*)(lds + 8 * HTB + tid * 16);
    typedef unsigned u32x2_ __attribute__((ext_vector_type(2)));
    if constexpr (GATHER) { unsigned g1_[2][2]; PG8_GLOAD(gc, cur.pm); Unit n1_; n1_.pm = 0; n1_.pn = 0; const bool h1_ = S.next(1, n1_); PG8_GLOAD(g1_, h1_ ? n1_.pm : cur.pm);
        *(PG8_LAS u32x2_*)gl_ = (u32x2_){g1_[0][0], g1_[0][1]}; *(PG8_LAS u32x2_*)(gl_ + 2) = (u32x2_){g1_[1][0], g1_[1][1]};
        asm volatile("" :: "v"(gc[0][0]), "v"(gc[0][1]), "v"(gc[1][0]), "v"(gc[1][1])); }
    if constexpr (SP2) {
        PG8_STGB(PG8_SB(0, 0), cB); PG8_STGB(PG8_SB(0, 1), cB + hstep); PG8_STGAG(PG8_SA(0, 0), 0, cA, 0u); PG8_STGAG(PG8_SA(0, 1), 1, cA + hstep, 0u);
        if (wr == 1) PG8_BAR;
        PG8_WAIT_V(2); PG8_BAR;
        PG8_STGB(PG8_SB(1, 0), cB + kstep); PG8_STGAG(PG8_SA(1, 0), 0, cA + kstep, kstep); PG8_STGB(PG8_SB(1, 1), cB + hstep + kstep);
        PG8_WAIT_V(6); PG8_BAR;
    } else {
        PG8_STGB(PG8_SB(0, 0), cB); PG8_STGA(PG8_SA(0, 0), cA); PG8_STGB(PG8_SB(0, 1), cB + hstep); PG8_STGA(PG8_SA(0, 1), cA + hstep);
        if (wr == 1) PG8_BAR;
        PG8_WAIT_V(4); PG8_BAR;
        PG8_STGB(PG8_SB(1, 0), cB + kstep); PG8_STGA(PG8_SA(1, 0), cA + kstep); PG8_STGB(PG8_SB(1, 1), cB + hstep + kstep);
        PG8_WAIT_V(6); PG8_BAR;
    }
    for (;;) {
        const bool has_next = S.next(ui + 1, nxt);
        const unsigned nA = has_next ? (unsigned)nxt.pm * tstep : cA, nB = has_next ? (unsigned)nxt.pn * tstep : cB;
#pragma unroll 1
        for (int t = 0; t < nt; t += 2) {
            const bool last = (t == nt - 2);
            const unsigned a1 = cA + (unsigned)(t + 1) * kstep;
            const unsigned a2 = last ? nA : cA + (unsigned)(t + 2) * kstep, b2 = last ? nB : cB + (unsigned)(t + 2) * kstep;
            const unsigned a3 = a2 + kstep, b3 = b2 + kstep;
            if (last && has_next) S.a_ready(nxt);
            const unsigned k1_ = (unsigned)(t + 1) * kstep, k2_ = last ? 0u : (unsigned)(t + 2) * kstep;
            if constexpr (GATHER) { if (last) { const u32x2_ w0_ = *(const PG8_LAS u32x2_*)gl_; gc[0][0] = w0_.x; gc[0][1] = w0_.y; } }
            if constexpr (SP2) {
            PG8_LDB(B0, 0, 0); PG8_LDB(B1, 0, 1); PG8_SCHED; PG8_LDA(At, 0, 0); PG8_STGAG(PG8_SA(1, 1), 1, a1 + hstep, k1_);
            if constexpr (GATHER) { if (last) { const u32x2_ w1_ = *(const PG8_LAS u32x2_*)(gl_ + 2); gc[1][0] = w1_.x; gc[1][1] = w1_.y; } }
            PG8_WAIT_V(8); PG8_WAIT_L(0); PG8_BAR; PG8_MMA(0, 0, At, B0); PG8_MMA(0, 1, At, B1); PG8_BAR; PG8_SCHED;
            PG8_LDA(At, 0, 1); PG8_STGB(PG8_SB(0, 0), b2); PG8_STGB(PG8_SB(0, 1), b2 + hstep); PG8_STGAG(PG8_SA(0, 0), 0, a2, k2_);
            PG8_WAIT_V(8); PG8_WAIT_L(0); PG8_BAR; PG8_MMA(1, 0, At, B0); PG8_MMA(1, 1, At, B1); PG8_BAR; PG8_SCHED;
            PG8_LDB(B0, 1, 0); PG8_LDB(B1, 1, 1); PG8_SCHED; PG8_LDA(At, 1, 0); PG8_STGAG(PG8_SA(0, 1), 1, a2 + hstep, k2_);
            PG8_WAIT_V(8); PG8_WAIT_L(0); PG8_BAR; PG8_MMA(0, 0, At, B0); PG8_MMA(0, 1, At, B1); PG8_BAR; PG8_SCHED;
            PG8_LDA(At, 1, 1); PG8_STGB(PG8_SB(1, 0), b3); PG8_STGB(PG8_SB(1, 1), b3 + hstep); PG8_STGAG(PG8_SA(1, 0), 0, a3, k2_ + kstep);
            PG8_WAIT_V(8); PG8_WAIT_L(0); PG8_BAR; PG8_MMA(1, 0, At, B0); PG8_MMA(1, 1, At, B1); PG8_BAR; PG8_SCHED;
            } else {
            PG8_LDB(B0, 0, 0); PG8_SCHED; PG8_LDA(At, 0, 0); PG8_STGA(PG8_SA(1, 1), a1 + hstep);
            PG8_WAIT_L(8); PG8_BAR; PG8_WAIT_L(0); PG8_MMA(0, 0, At, B0); PG8_BAR; PG8_SCHED;
            PG8_LDB(B1, 0, 1); PG8_STGB(PG8_SB(0, 0), b2);
            PG8_BAR; PG8_WAIT_L(0); PG8_MMA(0, 1, At, B1); PG8_BAR;
            PG8_LDA(At, 0, 1); PG8_STGA(PG8_SA(0, 0), a2);
            PG8_BAR; PG8_WAIT_L(0); PG8_MMA(1, 0, At, B0); PG8_BAR; PG8_SCHED;
            PG8_STGB(PG8_SB(0, 1), b2 + hstep);
            PG8_WAIT_V(6); PG8_BAR; PG8_MMA(1, 1, At, B1); PG8_BAR;
            PG8_LDB(B0, 1, 0); PG8_SCHED; PG8_LDA(At, 1, 0); PG8_STGA(PG8_SA(0, 1), a2 + hstep);
            PG8_WAIT_L(8); PG8_BAR; PG8_WAIT_L(0); PG8_MMA(0, 0, At, B0); PG8_BAR; PG8_SCHED;
            PG8_LDB(B1, 1, 1); PG8_STGB(PG8_SB(1, 0), b3);
            PG8_BAR; PG8_WAIT_L(0); PG8_MMA(0, 1, At, B1); PG8_BAR;
            PG8_LDA(At, 1, 1); PG8_STGA(PG8_SA(1, 0), a3);
            PG8_BAR; PG8_WAIT_L(0); PG8_MMA(1, 0, At, B0); PG8_BAR; PG8_SCHED;
            PG8_STGB(PG8_SB(1, 1), b3 + hstep);
            PG8_WAIT_V(6); PG8_BAR; PG8_MMA(1, 1, At, B1); PG8_BAR;
            }
        }
        if constexpr (ALIGN_EPI) { if (wr == 0) PG8_BAR; }
        unsigned gnn[2][2];
        if constexpr (GATHER) { Unit n2_; n2_.pm = 0; n2_.pn = 0; const bool h2_ = S.next(ui + 2, n2_); const int pm2_ = h2_ ? n2_.pm : (has_next ? nxt.pm : cur.pm); PG8_GLOAD(gnn, pm2_); }
        if constexpr (!Epi::AFTER_DRAIN) { int t2_ = threadIdx.x; asm volatile("" : "+v"(t2_)); { const Unit pu_ = has_next ? nxt : cur; E.pre_load(pu_, wc, (t2_ & 63) >> 4, pre); }     E(acc, cur, wr, wc, t2_ & 15, (t2_ & 63) >> 4); S.done(cur); }
        if (!has_next) break;
        E.acc_init(acc, pre);
        if constexpr (GATHER) { *(PG8_LAS u32x2_*)gl_ = (u32x2_){gnn[0][0], gnn[0][1]}; *(PG8_LAS u32x2_*)(gl_ + 2) = (u32x2_){gnn[1][0], gnn[1][1]}; }
        cur = nxt; cA = nA; cB = nB; ++ui;
        if constexpr (ALIGN_EPI) { if (wr == 1) PG8_BAR; }
    }
    PG8_WAIT_V(0);
    if constexpr (!ALIGN_EPI) { if (wr == 0) PG8_BAR; }
    PG8_BAR;
    if constexpr (Epi::AFTER_DRAIN) { E.fused(acc, cur, wr, wc, fr, fq, lds, wid, lane); S.done(cur); }
#undef PG8_SA
#undef PG8_SB
#undef PG8_STG
#undef PG8_STGA
#undef PG8_STGB
#undef PG8_STGAG
#undef PG8_GLOAD
#undef PG8_LDA
#undef PG8_LDB
#undef PG8_MMA
#undef PG8_WAIT_V
#undef PG8_WAIT_L
#undef PG8_BAR
#undef PG8_SCHED
}
}

constexpr int NWAVES = 8, NTHR = 512, GRID = 256;
constexpr int NBATCH = 2, SEQ = 16384, T = NBATCH * SEQ, D = 1024, DEPTH = 4;
constexpr int MIXW = 768, NC_H = 3328, NC_M = 2560;
constexpr int HG_H = 6;
constexpr int HSEG = 256, HNSEG = SEQ / HSEG;
constexpr int MB_H = 12, MB_NB = 64;
constexpr int NE = 32;
constexpr float DN_ALPHA = 1.6817928305074290f;
constexpr int MOE_MAXROWS = T * 4 + NE * 256;
#ifndef ONE_LAUNCH
#define ONE_LAUNCH 1
#endif
constexpr int NPHASE = 13;

constexpr size_t MiB = 1u << 20;
constexpr size_t WS_CTL = 0, CTL_ZERO_BYTES = 1 * MiB;
constexpr size_t WS_WIN = 1 * MiB, WS_WKV = 9 * MiB, WS_WO = 10 * MiB, WS_WGU = 12 * MiB, WS_WD = 140 * MiB;
constexpr size_t WS_XBF = 204 * MiB, WS_WKV4 = 268 * MiB  , WS_KV4 = 272 * MiB  , WS_WRS = 280 * MiB  , WS_MEMBF = 524 * MiB;
constexpr size_t WS_H = 526 * MiB, WS_MIX = 734 * MiB, WS_Y = 798 * MiB, WS_SLOC = 862 * MiB, WS_DSEG = 910 * MiB, WS_KMEAN = 911 * MiB;
constexpr size_t WS_SELINFO = 912 * MiB, WS_TOK = 914 * MiB, WS_R1 = 918 * MiB;
constexpr size_t WS_LIST = WS_R1, WS_PML = WS_R1 + 96 * MiB, WS_PO = WS_R1 + 108 * MiB;
constexpr size_t WS_XS = WS_R1, WS_HID = WS_R1 + 272 * MiB;
constexpr size_t WS_END = WS_R1 + 544 * MiB;
static_assert((size_t)MOE_MAXROWS * 1024 * 2 <= 272 * MiB, "moe rows");
static_assert((size_t)T * MB_H * 4 * 64 * 4 <= 384 * MiB && (size_t)24 * 64 * 16384 * 4 <= 96 * MiB, "moba bufs");
constexpr size_t TOK_E = 0, TOK_LR = 512 * 1024, TOK_W = 1024 * 1024, TOK_ROW = 1536 * 1024, TOK_BLKCNT = 2048 * 1024, TOK_TAB = 2048 * 1024 + 65536;
constexpr int CW_BAR = 4096, CW_GCOUNT = 8192;

constexpr int RING_BYTES = 131072, LDS_BYTES = 147456, MISC_OFF = LDS_BYTES - 1024;

#define GAS __attribute__((address_space(1)))
#define LAS __attribute__((address_space(3)))
typedef unsigned short bf16;
typedef unsigned v4u __attribute__((ext_vector_type(4)));
typedef unsigned v2u __attribute__((ext_vector_type(2)));
typedef float f32x4 __attribute__((ext_vector_type(4)));
typedef float f32x2 __attribute__((ext_vector_type(2)));
typedef short s16x8 __attribute__((ext_vector_type(8)));
typedef float f32x16 __attribute__((ext_vector_type(16)));
typedef float f32x2_t __attribute__((ext_vector_type(2))); typedef __bf16 bf16x2_t __attribute__((ext_vector_type(2)));
__device__ __forceinline__ unsigned cvtpk(float lo, float hi) { f32x2_t v = {lo, hi}; bf16x2_t b = __builtin_convertvector(v, bf16x2_t); return __builtin_bit_cast(unsigned, b); }
#define LDS_WAIT() asm volatile("s_waitcnt lgkmcnt(0)" ::: "memory")
__device__ __forceinline__ unsigned f2bf(float f) { unsigned u = __builtin_bit_cast(unsigned, f); return (u + 0x7fffu + ((u >> 16) & 1u)) >> 16; }
__device__ __forceinline__ unsigned pk2(float lo, float hi) { return f2bf(lo) | (f2bf(hi) << 16); }
__device__ __forceinline__ float bflo(unsigned w) { return __builtin_bit_cast(float, w << 16); }
__device__ __forceinline__ float bfhi(unsigned w) { return __builtin_bit_cast(float, w & 0xffff0000u); }
__device__ __forceinline__ float bf2f(bf16 h) { return __builtin_bit_cast(float, (unsigned)h << 16); }
__device__ __forceinline__ float sigmoidf_(float z) { return __builtin_amdgcn_rcpf(1.0f + __builtin_amdgcn_exp2f(-1.4426950408889634f * z)); }
template <int X> __device__ __forceinline__ float xorf(float v) { return __builtin_bit_cast(float, __builtin_amdgcn_ds_swizzle(__builtin_bit_cast(int, v), (X << 10) | 0x1F)); }
template <int X> __device__ __forceinline__ int xori(int v) { return __builtin_amdgcn_ds_swizzle(v, (X << 10) | 0x1F); }
__device__ __forceinline__ float wave_sum(float v) {
    v += xorf<1>(v); v += xorf<2>(v); v += xorf<4>(v); v += xorf<8>(v); v += xorf<16>(v);
    return __builtin_bit_cast(float, __builtin_amdgcn_readlane(__builtin_bit_cast(int, v), 0)) + __builtin_bit_cast(float, __builtin_amdgcn_readlane(__builtin_bit_cast(int, v), 32));
}
__device__ __forceinline__ float wave_max(float v) {
    v = fmaxf(v, xorf<1>(v)); v = fmaxf(v, xorf<2>(v)); v = fmaxf(v, xorf<4>(v)); v = fmaxf(v, xorf<8>(v)); v = fmaxf(v, xorf<16>(v));
    return fmaxf(__builtin_bit_cast(float, __builtin_amdgcn_readlane(__builtin_bit_cast(int, v), 0)), __builtin_bit_cast(float, __builtin_amdgcn_readlane(__builtin_bit_cast(int, v), 32)));
}
__device__ __forceinline__ float xor32f(float v, int lane) { return __builtin_bit_cast(float, __builtin_amdgcn_ds_bpermute((lane ^ 32) << 2, __builtin_bit_cast(int, v))); }
#define XB_TMO      128
#define XB_XCNT(j)  (256  + 64 * (j))
#define XB_XSUB(j)  (1280 + 64 * (j))
#define XB_XGEN(j)  (2304 + 64 * (j))
#define XB_TOP      3328
#define XB_TOPGEN   3392
#define XCD_BAR_WORDS 3456
#define XB_SPIN_CAP (1u << 18)

__device__ __forceinline__ unsigned xb_ld(unsigned* p)              { return __hip_atomic_load(p, __ATOMIC_RELAXED, __HIP_MEMORY_SCOPE_AGENT); }
__device__ __forceinline__ unsigned xb_add(unsigned* p, unsigned v) { return __hip_atomic_fetch_add(p, v, __ATOMIC_RELAXED, __HIP_MEMORY_SCOPE_AGENT); }
__device__ __forceinline__ unsigned xb_xcc_id() { return (unsigned)__builtin_amdgcn_s_getreg((3 << 11) | 20) & 0xFu; }
#define XB_SPIN(cond, bar) do { unsigned _sp = 0; while (cond) { __builtin_amdgcn_s_sleep(1); \
    if ((++_sp & 255u) == 0u) { if (xb_ld(&(bar)[XB_TMO])) break; if (_sp > XB_SPIN_CAP) { atomicAdd(&(bar)[XB_TMO], 1u); break; } } } } while (0)

struct XcdBarrier {
    unsigned* bar; unsigned x;
    volatile LAS unsigned* st;
};

__device__ __forceinline__ XcdBarrier xcd_barrier_post(unsigned* bar, volatile LAS unsigned* st) {
    XcdBarrier b; b.bar = bar; b.x = xb_xcc_id(); b.st = st;
    if (threadIdx.x == 0) (void)xb_add(&bar[XB_XCNT(b.x)], 1u);
    return b;
}
__device__ __forceinline__ void xcd_barrier_complete(unsigned* bar, unsigned x, unsigned& nloc, unsigned& nx) {
    const unsigned G = gridDim.x * gridDim.y * gridDim.z;
    unsigned sum, cnt, mine, sp = 0u;
    for (;;) {
        sum = 0u; cnt = 0u; mine = 0u;
#pragma unroll
        for (unsigned j = 0; j < 16; ++j) { const unsigned c = xb_ld(&bar[XB_XCNT(j)]); sum += c; cnt += (c > 0u) ? 1u : 0u; mine = (j == x) ? c : mine; }
        if (sum == G) break;
        __builtin_amdgcn_s_sleep(1);
        if ((++sp & 255u) == 0u) { if (xb_ld(&bar[XB_TMO])) break; if (sp > XB_SPIN_CAP) { atomicAdd(&bar[XB_TMO], 1u); break; } }
    }
    nloc = mine > 0u ? mine : 1u; nx = cnt > 0u ? cnt : 1u;
}

__device__ __forceinline__ void xcd_barrier(const XcdBarrier& b) {
    asm volatile("s_waitcnt vmcnt(0)" ::: "memory");
    __syncthreads();
    if (threadIdx.x == 0) {
        unsigned* bar = b.bar;
        __builtin_amdgcn_s_waitcnt(0);
        unsigned nloc = b.st[0], nx = b.st[1];
        if (nloc == 0u) { xcd_barrier_complete(bar, b.x, nloc, nx); b.st[0] = nloc; b.st[1] = nx; }
        const unsigned old = xb_add(&bar[XB_XSUB(b.x)], 1u);
        const unsigned gen = old / nloc;
        if (old + 1u == (gen + 1u) * nloc) {
            __builtin_amdgcn_fence(__ATOMIC_RELEASE, "agent");
            asm volatile("s_waitcnt vmcnt(0)" ::: "memory");
            const unsigned og = xb_add(&bar[XB_TOP], 1u);
            const unsigned tg = og / nx;
            if (og + 1u == (tg + 1u) * nx) xb_add(&bar[XB_TOPGEN], 1u);
            else XB_SPIN(xb_ld(&bar[XB_TOPGEN]) == tg, bar);
            __builtin_amdgcn_fence(__ATOMIC_ACQUIRE, "agent");
            xb_add(&bar[XB_XGEN(b.x)], 1u);
            asm volatile("s_waitcnt vmcnt(0)" ::: "memory");
        } else {
            XB_SPIN(xb_ld(&bar[XB_XGEN(b.x)]) == gen, bar);
            __builtin_amdgcn_fence(__ATOMIC_ACQUIRE, "agent");
            asm volatile("s_waitcnt vmcnt(0)" ::: "memory");
        }
    }
    __syncthreads();
}
__device__ __forceinline__ void cvt_rows_bf16(const float* src, bf16* dst, size_t n8, size_t gtid, size_t gthreads) {
    for (size_t i = gtid; i < n8; i += gthreads) { const f32x4 a = ((const f32x4*)src)[2 * i], b = ((const f32x4*)src)[2 * i + 1];
        v4u o; o.x = pk2(a.x, a.y); o.y = pk2(a.z, a.w); o.z = pk2(b.x, b.y); o.w = pk2(b.z, b.w); ((v4u*)dst)[i] = o; }
}
__device__ __forceinline__ void transpose_item(const float* W, int N, bf16* WT, int dst_row0, LAS float* scr, int k0, int n0, int lane) {
#pragma unroll 8
    for (int i = 0; i < 32; ++i) { const int kk = 2 * i + (lane >> 5); scr[kk * 33 + (lane & 31)] = W[(size_t)(k0 + kk) * N + n0 + (lane & 31)]; }
    LDS_WAIT(); asm volatile("" ::: "memory");
    const int c = lane & 7;
#pragma unroll
    for (int j = 0; j < 4; ++j) { const int n = (lane >> 3) + 8 * j; const LAS float* s = scr + (8 * c) * 33 + n;
        v4u o; o.x = pk2(s[0 * 33], s[1 * 33]); o.y = pk2(s[2 * 33], s[3 * 33]); o.z = pk2(s[4 * 33], s[5 * 33]); o.w = pk2(s[6 * 33], s[7 * 33]);
        *(v4u*)(WT + (size_t)(dst_row0 + n) * 1024 + k0 + 8 * c) = o; }
    LDS_WAIT(); asm volatile("" ::: "memory");
}
__device__ __forceinline__ unsigned pk4_fp8(float a, float b, float c, float d) { int w = 0; w = __builtin_amdgcn_cvt_pk_fp8_f32(a, b, w, false); w = __builtin_amdgcn_cvt_pk_fp8_f32(c, d, w, true); return (unsigned)w; }
__device__ __forceinline__ void transpose_item_f8(const float* W, int N, unsigned char* WT8, int dst_row0, LAS float* scr, int k0, int n0, int lane, float wscale) {
#pragma unroll 8
    for (int i = 0; i < 32; ++i) { const int kk = 2 * i + (lane >> 5); scr[kk * 33 + (lane & 31)] = W[(size_t)(k0 + kk) * N + n0 + (lane & 31)]; }
    LDS_WAIT(); asm volatile("" ::: "memory");
    const int c = lane & 7;
#pragma unroll
    for (int j = 0; j < 4; ++j) { const int n = (lane >> 3) + 8 * j; const LAS float* s = scr + (8 * c) * 33 + n;
        v2u o; o.x = pk4_fp8(s[0 * 33] * wscale, s[1 * 33] * wscale, s[2 * 33] * wscale, s[3 * 33] * wscale); o.y = pk4_fp8(s[4 * 33] * wscale, s[5 * 33] * wscale, s[6 * 33] * wscale, s[7 * 33] * wscale);
        *(v2u*)(WT8 + (size_t)(dst_row0 + n) * 1024 + k0 + 8 * c) = o; }
    LDS_WAIT(); asm volatile("" ::: "memory");
}
__device__ __forceinline__ void phase_weights(LAS float* scr, int gw, int ngw, int lane, const float* win_src, int NC, const float* wkv_src, int nkv, const float* wo_src,
                                              const float* wg_src, const float* wu_src, const float* wd_src, bf16* win_t, bf16* wkv_t, bf16* wo_t, bf16* wgu_t, bf16* wd_t) {
    const int nbw = NC / 32, nWin = nbw * 16, NIT = nWin + 256 * nkv + 512 + NE * 1536;
    for (int it = gw; it < NIT; it += ngw) {
        int r = it;
        if (r < nWin) { const int kb = r / nbw, nb = r - kb * nbw; transpose_item(win_src, NC, win_t, 32 * nb, scr, 64 * kb, 32 * nb, lane); continue; } r -= nWin;
        if (r < 256 * nkv) { const int lay = r >> 8, rr = r & 255, kb = rr >> 4, nb = rr & 15; transpose_item(wkv_src + (size_t)lay * D * 512, 512, wkv_t + (size_t)lay * 512 * 1024, 32 * nb, scr, 64 * kb, 32 * nb, lane); continue; } r -= 256 * nkv;
        if (r < 512) { const int kb = r >> 5, nb = r & 31; transpose_item(wo_src, 1024, wo_t, 32 * nb, scr, 64 * kb, 32 * nb, lane); continue; } r -= 512;
        const int e = r / 1536, q = r - e * 1536, which = q >> 9, rr = q & 511, kb = rr >> 5, nb = rr & 31, n0 = 32 * nb;
        const size_t eoff = (size_t)e * 1024 * 1024;
        if (which == 0) transpose_item_f8(wg_src + eoff, 1024, (unsigned char*)wgu_t + 2 * eoff, (n0 >> 7) * 256 + (n0 & 127), scr, 64 * kb, n0, lane, 32.f);
        else if (which == 1) transpose_item_f8(wu_src + eoff, 1024, (unsigned char*)wgu_t + 2 * eoff, (n0 >> 7) * 256 + 128 + (n0 & 127), scr, 64 * kb, n0, lane, 32.f);
        else transpose_item_f8(wd_src + eoff, 1024, (unsigned char*)wd_t + eoff, n0, scr, 64 * kb, n0, lane, 64.f);
    }
}

template <bool OUT>
__device__ __forceinline__ void hgrn_seg(LAS unsigned char* lds, const bf16* h, const float* lbl, int j, const float* normg, float* Sloc, float* Dseg, bf16* mix, int unit, int tid, int wave, int lane) {
    const int seg = unit & (HNSEG - 1), bh = unit >> 6, hh = bh % HG_H, b = bh / HG_H;
    const int v = tid & 127, dg = tid >> 7;
    LAS float* fgs = (LAS float*)lds; LAS float* vs = fgs + 4096; LAS float* qs = vs + 4096; LAS float* op = qs + 4096;
    f32x2 st[16];
    float* Sp = Sloc + (size_t)unit * 16384 + (size_t)(dg * 32) * 128 + v;
#pragma unroll
    for (int dd = 0; dd < 16; ++dd) { st[dd].x = OUT ? Sp[(2 * dd) * 128] : 0.f; st[dd].y = OUT ? Sp[(2 * dd + 1) * 128] : 0.f; }
    float dprod = 1.f;
    const int stok = tid >> 4, c8 = (tid & 15) * 8;
    float lb[8];
#pragma unroll
    for (int i = 0; i < 8; ++i) { lb[i] = 0.f; if (j > 0) { const float a0 = lbl[hh * 128 + c8 + i], a1 = lbl[MIXW + hh * 128 + c8 + i]; lb[i] = 1.f / (1.f + __expf(a0 - a1)); } }
    for (int ch = 0; ch < HSEG / 32; ++ch) {
        const size_t t0 = (size_t)b * SEQ + seg * HSEG + ch * 32;
        { const bf16* row = h + (t0 + stok) * NC_H + hh * 128 + c8;
          const v4u f8 = *(const v4u*)(row + 768), i8 = *(const v4u*)(row + 1536); v4u q8 = {0u, 0u, 0u, 0u}; if (OUT) q8 = *(const v4u*)row;
#pragma unroll
          for (int w = 0; w < 4; ++w) { const float f0 = bflo(f8[w]), f1 = bfhi(f8[w]); const int o = stok * 128 + c8 + 2 * w;
              fgs[o] = lb[2 * w] + (1.f - lb[2 * w]) * sigmoidf_(f0); fgs[o + 1] = lb[2 * w + 1] + (1.f - lb[2 * w + 1]) * sigmoidf_(f1);
              vs[o] = bflo(i8[w]); vs[o + 1] = bfhi(i8[w]);
              if (OUT) { const float q0 = bflo(q8[w]), q1 = bfhi(q8[w]); qs[o] = q0 * sigmoidf_(q0); qs[o + 1] = q1 * sigmoidf_(q1); } } }
        __syncthreads();
        if (!OUT) { if (tid < 128) { for (int tt = 0; tt < 32; ++tt) dprod *= fgs[tt * 128 + tid]; } }
        f32x4 fA[8], qA[8], fB[8], qB[8]; float vA, vB;
#define HG_LOAD(F, Q, V, tt_) do { V = vs[(tt_) * 128 + v]; _Pragma("unroll") for (int d4 = 0; d4 < 8; ++d4) { F[d4] = *(const LAS f32x4*)(fgs + (tt_) * 128 + dg * 32 + d4 * 4); \
            if (OUT) Q[d4] = *(const LAS f32x4*)(qs + (tt_) * 128 + dg * 32 + d4 * 4); } } while (0)
#define HG_STEP(F, Q, V, tt_) do { const f32x2 vv2 = {V, V}; f32x2 acc2 = {0.f, 0.f}; _Pragma("unroll") for (int d4 = 0; d4 < 8; ++d4) { \
            const f32x2 fa = {F[d4].x, F[d4].y}, fb = {F[d4].z, F[d4].w}; \
            st[2 * d4] = fa * (st[2 * d4] - vv2) + vv2; st[2 * d4 + 1] = fb * (st[2 * d4 + 1] - vv2) + vv2; \
            if (OUT) { const f32x2 qa = {Q[d4].x, Q[d4].y}, qb = {Q[d4].z, Q[d4].w}; acc2 = qa * st[2 * d4] + acc2; acc2 = qb * st[2 * d4 + 1] + acc2; } } \
            if (OUT) op[(dg * 32 + (tt_)) * 128 + v] = acc2.x + acc2.y; } while (0)
        HG_LOAD(fA, qA, vA, 0);
#pragma unroll 1
        for (int tt = 0; tt < 32; tt += 2) {
            HG_LOAD(fB, qB, vB, tt + 1);
            __builtin_amdgcn_sched_barrier(0);
            HG_STEP(fA, qA, vA, tt);
            __builtin_amdgcn_sched_barrier(0);
            if (tt + 2 < 32) HG_LOAD(fA, qA, vA, tt + 2);
            __builtin_amdgcn_sched_barrier(0);
            HG_STEP(fB, qB, vB, tt + 1);
            __builtin_amdgcn_sched_barrier(0);
        }
#undef HG_LOAD
#undef HG_STEP
        if (OUT) {
            __syncthreads();
#pragma unroll
            for (int k = 0; k < 4; ++k) { const int tt = wave + 8 * k; float o0 = 0.f, o1 = 0.f;
#pragma unroll
                for (int g = 0; g < 4; ++g) { o0 += op[(g * 32 + tt) * 128 + lane]; o1 += op[(g * 32 + tt) * 128 + lane + 64]; }
                const float ms = wave_sum(o0 * o0 + o1 * o1) * (1.f / 128.f), r = 1.f / sqrtf(ms + 1e-6f);
                const bf16* grow = h + (t0 + tt) * NC_H + 2304 + hh * 128; const float g0 = bf2f(grow[lane]), g1 = bf2f(grow[lane + 64]);
                bf16* mrow = mix + (t0 + tt) * 1024 + hh * 128;
                mrow[lane] = (bf16)f2bf(o0 * r * normg[lane] * sigmoidf_(g0)); mrow[lane + 64] = (bf16)f2bf(o1 * r * normg[lane + 64] * sigmoidf_(g1)); }
        }
        __syncthreads();
    }
    if (!OUT) {
#pragma unroll
        for (int dd = 0; dd < 16; ++dd) { Sp[(2 * dd) * 128] = st[dd].x; Sp[(2 * dd + 1) * 128] = st[dd].y; }
        if (tid < 128) Dseg[(size_t)unit * 128 + tid] = dprod;
    }
}
constexpr int HG_G = 0, HG_QT = 32768, HG_KT = 50176, HG_KE = 67584, HG_VT = 86016, HG_ST = 104448, HG_GM = 139264, HG_GE = 139776, HG_PART = 140288, HG_EGM = 142336, HG_EGE = 142848;
static_assert(HG_EGE + 512 <= MISC_OFF, "HGRN LDS map");
__device__ __forceinline__ int crow16(int i, int hf) { return (i & 3) + 8 * (i >> 2) + 4 * hf; }
template <bool OUT>
__device__ __forceinline__ void hgrn_mfma(LAS unsigned char* lds, const bf16* h, const float* lbl, int j, const float* normg, float* Sloc, float* Dseg, bf16* mix, int unit, int tid, int wave, int lane) {
    const int seg = unit & (HNSEG - 1), bh = unit >> 6, hh = bh % HG_H, b = bh / HG_H;
    const int r = lane & 31, hf = lane >> 5, tr = wave & 1, vq = wave >> 1;
    LAS float* G = (LAS float*)(lds + HG_G); LAS float* GM = (LAS float*)(lds + HG_GM); LAS float* GE = (LAS float*)(lds + HG_GE); LAS float* PART = (LAS float*)(lds + HG_PART); LAS float* EGM = (LAS float*)(lds + HG_EGM); LAS float* EGE = (LAS float*)(lds + HG_EGE);
    const int stok = tid >> 3, c16 = (tid & 7) * 16, sperm = (stok & ~15) | (stok & 3) | ((stok & 4) << 1) | ((stok & 8) >> 1);
    const int cd = tid & 127, cpart = tid >> 7;
    float lb[16];
#pragma unroll
    for (int e = 0; e < 16; ++e) { lb[e] = 0.f; if (j > 0) { const float a0 = lbl[hh * 128 + c16 + e], a1 = lbl[MIXW + hh * 128 + c16 + e]; lb[e] = 1.f / (1.f + __expf(a0 - a1)); } }
    f32x16 S[2];
    float* Sp = Sloc + (size_t)unit * 16384 + 32 * vq + r;
#pragma unroll
    for (int dd = 0; dd < 2; ++dd)
#pragma unroll
        for (int i = 0; i < 16; ++i) S[dd][i] = OUT ? Sp[(32 * (2 * tr + dd) + crow16(i, hf)) * 128] : 0.f;
    float gsum = 0.f;
    float ng16[16];
#pragma unroll
    for (int e = 0; e < 16; ++e) ng16[e] = OUT ? normg[c16 + e] : 0.f;
    v4u nf8[2], ni8[2], nq8[2] = {{0u, 0u, 0u, 0u}, {0u, 0u, 0u, 0u}}, ng8[2] = {{0u, 0u, 0u, 0u}, {0u, 0u, 0u, 0u}};
#define HG_RAWLOAD(t0_) do { const bf16* row_ = h + ((t0_) + stok) * NC_H + hh * 128 + c16; nf8[0] = *(const v4u*)(row_ + 768); nf8[1] = *(const v4u*)(row_ + 776); ni8[0] = *(const v4u*)(row_ + 1536); ni8[1] = *(const v4u*)(row_ + 1544); \
        if (OUT) { nq8[0] = *(const v4u*)row_; nq8[1] = *(const v4u*)(row_ + 8); ng8[0] = *(const v4u*)(row_ + 2304); ng8[1] = *(const v4u*)(row_ + 2312); } } while (0)
    HG_RAWLOAD((size_t)b * SEQ + seg * HSEG);
    for (int ch = 0; ch < HSEG / 64; ++ch) {
        const size_t t0 = (size_t)b * SEQ + seg * HSEG + ch * 64;
        float fg[16], qv[16]; v4u i8[2], g8[2];
        { const v4u f8[2] = {nf8[0], nf8[1]}; i8[0] = ni8[0]; i8[1] = ni8[1]; const v4u q8[2] = {nq8[0], nq8[1]}; g8[0] = ng8[0]; g8[1] = ng8[1];
#pragma unroll
          for (int w = 0; w < 8; ++w) { const unsigned fw = f8[w >> 2][w & 3]; const float f0 = bflo(fw), f1 = bfhi(fw);
              fg[2 * w] = lb[2 * w] + (1.f - lb[2 * w]) * sigmoidf_(f0); fg[2 * w + 1] = lb[2 * w + 1] + (1.f - lb[2 * w + 1]) * sigmoidf_(f1);
              if (OUT) { const unsigned qw = q8[w >> 2][w & 3]; const float q0 = bflo(qw), q1 = bfhi(qw); qv[2 * w] = q0 * sigmoidf_(q0); qv[2 * w + 1] = q1 * sigmoidf_(q1); } else { qv[2 * w] = 0.f; qv[2 * w + 1] = 0.f; } }
#pragma unroll
          for (int e4 = 0; e4 < 4; ++e4) { f32x4 lg; lg.x = __builtin_amdgcn_logf(fg[4 * e4]); lg.y = __builtin_amdgcn_logf(fg[4 * e4 + 1]); lg.z = __builtin_amdgcn_logf(fg[4 * e4 + 2]); lg.w = __builtin_amdgcn_logf(fg[4 * e4 + 3]);
              *(LAS f32x4*)(G + stok * 128 + c16 + 4 * e4) = lg; } }
        __syncthreads();
        { float run = 0.f;
#pragma unroll
          for (int k = 0; k < 16; ++k) run += G[(16 * cpart + k) * 128 + cd];
          PART[cpart * 128 + cd] = run; }
        __syncthreads();
        { float run = 0.f;
#pragma unroll
          for (int pp = 0; pp < 3; ++pp) run += (pp < cpart) ? PART[pp * 128 + cd] : 0.f;
#pragma unroll
          for (int k = 0; k < 16; ++k) { run += G[(16 * cpart + k) * 128 + cd]; G[(16 * cpart + k) * 128 + cd] = run; }
          if (cpart == 1) { GM[cd] = run; EGM[cd] = __builtin_amdgcn_exp2f(run); }
          if (cpart == 3) { GE[cd] = run; EGE[cd] = __builtin_amdgcn_exp2f(run); gsum += run; } }
        __syncthreads();
        if (OUT) {
#pragma unroll
            for (int dd = 0; dd < 2; ++dd)
#pragma unroll
                for (int g4 = 0; g4 < 4; ++g4) { const int dbase = 32 * (2 * tr + dd) + 8 * g4 + 4 * hf; const f32x4 gm = *(const LAS f32x4*)(EGM + dbase);
                    v2u w; w.x = cvtpk(S[dd][4 * g4] * gm.x, S[dd][4 * g4 + 1] * gm.y); w.y = cvtpk(S[dd][4 * g4 + 2] * gm.z, S[dd][4 * g4 + 3] * gm.w);
                    *(LAS v2u*)(lds + HG_ST + (32 * vq + r) * 272 + dbase * 2) = w; }
        }
        { unsigned qt[8], kt[8];
#pragma unroll
          for (int e4 = 0; e4 < 4; ++e4) { const f32x4 gv = *(const LAS f32x4*)(G + stok * 128 + c16 + 4 * e4), gm = *(const LAS f32x4*)(GM + c16 + 4 * e4), ge = *(const LAS f32x4*)(GE + c16 + 4 * e4);
              float ke[4];
#pragma unroll
              for (int e = 0; e < 4; ++e) { const float kk = 1.f - fg[4 * e4 + e]; ke[e] = kk * __builtin_amdgcn_exp2f(ge[e] - gv[e]);
                  if (OUT) { const float a = qv[4 * e4 + e] * __builtin_amdgcn_exp2f(gv[e] - gm[e]), c = kk * __builtin_amdgcn_exp2f(gm[e] - gv[e]);
                      if (e & 1) { qt[2 * e4 + (e >> 1)] |= f2bf(a) << 16; kt[2 * e4 + (e >> 1)] |= f2bf(c) << 16; } else { qt[2 * e4 + (e >> 1)] = f2bf(a); kt[2 * e4 + (e >> 1)] = f2bf(c); } } }
#pragma unroll
              for (int e = 0; e < 4; ++e) { const int col = c16 + 4 * e4 + e;
                  *(LAS bf16*)(lds + HG_KE + col * 144 + sperm * 2) = (bf16)f2bf(ke[e]);
                  const unsigned vw = i8[e4 >> 1][(2 * e4 + (e >> 1)) & 3]; *(LAS bf16*)(lds + HG_VT + col * 144 + sperm * 2) = (bf16)((e & 1) ? (vw >> 16) : (vw & 0xffffu)); } }
          if (OUT) { *(LAS v4u*)(lds + HG_QT + stok * 272 + c16 * 2) = (v4u){qt[0], qt[1], qt[2], qt[3]}; *(LAS v4u*)(lds + HG_QT + stok * 272 + c16 * 2 + 16) = (v4u){qt[4], qt[5], qt[6], qt[7]};
                     *(LAS v4u*)(lds + HG_KT + stok * 272 + c16 * 2) = (v4u){kt[0], kt[1], kt[2], kt[3]}; *(LAS v4u*)(lds + HG_KT + stok * 272 + c16 * 2 + 16) = (v4u){kt[4], kt[5], kt[6], kt[7]}; } }
        __syncthreads();
        if (ch + 1 < HSEG / 64) HG_RAWLOAD(t0 + 64);
        if (OUT) {
            f32x16 X0, X1, O;
#pragma unroll
            for (int i = 0; i < 16; ++i) { X0[i] = 0.f; X1[i] = 0.f; O[i] = 0.f; }
            const LAS unsigned char* qtp = lds + HG_QT + (32 * tr + r) * 272 + hf * 16;
#pragma unroll
            for (int ks = 0; ks < 8; ++ks) { const s16x8 bq = *(const LAS s16x8*)(qtp + ks * 32);
                const s16x8 a0 = *(const LAS s16x8*)(lds + HG_KT + r * 272 + hf * 16 + ks * 32); X0 = __builtin_amdgcn_mfma_f32_32x32x16_bf16(a0, bq, X0, 0, 0, 0);
                if (tr == 1) { const s16x8 a1 = *(const LAS s16x8*)(lds + HG_KT + (32 + r) * 272 + hf * 16 + ks * 32); X1 = __builtin_amdgcn_mfma_f32_32x32x16_bf16(a1, bq, X1, 0, 0, 0); } }
#pragma unroll
            for (int i = 0; i < 16; ++i) { const bool keep = crow16(i, hf) <= r; if (tr == 0) X0[i] = keep ? X0[i] : 0.f; else X1[i] = keep ? X1[i] : 0.f; }
            const LAS unsigned char* vtp = lds + HG_VT + (32 * vq + r) * 144 + hf * 16;
#pragma unroll
            for (int s2 = 0; s2 < 2; ++s2) { v4u pw; pw.x = cvtpk(X0[8 * s2], X0[8 * s2 + 1]); pw.y = cvtpk(X0[8 * s2 + 2], X0[8 * s2 + 3]); pw.z = cvtpk(X0[8 * s2 + 4], X0[8 * s2 + 5]); pw.w = cvtpk(X0[8 * s2 + 6], X0[8 * s2 + 7]);
                const s16x8 bv = *(const LAS s16x8*)(vtp + (16 * s2) * 2); O = __builtin_amdgcn_mfma_f32_32x32x16_bf16(__builtin_bit_cast(s16x8, pw), bv, O, 0, 0, 0); }
            if (tr == 1) {
#pragma unroll
                for (int s2 = 0; s2 < 2; ++s2) { v4u pw; pw.x = cvtpk(X1[8 * s2], X1[8 * s2 + 1]); pw.y = cvtpk(X1[8 * s2 + 2], X1[8 * s2 + 3]); pw.z = cvtpk(X1[8 * s2 + 4], X1[8 * s2 + 5]); pw.w = cvtpk(X1[8 * s2 + 6], X1[8 * s2 + 7]);
                    const s16x8 bv = *(const LAS s16x8*)(vtp + (32 + 16 * s2) * 2); O = __builtin_amdgcn_mfma_f32_32x32x16_bf16(__builtin_bit_cast(s16x8, pw), bv, O, 0, 0, 0); } }
            const LAS unsigned char* stp = lds + HG_ST + (32 * vq + r) * 272 + hf * 16;
#pragma unroll
            for (int ks = 0; ks < 8; ++ks) { const s16x8 aq = *(const LAS s16x8*)(qtp + ks * 32), bs = *(const LAS s16x8*)(stp + ks * 32); O = __builtin_amdgcn_mfma_f32_32x32x16_bf16(aq, bs, O, 0, 0, 0); }
#pragma unroll
            for (int i = 0; i < 16; ++i) G[(32 * tr + crow16(i, hf)) * 128 + 32 * vq + r] = O[i];
        }
#pragma unroll
        for (int dd = 0; dd < 2; ++dd) { const int dr = 2 * tr + dd;
#pragma unroll
            for (int g4 = 0; g4 < 4; ++g4) { const f32x4 ge = *(const LAS f32x4*)(EGE + 32 * dr + 8 * g4 + 4 * hf);
                S[dd][4 * g4] *= ge.x; S[dd][4 * g4 + 1] *= ge.y; S[dd][4 * g4 + 2] *= ge.z; S[dd][4 * g4 + 3] *= ge.w; }
#pragma unroll
            for (int ks = 0; ks < 4; ++ks) { const s16x8 a = *(const LAS s16x8*)(lds + HG_KE + (32 * dr + r) * 144 + hf * 16 + ks * 32), bv = *(const LAS s16x8*)(lds + HG_VT + (32 * vq + r) * 144 + hf * 16 + ks * 32);
                S[dd] = __builtin_amdgcn_mfma_f32_32x32x16_bf16(a, bv, S[dd], 0, 0, 0); } }
        __syncthreads();
        if (OUT) {
            float ov[16]; float ss = 0.f;
#pragma unroll
            for (int e4 = 0; e4 < 4; ++e4) { const f32x4 o4 = *(const LAS f32x4*)(G + stok * 128 + c16 + 4 * e4); ov[4 * e4] = o4.x; ov[4 * e4 + 1] = o4.y; ov[4 * e4 + 2] = o4.z; ov[4 * e4 + 3] = o4.w;
                ss += (o4.x * o4.x + o4.y * o4.y) + (o4.z * o4.z + o4.w * o4.w); }
            ss += xorf<1>(ss); ss += xorf<2>(ss); ss += xorf<4>(ss);
            const float rr = 1.f / sqrtf(ss * (1.f / 128.f) + 1e-6f);
            unsigned ow[8];
#pragma unroll
            for (int w = 0; w < 8; ++w) { const unsigned gw_ = g8[w >> 2][w & 3]; ow[w] = cvtpk(ov[2 * w] * rr * ng16[2 * w] * sigmoidf_(bflo(gw_)), ov[2 * w + 1] * rr * ng16[2 * w + 1] * sigmoidf_(bfhi(gw_))); }
            bf16* mrow = mix + (t0 + stok) * 1024 + hh * 128 + c16;
            *(v4u*)mrow = (v4u){ow[0], ow[1], ow[2], ow[3]}; *(v4u*)(mrow + 8) = (v4u){ow[4], ow[5], ow[6], ow[7]};
            __syncthreads();
        }
    }
#undef HG_RAWLOAD
    if (!OUT) {
#pragma unroll
        for (int dd = 0; dd < 2; ++dd)
#pragma unroll
            for (int i = 0; i < 16; ++i) Sp[(32 * (2 * tr + dd) + crow16(i, hf)) * 128] = S[dd][i];
        if (cpart == 3) Dseg[(size_t)unit * 128 + cd] = __builtin_amdgcn_exp2f(gsum);
    }
}
__device__ __forceinline__ void hgrn_scan(float* Sloc, const float* Dseg, size_t gtid, size_t gthreads) {
    for (size_t idx = gtid; idx < (size_t)NBATCH * HG_H * 16384; idx += gthreads) { const int bh = (int)(idx >> 14), e = (int)(idx & 16383), d = e >> 7; float cur = 0.f;
        float* __restrict__ sp = Sloc + (size_t)bh * HNSEG * 16384 + e; const float* __restrict__ dp = Dseg + (size_t)bh * HNSEG * 128 + d;
        for (int s0 = 0; s0 < HNSEG; s0 += 16) { float tv[16], dv[16];
#pragma unroll
            for (int k = 0; k < 16; ++k) { tv[k] = sp[(size_t)(s0 + k) * 16384]; dv[k] = dp[(s0 + k) * 128]; }
#pragma unroll
            for (int k = 0; k < 16; ++k) { sp[(size_t)(s0 + k) * 16384] = cur; cur = dv[k] * cur + tv[k]; } } }
}

template <bool MASK>
__device__ __forceinline__ void attn4(const LAS unsigned* Ks, const LAS bf16* Vs, const LAS float* qst, LAS float* pb, int lane, const int (&tq)[4], int kbase, float slope,
                                      float (&mo)[4], float (&lo)[4], float (&oo)[4]) {
    float sc[4][4];
#pragma unroll
    for (int a = 0; a < 4; ++a)
#pragma unroll
        for (int c = 0; c < 4; ++c) sc[a][c] = 0.f;
#pragma unroll 4
    for (int dd = 0; dd < 32; ++dd) {
        f32x2 qv[4];
#pragma unroll
        for (int qi = 0; qi < 4; ++qi) qv[qi] = *(const LAS f32x2*)(qst + qi * 64 + 2 * dd);
#pragma unroll
        for (int kk = 0; kk < 4; ++kk) { const unsigned kw = Ks[(lane + 64 * kk) * 33 + dd]; const float k0 = bflo(kw), k1 = bfhi(kw);
#pragma unroll
            for (int qi = 0; qi < 4; ++qi) sc[qi][kk] += qv[qi].x * k0 + qv[qi].y * k1; }
    }
#pragma unroll
    for (int qi = 0; qi < 4; ++qi) { float mx = -INFINITY;
#pragma unroll
        for (int kk = 0; kk < 4; ++kk) { const int pos = kbase + lane + 64 * kk; float lg = sc[qi][kk] * 0.125f - slope * (float)(tq[qi] - pos); if (MASK && pos > tq[qi]) lg = -INFINITY; sc[qi][kk] = lg; mx = fmaxf(mx, lg); }
        mx = wave_max(mx); float s = 0.f;
#pragma unroll
        for (int kk = 0; kk < 4; ++kk) { const float p = __builtin_amdgcn_exp2f((sc[qi][kk] - mx) * 1.4426950408889634f); pb[qi * 256 + lane + 64 * kk] = p; s += p; }
        lo[qi] = wave_sum(s); mo[qi] = mx; }
    float o[4] = {0.f, 0.f, 0.f, 0.f};
#pragma unroll 4
    for (int k4 = 0; k4 < 64; ++k4) { f32x4 p4[4];
#pragma unroll
        for (int qi = 0; qi < 4; ++qi) p4[qi] = *(const LAS f32x4*)(pb + qi * 256 + 4 * k4);
#pragma unroll
        for (int jj = 0; jj < 4; ++jj) { const float vv = bf2f(Vs[(4 * k4 + jj) * 64 + lane]);
#pragma unroll
            for (int qi = 0; qi < 4; ++qi) o[qi] += p4[qi][jj] * vv; } }
#pragma unroll
    for (int qi = 0; qi < 4; ++qi) oo[qi] = o[qi];
}
constexpr int AT_KS = 0, AT_VS = 33792, AT_WV = 66560, AT_WVB = 5120;

__device__ __forceinline__ void memattn_unit(LAS unsigned char* lds, const bf16* h, int NC, int qoff, const bf16* kv, bf16* mix, int unit, int tid, int wave, int lane) {
    const int chunk = unit & 31, bm = unit >> 5, mh = bm & 3, b = bm >> 2;
    LAS unsigned* Ks = (LAS unsigned*)(lds + AT_KS); LAS unsigned* Vs32 = (LAS unsigned*)(lds + AT_VS);
    LAS float* qst = (LAS float*)(lds + AT_WV + wave * AT_WVB); LAS float* pb = qst + 256;
    for (int i = 0; i < 16; ++i) { const int idx = tid + 512 * i, r = idx >> 5, dd = idx & 31; const unsigned* src = (const unsigned*)(kv + (size_t)(b * 256 + r) * 512 + mh * 64);
        Ks[r * 33 + dd] = src[dd]; Vs32[r * 32 + dd] = src[128 + dd]; }
    __syncthreads();
    for (int qd = 0; qd < 16; ++qd) { const size_t tg = (size_t)b * SEQ + chunk * 512 + wave * 64 + qd * 4;
#pragma unroll
        for (int qi = 0; qi < 4; ++qi) qst[qi * 64 + lane] = bf2f(h[(tg + qi) * NC + qoff + mh * 64 + lane]);
        const int tq[4] = {0, 0, 0, 0}; float m[4], l[4], o[4];
        attn4<false>(Ks, (const LAS bf16*)Vs32, qst, pb, lane, tq, 0, 0.f, m, l, o);
#pragma unroll
        for (int qi = 0; qi < 4; ++qi) mix[(tg + qi) * 1024 + MIXW + mh * 64 + lane] = (bf16)f2bf(o[qi] / l[qi]); }
    __syncthreads();
}

constexpr int AT2_K = 0, AT2_KROW = 176, AT2_V = 256 * AT2_KROW, AT2_VROW = 528, AT2_SCR = AT2_V + 64 * AT2_VROW, AT2_SCRW = 4864;
__device__ __forceinline__ void stage_kv_images(LAS unsigned char* lds, const bf16* kp, const bf16* vp, size_t row_stride, int tid) {
    v4u kx[4], vx[4];
#pragma unroll
    for (int i = 0; i < 4; ++i) { const int idx = tid + 512 * i, key = idx >> 3, c = idx & 7; kx[i] = *(const v4u*)(kp + (size_t)key * row_stride + 8 * c); vx[i] = *(const v4u*)(vp + (size_t)key * row_stride + 8 * c); }
    __builtin_amdgcn_sched_barrier(0);
#pragma unroll
    for (int i = 0; i < 4; ++i) { const int idx = tid + 512 * i, key = idx >> 3, c = idx & 7;
        *(LAS v4u*)(lds + AT2_K + key * AT2_KROW + c * 16) = kx[i];
        const int pos = (key & ~15) | (key & 3) | ((key & 4) << 1) | ((key & 8) >> 1);
        LAS bf16* vt = (LAS bf16*)(lds + AT2_V) + pos;
#pragma unroll
        for (int w = 0; w < 4; ++w) { vt[(8 * c + 2 * w) * (AT2_VROW / 2)] = (bf16)(vx[i][w] & 0xffffu); vt[(8 * c + 2 * w + 1) * (AT2_VROW / 2)] = (bf16)(vx[i][w] >> 16); } }
    if (tid < 256) { const unsigned pb = f2bf((float)tid); const v4u e0 = {pb | (pb << 16), 0x3F803F80u, 0u, 0u}, z = {0u, 0u, 0u, 0u};
        *(LAS v4u*)(lds + AT2_K + tid * AT2_KROW + 128) = e0; *(LAS v4u*)(lds + AT2_K + tid * AT2_KROW + 144) = z; }
}
template <bool MASK>
__device__ __forceinline__ void attn_tile32(const LAS unsigned char* lds, const s16x8 (&qf)[4], int lane, float dist0, unsigned qx, unsigned qx2, bool own, f32x16 (&o)[2], float& mrow, float& lrow) {
    const int r = lane & 31, hf = lane >> 5;
    const v4u qxv = {qx, qx2, 0u, 0u}; const s16x8 qe = __builtin_bit_cast(s16x8, qxv);
    f32x16 acc[8];
    const LAS unsigned char* kb = lds + AT2_K + r * AT2_KROW + hf * 16;
    constexpr int NKS = MASK ? 5 : 4;
    s16x8 kf[NKS];
#pragma unroll
    for (int s = 0; s < NKS; ++s) kf[s] = *(const LAS s16x8*)(kb + s * 32);
#pragma unroll
    for (int kt = 0; kt < 8; ++kt) {
#pragma unroll
        for (int i = 0; i < 16; ++i) acc[kt][i] = 0.f;
#pragma unroll
        for (int s = 0; s < NKS; ++s) { acc[kt] = __builtin_amdgcn_mfma_f32_32x32x16_bf16(kf[s], s < 4 ? qf[s < 4 ? s : 0] : qe, acc[kt], 0, 0, 0);
            if (kt + 1 < 8) kf[s] = *(const LAS s16x8*)(kb + (kt + 1) * 32 * AT2_KROW + s * 32); }
        __builtin_amdgcn_sched_barrier(0); }
    float mx = -INFINITY;
    if (MASK) { mx = 0.f;
        if (own) { const float base2 = dist0 - 4.f * (float)hf;
#pragma unroll
            for (int kt = 0; kt < 8; ++kt)
#pragma unroll
                for (int i = 0; i < 16; ++i) { const float dist = base2 - (float)(32 * kt + (i & 3) + 8 * (i >> 2)); acc[kt][i] = dist < 0.f ? -INFINITY : acc[kt][i]; } }
    } else {
#pragma unroll
        for (int kt = 0; kt < 8; ++kt)
#pragma unroll
            for (int i = 0; i < 16; ++i) mx = fmaxf(mx, acc[kt][i]);
        mx = fmaxf(mx, xor32f(mx, lane));
    }
    f32x2 sum2 = {0.f, 0.f};
#pragma unroll
    for (int i = 0; i < 16; ++i) { o[0][i] = 0.f; o[1][i] = 0.f; }
    const LAS unsigned char* vb = lds + AT2_V + r * AT2_VROW + hf * 16;
    s16x8 vf[4];
#pragma unroll
    for (int s2 = 0; s2 < 2; ++s2)
#pragma unroll
        for (int dt = 0; dt < 2; ++dt) vf[2 * s2 + dt] = *(const LAS s16x8*)(vb + dt * 32 * AT2_VROW + (16 * s2) * 2);
#pragma unroll
    for (int kt = 0; kt < 8; ++kt) {
#pragma unroll
        for (int i = 0; i < 16; ++i) acc[kt][i] = __builtin_amdgcn_exp2f(MASK ? acc[kt][i] : acc[kt][i] - mx);
#pragma unroll
        for (int i = 0; i < 8; ++i) sum2 += (f32x2){acc[kt][2 * i], acc[kt][2 * i + 1]};
#pragma unroll
        for (int s2 = 0; s2 < 2; ++s2) { v4u pw; pw.x = cvtpk(acc[kt][8 * s2], acc[kt][8 * s2 + 1]); pw.y = cvtpk(acc[kt][8 * s2 + 2], acc[kt][8 * s2 + 3]);
            pw.z = cvtpk(acc[kt][8 * s2 + 4], acc[kt][8 * s2 + 5]); pw.w = cvtpk(acc[kt][8 * s2 + 6], acc[kt][8 * s2 + 7]); const s16x8 pf = __builtin_bit_cast(s16x8, pw);
#pragma unroll
            for (int dt = 0; dt < 2; ++dt) { o[dt] = __builtin_amdgcn_mfma_f32_32x32x16_bf16(vf[2 * s2 + dt], pf, o[dt], 0, 0, 0);
                if (kt + 1 < 8) vf[2 * s2 + dt] = *(const LAS s16x8*)(vb + dt * 32 * AT2_VROW + (32 * (kt + 1) + 16 * s2) * 2); } }
        __builtin_amdgcn_sched_barrier(0); }
    float sum = sum2.x + sum2.y; sum += xor32f(sum, lane);
    if (!MASK) mrow = mx;
    lrow = sum;
}
__device__ __forceinline__ void memattn_unit2(LAS unsigned char* lds, const bf16* h, int NC, int qoff, const bf16* kv  , bf16* mix, int unit, int tid, int wave, int lane) {
    const int chunk = unit & 63, bm = unit >> 6, mh = bm & 3, b = bm >> 2, r = lane & 31, hf = lane >> 5;
    const bf16* kvrow0 = kv + (size_t)(b * 256) * 2048 + mh * 64;
    stage_kv_images(lds, kvrow0, kvrow0 + 256, 2048, tid);
    __syncthreads();
    { const size_t tg = (size_t)b * SEQ + chunk * 256 + wave * 32 + r;
        f32x16 o[2]; float m2, l; s16x8 qf[4];
#pragma unroll
        for (int s = 0; s < 4; ++s) qf[s] = *(const s16x8*)(h + tg * NC + qoff + mh * 64 + 16 * s + 8 * hf);
        attn_tile32<false>(lds, qf, lane, 0.f, 0u, 0u, false, o, m2, l);
        const float inv = 1.f / l; bf16* mp = mix + tg * 1024 + MIXW + mh * 64 + 4 * hf;
#pragma unroll
        for (int dt = 0; dt < 2; ++dt)
#pragma unroll
            for (int g = 0; g < 4; ++g) { v2u w; w.x = cvtpk(o[dt][4 * g] * inv, o[dt][4 * g + 1] * inv); w.y = cvtpk(o[dt][4 * g + 2] * inv, o[dt][4 * g + 3] * inv); *(v2u*)(mp + 32 * dt + 8 * g) = w; } }
    __syncthreads();
}
__device__ __forceinline__ void kmean_unit(LAS unsigned char* lds, const bf16* h, float* kmean, float* kmaxg, int unit, int tid, int wave) {
    const int n = unit & 63, bh = unit >> 6, hh = bh % MB_H, b = bh / MB_H, d = tid & 63, part = tid >> 6;
    LAS float* red = (LAS float*)lds;
    float s = 0.f; const bf16* p = h + ((size_t)b * SEQ + n * 256 + part * 32) * NC_M + 768 + hh * 64 + d;
    for (int i = 0; i < 32; ++i) s += bf2f(p[(size_t)i * NC_M]);
    float ss = 0.f; { const v4u* kp = (const v4u*)(h + ((size_t)b * SEQ + n * 256 + (tid >> 1)) * NC_M + 768 + hh * 64 + (tid & 1) * 32);
#pragma unroll
        for (int w = 0; w < 4; ++w) { const v4u x = kp[w]; ss += bflo(x.x) * bflo(x.x) + bfhi(x.x) * bfhi(x.x) + bflo(x.y) * bflo(x.y) + bfhi(x.y) * bfhi(x.y) + bflo(x.z) * bflo(x.z) + bfhi(x.z) * bfhi(x.z) + bflo(x.w) * bflo(x.w) + bfhi(x.w) * bfhi(x.w); } }
    ss += xorf<1>(ss); ss = wave_max(ss);
    red[part * 64 + d] = s; if ((tid & 63) == 0) red[512 + wave] = ss; __syncthreads();
    if (tid < 64) { float a = 0.f; for (int pp = 0; pp < 8; ++pp) a += red[pp * 64 + tid]; a *= (1.f / 256.f);
        const unsigned hi = f2bf(a), lo = f2bf(a - __builtin_bit_cast(float, hi << 16)); bf16* kmh = (bf16*)kmean; kmh[((size_t)bh * 64 + n) * 64 + tid] = (bf16)hi; kmh[(size_t)24 * 4096 + ((size_t)bh * 64 + n) * 64 + tid] = (bf16)lo; }
    if (tid == 0) { float mx = 0.f; for (int w = 0; w < 8; ++w) mx = fmaxf(mx, red[512 + w]); kmaxg[bh * 64 + n] = sqrtf(mx) * 1.001f; }
    __syncthreads();
}
__device__ __forceinline__ void gate_unit_core(const s16x8 (&qf)[4], const s16x8 (&kf)[4], const bf16* kmh, const bf16* kml, LAS int* hist, const LAS float* kmx, int* selinfo, int bh, int c, int t, int lane, unsigned& sel, unsigned& rr) {
    const int hh = bh % MB_H, b = bh / MB_H, hf = lane >> 5, r = lane & 31;
    int s0 = 0, s1 = 0, s2 = 0, r0 = 0, r1 = 0, r2 = 0, ns = 0;
    float v0 = -INFINITY, v1 = -INFINITY, v2 = -INFINITY, qn = 0.f, lown = 0.f;
    if (c > 0) {
        const int ntile = (c + 31) >> 5, ch = c - 4 * hf;
        s16x8 ah[2][4], al[2][4];
#pragma unroll
        for (int tile = 0; tile < 2; ++tile) if (tile < ntile) { const size_t ko = ((size_t)bh * 64 + 32 * tile + r) * 64 + 8 * hf;
#pragma unroll
            for (int ks = 0; ks < 4; ++ks) { ah[tile][ks] = *(const s16x8*)(kmh + ko + 16 * ks); al[tile][ks] = *(const s16x8*)(kml + ko + 16 * ks); } }
#pragma unroll
        for (int tile = 0; tile < 2; ++tile) if (tile < ntile) {
            f32x16 X;
#pragma unroll
            for (int i = 0; i < 16; ++i) X[i] = 0.f;
#pragma unroll
            for (int ks = 0; ks < 4; ++ks) { X = __builtin_amdgcn_mfma_f32_32x32x16_bf16(ah[tile][ks], qf[ks], X, 0, 0, 0); X = __builtin_amdgcn_mfma_f32_32x32x16_bf16(al[tile][ks], qf[ks], X, 0, 0, 0); }
#pragma unroll
            for (int i = 0; i < 16; ++i) { const int n = 32 * tile + (i & 3) + 8 * (i >> 2); const float g = (n < ch) ? X[i] : -INFINITY;
                if (g > v0) { v2 = v1; s2 = s1; v1 = v0; s1 = s0; v0 = g; s0 = n; } else if (g > v1) { v2 = v1; s2 = s1; v1 = g; s1 = n; } else if (g > v2) { v2 = g; s2 = n; } }
        }
        s0 += 4 * hf; s1 += 4 * hf; s2 += 4 * hf;
        { float qq = 0.f, qk = 0.f;
#pragma unroll
          for (int s = 0; s < 4; ++s)
#pragma unroll
              for (int jj = 0; jj < 8; ++jj) { const float qv = bf2f((bf16)qf[s][jj]), kv = bf2f((bf16)kf[s][jj]); qq += qv * qv; qk += qv * kv; }
          qq += xor32f(qq, lane); qk += xor32f(qk, lane);
          qn = sqrtf(qq) * 1.001f; lown = qk; }
        { float pv[3]; int ps[3]; const int pl = (lane ^ 32) << 2;
          pv[0] = __builtin_bit_cast(float, __builtin_amdgcn_ds_bpermute(pl, __builtin_bit_cast(int, v0))); pv[1] = __builtin_bit_cast(float, __builtin_amdgcn_ds_bpermute(pl, __builtin_bit_cast(int, v1)));
          pv[2] = __builtin_bit_cast(float, __builtin_amdgcn_ds_bpermute(pl, __builtin_bit_cast(int, v2)));
          ps[0] = __builtin_amdgcn_ds_bpermute(pl, s0); ps[1] = __builtin_amdgcn_ds_bpermute(pl, s1); ps[2] = __builtin_amdgcn_ds_bpermute(pl, s2);
#pragma unroll
          for (int k = 0; k < 3; ++k) { const float g = pv[k]; const int n = ps[k];
              if (g > v0 || (g == v0 && n < s0)) { v2 = v1; s2 = s1; v1 = v0; s1 = s0; v0 = g; s0 = n; } else if (g > v1 || (g == v1 && n < s1)) { v2 = v1; s2 = s1; v1 = g; s1 = n; } else if (g > v2 || (g == v2 && n < s2)) { v2 = g; s2 = n; } } }
    }
    sel = 0u; rr = 0u;
    if (hf == 0) {
        ns = c < 3 ? c : 3; s0 &= 63; s1 &= 63; s2 &= 63;
        { const float slope2 = (hh < 8 ? ldexpf(1.0f, -(hh + 1)) : ldexpf(0.70710678118654752f, -(hh - 8))) * 1.4426950408889634f;
          const bool k0 = ns > 0 && (qn * kmx[s0] - slope2 * (float)(t - (s0 * 256 + 255)) - lown) > -64.f;
          const bool k1 = ns > 1 && (qn * kmx[s1] - slope2 * (float)(t - (s1 * 256 + 255)) - lown) > -64.f;
          const bool k2 = ns > 2 && (qn * kmx[s2] - slope2 * (float)(t - (s2 * 256 + 255)) - lown) > -64.f;
          ns = (k0 ? 1 : 0) | (k1 ? 2 : 0) | (k2 ? 4 : 0); }
        if (ns & 1) r0 = __hip_atomic_fetch_add(hist + s0, 1, __ATOMIC_RELAXED, __HIP_MEMORY_SCOPE_WORKGROUP);
        if (ns & 2) r1 = __hip_atomic_fetch_add(hist + s1, 1, __ATOMIC_RELAXED, __HIP_MEMORY_SCOPE_WORKGROUP);
        if (ns & 4) r2 = __hip_atomic_fetch_add(hist + s2, 1, __ATOMIC_RELAXED, __HIP_MEMORY_SCOPE_WORKGROUP);
        selinfo[((size_t)b * SEQ + t) * MB_H + hh] = ns;
        sel = (unsigned)s0 | ((unsigned)s1 << 6) | ((unsigned)s2 << 12) | ((unsigned)ns << 18); rr = (unsigned)r0 | ((unsigned)r1 << 8) | ((unsigned)r2 << 16);
    }
}
__device__ __forceinline__ void moba_gate_wg(LAS unsigned char* lds, const bf16* h, const float* kmean, const float* kmaxg, unsigned* gcount, int* selinfo, unsigned* list, int blk, int tid) {
    constexpr int NU = 24 * MB_NB / GRID;
    static_assert(NU * GRID == 24 * MB_NB && GRID % 64 == 0 && NU * 64 <= NTHR, "gate deal");
    const int lane = tid & 63, r = lane & 31, hf = lane >> 5, wv = tid >> 6;
    const bf16* kmh = (const bf16*)kmean; const bf16* kml = kmh + (size_t)24 * 4096;
    LAS int* hist = (LAS int*)(lds + 16384); LAS int* base = hist + NU * 64; LAS float* kmx = (LAS float*)(base + NU * 64);
    if (tid < NU * 64) { const int bh = (blk >> 6) + 4 * (tid >> 6); hist[tid] = 0; kmx[tid] = kmaxg[bh * 64 + (tid & 63)]; }
    unsigned sel[NU], rr[NU];
    s16x8 qf[4], kf[4];
#define GU_BH(k) ((blk >> 6) + 4 * (k))
#define GU_C(k) (((k) & 1) ? 63 - (blk & 63) : (blk & 63))
#define GU_T(k) (GU_C(k) * 256 + wv * 32 + r)
    { const bf16* qp = h + ((size_t)(GU_BH(0) / MB_H) * SEQ + GU_T(0)) * NC_M + (GU_BH(0) % MB_H) * 64 + 8 * hf;
#pragma unroll
      for (int s = 0; s < 4; ++s) { qf[s] = *(const s16x8*)(qp + 16 * s); kf[s] = *(const s16x8*)(qp + 768 + 16 * s); } }
    __syncthreads();
#pragma unroll
    for (int k = 0; k < NU; ++k) {
        s16x8 qn_[4], kn_[4];
        if (k + 1 < NU) { const bf16* qp = h + ((size_t)(GU_BH(k + 1) / MB_H) * SEQ + GU_T(k + 1)) * NC_M + (GU_BH(k + 1) % MB_H) * 64 + 8 * hf;
#pragma unroll
            for (int s = 0; s < 4; ++s) { qn_[s] = *(const s16x8*)(qp + 16 * s); kn_[s] = *(const s16x8*)(qp + 768 + 16 * s); } }
        gate_unit_core(qf, kf, kmh, kml, hist + k * 64, kmx + k * 64, selinfo, GU_BH(k), GU_C(k), GU_T(k), lane, sel[k], rr[k]);
        if (k + 1 < NU) {
#pragma unroll
            for (int s = 0; s < 4; ++s) { qf[s] = qn_[s]; kf[s] = kn_[s]; } }
    }
    __syncthreads();
    if (tid < NU * 64) { const int hc = hist[tid]; if (hc > 0) base[tid] = (int)__hip_atomic_fetch_add(gcount + GU_BH(tid >> 6) * 64 + (tid & 63), (unsigned)hc, __ATOMIC_RELAXED, __HIP_MEMORY_SCOPE_AGENT); }
    __syncthreads();
    if (hf == 0) {
#pragma unroll
        for (int k = 0; k < NU; ++k) { unsigned* lp = list + ((size_t)GU_BH(k) * 64 << 14); const unsigned sl = sel[k], rk = rr[k], t = (unsigned)GU_T(k); const int s0 = sl & 63, s1 = (sl >> 6) & 63, s2 = (sl >> 12) & 63;
            if (sl & (1u << 18)) lp[((size_t)s0 << 14) + base[k * 64 + s0] + (rk & 255u)] = t;
            if (sl & (2u << 18)) lp[((size_t)s1 << 14) + base[k * 64 + s1] + ((rk >> 8) & 255u)] = t | (1u << 14);
            if (sl & (4u << 18)) lp[((size_t)s2 << 14) + base[k * 64 + s2] + ((rk >> 16) & 255u)] = t | (2u << 14); } }
#undef GU_BH
#undef GU_C
#undef GU_T
    __syncthreads();
}
__device__ __forceinline__ void moba_attn_item(LAS unsigned char* lds, const bf16* h, const unsigned* gcount, const unsigned* list, float* po, float* pml, int item, int tid, int wave, int lane) {
    const int n = item / 24, bh = item - n * 24, hh = bh % MB_H, b = bh / MB_H;
    LAS unsigned* Ks = (LAS unsigned*)(lds + AT_KS); LAS unsigned* Vs32 = (LAS unsigned*)(lds + AT_VS);
    LAS float* qst = (LAS float*)(lds + AT_WV + wave * AT_WVB); LAS float* pb = qst + 256;
    for (int i = 0; i < 16; ++i) { const int idx = tid + 512 * i, r = idx >> 5, dd = idx & 31; const unsigned* src = (const unsigned*)(h + ((size_t)b * SEQ + n * 256 + r) * NC_M + hh * 64);
        Ks[r * 33 + dd] = src[384 + dd]; Vs32[r * 32 + dd] = src[768 + dd]; }
    __syncthreads();
    const int cnt = (int)gcount[bh * 64 + n], total = 256 + cnt, nquads = (total + 3) >> 2;
    const float slope = hh < 8 ? ldexpf(1.0f, -(hh + 1)) : ldexpf(0.70710678118654752f, -(hh - 8));
    const unsigned* lp = list + (((size_t)bh * 64 + n) << 14);
    for (int quad = wave; quad < nquads; quad += 8) {
        int tq[4], slot[4];
#pragma unroll
        for (int qi = 0; qi < 4; ++qi) { int idx = quad * 4 + qi; idx = idx < total ? idx : total - 1;
            if (idx < 256) { tq[qi] = n * 256 + idx; slot[qi] = 3; } else { const unsigned e = lp[idx - 256]; tq[qi] = (int)(e & 16383u); slot[qi] = (int)(e >> 14); } }
#pragma unroll
        for (int qi = 0; qi < 4; ++qi) qst[qi * 64 + lane] = bf2f(h[((size_t)b * SEQ + tq[qi]) * NC_M + hh * 64 + lane]);
        float m[4], l[4], o[4];
        attn4<true>(Ks, (const LAS bf16*)Vs32, qst, pb, lane, tq, n * 256, slope, m, l, o);
#pragma unroll
        for (int qi = 0; qi < 4; ++qi) if (quad * 4 + qi < total) { const size_t pi = (((size_t)b * SEQ + tq[qi]) * MB_H + hh) * 4 + slot[qi];
            po[pi * 64 + lane] = o[qi]; if (lane == 0) { pml[pi * 2] = m[qi]; pml[pi * 2 + 1] = l[qi]; } }
    }
    __syncthreads();
}

__device__ __forceinline__ void moba_attn_item2(LAS unsigned char* lds, const bf16* h, const float* kmaxg, const unsigned* gcount, const unsigned* list, bf16* po, float* pml, int item, int tid, int wave, int lane) {
    const int n = item / 24, bh = item - n * 24, hh = bh % MB_H, b = bh / MB_H, r = lane & 31, hf = lane >> 5;
    const bf16* hrow0 = h + ((size_t)b * SEQ + n * 256) * NC_M + hh * 64;
    stage_kv_images(lds, hrow0 + 768, hrow0 + 1536, NC_M, tid);
    __syncthreads();
    const int cnt = (int)gcount[bh * 64 + n], total = 256 + cnt, ntiles = (total + 31) >> 5;
    const float slope2 = (hh < 8 ? ldexpf(1.0f, -(hh + 1)) : ldexpf(0.70710678118654752f, -(hh - 8))) * 1.4426950408889634f;
    const unsigned shi = f2bf(slope2), slo = f2bf(slope2 - __builtin_bit_cast(float, shi << 16)); const unsigned qx = hf == 0 ? (shi | (slo << 16)) : 0u;
    const unsigned* lp = list + (((size_t)bh * 64 + n) << 14);
    const float kmx1 = kmaxg[bh * 64 + n];
    const bf16* hq = h + (size_t)b * SEQ * NC_M + hh * 64 + 8 * hf;
#pragma unroll 1
    for (int tile = wave; tile < ntiles; tile += NWAVES) {
        int idx = tile * 32 + r; const bool valid = idx < total; idx = valid ? idx : total - 1;
        int tq, slot; if (idx < 256) { tq = n * 256 + idx; slot = 3; } else { const unsigned e = lp[idx - 256]; tq = (int)(e & 16383u); slot = (int)(e >> 14); }
        s16x8 qf[4]; { const bf16* qp = hq + (size_t)tq * NC_M;
#pragma unroll
            for (int s = 0; s < 4; ++s) qf[s] = *(const s16x8*)(qp + 16 * s); }
        f32x16 o[2]; float m2, l; const float dist0 = (float)(tq - n * 256);
        unsigned qx2;
        { float qq = 0.f;
#pragma unroll
          for (int s = 0; s < 4; ++s)
#pragma unroll
              for (int jj = 0; jj < 8; ++jj) { const float qv = bf2f((bf16)qf[s][jj]); qq += qv * qv; }
          qq += xor32f(qq, lane);
          const float sh = sqrtf(qq) * kmx1 + slope2 * fminf(dist0, 255.f);
          const unsigned nh = f2bf(-sh), nl = f2bf(-sh - __builtin_bit_cast(float, nh << 16)); qx2 = hf == 0 ? (nh | (nl << 16)) : 0u;
          m2 = -(__builtin_bit_cast(float, nh << 16) + __builtin_bit_cast(float, nl << 16)); }
        attn_tile32<true>(lds, qf, lane, dist0, qx, qx2, tile < 8, o, m2, l);
        { LAS unsigned char* sw = lds + AT2_SCR + wave * AT2_SCRW; const int pi = valid ? (int)((((size_t)b * SEQ + tq) * MB_H + hh) * 4 + slot) : -1;
#pragma unroll
          for (int dt = 0; dt < 2; ++dt)
#pragma unroll
              for (int g = 0; g < 4; ++g) { v2u w; w.x = cvtpk(o[dt][4 * g], o[dt][4 * g + 1]); w.y = cvtpk(o[dt][4 * g + 2], o[dt][4 * g + 3]); *(LAS v2u*)(sw + r * 144 + (32 * dt + 8 * g + 4 * hf) * 2) = w; }
          if (hf == 0) { *(LAS int*)(sw + 4608 + 4 * r) = pi; if (valid) { pml[(size_t)pi * 2] = m2 - slope2 * dist0; pml[(size_t)pi * 2 + 1] = l; } }
#pragma unroll
          for (int it = 0; it < 4; ++it) { const int q = 8 * it + (lane >> 3), c = lane & 7; const int pq = *(const LAS int*)(sw + 4608 + 4 * q); const v4u row = *(const LAS v4u*)(sw + q * 144 + c * 16);
              if (pq >= 0) *(v4u*)(po + (size_t)pq * 64 + c * 8) = row; } }
    }
    __syncthreads();
}
__device__ __forceinline__ void moba_combine(const bf16* __restrict__ po, const float* __restrict__ pml, const int* __restrict__ selinfo, bf16* __restrict__ mix, int gw, int ngw, int lane) {
    const int sub = lane >> 4, d4 = (lane & 15) * 4;
#pragma unroll 8
    for (int idx = gw * 4 + sub; idx < T * MB_H; idx += ngw * 4) { const int tg = idx / MB_H, hh = idx - tg * MB_H, ns = selinfo[idx]; const size_t p4 = (size_t)idx * 4;
        f32x2 ml[4]; f32x4 ov[4];
#pragma unroll
        for (int j = 0; j < 4; ++j) { const size_t pj = p4 + ((j == 3 || ((ns >> j) & 1)) ? j : 3);
            ml[j] = ((const f32x2*)pml)[pj]; const v2u ow = *(const v2u*)(po + pj * 64 + d4); ov[j] = (f32x4){bflo(ow.x), bfhi(ow.x), bflo(ow.y), bfhi(ow.y)}; }
        float M = ml[3].x;
#pragma unroll
        for (int j = 0; j < 3; ++j) { const bool ok = (ns >> j) & 1; ml[j].x = ok ? ml[j].x : -INFINITY; ml[j].y = ok ? ml[j].y : 0.f; M = fmaxf(M, ml[j].x);
            ov[j].x = ok ? ov[j].x : 0.f; ov[j].y = ok ? ov[j].y : 0.f; ov[j].z = ok ? ov[j].z : 0.f; ov[j].w = ok ? ov[j].w : 0.f; }
        float den = 0.f; f32x4 num = {0.f, 0.f, 0.f, 0.f};
#pragma unroll
        for (int j = 0; j < 4; ++j) { const float w = __builtin_amdgcn_exp2f(ml[j].x - M); den += w * ml[j].y; num += ov[j] * w; }
        const float inv = 1.f / den; v2u o; o.x = pk2(num.x * inv, num.y * inv); o.y = pk2(num.z * inv, num.w * inv);
        *(v2u*)(mix + (size_t)tg * 1024 + hh * 64 + d4) = o; }
}

template <int CTRL> __device__ __forceinline__ float dppf(float v) { return __builtin_bit_cast(float, __builtin_amdgcn_update_dpp(0, __builtin_bit_cast(int, v), CTRL, 0xF, 0xF, true)); }
template <int CTRL> __device__ __forceinline__ int dppi(int v) { return __builtin_amdgcn_update_dpp(0, v, CTRL, 0xF, 0xF, true); }
__device__ __forceinline__ float wave_sum_dpp(float v) {
    v += dppf<0xB1>(v); v += dppf<0x4E>(v); v += dppf<0x141>(v); v += dppf<0x140>(v);
    v += __builtin_bit_cast(float, __builtin_amdgcn_update_dpp(0, __builtin_bit_cast(int, v), 0x142, 0xA, 0xF, false));
    v += __builtin_bit_cast(float, __builtin_amdgcn_update_dpp(0, __builtin_bit_cast(int, v), 0x143, 0xC, 0xF, false));
    return __builtin_bit_cast(float, __builtin_amdgcn_readlane(__builtin_bit_cast(int, v), 63));
}
__device__ __forceinline__ void ln_row(f32x4 (&v)[4], const f32x4 (&gv)[4], const f32x4 (&bv)[4]) {
    float s = 0.f;
#pragma unroll
    for (int j = 0; j < 4; ++j) s += (v[j].x + v[j].y) + (v[j].z + v[j].w);
    const float mean = wave_sum_dpp(s) * (1.f / D); float s2 = 0.f;
#pragma unroll
    for (int j = 0; j < 4; ++j) { v[j] = v[j] - mean; s2 += (v[j].x * v[j].x + v[j].y * v[j].y) + (v[j].z * v[j].z + v[j].w * v[j].w); }
    const float rstd = __builtin_amdgcn_rsqf(wave_sum_dpp(s2) * (1.f / D) + 1e-5f);
#pragma unroll
    for (int j = 0; j < 4; ++j) v[j] = v[j] * rstd * gv[j] + bv[j];
}
__device__ __forceinline__ void split_router_weights(const float* wr  , bf16* wrs  , size_t gtid, size_t gthreads) {
    for (size_t i = gtid; i < (size_t)DEPTH * D * NE; i += gthreads) { const int e = (int)(i & 31), d = (int)((i >> 5) & 1023), l = (int)(i >> 15);
        const float w = wr[i]; const unsigned hi = f2bf(w); const unsigned lo = f2bf(w - __builtin_bit_cast(float, hi << 16));
        wrs[(((size_t)l * 2 + 0) * NE + e) * D + d] = (bf16)hi; wrs[(((size_t)l * 2 + 1) * NE + e) * D + d] = (bf16)lo; }
}
constexpr int L1_XH = 0, L1_XL = 33024, L1_ROW = 2064, L1_PART = 66048, L1_HIST = 82432, L1_TOK = 82944;
__device__ __forceinline__ void phase_ln1(LAS unsigned char* lds, const bf16* y, const float* g, const float* bb, const bf16* wrs  , const float* br,
                                          bf16* xbf, unsigned char* x8, int* tok_e, int* tok_lr, float* tok_w, int* blk_cnt, int blk, int tid, int wave, int lane) {
    LAS float* part = (LAS float*)(lds + L1_PART);
    LAS int* hist = (LAS int*)(lds + L1_HIST); LAS int* tokl = (LAS int*)(lds + L1_TOK);
    if (tid < 32) hist[tid] = 0;
    constexpr int TPB = T / GRID;
    const int e = lane & 31, m16 = lane & 15, quad = lane >> 4;
    s16x8 bw[4][2][2];
#pragma unroll
    for (int ks = 0; ks < 4; ++ks)
#pragma unroll
        for (int nt = 0; nt < 2; ++nt)
#pragma unroll
            for (int pp = 0; pp < 2; ++pp) bw[ks][nt][pp] = *(const s16x8*)(wrs + ((size_t)pp * NE + 16 * nt + m16) * D + wave * 128 + 32 * ks + 8 * quad);
    const float bre = br[e];
    f32x4 gv[4], bv[4];
#pragma unroll
    for (int j = 0; j < 4; ++j) { gv[j] = ((const f32x4*)g)[lane + 64 * j]; bv[j] = ((const f32x4*)bb)[lane + 64 * j]; }
    v2u xn[2][4], yn[2][4];
#pragma unroll
    for (int u = 0; u < 2; ++u) { const size_t t0 = (size_t)blk * TPB + 2 * wave + u; const v2u* xr = (const v2u*)(xbf + t0 * D) + lane; const v2u* yr = (const v2u*)(y + t0 * D) + lane;
#pragma unroll
        for (int j = 0; j < 4; ++j) { xn[u][j] = xr[64 * j]; yn[u][j] = yr[64 * j]; } }
#pragma unroll
    for (int j = 0; j < 4; ++j) asm volatile("" :: "v"(gv[j]), "v"(bv[j]), "v"(xn[0][j]), "v"(xn[1][j]), "v"(yn[0][j]), "v"(yn[1][j]));
#pragma unroll
    for (int ks = 0; ks < 4; ++ks) asm volatile("" :: "v"(bw[ks][0][0]), "v"(bw[ks][0][1]), "v"(bw[ks][1][0]), "v"(bw[ks][1][1]));
    asm volatile("" :: "v"(bre));
    __syncthreads();
    for (int grp = 0; grp < TPB / 16; ++grp) { const size_t tg0 = (size_t)blk * TPB + grp * 16 + 2 * wave;
        f32x4 v[2][4];
#pragma unroll
        for (int u = 0; u < 2; ++u)
#pragma unroll
            for (int j = 0; j < 4; ++j) { const v2u xw = xn[u][j]; const v2u yw = yn[u][j];
                v[u][j].x = DN_ALPHA * bflo(xw.x) + bflo(yw.x); v[u][j].y = DN_ALPHA * bfhi(xw.x) + bfhi(yw.x); v[u][j].z = DN_ALPHA * bflo(xw.y) + bflo(yw.y); v[u][j].w = DN_ALPHA * bfhi(xw.y) + bfhi(yw.y); }
        if (grp + 1 < TPB / 16) {
#pragma unroll
            for (int u = 0; u < 2; ++u) { const v2u* xr = (const v2u*)(xbf + (tg0 + 16 + u) * D) + lane; const v2u* yr = (const v2u*)(y + (tg0 + 16 + u) * D) + lane;
#pragma unroll
                for (int j = 0; j < 4; ++j) { xn[u][j] = xr[64 * j]; yn[u][j] = yr[64 * j]; } } }
#pragma unroll
        for (int u = 0; u < 2; ++u) { ln_row(v[u], gv, bv);
            v2u* xb = (v2u*)(xbf + (tg0 + u) * D) + lane; unsigned* x8r = (unsigned*)(x8 + (tg0 + u) * D) + lane;
#pragma unroll
            for (int j = 0; j < 4; ++j) { v2u hw; hw.x = cvtpk(v[u][j].x, v[u][j].y); hw.y = cvtpk(v[u][j].z, v[u][j].w); xb[64 * j] = hw;
                x8r[64 * j] = pk4_fp8(bflo(hw.x), bfhi(hw.x), bflo(hw.y), bfhi(hw.y));
                v2u lw; lw.x = cvtpk(v[u][j].x - bflo(hw.x), v[u][j].y - bfhi(hw.x)); lw.y = cvtpk(v[u][j].z - bflo(hw.y), v[u][j].w - bfhi(hw.y));
                *(LAS v2u*)(lds + L1_XH + (2 * wave + u) * L1_ROW + (4 * lane + 256 * j) * 2) = hw; *(LAS v2u*)(lds + L1_XL + (2 * wave + u) * L1_ROW + (4 * lane + 256 * j) * 2) = lw; } }
        __syncthreads();
        { f32x4 acc[2] = {{0.f, 0.f, 0.f, 0.f}, {0.f, 0.f, 0.f, 0.f}};
#pragma unroll
          for (int ks = 0; ks < 4; ++ks) { const int off = m16 * L1_ROW + (wave * 128 + 32 * ks + 8 * quad) * 2;
              const s16x8 ah = *(const LAS s16x8*)(lds + L1_XH + off), al = *(const LAS s16x8*)(lds + L1_XL + off);
#pragma unroll
              for (int nt = 0; nt < 2; ++nt) { acc[nt] = __builtin_amdgcn_mfma_f32_16x16x32_bf16(ah, bw[ks][nt][0], acc[nt], 0, 0, 0); acc[nt] = __builtin_amdgcn_mfma_f32_16x16x32_bf16(ah, bw[ks][nt][1], acc[nt], 0, 0, 0);
                  acc[nt] = __builtin_amdgcn_mfma_f32_16x16x32_bf16(al, bw[ks][nt][0], acc[nt], 0, 0, 0); } }
#pragma unroll
          for (int nt = 0; nt < 2; ++nt)
#pragma unroll
              for (int jj = 0; jj < 4; ++jj) part[(wave * 16 + 4 * quad + jj) * 32 + 16 * nt + m16] = acc[nt][jj]; }
        __syncthreads();
#pragma unroll
        for (int u = 0; u < 2; ++u) { const size_t t = tg0 + u;
            float logit = bre;
#pragma unroll
            for (int w = 0; w < 8; ++w) logit += part[(w * 16 + 2 * wave + u) * 32 + e];
            int se[4]; float sv[4]; int cur = __builtin_bit_cast(int, logit); cur ^= (cur >> 31) & 0x7fffffff;
#pragma unroll
            for (int k = 0; k < 4; ++k) { int m = cur;
                m = max(m, dppi<0xB1>(m)); m = max(m, dppi<0x4E>(m)); m = max(m, dppi<0x141>(m)); m = max(m, dppi<0x140>(m));
                const int mm = max(__builtin_amdgcn_readlane(m, 0), __builtin_amdgcn_readlane(m, 16));
                const unsigned long long mk = __ballot(cur == mm); const int src = __builtin_ctzll(mk);
                se[k] = src; sv[k] = __builtin_bit_cast(float, mm ^ ((mm >> 31) & 0x7fffffff)); cur = (e == src) ? (int)0x80000000 : cur; }
            const float e1 = __expf(sv[1] - sv[0]), e2 = __expf(sv[2] - sv[0]), e3 = __expf(sv[3] - sv[0]), inv = __builtin_amdgcn_rcpf(1.f + e1 + e2 + e3);
            const float wk[4] = {inv, e1 * inv, e2 * inv, e3 * inv};
            if (lane == 0) { const int tl = (grp * 16 + 2 * wave + u) * 4;
#pragma unroll
                for (int k = 0; k < 4; ++k) { const int lr = __hip_atomic_fetch_add(hist + se[k], 1, __ATOMIC_RELAXED, __HIP_MEMORY_SCOPE_WORKGROUP);
                    tokl[tl + k] = se[k]; tokl[512 + tl + k] = lr; tokl[1024 + tl + k] = __builtin_bit_cast(int, wk[k]); } } }
    }
    __syncthreads();
    if (tid < 32) blk_cnt[blk * 32 + tid] = hist[tid];
    { const size_t ti = (size_t)blk * TPB * 4 + tid; tok_e[ti] = tokl[tid]; tok_lr[ti] = tokl[512 + tid]; tok_w[ti] = __builtin_bit_cast(float, tokl[1024 + tid]); }
    __syncthreads();
}
__device__ __forceinline__ void phase_dispatch(LAS unsigned char* lds, const int* __restrict__ blk_cnt, const int* __restrict__ tok_e, const int* __restrict__ tok_lr, int* __restrict__ tok_row, int* __restrict__ tab,
                                               int* __restrict__ rowtok, int blk, int tid, int wave, int lane) {
    LAS int* tot = (LAS int*)lds; LAS int* pre = tot + 32; LAS int* pst = pre + 32; LAS int* rows = pst + 64;
    LAS int* red = rows + 512;
    static_assert(GRID == 256 && NTHR == 512, "16 thread groups x 16 blocks");
    { const int e = tid & 31, part = tid >> 5; int s = 0, p = 0;
#pragma unroll
      for (int i = 0; i < 16; ++i) { const int bb = part * 16 + i; const int c = blk_cnt[bb * 32 + e]; s += c; p += (bb < blk) ? c : 0; }
      red[part * 32 + e] = s; red[512 + part * 32 + e] = p; }
    __syncthreads();
    if (tid < 32) { int s = 0, p = 0;
#pragma unroll
        for (int q = 0; q < 16; ++q) { s += red[q * 32 + tid]; p += red[512 + q * 32 + tid]; }
        tot[tid] = s; pre[tid] = p; }
    __syncthreads();
    if (tid == 0) { int acc = 0; for (int e = 0; e < 32; ++e) { pst[e] = acc; acc += ((tot[e] + 255) >> 8) << 8; } pst[32] = acc; }
    __syncthreads();
    if (blk == 0 && tid < 33) tab[tid] = pst[tid] >> 8;
    constexpr int TPB = T / GRID;
    static_assert(TPB * 4 == NTHR, "one (token, k) pair per thread");
    { const size_t ti = (size_t)blk * TPB * 4 + tid; const int e = tok_e[ti]; const int r = pst[e] + pre[e] + tok_lr[ti]; tok_row[ti] = r; rowtok[r] = blk * TPB + (tid >> 2); }
    if (blk < NE) { const int r0 = pst[blk] + tot[blk], npad = pst[blk + 1] - r0; if (tid < npad) rowtok[r0 + tid] = 0; }
    __syncthreads();
}
__device__ __forceinline__ f32x4 fp8x4_to_f32(unsigned w) {
    const f32x2 lo = __builtin_amdgcn_cvt_pk_f32_fp8((int)w, false), hi = __builtin_amdgcn_cvt_pk_f32_fp8((int)w, true); return (f32x4){lo.x, lo.y, hi.x, hi.y};
}
__device__ __forceinline__ void phase_ln2(const unsigned char* __restrict__ yrows, const int* __restrict__ tok_row, const float* __restrict__ tok_w, const float* __restrict__ g, const float* __restrict__ bb,
                                          float* __restrict__ xout, bf16* xbf, int gw, int ngw, int lane) {
    f32x4 gv[4], bv[4];
#pragma unroll
    for (int j = 0; j < 4; ++j) { gv[j] = ((const f32x4*)g)[lane + 64 * j]; bv[j] = ((const f32x4*)bb)[lane + 64 * j]; }
    constexpr int NTK = 2;
    static_assert(T % (NTK * GRID * NWAVES) == 0, "NTK tokens per wave per step");
    for (int t0 = gw; t0 < T; t0 += NTK * ngw) {
        f32x4 v[NTK][4];
#pragma unroll
        for (int u = 0; u < NTK; ++u) { const int t = t0 + u * ngw; int r[4]; float w[4];
#pragma unroll
            for (int k = 0; k < 4; ++k) { r[k] = tok_row[(size_t)t * 4 + k]; w[k] = tok_w[(size_t)t * 4 + k] * (1.f / 16.f); }
            const v2u* xr = (const v2u*)(xbf + (size_t)t * D) + lane;
#pragma unroll
            for (int j = 0; j < 4; ++j) { f32x4 f = {0.f, 0.f, 0.f, 0.f};
#pragma unroll
                for (int k = 0; k < 4; ++k) { const unsigned yw = ((const unsigned*)(yrows + (size_t)r[k] * D))[lane + 64 * j]; f += fp8x4_to_f32(yw) * w[k]; }
                const v2u xw = xr[64 * j]; v[u][j].x = DN_ALPHA * bflo(xw.x) + f.x; v[u][j].y = DN_ALPHA * bfhi(xw.x) + f.y; v[u][j].z = DN_ALPHA * bflo(xw.y) + f.z; v[u][j].w = DN_ALPHA * bfhi(xw.y) + f.w; } }
#pragma unroll
        for (int u = 0; u < NTK; ++u) { const int t = t0 + u * ngw;
            ln_row(v[u], gv, bv);
            if (xout) { f32x4* xo = (f32x4*)(xout + (size_t)t * D) + lane;
#pragma unroll
                for (int j = 0; j < 4; ++j) xo[64 * j] = v[u][j]; }
            else { v2u* xb = (v2u*)(xbf + (size_t)t * D) + lane;
#pragma unroll
                for (int j = 0; j < 4; ++j) { v2u ww; ww.x = pk2(v[u][j].x, v[u][j].y); ww.y = pk2(v[u][j].z, v[u][j].w); xb[64 * j] = ww; } } } }
}


struct Args { const float* in[20]; float* out; unsigned char* ws; int l_lo, l_hi, ph_lo, ph_hi; };
typedef const __attribute__((address_space(4))) Args* KArgsP;
#define KA_LOAD() ({ KArgsP p_ = (KArgsP)__builtin_amdgcn_kernarg_segment_ptr(); asm volatile("" : "+s"(p_)); p_; })
#ifndef PHMASK
#define PHMASK 0xFFFF
#endif
#ifndef REPEAT_MASK
#define REPEAT_MASK 0
#endif
#ifndef REPEAT_LMASK
#define REPEAT_LMASK 0xF
#endif
#define PH_BEGIN(k) _Pragma("unroll") for (int rep_ = 0; rep_ < ((((REPEAT_MASK >> (k)) & 1) && ((REPEAT_LMASK >> l) & 1)) ? 2 : 1); ++rep_) { if ((PHMASK >> (k)) & 1) { KArgsP ka = KA_LOAD(); unsigned char* ws = ka->ws; int tid = threadIdx.x; asm volatile("" : "+v"(tid)); \
    const int lane = tid & 63, wave = __builtin_amdgcn_readfirstlane(tid >> 6); int blk = blockIdx.x; asm volatile("" : "+s"(blk)); \
    const int gw = blk * NWAVES + wave; const size_t gtid = (size_t)blk * NTHR + tid; (void)lane; (void)gw; (void)gtid; (void)ws;
#if ONE_LAUNCH
#define PH_SEAM() do { XcdBarrier b_; b_.bar = (unsigned*)(KA_LOAD()->ws + WS_CTL) + CW_BAR; b_.x = xb_xcc_id(); b_.st = (volatile LAS unsigned*)(lds + MISC_OFF); xcd_barrier(b_); } while (0)
#else
#define PH_SEAM() do {} while (0)
#endif
#define PH_END() PH_SEAM(); } }
#define PH_END_NOSEAM() } }
#define WSP(type, off) ((type*)(ws + (off)))
constexpr int G = GRID, NGW = GRID * NWAVES; constexpr size_t GTHREADS = (size_t)GRID * NTHR;
template <int L> __device__ __forceinline__ void layer_phases(LAS unsigned char* lds) {
    constexpr int l = L; LAS int* tabL = (LAS int*)(lds + MISC_OFF + 256);

        const int j = l >> 1; const bool moba = (l & 1) != 0;
        const int NC = moba ? NC_M : NC_H, qoff = moba ? 2304 : 3072;

        if (l == 0) {
        PH_BEGIN(1)
            phase_weights((LAS float*)(lds + wave * 16384), gw, NGW, lane, ka->in[2], NC_H, ka->in[6], 4, ka->in[7], ka->in[12], ka->in[14], ka->in[16], WSP(bf16, WS_WIN), WSP(bf16, WS_WKV4), WSP(bf16, WS_WO), WSP(bf16, WS_WGU), WSP(bf16, WS_WD));
        PH_END()
        }
        PH_BEGIN(2)
            { pg8::Gemm g{WSP(bf16, WS_XBF), WSP(bf16, WS_WIN), T, NC, D, 0, 0}; pg8::StaticOrder S; S.init(T, NC, G, blk); pg8::EpiPlain E{WSP(bf16, WS_H), NC, moba ? 0x207u : 0x1000u, 0.125f * 1.4426950408889634f};
              pg8::gemm_phase<pg8::EpiPlain, pg8::StaticOrder, true, true>(lds, g, S, E); }
            if (l == 0) {
              pg8::Gemm g{WSP(bf16, WS_MEMBF), WSP(bf16, WS_WKV4), 512, 2048, D, 0, 0}; pg8::StaticOrder S; S.init(512, 2048, G, blk >= 128 ? blk - 128 : G); pg8::EpiPlain E{WSP(bf16, WS_KV4), 2048, 0u, 1.f};
              pg8::gemm_phase<pg8::EpiPlain, pg8::StaticOrder, true, true>(lds, g, S, E); }
        PH_END()
        if (!moba) {
            PH_BEGIN(3)
                for (int u = blk; u < NBATCH * HG_H * HNSEG; u += G) hgrn_mfma<false>(lds, WSP(bf16, WS_H), ka->in[3], j, ka->in[4] + j * 128, WSP(float, WS_SLOC), WSP(float, WS_DSEG), WSP(bf16, WS_MIX), u, tid, wave, lane);
                for (int u = blk; u < 512; u += G) memattn_unit2(lds, WSP(bf16, WS_H), NC, qoff, WSP(bf16, WS_KV4) + 512 * l, WSP(bf16, WS_MIX), u, tid, wave, lane);
            PH_END()
            PH_BEGIN(4)
                hgrn_scan(WSP(float, WS_SLOC), WSP(float, WS_DSEG), gtid, GTHREADS);
            PH_END()
            PH_BEGIN(5)
                for (int u = blk; u < NBATCH * HG_H * HNSEG; u += G) hgrn_mfma<true>(lds, WSP(bf16, WS_H), ka->in[3], j, ka->in[4] + j * 128, WSP(float, WS_SLOC), WSP(float, WS_DSEG), WSP(bf16, WS_MIX), u, tid, wave, lane);
            PH_END()
        } else {
            PH_BEGIN(3)
                for (int u = blk; u < 24 * MB_NB; u += G) kmean_unit(lds, WSP(bf16, WS_H), WSP(float, WS_KMEAN), WSP(float, WS_KMEAN + 512 * 1024), u, tid, wave);
                for (int u = blk; u < 512; u += G) memattn_unit2(lds, WSP(bf16, WS_H), NC, qoff, WSP(bf16, WS_KV4) + 512 * l, WSP(bf16, WS_MIX), u, tid, wave, lane);
            PH_END()
            PH_BEGIN(4)
                moba_gate_wg(lds, WSP(bf16, WS_H), WSP(float, WS_KMEAN), WSP(float, WS_KMEAN + 512 * 1024), WSP(unsigned, WS_CTL) + CW_GCOUNT + j * 1536, WSP(int, WS_SELINFO), WSP(unsigned, WS_LIST), blk, tid);
            PH_END()
            PH_BEGIN(5)
                { unsigned* qhead = WSP(unsigned, WS_CTL) + CW_GCOUNT + 2 * 1536 + 64 * j; LAS int* itl = (LAS int*)(lds + MISC_OFF + 512);
                  for (;;) { if (tid == 0) *itl = (int)__hip_atomic_fetch_add(qhead, 1u, __ATOMIC_RELAXED, __HIP_MEMORY_SCOPE_AGENT);
                      __syncthreads(); const int it = *itl; __syncthreads();
                      if (it >= 24 * MB_NB) break;
                      moba_attn_item2(lds, WSP(bf16, WS_H), WSP(float, WS_KMEAN + 512 * 1024), WSP(unsigned, WS_CTL) + CW_GCOUNT + j * 1536, WSP(unsigned, WS_LIST), WSP(bf16, WS_PO), WSP(float, WS_PML), it, tid, wave, lane); } }
            PH_END()
            PH_BEGIN(6)
                moba_combine(WSP(bf16, WS_PO), WSP(float, WS_PML), WSP(int, WS_SELINFO), WSP(bf16, WS_MIX), gw, NGW, lane);
            PH_END()
        }
        PH_BEGIN(7)
            pg8::Gemm g{WSP(bf16, WS_MIX), WSP(bf16, WS_WO), T, D, D, 0, 0, nullptr}; pg8::StaticOrder S; S.init(T, D, G, blk); pg8::EpiPlain E{WSP(bf16, WS_Y), D, 0u, 1.f};
            pg8::gemm_phase<pg8::EpiPlain, pg8::StaticOrder, true, true>(lds, g, S, E);
        PH_END()
        PH_BEGIN(8)
            phase_ln1(lds, WSP(bf16, WS_Y), ka->in[8] + l * D, ka->in[9] + l * D, WSP(bf16, WS_WRS) + (size_t)l * 2 * NE * D, ka->in[11] + l * NE, WSP(bf16, WS_XBF), WSP(unsigned char, WS_H),
                      WSP(int, WS_TOK + TOK_E), WSP(int, WS_TOK + TOK_LR), WSP(float, WS_TOK + TOK_W), WSP(int, WS_TOK + TOK_BLKCNT), blk, tid, wave, lane);
        PH_END()
        PH_BEGIN(9)
            phase_dispatch(lds, WSP(int, WS_TOK + TOK_BLKCNT), WSP(int, WS_TOK + TOK_E), WSP(int, WS_TOK + TOK_LR), WSP(int, WS_TOK + TOK_ROW), WSP(int, WS_TOK + TOK_TAB), WSP(int, WS_H + 64 * MiB), blk, tid, wave, lane);
        PH_END()
        PH_BEGIN(10)
            if (tid < 33) tabL[tid] = WSP(int, WS_TOK + TOK_TAB)[tid];
            __syncthreads();
            int sw_ = 0x7A7A7A7A, sx_ = 0x7F7F7F7F; asm volatile("" : "+s"(sw_), "+s"(sx_));
            pg8::Gemm g{WSP(bf16, WS_H), WSP(bf16, WS_WGU), MOE_MAXROWS, NE * 2048, D / 2, sw_, sx_, WSP(int, WS_H + 64 * MiB)};   pg8::MoeOrder S{tabL, 8, G, blk, tabL[32] * 8, false};
            pg8::EpiSwiglu E{WSP(unsigned char, WS_HID), ka->in[13] + (size_t)l * NE * 1024, ka->in[15] + (size_t)l * NE * 1024};
            pg8::gemm_phase<pg8::EpiSwiglu, pg8::MoeOrder, true, true, true, true>(lds, g, S, E);
        PH_END()
        PH_BEGIN(11)
            if (tid < 33) tabL[tid] = WSP(int, WS_TOK + TOK_TAB)[tid];
            __syncthreads();
            int sw_ = 0x79797979, sx_ = 0x83838383; asm volatile("" : "+s"(sw_), "+s"(sx_));
            pg8::Gemm g{WSP(bf16, WS_HID), WSP(bf16, WS_WD), MOE_MAXROWS, NE * 1024, D / 2, sw_, sx_, nullptr}; pg8::MoeOrder S{tabL, 4, G, blk, tabL[32] * 4, true};
            pg8::EpiDown E{WSP(unsigned char, WS_XS), ka->in[17] + (size_t)l * NE * 1024};
            pg8::gemm_phase<pg8::EpiDown, pg8::MoeOrder, true, true, true>(lds, g, S, E);
        PH_END()
        PH_BEGIN(12)
            float* x2out = (l == DEPTH - 1) ? ka->out : nullptr;
            phase_ln2(WSP(unsigned char, WS_XS), WSP(int, WS_TOK + TOK_ROW), WSP(float, WS_TOK + TOK_W), ka->in[18] + l * D, ka->in[19] + l * D, x2out, WSP(bf16, WS_XBF), gw, NGW, lane);
            if (l + 1 < DEPTH) { constexpr int ln = l + 1, jn = ln >> 1; constexpr bool mn = (ln & 1) != 0;
                const float* win_src = mn ? ka->in[5] + (size_t)jn * D * NC_M : ka->in[2] + (size_t)jn * D * NC_H; const size_t moff = (size_t)ln * NE * 1024 * 1024;
                phase_weights((LAS float*)(lds + wave * 16384), gw, NGW, lane, win_src, mn ? NC_M : NC_H, ka->in[6], 0, ka->in[7] + (size_t)ln * D * D,
                              ka->in[12] + moff, ka->in[14] + moff, ka->in[16] + moff, WSP(bf16, WS_WIN), WSP(bf16, WS_WKV4), WSP(bf16, WS_WO), WSP(bf16, WS_WGU), WSP(bf16, WS_WD)); }
            if (l + 1 < DEPTH) PH_SEAM();
        PH_END_NOSEAM()
}
__global__ void __launch_bounds__(NTHR, 2) fwd_kernel(Args args) {
    extern __shared__ __attribute__((aligned(16))) unsigned char lds_raw[];
    LAS unsigned char* lds = (LAS unsigned char*)lds_raw;
    if (threadIdx.x < 4) ((LAS unsigned*)(lds + MISC_OFF))[threadIdx.x] = 0u;
    __syncthreads();
#if ONE_LAUNCH
    (void)xcd_barrier_post((unsigned*)(args.ws + WS_CTL) + CW_BAR, (volatile LAS unsigned*)(lds + MISC_OFF));
#endif
    { const int l = 0; (void)l;
    PH_BEGIN(0)
        cvt_rows_bf16(ka->in[0], WSP(bf16, WS_XBF), (size_t)T * D / 8, gtid, GTHREADS);
        cvt_rows_bf16(ka->in[1], WSP(bf16, WS_MEMBF), (size_t)512 * D / 8, gtid, GTHREADS);
        split_router_weights(ka->in[10], WSP(bf16, WS_WRS), gtid, GTHREADS);
    PH_END_NOSEAM() }
    layer_phases<0>(lds); layer_phases<1>(lds); layer_phases<2>(lds); layer_phases<3>(lds);
}

extern "C" void kernel_launch(void* const* d_in, const int* in_sizes, int n_in, void* d_out, int out_size, void* d_ws, size_t ws_size, hipStream_t stream) {
    static int ready = 0;
    if (ready == 0) {
        if (n_in != 20 || in_sizes[0] != T * D || out_size != T * D || ws_size < WS_END) { fprintf(stderr, "kernel_launch: unexpected shapes (n_in %d, in0 %d, out %d, ws %zu < %zu)\n", n_in, n_in > 0 ? in_sizes[0] : -1, out_size, ws_size, (size_t)WS_END); ready = -1; return; }
        if (hipFuncSetAttribute((const void*)fwd_kernel, hipFuncAttributeMaxDynamicSharedMemorySize, LDS_BYTES) != hipSuccess) { fprintf(stderr, "kernel_launch: hipFuncSetAttribute failed\n"); ready = -1; return; }
        int per_cu = 0;
        if (hipOccupancyMaxActiveBlocksPerMultiprocessor(&per_cu, (const void*)fwd_kernel, NTHR, LDS_BYTES) != hipSuccess || per_cu < 1) fprintf(stderr, "kernel_launch: occupancy query says %d\n", per_cu);
        (void)hipGetLastError();
        ready = 1;
    }
    if (ready < 0) return;
    if (hipMemsetAsync((char*)d_ws + WS_CTL, 0, CTL_ZERO_BYTES, stream) != hipSuccess) return;
    Args a{};
    for (int i = 0; i < 20; ++i) a.in[i] = (const float*)d_in[i];
    a.out = (float*)d_out; a.ws = (unsigned char*)d_ws;
    a.l_lo = 0; a.l_hi = DEPTH; a.ph_lo = 0; a.ph_hi = NPHASE;
    hipLaunchKernelGGL(fwd_kernel, dim3(GRID), dim3(NTHR), LDS_BYTES, stream, a);
}
```

```cpp
#include <hip/hip_runtime.h>
#include <cstdio>
#include <cstdint>
#include <cmath>
namespace pg8 {
#define PG8_LAS __attribute__((address_space(3)))
typedef unsigned short bf16_t;
typedef short bf16x8 __attribute__((ext_vector_type(8)));
typedef float f32x4 __attribute__((ext_vector_type(4)));
typedef unsigned u32x4 __attribute__((ext_vector_type(4)));
constexpr int BM = 256, BK = 64, HALF = 128, HTB = HALF * BK * 2  , STAGE_BYTES = 8 * HTB, NXCD = 8, WGM = 8;

__host__ __device__ __forceinline__ int lds_byte(int r, int c) { const int st = (r >> 4) * 2 + (c >> 5), rr = r & 15, cc = c & 31, ob = rr * 64 + cc * 2; return st * 1024 + (ob ^ (((ob >> 9) & 1) << 5)); }
__host__ __device__ __forceinline__ void stage_rc(int b, int& R, int& C) { const int st = b / 1024, sb = b % 1024, swz = sb ^ (((sb >> 9) & 1) << 5); R = (st >> 1) * 16 + swz / 64; C = (st & 1) * 32 + (swz % 64) / 2; }
__host__ __device__ __forceinline__ int perm32(int rho) { const int n = rho >> 4, i = rho & 15; return 8 * (i >> 2) + 4 * n + (i & 3); }

struct Unit { int pm, pn; };
struct Gemm { const bf16_t* A; const bf16_t* Bt; int M, N, K; int sw, sx; const int* rowtok; };
typedef int i32x8 __attribute__((ext_vector_type(8))); typedef int i32x4 __attribute__((ext_vector_type(4)));

struct StaticOrder {
    int nM, nN, nwg, G, c;
    __host__ __device__ void init(int M, int N, int G_, int c_) { nM = M / BM; nN = N / BM; nwg = nM * nN; G = G_; c = c_; }
    __host__ __device__ bool next(int i, Unit& u) const {
        const long L = (long)i * G + c; if (L >= nwg) return false;
        int wgid = (int)L; { const int q = nwg / NXCD, r = nwg % NXCD, xcd = wgid % NXCD, off = wgid / NXCD; wgid = (xcd < r ? xcd * (q + 1) : r * (q + 1) + (xcd - r) * q) + off; }
        const int nig = WGM * nN, gid = wgid / nig, fm = gid * WGM, gsz = (nM - fm) < WGM ? (nM - fm) : WGM;
        u.pm = fm + ((wgid % nig) % gsz); u.pn = (wgid % nig) / gsz; return true;
    }
    __device__ __forceinline__ void a_ready(const Unit&) const {}
    __device__ __forceinline__ void done(const Unit&) const {}
};

__device__ __forceinline__ unsigned cvt_pk_bf16(float lo, float hi) { unsigned r; asm volatile("v_cvt_pk_bf16_f32 %0, %1, %2" : "=v"(r) : "v"(lo), "v"(hi)); return r; }
typedef float f32x2 __attribute__((ext_vector_type(2)));
struct EpiPlain {
    static constexpr bool PERM = true, AFTER_DRAIN = false;
    bf16_t* O; int ldc; unsigned smask; float sc;
    struct Pre {};
    __device__ __forceinline__ void pre_load(const Unit&, int, int, Pre&) const {}
    __device__ __forceinline__ void acc_init(f32x4 (&acc)[2][2][4][2], const Pre&) const {
#pragma unroll
        for (int a = 0; a < 2; ++a)
#pragma unroll
            for (int b = 0; b < 2; ++b)
#pragma unroll
                for (int m = 0; m < 4; ++m)
#pragma unroll
                    for (int n = 0; n < 2; ++n) acc[a][b][m][n] = (f32x4){0.f, 0.f, 0.f, 0.f}; }
    __device__ __forceinline__ void operator()(const f32x4 (&acc)[2][2][4][2], const Unit& u, int wr, int wc, int fr, int fq) const {
        const int row0 = u.pm * BM + wr * 64 + fr; const int col0 = u.pn * BM + wc * 32 + 8 * fq; const float s = ((smask >> u.pn) & 1u) ? sc : 1.f;
#pragma unroll
        for (int ai = 0; ai < 2; ++ai)
#pragma unroll
            for (int m = 0; m < 4; ++m) { bf16_t* rowp = O + (size_t)(row0 + ai * HALF + m * 16) * ldc + col0;
#pragma unroll
                for (int bj = 0; bj < 2; ++bj) { const f32x4 v0 = acc[ai][bj][m][0] * s, v1 = acc[ai][bj][m][1] * s;
                    u32x4 w; w.x = cvt_pk_bf16(v0[0], v0[1]); w.y = cvt_pk_bf16(v0[2], v0[3]); w.z = cvt_pk_bf16(v1[0], v1[1]); w.w = cvt_pk_bf16(v1[2], v1[3]);
                    *(u32x4*)(rowp + bj * HALF) = w; } }
    }
};
__device__ __forceinline__ float swiglu1(float g, float u) {
    float gm; asm("v_min_f32 %0, 0x40e00000, %1" : "=v"(gm) : "v"(g));
    const float um = __builtin_amdgcn_fmed3f(u, -7.0f, 7.0f);
    const float s = __builtin_amdgcn_rcpf(1.0f + __builtin_amdgcn_exp2f(gm * (-1.702f * 1.4426950408889634f)));
    const float gs = gm * s;
    return __builtin_fmaf(gs, um, gs);
}
__device__ __forceinline__ void swiglu4(const f32x4 g, const f32x4 u, float (&o)[4]) {
    typedef float f32x2_ __attribute__((ext_vector_type(2)));
#pragma unroll
    for (int h = 0; h < 2; ++h) { f32x2_ gm, um;
        asm("v_min_f32 %0, 0x40e00000, %1" : "=v"(gm.x) : "v"(g[2 * h])); asm("v_min_f32 %0, 0x40e00000, %1" : "=v"(gm.y) : "v"(g[2 * h + 1]));
        um.x = __builtin_amdgcn_fmed3f(u[2 * h], -7.0f, 7.0f); um.y = __builtin_amdgcn_fmed3f(u[2 * h + 1], -7.0f, 7.0f);
        const f32x2_ t = gm * (-1.702f * 1.4426950408889634f);
        f32x2_ e; e.x = __builtin_amdgcn_exp2f(t.x); e.y = __builtin_amdgcn_exp2f(t.y);
        const f32x2_ d = e + 1.0f;
        f32x2_ s; s.x = __builtin_amdgcn_rcpf(d.x); s.y = __builtin_amdgcn_rcpf(d.y);
        const f32x2_ gs = gm * s; const f32x2_ r = gs * um + gs;
        o[2 * h] = r.x; o[2 * h + 1] = r.y; }
}
__device__ __forceinline__ unsigned pk4_fp8e(float a, float b, float c, float d) { int w = 0; w = __builtin_amdgcn_cvt_pk_fp8_f32(a, b, w, false); w = __builtin_amdgcn_cvt_pk_fp8_f32(c, d, w, true); return (unsigned)w; }
struct EpiSwiglu {
    static constexpr bool PERM = true, AFTER_DRAIN = false;
    unsigned char* hid; const float* bg; const float* bu;
    struct Pre { f32x4 g0, g1, u0, u1; };
    __device__ __forceinline__ void pre_load(const Unit& u, int wc, int fq, Pre& p) const { const int e = u.pn >> 3, col0 = (u.pn & 7) * 128 + wc * 32 + 8 * fq;
        p.g0 = *(const f32x4*)(bg + e * 1024 + col0); p.g1 = *(const f32x4*)(bg + e * 1024 + col0 + 4); p.u0 = *(const f32x4*)(bu + e * 1024 + col0); p.u1 = *(const f32x4*)(bu + e * 1024 + col0 + 4); }
    __device__ __forceinline__ void acc_init(f32x4 (&acc)[2][2][4][2], const Pre& p) const {
#pragma unroll
        for (int a = 0; a < 2; ++a)
#pragma unroll
            for (int m = 0; m < 4; ++m) { acc[a][0][m][0] = p.g0; acc[a][0][m][1] = p.g1; acc[a][1][m][0] = p.u0; acc[a][1][m][1] = p.u1; } }
    __device__ __forceinline__ void operator()(const f32x4 (&acc)[2][2][4][2], const Unit& u, int wr, int wc, int fr, int fq) const {
        const int pn = u.pn & 7;
        const int row0 = u.pm * BM + wr * 64 + fr; const int col0 = pn * 128 + wc * 32 + 8 * fq;
#pragma unroll
        for (int ai = 0; ai < 2; ++ai)
#pragma unroll
            for (int m = 0; m < 4; ++m) { unsigned char* rowp = hid + (size_t)(row0 + ai * HALF + m * 16) * 1024 + col0;
                const f32x4 ga = acc[ai][0][m][0], gb = acc[ai][0][m][1], ua = acc[ai][1][m][0], ub = acc[ai][1][m][1];
                typedef unsigned u32x2 __attribute__((ext_vector_type(2))); u32x2 w;
                float oa[4], ob[4]; swiglu4(ga, ua, oa); swiglu4(gb, ub, ob);
                w.x = pk4_fp8e(oa[0], oa[1], oa[2], oa[3]); w.y = pk4_fp8e(ob[0], ob[1], ob[2], ob[3]);
                *(u32x2*)rowp = w; }
    }
};
struct EpiDown {
    static constexpr bool PERM = true, AFTER_DRAIN = false;
    unsigned char* y; const float* bd;
    struct Pre { f32x4 b[2][2]; };
    __device__ __forceinline__ void pre_load(const Unit& u, int wc, int fq, Pre& p) const { const int e = u.pn >> 2, col0 = (u.pn & 3) * BM + wc * 32 + 8 * fq;
#pragma unroll
        for (int bj = 0; bj < 2; ++bj)
#pragma unroll
            for (int n = 0; n < 2; ++n) p.b[bj][n] = *(const f32x4*)(bd + e * 1024 + col0 + bj * HALF + 4 * n); }
    __device__ __forceinline__ void acc_init(f32x4 (&acc)[2][2][4][2], const Pre& p) const {
#pragma unroll
        for (int a = 0; a < 2; ++a)
#pragma unroll
            for (int bj = 0; bj < 2; ++bj)
#pragma unroll
                for (int m = 0; m < 4; ++m) { acc[a][bj][m][0] = p.b[bj][0] * 16.f; acc[a][bj][m][1] = p.b[bj][1] * 16.f; } }
    __device__ __forceinline__ void operator()(const f32x4 (&acc)[2][2][4][2], const Unit& u, int wr, int wc, int fr, int fq) const {
        const int pn = u.pn & 3;
        const int row0 = u.pm * BM + wr * 64 + fr; const int col0 = pn * BM + wc * 32 + 8 * fq;
#pragma unroll
        for (int ai = 0; ai < 2; ++ai)
#pragma unroll
            for (int m = 0; m < 4; ++m) { unsigned char* rowp = y + (size_t)(row0 + ai * HALF + m * 16) * 1024 + col0;
#pragma unroll
                for (int bj = 0; bj < 2; ++bj) { const f32x4 v0 = acc[ai][bj][m][0], v1 = acc[ai][bj][m][1];
                    typedef unsigned u32x2 __attribute__((ext_vector_type(2))); u32x2 w; w.x = pk4_fp8e(v0[0], v0[1], v0[2], v0[3]); w.y = pk4_fp8e(v1[0], v1[1], v1[2], v1[3]);
                    *(u32x2*)(rowp + bj * HALF) = w; } }
    }
};
struct MoeOrder {
    const PG8_LAS int* tab; int npn, G, c, nunits; bool rev;
    __device__ __forceinline__ bool next(int i, Unit& u) const {
        const int tpx = 32 / npn, s = c >> 3, tile = (i * 8 + (c & 7)) * tpx + s / npn, pn = s % npn;
        if ((i * 8) * tpx >= nunits / npn) return false;
        if (tile >= nunits / npn) { u.pm = 0; u.pn = 0; return false; }
        const int tl_ = rev ? nunits / npn - 1 - tile : tile;
        int e = 0;
#pragma unroll
        for (int k = 1; k < 32; ++k) e += (tab[k] <= tl_) ? 1 : 0;
        u.pm = tl_; u.pn = __builtin_amdgcn_readfirstlane(e) * npn + pn; return true;
    }
    __device__ __forceinline__ void a_ready(const Unit&) const {}
    __device__ __forceinline__ void done(const Unit&) const {}
};
template <class Epi, class Sched, bool ALIGN_EPI = false, bool SP2 = false, bool F8 = false, bool GATHER = false>
__device__ __forceinline__ void gemm_phase(PG8_LAS unsigned char* lds, const Gemm g, const Sched& S, const Epi& E) {
    int tid_ = threadIdx.x; asm volatile("" : "+v"(tid_));
    const int tid = tid_, wid = __builtin_amdgcn_readfirstlane(tid >> 6), lane = tid & 63, wr = wid >> 2, wc = wid & 3, fr = lane & 15, fq = lane >> 4;
    const int K = g.K, nt = K / BK;
    unsigned voffA, voffB;
    { int R, C; stage_rc(tid * 16, R, C); const int Rb = Epi::PERM ? ((R & ~31) + perm32(R & 31)) : R; voffA = (unsigned)(R * K + C) * 2u; voffB = (unsigned)(Rb * K + C) * 2u; }
    const unsigned qstep = 64u * (unsigned)K * 2u;
    const unsigned kstep = (unsigned)(BK * 2);
    const unsigned hstep = (unsigned)HALF * (unsigned)K * 2u;
    const unsigned tstep = 2u * hstep;
    const __amdgpu_buffer_rsrc_t rA = __builtin_amdgcn_make_buffer_rsrc((void*)g.A, 0, 0x7FFFFFFF, 0x00020000), rB = __builtin_amdgcn_make_buffer_rsrc((void*)g.Bt, 0, 0x7FFFFFFF, 0x00020000);
    const unsigned ldsw = (unsigned)wid * 1024u;
    const int aoff = lds_byte(wr * 64 + fr, fq * 8), boff = lds_byte(wc * 32 + fr, fq * 8);
#define PG8_SA(b, h) (((b) * 2 + (h)) * HTB)
#define PG8_SB(b, h) ((4 + (b) * 2 + (h)) * HTB)
#define PG8_STG(bufoff, rsrc, soff, voff) do { _Pragma("unroll") for (int _i = 0; _i < 2; ++_i) \
        __builtin_amdgcn_raw_ptr_buffer_load_lds((rsrc), (PG8_LAS void*)(lds + (bufoff) + ldsw + _i * 8192), 16, (int)(voff), (int)((soff) + (unsigned)_i * qstep), 0, 0); } while (0)
#define PG8_STGA(bufoff, soff) PG8_STG(bufoff, rA, soff, voffA)
#define PG8_STGB(bufoff, soff) PG8_STG(bufoff, rB, soff, voffB)
#define PG8_STGAG(bufoff, h, soff_plain, kb) do { if constexpr (GATHER) { _Pragma("unroll") for (int _i = 0; _i < 2; ++_i) \
        __builtin_amdgcn_raw_ptr_buffer_load_lds(rA, (PG8_LAS void*)(lds + (bufoff) + ldsw + _i * 8192), 16, (int)gc[h][_i], (int)(kb), 0, 0); } else PG8_STGA(bufoff, soff_plain); } while (0)
#define PG8_GLOAD(gv, pm_) do { int t3_ = threadIdx.x; asm volatile("" : "+v"(t3_)); int R_, C_; stage_rc(t3_ * 16, R_, C_); const int* rt_ = g.rowtok + (pm_) * BM + R_; \
        _Pragma("unroll") for (int h_ = 0; h_ < 2; ++h_) _Pragma("unroll") for (int i_ = 0; i_ < 2; ++i_) gv[h_][i_] = (unsigned)rt_[h_ * HALF + i_ * 64] * (unsigned)(K * 2) + (unsigned)(C_ * 2); } while (0)
#define PG8_LDA(dst, b, h) do { _Pragma("unroll") for (int m = 0; m < 4; ++m) { if constexpr (F8) { const i32x4 lo_ = *(const PG8_LAS i32x4*)(lds + PG8_SA(b, h) + aoff + m * 2048), hi_ = *(const PG8_LAS i32x4*)(lds + PG8_SA(b, h) + aoff + m * 2048 + 1024); \
            dst##_8[m] = __builtin_shufflevector(lo_, hi_, 0, 1, 2, 3, 4, 5, 6, 7); } else { _Pragma("unroll") for (int k = 0; k < 2; ++k) dst[m][k] = *(const PG8_LAS bf16x8*)(lds + PG8_SA(b, h) + aoff + m * 2048 + k * 1024); } } } while (0)
#define PG8_LDB(dst, b, h) do { _Pragma("unroll") for (int n = 0; n < 2; ++n) { if constexpr (F8) { const i32x4 lo_ = *(const PG8_LAS i32x4*)(lds + PG8_SB(b, h) + boff + n * 2048), hi_ = *(const PG8_LAS i32x4*)(lds + PG8_SB(b, h) + boff + n * 2048 + 1024); \
            dst##_8[n] = __builtin_shufflevector(lo_, hi_, 0, 1, 2, 3, 4, 5, 6, 7); } else { _Pragma("unroll") for (int k = 0; k < 2; ++k) dst[n][k] = *(const PG8_LAS bf16x8*)(lds + PG8_SB(b, h) + boff + n * 2048 + k * 1024); } } } while (0)
#define PG8_MMA(ai, bj, At, Bt) do { __builtin_amdgcn_s_setprio(1); _Pragma("unroll") for (int m = 0; m < 4; ++m) _Pragma("unroll") for (int n = 0; n < 2; ++n) { \
        if constexpr (F8) acc[ai][bj][m][n] = __builtin_amdgcn_mfma_scale_f32_16x16x128_f8f6f4(Bt##_8[n], At##_8[m], acc[ai][bj][m][n], 0, 0, 0, g.sw, 0, g.sx); \
        else { _Pragma("unroll") for (int k = 0; k < 2; ++k) acc[ai][bj][m][n] = __builtin_amdgcn_mfma_f32_16x16x32_bf16(Bt[n][k], At[m][k], acc[ai][bj][m][n], 0, 0, 0); } } \
        __builtin_amdgcn_s_setprio(0); } while (0)
#define PG8_WAIT_V(n) asm volatile("s_waitcnt vmcnt(" #n ")" ::: "memory")
#define PG8_WAIT_L(n) asm volatile("s_waitcnt lgkmcnt(" #n ")" ::: "memory")
#define PG8_BAR __builtin_amdgcn_s_barrier()
#define PG8_SCHED __builtin_amdgcn_sched_barrier(0)
    Unit cur, nxt; int ui = 0;
    if (!S.next(0, cur)) return;
    f32x4 acc[2][2][4][2];
    typename Epi::Pre pre; E.pre_load(cur, wc, fq, pre); E.acc_init(acc, pre);
    bf16x8 At[4][2], B0[2][2], B1[2][2]; i32x8 At_8[4], B0_8[2], B1_8[2];
    unsigned cA = (unsigned)cur.pm * tstep, cB = (unsigned)cur.pn * tstep;
    S.a_ready(cur);
    unsigned gc[2][2]; PG8_LAS unsigned* gl_ = (PG8_LAS unsigned*)(lds + 8 * HTB + tid * 16);
    typedef unsigned u32x2_ __attribute__((ext_vector_type(2)));
    if constexpr (GATHER) { unsigned g1_[2][2]; PG8_GLOAD(gc, cur.pm); Unit n1_; n1_.pm = 0; n1_.pn = 0; const bool h1_ = S.next(1, n1_); PG8_GLOAD(g1_, h1_ ? n1_.pm : cur.pm);
        *(PG8_LAS u32x2_*)gl_ = (u32x2_){g1_[0][0], g1_[0][1]}; *(PG8_LAS u32x2_*)(gl_ + 2) = (u32x2_){g1_[1][0], g1_[1][1]};
        asm volatile("" :: "v"(gc[0][0]), "v"(gc[0][1]), "v"(gc[1][0]), "v"(gc[1][1])); }
    if constexpr (SP2) {
        PG8_STGB(PG8_SB(0, 0), cB); PG8_STGB(PG8_SB(0, 1), cB + hstep); PG8_STGAG(PG8_SA(0, 0), 0, cA, 0u); PG8_STGAG(PG8_SA(0, 1), 1, cA + hstep, 0u);
        if (wr == 1) PG8_BAR;
        PG8_WAIT_V(2); PG8_BAR;
        PG8_STGB(PG8_SB(1, 0), cB + kstep); PG8_STGAG(PG8_SA(1, 0), 0, cA + kstep, kstep); PG8_STGB(PG8_SB(1, 1), cB + hstep + kstep);
        PG8_WAIT_V(6); PG8_BAR;
    } else {
        PG8_STGB(PG8_SB(0, 0), cB); PG8_STGA(PG8_SA(0, 0), cA); PG8_STGB(PG8_SB(0, 1), cB + hstep); PG8_STGA(PG8_SA(0, 1), cA + hstep);
        if (wr == 1) PG8_BAR;
        PG8_WAIT_V(4); PG8_BAR;
        PG8_STGB(PG8_SB(1, 0), cB + kstep); PG8_STGA(PG8_SA(1, 0), cA + kstep); PG8_STGB(PG8_SB(1, 1), cB + hstep + kstep);
        PG8_WAIT_V(6); PG8_BAR;
    }
    for (;;) {
        const bool has_next = S.next(ui + 1, nxt);
        const unsigned nA = has_next ? (unsigned)nxt.pm * tstep : cA, nB = has_next ? (unsigned)nxt.pn * tstep : cB;
#pragma unroll 1
        for (int t = 0; t < nt; t += 2) {
            const bool last = (t == nt - 2);
            const unsigned a1 = cA + (unsigned)(t + 1) * kstep;
            const unsigned a2 = last ? nA : cA + (unsigned)(t + 2) * kstep, b2 = last ? nB : cB + (unsigned)(t + 2) * kstep;
            const unsigned a3 = a2 + kstep, b3 = b2 + kstep;
            if (last && has_next) S.a_ready(nxt);
            const unsigned k1_ = (unsigned)(t + 1) * kstep, k2_ = last ? 0u : (unsigned)(t + 2) * kstep;
            if constexpr (GATHER) { if (last) { const u32x2_ w0_ = *(const PG8_LAS u32x2_*)gl_; gc[0][0] = w0_.x; gc[0][1] = w0_.y; } }
            if constexpr (SP2) {
            PG8_LDB(B0, 0, 0); PG8_LDB(B1, 0, 1); PG8_SCHED; PG8_LDA(At, 0, 0); PG8_STGAG(PG8_SA(1, 1), 1, a1 + hstep, k1_);
            if constexpr (GATHER) { if (last) { const u32x2_ w1_ = *(const PG8_LAS u32x2_*)(gl_ + 2); gc[1][0] = w1_.x; gc[1][1] = w1_.y; } }
            PG8_WAIT_V(8); PG8_WAIT_L(0); PG8_BAR; PG8_MMA(0, 0, At, B0); PG8_MMA(0, 1, At, B1); PG8_BAR; PG8_SCHED;
            PG8_LDA(At, 0, 1); PG8_STGB(PG8_SB(0, 0), b2); PG8_STGB(PG8_SB(0, 1), b2 + hstep); PG8_STGAG(PG8_SA(0, 0), 0, a2, k2_);
            PG8_WAIT_V(8); PG8_WAIT_L(0); PG8_BAR; PG8_MMA(1, 0, At, B0); PG8_MMA(1, 1, At, B1); PG8_BAR; PG8_SCHED;
            PG8_LDB(B0, 1, 0); PG8_LDB(B1, 1, 1); PG8_SCHED; PG8_LDA(At, 1, 0); PG8_STGAG(PG8_SA(0, 1), 1, a2 + hstep, k2_);
            PG8_WAIT_V(8); PG8_WAIT_L(0); PG8_BAR; PG8_MMA(0, 0, At, B0); PG8_MMA(0, 1, At, B1); PG8_BAR; PG8_SCHED;
            PG8_LDA(At, 1, 1); PG8_STGB(PG8_SB(1, 0), b3); PG8_STGB(PG8_SB(1, 1), b3 + hstep); PG8_STGAG(PG8_SA(1, 0), 0, a3, k2_ + kstep);
            PG8_WAIT_V(8); PG8_WAIT_L(0); PG8_BAR; PG8_MMA(1, 0, At, B0); PG8_MMA(1, 1, At, B1); PG8_BAR; PG8_SCHED;
            } else {
            PG8_LDB(B0, 0, 0); PG8_SCHED; PG8_LDA(At, 0, 0); PG8_STGA(PG8_SA(1, 1), a1 + hstep);
            PG8_WAIT_L(8); PG8_BAR; PG8_WAIT_L(0); PG8_MMA(0, 0, At, B0); PG8_BAR; PG8_SCHED;
            PG8_LDB(B1, 0, 1); PG8_STGB(PG8_SB(0, 0), b2);
            PG8_BAR; PG8_WAIT_L(0); PG8_MMA(0, 1, At, B1); PG8_BAR;
            PG8_LDA(At, 0, 1); PG8_STGA(PG8_SA(0, 0), a2);
            PG8_BAR; PG8_WAIT_L(0); PG8_MMA(1, 0, At, B0); PG8_BAR; PG8_SCHED;
            PG8_STGB(PG8_SB(0, 1), b2 + hstep);
            PG8_WAIT_V(6); PG8_BAR; PG8_MMA(1, 1, At, B1); PG8_BAR;
            PG8_LDB(B0, 1, 0); PG8_SCHED; PG8_LDA(At, 1, 0); PG8_STGA(PG8_SA(0, 1), a2 + hstep);
            PG8_WAIT_L(8); PG8_BAR; PG8_WAIT_L(0); PG8_MMA(0, 0, At, B0); PG8_BAR; PG8_SCHED;
            PG8_LDB(B1, 1, 1); PG8_STGB(PG8_SB(1, 0), b3);
            PG8_BAR; PG8_WAIT_L(0); PG8_MMA(0, 1, At, B1); PG8_BAR;
            PG8_LDA(At, 1, 1); PG8_STGA(PG8_SA(1, 0), a3);
            PG8_BAR; PG8_WAIT_L(0); PG8_MMA(1, 0, At, B0); PG8_BAR; PG8_SCHED;
            PG8_STGB(PG8_SB(1, 1), b3 + hstep);
            PG8_WAIT_V(6); PG8_BAR; PG8_MMA(1, 1, At, B1); PG8_BAR;
            }
        }
        if constexpr (ALIGN_EPI) { if (wr == 0) PG8_BAR; }
        unsigned gnn[2][2];
        if constexpr (GATHER) { Unit n2_; n2_.pm = 0; n2_.pn = 0; const bool h2_ = S.next(ui + 2, n2_); const int pm2_ = h2_ ? n2_.pm : (has_next ? nxt.pm : cur.pm); PG8_GLOAD(gnn, pm2_); }
        if constexpr (!Epi::AFTER_DRAIN) { int t2_ = threadIdx.x; asm volatile("" : "+v"(t2_)); { const Unit pu_ = has_next ? nxt : cur; E.pre_load(pu_, wc, (t2_ & 63) >> 4, pre); }     E(acc, cur, wr, wc, t2_ & 15, (t2_ & 63) >> 4); S.done(cur); }
        if (!has_next) break;
        E.acc_init(acc, pre);
        if constexpr (GATHER) { *(PG8_LAS u32x2_*)gl_ = (u32x2_){gnn[0][0], gnn[0][1]}; *(PG8_LAS u32x2_*)(gl_ + 2) = (u32x2_){gnn[1][0], gnn[1][1]}; }
        cur = nxt; cA = nA; cB = nB; ++ui;
        if constexpr (ALIGN_EPI) { if (wr == 1) PG8_BAR; }
    }
    PG8_WAIT_V(0);
    if constexpr (!ALIGN_EPI) { if (wr == 0) PG8_BAR; }
    PG8_BAR;
    if constexpr (Epi::AFTER_DRAIN) { E.fused(acc, cur, wr, wc, fr, fq, lds, wid, lane); S.done(cur); }
#undef PG8_SA
#undef PG8_SB
#undef PG8_STG
#undef PG8_STGA
#undef PG8_STGB
#undef PG8_STGAG
#undef PG8_GLOAD
#undef PG8_LDA
#undef PG8_LDB
#undef PG8_MMA
#undef PG8_WAIT_V
#undef PG8_WAIT_L
#undef PG8_BAR
#undef PG8_SCHED
}
}

constexpr int NWAVES = 8, NTHR = 512, GRID = 256;
constexpr int NBATCH = 2, SEQ = 16384, T = NBATCH * SEQ, D = 1024, DEPTH = 4;
constexpr int MIXW = 768, NC_H = 3328, NC_M = 2560;
constexpr int HG_H = 6;
constexpr int HSEG = 256, HNSEG = SEQ / HSEG;
constexpr int MB_H = 12, MB_NB = 64;
constexpr int NE = 32;
constexpr float DN_ALPHA = 1.6817928305074290f;
constexpr int MOE_MAXROWS = T * 4 + NE * 256;
#ifndef ONE_LAUNCH
#define ONE_LAUNCH 1
#endif
constexpr int NPHASE = 13;

constexpr size_t MiB = 1u << 20;
constexpr size_t WS_CTL = 0, CTL_ZERO_BYTES = 1 * MiB;
constexpr size_t WS_WIN = 1 * MiB, WS_WKV = 9 * MiB, WS_WO = 10 * MiB, WS_WGU = 12 * MiB, WS_WD = 140 * MiB;
constexpr size_t WS_XBF = 204 * MiB, WS_WKV4 = 268 * MiB  , WS_KV4 = 272 * MiB  , WS_WRS = 280 * MiB  , WS_MEMBF = 524 * MiB;
constexpr size_t WS_H = 526 * MiB, WS_MIX = 734 * MiB, WS_Y = 798 * MiB, WS_SLOC = 862 * MiB, WS_DSEG = 910 * MiB, WS_KMEAN = 911 * MiB;
constexpr size_t WS_SELINFO = 912 * MiB, WS_TOK = 914 * MiB, WS_R1 = 918 * MiB;
constexpr size_t WS_LIST = WS_R1, WS_PML = WS_R1 + 96 * MiB, WS_PO = WS_R1 + 108 * MiB;
constexpr size_t WS_XS = WS_R1, WS_HID = WS_R1 + 272 * MiB;
constexpr size_t WS_END = WS_R1 + 544 * MiB;
static_assert((size_t)MOE_MAXROWS * 1024 * 2 <= 272 * MiB, "moe rows");
static_assert((size_t)T * MB_H * 4 * 64 * 4 <= 384 * MiB && (size_t)24 * 64 * 16384 * 4 <= 96 * MiB, "moba bufs");
constexpr size_t TOK_E = 0, TOK_LR = 512 * 1024, TOK_W = 1024 * 1024, TOK_ROW = 1536 * 1024, TOK_BLKCNT = 2048 * 1024, TOK_TAB = 2048 * 1024 + 65536;
constexpr int CW_BAR = 4096, CW_GCOUNT = 8192;

constexpr int RING_BYTES = 131072, LDS_BYTES = 147456, MISC_OFF = LDS_BYTES - 1024;

#define GAS __attribute__((address_space(1)))
#define LAS __attribute__((address_space(3)))
typedef unsigned short bf16;
typedef unsigned v4u __attribute__((ext_vector_type(4)));
typedef unsigned v2u __attribute__((ext_vector_type(2)));
typedef float f32x4 __attribute__((ext_vector_type(4)));
typedef float f32x2 __attribute__((ext_vector_type(2)));
typedef short s16x8 __attribute__((ext_vector_type(8)));
typedef float f32x16 __attribute__((ext_vector_type(16)));
typedef float f32x2_t __attribute__((ext_vector_type(2))); typedef __bf16 bf16x2_t __attribute__((ext_vector_type(2)));
__device__ __forceinline__ unsigned cvtpk(float lo, float hi) { f32x2_t v = {lo, hi}; bf16x2_t b = __builtin_convertvector(v, bf16x2_t); return __builtin_bit_cast(unsigned, b); }
#define LDS_WAIT() asm volatile("s_waitcnt lgkmcnt(0)" ::: "memory")
__device__ __forceinline__ unsigned f2bf(float f) { unsigned u = __builtin_bit_cast(unsigned, f); return (u + 0x7fffu + ((u >> 16) & 1u)) >> 16; }
__device__ __forceinline__ unsigned pk2(float lo, float hi) { return f2bf(lo) | (f2bf(hi) << 16); }
__device__ __forceinline__ float bflo(unsigned w) { return __builtin_bit_cast(float, w << 16); }
__device__ __forceinline__ float bfhi(unsigned w) { return __builtin_bit_cast(float, w & 0xffff0000u); }
__device__ __forceinline__ float bf2f(bf16 h) { return __builtin_bit_cast(float, (unsigned)h << 16); }
__device__ __forceinline__ float sigmoidf_(float z) { return __builtin_amdgcn_rcpf(1.0f + __builtin_amdgcn_exp2f(-1.4426950408889634f * z)); }
template <int X> __device__ __forceinline__ float xorf(float v) { return __builtin_bit_cast(float, __builtin_amdgcn_ds_swizzle(__builtin_bit_cast(int, v), (X << 10) | 0x1F)); }
template <int X> __device__ __forceinline__ int xori(int v) { return __builtin_amdgcn_ds_swizzle(v, (X << 10) | 0x1F); }
__device__ __forceinline__ float wave_sum(float v) {
    v += xorf<1>(v); v += xorf<2>(v); v += xorf<4>(v); v += xorf<8>(v); v += xorf<16>(v);
    return __builtin_bit_cast(float, __builtin_amdgcn_readlane(__builtin_bit_cast(int, v), 0)) + __builtin_bit_cast(float, __builtin_amdgcn_readlane(__builtin_bit_cast(int, v), 32));
}
__device__ __forceinline__ float wave_max(float v) {
    v = fmaxf(v, xorf<1>(v)); v = fmaxf(v, xorf<2>(v)); v = fmaxf(v, xorf<4>(v)); v = fmaxf(v, xorf<8>(v)); v = fmaxf(v, xorf<16>(v));
    return fmaxf(__builtin_bit_cast(float, __builtin_amdgcn_readlane(__builtin_bit_cast(int, v), 0)), __builtin_bit_cast(float, __builtin_amdgcn_readlane(__builtin_bit_cast(int, v), 32)));
}
__device__ __forceinline__ float xor32f(float v, int lane) { return __builtin_bit_cast(float, __builtin_amdgcn_ds_bpermute((lane ^ 32) << 2, __builtin_bit_cast(int, v))); }
#define XB_TMO      128
#define XB_XCNT(j)  (256  + 64 * (j))
#define XB_XSUB(j)  (1280 + 64 * (j))
#define XB_XGEN(j)  (2304 + 64 * (j))
#define XB_TOP      3328
#define XB_TOPGEN   3392
#define XCD_BAR_WORDS 3456
#define XB_SPIN_CAP (1u << 18)

__device__ __forceinline__ unsigned xb_ld(unsigned* p)              { return __hip_atomic_load(p, __ATOMIC_RELAXED, __HIP_MEMORY_SCOPE_AGENT); }
__device__ __forceinline__ unsigned xb_add(unsigned* p, unsigned v) { return __hip_atomic_fetch_add(p, v, __ATOMIC_RELAXED, __HIP_MEMORY_SCOPE_AGENT); }
__device__ __forceinline__ unsigned xb_xcc_id() { return (unsigned)__builtin_amdgcn_s_getreg((3 << 11) | 20) & 0xFu; }
#define XB_SPIN(cond, bar) do { unsigned _sp = 0; while (cond) { __builtin_amdgcn_s_sleep(1); \
    if ((++_sp & 255u) == 0u) { if (xb_ld(&(bar)[XB_TMO])) break; if (_sp > XB_SPIN_CAP) { atomicAdd(&(bar)[XB_TMO], 1u); break; } } } } while (0)

struct XcdBarrier {
    unsigned* bar; unsigned x;
    volatile LAS unsigned* st;
};

__device__ __forceinline__ XcdBarrier xcd_barrier_post(unsigned* bar, volatile LAS unsigned* st) {
    XcdBarrier b; b.bar = bar; b.x = xb_xcc_id(); b.st = st;
    if (threadIdx.x == 0) (void)xb_add(&bar[XB_XCNT(b.x)], 1u);
    return b;
}
__device__ __forceinline__ void xcd_barrier_complete(unsigned* bar, unsigned x, unsigned& nloc, unsigned& nx) {
    const unsigned G = gridDim.x * gridDim.y * gridDim.z;
    unsigned sum, cnt, mine, sp = 0u;
    for (;;) {
        sum = 0u; cnt = 0u; mine = 0u;
#pragma unroll
        for (unsigned j = 0; j < 16; ++j) { const unsigned c = xb_ld(&bar[XB_XCNT(j)]); sum += c; cnt += (c > 0u) ? 1u : 0u; mine = (j == x) ? c : mine; }
        if (sum == G) break;
        __builtin_amdgcn_s_sleep(1);
        if ((++sp & 255u) == 0u) { if (xb_ld(&bar[XB_TMO])) break; if (sp > XB_SPIN_CAP) { atomicAdd(&bar[XB_TMO], 1u); break; } }
    }
    nloc = mine > 0u ? mine : 1u; nx = cnt > 0u ? cnt : 1u;
}

__device__ __forceinline__ void xcd_barrier(const XcdBarrier& b) {
    asm volatile("s_waitcnt vmcnt(0)" ::: "memory");
    __syncthreads();
    if (threadIdx.x == 0) {
        unsigned* bar = b.bar;
        __builtin_amdgcn_s_waitcnt(0);
        unsigned nloc = b.st[0], nx = b.st[1];
        if (nloc == 0u) { xcd_barrier_complete(bar, b.x, nloc, nx); b.st[0] = nloc; b.st[1] = nx; }
        const unsigned old = xb_add(&bar[XB_XSUB(b.x)], 1u);
        const unsigned gen = old / nloc;
        if (old + 1u == (gen + 1u) * nloc) {
            __builtin_amdgcn_fence(__ATOMIC_RELEASE, "agent");
            asm volatile("s_waitcnt vmcnt(0)" ::: "memory");
            const unsigned og = xb_add(&bar[XB_TOP], 1u);
            const unsigned tg = og / nx;
            if (og + 1u == (tg + 1u) * nx) xb_add(&bar[XB_TOPGEN], 1u);
            else XB_SPIN(xb_ld(&bar[XB_TOPGEN]) == tg, bar);
            __builtin_amdgcn_fence(__ATOMIC_ACQUIRE, "agent");
            xb_add(&bar[XB_XGEN(b.x)], 1u);
            asm volatile("s_waitcnt vmcnt(0)" ::: "memory");
        } else {
            XB_SPIN(xb_ld(&bar[XB_XGEN(b.x)]) == gen, bar);
            __builtin_amdgcn_fence(__ATOMIC_ACQUIRE, "agent");
            asm volatile("s_waitcnt vmcnt(0)" ::: "memory");
        }
    }
    __syncthreads();
}
__device__ __forceinline__ void cvt_rows_bf16(const float* src, bf16* dst, size_t n8, size_t gtid, size_t gthreads) {
    for (size_t i = gtid; i < n8; i += gthreads) { const f32x4 a = ((const f32x4*)src)[2 * i], b = ((const f32x4*)src)[2 * i + 1];
        v4u o; o.x = pk2(a.x, a.y); o.y = pk2(a.z, a.w); o.z = pk2(b.x, b.y); o.w = pk2(b.z, b.w); ((v4u*)dst)[i] = o; }
}
__device__ __forceinline__ void transpose_item(const float* W, int N, bf16* WT, int dst_row0, LAS float* scr, int k0, int n0, int lane) {
#pragma unroll 8
    for (int i = 0; i < 32; ++i) { const int kk = 2 * i + (lane >> 5); scr[kk * 33 + (lane & 31)] = W[(size_t)(k0 + kk) * N + n0 + (lane & 31)]; }
    LDS_WAIT(); asm volatile("" ::: "memory");
    const int c = lane & 7;
#pragma unroll
    for (int j = 0; j < 4; ++j) { const int n = (lane >> 3) + 8 * j; const LAS float* s = scr + (8 * c) * 33 + n;
        v4u o; o.x = pk2(s[0 * 33], s[1 * 33]); o.y = pk2(s[2 * 33], s[3 * 33]); o.z = pk2(s[4 * 33], s[5 * 33]); o.w = pk2(s[6 * 33], s[7 * 33]);
        *(v4u*)(WT + (size_t)(dst_row0 + n) * 1024 + k0 + 8 * c) = o; }
    LDS_WAIT(); asm volatile("" ::: "memory");
}
__device__ __forceinline__ unsigned pk4_fp8(float a, float b, float c, float d) { int w = 0; w = __builtin_amdgcn_cvt_pk_fp8_f32(a, b, w, false); w = __builtin_amdgcn_cvt_pk_fp8_f32(c, d, w, true); return (unsigned)w; }
__device__ __forceinline__ void transpose_item_f8(const float* W, int N, unsigned char* WT8, int dst_row0, LAS float* scr, int k0, int n0, int lane, float wscale) {
#pragma unroll 8
    for (int i = 0; i < 32; ++i) { const int kk = 2 * i + (lane >> 5); scr[kk * 33 + (lane & 31)] = W[(size_t)(k0 + kk) * N + n0 + (lane & 31)]; }
    LDS_WAIT(); asm volatile("" ::: "memory");
    const int c = lane & 7;
#pragma unroll
    for (int j = 0; j < 4; ++j) { const int n = (lane >> 3) + 8 * j; const LAS float* s = scr + (8 * c) * 33 + n;
        v2u o; o.x = pk4_fp8(s[0 * 33] * wscale, s[1 * 33] * wscale, s[2 * 33] * wscale, s[3 * 33] * wscale); o.y = pk4_fp8(s[4 * 33] * wscale, s[5 * 33] * wscale, s[6 * 33] * wscale, s[7 * 33] * wscale);
        *(v2u*)(WT8 + (size_t)(dst_row0 + n) * 1024 + k0 + 8 * c) = o; }
    LDS_WAIT(); asm volatile("" ::: "memory");
}
__device__ __forceinline__ void phase_weights(LAS float* scr, int gw, int ngw, int lane, const float* win_src, int NC, const float* wkv_src, int nkv, const float* wo_src,
                                              const float* wg_src, const float* wu_src, const float* wd_src, bf16* win_t, bf16* wkv_t, bf16* wo_t, bf16* wgu_t, bf16* wd_t, int mode) {
    const int nbw = NC / 32, nWin = nbw * 16, NPROJ = nWin + 256 * nkv + 512, NIT = mode == 1 ? NPROJ : NPROJ + NE * 1536;
    for (int it = (mode == 2 ? NPROJ : 0) + gw; it < NIT; it += ngw) {
        int r = it;
        if (r < nWin) { const int kb = r / nbw, nb = r - kb * nbw; transpose_item(win_src, NC, win_t, 32 * nb, scr, 64 * kb, 32 * nb, lane); continue; } r -= nWin;
        if (r < 256 * nkv) { const int lay = r >> 8, rr = r & 255, kb = rr >> 4, nb = rr & 15; transpose_item(wkv_src + (size_t)lay * D * 512, 512, wkv_t + (size_t)lay * 512 * 1024, 32 * nb, scr, 64 * kb, 32 * nb, lane); continue; } r -= 256 * nkv;
        if (r < 512) { const int kb = r >> 5, nb = r & 31; transpose_item(wo_src, 1024, wo_t, 32 * nb, scr, 64 * kb, 32 * nb, lane); continue; } r -= 512;
        const int e = r / 1536, q = r - e * 1536, which = q >> 9, rr = q & 511, kb = rr >> 5, nb = rr & 31, n0 = 32 * nb;
        const size_t eoff = (size_t)e * 1024 * 1024;
        if (which == 0) transpose_item_f8(wg_src + eoff, 1024, (unsigned char*)wgu_t + 2 * eoff, (n0 >> 7) * 256 + (n0 & 127), scr, 64 * kb, n0, lane, 32.f);
        else if (which == 1) transpose_item_f8(wu_src + eoff, 1024, (unsigned char*)wgu_t + 2 * eoff, (n0 >> 7) * 256 + 128 + (n0 & 127), scr, 64 * kb, n0, lane, 32.f);
        else transpose_item_f8(wd_src + eoff, 1024, (unsigned char*)wd_t + eoff, n0, scr, 64 * kb, n0, lane, 64.f);
    }
}

template <bool OUT>
__device__ __forceinline__ void hgrn_seg(LAS unsigned char* lds, const bf16* h, const float* lbl, int j, const float* normg, float* Sloc, float* Dseg, bf16* mix, int unit, int tid, int wave, int lane) {
    const int seg = unit & (HNSEG - 1), bh = unit >> 6, hh = bh % HG_H, b = bh / HG_H;
    const int v = tid & 127, dg = tid >> 7;
    LAS float* fgs = (LAS float*)lds; LAS float* vs = fgs + 4096; LAS float* qs = vs + 4096; LAS float* op = qs + 4096;
    f32x2 st[16];
    float* Sp = Sloc + (size_t)unit * 16384 + (size_t)(dg * 32) * 128 + v;
#pragma unroll
    for (int dd = 0; dd < 16; ++dd) { st[dd].x = OUT ? Sp[(2 * dd) * 128] : 0.f; st[dd].y = OUT ? Sp[(2 * dd + 1) * 128] : 0.f; }
    float dprod = 1.f;
    const int stok = tid >> 4, c8 = (tid & 15) * 8;
    float lb[8];
#pragma unroll
    for (int i = 0; i < 8; ++i) { lb[i] = 0.f; if (j > 0) { const float a0 = lbl[hh * 128 + c8 + i], a1 = lbl[MIXW + hh * 128 + c8 + i]; lb[i] = 1.f / (1.f + __expf(a0 - a1)); } }
    for (int ch = 0; ch < HSEG / 32; ++ch) {
        const size_t t0 = (size_t)b * SEQ + seg * HSEG + ch * 32;
        { const bf16* row = h + (t0 + stok) * NC_H + hh * 128 + c8;
          const v4u f8 = *(const v4u*)(row + 768), i8 = *(const v4u*)(row + 1536); v4u q8 = {0u, 0u, 0u, 0u}; if (OUT) q8 = *(const v4u*)row;
#pragma unroll
          for (int w = 0; w < 4; ++w) { const float f0 = bflo(f8[w]), f1 = bfhi(f8[w]); const int o = stok * 128 + c8 + 2 * w;
              fgs[o] = lb[2 * w] + (1.f - lb[2 * w]) * sigmoidf_(f0); fgs[o + 1] = lb[2 * w + 1] + (1.f - lb[2 * w + 1]) * sigmoidf_(f1);
              vs[o] = bflo(i8[w]); vs[o + 1] = bfhi(i8[w]);
              if (OUT) { const float q0 = bflo(q8[w]), q1 = bfhi(q8[w]); qs[o] = q0 * sigmoidf_(q0); qs[o + 1] = q1 * sigmoidf_(q1); } } }
        __syncthreads();
        if (!OUT) { if (tid < 128) { for (int tt = 0; tt < 32; ++tt) dprod *= fgs[tt * 128 + tid]; } }
        f32x4 fA[8], qA[8], fB[8], qB[8]; float vA, vB;
#define HG_LOAD(F, Q, V, tt_) do { V = vs[(tt_) * 128 + v]; _Pragma("unroll") for (int d4 = 0; d4 < 8; ++d4) { F[d4] = *(const LAS f32x4*)(fgs + (tt_) * 128 + dg * 32 + d4 * 4); \
            if (OUT) Q[d4] = *(const LAS f32x4*)(qs + (tt_) * 128 + dg * 32 + d4 * 4); } } while (0)
#define HG_STEP(F, Q, V, tt_) do { const f32x2 vv2 = {V, V}; f32x2 acc2 = {0.f, 0.f}; _Pragma("unroll") for (int d4 = 0; d4 < 8; ++d4) { \
            const f32x2 fa = {F[d4].x, F[d4].y}, fb = {F[d4].z, F[d4].w}; \
            st[2 * d4] = fa * (st[2 * d4] - vv2) + vv2; st[2 * d4 + 1] = fb * (st[2 * d4 + 1] - vv2) + vv2; \
            if (OUT) { const f32x2 qa = {Q[d4].x, Q[d4].y}, qb = {Q[d4].z, Q[d4].w}; acc2 = qa * st[2 * d4] + acc2; acc2 = qb * st[2 * d4 + 1] + acc2; } } \
            if (OUT) op[(dg * 32 + (tt_)) * 128 + v] = acc2.x + acc2.y; } while (0)
        HG_LOAD(fA, qA, vA, 0);
#pragma unroll 1
        for (int tt = 0; tt < 32; tt += 2) {
            HG_LOAD(fB, qB, vB, tt + 1);
            __builtin_amdgcn_sched_barrier(0);
            HG_STEP(fA, qA, vA, tt);
            __builtin_amdgcn_sched_barrier(0);
            if (tt + 2 < 32) HG_LOAD(fA, qA, vA, tt + 2);
            __builtin_amdgcn_sched_barrier(0);
            HG_STEP(fB, qB, vB, tt + 1);
            __builtin_amdgcn_sched_barrier(0);
        }
#undef HG_LOAD
#undef HG_STEP
        if (OUT) {
            __syncthreads();
#pragma unroll
            for (int k = 0; k < 4; ++k) { const int tt = wave + 8 * k; float o0 = 0.f, o1 = 0.f;
#pragma unroll
                for (int g = 0; g < 4; ++g) { o0 += op[(g * 32 + tt) * 128 + lane]; o1 += op[(g * 32 + tt) * 128 + lane + 64]; }
                const float ms = wave_sum(o0 * o0 + o1 * o1) * (1.f / 128.f), r = 1.f / sqrtf(ms + 1e-6f);
                const bf16* grow = h + (t0 + tt) * NC_H + 2304 + hh * 128; const float g0 = bf2f(grow[lane]), g1 = bf2f(grow[lane + 64]);
                bf16* mrow = mix + (t0 + tt) * 1024 + hh * 128;
                mrow[lane] = (bf16)f2bf(o0 * r * normg[lane] * sigmoidf_(g0)); mrow[lane + 64] = (bf16)f2bf(o1 * r * normg[lane + 64] * sigmoidf_(g1)); }
        }
        __syncthreads();
    }
    if (!OUT) {
#pragma unroll
        for (int dd = 0; dd < 16; ++dd) { Sp[(2 * dd) * 128] = st[dd].x; Sp[(2 * dd + 1) * 128] = st[dd].y; }
        if (tid < 128) Dseg[(size_t)unit * 128 + tid] = dprod;
    }
}
constexpr int HG_G = 0, HG_QT = 32768, HG_KT = 50176, HG_KE = 67584, HG_VT = 86016, HG_ST = 104448, HG_GM = 139264, HG_GE = 139776, HG_PART = 140288, HG_EGM = 142336, HG_EGE = 142848;
static_assert(HG_EGE + 512 <= MISC_OFF, "HGRN LDS map");
__device__ __forceinline__ int crow16(int i, int hf) { return (i & 3) + 8 * (i >> 2) + 4 * hf; }
template <bool OUT>
__device__ __forceinline__ void hgrn_mfma(LAS unsigned char* lds, const bf16* h, const float* lbl, int j, const float* normg, float* Sloc, float* Dseg, bf16* mix, int unit, int tid, int wave, int lane) {
    const int seg = unit & (HNSEG - 1), bh = unit >> 6, hh = bh % HG_H, b = bh / HG_H;
    const int r = lane & 31, hf = lane >> 5, tr = wave & 1, vq = wave >> 1;
    LAS float* G = (LAS float*)(lds + HG_G); LAS float* GM = (LAS float*)(lds + HG_GM); LAS float* GE = (LAS float*)(lds + HG_GE); LAS float* PART = (LAS float*)(lds + HG_PART); LAS float* EGM = (LAS float*)(lds + HG_EGM); LAS float* EGE = (LAS float*)(lds + HG_EGE);
    const int stok = tid >> 3, c16 = (tid & 7) * 16, sperm = (stok & ~15) | (stok & 3) | ((stok & 4) << 1) | ((stok & 8) >> 1);
    const int cd = tid & 127, cpart = tid >> 7;
    float lb[16];
#pragma unroll
    for (int e = 0; e < 16; ++e) { lb[e] = 0.f; if (j > 0) { const float a0 = lbl[hh * 128 + c16 + e], a1 = lbl[MIXW + hh * 128 + c16 + e]; lb[e] = 1.f / (1.f + __expf(a0 - a1)); } }
    f32x16 S[2];
    float* Sp = Sloc + (size_t)unit * 16384 + 32 * vq + r;
#pragma unroll
    for (int dd = 0; dd < 2; ++dd)
#pragma unroll
        for (int i = 0; i < 16; ++i) S[dd][i] = OUT ? Sp[(32 * (2 * tr + dd) + crow16(i, hf)) * 128] : 0.f;
    float gsum = 0.f;
    float ng16[16];
#pragma unroll
    for (int e = 0; e < 16; ++e) ng16[e] = OUT ? normg[c16 + e] : 0.f;
    v4u nf8[2], ni8[2], nq8[2] = {{0u, 0u, 0u, 0u}, {0u, 0u, 0u, 0u}}, ng8[2] = {{0u, 0u, 0u, 0u}, {0u, 0u, 0u, 0u}};
#define HG_RAWLOAD(t0_) do { const bf16* row_ = h + ((t0_) + stok) * NC_H + hh * 128 + c16; nf8[0] = *(const v4u*)(row_ + 768); nf8[1] = *(const v4u*)(row_ + 776); ni8[0] = *(const v4u*)(row_ + 1536); ni8[1] = *(const v4u*)(row_ + 1544); \
        if (OUT) { nq8[0] = *(const v4u*)row_; nq8[1] = *(const v4u*)(row_ + 8); ng8[0] = *(const v4u*)(row_ + 2304); ng8[1] = *(const v4u*)(row_ + 2312); } } while (0)
    HG_RAWLOAD((size_t)b * SEQ + seg * HSEG);
    for (int ch = 0; ch < HSEG / 64; ++ch) {
        const size_t t0 = (size_t)b * SEQ + seg * HSEG + ch * 64;
        float fg[16], qv[16]; v4u i8[2], g8[2];
        { const v4u f8[2] = {nf8[0], nf8[1]}; i8[0] = ni8[0]; i8[1] = ni8[1]; const v4u q8[2] = {nq8[0], nq8[1]}; g8[0] = ng8[0]; g8[1] = ng8[1];
#pragma unroll
          for (int w = 0; w < 8; ++w) { const unsigned fw = f8[w >> 2][w & 3]; const float f0 = bflo(fw), f1 = bfhi(fw);
              fg[2 * w] = lb[2 * w] + (1.f - lb[2 * w]) * sigmoidf_(f0); fg[2 * w + 1] = lb[2 * w + 1] + (1.f - lb[2 * w + 1]) * sigmoidf_(f1);
              if (OUT) { const unsigned qw = q8[w >> 2][w & 3]; const float q0 = bflo(qw), q1 = bfhi(qw); qv[2 * w] = q0 * sigmoidf_(q0); qv[2 * w + 1] = q1 * sigmoidf_(q1); } else { qv[2 * w] = 0.f; qv[2 * w + 1] = 0.f; } }
#pragma unroll
          for (int e4 = 0; e4 < 4; ++e4) { f32x4 lg; lg.x = __builtin_amdgcn_logf(fg[4 * e4]); lg.y = __builtin_amdgcn_logf(fg[4 * e4 + 1]); lg.z = __builtin_amdgcn_logf(fg[4 * e4 + 2]); lg.w = __builtin_amdgcn_logf(fg[4 * e4 + 3]);
              *(LAS f32x4*)(G + stok * 128 + c16 + 4 * e4) = lg; } }
        __syncthreads();
        { float run = 0.f;
#pragma unroll
          for (int k = 0; k < 16; ++k) run += G[(16 * cpart + k) * 128 + cd];
          PART[cpart * 128 + cd] = run; }
        __syncthreads();
        { float run = 0.f;
#pragma unroll
          for (int pp = 0; pp < 3; ++pp) run += (pp < cpart) ? PART[pp * 128 + cd] : 0.f;
#pragma unroll
          for (int k = 0; k < 16; ++k) { run += G[(16 * cpart + k) * 128 + cd]; G[(16 * cpart + k) * 128 + cd] = run; }
          if (cpart == 1) { GM[cd] = run; EGM[cd] = __builtin_amdgcn_exp2f(run); }
          if (cpart == 3) { GE[cd] = run; EGE[cd] = __builtin_amdgcn_exp2f(run); gsum += run; } }
        __syncthreads();
        if (OUT) {
#pragma unroll
            for (int dd = 0; dd < 2; ++dd)
#pragma unroll
                for (int g4 = 0; g4 < 4; ++g4) { const int dbase = 32 * (2 * tr + dd) + 8 * g4 + 4 * hf; const f32x4 gm = *(const LAS f32x4*)(EGM + dbase);
                    v2u w; w.x = cvtpk(S[dd][4 * g4] * gm.x, S[dd][4 * g4 + 1] * gm.y); w.y = cvtpk(S[dd][4 * g4 + 2] * gm.z, S[dd][4 * g4 + 3] * gm.w);
                    *(LAS v2u*)(lds + HG_ST + (32 * vq + r) * 272 + dbase * 2) = w; }
        }
        { unsigned qt[8], kt[8];
#pragma unroll
          for (int e4 = 0; e4 < 4; ++e4) { const f32x4 gv = *(const LAS f32x4*)(G + stok * 128 + c16 + 4 * e4), gm = *(const LAS f32x4*)(GM + c16 + 4 * e4), ge = *(const LAS f32x4*)(GE + c16 + 4 * e4);
              float ke[4];
#pragma unroll
              for (int e = 0; e < 4; ++e) { const float kk = 1.f - fg[4 * e4 + e]; ke[e] = kk * __builtin_amdgcn_exp2f(ge[e] - gv[e]);
                  if (OUT) { const float a = qv[4 * e4 + e] * __builtin_amdgcn_exp2f(gv[e] - gm[e]), c = kk * __builtin_amdgcn_exp2f(gm[e] - gv[e]);
                      if (e & 1) { qt[2 * e4 + (e >> 1)] |= f2bf(a) << 16; kt[2 * e4 + (e >> 1)] |= f2bf(c) << 16; } else { qt[2 * e4 + (e >> 1)] = f2bf(a); kt[2 * e4 + (e >> 1)] = f2bf(c); } } }
#pragma unroll
              for (int e = 0; e < 4; ++e) { const int col = c16 + 4 * e4 + e;
                  *(LAS bf16*)(lds + HG_KE + col * 144 + sperm * 2) = (bf16)f2bf(ke[e]);
                  const unsigned vw = i8[e4 >> 1][(2 * e4 + (e >> 1)) & 3]; *(LAS bf16*)(lds + HG_VT + col * 144 + sperm * 2) = (bf16)((e & 1) ? (vw >> 16) : (vw & 0xffffu)); } }
          if (OUT) { *(LAS v4u*)(lds + HG_QT + stok * 272 + c16 * 2) = (v4u){qt[0], qt[1], qt[2], qt[3]}; *(LAS v4u*)(lds + HG_QT + stok * 272 + c16 * 2 + 16) = (v4u){qt[4], qt[5], qt[6], qt[7]};
                     *(LAS v4u*)(lds + HG_KT + stok * 272 + c16 * 2) = (v4u){kt[0], kt[1], kt[2], kt[3]}; *(LAS v4u*)(lds + HG_KT + stok * 272 + c16 * 2 + 16) = (v4u){kt[4], kt[5], kt[6], kt[7]}; } }
        __syncthreads();
        if (ch + 1 < HSEG / 64) HG_RAWLOAD(t0 + 64);
        if (OUT) {
            f32x16 X0, X1, O;
#pragma unroll
            for (int i = 0; i < 16; ++i) { X0[i] = 0.f; X1[i] = 0.f; O[i] = 0.f; }
            const LAS unsigned char* qtp = lds + HG_QT + (32 * tr + r) * 272 + hf * 16;
#pragma unroll
            for (int ks = 0; ks < 8; ++ks) { const s16x8 bq = *(const LAS s16x8*)(qtp + ks * 32);
                const s16x8 a0 = *(const LAS s16x8*)(lds + HG_KT + r * 272 + hf * 16 + ks * 32); X0 = __builtin_amdgcn_mfma_f32_32x32x16_bf16(a0, bq, X0, 0, 0, 0);
                if (tr == 1) { const s16x8 a1 = *(const LAS s16x8*)(lds + HG_KT + (32 + r) * 272 + hf * 16 + ks * 32); X1 = __builtin_amdgcn_mfma_f32_32x32x16_bf16(a1, bq, X1, 0, 0, 0); } }
#pragma unroll
            for (int i = 0; i < 16; ++i) { const bool keep = crow16(i, hf) <= r; if (tr == 0) X0[i] = keep ? X0[i] : 0.f; else X1[i] = keep ? X1[i] : 0.f; }
            const LAS unsigned char* vtp = lds + HG_VT + (32 * vq + r) * 144 + hf * 16;
#pragma unroll
            for (int s2 = 0; s2 < 2; ++s2) { v4u pw; pw.x = cvtpk(X0[8 * s2], X0[8 * s2 + 1]); pw.y = cvtpk(X0[8 * s2 + 2], X0[8 * s2 + 3]); pw.z = cvtpk(X0[8 * s2 + 4], X0[8 * s2 + 5]); pw.w = cvtpk(X0[8 * s2 + 6], X0[8 * s2 + 7]);
                const s16x8 bv = *(const LAS s16x8*)(vtp + (16 * s2) * 2); O = __builtin_amdgcn_mfma_f32_32x32x16_bf16(__builtin_bit_cast(s16x8, pw), bv, O, 0, 0, 0); }
            if (tr == 1) {
#pragma unroll
                for (int s2 = 0; s2 < 2; ++s2) { v4u pw; pw.x = cvtpk(X1[8 * s2], X1[8 * s2 + 1]); pw.y = cvtpk(X1[8 * s2 + 2], X1[8 * s2 + 3]); pw.z = cvtpk(X1[8 * s2 + 4], X1[8 * s2 + 5]); pw.w = cvtpk(X1[8 * s2 + 6], X1[8 * s2 + 7]);
                    const s16x8 bv = *(const LAS s16x8*)(vtp + (32 + 16 * s2) * 2); O = __builtin_amdgcn_mfma_f32_32x32x16_bf16(__builtin_bit_cast(s16x8, pw), bv, O, 0, 0, 0); } }
            const LAS unsigned char* stp = lds + HG_ST + (32 * vq + r) * 272 + hf * 16;
#pragma unroll
            for (int ks = 0; ks < 8; ++ks) { const s16x8 aq = *(const LAS s16x8*)(qtp + ks * 32), bs = *(const LAS s16x8*)(stp + ks * 32); O = __builtin_amdgcn_mfma_f32_32x32x16_bf16(aq, bs, O, 0, 0, 0); }
#pragma unroll
            for (int i = 0; i < 16; ++i) G[(32 * tr + crow16(i, hf)) * 128 + 32 * vq + r] = O[i];
        }
#pragma unroll
        for (int dd = 0; dd < 2; ++dd) { const int dr = 2 * tr + dd;
#pragma unroll
            for (int g4 = 0; g4 < 4; ++g4) { const f32x4 ge = *(const LAS f32x4*)(EGE + 32 * dr + 8 * g4 + 4 * hf);
                S[dd][4 * g4] *= ge.x; S[dd][4 * g4 + 1] *= ge.y; S[dd][4 * g4 + 2] *= ge.z; S[dd][4 * g4 + 3] *= ge.w; }
#pragma unroll
            for (int ks = 0; ks < 4; ++ks) { const s16x8 a = *(const LAS s16x8*)(lds + HG_KE + (32 * dr + r) * 144 + hf * 16 + ks * 32), bv = *(const LAS s16x8*)(lds + HG_VT + (32 * vq + r) * 144 + hf * 16 + ks * 32);
                S[dd] = __builtin_amdgcn_mfma_f32_32x32x16_bf16(a, bv, S[dd], 0, 0, 0); } }
        __syncthreads();
        if (OUT) {
            float ov[16]; float ss = 0.f;
#pragma unroll
            for (int e4 = 0; e4 < 4; ++e4) { const f32x4 o4 = *(const LAS f32x4*)(G + stok * 128 + c16 + 4 * e4); ov[4 * e4] = o4.x; ov[4 * e4 + 1] = o4.y; ov[4 * e4 + 2] = o4.z; ov[4 * e4 + 3] = o4.w;
                ss += (o4.x * o4.x + o4.y * o4.y) + (o4.z * o4.z + o4.w * o4.w); }
            ss += xorf<1>(ss); ss += xorf<2>(ss); ss += xorf<4>(ss);
            const float rr = 1.f / sqrtf(ss * (1.f / 128.f) + 1e-6f);
            unsigned ow[8];
#pragma unroll
            for (int w = 0; w < 8; ++w) { const unsigned gw_ = g8[w >> 2][w & 3]; ow[w] = cvtpk(ov[2 * w] * rr * ng16[2 * w] * sigmoidf_(bflo(gw_)), ov[2 * w + 1] * rr * ng16[2 * w + 1] * sigmoidf_(bfhi(gw_))); }
            bf16* mrow = mix + (t0 + stok) * 1024 + hh * 128 + c16;
            *(v4u*)mrow = (v4u){ow[0], ow[1], ow[2], ow[3]}; *(v4u*)(mrow + 8) = (v4u){ow[4], ow[5], ow[6], ow[7]};
            __syncthreads();
        }
    }
#undef HG_RAWLOAD
    if (!OUT) {
#pragma unroll
        for (int dd = 0; dd < 2; ++dd)
#pragma unroll
            for (int i = 0; i < 16; ++i) Sp[(32 * (2 * tr + dd) + crow16(i, hf)) * 128] = S[dd][i];
        if (cpart == 3) Dseg[(size_t)unit * 128 + cd] = __builtin_amdgcn_exp2f(gsum);
    }
}
__device__ __forceinline__ void hgrn_scan(float* Sloc, const float* Dseg, size_t gtid, size_t gthreads) {
    for (size_t idx = gtid; idx < (size_t)NBATCH * HG_H * 16384; idx += gthreads) { const int bh = (int)(idx >> 14), e = (int)(idx & 16383), d = e >> 7; float cur = 0.f;
        float* __restrict__ sp = Sloc + (size_t)bh * HNSEG * 16384 + e; const float* __restrict__ dp = Dseg + (size_t)bh * HNSEG * 128 + d;
        for (int s0 = 0; s0 < HNSEG; s0 += 16) { float tv[16], dv[16];
#pragma unroll
            for (int k = 0; k < 16; ++k) { tv[k] = sp[(size_t)(s0 + k) * 16384]; dv[k] = dp[(s0 + k) * 128]; }
#pragma unroll
            for (int k = 0; k < 16; ++k) { sp[(size_t)(s0 + k) * 16384] = cur; cur = dv[k] * cur + tv[k]; } } }
}

template <bool MASK>
__device__ __forceinline__ void attn4(const LAS unsigned* Ks, const LAS bf16* Vs, const LAS float* qst, LAS float* pb, int lane, const int (&tq)[4], int kbase, float slope,
                                      float (&mo)[4], float (&lo)[4], float (&oo)[4]) {
    float sc[4][4];
#pragma unroll
    for (int a = 0; a < 4; ++a)
#pragma unroll
        for (int c = 0; c < 4; ++c) sc[a][c] = 0.f;
#pragma unroll 4
    for (int dd = 0; dd < 32; ++dd) {
        f32x2 qv[4];
#pragma unroll
        for (int qi = 0; qi < 4; ++qi) qv[qi] = *(const LAS f32x2*)(qst + qi * 64 + 2 * dd);
#pragma unroll
        for (int kk = 0; kk < 4; ++kk) { const unsigned kw = Ks[(lane + 64 * kk) * 33 + dd]; const float k0 = bflo(kw), k1 = bfhi(kw);
#pragma unroll
            for (int qi = 0; qi < 4; ++qi) sc[qi][kk] += qv[qi].x * k0 + qv[qi].y * k1; }
    }
#pragma unroll
    for (int qi = 0; qi < 4; ++qi) { float mx = -INFINITY;
#pragma unroll
        for (int kk = 0; kk < 4; ++kk) { const int pos = kbase + lane + 64 * kk; float lg = sc[qi][kk] * 0.125f - slope * (float)(tq[qi] - pos); if (MASK && pos > tq[qi]) lg = -INFINITY; sc[qi][kk] = lg; mx = fmaxf(mx, lg); }
        mx = wave_max(mx); float s = 0.f;
#pragma unroll
        for (int kk = 0; kk < 4; ++kk) { const float p = __builtin_amdgcn_exp2f((sc[qi][kk] - mx) * 1.4426950408889634f); pb[qi * 256 + lane + 64 * kk] = p; s += p; }
        lo[qi] = wave_sum(s); mo[qi] = mx; }
    float o[4] = {0.f, 0.f, 0.f, 0.f};
#pragma unroll 4
    for (int k4 = 0; k4 < 64; ++k4) { f32x4 p4[4];
#pragma unroll
        for (int qi = 0; qi < 4; ++qi) p4[qi] = *(const LAS f32x4*)(pb + qi * 256 + 4 * k4);
#pragma unroll
        for (int jj = 0; jj < 4; ++jj) { const float vv = bf2f(Vs[(4 * k4 + jj) * 64 + lane]);
#pragma unroll
            for (int qi = 0; qi < 4; ++qi) o[qi] += p4[qi][jj] * vv; } }
#pragma unroll
    for (int qi = 0; qi < 4; ++qi) oo[qi] = o[qi];
}
constexpr int AT_KS = 0, AT_VS = 33792, AT_WV = 66560, AT_WVB = 5120;

__device__ __forceinline__ void memattn_unit(LAS unsigned char* lds, const bf16* h, int NC, int qoff, const bf16* kv, bf16* mix, int unit, int tid, int wave, int lane) {
    const int chunk = unit & 31, bm = unit >> 5, mh = bm & 3, b = bm >> 2;
    LAS unsigned* Ks = (LAS unsigned*)(lds + AT_KS); LAS unsigned* Vs32 = (LAS unsigned*)(lds + AT_VS);
    LAS float* qst = (LAS float*)(lds + AT_WV + wave * AT_WVB); LAS float* pb = qst + 256;
    for (int i = 0; i < 16; ++i) { const int idx = tid + 512 * i, r = idx >> 5, dd = idx & 31; const unsigned* src = (const unsigned*)(kv + (size_t)(b * 256 + r) * 512 + mh * 64);
        Ks[r * 33 + dd] = src[dd]; Vs32[r * 32 + dd] = src[128 + dd]; }
    __syncthreads();
    for (int qd = 0; qd < 16; ++qd) { const size_t tg = (size_t)b * SEQ + chunk * 512 + wave * 64 + qd * 4;
#pragma unroll
        for (int qi = 0; qi < 4; ++qi) qst[qi * 64 + lane] = bf2f(h[(tg + qi) * NC + qoff + mh * 64 + lane]);
        const int tq[4] = {0, 0, 0, 0}; float m[4], l[4], o[4];
        attn4<false>(Ks, (const LAS bf16*)Vs32, qst, pb, lane, tq, 0, 0.f, m, l, o);
#pragma unroll
        for (int qi = 0; qi < 4; ++qi) mix[(tg + qi) * 1024 + MIXW + mh * 64 + lane] = (bf16)f2bf(o[qi] / l[qi]); }
    __syncthreads();
}

constexpr int AT2_K = 0, AT2_KROW = 176, AT2_V = 256 * AT2_KROW, AT2_VROW = 528, AT2_SCR = AT2_V + 64 * AT2_VROW, AT2_SCRW = 4864;
__device__ __forceinline__ void stage_kv_images(LAS unsigned char* lds, const bf16* kp, const bf16* vp, size_t row_stride, int tid) {
    v4u kx[4], vx[4];
#pragma unroll
    for (int i = 0; i < 4; ++i) { const int idx = tid + 512 * i, key = idx >> 3, c = idx & 7; kx[i] = *(const v4u*)(kp + (size_t)key * row_stride + 8 * c); vx[i] = *(const v4u*)(vp + (size_t)key * row_stride + 8 * c); }
    __builtin_amdgcn_sched_barrier(0);
#pragma unroll
    for (int i = 0; i < 4; ++i) { const int idx = tid + 512 * i, key = idx >> 3, c = idx & 7;
        *(LAS v4u*)(lds + AT2_K + key * AT2_KROW + c * 16) = kx[i];
        const int pos = (key & ~15) | (key & 3) | ((key & 4) << 1) | ((key & 8) >> 1);
        LAS bf16* vt = (LAS bf16*)(lds + AT2_V) + pos;
#pragma unroll
        for (int w = 0; w < 4; ++w) { vt[(8 * c + 2 * w) * (AT2_VROW / 2)] = (bf16)(vx[i][w] & 0xffffu); vt[(8 * c + 2 * w + 1) * (AT2_VROW / 2)] = (bf16)(vx[i][w] >> 16); } }
    if (tid < 256) { const unsigned pb = f2bf((float)tid); const v4u e0 = {pb | (pb << 16), 0x3F803F80u, 0u, 0u}, z = {0u, 0u, 0u, 0u};
        *(LAS v4u*)(lds + AT2_K + tid * AT2_KROW + 128) = e0; *(LAS v4u*)(lds + AT2_K + tid * AT2_KROW + 144) = z; }
}
template <bool MASK>
__device__ __forceinline__ void attn_tile32(const LAS unsigned char* lds, const s16x8 (&qf)[4], int lane, float dist0, unsigned qx, unsigned qx2, bool own, f32x16 (&o)[2], float& mrow, float& lrow) {
    const int r = lane & 31, hf = lane >> 5;
    const v4u qxv = {qx, qx2, 0u, 0u}; const s16x8 qe = __builtin_bit_cast(s16x8, qxv);
    f32x16 acc[8];
    const LAS unsigned char* kb = lds + AT2_K + r * AT2_KROW + hf * 16;
    constexpr int NKS = MASK ? 5 : 4;
    s16x8 kf[NKS];
#pragma unroll
    for (int s = 0; s < NKS; ++s) kf[s] = *(const LAS s16x8*)(kb + s * 32);
#pragma unroll
    for (int kt = 0; kt < 8; ++kt) {
#pragma unroll
        for (int i = 0; i < 16; ++i) acc[kt][i] = 0.f;
#pragma unroll
        for (int s = 0; s < NKS; ++s) { acc[kt] = __builtin_amdgcn_mfma_f32_32x32x16_bf16(kf[s], s < 4 ? qf[s < 4 ? s : 0] : qe, acc[kt], 0, 0, 0);
            if (kt + 1 < 8) kf[s] = *(const LAS s16x8*)(kb + (kt + 1) * 32 * AT2_KROW + s * 32); }
        __builtin_amdgcn_sched_barrier(0); }
    float mx = -INFINITY;
    if (MASK) { mx = 0.f;
        if (own) { const float base2 = dist0 - 4.f * (float)hf;
#pragma unroll
            for (int kt = 0; kt < 8; ++kt)
#pragma unroll
                for (int i = 0; i < 16; ++i) { const float dist = base2 - (float)(32 * kt + (i & 3) + 8 * (i >> 2)); acc[kt][i] = dist < 0.f ? -INFINITY : acc[kt][i]; } }
    } else {
#pragma unroll
        for (int kt = 0; kt < 8; ++kt)
#pragma unroll
            for (int i = 0; i < 16; ++i) mx = fmaxf(mx, acc[kt][i]);
        mx = fmaxf(mx, xor32f(mx, lane));
    }
    f32x2 sum2 = {0.f, 0.f};
#pragma unroll
    for (int i = 0; i < 16; ++i) { o[0][i] = 0.f; o[1][i] = 0.f; }
    const LAS unsigned char* vb = lds + AT2_V + r * AT2_VROW + hf * 16;
    s16x8 vf[4];
#pragma unroll
    for (int s2 = 0; s2 < 2; ++s2)
#pragma unroll
        for (int dt = 0; dt < 2; ++dt) vf[2 * s2 + dt] = *(const LAS s16x8*)(vb + dt * 32 * AT2_VROW + (16 * s2) * 2);
#pragma unroll
    for (int kt = 0; kt < 8; ++kt) {
#pragma unroll
        for (int i = 0; i < 16; ++i) acc[kt][i] = __builtin_amdgcn_exp2f(MASK ? acc[kt][i] : acc[kt][i] - mx);
#pragma unroll
        for (int i = 0; i < 8; ++i) sum2 += (f32x2){acc[kt][2 * i], acc[kt][2 * i + 1]};
#pragma unroll
        for (int s2 = 0; s2 < 2; ++s2) { v4u pw; pw.x = cvtpk(acc[kt][8 * s2], acc[kt][8 * s2 + 1]); pw.y = cvtpk(acc[kt][8 * s2 + 2], acc[kt][8 * s2 + 3]);
            pw.z = cvtpk(acc[kt][8 * s2 + 4], acc[kt][8 * s2 + 5]); pw.w = cvtpk(acc[kt][8 * s2 + 6], acc[kt][8 * s2 + 7]); const s16x8 pf = __builtin_bit_cast(s16x8, pw);
#pragma unroll
            for (int dt = 0; dt < 2; ++dt) { o[dt] = __builtin_amdgcn_mfma_f32_32x32x16_bf16(vf[2 * s2 + dt], pf, o[dt], 0, 0, 0);
                if (kt + 1 < 8) vf[2 * s2 + dt] = *(const LAS s16x8*)(vb + dt * 32 * AT2_VROW + (32 * (kt + 1) + 16 * s2) * 2); } }
        __builtin_amdgcn_sched_barrier(0); }
    float sum = sum2.x + sum2.y; sum += xor32f(sum, lane);
    if (!MASK) mrow = mx;
    lrow = sum;
}
__device__ __forceinline__ void memattn_unit2(LAS unsigned char* lds, const bf16* h, int NC, int qoff, const bf16* kv  , bf16* mix, int unit, int tid, int wave, int lane) {
    const int chunk = unit & 63, bm = unit >> 6, mh = bm & 3, b = bm >> 2, r = lane & 31, hf = lane >> 5;
    const bf16* kvrow0 = kv + (size_t)(b * 256) * 2048 + mh * 64;
    stage_kv_images(lds, kvrow0, kvrow0 + 256, 2048, tid);
    __syncthreads();
    { const size_t tg = (size_t)b * SEQ + chunk * 256 + wave * 32 + r;
        f32x16 o[2]; float m2, l; s16x8 qf[4];
#pragma unroll
        for (int s = 0; s < 4; ++s) qf[s] = *(const s16x8*)(h + tg * NC + qoff + mh * 64 + 16 * s + 8 * hf);
        attn_tile32<false>(lds, qf, lane, 0.f, 0u, 0u, false, o, m2, l);
        const float inv = 1.f / l; bf16* mp = mix + tg * 1024 + MIXW + mh * 64 + 4 * hf;
#pragma unroll
        for (int dt = 0; dt < 2; ++dt)
#pragma unroll
            for (int g = 0; g < 4; ++g) { v2u w; w.x = cvtpk(o[dt][4 * g] * inv, o[dt][4 * g + 1] * inv); w.y = cvtpk(o[dt][4 * g + 2] * inv, o[dt][4 * g + 3] * inv); *(v2u*)(mp + 32 * dt + 8 * g) = w; } }
    __syncthreads();
}
__device__ __forceinline__ void kmean_unit(LAS unsigned char* lds, const bf16* h, float* kmean, float* kmaxg, int unit, int tid, int wave) {
    const int n = unit & 63, bh = unit >> 6, hh = bh % MB_H, b = bh / MB_H, d = tid & 63, part = tid >> 6;
    LAS float* red = (LAS float*)lds;
    float s = 0.f; const bf16* p = h + ((size_t)b * SEQ + n * 256 + part * 32) * NC_M + 768 + hh * 64 + d;
    for (int i = 0; i < 32; ++i) s += bf2f(p[(size_t)i * NC_M]);
    float ss = 0.f; { const v4u* kp = (const v4u*)(h + ((size_t)b * SEQ + n * 256 + (tid >> 1)) * NC_M + 768 + hh * 64 + (tid & 1) * 32);
#pragma unroll
        for (int w = 0; w < 4; ++w) { const v4u x = kp[w]; ss += bflo(x.x) * bflo(x.x) + bfhi(x.x) * bfhi(x.x) + bflo(x.y) * bflo(x.y) + bfhi(x.y) * bfhi(x.y) + bflo(x.z) * bflo(x.z) + bfhi(x.z) * bfhi(x.z) + bflo(x.w) * bflo(x.w) + bfhi(x.w) * bfhi(x.w); } }
    ss += xorf<1>(ss); ss = wave_max(ss);
    red[part * 64 + d] = s; if ((tid & 63) == 0) red[512 + wave] = ss; __syncthreads();
    if (tid < 64) { float a = 0.f; for (int pp = 0; pp < 8; ++pp) a += red[pp * 64 + tid]; a *= (1.f / 256.f);
        const unsigned hi = f2bf(a), lo = f2bf(a - __builtin_bit_cast(float, hi << 16)); bf16* kmh = (bf16*)kmean; kmh[((size_t)bh * 64 + n) * 64 + tid] = (bf16)hi; kmh[(size_t)24 * 4096 + ((size_t)bh * 64 + n) * 64 + tid] = (bf16)lo; }
    if (tid == 0) { float mx = 0.f; for (int w = 0; w < 8; ++w) mx = fmaxf(mx, red[512 + w]); kmaxg[bh * 64 + n] = sqrtf(mx) * 1.001f; }
    __syncthreads();
}
__device__ __forceinline__ void gate_unit_core(const s16x8 (&qf)[4], const s16x8 (&kf)[4], const bf16* kmh, const bf16* kml, LAS int* hist, const LAS float* kmx, int* selinfo, int bh, int c, int t, int lane, unsigned& sel, unsigned& rr) {
    const int hh = bh % MB_H, b = bh / MB_H, hf = lane >> 5, r = lane & 31;
    int s0 = 0, s1 = 0, s2 = 0, r0 = 0, r1 = 0, r2 = 0, ns = 0;
    float v0 = -INFINITY, v1 = -INFINITY, v2 = -INFINITY, qn = 0.f, lown = 0.f;
    if (c > 0) {
        const int ntile = (c + 31) >> 5, ch = c - 4 * hf;
        s16x8 ah[2][4], al[2][4];
#pragma unroll
        for (int tile = 0; tile < 2; ++tile) if (tile < ntile) { const size_t ko = ((size_t)bh * 64 + 32 * tile + r) * 64 + 8 * hf;
#pragma unroll
            for (int ks = 0; ks < 4; ++ks) { ah[tile][ks] = *(const s16x8*)(kmh + ko + 16 * ks); al[tile][ks] = *(const s16x8*)(kml + ko + 16 * ks); } }
#pragma unroll
        for (int tile = 0; tile < 2; ++tile) if (tile < ntile) {
            f32x16 X;
#pragma unroll
            for (int i = 0; i < 16; ++i) X[i] = 0.f;
#pragma unroll
            for (int ks = 0; ks < 4; ++ks) { X = __builtin_amdgcn_mfma_f32_32x32x16_bf16(ah[tile][ks], qf[ks], X, 0, 0, 0); X = __builtin_amdgcn_mfma_f32_32x32x16_bf16(al[tile][ks], qf[ks], X, 0, 0, 0); }
#pragma unroll
            for (int i = 0; i < 16; ++i) { const int n = 32 * tile + (i & 3) + 8 * (i >> 2); const float g = (n < ch) ? X[i] : -INFINITY;
                if (g > v0) { v2 = v1; s2 = s1; v1 = v0; s1 = s0; v0 = g; s0 = n; } else if (g > v1) { v2 = v1; s2 = s1; v1 = g; s1 = n; } else if (g > v2) { v2 = g; s2 = n; } }
        }
        s0 += 4 * hf; s1 += 4 * hf; s2 += 4 * hf;
        { float qq = 0.f, qk = 0.f;
#pragma unroll
          for (int s = 0; s < 4; ++s)
#pragma unroll
              for (int jj = 0; jj < 8; ++jj) { const float qv = bf2f((bf16)qf[s][jj]), kv = bf2f((bf16)kf[s][jj]); qq += qv * qv; qk += qv * kv; }
          qq += xor32f(qq, lane); qk += xor32f(qk, lane);
          qn = sqrtf(qq) * 1.001f; lown = qk; }
        { float pv[3]; int ps[3]; const int pl = (lane ^ 32) << 2;
          pv[0] = __builtin_bit_cast(float, __builtin_amdgcn_ds_bpermute(pl, __builtin_bit_cast(int, v0))); pv[1] = __builtin_bit_cast(float, __builtin_amdgcn_ds_bpermute(pl, __builtin_bit_cast(int, v1)));
          pv[2] = __builtin_bit_cast(float, __builtin_amdgcn_ds_bpermute(pl, __builtin_bit_cast(int, v2)));
          ps[0] = __builtin_amdgcn_ds_bpermute(pl, s0); ps[1] = __builtin_amdgcn_ds_bpermute(pl, s1); ps[2] = __builtin_amdgcn_ds_bpermute(pl, s2);
#pragma unroll
          for (int k = 0; k < 3; ++k) { const float g = pv[k]; const int n = ps[k];
              if (g > v0 || (g == v0 && n < s0)) { v2 = v1; s2 = s1; v1 = v0; s1 = s0; v0 = g; s0 = n; } else if (g > v1 || (g == v1 && n < s1)) { v2 = v1; s2 = s1; v1 = g; s1 = n; } else if (g > v2 || (g == v2 && n < s2)) { v2 = g; s2 = n; } } }
    }
    sel = 0u; rr = 0u;
    if (hf == 0) {
        ns = c < 3 ? c : 3; s0 &= 63; s1 &= 63; s2 &= 63;
        { const float slope2 = (hh < 8 ? ldexpf(1.0f, -(hh + 1)) : ldexpf(0.70710678118654752f, -(hh - 8))) * 1.4426950408889634f;
          const bool k0 = ns > 0 && (qn * kmx[s0] - slope2 * (float)(t - (s0 * 256 + 255)) - lown) > -64.f;
          const bool k1 = ns > 1 && (qn * kmx[s1] - slope2 * (float)(t - (s1 * 256 + 255)) - lown) > -64.f;
          const bool k2 = ns > 2 && (qn * kmx[s2] - slope2 * (float)(t - (s2 * 256 + 255)) - lown) > -64.f;
          ns = (k0 ? 1 : 0) | (k1 ? 2 : 0) | (k2 ? 4 : 0); }
        if (ns & 1) r0 = __hip_atomic_fetch_add(hist + s0, 1, __ATOMIC_RELAXED, __HIP_MEMORY_SCOPE_WORKGROUP);
        if (ns & 2) r1 = __hip_atomic_fetch_add(hist + s1, 1, __ATOMIC_RELAXED, __HIP_MEMORY_SCOPE_WORKGROUP);
        if (ns & 4) r2 = __hip_atomic_fetch_add(hist + s2, 1, __ATOMIC_RELAXED, __HIP_MEMORY_SCOPE_WORKGROUP);
        selinfo[((size_t)b * SEQ + t) * MB_H + hh] = ns;
        sel = (unsigned)s0 | ((unsigned)s1 << 6) | ((unsigned)s2 << 12) | ((unsigned)ns << 18); rr = (unsigned)r0 | ((unsigned)r1 << 8) | ((unsigned)r2 << 16);
    }
}
__device__ __forceinline__ void moba_gate_wg(LAS unsigned char* lds, const bf16* h, const float* kmean, const float* kmaxg, unsigned* gcount, int* selinfo, unsigned* list, int blk, int tid) {
    constexpr int NU = 24 * MB_NB / GRID;
    static_assert(NU * GRID == 24 * MB_NB && GRID % 64 == 0 && NU * 64 <= NTHR, "gate deal");
    const int lane = tid & 63, r = lane & 31, hf = lane >> 5, wv = tid >> 6;
    const bf16* kmh = (const bf16*)kmean; const bf16* kml = kmh + (size_t)24 * 4096;
    LAS int* hist = (LAS int*)(lds + 16384); LAS int* base = hist + NU * 64; LAS float* kmx = (LAS float*)(base + NU * 64);
    if (tid < NU * 64) { const int bh = (blk >> 6) + 4 * (tid >> 6); hist[tid] = 0; kmx[tid] = kmaxg[bh * 64 + (tid & 63)]; }
    unsigned sel[NU], rr[NU];
    s16x8 qf[4], kf[4];
#define GU_BH(k) ((blk >> 6) + 4 * (k))
#define GU_C(k) (((k) & 1) ? 63 - (blk & 63) : (blk & 63))
#define GU_T(k) (GU_C(k) * 256 + wv * 32 + r)
    { const bf16* qp = h + ((size_t)(GU_BH(0) / MB_H) * SEQ + GU_T(0)) * NC_M + (GU_BH(0) % MB_H) * 64 + 8 * hf;
#pragma unroll
      for (int s = 0; s < 4; ++s) { qf[s] = *(const s16x8*)(qp + 16 * s); kf[s] = *(const s16x8*)(qp + 768 + 16 * s); } }
    __syncthreads();
#pragma unroll
    for (int k = 0; k < NU; ++k) {
        s16x8 qn_[4], kn_[4];
        if (k + 1 < NU) { const bf16* qp = h + ((size_t)(GU_BH(k + 1) / MB_H) * SEQ + GU_T(k + 1)) * NC_M + (GU_BH(k + 1) % MB_H) * 64 + 8 * hf;
#pragma unroll
            for (int s = 0; s < 4; ++s) { qn_[s] = *(const s16x8*)(qp + 16 * s); kn_[s] = *(const s16x8*)(qp + 768 + 16 * s); } }
        gate_unit_core(qf, kf, kmh, kml, hist + k * 64, kmx + k * 64, selinfo, GU_BH(k), GU_C(k), GU_T(k), lane, sel[k], rr[k]);
        if (k + 1 < NU) {
#pragma unroll
            for (int s = 0; s < 4; ++s) { qf[s] = qn_[s]; kf[s] = kn_[s]; } }
    }
    __syncthreads();
    if (tid < NU * 64) { const int hc = hist[tid]; if (hc > 0) base[tid] = (int)__hip_atomic_fetch_add(gcount + GU_BH(tid >> 6) * 64 + (tid & 63), (unsigned)hc, __ATOMIC_RELAXED, __HIP_MEMORY_SCOPE_AGENT); }
    __syncthreads();
    if (hf == 0) {
#pragma unroll
        for (int k = 0; k < NU; ++k) { unsigned* lp = list + ((size_t)GU_BH(k) * 64 << 14); const unsigned sl = sel[k], rk = rr[k], t = (unsigned)GU_T(k); const int s0 = sl & 63, s1 = (sl >> 6) & 63, s2 = (sl >> 12) & 63;
            if (sl & (1u << 18)) lp[((size_t)s0 << 14) + base[k * 64 + s0] + (rk & 255u)] = t;
            if (sl & (2u << 18)) lp[((size_t)s1 << 14) + base[k * 64 + s1] + ((rk >> 8) & 255u)] = t | (1u << 14);
            if (sl & (4u << 18)) lp[((size_t)s2 << 14) + base[k * 64 + s2] + ((rk >> 16) & 255u)] = t | (2u << 14); } }
#undef GU_BH
#undef GU_C
#undef GU_T
    __syncthreads();
}
__device__ __forceinline__ void moba_attn_item(LAS unsigned char* lds, const bf16* h, const unsigned* gcount, const unsigned* list, float* po, float* pml, int item, int tid, int wave, int lane) {
    const int n = item / 24, bh = item - n * 24, hh = bh % MB_H, b = bh / MB_H;
    LAS unsigned* Ks = (LAS unsigned*)(lds + AT_KS); LAS unsigned* Vs32 = (LAS unsigned*)(lds + AT_VS);
    LAS float* qst = (LAS float*)(lds + AT_WV + wave * AT_WVB); LAS float* pb = qst + 256;
    for (int i = 0; i < 16; ++i) { const int idx = tid + 512 * i, r = idx >> 5, dd = idx & 31; const unsigned* src = (const unsigned*)(h + ((size_t)b * SEQ + n * 256 + r) * NC_M + hh * 64);
        Ks[r * 33 + dd] = src[384 + dd]; Vs32[r * 32 + dd] = src[768 + dd]; }
    __syncthreads();
    const int cnt = (int)gcount[bh * 64 + n], total = 256 + cnt, nquads = (total + 3) >> 2;
    const float slope = hh < 8 ? ldexpf(1.0f, -(hh + 1)) : ldexpf(0.70710678118654752f, -(hh - 8));
    const unsigned* lp = list + (((size_t)bh * 64 + n) << 14);
    for (int quad = wave; quad < nquads; quad += 8) {
        int tq[4], slot[4];
#pragma unroll
        for (int qi = 0; qi < 4; ++qi) { int idx = quad * 4 + qi; idx = idx < total ? idx : total - 1;
            if (idx < 256) { tq[qi] = n * 256 + idx; slot[qi] = 3; } else { const unsigned e = lp[idx - 256]; tq[qi] = (int)(e & 16383u); slot[qi] = (int)(e >> 14); } }
#pragma unroll
        for (int qi = 0; qi < 4; ++qi) qst[qi * 64 + lane] = bf2f(h[((size_t)b * SEQ + tq[qi]) * NC_M + hh * 64 + lane]);
        float m[4], l[4], o[4];
        attn4<true>(Ks, (const LAS bf16*)Vs32, qst, pb, lane, tq, n * 256, slope, m, l, o);
#pragma unroll
        for (int qi = 0; qi < 4; ++qi) if (quad * 4 + qi < total) { const size_t pi = (((size_t)b * SEQ + tq[qi]) * MB_H + hh) * 4 + slot[qi];
            po[pi * 64 + lane] = o[qi]; if (lane == 0) { pml[pi * 2] = m[qi]; pml[pi * 2 + 1] = l[qi]; } }
    }
    __syncthreads();
}

__device__ __forceinline__ void moba_attn_item2(LAS unsigned char* lds, const bf16* h, const float* kmaxg, const unsigned* gcount, const unsigned* list, bf16* po, float* pml, int item, int tid, int wave, int lane) {
    const int n = item / 24, bh = item - n * 24, hh = bh % MB_H, b = bh / MB_H, r = lane & 31, hf = lane >> 5;
    const bf16* hrow0 = h + ((size_t)b * SEQ + n * 256) * NC_M + hh * 64;
    stage_kv_images(lds, hrow0 + 768, hrow0 + 1536, NC_M, tid);
    __syncthreads();
    const int cnt = (int)gcount[bh * 64 + n], total = 256 + cnt, ntiles = (total + 31) >> 5;
    const float slope2 = (hh < 8 ? ldexpf(1.0f, -(hh + 1)) : ldexpf(0.70710678118654752f, -(hh - 8))) * 1.4426950408889634f;
    const unsigned shi = f2bf(slope2), slo = f2bf(slope2 - __builtin_bit_cast(float, shi << 16)); const unsigned qx = hf == 0 ? (shi | (slo << 16)) : 0u;
    const unsigned* lp = list + (((size_t)bh * 64 + n) << 14);
    const float kmx1 = kmaxg[bh * 64 + n];
    const bf16* hq = h + (size_t)b * SEQ * NC_M + hh * 64 + 8 * hf;
#pragma unroll 1
    for (int tile = wave; tile < ntiles; tile += NWAVES) {
        int idx = tile * 32 + r; const bool valid = idx < total; idx = valid ? idx : total - 1;
        int tq, slot; if (idx < 256) { tq = n * 256 + idx; slot = 3; } else { const unsigned e = lp[idx - 256]; tq = (int)(e & 16383u); slot = (int)(e >> 14); }
        s16x8 qf[4]; { const bf16* qp = hq + (size_t)tq * NC_M;
#pragma unroll
            for (int s = 0; s < 4; ++s) qf[s] = *(const s16x8*)(qp + 16 * s); }
        f32x16 o[2]; float m2, l; const float dist0 = (float)(tq - n * 256);
        unsigned qx2;
        { float qq = 0.f;
#pragma unroll
          for (int s = 0; s < 4; ++s)
#pragma unroll
              for (int jj = 0; jj < 8; ++jj) { const float qv = bf2f((bf16)qf[s][jj]); qq += qv * qv; }
          qq += xor32f(qq, lane);
          const float sh = sqrtf(qq) * kmx1 + slope2 * fminf(dist0, 255.f);
          const unsigned nh = f2bf(-sh), nl = f2bf(-sh - __builtin_bit_cast(float, nh << 16)); qx2 = hf == 0 ? (nh | (nl << 16)) : 0u;
          m2 = -(__builtin_bit_cast(float, nh << 16) + __builtin_bit_cast(float, nl << 16)); }
        attn_tile32<true>(lds, qf, lane, dist0, qx, qx2, tile < 8, o, m2, l);
        { LAS unsigned char* sw = lds + AT2_SCR + wave * AT2_SCRW; const int pi = valid ? (int)((((size_t)b * SEQ + tq) * MB_H + hh) * 4 + slot) : -1;
#pragma unroll
          for (int dt = 0; dt < 2; ++dt)
#pragma unroll
              for (int g = 0; g < 4; ++g) { v2u w; w.x = cvtpk(o[dt][4 * g], o[dt][4 * g + 1]); w.y = cvtpk(o[dt][4 * g + 2], o[dt][4 * g + 3]); *(LAS v2u*)(sw + r * 144 + (32 * dt + 8 * g + 4 * hf) * 2) = w; }
          if (hf == 0) { *(LAS int*)(sw + 4608 + 4 * r) = pi; if (valid) { pml[(size_t)pi * 2] = m2 - slope2 * dist0; pml[(size_t)pi * 2 + 1] = l; } }
#pragma unroll
          for (int it = 0; it < 4; ++it) { const int q = 8 * it + (lane >> 3), c = lane & 7; const int pq = *(const LAS int*)(sw + 4608 + 4 * q); const v4u row = *(const LAS v4u*)(sw + q * 144 + c * 16);
              if (pq >= 0) *(v4u*)(po + (size_t)pq * 64 + c * 8) = row; } }
    }
    __syncthreads();
}
__device__ __forceinline__ void moba_combine(const bf16* __restrict__ po, const float* __restrict__ pml, const int* __restrict__ selinfo, bf16* __restrict__ mix, int gw, int ngw, int lane) {
    const int sub = lane >> 4, d4 = (lane & 15) * 4;
#pragma unroll 8
    for (int idx = gw * 4 + sub; idx < T * MB_H; idx += ngw * 4) { const int tg = idx / MB_H, hh = idx - tg * MB_H, ns = selinfo[idx]; const size_t p4 = (size_t)idx * 4;
        f32x2 ml[4]; f32x4 ov[4];
#pragma unroll
        for (int j = 0; j < 4; ++j) { const size_t pj = p4 + ((j == 3 || ((ns >> j) & 1)) ? j : 3);
            ml[j] = ((const f32x2*)pml)[pj]; const v2u ow = *(const v2u*)(po + pj * 64 + d4); ov[j] = (f32x4){bflo(ow.x), bfhi(ow.x), bflo(ow.y), bfhi(ow.y)}; }
        float M = ml[3].x;
#pragma unroll
        for (int j = 0; j < 3; ++j) { const bool ok = (ns >> j) & 1; ml[j].x = ok ? ml[j].x : -INFINITY; ml[j].y = ok ? ml[j].y : 0.f; M = fmaxf(M, ml[j].x);
            ov[j].x = ok ? ov[j].x : 0.f; ov[j].y = ok ? ov[j].y : 0.f; ov[j].z = ok ? ov[j].z : 0.f; ov[j].w = ok ? ov[j].w : 0.f; }
        float den = 0.f; f32x4 num = {0.f, 0.f, 0.f, 0.f};
#pragma unroll
        for (int j = 0; j < 4; ++j) { const float w = __builtin_amdgcn_exp2f(ml[j].x - M); den += w * ml[j].y; num += ov[j] * w; }
        const float inv = 1.f / den; v2u o; o.x = pk2(num.x * inv, num.y * inv); o.y = pk2(num.z * inv, num.w * inv);
        *(v2u*)(mix + (size_t)tg * 1024 + hh * 64 + d4) = o; }
}

template <int CTRL> __device__ __forceinline__ float dppf(float v) { return __builtin_bit_cast(float, __builtin_amdgcn_update_dpp(0, __builtin_bit_cast(int, v), CTRL, 0xF, 0xF, true)); }
template <int CTRL> __device__ __forceinline__ int dppi(int v) { return __builtin_amdgcn_update_dpp(0, v, CTRL, 0xF, 0xF, true); }
__device__ __forceinline__ float wave_sum_dpp(float v) {
    v += dppf<0xB1>(v); v += dppf<0x4E>(v); v += dppf<0x141>(v); v += dppf<0x140>(v);
    v += __builtin_bit_cast(float, __builtin_amdgcn_update_dpp(0, __builtin_bit_cast(int, v), 0x142, 0xA, 0xF, false));
    v += __builtin_bit_cast(float, __builtin_amdgcn_update_dpp(0, __builtin_bit_cast(int, v), 0x143, 0xC, 0xF, false));
    return __builtin_bit_cast(float, __builtin_amdgcn_readlane(__builtin_bit_cast(int, v), 63));
}
__device__ __forceinline__ void ln_row(f32x4 (&v)[4], const f32x4 (&gv)[4], const f32x4 (&bv)[4]) {
    float s = 0.f;
#pragma unroll
    for (int j = 0; j < 4; ++j) s += (v[j].x + v[j].y) + (v[j].z + v[j].w);
    const float mean = wave_sum_dpp(s) * (1.f / D); float s2 = 0.f;
#pragma unroll
    for (int j = 0; j < 4; ++j) { v[j] = v[j] - mean; s2 += (v[j].x * v[j].x + v[j].y * v[j].y) + (v[j].z * v[j].z + v[j].w * v[j].w); }
    const float rstd = __builtin_amdgcn_rsqf(wave_sum_dpp(s2) * (1.f / D) + 1e-5f);
#pragma unroll
    for (int j = 0; j < 4; ++j) v[j] = v[j] * rstd * gv[j] + bv[j];
}
__device__ __forceinline__ void split_router_weights(const float* wr  , bf16* wrs  , size_t gtid, size_t gthreads) {
    for (size_t i = gtid; i < (size_t)DEPTH * D * NE; i += gthreads) { const int e = (int)(i & 31), d = (int)((i >> 5) & 1023), l = (int)(i >> 15);
        const float w = wr[i]; const unsigned hi = f2bf(w); const unsigned lo = f2bf(w - __builtin_bit_cast(float, hi << 16));
        wrs[(((size_t)l * 2 + 0) * NE + e) * D + d] = (bf16)hi; wrs[(((size_t)l * 2 + 1) * NE + e) * D + d] = (bf16)lo; }
}
constexpr int L1_XH = 0, L1_XL = 33024, L1_ROW = 2064, L1_PART = 66048, L1_HIST = 82432, L1_TOK = 82944;
__device__ __forceinline__ void phase_ln1(LAS unsigned char* lds, const bf16* y, const float* g, const float* bb, const bf16* wrs  , const float* br,
                                          bf16* xbf, unsigned char* x8, int* tok_e, int* tok_lr, float* tok_w, int* blk_cnt, int blk, int tid, int wave, int lane) {
    LAS float* part = (LAS float*)(lds + L1_PART);
    LAS int* hist = (LAS int*)(lds + L1_HIST); LAS int* tokl = (LAS int*)(lds + L1_TOK);
    if (tid < 32) hist[tid] = 0;
    constexpr int TPB = T / GRID;
    const int e = lane & 31, m16 = lane & 15, quad = lane >> 4;
    s16x8 bw[4][2][2];
#pragma unroll
    for (int ks = 0; ks < 4; ++ks)
#pragma unroll
        for (int nt = 0; nt < 2; ++nt)
#pragma unroll
            for (int pp = 0; pp < 2; ++pp) bw[ks][nt][pp] = *(const s16x8*)(wrs + ((size_t)pp * NE + 16 * nt + m16) * D + wave * 128 + 32 * ks + 8 * quad);
    const float bre = br[e];
    f32x4 gv[4], bv[4];
#pragma unroll
    for (int j = 0; j < 4; ++j) { gv[j] = ((const f32x4*)g)[lane + 64 * j]; bv[j] = ((const f32x4*)bb)[lane + 64 * j]; }
    v2u xn[2][4], yn[2][4];
#pragma unroll
    for (int u = 0; u < 2; ++u) { const size_t t0 = (size_t)blk * TPB + 2 * wave + u; const v2u* xr = (const v2u*)(xbf + t0 * D) + lane; const v2u* yr = (const v2u*)(y + t0 * D) + lane;
#pragma unroll
        for (int j = 0; j < 4; ++j) { xn[u][j] = xr[64 * j]; yn[u][j] = yr[64 * j]; } }
#pragma unroll
    for (int j = 0; j < 4; ++j) asm volatile("" :: "v"(gv[j]), "v"(bv[j]), "v"(xn[0][j]), "v"(xn[1][j]), "v"(yn[0][j]), "v"(yn[1][j]));
#pragma unroll
    for (int ks = 0; ks < 4; ++ks) asm volatile("" :: "v"(bw[ks][0][0]), "v"(bw[ks][0][1]), "v"(bw[ks][1][0]), "v"(bw[ks][1][1]));
    asm volatile("" :: "v"(bre));
    __syncthreads();
    for (int grp = 0; grp < TPB / 16; ++grp) { const size_t tg0 = (size_t)blk * TPB + grp * 16 + 2 * wave;
        f32x4 v[2][4];
#pragma unroll
        for (int u = 0; u < 2; ++u)
#pragma unroll
            for (int j = 0; j < 4; ++j) { const v2u xw = xn[u][j]; const v2u yw = yn[u][j];
                v[u][j].x = DN_ALPHA * bflo(xw.x) + bflo(yw.x); v[u][j].y = DN_ALPHA * bfhi(xw.x) + bfhi(yw.x); v[u][j].z = DN_ALPHA * bflo(xw.y) + bflo(yw.y); v[u][j].w = DN_ALPHA * bfhi(xw.y) + bfhi(yw.y); }
        if (grp + 1 < TPB / 16) {
#pragma unroll
            for (int u = 0; u < 2; ++u) { const v2u* xr = (const v2u*)(xbf + (tg0 + 16 + u) * D) + lane; const v2u* yr = (const v2u*)(y + (tg0 + 16 + u) * D) + lane;
#pragma unroll
                for (int j = 0; j < 4; ++j) { xn[u][j] = xr[64 * j]; yn[u][j] = yr[64 * j]; } } }
#pragma unroll
        for (int u = 0; u < 2; ++u) { ln_row(v[u], gv, bv);
            v2u* xb = (v2u*)(xbf + (tg0 + u) * D) + lane; unsigned* x8r = (unsigned*)(x8 + (tg0 + u) * D) + lane;
#pragma unroll
            for (int j = 0; j < 4; ++j) { v2u hw; hw.x = cvtpk(v[u][j].x, v[u][j].y); hw.y = cvtpk(v[u][j].z, v[u][j].w); xb[64 * j] = hw;
                x8r[64 * j] = pk4_fp8(bflo(hw.x), bfhi(hw.x), bflo(hw.y), bfhi(hw.y));
                v2u lw; lw.x = cvtpk(v[u][j].x - bflo(hw.x), v[u][j].y - bfhi(hw.x)); lw.y = cvtpk(v[u][j].z - bflo(hw.y), v[u][j].w - bfhi(hw.y));
                *(LAS v2u*)(lds + L1_XH + (2 * wave + u) * L1_ROW + (4 * lane + 256 * j) * 2) = hw; *(LAS v2u*)(lds + L1_XL + (2 * wave + u) * L1_ROW + (4 * lane + 256 * j) * 2) = lw; } }
        __syncthreads();
        { f32x4 acc[2] = {{0.f, 0.f, 0.f, 0.f}, {0.f, 0.f, 0.f, 0.f}};
#pragma unroll
          for (int ks = 0; ks < 4; ++ks) { const int off = m16 * L1_ROW + (wave * 128 + 32 * ks + 8 * quad) * 2;
              const s16x8 ah = *(const LAS s16x8*)(lds + L1_XH + off), al = *(const LAS s16x8*)(lds + L1_XL + off);
#pragma unroll
              for (int nt = 0; nt < 2; ++nt) { acc[nt] = __builtin_amdgcn_mfma_f32_16x16x32_bf16(ah, bw[ks][nt][0], acc[nt], 0, 0, 0); acc[nt] = __builtin_amdgcn_mfma_f32_16x16x32_bf16(ah, bw[ks][nt][1], acc[nt], 0, 0, 0);
                  acc[nt] = __builtin_amdgcn_mfma_f32_16x16x32_bf16(al, bw[ks][nt][0], acc[nt], 0, 0, 0); } }
#pragma unroll
          for (int nt = 0; nt < 2; ++nt)
#pragma unroll
              for (int jj = 0; jj < 4; ++jj) part[(wave * 16 + 4 * quad + jj) * 32 + 16 * nt + m16] = acc[nt][jj]; }
        __syncthreads();
#pragma unroll
        for (int u = 0; u < 2; ++u) { const size_t t = tg0 + u;
            float logit = bre;
#pragma unroll
            for (int w = 0; w < 8; ++w) logit += part[(w * 16 + 2 * wave + u) * 32 + e];
            int se[4]; float sv[4]; int cur = __builtin_bit_cast(int, logit); cur ^= (cur >> 31) & 0x7fffffff;
#pragma unroll
            for (int k = 0; k < 4; ++k) { int m = cur;
                m = max(m, dppi<0xB1>(m)); m = max(m, dppi<0x4E>(m)); m = max(m, dppi<0x141>(m)); m = max(m, dppi<0x140>(m));
                const int mm = max(__builtin_amdgcn_readlane(m, 0), __builtin_amdgcn_readlane(m, 16));
                const unsigned long long mk = __ballot(cur == mm); const int src = __builtin_ctzll(mk);
                se[k] = src; sv[k] = __builtin_bit_cast(float, mm ^ ((mm >> 31) & 0x7fffffff)); cur = (e == src) ? (int)0x80000000 : cur; }
            const float e1 = __expf(sv[1] - sv[0]), e2 = __expf(sv[2] - sv[0]), e3 = __expf(sv[3] - sv[0]), inv = __builtin_amdgcn_rcpf(1.f + e1 + e2 + e3);
            const float wk[4] = {inv, e1 * inv, e2 * inv, e3 * inv};
            if (lane == 0) { const int tl = (grp * 16 + 2 * wave + u) * 4;
#pragma unroll
                for (int k = 0; k < 4; ++k) { const int lr = __hip_atomic_fetch_add(hist + se[k], 1, __ATOMIC_RELAXED, __HIP_MEMORY_SCOPE_WORKGROUP);
                    tokl[tl + k] = se[k]; tokl[512 + tl + k] = lr; tokl[1024 + tl + k] = __builtin_bit_cast(int, wk[k]); } } }
    }
    __syncthreads();
    if (tid < 32) blk_cnt[blk * 32 + tid] = hist[tid];
    { const size_t ti = (size_t)blk * TPB * 4 + tid; tok_e[ti] = tokl[tid]; tok_lr[ti] = tokl[512 + tid]; tok_w[ti] = __builtin_bit_cast(float, tokl[1024 + tid]); }
    __syncthreads();
}
__device__ __forceinline__ void phase_dispatch(LAS unsigned char* lds, const int* __restrict__ blk_cnt, const int* __restrict__ tok_e, const int* __restrict__ tok_lr, int* __restrict__ tok_row, int* __restrict__ tab,
                                               int* __restrict__ rowtok, int blk, int tid, int wave, int lane) {
    LAS int* tot = (LAS int*)lds; LAS int* pre = tot + 32; LAS int* pst = pre + 32; LAS int* rows = pst + 64;
    LAS int* red = rows + 512;
    static_assert(GRID == 256 && NTHR == 512, "16 thread groups x 16 blocks");
    { const int e = tid & 31, part = tid >> 5; int s = 0, p = 0;
#pragma unroll
      for (int i = 0; i < 16; ++i) { const int bb = part * 16 + i; const int c = blk_cnt[bb * 32 + e]; s += c; p += (bb < blk) ? c : 0; }
      red[part * 32 + e] = s; red[512 + part * 32 + e] = p; }
    __syncthreads();
    if (tid < 32) { int s = 0, p = 0;
#pragma unroll
        for (int q = 0; q < 16; ++q) { s += red[q * 32 + tid]; p += red[512 + q * 32 + tid]; }
        tot[tid] = s; pre[tid] = p; }
    __syncthreads();
    if (tid == 0) { int acc = 0; for (int e = 0; e < 32; ++e) { pst[e] = acc; acc += ((tot[e] + 255) >> 8) << 8; } pst[32] = acc; }
    __syncthreads();
    if (blk == 0 && tid < 33) tab[tid] = pst[tid] >> 8;
    constexpr int TPB = T / GRID;
    static_assert(TPB * 4 == NTHR, "one (token, k) pair per thread");
    { const size_t ti = (size_t)blk * TPB * 4 + tid; const int e = tok_e[ti]; const int r = pst[e] + pre[e] + tok_lr[ti]; tok_row[ti] = r; rowtok[r] = blk * TPB + (tid >> 2); }
    if (blk < NE) { const int r0 = pst[blk] + tot[blk], npad = pst[blk + 1] - r0; if (tid < npad) rowtok[r0 + tid] = 0; }
    __syncthreads();
}
__device__ __forceinline__ f32x4 fp8x4_to_f32(unsigned w) {
    const f32x2 lo = __builtin_amdgcn_cvt_pk_f32_fp8((int)w, false), hi = __builtin_amdgcn_cvt_pk_f32_fp8((int)w, true); return (f32x4){lo.x, lo.y, hi.x, hi.y};
}
__device__ __forceinline__ void phase_ln2(const unsigned char* __restrict__ yrows, const int* __restrict__ tok_row, const float* __restrict__ tok_w, const float* __restrict__ g, const float* __restrict__ bb,
                                          float* __restrict__ xout, bf16* xbf, int gw, int ngw, int lane) {
    f32x4 gv[4], bv[4];
#pragma unroll
    for (int j = 0; j < 4; ++j) { gv[j] = ((const f32x4*)g)[lane + 64 * j]; bv[j] = ((const f32x4*)bb)[lane + 64 * j]; }
    constexpr int NTK = 2;
    static_assert(T % (NTK * GRID * NWAVES) == 0, "NTK tokens per wave per step");
    for (int t0 = gw; t0 < T; t0 += NTK * ngw) {
        f32x4 v[NTK][4];
#pragma unroll
        for (int u = 0; u < NTK; ++u) { const int t = t0 + u * ngw; int r[4]; float w[4];
#pragma unroll
            for (int k = 0; k < 4; ++k) { r[k] = tok_row[(size_t)t * 4 + k]; w[k] = tok_w[(size_t)t * 4 + k] * (1.f / 16.f); }
            const v2u* xr = (const v2u*)(xbf + (size_t)t * D) + lane;
#pragma unroll
            for (int j = 0; j < 4; ++j) { f32x4 f = {0.f, 0.f, 0.f, 0.f};
#pragma unroll
                for (int k = 0; k < 4; ++k) { const unsigned yw = ((const unsigned*)(yrows + (size_t)r[k] * D))[lane + 64 * j]; f += fp8x4_to_f32(yw) * w[k]; }
                const v2u xw = xr[64 * j]; v[u][j].x = DN_ALPHA * bflo(xw.x) + f.x; v[u][j].y = DN_ALPHA * bfhi(xw.x) + f.y; v[u][j].z = DN_ALPHA * bflo(xw.y) + f.z; v[u][j].w = DN_ALPHA * bfhi(xw.y) + f.w; } }
#pragma unroll
        for (int u = 0; u < NTK; ++u) { const int t = t0 + u * ngw;
            ln_row(v[u], gv, bv);
            if (xout) { f32x4* xo = (f32x4*)(xout + (size_t)t * D) + lane;
#pragma unroll
                for (int j = 0; j < 4; ++j) xo[64 * j] = v[u][j]; }
            else { v2u* xb = (v2u*)(xbf + (size_t)t * D) + lane;
#pragma unroll
                for (int j = 0; j < 4; ++j) { v2u ww; ww.x = pk2(v[u][j].x, v[u][j].y); ww.y = pk2(v[u][j].z, v[u][j].w); xb[64 * j] = ww; } } } }
}


struct Args { const float* in[20]; float* out; unsigned char* ws; int l_lo, l_hi, ph_lo, ph_hi; };
typedef const __attribute__((address_space(4))) Args* KArgsP;
#define KA_LOAD() ({ KArgsP p_ = (KArgsP)__builtin_amdgcn_kernarg_segment_ptr(); asm volatile("" : "+s"(p_)); p_; })
#ifndef PHMASK
#define PHMASK 0xFFFF
#endif
#ifndef REPEAT_MASK
#define REPEAT_MASK 0
#endif
#ifndef REPEAT_LMASK
#define REPEAT_LMASK 0xF
#endif
#define PH_BEGIN(k) _Pragma("unroll") for (int rep_ = 0; rep_ < ((((REPEAT_MASK >> (k)) & 1) && ((REPEAT_LMASK >> l) & 1)) ? 2 : 1); ++rep_) { if ((PHMASK >> (k)) & 1) { KArgsP ka = KA_LOAD(); unsigned char* ws = ka->ws; int tid = threadIdx.x; asm volatile("" : "+v"(tid)); \
    const int lane = tid & 63, wave = __builtin_amdgcn_readfirstlane(tid >> 6); int blk = blockIdx.x; asm volatile("" : "+s"(blk)); \
    const int gw = blk * NWAVES + wave; const size_t gtid = (size_t)blk * NTHR + tid; (void)lane; (void)gw; (void)gtid; (void)ws;
#if ONE_LAUNCH
#define PH_SEAM() do { XcdBarrier b_; b_.bar = (unsigned*)(KA_LOAD()->ws + WS_CTL) + CW_BAR; b_.x = xb_xcc_id(); b_.st = (volatile LAS unsigned*)(lds + MISC_OFF); xcd_barrier(b_); } while (0)
#else
#define PH_SEAM() do {} while (0)
#endif
#define PH_END() PH_SEAM(); } }
#define PH_END_NOSEAM() } }
#define WSP(type, off) ((type*)(ws + (off)))
constexpr int G = GRID, NGW = GRID * NWAVES; constexpr size_t GTHREADS = (size_t)GRID * NTHR;
template <int L> __device__ __forceinline__ void layer_phases(LAS unsigned char* lds) {
    constexpr int l = L; LAS int* tabL = (LAS int*)(lds + MISC_OFF + 256);

        const int j = l >> 1; const bool moba = (l & 1) != 0;
        const int NC = moba ? NC_M : NC_H, qoff = moba ? 2304 : 3072;

        if (l == 0) {
        PH_BEGIN(1)
            phase_weights((LAS float*)(lds + wave * 16384), gw, NGW, lane, ka->in[2], NC_H, ka->in[6], 4, ka->in[7], ka->in[12], ka->in[14], ka->in[16], WSP(bf16, WS_WIN), WSP(bf16, WS_WKV4), WSP(bf16, WS_WO), WSP(bf16, WS_WGU), WSP(bf16, WS_WD), 1);
        PH_END()
        }
        PH_BEGIN(2)
            { pg8::Gemm g{WSP(bf16, WS_XBF), WSP(bf16, WS_WIN), T, NC, D, 0, 0}; pg8::StaticOrder S; S.init(T, NC, G, blk); pg8::EpiPlain E{WSP(bf16, WS_H), NC, moba ? 0x207u : 0x1000u, 0.125f * 1.4426950408889634f};
              pg8::gemm_phase<pg8::EpiPlain, pg8::StaticOrder, true, true>(lds, g, S, E); }
            if (l == 0) {
              pg8::Gemm g{WSP(bf16, WS_MEMBF), WSP(bf16, WS_WKV4), 512, 2048, D, 0, 0}; pg8::StaticOrder S; S.init(512, 2048, G, blk >= 128 ? blk - 128 : G); pg8::EpiPlain E{WSP(bf16, WS_KV4), 2048, 0u, 1.f};
              pg8::gemm_phase<pg8::EpiPlain, pg8::StaticOrder, true, true>(lds, g, S, E); }
        PH_END()
        if (!moba) {
            PH_BEGIN(3)
                for (int u = blk; u < NBATCH * HG_H * HNSEG; u += G) hgrn_mfma<false>(lds, WSP(bf16, WS_H), ka->in[3], j, ka->in[4] + j * 128, WSP(float, WS_SLOC), WSP(float, WS_DSEG), WSP(bf16, WS_MIX), u, tid, wave, lane);
                for (int u = blk; u < 512; u += G) memattn_unit2(lds, WSP(bf16, WS_H), NC, qoff, WSP(bf16, WS_KV4) + 512 * l, WSP(bf16, WS_MIX), u, tid, wave, lane);
            PH_END()
            PH_BEGIN(4)
                hgrn_scan(WSP(float, WS_SLOC), WSP(float, WS_DSEG), gtid, GTHREADS);
            PH_END()
            PH_BEGIN(5)
                for (int u = blk; u < NBATCH * HG_H * HNSEG; u += G) hgrn_mfma<true>(lds, WSP(bf16, WS_H), ka->in[3], j, ka->in[4] + j * 128, WSP(float, WS_SLOC), WSP(float, WS_DSEG), WSP(bf16, WS_MIX), u, tid, wave, lane);
            PH_END()
        } else {
            PH_BEGIN(3)
                for (int u = blk; u < 24 * MB_NB; u += G) kmean_unit(lds, WSP(bf16, WS_H), WSP(float, WS_KMEAN), WSP(float, WS_KMEAN + 512 * 1024), u, tid, wave);
                for (int u = blk; u < 512; u += G) memattn_unit2(lds, WSP(bf16, WS_H), NC, qoff, WSP(bf16, WS_KV4) + 512 * l, WSP(bf16, WS_MIX), u, tid, wave, lane);
            PH_END()
            PH_BEGIN(4)
                moba_gate_wg(lds, WSP(bf16, WS_H), WSP(float, WS_KMEAN), WSP(float, WS_KMEAN + 512 * 1024), WSP(unsigned, WS_CTL) + CW_GCOUNT + j * 1536, WSP(int, WS_SELINFO), WSP(unsigned, WS_LIST), blk, tid);
            PH_END()
            PH_BEGIN(5)
                { unsigned* qhead = WSP(unsigned, WS_CTL) + CW_GCOUNT + 2 * 1536 + 64 * j; LAS int* itl = (LAS int*)(lds + MISC_OFF + 512);
                  for (;;) { if (tid == 0) *itl = (int)__hip_atomic_fetch_add(qhead, 1u, __ATOMIC_RELAXED, __HIP_MEMORY_SCOPE_AGENT);
                      __syncthreads(); const int it = *itl; __syncthreads();
                      if (it >= 24 * MB_NB) break;
                      moba_attn_item2(lds, WSP(bf16, WS_H), WSP(float, WS_KMEAN + 512 * 1024), WSP(unsigned, WS_CTL) + CW_GCOUNT + j * 1536, WSP(unsigned, WS_LIST), WSP(bf16, WS_PO), WSP(float, WS_PML), it, tid, wave, lane); } }
            PH_END()
            PH_BEGIN(6)
                moba_combine(WSP(bf16, WS_PO), WSP(float, WS_PML), WSP(int, WS_SELINFO), WSP(bf16, WS_MIX), gw, NGW, lane);
            PH_END()
        }
        PH_BEGIN(7)
            pg8::Gemm g{WSP(bf16, WS_MIX), WSP(bf16, WS_WO), T, D, D, 0, 0, nullptr}; pg8::StaticOrder S; S.init(T, D, G, blk); pg8::EpiPlain E{WSP(bf16, WS_Y), D, 0u, 1.f};
            pg8::gemm_phase<pg8::EpiPlain, pg8::StaticOrder, true, true>(lds, g, S, E);
        PH_END()
        PH_BEGIN(8)
            phase_ln1(lds, WSP(bf16, WS_Y), ka->in[8] + l * D, ka->in[9] + l * D, WSP(bf16, WS_WRS) + (size_t)l * 2 * NE * D, ka->in[11] + l * NE, WSP(bf16, WS_XBF), WSP(unsigned char, WS_H),
                      WSP(int, WS_TOK + TOK_E), WSP(int, WS_TOK + TOK_LR), WSP(float, WS_TOK + TOK_W), WSP(int, WS_TOK + TOK_BLKCNT), blk, tid, wave, lane);
        PH_END()
        PH_BEGIN(9)
            phase_dispatch(lds, WSP(int, WS_TOK + TOK_BLKCNT), WSP(int, WS_TOK + TOK_E), WSP(int, WS_TOK + TOK_LR), WSP(int, WS_TOK + TOK_ROW), WSP(int, WS_TOK + TOK_TAB), WSP(int, WS_H + 64 * MiB), blk, tid, wave, lane);
            { const size_t moff = (size_t)l * NE * 1024 * 1024;
              phase_weights((LAS float*)(lds + wave * 16384), gw, NGW, lane, ka->in[2], NC_H, ka->in[6], 0, ka->in[7], ka->in[12] + moff, ka->in[14] + moff, ka->in[16] + moff,
                            WSP(bf16, WS_WIN), WSP(bf16, WS_WKV4), WSP(bf16, WS_WO), WSP(bf16, WS_WGU), WSP(bf16, WS_WD), 2); }
        PH_END()
        PH_BEGIN(10)
            if (tid < 33) tabL[tid] = WSP(int, WS_TOK + TOK_TAB)[tid];
            __syncthreads();
            int sw_ = 0x7A7A7A7A, sx_ = 0x7F7F7F7F; asm volatile("" : "+s"(sw_), "+s"(sx_));
            pg8::Gemm g{WSP(bf16, WS_H), WSP(bf16, WS_WGU), MOE_MAXROWS, NE * 2048, D / 2, sw_, sx_, WSP(int, WS_H + 64 * MiB)};   pg8::MoeOrder S{tabL, 8, G, blk, tabL[32] * 8, false};
            pg8::EpiSwiglu E{WSP(unsigned char, WS_HID), ka->in[13] + (size_t)l * NE * 1024, ka->in[15] + (size_t)l * NE * 1024};
            pg8::gemm_phase<pg8::EpiSwiglu, pg8::MoeOrder, true, true, true, true>(lds, g, S, E);
        PH_END()
        PH_BEGIN(11)
            if (tid < 33) tabL[tid] = WSP(int, WS_TOK + TOK_TAB)[tid];
            __syncthreads();
            int sw_ = 0x79797979, sx_ = 0x83838383; asm volatile("" : "+s"(sw_), "+s"(sx_));
            pg8::Gemm g{WSP(bf16, WS_HID), WSP(bf16, WS_WD), MOE_MAXROWS, NE * 1024, D / 2, sw_, sx_, nullptr}; pg8::MoeOrder S{tabL, 4, G, blk, tabL[32] * 4, true};
            pg8::EpiDown E{WSP(unsigned char, WS_XS), ka->in[17] + (size_t)l * NE * 1024};
            pg8::gemm_phase<pg8::EpiDown, pg8::MoeOrder, true, true, true>(lds, g, S, E);
        PH_END()
        PH_BEGIN(12)
            float* x2out = (l == DEPTH - 1) ? ka->out : nullptr;
            phase_ln2(WSP(unsigned char, WS_XS), WSP(int, WS_TOK + TOK_ROW), WSP(float, WS_TOK + TOK_W), ka->in[18] + l * D, ka->in[19] + l * D, x2out, WSP(bf16, WS_XBF), gw, NGW, lane);
            if (l + 1 < DEPTH) { constexpr int ln = l + 1, jn = ln >> 1; constexpr bool mn = (ln & 1) != 0;
                const float* win_src = mn ? ka->in[5] + (size_t)jn * D * NC_M : ka->in[2] + (size_t)jn * D * NC_H; const size_t moff = (size_t)ln * NE * 1024 * 1024;
                phase_weights((LAS float*)(lds + wave * 16384), gw, NGW, lane, win_src, mn ? NC_M : NC_H, ka->in[6], 0, ka->in[7] + (size_t)ln * D * D,
                              ka->in[12] + moff, ka->in[14] + moff, ka->in[16] + moff, WSP(bf16, WS_WIN), WSP(bf16, WS_WKV4), WSP(bf16, WS_WO), WSP(bf16, WS_WGU), WSP(bf16, WS_WD), 1); }
            if (l + 1 < DEPTH) PH_SEAM();
        PH_END_NOSEAM()
}
__global__ void __launch_bounds__(NTHR, 2) fwd_kernel(Args args) {
    extern __shared__ __attribute__((aligned(16))) unsigned char lds_raw[];
    LAS unsigned char* lds = (LAS unsigned char*)lds_raw;
    if (threadIdx.x < 4) ((LAS unsigned*)(lds + MISC_OFF))[threadIdx.x] = 0u;
    __syncthreads();
#if ONE_LAUNCH
    (void)xcd_barrier_post((unsigned*)(args.ws + WS_CTL) + CW_BAR, (volatile LAS unsigned*)(lds + MISC_OFF));
#endif
    { const int l = 0; (void)l;
    PH_BEGIN(0)
        cvt_rows_bf16(ka->in[0], WSP(bf16, WS_XBF), (size_t)T * D / 8, gtid, GTHREADS);
        cvt_rows_bf16(ka->in[1], WSP(bf16, WS_MEMBF), (size_t)512 * D / 8, gtid, GTHREADS);
        split_router_weights(ka->in[10], WSP(bf16, WS_WRS), gtid, GTHREADS);
    PH_END_NOSEAM() }
    layer_phases<0>(lds); layer_phases<1>(lds); layer_phases<2>(lds); layer_phases<3>(lds);
}

extern "C" void kernel_launch(void* const* d_in, const int* in_sizes, int n_in, void* d_out, int out_size, void* d_ws, size_t ws_size, hipStream_t stream) {
    static int ready = 0;
    if (ready == 0) {
        if (n_in != 20 || in_sizes[0] != T * D || out_size != T * D || ws_size < WS_END) { fprintf(stderr, "kernel_launch: unexpected shapes (n_in %d, in0 %d, out %d, ws %zu < %zu)\n", n_in, n_in > 0 ? in_sizes[0] : -1, out_size, ws_size, (size_t)WS_END); ready = -1; return; }
        if (hipFuncSetAttribute((const void*)fwd_kernel, hipFuncAttributeMaxDynamicSharedMemorySize, LDS_BYTES) != hipSuccess) { fprintf(stderr, "kernel_launch: hipFuncSetAttribute failed\n"); ready = -1; return; }
        int per_cu = 0;
        if (hipOccupancyMaxActiveBlocksPerMultiprocessor(&per_cu, (const void*)fwd_kernel, NTHR, LDS_BYTES) != hipSuccess || per_cu < 1) fprintf(stderr, "kernel_launch: occupancy query says %d\n", per_cu);
        (void)hipGetLastError();
        ready = 1;
    }
    if (ready < 0) return;
    if (hipMemsetAsync((char*)d_ws + WS_CTL, 0, CTL_ZERO_BYTES, stream) != hipSuccess) return;
    Args a{};
    for (int i = 0; i < 20; ++i) a.in[i] = (const float*)d_in[i];
    a.out = (float*)d_out; a.ws = (unsigned char*)d_ws;
    a.l_lo = 0; a.l_hi = DEPTH; a.ph_lo = 0; a.ph_hi = NPHASE;
    hipLaunchKernelGGL(fwd_kernel, dim3(GRID), dim3(NTHR), LDS_BYTES, stream, a);
}
```

```cpp
#include <hip/hip_runtime.h>
#include <cstdio>
#include <cstdint>
#include <cmath>
namespace pg8 {
#define PG8_LAS __attribute__((address_space(3)))
typedef unsigned short bf16_t;
typedef short bf16x8 __attribute__((ext_vector_type(8)));
typedef float f32x4 __attribute__((ext_vector_type(4)));
typedef unsigned u32x4 __attribute__((ext_vector_type(4)));
constexpr int BM = 256, BK = 64, HALF = 128, HTB = HALF * BK * 2  , STAGE_BYTES = 8 * HTB, NXCD = 8, WGM = 8;

__host__ __device__ __forceinline__ int lds_byte(int r, int c) { const int st = (r >> 4) * 2 + (c >> 5), rr = r & 15, cc = c & 31, ob = rr * 64 + cc * 2; return st * 1024 + (ob ^ (((ob >> 9) & 1) << 5)); }
__host__ __device__ __forceinline__ void stage_rc(int b, int& R, int& C) { const int st = b / 1024, sb = b % 1024, swz = sb ^ (((sb >> 9) & 1) << 5); R = (st >> 1) * 16 + swz / 64; C = (st & 1) * 32 + (swz % 64) / 2; }
__host__ __device__ __forceinline__ int perm32(int rho) { const int n = rho >> 4, i = rho & 15; return 8 * (i >> 2) + 4 * n + (i & 3); }

struct Unit { int pm, pn; };
struct Gemm { const bf16_t* A; const bf16_t* Bt; int M, N, K; int sw, sx; const int* rowtok; };
typedef int i32x8 __attribute__((ext_vector_type(8))); typedef int i32x4 __attribute__((ext_vector_type(4)));

struct StaticOrder {
    int nM, nN, nwg, G, c;
    __host__ __device__ void init(int M, int N, int G_, int c_) { nM = M / BM; nN = N / BM; nwg = nM * nN; G = G_; c = c_; }
    __host__ __device__ bool next(int i, Unit& u) const {
        const long L = (long)i * G + c; if (L >= nwg) return false;
        int wgid = (int)L; { const int q = nwg / NXCD, r = nwg % NXCD, xcd = wgid % NXCD, off = wgid / NXCD; wgid = (xcd < r ? xcd * (q + 1) : r * (q + 1) + (xcd - r) * q) + off; }
        const int nig = WGM * nN, gid = wgid / nig, fm = gid * WGM, gsz = (nM - fm) < WGM ? (nM - fm) : WGM;
        u.pm = fm + ((wgid % nig) % gsz); u.pn = (wgid % nig) / gsz; return true;
    }
    __device__ __forceinline__ void a_ready(const Unit&) const {}
    __device__ __forceinline__ void done(const Unit&) const {}
};

__device__ __forceinline__ unsigned cvt_pk_bf16(float lo, float hi) { unsigned r; asm volatile("v_cvt_pk_bf16_f32 %0, %1, %2" : "=v"(r) : "v"(lo), "v"(hi)); return r; }
typedef float f32x2 __attribute__((ext_vector_type(2)));
struct EpiPlain {
    static constexpr bool PERM = true, AFTER_DRAIN = false;
    bf16_t* O; int ldc; unsigned smask; float sc;
    struct Pre {};
    __device__ __forceinline__ void pre_load(const Unit&, int, int, Pre&) const {}
    __device__ __forceinline__ void acc_init(f32x4 (&acc)[2][2][4][2], const Pre&) const {
#pragma unroll
        for (int a = 0; a < 2; ++a)
#pragma unroll
            for (int b = 0; b < 2; ++b)
#pragma unroll
                for (int m = 0; m < 4; ++m)
#pragma unroll
                    for (int n = 0; n < 2; ++n) acc[a][b][m][n] = (f32x4){0.f, 0.f, 0.f, 0.f}; }
    __device__ __forceinline__ void operator()(const f32x4 (&acc)[2][2][4][2], const Unit& u, int wr, int wc, int fr, int fq) const {
        const int row0 = u.pm * BM + wr * 64 + fr; const int col0 = u.pn * BM + wc * 32 + 8 * fq; const float s = ((smask >> u.pn) & 1u) ? sc : 1.f;
#pragma unroll
        for (int ai = 0; ai < 2; ++ai)
#pragma unroll
            for (int m = 0; m < 4; ++m) { bf16_t* rowp = O + (size_t)(row0 + ai * HALF + m * 16) * ldc + col0;
#pragma unroll
                for (int bj = 0; bj < 2; ++bj) { const f32x4 v0 = acc[ai][bj][m][0] * s, v1 = acc[ai][bj][m][1] * s;
                    u32x4 w; w.x = cvt_pk_bf16(v0[0], v0[1]); w.y = cvt_pk_bf16(v0[2], v0[3]); w.z = cvt_pk_bf16(v1[0], v1[1]); w.w = cvt_pk_bf16(v1[2], v1[3]);
                    *(u32x4*)(rowp + bj * HALF) = w; } }
    }
};
__device__ __forceinline__ float swiglu1(float g, float u) {
    float gm; asm("v_min_f32 %0, 0x40e00000, %1" : "=v"(gm) : "v"(g));
    const float um = __builtin_amdgcn_fmed3f(u, -7.0f, 7.0f);
    const float s = __builtin_amdgcn_rcpf(1.0f + __builtin_amdgcn_exp2f(gm * (-1.702f * 1.4426950408889634f)));
    const float gs = gm * s;
    return __builtin_fmaf(gs, um, gs);
}
__device__ __forceinline__ void swiglu4(const f32x4 g, const f32x4 u, float (&o)[4]) {
    typedef float f32x2_ __attribute__((ext_vector_type(2)));
#pragma unroll
    for (int h = 0; h < 2; ++h) { f32x2_ gm, um;
        asm("v_min_f32 %0, 0x40e00000, %1" : "=v"(gm.x) : "v"(g[2 * h])); asm("v_min_f32 %0, 0x40e00000, %1" : "=v"(gm.y) : "v"(g[2 * h + 1]));
        um.x = __builtin_amdgcn_fmed3f(u[2 * h], -7.0f, 7.0f); um.y = __builtin_amdgcn_fmed3f(u[2 * h + 1], -7.0f, 7.0f);
        const f32x2_ t = gm * (-1.702f * 1.4426950408889634f);
        f32x2_ e; e.x = __builtin_amdgcn_exp2f(t.x); e.y = __builtin_amdgcn_exp2f(t.y);
        const f32x2_ d = e + 1.0f;
        f32x2_ s; s.x = __builtin_amdgcn_rcpf(d.x); s.y = __builtin_amdgcn_rcpf(d.y);
        const f32x2_ gs = gm * s; const f32x2_ r = gs * um + gs;
        o[2 * h] = r.x; o[2 * h + 1] = r.y; }
}
__device__ __forceinline__ unsigned pk4_fp8e(float a, float b, float c, float d) { int w = 0; w = __builtin_amdgcn_cvt_pk_fp8_f32(a, b, w, false); w = __builtin_amdgcn_cvt_pk_fp8_f32(c, d, w, true); return (unsigned)w; }
struct EpiSwiglu {
    static constexpr bool PERM = true, AFTER_DRAIN = false;
    unsigned char* hid; const float* bg; const float* bu;
    struct Pre { f32x4 g0, g1, u0, u1; };
    __device__ __forceinline__ void pre_load(const Unit& u, int wc, int fq, Pre& p) const { const int e = u.pn >> 3, col0 = (u.pn & 7) * 128 + wc * 32 + 8 * fq;
        p.g0 = *(const f32x4*)(bg + e * 1024 + col0); p.g1 = *(const f32x4*)(bg + e * 1024 + col0 + 4); p.u0 = *(const f32x4*)(bu + e * 1024 + col0); p.u1 = *(const f32x4*)(bu + e * 1024 + col0 + 4); }
    __device__ __forceinline__ void acc_init(f32x4 (&acc)[2][2][4][2], const Pre& p) const {
#pragma unroll
        for (int a = 0; a < 2; ++a)
#pragma unroll
            for (int m = 0; m < 4; ++m) { acc[a][0][m][0] = p.g0; acc[a][0][m][1] = p.g1; acc[a][1][m][0] = p.u0; acc[a][1][m][1] = p.u1; } }
    __device__ __forceinline__ void operator()(const f32x4 (&acc)[2][2][4][2], const Unit& u, int wr, int wc, int fr, int fq) const {
        const int pn = u.pn & 7;
        const int row0 = u.pm * BM + wr * 64 + fr; const int col0 = pn * 128 + wc * 32 + 8 * fq;
#pragma unroll
        for (int ai = 0; ai < 2; ++ai)
#pragma unroll
            for (int m = 0; m < 4; ++m) { unsigned char* rowp = hid + (size_t)(row0 + ai * HALF + m * 16) * 1024 + col0;
                const f32x4 ga = acc[ai][0][m][0], gb = acc[ai][0][m][1], ua = acc[ai][1][m][0], ub = acc[ai][1][m][1];
                typedef unsigned u32x2 __attribute__((ext_vector_type(2))); u32x2 w;
                float oa[4], ob[4]; swiglu4(ga, ua, oa); swiglu4(gb, ub, ob);
                w.x = pk4_fp8e(oa[0], oa[1], oa[2], oa[3]); w.y = pk4_fp8e(ob[0], ob[1], ob[2], ob[3]);
                *(u32x2*)rowp = w; }
    }
};
struct EpiDown {
    static constexpr bool PERM = true, AFTER_DRAIN = false;
    unsigned char* y; const float* bd;
    struct Pre { f32x4 b[2][2]; };
    __device__ __forceinline__ void pre_load(const Unit& u, int wc, int fq, Pre& p) const { const int e = u.pn >> 2, col0 = (u.pn & 3) * BM + wc * 32 + 8 * fq;
#pragma unroll
        for (int bj = 0; bj < 2; ++bj)
#pragma unroll
            for (int n = 0; n < 2; ++n) p.b[bj][n] = *(const f32x4*)(bd + e * 1024 + col0 + bj * HALF + 4 * n); }
    __device__ __forceinline__ void acc_init(f32x4 (&acc)[2][2][4][2], const Pre& p) const {
#pragma unroll
        for (int a = 0; a < 2; ++a)
#pragma unroll
            for (int bj = 0; bj < 2; ++bj)
#pragma unroll
                for (int m = 0; m < 4; ++m) { acc[a][bj][m][0] = p.b[bj][0] * 16.f; acc[a][bj][m][1] = p.b[bj][1] * 16.f; } }
    __device__ __forceinline__ void operator()(const f32x4 (&acc)[2][2][4][2], const Unit& u, int wr, int wc, int fr, int fq) const {
        const int pn = u.pn & 3;
        const int row0 = u.pm * BM + wr * 64 + fr; const int col0 = pn * BM + wc * 32 + 8 * fq;
#pragma unroll
        for (int ai = 0; ai < 2; ++ai)
#pragma unroll
            for (int m = 0; m < 4; ++m) { unsigned char* rowp = y + (size_t)(row0 + ai * HALF + m * 16) * 1024 + col0;
#pragma unroll
                for (int bj = 0; bj < 2; ++bj) { const f32x4 v0 = acc[ai][bj][m][0], v1 = acc[ai][bj][m][1];
                    typedef unsigned u32x2 __attribute__((ext_vector_type(2))); u32x2 w; w.x = pk4_fp8e(v0[0], v0[1], v0[2], v0[3]); w.y = pk4_fp8e(v1[0], v1[1], v1[2], v1[3]);
                    *(u32x2*)(rowp + bj * HALF) = w; } }
    }
};
struct MoeOrder {
    const PG8_LAS int* tab; int npn, G, c, nunits; bool rev;
    __device__ __forceinline__ bool next(int i, Unit& u) const {
        const int tpx = 32 / npn, s = c >> 3, tile = (i * 8 + (c & 7)) * tpx + s / npn, pn = s % npn;
        if ((i * 8) * tpx >= nunits / npn) return false;
        if (tile >= nunits / npn) { u.pm = 0; u.pn = 0; return false; }
        const int tl_ = rev ? nunits / npn - 1 - tile : tile;
        int e = 0;
#pragma unroll
        for (int k = 1; k < 32; ++k) e += (tab[k] <= tl_) ? 1 : 0;
        u.pm = tl_; u.pn = __builtin_amdgcn_readfirstlane(e) * npn + pn; return true;
    }
    __device__ __forceinline__ void a_ready(const Unit&) const {}
    __device__ __forceinline__ void done(const Unit&) const {}
};
template <class Epi, class Sched, bool ALIGN_EPI = false, bool SP2 = false, bool F8 = false, bool GATHER = false>
__device__ __forceinline__ void gemm_phase(PG8_LAS unsigned char* lds, const Gemm g, const Sched& S, const Epi& E) {
    int tid_ = threadIdx.x; asm volatile("" : "+v"(tid_));
    const int tid = tid_, wid = __builtin_amdgcn_readfirstlane(tid >> 6), lane = tid & 63, wr = wid >> 2, wc = wid & 3, fr = lane & 15, fq = lane >> 4;
    const int K = g.K, nt = K / BK;
    unsigned voffA, voffB;
    { int R, C; stage_rc(tid * 16, R, C); const int Rb = Epi::PERM ? ((R & ~31) + perm32(R & 31)) : R; voffA = (unsigned)(R * K + C) * 2u; voffB = (unsigned)(Rb * K + C) * 2u; }
    const unsigned qstep = 64u * (unsigned)K * 2u;
    const unsigned kstep = (unsigned)(BK * 2);
    const unsigned hstep = (unsigned)HALF * (unsigned)K * 2u;
    const unsigned tstep = 2u * hstep;
    const __amdgpu_buffer_rsrc_t rA = __builtin_amdgcn_make_buffer_rsrc((void*)g.A, 0, 0x7FFFFFFF, 0x00020000), rB = __builtin_amdgcn_make_buffer_rsrc((void*)g.Bt, 0, 0x7FFFFFFF, 0x00020000);
    const unsigned ldsw = (unsigned)wid * 1024u;
    const int aoff = lds_byte(wr * 64 + fr, fq * 8), boff = lds_byte(wc * 32 + fr, fq * 8);
#define PG8_SA(b, h) (((b) * 2 + (h)) * HTB)
#define PG8_SB(b, h) ((4 + (b) * 2 + (h)) * HTB)
#define PG8_STG(bufoff, rsrc, soff, voff) do { _Pragma("unroll") for (int _i = 0; _i < 2; ++_i) \
        __builtin_amdgcn_raw_ptr_buffer_load_lds((rsrc), (PG8_LAS void*)(lds + (bufoff) + ldsw + _i * 8192), 16, (int)(voff), (int)((soff) + (unsigned)_i * qstep), 0, 0); } while (0)
#define PG8_STGA(bufoff, soff) PG8_STG(bufoff, rA, soff, voffA)
#define PG8_STGB(bufoff, soff) PG8_STG(bufoff, rB, soff, voffB)
#define PG8_STGAG(bufoff, h, soff_plain, kb) do { if constexpr (GATHER) { _Pragma("unroll") for (int _i = 0; _i < 2; ++_i) \
        __builtin_amdgcn_raw_ptr_buffer_load_lds(rA, (PG8_LAS void*)(lds + (bufoff) + ldsw + _i * 8192), 16, (int)gc[h][_i], (int)(kb), 0, 0); } else PG8_STGA(bufoff, soff_plain); } while (0)
#define PG8_GLOAD(gv, pm_) do { int t3_ = threadIdx.x; asm volatile("" : "+v"(t3_)); int R_, C_; stage_rc(t3_ * 16, R_, C_); const int* rt_ = g.rowtok + (pm_) * BM + R_; \
        _Pragma("unroll") for (int h_ = 0; h_ < 2; ++h_) _Pragma("unroll") for (int i_ = 0; i_ < 2; ++i_) gv[h_][i_] = (unsigned)rt_[h_ * HALF + i_ * 64] * (unsigned)(K * 2) + (unsigned)(C_ * 2); } while (0)
#define PG8_LDA(dst, b, h) do { _Pragma("unroll") for (int m = 0; m < 4; ++m) { if constexpr (F8) { const i32x4 lo_ = *(const PG8_LAS i32x4*)(lds + PG8_SA(b, h) + aoff + m * 2048), hi_ = *(const PG8_LAS i32x4*)(lds + PG8_SA(b, h) + aoff + m * 2048 + 1024); \
            dst##_8[m] = __builtin_shufflevector(lo_, hi_, 0, 1, 2, 3, 4, 5, 6, 7); } else { _Pragma("unroll") for (int k = 0; k < 2; ++k) dst[m][k] = *(const PG8_LAS bf16x8*)(lds + PG8_SA(b, h) + aoff + m * 2048 + k * 1024); } } } while (0)
#define PG8_LDB(dst, b, h) do { _Pragma("unroll") for (int n = 0; n < 2; ++n) { if constexpr (F8) { const i32x4 lo_ = *(const PG8_LAS i32x4*)(lds + PG8_SB(b, h) + boff + n * 2048), hi_ = *(const PG8_LAS i32x4*)(lds + PG8_SB(b, h) + boff + n * 2048 + 1024); \
            dst##_8[n] = __builtin_shufflevector(lo_, hi_, 0, 1, 2, 3, 4, 5, 6, 7); } else { _Pragma("unroll") for (int k = 0; k < 2; ++k) dst[n][k] = *(const PG8_LAS bf16x8*)(lds + PG8_SB(b, h) + boff + n * 2048 + k * 1024); } } } while (0)
#define PG8_MMA(ai, bj, At, Bt) do { __builtin_amdgcn_s_setprio(1); _Pragma("unroll") for (int m = 0; m < 4; ++m) _Pragma("unroll") for (int n = 0; n < 2; ++n) { \
        if constexpr (F8) acc[ai][bj][m][n] = __builtin_amdgcn_mfma_scale_f32_16x16x128_f8f6f4(Bt##_8[n], At##_8[m], acc[ai][bj][m][n], 0, 0, 0, g.sw, 0, g.sx); \
        else { _Pragma("unroll") for (int k = 0; k < 2; ++k) acc[ai][bj][m][n] = __builtin_amdgcn_mfma_f32_16x16x32_bf16(Bt[n][k], At[m][k], acc[ai][bj][m][n], 0, 0, 0); } } \
        __builtin_amdgcn_s_setprio(0); } while (0)
#define PG8_WAIT_V(n) asm volatile("s_waitcnt vmcnt(" #n ")" ::: "memory")
#define PG8_WAIT_L(n) asm volatile("s_waitcnt lgkmcnt(" #n ")" ::: "memory")
#define PG8_BAR __builtin_amdgcn_s_barrier()
#define PG8_SCHED __builtin_amdgcn_sched_barrier(0)
    Unit cur, nxt; int ui = 0;
    if (!S.next(0, cur)) return;
    f32x4 acc[2][2][4][2];
    typename Epi::Pre pre; E.pre_load(cur, wc, fq, pre); E.acc_init(acc, pre);
    bf16x8 At[4][2], B0[2][2], B1[2][2]; i32x8 At_8[4], B0_8[2], B1_8[2];
    unsigned cA = (unsigned)cur.pm * tstep, cB = (unsigned)cur.pn * tstep;
    S.a_ready(cur);
    unsigned gc[2][2]; PG8_LAS unsigned* gl_ = (PG8_LAS unsigned*)(lds + 8 * HTB + tid * 16);
    typedef unsigned u32x2_ __attribute__((ext_vector_type(2)));
    if constexpr (GATHER) { unsigned g1_[2][2]; PG8_GLOAD(gc, cur.pm); Unit n1_; n1_.pm = 0; n1_.pn = 0; const bool h1_ = S.next(1, n1_); PG8_GLOAD(g1_, h1_ ? n1_.pm : cur.pm);
        *(PG8_LAS u32x2_*)gl_ = (u32x2_){g1_[0][0], g1_[0][1]}; *(PG8_LAS u32x2_*)(gl_ + 2) = (u32x2_){g1_[1][0], g1_[1][1]};
        asm volatile("" :: "v"(gc[0][0]), "v"(gc[0][1]), "v"(gc[1][0]), "v"(gc[1][1])); }
    if constexpr (SP2) {
        PG8_STGB(PG8_SB(0, 0), cB); PG8_STGB(PG8_SB(0, 1), cB + hstep); PG8_STGAG(PG8_SA(0, 0), 0, cA, 0u); PG8_STGAG(PG8_SA(0, 1), 1, cA + hstep, 0u);
        if (wr == 1) PG8_BAR;
        PG8_WAIT_V(2); PG8_BAR;
        PG8_STGB(PG8_SB(1, 0), cB + kstep); PG8_STGAG(PG8_SA(1, 0), 0, cA + kstep, kstep); PG8_STGB(PG8_SB(1, 1), cB + hstep + kstep);
        PG8_WAIT_V(6); PG8_BAR;
    } else {
        PG8_STGB(PG8_SB(0, 0), cB); PG8_STGA(PG8_SA(0, 0), cA); PG8_STGB(PG8_SB(0, 1), cB + hstep); PG8_STGA(PG8_SA(0, 1), cA + hstep);
        if (wr == 1) PG8_BAR;
        PG8_WAIT_V(4); PG8_BAR;
        PG8_STGB(PG8_SB(1, 0), cB + kstep); PG8_STGA(PG8_SA(1, 0), cA + kstep); PG8_STGB(PG8_SB(1, 1), cB + hstep + kstep);
        PG8_WAIT_V(6); PG8_BAR;
    }
    for (;;) {
        const bool has_next = S.next(ui + 1, nxt);
        const unsigned nA = has_next ? (unsigned)nxt.pm * tstep : cA, nB = has_next ? (unsigned)nxt.pn * tstep : cB;
#pragma unroll 1
        for (int t = 0; t < nt; t += 2) {
            const bool last = (t == nt - 2);
            const unsigned a1 = cA + (unsigned)(t + 1) * kstep;
            const unsigned a2 = last ? nA : cA + (unsigned)(t + 2) * kstep, b2 = last ? nB : cB + (unsigned)(t + 2) * kstep;
            const unsigned a3 = a2 + kstep, b3 = b2 + kstep;
            if (last && has_next) S.a_ready(nxt);
            const unsigned k1_ = (unsigned)(t + 1) * kstep, k2_ = last ? 0u : (unsigned)(t + 2) * kstep;
            if constexpr (GATHER) { if (last) { const u32x2_ w0_ = *(const PG8_LAS u32x2_*)gl_; gc[0][0] = w0_.x; gc[0][1] = w0_.y; } }
            if constexpr (SP2) {
            PG8_LDB(B0, 0, 0); PG8_LDB(B1, 0, 1); PG8_SCHED; PG8_LDA(At, 0, 0); PG8_STGAG(PG8_SA(1, 1), 1, a1 + hstep, k1_);
            if constexpr (GATHER) { if (last) { const u32x2_ w1_ = *(const PG8_LAS u32x2_*)(gl_ + 2); gc[1][0] = w1_.x; gc[1][1] = w1_.y; } }
            PG8_WAIT_V(8); PG8_WAIT_L(0); PG8_BAR; PG8_MMA(0, 0, At, B0); PG8_MMA(0, 1, At, B1); PG8_BAR; PG8_SCHED;
            PG8_LDA(At, 0, 1); PG8_STGB(PG8_SB(0, 0), b2); PG8_STGB(PG8_SB(0, 1), b2 + hstep); PG8_STGAG(PG8_SA(0, 0), 0, a2, k2_);
            PG8_WAIT_V(8); PG8_WAIT_L(0); PG8_BAR; PG8_MMA(1, 0, At, B0); PG8_MMA(1, 1, At, B1); PG8_BAR; PG8_SCHED;
            PG8_LDB(B0, 1, 0); PG8_LDB(B1, 1, 1); PG8_SCHED; PG8_LDA(At, 1, 0); PG8_STGAG(PG8_SA(0, 1), 1, a2 + hstep, k2_);
            PG8_WAIT_V(8); PG8_WAIT_L(0); PG8_BAR; PG8_MMA(0, 0, At, B0); PG8_MMA(0, 1, At, B1); PG8_BAR; PG8_SCHED;
            PG8_LDA(At, 1, 1); PG8_STGB(PG8_SB(1, 0), b3); PG8_STGB(PG8_SB(1, 1), b3 + hstep); PG8_STGAG(PG8_SA(1, 0), 0, a3, k2_ + kstep);
            PG8_WAIT_V(8); PG8_WAIT_L(0); PG8_BAR; PG8_MMA(1, 0, At, B0); PG8_MMA(1, 1, At, B1); PG8_BAR; PG8_SCHED;
            } else {
            PG8_LDB(B0, 0, 0); PG8_SCHED; PG8_LDA(At, 0, 0); PG8_STGA(PG8_SA(1, 1), a1 + hstep);
            PG8_WAIT_L(8); PG8_BAR; PG8_WAIT_L(0); PG8_MMA(0, 0, At, B0); PG8_BAR; PG8_SCHED;
            PG8_LDB(B1, 0, 1); PG8_STGB(PG8_SB(0, 0), b2);
            PG8_BAR; PG8_WAIT_L(0); PG8_MMA(0, 1, At, B1); PG8_BAR;
            PG8_LDA(At, 0, 1); PG8_STGA(PG8_SA(0, 0), a2);
            PG8_BAR; PG8_WAIT_L(0); PG8_MMA(1, 0, At, B0); PG8_BAR; PG8_SCHED;
            PG8_STGB(PG8_SB(0, 1), b2 + hstep);
            PG8_WAIT_V(6); PG8_BAR; PG8_MMA(1, 1, At, B1); PG8_BAR;
            PG8_LDB(B0, 1, 0); PG8_SCHED; PG8_LDA(At, 1, 0); PG8_STGA(PG8_SA(0, 1), a2 + hstep);
            PG8_WAIT_L(8); PG8_BAR; PG8_WAIT_L(0); PG8_MMA(0, 0, At, B0); PG8_BAR; PG8_SCHED;
            PG8_LDB(B1, 1, 1); PG8_STGB(PG8_SB(1, 0), b3);
            PG8_BAR; PG8_WAIT_L(0); PG8_MMA(0, 1, At, B1); PG8_BAR;
            PG8_LDA(At, 1, 1); PG8_STGA(PG8_SA(1, 0), a3);
            PG8_BAR; PG8_WAIT_L(0); PG8_MMA(1, 0, At, B0); PG8_BAR; PG8_SCHED;
            PG8_STGB(PG8_SB(1, 1), b3 + hstep);
            PG8_WAIT_V(6); PG8_BAR; PG8_MMA(1, 1, At, B1); PG8_BAR;
            }
        }
        if constexpr (ALIGN_EPI) { if (wr == 0) PG8_BAR; }
        unsigned gnn[2][2];
        if constexpr (GATHER) { Unit n2_; n2_.pm = 0; n2_.pn = 0; const bool h2_ = S.next(ui + 2, n2_); const int pm2_ = h2_ ? n2_.pm : (has_next ? nxt.pm : cur.pm); PG8_GLOAD(gnn, pm2_); }
        if constexpr (!Epi::AFTER_DRAIN) { int t2_ = threadIdx.x; asm volatile("" : "+v"(t2_)); { const Unit pu_ = has_next ? nxt : cur; E.pre_load(pu_, wc, (t2_ & 63) >> 4, pre); }     E(acc, cur, wr, wc, t2_ & 15, (t2_ & 63) >> 4); S.done(cur); }
        if (!has_next) break;
        E.acc_init(acc, pre);
        if constexpr (GATHER) { *(PG8_LAS u32x2_*)gl_ = (u32x2_){gnn[0][0], gnn[0][1]}; *(PG8_LAS u32x2_*)(gl_ + 2) = (u32x2_){gnn[1][0], gnn[1][1]}; }
        cur = nxt; cA = nA; cB = nB; ++ui;
        if constexpr (ALIGN_EPI) { if (wr == 1) PG8_BAR; }
    }
    PG8_WAIT_V(0);
    if constexpr (!ALIGN_EPI) { if (wr == 0) PG8_BAR; }
    PG8_BAR;
    if constexpr (Epi::AFTER_DRAIN) { E.fused(acc, cur, wr, wc, fr, fq, lds, wid, lane); S.done(cur); }
#undef PG8_SA
#undef PG8_SB
#undef PG8_STG
#undef PG8_STGA
#undef PG8_STGB
#undef PG8_STGAG
#undef PG8_GLOAD
#undef PG8_LDA
#undef PG8_LDB
#undef PG8_MMA
#undef PG8_WAIT_V
#undef PG8_WAIT_L
#undef PG8_BAR
#undef PG8_SCHED
}
}

constexpr int NWAVES = 8, NTHR = 512, GRID = 256;
constexpr int NBATCH = 2, SEQ = 16384, T = NBATCH * SEQ, D = 1024, DEPTH = 4;
constexpr int MIXW = 768, NC_H = 3328, NC_M = 2560;
constexpr int HG_H = 6;
constexpr int HSEG = 256, HNSEG = SEQ / HSEG;
constexpr int MB_H = 12, MB_NB = 64;
constexpr int NE = 32;
constexpr float DN_ALPHA = 1.6817928305074290f;
constexpr int MOE_MAXROWS = T * 4 + NE * 256;
#ifndef ONE_LAUNCH
#define ONE_LAUNCH 1
#endif
constexpr int NPHASE = 13;

constexpr size_t MiB = 1u << 20;
constexpr size_t WS_CTL = 0, CTL_ZERO_BYTES = 1 * MiB;
constexpr size_t WS_WIN = 1 * MiB, WS_WKV = 9 * MiB, WS_WO = 10 * MiB, WS_WGU = 12 * MiB, WS_WD = 140 * MiB;
constexpr size_t WS_XBF = 204 * MiB, WS_WKV4 = 268 * MiB  , WS_KV4 = 272 * MiB  , WS_WRS = 280 * MiB  , WS_MEMBF = 524 * MiB;
constexpr size_t WS_H = 526 * MiB, WS_MIX = 734 * MiB, WS_Y = 798 * MiB, WS_SLOC = 862 * MiB, WS_DSEG = 910 * MiB, WS_KMEAN = 911 * MiB;
constexpr size_t WS_SELINFO = 912 * MiB, WS_TOK = 914 * MiB, WS_R1 = 918 * MiB;
constexpr size_t WS_LIST = WS_R1, WS_PML = WS_R1 + 96 * MiB, WS_PO = WS_R1 + 108 * MiB;
constexpr size_t WS_XS = WS_R1, WS_HID = WS_R1 + 272 * MiB;
constexpr size_t WS_END = WS_R1 + 544 * MiB;
static_assert((size_t)MOE_MAXROWS * 1024 * 2 <= 272 * MiB, "moe rows");
static_assert((size_t)T * MB_H * 4 * 64 * 4 <= 384 * MiB && (size_t)24 * 64 * 16384 * 4 <= 96 * MiB, "moba bufs");
constexpr size_t TOK_E = 0, TOK_LR = 512 * 1024, TOK_W = 1024 * 1024, TOK_ROW = 1536 * 1024, TOK_BLKCNT = 2048 * 1024, TOK_TAB = 2048 * 1024 + 65536;
constexpr int CW_BAR = 4096, CW_GCOUNT = 8192;

constexpr int RING_BYTES = 131072, LDS_BYTES = 147456, MISC_OFF = LDS_BYTES - 1024;

#define GAS __attribute__((address_space(1)))
#define LAS __attribute__((address_space(3)))
typedef unsigned short bf16;
typedef unsigned v4u __attribute__((ext_vector_type(4)));
typedef unsigned v2u __attribute__((ext_vector_type(2)));
typedef float f32x4 __attribute__((ext_vector_type(4)));
typedef float f32x2 __attribute__((ext_vector_type(2)));
typedef short s16x8 __attribute__((ext_vector_type(8)));
typedef float f32x16 __attribute__((ext_vector_type(16)));
typedef float f32x2_t __attribute__((ext_vector_type(2))); typedef __bf16 bf16x2_t __attribute__((ext_vector_type(2)));
__device__ __forceinline__ unsigned cvtpk(float lo, float hi) { f32x2_t v = {lo, hi}; bf16x2_t b = __builtin_convertvector(v, bf16x2_t); return __builtin_bit_cast(unsigned, b); }
#define LDS_WAIT() asm volatile("s_waitcnt lgkmcnt(0)" ::: "memory")
__device__ __forceinline__ unsigned f2bf(float f) { unsigned u = __builtin_bit_cast(unsigned, f); return (u + 0x7fffu + ((u >> 16) & 1u)) >> 16; }
__device__ __forceinline__ unsigned pk2(float lo, float hi) { return f2bf(lo) | (f2bf(hi) << 16); }
__device__ __forceinline__ float bflo(unsigned w) { return __builtin_bit_cast(float, w << 16); }
__device__ __forceinline__ float bfhi(unsigned w) { return __builtin_bit_cast(float, w & 0xffff0000u); }
__device__ __forceinline__ float bf2f(bf16 h) { return __builtin_bit_cast(float, (unsigned)h << 16); }
__device__ __forceinline__ float sigmoidf_(float z) { return __builtin_amdgcn_rcpf(1.0f + __builtin_amdgcn_exp2f(-1.4426950408889634f * z)); }
template <int X> __device__ __forceinline__ float xorf(float v) { return __builtin_bit_cast(float, __builtin_amdgcn_ds_swizzle(__builtin_bit_cast(int, v), (X << 10) | 0x1F)); }
template <int X> __device__ __forceinline__ int xori(int v) { return __builtin_amdgcn_ds_swizzle(v, (X << 10) | 0x1F); }
__device__ __forceinline__ float wave_sum(float v) {
    v += xorf<1>(v); v += xorf<2>(v); v += xorf<4>(v); v += xorf<8>(v); v += xorf<16>(v);
    return __builtin_bit_cast(float, __builtin_amdgcn_readlane(__builtin_bit_cast(int, v), 0)) + __builtin_bit_cast(float, __builtin_amdgcn_readlane(__builtin_bit_cast(int, v), 32));
}
__device__ __forceinline__ float wave_max(float v) {
    v = fmaxf(v, xorf<1>(v)); v = fmaxf(v, xorf<2>(v)); v = fmaxf(v, xorf<4>(v)); v = fmaxf(v, xorf<8>(v)); v = fmaxf(v, xorf<16>(v));
    return fmaxf(__builtin_bit_cast(float, __builtin_amdgcn_readlane(__builtin_bit_cast(int, v), 0)), __builtin_bit_cast(float, __builtin_amdgcn_readlane(__builtin_bit_cast(int, v), 32)));
}
__device__ __forceinline__ float xor32f(float v, int lane) { return __builtin_bit_cast(float, __builtin_amdgcn_ds_bpermute((lane ^ 32) << 2, __builtin_bit_cast(int, v))); }
#define XB_TMO      128
#define XB_XCNT(j)  (256  + 64 * (j))
#define XB_XSUB(j)  (1280 + 64 * (j))
#define XB_XGEN(j)  (2304 + 64 * (j))
#define XB_TOP      3328
#define XB_TOPGEN   3392
#define XCD_BAR_WORDS 3456
#define XB_SPIN_CAP (1u << 18)

__device__ __forceinline__ unsigned xb_ld(unsigned* p)              { return __hip_atomic_load(p, __ATOMIC_RELAXED, __HIP_MEMORY_SCOPE_AGENT); }
__device__ __forceinline__ unsigned xb_add(unsigned* p, unsigned v) { return __hip_atomic_fetch_add(p, v, __ATOMIC_RELAXED, __HIP_MEMORY_SCOPE_AGENT); }
__device__ __forceinline__ unsigned xb_xcc_id() { return (unsigned)__builtin_amdgcn_s_getreg((3 << 11) | 20) & 0xFu; }
#define XB_SPIN(cond, bar) do { unsigned _sp = 0; while (cond) { __builtin_amdgcn_s_sleep(1); \
    if ((++_sp & 255u) == 0u) { if (xb_ld(&(bar)[XB_TMO])) break; if (_sp > XB_SPIN_CAP) { atomicAdd(&(bar)[XB_TMO], 1u); break; } } } } while (0)

struct XcdBarrier {
    unsigned* bar; unsigned x;
    volatile LAS unsigned* st;
};

__device__ __forceinline__ XcdBarrier xcd_barrier_post(unsigned* bar, volatile LAS unsigned* st) {
    XcdBarrier b; b.bar = bar; b.x = xb_xcc_id(); b.st = st;
    if (threadIdx.x == 0) (void)xb_add(&bar[XB_XCNT(b.x)], 1u);
    return b;
}
__device__ __forceinline__ void xcd_barrier_complete(unsigned* bar, unsigned x, unsigned& nloc, unsigned& nx) {
    const unsigned G = gridDim.x * gridDim.y * gridDim.z;
    unsigned sum, cnt, mine, sp = 0u;
    for (;;) {
        sum = 0u; cnt = 0u; mine = 0u;
#pragma unroll
        for (unsigned j = 0; j < 16; ++j) { const unsigned c = xb_ld(&bar[XB_XCNT(j)]); sum += c; cnt += (c > 0u) ? 1u : 0u; mine = (j == x) ? c : mine; }
        if (sum == G) break;
        __builtin_amdgcn_s_sleep(1);
        if ((++sp & 255u) == 0u) { if (xb_ld(&bar[XB_TMO])) break; if (sp > XB_SPIN_CAP) { atomicAdd(&bar[XB_TMO], 1u); break; } }
    }
    nloc = mine > 0u ? mine : 1u; nx = cnt > 0u ? cnt : 1u;
}

__device__ __forceinline__ void xcd_barrier(const XcdBarrier& b) {
    asm volatile("s_waitcnt vmcnt(0)" ::: "memory");
    __syncthreads();
    if (threadIdx.x == 0) {
        unsigned* bar = b.bar;
        __builtin_amdgcn_s_waitcnt(0);
        unsigned nloc = b.st[0], nx = b.st[1];
        if (nloc == 0u) { xcd_barrier_complete(bar, b.x, nloc, nx); b.st[0] = nloc; b.st[1] = nx; }
        const unsigned old = xb_add(&bar[XB_XSUB(b.x)], 1u);
        const unsigned gen = old / nloc;
        if (old + 1u == (gen + 1u) * nloc) {
            __builtin_amdgcn_fence(__ATOMIC_RELEASE, "agent");
            asm volatile("s_waitcnt vmcnt(0)" ::: "memory");
            const unsigned og = xb_add(&bar[XB_TOP], 1u);
            const unsigned tg = og / nx;
            if (og + 1u == (tg + 1u) * nx) xb_add(&bar[XB_TOPGEN], 1u);
            else XB_SPIN(xb_ld(&bar[XB_TOPGEN]) == tg, bar);
            __builtin_amdgcn_fence(__ATOMIC_ACQUIRE, "agent");
            xb_add(&bar[XB_XGEN(b.x)], 1u);
            asm volatile("s_waitcnt vmcnt(0)" ::: "memory");
        } else {
            XB_SPIN(xb_ld(&bar[XB_XGEN(b.x)]) == gen, bar);
            __builtin_amdgcn_fence(__ATOMIC_ACQUIRE, "agent");
            asm volatile("s_waitcnt vmcnt(0)" ::: "memory");
        }
    }
    __syncthreads();
}
__device__ __forceinline__ void cvt_rows_bf16(const float* src, bf16* dst, size_t n8, size_t gtid, size_t gthreads) {
    for (size_t i = gtid; i < n8; i += gthreads) { const f32x4 a = __builtin_nontemporal_load((const f32x4*)src + 2 * i), b = __builtin_nontemporal_load((const f32x4*)src + 2 * i + 1);
        v4u o; o.x = pk2(a.x, a.y); o.y = pk2(a.z, a.w); o.z = pk2(b.x, b.y); o.w = pk2(b.z, b.w); ((v4u*)dst)[i] = o; }
}
__device__ __forceinline__ void transpose_item(const float* W, int N, bf16* WT, int dst_row0, LAS float* scr, int k0, int n0, int lane) {
#pragma unroll 8
    for (int i = 0; i < 32; ++i) { const int kk = 2 * i + (lane >> 5); scr[kk * 33 + (lane & 31)] = __builtin_nontemporal_load(W + (size_t)(k0 + kk) * N + n0 + (lane & 31)); }
    LDS_WAIT(); asm volatile("" ::: "memory");
    const int c = lane & 7;
#pragma unroll
    for (int j = 0; j < 4; ++j) { const int n = (lane >> 3) + 8 * j; const LAS float* s = scr + (8 * c) * 33 + n;
        v4u o; o.x = pk2(s[0 * 33], s[1 * 33]); o.y = pk2(s[2 * 33], s[3 * 33]); o.z = pk2(s[4 * 33], s[5 * 33]); o.w = pk2(s[6 * 33], s[7 * 33]);
        *(v4u*)(WT + (size_t)(dst_row0 + n) * 1024 + k0 + 8 * c) = o; }
    LDS_WAIT(); asm volatile("" ::: "memory");
}
__device__ __forceinline__ unsigned pk4_fp8(float a, float b, float c, float d) { int w = 0; w = __builtin_amdgcn_cvt_pk_fp8_f32(a, b, w, false); w = __builtin_amdgcn_cvt_pk_fp8_f32(c, d, w, true); return (unsigned)w; }
__device__ __forceinline__ void transpose_item_f8(const float* W, int N, unsigned char* WT8, int dst_row0, LAS float* scr, int k0, int n0, int lane, float wscale) {
#pragma unroll 8
    for (int i = 0; i < 32; ++i) { const int kk = 2 * i + (lane >> 5); scr[kk * 33 + (lane & 31)] = __builtin_nontemporal_load(W + (size_t)(k0 + kk) * N + n0 + (lane & 31)); }
    LDS_WAIT(); asm volatile("" ::: "memory");
    const int c = lane & 7;
#pragma unroll
    for (int j = 0; j < 4; ++j) { const int n = (lane >> 3) + 8 * j; const LAS float* s = scr + (8 * c) * 33 + n;
        v2u o; o.x = pk4_fp8(s[0 * 33] * wscale, s[1 * 33] * wscale, s[2 * 33] * wscale, s[3 * 33] * wscale); o.y = pk4_fp8(s[4 * 33] * wscale, s[5 * 33] * wscale, s[6 * 33] * wscale, s[7 * 33] * wscale);
        *(v2u*)(WT8 + (size_t)(dst_row0 + n) * 1024 + k0 + 8 * c) = o; }
    LDS_WAIT(); asm volatile("" ::: "memory");
}
__device__ __forceinline__ void phase_weights(LAS float* scr, int gw, int ngw, int lane, const float* win_src, int NC, const float* wkv_src, int nkv, const float* wo_src,
                                              const float* wg_src, const float* wu_src, const float* wd_src, bf16* win_t, bf16* wkv_t, bf16* wo_t, bf16* wgu_t, bf16* wd_t, int mode) {
    const int nbw = NC / 32, nWin = nbw * 16, NPROJ = nWin + 256 * nkv + 512, NIT = mode == 1 ? NPROJ : NPROJ + NE * 1536;
    for (int it = (mode == 2 ? NPROJ : 0) + gw; it < NIT; it += ngw) {
        int r = it;
        if (r < nWin) { const int kb = r / nbw, nb = r - kb * nbw; transpose_item(win_src, NC, win_t, 32 * nb, scr, 64 * kb, 32 * nb, lane); continue; } r -= nWin;
        if (r < 256 * nkv) { const int lay = r >> 8, rr = r & 255, kb = rr >> 4, nb = rr & 15; transpose_item(wkv_src + (size_t)lay * D * 512, 512, wkv_t + (size_t)lay * 512 * 1024, 32 * nb, scr, 64 * kb, 32 * nb, lane); continue; } r -= 256 * nkv;
        if (r < 512) { const int kb = r >> 5, nb = r & 31; transpose_item(wo_src, 1024, wo_t, 32 * nb, scr, 64 * kb, 32 * nb, lane); continue; } r -= 512;
        const int e = r / 1536, q = r - e * 1536, which = q >> 9, rr = q & 511, kb = rr >> 5, nb = rr & 31, n0 = 32 * nb;
        const size_t eoff = (size_t)e * 1024 * 1024;
        if (which == 0) transpose_item_f8(wg_src + eoff, 1024, (unsigned char*)wgu_t + 2 * eoff, (n0 >> 7) * 256 + (n0 & 127), scr, 64 * kb, n0, lane, 32.f);
        else if (which == 1) transpose_item_f8(wu_src + eoff, 1024, (unsigned char*)wgu_t + 2 * eoff, (n0 >> 7) * 256 + 128 + (n0 & 127), scr, 64 * kb, n0, lane, 32.f);
        else transpose_item_f8(wd_src + eoff, 1024, (unsigned char*)wd_t + eoff, n0, scr, 64 * kb, n0, lane, 64.f);
    }
}

template <bool OUT>
__device__ __forceinline__ void hgrn_seg(LAS unsigned char* lds, const bf16* h, const float* lbl, int j, const float* normg, float* Sloc, float* Dseg, bf16* mix, int unit, int tid, int wave, int lane) {
    const int seg = unit & (HNSEG - 1), bh = unit >> 6, hh = bh % HG_H, b = bh / HG_H;
    const int v = tid & 127, dg = tid >> 7;
    LAS float* fgs = (LAS float*)lds; LAS float* vs = fgs + 4096; LAS float* qs = vs + 4096; LAS float* op = qs + 4096;
    f32x2 st[16];
    float* Sp = Sloc + (size_t)unit * 16384 + (size_t)(dg * 32) * 128 + v;
#pragma unroll
    for (int dd = 0; dd < 16; ++dd) { st[dd].x = OUT ? Sp[(2 * dd) * 128] : 0.f; st[dd].y = OUT ? Sp[(2 * dd + 1) * 128] : 0.f; }
    float dprod = 1.f;
    const int stok = tid >> 4, c8 = (tid & 15) * 8;
    float lb[8];
#pragma unroll
    for (int i = 0; i < 8; ++i) { lb[i] = 0.f; if (j > 0) { const float a0 = lbl[hh * 128 + c8 + i], a1 = lbl[MIXW + hh * 128 + c8 + i]; lb[i] = 1.f / (1.f + __expf(a0 - a1)); } }
    for (int ch = 0; ch < HSEG / 32; ++ch) {
        const size_t t0 = (size_t)b * SEQ + seg * HSEG + ch * 32;
        { const bf16* row = h + (t0 + stok) * NC_H + hh * 128 + c8;
          const v4u f8 = *(const v4u*)(row + 768), i8 = *(const v4u*)(row + 1536); v4u q8 = {0u, 0u, 0u, 0u}; if (OUT) q8 = *(const v4u*)row;
#pragma unroll
          for (int w = 0; w < 4; ++w) { const float f0 = bflo(f8[w]), f1 = bfhi(f8[w]); const int o = stok * 128 + c8 + 2 * w;
              fgs[o] = lb[2 * w] + (1.f - lb[2 * w]) * sigmoidf_(f0); fgs[o + 1] = lb[2 * w + 1] + (1.f - lb[2 * w + 1]) * sigmoidf_(f1);
              vs[o] = bflo(i8[w]); vs[o + 1] = bfhi(i8[w]);
              if (OUT) { const float q0 = bflo(q8[w]), q1 = bfhi(q8[w]); qs[o] = q0 * sigmoidf_(q0); qs[o + 1] = q1 * sigmoidf_(q1); } } }
        __syncthreads();
        if (!OUT) { if (tid < 128) { for (int tt = 0; tt < 32; ++tt) dprod *= fgs[tt * 128 + tid]; } }
        f32x4 fA[8], qA[8], fB[8], qB[8]; float vA, vB;
#define HG_LOAD(F, Q, V, tt_) do { V = vs[(tt_) * 128 + v]; _Pragma("unroll") for (int d4 = 0; d4 < 8; ++d4) { F[d4] = *(const LAS f32x4*)(fgs + (tt_) * 128 + dg * 32 + d4 * 4); \
            if (OUT) Q[d4] = *(const LAS f32x4*)(qs + (tt_) * 128 + dg * 32 + d4 * 4); } } while (0)
#define HG_STEP(F, Q, V, tt_) do { const f32x2 vv2 = {V, V}; f32x2 acc2 = {0.f, 0.f}; _Pragma("unroll") for (int d4 = 0; d4 < 8; ++d4) { \
            const f32x2 fa = {F[d4].x, F[d4].y}, fb = {F[d4].z, F[d4].w}; \
            st[2 * d4] = fa * (st[2 * d4] - vv2) + vv2; st[2 * d4 + 1] = fb * (st[2 * d4 + 1] - vv2) + vv2; \
            if (OUT) { const f32x2 qa = {Q[d4].x, Q[d4].y}, qb = {Q[d4].z, Q[d4].w}; acc2 = qa * st[2 * d4] + acc2; acc2 = qb * st[2 * d4 + 1] + acc2; } } \
            if (OUT) op[(dg * 32 + (tt_)) * 128 + v] = acc2.x + acc2.y; } while (0)
        HG_LOAD(fA, qA, vA, 0);
#pragma unroll 1
        for (int tt = 0; tt < 32; tt += 2) {
            HG_LOAD(fB, qB, vB, tt + 1);
            __builtin_amdgcn_sched_barrier(0);
            HG_STEP(fA, qA, vA, tt);
            __builtin_amdgcn_sched_barrier(0);
            if (tt + 2 < 32) HG_LOAD(fA, qA, vA, tt + 2);
            __builtin_amdgcn_sched_barrier(0);
            HG_STEP(fB, qB, vB, tt + 1);
            __builtin_amdgcn_sched_barrier(0);
        }
#undef HG_LOAD
#undef HG_STEP
        if (OUT) {
            __syncthreads();
#pragma unroll
            for (int k = 0; k < 4; ++k) { const int tt = wave + 8 * k; float o0 = 0.f, o1 = 0.f;
#pragma unroll
                for (int g = 0; g < 4; ++g) { o0 += op[(g * 32 + tt) * 128 + lane]; o1 += op[(g * 32 + tt) * 128 + lane + 64]; }
                const float ms = wave_sum(o0 * o0 + o1 * o1) * (1.f / 128.f), r = 1.f / sqrtf(ms + 1e-6f);
                const bf16* grow = h + (t0 + tt) * NC_H + 2304 + hh * 128; const float g0 = bf2f(grow[lane]), g1 = bf2f(grow[lane + 64]);
                bf16* mrow = mix + (t0 + tt) * 1024 + hh * 128;
                mrow[lane] = (bf16)f2bf(o0 * r * normg[lane] * sigmoidf_(g0)); mrow[lane + 64] = (bf16)f2bf(o1 * r * normg[lane + 64] * sigmoidf_(g1)); }
        }
        __syncthreads();
    }
    if (!OUT) {
#pragma unroll
        for (int dd = 0; dd < 16; ++dd) { Sp[(2 * dd) * 128] = st[dd].x; Sp[(2 * dd + 1) * 128] = st[dd].y; }
        if (tid < 128) Dseg[(size_t)unit * 128 + tid] = dprod;
    }
}
constexpr int HG_G = 0, HG_QT = 32768, HG_KT = 50176, HG_KE = 67584, HG_VT = 86016, HG_ST = 104448, HG_GM = 139264, HG_GE = 139776, HG_PART = 140288, HG_EGM = 142336, HG_EGE = 142848;
static_assert(HG_EGE + 512 <= MISC_OFF, "HGRN LDS map");
__device__ __forceinline__ int crow16(int i, int hf) { return (i & 3) + 8 * (i >> 2) + 4 * hf; }
template <bool OUT>
__device__ __forceinline__ void hgrn_mfma(LAS unsigned char* lds, const bf16* h, const float* lbl, int j, const float* normg, float* Sloc, float* Dseg, bf16* mix, int unit, int tid, int wave, int lane) {
    const int seg = unit & (HNSEG - 1), bh = unit >> 6, hh = bh % HG_H, b = bh / HG_H;
    const int r = lane & 31, hf = lane >> 5, tr = wave & 1, vq = wave >> 1;
    LAS float* G = (LAS float*)(lds + HG_G); LAS float* GM = (LAS float*)(lds + HG_GM); LAS float* GE = (LAS float*)(lds + HG_GE); LAS float* PART = (LAS float*)(lds + HG_PART); LAS float* EGM = (LAS float*)(lds + HG_EGM); LAS float* EGE = (LAS float*)(lds + HG_EGE);
    const int stok = tid >> 3, c16 = (tid & 7) * 16, sperm = (stok & ~15) | (stok & 3) | ((stok & 4) << 1) | ((stok & 8) >> 1);
    const int cd = tid & 127, cpart = tid >> 7;
    float lb[16];
#pragma unroll
    for (int e = 0; e < 16; ++e) { lb[e] = 0.f; if (j > 0) { const float a0 = lbl[hh * 128 + c16 + e], a1 = lbl[MIXW + hh * 128 + c16 + e]; lb[e] = 1.f / (1.f + __expf(a0 - a1)); } }
    f32x16 S[2];
    float* Sp = Sloc + (size_t)unit * 16384 + 32 * vq + r;
#pragma unroll
    for (int dd = 0; dd < 2; ++dd)
#pragma unroll
        for (int i = 0; i < 16; ++i) S[dd][i] = OUT ? Sp[(32 * (2 * tr + dd) + crow16(i, hf)) * 128] : 0.f;
    float gsum = 0.f;
    float ng16[16];
#pragma unroll
    for (int e = 0; e < 16; ++e) ng16[e] = OUT ? normg[c16 + e] : 0.f;
    v4u nf8[2], ni8[2], nq8[2] = {{0u, 0u, 0u, 0u}, {0u, 0u, 0u, 0u}}, ng8[2] = {{0u, 0u, 0u, 0u}, {0u, 0u, 0u, 0u}};
#define HG_RAWLOAD(t0_) do { const bf16* row_ = h + ((t0_) + stok) * NC_H + hh * 128 + c16; nf8[0] = *(const v4u*)(row_ + 768); nf8[1] = *(const v4u*)(row_ + 776); ni8[0] = *(const v4u*)(row_ + 1536); ni8[1] = *(const v4u*)(row_ + 1544); \
        if (OUT) { nq8[0] = *(const v4u*)row_; nq8[1] = *(const v4u*)(row_ + 8); ng8[0] = *(const v4u*)(row_ + 2304); ng8[1] = *(const v4u*)(row_ + 2312); } } while (0)
    HG_RAWLOAD((size_t)b * SEQ + seg * HSEG);
    for (int ch = 0; ch < HSEG / 64; ++ch) {
        const size_t t0 = (size_t)b * SEQ + seg * HSEG + ch * 64;
        float fg[16], qv[16]; v4u i8[2], g8[2];
        { const v4u f8[2] = {nf8[0], nf8[1]}; i8[0] = ni8[0]; i8[1] = ni8[1]; const v4u q8[2] = {nq8[0], nq8[1]}; g8[0] = ng8[0]; g8[1] = ng8[1];
#pragma unroll
          for (int w = 0; w < 8; ++w) { const unsigned fw = f8[w >> 2][w & 3]; const float f0 = bflo(fw), f1 = bfhi(fw);
              fg[2 * w] = lb[2 * w] + (1.f - lb[2 * w]) * sigmoidf_(f0); fg[2 * w + 1] = lb[2 * w + 1] + (1.f - lb[2 * w + 1]) * sigmoidf_(f1);
              if (OUT) { const unsigned qw = q8[w >> 2][w & 3]; const float q0 = bflo(qw), q1 = bfhi(qw); qv[2 * w] = q0 * sigmoidf_(q0); qv[2 * w + 1] = q1 * sigmoidf_(q1); } else { qv[2 * w] = 0.f; qv[2 * w + 1] = 0.f; } }
#pragma unroll
          for (int e4 = 0; e4 < 4; ++e4) { f32x4 lg; lg.x = __builtin_amdgcn_logf(fg[4 * e4]); lg.y = __builtin_amdgcn_logf(fg[4 * e4 + 1]); lg.z = __builtin_amdgcn_logf(fg[4 * e4 + 2]); lg.w = __builtin_amdgcn_logf(fg[4 * e4 + 3]);
              *(LAS f32x4*)(G + stok * 128 + c16 + 4 * e4) = lg; } }
        __syncthreads();
        { float run = 0.f;
#pragma unroll
          for (int k = 0; k < 16; ++k) run += G[(16 * cpart + k) * 128 + cd];
          PART[cpart * 128 + cd] = run; }
        __syncthreads();
        { float run = 0.f;
#pragma unroll
          for (int pp = 0; pp < 3; ++pp) run += (pp < cpart) ? PART[pp * 128 + cd] : 0.f;
#pragma unroll
          for (int k = 0; k < 16; ++k) { run += G[(16 * cpart + k) * 128 + cd]; G[(16 * cpart + k) * 128 + cd] = run; }
          if (cpart == 1) { GM[cd] = run; EGM[cd] = __builtin_amdgcn_exp2f(run); }
          if (cpart == 3) { GE[cd] = run; EGE[cd] = __builtin_amdgcn_exp2f(run); gsum += run; } }
        __syncthreads();
        if (OUT) {
#pragma unroll
            for (int dd = 0; dd < 2; ++dd)
#pragma unroll
                for (int g4 = 0; g4 < 4; ++g4) { const int dbase = 32 * (2 * tr + dd) + 8 * g4 + 4 * hf; const f32x4 gm = *(const LAS f32x4*)(EGM + dbase);
                    v2u w; w.x = cvtpk(S[dd][4 * g4] * gm.x, S[dd][4 * g4 + 1] * gm.y); w.y = cvtpk(S[dd][4 * g4 + 2] * gm.z, S[dd][4 * g4 + 3] * gm.w);
                    *(LAS v2u*)(lds + HG_ST + (32 * vq + r) * 272 + dbase * 2) = w; }
        }
        { unsigned qt[8], kt[8];
#pragma unroll
          for (int e4 = 0; e4 < 4; ++e4) { const f32x4 gv = *(const LAS f32x4*)(G + stok * 128 + c16 + 4 * e4), gm = *(const LAS f32x4*)(GM + c16 + 4 * e4), ge = *(const LAS f32x4*)(GE + c16 + 4 * e4);
              float ke[4];
#pragma unroll
              for (int e = 0; e < 4; ++e) { const float kk = 1.f - fg[4 * e4 + e]; ke[e] = kk * __builtin_amdgcn_exp2f(ge[e] - gv[e]);
                  if (OUT) { const float a = qv[4 * e4 + e] * __builtin_amdgcn_exp2f(gv[e] - gm[e]), c = kk * __builtin_amdgcn_exp2f(gm[e] - gv[e]);
                      if (e & 1) { qt[2 * e4 + (e >> 1)] |= f2bf(a) << 16; kt[2 * e4 + (e >> 1)] |= f2bf(c) << 16; } else { qt[2 * e4 + (e >> 1)] = f2bf(a); kt[2 * e4 + (e >> 1)] = f2bf(c); } } }
#pragma unroll
              for (int e = 0; e < 4; ++e) { const int col = c16 + 4 * e4 + e;
                  *(LAS bf16*)(lds + HG_KE + col * 144 + sperm * 2) = (bf16)f2bf(ke[e]);
                  const unsigned vw = i8[e4 >> 1][(2 * e4 + (e >> 1)) & 3]; *(LAS bf16*)(lds + HG_VT + col * 144 + sperm * 2) = (bf16)((e & 1) ? (vw >> 16) : (vw & 0xffffu)); } }
          if (OUT) { *(LAS v4u*)(lds + HG_QT + stok * 272 + c16 * 2) = (v4u){qt[0], qt[1], qt[2], qt[3]}; *(LAS v4u*)(lds + HG_QT + stok * 272 + c16 * 2 + 16) = (v4u){qt[4], qt[5], qt[6], qt[7]};
                     *(LAS v4u*)(lds + HG_KT + stok * 272 + c16 * 2) = (v4u){kt[0], kt[1], kt[2], kt[3]}; *(LAS v4u*)(lds + HG_KT + stok * 272 + c16 * 2 + 16) = (v4u){kt[4], kt[5], kt[6], kt[7]}; } }
        __syncthreads();
        if (ch + 1 < HSEG / 64) HG_RAWLOAD(t0 + 64);
        if (OUT) {
            f32x16 X0, X1, O;
#pragma unroll
            for (int i = 0; i < 16; ++i) { X0[i] = 0.f; X1[i] = 0.f; O[i] = 0.f; }
            const LAS unsigned char* qtp = lds + HG_QT + (32 * tr + r) * 272 + hf * 16;
#pragma unroll
            for (int ks = 0; ks < 8; ++ks) { const s16x8 bq = *(const LAS s16x8*)(qtp + ks * 32);
                const s16x8 a0 = *(const LAS s16x8*)(lds + HG_KT + r * 272 + hf * 16 + ks * 32); X0 = __builtin_amdgcn_mfma_f32_32x32x16_bf16(a0, bq, X0, 0, 0, 0);
                if (tr == 1) { const s16x8 a1 = *(const LAS s16x8*)(lds + HG_KT + (32 + r) * 272 + hf * 16 + ks * 32); X1 = __builtin_amdgcn_mfma_f32_32x32x16_bf16(a1, bq, X1, 0, 0, 0); } }
#pragma unroll
            for (int i = 0; i < 16; ++i) { const bool keep = crow16(i, hf) <= r; if (tr == 0) X0[i] = keep ? X0[i] : 0.f; else X1[i] = keep ? X1[i] : 0.f; }
            const LAS unsigned char* vtp = lds + HG_VT + (32 * vq + r) * 144 + hf * 16;
#pragma unroll
            for (int s2 = 0; s2 < 2; ++s2) { v4u pw; pw.x = cvtpk(X0[8 * s2], X0[8 * s2 + 1]); pw.y = cvtpk(X0[8 * s2 + 2], X0[8 * s2 + 3]); pw.z = cvtpk(X0[8 * s2 + 4], X0[8 * s2 + 5]); pw.w = cvtpk(X0[8 * s2 + 6], X0[8 * s2 + 7]);
                const s16x8 bv = *(const LAS s16x8*)(vtp + (16 * s2) * 2); O = __builtin_amdgcn_mfma_f32_32x32x16_bf16(__builtin_bit_cast(s16x8, pw), bv, O, 0, 0, 0); }
            if (tr == 1) {
#pragma unroll
                for (int s2 = 0; s2 < 2; ++s2) { v4u pw; pw.x = cvtpk(X1[8 * s2], X1[8 * s2 + 1]); pw.y = cvtpk(X1[8 * s2 + 2], X1[8 * s2 + 3]); pw.z = cvtpk(X1[8 * s2 + 4], X1[8 * s2 + 5]); pw.w = cvtpk(X1[8 * s2 + 6], X1[8 * s2 + 7]);
                    const s16x8 bv = *(const LAS s16x8*)(vtp + (32 + 16 * s2) * 2); O = __builtin_amdgcn_mfma_f32_32x32x16_bf16(__builtin_bit_cast(s16x8, pw), bv, O, 0, 0, 0); } }
            const LAS unsigned char* stp = lds + HG_ST + (32 * vq + r) * 272 + hf * 16;
#pragma unroll
            for (int ks = 0; ks < 8; ++ks) { const s16x8 aq = *(const LAS s16x8*)(qtp + ks * 32), bs = *(const LAS s16x8*)(stp + ks * 32); O = __builtin_amdgcn_mfma_f32_32x32x16_bf16(aq, bs, O, 0, 0, 0); }
#pragma unroll
            for (int i = 0; i < 16; ++i) G[(32 * tr + crow16(i, hf)) * 128 + 32 * vq + r] = O[i];
        }
#pragma unroll
        for (int dd = 0; dd < 2; ++dd) { const int dr = 2 * tr + dd;
#pragma unroll
            for (int g4 = 0; g4 < 4; ++g4) { const f32x4 ge = *(const LAS f32x4*)(EGE + 32 * dr + 8 * g4 + 4 * hf);
                S[dd][4 * g4] *= ge.x; S[dd][4 * g4 + 1] *= ge.y; S[dd][4 * g4 + 2] *= ge.z; S[dd][4 * g4 + 3] *= ge.w; }
#pragma unroll
            for (int ks = 0; ks < 4; ++ks) { const s16x8 a = *(const LAS s16x8*)(lds + HG_KE + (32 * dr + r) * 144 + hf * 16 + ks * 32), bv = *(const LAS s16x8*)(lds + HG_VT + (32 * vq + r) * 144 + hf * 16 + ks * 32);
                S[dd] = __builtin_amdgcn_mfma_f32_32x32x16_bf16(a, bv, S[dd], 0, 0, 0); } }
        __syncthreads();
        if (OUT) {
            float ov[16]; float ss = 0.f;
#pragma unroll
            for (int e4 = 0; e4 < 4; ++e4) { const f32x4 o4 = *(const LAS f32x4*)(G + stok * 128 + c16 + 4 * e4); ov[4 * e4] = o4.x; ov[4 * e4 + 1] = o4.y; ov[4 * e4 + 2] = o4.z; ov[4 * e4 + 3] = o4.w;
                ss += (o4.x * o4.x + o4.y * o4.y) + (o4.z * o4.z + o4.w * o4.w); }
            ss += xorf<1>(ss); ss += xorf<2>(ss); ss += xorf<4>(ss);
            const float rr = 1.f / sqrtf(ss * (1.f / 128.f) + 1e-6f);
            unsigned ow[8];
#pragma unroll
            for (int w = 0; w < 8; ++w) { const unsigned gw_ = g8[w >> 2][w & 3]; ow[w] = cvtpk(ov[2 * w] * rr * ng16[2 * w] * sigmoidf_(bflo(gw_)), ov[2 * w + 1] * rr * ng16[2 * w + 1] * sigmoidf_(bfhi(gw_))); }
            bf16* mrow = mix + (t0 + stok) * 1024 + hh * 128 + c16;
            *(v4u*)mrow = (v4u){ow[0], ow[1], ow[2], ow[3]}; *(v4u*)(mrow + 8) = (v4u){ow[4], ow[5], ow[6], ow[7]};
            __syncthreads();
        }
    }
#undef HG_RAWLOAD
    if (!OUT) {
#pragma unroll
        for (int dd = 0; dd < 2; ++dd)
#pragma unroll
            for (int i = 0; i < 16; ++i) Sp[(32 * (2 * tr + dd) + crow16(i, hf)) * 128] = S[dd][i];
        if (cpart == 3) Dseg[(size_t)unit * 128 + cd] = __builtin_amdgcn_exp2f(gsum);
    }
}
__device__ __forceinline__ void hgrn_scan(float* Sloc, const float* Dseg, size_t gtid, size_t gthreads) {
    for (size_t idx = gtid; idx < (size_t)NBATCH * HG_H * 16384; idx += gthreads) { const int bh = (int)(idx >> 14), e = (int)(idx & 16383), d = e >> 7; float cur = 0.f;
        float* __restrict__ sp = Sloc + (size_t)bh * HNSEG * 16384 + e; const float* __restrict__ dp = Dseg + (size_t)bh * HNSEG * 128 + d;
        for (int s0 = 0; s0 < HNSEG; s0 += 16) { float tv[16], dv[16];
#pragma unroll
            for (int k = 0; k < 16; ++k) { tv[k] = sp[(size_t)(s0 + k) * 16384]; dv[k] = dp[(s0 + k) * 128]; }
#pragma unroll
            for (int k = 0; k < 16; ++k) { sp[(size_t)(s0 + k) * 16384] = cur; cur = dv[k] * cur + tv[k]; } } }
}

template <bool MASK>
__device__ __forceinline__ void attn4(const LAS unsigned* Ks, const LAS bf16* Vs, const LAS float* qst, LAS float* pb, int lane, const int (&tq)[4], int kbase, float slope,
                                      float (&mo)[4], float (&lo)[4], float (&oo)[4]) {
    float sc[4][4];
#pragma unroll
    for (int a = 0; a < 4; ++a)
#pragma unroll
        for (int c = 0; c < 4; ++c) sc[a][c] = 0.f;
#pragma unroll 4
    for (int dd = 0; dd < 32; ++dd) {
        f32x2 qv[4];
#pragma unroll
        for (int qi = 0; qi < 4; ++qi) qv[qi] = *(const LAS f32x2*)(qst + qi * 64 + 2 * dd);
#pragma unroll
        for (int kk = 0; kk < 4; ++kk) { const unsigned kw = Ks[(lane + 64 * kk) * 33 + dd]; const float k0 = bflo(kw), k1 = bfhi(kw);
#pragma unroll
            for (int qi = 0; qi < 4; ++qi) sc[qi][kk] += qv[qi].x * k0 + qv[qi].y * k1; }
    }
#pragma unroll
    for (int qi = 0; qi < 4; ++qi) { float mx = -INFINITY;
#pragma unroll
        for (int kk = 0; kk < 4; ++kk) { const int pos = kbase + lane + 64 * kk; float lg = sc[qi][kk] * 0.125f - slope * (float)(tq[qi] - pos); if (MASK && pos > tq[qi]) lg = -INFINITY; sc[qi][kk] = lg; mx = fmaxf(mx, lg); }
        mx = wave_max(mx); float s = 0.f;
#pragma unroll
        for (int kk = 0; kk < 4; ++kk) { const float p = __builtin_amdgcn_exp2f((sc[qi][kk] - mx) * 1.4426950408889634f); pb[qi * 256 + lane + 64 * kk] = p; s += p; }
        lo[qi] = wave_sum(s); mo[qi] = mx; }
    float o[4] = {0.f, 0.f, 0.f, 0.f};
#pragma unroll 4
    for (int k4 = 0; k4 < 64; ++k4) { f32x4 p4[4];
#pragma unroll
        for (int qi = 0; qi < 4; ++qi) p4[qi] = *(const LAS f32x4*)(pb + qi * 256 + 4 * k4);
#pragma unroll
        for (int jj = 0; jj < 4; ++jj) { const float vv = bf2f(Vs[(4 * k4 + jj) * 64 + lane]);
#pragma unroll
            for (int qi = 0; qi < 4; ++qi) o[qi] += p4[qi][jj] * vv; } }
#pragma unroll
    for (int qi = 0; qi < 4; ++qi) oo[qi] = o[qi];
}
constexpr int AT_KS = 0, AT_VS = 33792, AT_WV = 66560, AT_WVB = 5120;

__device__ __forceinline__ void memattn_unit(LAS unsigned char* lds, const bf16* h, int NC, int qoff, const bf16* kv, bf16* mix, int unit, int tid, int wave, int lane) {
    const int chunk = unit & 31, bm = unit >> 5, mh = bm & 3, b = bm >> 2;
    LAS unsigned* Ks = (LAS unsigned*)(lds + AT_KS); LAS unsigned* Vs32 = (LAS unsigned*)(lds + AT_VS);
    LAS float* qst = (LAS float*)(lds + AT_WV + wave * AT_WVB); LAS float* pb = qst + 256;
    for (int i = 0; i < 16; ++i) { const int idx = tid + 512 * i, r = idx >> 5, dd = idx & 31; const unsigned* src = (const unsigned*)(kv + (size_t)(b * 256 + r) * 512 + mh * 64);
        Ks[r * 33 + dd] = src[dd]; Vs32[r * 32 + dd] = src[128 + dd]; }
    __syncthreads();
    for (int qd = 0; qd < 16; ++qd) { const size_t tg = (size_t)b * SEQ + chunk * 512 + wave * 64 + qd * 4;
#pragma unroll
        for (int qi = 0; qi < 4; ++qi) qst[qi * 64 + lane] = bf2f(h[(tg + qi) * NC + qoff + mh * 64 + lane]);
        const int tq[4] = {0, 0, 0, 0}; float m[4], l[4], o[4];
        attn4<false>(Ks, (const LAS bf16*)Vs32, qst, pb, lane, tq, 0, 0.f, m, l, o);
#pragma unroll
        for (int qi = 0; qi < 4; ++qi) mix[(tg + qi) * 1024 + MIXW + mh * 64 + lane] = (bf16)f2bf(o[qi] / l[qi]); }
    __syncthreads();
}

constexpr int AT2_K = 0, AT2_KROW = 176, AT2_V = 256 * AT2_KROW, AT2_VROW = 528, AT2_SCR = AT2_V + 64 * AT2_VROW, AT2_SCRW = 4864;
__device__ __forceinline__ void stage_kv_images(LAS unsigned char* lds, const bf16* kp, const bf16* vp, size_t row_stride, int tid) {
    v4u kx[4], vx[4];
#pragma unroll
    for (int i = 0; i < 4; ++i) { const int idx = tid + 512 * i, key = idx >> 3, c = idx & 7; kx[i] = *(const v4u*)(kp + (size_t)key * row_stride + 8 * c); vx[i] = *(const v4u*)(vp + (size_t)key * row_stride + 8 * c); }
    __builtin_amdgcn_sched_barrier(0);
#pragma unroll
    for (int i = 0; i < 4; ++i) { const int idx = tid + 512 * i, key = idx >> 3, c = idx & 7;
        *(LAS v4u*)(lds + AT2_K + key * AT2_KROW + c * 16) = kx[i];
        const int pos = (key & ~15) | (key & 3) | ((key & 4) << 1) | ((key & 8) >> 1);
        LAS bf16* vt = (LAS bf16*)(lds + AT2_V) + pos;
#pragma unroll
        for (int w = 0; w < 4; ++w) { vt[(8 * c + 2 * w) * (AT2_VROW / 2)] = (bf16)(vx[i][w] & 0xffffu); vt[(8 * c + 2 * w + 1) * (AT2_VROW / 2)] = (bf16)(vx[i][w] >> 16); } }
    if (tid < 256) { const unsigned pb = f2bf((float)tid); const v4u e0 = {pb | (pb << 16), 0x3F803F80u, 0u, 0u}, z = {0u, 0u, 0u, 0u};
        *(LAS v4u*)(lds + AT2_K + tid * AT2_KROW + 128) = e0; *(LAS v4u*)(lds + AT2_K + tid * AT2_KROW + 144) = z; }
}
template <bool MASK>
__device__ __forceinline__ void attn_tile32(const LAS unsigned char* lds, const s16x8 (&qf)[4], int lane, float dist0, unsigned qx, unsigned qx2, bool own, f32x16 (&o)[2], float& mrow, float& lrow) {
    const int r = lane & 31, hf = lane >> 5;
    const v4u qxv = {qx, qx2, 0u, 0u}; const s16x8 qe = __builtin_bit_cast(s16x8, qxv);
    f32x16 acc[8];
    const LAS unsigned char* kb = lds + AT2_K + r * AT2_KROW + hf * 16;
    constexpr int NKS = MASK ? 5 : 4;
    s16x8 kf[NKS];
#pragma unroll
    for (int s = 0; s < NKS; ++s) kf[s] = *(const LAS s16x8*)(kb + s * 32);
#pragma unroll
    for (int kt = 0; kt < 8; ++kt) {
#pragma unroll
        for (int i = 0; i < 16; ++i) acc[kt][i] = 0.f;
#pragma unroll
        for (int s = 0; s < NKS; ++s) { acc[kt] = __builtin_amdgcn_mfma_f32_32x32x16_bf16(kf[s], s < 4 ? qf[s < 4 ? s : 0] : qe, acc[kt], 0, 0, 0);
            if (kt + 1 < 8) kf[s] = *(const LAS s16x8*)(kb + (kt + 1) * 32 * AT2_KROW + s * 32); }
        __builtin_amdgcn_sched_barrier(0); }
    float mx = -INFINITY;
    if (MASK) { mx = 0.f;
        if (own) { const float base2 = dist0 - 4.f * (float)hf;
#pragma unroll
            for (int kt = 0; kt < 8; ++kt)
#pragma unroll
                for (int i = 0; i < 16; ++i) { const float dist = base2 - (float)(32 * kt + (i & 3) + 8 * (i >> 2)); acc[kt][i] = dist < 0.f ? -INFINITY : acc[kt][i]; } }
    } else {
#pragma unroll
        for (int kt = 0; kt < 8; ++kt)
#pragma unroll
            for (int i = 0; i < 16; ++i) mx = fmaxf(mx, acc[kt][i]);
        mx = fmaxf(mx, xor32f(mx, lane));
    }
    f32x2 sum2 = {0.f, 0.f};
#pragma unroll
    for (int i = 0; i < 16; ++i) { o[0][i] = 0.f; o[1][i] = 0.f; }
    const LAS unsigned char* vb = lds + AT2_V + r * AT2_VROW + hf * 16;
    s16x8 vf[4];
#pragma unroll
    for (int s2 = 0; s2 < 2; ++s2)
#pragma unroll
        for (int dt = 0; dt < 2; ++dt) vf[2 * s2 + dt] = *(const LAS s16x8*)(vb + dt * 32 * AT2_VROW + (16 * s2) * 2);
#pragma unroll
    for (int kt = 0; kt < 8; ++kt) {
#pragma unroll
        for (int i = 0; i < 16; ++i) acc[kt][i] = __builtin_amdgcn_exp2f(MASK ? acc[kt][i] : acc[kt][i] - mx);
#pragma unroll
        for (int i = 0; i < 8; ++i) sum2 += (f32x2){acc[kt][2 * i], acc[kt][2 * i + 1]};
#pragma unroll
        for (int s2 = 0; s2 < 2; ++s2) { v4u pw; pw.x = cvtpk(acc[kt][8 * s2], acc[kt][8 * s2 + 1]); pw.y = cvtpk(acc[kt][8 * s2 + 2], acc[kt][8 * s2 + 3]);
            pw.z = cvtpk(acc[kt][8 * s2 + 4], acc[kt][8 * s2 + 5]); pw.w = cvtpk(acc[kt][8 * s2 + 6], acc[kt][8 * s2 + 7]); const s16x8 pf = __builtin_bit_cast(s16x8, pw);
#pragma unroll
            for (int dt = 0; dt < 2; ++dt) { o[dt] = __builtin_amdgcn_mfma_f32_32x32x16_bf16(vf[2 * s2 + dt], pf, o[dt], 0, 0, 0);
                if (kt + 1 < 8) vf[2 * s2 + dt] = *(const LAS s16x8*)(vb + dt * 32 * AT2_VROW + (32 * (kt + 1) + 16 * s2) * 2); } }
        __builtin_amdgcn_sched_barrier(0); }
    float sum = sum2.x + sum2.y; sum += xor32f(sum, lane);
    if (!MASK) mrow = mx;
    lrow = sum;
}
__device__ __forceinline__ void memattn_unit2(LAS unsigned char* lds, const bf16* h, int NC, int qoff, const bf16* kv  , bf16* mix, int unit, int tid, int wave, int lane) {
    const int chunk = unit & 63, bm = unit >> 6, mh = bm & 3, b = bm >> 2, r = lane & 31, hf = lane >> 5;
    const bf16* kvrow0 = kv + (size_t)(b * 256) * 2048 + mh * 64;
    stage_kv_images(lds, kvrow0, kvrow0 + 256, 2048, tid);
    __syncthreads();
    { const size_t tg = (size_t)b * SEQ + chunk * 256 + wave * 32 + r;
        f32x16 o[2]; float m2, l; s16x8 qf[4];
#pragma unroll
        for (int s = 0; s < 4; ++s) qf[s] = *(const s16x8*)(h + tg * NC + qoff + mh * 64 + 16 * s + 8 * hf);
        attn_tile32<false>(lds, qf, lane, 0.f, 0u, 0u, false, o, m2, l);
        const float inv = 1.f / l; bf16* mp = mix + tg * 1024 + MIXW + mh * 64 + 4 * hf;
#pragma unroll
        for (int dt = 0; dt < 2; ++dt)
#pragma unroll
            for (int g = 0; g < 4; ++g) { v2u w; w.x = cvtpk(o[dt][4 * g] * inv, o[dt][4 * g + 1] * inv); w.y = cvtpk(o[dt][4 * g + 2] * inv, o[dt][4 * g + 3] * inv); *(v2u*)(mp + 32 * dt + 8 * g) = w; } }
    __syncthreads();
}
__device__ __forceinline__ void kmean_unit(LAS unsigned char* lds, const bf16* h, float* kmean, float* kmaxg, int unit, int tid, int wave) {
    const int n = unit & 63, bh = unit >> 6, hh = bh % MB_H, b = bh / MB_H, d = tid & 63, part = tid >> 6;
    LAS float* red = (LAS float*)lds;
    float s = 0.f; const bf16* p = h + ((size_t)b * SEQ + n * 256 + part * 32) * NC_M + 768 + hh * 64 + d;
    for (int i = 0; i < 32; ++i) s += bf2f(p[(size_t)i * NC_M]);
    float ss = 0.f; { const v4u* kp = (const v4u*)(h + ((size_t)b * SEQ + n * 256 + (tid >> 1)) * NC_M + 768 + hh * 64 + (tid & 1) * 32);
#pragma unroll
        for (int w = 0; w < 4; ++w) { const v4u x = kp[w]; ss += bflo(x.x) * bflo(x.x) + bfhi(x.x) * bfhi(x.x) + bflo(x.y) * bflo(x.y) + bfhi(x.y) * bfhi(x.y) + bflo(x.z) * bflo(x.z) + bfhi(x.z) * bfhi(x.z) + bflo(x.w) * bflo(x.w) + bfhi(x.w) * bfhi(x.w); } }
    ss += xorf<1>(ss); ss = wave_max(ss);
    red[part * 64 + d] = s; if ((tid & 63) == 0) red[512 + wave] = ss; __syncthreads();
    if (tid < 64) { float a = 0.f; for (int pp = 0; pp < 8; ++pp) a += red[pp * 64 + tid]; a *= (1.f / 256.f);
        const unsigned hi = f2bf(a), lo = f2bf(a - __builtin_bit_cast(float, hi << 16)); bf16* kmh = (bf16*)kmean; kmh[((size_t)bh * 64 + n) * 64 + tid] = (bf16)hi; kmh[(size_t)24 * 4096 + ((size_t)bh * 64 + n) * 64 + tid] = (bf16)lo; }
    if (tid == 0) { float mx = 0.f; for (int w = 0; w < 8; ++w) mx = fmaxf(mx, red[512 + w]); kmaxg[bh * 64 + n] = sqrtf(mx) * 1.001f; }
    __syncthreads();
}
__device__ __forceinline__ void gate_unit_core(const s16x8 (&qf)[4], const s16x8 (&kf)[4], const bf16* kmh, const bf16* kml, LAS int* hist, const LAS float* kmx, int* selinfo, int bh, int c, int t, int lane, unsigned& sel, unsigned& rr) {
    const int hh = bh % MB_H, b = bh / MB_H, hf = lane >> 5, r = lane & 31;
    int s0 = 0, s1 = 0, s2 = 0, r0 = 0, r1 = 0, r2 = 0, ns = 0;
    float v0 = -INFINITY, v1 = -INFINITY, v2 = -INFINITY, qn = 0.f, lown = 0.f;
    if (c > 0) {
        const int ntile = (c + 31) >> 5, ch = c - 4 * hf;
        s16x8 ah[2][4], al[2][4];
#pragma unroll
        for (int tile = 0; tile < 2; ++tile) if (tile < ntile) { const size_t ko = ((size_t)bh * 64 + 32 * tile + r) * 64 + 8 * hf;
#pragma unroll
            for (int ks = 0; ks < 4; ++ks) { ah[tile][ks] = *(const s16x8*)(kmh + ko + 16 * ks); al[tile][ks] = *(const s16x8*)(kml + ko + 16 * ks); } }
#pragma unroll
        for (int tile = 0; tile < 2; ++tile) if (tile < ntile) {
            f32x16 X;
#pragma unroll
            for (int i = 0; i < 16; ++i) X[i] = 0.f;
#pragma unroll
            for (int ks = 0; ks < 4; ++ks) { X = __builtin_amdgcn_mfma_f32_32x32x16_bf16(ah[tile][ks], qf[ks], X, 0, 0, 0); X = __builtin_amdgcn_mfma_f32_32x32x16_bf16(al[tile][ks], qf[ks], X, 0, 0, 0); }
#pragma unroll
            for (int i = 0; i < 16; ++i) { const int n = 32 * tile + (i & 3) + 8 * (i >> 2); const float g = (n < ch) ? X[i] : -INFINITY;
                if (g > v0) { v2 = v1; s2 = s1; v1 = v0; s1 = s0; v0 = g; s0 = n; } else if (g > v1) { v2 = v1; s2 = s1; v1 = g; s1 = n; } else if (g > v2) { v2 = g; s2 = n; } }
        }
        s0 += 4 * hf; s1 += 4 * hf; s2 += 4 * hf;
        { float qq = 0.f, qk = 0.f;
#pragma unroll
          for (int s = 0; s < 4; ++s)
#pragma unroll
              for (int jj = 0; jj < 8; ++jj) { const float qv = bf2f((bf16)qf[s][jj]), kv = bf2f((bf16)kf[s][jj]); qq += qv * qv; qk += qv * kv; }
          qq += xor32f(qq, lane); qk += xor32f(qk, lane);
          qn = sqrtf(qq) * 1.001f; lown = qk; }
        { float pv[3]; int ps[3]; const int pl = (lane ^ 32) << 2;
          pv[0] = __builtin_bit_cast(float, __builtin_amdgcn_ds_bpermute(pl, __builtin_bit_cast(int, v0))); pv[1] = __builtin_bit_cast(float, __builtin_amdgcn_ds_bpermute(pl, __builtin_bit_cast(int, v1)));
          pv[2] = __builtin_bit_cast(float, __builtin_amdgcn_ds_bpermute(pl, __builtin_bit_cast(int, v2)));
          ps[0] = __builtin_amdgcn_ds_bpermute(pl, s0); ps[1] = __builtin_amdgcn_ds_bpermute(pl, s1); ps[2] = __builtin_amdgcn_ds_bpermute(pl, s2);
#pragma unroll
          for (int k = 0; k < 3; ++k) { const float g = pv[k]; const int n = ps[k];
              if (g > v0 || (g == v0 && n < s0)) { v2 = v1; s2 = s1; v1 = v0; s1 = s0; v0 = g; s0 = n; } else if (g > v1 || (g == v1 && n < s1)) { v2 = v1; s2 = s1; v1 = g; s1 = n; } else if (g > v2 || (g == v2 && n < s2)) { v2 = g; s2 = n; } } }
    }
    sel = 0u; rr = 0u;
    if (hf == 0) {
        ns = c < 3 ? c : 3; s0 &= 63; s1 &= 63; s2 &= 63;
        { const float slope2 = (hh < 8 ? ldexpf(1.0f, -(hh + 1)) : ldexpf(0.70710678118654752f, -(hh - 8))) * 1.4426950408889634f;
          const bool k0 = ns > 0 && (qn * kmx[s0] - slope2 * (float)(t - (s0 * 256 + 255)) - lown) > -64.f;
          const bool k1 = ns > 1 && (qn * kmx[s1] - slope2 * (float)(t - (s1 * 256 + 255)) - lown) > -64.f;
          const bool k2 = ns > 2 && (qn * kmx[s2] - slope2 * (float)(t - (s2 * 256 + 255)) - lown) > -64.f;
          ns = (k0 ? 1 : 0) | (k1 ? 2 : 0) | (k2 ? 4 : 0); }
        if (ns & 1) r0 = __hip_atomic_fetch_add(hist + s0, 1, __ATOMIC_RELAXED, __HIP_MEMORY_SCOPE_WORKGROUP);
        if (ns & 2) r1 = __hip_atomic_fetch_add(hist + s1, 1, __ATOMIC_RELAXED, __HIP_MEMORY_SCOPE_WORKGROUP);
        if (ns & 4) r2 = __hip_atomic_fetch_add(hist + s2, 1, __ATOMIC_RELAXED, __HIP_MEMORY_SCOPE_WORKGROUP);
        selinfo[((size_t)b * SEQ + t) * MB_H + hh] = ns;
        sel = (unsigned)s0 | ((unsigned)s1 << 6) | ((unsigned)s2 << 12) | ((unsigned)ns << 18); rr = (unsigned)r0 | ((unsigned)r1 << 8) | ((unsigned)r2 << 16);
    }
}
__device__ __forceinline__ void moba_gate_wg(LAS unsigned char* lds, const bf16* h, const float* kmean, const float* kmaxg, unsigned* gcount, int* selinfo, unsigned* list, int blk, int tid) {
    constexpr int NU = 24 * MB_NB / GRID;
    static_assert(NU * GRID == 24 * MB_NB && GRID % 64 == 0 && NU * 64 <= NTHR, "gate deal");
    const int lane = tid & 63, r = lane & 31, hf = lane >> 5, wv = tid >> 6;
    const bf16* kmh = (const bf16*)kmean; const bf16* kml = kmh + (size_t)24 * 4096;
    LAS int* hist = (LAS int*)(lds + 16384); LAS int* base = hist + NU * 64; LAS float* kmx = (LAS float*)(base + NU * 64);
    if (tid < NU * 64) { const int bh = (blk >> 6) + 4 * (tid >> 6); hist[tid] = 0; kmx[tid] = kmaxg[bh * 64 + (tid & 63)]; }
    unsigned sel[NU], rr[NU];
    s16x8 qf[4], kf[4];
#define GU_BH(k) ((blk >> 6) + 4 * (k))
#define GU_C(k) (((k) & 1) ? 63 - (blk & 63) : (blk & 63))
#define GU_T(k) (GU_C(k) * 256 + wv * 32 + r)
    { const bf16* qp = h + ((size_t)(GU_BH(0) / MB_H) * SEQ + GU_T(0)) * NC_M + (GU_BH(0) % MB_H) * 64 + 8 * hf;
#pragma unroll
      for (int s = 0; s < 4; ++s) { qf[s] = *(const s16x8*)(qp + 16 * s); kf[s] = *(const s16x8*)(qp + 768 + 16 * s); } }
    __syncthreads();
#pragma unroll
    for (int k = 0; k < NU; ++k) {
        s16x8 qn_[4], kn_[4];
        if (k + 1 < NU) { const bf16* qp = h + ((size_t)(GU_BH(k + 1) / MB_H) * SEQ + GU_T(k + 1)) * NC_M + (GU_BH(k + 1) % MB_H) * 64 + 8 * hf;
#pragma unroll
            for (int s = 0; s < 4; ++s) { qn_[s] = *(const s16x8*)(qp + 16 * s); kn_[s] = *(const s16x8*)(qp + 768 + 16 * s); } }
        gate_unit_core(qf, kf, kmh, kml, hist + k * 64, kmx + k * 64, selinfo, GU_BH(k), GU_C(k), GU_T(k), lane, sel[k], rr[k]);
        if (k + 1 < NU) {
#pragma unroll
            for (int s = 0; s < 4; ++s) { qf[s] = qn_[s]; kf[s] = kn_[s]; } }
    }
    __syncthreads();
    if (tid < NU * 64) { const int hc = hist[tid]; if (hc > 0) base[tid] = (int)__hip_atomic_fetch_add(gcount + GU_BH(tid >> 6) * 64 + (tid & 63), (unsigned)hc, __ATOMIC_RELAXED, __HIP_MEMORY_SCOPE_AGENT); }
    __syncthreads();
    if (hf == 0) {
#pragma unroll
        for (int k = 0; k < NU; ++k) { unsigned* lp = list + ((size_t)GU_BH(k) * 64 << 14); const unsigned sl = sel[k], rk = rr[k], t = (unsigned)GU_T(k); const int s0 = sl & 63, s1 = (sl >> 6) & 63, s2 = (sl >> 12) & 63;
            if (sl & (1u << 18)) lp[((size_t)s0 << 14) + base[k * 64 + s0] + (rk & 255u)] = t;
            if (sl & (2u << 18)) lp[((size_t)s1 << 14) + base[k * 64 + s1] + ((rk >> 8) & 255u)] = t | (1u << 14);
            if (sl & (4u << 18)) lp[((size_t)s2 << 14) + base[k * 64 + s2] + ((rk >> 16) & 255u)] = t | (2u << 14); } }
#undef GU_BH
#undef GU_C
#undef GU_T
    __syncthreads();
}
__device__ __forceinline__ void moba_attn_item(LAS unsigned char* lds, const bf16* h, const unsigned* gcount, const unsigned* list, float* po, float* pml, int item, int tid, int wave, int lane) {
    const int n = item / 24, bh = item - n * 24, hh = bh % MB_H, b = bh / MB_H;
    LAS unsigned* Ks = (LAS unsigned*)(lds + AT_KS); LAS unsigned* Vs32 = (LAS unsigned*)(lds + AT_VS);
    LAS float* qst = (LAS float*)(lds + AT_WV + wave * AT_WVB); LAS float* pb = qst + 256;
    for (int i = 0; i < 16; ++i) { const int idx = tid + 512 * i, r = idx >> 5, dd = idx & 31; const unsigned* src = (const unsigned*)(h + ((size_t)b * SEQ + n * 256 + r) * NC_M + hh * 64);
        Ks[r * 33 + dd] = src[384 + dd]; Vs32[r * 32 + dd] = src[768 + dd]; }
    __syncthreads();
    const int cnt = (int)gcount[bh * 64 + n], total = 256 + cnt, nquads = (total + 3) >> 2;
    const float slope = hh < 8 ? ldexpf(1.0f, -(hh + 1)) : ldexpf(0.70710678118654752f, -(hh - 8));
    const unsigned* lp = list + (((size_t)bh * 64 + n) << 14);
    for (int quad = wave; quad < nquads; quad += 8) {
        int tq[4], slot[4];
#pragma unroll
        for (int qi = 0; qi < 4; ++qi) { int idx = quad * 4 + qi; idx = idx < total ? idx : total - 1;
            if (idx < 256) { tq[qi] = n * 256 + idx; slot[qi] = 3; } else { const unsigned e = lp[idx - 256]; tq[qi] = (int)(e & 16383u); slot[qi] = (int)(e >> 14); } }
#pragma unroll
        for (int qi = 0; qi < 4; ++qi) qst[qi * 64 + lane] = bf2f(h[((size_t)b * SEQ + tq[qi]) * NC_M + hh * 64 + lane]);
        float m[4], l[4], o[4];
        attn4<true>(Ks, (const LAS bf16*)Vs32, qst, pb, lane, tq, n * 256, slope, m, l, o);
#pragma unroll
        for (int qi = 0; qi < 4; ++qi) if (quad * 4 + qi < total) { const size_t pi = (((size_t)b * SEQ + tq[qi]) * MB_H + hh) * 4 + slot[qi];
            po[pi * 64 + lane] = o[qi]; if (lane == 0) { pml[pi * 2] = m[qi]; pml[pi * 2 + 1] = l[qi]; } }
    }
    __syncthreads();
}

__device__ __forceinline__ void moba_attn_item2(LAS unsigned char* lds, const bf16* h, const float* kmaxg, const unsigned* gcount, const unsigned* list, bf16* po, float* pml, int item, int tid, int wave, int lane) {
    const int n = item / 24, bh = item - n * 24, hh = bh % MB_H, b = bh / MB_H, r = lane & 31, hf = lane >> 5;
    const bf16* hrow0 = h + ((size_t)b * SEQ + n * 256) * NC_M + hh * 64;
    stage_kv_images(lds, hrow0 + 768, hrow0 + 1536, NC_M, tid);
    __syncthreads();
    const int cnt = (int)gcount[bh * 64 + n], total = 256 + cnt, ntiles = (total + 31) >> 5;
    const float slope2 = (hh < 8 ? ldexpf(1.0f, -(hh + 1)) : ldexpf(0.70710678118654752f, -(hh - 8))) * 1.4426950408889634f;
    const unsigned shi = f2bf(slope2), slo = f2bf(slope2 - __builtin_bit_cast(float, shi << 16)); const unsigned qx = hf == 0 ? (shi | (slo << 16)) : 0u;
    const unsigned* lp = list + (((size_t)bh * 64 + n) << 14);
    const float kmx1 = kmaxg[bh * 64 + n];
    const bf16* hq = h + (size_t)b * SEQ * NC_M + hh * 64 + 8 * hf;
#pragma unroll 1
    for (int tile = wave; tile < ntiles; tile += NWAVES) {
        int idx = tile * 32 + r; const bool valid = idx < total; idx = valid ? idx : total - 1;
        int tq, slot; if (idx < 256) { tq = n * 256 + idx; slot = 3; } else { const unsigned e = lp[idx - 256]; tq = (int)(e & 16383u); slot = (int)(e >> 14); }
        s16x8 qf[4]; { const bf16* qp = hq + (size_t)tq * NC_M;
#pragma unroll
            for (int s = 0; s < 4; ++s) qf[s] = *(const s16x8*)(qp + 16 * s); }
        f32x16 o[2]; float m2, l; const float dist0 = (float)(tq - n * 256);
        unsigned qx2;
        { float qq = 0.f;
#pragma unroll
          for (int s = 0; s < 4; ++s)
#pragma unroll
              for (int jj = 0; jj < 8; ++jj) { const float qv = bf2f((bf16)qf[s][jj]); qq += qv * qv; }
          qq += xor32f(qq, lane);
          const float sh = sqrtf(qq) * kmx1 + slope2 * fminf(dist0, 255.f);
          const unsigned nh = f2bf(-sh), nl = f2bf(-sh - __builtin_bit_cast(float, nh << 16)); qx2 = hf == 0 ? (nh | (nl << 16)) : 0u;
          m2 = -(__builtin_bit_cast(float, nh << 16) + __builtin_bit_cast(float, nl << 16)); }
        attn_tile32<true>(lds, qf, lane, dist0, qx, qx2, tile < 8, o, m2, l);
        { LAS unsigned char* sw = lds + AT2_SCR + wave * AT2_SCRW; const int pi = valid ? (int)((((size_t)b * SEQ + tq) * MB_H + hh) * 4 + slot) : -1;
#pragma unroll
          for (int dt = 0; dt < 2; ++dt)
#pragma unroll
              for (int g = 0; g < 4; ++g) { v2u w; w.x = cvtpk(o[dt][4 * g], o[dt][4 * g + 1]); w.y = cvtpk(o[dt][4 * g + 2], o[dt][4 * g + 3]); *(LAS v2u*)(sw + r * 144 + (32 * dt + 8 * g + 4 * hf) * 2) = w; }
          if (hf == 0) { *(LAS int*)(sw + 4608 + 4 * r) = pi; if (valid) { pml[(size_t)pi * 2] = m2 - slope2 * dist0; pml[(size_t)pi * 2 + 1] = l; } }
#pragma unroll
          for (int it = 0; it < 4; ++it) { const int q = 8 * it + (lane >> 3), c = lane & 7; const int pq = *(const LAS int*)(sw + 4608 + 4 * q); const v4u row = *(const LAS v4u*)(sw + q * 144 + c * 16);
              if (pq >= 0) *(v4u*)(po + (size_t)pq * 64 + c * 8) = row; } }
    }
    __syncthreads();
}
__device__ __forceinline__ void moba_combine(const bf16* __restrict__ po, const float* __restrict__ pml, const int* __restrict__ selinfo, bf16* __restrict__ mix, int gw, int ngw, int lane) {
    const int sub = lane >> 4, d4 = (lane & 15) * 4;
#pragma unroll 8
    for (int idx = gw * 4 + sub; idx < T * MB_H; idx += ngw * 4) { const int tg = idx / MB_H, hh = idx - tg * MB_H, ns = selinfo[idx]; const size_t p4 = (size_t)idx * 4;
        f32x2 ml[4]; f32x4 ov[4];
#pragma unroll
        for (int j = 0; j < 4; ++j) { const size_t pj = p4 + ((j == 3 || ((ns >> j) & 1)) ? j : 3);
            ml[j] = __builtin_nontemporal_load((const f32x2*)pml + pj); const v2u ow = __builtin_nontemporal_load((const v2u*)(po + pj * 64 + d4)); ov[j] = (f32x4){bflo(ow.x), bfhi(ow.x), bflo(ow.y), bfhi(ow.y)}; }
        float M = ml[3].x;
#pragma unroll
        for (int j = 0; j < 3; ++j) { const bool ok = (ns >> j) & 1; ml[j].x = ok ? ml[j].x : -INFINITY; ml[j].y = ok ? ml[j].y : 0.f; M = fmaxf(M, ml[j].x);
            ov[j].x = ok ? ov[j].x : 0.f; ov[j].y = ok ? ov[j].y : 0.f; ov[j].z = ok ? ov[j].z : 0.f; ov[j].w = ok ? ov[j].w : 0.f; }
        float den = 0.f; f32x4 num = {0.f, 0.f, 0.f, 0.f};
#pragma unroll
        for (int j = 0; j < 4; ++j) { const float w = __builtin_amdgcn_exp2f(ml[j].x - M); den += w * ml[j].y; num += ov[j] * w; }
        const float inv = 1.f / den; v2u o; o.x = pk2(num.x * inv, num.y * inv); o.y = pk2(num.z * inv, num.w * inv);
        *(v2u*)(mix + (size_t)tg * 1024 + hh * 64 + d4) = o; }
}

template <int CTRL> __device__ __forceinline__ float dppf(float v) { return __builtin_bit_cast(float, __builtin_amdgcn_update_dpp(0, __builtin_bit_cast(int, v), CTRL, 0xF, 0xF, true)); }
template <int CTRL> __device__ __forceinline__ int dppi(int v) { return __builtin_amdgcn_update_dpp(0, v, CTRL, 0xF, 0xF, true); }
__device__ __forceinline__ float wave_sum_dpp(float v) {
    v += dppf<0xB1>(v); v += dppf<0x4E>(v); v += dppf<0x141>(v); v += dppf<0x140>(v);
    v += __builtin_bit_cast(float, __builtin_amdgcn_update_dpp(0, __builtin_bit_cast(int, v), 0x142, 0xA, 0xF, false));
    v += __builtin_bit_cast(float, __builtin_amdgcn_update_dpp(0, __builtin_bit_cast(int, v), 0x143, 0xC, 0xF, false));
    return __builtin_bit_cast(float, __builtin_amdgcn_readlane(__builtin_bit_cast(int, v), 63));
}
__device__ __forceinline__ void ln_row(f32x4 (&v)[4], const f32x4 (&gv)[4], const f32x4 (&bv)[4]) {
    float s = 0.f;
#pragma unroll
    for (int j = 0; j < 4; ++j) s += (v[j].x + v[j].y) + (v[j].z + v[j].w);
    const float mean = wave_sum_dpp(s) * (1.f / D); float s2 = 0.f;
#pragma unroll
    for (int j = 0; j < 4; ++j) { v[j] = v[j] - mean; s2 += (v[j].x * v[j].x + v[j].y * v[j].y) + (v[j].z * v[j].z + v[j].w * v[j].w); }
    const float rstd = __builtin_amdgcn_rsqf(wave_sum_dpp(s2) * (1.f / D) + 1e-5f);
#pragma unroll
    for (int j = 0; j < 4; ++j) v[j] = v[j] * rstd * gv[j] + bv[j];
}
__device__ __forceinline__ void split_router_weights(const float* wr  , bf16* wrs  , size_t gtid, size_t gthreads) {
    for (size_t i = gtid; i < (size_t)DEPTH * D * NE; i += gthreads) { const int e = (int)(i & 31), d = (int)((i >> 5) & 1023), l = (int)(i >> 15);
        const float w = wr[i]; const unsigned hi = f2bf(w); const unsigned lo = f2bf(w - __builtin_bit_cast(float, hi << 16));
        wrs[(((size_t)l * 2 + 0) * NE + e) * D + d] = (bf16)hi; wrs[(((size_t)l * 2 + 1) * NE + e) * D + d] = (bf16)lo; }
}
constexpr int L1_XH = 0, L1_XL = 33024, L1_ROW = 2064, L1_PART = 66048, L1_HIST = 82432, L1_TOK = 82944;
__device__ __forceinline__ void phase_ln1(LAS unsigned char* lds, const bf16* y, const float* g, const float* bb, const bf16* wrs  , const float* br,
                                          bf16* xbf, unsigned char* x8, int* tok_e, int* tok_lr, float* tok_w, int* blk_cnt, int blk, int tid, int wave, int lane) {
    LAS float* part = (LAS float*)(lds + L1_PART);
    LAS int* hist = (LAS int*)(lds + L1_HIST); LAS int* tokl = (LAS int*)(lds + L1_TOK);
    if (tid < 32) hist[tid] = 0;
    constexpr int TPB = T / GRID;
    const int e = lane & 31, m16 = lane & 15, quad = lane >> 4;
    s16x8 bw[4][2][2];
#pragma unroll
    for (int ks = 0; ks < 4; ++ks)
#pragma unroll
        for (int nt = 0; nt < 2; ++nt)
#pragma unroll
            for (int pp = 0; pp < 2; ++pp) bw[ks][nt][pp] = *(const s16x8*)(wrs + ((size_t)pp * NE + 16 * nt + m16) * D + wave * 128 + 32 * ks + 8 * quad);
    const float bre = br[e];
    f32x4 gv[4], bv[4];
#pragma unroll
    for (int j = 0; j < 4; ++j) { gv[j] = ((const f32x4*)g)[lane + 64 * j]; bv[j] = ((const f32x4*)bb)[lane + 64 * j]; }
    v2u xn[2][4], yn[2][4];
#pragma unroll
    for (int u = 0; u < 2; ++u) { const size_t t0 = (size_t)blk * TPB + 2 * wave + u; const v2u* xr = (const v2u*)(xbf + t0 * D) + lane; const v2u* yr = (const v2u*)(y + t0 * D) + lane;
#pragma unroll
        for (int j = 0; j < 4; ++j) { xn[u][j] = __builtin_nontemporal_load(xr + 64 * j); yn[u][j] = __builtin_nontemporal_load(yr + 64 * j); } }
#pragma unroll
    for (int j = 0; j < 4; ++j) asm volatile("" :: "v"(gv[j]), "v"(bv[j]), "v"(xn[0][j]), "v"(xn[1][j]), "v"(yn[0][j]), "v"(yn[1][j]));
#pragma unroll
    for (int ks = 0; ks < 4; ++ks) asm volatile("" :: "v"(bw[ks][0][0]), "v"(bw[ks][0][1]), "v"(bw[ks][1][0]), "v"(bw[ks][1][1]));
    asm volatile("" :: "v"(bre));
    __syncthreads();
    for (int grp = 0; grp < TPB / 16; ++grp) { const size_t tg0 = (size_t)blk * TPB + grp * 16 + 2 * wave;
        f32x4 v[2][4];
#pragma unroll
        for (int u = 0; u < 2; ++u)
#pragma unroll
            for (int j = 0; j < 4; ++j) { const v2u xw = xn[u][j]; const v2u yw = yn[u][j];
                v[u][j].x = DN_ALPHA * bflo(xw.x) + bflo(yw.x); v[u][j].y = DN_ALPHA * bfhi(xw.x) + bfhi(yw.x); v[u][j].z = DN_ALPHA * bflo(xw.y) + bflo(yw.y); v[u][j].w = DN_ALPHA * bfhi(xw.y) + bfhi(yw.y); }
        if (grp + 1 < TPB / 16) {
#pragma unroll
            for (int u = 0; u < 2; ++u) { const v2u* xr = (const v2u*)(xbf + (tg0 + 16 + u) * D) + lane; const v2u* yr = (const v2u*)(y + (tg0 + 16 + u) * D) + lane;
#pragma unroll
                for (int j = 0; j < 4; ++j) { xn[u][j] = __builtin_nontemporal_load(xr + 64 * j); yn[u][j] = __builtin_nontemporal_load(yr + 64 * j); } } }
#pragma unroll
        for (int u = 0; u < 2; ++u) { ln_row(v[u], gv, bv);
            v2u* xb = (v2u*)(xbf + (tg0 + u) * D) + lane; unsigned* x8r = (unsigned*)(x8 + (tg0 + u) * D) + lane;
#pragma unroll
            for (int j = 0; j < 4; ++j) { v2u hw; hw.x = cvtpk(v[u][j].x, v[u][j].y); hw.y = cvtpk(v[u][j].z, v[u][j].w); xb[64 * j] = hw;
                x8r[64 * j] = pk4_fp8(bflo(hw.x), bfhi(hw.x), bflo(hw.y), bfhi(hw.y));
                v2u lw; lw.x = cvtpk(v[u][j].x - bflo(hw.x), v[u][j].y - bfhi(hw.x)); lw.y = cvtpk(v[u][j].z - bflo(hw.y), v[u][j].w - bfhi(hw.y));
                *(LAS v2u*)(lds + L1_XH + (2 * wave + u) * L1_ROW + (4 * lane + 256 * j) * 2) = hw; *(LAS v2u*)(lds + L1_XL + (2 * wave + u) * L1_ROW + (4 * lane + 256 * j) * 2) = lw; } }
        __syncthreads();
        { f32x4 acc[2] = {{0.f, 0.f, 0.f, 0.f}, {0.f, 0.f, 0.f, 0.f}};
#pragma unroll
          for (int ks = 0; ks < 4; ++ks) { const int off = m16 * L1_ROW + (wave * 128 + 32 * ks + 8 * quad) * 2;
              const s16x8 ah = *(const LAS s16x8*)(lds + L1_XH + off), al = *(const LAS s16x8*)(lds + L1_XL + off);
#pragma unroll
              for (int nt = 0; nt < 2; ++nt) { acc[nt] = __builtin_amdgcn_mfma_f32_16x16x32_bf16(ah, bw[ks][nt][0], acc[nt], 0, 0, 0); acc[nt] = __builtin_amdgcn_mfma_f32_16x16x32_bf16(ah, bw[ks][nt][1], acc[nt], 0, 0, 0);
                  acc[nt] = __builtin_amdgcn_mfma_f32_16x16x32_bf16(al, bw[ks][nt][0], acc[nt], 0, 0, 0); } }
#pragma unroll
          for (int nt = 0; nt < 2; ++nt)
#pragma unroll
              for (int jj = 0; jj < 4; ++jj) part[(wave * 16 + 4 * quad + jj) * 32 + 16 * nt + m16] = acc[nt][jj]; }
        __syncthreads();
#pragma unroll
        for (int u = 0; u < 2; ++u) { const size_t t = tg0 + u;
            float logit = bre;
#pragma unroll
            for (int w = 0; w < 8; ++w) logit += part[(w * 16 + 2 * wave + u) * 32 + e];
            int se[4]; float sv[4]; int cur = __builtin_bit_cast(int, logit); cur ^= (cur >> 31) & 0x7fffffff;
#pragma unroll
            for (int k = 0; k < 4; ++k) { int m = cur;
                m = max(m, dppi<0xB1>(m)); m = max(m, dppi<0x4E>(m)); m = max(m, dppi<0x141>(m)); m = max(m, dppi<0x140>(m));
                const int mm = max(__builtin_amdgcn_readlane(m, 0), __builtin_amdgcn_readlane(m, 16));
                const unsigned long long mk = __ballot(cur == mm); const int src = __builtin_ctzll(mk);
                se[k] = src; sv[k] = __builtin_bit_cast(float, mm ^ ((mm >> 31) & 0x7fffffff)); cur = (e == src) ? (int)0x80000000 : cur; }
            const float e1 = __expf(sv[1] - sv[0]), e2 = __expf(sv[2] - sv[0]), e3 = __expf(sv[3] - sv[0]), inv = __builtin_amdgcn_rcpf(1.f + e1 + e2 + e3);
            const float wk[4] = {inv, e1 * inv, e2 * inv, e3 * inv};
            if (lane == 0) { const int tl = (grp * 16 + 2 * wave + u) * 4;
#pragma unroll
                for (int k = 0; k < 4; ++k) { const int lr = __hip_atomic_fetch_add(hist + se[k], 1, __ATOMIC_RELAXED, __HIP_MEMORY_SCOPE_WORKGROUP);
                    tokl[tl + k] = se[k]; tokl[512 + tl + k] = lr; tokl[1024 + tl + k] = __builtin_bit_cast(int, wk[k]); } } }
    }
    __syncthreads();
    if (tid < 32) blk_cnt[blk * 32 + tid] = hist[tid];
    { const size_t ti = (size_t)blk * TPB * 4 + tid; tok_e[ti] = tokl[tid]; tok_lr[ti] = tokl[512 + tid]; tok_w[ti] = __builtin_bit_cast(float, tokl[1024 + tid]); }
    __syncthreads();
}
__device__ __forceinline__ void phase_dispatch(LAS unsigned char* lds, const int* __restrict__ blk_cnt, const int* __restrict__ tok_e, const int* __restrict__ tok_lr, int* __restrict__ tok_row, int* __restrict__ tab,
                                               int* __restrict__ rowtok, int blk, int tid, int wave, int lane) {
    LAS int* tot = (LAS int*)lds; LAS int* pre = tot + 32; LAS int* pst = pre + 32; LAS int* rows = pst + 64;
    LAS int* red = rows + 512;
    static_assert(GRID == 256 && NTHR == 512, "16 thread groups x 16 blocks");
    { const int e = tid & 31, part = tid >> 5; int s = 0, p = 0;
#pragma unroll
      for (int i = 0; i < 16; ++i) { const int bb = part * 16 + i; const int c = blk_cnt[bb * 32 + e]; s += c; p += (bb < blk) ? c : 0; }
      red[part * 32 + e] = s; red[512 + part * 32 + e] = p; }
    __syncthreads();
    if (tid < 32) { int s = 0, p = 0;
#pragma unroll
        for (int q = 0; q < 16; ++q) { s += red[q * 32 + tid]; p += red[512 + q * 32 + tid]; }
        tot[tid] = s; pre[tid] = p; }
    __syncthreads();
    if (tid == 0) { int acc = 0; for (int e = 0; e < 32; ++e) { pst[e] = acc; acc += ((tot[e] + 255) >> 8) << 8; } pst[32] = acc; }
    __syncthreads();
    if (blk == 0 && tid < 33) tab[tid] = pst[tid] >> 8;
    constexpr int TPB = T / GRID;
    static_assert(TPB * 4 == NTHR, "one (token, k) pair per thread");
    { const size_t ti = (size_t)blk * TPB * 4 + tid; const int e = tok_e[ti]; const int r = pst[e] + pre[e] + tok_lr[ti]; tok_row[ti] = r; rowtok[r] = blk * TPB + (tid >> 2); }
    if (blk < NE) { const int r0 = pst[blk] + tot[blk], npad = pst[blk + 1] - r0; if (tid < npad) rowtok[r0 + tid] = 0; }
    __syncthreads();
}
__device__ __forceinline__ f32x4 fp8x4_to_f32(unsigned w) {
    const f32x2 lo = __builtin_amdgcn_cvt_pk_f32_fp8((int)w, false), hi = __builtin_amdgcn_cvt_pk_f32_fp8((int)w, true); return (f32x4){lo.x, lo.y, hi.x, hi.y};
}
__device__ __forceinline__ void phase_ln2(const unsigned char* __restrict__ yrows, const int* __restrict__ tok_row, const float* __restrict__ tok_w, const float* __restrict__ g, const float* __restrict__ bb,
                                          float* __restrict__ xout, bf16* xbf, int gw, int ngw, int lane) {
    f32x4 gv[4], bv[4];
#pragma unroll
    for (int j = 0; j < 4; ++j) { gv[j] = ((const f32x4*)g)[lane + 64 * j]; bv[j] = ((const f32x4*)bb)[lane + 64 * j]; }
    constexpr int NTK = 2;
    static_assert(T % (NTK * GRID * NWAVES) == 0, "NTK tokens per wave per step");
    for (int t0 = gw; t0 < T; t0 += NTK * ngw) {
        f32x4 v[NTK][4];
#pragma unroll
        for (int u = 0; u < NTK; ++u) { const int t = t0 + u * ngw; int r[4]; float w[4];
#pragma unroll
            for (int k = 0; k < 4; ++k) { r[k] = tok_row[(size_t)t * 4 + k]; w[k] = tok_w[(size_t)t * 4 + k] * (1.f / 16.f); }
            const v2u* xr = (const v2u*)(xbf + (size_t)t * D) + lane;
#pragma unroll
            for (int j = 0; j < 4; ++j) { f32x4 f = {0.f, 0.f, 0.f, 0.f};
#pragma unroll
                for (int k = 0; k < 4; ++k) { const unsigned yw = __builtin_nontemporal_load((const unsigned*)(yrows + (size_t)r[k] * D) + lane + 64 * j); f += fp8x4_to_f32(yw) * w[k]; }
                const v2u xw = __builtin_nontemporal_load(xr + 64 * j); v[u][j].x = DN_ALPHA * bflo(xw.x) + f.x; v[u][j].y = DN_ALPHA * bfhi(xw.x) + f.y; v[u][j].z = DN_ALPHA * bflo(xw.y) + f.z; v[u][j].w = DN_ALPHA * bfhi(xw.y) + f.w; } }
#pragma unroll
        for (int u = 0; u < NTK; ++u) { const int t = t0 + u * ngw;
            ln_row(v[u], gv, bv);
            if (xout) { f32x4* xo = (f32x4*)(xout + (size_t)t * D) + lane;
#pragma unroll
                for (int j = 0; j < 4; ++j) __builtin_nontemporal_store(v[u][j], xo + 64 * j); }
            else { v2u* xb = (v2u*)(xbf + (size_t)t * D) + lane;
#pragma unroll
                for (int j = 0; j < 4; ++j) { v2u ww; ww.x = pk2(v[u][j].x, v[u][j].y); ww.y = pk2(v[u][j].z, v[u][j].w); xb[64 * j] = ww; } } } }
}


struct Args { const float* in[20]; float* out; unsigned char* ws; int l_lo, l_hi, ph_lo, ph_hi; };
typedef const __attribute__((address_space(4))) Args* KArgsP;
#define KA_LOAD() ({ KArgsP p_ = (KArgsP)__builtin_amdgcn_kernarg_segment_ptr(); asm volatile("" : "+s"(p_)); p_; })
#ifndef PHMASK
#define PHMASK 0xFFFF
#endif
#ifndef REPEAT_MASK
#define REPEAT_MASK 0
#endif
#ifndef REPEAT_LMASK
#define REPEAT_LMASK 0xF
#endif
#define PH_BEGIN(k) _Pragma("unroll") for (int rep_ = 0; rep_ < ((((REPEAT_MASK >> (k)) & 1) && ((REPEAT_LMASK >> l) & 1)) ? 2 : 1); ++rep_) { if ((PHMASK >> (k)) & 1) { KArgsP ka = KA_LOAD(); unsigned char* ws = ka->ws; int tid = threadIdx.x; asm volatile("" : "+v"(tid)); \
    const int lane = tid & 63, wave = __builtin_amdgcn_readfirstlane(tid >> 6); int blk = blockIdx.x; asm volatile("" : "+s"(blk)); \
    const int gw = blk * NWAVES + wave; const size_t gtid = (size_t)blk * NTHR + tid; (void)lane; (void)gw; (void)gtid; (void)ws;
#if ONE_LAUNCH
#define PH_SEAM() do { XcdBarrier b_; b_.bar = (unsigned*)(KA_LOAD()->ws + WS_CTL) + CW_BAR; b_.x = xb_xcc_id(); b_.st = (volatile LAS unsigned*)(lds + MISC_OFF); xcd_barrier(b_); } while (0)
#else
#define PH_SEAM() do {} while (0)
#endif
#define PH_END() PH_SEAM(); } }
#define PH_END_NOSEAM() } }
#define WSP(type, off) ((type*)(ws + (off)))
constexpr int G = GRID, NGW = GRID * NWAVES; constexpr size_t GTHREADS = (size_t)GRID * NTHR;
template <int L> __device__ __forceinline__ void layer_phases(LAS unsigned char* lds) {
    constexpr int l = L; LAS int* tabL = (LAS int*)(lds + MISC_OFF + 256);

        const int j = l >> 1; const bool moba = (l & 1) != 0;
        const int NC = moba ? NC_M : NC_H, qoff = moba ? 2304 : 3072;

        if (l == 0) {
        PH_BEGIN(1)
            phase_weights((LAS float*)(lds + wave * 16384), gw, NGW, lane, ka->in[2], NC_H, ka->in[6], 4, ka->in[7], ka->in[12], ka->in[14], ka->in[16], WSP(bf16, WS_WIN), WSP(bf16, WS_WKV4), WSP(bf16, WS_WO), WSP(bf16, WS_WGU), WSP(bf16, WS_WD), 1);
        PH_END()
        }
        PH_BEGIN(2)
            { pg8::Gemm g{WSP(bf16, WS_XBF), WSP(bf16, WS_WIN), T, NC, D, 0, 0}; pg8::StaticOrder S; S.init(T, NC, G, blk); pg8::EpiPlain E{WSP(bf16, WS_H), NC, moba ? 0x207u : 0x1000u, 0.125f * 1.4426950408889634f};
              pg8::gemm_phase<pg8::EpiPlain, pg8::StaticOrder, true, true>(lds, g, S, E); }
            if (l == 0) {
              pg8::Gemm g{WSP(bf16, WS_MEMBF), WSP(bf16, WS_WKV4), 512, 2048, D, 0, 0}; pg8::StaticOrder S; S.init(512, 2048, G, blk >= 128 ? blk - 128 : G); pg8::EpiPlain E{WSP(bf16, WS_KV4), 2048, 0u, 1.f};
              pg8::gemm_phase<pg8::EpiPlain, pg8::StaticOrder, true, true>(lds, g, S, E); }
        PH_END()
        if (!moba) {
            PH_BEGIN(3)
                for (int u = blk; u < NBATCH * HG_H * HNSEG; u += G) hgrn_mfma<false>(lds, WSP(bf16, WS_H), ka->in[3], j, ka->in[4] + j * 128, WSP(float, WS_SLOC), WSP(float, WS_DSEG), WSP(bf16, WS_MIX), u, tid, wave, lane);
                for (int u = blk; u < 512; u += G) memattn_unit2(lds, WSP(bf16, WS_H), NC, qoff, WSP(bf16, WS_KV4) + 512 * l, WSP(bf16, WS_MIX), u, tid, wave, lane);
            PH_END()
            PH_BEGIN(4)
                hgrn_scan(WSP(float, WS_SLOC), WSP(float, WS_DSEG), gtid, GTHREADS);
            PH_END()
            PH_BEGIN(5)
                for (int u = blk; u < NBATCH * HG_H * HNSEG; u += G) hgrn_mfma<true>(lds, WSP(bf16, WS_H), ka->in[3], j, ka->in[4] + j * 128, WSP(float, WS_SLOC), WSP(float, WS_DSEG), WSP(bf16, WS_MIX), u, tid, wave, lane);
            PH_END()
        } else {
            PH_BEGIN(3)
                for (int u = blk; u < 24 * MB_NB; u += G) kmean_unit(lds, WSP(bf16, WS_H), WSP(float, WS_KMEAN), WSP(float, WS_KMEAN + 512 * 1024), u, tid, wave);
                for (int u = blk; u < 512; u += G) memattn_unit2(lds, WSP(bf16, WS_H), NC, qoff, WSP(bf16, WS_KV4) + 512 * l, WSP(bf16, WS_MIX), u, tid, wave, lane);
            PH_END()
            PH_BEGIN(4)
                moba_gate_wg(lds, WSP(bf16, WS_H), WSP(float, WS_KMEAN), WSP(float, WS_KMEAN + 512 * 1024), WSP(unsigned, WS_CTL) + CW_GCOUNT + j * 1536, WSP(int, WS_SELINFO), WSP(unsigned, WS_LIST), blk, tid);
            PH_END()
            PH_BEGIN(5)
                { unsigned* qhead = WSP(unsigned, WS_CTL) + CW_GCOUNT + 2 * 1536 + 64 * j; LAS int* itl = (LAS int*)(lds + MISC_OFF + 512);
                  for (;;) { if (tid == 0) *itl = (int)__hip_atomic_fetch_add(qhead, 1u, __ATOMIC_RELAXED, __HIP_MEMORY_SCOPE_AGENT);
                      __syncthreads(); const int it = *itl; __syncthreads();
                      if (it >= 24 * MB_NB) break;
                      moba_attn_item2(lds, WSP(bf16, WS_H), WSP(float, WS_KMEAN + 512 * 1024), WSP(unsigned, WS_CTL) + CW_GCOUNT + j * 1536, WSP(unsigned, WS_LIST), WSP(bf16, WS_PO), WSP(float, WS_PML), it, tid, wave, lane); } }
            PH_END()
            PH_BEGIN(6)
                moba_combine(WSP(bf16, WS_PO), WSP(float, WS_PML), WSP(int, WS_SELINFO), WSP(bf16, WS_MIX), gw, NGW, lane);
            PH_END()
        }
        PH_BEGIN(7)
            pg8::Gemm g{WSP(bf16, WS_MIX), WSP(bf16, WS_WO), T, D, D, 0, 0, nullptr}; pg8::StaticOrder S; S.init(T, D, G, blk); pg8::EpiPlain E{WSP(bf16, WS_Y), D, 0u, 1.f};
            pg8::gemm_phase<pg8::EpiPlain, pg8::StaticOrder, true, true>(lds, g, S, E);
        PH_END()
        PH_BEGIN(8)
            phase_ln1(lds, WSP(bf16, WS_Y), ka->in[8] + l * D, ka->in[9] + l * D, WSP(bf16, WS_WRS) + (size_t)l * 2 * NE * D, ka->in[11] + l * NE, WSP(bf16, WS_XBF), WSP(unsigned char, WS_H),
                      WSP(int, WS_TOK + TOK_E), WSP(int, WS_TOK + TOK_LR), WSP(float, WS_TOK + TOK_W), WSP(int, WS_TOK + TOK_BLKCNT), blk, tid, wave, lane);
        PH_END()
        PH_BEGIN(9)
            phase_dispatch(lds, WSP(int, WS_TOK + TOK_BLKCNT), WSP(int, WS_TOK + TOK_E), WSP(int, WS_TOK + TOK_LR), WSP(int, WS_TOK + TOK_ROW), WSP(int, WS_TOK + TOK_TAB), WSP(int, WS_H + 64 * MiB), blk, tid, wave, lane);
            { const size_t moff = (size_t)l * NE * 1024 * 1024;
              phase_weights((LAS float*)(lds + wave * 16384), gw, NGW, lane, ka->in[2], NC_H, ka->in[6], 0, ka->in[7], ka->in[12] + moff, ka->in[14] + moff, ka->in[16] + moff,
                            WSP(bf16, WS_WIN), WSP(bf16, WS_WKV4), WSP(bf16, WS_WO), WSP(bf16, WS_WGU), WSP(bf16, WS_WD), 2); }
        PH_END()
        PH_BEGIN(10)
            if (tid < 33) tabL[tid] = WSP(int, WS_TOK + TOK_TAB)[tid];
            __syncthreads();
            int sw_ = 0x7A7A7A7A, sx_ = 0x7F7F7F7F; asm volatile("" : "+s"(sw_), "+s"(sx_));
            pg8::Gemm g{WSP(bf16, WS_H), WSP(bf16, WS_WGU), MOE_MAXROWS, NE * 2048, D / 2, sw_, sx_, WSP(int, WS_H + 64 * MiB)};   pg8::MoeOrder S{tabL, 8, G, blk, tabL[32] * 8, false};
            pg8::EpiSwiglu E{WSP(unsigned char, WS_HID), ka->in[13] + (size_t)l * NE * 1024, ka->in[15] + (size_t)l * NE * 1024};
            pg8::gemm_phase<pg8::EpiSwiglu, pg8::MoeOrder, true, true, true, true>(lds, g, S, E);
        PH_END()
        PH_BEGIN(11)
            if (tid < 33) tabL[tid] = WSP(int, WS_TOK + TOK_TAB)[tid];
            __syncthreads();
            int sw_ = 0x79797979, sx_ = 0x83838383; asm volatile("" : "+s"(sw_), "+s"(sx_));
            pg8::Gemm g{WSP(bf16, WS_HID), WSP(bf16, WS_WD), MOE_MAXROWS, NE * 1024, D / 2, sw_, sx_, nullptr}; pg8::MoeOrder S{tabL, 4, G, blk, tabL[32] * 4, true};
            pg8::EpiDown E{WSP(unsigned char, WS_XS), ka->in[17] + (size_t)l * NE * 1024};
            pg8::gemm_phase<pg8::EpiDown, pg8::MoeOrder, true, true, true>(lds, g, S, E);
        PH_END()
        PH_BEGIN(12)
            float* x2out = (l == DEPTH - 1) ? ka->out : nullptr;
            phase_ln2(WSP(unsigned char, WS_XS), WSP(int, WS_TOK + TOK_ROW), WSP(float, WS_TOK + TOK_W), ka->in[18] + l * D, ka->in[19] + l * D, x2out, WSP(bf16, WS_XBF), gw, NGW, lane);
            if (l + 1 < DEPTH) { constexpr int ln = l + 1, jn = ln >> 1; constexpr bool mn = (ln & 1) != 0;
                const float* win_src = mn ? ka->in[5] + (size_t)jn * D * NC_M : ka->in[2] + (size_t)jn * D * NC_H; const size_t moff = (size_t)ln * NE * 1024 * 1024;
                phase_weights((LAS float*)(lds + wave * 16384), gw, NGW, lane, win_src, mn ? NC_M : NC_H, ka->in[6], 0, ka->in[7] + (size_t)ln * D * D,
                              ka->in[12] + moff, ka->in[14] + moff, ka->in[16] + moff, WSP(bf16, WS_WIN), WSP(bf16, WS_WKV4), WSP(bf16, WS_WO), WSP(bf16, WS_WGU), WSP(bf16, WS_WD), 1); }
            if (l + 1 < DEPTH) PH_SEAM();
        PH_END_NOSEAM()
}
__global__ void __launch_bounds__(NTHR, 2) fwd_kernel(Args args) {
    extern __shared__ __attribute__((aligned(16))) unsigned char lds_raw[];
    LAS unsigned char* lds = (LAS unsigned char*)lds_raw;
    if (threadIdx.x < 4) ((LAS unsigned*)(lds + MISC_OFF))[threadIdx.x] = 0u;
    __syncthreads();
#if ONE_LAUNCH
    (void)xcd_barrier_post((unsigned*)(args.ws + WS_CTL) + CW_BAR, (volatile LAS unsigned*)(lds + MISC_OFF));
#endif
    { const int l = 0; (void)l;
    PH_BEGIN(0)
        cvt_rows_bf16(ka->in[0], WSP(bf16, WS_XBF), (size_t)T * D / 8, gtid, GTHREADS);
        cvt_rows_bf16(ka->in[1], WSP(bf16, WS_MEMBF), (size_t)512 * D / 8, gtid, GTHREADS);
        split_router_weights(ka->in[10], WSP(bf16, WS_WRS), gtid, GTHREADS);
    PH_END_NOSEAM() }
    layer_phases<0>(lds); layer_phases<1>(lds); layer_phases<2>(lds); layer_phases<3>(lds);
}

extern "C" void kernel_launch(void* const* d_in, const int* in_sizes, int n_in, void* d_out, int out_size, void* d_ws, size_t ws_size, hipStream_t stream) {
    static int ready = 0;
    if (ready == 0) {
        if (n_in != 20 || in_sizes[0] != T * D || out_size != T * D || ws_size < WS_END) { fprintf(stderr, "kernel_launch: unexpected shapes (n_in %d, in0 %d, out %d, ws %zu < %zu)\n", n_in, n_in > 0 ? in_sizes[0] : -1, out_size, ws_size, (size_t)WS_END); ready = -1; return; }
        if (hipFuncSetAttribute((const void*)fwd_kernel, hipFuncAttributeMaxDynamicSharedMemorySize, LDS_BYTES) != hipSuccess) { fprintf(stderr, "kernel_launch: hipFuncSetAttribute failed\n"); ready = -1; return; }
        int per_cu = 0;
        if (hipOccupancyMaxActiveBlocksPerMultiprocessor(&per_cu, (const void*)fwd_kernel, NTHR, LDS_BYTES) != hipSuccess || per_cu < 1) fprintf(stderr, "kernel_launch: occupancy query says %d\n", per_cu);
        (void)hipGetLastError();
        ready = 1;
    }
    if (ready < 0) return;
    if (hipMemsetAsync((char*)d_ws + WS_CTL, 0, CTL_ZERO_BYTES, stream) != hipSuccess) return;
    Args a{};
    for (int i = 0; i < 20; ++i) a.in[i] = (const float*)d_in[i];
    a.out = (float*)d_out; a.ws = (unsigned char*)d_ws;
    a.l_lo = 0; a.l_hi = DEPTH; a.ph_lo = 0; a.ph_hi = NPHASE;
    hipLaunchKernelGGL(fwd_kernel, dim3(GRID), dim3(NTHR), LDS_BYTES, stream, a);
}
```

```cpp
#include <hip/hip_runtime.h>
#include <cstdio>
#include <cstdint>
#include <cmath>
namespace pg8 {
#define PG8_LAS __attribute__((address_space(3)))
typedef unsigned short bf16_t;
typedef short bf16x8 __attribute__((ext_vector_type(8)));
typedef float f32x4 __attribute__((ext_vector_type(4)));
typedef unsigned u32x4 __attribute__((ext_vector_type(4)));
constexpr int BM = 256, BK = 64, HALF = 128, HTB = HALF * BK * 2  , STAGE_BYTES = 8 * HTB, NXCD = 8, WGM = 8;

__host__ __device__ __forceinline__ int lds_byte(int r, int c) { const int st = (r >> 4) * 2 + (c >> 5), rr = r & 15, cc = c & 31, ob = rr * 64 + cc * 2; return st * 1024 + (ob ^ (((ob >> 9) & 1) << 5)); }
__host__ __device__ __forceinline__ void stage_rc(int b, int& R, int& C) { const int st = b / 1024, sb = b % 1024, swz = sb ^ (((sb >> 9) & 1) << 5); R = (st >> 1) * 16 + swz / 64; C = (st & 1) * 32 + (swz % 64) / 2; }
__host__ __device__ __forceinline__ int perm32(int rho) { const int n = rho >> 4, i = rho & 15; return 8 * (i >> 2) + 4 * n + (i & 3); }

struct Unit { int pm, pn; };
struct Gemm { const bf16_t* A; const bf16_t* Bt; int M, N, K; int sw, sx; const int* rowtok; };
typedef int i32x8 __attribute__((ext_vector_type(8))); typedef int i32x4 __attribute__((ext_vector_type(4)));

struct StaticOrder {
    int nM, nN, nwg, G, c;
    __host__ __device__ void init(int M, int N, int G_, int c_) { nM = M / BM; nN = N / BM; nwg = nM * nN; G = G_; c = c_; }
    __host__ __device__ bool next(int i, Unit& u) const {
        const long L = (long)i * G + c; if (L >= nwg) return false;
        int wgid = (int)L; { const int q = nwg / NXCD, r = nwg % NXCD, xcd = wgid % NXCD, off = wgid / NXCD; wgid = (xcd < r ? xcd * (q + 1) : r * (q + 1) + (xcd - r) * q) + off; }
        const int nig = WGM * nN, gid = wgid / nig, fm = gid * WGM, gsz = (nM - fm) < WGM ? (nM - fm) : WGM;
        u.pm = fm + ((wgid % nig) % gsz); u.pn = (wgid % nig) / gsz; return true;
    }
    __device__ __forceinline__ void a_ready(const Unit&) const {}
    __device__ __forceinline__ void done(const Unit&) const {}
};

template <int NM, int NN> struct StaticOrderT {
    int G, c;
    __device__ __forceinline__ bool next(int i, Unit& u) const {
        constexpr int nwg = NM * NN; const int L = i * G + c; if (L >= nwg) return false;
        int wgid = L; { constexpr int q = nwg / NXCD, r = nwg % NXCD; const int xcd = wgid % NXCD, off = wgid / NXCD; wgid = (xcd < r ? xcd * (q + 1) : r * (q + 1) + (xcd - r) * q) + off; }
        constexpr int nig = WGM * NN; const int gid = wgid / nig, fm = gid * WGM, gsz = (NM % WGM == 0) ? WGM : ((NM - fm) < WGM ? (NM - fm) : WGM);
        u.pm = fm + ((wgid % nig) % gsz); u.pn = (wgid % nig) / gsz; return true;
    }
    __device__ __forceinline__ void a_ready(const Unit&) const {}
    __device__ __forceinline__ void done(const Unit&) const {}
};

__device__ __forceinline__ unsigned cvt_pk_bf16(float lo, float hi) { unsigned r; asm volatile("v_cvt_pk_bf16_f32 %0, %1, %2" : "=v"(r) : "v"(lo), "v"(hi)); return r; }
typedef float f32x2 __attribute__((ext_vector_type(2)));
struct EpiPlain {
    static constexpr bool PERM = true, AFTER_DRAIN = false;
    bf16_t* O; int ldc; unsigned smask; float sc;
    struct Pre {};
    __device__ __forceinline__ void pre_load(const Unit&, int, int, Pre&) const {}
    __device__ __forceinline__ void acc_init(f32x4 (&acc)[2][2][4][2], const Pre&) const {
#pragma unroll
        for (int a = 0; a < 2; ++a)
#pragma unroll
            for (int b = 0; b < 2; ++b)
#pragma unroll
                for (int m = 0; m < 4; ++m)
#pragma unroll
                    for (int n = 0; n < 2; ++n) acc[a][b][m][n] = (f32x4){0.f, 0.f, 0.f, 0.f}; }
    __device__ __forceinline__ void operator()(const f32x4 (&acc)[2][2][4][2], const Unit& u, int wr, int wc, int fr, int fq) const {
        const int row0 = u.pm * BM + wr * 64 + fr; const int col0 = u.pn * BM + wc * 32 + 8 * fq; const float s = ((smask >> u.pn) & 1u) ? sc : 1.f;
#pragma unroll
        for (int ai = 0; ai < 2; ++ai)
#pragma unroll
            for (int m = 0; m < 4; ++m) { bf16_t* rowp = O + (size_t)(row0 + ai * HALF + m * 16) * ldc + col0;
#pragma unroll
                for (int bj = 0; bj < 2; ++bj) { const f32x4 v0 = acc[ai][bj][m][0] * s, v1 = acc[ai][bj][m][1] * s;
                    u32x4 w; w.x = cvt_pk_bf16(v0[0], v0[1]); w.y = cvt_pk_bf16(v0[2], v0[3]); w.z = cvt_pk_bf16(v1[0], v1[1]); w.w = cvt_pk_bf16(v1[2], v1[3]);
                    *(u32x4*)(rowp + bj * HALF) = w; } }
    }
};
__device__ __forceinline__ float swiglu1(float g, float u) {
    float gm; asm("v_min_f32 %0, 0x40e00000, %1" : "=v"(gm) : "v"(g));
    const float um = __builtin_amdgcn_fmed3f(u, -7.0f, 7.0f);
    const float s = __builtin_amdgcn_rcpf(1.0f + __builtin_amdgcn_exp2f(gm * (-1.702f * 1.4426950408889634f)));
    const float gs = gm * s;
    return __builtin_fmaf(gs, um, gs);
}
__device__ __forceinline__ void swiglu4(const f32x4 g, const f32x4 u, float (&o)[4]) {
    typedef float f32x2_ __attribute__((ext_vector_type(2)));
#pragma unroll
    for (int h = 0; h < 2; ++h) { f32x2_ gm, um;
        asm("v_min_f32 %0, 0x40e00000, %1" : "=v"(gm.x) : "v"(g[2 * h])); asm("v_min_f32 %0, 0x40e00000, %1" : "=v"(gm.y) : "v"(g[2 * h + 1]));
        um.x = __builtin_amdgcn_fmed3f(u[2 * h], -7.0f, 7.0f); um.y = __builtin_amdgcn_fmed3f(u[2 * h + 1], -7.0f, 7.0f);
        const f32x2_ t = gm * (-1.702f * 1.4426950408889634f);
        f32x2_ e; e.x = __builtin_amdgcn_exp2f(t.x); e.y = __builtin_amdgcn_exp2f(t.y);
        const f32x2_ d = e + 1.0f;
        f32x2_ s; s.x = __builtin_amdgcn_rcpf(d.x); s.y = __builtin_amdgcn_rcpf(d.y);
        const f32x2_ gs = gm * s; const f32x2_ r = gs * um + gs;
        o[2 * h] = r.x; o[2 * h + 1] = r.y; }
}
__device__ __forceinline__ unsigned pk4_fp8e(float a, float b, float c, float d) { int w = 0; w = __builtin_amdgcn_cvt_pk_fp8_f32(a, b, w, false); w = __builtin_amdgcn_cvt_pk_fp8_f32(c, d, w, true); return (unsigned)w; }
struct EpiSwiglu {
    static constexpr bool PERM = true, AFTER_DRAIN = false;
    unsigned char* hid; const float* bg; const float* bu;
    struct Pre { f32x4 g0, g1, u0, u1; };
    __device__ __forceinline__ void pre_load(const Unit& u, int wc, int fq, Pre& p) const { const int e = u.pn >> 3, col0 = (u.pn & 7) * 128 + wc * 32 + 8 * fq;
        p.g0 = *(const f32x4*)(bg + e * 1024 + col0); p.g1 = *(const f32x4*)(bg + e * 1024 + col0 + 4); p.u0 = *(const f32x4*)(bu + e * 1024 + col0); p.u1 = *(const f32x4*)(bu + e * 1024 + col0 + 4); }
    __device__ __forceinline__ void acc_init(f32x4 (&acc)[2][2][4][2], const Pre& p) const {
#pragma unroll
        for (int a = 0; a < 2; ++a)
#pragma unroll
            for (int m = 0; m < 4; ++m) { acc[a][0][m][0] = p.g0; acc[a][0][m][1] = p.g1; acc[a][1][m][0] = p.u0; acc[a][1][m][1] = p.u1; } }
    __device__ __forceinline__ void operator()(const f32x4 (&acc)[2][2][4][2], const Unit& u, int wr, int wc, int fr, int fq) const {
        const int pn = u.pn & 7;
        const int row0 = u.pm * BM + wr * 64 + fr; const int col0 = pn * 128 + wc * 32 + 8 * fq;
#pragma unroll
        for (int ai = 0; ai < 2; ++ai)
#pragma unroll
            for (int m = 0; m < 4; ++m) { unsigned char* rowp = hid + (size_t)(row0 + ai * HALF + m * 16) * 1024 + col0;
                const f32x4 ga = acc[ai][0][m][0], gb = acc[ai][0][m][1], ua = acc[ai][1][m][0], ub = acc[ai][1][m][1];
                typedef unsigned u32x2 __attribute__((ext_vector_type(2))); u32x2 w;
                float oa[4], ob[4]; swiglu4(ga, ua, oa); swiglu4(gb, ub, ob);
                w.x = pk4_fp8e(oa[0], oa[1], oa[2], oa[3]); w.y = pk4_fp8e(ob[0], ob[1], ob[2], ob[3]);
                *(u32x2*)rowp = w; }
    }
};
struct EpiDown {
    static constexpr bool PERM = true, AFTER_DRAIN = false;
    unsigned char* y; const float* bd;
    struct Pre { f32x4 b[2][2]; };
    __device__ __forceinline__ void pre_load(const Unit& u, int wc, int fq, Pre& p) const { const int e = u.pn >> 2, col0 = (u.pn & 3) * BM + wc * 32 + 8 * fq;
#pragma unroll
        for (int bj = 0; bj < 2; ++bj)
#pragma unroll
            for (int n = 0; n < 2; ++n) p.b[bj][n] = *(const f32x4*)(bd + e * 1024 + col0 + bj * HALF + 4 * n); }
    __device__ __forceinline__ void acc_init(f32x4 (&acc)[2][2][4][2], const Pre& p) const {
#pragma unroll
        for (int a = 0; a < 2; ++a)
#pragma unroll
            for (int bj = 0; bj < 2; ++bj)
#pragma unroll
                for (int m = 0; m < 4; ++m) { acc[a][bj][m][0] = p.b[bj][0] * 16.f; acc[a][bj][m][1] = p.b[bj][1] * 16.f; } }
    __device__ __forceinline__ void operator()(const f32x4 (&acc)[2][2][4][2], const Unit& u, int wr, int wc, int fr, int fq) const {
        const int pn = u.pn & 3;
        const int row0 = u.pm * BM + wr * 64 + fr; const int col0 = pn * BM + wc * 32 + 8 * fq;
#pragma unroll
        for (int ai = 0; ai < 2; ++ai)
#pragma unroll
            for (int m = 0; m < 4; ++m) { unsigned char* rowp = y + (size_t)(row0 + ai * HALF + m * 16) * 1024 + col0;
#pragma unroll
                for (int bj = 0; bj < 2; ++bj) { const f32x4 v0 = acc[ai][bj][m][0], v1 = acc[ai][bj][m][1];
                    typedef unsigned u32x2 __attribute__((ext_vector_type(2))); u32x2 w; w.x = pk4_fp8e(v0[0], v0[1], v0[2], v0[3]); w.y = pk4_fp8e(v1[0], v1[1], v1[2], v1[3]);
                    *(u32x2*)(rowp + bj * HALF) = w; } }
    }
};
template <int NPN> struct MoeOrderT {
    const PG8_LAS int* t2e; int c, ntiles; bool rev;
    __device__ __forceinline__ bool next(int i, Unit& u) const {
        constexpr int tpx = 32 / NPN; const int s = c >> 3, tile = (i * 8 + (c & 7)) * tpx + s / NPN, pn = s % NPN;
        if ((i * 8) * tpx >= ntiles) return false;
        if (tile >= ntiles) { u.pm = 0; u.pn = 0; return false; }
        const int tl_ = rev ? ntiles - 1 - tile : tile;
        u.pm = tl_; u.pn = __builtin_amdgcn_readfirstlane(t2e[tl_]) * NPN + pn; return true;
    }
    __device__ __forceinline__ void a_ready(const Unit&) const {}
    __device__ __forceinline__ void done(const Unit&) const {}
};
struct MoeOrder {
    const PG8_LAS int* tab; int npn, G, c, nunits; bool rev;
    __device__ __forceinline__ bool next(int i, Unit& u) const {
        const int tpx = 32 / npn, s = c >> 3, tile = (i * 8 + (c & 7)) * tpx + s / npn, pn = s % npn;
        if ((i * 8) * tpx >= nunits / npn) return false;
        if (tile >= nunits / npn) { u.pm = 0; u.pn = 0; return false; }
        const int tl_ = rev ? nunits / npn - 1 - tile : tile;
        int e = 0;
#pragma unroll
        for (int k = 1; k < 32; ++k) e += (tab[k] <= tl_) ? 1 : 0;
        u.pm = tl_; u.pn = __builtin_amdgcn_readfirstlane(e) * npn + pn; return true;
    }
    __device__ __forceinline__ void a_ready(const Unit&) const {}
    __device__ __forceinline__ void done(const Unit&) const {}
};
template <class Epi, class Sched, bool ALIGN_EPI = false, bool SP2 = false, bool F8 = false, bool GATHER = false>
__device__ __forceinline__ void gemm_phase(PG8_LAS unsigned char* lds, const Gemm g, const Sched& S, const Epi& E) {
    int tid_ = threadIdx.x; asm volatile("" : "+v"(tid_));
    const int tid = tid_, wid = __builtin_amdgcn_readfirstlane(tid >> 6), lane = tid & 63, wr = wid >> 2, wc = wid & 3, fr = lane & 15, fq = lane >> 4;
    const int K = g.K, nt = K / BK;
    unsigned voffA, voffB;
    { int R, C; stage_rc(tid * 16, R, C); const int Rb = Epi::PERM ? ((R & ~31) + perm32(R & 31)) : R; voffA = (unsigned)(R * K + C) * 2u; voffB = (unsigned)(Rb * K + C) * 2u; }
    const unsigned qstep = 64u * (unsigned)K * 2u;
    const unsigned kstep = (unsigned)(BK * 2);
    const unsigned hstep = (unsigned)HALF * (unsigned)K * 2u;
    const unsigned tstep = 2u * hstep;
    const __amdgpu_buffer_rsrc_t rA = __builtin_amdgcn_make_buffer_rsrc((void*)g.A, 0, 0x7FFFFFFF, 0x00020000), rB = __builtin_amdgcn_make_buffer_rsrc((void*)g.Bt, 0, 0x7FFFFFFF, 0x00020000);
    const unsigned ldsw = (unsigned)wid * 1024u;
    const int aoff = lds_byte(wr * 64 + fr, fq * 8), boff = lds_byte(wc * 32 + fr, fq * 8);
#define PG8_SA(b, h) (((b) * 2 + (h)) * HTB)
#define PG8_SB(b, h) ((4 + (b) * 2 + (h)) * HTB)
#define PG8_STG(bufoff, rsrc, soff, voff) do { _Pragma("unroll") for (int _i = 0; _i < 2; ++_i) \
        __builtin_amdgcn_raw_ptr_buffer_load_lds((rsrc), (PG8_LAS void*)(lds + (bufoff) + ldsw + _i * 8192), 16, (int)(voff), (int)((soff) + (unsigned)_i * qstep), 0, 0); } while (0)
#define PG8_STGA(bufoff, soff) PG8_STG(bufoff, rA, soff, voffA)
#define PG8_STGB(bufoff, soff) PG8_STG(bufoff, rB, soff, voffB)
#define PG8_STGAG(bufoff, h, soff_plain, kb) do { if constexpr (GATHER) { _Pragma("unroll") for (int _i = 0; _i < 2; ++_i) \
        __builtin_amdgcn_raw_ptr_buffer_load_lds(rA, (PG8_LAS void*)(lds + (bufoff) + ldsw + _i * 8192), 16, (int)gc[h][_i], (int)(kb), 0, 0); } else PG8_STGA(bufoff, soff_plain); } while (0)
#define PG8_GLOAD(gv, pm_) do { int t3_ = threadIdx.x; asm volatile("" : "+v"(t3_)); int R_, C_; stage_rc(t3_ * 16, R_, C_); const int* rt_ = g.rowtok + (pm_) * BM + R_; \
        _Pragma("unroll") for (int h_ = 0; h_ < 2; ++h_) _Pragma("unroll") for (int i_ = 0; i_ < 2; ++i_) gv[h_][i_] = (unsigned)rt_[h_ * HALF + i_ * 64] * (unsigned)(K * 2) + (unsigned)(C_ * 2); } while (0)
#define PG8_LDA(dst, b, h) do { _Pragma("unroll") for (int m = 0; m < 4; ++m) { if constexpr (F8) { const i32x4 lo_ = *(const PG8_LAS i32x4*)(lds + PG8_SA(b, h) + aoff + m * 2048), hi_ = *(const PG8_LAS i32x4*)(lds + PG8_SA(b, h) + aoff + m * 2048 + 1024); \
            dst##_8[m] = __builtin_shufflevector(lo_, hi_, 0, 1, 2, 3, 4, 5, 6, 7); } else { _Pragma("unroll") for (int k = 0; k < 2; ++k) dst[m][k] = *(const PG8_LAS bf16x8*)(lds + PG8_SA(b, h) + aoff + m * 2048 + k * 1024); } } } while (0)
#define PG8_LDB(dst, b, h) do { _Pragma("unroll") for (int n = 0; n < 2; ++n) { if constexpr (F8) { const i32x4 lo_ = *(const PG8_LAS i32x4*)(lds + PG8_SB(b, h) + boff + n * 2048), hi_ = *(const PG8_LAS i32x4*)(lds + PG8_SB(b, h) + boff + n * 2048 + 1024); \
            dst##_8[n] = __builtin_shufflevector(lo_, hi_, 0, 1, 2, 3, 4, 5, 6, 7); } else { _Pragma("unroll") for (int k = 0; k < 2; ++k) dst[n][k] = *(const PG8_LAS bf16x8*)(lds + PG8_SB(b, h) + boff + n * 2048 + k * 1024); } } } while (0)
#define PG8_MMA(ai, bj, At, Bt) do { __builtin_amdgcn_s_setprio(1); _Pragma("unroll") for (int m = 0; m < 4; ++m) _Pragma("unroll") for (int n = 0; n < 2; ++n) { \
        if constexpr (F8) acc[ai][bj][m][n] = __builtin_amdgcn_mfma_scale_f32_16x16x128_f8f6f4(Bt##_8[n], At##_8[m], acc[ai][bj][m][n], 0, 0, 0, g.sw, 0, g.sx); \
        else { _Pragma("unroll") for (int k = 0; k < 2; ++k) acc[ai][bj][m][n] = __builtin_amdgcn_mfma_f32_16x16x32_bf16(Bt[n][k], At[m][k], acc[ai][bj][m][n], 0, 0, 0); } } \
        __builtin_amdgcn_s_setprio(0); } while (0)
#define PG8_WAIT_V(n) asm volatile("s_waitcnt vmcnt(" #n ")" ::: "memory")
#define PG8_WAIT_L(n) asm volatile("s_waitcnt lgkmcnt(" #n ")" ::: "memory")
#define PG8_BAR __builtin_amdgcn_s_barrier()
#define PG8_SCHED __builtin_amdgcn_sched_barrier(0)
    Unit cur, nxt; int ui = 0;
    if (!S.next(0, cur)) return;
    f32x4 acc[2][2][4][2];
    typename Epi::Pre pre; E.pre_load(cur, wc, fq, pre); E.acc_init(acc, pre);
    bf16x8 At[4][2], B0[2][2], B1[2][2]; i32x8 At_8[4], B0_8[2], B1_8[2];
    unsigned cA = (unsigned)cur.pm * tstep, cB = (unsigned)cur.pn * tstep;
    S.a_ready(cur);
    unsigned gc[2][2]; PG8_LAS unsigned* gl_ = (PG8_LAS unsigned*)(lds + 8 * HTB + tid * 16);
    typedef unsigned u32x2_ __attribute__((ext_vector_type(2)));
    if constexpr (GATHER) { unsigned g1_[2][2]; PG8_GLOAD(gc, cur.pm); Unit n1_; n1_.pm = 0; n1_.pn = 0; const bool h1_ = S.next(1, n1_); PG8_GLOAD(g1_, h1_ ? n1_.pm : cur.pm);
        *(PG8_LAS u32x2_*)gl_ = (u32x2_){g1_[0][0], g1_[0][1]}; *(PG8_LAS u32x2_*)(gl_ + 2) = (u32x2_){g1_[1][0], g1_[1][1]};
        asm volatile("" :: "v"(gc[0][0]), "v"(gc[0][1]), "v"(gc[1][0]), "v"(gc[1][1])); }
    if constexpr (SP2) {
        PG8_STGB(PG8_SB(0, 0), cB); PG8_STGB(PG8_SB(0, 1), cB + hstep); PG8_STGAG(PG8_SA(0, 0), 0, cA, 0u); PG8_STGAG(PG8_SA(0, 1), 1, cA + hstep, 0u);
        if (wr == 1) PG8_BAR;
        PG8_WAIT_V(2); PG8_BAR;
        PG8_STGB(PG8_SB(1, 0), cB + kstep); PG8_STGAG(PG8_SA(1, 0), 0, cA + kstep, kstep); PG8_STGB(PG8_SB(1, 1), cB + hstep + kstep);
        PG8_WAIT_V(6); PG8_BAR;
    } else {
        PG8_STGB(PG8_SB(0, 0), cB); PG8_STGA(PG8_SA(0, 0), cA); PG8_STGB(PG8_SB(0, 1), cB + hstep); PG8_STGA(PG8_SA(0, 1), cA + hstep);
        if (wr == 1) PG8_BAR;
        PG8_WAIT_V(4); PG8_BAR;
        PG8_STGB(PG8_SB(1, 0), cB + kstep); PG8_STGA(PG8_SA(1, 0), cA + kstep); PG8_STGB(PG8_SB(1, 1), cB + hstep + kstep);
        PG8_WAIT_V(6); PG8_BAR;
    }
    for (;;) {
        const bool has_next = S.next(ui + 1, nxt);
        const unsigned nA = has_next ? (unsigned)nxt.pm * tstep : cA, nB = has_next ? (unsigned)nxt.pn * tstep : cB;
#pragma unroll 1
        for (int t = 0; t < nt; t += 2) {
            const bool last = (t == nt - 2);
            const unsigned a1 = cA + (unsigned)(t + 1) * kstep;
            const unsigned a2 = last ? nA : cA + (unsigned)(t + 2) * kstep, b2 = last ? nB : cB + (unsigned)(t + 2) * kstep;
            const unsigned a3 = a2 + kstep, b3 = b2 + kstep;
            if (last && has_next) S.a_ready(nxt);
            const unsigned k1_ = (unsigned)(t + 1) * kstep, k2_ = last ? 0u : (unsigned)(t + 2) * kstep;
            if constexpr (GATHER) { if (last) { const u32x2_ w0_ = *(const PG8_LAS u32x2_*)gl_; gc[0][0] = w0_.x; gc[0][1] = w0_.y; } }
            if constexpr (SP2) {
            PG8_LDB(B0, 0, 0); PG8_LDB(B1, 0, 1); PG8_SCHED; PG8_LDA(At, 0, 0); PG8_STGAG(PG8_SA(1, 1), 1, a1 + hstep, k1_);
            if constexpr (GATHER) { if (last) { const u32x2_ w1_ = *(const PG8_LAS u32x2_*)(gl_ + 2); gc[1][0] = w1_.x; gc[1][1] = w1_.y; } }
            PG8_WAIT_V(8); PG8_WAIT_L(0); PG8_BAR; PG8_MMA(0, 0, At, B0); PG8_MMA(0, 1, At, B1); PG8_BAR; PG8_SCHED;
            PG8_LDA(At, 0, 1); PG8_STGB(PG8_SB(0, 0), b2); PG8_STGB(PG8_SB(0, 1), b2 + hstep); PG8_STGAG(PG8_SA(0, 0), 0, a2, k2_);
            PG8_WAIT_V(8); PG8_WAIT_L(0); PG8_BAR; PG8_MMA(1, 0, At, B0); PG8_MMA(1, 1, At, B1); PG8_BAR; PG8_SCHED;
            PG8_LDB(B0, 1, 0); PG8_LDB(B1, 1, 1); PG8_SCHED; PG8_LDA(At, 1, 0); PG8_STGAG(PG8_SA(0, 1), 1, a2 + hstep, k2_);
            PG8_WAIT_V(8); PG8_WAIT_L(0); PG8_BAR; PG8_MMA(0, 0, At, B0); PG8_MMA(0, 1, At, B1); PG8_BAR; PG8_SCHED;
            PG8_LDA(At, 1, 1); PG8_STGB(PG8_SB(1, 0), b3); PG8_STGB(PG8_SB(1, 1), b3 + hstep); PG8_STGAG(PG8_SA(1, 0), 0, a3, k2_ + kstep);
            PG8_WAIT_V(8); PG8_WAIT_L(0); PG8_BAR; PG8_MMA(1, 0, At, B0); PG8_MMA(1, 1, At, B1); PG8_BAR; PG8_SCHED;
            } else {
            PG8_LDB(B0, 0, 0); PG8_SCHED; PG8_LDA(At, 0, 0); PG8_STGA(PG8_SA(1, 1), a1 + hstep);
            PG8_WAIT_L(8); PG8_BAR; PG8_WAIT_L(0); PG8_MMA(0, 0, At, B0); PG8_BAR; PG8_SCHED;
            PG8_LDB(B1, 0, 1); PG8_STGB(PG8_SB(0, 0), b2);
            PG8_BAR; PG8_WAIT_L(0); PG8_MMA(0, 1, At, B1); PG8_BAR;
            PG8_LDA(At, 0, 1); PG8_STGA(PG8_SA(0, 0), a2);
            PG8_BAR; PG8_WAIT_L(0); PG8_MMA(1, 0, At, B0); PG8_BAR; PG8_SCHED;
            PG8_STGB(PG8_SB(0, 1), b2 + hstep);
            PG8_WAIT_V(6); PG8_BAR; PG8_MMA(1, 1, At, B1); PG8_BAR;
            PG8_LDB(B0, 1, 0); PG8_SCHED; PG8_LDA(At, 1, 0); PG8_STGA(PG8_SA(0, 1), a2 + hstep);
            PG8_WAIT_L(8); PG8_BAR; PG8_WAIT_L(0); PG8_MMA(0, 0, At, B0); PG8_BAR; PG8_SCHED;
            PG8_LDB(B1, 1, 1); PG8_STGB(PG8_SB(1, 0), b3);
            PG8_BAR; PG8_WAIT_L(0); PG8_MMA(0, 1, At, B1); PG8_BAR;
            PG8_LDA(At, 1, 1); PG8_STGA(PG8_SA(1, 0), a3);
            PG8_BAR; PG8_WAIT_L(0); PG8_MMA(1, 0, At, B0); PG8_BAR; PG8_SCHED;
            PG8_STGB(PG8_SB(1, 1), b3 + hstep);
            PG8_WAIT_V(6); PG8_BAR; PG8_MMA(1, 1, At, B1); PG8_BAR;
            }
        }
        if constexpr (ALIGN_EPI) { if (wr == 0) PG8_BAR; }
        unsigned gnn[2][2];
        if constexpr (GATHER) { Unit n2_; n2_.pm = 0; n2_.pn = 0; const bool h2_ = S.next(ui + 2, n2_); const int pm2_ = h2_ ? n2_.pm : (has_next ? nxt.pm : cur.pm); PG8_GLOAD(gnn, pm2_); }
        if constexpr (!Epi::AFTER_DRAIN) { int t2_ = threadIdx.x; asm volatile("" : "+v"(t2_)); { const Unit pu_ = has_next ? nxt : cur; E.pre_load(pu_, wc, (t2_ & 63) >> 4, pre); }     E(acc, cur, wr, wc, t2_ & 15, (t2_ & 63) >> 4); S.done(cur); }
        if (!has_next) break;
        E.acc_init(acc, pre);
        if constexpr (GATHER) { *(PG8_LAS u32x2_*)gl_ = (u32x2_){gnn[0][0], gnn[0][1]}; *(PG8_LAS u32x2_*)(gl_ + 2) = (u32x2_){gnn[1][0], gnn[1][1]}; }
        cur = nxt; cA = nA; cB = nB; ++ui;
        if constexpr (ALIGN_EPI) { if (wr == 1) PG8_BAR; }
    }
    PG8_WAIT_V(0);
    if constexpr (!ALIGN_EPI) { if (wr == 0) PG8_BAR; }
    PG8_BAR;
    if constexpr (Epi::AFTER_DRAIN) { E.fused(acc, cur, wr, wc, fr, fq, lds, wid, lane); S.done(cur); }
#undef PG8_SA
#undef PG8_SB
#undef PG8_STG
#undef PG8_STGA
#undef PG8_STGB
#undef PG8_STGAG
#undef PG8_GLOAD
#undef PG8_LDA
#undef PG8_LDB
#undef PG8_MMA
#undef PG8_WAIT_V
#undef PG8_WAIT_L
#undef PG8_BAR
#undef PG8_SCHED
}
}

constexpr int NWAVES = 8, NTHR = 512, GRID = 256;
constexpr int NBATCH = 2, SEQ = 16384, T = NBATCH * SEQ, D = 1024, DEPTH = 4;
constexpr int MIXW = 768, NC_H = 3328, NC_M = 2560;
constexpr int HG_H = 6;
constexpr int HSEG = 256, HNSEG = SEQ / HSEG;
constexpr int MB_H = 12, MB_NB = 64;
constexpr int NE = 32;
constexpr float DN_ALPHA = 1.6817928305074290f;
constexpr int MOE_MAXROWS = T * 4 + NE * 256;
#ifndef ONE_LAUNCH
#define ONE_LAUNCH 1
#endif
constexpr int NPHASE = 13;

constexpr size_t MiB = 1u << 20;
constexpr size_t WS_CTL = 0, CTL_ZERO_BYTES = 1 * MiB;
constexpr size_t WS_WIN = 1 * MiB, WS_WKV = 9 * MiB, WS_WO = 10 * MiB, WS_WGU = 12 * MiB, WS_WD = 140 * MiB;
constexpr size_t WS_XBF = 204 * MiB, WS_WKV4 = 268 * MiB  , WS_KV4 = 272 * MiB  , WS_WRS = 280 * MiB  , WS_MEMBF = 524 * MiB;
constexpr size_t WS_H = 526 * MiB, WS_MIX = 734 * MiB, WS_Y = 798 * MiB, WS_SLOC = 862 * MiB, WS_DSEG = 910 * MiB, WS_KMEAN = 911 * MiB;
constexpr size_t WS_SELINFO = 912 * MiB, WS_TOK = 914 * MiB, WS_R1 = 918 * MiB;
constexpr size_t WS_LIST = WS_R1, WS_PML = WS_R1 + 96 * MiB, WS_PO = WS_R1 + 108 * MiB;
constexpr size_t WS_XS = WS_R1, WS_HID = WS_R1 + 272 * MiB;
constexpr size_t WS_END = WS_R1 + 544 * MiB;
static_assert((size_t)MOE_MAXROWS * 1024 * 2 <= 272 * MiB, "moe rows");
static_assert((size_t)T * MB_H * 4 * 64 * 4 <= 384 * MiB && (size_t)24 * 64 * 16384 * 4 <= 96 * MiB, "moba bufs");
constexpr size_t TOK_E = 0, TOK_LR = 512 * 1024, TOK_W = 1024 * 1024, TOK_ROW = 1536 * 1024, TOK_BLKCNT = 2048 * 1024, TOK_TAB = 2048 * 1024 + 65536;
constexpr int CW_BAR = 4096, CW_GCOUNT = 8192;

constexpr int RING_BYTES = 131072, LDS_BYTES = 147456, MISC_OFF = LDS_BYTES - 1024;

#define GAS __attribute__((address_space(1)))
#define LAS __attribute__((address_space(3)))
typedef unsigned short bf16;
typedef unsigned v4u __attribute__((ext_vector_type(4)));
typedef unsigned v2u __attribute__((ext_vector_type(2)));
typedef float f32x4 __attribute__((ext_vector_type(4)));
typedef float f32x2 __attribute__((ext_vector_type(2)));
typedef short s16x8 __attribute__((ext_vector_type(8)));
typedef float f32x16 __attribute__((ext_vector_type(16)));
typedef float f32x2_t __attribute__((ext_vector_type(2))); typedef __bf16 bf16x2_t __attribute__((ext_vector_type(2)));
__device__ __forceinline__ unsigned cvtpk(float lo, float hi) { f32x2_t v = {lo, hi}; bf16x2_t b = __builtin_convertvector(v, bf16x2_t); return __builtin_bit_cast(unsigned, b); }
#define LDS_WAIT() asm volatile("s_waitcnt lgkmcnt(0)" ::: "memory")
__device__ __forceinline__ unsigned f2bf(float f) { unsigned u = __builtin_bit_cast(unsigned, f); return (u + 0x7fffu + ((u >> 16) & 1u)) >> 16; }
__device__ __forceinline__ unsigned pk2(float lo, float hi) { return f2bf(lo) | (f2bf(hi) << 16); }
__device__ __forceinline__ float bflo(unsigned w) { return __builtin_bit_cast(float, w << 16); }
__device__ __forceinline__ float bfhi(unsigned w) { return __builtin_bit_cast(float, w & 0xffff0000u); }
__device__ __forceinline__ float bf2f(bf16 h) { return __builtin_bit_cast(float, (unsigned)h << 16); }
__device__ __forceinline__ float sigmoidf_(float z) { return __builtin_amdgcn_rcpf(1.0f + __builtin_amdgcn_exp2f(-1.4426950408889634f * z)); }
template <int X> __device__ __forceinline__ float xorf(float v) { return __builtin_bit_cast(float, __builtin_amdgcn_ds_swizzle(__builtin_bit_cast(int, v), (X << 10) | 0x1F)); }
template <int X> __device__ __forceinline__ int xori(int v) { return __builtin_amdgcn_ds_swizzle(v, (X << 10) | 0x1F); }
__device__ __forceinline__ float wave_sum(float v) {
    v += xorf<1>(v); v += xorf<2>(v); v += xorf<4>(v); v += xorf<8>(v); v += xorf<16>(v);
    return __builtin_bit_cast(float, __builtin_amdgcn_readlane(__builtin_bit_cast(int, v), 0)) + __builtin_bit_cast(float, __builtin_amdgcn_readlane(__builtin_bit_cast(int, v), 32));
}
__device__ __forceinline__ float wave_max(float v) {
    v = fmaxf(v, xorf<1>(v)); v = fmaxf(v, xorf<2>(v)); v = fmaxf(v, xorf<4>(v)); v = fmaxf(v, xorf<8>(v)); v = fmaxf(v, xorf<16>(v));
    return fmaxf(__builtin_bit_cast(float, __builtin_amdgcn_readlane(__builtin_bit_cast(int, v), 0)), __builtin_bit_cast(float, __builtin_amdgcn_readlane(__builtin_bit_cast(int, v), 32)));
}
__device__ __forceinline__ float xor32f(float v, int lane) { return __builtin_bit_cast(float, __builtin_amdgcn_ds_bpermute((lane ^ 32) << 2, __builtin_bit_cast(int, v))); }
#define XB_TMO      128
#define XB_XCNT(j)  (256  + 64 * (j))
#define XB_XSUB(j)  (1280 + 64 * (j))
#define XB_XGEN(j)  (2304 + 64 * (j))
#define XB_TOP      3328
#define XB_TOPGEN   3392
#define XCD_BAR_WORDS 3456
#define XB_SPIN_CAP (1u << 18)

__device__ __forceinline__ unsigned xb_ld(unsigned* p)              { return __hip_atomic_load(p, __ATOMIC_RELAXED, __HIP_MEMORY_SCOPE_AGENT); }
__device__ __forceinline__ unsigned xb_add(unsigned* p, unsigned v) { return __hip_atomic_fetch_add(p, v, __ATOMIC_RELAXED, __HIP_MEMORY_SCOPE_AGENT); }
__device__ __forceinline__ unsigned xb_xcc_id() { return (unsigned)__builtin_amdgcn_s_getreg((3 << 11) | 20) & 0xFu; }
#define XB_SPIN(cond, bar) do { unsigned _sp = 0; while (cond) { __builtin_amdgcn_s_sleep(1); \
    if ((++_sp & 255u) == 0u) { if (xb_ld(&(bar)[XB_TMO])) break; if (_sp > XB_SPIN_CAP) { atomicAdd(&(bar)[XB_TMO], 1u); break; } } } } while (0)

struct XcdBarrier {
    unsigned* bar; unsigned x;
    volatile LAS unsigned* st;
};

__device__ __forceinline__ XcdBarrier xcd_barrier_post(unsigned* bar, volatile LAS unsigned* st) {
    XcdBarrier b; b.bar = bar; b.x = xb_xcc_id(); b.st = st;
    if (threadIdx.x == 0) (void)xb_add(&bar[XB_XCNT(b.x)], 1u);
    return b;
}
__device__ __forceinline__ void xcd_barrier_complete(unsigned* bar, unsigned x, unsigned& nloc, unsigned& nx) {
    const unsigned G = gridDim.x * gridDim.y * gridDim.z;
    unsigned sum, cnt, mine, sp = 0u;
    for (;;) {
        sum = 0u; cnt = 0u; mine = 0u;
#pragma unroll
        for (unsigned j = 0; j < 16; ++j) { const unsigned c = xb_ld(&bar[XB_XCNT(j)]); sum += c; cnt += (c > 0u) ? 1u : 0u; mine = (j == x) ? c : mine; }
        if (sum == G) break;
        __builtin_amdgcn_s_sleep(1);
        if ((++sp & 255u) == 0u) { if (xb_ld(&bar[XB_TMO])) break; if (sp > XB_SPIN_CAP) { atomicAdd(&bar[XB_TMO], 1u); break; } }
    }
    nloc = mine > 0u ? mine : 1u; nx = cnt > 0u ? cnt : 1u;
}

__device__ __forceinline__ void xcd_barrier(const XcdBarrier& b) {
    asm volatile("s_waitcnt vmcnt(0)" ::: "memory");
    __syncthreads();
    if (threadIdx.x == 0) {
        unsigned* bar = b.bar;
        __builtin_amdgcn_s_waitcnt(0);
        unsigned nloc = b.st[0], nx = b.st[1];
        if (nloc == 0u) { xcd_barrier_complete(bar, b.x, nloc, nx); b.st[0] = nloc; b.st[1] = nx; }
        const unsigned old = xb_add(&bar[XB_XSUB(b.x)], 1u);
        const unsigned gen = old / nloc;
        if (old + 1u == (gen + 1u) * nloc) {
            __builtin_amdgcn_fence(__ATOMIC_RELEASE, "agent");
            asm volatile("s_waitcnt vmcnt(0)" ::: "memory");
            const unsigned og = xb_add(&bar[XB_TOP], 1u);
            const unsigned tg = og / nx;
            if (og + 1u == (tg + 1u) * nx) xb_add(&bar[XB_TOPGEN], 1u);
            else XB_SPIN(xb_ld(&bar[XB_TOPGEN]) == tg, bar);
            __builtin_amdgcn_fence(__ATOMIC_ACQUIRE, "agent");
            xb_add(&bar[XB_XGEN(b.x)], 1u);
            asm volatile("s_waitcnt vmcnt(0)" ::: "memory");
        } else {
            XB_SPIN(xb_ld(&bar[XB_XGEN(b.x)]) == gen, bar);
            __builtin_amdgcn_fence(__ATOMIC_ACQUIRE, "agent");
            asm volatile("s_waitcnt vmcnt(0)" ::: "memory");
        }
    }
    __syncthreads();
}
__device__ __forceinline__ void cvt_rows_bf16_f8(const float* src, bf16* dst, unsigned char* dst8, size_t n8, size_t gtid, size_t gthreads) {
    for (size_t i = gtid; i < n8; i += gthreads) { const f32x4 a = __builtin_nontemporal_load((const f32x4*)src + 2 * i), b = __builtin_nontemporal_load((const f32x4*)src + 2 * i + 1);
        v4u o; o.x = pk2(a.x, a.y); o.y = pk2(a.z, a.w); o.z = pk2(b.x, b.y); o.w = pk2(b.z, b.w); ((v4u*)dst)[i] = o;
        v2u q; { int w = 0; w = __builtin_amdgcn_cvt_pk_fp8_f32(bflo(o.x), bfhi(o.x), w, false); w = __builtin_amdgcn_cvt_pk_fp8_f32(bflo(o.y), bfhi(o.y), w, true); q.x = (unsigned)w; }
        { int w = 0; w = __builtin_amdgcn_cvt_pk_fp8_f32(bflo(o.z), bfhi(o.z), w, false); w = __builtin_amdgcn_cvt_pk_fp8_f32(bflo(o.w), bfhi(o.w), w, true); q.y = (unsigned)w; }
        ((v2u*)dst8)[i] = q; }
}
__device__ __forceinline__ void cvt_rows_bf16(const float* src, bf16* dst, size_t n8, size_t gtid, size_t gthreads) {
    for (size_t i = gtid; i < n8; i += gthreads) { const f32x4 a = __builtin_nontemporal_load((const f32x4*)src + 2 * i), b = __builtin_nontemporal_load((const f32x4*)src + 2 * i + 1);
        v4u o; o.x = pk2(a.x, a.y); o.y = pk2(a.z, a.w); o.z = pk2(b.x, b.y); o.w = pk2(b.z, b.w); ((v4u*)dst)[i] = o; }
}
__device__ __forceinline__ void transpose_item(const float* W, int N, bf16* WT, int dst_row0, LAS float* scr, int k0, int n0, int lane) {
#pragma unroll 8
    for (int i = 0; i < 32; ++i) { const int kk = 2 * i + (lane >> 5); scr[kk * 33 + (lane & 31)] = __builtin_nontemporal_load(W + (size_t)(k0 + kk) * N + n0 + (lane & 31)); }
    LDS_WAIT(); asm volatile("" ::: "memory");
    const int c = lane & 7;
#pragma unroll
    for (int j = 0; j < 4; ++j) { const int n = (lane >> 3) + 8 * j; const LAS float* s = scr + (8 * c) * 33 + n;
        v4u o; o.x = pk2(s[0 * 33], s[1 * 33]); o.y = pk2(s[2 * 33], s[3 * 33]); o.z = pk2(s[4 * 33], s[5 * 33]); o.w = pk2(s[6 * 33], s[7 * 33]);
        *(v4u*)(WT + (size_t)(dst_row0 + n) * 1024 + k0 + 8 * c) = o; }
    LDS_WAIT(); asm volatile("" ::: "memory");
}
__device__ __forceinline__ unsigned pk4_fp8(float a, float b, float c, float d) { int w = 0; w = __builtin_amdgcn_cvt_pk_fp8_f32(a, b, w, false); w = __builtin_amdgcn_cvt_pk_fp8_f32(c, d, w, true); return (unsigned)w; }
__device__ __forceinline__ void transpose_item_f8(const float* W, int N, unsigned char* WT8, int dst_row0, LAS float* scr, int k0, int n0, int lane, float wscale) {
#pragma unroll 8
    for (int i = 0; i < 32; ++i) { const int kk = 2 * i + (lane >> 5); scr[kk * 33 + (lane & 31)] = __builtin_nontemporal_load(W + (size_t)(k0 + kk) * N + n0 + (lane & 31)); }
    LDS_WAIT(); asm volatile("" ::: "memory");
    const int c = lane & 7;
#pragma unroll
    for (int j = 0; j < 4; ++j) { const int n = (lane >> 3) + 8 * j; const LAS float* s = scr + (8 * c) * 33 + n;
        v2u o; o.x = pk4_fp8(s[0 * 33] * wscale, s[1 * 33] * wscale, s[2 * 33] * wscale, s[3 * 33] * wscale); o.y = pk4_fp8(s[4 * 33] * wscale, s[5 * 33] * wscale, s[6 * 33] * wscale, s[7 * 33] * wscale);
        *(v2u*)(WT8 + (size_t)(dst_row0 + n) * 1024 + k0 + 8 * c) = o; }
    LDS_WAIT(); asm volatile("" ::: "memory");
}
__device__ __forceinline__ void phase_weights(LAS float* scr, int gw, int ngw, int lane, const float* win_src, int NC, const float* wkv_src, int nkv, const float* wo_src,
                                              const float* wg_src, const float* wu_src, const float* wd_src, bf16* win_t, bf16* wkv_t, bf16* wo_t, bf16* wgu_t, bf16* wd_t, int mode, bool win8 = false) {
    const int nbw = NC / 32, nWin = nbw * 16, NPROJ = nWin + 256 * nkv + 512, NIT = mode == 1 ? NPROJ : NPROJ + NE * 1536;
    if (mode >= 2) {
        const int per = mode == 2 ? 1024 : 512;
        for (int it = gw; it < NE * per; it += ngw) { const int e = it / per, q = it - e * per, which = mode == 2 ? (q >> 9) : 2, rr = q & 511, kb = rr >> 5, nb = rr & 31, n0 = 32 * nb;
            const size_t eoff = (size_t)e * 1024 * 1024;
            if (which == 0) transpose_item_f8(wg_src + eoff, 1024, (unsigned char*)wgu_t + 2 * eoff, (n0 >> 7) * 256 + (n0 & 127), scr, 64 * kb, n0, lane, 32.f);
            else if (which == 1) transpose_item_f8(wu_src + eoff, 1024, (unsigned char*)wgu_t + 2 * eoff, (n0 >> 7) * 256 + 128 + (n0 & 127), scr, 64 * kb, n0, lane, 32.f);
            else transpose_item_f8(wd_src + eoff, 1024, (unsigned char*)wd_t + eoff, n0, scr, 64 * kb, n0, lane, 64.f); }
        return; }
    for (int it = gw; it < NIT; it += ngw) {
        int r = it;
        if (r < nWin) { const int kb = r / nbw, nb = r - kb * nbw; if (win8) transpose_item_f8(win_src, NC, (unsigned char*)win_t, 32 * nb, scr, 64 * kb, 32 * nb, lane, 32.f); else transpose_item(win_src, NC, win_t, 32 * nb, scr, 64 * kb, 32 * nb, lane); continue; } r -= nWin;
        if (r < 256 * nkv) { const int lay = r >> 8, rr = r & 255, kb = rr >> 4, nb = rr & 15; transpose_item(wkv_src + (size_t)lay * D * 512, 512, wkv_t + (size_t)lay * 512 * 1024, 32 * nb, scr, 64 * kb, 32 * nb, lane); continue; } r -= 256 * nkv;
        if (r < 512) { const int kb = r >> 5, nb = r & 31; transpose_item_f8(wo_src, 1024, (unsigned char*)wo_t, 32 * nb, scr, 64 * kb, 32 * nb, lane, 32.f); continue; } r -= 512;
        const int e = r / 1536, q = r - e * 1536, which = q >> 9, rr = q & 511, kb = rr >> 5, nb = rr & 31, n0 = 32 * nb;
        const size_t eoff = (size_t)e * 1024 * 1024;
        if (which == 0) transpose_item_f8(wg_src + eoff, 1024, (unsigned char*)wgu_t + 2 * eoff, (n0 >> 7) * 256 + (n0 & 127), scr, 64 * kb, n0, lane, 32.f);
        else if (which == 1) transpose_item_f8(wu_src + eoff, 1024, (unsigned char*)wgu_t + 2 * eoff, (n0 >> 7) * 256 + 128 + (n0 & 127), scr, 64 * kb, n0, lane, 32.f);
        else transpose_item_f8(wd_src + eoff, 1024, (unsigned char*)wd_t + eoff, n0, scr, 64 * kb, n0, lane, 64.f);
    }
}

template <bool OUT>
__device__ __forceinline__ void hgrn_seg(LAS unsigned char* lds, const bf16* h, const float* lbl, int j, const float* normg, float* Sloc, float* Dseg, bf16* mix, int unit, int tid, int wave, int lane) {
    const int seg = unit & (HNSEG - 1), bh = unit >> 6, hh = bh % HG_H, b = bh / HG_H;
    const int v = tid & 127, dg = tid >> 7;
    LAS float* fgs = (LAS float*)lds; LAS float* vs = fgs + 4096; LAS float* qs = vs + 4096; LAS float* op = qs + 4096;
    f32x2 st[16];
    float* Sp = Sloc + (size_t)unit * 16384 + (size_t)(dg * 32) * 128 + v;
#pragma unroll
    for (int dd = 0; dd < 16; ++dd) { st[dd].x = OUT ? Sp[(2 * dd) * 128] : 0.f; st[dd].y = OUT ? Sp[(2 * dd + 1) * 128] : 0.f; }
    float dprod = 1.f;
    const int stok = tid >> 4, c8 = (tid & 15) * 8;
    float lb[8];
#pragma unroll
    for (int i = 0; i < 8; ++i) { lb[i] = 0.f; if (j > 0) { const float a0 = lbl[hh * 128 + c8 + i], a1 = lbl[MIXW + hh * 128 + c8 + i]; lb[i] = 1.f / (1.f + __expf(a0 - a1)); } }
    for (int ch = 0; ch < HSEG / 32; ++ch) {
        const size_t t0 = (size_t)b * SEQ + seg * HSEG + ch * 32;
        { const bf16* row = h + (t0 + stok) * NC_H + hh * 128 + c8;
          const v4u f8 = *(const v4u*)(row + 768), i8 = *(const v4u*)(row + 1536); v4u q8 = {0u, 0u, 0u, 0u}; if (OUT) q8 = *(const v4u*)row;
#pragma unroll
          for (int w = 0; w < 4; ++w) { const float f0 = bflo(f8[w]), f1 = bfhi(f8[w]); const int o = stok * 128 + c8 + 2 * w;
              fgs[o] = lb[2 * w] + (1.f - lb[2 * w]) * sigmoidf_(f0); fgs[o + 1] = lb[2 * w + 1] + (1.f - lb[2 * w + 1]) * sigmoidf_(f1);
              vs[o] = bflo(i8[w]); vs[o + 1] = bfhi(i8[w]);
              if (OUT) { const float q0 = bflo(q8[w]), q1 = bfhi(q8[w]); qs[o] = q0 * sigmoidf_(q0); qs[o + 1] = q1 * sigmoidf_(q1); } } }
        __syncthreads();
        if (!OUT) { if (tid < 128) { for (int tt = 0; tt < 32; ++tt) dprod *= fgs[tt * 128 + tid]; } }
        f32x4 fA[8], qA[8], fB[8], qB[8]; float vA, vB;
#define HG_LOAD(F, Q, V, tt_) do { V = vs[(tt_) * 128 + v]; _Pragma("unroll") for (int d4 = 0; d4 < 8; ++d4) { F[d4] = *(const LAS f32x4*)(fgs + (tt_) * 128 + dg * 32 + d4 * 4); \
            if (OUT) Q[d4] = *(const LAS f32x4*)(qs + (tt_) * 128 + dg * 32 + d4 * 4); } } while (0)
#define HG_STEP(F, Q, V, tt_) do { const f32x2 vv2 = {V, V}; f32x2 acc2 = {0.f, 0.f}; _Pragma("unroll") for (int d4 = 0; d4 < 8; ++d4) { \
            const f32x2 fa = {F[d4].x, F[d4].y}, fb = {F[d4].z, F[d4].w}; \
            st[2 * d4] = fa * (st[2 * d4] - vv2) + vv2; st[2 * d4 + 1] = fb * (st[2 * d4 + 1] - vv2) + vv2; \
            if (OUT) { const f32x2 qa = {Q[d4].x, Q[d4].y}, qb = {Q[d4].z, Q[d4].w}; acc2 = qa * st[2 * d4] + acc2; acc2 = qb * st[2 * d4 + 1] + acc2; } } \
            if (OUT) op[(dg * 32 + (tt_)) * 128 + v] = acc2.x + acc2.y; } while (0)
        HG_LOAD(fA, qA, vA, 0);
#pragma unroll 1
        for (int tt = 0; tt < 32; tt += 2) {
            HG_LOAD(fB, qB, vB, tt + 1);
            __builtin_amdgcn_sched_barrier(0);
            HG_STEP(fA, qA, vA, tt);
            __builtin_amdgcn_sched_barrier(0);
            if (tt + 2 < 32) HG_LOAD(fA, qA, vA, tt + 2);
            __builtin_amdgcn_sched_barrier(0);
            HG_STEP(fB, qB, vB, tt + 1);
            __builtin_amdgcn_sched_barrier(0);
        }
#undef HG_LOAD
#undef HG_STEP
        if (OUT) {
            __syncthreads();
#pragma unroll
            for (int k = 0; k < 4; ++k) { const int tt = wave + 8 * k; float o0 = 0.f, o1 = 0.f;
#pragma unroll
                for (int g = 0; g < 4; ++g) { o0 += op[(g * 32 + tt) * 128 + lane]; o1 += op[(g * 32 + tt) * 128 + lane + 64]; }
                const float ms = wave_sum(o0 * o0 + o1 * o1) * (1.f / 128.f), r = 1.f / sqrtf(ms + 1e-6f);
                const bf16* grow = h + (t0 + tt) * NC_H + 2304 + hh * 128; const float g0 = bf2f(grow[lane]), g1 = bf2f(grow[lane + 64]);
                bf16* mrow = mix + (t0 + tt) * 1024 + hh * 128;
                mrow[lane] = (bf16)f2bf(o0 * r * normg[lane] * sigmoidf_(g0)); mrow[lane + 64] = (bf16)f2bf(o1 * r * normg[lane + 64] * sigmoidf_(g1)); }
        }
        __syncthreads();
    }
    if (!OUT) {
#pragma unroll
        for (int dd = 0; dd < 16; ++dd) { Sp[(2 * dd) * 128] = st[dd].x; Sp[(2 * dd + 1) * 128] = st[dd].y; }
        if (tid < 128) Dseg[(size_t)unit * 128 + tid] = dprod;
    }
}
constexpr int HG_G = 0, HG_QT = 32768, HG_KT = 50176, HG_KE = 67584, HG_VT = 86016, HG_ST = 104448, HG_GM = 139264, HG_GE = 139776, HG_PART = 140288, HG_EGM = 142336, HG_EGE = 142848;
static_assert(HG_EGE + 512 <= MISC_OFF, "HGRN LDS map");
__device__ __forceinline__ int crow16(int i, int hf) { return (i & 3) + 8 * (i >> 2) + 4 * hf; }
template <bool OUT>
__device__ __forceinline__ void hgrn_mfma(LAS unsigned char* lds, const bf16* h, const float* lbl, int j, const float* normg, float* Sloc, float* Dseg, bf16* mix, int unit, int tid, int wave, int lane) {
    const int seg = unit & (HNSEG - 1), bh = unit >> 6, hh = bh % HG_H, b = bh / HG_H;
    const int r = lane & 31, hf = lane >> 5, tr = wave & 1, vq = wave >> 1;
    LAS float* G = (LAS float*)(lds + HG_G); LAS float* GM = (LAS float*)(lds + HG_GM); LAS float* GE = (LAS float*)(lds + HG_GE); LAS float* PART = (LAS float*)(lds + HG_PART); LAS float* EGM = (LAS float*)(lds + HG_EGM); LAS float* EGE = (LAS float*)(lds + HG_EGE);
    const int stok = tid >> 3, c16 = (tid & 7) * 16, sperm = (stok & ~15) | (stok & 3) | ((stok & 4) << 1) | ((stok & 8) >> 1);
    const int cd = tid & 127, cpart = tid >> 7;
    float lb[16];
#pragma unroll
    for (int e = 0; e < 16; ++e) { lb[e] = 0.f; if (j > 0) { const float a0 = lbl[hh * 128 + c16 + e], a1 = lbl[MIXW + hh * 128 + c16 + e]; lb[e] = 1.f / (1.f + __expf(a0 - a1)); } }
    f32x16 S[2];
    bf16* Sp = (bf16*)Sloc + (size_t)unit * 16384 + 32 * vq + r;
#pragma unroll
    for (int dd = 0; dd < 2; ++dd)
#pragma unroll
        for (int i = 0; i < 16; ++i) S[dd][i] = OUT ? bf2f(Sp[(32 * (2 * tr + dd) + crow16(i, hf)) * 128]) : 0.f;
    float gsum = 0.f;
    float ng16[16];
#pragma unroll
    for (int e = 0; e < 16; ++e) ng16[e] = OUT ? normg[c16 + e] : 0.f;
    v4u nf8[2], ni8[2], nq8[2] = {{0u, 0u, 0u, 0u}, {0u, 0u, 0u, 0u}}, ng8[2] = {{0u, 0u, 0u, 0u}, {0u, 0u, 0u, 0u}};
#define HG_RAWLOAD(t0_) do { const bf16* row_ = h + ((t0_) + stok) * NC_H + hh * 128 + c16; nf8[0] = *(const v4u*)(row_ + 768); nf8[1] = *(const v4u*)(row_ + 776); ni8[0] = *(const v4u*)(row_ + 1536); ni8[1] = *(const v4u*)(row_ + 1544); \
        if (OUT) { nq8[0] = *(const v4u*)row_; nq8[1] = *(const v4u*)(row_ + 8); ng8[0] = *(const v4u*)(row_ + 2304); ng8[1] = *(const v4u*)(row_ + 2312); } } while (0)
    HG_RAWLOAD((size_t)b * SEQ + seg * HSEG);
    for (int ch = 0; ch < HSEG / 64; ++ch) {
        const size_t t0 = (size_t)b * SEQ + seg * HSEG + ch * 64;
        float fg[16], qv[16]; v4u i8[2], g8[2];
        { const v4u f8[2] = {nf8[0], nf8[1]}; i8[0] = ni8[0]; i8[1] = ni8[1]; const v4u q8[2] = {nq8[0], nq8[1]}; g8[0] = ng8[0]; g8[1] = ng8[1];
#pragma unroll
          for (int w = 0; w < 8; ++w) { const unsigned fw = f8[w >> 2][w & 3]; const float f0 = bflo(fw), f1 = bfhi(fw);
              fg[2 * w] = lb[2 * w] + (1.f - lb[2 * w]) * sigmoidf_(f0); fg[2 * w + 1] = lb[2 * w + 1] + (1.f - lb[2 * w + 1]) * sigmoidf_(f1);
              if (OUT) { const unsigned qw = q8[w >> 2][w & 3]; const float q0 = bflo(qw), q1 = bfhi(qw); qv[2 * w] = q0 * sigmoidf_(q0); qv[2 * w + 1] = q1 * sigmoidf_(q1); } else { qv[2 * w] = 0.f; qv[2 * w + 1] = 0.f; } }
#pragma unroll
          for (int e4 = 0; e4 < 4; ++e4) { f32x4 lg; lg.x = __builtin_amdgcn_logf(fg[4 * e4]); lg.y = __builtin_amdgcn_logf(fg[4 * e4 + 1]); lg.z = __builtin_amdgcn_logf(fg[4 * e4 + 2]); lg.w = __builtin_amdgcn_logf(fg[4 * e4 + 3]);
              *(LAS f32x4*)(G + stok * 128 + c16 + 4 * e4) = lg; } }
        __syncthreads();
        { float run = 0.f;
#pragma unroll
          for (int k = 0; k < 16; ++k) run += G[(16 * cpart + k) * 128 + cd];
          PART[cpart * 128 + cd] = run; }
        __syncthreads();
        { float run = 0.f;
#pragma unroll
          for (int pp = 0; pp < 3; ++pp) run += (pp < cpart) ? PART[pp * 128 + cd] : 0.f;
#pragma unroll
          for (int k = 0; k < 16; ++k) { run += G[(16 * cpart + k) * 128 + cd]; G[(16 * cpart + k) * 128 + cd] = run; }
          if (cpart == 1) { GM[cd] = run; EGM[cd] = __builtin_amdgcn_exp2f(run); }
          if (cpart == 3) { GE[cd] = run; EGE[cd] = __builtin_amdgcn_exp2f(run); gsum += run; } }
        __syncthreads();
        if (OUT) {
#pragma unroll
            for (int dd = 0; dd < 2; ++dd)
#pragma unroll
                for (int g4 = 0; g4 < 4; ++g4) { const int dbase = 32 * (2 * tr + dd) + 8 * g4 + 4 * hf; const f32x4 gm = *(const LAS f32x4*)(EGM + dbase);
                    v2u w; w.x = cvtpk(S[dd][4 * g4] * gm.x, S[dd][4 * g4 + 1] * gm.y); w.y = cvtpk(S[dd][4 * g4 + 2] * gm.z, S[dd][4 * g4 + 3] * gm.w);
                    *(LAS v2u*)(lds + HG_ST + (32 * vq + r) * 272 + dbase * 2) = w; }
        }
        { unsigned qt[8], kt[8];
#pragma unroll
          for (int e4 = 0; e4 < 4; ++e4) { const f32x4 gv = *(const LAS f32x4*)(G + stok * 128 + c16 + 4 * e4), gm = *(const LAS f32x4*)(GM + c16 + 4 * e4), ge = *(const LAS f32x4*)(GE + c16 + 4 * e4);
              float ke[4];
#pragma unroll
              for (int e = 0; e < 4; ++e) { const float kk = 1.f - fg[4 * e4 + e]; ke[e] = kk * __builtin_amdgcn_exp2f(ge[e] - gv[e]);
                  if (OUT) { const float a = qv[4 * e4 + e] * __builtin_amdgcn_exp2f(gv[e] - gm[e]), c = kk * __builtin_amdgcn_exp2f(gm[e] - gv[e]);
                      if (e & 1) { qt[2 * e4 + (e >> 1)] |= f2bf(a) << 16; kt[2 * e4 + (e >> 1)] |= f2bf(c) << 16; } else { qt[2 * e4 + (e >> 1)] = f2bf(a); kt[2 * e4 + (e >> 1)] = f2bf(c); } } }
#pragma unroll
              for (int e = 0; e < 4; ++e) { const int col = c16 + 4 * e4 + e;
                  *(LAS bf16*)(lds + HG_KE + col * 144 + sperm * 2) = (bf16)f2bf(ke[e]);
                  const unsigned vw = i8[e4 >> 1][(2 * e4 + (e >> 1)) & 3]; *(LAS bf16*)(lds + HG_VT + col * 144 + sperm * 2) = (bf16)((e & 1) ? (vw >> 16) : (vw & 0xffffu)); } }
          if (OUT) { *(LAS v4u*)(lds + HG_QT + stok * 272 + c16 * 2) = (v4u){qt[0], qt[1], qt[2], qt[3]}; *(LAS v4u*)(lds + HG_QT + stok * 272 + c16 * 2 + 16) = (v4u){qt[4], qt[5], qt[6], qt[7]};
                     *(LAS v4u*)(lds + HG_KT + stok * 272 + c16 * 2) = (v4u){kt[0], kt[1], kt[2], kt[3]}; *(LAS v4u*)(lds + HG_KT + stok * 272 + c16 * 2 + 16) = (v4u){kt[4], kt[5], kt[6], kt[7]}; } }
        __syncthreads();
        if (ch + 1 < HSEG / 64) HG_RAWLOAD(t0 + 64);
        if (OUT) {
            f32x16 X0, X1, O;
#pragma unroll
            for (int i = 0; i < 16; ++i) { X0[i] = 0.f; X1[i] = 0.f; O[i] = 0.f; }
            const LAS unsigned char* qtp = lds + HG_QT + (32 * tr + r) * 272 + hf * 16;
#pragma unroll
            for (int ks = 0; ks < 8; ++ks) { const s16x8 bq = *(const LAS s16x8*)(qtp + ks * 32);
                const s16x8 a0 = *(const LAS s16x8*)(lds + HG_KT + r * 272 + hf * 16 + ks * 32); X0 = __builtin_amdgcn_mfma_f32_32x32x16_bf16(a0, bq, X0, 0, 0, 0);
                if (tr == 1) { const s16x8 a1 = *(const LAS s16x8*)(lds + HG_KT + (32 + r) * 272 + hf * 16 + ks * 32); X1 = __builtin_amdgcn_mfma_f32_32x32x16_bf16(a1, bq, X1, 0, 0, 0); } }
#pragma unroll
            for (int i = 0; i < 16; ++i) { const bool keep = crow16(i, hf) <= r; if (tr == 0) X0[i] = keep ? X0[i] : 0.f; else X1[i] = keep ? X1[i] : 0.f; }
            const LAS unsigned char* vtp = lds + HG_VT + (32 * vq + r) * 144 + hf * 16;
#pragma unroll
            for (int s2 = 0; s2 < 2; ++s2) { v4u pw; pw.x = cvtpk(X0[8 * s2], X0[8 * s2 + 1]); pw.y = cvtpk(X0[8 * s2 + 2], X0[8 * s2 + 3]); pw.z = cvtpk(X0[8 * s2 + 4], X0[8 * s2 + 5]); pw.w = cvtpk(X0[8 * s2 + 6], X0[8 * s2 + 7]);
                const s16x8 bv = *(const LAS s16x8*)(vtp + (16 * s2) * 2); O = __builtin_amdgcn_mfma_f32_32x32x16_bf16(__builtin_bit_cast(s16x8, pw), bv, O, 0, 0, 0); }
            if (tr == 1) {
#pragma unroll
                for (int s2 = 0; s2 < 2; ++s2) { v4u pw; pw.x = cvtpk(X1[8 * s2], X1[8 * s2 + 1]); pw.y = cvtpk(X1[8 * s2 + 2], X1[8 * s2 + 3]); pw.z = cvtpk(X1[8 * s2 + 4], X1[8 * s2 + 5]); pw.w = cvtpk(X1[8 * s2 + 6], X1[8 * s2 + 7]);
                    const s16x8 bv = *(const LAS s16x8*)(vtp + (32 + 16 * s2) * 2); O = __builtin_amdgcn_mfma_f32_32x32x16_bf16(__builtin_bit_cast(s16x8, pw), bv, O, 0, 0, 0); } }
            const LAS unsigned char* stp = lds + HG_ST + (32 * vq + r) * 272 + hf * 16;
#pragma unroll
            for (int ks = 0; ks < 8; ++ks) { const s16x8 aq = *(const LAS s16x8*)(qtp + ks * 32), bs = *(const LAS s16x8*)(stp + ks * 32); O = __builtin_amdgcn_mfma_f32_32x32x16_bf16(aq, bs, O, 0, 0, 0); }
#pragma unroll
            for (int i = 0; i < 16; ++i) G[(32 * tr + crow16(i, hf)) * 128 + 32 * vq + r] = O[i];
        }
#pragma unroll
        for (int dd = 0; dd < 2; ++dd) { const int dr = 2 * tr + dd;
#pragma unroll
            for (int g4 = 0; g4 < 4; ++g4) { const f32x4 ge = *(const LAS f32x4*)(EGE + 32 * dr + 8 * g4 + 4 * hf);
                S[dd][4 * g4] *= ge.x; S[dd][4 * g4 + 1] *= ge.y; S[dd][4 * g4 + 2] *= ge.z; S[dd][4 * g4 + 3] *= ge.w; }
#pragma unroll
            for (int ks = 0; ks < 4; ++ks) { const s16x8 a = *(const LAS s16x8*)(lds + HG_KE + (32 * dr + r) * 144 + hf * 16 + ks * 32), bv = *(const LAS s16x8*)(lds + HG_VT + (32 * vq + r) * 144 + hf * 16 + ks * 32);
                S[dd] = __builtin_amdgcn_mfma_f32_32x32x16_bf16(a, bv, S[dd], 0, 0, 0); } }
        __syncthreads();
        if (OUT) {
            float ov[16]; float ss = 0.f;
#pragma unroll
            for (int e4 = 0; e4 < 4; ++e4) { const f32x4 o4 = *(const LAS f32x4*)(G + stok * 128 + c16 + 4 * e4); ov[4 * e4] = o4.x; ov[4 * e4 + 1] = o4.y; ov[4 * e4 + 2] = o4.z; ov[4 * e4 + 3] = o4.w;
                ss += (o4.x * o4.x + o4.y * o4.y) + (o4.z * o4.z + o4.w * o4.w); }
            ss += xorf<1>(ss); ss += xorf<2>(ss); ss += xorf<4>(ss);
            const float rr = 1.f / sqrtf(ss * (1.f / 128.f) + 1e-6f);
            unsigned ow[8];
            float of[16];
#pragma unroll
            for (int w = 0; w < 8; ++w) { const unsigned gw_ = g8[w >> 2][w & 3]; of[2 * w] = ov[2 * w] * (rr * 16.f) * ng16[2 * w] * sigmoidf_(bflo(gw_)); of[2 * w + 1] = ov[2 * w + 1] * (rr * 16.f) * ng16[2 * w + 1] * sigmoidf_(bfhi(gw_)); }
#pragma unroll
            for (int w = 0; w < 4; ++w) ow[w] = pk4_fp8(of[4 * w], of[4 * w + 1], of[4 * w + 2], of[4 * w + 3]);
            *(v4u*)((unsigned char*)mix + (t0 + stok) * 1024 + hh * 128 + c16) = (v4u){ow[0], ow[1], ow[2], ow[3]};
            __syncthreads();
        }
    }
#undef HG_RAWLOAD
    if (!OUT) {
#pragma unroll
        for (int dd = 0; dd < 2; ++dd)
#pragma unroll
            for (int i = 0; i < 16; ++i) Sp[(32 * (2 * tr + dd) + crow16(i, hf)) * 128] = (bf16)f2bf(S[dd][i]);
        if (cpart == 3) Dseg[(size_t)unit * 128 + cd] = __builtin_amdgcn_exp2f(gsum);
    }
}
__device__ __forceinline__ void hgrn_scan(float* Sloc, const float* Dseg, size_t gtid, size_t gthreads) {
    for (size_t idx = gtid; idx < (size_t)NBATCH * HG_H * 16384; idx += gthreads) { const int bh = (int)(idx >> 14), e = (int)(idx & 16383), d = e >> 7; float cur = 0.f;
        bf16* __restrict__ sp = (bf16*)Sloc + (size_t)bh * HNSEG * 16384 + e; const float* __restrict__ dp = Dseg + (size_t)bh * HNSEG * 128 + d;
        for (int s0 = 0; s0 < HNSEG; s0 += 16) { float tv[16], dv[16];
#pragma unroll
            for (int k = 0; k < 16; ++k) { tv[k] = bf2f(sp[(size_t)(s0 + k) * 16384]); dv[k] = dp[(s0 + k) * 128]; }
#pragma unroll
            for (int k = 0; k < 16; ++k) { sp[(size_t)(s0 + k) * 16384] = (bf16)f2bf(cur); cur = dv[k] * cur + tv[k]; } } }
}

template <bool MASK>
__device__ __forceinline__ void attn4(const LAS unsigned* Ks, const LAS bf16* Vs, const LAS float* qst, LAS float* pb, int lane, const int (&tq)[4], int kbase, float slope,
                                      float (&mo)[4], float (&lo)[4], float (&oo)[4]) {
    float sc[4][4];
#pragma unroll
    for (int a = 0; a < 4; ++a)
#pragma unroll
        for (int c = 0; c < 4; ++c) sc[a][c] = 0.f;
#pragma unroll 4
    for (int dd = 0; dd < 32; ++dd) {
        f32x2 qv[4];
#pragma unroll
        for (int qi = 0; qi < 4; ++qi) qv[qi] = *(const LAS f32x2*)(qst + qi * 64 + 2 * dd);
#pragma unroll
        for (int kk = 0; kk < 4; ++kk) { const unsigned kw = Ks[(lane + 64 * kk) * 33 + dd]; const float k0 = bflo(kw), k1 = bfhi(kw);
#pragma unroll
            for (int qi = 0; qi < 4; ++qi) sc[qi][kk] += qv[qi].x * k0 + qv[qi].y * k1; }
    }
#pragma unroll
    for (int qi = 0; qi < 4; ++qi) { float mx = -INFINITY;
#pragma unroll
        for (int kk = 0; kk < 4; ++kk) { const int pos = kbase + lane + 64 * kk; float lg = sc[qi][kk] * 0.125f - slope * (float)(tq[qi] - pos); if (MASK && pos > tq[qi]) lg = -INFINITY; sc[qi][kk] = lg; mx = fmaxf(mx, lg); }
        mx = wave_max(mx); float s = 0.f;
#pragma unroll
        for (int kk = 0; kk < 4; ++kk) { const float p = __builtin_amdgcn_exp2f((sc[qi][kk] - mx) * 1.4426950408889634f); pb[qi * 256 + lane + 64 * kk] = p; s += p; }
        lo[qi] = wave_sum(s); mo[qi] = mx; }
    float o[4] = {0.f, 0.f, 0.f, 0.f};
#pragma unroll 4
    for (int k4 = 0; k4 < 64; ++k4) { f32x4 p4[4];
#pragma unroll
        for (int qi = 0; qi < 4; ++qi) p4[qi] = *(const LAS f32x4*)(pb + qi * 256 + 4 * k4);
#pragma unroll
        for (int jj = 0; jj < 4; ++jj) { const float vv = bf2f(Vs[(4 * k4 + jj) * 64 + lane]);
#pragma unroll
            for (int qi = 0; qi < 4; ++qi) o[qi] += p4[qi][jj] * vv; } }
#pragma unroll
    for (int qi = 0; qi < 4; ++qi) oo[qi] = o[qi];
}
constexpr int AT_KS = 0, AT_VS = 33792, AT_WV = 66560, AT_WVB = 5120;

__device__ __forceinline__ void memattn_unit(LAS unsigned char* lds, const bf16* h, int NC, int qoff, const bf16* kv, bf16* mix, int unit, int tid, int wave, int lane) {
    const int chunk = unit & 31, bm = unit >> 5, mh = bm & 3, b = bm >> 2;
    LAS unsigned* Ks = (LAS unsigned*)(lds + AT_KS); LAS unsigned* Vs32 = (LAS unsigned*)(lds + AT_VS);
    LAS float* qst = (LAS float*)(lds + AT_WV + wave * AT_WVB); LAS float* pb = qst + 256;
    for (int i = 0; i < 16; ++i) { const int idx = tid + 512 * i, r = idx >> 5, dd = idx & 31; const unsigned* src = (const unsigned*)(kv + (size_t)(b * 256 + r) * 512 + mh * 64);
        Ks[r * 33 + dd] = src[dd]; Vs32[r * 32 + dd] = src[128 + dd]; }
    __syncthreads();
    for (int qd = 0; qd < 16; ++qd) { const size_t tg = (size_t)b * SEQ + chunk * 512 + wave * 64 + qd * 4;
#pragma unroll
        for (int qi = 0; qi < 4; ++qi) qst[qi * 64 + lane] = bf2f(h[(tg + qi) * NC + qoff + mh * 64 + lane]);
        const int tq[4] = {0, 0, 0, 0}; float m[4], l[4], o[4];
        attn4<false>(Ks, (const LAS bf16*)Vs32, qst, pb, lane, tq, 0, 0.f, m, l, o);
#pragma unroll
        for (int qi = 0; qi < 4; ++qi) mix[(tg + qi) * 1024 + MIXW + mh * 64 + lane] = (bf16)f2bf(o[qi] / l[qi]); }
    __syncthreads();
}

constexpr int AT2_K = 0, AT2_KROW = 176, AT2_V = 256 * AT2_KROW, AT2_VROW = 528, AT2_SCR = AT2_V + 64 * AT2_VROW, AT2_SCRW = 4864;
__device__ __forceinline__ void stage_kv_images(LAS unsigned char* lds, const bf16* kp, const bf16* vp, size_t row_stride, int tid) {
    v4u kx[4], vx[4];
#pragma unroll
    for (int i = 0; i < 4; ++i) { const int idx = tid + 512 * i, key = idx >> 3, c = idx & 7; kx[i] = *(const v4u*)(kp + (size_t)key * row_stride + 8 * c); vx[i] = *(const v4u*)(vp + (size_t)key * row_stride + 8 * c); }
    __builtin_amdgcn_sched_barrier(0);
#pragma unroll
    for (int i = 0; i < 4; ++i) { const int idx = tid + 512 * i, key = idx >> 3, c = idx & 7;
        *(LAS v4u*)(lds + AT2_K + key * AT2_KROW + c * 16) = kx[i];
        const int pos = (key & ~15) | (key & 3) | ((key & 4) << 1) | ((key & 8) >> 1);
        LAS bf16* vt = (LAS bf16*)(lds + AT2_V) + pos;
#pragma unroll
        for (int w = 0; w < 4; ++w) { vt[(8 * c + 2 * w) * (AT2_VROW / 2)] = (bf16)(vx[i][w] & 0xffffu); vt[(8 * c + 2 * w + 1) * (AT2_VROW / 2)] = (bf16)(vx[i][w] >> 16); } }
    if (tid < 256) { const unsigned pb = f2bf((float)tid); const v4u e0 = {pb | (pb << 16), 0x3F803F80u, 0u, 0u}, z = {0u, 0u, 0u, 0u};
        *(LAS v4u*)(lds + AT2_K + tid * AT2_KROW + 128) = e0; *(LAS v4u*)(lds + AT2_K + tid * AT2_KROW + 144) = z; }
}
template <bool MASK>
__device__ __forceinline__ void attn_tile32(const LAS unsigned char* lds, const s16x8 (&qf)[4], int lane, float dist0, unsigned qx, unsigned qx2, bool own, f32x16 (&o)[2], float& mrow, float& lrow) {
    const int r = lane & 31, hf = lane >> 5;
    const v4u qxv = {qx, qx2, 0u, 0u}; const s16x8 qe = __builtin_bit_cast(s16x8, qxv);
    f32x16 acc[8];
    const LAS unsigned char* kb = lds + AT2_K + r * AT2_KROW + hf * 16;
    constexpr int NKS = MASK ? 5 : 4;
    s16x8 kf[NKS];
#pragma unroll
    for (int s = 0; s < NKS; ++s) kf[s] = *(const LAS s16x8*)(kb + s * 32);
#pragma unroll
    for (int kt = 0; kt < 8; ++kt) {
#pragma unroll
        for (int i = 0; i < 16; ++i) acc[kt][i] = 0.f;
#pragma unroll
        for (int s = 0; s < NKS; ++s) { acc[kt] = __builtin_amdgcn_mfma_f32_32x32x16_bf16(kf[s], s < 4 ? qf[s < 4 ? s : 0] : qe, acc[kt], 0, 0, 0);
            if (kt + 1 < 8) kf[s] = *(const LAS s16x8*)(kb + (kt + 1) * 32 * AT2_KROW + s * 32); }
        __builtin_amdgcn_sched_barrier(0); }
    float mx = -INFINITY;
    if (MASK) { mx = 0.f;
        if (own) { const float base2 = dist0 - 4.f * (float)hf;
#pragma unroll
            for (int kt = 0; kt < 8; ++kt)
#pragma unroll
                for (int i = 0; i < 16; ++i) { const float dist = base2 - (float)(32 * kt + (i & 3) + 8 * (i >> 2)); acc[kt][i] = dist < 0.f ? -INFINITY : acc[kt][i]; } }
    } else {
#pragma unroll
        for (int kt = 0; kt < 8; ++kt)
#pragma unroll
            for (int i = 0; i < 16; ++i) mx = fmaxf(mx, acc[kt][i]);
        mx = fmaxf(mx, xor32f(mx, lane));
    }
    f32x2 sum2 = {0.f, 0.f};
#pragma unroll
    for (int i = 0; i < 16; ++i) { o[0][i] = 0.f; o[1][i] = 0.f; }
    const LAS unsigned char* vb = lds + AT2_V + r * AT2_VROW + hf * 16;
    s16x8 vf[4];
#pragma unroll
    for (int s2 = 0; s2 < 2; ++s2)
#pragma unroll
        for (int dt = 0; dt < 2; ++dt) vf[2 * s2 + dt] = *(const LAS s16x8*)(vb + dt * 32 * AT2_VROW + (16 * s2) * 2);
#pragma unroll
    for (int kt = 0; kt < 8; ++kt) {
#pragma unroll
        for (int i = 0; i < 16; ++i) acc[kt][i] = __builtin_amdgcn_exp2f(MASK ? acc[kt][i] : acc[kt][i] - mx);
#pragma unroll
        for (int i = 0; i < 8; ++i) sum2 += (f32x2){acc[kt][2 * i], acc[kt][2 * i + 1]};
#pragma unroll
        for (int s2 = 0; s2 < 2; ++s2) { v4u pw; pw.x = cvtpk(acc[kt][8 * s2], acc[kt][8 * s2 + 1]); pw.y = cvtpk(acc[kt][8 * s2 + 2], acc[kt][8 * s2 + 3]);
            pw.z = cvtpk(acc[kt][8 * s2 + 4], acc[kt][8 * s2 + 5]); pw.w = cvtpk(acc[kt][8 * s2 + 6], acc[kt][8 * s2 + 7]); const s16x8 pf = __builtin_bit_cast(s16x8, pw);
#pragma unroll
            for (int dt = 0; dt < 2; ++dt) { o[dt] = __builtin_amdgcn_mfma_f32_32x32x16_bf16(vf[2 * s2 + dt], pf, o[dt], 0, 0, 0);
                if (kt + 1 < 8) vf[2 * s2 + dt] = *(const LAS s16x8*)(vb + dt * 32 * AT2_VROW + (32 * (kt + 1) + 16 * s2) * 2); } }
        __builtin_amdgcn_sched_barrier(0); }
    float sum = sum2.x + sum2.y; sum += xor32f(sum, lane);
    if (!MASK) mrow = mx;
    lrow = sum;
}
__device__ __forceinline__ void memattn_unit2(LAS unsigned char* lds, const bf16* h, int NC, int qoff, const bf16* kv  , bf16* mix, int unit, int tid, int wave, int lane) {
    const int chunk = unit & 63, bm = unit >> 6, mh = bm & 3, b = bm >> 2, r = lane & 31, hf = lane >> 5;
    const bf16* kvrow0 = kv + (size_t)(b * 256) * 2048 + mh * 64;
    stage_kv_images(lds, kvrow0, kvrow0 + 256, 2048, tid);
    __syncthreads();
    { const size_t tg = (size_t)b * SEQ + chunk * 256 + wave * 32 + r;
        f32x16 o[2]; float m2, l; s16x8 qf[4];
#pragma unroll
        for (int s = 0; s < 4; ++s) qf[s] = *(const s16x8*)(h + tg * NC + qoff + mh * 64 + 16 * s + 8 * hf);
        attn_tile32<false>(lds, qf, lane, 0.f, 0u, 0u, false, o, m2, l);
        const float inv = 16.f / l; unsigned char* mp = (unsigned char*)mix + tg * 1024 + MIXW + mh * 64 + 4 * hf;
#pragma unroll
        for (int dt = 0; dt < 2; ++dt)
#pragma unroll
            for (int g = 0; g < 4; ++g) *(unsigned*)(mp + 32 * dt + 8 * g) = pk4_fp8(o[dt][4 * g] * inv, o[dt][4 * g + 1] * inv, o[dt][4 * g + 2] * inv, o[dt][4 * g + 3] * inv); }
    __syncthreads();
}
__device__ __forceinline__ void kmean_unit(LAS unsigned char* lds, const bf16* h, float* kmean, float* kmaxg, int unit, int tid, int wave) {
    const int n = unit & 63, bh = unit >> 6, hh = bh % MB_H, b = bh / MB_H, d = tid & 63, part = tid >> 6;
    LAS float* red = (LAS float*)lds;
    float s = 0.f; const bf16* p = h + ((size_t)b * SEQ + n * 256 + part * 32) * NC_M + 768 + hh * 64 + d;
    for (int i = 0; i < 32; ++i) s += bf2f(p[(size_t)i * NC_M]);
    float ss = 0.f; { const v4u* kp = (const v4u*)(h + ((size_t)b * SEQ + n * 256 + (tid >> 1)) * NC_M + 768 + hh * 64 + (tid & 1) * 32);
#pragma unroll
        for (int w = 0; w < 4; ++w) { const v4u x = kp[w]; ss += bflo(x.x) * bflo(x.x) + bfhi(x.x) * bfhi(x.x) + bflo(x.y) * bflo(x.y) + bfhi(x.y) * bfhi(x.y) + bflo(x.z) * bflo(x.z) + bfhi(x.z) * bfhi(x.z) + bflo(x.w) * bflo(x.w) + bfhi(x.w) * bfhi(x.w); } }
    ss += xorf<1>(ss); ss = wave_max(ss);
    red[part * 64 + d] = s; if ((tid & 63) == 0) red[512 + wave] = ss; __syncthreads();
    if (tid < 64) { float a = 0.f; for (int pp = 0; pp < 8; ++pp) a += red[pp * 64 + tid]; a *= (1.f / 256.f);
        const unsigned hi = f2bf(a), lo = f2bf(a - __builtin_bit_cast(float, hi << 16)); bf16* kmh = (bf16*)kmean; kmh[((size_t)bh * 64 + n) * 64 + tid] = (bf16)hi; kmh[(size_t)24 * 4096 + ((size_t)bh * 64 + n) * 64 + tid] = (bf16)lo; }
    if (tid == 0) { float mx = 0.f; for (int w = 0; w < 8; ++w) mx = fmaxf(mx, red[512 + w]); kmaxg[bh * 64 + n] = sqrtf(mx) * 1.001f; }
    __syncthreads();
}
__device__ __forceinline__ void gate_unit_core(const s16x8 (&qf)[4], const s16x8 (&kf)[4], const bf16* kmh, const bf16* kml, LAS int* hist, const LAS float* kmx, int* selinfo, int bh, int c, int t, int lane, unsigned& sel, unsigned& rr) {
    const int hh = bh % MB_H, b = bh / MB_H, hf = lane >> 5, r = lane & 31;
    int s0 = 0, s1 = 0, s2 = 0, r0 = 0, r1 = 0, r2 = 0, ns = 0;
    float v0 = -INFINITY, v1 = -INFINITY, v2 = -INFINITY, qn = 0.f, lown = 0.f;
    if (c > 0) {
        const int ntile = (c + 31) >> 5, ch = c - 4 * hf;
        s16x8 ah[2][4], al[2][4];
#pragma unroll
        for (int tile = 0; tile < 2; ++tile) if (tile < ntile) { const size_t ko = ((size_t)bh * 64 + 32 * tile + r) * 64 + 8 * hf;
#pragma unroll
            for (int ks = 0; ks < 4; ++ks) { ah[tile][ks] = *(const s16x8*)(kmh + ko + 16 * ks); al[tile][ks] = *(const s16x8*)(kml + ko + 16 * ks); } }
#pragma unroll
        for (int tile = 0; tile < 2; ++tile) if (tile < ntile) {
            f32x16 X;
#pragma unroll
            for (int i = 0; i < 16; ++i) X[i] = 0.f;
#pragma unroll
            for (int ks = 0; ks < 4; ++ks) { X = __builtin_amdgcn_mfma_f32_32x32x16_bf16(ah[tile][ks], qf[ks], X, 0, 0, 0); X = __builtin_amdgcn_mfma_f32_32x32x16_bf16(al[tile][ks], qf[ks], X, 0, 0, 0); }
#pragma unroll
            for (int i = 0; i < 16; ++i) { const int n = 32 * tile + (i & 3) + 8 * (i >> 2); const float g = (n < ch) ? X[i] : -INFINITY;
                if (g > v0) { v2 = v1; s2 = s1; v1 = v0; s1 = s0; v0 = g; s0 = n; } else if (g > v1) { v2 = v1; s2 = s1; v1 = g; s1 = n; } else if (g > v2) { v2 = g; s2 = n; } }
        }
        s0 += 4 * hf; s1 += 4 * hf; s2 += 4 * hf;
        { float qq = 0.f, qk = 0.f;
#pragma unroll
          for (int s = 0; s < 4; ++s)
#pragma unroll
              for (int jj = 0; jj < 8; ++jj) { const float qv = bf2f((bf16)qf[s][jj]), kv = bf2f((bf16)kf[s][jj]); qq += qv * qv; qk += qv * kv; }
          qq += xor32f(qq, lane); qk += xor32f(qk, lane);
          qn = sqrtf(qq) * 1.001f; lown = qk; }
        { float pv[3]; int ps[3]; const int pl = (lane ^ 32) << 2;
          pv[0] = __builtin_bit_cast(float, __builtin_amdgcn_ds_bpermute(pl, __builtin_bit_cast(int, v0))); pv[1] = __builtin_bit_cast(float, __builtin_amdgcn_ds_bpermute(pl, __builtin_bit_cast(int, v1)));
          pv[2] = __builtin_bit_cast(float, __builtin_amdgcn_ds_bpermute(pl, __builtin_bit_cast(int, v2)));
          ps[0] = __builtin_amdgcn_ds_bpermute(pl, s0); ps[1] = __builtin_amdgcn_ds_bpermute(pl, s1); ps[2] = __builtin_amdgcn_ds_bpermute(pl, s2);
#pragma unroll
          for (int k = 0; k < 3; ++k) { const float g = pv[k]; const int n = ps[k];
              if (g > v0 || (g == v0 && n < s0)) { v2 = v1; s2 = s1; v1 = v0; s1 = s0; v0 = g; s0 = n; } else if (g > v1 || (g == v1 && n < s1)) { v2 = v1; s2 = s1; v1 = g; s1 = n; } else if (g > v2 || (g == v2 && n < s2)) { v2 = g; s2 = n; } } }
    }
    sel = 0u; rr = 0u;
    if (hf == 0) {
        ns = c < 3 ? c : 3; s0 &= 63; s1 &= 63; s2 &= 63;
        { const float slope2 = (hh < 8 ? ldexpf(1.0f, -(hh + 1)) : ldexpf(0.70710678118654752f, -(hh - 8))) * 1.4426950408889634f;
          const bool k0 = ns > 0 && (qn * kmx[s0] - slope2 * (float)(t - (s0 * 256 + 255)) - lown) > -64.f;
          const bool k1 = ns > 1 && (qn * kmx[s1] - slope2 * (float)(t - (s1 * 256 + 255)) - lown) > -64.f;
          const bool k2 = ns > 2 && (qn * kmx[s2] - slope2 * (float)(t - (s2 * 256 + 255)) - lown) > -64.f;
          ns = (k0 ? 1 : 0) | (k1 ? 2 : 0) | (k2 ? 4 : 0); }
        if (ns & 1) r0 = __hip_atomic_fetch_add(hist + s0, 1, __ATOMIC_RELAXED, __HIP_MEMORY_SCOPE_WORKGROUP);
        if (ns & 2) r1 = __hip_atomic_fetch_add(hist + s1, 1, __ATOMIC_RELAXED, __HIP_MEMORY_SCOPE_WORKGROUP);
        if (ns & 4) r2 = __hip_atomic_fetch_add(hist + s2, 1, __ATOMIC_RELAXED, __HIP_MEMORY_SCOPE_WORKGROUP);
        selinfo[((size_t)b * SEQ + t) * MB_H + hh] = ns;
        sel = (unsigned)s0 | ((unsigned)s1 << 6) | ((unsigned)s2 << 12) | ((unsigned)ns << 18); rr = (unsigned)r0 | ((unsigned)r1 << 8) | ((unsigned)r2 << 16);
    }
}
__device__ __forceinline__ void moba_gate_wg(LAS unsigned char* lds, const bf16* h, const float* kmean, const float* kmaxg, unsigned* gcount, int* selinfo, unsigned* list, int blk, int tid) {
    constexpr int NU = 24 * MB_NB / GRID;
    static_assert(NU * GRID == 24 * MB_NB && GRID % 64 == 0 && NU * 64 <= NTHR, "gate deal");
    const int lane = tid & 63, r = lane & 31, hf = lane >> 5, wv = tid >> 6;
    const bf16* kmh = (const bf16*)kmean; const bf16* kml = kmh + (size_t)24 * 4096;
    LAS int* hist = (LAS int*)(lds + 16384); LAS int* base = hist + NU * 64; LAS float* kmx = (LAS float*)(base + NU * 64);
    if (tid < NU * 64) { const int bh = (blk >> 6) + 4 * (tid >> 6); hist[tid] = 0; kmx[tid] = kmaxg[bh * 64 + (tid & 63)]; }
    unsigned sel[NU], rr[NU];
    s16x8 qf[4], kf[4];
#define GU_BH(k) ((blk >> 6) + 4 * (k))
#define GU_C(k) (((k) & 1) ? 63 - (blk & 63) : (blk & 63))
#define GU_T(k) (GU_C(k) * 256 + wv * 32 + r)
    { const bf16* qp = h + ((size_t)(GU_BH(0) / MB_H) * SEQ + GU_T(0)) * NC_M + (GU_BH(0) % MB_H) * 64 + 8 * hf;
#pragma unroll
      for (int s = 0; s < 4; ++s) { qf[s] = *(const s16x8*)(qp + 16 * s); kf[s] = *(const s16x8*)(qp + 768 + 16 * s); } }
    __syncthreads();
#pragma unroll
    for (int k = 0; k < NU; ++k) {
        s16x8 qn_[4], kn_[4];
        if (k + 1 < NU) { const bf16* qp = h + ((size_t)(GU_BH(k + 1) / MB_H) * SEQ + GU_T(k + 1)) * NC_M + (GU_BH(k + 1) % MB_H) * 64 + 8 * hf;
#pragma unroll
            for (int s = 0; s < 4; ++s) { qn_[s] = *(const s16x8*)(qp + 16 * s); kn_[s] = *(const s16x8*)(qp + 768 + 16 * s); } }
        gate_unit_core(qf, kf, kmh, kml, hist + k * 64, kmx + k * 64, selinfo, GU_BH(k), GU_C(k), GU_T(k), lane, sel[k], rr[k]);
        if (k + 1 < NU) {
#pragma unroll
            for (int s = 0; s < 4; ++s) { qf[s] = qn_[s]; kf[s] = kn_[s]; } }
    }
    __syncthreads();
    if (tid < NU * 64) { const int hc = hist[tid]; if (hc > 0) base[tid] = (int)__hip_atomic_fetch_add(gcount + GU_BH(tid >> 6) * 64 + (tid & 63), (unsigned)hc, __ATOMIC_RELAXED, __HIP_MEMORY_SCOPE_AGENT); }
    __syncthreads();
    if (hf == 0) {
#pragma unroll
        for (int k = 0; k < NU; ++k) { unsigned* lp = list + ((size_t)GU_BH(k) * 64 << 14); const unsigned sl = sel[k], rk = rr[k], t = (unsigned)GU_T(k); const int s0 = sl & 63, s1 = (sl >> 6) & 63, s2 = (sl >> 12) & 63;
            if (sl & (1u << 18)) lp[((size_t)s0 << 14) + base[k * 64 + s0] + (rk & 255u)] = t;
            if (sl & (2u << 18)) lp[((size_t)s1 << 14) + base[k * 64 + s1] + ((rk >> 8) & 255u)] = t | (1u << 14);
            if (sl & (4u << 18)) lp[((size_t)s2 << 14) + base[k * 64 + s2] + ((rk >> 16) & 255u)] = t | (2u << 14); } }
#undef GU_BH
#undef GU_C
#undef GU_T
    __syncthreads();
}
__device__ __forceinline__ void moba_attn_item(LAS unsigned char* lds, const bf16* h, const unsigned* gcount, const unsigned* list, float* po, float* pml, int item, int tid, int wave, int lane) {
    const int n = item / 24, bh = item - n * 24, hh = bh % MB_H, b = bh / MB_H;
    LAS unsigned* Ks = (LAS unsigned*)(lds + AT_KS); LAS unsigned* Vs32 = (LAS unsigned*)(lds + AT_VS);
    LAS float* qst = (LAS float*)(lds + AT_WV + wave * AT_WVB); LAS float* pb = qst + 256;
    for (int i = 0; i < 16; ++i) { const int idx = tid + 512 * i, r = idx >> 5, dd = idx & 31; const unsigned* src = (const unsigned*)(h + ((size_t)b * SEQ + n * 256 + r) * NC_M + hh * 64);
        Ks[r * 33 + dd] = src[384 + dd]; Vs32[r * 32 + dd] = src[768 + dd]; }
    __syncthreads();
    const int cnt = (int)gcount[bh * 64 + n], total = 256 + cnt, nquads = (total + 3) >> 2;
    const float slope = hh < 8 ? ldexpf(1.0f, -(hh + 1)) : ldexpf(0.70710678118654752f, -(hh - 8));
    const unsigned* lp = list + (((size_t)bh * 64 + n) << 14);
    for (int quad = wave; quad < nquads; quad += 8) {
        int tq[4], slot[4];
#pragma unroll
        for (int qi = 0; qi < 4; ++qi) { int idx = quad * 4 + qi; idx = idx < total ? idx : total - 1;
            if (idx < 256) { tq[qi] = n * 256 + idx; slot[qi] = 3; } else { const unsigned e = lp[idx - 256]; tq[qi] = (int)(e & 16383u); slot[qi] = (int)(e >> 14); } }
#pragma unroll
        for (int qi = 0; qi < 4; ++qi) qst[qi * 64 + lane] = bf2f(h[((size_t)b * SEQ + tq[qi]) * NC_M + hh * 64 + lane]);
        float m[4], l[4], o[4];
        attn4<true>(Ks, (const LAS bf16*)Vs32, qst, pb, lane, tq, n * 256, slope, m, l, o);
#pragma unroll
        for (int qi = 0; qi < 4; ++qi) if (quad * 4 + qi < total) { const size_t pi = (((size_t)b * SEQ + tq[qi]) * MB_H + hh) * 4 + slot[qi];
            po[pi * 64 + lane] = o[qi]; if (lane == 0) { pml[pi * 2] = m[qi]; pml[pi * 2 + 1] = l[qi]; } }
    }
    __syncthreads();
}

__device__ __forceinline__ void moba_attn_item2(LAS unsigned char* lds, const bf16* h, const float* kmaxg, const unsigned* gcount, const unsigned* list, bf16* po, float* pml, int item, int tid, int wave, int lane) {
    const int n = item / 24, bh = item - n * 24, hh = bh % MB_H, b = bh / MB_H, r = lane & 31, hf = lane >> 5;
    const bf16* hrow0 = h + ((size_t)b * SEQ + n * 256) * NC_M + hh * 64;
    stage_kv_images(lds, hrow0 + 768, hrow0 + 1536, NC_M, tid);
    __syncthreads();
    const int cnt = (int)gcount[bh * 64 + n], total = 256 + cnt, ntiles = (total + 31) >> 5;
    const float slope2 = (hh < 8 ? ldexpf(1.0f, -(hh + 1)) : ldexpf(0.70710678118654752f, -(hh - 8))) * 1.4426950408889634f;
    const unsigned shi = f2bf(slope2), slo = f2bf(slope2 - __builtin_bit_cast(float, shi << 16)); const unsigned qx = hf == 0 ? (shi | (slo << 16)) : 0u;
    const unsigned* lp = list + (((size_t)bh * 64 + n) << 14);
    const float kmx1 = kmaxg[bh * 64 + n];
    const bf16* hq = h + (size_t)b * SEQ * NC_M + hh * 64 + 8 * hf;
#pragma unroll 1
    for (int tile = wave; tile < ntiles; tile += NWAVES) {
        int idx = tile * 32 + r; const bool valid = idx < total; idx = valid ? idx : total - 1;
        int tq, slot; if (idx < 256) { tq = n * 256 + idx; slot = 3; } else { const unsigned e = lp[idx - 256]; tq = (int)(e & 16383u); slot = (int)(e >> 14); }
        s16x8 qf[4]; { const bf16* qp = hq + (size_t)tq * NC_M;
#pragma unroll
            for (int s = 0; s < 4; ++s) qf[s] = *(const s16x8*)(qp + 16 * s); }
        f32x16 o[2]; float m2, l; const float dist0 = (float)(tq - n * 256);
        unsigned qx2;
        { float qq = 0.f;
#pragma unroll
          for (int s = 0; s < 4; ++s)
#pragma unroll
              for (int jj = 0; jj < 8; ++jj) { const float qv = bf2f((bf16)qf[s][jj]); qq += qv * qv; }
          qq += xor32f(qq, lane);
          const float sh = sqrtf(qq) * kmx1 + slope2 * fminf(dist0, 255.f);
          const unsigned nh = f2bf(-sh), nl = f2bf(-sh - __builtin_bit_cast(float, nh << 16)); qx2 = hf == 0 ? (nh | (nl << 16)) : 0u;
          m2 = -(__builtin_bit_cast(float, nh << 16) + __builtin_bit_cast(float, nl << 16)); }
        attn_tile32<true>(lds, qf, lane, dist0, qx, qx2, tile < 8, o, m2, l);
        { LAS unsigned char* sw = lds + AT2_SCR + wave * AT2_SCRW; const int pi = valid ? (int)((((size_t)b * SEQ + tq) * MB_H + hh) * 4 + slot) : -1;
#pragma unroll
          for (int dt = 0; dt < 2; ++dt)
#pragma unroll
              for (int g = 0; g < 4; ++g) { v2u w; w.x = cvtpk(o[dt][4 * g], o[dt][4 * g + 1]); w.y = cvtpk(o[dt][4 * g + 2], o[dt][4 * g + 3]); *(LAS v2u*)(sw + r * 144 + (32 * dt + 8 * g + 4 * hf) * 2) = w; }
          if (hf == 0) { *(LAS int*)(sw + 4608 + 4 * r) = pi; if (valid) { pml[(size_t)pi * 2] = m2 - slope2 * dist0; pml[(size_t)pi * 2 + 1] = l; } }
#pragma unroll
          for (int it = 0; it < 4; ++it) { const int q = 8 * it + (lane >> 3), c = lane & 7; const int pq = *(const LAS int*)(sw + 4608 + 4 * q); const v4u row = *(const LAS v4u*)(sw + q * 144 + c * 16);
              if (pq >= 0) *(v4u*)(po + (size_t)pq * 64 + c * 8) = row; } }
    }
    __syncthreads();
}
__device__ __forceinline__ void moba_combine(const bf16* __restrict__ po, const float* __restrict__ pml, const int* __restrict__ selinfo, bf16* __restrict__ mix, int gw, int ngw, int lane) {
    const int sub = lane >> 4, d4 = (lane & 15) * 4;
#pragma unroll 8
    for (int idx = gw * 4 + sub; idx < T * MB_H; idx += ngw * 4) { const int tg = idx / MB_H, hh = idx - tg * MB_H, ns = selinfo[idx]; const size_t p4 = (size_t)idx * 4;
        f32x2 ml[4]; f32x4 ov[4];
#pragma unroll
        for (int j = 0; j < 4; ++j) { const size_t pj = p4 + ((j == 3 || ((ns >> j) & 1)) ? j : 3);
            ml[j] = __builtin_nontemporal_load((const f32x2*)pml + pj); const v2u ow = __builtin_nontemporal_load((const v2u*)(po + pj * 64 + d4)); ov[j] = (f32x4){bflo(ow.x), bfhi(ow.x), bflo(ow.y), bfhi(ow.y)}; }
        float M = ml[3].x;
#pragma unroll
        for (int j = 0; j < 3; ++j) { const bool ok = (ns >> j) & 1; ml[j].x = ok ? ml[j].x : -INFINITY; ml[j].y = ok ? ml[j].y : 0.f; M = fmaxf(M, ml[j].x);
            ov[j].x = ok ? ov[j].x : 0.f; ov[j].y = ok ? ov[j].y : 0.f; ov[j].z = ok ? ov[j].z : 0.f; ov[j].w = ok ? ov[j].w : 0.f; }
        float den = 0.f; f32x4 num = {0.f, 0.f, 0.f, 0.f};
#pragma unroll
        for (int j = 0; j < 4; ++j) { const float w = __builtin_amdgcn_exp2f(ml[j].x - M); den += w * ml[j].y; num += ov[j] * w; }
        const float inv = 16.f / den;
        *(unsigned*)((unsigned char*)mix + (size_t)tg * 1024 + hh * 64 + d4) = pk4_fp8(num.x * inv, num.y * inv, num.z * inv, num.w * inv); }
}

template <int CTRL> __device__ __forceinline__ float dppf(float v) { return __builtin_bit_cast(float, __builtin_amdgcn_update_dpp(0, __builtin_bit_cast(int, v), CTRL, 0xF, 0xF, true)); }
template <int CTRL> __device__ __forceinline__ int dppi(int v) { return __builtin_amdgcn_update_dpp(0, v, CTRL, 0xF, 0xF, true); }
__device__ __forceinline__ float wave_sum_dpp(float v) {
    v += dppf<0xB1>(v); v += dppf<0x4E>(v); v += dppf<0x141>(v); v += dppf<0x140>(v);
    v += __builtin_bit_cast(float, __builtin_amdgcn_update_dpp(0, __builtin_bit_cast(int, v), 0x142, 0xA, 0xF, false));
    v += __builtin_bit_cast(float, __builtin_amdgcn_update_dpp(0, __builtin_bit_cast(int, v), 0x143, 0xC, 0xF, false));
    return __builtin_bit_cast(float, __builtin_amdgcn_readlane(__builtin_bit_cast(int, v), 63));
}
__device__ __forceinline__ void ln_row(f32x4 (&v)[4], const f32x4 (&gv)[4], const f32x4 (&bv)[4]) {
    float s = 0.f;
#pragma unroll
    for (int j = 0; j < 4; ++j) s += (v[j].x + v[j].y) + (v[j].z + v[j].w);
    const float mean = wave_sum_dpp(s) * (1.f / D); float s2 = 0.f;
#pragma unroll
    for (int j = 0; j < 4; ++j) { v[j] = v[j] - mean; s2 += (v[j].x * v[j].x + v[j].y * v[j].y) + (v[j].z * v[j].z + v[j].w * v[j].w); }
    const float rstd = __builtin_amdgcn_rsqf(wave_sum_dpp(s2) * (1.f / D) + 1e-5f);
#pragma unroll
    for (int j = 0; j < 4; ++j) v[j] = v[j] * rstd * gv[j] + bv[j];
}
__device__ __forceinline__ void split_router_weights(const float* wr  , bf16* wrs  , size_t gtid, size_t gthreads) {
    for (size_t i = gtid; i < (size_t)DEPTH * D * NE; i += gthreads) { const int e = (int)(i & 31), d = (int)((i >> 5) & 1023), l = (int)(i >> 15);
        const float w = wr[i]; const unsigned hi = f2bf(w); const unsigned lo = f2bf(w - __builtin_bit_cast(float, hi << 16));
        wrs[(((size_t)l * 2 + 0) * NE + e) * D + d] = (bf16)hi; wrs[(((size_t)l * 2 + 1) * NE + e) * D + d] = (bf16)lo; }
}
constexpr int L1_XH = 0, L1_XL = 33024, L1_ROW = 2064, L1_PART = 66048, L1_HIST = 82432, L1_TOK = 82944;
__device__ __forceinline__ void phase_ln1(LAS unsigned char* lds, const bf16* y, const float* g, const float* bb, const bf16* wrs  , const float* br,
                                          bf16* xbf, unsigned char* x8, int* tok_e, int* tok_lr, float* tok_w, int* blk_cnt, int blk, int tid, int wave, int lane) {
    LAS float* part = (LAS float*)(lds + L1_PART);
    LAS int* hist = (LAS int*)(lds + L1_HIST); LAS int* tokl = (LAS int*)(lds + L1_TOK);
    if (tid < 32) hist[tid] = 0;
    constexpr int TPB = T / GRID;
    const int e = lane & 31, m16 = lane & 15, quad = lane >> 4;
    s16x8 bw[4][2][2];
#pragma unroll
    for (int ks = 0; ks < 4; ++ks)
#pragma unroll
        for (int nt = 0; nt < 2; ++nt)
#pragma unroll
            for (int pp = 0; pp < 2; ++pp) bw[ks][nt][pp] = *(const s16x8*)(wrs + ((size_t)pp * NE + 16 * nt + m16) * D + wave * 128 + 32 * ks + 8 * quad);
    const float bre = br[e];
    f32x4 gv[4], bv[4];
#pragma unroll
    for (int j = 0; j < 4; ++j) { gv[j] = ((const f32x4*)g)[lane + 64 * j]; bv[j] = ((const f32x4*)bb)[lane + 64 * j]; }
    v2u xn[2][4], yn[2][4];
#pragma unroll
    for (int u = 0; u < 2; ++u) { const size_t t0 = (size_t)blk * TPB + 2 * wave + u; const v2u* xr = (const v2u*)(xbf + t0 * D) + lane; const v2u* yr = (const v2u*)(y + t0 * D) + lane;
#pragma unroll
        for (int j = 0; j < 4; ++j) { xn[u][j] = __builtin_nontemporal_load(xr + 64 * j); yn[u][j] = __builtin_nontemporal_load(yr + 64 * j); } }
#pragma unroll
    for (int j = 0; j < 4; ++j) asm volatile("" :: "v"(gv[j]), "v"(bv[j]), "v"(xn[0][j]), "v"(xn[1][j]), "v"(yn[0][j]), "v"(yn[1][j]));
#pragma unroll
    for (int ks = 0; ks < 4; ++ks) asm volatile("" :: "v"(bw[ks][0][0]), "v"(bw[ks][0][1]), "v"(bw[ks][1][0]), "v"(bw[ks][1][1]));
    asm volatile("" :: "v"(bre));
    __syncthreads();
    for (int grp = 0; grp < TPB / 16; ++grp) { const size_t tg0 = (size_t)blk * TPB + grp * 16 + 2 * wave;
        f32x4 v[2][4];
#pragma unroll
        for (int u = 0; u < 2; ++u)
#pragma unroll
            for (int j = 0; j < 4; ++j) { const v2u xw = xn[u][j]; const v2u yw = yn[u][j];
                v[u][j].x = DN_ALPHA * bflo(xw.x) + bflo(yw.x); v[u][j].y = DN_ALPHA * bfhi(xw.x) + bfhi(yw.x); v[u][j].z = DN_ALPHA * bflo(xw.y) + bflo(yw.y); v[u][j].w = DN_ALPHA * bfhi(xw.y) + bfhi(yw.y); }
        if (grp + 1 < TPB / 16) {
#pragma unroll
            for (int u = 0; u < 2; ++u) { const v2u* xr = (const v2u*)(xbf + (tg0 + 16 + u) * D) + lane; const v2u* yr = (const v2u*)(y + (tg0 + 16 + u) * D) + lane;
#pragma unroll
                for (int j = 0; j < 4; ++j) { xn[u][j] = __builtin_nontemporal_load(xr + 64 * j); yn[u][j] = __builtin_nontemporal_load(yr + 64 * j); } } }
#pragma unroll
        for (int u = 0; u < 2; ++u) { ln_row(v[u], gv, bv);
            v2u* xb = (v2u*)(xbf + (tg0 + u) * D) + lane; unsigned* x8r = (unsigned*)(x8 + (tg0 + u) * D) + lane;
#pragma unroll
            for (int j = 0; j < 4; ++j) { v2u hw; hw.x = cvtpk(v[u][j].x, v[u][j].y); hw.y = cvtpk(v[u][j].z, v[u][j].w); xb[64 * j] = hw;
                x8r[64 * j] = pk4_fp8(bflo(hw.x), bfhi(hw.x), bflo(hw.y), bfhi(hw.y));
                v2u lw; lw.x = cvtpk(v[u][j].x - bflo(hw.x), v[u][j].y - bfhi(hw.x)); lw.y = cvtpk(v[u][j].z - bflo(hw.y), v[u][j].w - bfhi(hw.y));
                *(LAS v2u*)(lds + L1_XH + (2 * wave + u) * L1_ROW + (4 * lane + 256 * j) * 2) = hw; *(LAS v2u*)(lds + L1_XL + (2 * wave + u) * L1_ROW + (4 * lane + 256 * j) * 2) = lw; } }
        __syncthreads();
        { f32x4 acc[2] = {{0.f, 0.f, 0.f, 0.f}, {0.f, 0.f, 0.f, 0.f}};
#pragma unroll
          for (int ks = 0; ks < 4; ++ks) { const int off = m16 * L1_ROW + (wave * 128 + 32 * ks + 8 * quad) * 2;
              const s16x8 ah = *(const LAS s16x8*)(lds + L1_XH + off), al = *(const LAS s16x8*)(lds + L1_XL + off);
#pragma unroll
              for (int nt = 0; nt < 2; ++nt) { acc[nt] = __builtin_amdgcn_mfma_f32_16x16x32_bf16(ah, bw[ks][nt][0], acc[nt], 0, 0, 0); acc[nt] = __builtin_amdgcn_mfma_f32_16x16x32_bf16(ah, bw[ks][nt][1], acc[nt], 0, 0, 0);
                  acc[nt] = __builtin_amdgcn_mfma_f32_16x16x32_bf16(al, bw[ks][nt][0], acc[nt], 0, 0, 0); } }
#pragma unroll
          for (int nt = 0; nt < 2; ++nt)
#pragma unroll
              for (int jj = 0; jj < 4; ++jj) part[(wave * 16 + 4 * quad + jj) * 32 + 16 * nt + m16] = acc[nt][jj]; }
        __syncthreads();
#pragma unroll
        for (int u = 0; u < 2; ++u) { const size_t t = tg0 + u;
            float logit = bre;
#pragma unroll
            for (int w = 0; w < 8; ++w) logit += part[(w * 16 + 2 * wave + u) * 32 + e];
            int se[4]; float sv[4]; int cur = __builtin_bit_cast(int, logit); cur ^= (cur >> 31) & 0x7fffffff;
#pragma unroll
            for (int k = 0; k < 4; ++k) { int m = cur;
                m = max(m, dppi<0xB1>(m)); m = max(m, dppi<0x4E>(m)); m = max(m, dppi<0x141>(m)); m = max(m, dppi<0x140>(m));
                const int mm = max(__builtin_amdgcn_readlane(m, 0), __builtin_amdgcn_readlane(m, 16));
                const unsigned long long mk = __ballot(cur == mm); const int src = __builtin_ctzll(mk);
                se[k] = src; sv[k] = __builtin_bit_cast(float, mm ^ ((mm >> 31) & 0x7fffffff)); cur = (e == src) ? (int)0x80000000 : cur; }
            const float e1 = __expf(sv[1] - sv[0]), e2 = __expf(sv[2] - sv[0]), e3 = __expf(sv[3] - sv[0]), inv = __builtin_amdgcn_rcpf(1.f + e1 + e2 + e3);
            const float wk[4] = {inv, e1 * inv, e2 * inv, e3 * inv};
            if (lane == 0) { const int tl = (grp * 16 + 2 * wave + u) * 4;
#pragma unroll
                for (int k = 0; k < 4; ++k) { const int lr = __hip_atomic_fetch_add(hist + se[k], 1, __ATOMIC_RELAXED, __HIP_MEMORY_SCOPE_WORKGROUP);
                    tokl[tl + k] = se[k]; tokl[512 + tl + k] = lr; tokl[1024 + tl + k] = __builtin_bit_cast(int, wk[k]); } } }
    }
    __syncthreads();
    if (tid < 32) blk_cnt[blk * 32 + tid] = hist[tid];
    { const size_t ti = (size_t)blk * TPB * 4 + tid; tok_e[ti] = tokl[tid]; tok_lr[ti] = tokl[512 + tid]; tok_w[ti] = __builtin_bit_cast(float, tokl[1024 + tid]); }
    __syncthreads();
}
__device__ __forceinline__ void phase_dispatch(LAS unsigned char* lds, const int* __restrict__ blk_cnt, const int* __restrict__ tok_e, const int* __restrict__ tok_lr, int* __restrict__ tok_row, int* __restrict__ tab,
                                               int* __restrict__ rowtok, int blk, int tid, int wave, int lane) {
    LAS int* tot = (LAS int*)lds; LAS int* pre = tot + 32; LAS int* pst = pre + 32; LAS int* rows = pst + 64;
    LAS int* red = rows + 512;
    static_assert(GRID == 256 && NTHR == 512, "16 thread groups x 16 blocks");
    { const int e = tid & 31, part = tid >> 5; int s = 0, p = 0;
#pragma unroll
      for (int i = 0; i < 16; ++i) { const int bb = part * 16 + i; const int c = blk_cnt[bb * 32 + e]; s += c; p += (bb < blk) ? c : 0; }
      red[part * 32 + e] = s; red[512 + part * 32 + e] = p; }
    __syncthreads();
    if (tid < 32) { int s = 0, p = 0;
#pragma unroll
        for (int q = 0; q < 16; ++q) { s += red[q * 32 + tid]; p += red[512 + q * 32 + tid]; }
        tot[tid] = s; pre[tid] = p; }
    __syncthreads();
    if (tid == 0) { int acc = 0; for (int e = 0; e < 32; ++e) { pst[e] = acc; acc += ((tot[e] + 255) >> 8) << 8; } pst[32] = acc; }
    __syncthreads();
    if (blk == 0 && tid < 33) tab[tid] = pst[tid] >> 8;
    constexpr int TPB = T / GRID;
    static_assert(TPB * 4 == NTHR, "one (token, k) pair per thread");
    { const size_t ti = (size_t)blk * TPB * 4 + tid; const int e = tok_e[ti]; const int r = pst[e] + pre[e] + tok_lr[ti]; tok_row[ti] = r; rowtok[r] = blk * TPB + (tid >> 2); }
    if (blk < NE) { const int r0 = pst[blk] + tot[blk], npad = pst[blk + 1] - r0; if (tid < npad) rowtok[r0 + tid] = 0; }
    __syncthreads();
}
__device__ __forceinline__ f32x4 fp8x4_to_f32(unsigned w) {
    const f32x2 lo = __builtin_amdgcn_cvt_pk_f32_fp8((int)w, false), hi = __builtin_amdgcn_cvt_pk_f32_fp8((int)w, true); return (f32x4){lo.x, lo.y, hi.x, hi.y};
}
__device__ __forceinline__ void phase_ln2(const unsigned char* __restrict__ yrows, const int* __restrict__ tok_row, const float* __restrict__ tok_w, const float* __restrict__ g, const float* __restrict__ bb,
                                          float* __restrict__ xout, bf16* xbf, unsigned char* x8n, int gw, int ngw, int lane) {
    f32x4 gv[4], bv[4];
#pragma unroll
    for (int j = 0; j < 4; ++j) { gv[j] = ((const f32x4*)g)[lane + 64 * j]; bv[j] = ((const f32x4*)bb)[lane + 64 * j]; }
    constexpr int NTK = 2;
    static_assert(T % (NTK * GRID * NWAVES) == 0, "NTK tokens per wave per step");
    for (int t0 = gw; t0 < T; t0 += NTK * ngw) {
        f32x4 v[NTK][4];
#pragma unroll
        for (int u = 0; u < NTK; ++u) { const int t = t0 + u * ngw; int r[4]; float w[4];
#pragma unroll
            for (int k = 0; k < 4; ++k) { r[k] = tok_row[(size_t)t * 4 + k]; w[k] = tok_w[(size_t)t * 4 + k] * (1.f / 16.f); }
            const v2u* xr = (const v2u*)(xbf + (size_t)t * D) + lane;
#pragma unroll
            for (int j = 0; j < 4; ++j) { f32x4 f = {0.f, 0.f, 0.f, 0.f};
#pragma unroll
                for (int k = 0; k < 4; ++k) { const unsigned yw = __builtin_nontemporal_load((const unsigned*)(yrows + (size_t)r[k] * D) + lane + 64 * j); f += fp8x4_to_f32(yw) * w[k]; }
                const v2u xw = __builtin_nontemporal_load(xr + 64 * j); v[u][j].x = DN_ALPHA * bflo(xw.x) + f.x; v[u][j].y = DN_ALPHA * bfhi(xw.x) + f.y; v[u][j].z = DN_ALPHA * bflo(xw.y) + f.z; v[u][j].w = DN_ALPHA * bfhi(xw.y) + f.w; } }
#pragma unroll
        for (int u = 0; u < NTK; ++u) { const int t = t0 + u * ngw;
            ln_row(v[u], gv, bv);
            if (xout) { f32x4* xo = (f32x4*)(xout + (size_t)t * D) + lane;
#pragma unroll
                for (int j = 0; j < 4; ++j) __builtin_nontemporal_store(v[u][j], xo + 64 * j); }
            else { v2u* xb = (v2u*)(xbf + (size_t)t * D) + lane;
#pragma unroll
                for (int j = 0; j < 4; ++j) { v2u ww; ww.x = pk2(v[u][j].x, v[u][j].y); ww.y = pk2(v[u][j].z, v[u][j].w); __builtin_nontemporal_store(ww, xb + 64 * j);
                    if (x8n) ((unsigned*)(x8n + (size_t)t * D))[lane + 64 * j] = pk4_fp8(bflo(ww.x), bfhi(ww.x), bflo(ww.y), bfhi(ww.y)); } } } }
}


struct Args { const float* in[20]; float* out; unsigned char* ws; int l_lo, l_hi, ph_lo, ph_hi; };
typedef const __attribute__((address_space(4))) Args* KArgsP;
#define KA_LOAD() ({ KArgsP p_ = (KArgsP)__builtin_amdgcn_kernarg_segment_ptr(); asm volatile("" : "+s"(p_)); p_; })
#ifndef PHMASK
#define PHMASK 0xFFFF
#endif
#ifndef REPEAT_MASK
#define REPEAT_MASK 0
#endif
#ifndef REPEAT_LMASK
#define REPEAT_LMASK 0xF
#endif
#define PH_BEGIN(k) _Pragma("unroll") for (int rep_ = 0; rep_ < ((((REPEAT_MASK >> (k)) & 1) && ((REPEAT_LMASK >> l) & 1)) ? 2 : 1); ++rep_) { if ((PHMASK >> (k)) & 1) { KArgsP ka = KA_LOAD(); unsigned char* ws = ka->ws; int tid = threadIdx.x; asm volatile("" : "+v"(tid)); \
    const int lane = tid & 63, wave = __builtin_amdgcn_readfirstlane(tid >> 6); int blk = blockIdx.x; asm volatile("" : "+s"(blk)); \
    const int gw = blk * NWAVES + wave; const size_t gtid = (size_t)blk * NTHR + tid; (void)lane; (void)gw; (void)gtid; (void)ws;
#if ONE_LAUNCH
#define PH_SEAM() do { XcdBarrier b_; b_.bar = (unsigned*)(KA_LOAD()->ws + WS_CTL) + CW_BAR; b_.x = xb_xcc_id(); b_.st = (volatile LAS unsigned*)(lds + MISC_OFF); xcd_barrier(b_); } while (0)
#else
#define PH_SEAM() do {} while (0)
#endif
#define PH_END() PH_SEAM(); } }
#define PH_END_NOSEAM() } }
#define WSP(type, off) ((type*)(ws + (off)))
constexpr int G = GRID, NGW = GRID * NWAVES; constexpr size_t GTHREADS = (size_t)GRID * NTHR;
template <int L> __device__ __forceinline__ void layer_phases(LAS unsigned char* lds) {
    constexpr int l = L; LAS int* tabL = (LAS int*)(lds + MISC_OFF + 256);

        const int j = l >> 1; const bool moba = (l & 1) != 0;
        const int NC = moba ? NC_M : NC_H, qoff = moba ? 2304 : 3072;

        if (l == 0) {
        PH_BEGIN(1)
            phase_weights((LAS float*)(lds + wave * 16384), gw, NGW, lane, ka->in[2], NC_H, ka->in[6], 4, ka->in[7], ka->in[12], ka->in[14], ka->in[16], WSP(bf16, WS_WIN), WSP(bf16, WS_WKV4), WSP(bf16, WS_WO), WSP(bf16, WS_WGU), WSP(bf16, WS_WD), 1, true);
        PH_END()
        }
        PH_BEGIN(2)
            {
              int sw_ = 0x7A7A7A7A, sx_ = 0x7F7F7F7F; asm volatile("" : "+s"(sw_), "+s"(sx_));
              pg8::Gemm g{WSP(bf16, WS_MIX), WSP(bf16, WS_WIN), T, NC, D / 2, sw_, sx_, nullptr}; constexpr int NCT_ = ((l & 1) ? NC_M : NC_H) / 256; pg8::StaticOrderT<T / 256, NCT_> S{G, blk}; pg8::EpiPlain E{WSP(bf16, WS_H), NC, moba ? 0x207u : 0x1000u, 0.125f * 1.4426950408889634f};
              pg8::gemm_phase<pg8::EpiPlain, pg8::StaticOrderT<T / 256, NCT_>, true, true, true>(lds, g, S, E); }
            if (l == 0) {
              pg8::Gemm g{WSP(bf16, WS_MEMBF), WSP(bf16, WS_WKV4), 512, 2048, D, 0, 0}; pg8::StaticOrder S; S.init(512, 2048, G, blk >= 128 ? blk - 128 : G); pg8::EpiPlain E{WSP(bf16, WS_KV4), 2048, 0u, 1.f};
              pg8::gemm_phase<pg8::EpiPlain, pg8::StaticOrder, true, true>(lds, g, S, E); }
        PH_END()
        if (!moba) {
            PH_BEGIN(3)
                for (int u = blk; u < NBATCH * HG_H * HNSEG; u += G) hgrn_mfma<false>(lds, WSP(bf16, WS_H), ka->in[3], j, ka->in[4] + j * 128, WSP(float, WS_SLOC), WSP(float, WS_DSEG), WSP(bf16, WS_MIX), u, tid, wave, lane);
                for (int u = blk; u < 512; u += G) memattn_unit2(lds, WSP(bf16, WS_H), NC, qoff, WSP(bf16, WS_KV4) + 512 * l, WSP(bf16, WS_MIX), u, tid, wave, lane);
            PH_END()
            PH_BEGIN(4)
                hgrn_scan(WSP(float, WS_SLOC), WSP(float, WS_DSEG), gtid, GTHREADS);
            PH_END()
            PH_BEGIN(5)
                for (int u = blk; u < NBATCH * HG_H * HNSEG; u += G) hgrn_mfma<true>(lds, WSP(bf16, WS_H), ka->in[3], j, ka->in[4] + j * 128, WSP(float, WS_SLOC), WSP(float, WS_DSEG), WSP(bf16, WS_MIX), u, tid, wave, lane);
            PH_END()
        } else {
            PH_BEGIN(3)
                for (int u = blk; u < 24 * MB_NB; u += G) kmean_unit(lds, WSP(bf16, WS_H), WSP(float, WS_KMEAN), WSP(float, WS_KMEAN + 512 * 1024), u, tid, wave);
                for (int u = blk; u < 512; u += G) memattn_unit2(lds, WSP(bf16, WS_H), NC, qoff, WSP(bf16, WS_KV4) + 512 * l, WSP(bf16, WS_MIX), u, tid, wave, lane);
            PH_END()
            PH_BEGIN(4)
                moba_gate_wg(lds, WSP(bf16, WS_H), WSP(float, WS_KMEAN), WSP(float, WS_KMEAN + 512 * 1024), WSP(unsigned, WS_CTL) + CW_GCOUNT + j * 1536, WSP(int, WS_SELINFO), WSP(unsigned, WS_LIST), blk, tid);
            PH_END()
            PH_BEGIN(5)
                { unsigned* qhead = WSP(unsigned, WS_CTL) + CW_GCOUNT + 2 * 1536 + 64 * j; LAS int* itl = (LAS int*)(lds + MISC_OFF + 512);
                  for (;;) { if (tid == 0) *itl = (int)__hip_atomic_fetch_add(qhead, 1u, __ATOMIC_RELAXED, __HIP_MEMORY_SCOPE_AGENT);
                      __syncthreads(); const int it = *itl; __syncthreads();
                      if (it >= 24 * MB_NB) break;
                      moba_attn_item2(lds, WSP(bf16, WS_H), WSP(float, WS_KMEAN + 512 * 1024), WSP(unsigned, WS_CTL) + CW_GCOUNT + j * 1536, WSP(unsigned, WS_LIST), WSP(bf16, WS_PO), WSP(float, WS_PML), it, tid, wave, lane); } }
            PH_END()
            PH_BEGIN(6)
                moba_combine(WSP(bf16, WS_PO), WSP(float, WS_PML), WSP(int, WS_SELINFO), WSP(bf16, WS_MIX), gw, NGW, lane);
            PH_END()
        }
        PH_BEGIN(7)
            int sw_ = 0x7A7A7A7A, sx_ = 0x7B7B7B7B; asm volatile("" : "+s"(sw_), "+s"(sx_));
            pg8::Gemm g{WSP(bf16, WS_MIX), WSP(bf16, WS_WO), T, D, D / 2, sw_, sx_, nullptr}; pg8::StaticOrderT<T / 256, D / 256> S{G, blk}; pg8::EpiPlain E{WSP(bf16, WS_Y), D, 0u, 1.f};
            pg8::gemm_phase<pg8::EpiPlain, pg8::StaticOrderT<T / 256, D / 256>, true, true, true>(lds, g, S, E);
        PH_END()
        PH_BEGIN(8)
            phase_ln1(lds, WSP(bf16, WS_Y), ka->in[8] + l * D, ka->in[9] + l * D, WSP(bf16, WS_WRS) + (size_t)l * 2 * NE * D, ka->in[11] + l * NE, WSP(bf16, WS_XBF), WSP(unsigned char, WS_H),
                      WSP(int, WS_TOK + TOK_E), WSP(int, WS_TOK + TOK_LR), WSP(float, WS_TOK + TOK_W), WSP(int, WS_TOK + TOK_BLKCNT), blk, tid, wave, lane);
        PH_END()
        PH_BEGIN(9)
            phase_dispatch(lds, WSP(int, WS_TOK + TOK_BLKCNT), WSP(int, WS_TOK + TOK_E), WSP(int, WS_TOK + TOK_LR), WSP(int, WS_TOK + TOK_ROW), WSP(int, WS_TOK + TOK_TAB), WSP(int, WS_H + 64 * MiB), blk, tid, wave, lane);
            { const size_t moff = (size_t)l * NE * 1024 * 1024;
              phase_weights((LAS float*)(lds + wave * 16384), gw, NGW, lane, ka->in[2], NC_H, ka->in[6], 0, ka->in[7], ka->in[12] + moff, ka->in[14] + moff, ka->in[16] + moff,
                            WSP(bf16, WS_WIN), WSP(bf16, WS_WKV4), WSP(bf16, WS_WO), WSP(bf16, WS_WGU), WSP(bf16, WS_WD), 2); }
        PH_END()
        PH_BEGIN(10)
            if (tid < 33) tabL[tid] = WSP(int, WS_TOK + TOK_TAB)[tid];
            __syncthreads();
            LAS int* t2e = (LAS int*)(lds + 139264);
            { const int nt_ = tabL[32];
              for (int t = tid; t < nt_; t += NTHR) { int e_ = 0;
#pragma unroll
                  for (int kk = 1; kk < 32; ++kk) e_ += (tabL[kk] <= t) ? 1 : 0;
                  t2e[t] = e_; } }
            __syncthreads();
            int sw_ = 0x7A7A7A7A, sx_ = 0x7F7F7F7F; asm volatile("" : "+s"(sw_), "+s"(sx_));
            pg8::Gemm g{WSP(bf16, WS_H), WSP(bf16, WS_WGU), MOE_MAXROWS, NE * 2048, D / 2, sw_, sx_, WSP(int, WS_H + 64 * MiB)};   pg8::MoeOrderT<8> S{t2e, blk, tabL[32], false};
            pg8::EpiSwiglu E{WSP(unsigned char, WS_HID), ka->in[13] + (size_t)l * NE * 1024, ka->in[15] + (size_t)l * NE * 1024};
            pg8::gemm_phase<pg8::EpiSwiglu, pg8::MoeOrderT<8>, true, true, true, true>(lds, g, S, E);
            { const size_t moff = (size_t)l * NE * 1024 * 1024;
              __syncthreads();
              phase_weights((LAS float*)(lds + wave * 16384), gw, NGW, lane, ka->in[2], NC_H, ka->in[6], 0, ka->in[7], ka->in[12] + moff, ka->in[14] + moff, ka->in[16] + moff,
                            WSP(bf16, WS_WIN), WSP(bf16, WS_WKV4), WSP(bf16, WS_WO), WSP(bf16, WS_WGU), WSP(bf16, WS_WD), 3); }
        PH_END()
        PH_BEGIN(11)
            if (tid < 33) tabL[tid] = WSP(int, WS_TOK + TOK_TAB)[tid];
            __syncthreads();
            LAS int* t2e = (LAS int*)(lds + 139264);
            { const int nt_ = tabL[32];
              for (int t = tid; t < nt_; t += NTHR) { int e_ = 0;
#pragma unroll
                  for (int kk = 1; kk < 32; ++kk) e_ += (tabL[kk] <= t) ? 1 : 0;
                  t2e[t] = e_; } }
            __syncthreads();
            int sw_ = 0x79797979, sx_ = 0x83838383; asm volatile("" : "+s"(sw_), "+s"(sx_));
            pg8::Gemm g{WSP(bf16, WS_HID), WSP(bf16, WS_WD), MOE_MAXROWS, NE * 1024, D / 2, sw_, sx_, nullptr}; pg8::MoeOrderT<4> S{t2e, blk, tabL[32], true};
            pg8::EpiDown E{WSP(unsigned char, WS_XS), ka->in[17] + (size_t)l * NE * 1024};
            pg8::gemm_phase<pg8::EpiDown, pg8::MoeOrderT<4>, true, true, true>(lds, g, S, E);
        PH_END()
        PH_BEGIN(12)
            float* x2out = (l == DEPTH - 1) ? ka->out : nullptr;
            phase_ln2(WSP(unsigned char, WS_XS), WSP(int, WS_TOK + TOK_ROW), WSP(float, WS_TOK + TOK_W), ka->in[18] + l * D, ka->in[19] + l * D, x2out, WSP(bf16, WS_XBF), (l + 1 < DEPTH) ? WSP(unsigned char, WS_MIX) : nullptr, gw, NGW, lane);
            if (l + 1 < DEPTH) { constexpr int ln = l + 1, jn = ln >> 1; constexpr bool mn = (ln & 1) != 0;
                const float* win_src = mn ? ka->in[5] + (size_t)jn * D * NC_M : ka->in[2] + (size_t)jn * D * NC_H; const size_t moff = (size_t)ln * NE * 1024 * 1024;
                phase_weights((LAS float*)(lds + wave * 16384), gw, NGW, lane, win_src, mn ? NC_M : NC_H, ka->in[6], 0, ka->in[7] + (size_t)ln * D * D,
                              ka->in[12] + moff, ka->in[14] + moff, ka->in[16] + moff, WSP(bf16, WS_WIN), WSP(bf16, WS_WKV4), WSP(bf16, WS_WO), WSP(bf16, WS_WGU), WSP(bf16, WS_WD), 1, true); }
            if (l + 1 < DEPTH) PH_SEAM();
        PH_END_NOSEAM()
}
__global__ void __launch_bounds__(NTHR, 2) fwd_kernel(Args args) {
    extern __shared__ __attribute__((aligned(16))) unsigned char lds_raw[];
    LAS unsigned char* lds = (LAS unsigned char*)lds_raw;
    if (threadIdx.x < 4) ((LAS unsigned*)(lds + MISC_OFF))[threadIdx.x] = 0u;
    __syncthreads();
#if ONE_LAUNCH
    (void)xcd_barrier_post((unsigned*)(args.ws + WS_CTL) + CW_BAR, (volatile LAS unsigned*)(lds + MISC_OFF));
#endif
    { const int l = 0; (void)l;
    PH_BEGIN(0)
        cvt_rows_bf16_f8(ka->in[0], WSP(bf16, WS_XBF), WSP(unsigned char, WS_MIX), (size_t)T * D / 8, gtid, GTHREADS);
        cvt_rows_bf16(ka->in[1], WSP(bf16, WS_MEMBF), (size_t)512 * D / 8, gtid, GTHREADS);
        split_router_weights(ka->in[10], WSP(bf16, WS_WRS), gtid, GTHREADS);
    PH_END_NOSEAM() }
    layer_phases<0>(lds); layer_phases<1>(lds); layer_phases<2>(lds); layer_phases<3>(lds);
}

extern "C" void kernel_launch(void* const* d_in, const int* in_sizes, int n_in, void* d_out, int out_size, void* d_ws, size_t ws_size, hipStream_t stream) {
    static int ready = 0;
    if (ready == 0) {
        if (n_in != 20 || in_sizes[0] != T * D || out_size != T * D || ws_size < WS_END) { fprintf(stderr, "kernel_launch: unexpected shapes (n_in %d, in0 %d, out %d, ws %zu < %zu)\n", n_in, n_in > 0 ? in_sizes[0] : -1, out_size, ws_size, (size_t)WS_END); ready = -1; return; }
        if (hipFuncSetAttribute((const void*)fwd_kernel, hipFuncAttributeMaxDynamicSharedMemorySize, LDS_BYTES) != hipSuccess) { fprintf(stderr, "kernel_launch: hipFuncSetAttribute failed\n"); ready = -1; return; }
        int per_cu = 0;
        if (hipOccupancyMaxActiveBlocksPerMultiprocessor(&per_cu, (const void*)fwd_kernel, NTHR, LDS_BYTES) != hipSuccess || per_cu < 1) fprintf(stderr, "kernel_launch: occupancy query says %d\n", per_cu);
        (void)hipGetLastError();
        ready = 1;
    }
    if (ready < 0) return;
    if (hipMemsetAsync((char*)d_ws + WS_CTL, 0, CTL_ZERO_BYTES, stream) != hipSuccess) return;
    Args a{};
    for (int i = 0; i < 20; ++i) a.in[i] = (const float*)d_in[i];
    a.out = (float*)d_out; a.ws = (unsigned char*)d_ws;
    a.l_lo = 0; a.l_hi = DEPTH; a.ph_lo = 0; a.ph_hi = NPHASE;
    hipLaunchKernelGGL(fwd_kernel, dim3(GRID), dim3(NTHR), LDS_BYTES, stream, a);
}
```
